# Optimizing an MI355X kernel written in HIP

```python
import jax, jax.numpy as jnp
from jax import lax
import numpy as np

D_MODEL = 1024
BATCH = 8
SEQ = 2048
DEPTH = 2

CHUNK = 64
Q_BLOCK = 128
EPS = 1e-6
NEG = -1e30
MIX_WIDTH = 1024
POOL_WIDTH = 512
POOL_GROUPS = 4
POOL_GROUP_DIM = POOL_WIDTH // POOL_GROUPS
POOL_WINDOWS = (2, 4, 8, 16)
HEAD_DIM = 64
DSA_HEADS = 8
DSA_WIDTH = DSA_HEADS * HEAD_DIM
IDX_HEADS = 4
IDX_DIM = 64
TOPK_MAX = 256
ROPE_THETA = 500000.0
ROPE_DIM = HEAD_DIM // 4
FOX_HEADS = 8
FOX_WIDTH = FOX_HEADS * HEAD_DIM
SGU_WIDTH = 512
SGU_GROUPS = 4
SGU_GROUP_DIM = SGU_WIDTH // SGU_GROUPS
SGU_CHUNK = 128
D_FF = 2816
CONV_W = 3
PLE_DIM = 256
N_EVEN = (DEPTH + 1) // 2
N_ODD = DEPTH // 2
EVEN_IN = POOL_WIDTH + DSA_WIDTH + 2 * HEAD_DIM + IDX_HEADS * IDX_DIM + IDX_DIM + IDX_HEADS
ODD_IN = 3 * FOX_WIDTH + FOX_HEADS + 2 * SGU_WIDTH

kernel_name = 'hybrid_chunk_causal_pool_dsa_fox_sgu'


def rmsnorm(x, g):
    xf = x.astype(jnp.float32)
    y = xf * lax.rsqrt(jnp.mean(xf * xf, axis=-1, keepdims=True) + EPS) * g.astype(jnp.float32)
    return y.astype(x.dtype)


def partial_rope(x, pos):
    half = ROPE_DIM // 2
    inv = ROPE_THETA ** (-jnp.arange(half, dtype=jnp.float32) / half)
    ang = pos.astype(jnp.float32)[..., None] * inv
    cos = jnp.cos(ang)[:, :, None, :]
    sin = jnp.sin(ang)[:, :, None, :]
    xf = x.astype(jnp.float32)
    x1, x2 = xf[..., :half], xf[..., half:ROPE_DIM]
    out = jnp.concatenate([x1 * cos - x2 * sin, x2 * cos + x1 * sin, xf[..., ROPE_DIM:]], axis=-1)
    return out.astype(x.dtype)


def pool_mixer(z, w_pool, s_pool):
    B, S, _ = z.shape
    zf = z.astype(jnp.float32)
    cs = jnp.concatenate([jnp.zeros_like(zf[:, :1]), jnp.cumsum(zf, axis=1)], axis=1)
    t = jnp.arange(S)
    outs = []
    for g, w in enumerate(POOL_WINDOWS):
        sl = slice(g * POOL_GROUP_DIM, (g + 1) * POOL_GROUP_DIM)
        lo = jnp.maximum(t + 1 - w, 0)
        cnt = (t + 1 - lo).astype(jnp.float32)
        cg = cs[..., sl]
        mean = (cg[:, 1:] - cg[:, lo]) / cnt[None, :, None]
        outs.append(mean - zf[..., sl])
    d = jnp.stack(outs, axis=2).astype(z.dtype)
    y = jnp.einsum('bsgc,gcd->bsgd', d, w_pool).reshape(B, S, POOL_WIDTH)
    return y * s_pool


def dsa_mixer(q, k, v, iq, ik, iw):
    B, S = q.shape[:2]
    n_sel = min(TOPK_MAX, S // 4)
    nb = S // Q_BLOCK
    s_chunk = jnp.arange(S) // CHUNK

    def block(n):
        start = n * Q_BLOCK
        qb = lax.dynamic_slice_in_dim(q, start, Q_BLOCK, axis=1)
        iqb = lax.dynamic_slice_in_dim(iq, start, Q_BLOCK, axis=1)
        iwb = lax.dynamic_slice_in_dim(iw, start, Q_BLOCK, axis=1)
        t_chunk = (start + jnp.arange(Q_BLOCK)) // CHUNK
        visible = s_chunk[None, :] <= t_chunk[:, None]
        dots = jax.nn.relu(jnp.einsum('bqhe,bse->bqsh', iqb, ik).astype(jnp.float32) * IDX_DIM ** -0.5)
        score = jnp.einsum('bqsh,bqh->bqs', dots, iwb.astype(jnp.float32) * IDX_HEADS ** -0.5)
        score = jnp.where(visible[None], score, NEG)
        _, idx = lax.top_k(score, n_sel)
        valid = (idx // CHUNK) <= t_chunk[None, :, None]
        k_g = jax.vmap(lambda a, i: a[i])(k, idx)
        v_g = jax.vmap(lambda a, i: a[i])(v, idx)
        logits = jnp.einsum('bqhd,bqkd->bqhk', qb, k_g).astype(jnp.float32) * HEAD_DIM ** -0.5
        logits = jnp.where(valid[:, :, None, :], logits, NEG)
        probs = jax.nn.softmax(logits, axis=-1).astype(v.dtype)
        return jnp.einsum('bqhk,bqkd->bqhd', probs, v_g)

    out = lax.map(block, jnp.arange(nb))
    return jnp.moveaxis(out, 0, 1).reshape(B, S, DSA_WIDTH)


def fox_mixer(q, k, v, f_raw, b_f):
    B, S, H, _ = q.shape
    logf = jax.nn.log_sigmoid(f_raw.astype(jnp.float32) + b_f.astype(jnp.float32))
    cum = jnp.moveaxis(jnp.cumsum(logf, axis=1), 1, 2)
    s_idx = jnp.arange(S)
    nb = S // Q_BLOCK

    def block(n):
        start = n * Q_BLOCK
        qb = lax.dynamic_slice_in_dim(q, start, Q_BLOCK, axis=1)
        cq = lax.dynamic_slice_in_dim(cum, start, Q_BLOCK, axis=2)
        t = start + jnp.arange(Q_BLOCK)
        logits = jnp.einsum('bqhd,bshd->bhqs', qb, k).astype(jnp.float32) * HEAD_DIM ** -0.5
        logits = logits + cq[..., None] - cum[:, :, None, :]
        logits = jnp.where((s_idx[None, :] <= t[:, None])[None, None], logits, NEG)
        probs = jax.nn.softmax(logits, axis=-1).astype(v.dtype)
        return jnp.einsum('bhqs,bshd->bqhd', probs, v)

    out = lax.map(block, jnp.arange(nb))
    return jnp.moveaxis(out, 0, 1).reshape(B, S, FOX_WIDTH)


def sgu_mixer(zs, ln_g, ln_b, w_s, b_s):
    B, S, _ = zs.shape
    a = jax.nn.gelu(zs)
    u, v = jnp.split(a, 2, axis=-1)
    vf = v.astype(jnp.float32)
    mu = jnp.mean(vf, axis=-1, keepdims=True)
    var = jnp.mean((vf - mu) ** 2, axis=-1, keepdims=True)
    v = ((vf - mu) * lax.rsqrt(var + EPS) * ln_g + ln_b).astype(zs.dtype)
    vc = v.reshape(B, S // SGU_CHUNK, SGU_CHUNK, SGU_GROUPS, SGU_GROUP_DIM)
    ci = jnp.arange(SGU_CHUNK) // CHUNK
    mask = ci[None, :] <= ci[:, None]
    w = jnp.where(mask[None], w_s, 0)
    mixed = jnp.einsum('gij,bnjgc->bnigc', w, vc) + b_s.T[None, None, :, :, None]
    return u * mixed.reshape(B, S, SGU_WIDTH)


def even_mixer(hn, positions, w_in, w_out, pool_w, pool_scale):
    B, S, _ = hn.shape
    z = hn @ w_in
    cuts = [int(c) for c in np.cumsum([POOL_WIDTH, DSA_WIDTH, HEAD_DIM, HEAD_DIM, IDX_HEADS * IDX_DIM, IDX_DIM])]
    z_pool, z_q, z_k, z_v, z_iq, z_ik, z_iw = jnp.split(z, cuts, axis=-1)
    y_pool = pool_mixer(z_pool, pool_w, pool_scale)
    q = partial_rope(z_q.reshape(B, S, DSA_HEADS, HEAD_DIM), positions)
    k = partial_rope(z_k[:, :, None, :], positions)[:, :, 0]
    iq = partial_rope(z_iq.reshape(B, S, IDX_HEADS, IDX_DIM), positions)
    ik = partial_rope(z_ik[:, :, None, :], positions)[:, :, 0]
    y_dsa = dsa_mixer(q, k, z_v, iq, ik, z_iw)
    return jnp.concatenate([y_pool, y_dsa], axis=-1) @ w_out


def odd_mixer(hn, w_in, w_out, b_f, ln_g, ln_b, w_s, b_s):
    B, S, _ = hn.shape
    z = hn @ w_in
    cuts = [FOX_WIDTH, 2 * FOX_WIDTH, 3 * FOX_WIDTH, 3 * FOX_WIDTH + FOX_HEADS]
    z_q, z_k, z_v, z_f, z_sgu = jnp.split(z, cuts, axis=-1)
    shp = (B, S, FOX_HEADS, HEAD_DIM)
    y_fox = fox_mixer(z_q.reshape(shp), z_k.reshape(shp), z_v.reshape(shp), z_f, b_f)
    y_sgu = sgu_mixer(z_sgu, ln_g, ln_b, w_s, b_s)
    return jnp.concatenate([y_fox, y_sgu], axis=-1) @ w_out


def conv_ffn(hn, w_in, conv_w, conv_b, w_out):
    S = hn.shape[1]
    a = hn @ w_in
    ap = jnp.pad(a, ((0, 0), (CONV_W - 1, 0), (0, 0)))
    c = sum(ap[:, i:i + S] * conv_w[i] for i in range(CONV_W)) + conv_b
    g, u = jnp.split(c, 2, axis=-1)
    return (jax.nn.gelu(g) * u) @ w_out


def setup_inputs(seed: int = 0) -> dict:
    key = jax.random.key(seed)
    ks = jax.random.split(key, 24)

    def nrm(i, shape, scale):
        return jax.random.normal(ks[i], shape, jnp.float32) * scale

    x = nrm(0, (BATCH, SEQ, D_MODEL), 1.0)
    p = nrm(1, (DEPTH, BATCH, SEQ, PLE_DIM), 1.0)
    offsets = jax.random.randint(ks[2], (BATCH, 1), 0, 16) * CHUNK
    positions = (offsets + jnp.arange(SEQ, dtype=jnp.int32)[None, :]).astype(jnp.int32)
    return {
        'x': x,
        'p': p,
        'positions': positions,
        'norm_mix': 1.0 + nrm(3, (DEPTH, D_MODEL), 0.1),
        'norm_ffn': 1.0 + nrm(4, (DEPTH, D_MODEL), 0.1),
        'norm_ple': 1.0 + nrm(5, (DEPTH, D_MODEL), 0.1),
        'ffn_w_in': nrm(6, (DEPTH, D_MODEL, 2 * D_FF), D_MODEL ** -0.5),
        'ffn_conv_w': nrm(7, (DEPTH, CONV_W, 2 * D_FF), CONV_W ** -0.5),
        'ffn_conv_b': nrm(8, (DEPTH, 2 * D_FF), 0.01),
        'ffn_w_out': nrm(9, (DEPTH, D_FF, D_MODEL), D_FF ** -0.5),
        'ple_w_proj': nrm(10, (DEPTH, PLE_DIM, D_MODEL), PLE_DIM ** -0.5),
        'ple_w_gate': nrm(11, (DEPTH, D_MODEL, D_MODEL), D_MODEL ** -0.5),
        'norm_final': 1.0 + nrm(12, (D_MODEL,), 0.1),
        'ev_w_in': nrm(13, (N_EVEN, D_MODEL, EVEN_IN), D_MODEL ** -0.5),
        'ev_w_out': nrm(14, (N_EVEN, MIX_WIDTH, D_MODEL), MIX_WIDTH ** -0.5),
        'pool_w': nrm(15, (N_EVEN, POOL_GROUPS, POOL_GROUP_DIM, POOL_GROUP_DIM), POOL_GROUP_DIM ** -0.5),
        'pool_scale': 1.0 + nrm(16, (N_EVEN, POOL_WIDTH), 0.1),
        'od_w_in': nrm(17, (N_ODD, D_MODEL, ODD_IN), D_MODEL ** -0.5),
        'od_w_out': nrm(18, (N_ODD, MIX_WIDTH, D_MODEL), MIX_WIDTH ** -0.5),
        'fox_b_f': 3.0 + nrm(19, (N_ODD, FOX_HEADS), 0.5),
        'sgu_ln_g': 1.0 + nrm(20, (N_ODD, SGU_WIDTH), 0.1),
        'sgu_ln_b': nrm(21, (N_ODD, SGU_WIDTH), 0.01),
        'sgu_w': nrm(22, (N_ODD, SGU_GROUPS, SGU_CHUNK, SGU_CHUNK), CHUNK ** -0.5),
        'sgu_b': 1.0 + nrm(23, (N_ODD, SGU_GROUPS, SGU_CHUNK), 0.1),
    }


def reference(x, p, positions, norm_mix, norm_ffn, norm_ple, ffn_w_in, ffn_conv_w, ffn_conv_b,
              ffn_w_out, ple_w_proj, ple_w_gate, norm_final, ev_w_in, ev_w_out, pool_w, pool_scale,
              od_w_in, od_w_out, fox_b_f, sgu_ln_g, sgu_ln_b, sgu_w, sgu_b):
    h = x
    for i in range(DEPTH):
        j = i // 2
        hn = rmsnorm(h, norm_mix[i])
        if i % 2 == 0:
            h = h + even_mixer(hn, positions, ev_w_in[j], ev_w_out[j], pool_w[j], pool_scale[j])
        else:
            h = h + odd_mixer(hn, od_w_in[j], od_w_out[j], fox_b_f[j], sgu_ln_g[j], sgu_ln_b[j],
                              sgu_w[j], sgu_b[j])
        h = h + conv_ffn(rmsnorm(h, norm_ffn[i]), ffn_w_in[i], ffn_conv_w[i], ffn_conv_b[i], ffn_w_out[i])
        gate = jax.nn.sigmoid(rmsnorm(h, norm_ple[i]) @ ple_w_gate[i])
        h = h + (p[i] @ ple_w_proj[i]) * gate
    return rmsnorm(h, norm_final)
```

```cpp
#include <hip/hip_runtime.h>
#include <hip/hip_bf16.h>
#include <cstdio>
#include <cstdint>
#include <cmath>
constexpr int TOK = 16384, DMODEL = 1024, SEQ = 2048, NBATCH = 8;
constexpr int DFF = 2816, NFF2 = 5632, PLE = 256;
constexpr int EV_N = 1536;
constexpr int OD_N = 2816;
constexpr int Z1P = 2560;
constexpr float RMS_EPS = 1e-6f;
constexpr float C2 = 0.125f * 1.4426950408889634f;


__device__ __forceinline__ int lane_opaque() { unsigned z = 0u; asm volatile("" : "+v"(z)); return (int)__builtin_amdgcn_mbcnt_hi(~0u, __builtin_amdgcn_mbcnt_lo(~0u, z)); }
__device__ __forceinline__ float xor16_f(float v) { return __builtin_bit_cast(float, __builtin_amdgcn_ds_swizzle(__builtin_bit_cast(int, v), 0x401F)); }
__device__ __forceinline__ void halves_pair(unsigned v, unsigned& a, unsigned& b) { unsigned w = v; asm volatile("" : "+v"(w)); auto rr = __builtin_amdgcn_permlane32_swap(v, w, false, false); a = rr[0]; b = rr[1]; }
__device__ __forceinline__ float halves_sum_f(float v) { unsigned a, b; halves_pair(__builtin_bit_cast(unsigned, v), a, b); return __builtin_bit_cast(float, a) + __builtin_bit_cast(float, b); }
__device__ __forceinline__ float halves_max_f(float v) { unsigned a, b; halves_pair(__builtin_bit_cast(unsigned, v), a, b); return __builtin_fmaxf(__builtin_bit_cast(float, a), __builtin_bit_cast(float, b)); }
__device__ __forceinline__ unsigned halves_add_u(unsigned v) { unsigned a, b; halves_pair(v, a, b); return a + b; }
__device__ __forceinline__ unsigned halves_or_u(unsigned v) { unsigned a, b; halves_pair(v, a, b); return a | b; }
namespace pg8 {
#define PG8_LAS __attribute__((address_space(3)))
typedef unsigned short bf16_t;
typedef short bf16x8 __attribute__((ext_vector_type(8)));
typedef float f32x4 __attribute__((ext_vector_type(4)));
typedef unsigned u32x4 __attribute__((ext_vector_type(4)));
constexpr int BM = 256, BK = 64, HALF = 128, HTB = HALF * BK * 2  , STAGE_BYTES = 8 * HTB, NXCD = 8, WGM = 8;

__host__ __device__ __forceinline__ int lds_byte(int r, int c) { const int st = (r >> 4) * 2 + (c >> 5), rr = r & 15, cc = c & 31, ob = rr * 64 + cc * 2; return st * 1024 + (ob ^ (((ob >> 9) & 1) << 5)); }
__host__ __device__ __forceinline__ void stage_rc(int b, int& R, int& C) { const int st = b / 1024, sb = b % 1024, swz = sb ^ (((sb >> 9) & 1) << 5); R = (st >> 1) * 16 + swz / 64; C = (st & 1) * 32 + (swz % 64) / 2; }
__host__ __device__ __forceinline__ int perm32(int rho) { const int n = rho >> 4, i = rho & 15; return 8 * (i >> 2) + 4 * n + (i & 3); }

struct Unit { int pm, pn; };
struct Gemm { const bf16_t* A; const bf16_t* Bt; int M, N, K; };

struct StaticOrder {
    int nM, nN, nwg, G, c;
    __host__ __device__ void init(int M, int N, int G_, int c_) { nM = M / BM; nN = N / BM; nwg = nM * nN; G = G_; c = c_; }
    __host__ __device__ bool next(int i, Unit& u) const {
        const long L = (long)i * G + c; if (L >= nwg) return false;
        int wgid = (int)L; { const int q = nwg / NXCD, r = nwg % NXCD, xcd = wgid % NXCD, off = wgid / NXCD; wgid = (xcd < r ? xcd * (q + 1) : r * (q + 1) + (xcd - r) * q) + off; }
        const int nig = WGM * nN, gid = wgid / nig, fm = gid * WGM, gsz = (nM - fm) < WGM ? (nM - fm) : WGM;
        u.pm = fm + ((wgid % nig) % gsz); u.pn = (wgid % nig) / gsz; return true;
    }
    __device__ __forceinline__ void a_ready(const Unit&) const {}
    __device__ __forceinline__ void done(const Unit&) const {}
};

struct OneUnit {
    int pm, pn, on;
    __host__ __device__ bool next(int i, Unit& u) const { if (!on || i != 0) return false; u.pm = pm; u.pn = pn; return true; }
    __device__ __forceinline__ void a_ready(const Unit&) const {}
    __device__ __forceinline__ void done(const Unit&) const {}
};
struct FfnOrder {
    StaticOrder S0; int extra;
    __host__ __device__ void init(int M, int N, int G_, int c_) { S0.init(M, N, G_, c_); extra = (G_ == 256 && c_ >= 128 && c_ < 128 + N / BM) ? 1 : 0; }
    __host__ __device__ bool next(int i, Unit& u) const { if (extra) { if (i == 0) { u.pm = 64; u.pn = S0.c - 128; return true; } return S0.next(i - 1, u); } return S0.next(i, u); }
    __device__ __forceinline__ void a_ready(const Unit&) const {}
    __device__ __forceinline__ void done(const Unit&) const {}
};
typedef float f32x2 __attribute__((ext_vector_type(2)));
typedef unsigned u32x2 __attribute__((ext_vector_type(2)));
__device__ __forceinline__ unsigned cvt_pk_bf16(float lo, float hi) { unsigned r; asm volatile("v_cvt_pk_bf16_f32 %0, %1, %2" : "=v"(r) : "v"(lo), "v"(hi)); return r; }
__device__ __forceinline__ float bf_lo(unsigned w) { return __builtin_bit_cast(float, w << 16); }
__device__ __forceinline__ float bf_hi(unsigned w) { return __builtin_bit_cast(float, w & 0xffff0000u); }
__device__ __forceinline__ float sq4(const f32x4 v) { return (v[0] * v[0] + v[1] * v[1]) + (v[2] * v[2] + v[3] * v[3]); }
__device__ __forceinline__ float row_rstd(const float* ssq, int row) {
    const f32x4* p = (const f32x4*)(ssq + (size_t)row * 16);
    const f32x4 a = p[0], b = p[1], c = p[2], d = p[3];
    const float s = (((a[0] + a[1]) + (a[2] + a[3])) + ((b[0] + b[1]) + (b[2] + b[3]))) + (((c[0] + c[1]) + (c[2] + c[3])) + ((d[0] + d[1]) + (d[2] + d[3])));
    return 1.0f / sqrtf(s * (1.0f / 1024.0f) + RMS_EPS);
}
__device__ __forceinline__ void ssq_write(float* ssq_out, float q, int row, int slot, int fq) {
    q += xor16_f(q); q = halves_sum_f(q);
    if (fq == 0) ssq_out[(size_t)row * 16 + slot] = q;
}
__device__ __forceinline__ float gelu_tanh(float x) {
    const float t = x + 0.044715f * x * x * x;
    const float e = __builtin_amdgcn_exp2f(-2.3022082f * t);
    return x * __builtin_amdgcn_rcpf(1.0f + e);
}
__device__ __forceinline__ float sigmoid_f(float x) { return __builtin_amdgcn_rcpf(1.0f + __builtin_amdgcn_exp2f(-1.4426950408889634f * x)); }


struct EpiRes {
    static constexpr bool PERM = true, AFTER_DRAIN = false;
    const float* basef; const bf16_t* baseb; bf16_t* hb; float* ssq_out; bf16_t* ahalo;
    __device__ __forceinline__ void operator()(const f32x4 (&acc)[2][2][4][2], const Unit& u_, int wr, int wc, int fr, int fq) const {
        Unit u; { int pm_ = u_.pm, pn_ = u_.pn; asm volatile("" : "+s"(pm_), "+s"(pn_)); u.pm = pm_; u.pn = pn_; }
        const int row0 = u.pm * BM + wr * 64 + fr, col0 = u.pn * BM + wc * 32 + 8 * fq;
        if (basef != nullptr) {
#pragma unroll
            for (int ai = 0; ai < 2; ++ai)
#pragma unroll
                for (int m = 0; m < 4; ++m) {
                    const int row = row0 + ai * HALF + m * 16; float q = 0.f;
#pragma unroll
                    for (int bj = 0; bj < 2; ++bj) {
                        const size_t off = (size_t)row * DMODEL + col0 + bj * HALF;
                        const f32x4 b0 = *(const f32x4*)(basef + off), b1 = *(const f32x4*)(basef + off + 4);
                        const f32x4 v0 = acc[ai][bj][m][0] + b0, v1 = acc[ai][bj][m][1] + b1;
                        q += sq4(v0) + sq4(v1);
                        u32x4 w; w.x = cvt_pk_bf16(v0[0], v0[1]); w.y = cvt_pk_bf16(v0[2], v0[3]); w.z = cvt_pk_bf16(v1[0], v1[1]); w.w = cvt_pk_bf16(v1[2], v1[3]);
                        *(u32x4*)(hb + off) = w;
                        if (ahalo != nullptr && ai == 1 && m == 3) {
                            const int rl = row & 255;
                            if (rl >= 254 && u.pm < 63) *(u32x4*)(ahalo + (size_t)(2 * (u.pm + 1) + (rl - 254)) * DMODEL + col0 + bj * HALF) = w;
                        }
                    }
                    ssq_write(ssq_out, q, row, u.pn * 4 + wc, fq);
                    if (m & 1) asm volatile("" ::: "memory");
                }
        } else {
#pragma unroll
            for (int ai = 0; ai < 2; ++ai) {
                u32x4 bw[4][2];
#pragma unroll
                for (int m = 0; m < 4; ++m)
#pragma unroll
                    for (int bj = 0; bj < 2; ++bj) bw[m][bj] = *(const u32x4*)(baseb + (size_t)(row0 + ai * HALF + m * 16) * DMODEL + col0 + bj * HALF);
                asm volatile("" ::: "memory");
#pragma unroll
                for (int m = 0; m < 4; ++m) {
                    const int row = row0 + ai * HALF + m * 16; float q = 0.f;
#pragma unroll
                    for (int bj = 0; bj < 2; ++bj) {
                        const size_t off = (size_t)row * DMODEL + col0 + bj * HALF;
                        const u32x4 pw = bw[m][bj];
                        const f32x4 b0 = {bf_lo(pw.x), bf_hi(pw.x), bf_lo(pw.y), bf_hi(pw.y)}, b1 = {bf_lo(pw.z), bf_hi(pw.z), bf_lo(pw.w), bf_hi(pw.w)};
                        const f32x4 v0 = acc[ai][bj][m][0] + b0, v1 = acc[ai][bj][m][1] + b1;
                        q += sq4(v0) + sq4(v1);
                        u32x4 w; w.x = cvt_pk_bf16(v0[0], v0[1]); w.y = cvt_pk_bf16(v0[2], v0[3]); w.z = cvt_pk_bf16(v1[0], v1[1]); w.w = cvt_pk_bf16(v1[2], v1[3]);
                        *(u32x4*)(hb + off) = w;
                        if (ahalo != nullptr && ai == 1 && m == 3) {
                            const int rl = row & 255;
                            if (rl >= 254 && u.pm < 63) *(u32x4*)(ahalo + (size_t)(2 * (u.pm + 1) + (rl - 254)) * DMODEL + col0 + bj * HALF) = w;
                        }
                    }
                    ssq_write(ssq_out, q, row, u.pn * 4 + wc, fq);
                }
                asm volatile("" ::: "memory");
            }
        }
    }
};
struct EpiGate {
    static constexpr bool PERM = true, AFTER_DRAIN = false;
    const float* ssq_in; const bf16_t* base; const bf16_t* pp; bf16_t* dst; float* ssq_out;
    __device__ __forceinline__ void operator()(const f32x4 (&acc)[2][2][4][2], const Unit& u_, int wr, int wc, int fr, int fq) const {
        Unit u; { int pm_ = u_.pm, pn_ = u_.pn; asm volatile("" : "+s"(pm_), "+s"(pn_)); u.pm = pm_; u.pn = pn_; }
        const int row0 = u.pm * BM + wr * 64 + fr, col0 = u.pn * BM + wc * 32 + 8 * fq;
#pragma unroll
        for (int ai = 0; ai < 2; ++ai)
#pragma unroll
            for (int mp = 0; mp < 2; ++mp) {
                u32x4 bw[2][2], pq[2][2]; float rs[2];
#pragma unroll
                for (int mi = 0; mi < 2; ++mi) {
                    const int row = row0 + ai * HALF + (2 * mp + mi) * 16;
#pragma unroll
                    for (int bj = 0; bj < 2; ++bj) { const size_t off = (size_t)row * DMODEL + col0 + bj * HALF; bw[mi][bj] = *(const u32x4*)(base + off); pq[mi][bj] = *(const u32x4*)(pp + off); }
                }
#pragma unroll
                for (int mi = 0; mi < 2; ++mi) rs[mi] = row_rstd(ssq_in, row0 + ai * HALF + (2 * mp + mi) * 16);
                asm volatile("" ::: "memory");
#pragma unroll
                for (int mi = 0; mi < 2; ++mi) {
                    const int m = 2 * mp + mi; const int row = row0 + ai * HALF + m * 16; float q = 0.f;
#pragma unroll
                    for (int bj = 0; bj < 2; ++bj) {
                        const size_t off = (size_t)row * DMODEL + col0 + bj * HALF;
                        const u32x4 b_ = bw[mi][bj], p_ = pq[mi][bj];
                        const float bb[8] = {bf_lo(b_.x), bf_hi(b_.x), bf_lo(b_.y), bf_hi(b_.y), bf_lo(b_.z), bf_hi(b_.z), bf_lo(b_.w), bf_hi(b_.w)};
                        const float pv[8] = {bf_lo(p_.x), bf_hi(p_.x), bf_lo(p_.y), bf_hi(p_.y), bf_lo(p_.z), bf_hi(p_.z), bf_lo(p_.w), bf_hi(p_.w)};
                        const f32x4 g0 = acc[ai][bj][m][0] * rs[mi], g1 = acc[ai][bj][m][1] * rs[mi];
                        const float gg[8] = {g0[0], g0[1], g0[2], g0[3], g1[0], g1[1], g1[2], g1[3]};
                        float v[8];
#pragma unroll
                        for (int i = 0; i < 8; ++i) { v[i] = bb[i] + pv[i] * sigmoid_f(gg[i]); q += v[i] * v[i]; }
                        u32x4 w; w.x = cvt_pk_bf16(v[0], v[1]); w.y = cvt_pk_bf16(v[2], v[3]); w.z = cvt_pk_bf16(v[4], v[5]); w.w = cvt_pk_bf16(v[6], v[7]);
                        *(u32x4*)(dst + off) = w;
                    }
                    ssq_write(ssq_out, q, row, u.pn * 4 + wc, fq);
                }
                asm volatile("" ::: "memory");
            }
    }
};
struct EpiBf16Plain {
    static constexpr bool PERM = true, AFTER_DRAIN = false;
    bf16_t* O; int ldc;
    __device__ __forceinline__ void operator()(const f32x4 (&acc)[2][2][4][2], const Unit& u_, int wr, int wc, int fr, int fq) const {
        Unit u; { int pm_ = u_.pm, pn_ = u_.pn; asm volatile("" : "+s"(pm_), "+s"(pn_)); u.pm = pm_; u.pn = pn_; }
        const int row0 = u.pm * BM + wr * 64 + fr, col0 = u.pn * BM + wc * 32 + 8 * fq;
#pragma unroll
        for (int ai = 0; ai < 2; ++ai)
#pragma unroll
            for (int m = 0; m < 4; ++m) {
                const int row = row0 + ai * HALF + m * 16;
#pragma unroll
                for (int bj = 0; bj < 2; ++bj) {
                    const f32x4 v0 = acc[ai][bj][m][0], v1 = acc[ai][bj][m][1];
                    u32x4 w; w.x = cvt_pk_bf16(v0[0], v0[1]); w.y = cvt_pk_bf16(v0[2], v0[3]); w.z = cvt_pk_bf16(v1[0], v1[1]); w.w = cvt_pk_bf16(v1[2], v1[3]);
                    *(u32x4*)(O + (size_t)row * ldc + col0 + bj * HALF) = w;
                }
            }
    }
};
struct EpiEvenIn {
    static constexpr bool PERM = true, AFTER_DRAIN = false;
    const float* ssq_in; bf16_t* Z; const f32x2* rope;
    __device__ __forceinline__ void operator()(const f32x4 (&acc)[2][2][4][2], const Unit& u_, int wr, int wc, int fr, int fq) const {
        Unit u; { int pm_ = u_.pm, pn_ = u_.pn; asm volatile("" : "+s"(pm_), "+s"(pn_)); u.pm = pm_; u.pn = pn_; }
        const int row0 = u.pm * BM + wr * 64 + fr, colw = wc * 32 + 8 * fq;
        const int pn = u.pn;
        const float sc = (pn == 2 || pn == 3) ? C2 : 1.0f;
#pragma unroll
        for (int ai = 0; ai < 2; ++ai)
#pragma unroll
            for (int m = 0; m < 4; ++m) {
                const int row = row0 + ai * HALF + m * 16;
                const float rs = row_rstd(ssq_in, row);
#pragma unroll
                for (int bj = 0; bj < 2; ++bj) {
                    const int gi = 2 * bj + (wc >> 1);
                    const bool ropeg = (pn == 2 || pn == 3 || pn == 5 || (pn == 4 && (gi == 0 || gi == 2))) && ((wc & 1) == 0);
                    f32x4 v0 = acc[ai][bj][m][0] * rs, v1 = acc[ai][bj][m][1] * rs;
                    if (ropeg && fq < 2) {
                        const f32x4* rp = (const f32x4*)(rope + (size_t)row * 8 + 4 * fq);
                        const f32x4 ra = rp[0], rb = rp[1];
                        f32x4 o0, o1;
                        o0[0] = v0[0] * ra[0] - v0[1] * ra[1]; o0[1] = v0[1] * ra[0] + v0[0] * ra[1];
                        o0[2] = v0[2] * ra[2] - v0[3] * ra[3]; o0[3] = v0[3] * ra[2] + v0[2] * ra[3];
                        o1[0] = v1[0] * rb[0] - v1[1] * rb[1]; o1[1] = v1[1] * rb[0] + v1[0] * rb[1];
                        o1[2] = v1[2] * rb[2] - v1[3] * rb[3]; o1[3] = v1[3] * rb[2] + v1[2] * rb[3];
                        v0 = o0; v1 = o1;
                    }
                    v0 = v0 * sc; v1 = v1 * sc;
                    u32x4 w; w.x = cvt_pk_bf16(v0[0], v0[1]); w.y = cvt_pk_bf16(v0[2], v0[3]); w.z = cvt_pk_bf16(v1[0], v1[1]); w.w = cvt_pk_bf16(v1[2], v1[3]);
                    *(u32x4*)(Z + (size_t)row * EV_N + pn * BM + bj * HALF + colw) = w;
                }
            }
    }
};
struct EpiOddIn {
    static constexpr bool PERM = true, AFTER_DRAIN = false;
    const float* ssq_in; bf16_t* Z; float* F; float* sst;
    __device__ __forceinline__ void operator()(const f32x4 (&acc)[2][2][4][2], const Unit& u_, int wr, int wc, int fr, int fq) const {
        Unit u; { int pm_ = u_.pm, pn_ = u_.pn; asm volatile("" : "+s"(pm_), "+s"(pn_)); u.pm = pm_; u.pn = pn_; }
        const int row0 = u.pm * BM + wr * 64 + fr, colw = wc * 32 + 8 * fq;
        const int pn = u.pn;
        const float sc = (pn < 2) ? C2 : 1.0f;
        const bool act = (pn >= 6 && pn < 10), stat = (pn == 8 || pn == 9);
#pragma unroll
        for (int ai = 0; ai < 2; ++ai)
#pragma unroll
            for (int m = 0; m < 4; ++m) {
                const int row = row0 + ai * HALF + m * 16;
                const float rs = row_rstd(ssq_in, row);
                if (pn == 10) {
                    if (wc == 0 && fq == 0) { *(f32x4*)(F + (size_t)row * 8) = acc[ai][0][m][0] * rs; *(f32x4*)(F + (size_t)row * 8 + 4) = acc[ai][0][m][1] * rs; }
                    continue;
                }
                float s1 = 0.f, s2 = 0.f;
#pragma unroll
                for (int bj = 0; bj < 2; ++bj) {
                    f32x4 v0 = acc[ai][bj][m][0] * (rs * sc), v1 = acc[ai][bj][m][1] * (rs * sc);
                    if (act) {
#pragma unroll
                        for (int i = 0; i < 4; ++i) { v0[i] = gelu_tanh(v0[i]); v1[i] = gelu_tanh(v1[i]); }
                    }
                    s1 += ((v0[0] + v0[1]) + (v0[2] + v0[3])) + ((v1[0] + v1[1]) + (v1[2] + v1[3])); s2 += sq4(v0) + sq4(v1);
                    u32x4 w; w.x = cvt_pk_bf16(v0[0], v0[1]); w.y = cvt_pk_bf16(v0[2], v0[3]); w.z = cvt_pk_bf16(v1[0], v1[1]); w.w = cvt_pk_bf16(v1[2], v1[3]);
                    *(u32x4*)(Z + (size_t)row * Z1P + pn * BM + bj * HALF + colw) = w;
                }
                if (stat) {
                    s1 += xor16_f(s1); s1 = halves_sum_f(s1); s2 += xor16_f(s2); s2 = halves_sum_f(s2);
                    if (fq == 0) *(f32x2*)(sst + ((size_t)row * 8 + (pn - 8) * 4 + wc) * 2) = (f32x2){s1, s2};
                }
            }
    }
};
struct EpiHalo {
    static constexpr bool PERM = true, AFTER_DRAIN = false;
    const float* ssq_in; float* AH;
    __device__ __forceinline__ void operator()(const f32x4 (&acc)[2][2][4][2], const Unit& u_, int wr, int wc, int fr, int fq) const {
        Unit u; { int pm_ = u_.pm, pn_ = u_.pn; asm volatile("" : "+s"(pm_), "+s"(pn_)); u.pm = pm_; u.pn = pn_; }
        const int col0 = u.pn * BM + wc * 32 + 8 * fq;
#pragma unroll
        for (int m = 0; m < 4; ++m) {
            const int rh = wr * 64 + m * 16 + fr;
            if (rh < 2) continue;
            const int tok = 256 * (rh >> 1) - 2 + (rh & 1);
            const float rs = row_rstd(ssq_in, tok);
#pragma unroll
            for (int bj = 0; bj < 2; ++bj) {
                *(f32x4*)(AH + (size_t)rh * NFF2 + col0 + bj * HALF) = acc[0][bj][m][0] * rs;
                *(f32x4*)(AH + (size_t)rh * NFF2 + col0 + bj * HALF + 4) = acc[0][bj][m][1] * rs;
            }
        }
    }
};
template <int SEL> __device__ __forceinline__ float dpp1(const float old, const float src) {
    const int o = __builtin_bit_cast(int, old), s = __builtin_bit_cast(int, src); int t;
    if (SEL == 0) t = __builtin_amdgcn_update_dpp(o, s, 0x111, 0xf, 0xf, false);
    else if (SEL == 1) t = __builtin_amdgcn_update_dpp(o, s, 0x112, 0xf, 0xf, false);
    else if (SEL == 2) t = __builtin_amdgcn_update_dpp(o, s, 0x10F, 0xf, 0xf, false);
    else t = __builtin_amdgcn_update_dpp(o, s, 0x10E, 0xf, 0xf, false);
    return __builtin_bit_cast(float, t);
}
template <int SEL> __device__ __forceinline__ f32x4 dpp4t(const f32x4 old, const f32x4 src) {
    const float o0 = old[0], o1 = old[1], o2 = old[2], o3 = old[3], s0 = src[0], s1 = src[1], s2 = src[2], s3 = src[3];
    const float r0 = dpp1<SEL>(o0, s0), r1 = dpp1<SEL>(o1, s1), r2 = dpp1<SEL>(o2, s2), r3 = dpp1<SEL>(o3, s3);
    return (f32x4){r0, r1, r2, r3};
}
#define dpp4(old, src, sel) dpp4t<sel>(old, src)
struct EpiHaloF {
    static constexpr bool PERM = true, AFTER_DRAIN = false;
    const float* ssq_in; float* ah; unsigned* flags;
    __device__ __forceinline__ void operator()(const f32x4 (&acc)[2][2][4][2], const Unit& u_, int wr, int wc, int fr, int fq) const {
        Unit u; { int pm_ = u_.pm, pn_ = u_.pn; asm volatile("" : "+s"(pm_), "+s"(pn_)); u.pm = pm_; u.pn = pn_; }
        const int col0 = u.pn * BM + wc * 32 + 8 * fq;
#pragma unroll
        for (int m = 0; m < 4; ++m) {
            const int rh = wr * 64 + m * 16 + fr;
            if (rh >= 2) {
                const int tok = 256 * (rh >> 1) - 2 + (rh & 1);
                const float rsh = row_rstd(ssq_in, tok);
#pragma unroll
                for (int bj = 0; bj < 2; ++bj) {
                    *(f32x4*)(ah + (size_t)rh * NFF2 + col0 + bj * HALF) = acc[0][bj][m][0] * rsh;
                    *(f32x4*)(ah + (size_t)rh * NFF2 + col0 + bj * HALF + 4) = acc[0][bj][m][1] * rsh;
                }
            }
        }
        asm volatile("s_waitcnt vmcnt(0)" ::: "memory"); __builtin_amdgcn_s_barrier(); asm volatile("" ::: "memory");
        if (wr == 0 && wc == 0 && fr == 0 && fq == 0) {
            __builtin_amdgcn_fence(__ATOMIC_RELEASE, "agent");
            asm volatile("s_waitcnt vmcnt(0)" ::: "memory");
            __hip_atomic_store(flags + 64 * u.pn, 1u, __ATOMIC_RELAXED, __HIP_MEMORY_SCOPE_AGENT);
        }
    }
};
struct EpiFfnIn {
    static constexpr bool PERM = true, AFTER_DRAIN = false;
    const float* ssq_in; const float* cw; const float* cb; float* ah; bf16_t* hid; PG8_LAS float* xb; unsigned* flags; unsigned phase_id;
    __device__ __forceinline__ void operator()(const f32x4 (&acc)[2][2][4][2], const Unit& u_, int wr, int wc, int fr, int fq) const {
        Unit u; { int pm_ = u_.pm, pn_ = u_.pn; asm volatile("" : "+s"(pm_), "+s"(pn_)); u.pm = pm_; u.pn = pn_; }
        PG8_LAS float* rtab = xb + 2048;
        const int row0 = u.pm * BM + wr * 64 + fr;
        if (wr == 0) rtab[wc * 64 + fq * 16 + fr] = row_rstd(ssq_in, u.pm * BM + wc * 64 + fq * 16 + fr);
        if (fr >= 14) {
#pragma unroll
            for (int ai = 0; ai < 2; ++ai) {
                PG8_LAS f32x4* dst = (PG8_LAS f32x4*)(xb + ((((ai * 2 + wr) * 4 + wc) * 2 + (fr - 14)) * 4 + fq) * 16);
#pragma unroll
                for (int bj = 0; bj < 2; ++bj)
#pragma unroll
                    for (int n = 0; n < 2; ++n) dst[bj * 2 + n] = acc[ai][bj][3][n];
            }
        }
        asm volatile("s_waitcnt lgkmcnt(0)" ::: "memory"); __builtin_amdgcn_s_barrier(); asm volatile("" ::: "memory");
        const bool has = (u.pm & 7) != 0;
        if (wr == 0) {
            PG8_LAS unsigned* stamp = (PG8_LAS unsigned*)(rtab + 256);
            if (*(volatile PG8_LAS unsigned*)stamp != phase_id) {
                if (wc == 0) {
                    unsigned sp = 0;
                    for (int t = 0; t < NFF2 / BM; ++t)
                        while (__hip_atomic_load(flags + 64 * t, __ATOMIC_RELAXED, __HIP_MEMORY_SCOPE_AGENT) == 0u) { __builtin_amdgcn_s_sleep(2); if (++sp > (1u << 22)) break; }
                    __builtin_amdgcn_fence(__ATOMIC_ACQUIRE, "agent");
                    asm volatile("s_waitcnt vmcnt(0)" ::: "memory");
                    if (fr == 0 && fq == 0) *(volatile PG8_LAS unsigned*)stamp = phase_id;
                } else {
                    unsigned sp = 0;
                    while (*(volatile PG8_LAS unsigned*)stamp != phase_id) { __builtin_amdgcn_s_sleep(2); if (++sp > (1u << 22)) break; }
                }
            }
        }
        float rs[2][4];
#pragma unroll
        for (int ai = 0; ai < 2; ++ai)
#pragma unroll
            for (int m = 0; m < 4; ++m) rs[ai][m] = rtab[ai * HALF + wr * 64 + m * 16 + fr];
        const f32x4 zero4 = {0.f, 0.f, 0.f, 0.f};
#pragma unroll
        for (int ai = 0; ai < 2; ++ai) {
#pragma unroll
            for (int n = 0; n < 2; ++n) {
                f32x4 cg[4];
#pragma unroll
                for (int bj = 0; bj < 2; ++bj) {
                    f32x4 b0, b1;
                    if (ai == 0 && wr == 0) {
                        const size_t c = (size_t)u.pn * BM + bj * HALF + wc * 32 + 8 * fq + 4 * n;
                        b0 = has ? *(const f32x4*)(ah + (size_t)(2 * u.pm) * NFF2 + c) : zero4;
                        b1 = has ? *(const f32x4*)(ah + (size_t)(2 * u.pm + 1) * NFF2 + c) : zero4;
                    } else {
                        const int sa = (wr == 1) ? ai : ai - 1, sw = (wr == 1) ? 0 : 1;
                        const float r0 = rtab[sa * HALF + sw * 64 + 62], r1 = rtab[sa * HALF + sw * 64 + 63];
                        b0 = *(const PG8_LAS f32x4*)(xb + ((((sa * 2 + sw) * 4 + wc) * 2 + 0) * 4 + fq) * 16 + (bj * 2 + n) * 4) * r0;
                        b1 = *(const PG8_LAS f32x4*)(xb + ((((sa * 2 + sw) * 4 + wc) * 2 + 1) * 4 + fq) * 16 + (bj * 2 + n) * 4) * r1;
                    }
                    const int oc = bj * DFF + 128 * u.pn + wc * 32 + 8 * fq + 4 * n;
                    const f32x4 w0 = *(const f32x4*)(cw + oc), w1 = *(const f32x4*)(cw + NFF2 + oc), w2 = *(const f32x4*)(cw + 2 * NFF2 + oc), bb = *(const f32x4*)(cb + oc);
                    f32x4 prev = zero4;
#pragma unroll
                    for (int m = 0; m < 4; ++m) {
                        const f32x4 cur = acc[ai][bj][m][n] * rs[ai][m];
                        f32x4 y1, y2;
                        if (m == 0) { y1 = b1; y2 = (fr == 0) ? b0 : b1; }
                        else { y1 = dpp4(zero4, prev, 2); y2 = dpp4(zero4, prev, 3); }
                        const f32x4 p1 = dpp4(y1, cur, 0), p2 = dpp4(y2, cur, 1);
                        const f32x4 c = w0 * p2 + w1 * p1 + w2 * cur + bb;
                        prev = cur;
                        if (bj == 0) cg[m] = c;
                        else {
                            const float h0 = gelu_tanh(cg[m].x) * c.x, h1 = gelu_tanh(cg[m].y) * c.y, h2 = gelu_tanh(cg[m].z) * c.z, h3 = gelu_tanh(cg[m].w) * c.w;
                            u32x2 w; w.x = cvt_pk_bf16(h0, h1); w.y = cvt_pk_bf16(h2, h3);
                            const int row = row0 + ai * HALF + m * 16;
                            *(u32x2*)(hid + (size_t)row * DFF + 128 * u.pn + wc * 32 + 8 * fq + 4 * n) = w;
                        }
                    }
                    asm volatile("" ::: "memory");
                }
            }
        }
    }
};
template <class Epi, class Sched, bool ALIGN_EPI = false, bool SP2 = false>
__device__ __forceinline__ void gemm_phase(PG8_LAS unsigned char* lds, const Gemm g, const Sched& S, const Epi& E, const int wave_s) {
    const int tid_ = wave_s * 64 + lane_opaque(); const int tid = tid_, wid = __builtin_amdgcn_readfirstlane(tid >> 6), lane = tid & 63, wr = wid >> 2, wc = wid & 3, fr = lane & 15, fq = lane >> 4;
    const int K = g.K, nt = K / BK;
    unsigned voffA[2], voffB[2];
#pragma unroll
    for (int i = 0; i < 2; ++i) { int R, C; stage_rc(tid * 16 + i * 8192, R, C); const int Rb = Epi::PERM ? ((R & ~31) + perm32(R & 31)) : R;
        voffA[i] = (unsigned)(R * K + C) * 2u; voffB[i] = (unsigned)(Rb * K + C) * 2u; }
    const size_t kstep = (size_t)(BK * 2);
    const size_t hstep = (size_t)HALF * K * 2;
    const size_t tstep = 2 * hstep;
    const unsigned ldsw = (unsigned)wid * 1024u;
    const int aoff = lds_byte(wr * 64 + fr, fq * 8), boff = lds_byte(wc * 32 + fr, fq * 8);
#define PG8_SA(b, h) (((b) * 2 + (h)) * HTB)
#define PG8_SB(b, h) ((4 + (b) * 2 + (h)) * HTB)
#define PG8_STAGE(bufoff, gbase, voff) do { _Pragma("unroll") for (int _i = 0; _i < 2; ++_i) \
        __builtin_amdgcn_global_load_lds((const unsigned*)((const char*)(gbase) + (voff)[_i]), (PG8_LAS unsigned*)(lds + (bufoff) + ldsw + _i * 8192), 16, 0, 0); } while (0)
#define PG8_LDA(dst, b, h) do { _Pragma("unroll") for (int m = 0; m < 4; ++m) _Pragma("unroll") for (int k = 0; k < 2; ++k) dst[m][k] = *(const PG8_LAS bf16x8*)(lds + PG8_SA(b, h) + aoff + m * 2048 + k * 1024); } while (0)
#define PG8_LDB(dst, b, h) do { _Pragma("unroll") for (int n = 0; n < 2; ++n) _Pragma("unroll") for (int k = 0; k < 2; ++k) dst[n][k] = *(const PG8_LAS bf16x8*)(lds + PG8_SB(b, h) + boff + n * 2048 + k * 1024); } while (0)
#define PG8_MMA(ai, bj, At, Bt) do { __builtin_amdgcn_s_setprio(1); _Pragma("unroll") for (int m = 0; m < 4; ++m) _Pragma("unroll") for (int n = 0; n < 2; ++n) _Pragma("unroll") for (int k = 0; k < 2; ++k) \
        acc[ai][bj][m][n] = __builtin_amdgcn_mfma_f32_16x16x32_bf16(Bt[n][k], At[m][k], acc[ai][bj][m][n], 0, 0, 0); __builtin_amdgcn_s_setprio(0); } while (0)
#define PG8_WAIT_V(n) asm volatile("s_waitcnt vmcnt(" #n ")" ::: "memory")
#define PG8_WAIT_L(n) asm volatile("s_waitcnt lgkmcnt(" #n ")" ::: "memory")
#define PG8_BAR __builtin_amdgcn_s_barrier()
#define PG8_SCHED __builtin_amdgcn_sched_barrier(0)
    Unit cur, nxt; int ui = 0;
    if (!S.next(0, cur)) return;
    f32x4 acc[2][2][4][2];
#pragma unroll
    for (int a = 0; a < 2; ++a)
#pragma unroll
        for (int b = 0; b < 2; ++b)
#pragma unroll
            for (int m = 0; m < 4; ++m)
#pragma unroll
                for (int n = 0; n < 2; ++n) acc[a][b][m][n] = (f32x4){0.f, 0.f, 0.f, 0.f};
    bf16x8 At[4][2], B0[2][2], B1[2][2];
    const char* cA = (const char*)g.A + (size_t)cur.pm * tstep; const char* cB = (const char*)g.Bt + (size_t)cur.pn * tstep;
    S.a_ready(cur);
    if constexpr (SP2) {
        PG8_STAGE(PG8_SB(0, 0), cB, voffB); PG8_STAGE(PG8_SB(0, 1), cB + hstep, voffB); PG8_STAGE(PG8_SA(0, 0), cA, voffA); PG8_STAGE(PG8_SA(0, 1), cA + hstep, voffA);
        if (wr == 1) PG8_BAR;
        PG8_WAIT_V(2); PG8_BAR;
        PG8_STAGE(PG8_SB(1, 0), cB + kstep, voffB); PG8_STAGE(PG8_SA(1, 0), cA + kstep, voffA); PG8_STAGE(PG8_SB(1, 1), cB + hstep + kstep, voffB);
        PG8_WAIT_V(6); PG8_BAR;
    } else {
        PG8_STAGE(PG8_SB(0, 0), cB, voffB); PG8_STAGE(PG8_SA(0, 0), cA, voffA); PG8_STAGE(PG8_SB(0, 1), cB + hstep, voffB); PG8_STAGE(PG8_SA(0, 1), cA + hstep, voffA);
        if (wr == 1) PG8_BAR;
        PG8_WAIT_V(4); PG8_BAR;
        PG8_STAGE(PG8_SB(1, 0), cB + kstep, voffB); PG8_STAGE(PG8_SA(1, 0), cA + kstep, voffA); PG8_STAGE(PG8_SB(1, 1), cB + hstep + kstep, voffB);
        PG8_WAIT_V(6); PG8_BAR;
    }
    for (;;) {
        const bool has_next = S.next(ui + 1, nxt);
        const char* nA = has_next ? (const char*)g.A + (size_t)nxt.pm * tstep : cA; const char* nB = has_next ? (const char*)g.Bt + (size_t)nxt.pn * tstep : cB;
        for (int t = 0; t < nt; t += 2) {
            const bool last = (t == nt - 2);
            const char* a1 = cA + (size_t)(t + 1) * kstep;
            const char* a2 = last ? nA : cA + (size_t)(t + 2) * kstep; const char* b2 = last ? nB : cB + (size_t)(t + 2) * kstep;
            const char* a3 = a2 + kstep; const char* b3 = b2 + kstep;
            if (last && has_next) S.a_ready(nxt);
            if constexpr (SP2) {
            PG8_LDB(B0, 0, 0); PG8_LDB(B1, 0, 1); PG8_SCHED; PG8_LDA(At, 0, 0); PG8_STAGE(PG8_SA(1, 1), a1 + hstep, voffA);
            PG8_WAIT_V(8); PG8_WAIT_L(0); PG8_BAR; PG8_MMA(0, 0, At, B0); PG8_MMA(0, 1, At, B1); PG8_BAR; PG8_SCHED;
            PG8_LDA(At, 0, 1); PG8_STAGE(PG8_SB(0, 0), b2, voffB); PG8_STAGE(PG8_SB(0, 1), b2 + hstep, voffB); PG8_STAGE(PG8_SA(0, 0), a2, voffA);
            PG8_WAIT_V(8); PG8_WAIT_L(0); PG8_BAR; PG8_MMA(1, 0, At, B0); PG8_MMA(1, 1, At, B1); PG8_BAR; PG8_SCHED;
            PG8_LDB(B0, 1, 0); PG8_LDB(B1, 1, 1); PG8_SCHED; PG8_LDA(At, 1, 0); PG8_STAGE(PG8_SA(0, 1), a2 + hstep, voffA);
            PG8_WAIT_V(8); PG8_WAIT_L(0); PG8_BAR; PG8_MMA(0, 0, At, B0); PG8_MMA(0, 1, At, B1); PG8_BAR; PG8_SCHED;
            PG8_LDA(At, 1, 1); PG8_STAGE(PG8_SB(1, 0), b3, voffB); PG8_STAGE(PG8_SB(1, 1), b3 + hstep, voffB); PG8_STAGE(PG8_SA(1, 0), a3, voffA);
            PG8_WAIT_V(8); PG8_WAIT_L(0); PG8_BAR; PG8_MMA(1, 0, At, B0); PG8_MMA(1, 1, At, B1); PG8_BAR; PG8_SCHED;
            } else {
            PG8_LDB(B0, 0, 0); PG8_SCHED; PG8_LDA(At, 0, 0); PG8_STAGE(PG8_SA(1, 1), a1 + hstep, voffA);
            PG8_WAIT_L(8); PG8_BAR; PG8_WAIT_L(0); PG8_MMA(0, 0, At, B0); PG8_BAR; PG8_SCHED;
            PG8_LDB(B1, 0, 1); PG8_STAGE(PG8_SB(0, 0), b2, voffB);
            PG8_BAR; PG8_WAIT_L(0); PG8_MMA(0, 1, At, B1); PG8_BAR;
            PG8_LDA(At, 0, 1); PG8_STAGE(PG8_SA(0, 0), a2, voffA);
            PG8_BAR; PG8_WAIT_L(0); PG8_MMA(1, 0, At, B0); PG8_BAR; PG8_SCHED;
            PG8_STAGE(PG8_SB(0, 1), b2 + hstep, voffB);
            PG8_WAIT_V(6); PG8_BAR; PG8_MMA(1, 1, At, B1); PG8_BAR;
            PG8_LDB(B0, 1, 0); PG8_SCHED; PG8_LDA(At, 1, 0); PG8_STAGE(PG8_SA(0, 1), a2 + hstep, voffA);
            PG8_WAIT_L(8); PG8_BAR; PG8_WAIT_L(0); PG8_MMA(0, 0, At, B0); PG8_BAR; PG8_SCHED;
            PG8_LDB(B1, 1, 1); PG8_STAGE(PG8_SB(1, 0), b3, voffB);
            PG8_BAR; PG8_WAIT_L(0); PG8_MMA(0, 1, At, B1); PG8_BAR;
            PG8_LDA(At, 1, 1); PG8_STAGE(PG8_SA(1, 0), a3, voffA);
            PG8_BAR; PG8_WAIT_L(0); PG8_MMA(1, 0, At, B0); PG8_BAR; PG8_SCHED;
            PG8_STAGE(PG8_SB(1, 1), b3 + hstep, voffB);
            PG8_WAIT_V(6); PG8_BAR; PG8_MMA(1, 1, At, B1); PG8_BAR;
            }
        }
        if constexpr (ALIGN_EPI) { if (wr == 0) PG8_BAR; }
        if constexpr (!Epi::AFTER_DRAIN) { E(acc, cur, wr, wc, fr, fq); S.done(cur); }
        if (!has_next) break;
#pragma unroll
        for (int a = 0; a < 2; ++a)
#pragma unroll
            for (int b = 0; b < 2; ++b)
#pragma unroll
                for (int m = 0; m < 4; ++m)
#pragma unroll
                    for (int n = 0; n < 2; ++n) acc[a][b][m][n] = (f32x4){0.f, 0.f, 0.f, 0.f};
        cur = nxt; cA = nA; cB = nB; ++ui;
        if constexpr (ALIGN_EPI) { if (wr == 1) PG8_BAR; }
    }
    PG8_WAIT_V(0);
    if constexpr (!ALIGN_EPI) { if (wr == 0) PG8_BAR; }
    PG8_BAR;
    if constexpr (Epi::AFTER_DRAIN) { E.fused(acc, cur, wr, wc, fr, fq, lds, wid, lane); S.done(cur); }
#undef PG8_SA
#undef PG8_SB
#undef PG8_STAGE
#undef PG8_LDA
#undef PG8_LDB
#undef PG8_MMA
#undef PG8_WAIT_V
#undef PG8_WAIT_L
#undef PG8_BAR
#undef PG8_SCHED
}
}
namespace mix {
#define MLAS __attribute__((address_space(3)))
typedef unsigned short bf16_t;
typedef short bf16x8 __attribute__((ext_vector_type(8)));
typedef short s16x4 __attribute__((ext_vector_type(4)));
typedef float f32x16 __attribute__((ext_vector_type(16)));
typedef float f32x4 __attribute__((ext_vector_type(4)));
typedef float f32x2 __attribute__((ext_vector_type(2)));
typedef unsigned u32x4 __attribute__((ext_vector_type(4)));
typedef unsigned u32x2 __attribute__((ext_vector_type(2)));
typedef MLAS const char* lds_cptr;
typedef short v4i16_t __attribute__((ext_vector_type(4)));
typedef __bf16 bf16x2_t __attribute__((ext_vector_type(2)));

constexpr int SLOTB = 8192;
constexpr int NSLOT = 4;
constexpr int L_K = 0, L_V = NSLOT * SLOTB, L_WSF = 2 * NSLOT * SLOTB, L_OST = L_WSF + 8 * 256, L_X = L_OST + 8 * 4096;
constexpr int LX_IQ = L_X, LX_EQ = L_X, LX_PFX = L_X + 8192, LX_CNT = LX_IQ + 16384, LX_GT = LX_CNT + 2048, LX_SEL = LX_GT, LX_END = LX_GT + 8192;
static_assert(LX_END <= 131072, "mixer LDS map");

__device__ __forceinline__ int crow(int r, int hi) { return (r & 3) + 8 * (r >> 2) + 4 * hi; }
__device__ __forceinline__ void glds16(const void* gsrc, unsigned lds_dst) { unsigned keep;
    asm volatile("s_mov_b32 %0, m0\n\ts_mov_b32 m0, %2\n\ts_nop 0\n\tglobal_load_lds_dwordx4 %1, off\n\ts_mov_b32 m0, %0" : "=&s"(keep) : "v"(gsrc), "s"(lds_dst) : "memory"); }
__device__ __forceinline__ unsigned cvtpk(float lo, float hi) { f32x2 v = {lo, hi}; bf16x2_t b = __builtin_convertvector(v, bf16x2_t); return __builtin_bit_cast(unsigned, b); }
__device__ __forceinline__ s16x4 vtr(lds_cptr p) { return __builtin_bit_cast(s16x4, __builtin_amdgcn_ds_read_tr16_b64_v4i16((MLAS v4i16_t*)p)); }
#define WAITV_BAR() asm volatile("s_waitcnt vmcnt(0) lgkmcnt(0)\n\ts_barrier" ::: "memory")
#define LGKM_BAR() asm volatile("s_waitcnt lgkmcnt(0)\n\ts_barrier" ::: "memory")
#define WAITV2_BAR() asm volatile("s_waitcnt vmcnt(2) lgkmcnt(0)\n\ts_barrier" ::: "memory")

__device__ __forceinline__ void dma_kv(const bf16_t* kbase, const bf16_t* vbase, int pitch, unsigned lds0, int slot, int wid, int lane) {
    const bf16_t* ks = kbase + (size_t)lane * pitch + wid * 8;
    const bf16_t* vs = vbase + (size_t)(16 * (wid & 3) + (lane >> 2)) * pitch + (wid >> 2) * 32 + (lane & 3) * 8;
    glds16(ks, (unsigned)__builtin_amdgcn_readfirstlane(lds0 + L_K + slot * SLOTB + wid * 1024));
    glds16(vs, (unsigned)__builtin_amdgcn_readfirstlane(lds0 + L_V + slot * SLOTB + wid * 1024));
}
__device__ __forceinline__ void kload(bf16x8 (&kf)[8], lds_cptr kslot, int r32, int hi) {
    lds_cptr kb = kslot + hi * 1024 + r32 * 16;
#pragma unroll
    for (int d0 = 0; d0 < 4; ++d0) { kf[2 * d0] = *(const MLAS bf16x8*)(kb + d0 * 2048); kf[2 * d0 + 1] = *(const MLAS bf16x8*)(kb + d0 * 2048 + 512); }
}
__device__ __forceinline__ void qkt_mma(f32x16& p0, f32x16& p1, const bf16x8 (&kf)[8], const bf16x8* qr, const f32x16& cinit) {
    p0 = __builtin_amdgcn_mfma_f32_32x32x16_bf16(kf[0], qr[0], cinit, 0, 0, 0); p1 = __builtin_amdgcn_mfma_f32_32x32x16_bf16(kf[1], qr[0], cinit, 0, 0, 0);
#pragma unroll
    for (int d0 = 1; d0 < 4; ++d0) { p0 = __builtin_amdgcn_mfma_f32_32x32x16_bf16(kf[2 * d0], qr[d0], p0, 0, 0, 0); p1 = __builtin_amdgcn_mfma_f32_32x32x16_bf16(kf[2 * d0 + 1], qr[d0], p1, 0, 0, 0); }
}
__device__ __forceinline__ void qkt(f32x16& p0, f32x16& p1, lds_cptr kslot, const bf16x8* qr, const f32x16& cinit, int r32, int hi) {
    bf16x8 kf[8]; kload(kf, kslot, r32, hi); qkt_mma(p0, p1, kf, qr, cinit);
}
__device__ __forceinline__ void vload(bf16x8 (&vf)[8], lds_cptr vslot, int lane, int hi) {
    lds_cptr vp = vslot + ((lane >> 4) & 1) * 32 + (lane & 3) * 8 + (4 * hi + ((lane & 15) >> 2)) * 64;
#pragma unroll
    for (int d0 = 0; d0 < 2; ++d0)
#pragma unroll
        for (int ks = 0; ks < 4; ++ks) {
            const s16x4 lo = vtr(vp + d0 * 4096 + ks * 1024), hh = vtr(vp + d0 * 4096 + ks * 1024 + 512);
            vf[d0 * 4 + ks] = (bf16x8){lo[0], lo[1], lo[2], lo[3], hh[0], hh[1], hh[2], hh[3]};
        }
}
#define V16_TO_ARR(v, a, o) do { a[(o) + 0] = v[0]; a[(o) + 1] = v[1]; a[(o) + 2] = v[2]; a[(o) + 3] = v[3]; a[(o) + 4] = v[4]; a[(o) + 5] = v[5]; a[(o) + 6] = v[6]; a[(o) + 7] = v[7]; \
    a[(o) + 8] = v[8]; a[(o) + 9] = v[9]; a[(o) + 10] = v[10]; a[(o) + 11] = v[11]; a[(o) + 12] = v[12]; a[(o) + 13] = v[13]; a[(o) + 14] = v[14]; a[(o) + 15] = v[15]; } while (0)
__device__ __forceinline__ f32x16 splat16(float x) { return (f32x16){x, x, x, x, x, x, x, x, x, x, x, x, x, x, x, x}; }
struct AttnState { f32x16 o[2]; float m, l, pend; bool started; };
constexpr float ATT_THR = 8.0f;
__device__ __forceinline__ void softmax_pv(AttnState& st, float (&sc)[32], const bf16x8 (&vf)[8], MLAS float* wsf, int lane, int r32, int hi) {
    if (__any(st.pend != 0.f)) {
#pragma unroll
        for (int r = 0; r < 32; ++r) sc[r] -= st.pend;
    }
    st.pend = 0.f;
    float ra = __builtin_fmaxf(__builtin_fmaxf(sc[0], sc[1]), sc[2]), rb = __builtin_fmaxf(__builtin_fmaxf(sc[3], sc[4]), sc[5]);
#pragma unroll
    for (int r = 6; r < 30; r += 4) { ra = __builtin_fmaxf(__builtin_fmaxf(ra, sc[r]), sc[r + 1]); rb = __builtin_fmaxf(__builtin_fmaxf(rb, sc[r + 2]), sc[r + 3]); }
    float rm = __builtin_fmaxf(__builtin_fmaxf(ra, rb), __builtin_fmaxf(sc[30], sc[31]));
    rm = halves_max_f(rm);
    const bool fresh = !st.started;
    const bool need = (rm > ATT_THR) || (fresh && rm < -ATT_THR && rm > -1e29f);
    st.started = st.started || (rm > -1e29f);
    if (__any(need)) {
        const float dl = need ? rm : 0.f;
        st.m += dl; st.pend = dl;
#pragma unroll
        for (int r = 0; r < 32; ++r) sc[r] -= dl;
        const float alpha = fresh ? 1.0f : __builtin_amdgcn_exp2f(-dl);
        st.l *= alpha;
        if (hi == 0) wsf[r32] = alpha;
        float fr_[16];
#pragma unroll
        for (int r = 0; r < 16; ++r) fr_[r] = wsf[crow(r, hi)];
        const f32x16 fv = {fr_[0], fr_[1], fr_[2], fr_[3], fr_[4], fr_[5], fr_[6], fr_[7], fr_[8], fr_[9], fr_[10], fr_[11], fr_[12], fr_[13], fr_[14], fr_[15]};
        st.o[0] = st.o[0] * fv; st.o[1] = st.o[1] * fv;
    }
    float pe[32]; float s0 = 0.f, s1 = 0.f;
#pragma unroll
    for (int r = 0; r < 32; r += 2) { pe[r] = __builtin_amdgcn_exp2f(sc[r]); pe[r + 1] = __builtin_amdgcn_exp2f(sc[r + 1]); s0 += pe[r]; s1 += pe[r + 1]; }
    st.l += s0 + s1;
    u32x4 pw[4];
#pragma unroll
    for (int k = 0; k < 4; ++k) pw[k] = (u32x4){cvtpk(pe[8 * k + 0], pe[8 * k + 1]), cvtpk(pe[8 * k + 2], pe[8 * k + 3]), cvtpk(pe[8 * k + 4], pe[8 * k + 5]), cvtpk(pe[8 * k + 6], pe[8 * k + 7])};
#pragma unroll
    for (int d0 = 0; d0 < 2; ++d0)
#pragma unroll
        for (int ks = 0; ks < 4; ++ks) st.o[d0] = __builtin_amdgcn_mfma_f32_32x32x16_bf16(__builtin_bit_cast(bf16x8, pw[ks]), vf[d0 * 4 + ks], st.o[d0], 0, 0, 0);
}
__device__ __forceinline__ void attn_store(AttnState& st, bf16_t* Ow, int pitch, MLAS float* wsf, MLAS bf16_t* stg, int lane, int r32, int hi) {
    float l = halves_sum_f(st.l);
    if (hi == 0) wsf[32 + r32] = l;
    float rli[16];
#pragma unroll
    for (int r = 0; r < 16; ++r) rli[r] = 1.0f / wsf[32 + crow(r, hi)];
#pragma unroll
    for (int r = 0; r < 16; ++r) { const int orow = crow(r, hi);
#pragma unroll
        for (int d0 = 0; d0 < 2; ++d0) { const unsigned short b = (unsigned short)(cvtpk(st.o[d0][r] * rli[r], 0.f) & 0xffffu); stg[orow * 64 + d0 * 32 + r32] = b; } }
#pragma unroll
    for (int i = 0; i < 4; ++i) { const int row = i * 8 + (lane >> 3), ch = lane & 7; const u32x4 v = *(const MLAS u32x4*)(stg + row * 64 + ch * 8); *(u32x4*)(Ow + (size_t)row * pitch + ch * 8) = v; }
}

#ifndef DBG_REP_BS
#define DBG_REP_BS 1
#endif
constexpr int KEY_LOW_BIT = 14;
template <int NS> __device__ __forceinline__ unsigned bit_search(const unsigned (&key)[8][16], MLAS unsigned* cntx, int wid, int r32, int hi) {
    unsigned tau = 0u;
#pragma unroll 1
    for (int bit = 31; bit >= KEY_LOW_BIT; --bit) {
        const unsigned cand = tau | (1u << bit);
        unsigned cnt = 0;
#pragma unroll
        for (int jj = 0; jj < NS; ++jj)
#pragma unroll
            for (int r = 0; r < 16; ++r) cnt += (key[jj][r] >= cand) ? 1u : 0u;
        cnt = halves_add_u(cnt);
        MLAS unsigned* cb = cntx + (bit & 1) * 256;
        if (hi == 0) cb[wid * 32 + r32] = cnt;
        LGKM_BAR();
        unsigned tot = 0;
#pragma unroll
        for (int w = 0; w < 8; ++w) tot += cb[w * 32 + r32];
        if (tot >= 256u) tau = cand;
    }
    return tau;
}
__device__ __forceinline__ void dsa_select(int b, int qg, const bf16_t* Z0, char* shm, const int wave_s) {
    const int tid_ = wave_s * 64 + lane_opaque(); const int tid = tid_, lane = tid & 63, r32 = lane & 31, hi = lane >> 5; const int wid = __builtin_amdgcn_readfirstlane(tid >> 6);
    MLAS char* L = (MLAS char*)shm;
    const int c = qg >> 1, nkeys = 64 * (c + 1), nt32 = nkeys >> 5, nt64 = nkeys >> 6;
    const size_t rowb = (size_t)b * SEQ;
    const size_t tok0 = rowb + 32 * qg;
    MLAS unsigned* selw = (MLAS unsigned*)(L + LX_SEL);
    if (nkeys <= 256) {
        for (int i = tid; i < 64 * 32; i += 512) selw[i] = (i < nt32 * 32) ? 0xffffffffu : 0u;
    } else {
        {
            MLAS u32x4* iqL = (MLAS u32x4*)(L + LX_IQ);
            for (int i = tid; i < 1024; i += 512) { const int q = i & 31, hh = (i >> 5) & 1, d0 = (i >> 6) & 3, h = i >> 8;
                iqL[i] = *(const u32x4*)(Z0 + (tok0 + q) * EV_N + 1280 + 64 * h + 16 * d0 + 8 * hh); }
        }
        float w4[4];
        { const u32x2 ww = *(const u32x2*)(Z0 + (tok0 + r32) * EV_N + 1216);
          w4[0] = pg8::bf_lo(ww.x) * 0.0625f; w4[1] = pg8::bf_hi(ww.x) * 0.0625f; w4[2] = pg8::bf_lo(ww.y) * 0.0625f; w4[3] = pg8::bf_hi(ww.y) * 0.0625f; }
        LGKM_BAR();
        unsigned key[8][16];
        const int nslots = (nt32 + 7) >> 3;
        const MLAS bf16x8* iqf = (const MLAS bf16x8*)(L + LX_IQ) + hi * 32 + r32;
#pragma unroll
        for (int jj = 0; jj < 8; ++jj) {
            const int j = wid + 8 * jj;
            if (j < nt32) {
                const bf16_t* ikp = Z0 + (rowb + 32 * j + r32) * EV_N + 1152 + 8 * hi;
                bf16x8 af[4];
#pragma unroll
                for (int d0 = 0; d0 < 4; ++d0) af[d0] = *(const bf16x8*)(ikp + 16 * d0);
                f32x16 ah[4];
#pragma unroll
                for (int h = 0; h < 4; ++h) {
                    f32x16 a = {};
#pragma unroll
                    for (int d0 = 0; d0 < 4; ++d0) a = __builtin_amdgcn_mfma_f32_32x32x16_bf16(af[d0], iqf[(h * 4 + d0) * 64], a, 0, 0, 0);
                    ah[h] = a;
                }
#pragma unroll
                for (int r = 0; r < 16; ++r) {
                    const float s = ((__builtin_fmaxf(ah[0][r], 0.f) * w4[0] + __builtin_fmaxf(ah[1][r], 0.f) * w4[1]) + __builtin_fmaxf(ah[2][r], 0.f) * w4[2]) + __builtin_fmaxf(ah[3][r], 0.f) * w4[3];
                    const unsigned u = __builtin_bit_cast(unsigned, s); key[jj][r] = (u & 0x80000000u) ? ~u : (u | 0x80000000u);
                }
            } else {
#pragma unroll
                for (int r = 0; r < 16; ++r) key[jj][r] = 0u;
            }
        }
        MLAS unsigned* cntx = (MLAS unsigned*)(L + L_OST);
        unsigned tau;
        for (int rep_ = 0; rep_ < DBG_REP_BS; ++rep_)
        switch (nslots) {
            case 2: tau = bit_search<2>(key, cntx, wid, r32, hi); break;
            case 3: tau = bit_search<3>(key, cntx, wid, r32, hi); break;
            case 4: tau = bit_search<4>(key, cntx, wid, r32, hi); break;
            case 5: tau = bit_search<5>(key, cntx, wid, r32, hi); break;
            case 6: tau = bit_search<6>(key, cntx, wid, r32, hi); break;
            case 7: tau = bit_search<7>(key, cntx, wid, r32, hi); break;
            default: tau = bit_search<8>(key, cntx, wid, r32, hi); break;
        }
        const unsigned tau_hi = (tau >= 0xffffffffu - ((1u << KEY_LOW_BIT) - 1u)) ? 0xffffffffu : tau + (1u << KEY_LOW_BIT);
        MLAS unsigned* gtw = (MLAS unsigned*)(L + LX_GT); MLAS unsigned* eqw = (MLAS unsigned*)(L + LX_EQ); MLAS unsigned* pfx = (MLAS unsigned*)(L + LX_PFX);
#pragma unroll
        for (int jj = 0; jj < 8; ++jj) {
            const int j = wid + 8 * jj;
            if (j < nt32) {
                unsigned g = 0, e = 0;
#pragma unroll
                for (int r = 0; r < 16; ++r) { const unsigned bitp = 1u << ((r & 3) + 8 * (r >> 2)); g |= (key[jj][r] >= tau_hi) ? bitp : 0u; e |= (key[jj][r] >= tau && key[jj][r] < tau_hi) ? bitp : 0u; }
                g <<= 4 * hi; e <<= 4 * hi;
                g = halves_or_u(g); e = halves_or_u(e);
                if (hi == 0) { gtw[j * 32 + r32] = g; eqw[j * 32 + r32] = e; }
            }
        }
        LGKM_BAR();
        if (wid == 0 && hi == 0) {
            unsigned cg = 0;
            for (int j = 0; j < nt32; ++j) cg += __builtin_popcount(gtw[j * 32 + r32]);
            const int need = 256 - (int)cg;
            int run = 0;
            for (int j = 0; j < nt32; ++j) { const unsigned e = eqw[j * 32 + r32]; int k = need - run; k = k < 0 ? 0 : (k > 32 ? 32 : k); pfx[j * 32 + r32] = (unsigned)k; run += __builtin_popcount(e); }
        }
        LGKM_BAR();
        for (int i = tid; i < nt32 * 32; i += 512) {
            const unsigned g = gtw[i], e = eqw[i]; const int k = (int)pfx[i];
            unsigned take = 0;
            if (e != 0u && k > 0) {
                unsigned rem = e; int cntk = 0;
                while (rem != 0u && cntk < k) { const unsigned low = rem & (0u - rem); take |= low; rem ^= low; ++cntk; }
            }
            selw[i] = g | take;
        }
        for (int i = nt32 * 32 + tid; i < 64 * 32; i += 512) selw[i] = 0u;
    }
    WAITV_BAR();
}

__device__ __forceinline__ void fox_unit(int b, int h, int qb, const bf16_t* Z1, const float* F, const float* bfp, bf16_t* Y, char* shm, unsigned lds0, const int wave_s) {
    const int tid_ = wave_s * 64 + lane_opaque(); const int tid = tid_, lane = tid & 63, r32 = lane & 31, hi = lane >> 5; const int wid = __builtin_amdgcn_readfirstlane(tid >> 6);
    MLAS char* L = (MLAS char*)shm;
    const size_t rowb = (size_t)b * SEQ;
    const int NT = 4 * (qb + 1), nk = 64 * NT;
    MLAS float* cum2 = (MLAS float*)(L + L_X);
    MLAS float* wtot = (MLAS float*)(L + L_X + 8192);
    const bf16_t* Kb = Z1 + rowb * Z1P + 512 + 64 * h; const bf16_t* Vb = Z1 + rowb * Z1P + 1024 + 64 * h;
#pragma unroll
    for (int i = 0; i < 3; ++i) dma_kv(Kb + (size_t)64 * i * Z1P, Vb + (size_t)64 * i * Z1P, Z1P, lds0, i, wid, lane);
    {
        const float bias = bfp[h];
        const int s0 = 4 * tid;
        float v[4]; float run = 0.f;
#pragma unroll
        for (int i = 0; i < 4; ++i) {
            float x = 0.f;
            if (s0 + i < nk) x = F[(rowb + s0 + i) * 8 + h] + bias;
            const float ls = (s0 + i < nk) ? (fminf(x, 0.f) - log1pf(expf(-fabsf(x)))) : 0.f;
            run += ls; v[i] = run;
        }
        float inc = run;
#pragma unroll
        for (int o = 1; o < 64; o <<= 1) { const int ln = lane_opaque(); const float t = __builtin_bit_cast(float, __builtin_amdgcn_ds_bpermute((ln - o) << 2, __builtin_bit_cast(int, inc))); if (ln >= o) inc += t; }
        if (lane == 63) wtot[wid] = inc;
        LGKM_BAR();
        float off = inc - run;
        for (int w = 0; w < wid; ++w) off += wtot[w];
#pragma unroll
        for (int i = 0; i < 4; ++i) cum2[s0 + i] = (off + v[i]) * 1.4426950408889634f;
    }
    const int tq = 256 * qb + 32 * wid + r32;
    bf16x8 qr[4];
#pragma unroll
    for (int d0 = 0; d0 < 4; ++d0) qr[d0] = *(const bf16x8*)(Z1 + (rowb + tq) * Z1P + 64 * h + 16 * d0 + 8 * hi);
    AttnState st; st.o[0] = f32x16{}; st.o[1] = f32x16{}; st.m = 0.f; st.l = 0.f; st.pend = 0.f; st.started = false;
    MLAS float* wsf = (MLAS float*)(L + L_WSF) + wid * 64;
    WAITV_BAR();
    const float cq2 = cum2[tq];
    const int tlast = 4 * qb + (wid >> 1);
    f32x16 s0, s1;
    qkt(s0, s1, (lds_cptr)(L + L_K), qr, splat16(-st.m), r32, hi);
    for (int t = 0; t < NT; ++t) {
        const int slot = t & 3;
        { const int tt = (t + 3 < NT) ? t + 3 : NT - 1; dma_kv(Kb + (size_t)64 * tt * Z1P, Vb + (size_t)64 * tt * Z1P, Z1P, lds0, (t + 3) & 3, wid, lane); }
        bf16x8 kf[8], vf[8];
        kload(kf, (lds_cptr)(L + L_K + ((t + 1) & 3) * SLOTB), r32, hi);
        __builtin_amdgcn_sched_barrier(0);
        vload(vf, (lds_cptr)(L + L_V + slot * SLOTB), lane, hi);
        const MLAS float* cb = cum2 + 64 * t + 4 * hi;
        f32x4 c0[4], c1[4];
#pragma unroll
        for (int g = 0; g < 4; ++g) { c0[g] = *(const MLAS f32x4*)(cb + 8 * g); c1[g] = *(const MLAS f32x4*)(cb + 32 + 8 * g); }
        f32x16 n0, n1;
        qkt_mma(n0, n1, kf, qr, splat16(-st.m));
        float sc[32];
        V16_TO_ARR(s0, sc, 0); V16_TO_ARR(s1, sc, 16);
#pragma unroll
        for (int g = 0; g < 4; ++g) {
            sc[4 * g + 0] += cq2 - c0[g].x; sc[4 * g + 1] += cq2 - c0[g].y; sc[4 * g + 2] += cq2 - c0[g].z; sc[4 * g + 3] += cq2 - c0[g].w;
            sc[16 + 4 * g + 0] += cq2 - c1[g].x; sc[16 + 4 * g + 1] += cq2 - c1[g].y; sc[16 + 4 * g + 2] += cq2 - c1[g].z; sc[16 + 4 * g + 3] += cq2 - c1[g].w;
        }
        if (t >= tlast) {
            const int qrel = tq - 64 * t;
#pragma unroll
            for (int r = 0; r < 16; ++r) { const int kr = crow(r, hi); if (kr > qrel) sc[r] = -INFINITY; if (kr + 32 > qrel) sc[16 + r] = -INFINITY; }
        }
        softmax_pv(st, sc, vf, wsf, lane, r32, hi);
        s0 = n0; s1 = n1;
        WAITV2_BAR();
    }
    attn_store(st, Y + (rowb + 256 * qb + 32 * wid) * DMODEL + 64 * h, DMODEL, wsf, (MLAS bf16_t*)(L + L_OST) + wid * 2048, lane, r32, hi);
    WAITV_BAR();
}

__device__ __forceinline__ void sgu_unit(int b, int n, int g, const bf16_t* Z1, const float* sst, const float* lng, const float* lnb, const bf16_t* Wm, const float* bs, bf16_t* Y, char* shm, const int wave_s) {
    const int tid_ = wave_s * 64 + lane_opaque(); const int tid = tid_, lane = tid & 63, r32 = lane & 31, hi = lane >> 5; const int wid = __builtin_amdgcn_readfirstlane(tid >> 6);
    MLAS char* L = (MLAS char*)shm;
    MLAS bf16_t* vn = (MLAS bf16_t*)L;
    constexpr int VP = 136;
    const size_t tok0 = (size_t)b * SEQ + 128 * n;
    {
        const int j = tid >> 2, cq = (tid & 3) * 32;
        const float* sp = sst + (tok0 + j) * 16;
        float s1 = 0.f, s2 = 0.f;
#pragma unroll
        for (int k = 0; k < 8; ++k) { s1 += sp[2 * k]; s2 += sp[2 * k + 1]; }
        const float mu = s1 * (1.0f / 512.0f); const float var = fmaxf(s2 * (1.0f / 512.0f) - mu * mu, 0.f);
        const float rstd = 1.0f / sqrtf(var + RMS_EPS);
        const bf16_t* vp = Z1 + (tok0 + j) * Z1P + 2048 + 128 * g + cq;
#pragma unroll
        for (int k = 0; k < 4; ++k) {
            const u32x4 w = *(const u32x4*)(vp + 8 * k);
            const int cc = 128 * g + cq + 8 * k;
            const f32x4 g0 = *(const f32x4*)(lng + cc), g1 = *(const f32x4*)(lng + cc + 4), b0 = *(const f32x4*)(lnb + cc), b1 = *(const f32x4*)(lnb + cc + 4);
            float x[8] = {pg8::bf_lo(w.x), pg8::bf_hi(w.x), pg8::bf_lo(w.y), pg8::bf_hi(w.y), pg8::bf_lo(w.z), pg8::bf_hi(w.z), pg8::bf_lo(w.w), pg8::bf_hi(w.w)};
            float y[8];
#pragma unroll
            for (int i = 0; i < 4; ++i) { y[i] = (x[i] - mu) * rstd * g0[i] + b0[i]; y[4 + i] = (x[4 + i] - mu) * rstd * g1[i] + b1[i]; }
            u32x4 o; o.x = cvtpk(y[0], y[1]); o.y = cvtpk(y[2], y[3]); o.z = cvtpk(y[4], y[5]); o.w = cvtpk(y[6], y[7]);
            *(MLAS u32x4*)(vn + j * VP + cq + 8 * k) = o;
        }
    }
    LGKM_BAR();
    MLAS bf16_t* ut = (MLAS bf16_t*)(L + 128 * VP * 2);
    {
        const int j = tid >> 2, cq = (tid & 3) * 32;
        const bf16_t* up = Z1 + (tok0 + j) * Z1P + 1536 + 128 * g + cq;
#pragma unroll
        for (int k = 0; k < 4; ++k) *(MLAS u32x4*)(ut + j * VP + cq + 8 * k) = *(const u32x4*)(up + 8 * k);
    }
    LGKM_BAR();
    const int ib = wid & 3;
    const bf16_t* wrow = Wm + ((size_t)g * 128 + 32 * ib + r32) * 128 + 8 * hi;
    bf16x8 af[8];
#pragma unroll
    for (int s = 0; s < 8; ++s) af[s] = *(const bf16x8*)(wrow + 16 * s);
#pragma unroll
    for (int cbi = 0; cbi < 2; ++cbi) {
        const int cb = (wid >> 2) * 2 + cbi;
        f32x16 acc = {};
        lds_cptr bp = (lds_cptr)(vn) + ((size_t)(8 * hi + ((lane & 15) >> 2)) * VP + 32 * cb + 16 * ((lane >> 4) & 1) + 4 * (lane & 3)) * 2;
#pragma unroll
        for (int s = 0; s < 8; ++s) {
            const s16x4 lo = vtr(bp + (16 * s) * VP * 2), hh = vtr(bp + (16 * s + 4) * VP * 2);
            const bf16x8 bfr = {lo[0], lo[1], lo[2], lo[3], hh[0], hh[1], hh[2], hh[3]};
            acc = __builtin_amdgcn_mfma_f32_32x32x16_bf16(af[s], bfr, acc, 0, 0, 0);
        }
        float a16[16]; V16_TO_ARR(acc, a16, 0);
#pragma unroll
        for (int r = 0; r < 16; ++r) {
            const int i = 32 * ib + crow(r, hi), cc = 32 * cb + r32;
            const float uu = __builtin_bit_cast(float, (unsigned)ut[i * VP + cc] << 16);
            const float o = uu * (a16[r] + bs[g * 128 + i]);
            ut[i * VP + cc] = (bf16_t)(cvtpk(o, 0.f) & 0xffffu);
        }
    }
    LGKM_BAR();
    {
        const int j = tid >> 2, cq = (tid & 3) * 32;
        bf16_t* yp = Y + (tok0 + j) * DMODEL + 512 + 128 * g + cq;
#pragma unroll
        for (int k = 0; k < 4; ++k) *(u32x4*)(yp + 8 * k) = *(const MLAS u32x4*)(ut + j * VP + cq + 8 * k);
    }
    LGKM_BAR();
}

__device__ __forceinline__ void pool_item(int item, const bf16_t* Z0, bf16_t* Y) {
    const int row = item >> 6, ch = item & 63, c0 = ch * 8, g = ch >> 4;
    const int w = 2 << g, tpos = row & (SEQ - 1);
    const int cnt = (tpos + 1 < w) ? tpos + 1 : w;
    u32x4 v[16];
#pragma unroll
    for (int k = 0; k < 16; ++k) { v[k] = (u32x4){0u, 0u, 0u, 0u}; if (k < cnt) v[k] = *(const u32x4*)(Z0 + (size_t)(row - k) * EV_N + c0); }
    float s[8] = {0.f, 0.f, 0.f, 0.f, 0.f, 0.f, 0.f, 0.f};
#pragma unroll
    for (int k = 0; k < 16; ++k) {
        s[0] += pg8::bf_lo(v[k].x); s[1] += pg8::bf_hi(v[k].x); s[2] += pg8::bf_lo(v[k].y); s[3] += pg8::bf_hi(v[k].y);
        s[4] += pg8::bf_lo(v[k].z); s[5] += pg8::bf_hi(v[k].z); s[6] += pg8::bf_lo(v[k].w); s[7] += pg8::bf_hi(v[k].w);
    }
    const float self[8] = {pg8::bf_lo(v[0].x), pg8::bf_hi(v[0].x), pg8::bf_lo(v[0].y), pg8::bf_hi(v[0].y), pg8::bf_lo(v[0].z), pg8::bf_hi(v[0].z), pg8::bf_lo(v[0].w), pg8::bf_hi(v[0].w)};
    const float inv = 1.0f / (float)cnt;
    u32x4 o; o.x = cvtpk(s[0] * inv - self[0], s[1] * inv - self[1]); o.y = cvtpk(s[2] * inv - self[2], s[3] * inv - self[3]);
    o.z = cvtpk(s[4] * inv - self[4], s[5] * inv - self[5]); o.w = cvtpk(s[6] * inv - self[6], s[7] * inv - self[7]);
    *(u32x4*)(Y + (size_t)row * DMODEL + c0) = o;
}
}
namespace foxa {
using bf16=__hip_bfloat16;
using bf16x8=__attribute__((ext_vector_type(8)))short;
using s16x4=__attribute__((ext_vector_type(4)))short;
using f32x16=__attribute__((ext_vector_type(16)))float;
using u32x4=__attribute__((ext_vector_type(4)))unsigned;
using f32x4v=__attribute__((ext_vector_type(4)))float;
constexpr int CUM_OFF=86016;
constexpr int SEQL=2048,D=64,OPI=1024;
constexpr int NW=8,QBLK=32,QB=QBLK*NW,KVBLK=64;
__device__ __forceinline__ int crow(int r,int hi){return (r&3)+8*(r>>2)+4*hi;}
#define SBAR() __builtin_amdgcn_sched_barrier(0)
__device__ __forceinline__ void cmask(f32x16&p0,f32x16&p1,int jb,int qrel,int hi){
  const float NEG=-INFINITY; int kb=64*jb+4*hi;
  #pragma unroll
  for(int r=0;r<16;++r){int kv=kb+(r&3)+8*(r>>2); if(kv>qrel)p0[r]=NEG; if(kv+32>qrel)p1[r]=NEG;}
}

constexpr int NSLOT=3, SLOTB=8192;
constexpr int LDS_K=0, LDS_V=NSLOT*SLOTB, LDS_WS=2*NSLOT*SLOTB, LDS_OST=LDS_WS+NW*64*4, LDS_BYTES=LDS_OST+NW*4096;
constexpr float C2=0.125f*1.4426950408889634f;
__device__ __forceinline__ void glds16(const void*gsrc,unsigned lds_dst){unsigned keep;
  asm volatile("s_mov_b32 %0, m0\n\ts_mov_b32 m0, %2\n\ts_nop 0\n\tglobal_load_lds_dwordx4 %1, off\n\ts_mov_b32 m0, %0":"=&s"(keep):"v"(gsrc),"s"(lds_dst):"memory");}
__device__ __forceinline__ float max3f(float a,float b,float c){float r;asm("v_max3_f32 %0, %1, %2, %3":"=v"(r):"v"(a),"v"(b),"v"(c));return r;}
__device__ __forceinline__ float max2f(float a,float b){float r;asm("v_max_f32_e32 %0, %1, %2":"=v"(r):"v"(a),"v"(b));return r;}
__device__ __forceinline__ float fadd_s(float a,float b){float r;asm("v_add_f32_e32 %0, %1, %2":"=v"(r):"v"(a),"v"(b));return r;}
__device__ __forceinline__ float fsub_s(float a,float b){float r;asm("v_sub_f32_e32 %0, %1, %2":"=v"(r):"v"(a),"v"(b));return r;}
typedef float f32x2_t __attribute__((ext_vector_type(2))); typedef __bf16 bf16x2_t __attribute__((ext_vector_type(2)));
__device__ __forceinline__ unsigned cvtpk_s(float lo,float hi){f32x2_t v={lo,hi};bf16x2_t b=__builtin_convertvector(v,bf16x2_t);return __builtin_bit_cast(unsigned,b);}
#define WAIT_BAR(N) asm volatile("s_waitcnt vmcnt(" #N ") lgkmcnt(0)\n\ts_barrier":::"memory")

__device__ __forceinline__ void qkt(f32x16&p0,f32x16&p1,const char*Kslot,const bf16x8*qr,const f32x16&negm,int r32,int hi){
  const char*kb=Kslot+hi*1024+r32*16;
  #pragma unroll
  for(int d0=0;d0<4;++d0){
    const bf16x8 b0=*reinterpret_cast<const bf16x8*>(kb+d0*2048);
    const bf16x8 b1=*reinterpret_cast<const bf16x8*>(kb+d0*2048+512);
    if(d0==0){p0=__builtin_amdgcn_mfma_f32_32x32x16_bf16(b0,qr[0],negm,0,0,0);p1=__builtin_amdgcn_mfma_f32_32x32x16_bf16(b1,qr[0],negm,0,0,0);}
    else{p0=__builtin_amdgcn_mfma_f32_32x32x16_bf16(b0,qr[d0],p0,0,0,0);p1=__builtin_amdgcn_mfma_f32_32x32x16_bf16(b1,qr[d0],p1,0,0,0);}}
}
typedef __attribute__((address_space(3))) const char* lds_cptr;
typedef short v4i16_t __attribute__((ext_vector_type(4)));
__device__ __forceinline__ void kload8(bf16x8*kf,lds_cptr kp){
  kf[0]=*(const __attribute__((address_space(3))) bf16x8*)(kp);      kf[1]=*(const __attribute__((address_space(3))) bf16x8*)(kp+512);
  kf[2]=*(const __attribute__((address_space(3))) bf16x8*)(kp+2048); kf[3]=*(const __attribute__((address_space(3))) bf16x8*)(kp+2560);
  kf[4]=*(const __attribute__((address_space(3))) bf16x8*)(kp+4096); kf[5]=*(const __attribute__((address_space(3))) bf16x8*)(kp+4608);
  kf[6]=*(const __attribute__((address_space(3))) bf16x8*)(kp+6144); kf[7]=*(const __attribute__((address_space(3))) bf16x8*)(kp+6656);
}
__device__ __forceinline__ void kload2(bf16x8*kf,lds_cptr kp,int j){ kf[2*j]=*(const __attribute__((address_space(3))) bf16x8*)(kp+j*2048); kf[2*j+1]=*(const __attribute__((address_space(3))) bf16x8*)(kp+j*2048+512); }
__device__ __forceinline__ s16x4 vtr(lds_cptr p){ return __builtin_bit_cast(s16x4,__builtin_amdgcn_ds_read_tr16_b64_v4i16((__attribute__((address_space(3))) v4i16_t*)p)); }
__device__ __forceinline__ float rowmax(const f32x16&p0,const f32x16&p1){
  float a=max3f(p0[0],p0[1],p1[0]),b=max3f(p0[2],p0[3],p1[1]);a=max3f(a,p1[2],p1[3]);
  #pragma unroll
  for(int r=4;r<16;r+=4){a=max3f(a,p0[r],p0[r+1]);b=max3f(b,p0[r+2],p0[r+3]);a=max3f(a,p1[r],p1[r+1]);b=max3f(b,p1[r+2],p1[r+3]);}
  const float m=max2f(a,b);
  auto rr=__builtin_amdgcn_permlane32_swap(__float_as_uint(m),__float_as_uint(m),false,false);
  return max2f(__uint_as_float(rr[0]),__uint_as_float(rr[1]));
}
__device__ __forceinline__ void pv(f32x16*o,int vb,bf16x8 pa0,bf16x8 pa1,bf16x8 pa2,bf16x8 pa3){
  #pragma unroll
  for(int d0=0;d0<2;++d0){s16x4 lo[4],hi[4];
    #pragma unroll
    for(int ks=0;ks<4;++ks){
      asm volatile("ds_read_b64_tr_b16 %0,%1 offset:%c2":"=&v"(lo[ks]):"v"(vb),"i"(d0*4096+ks*1024):"memory");
      asm volatile("ds_read_b64_tr_b16 %0,%1 offset:%c2":"=&v"(hi[ks]):"v"(vb),"i"(d0*4096+ks*1024+512):"memory");}
    asm volatile("s_waitcnt lgkmcnt(0)":::"memory");SBAR();
    #define PK(k) (bf16x8){lo[k][0],lo[k][1],lo[k][2],lo[k][3],hi[k][0],hi[k][1],hi[k][2],hi[k][3]}
    o[d0]=__builtin_amdgcn_mfma_f32_32x32x16_bf16(pa0,PK(0),o[d0],0,0,0);
    o[d0]=__builtin_amdgcn_mfma_f32_32x32x16_bf16(pa1,PK(1),o[d0],0,0,0);
    o[d0]=__builtin_amdgcn_mfma_f32_32x32x16_bf16(pa2,PK(2),o[d0],0,0,0);
    o[d0]=__builtin_amdgcn_mfma_f32_32x32x16_bf16(pa3,PK(3),o[d0],0,0,0);
    #undef PK
  }
}

#ifndef ATTN_STORE16
#define ATTN_STORE16(p,v) (*(u32x4*)(p)=(v))
#endif
template<int THRL,int MODE,int QKVP,class CumFn> __device__ __forceinline__ void attn_unit(CumFn&& CUMFN,int b,int h,int qb,int q0abs,int NTU,const bf16*Q,const bf16*__restrict__ K,const bf16*__restrict__ V,bf16*O,char*shm,const __attribute__((address_space(3))) unsigned*selw,const int wave_s){
  const int tid=wave_s*64+lane_opaque(),lane=tid&63,r32=lane&31,hi=lane>>5; const int wid=__builtin_amdgcn_readfirstlane(tid>>6);
  const long rowbase=(long)b*SEQL; const int q0=(MODE==0)?qb*QB:q0abs;
  const bf16*Qw=(MODE==0)?Q+(rowbase+q0+wid*QBLK)*QKVP+h*D:Q+(rowbase+q0)*QKVP+wid*D;
  const bf16*Kh=K+rowbase*QKVP+h*D,*Vh=V+rowbase*QKVP+h*D;
  const unsigned lds0=(unsigned)(uintptr_t)shm;
  float*wsf=(float*)(shm+LDS_WS)+wid*64;
  const bf16*ksrc=Kh+(long)lane*QKVP+wid*8;
  const bf16*vsrc=Vh+(long)(16*(wid&3)+(lane>>2))*QKVP+(wid>>2)*32+(lane&3)*8;
  const unsigned kdst=lds0+LDS_K+wid*1024, vdst=lds0+LDS_V+wid*1024;
  #define DMA_K(t,slot) glds16(ksrc+(long)(t)*KVBLK*QKVP,(unsigned)__builtin_amdgcn_readfirstlane(kdst+(slot)))
  #define DMA_V(t,slot) glds16(vsrc+(long)(t)*KVBLK*QKVP,(unsigned)__builtin_amdgcn_readfirstlane(vdst+(slot)))
  const int vb0=(int)(lds0+LDS_V)+((lane>>4)&1)*32+(lane&3)*8+(4*hi+((lane&15)>>2))*64;
  const char*Kbase=shm+LDS_K; bf16x8 kf[8];
  const lds_cptr shm3=(lds_cptr)shm; const lds_cptr kp0=shm3+LDS_K+hi*1024+r32*16; const lds_cptr vp0=shm3+LDS_V+((lane>>4)&1)*32+(lane&3)*8+(4*hi+((lane&15)>>2))*64;
  const int NT=(MODE==0)?(q0+QB)/KVBLK:NTU;
  DMA_K(0,0);DMA_V(0,0);DMA_K(1,SLOTB);
  if constexpr(MODE==0){ CUMFN(); }
  bf16x8 qr[4];
  #pragma unroll
  for(int d0=0;d0<4;++d0)qr[d0]=*reinterpret_cast<const bf16x8*>(&Qw[(long)r32*QKVP+d0*16+hi*8]);
  float mhat=0.f,l_reg=0.f;float z_=0.f;asm volatile("":"+v"(z_));f32x16 o[2];o[0]=(f32x16){z_,z_,z_,z_,z_,z_,z_,z_,z_,z_,z_,z_,z_,z_,z_,z_};o[1]=o[0];f32x16 negm=o[0];asm volatile("":"+v"(negm));
  const int qrel=wid*QBLK+r32;
  const __attribute__((address_space(3))) float*cum2=(const __attribute__((address_space(3))) float*)(shm+CUM_OFF);
  const float cq2=(MODE==0)?cum2[q0+qrel]:0.f;
  #define BIAS(P0,P1,t) do{ if constexpr(MODE==0){ const __attribute__((address_space(3))) float*cb_=cum2+64*(t)+4*hi; \
    _Pragma("unroll") for(int g_=0;g_<4;++g_){ const f32x4v c0_=*(const __attribute__((address_space(3))) f32x4v*)(cb_+8*g_), c1_=*(const __attribute__((address_space(3))) f32x4v*)(cb_+32+8*g_); \
      P0[4*g_+0]+=cq2-c0_.x; P0[4*g_+1]+=cq2-c0_.y; P0[4*g_+2]+=cq2-c0_.z; P0[4*g_+3]+=cq2-c0_.w; \
      P1[4*g_+0]+=cq2-c1_.x; P1[4*g_+1]+=cq2-c1_.y; P1[4*g_+2]+=cq2-c1_.z; P1[4*g_+3]+=cq2-c1_.w; } } }while(0)
  #define SELM(P0,P1,t) do{ if constexpr(MODE==1){ const unsigned w0_=selw[(2*(t))*32+r32]>>(4*hi), w1_=selw[(2*(t)+1)*32+r32]>>(4*hi); \
    _Pragma("unroll") for(int r=0;r<16;++r){ const int sh_=(r&3)+8*(r>>2); if(!((w0_>>sh_)&1u))P0[r]=-INFINITY; if(!((w1_>>sh_)&1u))P1[r]=-INFINITY; } } }while(0)
  #define CMASK(P0,P1,t) do{ if constexpr(MODE==0){int jb_=(t)-(NT-4); if(jb_>=0)cmask(P0,P1,jb_,qrel,hi);} }while(0)
  bool resc=false;
  #define START(P0,P1) do{ const float rm=rowmax(P0,P1); resc=false; \
    { const float dl=(MODE==1&&!(rm>-1e30f))?0.f:rm; mhat=fadd_s(mhat,dl); \
      _Pragma("unroll") for(int r=0;r<16;++r){P0[r]=fsub_s(P0[r],dl);P1[r]=fsub_s(P1[r],dl);} \
      _Pragma("unroll") for(int r=0;r<16;++r)negm[r]=-mhat; asm volatile("":"+v"(negm)); } \
    _Pragma("unroll") for(int r=0;r<16;++r)P0[r]=__builtin_amdgcn_exp2f(P0[r]); }while(0)
  #define RESC() do{ if(resc){ asm volatile("s_waitcnt lgkmcnt(0)":::"memory"); \
      _Pragma("unroll") for(int d_=0;d_<2;++d_) _Pragma("unroll") for(int r=0;r<16;++r)o[d_][r]*=wsf[crow(r,hi)]; } }while(0)
  f32x16 pA0,pA1,pB0,pB1;
  int sl_prev=0,sl_cur=0,sl_next=SLOTB;
  #define ROT() do{sl_prev=sl_cur;sl_cur=sl_next;sl_next=(sl_next==(NSLOT-1)*SLOTB)?0:sl_next+SLOTB;}while(0)
  DMA_K(2,2*SLOTB);
  WAIT_BAR(3);
  qkt(pA0,pA1,Kbase,qr,negm,r32,hi);asm volatile("s_nop 15\n\ts_nop 7":"+v"(pA0),"+v"(pA1));BIAS(pA0,pA1,0);SELM(pA0,pA1,0);CMASK(pA0,pA1,0);
  START(pA0,pA1);
  _Pragma("unroll") for(int r=0;r<16;++r)pA1[r]=__builtin_amdgcn_exp2f(pA1[r]);
  WAIT_BAR(0);
  DMA_K(3,0);DMA_V(1,SLOTB);
  ROT();
  kload8(kf,kp0+sl_cur);
  WAIT_BAR(2);
  s16x4 vlo[8],vhi[8]; u32x4 pw0,pw1,pw2,pw3;
  #define PKW(P,B) cvtpk_s(P[B],P[B+1])
  #define PAF(k) __builtin_bit_cast(bf16x8,pw##k)
  #define VFR(i) (bf16x8){vlo[i][0],vlo[i][1],vlo[i][2],vlo[i][3],vhi[i][0],vhi[i][1],vhi[i][2],vhi[i][3]}
  #define PIN(x) asm volatile("":"+v"(x))
  #define MX3(a,b,c) __builtin_fmaxf(__builtin_fmaxf((a),(b)),(c))
  #define GAPA(MF,A0,A1,A2,A3,W0,W1,PW) do{ MF; sacc+=A0; sacc+=A1; sacc+=A2; sacc+=A3; PIN(sacc); W0; W1; PIN(PW); SBAR(); }while(0)
  #define EX(v) __builtin_amdgcn_exp2f(v)
  #define GAPB(MF,X,B) do{ MF; X[B]=EX(X[B]); X[B+1]=EX(X[B+1]); X[B+2]=EX(X[B+2]); X[B+3]=EX(X[B+3]); PIN(X); SBAR(); }while(0)
  #define VRD(i) do{ vlo[i]=vtr(vp_+(((i)>>2)*4096+((i)&3)*1024)); vhi[i]=vtr(vp_+(((i)>>2)*4096+((i)&3)*1024+512)); }while(0)
  #define KRD(G,j) do{ if(G){ kload2(kf,kp0+sl_next,j); SBAR(); } }while(0)
  #define STEP(C0,C1,P0,P1,t,GK,GV,GL) do{ SBAR(); \
    const lds_cptr vp_=vp0+sl_prev; \
    VRD(0); SBAR(); float sacc=(P0[0]+P0[1]); \
    GAPA(C0=__builtin_amdgcn_mfma_f32_32x32x16_bf16(kf[0],qr[0],negm,0,0,0), P0[2],P0[3],P0[4],P0[5],     pw0[0]=PKW(P0,0), pw0[1]=PKW(P0,2), pw0); \
    VRD(4); SBAR(); GAPA(C1=__builtin_amdgcn_mfma_f32_32x32x16_bf16(kf[1],qr[0],negm,0,0,0), P0[6],P0[7],P0[8],P0[9],     pw0[2]=PKW(P0,4), pw0[3]=PKW(P0,6), pw0); \
    VRD(1); SBAR(); GAPA(C0=__builtin_amdgcn_mfma_f32_32x32x16_bf16(kf[2],qr[1],C0,0,0,0),   P0[10],P0[11],P0[12],P0[13], pw1[0]=PKW(P0,8), pw1[1]=PKW(P0,10), pw1); \
    VRD(5); SBAR(); GAPA(C1=__builtin_amdgcn_mfma_f32_32x32x16_bf16(kf[3],qr[1],C1,0,0,0),   P0[14],P0[15],P1[0],P1[1],   pw1[2]=PKW(P0,12),pw1[3]=PKW(P0,14), pw1); \
    VRD(2); SBAR(); GAPA(C0=__builtin_amdgcn_mfma_f32_32x32x16_bf16(kf[4],qr[2],C0,0,0,0),   P1[2],P1[3],P1[4],P1[5],     pw2[0]=PKW(P1,0), pw2[1]=PKW(P1,2), pw2); \
    VRD(6); SBAR(); GAPA(C1=__builtin_amdgcn_mfma_f32_32x32x16_bf16(kf[5],qr[2],C1,0,0,0),   P1[6],P1[7],P1[8],P1[9],     pw2[2]=PKW(P1,4), pw2[3]=PKW(P1,6), pw2); \
    VRD(3); SBAR(); GAPA(C0=__builtin_amdgcn_mfma_f32_32x32x16_bf16(kf[6],qr[3],C0,0,0,0),   P1[10],P1[11],P1[12],P1[13], pw3[0]=PKW(P1,8), pw3[1]=PKW(P1,10), pw3); \
    VRD(7); SBAR(); GAPA(C1=__builtin_amdgcn_mfma_f32_32x32x16_bf16(kf[7],qr[3],C1,0,0,0),   P1[14],P1[15],0.f,0.f,       pw3[2]=PKW(P1,12),pw3[3]=PKW(P1,14), pw3); \
    l_reg+=sacc; \
    if(GK){DMA_K((t)+3,sl_cur);} if(GV){DMA_V((t)+1,sl_next);} \
    BIAS(C0,C1,t); SELM(C0,C1,t); CMASK(C0,C1,t); \
    { float a=MX3(C0[0],C0[1],C1[0]),b=MX3(C0[2],C0[3],C1[1]); a=MX3(a,C1[2],C1[3]); \
      _Pragma("unroll") for(int r=4;r<16;r+=4){a=MX3(a,C0[r],C0[r+1]);b=MX3(b,C0[r+2],C0[r+3]);a=MX3(a,C1[r],C1[r+1]);b=MX3(b,C1[r+2],C1[r+3]);} \
      float rm=__builtin_fmaxf(a,b); { auto rr=__builtin_amdgcn_permlane32_swap(__float_as_uint(rm),__float_as_uint(rm),false,false); rm=__builtin_fmaxf(__uint_as_float(rr[0]),__uint_as_float(rr[1])); } \
      resc=false; \
      if(__builtin_expect(__any(rm>(float)THRL),0)){ const float dl=__builtin_fmaxf(rm,0.f); mhat+=dl; \
        _Pragma("unroll") for(int r=0;r<16;++r){C0[r]-=dl;C1[r]-=dl;} \
        _Pragma("unroll") for(int r=0;r<16;++r)negm[r]=-mhat; asm volatile("":"+v"(negm)); \
        const float f=__builtin_amdgcn_exp2f(-dl); l_reg*=f; if(hi==0)wsf[r32]=f; resc=true; } } \
    SBAR(); \
    GAPB(o[0]=__builtin_amdgcn_mfma_f32_32x32x16_bf16(PAF(0),VFR(0),o[0],0,0,0), C0,0); \
    GAPB(o[1]=__builtin_amdgcn_mfma_f32_32x32x16_bf16(PAF(0),VFR(4),o[1],0,0,0), C0,4); \
    KRD(GL,0); GAPB(o[0]=__builtin_amdgcn_mfma_f32_32x32x16_bf16(PAF(1),VFR(1),o[0],0,0,0), C0,8); \
    KRD(GL,1); GAPB(o[1]=__builtin_amdgcn_mfma_f32_32x32x16_bf16(PAF(1),VFR(5),o[1],0,0,0), C0,12); \
    KRD(GL,2); GAPB(o[0]=__builtin_amdgcn_mfma_f32_32x32x16_bf16(PAF(2),VFR(2),o[0],0,0,0), C1,0); \
    KRD(GL,3); GAPB(o[1]=__builtin_amdgcn_mfma_f32_32x32x16_bf16(PAF(2),VFR(6),o[1],0,0,0), C1,4); \
    GAPB(o[0]=__builtin_amdgcn_mfma_f32_32x32x16_bf16(PAF(3),VFR(3),o[0],0,0,0), C1,8); \
    GAPB(o[1]=__builtin_amdgcn_mfma_f32_32x32x16_bf16(PAF(3),VFR(7),o[1],0,0,0), C1,12); \
    }while(0)
  int t=1;
  #undef CMASK
  #define CMASK(P0,P1,t) do{}while(0)
  for(;t+5<NT;t+=2){
    STEP(pB0,pB1,pA0,pA1,t,true,true,true);     WAIT_BAR(2); RESC(); ROT();
    STEP(pA0,pA1,pB0,pB1,t+1,true,true,true);   WAIT_BAR(2); RESC(); ROT();
  }
  #undef CMASK
  #define CMASK(P0,P1,t) do{ if constexpr(MODE==0){int jb_=(t)-(NT-4); if(jb_>=0)cmask(P0,P1,jb_,qrel,hi);} }while(0)
  #define ENDW(tt) do{ if((tt)+3<NT){WAIT_BAR(2);} else if((tt)+2<NT){WAIT_BAR(1);} else {WAIT_BAR(0);} }while(0)
  for(;t+1<NT;t+=2){
    STEP(pB0,pB1,pA0,pA1,t,(t+3<NT),(t+1<NT),(t+1<NT));       ENDW(t);   RESC(); ROT();
    STEP(pA0,pA1,pB0,pB1,t+1,(t+4<NT),(t+2<NT),(t+2<NT));     ENDW(t+1); RESC(); ROT();
  }
  STEP(pB0,pB1,pA0,pA1,NT-1,false,false,false); RESC();
  { float sacc=pB0[0]+pB0[1]; _Pragma("unroll") for(int r=2;r<16;++r)sacc+=pB0[r]; _Pragma("unroll") for(int r=0;r<16;++r)sacc+=pB1[r]; l_reg+=sacc;
    pw0=(u32x4){PKW(pB0,0),PKW(pB0,2),PKW(pB0,4),PKW(pB0,6)};pw1=(u32x4){PKW(pB0,8),PKW(pB0,10),PKW(pB0,12),PKW(pB0,14)};pw2=(u32x4){PKW(pB1,0),PKW(pB1,2),PKW(pB1,4),PKW(pB1,6)};pw3=(u32x4){PKW(pB1,8),PKW(pB1,10),PKW(pB1,12),PKW(pB1,14)};
    SBAR(); pv(o,vb0+sl_cur,PAF(0),PAF(1),PAF(2),PAF(3)); }
  #undef PKW
  #undef PAF
  #undef VFR
  #undef PIN
  #undef MX3
  #undef GAPA
  #undef GAPB
  #undef EX
  #undef VRD
  #undef KRD
  #undef STEP
  #undef ENDW
  {auto rr=__builtin_amdgcn_permlane32_swap(__float_as_uint(l_reg),__float_as_uint(l_reg),false,false);l_reg=__uint_as_float(rr[0])+__uint_as_float(rr[1]);}
  if(hi==0)wsf[32+r32]=l_reg;asm volatile("s_waitcnt lgkmcnt(0)":::"memory");
  float rli[16];
  #pragma unroll
  for(int r=0;r<16;++r)rli[r]=__builtin_amdgcn_rcpf(wsf[32+crow(r,hi)]);
  bf16*Ow=(MODE==0)?O+(rowbase+q0+wid*QBLK)*OPI+h*D:O+(rowbase+q0)*OPI+wid*D;
  { bf16*stg=(bf16*)(shm+LDS_OST)+wid*2048;
    #pragma unroll
    for(int r=0;r<16;++r){const int orow=crow(r,hi);
      #pragma unroll
      for(int d0=0;d0<2;++d0)stg[orow*64+d0*32+r32]=__float2bfloat16(o[d0][r]*rli[r]);}
    asm volatile("s_waitcnt lgkmcnt(0)":::"memory");
    #pragma unroll
    for(int i=0;i<4;++i){const int row=i*8+(lane>>3),ch=lane&7; const u32x4 v=*(const u32x4*)(stg+row*64+ch*8); ATTN_STORE16(Ow+(long)row*OPI+ch*8,v);} }
  asm volatile("s_waitcnt lgkmcnt(0)\n\ts_barrier":::"memory");
  #undef DMA_K
  #undef DMA_V
  #undef CMASK
  #undef START
  #undef BIAS
  #undef SELM
  #undef RESC
  #undef ROT
}
#undef SBAR
#undef WAIT_BAR
}

#ifndef DBG_REP_SEL
#define DBG_REP_SEL 1
#endif
namespace mix {
__device__ __forceinline__ void fox_unit2(int b, int h, int qb, const bf16_t* Z1, const float* F, const float* bfp, bf16_t* Y, char* shm, const int wave_s) {
    const size_t rowb = (size_t)b * SEQ;
    const int nk = 256 * (qb + 1);
    auto cumfn = [=]() {
        const int tid = wave_s * 64 + lane_opaque(), lane = tid & 63; const int wid = __builtin_amdgcn_readfirstlane(tid >> 6);
        MLAS char* L = (MLAS char*)shm;
        MLAS float* cum2 = (MLAS float*)(L + foxa::CUM_OFF);
        MLAS float* wtot = (MLAS float*)(L + foxa::CUM_OFF + 8192);
        const float bias = bfp[h];
        const int s0 = 4 * tid;
        float v[4]; float run = 0.f;
#pragma unroll
        for (int i = 0; i < 4; ++i) {
            float x = 0.f;
            if (s0 + i < nk) x = F[(rowb + s0 + i) * 8 + h] + bias;
            const float ls = (s0 + i < nk) ? (fminf(x, 0.f) - log1pf(expf(-fabsf(x)))) : 0.f;
            run += ls; v[i] = run;
        }
        float inc = run;
#pragma unroll
        for (int o = 1; o < 64; o <<= 1) { const int ln = lane_opaque(); const float t = __builtin_bit_cast(float, __builtin_amdgcn_ds_bpermute((ln - o) << 2, __builtin_bit_cast(int, inc))); if (ln >= o) inc += t; }
        if (lane == 63) wtot[wid] = inc;
        LGKM_BAR();
        float off = inc - run;
        for (int w = 0; w < wid; ++w) off += wtot[w];
#pragma unroll
        for (int i = 0; i < 4; ++i) cum2[s0 + i] = (off + v[i]) * 1.4426950408889634f;
        LGKM_BAR();
    };
    foxa::attn_unit<8, 0, 2560>(cumfn, b, h, qb, 0, 0, (const foxa::bf16*)Z1, (const foxa::bf16*)(Z1 + 512), (const foxa::bf16*)(Z1 + 1024), (foxa::bf16*)Y, shm, nullptr, wave_s);
}
__device__ __forceinline__ void dsa_unit(int b, int qg, const bf16_t* Z0, bf16_t* Y, char* shm, unsigned lds0, const int wave_s) {
    for (int rep_ = 0; rep_ < DBG_REP_SEL; ++rep_) dsa_select(b, qg, Z0, shm, wave_s);
    const int nt64 = (qg >> 1) + 1; int ntu = (nt64 + 1) & ~1; if (ntu < 4) ntu = 4;
    foxa::attn_unit<8, 1, EV_N>([]() {}, b, 0, 0, 32 * qg, ntu, (const foxa::bf16*)(Z0 + 512), (const foxa::bf16*)(Z0 + 1024), (const foxa::bf16*)(Z0 + 1088), (foxa::bf16*)(Y + 512), shm,
                                (const MLAS unsigned*)((MLAS char*)shm + LX_SEL), wave_s);
}
}
constexpr int NWAVES = 8;
constexpr size_t KiB = 1024, MiB = 1u << 20;
constexpr size_t WS_CTL = 0, CTL_ZERO_BYTES = 1 * MiB;
constexpr size_t WS_W_EVIN = 1 * MiB, WS_W_OUT0 = 4 * MiB, WS_W_FFI0 = 6 * MiB, WS_W_FFO0 = 17 * MiB, WS_W_PG0 = 22 * MiB + 512 * KiB, WS_W_PP0 = 24 * MiB + 512 * KiB;
constexpr size_t WS_W_ODIN = 25 * MiB, WS_W_OUT1 = 30 * MiB + 512 * KiB, WS_W_FFI1 = 32 * MiB + 512 * KiB, WS_W_FFO1 = 43 * MiB + 512 * KiB, WS_W_PG1 = 49 * MiB, WS_W_PP1 = 51 * MiB, WS_W_SGU = 51 * MiB + 512 * KiB;
constexpr size_t WS_RSTD = 57 * MiB + 768 * KiB;
constexpr size_t WS_SSQA = 52 * MiB, WS_SSQB = 53 * MiB, WS_ROPE = 54 * MiB, WS_AH = 55 * MiB, WS_FBUF = 58 * MiB + 512 * KiB, WS_SST = 59 * MiB;
constexpr size_t WS_HB = 60 * MiB, WS_AHALO = 92 * MiB, WS_PP = 92 * MiB + 512 * KiB, WS_Y = 124 * MiB + 512 * KiB, WS_ZH = 156 * MiB + 512 * KiB, WS_PB = 244 * MiB + 512 * KiB, WS_END = 252 * MiB + 512 * KiB;
static_assert(WS_AHALO == WS_HB + (size_t)TOK * 1024 * 2, "the halo rows are row tile 64 of the FFN in-projection A operand");
static_assert(WS_W_EVIN + (size_t)EV_N * 1024 * 2 <= WS_W_OUT0 && WS_W_FFI0 + (size_t)NFF2 * 1024 * 2 <= WS_W_FFO0 && WS_W_FFO0 + (size_t)1024 * DFF * 2 <= WS_W_PG0, "ws map 1");
static_assert(WS_W_ODIN + (size_t)OD_N * 1024 * 2 <= WS_W_OUT1 && WS_W_FFI1 + (size_t)NFF2 * 1024 * 2 <= WS_W_FFO1 && WS_W_FFO1 + (size_t)1024 * DFF * 2 <= WS_W_PG1 && WS_W_SGU + 4 * 128 * 128 * 2 <= WS_SSQA, "ws map 2");
static_assert(WS_AH + (size_t)128 * NFF2 * 4 <= WS_RSTD && WS_ZH + (size_t)TOK * DFF * 2 <= WS_PB && WS_PB + (size_t)TOK * PLE * 2 <= WS_END, "ws map 3");
constexpr int CW_BAR = 4096, CW_FLAG = 8192;
constexpr int RING_BYTES = 131072, XB_OFF = RING_BYTES, LDSCTL_OFF = XB_OFF + 8192 + 1024 + 64, MISC_OFF = LDSCTL_OFF + 320, LDS_BYTES = 147456;
static_assert(MISC_OFF + 128 <= LDS_BYTES, "LDS map");

#define GAS __attribute__((address_space(1)))
#define LAS __attribute__((address_space(3)))
typedef unsigned short bf16;
typedef unsigned v4u __attribute__((ext_vector_type(4)));
typedef float f32x4 __attribute__((ext_vector_type(4)));
typedef float f32x2 __attribute__((ext_vector_type(2)));
#define LDS_WAIT() asm volatile("s_waitcnt lgkmcnt(0)" ::: "memory")
#define VM_WAIT() asm volatile("s_waitcnt vmcnt(0)" ::: "memory")
__device__ __forceinline__ unsigned f2bf(float f) { unsigned u = __builtin_bit_cast(unsigned, f); return (u + 0x7fffu + ((u >> 16) & 1u)) >> 16; }
__device__ __forceinline__ unsigned pk2(float lo, float hi) { return f2bf(lo) | (f2bf(hi) << 16); }

#define XB_TMO      128
#define XB_XCNT(j)  (256  + 64 * (j))
#define XB_XSUB(j)  (1280 + 64 * (j))
#define XB_XGEN(j)  (2304 + 64 * (j))
#define XB_TOP      3328
#define XB_TOPGEN   3392
#define XCD_BAR_WORDS 3456
#define XB_SPIN_CAP (1u << 18)
__device__ __forceinline__ unsigned xb_ld(unsigned* p)              { return __hip_atomic_load(p, __ATOMIC_RELAXED, __HIP_MEMORY_SCOPE_AGENT); }
__device__ __forceinline__ unsigned xb_add(unsigned* p, unsigned v) { return __hip_atomic_fetch_add(p, v, __ATOMIC_RELAXED, __HIP_MEMORY_SCOPE_AGENT); }
__device__ __forceinline__ unsigned xb_xcc_id() { return (unsigned)__builtin_amdgcn_s_getreg((3 << 11) | 20) & 0xFu; }
#define XB_SPIN(cond, bar) do { unsigned _sp = 0; while (cond) { __builtin_amdgcn_s_sleep(1); \
    if ((++_sp & 255u) == 0u) { if (xb_ld(&(bar)[XB_TMO])) break; if (_sp > XB_SPIN_CAP) { atomicAdd(&(bar)[XB_TMO], 1u); break; } } } } while (0)
struct XcdBarrier { unsigned* bar; unsigned x; volatile LAS unsigned* st; };
__device__ __forceinline__ XcdBarrier xcd_barrier_post(unsigned* bar, volatile LAS unsigned* st) {
    XcdBarrier b; b.bar = bar; b.x = xb_xcc_id(); b.st = st;
    if (threadIdx.x == 0) (void)xb_add(&bar[XB_XCNT(b.x)], 1u);
    return b;
}
__device__ __forceinline__ void xcd_barrier_complete(unsigned* bar, unsigned x, unsigned& nloc, unsigned& nx) {
    const unsigned G = gridDim.x * gridDim.y * gridDim.z;
    unsigned sum, cnt, mine, sp = 0u;
    for (;;) {
        sum = 0u; cnt = 0u; mine = 0u;
#pragma unroll 1
        for (unsigned j = 0; j < 16; ++j) { const unsigned c = xb_ld(&bar[XB_XCNT(j)]); sum += c; cnt += (c > 0u) ? 1u : 0u; mine = (j == x) ? c : mine; }
        if (sum == G) break;
        __builtin_amdgcn_s_sleep(1);
        if ((++sp & 255u) == 0u) { if (xb_ld(&bar[XB_TMO])) break; if (sp > XB_SPIN_CAP) { atomicAdd(&bar[XB_TMO], 1u); break; } }
    }
    nloc = mine > 0u ? mine : 1u; nx = cnt > 0u ? cnt : 1u;
}
__device__ __forceinline__ void xcd_barrier(const XcdBarrier& b) {
    asm volatile("s_waitcnt vmcnt(0)" ::: "memory");
    __syncthreads();
    if (threadIdx.x == 0) {
        unsigned* bar = b.bar;
        __builtin_amdgcn_s_waitcnt(0);
        unsigned nloc = b.st[0], nx = b.st[1];
        if (nloc == 0u) { xcd_barrier_complete(bar, b.x, nloc, nx); b.st[0] = nloc; b.st[1] = nx; }
        const unsigned old = xb_add(&bar[XB_XSUB(b.x)], 1u);
        const unsigned gen = old / nloc;
        if (old + 1u == (gen + 1u) * nloc) {
            __builtin_amdgcn_fence(__ATOMIC_RELEASE, "agent");
            asm volatile("s_waitcnt vmcnt(0)" ::: "memory");
            const unsigned og = xb_add(&bar[XB_TOP], 1u);
            const unsigned tg = og / nx;
            if (og + 1u == (tg + 1u) * nx) xb_add(&bar[XB_TOPGEN], 1u);
            else XB_SPIN(xb_ld(&bar[XB_TOPGEN]) == tg, bar);
            __builtin_amdgcn_fence(__ATOMIC_ACQUIRE, "agent");
            xb_add(&bar[XB_XGEN(b.x)], 1u);
            asm volatile("s_waitcnt vmcnt(0)" ::: "memory");
        } else {
            XB_SPIN(xb_ld(&bar[XB_XGEN(b.x)]) == gen, bar);
            __builtin_amdgcn_fence(__ATOMIC_ACQUIRE, "agent");
            asm volatile("s_waitcnt vmcnt(0)" ::: "memory");
        }
    }
    __syncthreads();
}

__device__ __forceinline__ float wave_sum(float v) {
#pragma unroll
    for (int o = 1; o < 64; o <<= 1) v += __builtin_bit_cast(float, __builtin_amdgcn_ds_bpermute((lane_opaque() ^ o) << 2, __builtin_bit_cast(int, v)));
    return v;
}
__device__ __forceinline__ int vcu_of(int i, int n) { return i; }
__device__ __forceinline__ int unperm16(int d) { return d < 16 ? ((d >> 1) + 8 * (d & 1)) : d; }
__device__ __forceinline__ int map_col(int type, int n, int nold) {
    if (type == 0) return n < nold ? n : -1;
    if (type == 1) {
        if (n < 512) return n;
        if (n < 1024) { const int h = (n - 512) >> 6, d = (n - 512) & 63; return 512 + 64 * h + unperm16(d); }
        if (n < 1088) return 1024 + unperm16(n - 1024);
        if (n < 1152) return n;
        if (n < 1216) return 1408 + unperm16(n - 1152);
        if (n < 1220) return 1472 + (n - 1216);
        if (n < 1280) return -1;
        { const int h = (n - 1280) >> 6, d = (n - 1280) & 63; return 1152 + 64 * h + unperm16(d); }
    }
    if (type == 2) {
        if (n < 1536) return n;
        if (n < 2560) return n + 8;
        if (n < 2568) return 1536 + (n - 2560);
        return -1;
    }
    { const int pn = n >> 8, bj = (n >> 7) & 1, jj = n & 127; return bj * DFF + 128 * pn + jj; }
}
struct TJob { const float* W; const float* rowscale; bf16* WT; int K, Nold, Nnew, ldk, koff, type, nitems; };
__device__ __forceinline__ void transpose_item(const TJob& J, LAS float* scr, int item, int lane) {
    const int nblk = J.Nnew / 32, kb = item / nblk, nb = item % nblk, k0 = 64 * kb, n0 = 32 * nb;
    const int oc = map_col(J.type, n0 + (lane & 31), J.Nold);
    const int occ = oc >= 0 ? oc : 0;
    float vv[32];
#pragma unroll
    for (int i = 0; i < 32; ++i) vv[i] = J.W[(size_t)(k0 + 2 * i + (lane >> 5)) * J.Nold + occ];
#pragma unroll
    for (int i = 0; i < 32; ++i) { const int kk = 2 * i + (lane >> 5);
        float v = (oc >= 0) ? vv[i] : 0.f;
        if (J.rowscale) v *= J.rowscale[k0 + kk];
        scr[kk * 33 + (lane & 31)] = v; }
    LDS_WAIT(); asm volatile("" ::: "memory");
    const int c = lane & 7;
#pragma unroll
    for (int j = 0; j < 4; ++j) { const int n = (lane >> 3) + 8 * j; const LAS float* s = scr + (8 * c) * 33 + n;
        v4u o; o.x = pk2(s[0 * 33], s[1 * 33]); o.y = pk2(s[2 * 33], s[3 * 33]); o.z = pk2(s[4 * 33], s[5 * 33]); o.w = pk2(s[6 * 33], s[7 * 33]);
        *(GAS v4u*)(J.WT + (size_t)(n0 + n) * J.ldk + J.koff + k0 + 8 * c) = o; }
    LDS_WAIT(); asm volatile("" ::: "memory");
}
__device__ __forceinline__ void sincos_d(double a, float& sn, float& cs) {
    const double q = rint(a * 0.63661977236758134308);
    double r = a - q * 1.57079632673412561417e+00; r -= q * 6.07710050650619224932e-11;
    const double r2 = r * r;
    double s = 1.0 / 6227020800.0; s = s * r2 - 1.0 / 39916800.0; s = s * r2 + 1.0 / 362880.0; s = s * r2 - 1.0 / 5040.0; s = s * r2 + 1.0 / 120.0; s = s * r2 - 1.0 / 6.0; s = s * r2 * r + r;
    double c = -1.0 / 87178291200.0; c = c * r2 + 1.0 / 479001600.0; c = c * r2 - 1.0 / 3628800.0; c = c * r2 + 1.0 / 40320.0; c = c * r2 - 1.0 / 720.0; c = c * r2 + 1.0 / 24.0; c = c * r2 - 0.5; c = c * r2 + 1.0;
    const int qi = ((int)q) & 3;
    const double ss = (qi == 0) ? s : (qi == 1) ? c : (qi == 2) ? -s : -c;
    const double cc = (qi == 0) ? c : (qi == 1) ? -s : (qi == 2) ? -c : s;
    sn = (float)ss; cs = (float)cc;
}

struct Args { const void* in[24]; float* out; unsigned char* ws; int ph_lo, ph_hi; };
typedef const Args __attribute__((address_space(4)))* argp_t;
__device__ __forceinline__ argp_t get_args() { argp_t p = (argp_t)__builtin_amdgcn_kernarg_segment_ptr(); asm volatile("" : "+s"(p)); return p; }
__device__ __forceinline__ int otid(int wave_s) { return wave_s * 64 + lane_opaque(); }
#define IN_F(k) ((const float*)A_->in[k])
#define PH_LOCALS \
    argp_t A_ = get_args(); unsigned char* const ws = A_->ws; float* const out = A_->out; (void)out; \
    const int tid = otid(wave_s), lane = tid & 63, wave = wave_s; (void)lane; (void)wave; \
    const int G = gridDim.x, bx = blockIdx.x, vcu = (G % 8 == 0) ? (bx % 8) * (G / 8) + bx / 8 : bx; (void)vcu; \
    const int gw = vcu * NWAVES + wave, NGW = G * NWAVES, gt = vcu * (NWAVES * 64) + tid, NGT = G * NWAVES * 64; (void)gw; (void)NGW; (void)gt; (void)NGT; \
    LAS unsigned char* const L = (LAS unsigned char*)lds; (void)L;
#define WSP(T, off) ((T*)(ws + (off)))

__global__ void __launch_bounds__(NWAVES * 64, 2) mega_fwd(Args args) {
    extern __shared__ __attribute__((aligned(16))) unsigned char lds[];
    int lo, hi; XcdBarrier bar;
    const int wave_s = __builtin_amdgcn_readfirstlane((int)threadIdx.x >> 6);
    {
        PH_LOCALS
        volatile LAS unsigned* MISC = (volatile LAS unsigned*)(L + MISC_OFF);
        for (int u = tid; u < (LDS_BYTES - XB_OFF) / 4; u += NWAVES * 64) ((LAS unsigned*)(L + XB_OFF))[u] = 0u;
        __syncthreads();
        bar = xcd_barrier_post((unsigned*)(ws + WS_CTL) + CW_BAR, MISC + 8);
        lo = A_->ph_lo; hi = A_->ph_hi;
    }
#ifndef DBG_REP_TR
#define DBG_REP_TR 1
#endif
#ifndef DBG_REP_HB
#define DBG_REP_HB 1
#endif
#ifndef DBG_REP_FOX
#define DBG_REP_FOX 1
#endif
#ifndef DBG_REP_DSA
#define DBG_REP_DSA 1
#endif
#ifndef DBG_REP_SGU
#define DBG_REP_SGU 1
#endif
#ifndef DBG_REP_POOL
#define DBG_REP_POOL 1
#endif
#ifndef PHMASK
#define PHMASK 0xffffffu
#endif
#define IN(k) (((PHMASK >> (k)) & 1u) && lo <= (k) && (k) < hi)
#define SEAM(k) do { if (IN(k) && IN((k) + 1)) xcd_barrier(bar); } while (0)
    if (IN(0)) {
        PH_LOCALS
        LAS float* scr = (LAS float*)(L + wave * 16384);
        const float* norm_mix = IN_F(3); const float* norm_ffn = IN_F(4); const float* norm_ple = IN_F(5);
        const float* ffn_w_in = IN_F(6); const float* ffn_w_out = IN_F(9); const float* ple_w_proj = IN_F(10); const float* ple_w_gate = IN_F(11);
        const float* ev_w_in = IN_F(13); const float* ev_w_out = IN_F(14); const float* od_w_in = IN_F(17); const float* od_w_out = IN_F(18);
#define TJ(Wp, RS, WTp, K_, NOLD, NNEW, LDK, KOFF, TYPE) { constexpr int NI_ = ((K_) / 64) * ((NNEW) / 32); if (r < NI_) { const TJob J{(Wp), (RS), (WTp), (K_), (NOLD), (NNEW), (LDK), (KOFF), (TYPE), NI_}; transpose_item(J, scr, r, lane); continue; } r -= NI_; }
        constexpr int NITEMS = 16 * 48 + 8 * 32 + 44 * 32 + 4 * 32;
        for (int rep_ = 0; rep_ < DBG_REP_TR; ++rep_) for (int it = gw; it < NITEMS; it += NGW) {
            int r = it;
            TJ(ev_w_in, norm_mix, WSP(bf16, WS_W_EVIN), 1024, 1476, EV_N, 1024, 0, 1)
            TJ(ev_w_out + (size_t)512 * 1024, nullptr, WSP(bf16, WS_W_OUT0), 512, 1024, 1024, 1024, 512, 0)
            TJ(ffn_w_out + (size_t)DFF * 1024, nullptr, WSP(bf16, WS_W_FFO1), DFF, 1024, 1024, DFF, 0, 0)
            TJ(ple_w_proj + (size_t)256 * 1024, nullptr, WSP(bf16, WS_W_PP1), 256, 1024, 1024, 256, 0, 0)
        }
#undef TJ
        { const float* sgu_w = IN_F(22); bf16* W_SGU = WSP(bf16, WS_W_SGU);
          for (int i = gt; i < 4 * 128 * 128; i += NGT) { const int jj = i & 127, ii = (i >> 7) & 127; W_SGU[i] = (bf16)((ii < 64 && jj >= 64) ? 0u : f2bf(sgu_w[i])); } }
        { const float* x = IN_F(0); bf16* HB = WSP(bf16, WS_HB); float* SSQA = WSP(float, WS_SSQA);
          for (int m = gw; m < TOK; m += 4 * NGW) {
            f32x4 v[4][4];
#pragma unroll
            for (int q = 0; q < 4; ++q) { const int mm = (m + q * NGW < TOK) ? m + q * NGW : m; const f32x4* xr = (const f32x4*)(x + (size_t)mm * DMODEL) + lane;
#pragma unroll
                for (int j = 0; j < 4; ++j) v[q][j] = xr[64 * j]; }
#pragma unroll
            for (int q = 0; q < 4; ++q) { const int mm = m + q * NGW; if (mm < TOK) {
                float s = 0.f; unsigned long long* o8 = (unsigned long long*)(HB + (size_t)mm * DMODEL) + lane;
#pragma unroll
                for (int j = 0; j < 4; ++j) { const f32x4 w = v[q][j]; s += (w.x * w.x + w.y * w.y) + (w.z * w.z + w.w * w.w);
                    o8[64 * j] = (unsigned long long)pk2(w.x, w.y) | ((unsigned long long)pk2(w.z, w.w) << 32); }
                s = wave_sum(s);
                if (lane < 16) SSQA[(size_t)mm * 16 + lane] = (lane == 0) ? s : 0.f; } }
          } }
        { const float* p_in = IN_F(1); bf16* PB = WSP(bf16, WS_PB);
          for (int i = gt; i < TOK * PLE / 4; i += 4 * NGT) { f32x4 v[4];
#pragma unroll
            for (int q = 0; q < 4; ++q) v[q] = ((const f32x4*)p_in)[(i + q * NGT < TOK * PLE / 4) ? i + q * NGT : i];
#pragma unroll
            for (int q = 0; q < 4; ++q) if (i + q * NGT < TOK * PLE / 4) ((unsigned long long*)PB)[i + q * NGT] = (unsigned long long)pk2(v[q].x, v[q].y) | ((unsigned long long)pk2(v[q].z, v[q].w) << 32); } }
        { const int* positions = (const int*)A_->in[2]; f32x2* ROPE = WSP(f32x2, WS_ROPE);
          for (int i = gt; i < TOK * 8; i += NGT) {
            const int row = i >> 3, j = i & 7;
            const float invf = (j == 0) ? 1.0f : (j == 1) ? 0.1939227432012558f : (j == 2) ? 0.03760603070259094f : (j == 3) ? 0.007292664609849453f : (j == 4) ? 0.0014142135623842478f :
                               (j == 5) ? 0.00027424818836152554f : (j == 6) ? 5.3182957344688475e-05f : 1.0313385246263351e-05f;
            const float ang = (float)positions[row] * invf;
            float sn, cs; sincos_d((double)ang, sn, cs);
            ROPE[i] = (f32x2){cs, sn};
          } }
    }
    SEAM(0);
    if (IN(1)) {
        { PH_LOCALS
          pg8::Gemm g{WSP(bf16, WS_HB), WSP(bf16, WS_W_EVIN), TOK, EV_N, 1024}; pg8::StaticOrder S; S.init(TOK, EV_N, G, bx);
          pg8::EpiEvenIn E{WSP(float, WS_SSQA), WSP(bf16, WS_ZH), WSP(const pg8::f32x2, WS_ROPE)};
          pg8::gemm_phase<pg8::EpiEvenIn, pg8::StaticOrder, true, true>(L, g, S, E, wave_s); }
        if (gridDim.x == 256 && blockIdx.x >= 128) {
            PH_LOCALS
            LAS float* scr = (LAS float*)(L + wave * 16384);
            const float* norm_mix = IN_F(3); const float* norm_ffn = IN_F(4); const float* norm_ple = IN_F(5);
            const float* ffn_w_in = IN_F(6); const float* ffn_w_out = IN_F(9); const float* ple_w_proj = IN_F(10); const float* ple_w_gate = IN_F(11);
            const float* od_w_in = IN_F(17); const float* od_w_out = IN_F(18);
#define TJ(Wp, RS, WTp, K_, NOLD, NNEW, LDK, KOFF, TYPE) { constexpr int NI_ = ((K_) / 64) * ((NNEW) / 32); if (r < NI_) { const TJob J{(Wp), (RS), (WTp), (K_), (NOLD), (NNEW), (LDK), (KOFF), (TYPE), NI_}; transpose_item(J, scr, r, lane); continue; } r -= NI_; }
            constexpr int NITEMS_B = (16 * 176 + 44 * 32 + 16 * 32 + 4 * 32) + 16 * 88 + 16 * 32;
            const int gwb = (vcu_of(bx - 128, 128)) * NWAVES + wave, NGWB = 128 * NWAVES;
            for (int it = gwb; it < NITEMS_B; it += NGWB) {
                int r = it;
                TJ(ffn_w_in, norm_ffn, WSP(bf16, WS_W_FFI0), 1024, NFF2, NFF2, 1024, 0, 3)
                TJ(ffn_w_out, nullptr, WSP(bf16, WS_W_FFO0), DFF, 1024, 1024, DFF, 0, 0)
                TJ(ple_w_gate, norm_ple, WSP(bf16, WS_W_PG0), 1024, 1024, 1024, 1024, 0, 0)
                TJ(ple_w_proj, nullptr, WSP(bf16, WS_W_PP0), 256, 1024, 1024, 256, 0, 0)
                TJ(od_w_in, norm_mix + 1024, WSP(bf16, WS_W_ODIN), 1024, 2568, OD_N, 1024, 0, 2)
                TJ(od_w_out, nullptr, WSP(bf16, WS_W_OUT1), 1024, 1024, 1024, 1024, 0, 0)
            }
#undef TJ
        {
            const float* pool_w = IN_F(15); const float* pool_scale = IN_F(16); const float* ev_w_out = IN_F(14); bf16* W_OUT0 = WSP(bf16, WS_W_OUT0);
            for (int it = gwb; it < 1024; it += NGWB) {
                const int g = it >> 8, nb = (it >> 4) & 15, cb = it & 15, n = 64 * nb + lane;
                float acc[8];
#pragma unroll
                for (int cc = 0; cc < 8; ++cc) acc[cc] = 0.f;
#pragma unroll 1
                for (int d0 = 0; d0 < 128; d0 += 16) {
                    float wv[16];
#pragma unroll
                    for (int e = 0; e < 16; ++e) wv[e] = ev_w_out[(size_t)(128 * g + d0 + e) * 1024 + n] * pool_scale[128 * g + d0 + e];
#pragma unroll
                    for (int cc = 0; cc < 8; ++cc) {
                        const float* pw = pool_w + ((size_t)g * 128 + 8 * cb + cc) * 128 + d0;
#pragma unroll
                        for (int e = 0; e < 16; ++e) acc[cc] += pw[e] * wv[e];
                    }
                }
#pragma unroll
                for (int c2 = 0; c2 < 4; ++c2) *(unsigned*)(W_OUT0 + (size_t)n * 1024 + 128 * g + 8 * cb + 2 * c2) = pk2(acc[2 * c2], acc[2 * c2 + 1]);
            }
        }
        }
    }
    SEAM(1);
    if (IN(2)) {
        { PH_LOCALS
          const bf16* ZH = WSP(bf16, WS_ZH); bf16* Y = WSP(bf16, WS_Y); const unsigned lds0 = (unsigned)(uintptr_t)lds;
          for (int pi = vcu; pi < 256; pi += G) {
            const int b = pi >> 5, s = pi & 31;
#pragma unroll 1
            for (int k = 0; k < 2 * DBG_REP_DSA; ++k) mix::dsa_unit(b, (k & 1) ? s : 63 - s, ZH, Y, (char*)lds, lds0, wave_s);
          } }
        { PH_LOCALS
          const bf16* ZH = WSP(bf16, WS_ZH); bf16* Y = WSP(bf16, WS_Y);
          for (int rep_ = 0; rep_ < DBG_REP_POOL; ++rep_) for (int it = gt; it < TOK * 64; it += NGT) mix::pool_item(it, ZH, Y);
        }
    }
    SEAM(2);
    {
        const size_t s1o = (0 == 0) ? WS_SSQA : WS_SSQB, s2o = (0 == 0) ? WS_SSQB : WS_SSQA, s3o = s1o;
        if (IN(3)) {
            PH_LOCALS
            pg8::Gemm g{WSP(bf16, WS_Y), WSP(bf16, (0 == 0) ? WS_W_OUT0 : WS_W_OUT1), TOK, 1024, 1024}; pg8::StaticOrder S; S.init(TOK, 1024, G, bx);
            pg8::EpiRes E{IN_F(0), nullptr, WSP(bf16, WS_HB), WSP(float, s1o), WSP(bf16, WS_AHALO)};
            pg8::gemm_phase<pg8::EpiRes, pg8::StaticOrder, true, true>(L, g, S, E, wave_s);
        }
        SEAM(3);
        if (IN(3 + 2)) {
            PH_LOCALS
            pg8::Gemm g{WSP(bf16, WS_HB), WSP(bf16, WS_W_FFI0), TOK + 256, NFF2, 1024}; pg8::StaticOrder S; S.init(TOK, NFF2, G, bx);
            if (G == 256 && bx >= 128 && bx < 128 + NFF2 / 256) {
                pg8::OneUnit S1{64, bx - 128, 1};
                pg8::EpiHaloF EH{WSP(float, s1o), WSP(float, WS_AH), (unsigned*)(ws + WS_CTL) + CW_FLAG + 2048 * 0};
                pg8::gemm_phase<pg8::EpiHaloF, pg8::OneUnit, true, true>(L, g, S1, EH, wave_s);
            }
            pg8::EpiFfnIn E{WSP(float, s1o), IN_F(7) + (size_t)0 * 3 * NFF2, IN_F(8) + (size_t)0 * NFF2, WSP(float, WS_AH), WSP(bf16, WS_ZH), (LAS float*)(L + XB_OFF), (unsigned*)(ws + WS_CTL) + CW_FLAG + 2048 * 0, 1u};
            pg8::gemm_phase<pg8::EpiFfnIn, pg8::StaticOrder, true, true>(L, g, S, E, wave_s);
            if (G == 256 && bx >= 150) {
                pg8::Gemm gp{WSP(bf16, WS_PB), WSP(bf16, WS_W_PP0), TOK, 1024, PLE}; pg8::StaticOrder SP; SP.init(TOK, 1024, 106, bx - 150);
                pg8::EpiBf16Plain EP{WSP(bf16, WS_PP), 1024};
                pg8::gemm_phase<pg8::EpiBf16Plain, pg8::StaticOrder, true, true>(L, gp, SP, EP, wave_s);
            }
        }
        SEAM(3 + 2);
        if (IN(3 + 3)) {
            PH_LOCALS
            pg8::Gemm g{WSP(bf16, WS_ZH), WSP(bf16, (0 == 0) ? WS_W_FFO0 : WS_W_FFO1), TOK, 1024, DFF}; pg8::StaticOrder S; S.init(TOK, 1024, G, bx);
            pg8::EpiRes E{nullptr, WSP(bf16, WS_HB), WSP(bf16, WS_HB), WSP(float, s2o), nullptr};
            pg8::gemm_phase<pg8::EpiRes, pg8::StaticOrder, true, true>(L, g, S, E, wave_s);
        }
        SEAM(3 + 3);
        if (IN(3 + 4)) {
            PH_LOCALS
            pg8::Gemm g{WSP(bf16, WS_HB), WSP(bf16, (0 == 0) ? WS_W_PG0 : WS_W_PG1), TOK, 1024, 1024}; pg8::StaticOrder S; S.init(TOK, 1024, G, bx);
            pg8::EpiGate E{WSP(float, s2o), WSP(bf16, WS_HB), WSP(bf16, WS_PP), (bf16*)out, WSP(float, s3o)};
            pg8::gemm_phase<pg8::EpiGate, pg8::StaticOrder, true, true>(L, g, S, E, wave_s);
        }
        SEAM(3 + 4);
    }
    {

            if (IN(8)) {
                { PH_LOCALS
                  pg8::Gemm g{(const bf16*)out, WSP(bf16, WS_W_ODIN), TOK, OD_N, 1024}; pg8::StaticOrder S; S.init(TOK, OD_N, G, bx);
                  pg8::EpiOddIn E{WSP(float, WS_SSQA), WSP(bf16, WS_ZH), WSP(float, WS_FBUF), WSP(float, WS_SST)};
                  pg8::gemm_phase<pg8::EpiOddIn, pg8::StaticOrder, true, true>(L, g, S, E, wave_s); }
                if (gridDim.x == 256 && blockIdx.x >= 192) {
                    PH_LOCALS
                    LAS float* scr = (LAS float*)(L + wave * 16384);
                    const float* norm_ffn = IN_F(4); const float* norm_ple = IN_F(5); const float* ffn_w_in = IN_F(6); const float* ple_w_gate = IN_F(11);
#define TJ(Wp, RS, WTp, K_, NOLD, NNEW, LDK, KOFF, TYPE) { constexpr int NI_ = ((K_) / 64) * ((NNEW) / 32); if (r < NI_) { const TJob J{(Wp), (RS), (WTp), (K_), (NOLD), (NNEW), (LDK), (KOFF), (TYPE), NI_}; transpose_item(J, scr, r, lane); continue; } r -= NI_; }
                    constexpr int NITEMS_C = 16 * 176 + 16 * 32;
                    const int gwc = (bx - 192) * NWAVES + wave, NGWC = 64 * NWAVES;
                    for (int it = gwc; it < NITEMS_C; it += NGWC) {
                        int r = it;
                        TJ(ffn_w_in + (size_t)1024 * NFF2, norm_ffn + 1024, WSP(bf16, WS_W_FFI1), 1024, NFF2, NFF2, 1024, 0, 3)
                        TJ(ple_w_gate + (size_t)1024 * 1024, norm_ple + 1024, WSP(bf16, WS_W_PG1), 1024, 1024, 1024, 1024, 0, 0)
                    }
#undef TJ
                }
            }
            SEAM(8);
            if (IN(9)) {
                { PH_LOCALS
                  const bf16* ZH = WSP(bf16, WS_ZH); bf16* Y = WSP(bf16, WS_Y); const unsigned lds0 = (unsigned)(uintptr_t)lds;
                  const float* FBUF = WSP(float, WS_FBUF); const float* fox_b_f = IN_F(19);
                  for (int pi = vcu; pi < 256; pi += G) {
                    const int bh = pi >> 2, s = pi & 3;
#pragma unroll 1
                    for (int k = 0; k < 2 * DBG_REP_FOX; ++k) mix::fox_unit2(bh >> 3, bh & 7, (k & 1) ? s : 7 - s, ZH, FBUF, fox_b_f, Y, (char*)lds, wave_s);
                  } }
                { PH_LOCALS
                  const bf16* ZH = WSP(bf16, WS_ZH); bf16* Y = WSP(bf16, WS_Y);
                  for (int rep_ = 0; rep_ < DBG_REP_SGU; ++rep_) for (int u = vcu; u < 512; u += G) mix::sgu_unit(u >> 6, (u >> 2) & 15, u & 3, ZH, WSP(float, WS_SST), IN_F(20), IN_F(21), WSP(bf16, WS_W_SGU), IN_F(23), Y, (char*)lds, wave_s); }
            }
            if (IN(9)) { PH_LOCALS
                  const float* p1 = IN_F(1) + (size_t)TOK * PLE; bf16* PB = WSP(bf16, WS_PB);
                  for (int i = gt; i < TOK * PLE / 4; i += NGT) { const f32x4 v = ((const f32x4*)p1)[i]; ((unsigned long long*)PB)[i] = (unsigned long long)pk2(v.x, v.y) | ((unsigned long long)pk2(v.z, v.w) << 32); } }
            SEAM(9);
            }
    {
        const size_t s1o = (1 == 0) ? WS_SSQA : WS_SSQB, s2o = (1 == 0) ? WS_SSQB : WS_SSQA, s3o = s1o;
        if (IN(10)) {
            PH_LOCALS
            pg8::Gemm g{WSP(bf16, WS_Y), WSP(bf16, (1 == 0) ? WS_W_OUT0 : WS_W_OUT1), TOK, 1024, 1024}; pg8::StaticOrder S; S.init(TOK, 1024, G, bx);
            pg8::EpiRes E{nullptr, (const bf16*)out, WSP(bf16, WS_HB), WSP(float, s1o), WSP(bf16, WS_AHALO)};
            pg8::gemm_phase<pg8::EpiRes, pg8::StaticOrder, true, true>(L, g, S, E, wave_s);
        }
        SEAM(10);
        if (IN(10 + 2)) {
            PH_LOCALS
            pg8::Gemm g{WSP(bf16, WS_HB), WSP(bf16, WS_W_FFI1), TOK + 256, NFF2, 1024}; pg8::StaticOrder S; S.init(TOK, NFF2, G, bx);
            if (G == 256 && bx >= 128 && bx < 128 + NFF2 / 256) {
                pg8::OneUnit S1{64, bx - 128, 1};
                pg8::EpiHaloF EH{WSP(float, s1o), WSP(float, WS_AH), (unsigned*)(ws + WS_CTL) + CW_FLAG + 2048 * 1};
                pg8::gemm_phase<pg8::EpiHaloF, pg8::OneUnit, true, true>(L, g, S1, EH, wave_s);
            }
            pg8::EpiFfnIn E{WSP(float, s1o), IN_F(7) + (size_t)1 * 3 * NFF2, IN_F(8) + (size_t)1 * NFF2, WSP(float, WS_AH), WSP(bf16, WS_ZH), (LAS float*)(L + XB_OFF), (unsigned*)(ws + WS_CTL) + CW_FLAG + 2048 * 1, 2u};
            pg8::gemm_phase<pg8::EpiFfnIn, pg8::StaticOrder, true, true>(L, g, S, E, wave_s);
            if (G == 256 && bx >= 150) {
                pg8::Gemm gp{WSP(bf16, WS_PB), WSP(bf16, WS_W_PP1), TOK, 1024, PLE}; pg8::StaticOrder SP; SP.init(TOK, 1024, 106, bx - 150);
                pg8::EpiBf16Plain EP{WSP(bf16, WS_PP), 1024};
                pg8::gemm_phase<pg8::EpiBf16Plain, pg8::StaticOrder, true, true>(L, gp, SP, EP, wave_s);
            }
        }
        SEAM(10 + 2);
        if (IN(10 + 3)) {
            PH_LOCALS
            pg8::Gemm g{WSP(bf16, WS_ZH), WSP(bf16, (1 == 0) ? WS_W_FFO0 : WS_W_FFO1), TOK, 1024, DFF}; pg8::StaticOrder S; S.init(TOK, 1024, G, bx);
            pg8::EpiRes E{nullptr, WSP(bf16, WS_HB), WSP(bf16, WS_HB), WSP(float, s2o), nullptr};
            pg8::gemm_phase<pg8::EpiRes, pg8::StaticOrder, true, true>(L, g, S, E, wave_s);
        }
        SEAM(10 + 3);
        if (IN(10 + 4)) {
            PH_LOCALS
            pg8::Gemm g{WSP(bf16, WS_HB), WSP(bf16, (1 == 0) ? WS_W_PG0 : WS_W_PG1), TOK, 1024, 1024}; pg8::StaticOrder S; S.init(TOK, 1024, G, bx);
            pg8::EpiGate E{WSP(float, s2o), WSP(bf16, WS_HB), WSP(bf16, WS_PP), WSP(bf16, WS_Y), WSP(float, s3o)};
            pg8::gemm_phase<pg8::EpiGate, pg8::StaticOrder, true, true>(L, g, S, E, wave_s);
        }
        SEAM(10 + 4);
    }
    if (IN(15)) {
        PH_LOCALS
        const float* SSQB = WSP(float, WS_SSQB); const float* norm_final = IN_F(12); const bf16* H6 = WSP(bf16, WS_Y);
        for (int m = gw; m < TOK; m += 4 * NGW) {
            unsigned long long w[4][4]; float rs[4];
#pragma unroll
            for (int q = 0; q < 4; ++q) { const int mm = (m + q * NGW < TOK) ? m + q * NGW : m; rs[q] = pg8::row_rstd(SSQB, mm);
                const unsigned long long* hr = (const unsigned long long*)(H6 + (size_t)mm * DMODEL) + lane;
#pragma unroll
                for (int j = 0; j < 4; ++j) w[q][j] = hr[64 * j]; }
            const f32x4* gr = (const f32x4*)norm_final + lane;
            f32x4 gg[4];
#pragma unroll
            for (int j = 0; j < 4; ++j) gg[j] = gr[64 * j];
#pragma unroll
            for (int q = 0; q < 4; ++q) { const int mm = m + q * NGW; if (mm < TOK) { f32x4* xr = (f32x4*)(out + (size_t)mm * DMODEL) + lane;
#pragma unroll
                for (int j = 0; j < 4; ++j) { const unsigned long long ww = w[q][j];
                    const f32x4 v = {pg8::bf_lo((unsigned)ww), pg8::bf_hi((unsigned)ww), pg8::bf_lo((unsigned)(ww >> 32)), pg8::bf_hi((unsigned)(ww >> 32))};
                    xr[64 * j] = v * rs[q] * gg[j]; } } }
        }
    }
#undef IN
#undef SEAM
}

#ifndef MK_N_LAUNCHES
#define MK_N_LAUNCHES 1
#endif
constexpr int N_PHASES = 16;
extern "C" void kernel_launch(void* const* d_in, const int* in_sizes, int n_in, void* d_out, int out_size, void* d_ws, size_t ws_size, hipStream_t stream) {
    static int grid = 0;
    if (grid == 0) {
        if (n_in != 24 || out_size != TOK * DMODEL || ws_size < WS_END) { fprintf(stderr, "kernel_launch: unexpected shapes (n_in %d, out %d, ws %zu)\n", n_in, out_size, ws_size); grid = -1; return; }
        int dev = 0, cus = 0;
        if (hipGetDevice(&dev) != hipSuccess || hipDeviceGetAttribute(&cus, hipDeviceAttributeMultiprocessorCount, dev) != hipSuccess) { grid = -1; return; }
        if (hipFuncSetAttribute((const void*)mega_fwd, hipFuncAttributeMaxDynamicSharedMemorySize, LDS_BYTES) != hipSuccess) { fprintf(stderr, "kernel_launch: hipFuncSetAttribute failed\n"); grid = -1; return; }
        int per_cu = 0;
        if (hipOccupancyMaxActiveBlocksPerMultiprocessor(&per_cu, (const void*)mega_fwd, NWAVES * 64, LDS_BYTES) != hipSuccess || per_cu < 1) { fprintf(stderr, "kernel_launch: occupancy query says %d\n", per_cu); }
        (void)hipGetLastError();
        grid = cus;
    }
    if (grid < 0) return;
    (void)hipMemsetAsync((char*)d_ws + WS_CTL, 0, CTL_ZERO_BYTES, stream);
    Args a{};
    for (int i = 0; i < 24; ++i) a.in[i] = d_in[i];
    a.out = (float*)d_out; a.ws = (unsigned char*)d_ws;
#ifdef DBG_CHECK
    {
        using namespace dbg;
        auto LP = [&](int ph) { a.ph_lo = ph; a.ph_hi = ph + 1; hipLaunchKernelGGL(mega_fwd, dim3(grid), dim3(NWAVES * 64), LDS_BYTES, stream, a); };
        char* wsb = (char*)d_ws; float* ERR = (float*)(wsb + 512 * 1024); float* SNAP = (float*)(wsb + 600 * 1024); float* outp = (float*)d_out;
        const unsigned short* ZHp = (const unsigned short*)(wsb + WS_ZH); const unsigned short* Yp = (const unsigned short*)(wsb + WS_Y); const float* FB = (const float*)(wsb + WS_FBUF);
        const unsigned short* HBp = (const unsigned short*)(wsb + WS_HB); const unsigned short* H3p = (const unsigned short*)d_out;
        auto F = [&](int i) { return (const float*)d_in[i]; };
        const float* x = F(0);
        LP(0); LP(1);
        k_evenin<<<NS, 256, 0, stream>>>(x, F(3), F(13), (const int*)d_in[2], ZHp, ERR, 0);
        LP(2);
        k_pool<<<NS, 256, 0, stream>>>(ZHp, Yp, ERR, 1);
        k_dsa<<<NS, 256, 0, stream>>>(ZHp, Yp, ERR, 2);
        LP(3);
        k_outproj<<<NS, 256, 0, stream>>>(x, 0, SNAP, Yp, F(14), F(15), F(16), HBp, ERR, 3);
        for (int layer = 0; layer < 2; ++layer) {
            const int pb = layer ? 10 : 3, kb = layer ? 10 : 3;
            if (layer == 1) {
                LP(8);
                k_oddin<<<NS, 256, 0, stream>>>(H3p, F(3) + 1024, F(17), ZHp, FB, ERR, 7);
                LP(9);
                k_fox<<<NS, 256, 0, stream>>>(ZHp, FB, F(19), Yp, ERR, 8);
                k_sgu<<<NS, 256, 0, stream>>>(ZHp, F(20), F(21), F(22), F(23), Yp, ERR, 9);
                k_snap<<<NS, 256, 0, stream>>>(H3p, SNAP);
                LP(10);
                k_outproj<<<NS, 256, 0, stream>>>(nullptr, 1, SNAP, Yp, F(18), nullptr, nullptr, HBp, ERR, 10);
            }
            LP(pb + 1); LP(pb + 2);
            k_ffnin<<<NS, 256, 0, stream>>>(HBp, F(4) + 1024 * layer, F(6) + (size_t)layer * 1024 * NFF2, F(7) + (size_t)layer * 3 * NFF2, F(8) + (size_t)layer * NFF2, ZHp, ERR, kb + 1);
            k_snap<<<NS, 256, 0, stream>>>(HBp, SNAP);
            LP(pb + 3);
            k_ffnout<<<NS, 256, 0, stream>>>(SNAP, ZHp, F(9) + (size_t)layer * DFF * 1024, HBp, ERR, kb + 2);
            k_snap<<<NS, 256, 0, stream>>>(HBp, SNAP);
            LP(pb + 4);
            k_ple<<<NS, 256, 0, stream>>>(SNAP, F(1) + (size_t)layer * TOK * PLE, F(5) + 1024 * layer, F(10) + (size_t)layer * PLE * 1024, F(11) + (size_t)layer * 1024 * 1024, layer ? Yp : H3p, ERR, kb + 3);
        }
        k_snap<<<NS, 256, 0, stream>>>(Yp, SNAP);
        LP(15);
        k_final<<<NS, 256, 0, stream>>>(SNAP, F(12), outp, ERR, 14);
        t_dpp<<<1, 64, 0, stream>>>(ERR + 40);
        k_report<<<1024, 256, 0, stream>>>(ERR, 15, DBG_TOL, outp);
        return;
    }
#endif
    if (MK_N_LAUNCHES == 1) {
        a.ph_lo = 0; a.ph_hi = N_PHASES;
        hipLaunchKernelGGL(mega_fwd, dim3(grid), dim3(NWAVES * 64), LDS_BYTES, stream, a);
    } else {
#ifndef DBG_STOP
#define DBG_STOP N_PHASES
#endif
#ifndef DBG_DOUBLE
#define DBG_DOUBLE -1
#endif
        for (int ph = 0; ph < DBG_STOP; ++ph) { a.ph_lo = ph; a.ph_hi = ph + 1; const int reps = (ph == DBG_DOUBLE || (DBG_DOUBLE == 100 && (ph == 0 || ph == 1 || ph == 2 || ph == 4 || ph == 5 || ph == 8 || ph == 9 || ph == 11 || ph == 12))) ? 2 : 1;
            for (int r = 0; r < reps; ++r) hipLaunchKernelGGL(mega_fwd, dim3(grid), dim3(NWAVES * 64), LDS_BYTES, stream, a); }
    }
}
```

```cpp
#include <hip/hip_runtime.h>
#include <hip/hip_bf16.h>
#include <cstdio>
#include <cstdint>
#include <cmath>
constexpr int TOK = 16384, DMODEL = 1024, SEQ = 2048, NBATCH = 8;
constexpr int DFF = 2816, NFF2 = 5632, PLE = 256;
constexpr int EV_N = 1536;
constexpr int OD_N = 2816;
constexpr int Z1P = 2560;
constexpr float RMS_EPS = 1e-6f;
constexpr float C2 = 0.125f * 1.4426950408889634f;


__device__ __forceinline__ int lane_opaque() { unsigned z = 0u; asm volatile("" : "+v"(z)); return (int)__builtin_amdgcn_mbcnt_hi(~0u, __builtin_amdgcn_mbcnt_lo(~0u, z)); }
__device__ __forceinline__ float xor16_f(float v) { return __builtin_bit_cast(float, __builtin_amdgcn_ds_swizzle(__builtin_bit_cast(int, v), 0x401F)); }
__device__ __forceinline__ void halves_pair(unsigned v, unsigned& a, unsigned& b) { unsigned w = v; asm volatile("" : "+v"(w)); auto rr = __builtin_amdgcn_permlane32_swap(v, w, false, false); a = rr[0]; b = rr[1]; }
__device__ __forceinline__ float halves_sum_f(float v) { unsigned a, b; halves_pair(__builtin_bit_cast(unsigned, v), a, b); return __builtin_bit_cast(float, a) + __builtin_bit_cast(float, b); }
__device__ __forceinline__ float halves_max_f(float v) { unsigned a, b; halves_pair(__builtin_bit_cast(unsigned, v), a, b); return __builtin_fmaxf(__builtin_bit_cast(float, a), __builtin_bit_cast(float, b)); }
__device__ __forceinline__ unsigned halves_add_u(unsigned v) { unsigned a, b; halves_pair(v, a, b); return a + b; }
__device__ __forceinline__ unsigned halves_or_u(unsigned v) { unsigned a, b; halves_pair(v, a, b); return a | b; }
namespace pg8 {
#define PG8_LAS __attribute__((address_space(3)))
typedef unsigned short bf16_t;
typedef short bf16x8 __attribute__((ext_vector_type(8)));
typedef float f32x4 __attribute__((ext_vector_type(4)));
typedef unsigned u32x4 __attribute__((ext_vector_type(4)));
constexpr int BM = 256, BK = 64, HALF = 128, HTB = HALF * BK * 2  , STAGE_BYTES = 8 * HTB, NXCD = 8, WGM = 8;

__host__ __device__ __forceinline__ int lds_byte(int r, int c) { const int st = (r >> 4) * 2 + (c >> 5), rr = r & 15, cc = c & 31, ob = rr * 64 + cc * 2; return st * 1024 + (ob ^ (((ob >> 9) & 1) << 5)); }
__host__ __device__ __forceinline__ void stage_rc(int b, int& R, int& C) { const int st = b / 1024, sb = b % 1024, swz = sb ^ (((sb >> 9) & 1) << 5); R = (st >> 1) * 16 + swz / 64; C = (st & 1) * 32 + (swz % 64) / 2; }
__host__ __device__ __forceinline__ int perm32(int rho) { const int n = rho >> 4, i = rho & 15; return 8 * (i >> 2) + 4 * n + (i & 3); }

struct Unit { int pm, pn; };
struct Gemm { const bf16_t* A; const bf16_t* Bt; int M, N, K; };

struct StaticOrder {
    int nM, nN, nwg, G, c;
    __host__ __device__ void init(int M, int N, int G_, int c_) { nM = M / BM; nN = N / BM; nwg = nM * nN; G = G_; c = c_; }
    __host__ __device__ bool next(int i, Unit& u) const {
        const long L = (long)i * G + c; if (L >= nwg) return false;
        int wgid = (int)L; { const int q = nwg / NXCD, r = nwg % NXCD, xcd = wgid % NXCD, off = wgid / NXCD; wgid = (xcd < r ? xcd * (q + 1) : r * (q + 1) + (xcd - r) * q) + off; }
        const int nig = WGM * nN, gid = wgid / nig, fm = gid * WGM, gsz = (nM - fm) < WGM ? (nM - fm) : WGM;
        u.pm = fm + ((wgid % nig) % gsz); u.pn = (wgid % nig) / gsz; return true;
    }
    __device__ __forceinline__ void a_ready(const Unit&) const {}
    __device__ __forceinline__ void done(const Unit&) const {}
};

struct OneUnit {
    int pm, pn, on;
    __host__ __device__ bool next(int i, Unit& u) const { if (!on || i != 0) return false; u.pm = pm; u.pn = pn; return true; }
    __device__ __forceinline__ void a_ready(const Unit&) const {}
    __device__ __forceinline__ void done(const Unit&) const {}
};
struct FfnOrder {
    StaticOrder S0; int extra;
    __host__ __device__ void init(int M, int N, int G_, int c_) { S0.init(M, N, G_, c_); extra = (G_ == 256 && c_ >= 128 && c_ < 128 + N / BM) ? 1 : 0; }
    __host__ __device__ bool next(int i, Unit& u) const { if (extra) { if (i == 0) { u.pm = 64; u.pn = S0.c - 128; return true; } return S0.next(i - 1, u); } return S0.next(i, u); }
    __device__ __forceinline__ void a_ready(const Unit&) const {}
    __device__ __forceinline__ void done(const Unit&) const {}
};
typedef float f32x2 __attribute__((ext_vector_type(2)));
typedef unsigned u32x2 __attribute__((ext_vector_type(2)));
__device__ __forceinline__ unsigned cvt_pk_bf16(float lo, float hi) { unsigned r; asm volatile("v_cvt_pk_bf16_f32 %0, %1, %2" : "=v"(r) : "v"(lo), "v"(hi)); return r; }
__device__ __forceinline__ float bf_lo(unsigned w) { return __builtin_bit_cast(float, w << 16); }
__device__ __forceinline__ float bf_hi(unsigned w) { return __builtin_bit_cast(float, w & 0xffff0000u); }
__device__ __forceinline__ float sq4(const f32x4 v) { return (v[0] * v[0] + v[1] * v[1]) + (v[2] * v[2] + v[3] * v[3]); }
__device__ __forceinline__ float row_rstd(const float* ssq, int row) {
    const f32x4* p = (const f32x4*)(ssq + (size_t)row * 16);
    const f32x4 a = p[0], b = p[1], c = p[2], d = p[3];
    const float s = (((a[0] + a[1]) + (a[2] + a[3])) + ((b[0] + b[1]) + (b[2] + b[3]))) + (((c[0] + c[1]) + (c[2] + c[3])) + ((d[0] + d[1]) + (d[2] + d[3])));
    return 1.0f / sqrtf(s * (1.0f / 1024.0f) + RMS_EPS);
}
__device__ __forceinline__ void ssq_write(float* ssq_out, float q, int row, int slot, int fq) {
    q += xor16_f(q); q = halves_sum_f(q);
    if (fq == 0) ssq_out[(size_t)row * 16 + slot] = q;
}
__device__ __forceinline__ float gelu_tanh(float x) {
    const float t = x + 0.044715f * x * x * x;
    const float e = __builtin_amdgcn_exp2f(-2.3022082f * t);
    return x * __builtin_amdgcn_rcpf(1.0f + e);
}
__device__ __forceinline__ float sigmoid_f(float x) { return __builtin_amdgcn_rcpf(1.0f + __builtin_amdgcn_exp2f(-1.4426950408889634f * x)); }


struct EpiRes {
    static constexpr bool PERM = true, AFTER_DRAIN = false;
    const float* basef; const bf16_t* baseb; bf16_t* hb; float* ssq_out; bf16_t* ahalo;
    __device__ __forceinline__ void operator()(const f32x4 (&acc)[2][2][4][2], const Unit& u_, int wr, int wc, int fr, int fq) const {
        Unit u; { int pm_ = u_.pm, pn_ = u_.pn; asm volatile("" : "+s"(pm_), "+s"(pn_)); u.pm = pm_; u.pn = pn_; }
        const int row0 = u.pm * BM + wr * 64 + fr, col0 = u.pn * BM + wc * 32 + 8 * fq;
        if (basef != nullptr) {
#pragma unroll
            for (int ai = 0; ai < 2; ++ai)
#pragma unroll
                for (int m = 0; m < 4; ++m) {
                    const int row = row0 + ai * HALF + m * 16; float q = 0.f;
#pragma unroll
                    for (int bj = 0; bj < 2; ++bj) {
                        const size_t off = (size_t)row * DMODEL + col0 + bj * HALF;
                        const f32x4 b0 = *(const f32x4*)(basef + off), b1 = *(const f32x4*)(basef + off + 4);
                        const f32x4 v0 = acc[ai][bj][m][0] + b0, v1 = acc[ai][bj][m][1] + b1;
                        q += sq4(v0) + sq4(v1);
                        u32x4 w; w.x = cvt_pk_bf16(v0[0], v0[1]); w.y = cvt_pk_bf16(v0[2], v0[3]); w.z = cvt_pk_bf16(v1[0], v1[1]); w.w = cvt_pk_bf16(v1[2], v1[3]);
                        *(u32x4*)(hb + off) = w;
                        if (ahalo != nullptr && ai == 1 && m == 3) {
                            const int rl = row & 255;
                            if (rl >= 254 && u.pm < 63) *(u32x4*)(ahalo + (size_t)(2 * (u.pm + 1) + (rl - 254)) * DMODEL + col0 + bj * HALF) = w;
                        }
                    }
                    ssq_write(ssq_out, q, row, u.pn * 4 + wc, fq);
                    if (m & 1) asm volatile("" ::: "memory");
                }
        } else {
#pragma unroll
            for (int ai = 0; ai < 2; ++ai) {
                u32x4 bw[4][2];
#pragma unroll
                for (int m = 0; m < 4; ++m)
#pragma unroll
                    for (int bj = 0; bj < 2; ++bj) bw[m][bj] = *(const u32x4*)(baseb + (size_t)(row0 + ai * HALF + m * 16) * DMODEL + col0 + bj * HALF);
                asm volatile("" ::: "memory");
#pragma unroll
                for (int m = 0; m < 4; ++m) {
                    const int row = row0 + ai * HALF + m * 16; float q = 0.f;
#pragma unroll
                    for (int bj = 0; bj < 2; ++bj) {
                        const size_t off = (size_t)row * DMODEL + col0 + bj * HALF;
                        const u32x4 pw = bw[m][bj];
                        const f32x4 b0 = {bf_lo(pw.x), bf_hi(pw.x), bf_lo(pw.y), bf_hi(pw.y)}, b1 = {bf_lo(pw.z), bf_hi(pw.z), bf_lo(pw.w), bf_hi(pw.w)};
                        const f32x4 v0 = acc[ai][bj][m][0] + b0, v1 = acc[ai][bj][m][1] + b1;
                        q += sq4(v0) + sq4(v1);
                        u32x4 w; w.x = cvt_pk_bf16(v0[0], v0[1]); w.y = cvt_pk_bf16(v0[2], v0[3]); w.z = cvt_pk_bf16(v1[0], v1[1]); w.w = cvt_pk_bf16(v1[2], v1[3]);
                        *(u32x4*)(hb + off) = w;
                        if (ahalo != nullptr && ai == 1 && m == 3) {
                            const int rl = row & 255;
                            if (rl >= 254 && u.pm < 63) *(u32x4*)(ahalo + (size_t)(2 * (u.pm + 1) + (rl - 254)) * DMODEL + col0 + bj * HALF) = w;
                        }
                    }
                    ssq_write(ssq_out, q, row, u.pn * 4 + wc, fq);
                }
                asm volatile("" ::: "memory");
            }
        }
    }
};
struct EpiGate {
    static constexpr bool PERM = true, AFTER_DRAIN = false;
    const float* ssq_in; const bf16_t* base; const bf16_t* pp; bf16_t* dst; float* ssq_out;
    __device__ __forceinline__ void operator()(const f32x4 (&acc)[2][2][4][2], const Unit& u_, int wr, int wc, int fr, int fq) const {
        Unit u; { int pm_ = u_.pm, pn_ = u_.pn; asm volatile("" : "+s"(pm_), "+s"(pn_)); u.pm = pm_; u.pn = pn_; }
        const int row0 = u.pm * BM + wr * 64 + fr, col0 = u.pn * BM + wc * 32 + 8 * fq;
#pragma unroll
        for (int ai = 0; ai < 2; ++ai)
#pragma unroll
            for (int mp = 0; mp < 2; ++mp) {
                u32x4 bw[2][2], pq[2][2]; float rs[2];
#pragma unroll
                for (int mi = 0; mi < 2; ++mi) {
                    const int row = row0 + ai * HALF + (2 * mp + mi) * 16;
#pragma unroll
                    for (int bj = 0; bj < 2; ++bj) { const size_t off = (size_t)row * DMODEL + col0 + bj * HALF; bw[mi][bj] = *(const u32x4*)(base + off); pq[mi][bj] = *(const u32x4*)(pp + off); }
                }
#pragma unroll
                for (int mi = 0; mi < 2; ++mi) rs[mi] = row_rstd(ssq_in, row0 + ai * HALF + (2 * mp + mi) * 16);
                asm volatile("" ::: "memory");
#pragma unroll
                for (int mi = 0; mi < 2; ++mi) {
                    const int m = 2 * mp + mi; const int row = row0 + ai * HALF + m * 16; float q = 0.f;
#pragma unroll
                    for (int bj = 0; bj < 2; ++bj) {
                        const size_t off = (size_t)row * DMODEL + col0 + bj * HALF;
                        const u32x4 b_ = bw[mi][bj], p_ = pq[mi][bj];
                        const float bb[8] = {bf_lo(b_.x), bf_hi(b_.x), bf_lo(b_.y), bf_hi(b_.y), bf_lo(b_.z), bf_hi(b_.z), bf_lo(b_.w), bf_hi(b_.w)};
                        const float pv[8] = {bf_lo(p_.x), bf_hi(p_.x), bf_lo(p_.y), bf_hi(p_.y), bf_lo(p_.z), bf_hi(p_.z), bf_lo(p_.w), bf_hi(p_.w)};
                        const f32x4 g0 = acc[ai][bj][m][0] * rs[mi], g1 = acc[ai][bj][m][1] * rs[mi];
                        const float gg[8] = {g0[0], g0[1], g0[2], g0[3], g1[0], g1[1], g1[2], g1[3]};
                        float v[8];
#pragma unroll
                        for (int i = 0; i < 8; ++i) { v[i] = bb[i] + pv[i] * sigmoid_f(gg[i]); q += v[i] * v[i]; }
                        u32x4 w; w.x = cvt_pk_bf16(v[0], v[1]); w.y = cvt_pk_bf16(v[2], v[3]); w.z = cvt_pk_bf16(v[4], v[5]); w.w = cvt_pk_bf16(v[6], v[7]);
                        *(u32x4*)(dst + off) = w;
                    }
                    ssq_write(ssq_out, q, row, u.pn * 4 + wc, fq);
                }
                asm volatile("" ::: "memory");
            }
    }
};
struct EpiBf16Plain {
    static constexpr bool PERM = true, AFTER_DRAIN = false;
    bf16_t* O; int ldc;
    __device__ __forceinline__ void operator()(const f32x4 (&acc)[2][2][4][2], const Unit& u_, int wr, int wc, int fr, int fq) const {
        Unit u; { int pm_ = u_.pm, pn_ = u_.pn; asm volatile("" : "+s"(pm_), "+s"(pn_)); u.pm = pm_; u.pn = pn_; }
        const int row0 = u.pm * BM + wr * 64 + fr, col0 = u.pn * BM + wc * 32 + 8 * fq;
#pragma unroll
        for (int ai = 0; ai < 2; ++ai)
#pragma unroll
            for (int m = 0; m < 4; ++m) {
                const int row = row0 + ai * HALF + m * 16;
#pragma unroll
                for (int bj = 0; bj < 2; ++bj) {
                    const f32x4 v0 = acc[ai][bj][m][0], v1 = acc[ai][bj][m][1];
                    u32x4 w; w.x = cvt_pk_bf16(v0[0], v0[1]); w.y = cvt_pk_bf16(v0[2], v0[3]); w.z = cvt_pk_bf16(v1[0], v1[1]); w.w = cvt_pk_bf16(v1[2], v1[3]);
                    *(u32x4*)(O + (size_t)row * ldc + col0 + bj * HALF) = w;
                }
            }
    }
};
struct EpiEvenIn {
    static constexpr bool PERM = true, AFTER_DRAIN = false;
    const float* ssq_in; bf16_t* Z; const f32x2* rope;
    __device__ __forceinline__ void operator()(const f32x4 (&acc)[2][2][4][2], const Unit& u_, int wr, int wc, int fr, int fq) const {
        Unit u; { int pm_ = u_.pm, pn_ = u_.pn; asm volatile("" : "+s"(pm_), "+s"(pn_)); u.pm = pm_; u.pn = pn_; }
        const int row0 = u.pm * BM + wr * 64 + fr, colw = wc * 32 + 8 * fq;
        const int pn = u.pn;
        const float sc = (pn == 2 || pn == 3) ? C2 : 1.0f;
#pragma unroll
        for (int ai = 0; ai < 2; ++ai)
#pragma unroll
            for (int m = 0; m < 4; ++m) {
                const int row = row0 + ai * HALF + m * 16;
                const float rs = row_rstd(ssq_in, row);
#pragma unroll
                for (int bj = 0; bj < 2; ++bj) {
                    const int gi = 2 * bj + (wc >> 1);
                    const bool ropeg = (pn == 2 || pn == 3 || pn == 5 || (pn == 4 && (gi == 0 || gi == 2))) && ((wc & 1) == 0);
                    f32x4 v0 = acc[ai][bj][m][0] * rs, v1 = acc[ai][bj][m][1] * rs;
                    if (ropeg && fq < 2) {
                        const f32x4* rp = (const f32x4*)(rope + (size_t)row * 8 + 4 * fq);
                        const f32x4 ra = rp[0], rb = rp[1];
                        f32x4 o0, o1;
                        o0[0] = v0[0] * ra[0] - v0[1] * ra[1]; o0[1] = v0[1] * ra[0] + v0[0] * ra[1];
                        o0[2] = v0[2] * ra[2] - v0[3] * ra[3]; o0[3] = v0[3] * ra[2] + v0[2] * ra[3];
                        o1[0] = v1[0] * rb[0] - v1[1] * rb[1]; o1[1] = v1[1] * rb[0] + v1[0] * rb[1];
                        o1[2] = v1[2] * rb[2] - v1[3] * rb[3]; o1[3] = v1[3] * rb[2] + v1[2] * rb[3];
                        v0 = o0; v1 = o1;
                    }
                    v0 = v0 * sc; v1 = v1 * sc;
                    u32x4 w; w.x = cvt_pk_bf16(v0[0], v0[1]); w.y = cvt_pk_bf16(v0[2], v0[3]); w.z = cvt_pk_bf16(v1[0], v1[1]); w.w = cvt_pk_bf16(v1[2], v1[3]);
                    *(u32x4*)(Z + (size_t)row * EV_N + pn * BM + bj * HALF + colw) = w;
                }
            }
    }
};
struct EpiOddIn {
    static constexpr bool PERM = true, AFTER_DRAIN = false;
    const float* ssq_in; bf16_t* Z; float* F; float* sst;
    __device__ __forceinline__ void operator()(const f32x4 (&acc)[2][2][4][2], const Unit& u_, int wr, int wc, int fr, int fq) const {
        Unit u; { int pm_ = u_.pm, pn_ = u_.pn; asm volatile("" : "+s"(pm_), "+s"(pn_)); u.pm = pm_; u.pn = pn_; }
        const int row0 = u.pm * BM + wr * 64 + fr, colw = wc * 32 + 8 * fq;
        const int pn = u.pn;
        const float sc = (pn < 2) ? C2 : 1.0f;
        const bool act = (pn >= 6 && pn < 10), stat = (pn == 8 || pn == 9);
#pragma unroll
        for (int ai = 0; ai < 2; ++ai)
#pragma unroll
            for (int m = 0; m < 4; ++m) {
                const int row = row0 + ai * HALF + m * 16;
                const float rs = row_rstd(ssq_in, row);
                if (pn == 10) {
                    if (wc == 0 && fq == 0) { *(f32x4*)(F + (size_t)row * 8) = acc[ai][0][m][0] * rs; *(f32x4*)(F + (size_t)row * 8 + 4) = acc[ai][0][m][1] * rs; }
                    continue;
                }
                float s1 = 0.f, s2 = 0.f;
#pragma unroll
                for (int bj = 0; bj < 2; ++bj) {
                    f32x4 v0 = acc[ai][bj][m][0] * (rs * sc), v1 = acc[ai][bj][m][1] * (rs * sc);
                    if (act) {
#pragma unroll
                        for (int i = 0; i < 4; ++i) { v0[i] = gelu_tanh(v0[i]); v1[i] = gelu_tanh(v1[i]); }
                    }
                    s1 += ((v0[0] + v0[1]) + (v0[2] + v0[3])) + ((v1[0] + v1[1]) + (v1[2] + v1[3])); s2 += sq4(v0) + sq4(v1);
                    u32x4 w; w.x = cvt_pk_bf16(v0[0], v0[1]); w.y = cvt_pk_bf16(v0[2], v0[3]); w.z = cvt_pk_bf16(v1[0], v1[1]); w.w = cvt_pk_bf16(v1[2], v1[3]);
                    *(u32x4*)(Z + (size_t)row * Z1P + pn * BM + bj * HALF + colw) = w;
                }
                if (stat) {
                    s1 += xor16_f(s1); s1 = halves_sum_f(s1); s2 += xor16_f(s2); s2 = halves_sum_f(s2);
                    if (fq == 0) *(f32x2*)(sst + ((size_t)row * 8 + (pn - 8) * 4 + wc) * 2) = (f32x2){s1, s2};
                }
            }
    }
};
struct EpiHalo {
    static constexpr bool PERM = true, AFTER_DRAIN = false;
    const float* ssq_in; float* AH;
    __device__ __forceinline__ void operator()(const f32x4 (&acc)[2][2][4][2], const Unit& u_, int wr, int wc, int fr, int fq) const {
        Unit u; { int pm_ = u_.pm, pn_ = u_.pn; asm volatile("" : "+s"(pm_), "+s"(pn_)); u.pm = pm_; u.pn = pn_; }
        const int col0 = u.pn * BM + wc * 32 + 8 * fq;
#pragma unroll
        for (int m = 0; m < 4; ++m) {
            const int rh = wr * 64 + m * 16 + fr;
            if (rh < 2) continue;
            const int tok = 256 * (rh >> 1) - 2 + (rh & 1);
            const float rs = row_rstd(ssq_in, tok);
#pragma unroll
            for (int bj = 0; bj < 2; ++bj) {
                *(f32x4*)(AH + (size_t)rh * NFF2 + col0 + bj * HALF) = acc[0][bj][m][0] * rs;
                *(f32x4*)(AH + (size_t)rh * NFF2 + col0 + bj * HALF + 4) = acc[0][bj][m][1] * rs;
            }
        }
    }
};
template <int SEL> __device__ __forceinline__ float dpp1(const float old, const float src) {
    const int o = __builtin_bit_cast(int, old), s = __builtin_bit_cast(int, src); int t;
    if (SEL == 0) t = __builtin_amdgcn_update_dpp(o, s, 0x111, 0xf, 0xf, false);
    else if (SEL == 1) t = __builtin_amdgcn_update_dpp(o, s, 0x112, 0xf, 0xf, false);
    else if (SEL == 2) t = __builtin_amdgcn_update_dpp(o, s, 0x10F, 0xf, 0xf, false);
    else t = __builtin_amdgcn_update_dpp(o, s, 0x10E, 0xf, 0xf, false);
    return __builtin_bit_cast(float, t);
}
template <int SEL> __device__ __forceinline__ f32x4 dpp4t(const f32x4 old, const f32x4 src) {
    const float o0 = old[0], o1 = old[1], o2 = old[2], o3 = old[3], s0 = src[0], s1 = src[1], s2 = src[2], s3 = src[3];
    const float r0 = dpp1<SEL>(o0, s0), r1 = dpp1<SEL>(o1, s1), r2 = dpp1<SEL>(o2, s2), r3 = dpp1<SEL>(o3, s3);
    return (f32x4){r0, r1, r2, r3};
}
#define dpp4(old, src, sel) dpp4t<sel>(old, src)
struct EpiHaloF {
    static constexpr bool PERM = true, AFTER_DRAIN = false;
    const float* ssq_in; float* ah; unsigned* flags;
    __device__ __forceinline__ void operator()(const f32x4 (&acc)[2][2][4][2], const Unit& u_, int wr, int wc, int fr, int fq) const {
        Unit u; { int pm_ = u_.pm, pn_ = u_.pn; asm volatile("" : "+s"(pm_), "+s"(pn_)); u.pm = pm_; u.pn = pn_; }
        const int col0 = u.pn * BM + wc * 32 + 8 * fq;
#pragma unroll
        for (int m = 0; m < 4; ++m) {
            const int rh = wr * 64 + m * 16 + fr;
            if (rh >= 2) {
                const int tok = 256 * (rh >> 1) - 2 + (rh & 1);
                const float rsh = row_rstd(ssq_in, tok);
#pragma unroll
                for (int bj = 0; bj < 2; ++bj) {
                    *(f32x4*)(ah + (size_t)rh * NFF2 + col0 + bj * HALF) = acc[0][bj][m][0] * rsh;
                    *(f32x4*)(ah + (size_t)rh * NFF2 + col0 + bj * HALF + 4) = acc[0][bj][m][1] * rsh;
                }
            }
        }
        asm volatile("s_waitcnt vmcnt(0)" ::: "memory"); __builtin_amdgcn_s_barrier(); asm volatile("" ::: "memory");
        if (wr == 0 && wc == 0 && fr == 0 && fq == 0) {
            __builtin_amdgcn_fence(__ATOMIC_RELEASE, "agent");
            asm volatile("s_waitcnt vmcnt(0)" ::: "memory");
            __hip_atomic_store(flags + 64 * u.pn, 1u, __ATOMIC_RELAXED, __HIP_MEMORY_SCOPE_AGENT);
        }
    }
};
struct EpiFfnIn {
    static constexpr bool PERM = true, AFTER_DRAIN = false;
    const float* ssq_in; const float* cw; const float* cb; float* ah; bf16_t* hid; PG8_LAS float* xb; unsigned* flags; unsigned phase_id;
    __device__ __forceinline__ void operator()(const f32x4 (&acc)[2][2][4][2], const Unit& u_, int wr, int wc, int fr, int fq) const {
        Unit u; { int pm_ = u_.pm, pn_ = u_.pn; asm volatile("" : "+s"(pm_), "+s"(pn_)); u.pm = pm_; u.pn = pn_; }
        PG8_LAS float* rtab = xb + 2048;
        const int row0 = u.pm * BM + wr * 64 + fr;
        if (wr == 0) rtab[wc * 64 + fq * 16 + fr] = row_rstd(ssq_in, u.pm * BM + wc * 64 + fq * 16 + fr);
        if (fr >= 14) {
#pragma unroll
            for (int ai = 0; ai < 2; ++ai) {
                PG8_LAS f32x4* dst = (PG8_LAS f32x4*)(xb + ((((ai * 2 + wr) * 4 + wc) * 2 + (fr - 14)) * 4 + fq) * 16);
#pragma unroll
                for (int bj = 0; bj < 2; ++bj)
#pragma unroll
                    for (int n = 0; n < 2; ++n) dst[bj * 2 + n] = acc[ai][bj][3][n];
            }
        }
        asm volatile("s_waitcnt lgkmcnt(0)" ::: "memory"); __builtin_amdgcn_s_barrier(); asm volatile("" ::: "memory");
        const bool has = (u.pm & 7) != 0;
        if (wr == 0) {
            PG8_LAS unsigned* stamp = (PG8_LAS unsigned*)(rtab + 256);
            if (*(volatile PG8_LAS unsigned*)stamp != phase_id) {
                if (wc == 0) {
                    unsigned sp = 0;
                    for (int t = 0; t < NFF2 / BM; ++t)
                        while (__hip_atomic_load(flags + 64 * t, __ATOMIC_RELAXED, __HIP_MEMORY_SCOPE_AGENT) == 0u) { __builtin_amdgcn_s_sleep(2); if (++sp > (1u << 22)) break; }
                    __builtin_amdgcn_fence(__ATOMIC_ACQUIRE, "agent");
                    asm volatile("s_waitcnt vmcnt(0)" ::: "memory");
                    if (fr == 0 && fq == 0) *(volatile PG8_LAS unsigned*)stamp = phase_id;
                } else {
                    unsigned sp = 0;
                    while (*(volatile PG8_LAS unsigned*)stamp != phase_id) { __builtin_amdgcn_s_sleep(2); if (++sp > (1u << 22)) break; }
                }
            }
        }
        float rs[2][4];
#pragma unroll
        for (int ai = 0; ai < 2; ++ai)
#pragma unroll
            for (int m = 0; m < 4; ++m) rs[ai][m] = rtab[ai * HALF + wr * 64 + m * 16 + fr];
        const f32x4 zero4 = {0.f, 0.f, 0.f, 0.f};
#pragma unroll
        for (int ai = 0; ai < 2; ++ai) {
#pragma unroll
            for (int n = 0; n < 2; ++n) {
                f32x4 cg[4];
#pragma unroll
                for (int bj = 0; bj < 2; ++bj) {
                    f32x4 b0, b1;
                    if (ai == 0 && wr == 0) {
                        const size_t c = (size_t)u.pn * BM + bj * HALF + wc * 32 + 8 * fq + 4 * n;
                        b0 = has ? *(const f32x4*)(ah + (size_t)(2 * u.pm) * NFF2 + c) : zero4;
                        b1 = has ? *(const f32x4*)(ah + (size_t)(2 * u.pm + 1) * NFF2 + c) : zero4;
                    } else {
                        const int sa = (wr == 1) ? ai : ai - 1, sw = (wr == 1) ? 0 : 1;
                        const float r0 = rtab[sa * HALF + sw * 64 + 62], r1 = rtab[sa * HALF + sw * 64 + 63];
                        b0 = *(const PG8_LAS f32x4*)(xb + ((((sa * 2 + sw) * 4 + wc) * 2 + 0) * 4 + fq) * 16 + (bj * 2 + n) * 4) * r0;
                        b1 = *(const PG8_LAS f32x4*)(xb + ((((sa * 2 + sw) * 4 + wc) * 2 + 1) * 4 + fq) * 16 + (bj * 2 + n) * 4) * r1;
                    }
                    const int oc = bj * DFF + 128 * u.pn + wc * 32 + 8 * fq + 4 * n;
                    const f32x4 w0 = *(const f32x4*)(cw + oc), w1 = *(const f32x4*)(cw + NFF2 + oc), w2 = *(const f32x4*)(cw + 2 * NFF2 + oc), bb = *(const f32x4*)(cb + oc);
                    f32x4 prev = zero4;
#pragma unroll
                    for (int m = 0; m < 4; ++m) {
                        const f32x4 cur = acc[ai][bj][m][n] * rs[ai][m];
                        f32x4 y1, y2;
                        if (m == 0) { y1 = b1; y2 = (fr == 0) ? b0 : b1; }
                        else { y1 = dpp4(zero4, prev, 2); y2 = dpp4(zero4, prev, 3); }
                        const f32x4 p1 = dpp4(y1, cur, 0), p2 = dpp4(y2, cur, 1);
                        const f32x4 c = w0 * p2 + w1 * p1 + w2 * cur + bb;
                        prev = cur;
                        if (bj == 0) cg[m] = c;
                        else {
                            const float h0 = gelu_tanh(cg[m].x) * c.x, h1 = gelu_tanh(cg[m].y) * c.y, h2 = gelu_tanh(cg[m].z) * c.z, h3 = gelu_tanh(cg[m].w) * c.w;
                            u32x2 w; w.x = cvt_pk_bf16(h0, h1); w.y = cvt_pk_bf16(h2, h3);
                            const int row = row0 + ai * HALF + m * 16;
                            *(u32x2*)(hid + (size_t)row * DFF + 128 * u.pn + wc * 32 + 8 * fq + 4 * n) = w;
                        }
                    }
                    asm volatile("" ::: "memory");
                }
            }
        }
    }
};
template <class Epi, class Sched, bool ALIGN_EPI = false, bool SP2 = false>
__device__ __forceinline__ void gemm_phase(PG8_LAS unsigned char* lds, const Gemm g, const Sched& S, const Epi& E, const int wave_s) {
    const int tid_ = wave_s * 64 + lane_opaque(); const int tid = tid_, wid = __builtin_amdgcn_readfirstlane(tid >> 6), lane = tid & 63, wr = wid >> 2, wc = wid & 3, fr = lane & 15, fq = lane >> 4;
    const int K = g.K, nt = K / BK;
    unsigned voffA[2], voffB[2];
#pragma unroll
    for (int i = 0; i < 2; ++i) { int R, C; stage_rc(tid * 16 + i * 8192, R, C); const int Rb = Epi::PERM ? ((R & ~31) + perm32(R & 31)) : R;
        voffA[i] = (unsigned)(R * K + C) * 2u; voffB[i] = (unsigned)(Rb * K + C) * 2u; }
    const size_t kstep = (size_t)(BK * 2);
    const size_t hstep = (size_t)HALF * K * 2;
    const size_t tstep = 2 * hstep;
    const unsigned ldsw = (unsigned)wid * 1024u;
    const int aoff = lds_byte(wr * 64 + fr, fq * 8), boff = lds_byte(wc * 32 + fr, fq * 8);
#define PG8_SA(b, h) (((b) * 2 + (h)) * HTB)
#define PG8_SB(b, h) ((4 + (b) * 2 + (h)) * HTB)
#define PG8_STAGE(bufoff, gbase, voff) do { _Pragma("unroll") for (int _i = 0; _i < 2; ++_i) \
        __builtin_amdgcn_global_load_lds((const unsigned*)((const char*)(gbase) + (voff)[_i]), (PG8_LAS unsigned*)(lds + (bufoff) + ldsw + _i * 8192), 16, 0, 0); } while (0)
#define PG8_LDA(dst, b, h) do { _Pragma("unroll") for (int m = 0; m < 4; ++m) _Pragma("unroll") for (int k = 0; k < 2; ++k) dst[m][k] = *(const PG8_LAS bf16x8*)(lds + PG8_SA(b, h) + aoff + m * 2048 + k * 1024); } while (0)
#define PG8_LDB(dst, b, h) do { _Pragma("unroll") for (int n = 0; n < 2; ++n) _Pragma("unroll") for (int k = 0; k < 2; ++k) dst[n][k] = *(const PG8_LAS bf16x8*)(lds + PG8_SB(b, h) + boff + n * 2048 + k * 1024); } while (0)
#define PG8_MMA(ai, bj, At, Bt) do { __builtin_amdgcn_s_setprio(1); _Pragma("unroll") for (int m = 0; m < 4; ++m) _Pragma("unroll") for (int n = 0; n < 2; ++n) _Pragma("unroll") for (int k = 0; k < 2; ++k) \
        acc[ai][bj][m][n] = __builtin_amdgcn_mfma_f32_16x16x32_bf16(Bt[n][k], At[m][k], acc[ai][bj][m][n], 0, 0, 0); __builtin_amdgcn_s_setprio(0); } while (0)
#define PG8_WAIT_V(n) asm volatile("s_waitcnt vmcnt(" #n ")" ::: "memory")
#define PG8_WAIT_L(n) asm volatile("s_waitcnt lgkmcnt(" #n ")" ::: "memory")
#define PG8_BAR __builtin_amdgcn_s_barrier()
#define PG8_SCHED __builtin_amdgcn_sched_barrier(0)
    Unit cur, nxt; int ui = 0;
    if (!S.next(0, cur)) return;
    f32x4 acc[2][2][4][2];
#pragma unroll
    for (int a = 0; a < 2; ++a)
#pragma unroll
        for (int b = 0; b < 2; ++b)
#pragma unroll
            for (int m = 0; m < 4; ++m)
#pragma unroll
                for (int n = 0; n < 2; ++n) acc[a][b][m][n] = (f32x4){0.f, 0.f, 0.f, 0.f};
    bf16x8 At[4][2], B0[2][2], B1[2][2];
    const char* cA = (const char*)g.A + (size_t)cur.pm * tstep; const char* cB = (const char*)g.Bt + (size_t)cur.pn * tstep;
    S.a_ready(cur);
    if constexpr (SP2) {
        PG8_STAGE(PG8_SB(0, 0), cB, voffB); PG8_STAGE(PG8_SB(0, 1), cB + hstep, voffB); PG8_STAGE(PG8_SA(0, 0), cA, voffA); PG8_STAGE(PG8_SA(0, 1), cA + hstep, voffA);
        if (wr == 1) PG8_BAR;
        PG8_WAIT_V(2); PG8_BAR;
        PG8_STAGE(PG8_SB(1, 0), cB + kstep, voffB); PG8_STAGE(PG8_SA(1, 0), cA + kstep, voffA); PG8_STAGE(PG8_SB(1, 1), cB + hstep + kstep, voffB);
        PG8_WAIT_V(6); PG8_BAR;
    } else {
        PG8_STAGE(PG8_SB(0, 0), cB, voffB); PG8_STAGE(PG8_SA(0, 0), cA, voffA); PG8_STAGE(PG8_SB(0, 1), cB + hstep, voffB); PG8_STAGE(PG8_SA(0, 1), cA + hstep, voffA);
        if (wr == 1) PG8_BAR;
        PG8_WAIT_V(4); PG8_BAR;
        PG8_STAGE(PG8_SB(1, 0), cB + kstep, voffB); PG8_STAGE(PG8_SA(1, 0), cA + kstep, voffA); PG8_STAGE(PG8_SB(1, 1), cB + hstep + kstep, voffB);
        PG8_WAIT_V(6); PG8_BAR;
    }
    for (;;) {
        const bool has_next = S.next(ui + 1, nxt);
        const char* nA = has_next ? (const char*)g.A + (size_t)nxt.pm * tstep : cA; const char* nB = has_next ? (const char*)g.Bt + (size_t)nxt.pn * tstep : cB;
        for (int t = 0; t < nt; t += 2) {
            const bool last = (t == nt - 2);
            const char* a1 = cA + (size_t)(t + 1) * kstep;
            const char* a2 = last ? nA : cA + (size_t)(t + 2) * kstep; const char* b2 = last ? nB : cB + (size_t)(t + 2) * kstep;
            const char* a3 = a2 + kstep; const char* b3 = b2 + kstep;
            if (last && has_next) S.a_ready(nxt);
            if constexpr (SP2) {
            PG8_LDB(B0, 0, 0); PG8_LDB(B1, 0, 1); PG8_SCHED; PG8_LDA(At, 0, 0); PG8_STAGE(PG8_SA(1, 1), a1 + hstep, voffA);
            PG8_WAIT_V(8); PG8_WAIT_L(0); PG8_BAR; PG8_MMA(0, 0, At, B0); PG8_MMA(0, 1, At, B1); PG8_BAR; PG8_SCHED;
            PG8_LDA(At, 0, 1); PG8_STAGE(PG8_SB(0, 0), b2, voffB); PG8_STAGE(PG8_SB(0, 1), b2 + hstep, voffB); PG8_STAGE(PG8_SA(0, 0), a2, voffA);
            PG8_WAIT_V(8); PG8_WAIT_L(0); PG8_BAR; PG8_MMA(1, 0, At, B0); PG8_MMA(1, 1, At, B1); PG8_BAR; PG8_SCHED;
            PG8_LDB(B0, 1, 0); PG8_LDB(B1, 1, 1); PG8_SCHED; PG8_LDA(At, 1, 0); PG8_STAGE(PG8_SA(0, 1), a2 + hstep, voffA);
            PG8_WAIT_V(8); PG8_WAIT_L(0); PG8_BAR; PG8_MMA(0, 0, At, B0); PG8_MMA(0, 1, At, B1); PG8_BAR; PG8_SCHED;
            PG8_LDA(At, 1, 1); PG8_STAGE(PG8_SB(1, 0), b3, voffB); PG8_STAGE(PG8_SB(1, 1), b3 + hstep, voffB); PG8_STAGE(PG8_SA(1, 0), a3, voffA);
            PG8_WAIT_V(8); PG8_WAIT_L(0); PG8_BAR; PG8_MMA(1, 0, At, B0); PG8_MMA(1, 1, At, B1); PG8_BAR; PG8_SCHED;
            } else {
            PG8_LDB(B0, 0, 0); PG8_SCHED; PG8_LDA(At, 0, 0); PG8_STAGE(PG8_SA(1, 1), a1 + hstep, voffA);
            PG8_WAIT_L(8); PG8_BAR; PG8_WAIT_L(0); PG8_MMA(0, 0, At, B0); PG8_BAR; PG8_SCHED;
            PG8_LDB(B1, 0, 1); PG8_STAGE(PG8_SB(0, 0), b2, voffB);
            PG8_BAR; PG8_WAIT_L(0); PG8_MMA(0, 1, At, B1); PG8_BAR;
            PG8_LDA(At, 0, 1); PG8_STAGE(PG8_SA(0, 0), a2, voffA);
            PG8_BAR; PG8_WAIT_L(0); PG8_MMA(1, 0, At, B0); PG8_BAR; PG8_SCHED;
            PG8_STAGE(PG8_SB(0, 1), b2 + hstep, voffB);
            PG8_WAIT_V(6); PG8_BAR; PG8_MMA(1, 1, At, B1); PG8_BAR;
            PG8_LDB(B0, 1, 0); PG8_SCHED; PG8_LDA(At, 1, 0); PG8_STAGE(PG8_SA(0, 1), a2 + hstep, voffA);
            PG8_WAIT_L(8); PG8_BAR; PG8_WAIT_L(0); PG8_MMA(0, 0, At, B0); PG8_BAR; PG8_SCHED;
            PG8_LDB(B1, 1, 1); PG8_STAGE(PG8_SB(1, 0), b3, voffB);
            PG8_BAR; PG8_WAIT_L(0); PG8_MMA(0, 1, At, B1); PG8_BAR;
            PG8_LDA(At, 1, 1); PG8_STAGE(PG8_SA(1, 0), a3, voffA);
            PG8_BAR; PG8_WAIT_L(0); PG8_MMA(1, 0, At, B0); PG8_BAR; PG8_SCHED;
            PG8_STAGE(PG8_SB(1, 1), b3 + hstep, voffB);
            PG8_WAIT_V(6); PG8_BAR; PG8_MMA(1, 1, At, B1); PG8_BAR;
            }
        }
        if constexpr (ALIGN_EPI) { if (wr == 0) PG8_BAR; }
        if constexpr (!Epi::AFTER_DRAIN) { E(acc, cur, wr, wc, fr, fq); S.done(cur); }
        if (!has_next) break;
#pragma unroll
        for (int a = 0; a < 2; ++a)
#pragma unroll
            for (int b = 0; b < 2; ++b)
#pragma unroll
                for (int m = 0; m < 4; ++m)
#pragma unroll
                    for (int n = 0; n < 2; ++n) acc[a][b][m][n] = (f32x4){0.f, 0.f, 0.f, 0.f};
        cur = nxt; cA = nA; cB = nB; ++ui;
        if constexpr (ALIGN_EPI) { if (wr == 1) PG8_BAR; }
    }
    PG8_WAIT_V(0);
    if constexpr (!ALIGN_EPI) { if (wr == 0) PG8_BAR; }
    PG8_BAR;
    if constexpr (Epi::AFTER_DRAIN) { E.fused(acc, cur, wr, wc, fr, fq, lds, wid, lane); S.done(cur); }
#undef PG8_SA
#undef PG8_SB
#undef PG8_STAGE
#undef PG8_LDA
#undef PG8_LDB
#undef PG8_MMA
#undef PG8_WAIT_V
#undef PG8_WAIT_L
#undef PG8_BAR
#undef PG8_SCHED
}
}
namespace mix {
#define MLAS __attribute__((address_space(3)))
typedef unsigned short bf16_t;
typedef short bf16x8 __attribute__((ext_vector_type(8)));
typedef short s16x4 __attribute__((ext_vector_type(4)));
typedef float f32x16 __attribute__((ext_vector_type(16)));
typedef float f32x4 __attribute__((ext_vector_type(4)));
typedef float f32x2 __attribute__((ext_vector_type(2)));
typedef unsigned u32x4 __attribute__((ext_vector_type(4)));
typedef unsigned u32x2 __attribute__((ext_vector_type(2)));
typedef MLAS const char* lds_cptr;
typedef short v4i16_t __attribute__((ext_vector_type(4)));
typedef __bf16 bf16x2_t __attribute__((ext_vector_type(2)));

constexpr int SLOTB = 8192;
constexpr int NSLOT = 4;
constexpr int L_K = 0, L_V = NSLOT * SLOTB, L_WSF = 2 * NSLOT * SLOTB, L_OST = L_WSF + 8 * 256, L_X = L_OST + 8 * 4096;
constexpr int LX_IQ = L_X, LX_EQ = L_X, LX_PFX = L_X + 8192, LX_CNT = LX_IQ + 16384, LX_GT = LX_CNT + 2048, LX_SEL = LX_GT, LX_END = LX_GT + 8192;
static_assert(LX_END <= 131072, "mixer LDS map");

__device__ __forceinline__ int crow(int r, int hi) { return (r & 3) + 8 * (r >> 2) + 4 * hi; }
__device__ __forceinline__ void glds16(const void* gsrc, unsigned lds_dst) { unsigned keep;
    asm volatile("s_mov_b32 %0, m0\n\ts_mov_b32 m0, %2\n\ts_nop 0\n\tglobal_load_lds_dwordx4 %1, off\n\ts_mov_b32 m0, %0" : "=&s"(keep) : "v"(gsrc), "s"(lds_dst) : "memory"); }
__device__ __forceinline__ unsigned cvtpk(float lo, float hi) { f32x2 v = {lo, hi}; bf16x2_t b = __builtin_convertvector(v, bf16x2_t); return __builtin_bit_cast(unsigned, b); }
__device__ __forceinline__ s16x4 vtr(lds_cptr p) { return __builtin_bit_cast(s16x4, __builtin_amdgcn_ds_read_tr16_b64_v4i16((MLAS v4i16_t*)p)); }
#define WAITV_BAR() asm volatile("s_waitcnt vmcnt(0) lgkmcnt(0)\n\ts_barrier" ::: "memory")
#define LGKM_BAR() asm volatile("s_waitcnt lgkmcnt(0)\n\ts_barrier" ::: "memory")
#define WAITV2_BAR() asm volatile("s_waitcnt vmcnt(2) lgkmcnt(0)\n\ts_barrier" ::: "memory")

__device__ __forceinline__ void dma_kv(const bf16_t* kbase, const bf16_t* vbase, int pitch, unsigned lds0, int slot, int wid, int lane) {
    const bf16_t* ks = kbase + (size_t)lane * pitch + wid * 8;
    const bf16_t* vs = vbase + (size_t)(16 * (wid & 3) + (lane >> 2)) * pitch + (wid >> 2) * 32 + (lane & 3) * 8;
    glds16(ks, (unsigned)__builtin_amdgcn_readfirstlane(lds0 + L_K + slot * SLOTB + wid * 1024));
    glds16(vs, (unsigned)__builtin_amdgcn_readfirstlane(lds0 + L_V + slot * SLOTB + wid * 1024));
}
__device__ __forceinline__ void kload(bf16x8 (&kf)[8], lds_cptr kslot, int r32, int hi) {
    lds_cptr kb = kslot + hi * 1024 + r32 * 16;
#pragma unroll
    for (int d0 = 0; d0 < 4; ++d0) { kf[2 * d0] = *(const MLAS bf16x8*)(kb + d0 * 2048); kf[2 * d0 + 1] = *(const MLAS bf16x8*)(kb + d0 * 2048 + 512); }
}
__device__ __forceinline__ void qkt_mma(f32x16& p0, f32x16& p1, const bf16x8 (&kf)[8], const bf16x8* qr, const f32x16& cinit) {
    p0 = __builtin_amdgcn_mfma_f32_32x32x16_bf16(kf[0], qr[0], cinit, 0, 0, 0); p1 = __builtin_amdgcn_mfma_f32_32x32x16_bf16(kf[1], qr[0], cinit, 0, 0, 0);
#pragma unroll
    for (int d0 = 1; d0 < 4; ++d0) { p0 = __builtin_amdgcn_mfma_f32_32x32x16_bf16(kf[2 * d0], qr[d0], p0, 0, 0, 0); p1 = __builtin_amdgcn_mfma_f32_32x32x16_bf16(kf[2 * d0 + 1], qr[d0], p1, 0, 0, 0); }
}
__device__ __forceinline__ void qkt(f32x16& p0, f32x16& p1, lds_cptr kslot, const bf16x8* qr, const f32x16& cinit, int r32, int hi) {
    bf16x8 kf[8]; kload(kf, kslot, r32, hi); qkt_mma(p0, p1, kf, qr, cinit);
}
__device__ __forceinline__ void vload(bf16x8 (&vf)[8], lds_cptr vslot, int lane, int hi) {
    lds_cptr vp = vslot + ((lane >> 4) & 1) * 32 + (lane & 3) * 8 + (4 * hi + ((lane & 15) >> 2)) * 64;
#pragma unroll
    for (int d0 = 0; d0 < 2; ++d0)
#pragma unroll
        for (int ks = 0; ks < 4; ++ks) {
            const s16x4 lo = vtr(vp + d0 * 4096 + ks * 1024), hh = vtr(vp + d0 * 4096 + ks * 1024 + 512);
            vf[d0 * 4 + ks] = (bf16x8){lo[0], lo[1], lo[2], lo[3], hh[0], hh[1], hh[2], hh[3]};
        }
}
#define V16_TO_ARR(v, a, o) do { a[(o) + 0] = v[0]; a[(o) + 1] = v[1]; a[(o) + 2] = v[2]; a[(o) + 3] = v[3]; a[(o) + 4] = v[4]; a[(o) + 5] = v[5]; a[(o) + 6] = v[6]; a[(o) + 7] = v[7]; \
    a[(o) + 8] = v[8]; a[(o) + 9] = v[9]; a[(o) + 10] = v[10]; a[(o) + 11] = v[11]; a[(o) + 12] = v[12]; a[(o) + 13] = v[13]; a[(o) + 14] = v[14]; a[(o) + 15] = v[15]; } while (0)
__device__ __forceinline__ f32x16 splat16(float x) { return (f32x16){x, x, x, x, x, x, x, x, x, x, x, x, x, x, x, x}; }
struct AttnState { f32x16 o[2]; float m, l, pend; bool started; };
constexpr float ATT_THR = 8.0f;
__device__ __forceinline__ void softmax_pv(AttnState& st, float (&sc)[32], const bf16x8 (&vf)[8], MLAS float* wsf, int lane, int r32, int hi) {
    if (__any(st.pend != 0.f)) {
#pragma unroll
        for (int r = 0; r < 32; ++r) sc[r] -= st.pend;
    }
    st.pend = 0.f;
    float ra = __builtin_fmaxf(__builtin_fmaxf(sc[0], sc[1]), sc[2]), rb = __builtin_fmaxf(__builtin_fmaxf(sc[3], sc[4]), sc[5]);
#pragma unroll
    for (int r = 6; r < 30; r += 4) { ra = __builtin_fmaxf(__builtin_fmaxf(ra, sc[r]), sc[r + 1]); rb = __builtin_fmaxf(__builtin_fmaxf(rb, sc[r + 2]), sc[r + 3]); }
    float rm = __builtin_fmaxf(__builtin_fmaxf(ra, rb), __builtin_fmaxf(sc[30], sc[31]));
    rm = halves_max_f(rm);
    const bool fresh = !st.started;
    const bool need = (rm > ATT_THR) || (fresh && rm < -ATT_THR && rm > -1e29f);
    st.started = st.started || (rm > -1e29f);
    if (__any(need)) {
        const float dl = need ? rm : 0.f;
        st.m += dl; st.pend = dl;
#pragma unroll
        for (int r = 0; r < 32; ++r) sc[r] -= dl;
        const float alpha = fresh ? 1.0f : __builtin_amdgcn_exp2f(-dl);
        st.l *= alpha;
        if (hi == 0) wsf[r32] = alpha;
        float fr_[16];
#pragma unroll
        for (int r = 0; r < 16; ++r) fr_[r] = wsf[crow(r, hi)];
        const f32x16 fv = {fr_[0], fr_[1], fr_[2], fr_[3], fr_[4], fr_[5], fr_[6], fr_[7], fr_[8], fr_[9], fr_[10], fr_[11], fr_[12], fr_[13], fr_[14], fr_[15]};
        st.o[0] = st.o[0] * fv; st.o[1] = st.o[1] * fv;
    }
    float pe[32]; float s0 = 0.f, s1 = 0.f;
#pragma unroll
    for (int r = 0; r < 32; r += 2) { pe[r] = __builtin_amdgcn_exp2f(sc[r]); pe[r + 1] = __builtin_amdgcn_exp2f(sc[r + 1]); s0 += pe[r]; s1 += pe[r + 1]; }
    st.l += s0 + s1;
    u32x4 pw[4];
#pragma unroll
    for (int k = 0; k < 4; ++k) pw[k] = (u32x4){cvtpk(pe[8 * k + 0], pe[8 * k + 1]), cvtpk(pe[8 * k + 2], pe[8 * k + 3]), cvtpk(pe[8 * k + 4], pe[8 * k + 5]), cvtpk(pe[8 * k + 6], pe[8 * k + 7])};
#pragma unroll
    for (int d0 = 0; d0 < 2; ++d0)
#pragma unroll
        for (int ks = 0; ks < 4; ++ks) st.o[d0] = __builtin_amdgcn_mfma_f32_32x32x16_bf16(__builtin_bit_cast(bf16x8, pw[ks]), vf[d0 * 4 + ks], st.o[d0], 0, 0, 0);
}
__device__ __forceinline__ void attn_store(AttnState& st, bf16_t* Ow, int pitch, MLAS float* wsf, MLAS bf16_t* stg, int lane, int r32, int hi) {
    float l = halves_sum_f(st.l);
    if (hi == 0) wsf[32 + r32] = l;
    float rli[16];
#pragma unroll
    for (int r = 0; r < 16; ++r) rli[r] = 1.0f / wsf[32 + crow(r, hi)];
#pragma unroll
    for (int r = 0; r < 16; ++r) { const int orow = crow(r, hi);
#pragma unroll
        for (int d0 = 0; d0 < 2; ++d0) { const unsigned short b = (unsigned short)(cvtpk(st.o[d0][r] * rli[r], 0.f) & 0xffffu); stg[orow * 64 + d0 * 32 + r32] = b; } }
#pragma unroll
    for (int i = 0; i < 4; ++i) { const int row = i * 8 + (lane >> 3), ch = lane & 7; const u32x4 v = *(const MLAS u32x4*)(stg + row * 64 + ch * 8); *(u32x4*)(Ow + (size_t)row * pitch + ch * 8) = v; }
}

#ifndef DBG_REP_BS
#define DBG_REP_BS 1
#endif
constexpr int KEY_LOW_BIT = 14;
template <int NS> __device__ __forceinline__ unsigned bit_search(const unsigned (&key)[8][16], MLAS unsigned* cntx, int wid, int r32, int hi) {
    unsigned tau = 0u;
#pragma unroll 1
    for (int bit = 31; bit >= KEY_LOW_BIT; --bit) {
        const unsigned cand = tau | (1u << bit);
        unsigned cnt = 0;
#pragma unroll
        for (int jj = 0; jj < NS; ++jj)
#pragma unroll
            for (int r = 0; r < 16; ++r) cnt += (key[jj][r] >= cand) ? 1u : 0u;
        cnt = halves_add_u(cnt);
        MLAS unsigned* cb = cntx + (bit & 1) * 256;
        if (hi == 0) cb[wid * 32 + r32] = cnt;
        LGKM_BAR();
        unsigned tot = 0;
#pragma unroll
        for (int w = 0; w < 8; ++w) tot += cb[w * 32 + r32];
        if (tot >= 256u) tau = cand;
    }
    return tau;
}
__device__ __forceinline__ void dsa_select(int b, int qg, const bf16_t* Z0, char* shm, const int wave_s) {
    const int tid_ = wave_s * 64 + lane_opaque(); const int tid = tid_, lane = tid & 63, r32 = lane & 31, hi = lane >> 5; const int wid = __builtin_amdgcn_readfirstlane(tid >> 6);
    MLAS char* L = (MLAS char*)shm;
    const int c = qg >> 1, nkeys = 64 * (c + 1), nt32 = nkeys >> 5, nt64 = nkeys >> 6;
    const size_t rowb = (size_t)b * SEQ;
    const size_t tok0 = rowb + 32 * qg;
    MLAS unsigned* selw = (MLAS unsigned*)(L + LX_SEL);
    if (nkeys <= 256) {
        for (int i = tid; i < 64 * 32; i += 512) selw[i] = (i < nt32 * 32) ? 0xffffffffu : 0u;
    } else {
        {
            MLAS u32x4* iqL = (MLAS u32x4*)(L + LX_IQ);
            for (int i = tid; i < 1024; i += 512) { const int q = i & 31, hh = (i >> 5) & 1, d0 = (i >> 6) & 3, h = i >> 8;
                iqL[i] = *(const u32x4*)(Z0 + (tok0 + q) * EV_N + 1280 + 64 * h + 16 * d0 + 8 * hh); }
        }
        float w4[4];
        { const u32x2 ww = *(const u32x2*)(Z0 + (tok0 + r32) * EV_N + 1216);
          w4[0] = pg8::bf_lo(ww.x) * 0.0625f; w4[1] = pg8::bf_hi(ww.x) * 0.0625f; w4[2] = pg8::bf_lo(ww.y) * 0.0625f; w4[3] = pg8::bf_hi(ww.y) * 0.0625f; }
        LGKM_BAR();
        unsigned key[8][16];
        const int nslots = (nt32 + 7) >> 3;
        const MLAS bf16x8* iqf = (const MLAS bf16x8*)(L + LX_IQ) + hi * 32 + r32;
#pragma unroll
        for (int jj = 0; jj < 8; ++jj) {
            const int j = wid + 8 * jj;
            if (j < nt32) {
                const bf16_t* ikp = Z0 + (rowb + 32 * j + r32) * EV_N + 1152 + 8 * hi;
                bf16x8 af[4];
#pragma unroll
                for (int d0 = 0; d0 < 4; ++d0) af[d0] = *(const bf16x8*)(ikp + 16 * d0);
                f32x16 ah[4];
#pragma unroll
                for (int h = 0; h < 4; ++h) {
                    f32x16 a = {};
#pragma unroll
                    for (int d0 = 0; d0 < 4; ++d0) a = __builtin_amdgcn_mfma_f32_32x32x16_bf16(af[d0], iqf[(h * 4 + d0) * 64], a, 0, 0, 0);
                    ah[h] = a;
                }
#pragma unroll
                for (int r = 0; r < 16; ++r) {
                    const float s = ((__builtin_fmaxf(ah[0][r], 0.f) * w4[0] + __builtin_fmaxf(ah[1][r], 0.f) * w4[1]) + __builtin_fmaxf(ah[2][r], 0.f) * w4[2]) + __builtin_fmaxf(ah[3][r], 0.f) * w4[3];
                    const unsigned u = __builtin_bit_cast(unsigned, s); key[jj][r] = (u & 0x80000000u) ? ~u : (u | 0x80000000u);
                }
            } else {
#pragma unroll
                for (int r = 0; r < 16; ++r) key[jj][r] = 0u;
            }
        }
        MLAS unsigned* cntx = (MLAS unsigned*)(L + L_OST);
        unsigned tau;
        for (int rep_ = 0; rep_ < DBG_REP_BS; ++rep_)
        switch (nslots) {
            case 2: tau = bit_search<2>(key, cntx, wid, r32, hi); break;
            case 3: tau = bit_search<3>(key, cntx, wid, r32, hi); break;
            case 4: tau = bit_search<4>(key, cntx, wid, r32, hi); break;
            case 5: tau = bit_search<5>(key, cntx, wid, r32, hi); break;
            case 6: tau = bit_search<6>(key, cntx, wid, r32, hi); break;
            case 7: tau = bit_search<7>(key, cntx, wid, r32, hi); break;
            default: tau = bit_search<8>(key, cntx, wid, r32, hi); break;
        }
        const unsigned tau_hi = (tau >= 0xffffffffu - ((1u << KEY_LOW_BIT) - 1u)) ? 0xffffffffu : tau + (1u << KEY_LOW_BIT);
        MLAS unsigned* gtw = (MLAS unsigned*)(L + LX_GT); MLAS unsigned* eqw = (MLAS unsigned*)(L + LX_EQ); MLAS unsigned* pfx = (MLAS unsigned*)(L + LX_PFX);
#pragma unroll
        for (int jj = 0; jj < 8; ++jj) {
            const int j = wid + 8 * jj;
            if (j < nt32) {
                unsigned g = 0, e = 0;
#pragma unroll
                for (int r = 0; r < 16; ++r) { const unsigned bitp = 1u << ((r & 3) + 8 * (r >> 2)); g |= (key[jj][r] >= tau_hi) ? bitp : 0u; e |= (key[jj][r] >= tau && key[jj][r] < tau_hi) ? bitp : 0u; }
                g <<= 4 * hi; e <<= 4 * hi;
                g = halves_or_u(g); e = halves_or_u(e);
                if (hi == 0) { gtw[j * 32 + r32] = g; eqw[j * 32 + r32] = e; }
            }
        }
        LGKM_BAR();
        if (wid == 0 && hi == 0) {
            unsigned cg = 0;
            for (int j = 0; j < nt32; ++j) cg += __builtin_popcount(gtw[j * 32 + r32]);
            const int need = 256 - (int)cg;
            int run = 0;
            for (int j = 0; j < nt32; ++j) { const unsigned e = eqw[j * 32 + r32]; int k = need - run; k = k < 0 ? 0 : (k > 32 ? 32 : k); pfx[j * 32 + r32] = (unsigned)k; run += __builtin_popcount(e); }
        }
        LGKM_BAR();
        for (int i = tid; i < nt32 * 32; i += 512) {
            const unsigned g = gtw[i], e = eqw[i]; const int k = (int)pfx[i];
            unsigned take = 0;
            if (e != 0u && k > 0) {
                unsigned rem = e; int cntk = 0;
                while (rem != 0u && cntk < k) { const unsigned low = rem & (0u - rem); take |= low; rem ^= low; ++cntk; }
            }
            selw[i] = g | take;
        }
        for (int i = nt32 * 32 + tid; i < 64 * 32; i += 512) selw[i] = 0u;
    }
    WAITV_BAR();
}

__device__ __forceinline__ void fox_unit(int b, int h, int qb, const bf16_t* Z1, const float* F, const float* bfp, bf16_t* Y, char* shm, unsigned lds0, const int wave_s) {
    const int tid_ = wave_s * 64 + lane_opaque(); const int tid = tid_, lane = tid & 63, r32 = lane & 31, hi = lane >> 5; const int wid = __builtin_amdgcn_readfirstlane(tid >> 6);
    MLAS char* L = (MLAS char*)shm;
    const size_t rowb = (size_t)b * SEQ;
    const int NT = 4 * (qb + 1), nk = 64 * NT;
    MLAS float* cum2 = (MLAS float*)(L + L_X);
    MLAS float* wtot = (MLAS float*)(L + L_X + 8192);
    const bf16_t* Kb = Z1 + rowb * Z1P + 512 + 64 * h; const bf16_t* Vb = Z1 + rowb * Z1P + 1024 + 64 * h;
#pragma unroll
    for (int i = 0; i < 3; ++i) dma_kv(Kb + (size_t)64 * i * Z1P, Vb + (size_t)64 * i * Z1P, Z1P, lds0, i, wid, lane);
    {
        const float bias = bfp[h];
        const int s0 = 4 * tid;
        float v[4]; float run = 0.f;
#pragma unroll
        for (int i = 0; i < 4; ++i) {
            float x = 0.f;
            if (s0 + i < nk) x = F[(rowb + s0 + i) * 8 + h] + bias;
            const float ls = (s0 + i < nk) ? (fminf(x, 0.f) - log1pf(expf(-fabsf(x)))) : 0.f;
            run += ls; v[i] = run;
        }
        float inc = run;
#pragma unroll
        for (int o = 1; o < 64; o <<= 1) { const int ln = lane_opaque(); const float t = __builtin_bit_cast(float, __builtin_amdgcn_ds_bpermute((ln - o) << 2, __builtin_bit_cast(int, inc))); if (ln >= o) inc += t; }
        if (lane == 63) wtot[wid] = inc;
        LGKM_BAR();
        float off = inc - run;
        for (int w = 0; w < wid; ++w) off += wtot[w];
#pragma unroll
        for (int i = 0; i < 4; ++i) cum2[s0 + i] = (off + v[i]) * 1.4426950408889634f;
    }
    const int tq = 256 * qb + 32 * wid + r32;
    bf16x8 qr[4];
#pragma unroll
    for (int d0 = 0; d0 < 4; ++d0) qr[d0] = *(const bf16x8*)(Z1 + (rowb + tq) * Z1P + 64 * h + 16 * d0 + 8 * hi);
    AttnState st; st.o[0] = f32x16{}; st.o[1] = f32x16{}; st.m = 0.f; st.l = 0.f; st.pend = 0.f; st.started = false;
    MLAS float* wsf = (MLAS float*)(L + L_WSF) + wid * 64;
    WAITV_BAR();
    const float cq2 = cum2[tq];
    const int tlast = 4 * qb + (wid >> 1);
    f32x16 s0, s1;
    qkt(s0, s1, (lds_cptr)(L + L_K), qr, splat16(-st.m), r32, hi);
    for (int t = 0; t < NT; ++t) {
        const int slot = t & 3;
        { const int tt = (t + 3 < NT) ? t + 3 : NT - 1; dma_kv(Kb + (size_t)64 * tt * Z1P, Vb + (size_t)64 * tt * Z1P, Z1P, lds0, (t + 3) & 3, wid, lane); }
        bf16x8 kf[8], vf[8];
        kload(kf, (lds_cptr)(L + L_K + ((t + 1) & 3) * SLOTB), r32, hi);
        __builtin_amdgcn_sched_barrier(0);
        vload(vf, (lds_cptr)(L + L_V + slot * SLOTB), lane, hi);
        const MLAS float* cb = cum2 + 64 * t + 4 * hi;
        f32x4 c0[4], c1[4];
#pragma unroll
        for (int g = 0; g < 4; ++g) { c0[g] = *(const MLAS f32x4*)(cb + 8 * g); c1[g] = *(const MLAS f32x4*)(cb + 32 + 8 * g); }
        f32x16 n0, n1;
        qkt_mma(n0, n1, kf, qr, splat16(-st.m));
        float sc[32];
        V16_TO_ARR(s0, sc, 0); V16_TO_ARR(s1, sc, 16);
#pragma unroll
        for (int g = 0; g < 4; ++g) {
            sc[4 * g + 0] += cq2 - c0[g].x; sc[4 * g + 1] += cq2 - c0[g].y; sc[4 * g + 2] += cq2 - c0[g].z; sc[4 * g + 3] += cq2 - c0[g].w;
            sc[16 + 4 * g + 0] += cq2 - c1[g].x; sc[16 + 4 * g + 1] += cq2 - c1[g].y; sc[16 + 4 * g + 2] += cq2 - c1[g].z; sc[16 + 4 * g + 3] += cq2 - c1[g].w;
        }
        if (t >= tlast) {
            const int qrel = tq - 64 * t;
#pragma unroll
            for (int r = 0; r < 16; ++r) { const int kr = crow(r, hi); if (kr > qrel) sc[r] = -INFINITY; if (kr + 32 > qrel) sc[16 + r] = -INFINITY; }
        }
        softmax_pv(st, sc, vf, wsf, lane, r32, hi);
        s0 = n0; s1 = n1;
        WAITV2_BAR();
    }
    attn_store(st, Y + (rowb + 256 * qb + 32 * wid) * DMODEL + 64 * h, DMODEL, wsf, (MLAS bf16_t*)(L + L_OST) + wid * 2048, lane, r32, hi);
    WAITV_BAR();
}

__device__ __forceinline__ void sgu_unit(int b, int n, int g, const bf16_t* Z1, const float* sst, const float* lng, const float* lnb, const bf16_t* Wm, const float* bs, bf16_t* Y, char* shm, const int wave_s) {
    const int tid_ = wave_s * 64 + lane_opaque(); const int tid = tid_, lane = tid & 63, r32 = lane & 31, hi = lane >> 5; const int wid = __builtin_amdgcn_readfirstlane(tid >> 6);
    MLAS char* L = (MLAS char*)shm;
    MLAS bf16_t* vn = (MLAS bf16_t*)L;
    constexpr int VP = 136;
    const size_t tok0 = (size_t)b * SEQ + 128 * n;
    {
        const int j = tid >> 2, cq = (tid & 3) * 32;
        const float* sp = sst + (tok0 + j) * 16;
        float s1 = 0.f, s2 = 0.f;
#pragma unroll
        for (int k = 0; k < 8; ++k) { s1 += sp[2 * k]; s2 += sp[2 * k + 1]; }
        const float mu = s1 * (1.0f / 512.0f); const float var = fmaxf(s2 * (1.0f / 512.0f) - mu * mu, 0.f);
        const float rstd = 1.0f / sqrtf(var + RMS_EPS);
        const bf16_t* vp = Z1 + (tok0 + j) * Z1P + 2048 + 128 * g + cq;
#pragma unroll
        for (int k = 0; k < 4; ++k) {
            const u32x4 w = *(const u32x4*)(vp + 8 * k);
            const int cc = 128 * g + cq + 8 * k;
            const f32x4 g0 = *(const f32x4*)(lng + cc), g1 = *(const f32x4*)(lng + cc + 4), b0 = *(const f32x4*)(lnb + cc), b1 = *(const f32x4*)(lnb + cc + 4);
            float x[8] = {pg8::bf_lo(w.x), pg8::bf_hi(w.x), pg8::bf_lo(w.y), pg8::bf_hi(w.y), pg8::bf_lo(w.z), pg8::bf_hi(w.z), pg8::bf_lo(w.w), pg8::bf_hi(w.w)};
            float y[8];
#pragma unroll
            for (int i = 0; i < 4; ++i) { y[i] = (x[i] - mu) * rstd * g0[i] + b0[i]; y[4 + i] = (x[4 + i] - mu) * rstd * g1[i] + b1[i]; }
            u32x4 o; o.x = cvtpk(y[0], y[1]); o.y = cvtpk(y[2], y[3]); o.z = cvtpk(y[4], y[5]); o.w = cvtpk(y[6], y[7]);
            *(MLAS u32x4*)(vn + j * VP + cq + 8 * k) = o;
        }
    }
    LGKM_BAR();
    MLAS bf16_t* ut = (MLAS bf16_t*)(L + 128 * VP * 2);
    {
        const int j = tid >> 2, cq = (tid & 3) * 32;
        const bf16_t* up = Z1 + (tok0 + j) * Z1P + 1536 + 128 * g + cq;
#pragma unroll
        for (int k = 0; k < 4; ++k) *(MLAS u32x4*)(ut + j * VP + cq + 8 * k) = *(const u32x4*)(up + 8 * k);
    }
    LGKM_BAR();
    const int ib = wid & 3;
    const bf16_t* wrow = Wm + ((size_t)g * 128 + 32 * ib + r32) * 128 + 8 * hi;
    bf16x8 af[8];
#pragma unroll
    for (int s = 0; s < 8; ++s) af[s] = *(const bf16x8*)(wrow + 16 * s);
#pragma unroll
    for (int cbi = 0; cbi < 2; ++cbi) {
        const int cb = (wid >> 2) * 2 + cbi;
        f32x16 acc = {};
        lds_cptr bp = (lds_cptr)(vn) + ((size_t)(8 * hi + ((lane & 15) >> 2)) * VP + 32 * cb + 16 * ((lane >> 4) & 1) + 4 * (lane & 3)) * 2;
#pragma unroll
        for (int s = 0; s < 8; ++s) {
            const s16x4 lo = vtr(bp + (16 * s) * VP * 2), hh = vtr(bp + (16 * s + 4) * VP * 2);
            const bf16x8 bfr = {lo[0], lo[1], lo[2], lo[3], hh[0], hh[1], hh[2], hh[3]};
            acc = __builtin_amdgcn_mfma_f32_32x32x16_bf16(af[s], bfr, acc, 0, 0, 0);
        }
        float a16[16]; V16_TO_ARR(acc, a16, 0);
#pragma unroll
        for (int r = 0; r < 16; ++r) {
            const int i = 32 * ib + crow(r, hi), cc = 32 * cb + r32;
            const float uu = __builtin_bit_cast(float, (unsigned)ut[i * VP + cc] << 16);
            const float o = uu * (a16[r] + bs[g * 128 + i]);
            ut[i * VP + cc] = (bf16_t)(cvtpk(o, 0.f) & 0xffffu);
        }
    }
    LGKM_BAR();
    {
        const int j = tid >> 2, cq = (tid & 3) * 32;
        bf16_t* yp = Y + (tok0 + j) * DMODEL + 512 + 128 * g + cq;
#pragma unroll
        for (int k = 0; k < 4; ++k) *(u32x4*)(yp + 8 * k) = *(const MLAS u32x4*)(ut + j * VP + cq + 8 * k);
    }
    LGKM_BAR();
}

__device__ __forceinline__ void pool_item(int item, const bf16_t* Z0, bf16_t* Y) {
    const int row = item >> 6, ch = item & 63, c0 = ch * 8, g = ch >> 4;
    const int w = 2 << g, tpos = row & (SEQ - 1);
    const int cnt = (tpos + 1 < w) ? tpos + 1 : w;
    u32x4 v[16];
#pragma unroll
    for (int k = 0; k < 16; ++k) { v[k] = (u32x4){0u, 0u, 0u, 0u}; if (k < cnt) v[k] = *(const u32x4*)(Z0 + (size_t)(row - k) * EV_N + c0); }
    float s[8] = {0.f, 0.f, 0.f, 0.f, 0.f, 0.f, 0.f, 0.f};
#pragma unroll
    for (int k = 0; k < 16; ++k) {
        s[0] += pg8::bf_lo(v[k].x); s[1] += pg8::bf_hi(v[k].x); s[2] += pg8::bf_lo(v[k].y); s[3] += pg8::bf_hi(v[k].y);
        s[4] += pg8::bf_lo(v[k].z); s[5] += pg8::bf_hi(v[k].z); s[6] += pg8::bf_lo(v[k].w); s[7] += pg8::bf_hi(v[k].w);
    }
    const float self[8] = {pg8::bf_lo(v[0].x), pg8::bf_hi(v[0].x), pg8::bf_lo(v[0].y), pg8::bf_hi(v[0].y), pg8::bf_lo(v[0].z), pg8::bf_hi(v[0].z), pg8::bf_lo(v[0].w), pg8::bf_hi(v[0].w)};
    const float inv = 1.0f / (float)cnt;
    u32x4 o; o.x = cvtpk(s[0] * inv - self[0], s[1] * inv - self[1]); o.y = cvtpk(s[2] * inv - self[2], s[3] * inv - self[3]);
    o.z = cvtpk(s[4] * inv - self[4], s[5] * inv - self[5]); o.w = cvtpk(s[6] * inv - self[6], s[7] * inv - self[7]);
    *(u32x4*)(Y + (size_t)row * DMODEL + c0) = o;
}
}
namespace foxa {
using bf16=__hip_bfloat16;
using bf16x8=__attribute__((ext_vector_type(8)))short;
using s16x4=__attribute__((ext_vector_type(4)))short;
using f32x16=__attribute__((ext_vector_type(16)))float;
using u32x4=__attribute__((ext_vector_type(4)))unsigned;
using f32x4v=__attribute__((ext_vector_type(4)))float;
constexpr int CUM_OFF=86016;
constexpr int SEQL=2048,D=64,OPI=1024;
constexpr int NW=8,QBLK=32,QB=QBLK*NW,KVBLK=64;
__device__ __forceinline__ int crow(int r,int hi){return (r&3)+8*(r>>2)+4*hi;}
#define SBAR() __builtin_amdgcn_sched_barrier(0)
__device__ __forceinline__ void cmask(f32x16&p0,f32x16&p1,int jb,int qrel,int hi){
  const float NEG=-INFINITY; int kb=64*jb+4*hi;
  #pragma unroll
  for(int r=0;r<16;++r){int kv=kb+(r&3)+8*(r>>2); if(kv>qrel)p0[r]=NEG; if(kv+32>qrel)p1[r]=NEG;}
}

constexpr int NSLOT=3, SLOTB=8192;
constexpr int LDS_K=0, LDS_V=NSLOT*SLOTB, LDS_WS=2*NSLOT*SLOTB, LDS_OST=LDS_WS+NW*64*4, LDS_BYTES=LDS_OST+NW*4096;
constexpr float C2=0.125f*1.4426950408889634f;
__device__ __forceinline__ void glds16(const void*gsrc,unsigned lds_dst){unsigned keep;
  asm volatile("s_mov_b32 %0, m0\n\ts_mov_b32 m0, %2\n\ts_nop 0\n\tglobal_load_lds_dwordx4 %1, off\n\ts_mov_b32 m0, %0":"=&s"(keep):"v"(gsrc),"s"(lds_dst):"memory");}
__device__ __forceinline__ float max3f(float a,float b,float c){float r;asm("v_max3_f32 %0, %1, %2, %3":"=v"(r):"v"(a),"v"(b),"v"(c));return r;}
__device__ __forceinline__ float max2f(float a,float b){float r;asm("v_max_f32_e32 %0, %1, %2":"=v"(r):"v"(a),"v"(b));return r;}
__device__ __forceinline__ float fadd_s(float a,float b){float r;asm("v_add_f32_e32 %0, %1, %2":"=v"(r):"v"(a),"v"(b));return r;}
__device__ __forceinline__ float fsub_s(float a,float b){float r;asm("v_sub_f32_e32 %0, %1, %2":"=v"(r):"v"(a),"v"(b));return r;}
typedef float f32x2_t __attribute__((ext_vector_type(2))); typedef __bf16 bf16x2_t __attribute__((ext_vector_type(2)));
__device__ __forceinline__ unsigned cvtpk_s(float lo,float hi){f32x2_t v={lo,hi};bf16x2_t b=__builtin_convertvector(v,bf16x2_t);return __builtin_bit_cast(unsigned,b);}
#define WAIT_BAR(N) asm volatile("s_waitcnt vmcnt(" #N ") lgkmcnt(0)\n\ts_barrier":::"memory")

__device__ __forceinline__ void qkt(f32x16&p0,f32x16&p1,const char*Kslot,const bf16x8*qr,const f32x16&negm,int r32,int hi){
  const char*kb=Kslot+hi*1024+r32*16;
  #pragma unroll
  for(int d0=0;d0<4;++d0){
    const bf16x8 b0=*reinterpret_cast<const bf16x8*>(kb+d0*2048);
    const bf16x8 b1=*reinterpret_cast<const bf16x8*>(kb+d0*2048+512);
    if(d0==0){p0=__builtin_amdgcn_mfma_f32_32x32x16_bf16(b0,qr[0],negm,0,0,0);p1=__builtin_amdgcn_mfma_f32_32x32x16_bf16(b1,qr[0],negm,0,0,0);}
    else{p0=__builtin_amdgcn_mfma_f32_32x32x16_bf16(b0,qr[d0],p0,0,0,0);p1=__builtin_amdgcn_mfma_f32_32x32x16_bf16(b1,qr[d0],p1,0,0,0);}}
}
typedef __attribute__((address_space(3))) const char* lds_cptr;
typedef short v4i16_t __attribute__((ext_vector_type(4)));
__device__ __forceinline__ void kload8(bf16x8*kf,lds_cptr kp){
  kf[0]=*(const __attribute__((address_space(3))) bf16x8*)(kp);      kf[1]=*(const __attribute__((address_space(3))) bf16x8*)(kp+512);
  kf[2]=*(const __attribute__((address_space(3))) bf16x8*)(kp+2048); kf[3]=*(const __attribute__((address_space(3))) bf16x8*)(kp+2560);
  kf[4]=*(const __attribute__((address_space(3))) bf16x8*)(kp+4096); kf[5]=*(const __attribute__((address_space(3))) bf16x8*)(kp+4608);
  kf[6]=*(const __attribute__((address_space(3))) bf16x8*)(kp+6144); kf[7]=*(const __attribute__((address_space(3))) bf16x8*)(kp+6656);
}
__device__ __forceinline__ void kload2(bf16x8*kf,lds_cptr kp,int j){ kf[2*j]=*(const __attribute__((address_space(3))) bf16x8*)(kp+j*2048); kf[2*j+1]=*(const __attribute__((address_space(3))) bf16x8*)(kp+j*2048+512); }
__device__ __forceinline__ s16x4 vtr(lds_cptr p){ return __builtin_bit_cast(s16x4,__builtin_amdgcn_ds_read_tr16_b64_v4i16((__attribute__((address_space(3))) v4i16_t*)p)); }
__device__ __forceinline__ float rowmax(const f32x16&p0,const f32x16&p1){
  float a=max3f(p0[0],p0[1],p1[0]),b=max3f(p0[2],p0[3],p1[1]);a=max3f(a,p1[2],p1[3]);
  #pragma unroll
  for(int r=4;r<16;r+=4){a=max3f(a,p0[r],p0[r+1]);b=max3f(b,p0[r+2],p0[r+3]);a=max3f(a,p1[r],p1[r+1]);b=max3f(b,p1[r+2],p1[r+3]);}
  const float m=max2f(a,b);
  auto rr=__builtin_amdgcn_permlane32_swap(__float_as_uint(m),__float_as_uint(m),false,false);
  return max2f(__uint_as_float(rr[0]),__uint_as_float(rr[1]));
}
__device__ __forceinline__ void pv(f32x16*o,int vb,bf16x8 pa0,bf16x8 pa1,bf16x8 pa2,bf16x8 pa3){
  #pragma unroll
  for(int d0=0;d0<2;++d0){s16x4 lo[4],hi[4];
    #pragma unroll
    for(int ks=0;ks<4;++ks){
      asm volatile("ds_read_b64_tr_b16 %0,%1 offset:%c2":"=&v"(lo[ks]):"v"(vb),"i"(d0*4096+ks*1024):"memory");
      asm volatile("ds_read_b64_tr_b16 %0,%1 offset:%c2":"=&v"(hi[ks]):"v"(vb),"i"(d0*4096+ks*1024+512):"memory");}
    asm volatile("s_waitcnt lgkmcnt(0)":::"memory");SBAR();
    #define PK(k) (bf16x8){lo[k][0],lo[k][1],lo[k][2],lo[k][3],hi[k][0],hi[k][1],hi[k][2],hi[k][3]}
    o[d0]=__builtin_amdgcn_mfma_f32_32x32x16_bf16(pa0,PK(0),o[d0],0,0,0);
    o[d0]=__builtin_amdgcn_mfma_f32_32x32x16_bf16(pa1,PK(1),o[d0],0,0,0);
    o[d0]=__builtin_amdgcn_mfma_f32_32x32x16_bf16(pa2,PK(2),o[d0],0,0,0);
    o[d0]=__builtin_amdgcn_mfma_f32_32x32x16_bf16(pa3,PK(3),o[d0],0,0,0);
    #undef PK
  }
}

#ifndef ATTN_STORE16
#define ATTN_STORE16(p,v) (*(u32x4*)(p)=(v))
#endif
template<int THRL,int MODE,int QKVP,class CumFn> __device__ __forceinline__ void attn_unit(CumFn&& CUMFN,int b,int h,int qb,int q0abs,int NTU,const bf16*Q,const bf16*__restrict__ K,const bf16*__restrict__ V,bf16*O,char*shm,const __attribute__((address_space(3))) unsigned*selw,const int wave_s){
  const int tid=wave_s*64+lane_opaque(),lane=tid&63,r32=lane&31,hi=lane>>5; const int wid=__builtin_amdgcn_readfirstlane(tid>>6);
  const long rowbase=(long)b*SEQL; const int q0=(MODE==0)?qb*QB:q0abs;
  const bf16*Qw=(MODE==0)?Q+(rowbase+q0+wid*QBLK)*QKVP+h*D:Q+(rowbase+q0)*QKVP+wid*D;
  const bf16*Kh=K+rowbase*QKVP+h*D,*Vh=V+rowbase*QKVP+h*D;
  const unsigned lds0=(unsigned)(uintptr_t)shm;
  float*wsf=(float*)(shm+LDS_WS)+wid*64;
  const bf16*ksrc=Kh+(long)lane*QKVP+wid*8;
  const bf16*vsrc=Vh+(long)(16*(wid&3)+(lane>>2))*QKVP+(wid>>2)*32+(lane&3)*8;
  const unsigned kdst=lds0+LDS_K+wid*1024, vdst=lds0+LDS_V+wid*1024;
  #define DMA_K(t,slot) glds16(ksrc+(long)(t)*KVBLK*QKVP,(unsigned)__builtin_amdgcn_readfirstlane(kdst+(slot)))
  #define DMA_V(t,slot) glds16(vsrc+(long)(t)*KVBLK*QKVP,(unsigned)__builtin_amdgcn_readfirstlane(vdst+(slot)))
  const int vb0=(int)(lds0+LDS_V)+((lane>>4)&1)*32+(lane&3)*8+(4*hi+((lane&15)>>2))*64;
  const char*Kbase=shm+LDS_K; bf16x8 kf[8];
  const lds_cptr shm3=(lds_cptr)shm; const lds_cptr kp0=shm3+LDS_K+hi*1024+r32*16; const lds_cptr vp0=shm3+LDS_V+((lane>>4)&1)*32+(lane&3)*8+(4*hi+((lane&15)>>2))*64;
  const int NT=(MODE==0)?(q0+QB)/KVBLK:NTU;
  DMA_K(0,0);DMA_V(0,0);DMA_K(1,SLOTB);
  if constexpr(MODE==0){ CUMFN(); }
  bf16x8 qr[4];
  #pragma unroll
  for(int d0=0;d0<4;++d0)qr[d0]=*reinterpret_cast<const bf16x8*>(&Qw[(long)r32*QKVP+d0*16+hi*8]);
  float mhat=0.f,l_reg=0.f;float z_=0.f;asm volatile("":"+v"(z_));f32x16 o[2];o[0]=(f32x16){z_,z_,z_,z_,z_,z_,z_,z_,z_,z_,z_,z_,z_,z_,z_,z_};o[1]=o[0];f32x16 negm=o[0];asm volatile("":"+v"(negm));
  const int qrel=wid*QBLK+r32;
  const __attribute__((address_space(3))) float*cum2=(const __attribute__((address_space(3))) float*)(shm+CUM_OFF);
  const float cq2=(MODE==0)?cum2[q0+qrel]:0.f;
  #define BIAS(P0,P1,t) do{ if constexpr(MODE==0){ const __attribute__((address_space(3))) float*cb_=cum2+64*(t)+4*hi; \
    _Pragma("unroll") for(int g_=0;g_<4;++g_){ const f32x4v c0_=*(const __attribute__((address_space(3))) f32x4v*)(cb_+8*g_), c1_=*(const __attribute__((address_space(3))) f32x4v*)(cb_+32+8*g_); \
      P0[4*g_+0]+=cq2-c0_.x; P0[4*g_+1]+=cq2-c0_.y; P0[4*g_+2]+=cq2-c0_.z; P0[4*g_+3]+=cq2-c0_.w; \
      P1[4*g_+0]+=cq2-c1_.x; P1[4*g_+1]+=cq2-c1_.y; P1[4*g_+2]+=cq2-c1_.z; P1[4*g_+3]+=cq2-c1_.w; } } }while(0)
  #define SELM(P0,P1,t) do{ if constexpr(MODE==1){ const unsigned w0_=selw[(2*(t))*32+r32]>>(4*hi), w1_=selw[(2*(t)+1)*32+r32]>>(4*hi); \
    _Pragma("unroll") for(int r=0;r<16;++r){ const int sh_=(r&3)+8*(r>>2); if(!((w0_>>sh_)&1u))P0[r]=-INFINITY; if(!((w1_>>sh_)&1u))P1[r]=-INFINITY; } } }while(0)
  #define CMASK(P0,P1,t) do{ if constexpr(MODE==0){int jb_=(t)-(NT-4); if(jb_>=0)cmask(P0,P1,jb_,qrel,hi);} }while(0)
  bool resc=false;
  #define START(P0,P1) do{ const float rm=rowmax(P0,P1); resc=false; \
    { const float dl=(MODE==1&&!(rm>-1e30f))?0.f:rm; mhat=fadd_s(mhat,dl); \
      _Pragma("unroll") for(int r=0;r<16;++r){P0[r]=fsub_s(P0[r],dl);P1[r]=fsub_s(P1[r],dl);} \
      _Pragma("unroll") for(int r=0;r<16;++r)negm[r]=-mhat; asm volatile("":"+v"(negm)); } \
    _Pragma("unroll") for(int r=0;r<16;++r)P0[r]=__builtin_amdgcn_exp2f(P0[r]); }while(0)
  #define RESC() do{ if(resc){ asm volatile("s_waitcnt lgkmcnt(0)":::"memory"); \
      _Pragma("unroll") for(int d_=0;d_<2;++d_) _Pragma("unroll") for(int r=0;r<16;++r)o[d_][r]*=wsf[crow(r,hi)]; } }while(0)
  f32x16 pA0,pA1,pB0,pB1;
  int sl_prev=0,sl_cur=0,sl_next=SLOTB;
  #define ROT() do{sl_prev=sl_cur;sl_cur=sl_next;sl_next=(sl_next==(NSLOT-1)*SLOTB)?0:sl_next+SLOTB;}while(0)
  DMA_K(2,2*SLOTB);
  WAIT_BAR(3);
  qkt(pA0,pA1,Kbase,qr,negm,r32,hi);asm volatile("s_nop 15\n\ts_nop 7":"+v"(pA0),"+v"(pA1));BIAS(pA0,pA1,0);SELM(pA0,pA1,0);CMASK(pA0,pA1,0);
  START(pA0,pA1);
  _Pragma("unroll") for(int r=0;r<16;++r)pA1[r]=__builtin_amdgcn_exp2f(pA1[r]);
  WAIT_BAR(0);
  DMA_K(3,0);DMA_V(1,SLOTB);
  ROT();
  kload8(kf,kp0+sl_cur);
  WAIT_BAR(2);
  s16x4 vlo[8],vhi[8]; u32x4 pw0,pw1,pw2,pw3;
  #define PKW(P,B) cvtpk_s(P[B],P[B+1])
  #define PAF(k) __builtin_bit_cast(bf16x8,pw##k)
  #define VFR(i) (bf16x8){vlo[i][0],vlo[i][1],vlo[i][2],vlo[i][3],vhi[i][0],vhi[i][1],vhi[i][2],vhi[i][3]}
  #define PIN(x) asm volatile("":"+v"(x))
  #define MX3(a,b,c) __builtin_fmaxf(__builtin_fmaxf((a),(b)),(c))
  #define GAPA(MF,A0,A1,A2,A3,W0,W1,PW) do{ MF; sacc+=A0; sacc+=A1; sacc+=A2; sacc+=A3; PIN(sacc); W0; W1; PIN(PW); SBAR(); }while(0)
  #define EX(v) __builtin_amdgcn_exp2f(v)
  #define GAPB(MF,X,B) do{ MF; X[B]=EX(X[B]); X[B+1]=EX(X[B+1]); X[B+2]=EX(X[B+2]); X[B+3]=EX(X[B+3]); PIN(X); SBAR(); }while(0)
  #define VRD(i) do{ vlo[i]=vtr(vp_+(((i)>>2)*4096+((i)&3)*1024)); vhi[i]=vtr(vp_+(((i)>>2)*4096+((i)&3)*1024+512)); }while(0)
  #define KRD(G,j) do{ if(G){ kload2(kf,kp0+sl_next,j); SBAR(); } }while(0)
  #define STEP(C0,C1,P0,P1,t,GK,GV,GL) do{ SBAR(); \
    const lds_cptr vp_=vp0+sl_prev; \
    VRD(0); SBAR(); float sacc=(P0[0]+P0[1]); \
    GAPA(C0=__builtin_amdgcn_mfma_f32_32x32x16_bf16(kf[0],qr[0],negm,0,0,0), P0[2],P0[3],P0[4],P0[5],     pw0[0]=PKW(P0,0), pw0[1]=PKW(P0,2), pw0); \
    VRD(4); SBAR(); GAPA(C1=__builtin_amdgcn_mfma_f32_32x32x16_bf16(kf[1],qr[0],negm,0,0,0), P0[6],P0[7],P0[8],P0[9],     pw0[2]=PKW(P0,4), pw0[3]=PKW(P0,6), pw0); \
    VRD(1); SBAR(); GAPA(C0=__builtin_amdgcn_mfma_f32_32x32x16_bf16(kf[2],qr[1],C0,0,0,0),   P0[10],P0[11],P0[12],P0[13], pw1[0]=PKW(P0,8), pw1[1]=PKW(P0,10), pw1); \
    VRD(5); SBAR(); GAPA(C1=__builtin_amdgcn_mfma_f32_32x32x16_bf16(kf[3],qr[1],C1,0,0,0),   P0[14],P0[15],P1[0],P1[1],   pw1[2]=PKW(P0,12),pw1[3]=PKW(P0,14), pw1); \
    VRD(2); SBAR(); GAPA(C0=__builtin_amdgcn_mfma_f32_32x32x16_bf16(kf[4],qr[2],C0,0,0,0),   P1[2],P1[3],P1[4],P1[5],     pw2[0]=PKW(P1,0), pw2[1]=PKW(P1,2), pw2); \
    VRD(6); SBAR(); GAPA(C1=__builtin_amdgcn_mfma_f32_32x32x16_bf16(kf[5],qr[2],C1,0,0,0),   P1[6],P1[7],P1[8],P1[9],     pw2[2]=PKW(P1,4), pw2[3]=PKW(P1,6), pw2); \
    VRD(3); SBAR(); GAPA(C0=__builtin_amdgcn_mfma_f32_32x32x16_bf16(kf[6],qr[3],C0,0,0,0),   P1[10],P1[11],P1[12],P1[13], pw3[0]=PKW(P1,8), pw3[1]=PKW(P1,10), pw3); \
    VRD(7); SBAR(); GAPA(C1=__builtin_amdgcn_mfma_f32_32x32x16_bf16(kf[7],qr[3],C1,0,0,0),   P1[14],P1[15],0.f,0.f,       pw3[2]=PKW(P1,12),pw3[3]=PKW(P1,14), pw3); \
    l_reg+=sacc; \
    if(GK){DMA_K((t)+3,sl_cur);} if(GV){DMA_V((t)+1,sl_next);} \
    BIAS(C0,C1,t); SELM(C0,C1,t); CMASK(C0,C1,t); \
    { float a=MX3(C0[0],C0[1],C1[0]),b=MX3(C0[2],C0[3],C1[1]); a=MX3(a,C1[2],C1[3]); \
      _Pragma("unroll") for(int r=4;r<16;r+=4){a=MX3(a,C0[r],C0[r+1]);b=MX3(b,C0[r+2],C0[r+3]);a=MX3(a,C1[r],C1[r+1]);b=MX3(b,C1[r+2],C1[r+3]);} \
      float rm=__builtin_fmaxf(a,b); { auto rr=__builtin_amdgcn_permlane32_swap(__float_as_uint(rm),__float_as_uint(rm),false,false); rm=__builtin_fmaxf(__uint_as_float(rr[0]),__uint_as_float(rr[1])); } \
      resc=false; \
      if(__builtin_expect(__any(rm>(float)THRL),0)){ const float dl=__builtin_fmaxf(rm,0.f); mhat+=dl; \
        _Pragma("unroll") for(int r=0;r<16;++r){C0[r]-=dl;C1[r]-=dl;} \
        _Pragma("unroll") for(int r=0;r<16;++r)negm[r]=-mhat; asm volatile("":"+v"(negm)); \
        const float f=__builtin_amdgcn_exp2f(-dl); l_reg*=f; if(hi==0)wsf[r32]=f; resc=true; } } \
    SBAR(); \
    GAPB(o[0]=__builtin_amdgcn_mfma_f32_32x32x16_bf16(PAF(0),VFR(0),o[0],0,0,0), C0,0); \
    GAPB(o[1]=__builtin_amdgcn_mfma_f32_32x32x16_bf16(PAF(0),VFR(4),o[1],0,0,0), C0,4); \
    KRD(GL,0); GAPB(o[0]=__builtin_amdgcn_mfma_f32_32x32x16_bf16(PAF(1),VFR(1),o[0],0,0,0), C0,8); \
    KRD(GL,1); GAPB(o[1]=__builtin_amdgcn_mfma_f32_32x32x16_bf16(PAF(1),VFR(5),o[1],0,0,0), C0,12); \
    KRD(GL,2); GAPB(o[0]=__builtin_amdgcn_mfma_f32_32x32x16_bf16(PAF(2),VFR(2),o[0],0,0,0), C1,0); \
    KRD(GL,3); GAPB(o[1]=__builtin_amdgcn_mfma_f32_32x32x16_bf16(PAF(2),VFR(6),o[1],0,0,0), C1,4); \
    GAPB(o[0]=__builtin_amdgcn_mfma_f32_32x32x16_bf16(PAF(3),VFR(3),o[0],0,0,0), C1,8); \
    GAPB(o[1]=__builtin_amdgcn_mfma_f32_32x32x16_bf16(PAF(3),VFR(7),o[1],0,0,0), C1,12); \
    }while(0)
  int t=1;
  #undef CMASK
  #define CMASK(P0,P1,t) do{}while(0)
  for(;t+5<NT;t+=2){
    STEP(pB0,pB1,pA0,pA1,t,true,true,true);     WAIT_BAR(2); RESC(); ROT();
    STEP(pA0,pA1,pB0,pB1,t+1,true,true,true);   WAIT_BAR(2); RESC(); ROT();
  }
  #undef CMASK
  #define CMASK(P0,P1,t) do{ if constexpr(MODE==0){int jb_=(t)-(NT-4); if(jb_>=0)cmask(P0,P1,jb_,qrel,hi);} }while(0)
  #define ENDW(tt) do{ if((tt)+3<NT){WAIT_BAR(2);} else if((tt)+2<NT){WAIT_BAR(1);} else {WAIT_BAR(0);} }while(0)
  for(;t+1<NT;t+=2){
    STEP(pB0,pB1,pA0,pA1,t,(t+3<NT),(t+1<NT),(t+1<NT));       ENDW(t);   RESC(); ROT();
    STEP(pA0,pA1,pB0,pB1,t+1,(t+4<NT),(t+2<NT),(t+2<NT));     ENDW(t+1); RESC(); ROT();
  }
  STEP(pB0,pB1,pA0,pA1,NT-1,false,false,false); RESC();
  { float sacc=pB0[0]+pB0[1]; _Pragma("unroll") for(int r=2;r<16;++r)sacc+=pB0[r]; _Pragma("unroll") for(int r=0;r<16;++r)sacc+=pB1[r]; l_reg+=sacc;
    pw0=(u32x4){PKW(pB0,0),PKW(pB0,2),PKW(pB0,4),PKW(pB0,6)};pw1=(u32x4){PKW(pB0,8),PKW(pB0,10),PKW(pB0,12),PKW(pB0,14)};pw2=(u32x4){PKW(pB1,0),PKW(pB1,2),PKW(pB1,4),PKW(pB1,6)};pw3=(u32x4){PKW(pB1,8),PKW(pB1,10),PKW(pB1,12),PKW(pB1,14)};
    SBAR(); pv(o,vb0+sl_cur,PAF(0),PAF(1),PAF(2),PAF(3)); }
  #undef PKW
  #undef PAF
  #undef VFR
  #undef PIN
  #undef MX3
  #undef GAPA
  #undef GAPB
  #undef EX
  #undef VRD
  #undef KRD
  #undef STEP
  #undef ENDW
  {auto rr=__builtin_amdgcn_permlane32_swap(__float_as_uint(l_reg),__float_as_uint(l_reg),false,false);l_reg=__uint_as_float(rr[0])+__uint_as_float(rr[1]);}
  if(hi==0)wsf[32+r32]=l_reg;asm volatile("s_waitcnt lgkmcnt(0)":::"memory");
  float rli[16];
  #pragma unroll
  for(int r=0;r<16;++r)rli[r]=__builtin_amdgcn_rcpf(wsf[32+crow(r,hi)]);
  bf16*Ow=(MODE==0)?O+(rowbase+q0+wid*QBLK)*OPI+h*D:O+(rowbase+q0)*OPI+wid*D;
  { bf16*stg=(bf16*)(shm+LDS_OST)+wid*2048;
    #pragma unroll
    for(int r=0;r<16;++r){const int orow=crow(r,hi);
      #pragma unroll
      for(int d0=0;d0<2;++d0)stg[orow*64+d0*32+r32]=__float2bfloat16(o[d0][r]*rli[r]);}
    asm volatile("s_waitcnt lgkmcnt(0)":::"memory");
    #pragma unroll
    for(int i=0;i<4;++i){const int row=i*8+(lane>>3),ch=lane&7; const u32x4 v=*(const u32x4*)(stg+row*64+ch*8); ATTN_STORE16(Ow+(long)row*OPI+ch*8,v);} }
  asm volatile("s_waitcnt lgkmcnt(0)\n\ts_barrier":::"memory");
  #undef DMA_K
  #undef DMA_V
  #undef CMASK
  #undef START
  #undef BIAS
  #undef SELM
  #undef RESC
  #undef ROT
}
#undef SBAR
#undef WAIT_BAR
}

#ifndef DBG_REP_SEL
#define DBG_REP_SEL 1
#endif
namespace mix {
__device__ __forceinline__ void fox_unit2(int b, int h, int qb, const bf16_t* Z1, const float* F, const float* bfp, bf16_t* Y, char* shm, const int wave_s) {
    const size_t rowb = (size_t)b * SEQ;
    const int nk = 256 * (qb + 1);
    auto cumfn = [=]() {
        const int tid = wave_s * 64 + lane_opaque(), lane = tid & 63; const int wid = __builtin_amdgcn_readfirstlane(tid >> 6);
        MLAS char* L = (MLAS char*)shm;
        MLAS float* cum2 = (MLAS float*)(L + foxa::CUM_OFF);
        MLAS float* wtot = (MLAS float*)(L + foxa::CUM_OFF + 8192);
        const float bias = bfp[h];
        const int s0 = 4 * tid;
        float v[4]; float run = 0.f;
#pragma unroll
        for (int i = 0; i < 4; ++i) {
            float x = 0.f;
            if (s0 + i < nk) x = F[(rowb + s0 + i) * 8 + h] + bias;
            const float ls = (s0 + i < nk) ? (fminf(x, 0.f) - log1pf(expf(-fabsf(x)))) : 0.f;
            run += ls; v[i] = run;
        }
        float inc = run;
#pragma unroll
        for (int o = 1; o < 64; o <<= 1) { const int ln = lane_opaque(); const float t = __builtin_bit_cast(float, __builtin_amdgcn_ds_bpermute((ln - o) << 2, __builtin_bit_cast(int, inc))); if (ln >= o) inc += t; }
        if (lane == 63) wtot[wid] = inc;
        LGKM_BAR();
        float off = inc - run;
        for (int w = 0; w < wid; ++w) off += wtot[w];
#pragma unroll
        for (int i = 0; i < 4; ++i) cum2[s0 + i] = (off + v[i]) * 1.4426950408889634f;
        LGKM_BAR();
    };
    foxa::attn_unit<8, 0, 2560>(cumfn, b, h, qb, 0, 0, (const foxa::bf16*)Z1, (const foxa::bf16*)(Z1 + 512), (const foxa::bf16*)(Z1 + 1024), (foxa::bf16*)Y, shm, nullptr, wave_s);
}
__device__ __forceinline__ void dsa_unit(int b, int qg, const bf16_t* Z0, bf16_t* Y, char* shm, unsigned lds0, const int wave_s) {
    for (int rep_ = 0; rep_ < DBG_REP_SEL; ++rep_) dsa_select(b, qg, Z0, shm, wave_s);
    const int nt64 = (qg >> 1) + 1; int ntu = (nt64 + 1) & ~1; if (ntu < 4) ntu = 4;
    foxa::attn_unit<8, 1, EV_N>([]() {}, b, 0, 0, 32 * qg, ntu, (const foxa::bf16*)(Z0 + 512), (const foxa::bf16*)(Z0 + 1024), (const foxa::bf16*)(Z0 + 1088), (foxa::bf16*)(Y + 512), shm,
                                (const MLAS unsigned*)((MLAS char*)shm + LX_SEL), wave_s);
}
}
constexpr int NWAVES = 8;
constexpr size_t KiB = 1024, MiB = 1u << 20;
constexpr size_t WS_CTL = 0, CTL_ZERO_BYTES = 1 * MiB;
constexpr size_t WS_W_EVIN = 1 * MiB, WS_W_OUT0 = 4 * MiB, WS_W_FFI0 = 6 * MiB, WS_W_FFO0 = 17 * MiB, WS_W_PG0 = 22 * MiB + 512 * KiB, WS_W_PP0 = 24 * MiB + 512 * KiB;
constexpr size_t WS_W_ODIN = 25 * MiB, WS_W_OUT1 = 30 * MiB + 512 * KiB, WS_W_FFI1 = 32 * MiB + 512 * KiB, WS_W_FFO1 = 43 * MiB + 512 * KiB, WS_W_PG1 = 49 * MiB, WS_W_PP1 = 51 * MiB, WS_W_SGU = 51 * MiB + 512 * KiB;
constexpr size_t WS_RSTD = 57 * MiB + 768 * KiB;
constexpr size_t WS_SSQA = 52 * MiB, WS_SSQB = 53 * MiB, WS_ROPE = 54 * MiB, WS_AH = 55 * MiB, WS_FBUF = 58 * MiB + 512 * KiB, WS_SST = 59 * MiB;
constexpr size_t WS_HB = 60 * MiB, WS_AHALO = 92 * MiB, WS_PP = 92 * MiB + 512 * KiB, WS_Y = 124 * MiB + 512 * KiB, WS_ZH = 156 * MiB + 512 * KiB, WS_PB = 244 * MiB + 512 * KiB, WS_END = 252 * MiB + 512 * KiB;
static_assert(WS_AHALO == WS_HB + (size_t)TOK * 1024 * 2, "the halo rows are row tile 64 of the FFN in-projection A operand");
static_assert(WS_W_EVIN + (size_t)EV_N * 1024 * 2 <= WS_W_OUT0 && WS_W_FFI0 + (size_t)NFF2 * 1024 * 2 <= WS_W_FFO0 && WS_W_FFO0 + (size_t)1024 * DFF * 2 <= WS_W_PG0, "ws map 1");
static_assert(WS_W_ODIN + (size_t)OD_N * 1024 * 2 <= WS_W_OUT1 && WS_W_FFI1 + (size_t)NFF2 * 1024 * 2 <= WS_W_FFO1 && WS_W_FFO1 + (size_t)1024 * DFF * 2 <= WS_W_PG1 && WS_W_SGU + 4 * 128 * 128 * 2 <= WS_SSQA, "ws map 2");
static_assert(WS_AH + (size_t)128 * NFF2 * 4 <= WS_RSTD && WS_ZH + (size_t)TOK * DFF * 2 <= WS_PB && WS_PB + (size_t)TOK * PLE * 2 <= WS_END, "ws map 3");
constexpr int CW_BAR = 4096, CW_FLAG = 8192;
constexpr int RING_BYTES = 131072, XB_OFF = RING_BYTES, LDSCTL_OFF = XB_OFF + 8192 + 1024 + 64, MISC_OFF = LDSCTL_OFF + 320, LDS_BYTES = 147456;
static_assert(MISC_OFF + 128 <= LDS_BYTES, "LDS map");

#define GAS __attribute__((address_space(1)))
#define LAS __attribute__((address_space(3)))
typedef unsigned short bf16;
typedef unsigned v4u __attribute__((ext_vector_type(4)));
typedef float f32x4 __attribute__((ext_vector_type(4)));
typedef float f32x2 __attribute__((ext_vector_type(2)));
#define LDS_WAIT() asm volatile("s_waitcnt lgkmcnt(0)" ::: "memory")
#define VM_WAIT() asm volatile("s_waitcnt vmcnt(0)" ::: "memory")
__device__ __forceinline__ unsigned f2bf(float f) { unsigned u = __builtin_bit_cast(unsigned, f); return (u + 0x7fffu + ((u >> 16) & 1u)) >> 16; }
__device__ __forceinline__ unsigned pk2(float lo, float hi) { return f2bf(lo) | (f2bf(hi) << 16); }

#define XB_TMO      128
#define XB_XCNT(j)  (256  + 64 * (j))
#define XB_XSUB(j)  (1280 + 64 * (j))
#define XB_XGEN(j)  (2304 + 64 * (j))
#define XB_TOP      3328
#define XB_TOPGEN   3392
#define XCD_BAR_WORDS 3456
#define XB_SPIN_CAP (1u << 18)
__device__ __forceinline__ unsigned xb_ld(unsigned* p)              { return __hip_atomic_load(p, __ATOMIC_RELAXED, __HIP_MEMORY_SCOPE_AGENT); }
__device__ __forceinline__ unsigned xb_add(unsigned* p, unsigned v) { return __hip_atomic_fetch_add(p, v, __ATOMIC_RELAXED, __HIP_MEMORY_SCOPE_AGENT); }
__device__ __forceinline__ unsigned xb_xcc_id() { return (unsigned)__builtin_amdgcn_s_getreg((3 << 11) | 20) & 0xFu; }
#define XB_SPIN(cond, bar) do { unsigned _sp = 0; while (cond) { __builtin_amdgcn_s_sleep(1); \
    if ((++_sp & 255u) == 0u) { if (xb_ld(&(bar)[XB_TMO])) break; if (_sp > XB_SPIN_CAP) { atomicAdd(&(bar)[XB_TMO], 1u); break; } } } } while (0)
struct XcdBarrier { unsigned* bar; unsigned x; volatile LAS unsigned* st; };
__device__ __forceinline__ XcdBarrier xcd_barrier_post(unsigned* bar, volatile LAS unsigned* st) {
    XcdBarrier b; b.bar = bar; b.x = xb_xcc_id(); b.st = st;
    if (threadIdx.x == 0) (void)xb_add(&bar[XB_XCNT(b.x)], 1u);
    return b;
}
__device__ __forceinline__ void xcd_barrier_complete(unsigned* bar, unsigned x, unsigned& nloc, unsigned& nx) {
    const unsigned G = gridDim.x * gridDim.y * gridDim.z;
    unsigned sum, cnt, mine, sp = 0u;
    for (;;) {
        sum = 0u; cnt = 0u; mine = 0u;
#pragma unroll 1
        for (unsigned j = 0; j < 16; ++j) { const unsigned c = xb_ld(&bar[XB_XCNT(j)]); sum += c; cnt += (c > 0u) ? 1u : 0u; mine = (j == x) ? c : mine; }
        if (sum == G) break;
        __builtin_amdgcn_s_sleep(1);
        if ((++sp & 255u) == 0u) { if (xb_ld(&bar[XB_TMO])) break; if (sp > XB_SPIN_CAP) { atomicAdd(&bar[XB_TMO], 1u); break; } }
    }
    nloc = mine > 0u ? mine : 1u; nx = cnt > 0u ? cnt : 1u;
}
__device__ __forceinline__ void xcd_barrier(const XcdBarrier& b) {
    asm volatile("s_waitcnt vmcnt(0)" ::: "memory");
    __syncthreads();
    if (threadIdx.x == 0) {
        unsigned* bar = b.bar;
        __builtin_amdgcn_s_waitcnt(0);
        unsigned nloc = b.st[0], nx = b.st[1];
        if (nloc == 0u) { xcd_barrier_complete(bar, b.x, nloc, nx); b.st[0] = nloc; b.st[1] = nx; }
        const unsigned old = xb_add(&bar[XB_XSUB(b.x)], 1u);
        const unsigned gen = old / nloc;
        if (old + 1u == (gen + 1u) * nloc) {
            __builtin_amdgcn_fence(__ATOMIC_RELEASE, "agent");
            asm volatile("s_waitcnt vmcnt(0)" ::: "memory");
            const unsigned og = xb_add(&bar[XB_TOP], 1u);
            const unsigned tg = og / nx;
            if (og + 1u == (tg + 1u) * nx) xb_add(&bar[XB_TOPGEN], 1u);
            else XB_SPIN(xb_ld(&bar[XB_TOPGEN]) == tg, bar);
            __builtin_amdgcn_fence(__ATOMIC_ACQUIRE, "agent");
            xb_add(&bar[XB_XGEN(b.x)], 1u);
            asm volatile("s_waitcnt vmcnt(0)" ::: "memory");
        } else {
            XB_SPIN(xb_ld(&bar[XB_XGEN(b.x)]) == gen, bar);
            __builtin_amdgcn_fence(__ATOMIC_ACQUIRE, "agent");
            asm volatile("s_waitcnt vmcnt(0)" ::: "memory");
        }
    }
    __syncthreads();
}

__device__ __forceinline__ float wave_sum(float v) {
#pragma unroll
    for (int o = 1; o < 64; o <<= 1) v += __builtin_bit_cast(float, __builtin_amdgcn_ds_bpermute((lane_opaque() ^ o) << 2, __builtin_bit_cast(int, v)));
    return v;
}
__device__ __forceinline__ int vcu_of(int i, int n) { return i; }
__device__ __forceinline__ int unperm16(int d) { return d < 16 ? ((d >> 1) + 8 * (d & 1)) : d; }
__device__ __forceinline__ int map_col(int type, int n, int nold) {
    if (type == 0) return n < nold ? n : -1;
    if (type == 1) {
        if (n < 512) return n;
        if (n < 1024) { const int h = (n - 512) >> 6, d = (n - 512) & 63; return 512 + 64 * h + unperm16(d); }
        if (n < 1088) return 1024 + unperm16(n - 1024);
        if (n < 1152) return n;
        if (n < 1216) return 1408 + unperm16(n - 1152);
        if (n < 1220) return 1472 + (n - 1216);
        if (n < 1280) return -1;
        { const int h = (n - 1280) >> 6, d = (n - 1280) & 63; return 1152 + 64 * h + unperm16(d); }
    }
    if (type == 2) {
        if (n < 1536) return n;
        if (n < 2560) return n + 8;
        if (n < 2568) return 1536 + (n - 2560);
        return -1;
    }
    { const int pn = n >> 8, bj = (n >> 7) & 1, jj = n & 127; return bj * DFF + 128 * pn + jj; }
}
struct TJob { const float* W; const float* rowscale; bf16* WT; int K, Nold, Nnew, ldk, koff, type, nitems; };
__device__ __forceinline__ void transpose_item(const TJob& J, LAS float* scr, int item, int lane) {
    const int nblk = J.Nnew / 32, kb = item / nblk, nb = item % nblk, k0 = 64 * kb, n0 = 32 * nb;
    const int oc = map_col(J.type, n0 + (lane & 31), J.Nold);
    const int occ = oc >= 0 ? oc : 0;
    float vv[32];
#pragma unroll
    for (int i = 0; i < 32; ++i) vv[i] = J.W[(size_t)(k0 + 2 * i + (lane >> 5)) * J.Nold + occ];
#pragma unroll
    for (int i = 0; i < 32; ++i) { const int kk = 2 * i + (lane >> 5);
        float v = (oc >= 0) ? vv[i] : 0.f;
        if (J.rowscale) v *= J.rowscale[k0 + kk];
        scr[kk * 33 + (lane & 31)] = v; }
    LDS_WAIT(); asm volatile("" ::: "memory");
    const int c = lane & 7;
#pragma unroll
    for (int j = 0; j < 4; ++j) { const int n = (lane >> 3) + 8 * j; const LAS float* s = scr + (8 * c) * 33 + n;
        v4u o; o.x = pk2(s[0 * 33], s[1 * 33]); o.y = pk2(s[2 * 33], s[3 * 33]); o.z = pk2(s[4 * 33], s[5 * 33]); o.w = pk2(s[6 * 33], s[7 * 33]);
        *(GAS v4u*)(J.WT + (size_t)(n0 + n) * J.ldk + J.koff + k0 + 8 * c) = o; }
    LDS_WAIT(); asm volatile("" ::: "memory");
}
__device__ __forceinline__ void sincos_d(double a, float& sn, float& cs) {
    const double q = rint(a * 0.63661977236758134308);
    double r = a - q * 1.57079632673412561417e+00; r -= q * 6.07710050650619224932e-11;
    const double r2 = r * r;
    double s = 1.0 / 6227020800.0; s = s * r2 - 1.0 / 39916800.0; s = s * r2 + 1.0 / 362880.0; s = s * r2 - 1.0 / 5040.0; s = s * r2 + 1.0 / 120.0; s = s * r2 - 1.0 / 6.0; s = s * r2 * r + r;
    double c = -1.0 / 87178291200.0; c = c * r2 + 1.0 / 479001600.0; c = c * r2 - 1.0 / 3628800.0; c = c * r2 + 1.0 / 40320.0; c = c * r2 - 1.0 / 720.0; c = c * r2 + 1.0 / 24.0; c = c * r2 - 0.5; c = c * r2 + 1.0;
    const int qi = ((int)q) & 3;
    const double ss = (qi == 0) ? s : (qi == 1) ? c : (qi == 2) ? -s : -c;
    const double cc = (qi == 0) ? c : (qi == 1) ? -s : (qi == 2) ? -c : s;
    sn = (float)ss; cs = (float)cc;
}

struct Args { const void* in[24]; float* out; unsigned char* ws; int ph_lo, ph_hi; };
typedef const Args __attribute__((address_space(4)))* argp_t;
__device__ __forceinline__ argp_t get_args() { argp_t p = (argp_t)__builtin_amdgcn_kernarg_segment_ptr(); asm volatile("" : "+s"(p)); return p; }
__device__ __forceinline__ int otid(int wave_s) { return wave_s * 64 + lane_opaque(); }
#define IN_F(k) ((const float*)A_->in[k])
#define PH_LOCALS \
    argp_t A_ = get_args(); unsigned char* const ws = A_->ws; float* const out = A_->out; (void)out; \
    const int tid = otid(wave_s), lane = tid & 63, wave = wave_s; (void)lane; (void)wave; \
    const int G = gridDim.x, bx = blockIdx.x, vcu = (G % 8 == 0) ? (bx % 8) * (G / 8) + bx / 8 : bx; (void)vcu; \
    const int gw = vcu * NWAVES + wave, NGW = G * NWAVES, gt = vcu * (NWAVES * 64) + tid, NGT = G * NWAVES * 64; (void)gw; (void)NGW; (void)gt; (void)NGT; \
    LAS unsigned char* const L = (LAS unsigned char*)lds; (void)L;
#define WSP(T, off) ((T*)(ws + (off)))

__global__ void __launch_bounds__(NWAVES * 64, 2) mega_fwd(Args args) {
    extern __shared__ __attribute__((aligned(16))) unsigned char lds[];
    int lo, hi; XcdBarrier bar;
    const int wave_s = __builtin_amdgcn_readfirstlane((int)threadIdx.x >> 6);
    {
        PH_LOCALS
        volatile LAS unsigned* MISC = (volatile LAS unsigned*)(L + MISC_OFF);
        for (int u = tid; u < (LDS_BYTES - XB_OFF) / 4; u += NWAVES * 64) ((LAS unsigned*)(L + XB_OFF))[u] = 0u;
        __syncthreads();
        bar = xcd_barrier_post((unsigned*)(ws + WS_CTL) + CW_BAR, MISC + 8);
        lo = A_->ph_lo; hi = A_->ph_hi;
    }
#ifndef DBG_REP_TR
#define DBG_REP_TR 1
#endif
#ifndef DBG_REP_HB
#define DBG_REP_HB 1
#endif
#ifndef DBG_REP_FOX
#define DBG_REP_FOX 1
#endif
#ifndef DBG_REP_DSA
#define DBG_REP_DSA 1
#endif
#ifndef DBG_REP_SGU
#define DBG_REP_SGU 1
#endif
#ifndef DBG_REP_POOL
#define DBG_REP_POOL 1
#endif
#ifndef PHMASK
#define PHMASK 0xffffffu
#endif
#define IN(k) (((PHMASK >> (k)) & 1u) && lo <= (k) && (k) < hi)
#define SEAM(k) do { if (IN(k) && IN((k) + 1)) xcd_barrier(bar); } while (0)
    if (IN(0)) {
        PH_LOCALS
        LAS float* scr = (LAS float*)(L + wave * 16384);
        const float* norm_mix = IN_F(3); const float* norm_ffn = IN_F(4); const float* norm_ple = IN_F(5);
        const float* ffn_w_in = IN_F(6); const float* ffn_w_out = IN_F(9); const float* ple_w_proj = IN_F(10); const float* ple_w_gate = IN_F(11);
        const float* ev_w_in = IN_F(13); const float* ev_w_out = IN_F(14); const float* od_w_in = IN_F(17); const float* od_w_out = IN_F(18);
#define TJ(Wp, RS, WTp, K_, NOLD, NNEW, LDK, KOFF, TYPE) { constexpr int NI_ = ((K_) / 64) * ((NNEW) / 32); if (r < NI_) { const TJob J{(Wp), (RS), (WTp), (K_), (NOLD), (NNEW), (LDK), (KOFF), (TYPE), NI_}; transpose_item(J, scr, r, lane); continue; } r -= NI_; }
        constexpr int NITEMS = 16 * 48 + 8 * 32 + 44 * 32 + 4 * 32;
        for (int rep_ = 0; rep_ < DBG_REP_TR; ++rep_) for (int it = gw; it < NITEMS; it += NGW) {
            int r = it;
            TJ(ev_w_in, norm_mix, WSP(bf16, WS_W_EVIN), 1024, 1476, EV_N, 1024, 0, 1)
            TJ(ev_w_out + (size_t)512 * 1024, nullptr, WSP(bf16, WS_W_OUT0), 512, 1024, 1024, 1024, 512, 0)
            TJ(ffn_w_out + (size_t)DFF * 1024, nullptr, WSP(bf16, WS_W_FFO1), DFF, 1024, 1024, DFF, 0, 0)
            TJ(ple_w_proj + (size_t)256 * 1024, nullptr, WSP(bf16, WS_W_PP1), 256, 1024, 1024, 256, 0, 0)
        }
#undef TJ
        { const float* sgu_w = IN_F(22); bf16* W_SGU = WSP(bf16, WS_W_SGU);
          for (int i = gt; i < 4 * 128 * 128; i += NGT) { const int jj = i & 127, ii = (i >> 7) & 127; W_SGU[i] = (bf16)((ii < 64 && jj >= 64) ? 0u : f2bf(sgu_w[i])); } }
        { const float* x = IN_F(0); bf16* HB = WSP(bf16, WS_HB); float* SSQA = WSP(float, WS_SSQA);
          for (int m = gw; m < TOK; m += 4 * NGW) {
            f32x4 v[4][4];
#pragma unroll
            for (int q = 0; q < 4; ++q) { const int mm = (m + q * NGW < TOK) ? m + q * NGW : m; const f32x4* xr = (const f32x4*)(x + (size_t)mm * DMODEL) + lane;
#pragma unroll
                for (int j = 0; j < 4; ++j) v[q][j] = xr[64 * j]; }
#pragma unroll
            for (int q = 0; q < 4; ++q) { const int mm = m + q * NGW; if (mm < TOK) {
                float s = 0.f; unsigned long long* o8 = (unsigned long long*)(HB + (size_t)mm * DMODEL) + lane;
#pragma unroll
                for (int j = 0; j < 4; ++j) { const f32x4 w = v[q][j]; s += (w.x * w.x + w.y * w.y) + (w.z * w.z + w.w * w.w);
                    o8[64 * j] = (unsigned long long)pk2(w.x, w.y) | ((unsigned long long)pk2(w.z, w.w) << 32); }
                s = wave_sum(s);
                if (lane < 16) SSQA[(size_t)mm * 16 + lane] = (lane == 0) ? s : 0.f; } }
          } }
        { const float* p_in = IN_F(1); bf16* PB = WSP(bf16, WS_PB);
          for (int i = gt; i < TOK * PLE / 4; i += 4 * NGT) { f32x4 v[4];
#pragma unroll
            for (int q = 0; q < 4; ++q) v[q] = ((const f32x4*)p_in)[(i + q * NGT < TOK * PLE / 4) ? i + q * NGT : i];
#pragma unroll
            for (int q = 0; q < 4; ++q) if (i + q * NGT < TOK * PLE / 4) ((unsigned long long*)PB)[i + q * NGT] = (unsigned long long)pk2(v[q].x, v[q].y) | ((unsigned long long)pk2(v[q].z, v[q].w) << 32); } }
        { const int* positions = (const int*)A_->in[2]; f32x2* ROPE = WSP(f32x2, WS_ROPE);
          for (int i = gt; i < TOK * 8; i += NGT) {
            const int row = i >> 3, j = i & 7;
            const float invf = (j == 0) ? 1.0f : (j == 1) ? 0.1939227432012558f : (j == 2) ? 0.03760603070259094f : (j == 3) ? 0.007292664609849453f : (j == 4) ? 0.0014142135623842478f :
                               (j == 5) ? 0.00027424818836152554f : (j == 6) ? 5.3182957344688475e-05f : 1.0313385246263351e-05f;
            const float ang = (float)positions[row] * invf;
            float sn, cs; sincos_d((double)ang, sn, cs);
            ROPE[i] = (f32x2){cs, sn};
          } }
    }
    SEAM(0);
    if (IN(1)) {
        { PH_LOCALS
          pg8::Gemm g{WSP(bf16, WS_HB), WSP(bf16, WS_W_EVIN), TOK, EV_N, 1024}; pg8::StaticOrder S; S.init(TOK, EV_N, G, bx);
          pg8::EpiEvenIn E{WSP(float, WS_SSQA), WSP(bf16, WS_ZH), WSP(const pg8::f32x2, WS_ROPE)};
          pg8::gemm_phase<pg8::EpiEvenIn, pg8::StaticOrder, true, true>(L, g, S, E, wave_s); }
        if (gridDim.x == 256 && blockIdx.x >= 128) {
            PH_LOCALS
            LAS float* scr = (LAS float*)(L + wave * 16384);
            const float* norm_mix = IN_F(3); const float* norm_ffn = IN_F(4); const float* norm_ple = IN_F(5);
            const float* ffn_w_in = IN_F(6); const float* ffn_w_out = IN_F(9); const float* ple_w_proj = IN_F(10); const float* ple_w_gate = IN_F(11);
            const float* od_w_in = IN_F(17); const float* od_w_out = IN_F(18);
#define TJ(Wp, RS, WTp, K_, NOLD, NNEW, LDK, KOFF, TYPE) { constexpr int NI_ = ((K_) / 64) * ((NNEW) / 32); if (r < NI_) { const TJob J{(Wp), (RS), (WTp), (K_), (NOLD), (NNEW), (LDK), (KOFF), (TYPE), NI_}; transpose_item(J, scr, r, lane); continue; } r -= NI_; }
            constexpr int NITEMS_B = (16 * 176 + 44 * 32 + 16 * 32 + 4 * 32) + 16 * 88 + 16 * 32;
            const int gwb = (vcu_of(bx - 128, 128)) * NWAVES + wave, NGWB = 128 * NWAVES;
            for (int it = gwb; it < NITEMS_B; it += NGWB) {
                int r = it;
                TJ(ffn_w_in, norm_ffn, WSP(bf16, WS_W_FFI0), 1024, NFF2, NFF2, 1024, 0, 3)
                TJ(ffn_w_out, nullptr, WSP(bf16, WS_W_FFO0), DFF, 1024, 1024, DFF, 0, 0)
                TJ(ple_w_gate, norm_ple, WSP(bf16, WS_W_PG0), 1024, 1024, 1024, 1024, 0, 0)
                TJ(ple_w_proj, nullptr, WSP(bf16, WS_W_PP0), 256, 1024, 1024, 256, 0, 0)
                TJ(od_w_in, norm_mix + 1024, WSP(bf16, WS_W_ODIN), 1024, 2568, OD_N, 1024, 0, 2)
                TJ(od_w_out, nullptr, WSP(bf16, WS_W_OUT1), 1024, 1024, 1024, 1024, 0, 0)
            }
#undef TJ
        {
            const float* pool_w = IN_F(15); const float* pool_scale = IN_F(16); const float* ev_w_out = IN_F(14); bf16* W_OUT0 = WSP(bf16, WS_W_OUT0);
            for (int it = gwb; it < 1024; it += NGWB) {
                const int g = it >> 8, nb = (it >> 4) & 15, cb = it & 15, n = 64 * nb + lane;
                float acc[8];
#pragma unroll
                for (int cc = 0; cc < 8; ++cc) acc[cc] = 0.f;
#pragma unroll 1
                for (int d0 = 0; d0 < 128; d0 += 16) {
                    float wv[16];
#pragma unroll
                    for (int e = 0; e < 16; ++e) wv[e] = ev_w_out[(size_t)(128 * g + d0 + e) * 1024 + n] * pool_scale[128 * g + d0 + e];
#pragma unroll
                    for (int cc = 0; cc < 8; ++cc) {
                        const float* pw = pool_w + ((size_t)g * 128 + 8 * cb + cc) * 128 + d0;
#pragma unroll
                        for (int e = 0; e < 16; ++e) acc[cc] += pw[e] * wv[e];
                    }
                }
#pragma unroll
                for (int c2 = 0; c2 < 4; ++c2) *(unsigned*)(W_OUT0 + (size_t)n * 1024 + 128 * g + 8 * cb + 2 * c2) = pk2(acc[2 * c2], acc[2 * c2 + 1]);
            }
        }
        }
    }
    SEAM(1);
    if (IN(2)) {
        { PH_LOCALS
          const bf16* ZH = WSP(bf16, WS_ZH); bf16* Y = WSP(bf16, WS_Y); const unsigned lds0 = (unsigned)(uintptr_t)lds;
          for (int pi = vcu; pi < 256; pi += G) {
            const int b = pi >> 5, s = pi & 31;
#pragma unroll 1
            for (int k = 0; k < 2 * DBG_REP_DSA; ++k) mix::dsa_unit(b, (k & 1) ? s : 63 - s, ZH, Y, (char*)lds, lds0, wave_s);
          } }
        { PH_LOCALS
          const bf16* ZH = WSP(bf16, WS_ZH); bf16* Y = WSP(bf16, WS_Y);
          for (int rep_ = 0; rep_ < DBG_REP_POOL; ++rep_) for (int it = gt; it < TOK * 64; it += NGT) mix::pool_item(it, ZH, Y);
        }
    }
    SEAM(2);
    {
        const size_t s1o = (0 == 0) ? WS_SSQA : WS_SSQB, s2o = (0 == 0) ? WS_SSQB : WS_SSQA, s3o = s1o;
        if (IN(3)) {
            PH_LOCALS
            pg8::Gemm g{WSP(bf16, WS_Y), WSP(bf16, (0 == 0) ? WS_W_OUT0 : WS_W_OUT1), TOK, 1024, 1024}; pg8::StaticOrder S; S.init(TOK, 1024, G, bx);
            pg8::EpiRes E{IN_F(0), nullptr, WSP(bf16, WS_HB), WSP(float, s1o), WSP(bf16, WS_AHALO)};
            pg8::gemm_phase<pg8::EpiRes, pg8::StaticOrder, true, true>(L, g, S, E, wave_s);
        }
        SEAM(3);
        if (IN(3 + 2)) {
            PH_LOCALS
            pg8::Gemm g{WSP(bf16, WS_HB), WSP(bf16, WS_W_FFI0), TOK + 256, NFF2, 1024}; pg8::StaticOrder S; S.init(TOK, NFF2, G, bx);
            if (G == 256 && bx >= 128 && bx < 128 + NFF2 / 256) {
                pg8::OneUnit S1{64, bx - 128, 1};
                pg8::EpiHaloF EH{WSP(float, s1o), WSP(float, WS_AH), (unsigned*)(ws + WS_CTL) + CW_FLAG + 2048 * 0};
                pg8::gemm_phase<pg8::EpiHaloF, pg8::OneUnit, true, true>(L, g, S1, EH, wave_s);
            }
            pg8::EpiFfnIn E{WSP(float, s1o), IN_F(7) + (size_t)0 * 3 * NFF2, IN_F(8) + (size_t)0 * NFF2, WSP(float, WS_AH), WSP(bf16, WS_ZH), (LAS float*)(L + XB_OFF), (unsigned*)(ws + WS_CTL) + CW_FLAG + 2048 * 0, 1u};
            pg8::gemm_phase<pg8::EpiFfnIn, pg8::StaticOrder, true, true>(L, g, S, E, wave_s);
            if (G == 256 && bx >= 150) {
                pg8::Gemm gp{WSP(bf16, WS_PB), WSP(bf16, WS_W_PP0), TOK, 1024, PLE}; pg8::StaticOrder SP; SP.init(TOK, 1024, 106, bx - 150);
                pg8::EpiBf16Plain EP{WSP(bf16, WS_PP), 1024};
                pg8::gemm_phase<pg8::EpiBf16Plain, pg8::StaticOrder, true, true>(L, gp, SP, EP, wave_s);
            }
        }
        SEAM(3 + 2);
        if (IN(3 + 3)) {
            PH_LOCALS
            pg8::Gemm g{WSP(bf16, WS_ZH), WSP(bf16, (0 == 0) ? WS_W_FFO0 : WS_W_FFO1), TOK, 1024, DFF}; pg8::StaticOrder S; S.init(TOK, 1024, G, bx);
            pg8::EpiRes E{nullptr, WSP(bf16, WS_HB), WSP(bf16, WS_HB), WSP(float, s2o), nullptr};
            pg8::gemm_phase<pg8::EpiRes, pg8::StaticOrder, true, true>(L, g, S, E, wave_s);
        }
        SEAM(3 + 3);
        if (IN(3 + 4)) {
            PH_LOCALS
            pg8::Gemm g{WSP(bf16, WS_HB), WSP(bf16, (0 == 0) ? WS_W_PG0 : WS_W_PG1), TOK, 1024, 1024}; pg8::StaticOrder S; S.init(TOK, 1024, G, bx);
            pg8::EpiGate E{WSP(float, s2o), WSP(bf16, WS_HB), WSP(bf16, WS_PP), (bf16*)out, WSP(float, s3o)};
            pg8::gemm_phase<pg8::EpiGate, pg8::StaticOrder, true, true>(L, g, S, E, wave_s);
        }
        SEAM(3 + 4);
    }
    {

            if (IN(8)) {
                { PH_LOCALS
                  pg8::Gemm g{(const bf16*)out, WSP(bf16, WS_W_ODIN), TOK, OD_N, 1024}; pg8::StaticOrder S; S.init(TOK, OD_N, G, bx);
                  pg8::EpiOddIn E{WSP(float, WS_SSQA), WSP(bf16, WS_ZH), WSP(float, WS_FBUF), WSP(float, WS_SST)};
                  pg8::gemm_phase<pg8::EpiOddIn, pg8::StaticOrder, true, true>(L, g, S, E, wave_s); }
                if (gridDim.x == 256 && blockIdx.x >= 192) {
                    PH_LOCALS
                    LAS float* scr = (LAS float*)(L + wave * 16384);
                    const float* norm_ffn = IN_F(4); const float* norm_ple = IN_F(5); const float* ffn_w_in = IN_F(6); const float* ple_w_gate = IN_F(11);
#define TJ(Wp, RS, WTp, K_, NOLD, NNEW, LDK, KOFF, TYPE) { constexpr int NI_ = ((K_) / 64) * ((NNEW) / 32); if (r < NI_) { const TJob J{(Wp), (RS), (WTp), (K_), (NOLD), (NNEW), (LDK), (KOFF), (TYPE), NI_}; transpose_item(J, scr, r, lane); continue; } r -= NI_; }
                    constexpr int NITEMS_C = 16 * 176 + 16 * 32;
                    const int gwc = (bx - 192) * NWAVES + wave, NGWC = 64 * NWAVES;
                    for (int it = gwc; it < NITEMS_C; it += NGWC) {
                        int r = it;
                        TJ(ffn_w_in + (size_t)1024 * NFF2, norm_ffn + 1024, WSP(bf16, WS_W_FFI1), 1024, NFF2, NFF2, 1024, 0, 3)
                        TJ(ple_w_gate + (size_t)1024 * 1024, norm_ple + 1024, WSP(bf16, WS_W_PG1), 1024, 1024, 1024, 1024, 0, 0)
                    }
#undef TJ
                    const float* p1 = IN_F(1) + (size_t)TOK * PLE; bf16* PB = WSP(bf16, WS_PB);
                    const int gtc = (bx - 192) * (NWAVES * 64) + tid, NGTC = 64 * NWAVES * 64;
                    for (int i = gtc; i < TOK * PLE / 4; i += 4 * NGTC) { f32x4 v[4];
#pragma unroll
                        for (int q = 0; q < 4; ++q) v[q] = ((const f32x4*)p1)[(i + q * NGTC < TOK * PLE / 4) ? i + q * NGTC : i];
#pragma unroll
                        for (int q = 0; q < 4; ++q) if (i + q * NGTC < TOK * PLE / 4) ((unsigned long long*)PB)[i + q * NGTC] = (unsigned long long)pk2(v[q].x, v[q].y) | ((unsigned long long)pk2(v[q].z, v[q].w) << 32); }
                }
            }
            SEAM(8);
            if (IN(9)) {
                { PH_LOCALS
                  const bf16* ZH = WSP(bf16, WS_ZH); bf16* Y = WSP(bf16, WS_Y); const unsigned lds0 = (unsigned)(uintptr_t)lds;
                  const float* FBUF = WSP(float, WS_FBUF); const float* fox_b_f = IN_F(19);
                  for (int pi = vcu; pi < 256; pi += G) {
                    const int bh = pi >> 2, s = pi & 3;
#pragma unroll 1
                    for (int k = 0; k < 2 * DBG_REP_FOX; ++k) mix::fox_unit2(bh >> 3, bh & 7, (k & 1) ? s : 7 - s, ZH, FBUF, fox_b_f, Y, (char*)lds, wave_s);
                  } }
                { PH_LOCALS
                  const bf16* ZH = WSP(bf16, WS_ZH); bf16* Y = WSP(bf16, WS_Y);
                  for (int rep_ = 0; rep_ < DBG_REP_SGU; ++rep_) for (int u = vcu; u < 512; u += G) mix::sgu_unit(u >> 6, (u >> 2) & 15, u & 3, ZH, WSP(float, WS_SST), IN_F(20), IN_F(21), WSP(bf16, WS_W_SGU), IN_F(23), Y, (char*)lds, wave_s); }
            }
            SEAM(9);
            }
    {
        const size_t s1o = (1 == 0) ? WS_SSQA : WS_SSQB, s2o = (1 == 0) ? WS_SSQB : WS_SSQA, s3o = s1o;
        if (IN(10)) {
            PH_LOCALS
            pg8::Gemm g{WSP(bf16, WS_Y), WSP(bf16, (1 == 0) ? WS_W_OUT0 : WS_W_OUT1), TOK, 1024, 1024}; pg8::StaticOrder S; S.init(TOK, 1024, G, bx);
            pg8::EpiRes E{nullptr, (const bf16*)out, WSP(bf16, WS_HB), WSP(float, s1o), WSP(bf16, WS_AHALO)};
            pg8::gemm_phase<pg8::EpiRes, pg8::StaticOrder, true, true>(L, g, S, E, wave_s);
        }
        SEAM(10);
        if (IN(10 + 2)) {
            PH_LOCALS
            pg8::Gemm g{WSP(bf16, WS_HB), WSP(bf16, WS_W_FFI1), TOK + 256, NFF2, 1024}; pg8::StaticOrder S; S.init(TOK, NFF2, G, bx);
            if (G == 256 && bx >= 128 && bx < 128 + NFF2 / 256) {
                pg8::OneUnit S1{64, bx - 128, 1};
                pg8::EpiHaloF EH{WSP(float, s1o), WSP(float, WS_AH), (unsigned*)(ws + WS_CTL) + CW_FLAG + 2048 * 1};
                pg8::gemm_phase<pg8::EpiHaloF, pg8::OneUnit, true, true>(L, g, S1, EH, wave_s);
            }
            pg8::EpiFfnIn E{WSP(float, s1o), IN_F(7) + (size_t)1 * 3 * NFF2, IN_F(8) + (size_t)1 * NFF2, WSP(float, WS_AH), WSP(bf16, WS_ZH), (LAS float*)(L + XB_OFF), (unsigned*)(ws + WS_CTL) + CW_FLAG + 2048 * 1, 2u};
            pg8::gemm_phase<pg8::EpiFfnIn, pg8::StaticOrder, true, true>(L, g, S, E, wave_s);
            if (G == 256 && bx >= 150) {
                pg8::Gemm gp{WSP(bf16, WS_PB), WSP(bf16, WS_W_PP1), TOK, 1024, PLE}; pg8::StaticOrder SP; SP.init(TOK, 1024, 106, bx - 150);
                pg8::EpiBf16Plain EP{WSP(bf16, WS_PP), 1024};
                pg8::gemm_phase<pg8::EpiBf16Plain, pg8::StaticOrder, true, true>(L, gp, SP, EP, wave_s);
            }
        }
        SEAM(10 + 2);
        if (IN(10 + 3)) {
            PH_LOCALS
            pg8::Gemm g{WSP(bf16, WS_ZH), WSP(bf16, (1 == 0) ? WS_W_FFO0 : WS_W_FFO1), TOK, 1024, DFF}; pg8::StaticOrder S; S.init(TOK, 1024, G, bx);
            pg8::EpiRes E{nullptr, WSP(bf16, WS_HB), WSP(bf16, WS_HB), WSP(float, s2o), nullptr};
            pg8::gemm_phase<pg8::EpiRes, pg8::StaticOrder, true, true>(L, g, S, E, wave_s);
        }
        SEAM(10 + 3);
        if (IN(10 + 4)) {
            PH_LOCALS
            pg8::Gemm g{WSP(bf16, WS_HB), WSP(bf16, (1 == 0) ? WS_W_PG0 : WS_W_PG1), TOK, 1024, 1024}; pg8::StaticOrder S; S.init(TOK, 1024, G, bx);
            pg8::EpiGate E{WSP(float, s2o), WSP(bf16, WS_HB), WSP(bf16, WS_PP), WSP(bf16, WS_Y), WSP(float, s3o)};
            pg8::gemm_phase<pg8::EpiGate, pg8::StaticOrder, true, true>(L, g, S, E, wave_s);
        }
        SEAM(10 + 4);
    }
    if (IN(15)) {
        PH_LOCALS
        const float* SSQB = WSP(float, WS_SSQB); const float* norm_final = IN_F(12); const bf16* H6 = WSP(bf16, WS_Y);
        for (int m = gw; m < TOK; m += 4 * NGW) {
            unsigned long long w[4][4]; float rs[4];
#pragma unroll
            for (int q = 0; q < 4; ++q) { const int mm = (m + q * NGW < TOK) ? m + q * NGW : m; rs[q] = pg8::row_rstd(SSQB, mm);
                const unsigned long long* hr = (const unsigned long long*)(H6 + (size_t)mm * DMODEL) + lane;
#pragma unroll
                for (int j = 0; j < 4; ++j) w[q][j] = hr[64 * j]; }
            const f32x4* gr = (const f32x4*)norm_final + lane;
            f32x4 gg[4];
#pragma unroll
            for (int j = 0; j < 4; ++j) gg[j] = gr[64 * j];
#pragma unroll
            for (int q = 0; q < 4; ++q) { const int mm = m + q * NGW; if (mm < TOK) { f32x4* xr = (f32x4*)(out + (size_t)mm * DMODEL) + lane;
#pragma unroll
                for (int j = 0; j < 4; ++j) { const unsigned long long ww = w[q][j];
                    const f32x4 v = {pg8::bf_lo((unsigned)ww), pg8::bf_hi((unsigned)ww), pg8::bf_lo((unsigned)(ww >> 32)), pg8::bf_hi((unsigned)(ww >> 32))};
                    __builtin_nontemporal_store(v * rs[q] * gg[j], xr + 64 * j); } } }
        }
    }
#undef IN
#undef SEAM
}

#ifndef MK_N_LAUNCHES
#define MK_N_LAUNCHES 1
#endif
constexpr int N_PHASES = 16;
extern "C" void kernel_launch(void* const* d_in, const int* in_sizes, int n_in, void* d_out, int out_size, void* d_ws, size_t ws_size, hipStream_t stream) {
    static int grid = 0;
    if (grid == 0) {
        if (n_in != 24 || out_size != TOK * DMODEL || ws_size < WS_END) { fprintf(stderr, "kernel_launch: unexpected shapes (n_in %d, out %d, ws %zu)\n", n_in, out_size, ws_size); grid = -1; return; }
        int dev = 0, cus = 0;
        if (hipGetDevice(&dev) != hipSuccess || hipDeviceGetAttribute(&cus, hipDeviceAttributeMultiprocessorCount, dev) != hipSuccess) { grid = -1; return; }
        if (hipFuncSetAttribute((const void*)mega_fwd, hipFuncAttributeMaxDynamicSharedMemorySize, LDS_BYTES) != hipSuccess) { fprintf(stderr, "kernel_launch: hipFuncSetAttribute failed\n"); grid = -1; return; }
        int per_cu = 0;
        if (hipOccupancyMaxActiveBlocksPerMultiprocessor(&per_cu, (const void*)mega_fwd, NWAVES * 64, LDS_BYTES) != hipSuccess || per_cu < 1) { fprintf(stderr, "kernel_launch: occupancy query says %d\n", per_cu); }
        (void)hipGetLastError();
        grid = cus;
    }
    if (grid < 0) return;
    (void)hipMemsetAsync((char*)d_ws + WS_CTL, 0, CTL_ZERO_BYTES, stream);
    Args a{};
    for (int i = 0; i < 24; ++i) a.in[i] = d_in[i];
    a.out = (float*)d_out; a.ws = (unsigned char*)d_ws;
#ifdef DBG_CHECK
    {
        using namespace dbg;
        auto LP = [&](int ph) { a.ph_lo = ph; a.ph_hi = ph + 1; hipLaunchKernelGGL(mega_fwd, dim3(grid), dim3(NWAVES * 64), LDS_BYTES, stream, a); };
        char* wsb = (char*)d_ws; float* ERR = (float*)(wsb + 512 * 1024); float* SNAP = (float*)(wsb + 600 * 1024); float* outp = (float*)d_out;
        const unsigned short* ZHp = (const unsigned short*)(wsb + WS_ZH); const unsigned short* Yp = (const unsigned short*)(wsb + WS_Y); const float* FB = (const float*)(wsb + WS_FBUF);
        const unsigned short* HBp = (const unsigned short*)(wsb + WS_HB); const unsigned short* H3p = (const unsigned short*)d_out;
        auto F = [&](int i) { return (const float*)d_in[i]; };
        const float* x = F(0);
        LP(0); LP(1);
        k_evenin<<<NS, 256, 0, stream>>>(x, F(3), F(13), (const int*)d_in[2], ZHp, ERR, 0);
        LP(2);
        k_pool<<<NS, 256, 0, stream>>>(ZHp, Yp, ERR, 1);
        k_dsa<<<NS, 256, 0, stream>>>(ZHp, Yp, ERR, 2);
        LP(3);
        k_outproj<<<NS, 256, 0, stream>>>(x, 0, SNAP, Yp, F(14), F(15), F(16), HBp, ERR, 3);
        for (int layer = 0; layer < 2; ++layer) {
            const int pb = layer ? 10 : 3, kb = layer ? 10 : 3;
            if (layer == 1) {
                LP(8);
                k_oddin<<<NS, 256, 0, stream>>>(H3p, F(3) + 1024, F(17), ZHp, FB, ERR, 7);
                LP(9);
                k_fox<<<NS, 256, 0, stream>>>(ZHp, FB, F(19), Yp, ERR, 8);
                k_sgu<<<NS, 256, 0, stream>>>(ZHp, F(20), F(21), F(22), F(23), Yp, ERR, 9);
                k_snap<<<NS, 256, 0, stream>>>(H3p, SNAP);
                LP(10);
                k_outproj<<<NS, 256, 0, stream>>>(nullptr, 1, SNAP, Yp, F(18), nullptr, nullptr, HBp, ERR, 10);
            }
            LP(pb + 1); LP(pb + 2);
            k_ffnin<<<NS, 256, 0, stream>>>(HBp, F(4) + 1024 * layer, F(6) + (size_t)layer * 1024 * NFF2, F(7) + (size_t)layer * 3 * NFF2, F(8) + (size_t)layer * NFF2, ZHp, ERR, kb + 1);
            k_snap<<<NS, 256, 0, stream>>>(HBp, SNAP);
            LP(pb + 3);
            k_ffnout<<<NS, 256, 0, stream>>>(SNAP, ZHp, F(9) + (size_t)layer * DFF * 1024, HBp, ERR, kb + 2);
            k_snap<<<NS, 256, 0, stream>>>(HBp, SNAP);
            LP(pb + 4);
            k_ple<<<NS, 256, 0, stream>>>(SNAP, F(1) + (size_t)layer * TOK * PLE, F(5) + 1024 * layer, F(10) + (size_t)layer * PLE * 1024, F(11) + (size_t)layer * 1024 * 1024, layer ? Yp : H3p, ERR, kb + 3);
        }
        k_snap<<<NS, 256, 0, stream>>>(Yp, SNAP);
        LP(15);
        k_final<<<NS, 256, 0, stream>>>(SNAP, F(12), outp, ERR, 14);
        t_dpp<<<1, 64, 0, stream>>>(ERR + 40);
        k_report<<<1024, 256, 0, stream>>>(ERR, 15, DBG_TOL, outp);
        return;
    }
#endif
    if (MK_N_LAUNCHES == 1) {
        a.ph_lo = 0; a.ph_hi = N_PHASES;
        hipLaunchKernelGGL(mega_fwd, dim3(grid), dim3(NWAVES * 64), LDS_BYTES, stream, a);
    } else {
#ifndef DBG_STOP
#define DBG_STOP N_PHASES
#endif
#ifndef DBG_DOUBLE
#define DBG_DOUBLE -1
#endif
        for (int ph = 0; ph < DBG_STOP; ++ph) { a.ph_lo = ph; a.ph_hi = ph + 1; const int reps = (ph == DBG_DOUBLE || (DBG_DOUBLE == 100 && (ph == 0 || ph == 1 || ph == 2 || ph == 4 || ph == 5 || ph == 8 || ph == 9 || ph == 11 || ph == 12))) ? 2 : 1;
            for (int r = 0; r < reps; ++r) hipLaunchKernelGGL(mega_fwd, dim3(grid), dim3(NWAVES * 64), LDS_BYTES, stream, a); }
    }
}
```

```cpp
#include <hip/hip_runtime.h>
#include <hip/hip_bf16.h>
#include <cstdio>
#include <cstdint>
#include <cmath>
constexpr int TOK = 16384, DMODEL = 1024, SEQ = 2048, NBATCH = 8;
constexpr int DFF = 2816, NFF2 = 5632, PLE = 256;
constexpr int EV_N = 1536;
constexpr int OD_N = 2816;
constexpr int Z1P = 2560;
constexpr float RMS_EPS = 1e-6f;
constexpr float C2 = 0.125f * 1.4426950408889634f;


__device__ __forceinline__ int lane_opaque() { unsigned z = 0u; asm volatile("" : "+v"(z)); return (int)__builtin_amdgcn_mbcnt_hi(~0u, __builtin_amdgcn_mbcnt_lo(~0u, z)); }
__device__ __forceinline__ float xor16_f(float v) { return __builtin_bit_cast(float, __builtin_amdgcn_ds_swizzle(__builtin_bit_cast(int, v), 0x401F)); }
__device__ __forceinline__ void halves_pair(unsigned v, unsigned& a, unsigned& b) { unsigned w = v; asm volatile("" : "+v"(w)); auto rr = __builtin_amdgcn_permlane32_swap(v, w, false, false); a = rr[0]; b = rr[1]; }
__device__ __forceinline__ float halves_sum_f(float v) { unsigned a, b; halves_pair(__builtin_bit_cast(unsigned, v), a, b); return __builtin_bit_cast(float, a) + __builtin_bit_cast(float, b); }
__device__ __forceinline__ float halves_max_f(float v) { unsigned a, b; halves_pair(__builtin_bit_cast(unsigned, v), a, b); return __builtin_fmaxf(__builtin_bit_cast(float, a), __builtin_bit_cast(float, b)); }
__device__ __forceinline__ unsigned halves_add_u(unsigned v) { unsigned a, b; halves_pair(v, a, b); return a + b; }
__device__ __forceinline__ unsigned halves_or_u(unsigned v) { unsigned a, b; halves_pair(v, a, b); return a | b; }
namespace pg8 {
#define PG8_LAS __attribute__((address_space(3)))
typedef unsigned short bf16_t;
typedef short bf16x8 __attribute__((ext_vector_type(8)));
typedef float f32x4 __attribute__((ext_vector_type(4)));
typedef unsigned u32x4 __attribute__((ext_vector_type(4)));
constexpr int BM = 256, BK = 64, HALF = 128, HTB = HALF * BK * 2  , STAGE_BYTES = 8 * HTB, NXCD = 8, WGM = 8;

__host__ __device__ __forceinline__ int lds_byte(int r, int c) { const int st = (r >> 4) * 2 + (c >> 5), rr = r & 15, cc = c & 31, ob = rr * 64 + cc * 2; return st * 1024 + (ob ^ (((ob >> 9) & 1) << 5)); }
__host__ __device__ __forceinline__ void stage_rc(int b, int& R, int& C) { const int st = b / 1024, sb = b % 1024, swz = sb ^ (((sb >> 9) & 1) << 5); R = (st >> 1) * 16 + swz / 64; C = (st & 1) * 32 + (swz % 64) / 2; }
__host__ __device__ __forceinline__ int perm32(int rho) { const int n = rho >> 4, i = rho & 15; return 8 * (i >> 2) + 4 * n + (i & 3); }

struct Unit { int pm, pn; };
struct Gemm { const bf16_t* A; const bf16_t* Bt; int M, N, K; };

struct StaticOrder {
    int nM, nN, nwg, G, c;
    __host__ __device__ void init(int M, int N, int G_, int c_) { nM = M / BM; nN = N / BM; nwg = nM * nN; G = G_; c = c_; }
    __host__ __device__ bool next(int i, Unit& u) const {
        const long L = (long)i * G + c; if (L >= nwg) return false;
        int wgid = (int)L; { const int q = nwg / NXCD, r = nwg % NXCD, xcd = wgid % NXCD, off = wgid / NXCD; wgid = (xcd < r ? xcd * (q + 1) : r * (q + 1) + (xcd - r) * q) + off; }
        const int nig = WGM * nN, gid = wgid / nig, fm = gid * WGM, gsz = (nM - fm) < WGM ? (nM - fm) : WGM;
        u.pm = fm + ((wgid % nig) % gsz); u.pn = (wgid % nig) / gsz; return true;
    }
    __device__ __forceinline__ void a_ready(const Unit&) const {}
    __device__ __forceinline__ void done(const Unit&) const {}
};

struct OneUnit {
    int pm, pn, on;
    __host__ __device__ bool next(int i, Unit& u) const { if (!on || i != 0) return false; u.pm = pm; u.pn = pn; return true; }
    __device__ __forceinline__ void a_ready(const Unit&) const {}
    __device__ __forceinline__ void done(const Unit&) const {}
};
struct FfnOrder {
    StaticOrder S0; int extra;
    __host__ __device__ void init(int M, int N, int G_, int c_) { S0.init(M, N, G_, c_); extra = (G_ == 256 && c_ >= 128 && c_ < 128 + N / BM) ? 1 : 0; }
    __host__ __device__ bool next(int i, Unit& u) const { if (extra) { if (i == 0) { u.pm = 64; u.pn = S0.c - 128; return true; } return S0.next(i - 1, u); } return S0.next(i, u); }
    __device__ __forceinline__ void a_ready(const Unit&) const {}
    __device__ __forceinline__ void done(const Unit&) const {}
};
typedef float f32x2 __attribute__((ext_vector_type(2)));
typedef unsigned u32x2 __attribute__((ext_vector_type(2)));
__device__ __forceinline__ unsigned cvt_pk_bf16(float lo, float hi) { unsigned r; asm volatile("v_cvt_pk_bf16_f32 %0, %1, %2" : "=v"(r) : "v"(lo), "v"(hi)); return r; }
__device__ __forceinline__ float bf_lo(unsigned w) { return __builtin_bit_cast(float, w << 16); }
__device__ __forceinline__ float bf_hi(unsigned w) { return __builtin_bit_cast(float, w & 0xffff0000u); }
__device__ __forceinline__ float sq4(const f32x4 v) { return (v[0] * v[0] + v[1] * v[1]) + (v[2] * v[2] + v[3] * v[3]); }
__device__ __forceinline__ float row_rstd(const float* ssq, int row) {
    const f32x4* p = (const f32x4*)(ssq + (size_t)row * 16);
    const f32x4 a = p[0], b = p[1], c = p[2], d = p[3];
    const float s = (((a[0] + a[1]) + (a[2] + a[3])) + ((b[0] + b[1]) + (b[2] + b[3]))) + (((c[0] + c[1]) + (c[2] + c[3])) + ((d[0] + d[1]) + (d[2] + d[3])));
    return 1.0f / sqrtf(s * (1.0f / 1024.0f) + RMS_EPS);
}
__device__ __forceinline__ void ssq_write(float* ssq_out, float q, int row, int slot, int fq) {
    q += xor16_f(q); q = halves_sum_f(q);
    if (fq == 0) ssq_out[(size_t)row * 16 + slot] = q;
}
__device__ __forceinline__ float gelu_tanh(float x) {
    const float t = x + 0.044715f * x * x * x;
    const float e = __builtin_amdgcn_exp2f(-2.3022082f * t);
    return x * __builtin_amdgcn_rcpf(1.0f + e);
}
__device__ __forceinline__ float sigmoid_f(float x) { return __builtin_amdgcn_rcpf(1.0f + __builtin_amdgcn_exp2f(-1.4426950408889634f * x)); }


struct EpiRes {
    static constexpr bool PERM = true, AFTER_DRAIN = false;
    const float* basef; const bf16_t* baseb; bf16_t* hb; float* ssq_out; bf16_t* ahalo;
    __device__ __forceinline__ void operator()(const f32x4 (&acc)[2][2][4][2], const Unit& u_, int wr, int wc, int fr, int fq) const {
        Unit u; { int pm_ = u_.pm, pn_ = u_.pn; asm volatile("" : "+s"(pm_), "+s"(pn_)); u.pm = pm_; u.pn = pn_; }
        const int row0 = u.pm * BM + wr * 64 + fr, col0 = u.pn * BM + wc * 32 + 8 * fq;
        if (basef != nullptr) {
#pragma unroll
            for (int ai = 0; ai < 2; ++ai)
#pragma unroll
                for (int m = 0; m < 4; ++m) {
                    const int row = row0 + ai * HALF + m * 16; float q = 0.f;
#pragma unroll
                    for (int bj = 0; bj < 2; ++bj) {
                        const size_t off = (size_t)row * DMODEL + col0 + bj * HALF;
                        const f32x4 b0 = *(const f32x4*)(basef + off), b1 = *(const f32x4*)(basef + off + 4);
                        const f32x4 v0 = acc[ai][bj][m][0] + b0, v1 = acc[ai][bj][m][1] + b1;
                        q += sq4(v0) + sq4(v1);
                        u32x4 w; w.x = cvt_pk_bf16(v0[0], v0[1]); w.y = cvt_pk_bf16(v0[2], v0[3]); w.z = cvt_pk_bf16(v1[0], v1[1]); w.w = cvt_pk_bf16(v1[2], v1[3]);
                        *(u32x4*)(hb + off) = w;
                        if (ahalo != nullptr && ai == 1 && m == 3) {
                            const int rl = row & 255;
                            if (rl >= 254 && u.pm < 63) *(u32x4*)(ahalo + (size_t)(2 * (u.pm + 1) + (rl - 254)) * DMODEL + col0 + bj * HALF) = w;
                        }
                    }
                    ssq_write(ssq_out, q, row, u.pn * 4 + wc, fq);
                    if (m & 1) asm volatile("" ::: "memory");
                }
        } else {
#pragma unroll
            for (int ai = 0; ai < 2; ++ai) {
                u32x4 bw[4][2];
#pragma unroll
                for (int m = 0; m < 4; ++m)
#pragma unroll
                    for (int bj = 0; bj < 2; ++bj) bw[m][bj] = *(const u32x4*)(baseb + (size_t)(row0 + ai * HALF + m * 16) * DMODEL + col0 + bj * HALF);
                asm volatile("" ::: "memory");
#pragma unroll
                for (int m = 0; m < 4; ++m) {
                    const int row = row0 + ai * HALF + m * 16; float q = 0.f;
#pragma unroll
                    for (int bj = 0; bj < 2; ++bj) {
                        const size_t off = (size_t)row * DMODEL + col0 + bj * HALF;
                        const u32x4 pw = bw[m][bj];
                        const f32x4 b0 = {bf_lo(pw.x), bf_hi(pw.x), bf_lo(pw.y), bf_hi(pw.y)}, b1 = {bf_lo(pw.z), bf_hi(pw.z), bf_lo(pw.w), bf_hi(pw.w)};
                        const f32x4 v0 = acc[ai][bj][m][0] + b0, v1 = acc[ai][bj][m][1] + b1;
                        q += sq4(v0) + sq4(v1);
                        u32x4 w; w.x = cvt_pk_bf16(v0[0], v0[1]); w.y = cvt_pk_bf16(v0[2], v0[3]); w.z = cvt_pk_bf16(v1[0], v1[1]); w.w = cvt_pk_bf16(v1[2], v1[3]);
                        *(u32x4*)(hb + off) = w;
                        if (ahalo != nullptr && ai == 1 && m == 3) {
                            const int rl = row & 255;
                            if (rl >= 254 && u.pm < 63) *(u32x4*)(ahalo + (size_t)(2 * (u.pm + 1) + (rl - 254)) * DMODEL + col0 + bj * HALF) = w;
                        }
                    }
                    ssq_write(ssq_out, q, row, u.pn * 4 + wc, fq);
                }
                asm volatile("" ::: "memory");
            }
        }
    }
};
struct EpiGate {
    static constexpr bool PERM = true, AFTER_DRAIN = false;
    const float* ssq_in; const bf16_t* base; const bf16_t* pp; bf16_t* dst; float* ssq_out;
    __device__ __forceinline__ void operator()(const f32x4 (&acc)[2][2][4][2], const Unit& u_, int wr, int wc, int fr, int fq) const {
        Unit u; { int pm_ = u_.pm, pn_ = u_.pn; asm volatile("" : "+s"(pm_), "+s"(pn_)); u.pm = pm_; u.pn = pn_; }
        const int row0 = u.pm * BM + wr * 64 + fr, col0 = u.pn * BM + wc * 32 + 8 * fq;
#pragma unroll
        for (int ai = 0; ai < 2; ++ai)
#pragma unroll
            for (int mp = 0; mp < 2; ++mp) {
                u32x4 bw[2][2], pq[2][2]; float rs[2];
#pragma unroll
                for (int mi = 0; mi < 2; ++mi) {
                    const int row = row0 + ai * HALF + (2 * mp + mi) * 16;
#pragma unroll
                    for (int bj = 0; bj < 2; ++bj) { const size_t off = (size_t)row * DMODEL + col0 + bj * HALF; bw[mi][bj] = *(const u32x4*)(base + off); pq[mi][bj] = *(const u32x4*)(pp + off); }
                }
#pragma unroll
                for (int mi = 0; mi < 2; ++mi) rs[mi] = row_rstd(ssq_in, row0 + ai * HALF + (2 * mp + mi) * 16);
                asm volatile("" ::: "memory");
#pragma unroll
                for (int mi = 0; mi < 2; ++mi) {
                    const int m = 2 * mp + mi; const int row = row0 + ai * HALF + m * 16; float q = 0.f;
#pragma unroll
                    for (int bj = 0; bj < 2; ++bj) {
                        const size_t off = (size_t)row * DMODEL + col0 + bj * HALF;
                        const u32x4 b_ = bw[mi][bj], p_ = pq[mi][bj];
                        const float bb[8] = {bf_lo(b_.x), bf_hi(b_.x), bf_lo(b_.y), bf_hi(b_.y), bf_lo(b_.z), bf_hi(b_.z), bf_lo(b_.w), bf_hi(b_.w)};
                        const float pv[8] = {bf_lo(p_.x), bf_hi(p_.x), bf_lo(p_.y), bf_hi(p_.y), bf_lo(p_.z), bf_hi(p_.z), bf_lo(p_.w), bf_hi(p_.w)};
                        const f32x4 g0 = acc[ai][bj][m][0] * rs[mi], g1 = acc[ai][bj][m][1] * rs[mi];
                        const float gg[8] = {g0[0], g0[1], g0[2], g0[3], g1[0], g1[1], g1[2], g1[3]};
                        float v[8];
#pragma unroll
                        for (int i = 0; i < 8; ++i) { v[i] = bb[i] + pv[i] * sigmoid_f(gg[i]); q += v[i] * v[i]; }
                        u32x4 w; w.x = cvt_pk_bf16(v[0], v[1]); w.y = cvt_pk_bf16(v[2], v[3]); w.z = cvt_pk_bf16(v[4], v[5]); w.w = cvt_pk_bf16(v[6], v[7]);
                        *(u32x4*)(dst + off) = w;
                    }
                    ssq_write(ssq_out, q, row, u.pn * 4 + wc, fq);
                }
                asm volatile("" ::: "memory");
            }
    }
};
struct EpiBf16Plain {
    static constexpr bool PERM = true, AFTER_DRAIN = false;
    bf16_t* O; int ldc;
    __device__ __forceinline__ void operator()(const f32x4 (&acc)[2][2][4][2], const Unit& u_, int wr, int wc, int fr, int fq) const {
        Unit u; { int pm_ = u_.pm, pn_ = u_.pn; asm volatile("" : "+s"(pm_), "+s"(pn_)); u.pm = pm_; u.pn = pn_; }
        const int row0 = u.pm * BM + wr * 64 + fr, col0 = u.pn * BM + wc * 32 + 8 * fq;
#pragma unroll
        for (int ai = 0; ai < 2; ++ai)
#pragma unroll
            for (int m = 0; m < 4; ++m) {
                const int row = row0 + ai * HALF + m * 16;
#pragma unroll
                for (int bj = 0; bj < 2; ++bj) {
                    const f32x4 v0 = acc[ai][bj][m][0], v1 = acc[ai][bj][m][1];
                    u32x4 w; w.x = cvt_pk_bf16(v0[0], v0[1]); w.y = cvt_pk_bf16(v0[2], v0[3]); w.z = cvt_pk_bf16(v1[0], v1[1]); w.w = cvt_pk_bf16(v1[2], v1[3]);
                    *(u32x4*)(O + (size_t)row * ldc + col0 + bj * HALF) = w;
                }
            }
    }
};
struct EpiEvenIn {
    static constexpr bool PERM = true, AFTER_DRAIN = false;
    const float* ssq_in; bf16_t* Z; const f32x2* rope;
    __device__ __forceinline__ void operator()(const f32x4 (&acc)[2][2][4][2], const Unit& u_, int wr, int wc, int fr, int fq) const {
        Unit u; { int pm_ = u_.pm, pn_ = u_.pn; asm volatile("" : "+s"(pm_), "+s"(pn_)); u.pm = pm_; u.pn = pn_; }
        const int row0 = u.pm * BM + wr * 64 + fr, colw = wc * 32 + 8 * fq;
        const int pn = u.pn;
        const float sc = (pn == 2 || pn == 3) ? C2 : 1.0f;
#pragma unroll
        for (int ai = 0; ai < 2; ++ai)
#pragma unroll
            for (int m = 0; m < 4; ++m) {
                const int row = row0 + ai * HALF + m * 16;
                const float rs = row_rstd(ssq_in, row);
#pragma unroll
                for (int bj = 0; bj < 2; ++bj) {
                    const int gi = 2 * bj + (wc >> 1);
                    const bool ropeg = (pn == 2 || pn == 3 || pn == 5 || (pn == 4 && (gi == 0 || gi == 2))) && ((wc & 1) == 0);
                    f32x4 v0 = acc[ai][bj][m][0] * rs, v1 = acc[ai][bj][m][1] * rs;
                    if (ropeg && fq < 2) {
                        const f32x4* rp = (const f32x4*)(rope + (size_t)row * 8 + 4 * fq);
                        const f32x4 ra = rp[0], rb = rp[1];
                        f32x4 o0, o1;
                        o0[0] = v0[0] * ra[0] - v0[1] * ra[1]; o0[1] = v0[1] * ra[0] + v0[0] * ra[1];
                        o0[2] = v0[2] * ra[2] - v0[3] * ra[3]; o0[3] = v0[3] * ra[2] + v0[2] * ra[3];
                        o1[0] = v1[0] * rb[0] - v1[1] * rb[1]; o1[1] = v1[1] * rb[0] + v1[0] * rb[1];
                        o1[2] = v1[2] * rb[2] - v1[3] * rb[3]; o1[3] = v1[3] * rb[2] + v1[2] * rb[3];
                        v0 = o0; v1 = o1;
                    }
                    v0 = v0 * sc; v1 = v1 * sc;
                    u32x4 w; w.x = cvt_pk_bf16(v0[0], v0[1]); w.y = cvt_pk_bf16(v0[2], v0[3]); w.z = cvt_pk_bf16(v1[0], v1[1]); w.w = cvt_pk_bf16(v1[2], v1[3]);
                    *(u32x4*)(Z + (size_t)row * EV_N + pn * BM + bj * HALF + colw) = w;
                }
            }
    }
};
struct EpiOddIn {
    static constexpr bool PERM = true, AFTER_DRAIN = false;
    const float* ssq_in; bf16_t* Z; float* F; float* sst;
    __device__ __forceinline__ void operator()(const f32x4 (&acc)[2][2][4][2], const Unit& u_, int wr, int wc, int fr, int fq) const {
        Unit u; { int pm_ = u_.pm, pn_ = u_.pn; asm volatile("" : "+s"(pm_), "+s"(pn_)); u.pm = pm_; u.pn = pn_; }
        const int row0 = u.pm * BM + wr * 64 + fr, colw = wc * 32 + 8 * fq;
        const int pn = u.pn;
        const float sc = (pn < 2) ? C2 : 1.0f;
        const bool act = (pn >= 6 && pn < 10), stat = (pn == 8 || pn == 9);
#pragma unroll
        for (int ai = 0; ai < 2; ++ai)
#pragma unroll
            for (int m = 0; m < 4; ++m) {
                const int row = row0 + ai * HALF + m * 16;
                const float rs = row_rstd(ssq_in, row);
                if (pn == 10) {
                    if (wc == 0 && fq == 0) { *(f32x4*)(F + (size_t)row * 8) = acc[ai][0][m][0] * rs; *(f32x4*)(F + (size_t)row * 8 + 4) = acc[ai][0][m][1] * rs; }
                    continue;
                }
                float s1 = 0.f, s2 = 0.f;
#pragma unroll
                for (int bj = 0; bj < 2; ++bj) {
                    f32x4 v0 = acc[ai][bj][m][0] * (rs * sc), v1 = acc[ai][bj][m][1] * (rs * sc);
                    if (act) {
#pragma unroll
                        for (int i = 0; i < 4; ++i) { v0[i] = gelu_tanh(v0[i]); v1[i] = gelu_tanh(v1[i]); }
                    }
                    s1 += ((v0[0] + v0[1]) + (v0[2] + v0[3])) + ((v1[0] + v1[1]) + (v1[2] + v1[3])); s2 += sq4(v0) + sq4(v1);
                    u32x4 w; w.x = cvt_pk_bf16(v0[0], v0[1]); w.y = cvt_pk_bf16(v0[2], v0[3]); w.z = cvt_pk_bf16(v1[0], v1[1]); w.w = cvt_pk_bf16(v1[2], v1[3]);
                    *(u32x4*)(Z + (size_t)row * Z1P + pn * BM + bj * HALF + colw) = w;
                }
                if (stat) {
                    s1 += xor16_f(s1); s1 = halves_sum_f(s1); s2 += xor16_f(s2); s2 = halves_sum_f(s2);
                    if (fq == 0) *(f32x2*)(sst + ((size_t)row * 8 + (pn - 8) * 4 + wc) * 2) = (f32x2){s1, s2};
                }
            }
    }
};
struct EpiHalo {
    static constexpr bool PERM = true, AFTER_DRAIN = false;
    const float* ssq_in; float* AH;
    __device__ __forceinline__ void operator()(const f32x4 (&acc)[2][2][4][2], const Unit& u_, int wr, int wc, int fr, int fq) const {
        Unit u; { int pm_ = u_.pm, pn_ = u_.pn; asm volatile("" : "+s"(pm_), "+s"(pn_)); u.pm = pm_; u.pn = pn_; }
        const int col0 = u.pn * BM + wc * 32 + 8 * fq;
#pragma unroll
        for (int m = 0; m < 4; ++m) {
            const int rh = wr * 64 + m * 16 + fr;
            if (rh < 2) continue;
            const int tok = 256 * (rh >> 1) - 2 + (rh & 1);
            const float rs = row_rstd(ssq_in, tok);
#pragma unroll
            for (int bj = 0; bj < 2; ++bj) {
                *(f32x4*)(AH + (size_t)rh * NFF2 + col0 + bj * HALF) = acc[0][bj][m][0] * rs;
                *(f32x4*)(AH + (size_t)rh * NFF2 + col0 + bj * HALF + 4) = acc[0][bj][m][1] * rs;
            }
        }
    }
};
template <int SEL> __device__ __forceinline__ float dpp1(const float old, const float src) {
    const int o = __builtin_bit_cast(int, old), s = __builtin_bit_cast(int, src); int t;
    if (SEL == 0) t = __builtin_amdgcn_update_dpp(o, s, 0x111, 0xf, 0xf, false);
    else if (SEL == 1) t = __builtin_amdgcn_update_dpp(o, s, 0x112, 0xf, 0xf, false);
    else if (SEL == 2) t = __builtin_amdgcn_update_dpp(o, s, 0x10F, 0xf, 0xf, false);
    else t = __builtin_amdgcn_update_dpp(o, s, 0x10E, 0xf, 0xf, false);
    return __builtin_bit_cast(float, t);
}
template <int SEL> __device__ __forceinline__ f32x4 dpp4t(const f32x4 old, const f32x4 src) {
    const float o0 = old[0], o1 = old[1], o2 = old[2], o3 = old[3], s0 = src[0], s1 = src[1], s2 = src[2], s3 = src[3];
    const float r0 = dpp1<SEL>(o0, s0), r1 = dpp1<SEL>(o1, s1), r2 = dpp1<SEL>(o2, s2), r3 = dpp1<SEL>(o3, s3);
    return (f32x4){r0, r1, r2, r3};
}
#define dpp4(old, src, sel) dpp4t<sel>(old, src)
struct EpiHaloF {
    static constexpr bool PERM = true, AFTER_DRAIN = false;
    const float* ssq_in; float* ah; unsigned* flags;
    __device__ __forceinline__ void operator()(const f32x4 (&acc)[2][2][4][2], const Unit& u_, int wr, int wc, int fr, int fq) const {
        Unit u; { int pm_ = u_.pm, pn_ = u_.pn; asm volatile("" : "+s"(pm_), "+s"(pn_)); u.pm = pm_; u.pn = pn_; }
        const int col0 = u.pn * BM + wc * 32 + 8 * fq;
#pragma unroll
        for (int m = 0; m < 4; ++m) {
            const int rh = wr * 64 + m * 16 + fr;
            if (rh >= 2) {
                const int tok = 256 * (rh >> 1) - 2 + (rh & 1);
                const float rsh = row_rstd(ssq_in, tok);
#pragma unroll
                for (int bj = 0; bj < 2; ++bj) {
                    *(f32x4*)(ah + (size_t)rh * NFF2 + col0 + bj * HALF) = acc[0][bj][m][0] * rsh;
                    *(f32x4*)(ah + (size_t)rh * NFF2 + col0 + bj * HALF + 4) = acc[0][bj][m][1] * rsh;
                }
            }
        }
        asm volatile("s_waitcnt vmcnt(0)" ::: "memory"); __builtin_amdgcn_s_barrier(); asm volatile("" ::: "memory");
        if (wr == 0 && wc == 0 && fr == 0 && fq == 0) {
            __builtin_amdgcn_fence(__ATOMIC_RELEASE, "agent");
            asm volatile("s_waitcnt vmcnt(0)" ::: "memory");
            __hip_atomic_store(flags + 64 * u.pn, 1u, __ATOMIC_RELAXED, __HIP_MEMORY_SCOPE_AGENT);
        }
    }
};
struct EpiFfnIn {
    static constexpr bool PERM = true, AFTER_DRAIN = false;
    const float* ssq_in; const float* cw; const float* cb; float* ah; bf16_t* hid; PG8_LAS float* xb; unsigned* flags; unsigned phase_id;
    __device__ __forceinline__ void operator()(const f32x4 (&acc)[2][2][4][2], const Unit& u_, int wr, int wc, int fr, int fq) const {
        Unit u; { int pm_ = u_.pm, pn_ = u_.pn; asm volatile("" : "+s"(pm_), "+s"(pn_)); u.pm = pm_; u.pn = pn_; }
        PG8_LAS float* rtab = xb + 2048;
        const int row0 = u.pm * BM + wr * 64 + fr;
        if (wr == 0) rtab[wc * 64 + fq * 16 + fr] = row_rstd(ssq_in, u.pm * BM + wc * 64 + fq * 16 + fr);
        if (fr >= 14) {
#pragma unroll
            for (int ai = 0; ai < 2; ++ai) {
                PG8_LAS f32x4* dst = (PG8_LAS f32x4*)(xb + ((((ai * 2 + wr) * 4 + wc) * 2 + (fr - 14)) * 4 + fq) * 16);
#pragma unroll
                for (int bj = 0; bj < 2; ++bj)
#pragma unroll
                    for (int n = 0; n < 2; ++n) dst[bj * 2 + n] = acc[ai][bj][3][n];
            }
        }
        asm volatile("s_waitcnt lgkmcnt(0)" ::: "memory"); __builtin_amdgcn_s_barrier(); asm volatile("" ::: "memory");
        const bool has = (u.pm & 7) != 0;
        if (wr == 0) {
            PG8_LAS unsigned* stamp = (PG8_LAS unsigned*)(rtab + 256);
            if (*(volatile PG8_LAS unsigned*)stamp != phase_id) {
                if (wc == 0) {
                    unsigned sp = 0;
                    for (int t = 0; t < NFF2 / BM; ++t)
                        while (__hip_atomic_load(flags + 64 * t, __ATOMIC_RELAXED, __HIP_MEMORY_SCOPE_AGENT) == 0u) { __builtin_amdgcn_s_sleep(2); if (++sp > (1u << 22)) break; }
                    __builtin_amdgcn_fence(__ATOMIC_ACQUIRE, "agent");
                    asm volatile("s_waitcnt vmcnt(0)" ::: "memory");
                    if (fr == 0 && fq == 0) *(volatile PG8_LAS unsigned*)stamp = phase_id;
                } else {
                    unsigned sp = 0;
                    while (*(volatile PG8_LAS unsigned*)stamp != phase_id) { __builtin_amdgcn_s_sleep(2); if (++sp > (1u << 22)) break; }
                }
            }
        }
        float rs[2][4];
#pragma unroll
        for (int ai = 0; ai < 2; ++ai)
#pragma unroll
            for (int m = 0; m < 4; ++m) rs[ai][m] = rtab[ai * HALF + wr * 64 + m * 16 + fr];
        const f32x4 zero4 = {0.f, 0.f, 0.f, 0.f};
#pragma unroll
        for (int ai = 0; ai < 2; ++ai) {
#pragma unroll
            for (int n = 0; n < 2; ++n) {
                f32x4 cg[4];
#pragma unroll
                for (int bj = 0; bj < 2; ++bj) {
                    f32x4 b0, b1;
                    if (ai == 0 && wr == 0) {
                        const size_t c = (size_t)u.pn * BM + bj * HALF + wc * 32 + 8 * fq + 4 * n;
                        b0 = has ? *(const f32x4*)(ah + (size_t)(2 * u.pm) * NFF2 + c) : zero4;
                        b1 = has ? *(const f32x4*)(ah + (size_t)(2 * u.pm + 1) * NFF2 + c) : zero4;
                    } else {
                        const int sa = (wr == 1) ? ai : ai - 1, sw = (wr == 1) ? 0 : 1;
                        const float r0 = rtab[sa * HALF + sw * 64 + 62], r1 = rtab[sa * HALF + sw * 64 + 63];
                        b0 = *(const PG8_LAS f32x4*)(xb + ((((sa * 2 + sw) * 4 + wc) * 2 + 0) * 4 + fq) * 16 + (bj * 2 + n) * 4) * r0;
                        b1 = *(const PG8_LAS f32x4*)(xb + ((((sa * 2 + sw) * 4 + wc) * 2 + 1) * 4 + fq) * 16 + (bj * 2 + n) * 4) * r1;
                    }
                    const int oc = bj * DFF + 128 * u.pn + wc * 32 + 8 * fq + 4 * n;
                    const f32x4 w0 = *(const f32x4*)(cw + oc), w1 = *(const f32x4*)(cw + NFF2 + oc), w2 = *(const f32x4*)(cw + 2 * NFF2 + oc), bb = *(const f32x4*)(cb + oc);
                    f32x4 prev = zero4;
#pragma unroll
                    for (int m = 0; m < 4; ++m) {
                        const f32x4 cur = acc[ai][bj][m][n] * rs[ai][m];
                        f32x4 y1, y2;
                        if (m == 0) { y1 = b1; y2 = (fr == 0) ? b0 : b1; }
                        else { y1 = dpp4(zero4, prev, 2); y2 = dpp4(zero4, prev, 3); }
                        const f32x4 p1 = dpp4(y1, cur, 0), p2 = dpp4(y2, cur, 1);
                        const f32x4 c = w0 * p2 + w1 * p1 + w2 * cur + bb;
                        prev = cur;
                        if (bj == 0) cg[m] = c;
                        else {
                            const float h0 = gelu_tanh(cg[m].x) * c.x, h1 = gelu_tanh(cg[m].y) * c.y, h2 = gelu_tanh(cg[m].z) * c.z, h3 = gelu_tanh(cg[m].w) * c.w;
                            u32x2 w; w.x = cvt_pk_bf16(h0, h1); w.y = cvt_pk_bf16(h2, h3);
                            const int row = row0 + ai * HALF + m * 16;
                            *(u32x2*)(hid + (size_t)row * DFF + 128 * u.pn + wc * 32 + 8 * fq + 4 * n) = w;
                        }
                    }
                    asm volatile("" ::: "memory");
                }
            }
        }
    }
};
template <class Epi, class Sched, bool ALIGN_EPI = false, bool SP2 = false>
__device__ __forceinline__ void gemm_phase(PG8_LAS unsigned char* lds, const Gemm g, const Sched& S, const Epi& E, const int wave_s) {
    const int tid_ = wave_s * 64 + lane_opaque(); const int tid = tid_, wid = __builtin_amdgcn_readfirstlane(tid >> 6), lane = tid & 63, wr = wid >> 2, wc = wid & 3, fr = lane & 15, fq = lane >> 4;
    const int K = g.K, nt = K / BK;
    unsigned voffA[2], voffB[2];
#pragma unroll
    for (int i = 0; i < 2; ++i) { int R, C; stage_rc(tid * 16 + i * 8192, R, C); const int Rb = Epi::PERM ? ((R & ~31) + perm32(R & 31)) : R;
        voffA[i] = (unsigned)(R * K + C) * 2u; voffB[i] = (unsigned)(Rb * K + C) * 2u; }
    const size_t kstep = (size_t)(BK * 2);
    const size_t hstep = (size_t)HALF * K * 2;
    const size_t tstep = 2 * hstep;
    const unsigned ldsw = (unsigned)wid * 1024u;
    const int aoff = lds_byte(wr * 64 + fr, fq * 8), boff = lds_byte(wc * 32 + fr, fq * 8);
#define PG8_SA(b, h) (((b) * 2 + (h)) * HTB)
#define PG8_SB(b, h) ((4 + (b) * 2 + (h)) * HTB)
#define PG8_STAGE(bufoff, gbase, voff) do { _Pragma("unroll") for (int _i = 0; _i < 2; ++_i) \
        __builtin_amdgcn_global_load_lds((const unsigned*)((const char*)(gbase) + (voff)[_i]), (PG8_LAS unsigned*)(lds + (bufoff) + ldsw + _i * 8192), 16, 0, 0); } while (0)
#define PG8_LDA(dst, b, h) do { _Pragma("unroll") for (int m = 0; m < 4; ++m) _Pragma("unroll") for (int k = 0; k < 2; ++k) dst[m][k] = *(const PG8_LAS bf16x8*)(lds + PG8_SA(b, h) + aoff + m * 2048 + k * 1024); } while (0)
#define PG8_LDB(dst, b, h) do { _Pragma("unroll") for (int n = 0; n < 2; ++n) _Pragma("unroll") for (int k = 0; k < 2; ++k) dst[n][k] = *(const PG8_LAS bf16x8*)(lds + PG8_SB(b, h) + boff + n * 2048 + k * 1024); } while (0)
#define PG8_MMA(ai, bj, At, Bt) do { __builtin_amdgcn_s_setprio(1); _Pragma("unroll") for (int m = 0; m < 4; ++m) _Pragma("unroll") for (int n = 0; n < 2; ++n) _Pragma("unroll") for (int k = 0; k < 2; ++k) \
        acc[ai][bj][m][n] = __builtin_amdgcn_mfma_f32_16x16x32_bf16(Bt[n][k], At[m][k], acc[ai][bj][m][n], 0, 0, 0); __builtin_amdgcn_s_setprio(0); } while (0)
#define PG8_WAIT_V(n) asm volatile("s_waitcnt vmcnt(" #n ")" ::: "memory")
#define PG8_WAIT_L(n) asm volatile("s_waitcnt lgkmcnt(" #n ")" ::: "memory")
#define PG8_BAR __builtin_amdgcn_s_barrier()
#define PG8_SCHED __builtin_amdgcn_sched_barrier(0)
    Unit cur, nxt; int ui = 0;
    if (!S.next(0, cur)) return;
    f32x4 acc[2][2][4][2];
#pragma unroll
    for (int a = 0; a < 2; ++a)
#pragma unroll
        for (int b = 0; b < 2; ++b)
#pragma unroll
            for (int m = 0; m < 4; ++m)
#pragma unroll
                for (int n = 0; n < 2; ++n) acc[a][b][m][n] = (f32x4){0.f, 0.f, 0.f, 0.f};
    bf16x8 At[4][2], B0[2][2], B1[2][2];
    const char* cA = (const char*)g.A + (size_t)cur.pm * tstep; const char* cB = (const char*)g.Bt + (size_t)cur.pn * tstep;
    S.a_ready(cur);
    if constexpr (SP2) {
        PG8_STAGE(PG8_SB(0, 0), cB, voffB); PG8_STAGE(PG8_SB(0, 1), cB + hstep, voffB); PG8_STAGE(PG8_SA(0, 0), cA, voffA); PG8_STAGE(PG8_SA(0, 1), cA + hstep, voffA);
        if (wr == 1) PG8_BAR;
        PG8_WAIT_V(2); PG8_BAR;
        PG8_STAGE(PG8_SB(1, 0), cB + kstep, voffB); PG8_STAGE(PG8_SA(1, 0), cA + kstep, voffA); PG8_STAGE(PG8_SB(1, 1), cB + hstep + kstep, voffB);
        PG8_WAIT_V(6); PG8_BAR;
    } else {
        PG8_STAGE(PG8_SB(0, 0), cB, voffB); PG8_STAGE(PG8_SA(0, 0), cA, voffA); PG8_STAGE(PG8_SB(0, 1), cB + hstep, voffB); PG8_STAGE(PG8_SA(0, 1), cA + hstep, voffA);
        if (wr == 1) PG8_BAR;
        PG8_WAIT_V(4); PG8_BAR;
        PG8_STAGE(PG8_SB(1, 0), cB + kstep, voffB); PG8_STAGE(PG8_SA(1, 0), cA + kstep, voffA); PG8_STAGE(PG8_SB(1, 1), cB + hstep + kstep, voffB);
        PG8_WAIT_V(6); PG8_BAR;
    }
    for (;;) {
        const bool has_next = S.next(ui + 1, nxt);
        const char* nA = has_next ? (const char*)g.A + (size_t)nxt.pm * tstep : cA; const char* nB = has_next ? (const char*)g.Bt + (size_t)nxt.pn * tstep : cB;
        for (int t = 0; t < nt; t += 2) {
            const bool last = (t == nt - 2);
            const char* a1 = cA + (size_t)(t + 1) * kstep;
            const char* a2 = last ? nA : cA + (size_t)(t + 2) * kstep; const char* b2 = last ? nB : cB + (size_t)(t + 2) * kstep;
            const char* a3 = a2 + kstep; const char* b3 = b2 + kstep;
            if (last && has_next) S.a_ready(nxt);
            if constexpr (SP2) {
            PG8_LDB(B0, 0, 0); PG8_LDB(B1, 0, 1); PG8_SCHED; PG8_LDA(At, 0, 0); PG8_STAGE(PG8_SA(1, 1), a1 + hstep, voffA);
            PG8_WAIT_V(8); PG8_WAIT_L(0); PG8_BAR; PG8_MMA(0, 0, At, B0); PG8_MMA(0, 1, At, B1); PG8_BAR; PG8_SCHED;
            PG8_LDA(At, 0, 1); PG8_STAGE(PG8_SB(0, 0), b2, voffB); PG8_STAGE(PG8_SB(0, 1), b2 + hstep, voffB); PG8_STAGE(PG8_SA(0, 0), a2, voffA);
            PG8_WAIT_V(8); PG8_WAIT_L(0); PG8_BAR; PG8_MMA(1, 0, At, B0); PG8_MMA(1, 1, At, B1); PG8_BAR; PG8_SCHED;
            PG8_LDB(B0, 1, 0); PG8_LDB(B1, 1, 1); PG8_SCHED; PG8_LDA(At, 1, 0); PG8_STAGE(PG8_SA(0, 1), a2 + hstep, voffA);
            PG8_WAIT_V(8); PG8_WAIT_L(0); PG8_BAR; PG8_MMA(0, 0, At, B0); PG8_MMA(0, 1, At, B1); PG8_BAR; PG8_SCHED;
            PG8_LDA(At, 1, 1); PG8_STAGE(PG8_SB(1, 0), b3, voffB); PG8_STAGE(PG8_SB(1, 1), b3 + hstep, voffB); PG8_STAGE(PG8_SA(1, 0), a3, voffA);
            PG8_WAIT_V(8); PG8_WAIT_L(0); PG8_BAR; PG8_MMA(1, 0, At, B0); PG8_MMA(1, 1, At, B1); PG8_BAR; PG8_SCHED;
            } else {
            PG8_LDB(B0, 0, 0); PG8_SCHED; PG8_LDA(At, 0, 0); PG8_STAGE(PG8_SA(1, 1), a1 + hstep, voffA);
            PG8_WAIT_L(8); PG8_BAR; PG8_WAIT_L(0); PG8_MMA(0, 0, At, B0); PG8_BAR; PG8_SCHED;
            PG8_LDB(B1, 0, 1); PG8_STAGE(PG8_SB(0, 0), b2, voffB);
            PG8_BAR; PG8_WAIT_L(0); PG8_MMA(0, 1, At, B1); PG8_BAR;
            PG8_LDA(At, 0, 1); PG8_STAGE(PG8_SA(0, 0), a2, voffA);
            PG8_BAR; PG8_WAIT_L(0); PG8_MMA(1, 0, At, B0); PG8_BAR; PG8_SCHED;
            PG8_STAGE(PG8_SB(0, 1), b2 + hstep, voffB);
            PG8_WAIT_V(6); PG8_BAR; PG8_MMA(1, 1, At, B1); PG8_BAR;
            PG8_LDB(B0, 1, 0); PG8_SCHED; PG8_LDA(At, 1, 0); PG8_STAGE(PG8_SA(0, 1), a2 + hstep, voffA);
            PG8_WAIT_L(8); PG8_BAR; PG8_WAIT_L(0); PG8_MMA(0, 0, At, B0); PG8_BAR; PG8_SCHED;
            PG8_LDB(B1, 1, 1); PG8_STAGE(PG8_SB(1, 0), b3, voffB);
            PG8_BAR; PG8_WAIT_L(0); PG8_MMA(0, 1, At, B1); PG8_BAR;
            PG8_LDA(At, 1, 1); PG8_STAGE(PG8_SA(1, 0), a3, voffA);
            PG8_BAR; PG8_WAIT_L(0); PG8_MMA(1, 0, At, B0); PG8_BAR; PG8_SCHED;
            PG8_STAGE(PG8_SB(1, 1), b3 + hstep, voffB);
            PG8_WAIT_V(6); PG8_BAR; PG8_MMA(1, 1, At, B1); PG8_BAR;
            }
        }
        if constexpr (ALIGN_EPI) { if (wr == 0) PG8_BAR; }
        if constexpr (!Epi::AFTER_DRAIN) { E(acc, cur, wr, wc, fr, fq); S.done(cur); }
        if (!has_next) break;
#pragma unroll
        for (int a = 0; a < 2; ++a)
#pragma unroll
            for (int b = 0; b < 2; ++b)
#pragma unroll
                for (int m = 0; m < 4; ++m)
#pragma unroll
                    for (int n = 0; n < 2; ++n) acc[a][b][m][n] = (f32x4){0.f, 0.f, 0.f, 0.f};
        cur = nxt; cA = nA; cB = nB; ++ui;
        if constexpr (ALIGN_EPI) { if (wr == 1) PG8_BAR; }
    }
    PG8_WAIT_V(0);
    if constexpr (!ALIGN_EPI) { if (wr == 0) PG8_BAR; }
    PG8_BAR;
    if constexpr (Epi::AFTER_DRAIN) { E.fused(acc, cur, wr, wc, fr, fq, lds, wid, lane); S.done(cur); }
#undef PG8_SA
#undef PG8_SB
#undef PG8_STAGE
#undef PG8_LDA
#undef PG8_LDB
#undef PG8_MMA
#undef PG8_WAIT_V
#undef PG8_WAIT_L
#undef PG8_BAR
#undef PG8_SCHED
}
}
namespace mix {
#define MLAS __attribute__((address_space(3)))
typedef unsigned short bf16_t;
typedef short bf16x8 __attribute__((ext_vector_type(8)));
typedef short s16x4 __attribute__((ext_vector_type(4)));
typedef float f32x16 __attribute__((ext_vector_type(16)));
typedef float f32x4 __attribute__((ext_vector_type(4)));
typedef float f32x2 __attribute__((ext_vector_type(2)));
typedef unsigned u32x4 __attribute__((ext_vector_type(4)));
typedef unsigned u32x2 __attribute__((ext_vector_type(2)));
typedef MLAS const char* lds_cptr;
typedef short v4i16_t __attribute__((ext_vector_type(4)));
typedef __bf16 bf16x2_t __attribute__((ext_vector_type(2)));

constexpr int SLOTB = 8192;
constexpr int NSLOT = 4;
constexpr int L_K = 0, L_V = NSLOT * SLOTB, L_WSF = 2 * NSLOT * SLOTB, L_OST = L_WSF + 8 * 256, L_X = L_OST + 8 * 4096;
constexpr int LX_IQ = L_X, LX_EQ = L_X, LX_PFX = L_X + 8192, LX_CNT = LX_IQ + 16384, LX_GT = LX_CNT + 2048, LX_SEL = LX_GT, LX_END = LX_GT + 8192;
static_assert(LX_END <= 131072, "mixer LDS map");

__device__ __forceinline__ int crow(int r, int hi) { return (r & 3) + 8 * (r >> 2) + 4 * hi; }
__device__ __forceinline__ void glds16(const void* gsrc, unsigned lds_dst) { unsigned keep;
    asm volatile("s_mov_b32 %0, m0\n\ts_mov_b32 m0, %2\n\ts_nop 0\n\tglobal_load_lds_dwordx4 %1, off\n\ts_mov_b32 m0, %0" : "=&s"(keep) : "v"(gsrc), "s"(lds_dst) : "memory"); }
__device__ __forceinline__ unsigned cvtpk(float lo, float hi) { f32x2 v = {lo, hi}; bf16x2_t b = __builtin_convertvector(v, bf16x2_t); return __builtin_bit_cast(unsigned, b); }
__device__ __forceinline__ s16x4 vtr(lds_cptr p) { return __builtin_bit_cast(s16x4, __builtin_amdgcn_ds_read_tr16_b64_v4i16((MLAS v4i16_t*)p)); }
#define WAITV_BAR() asm volatile("s_waitcnt vmcnt(0) lgkmcnt(0)\n\ts_barrier" ::: "memory")
#define LGKM_BAR() asm volatile("s_waitcnt lgkmcnt(0)\n\ts_barrier" ::: "memory")
#define WAITV2_BAR() asm volatile("s_waitcnt vmcnt(2) lgkmcnt(0)\n\ts_barrier" ::: "memory")

__device__ __forceinline__ void dma_kv(const bf16_t* kbase, const bf16_t* vbase, int pitch, unsigned lds0, int slot, int wid, int lane) {
    const bf16_t* ks = kbase + (size_t)lane * pitch + wid * 8;
    const bf16_t* vs = vbase + (size_t)(16 * (wid & 3) + (lane >> 2)) * pitch + (wid >> 2) * 32 + (lane & 3) * 8;
    glds16(ks, (unsigned)__builtin_amdgcn_readfirstlane(lds0 + L_K + slot * SLOTB + wid * 1024));
    glds16(vs, (unsigned)__builtin_amdgcn_readfirstlane(lds0 + L_V + slot * SLOTB + wid * 1024));
}
__device__ __forceinline__ void kload(bf16x8 (&kf)[8], lds_cptr kslot, int r32, int hi) {
    lds_cptr kb = kslot + hi * 1024 + r32 * 16;
#pragma unroll
    for (int d0 = 0; d0 < 4; ++d0) { kf[2 * d0] = *(const MLAS bf16x8*)(kb + d0 * 2048); kf[2 * d0 + 1] = *(const MLAS bf16x8*)(kb + d0 * 2048 + 512); }
}
__device__ __forceinline__ void qkt_mma(f32x16& p0, f32x16& p1, const bf16x8 (&kf)[8], const bf16x8* qr, const f32x16& cinit) {
    p0 = __builtin_amdgcn_mfma_f32_32x32x16_bf16(kf[0], qr[0], cinit, 0, 0, 0); p1 = __builtin_amdgcn_mfma_f32_32x32x16_bf16(kf[1], qr[0], cinit, 0, 0, 0);
#pragma unroll
    for (int d0 = 1; d0 < 4; ++d0) { p0 = __builtin_amdgcn_mfma_f32_32x32x16_bf16(kf[2 * d0], qr[d0], p0, 0, 0, 0); p1 = __builtin_amdgcn_mfma_f32_32x32x16_bf16(kf[2 * d0 + 1], qr[d0], p1, 0, 0, 0); }
}
__device__ __forceinline__ void qkt(f32x16& p0, f32x16& p1, lds_cptr kslot, const bf16x8* qr, const f32x16& cinit, int r32, int hi) {
    bf16x8 kf[8]; kload(kf, kslot, r32, hi); qkt_mma(p0, p1, kf, qr, cinit);
}
__device__ __forceinline__ void vload(bf16x8 (&vf)[8], lds_cptr vslot, int lane, int hi) {
    lds_cptr vp = vslot + ((lane >> 4) & 1) * 32 + (lane & 3) * 8 + (4 * hi + ((lane & 15) >> 2)) * 64;
#pragma unroll
    for (int d0 = 0; d0 < 2; ++d0)
#pragma unroll
        for (int ks = 0; ks < 4; ++ks) {
            const s16x4 lo = vtr(vp + d0 * 4096 + ks * 1024), hh = vtr(vp + d0 * 4096 + ks * 1024 + 512);
            vf[d0 * 4 + ks] = (bf16x8){lo[0], lo[1], lo[2], lo[3], hh[0], hh[1], hh[2], hh[3]};
        }
}
#define V16_TO_ARR(v, a, o) do { a[(o) + 0] = v[0]; a[(o) + 1] = v[1]; a[(o) + 2] = v[2]; a[(o) + 3] = v[3]; a[(o) + 4] = v[4]; a[(o) + 5] = v[5]; a[(o) + 6] = v[6]; a[(o) + 7] = v[7]; \
    a[(o) + 8] = v[8]; a[(o) + 9] = v[9]; a[(o) + 10] = v[10]; a[(o) + 11] = v[11]; a[(o) + 12] = v[12]; a[(o) + 13] = v[13]; a[(o) + 14] = v[14]; a[(o) + 15] = v[15]; } while (0)
__device__ __forceinline__ f32x16 splat16(float x) { return (f32x16){x, x, x, x, x, x, x, x, x, x, x, x, x, x, x, x}; }
struct AttnState { f32x16 o[2]; float m, l, pend; bool started; };
constexpr float ATT_THR = 8.0f;
__device__ __forceinline__ void softmax_pv(AttnState& st, float (&sc)[32], const bf16x8 (&vf)[8], MLAS float* wsf, int lane, int r32, int hi) {
    if (__any(st.pend != 0.f)) {
#pragma unroll
        for (int r = 0; r < 32; ++r) sc[r] -= st.pend;
    }
    st.pend = 0.f;
    float ra = __builtin_fmaxf(__builtin_fmaxf(sc[0], sc[1]), sc[2]), rb = __builtin_fmaxf(__builtin_fmaxf(sc[3], sc[4]), sc[5]);
#pragma unroll
    for (int r = 6; r < 30; r += 4) { ra = __builtin_fmaxf(__builtin_fmaxf(ra, sc[r]), sc[r + 1]); rb = __builtin_fmaxf(__builtin_fmaxf(rb, sc[r + 2]), sc[r + 3]); }
    float rm = __builtin_fmaxf(__builtin_fmaxf(ra, rb), __builtin_fmaxf(sc[30], sc[31]));
    rm = halves_max_f(rm);
    const bool fresh = !st.started;
    const bool need = (rm > ATT_THR) || (fresh && rm < -ATT_THR && rm > -1e29f);
    st.started = st.started || (rm > -1e29f);
    if (__any(need)) {
        const float dl = need ? rm : 0.f;
        st.m += dl; st.pend = dl;
#pragma unroll
        for (int r = 0; r < 32; ++r) sc[r] -= dl;
        const float alpha = fresh ? 1.0f : __builtin_amdgcn_exp2f(-dl);
        st.l *= alpha;
        if (hi == 0) wsf[r32] = alpha;
        float fr_[16];
#pragma unroll
        for (int r = 0; r < 16; ++r) fr_[r] = wsf[crow(r, hi)];
        const f32x16 fv = {fr_[0], fr_[1], fr_[2], fr_[3], fr_[4], fr_[5], fr_[6], fr_[7], fr_[8], fr_[9], fr_[10], fr_[11], fr_[12], fr_[13], fr_[14], fr_[15]};
        st.o[0] = st.o[0] * fv; st.o[1] = st.o[1] * fv;
    }
    float pe[32]; float s0 = 0.f, s1 = 0.f;
#pragma unroll
    for (int r = 0; r < 32; r += 2) { pe[r] = __builtin_amdgcn_exp2f(sc[r]); pe[r + 1] = __builtin_amdgcn_exp2f(sc[r + 1]); s0 += pe[r]; s1 += pe[r + 1]; }
    st.l += s0 + s1;
    u32x4 pw[4];
#pragma unroll
    for (int k = 0; k < 4; ++k) pw[k] = (u32x4){cvtpk(pe[8 * k + 0], pe[8 * k + 1]), cvtpk(pe[8 * k + 2], pe[8 * k + 3]), cvtpk(pe[8 * k + 4], pe[8 * k + 5]), cvtpk(pe[8 * k + 6], pe[8 * k + 7])};
#pragma unroll
    for (int d0 = 0; d0 < 2; ++d0)
#pragma unroll
        for (int ks = 0; ks < 4; ++ks) st.o[d0] = __builtin_amdgcn_mfma_f32_32x32x16_bf16(__builtin_bit_cast(bf16x8, pw[ks]), vf[d0 * 4 + ks], st.o[d0], 0, 0, 0);
}
__device__ __forceinline__ void attn_store(AttnState& st, bf16_t* Ow, int pitch, MLAS float* wsf, MLAS bf16_t* stg, int lane, int r32, int hi) {
    float l = halves_sum_f(st.l);
    if (hi == 0) wsf[32 + r32] = l;
    float rli[16];
#pragma unroll
    for (int r = 0; r < 16; ++r) rli[r] = 1.0f / wsf[32 + crow(r, hi)];
#pragma unroll
    for (int r = 0; r < 16; ++r) { const int orow = crow(r, hi);
#pragma unroll
        for (int d0 = 0; d0 < 2; ++d0) { const unsigned short b = (unsigned short)(cvtpk(st.o[d0][r] * rli[r], 0.f) & 0xffffu); stg[orow * 64 + d0 * 32 + r32] = b; } }
#pragma unroll
    for (int i = 0; i < 4; ++i) { const int row = i * 8 + (lane >> 3), ch = lane & 7; const u32x4 v = *(const MLAS u32x4*)(stg + row * 64 + ch * 8); *(u32x4*)(Ow + (size_t)row * pitch + ch * 8) = v; }
}

#ifndef DBG_REP_BS
#define DBG_REP_BS 1
#endif
__device__ __forceinline__ unsigned pk_sub_sat_u16(unsigned a, unsigned b) { unsigned r; asm("v_pk_sub_u16 %0, %1, %2 clamp" : "=v"(r) : "v"(a), "v"(b)); return r; }
__device__ __forceinline__ unsigned pk_min_u16(unsigned a, unsigned b) { unsigned r; asm("v_pk_min_u16 %0, %1, %2" : "=v"(r) : "v"(a), "v"(b)); return r; }
__device__ __forceinline__ unsigned pk_add_u16(unsigned a, unsigned b) { unsigned r; asm("v_pk_add_u16 %0, %1, %2" : "=v"(r) : "v"(a), "v"(b)); return r; }
__device__ __forceinline__ unsigned pk_ashr_i16(unsigned a, unsigned sh2) { unsigned r; asm("v_pk_ashrrev_i16 %0, %1, %2" : "=v"(r) : "v"(sh2), "v"(a)); return r; }
__device__ __forceinline__ unsigned score_keys(float a, float b) {
    const unsigned p = __builtin_bit_cast(unsigned, __builtin_amdgcn_cvt_pkrtz(a, b));
    const unsigned m = pk_ashr_i16(p, 0x000f000fu);
    return p ^ (m | 0x80008000u);
}
template <int NS> __device__ __forceinline__ unsigned bit_search(const unsigned (&kp)[8][8], MLAS unsigned* cntx, int wid, int r32, int hi) {
    unsigned tau = 0u;
#pragma unroll 1
    for (int bit = 15; bit >= 0; --bit) {
        const unsigned cand = tau | (1u << bit);
        const unsigned c2 = (cand - 1u) * 0x00010001u;
        unsigned cnt2 = 0;
#pragma unroll
        for (int jj = 0; jj < NS; ++jj)
#pragma unroll
            for (int r = 0; r < 8; ++r) cnt2 = pk_add_u16(cnt2, pk_min_u16(pk_sub_sat_u16(kp[jj][r], c2), 0x00010001u));
        unsigned cnt = (cnt2 & 0xffffu) + (cnt2 >> 16);
        cnt = halves_add_u(cnt);
        MLAS unsigned* cb = cntx + (bit & 1) * 256;
        if (hi == 0) cb[wid * 32 + r32] = cnt;
        LGKM_BAR();
        unsigned tot = 0;
#pragma unroll
        for (int w = 0; w < 8; ++w) tot += cb[w * 32 + r32];
        if (tot >= 256u) tau = cand;
    }
    return tau;
}
__device__ __forceinline__ void dsa_select(int b, int qg, const bf16_t* Z0, char* shm, const int wave_s) {
    const int tid_ = wave_s * 64 + lane_opaque(); const int tid = tid_, lane = tid & 63, r32 = lane & 31, hi = lane >> 5; const int wid = __builtin_amdgcn_readfirstlane(tid >> 6);
    MLAS char* L = (MLAS char*)shm;
    const int c = qg >> 1, nkeys = 64 * (c + 1), nt32 = nkeys >> 5, nt64 = nkeys >> 6;
    const size_t rowb = (size_t)b * SEQ;
    const size_t tok0 = rowb + 32 * qg;
    MLAS unsigned* selw = (MLAS unsigned*)(L + LX_SEL);
    if (nkeys <= 256) {
        for (int i = tid; i < 64 * 32; i += 512) selw[i] = (i < nt32 * 32) ? 0xffffffffu : 0u;
    } else {
        {
            MLAS u32x4* iqL = (MLAS u32x4*)(L + LX_IQ);
            for (int i = tid; i < 1024; i += 512) { const int q = i & 31, hh = (i >> 5) & 1, d0 = (i >> 6) & 3, h = i >> 8;
                iqL[i] = *(const u32x4*)(Z0 + (tok0 + q) * EV_N + 1280 + 64 * h + 16 * d0 + 8 * hh); }
        }
        float w4[4];
        { const u32x2 ww = *(const u32x2*)(Z0 + (tok0 + r32) * EV_N + 1216);
          w4[0] = pg8::bf_lo(ww.x) * 0.0625f; w4[1] = pg8::bf_hi(ww.x) * 0.0625f; w4[2] = pg8::bf_lo(ww.y) * 0.0625f; w4[3] = pg8::bf_hi(ww.y) * 0.0625f; }
        LGKM_BAR();
        unsigned kp[8][8];
        const int nslots = (nt32 + 7) >> 3;
        const MLAS bf16x8* iqf = (const MLAS bf16x8*)(L + LX_IQ) + hi * 32 + r32;
#pragma unroll
        for (int jj = 0; jj < 8; ++jj) {
            const int j = wid + 8 * jj;
            if (j < nt32) {
                const bf16_t* ikp = Z0 + (rowb + 32 * j + r32) * EV_N + 1152 + 8 * hi;
                bf16x8 af[4];
#pragma unroll
                for (int d0 = 0; d0 < 4; ++d0) af[d0] = *(const bf16x8*)(ikp + 16 * d0);
                f32x16 ah[4];
#pragma unroll
                for (int h = 0; h < 4; ++h) {
                    f32x16 a = {};
#pragma unroll
                    for (int d0 = 0; d0 < 4; ++d0) a = __builtin_amdgcn_mfma_f32_32x32x16_bf16(af[d0], iqf[(h * 4 + d0) * 64], a, 0, 0, 0);
                    ah[h] = a;
                }
                float sv[16];
                {
                    float a0[16], a1[16], a2[16], a3[16];
                    V16_TO_ARR(ah[0], a0, 0); V16_TO_ARR(ah[1], a1, 0); V16_TO_ARR(ah[2], a2, 0); V16_TO_ARR(ah[3], a3, 0);
#pragma unroll
                    for (int r = 0; r < 16; ++r) sv[r] = ((__builtin_fmaxf(a0[r], 0.f) * w4[0] + __builtin_fmaxf(a1[r], 0.f) * w4[1]) + __builtin_fmaxf(a2[r], 0.f) * w4[2]) + __builtin_fmaxf(a3[r], 0.f) * w4[3];
                }
#pragma unroll
                for (int r = 0; r < 8; ++r) kp[jj][r] = score_keys(sv[r], sv[r + 8]);
            } else {
#pragma unroll
                for (int r = 0; r < 8; ++r) kp[jj][r] = 0u;
            }
        }
        MLAS unsigned* cntx = (MLAS unsigned*)(L + L_OST);
        unsigned tau;
        for (int rep_ = 0; rep_ < DBG_REP_BS; ++rep_)
        switch (nslots) {
            case 2: tau = bit_search<2>(kp, cntx, wid, r32, hi); break;
            case 3: tau = bit_search<3>(kp, cntx, wid, r32, hi); break;
            case 4: tau = bit_search<4>(kp, cntx, wid, r32, hi); break;
            case 5: tau = bit_search<5>(kp, cntx, wid, r32, hi); break;
            case 6: tau = bit_search<6>(kp, cntx, wid, r32, hi); break;
            case 7: tau = bit_search<7>(kp, cntx, wid, r32, hi); break;
            default: tau = bit_search<8>(kp, cntx, wid, r32, hi); break;
        }
        MLAS unsigned* gtw = (MLAS unsigned*)(L + LX_GT); MLAS unsigned* eqw = (MLAS unsigned*)(L + LX_EQ); MLAS unsigned* pfx = (MLAS unsigned*)(L + LX_PFX);
        const unsigned tg = tau * 0x00010001u, te = (tau - 1u) * 0x00010001u;
#pragma unroll
        for (int jj = 0; jj < 8; ++jj) {
            const int j = wid + 8 * jj;
            if (j < nt32) {
                unsigned g = 0, e = 0;
#pragma unroll
                for (int r = 0; r < 8; ++r) {
                    const unsigned dgt = pk_min_u16(pk_sub_sat_u16(kp[jj][r], tg), 0x00010001u), dge = pk_min_u16(pk_sub_sat_u16(kp[jj][r], te), 0x00010001u);
                    const int pos = (r & 3) + 8 * (r >> 2);
                    g |= dgt << pos; e |= (dge - dgt) << pos;
                }
                g <<= 4 * hi; e <<= 4 * hi;
                g = halves_or_u(g); e = halves_or_u(e);
                if (hi == 0) { gtw[j * 32 + r32] = g; eqw[j * 32 + r32] = e; }
            }
        }
        LGKM_BAR();
        if (wid == 0 && hi == 0) {
            unsigned cg = 0;
            for (int j = 0; j < nt32; ++j) cg += __builtin_popcount(gtw[j * 32 + r32]);
            const int need = 256 - (int)cg;
            int run = 0;
            for (int j = 0; j < nt32; ++j) { const unsigned e = eqw[j * 32 + r32]; int k = need - run; k = k < 0 ? 0 : (k > 32 ? 32 : k); pfx[j * 32 + r32] = (unsigned)k; run += __builtin_popcount(e); }
        }
        LGKM_BAR();
        for (int i = tid; i < nt32 * 32; i += 512) {
            const unsigned g = gtw[i], e = eqw[i]; const int k = (int)pfx[i];
            unsigned take = 0;
            if (e != 0u && k > 0) {
                unsigned rem = e; int cntk = 0;
                while (rem != 0u && cntk < k) { const unsigned low = rem & (0u - rem); take |= low; rem ^= low; ++cntk; }
            }
            selw[i] = g | take;
        }
        for (int i = nt32 * 32 + tid; i < 64 * 32; i += 512) selw[i] = 0u;
    }
    WAITV_BAR();
}

__device__ __forceinline__ void fox_unit(int b, int h, int qb, const bf16_t* Z1, const float* F, const float* bfp, bf16_t* Y, char* shm, unsigned lds0, const int wave_s) {
    const int tid_ = wave_s * 64 + lane_opaque(); const int tid = tid_, lane = tid & 63, r32 = lane & 31, hi = lane >> 5; const int wid = __builtin_amdgcn_readfirstlane(tid >> 6);
    MLAS char* L = (MLAS char*)shm;
    const size_t rowb = (size_t)b * SEQ;
    const int NT = 4 * (qb + 1), nk = 64 * NT;
    MLAS float* cum2 = (MLAS float*)(L + L_X);
    MLAS float* wtot = (MLAS float*)(L + L_X + 8192);
    const bf16_t* Kb = Z1 + rowb * Z1P + 512 + 64 * h; const bf16_t* Vb = Z1 + rowb * Z1P + 1024 + 64 * h;
#pragma unroll
    for (int i = 0; i < 3; ++i) dma_kv(Kb + (size_t)64 * i * Z1P, Vb + (size_t)64 * i * Z1P, Z1P, lds0, i, wid, lane);
    {
        const float bias = bfp[h];
        const int s0 = 4 * tid;
        float v[4]; float run = 0.f;
#pragma unroll
        for (int i = 0; i < 4; ++i) {
            float x = 0.f;
            if (s0 + i < nk) x = F[(rowb + s0 + i) * 8 + h] + bias;
            const float ls = (s0 + i < nk) ? (fminf(x, 0.f) - log1pf(expf(-fabsf(x)))) : 0.f;
            run += ls; v[i] = run;
        }
        float inc = run;
#pragma unroll
        for (int o = 1; o < 64; o <<= 1) { const int ln = lane_opaque(); const float t = __builtin_bit_cast(float, __builtin_amdgcn_ds_bpermute((ln - o) << 2, __builtin_bit_cast(int, inc))); if (ln >= o) inc += t; }
        if (lane == 63) wtot[wid] = inc;
        LGKM_BAR();
        float off = inc - run;
        for (int w = 0; w < wid; ++w) off += wtot[w];
#pragma unroll
        for (int i = 0; i < 4; ++i) cum2[s0 + i] = (off + v[i]) * 1.4426950408889634f;
    }
    const int tq = 256 * qb + 32 * wid + r32;
    bf16x8 qr[4];
#pragma unroll
    for (int d0 = 0; d0 < 4; ++d0) qr[d0] = *(const bf16x8*)(Z1 + (rowb + tq) * Z1P + 64 * h + 16 * d0 + 8 * hi);
    AttnState st; st.o[0] = f32x16{}; st.o[1] = f32x16{}; st.m = 0.f; st.l = 0.f; st.pend = 0.f; st.started = false;
    MLAS float* wsf = (MLAS float*)(L + L_WSF) + wid * 64;
    WAITV_BAR();
    const float cq2 = cum2[tq];
    const int tlast = 4 * qb + (wid >> 1);
    f32x16 s0, s1;
    qkt(s0, s1, (lds_cptr)(L + L_K), qr, splat16(-st.m), r32, hi);
    for (int t = 0; t < NT; ++t) {
        const int slot = t & 3;
        { const int tt = (t + 3 < NT) ? t + 3 : NT - 1; dma_kv(Kb + (size_t)64 * tt * Z1P, Vb + (size_t)64 * tt * Z1P, Z1P, lds0, (t + 3) & 3, wid, lane); }
        bf16x8 kf[8], vf[8];
        kload(kf, (lds_cptr)(L + L_K + ((t + 1) & 3) * SLOTB), r32, hi);
        __builtin_amdgcn_sched_barrier(0);
        vload(vf, (lds_cptr)(L + L_V + slot * SLOTB), lane, hi);
        const MLAS float* cb = cum2 + 64 * t + 4 * hi;
        f32x4 c0[4], c1[4];
#pragma unroll
        for (int g = 0; g < 4; ++g) { c0[g] = *(const MLAS f32x4*)(cb + 8 * g); c1[g] = *(const MLAS f32x4*)(cb + 32 + 8 * g); }
        f32x16 n0, n1;
        qkt_mma(n0, n1, kf, qr, splat16(-st.m));
        float sc[32];
        V16_TO_ARR(s0, sc, 0); V16_TO_ARR(s1, sc, 16);
#pragma unroll
        for (int g = 0; g < 4; ++g) {
            sc[4 * g + 0] += cq2 - c0[g].x; sc[4 * g + 1] += cq2 - c0[g].y; sc[4 * g + 2] += cq2 - c0[g].z; sc[4 * g + 3] += cq2 - c0[g].w;
            sc[16 + 4 * g + 0] += cq2 - c1[g].x; sc[16 + 4 * g + 1] += cq2 - c1[g].y; sc[16 + 4 * g + 2] += cq2 - c1[g].z; sc[16 + 4 * g + 3] += cq2 - c1[g].w;
        }
        if (t >= tlast) {
            const int qrel = tq - 64 * t;
#pragma unroll
            for (int r = 0; r < 16; ++r) { const int kr = crow(r, hi); if (kr > qrel) sc[r] = -INFINITY; if (kr + 32 > qrel) sc[16 + r] = -INFINITY; }
        }
        softmax_pv(st, sc, vf, wsf, lane, r32, hi);
        s0 = n0; s1 = n1;
        WAITV2_BAR();
    }
    attn_store(st, Y + (rowb + 256 * qb + 32 * wid) * DMODEL + 64 * h, DMODEL, wsf, (MLAS bf16_t*)(L + L_OST) + wid * 2048, lane, r32, hi);
    WAITV_BAR();
}

__device__ __forceinline__ void sgu_unit(int b, int n, int g, const bf16_t* Z1, const float* sst, const float* lng, const float* lnb, const bf16_t* Wm, const float* bs, bf16_t* Y, char* shm, const int wave_s) {
    const int tid_ = wave_s * 64 + lane_opaque(); const int tid = tid_, lane = tid & 63, r32 = lane & 31, hi = lane >> 5; const int wid = __builtin_amdgcn_readfirstlane(tid >> 6);
    MLAS char* L = (MLAS char*)shm;
    MLAS bf16_t* vn = (MLAS bf16_t*)L;
    constexpr int VP = 136;
    const size_t tok0 = (size_t)b * SEQ + 128 * n;
    {
        const int j = tid >> 2, cq = (tid & 3) * 32;
        const float* sp = sst + (tok0 + j) * 16;
        float s1 = 0.f, s2 = 0.f;
#pragma unroll
        for (int k = 0; k < 8; ++k) { s1 += sp[2 * k]; s2 += sp[2 * k + 1]; }
        const float mu = s1 * (1.0f / 512.0f); const float var = fmaxf(s2 * (1.0f / 512.0f) - mu * mu, 0.f);
        const float rstd = 1.0f / sqrtf(var + RMS_EPS);
        const bf16_t* vp = Z1 + (tok0 + j) * Z1P + 2048 + 128 * g + cq;
#pragma unroll
        for (int k = 0; k < 4; ++k) {
            const u32x4 w = *(const u32x4*)(vp + 8 * k);
            const int cc = 128 * g + cq + 8 * k;
            const f32x4 g0 = *(const f32x4*)(lng + cc), g1 = *(const f32x4*)(lng + cc + 4), b0 = *(const f32x4*)(lnb + cc), b1 = *(const f32x4*)(lnb + cc + 4);
            float x[8] = {pg8::bf_lo(w.x), pg8::bf_hi(w.x), pg8::bf_lo(w.y), pg8::bf_hi(w.y), pg8::bf_lo(w.z), pg8::bf_hi(w.z), pg8::bf_lo(w.w), pg8::bf_hi(w.w)};
            float y[8];
#pragma unroll
            for (int i = 0; i < 4; ++i) { y[i] = (x[i] - mu) * rstd * g0[i] + b0[i]; y[4 + i] = (x[4 + i] - mu) * rstd * g1[i] + b1[i]; }
            u32x4 o; o.x = cvtpk(y[0], y[1]); o.y = cvtpk(y[2], y[3]); o.z = cvtpk(y[4], y[5]); o.w = cvtpk(y[6], y[7]);
            *(MLAS u32x4*)(vn + j * VP + cq + 8 * k) = o;
        }
    }
    LGKM_BAR();
    MLAS bf16_t* ut = (MLAS bf16_t*)(L + 128 * VP * 2);
    {
        const int j = tid >> 2, cq = (tid & 3) * 32;
        const bf16_t* up = Z1 + (tok0 + j) * Z1P + 1536 + 128 * g + cq;
#pragma unroll
        for (int k = 0; k < 4; ++k) *(MLAS u32x4*)(ut + j * VP + cq + 8 * k) = *(const u32x4*)(up + 8 * k);
    }
    LGKM_BAR();
    const int ib = wid & 3;
    const bf16_t* wrow = Wm + ((size_t)g * 128 + 32 * ib + r32) * 128 + 8 * hi;
    bf16x8 af[8];
#pragma unroll
    for (int s = 0; s < 8; ++s) af[s] = *(const bf16x8*)(wrow + 16 * s);
#pragma unroll
    for (int cbi = 0; cbi < 2; ++cbi) {
        const int cb = (wid >> 2) * 2 + cbi;
        f32x16 acc = {};
        lds_cptr bp = (lds_cptr)(vn) + ((size_t)(8 * hi + ((lane & 15) >> 2)) * VP + 32 * cb + 16 * ((lane >> 4) & 1) + 4 * (lane & 3)) * 2;
#pragma unroll
        for (int s = 0; s < 8; ++s) {
            const s16x4 lo = vtr(bp + (16 * s) * VP * 2), hh = vtr(bp + (16 * s + 4) * VP * 2);
            const bf16x8 bfr = {lo[0], lo[1], lo[2], lo[3], hh[0], hh[1], hh[2], hh[3]};
            acc = __builtin_amdgcn_mfma_f32_32x32x16_bf16(af[s], bfr, acc, 0, 0, 0);
        }
        float a16[16]; V16_TO_ARR(acc, a16, 0);
#pragma unroll
        for (int r = 0; r < 16; ++r) {
            const int i = 32 * ib + crow(r, hi), cc = 32 * cb + r32;
            const float uu = __builtin_bit_cast(float, (unsigned)ut[i * VP + cc] << 16);
            const float o = uu * (a16[r] + bs[g * 128 + i]);
            ut[i * VP + cc] = (bf16_t)(cvtpk(o, 0.f) & 0xffffu);
        }
    }
    LGKM_BAR();
    {
        const int j = tid >> 2, cq = (tid & 3) * 32;
        bf16_t* yp = Y + (tok0 + j) * DMODEL + 512 + 128 * g + cq;
#pragma unroll
        for (int k = 0; k < 4; ++k) *(u32x4*)(yp + 8 * k) = *(const MLAS u32x4*)(ut + j * VP + cq + 8 * k);
    }
    LGKM_BAR();
}

__device__ __forceinline__ void pool_item(int item, const bf16_t* Z0, bf16_t* Y) {
    const int row = item >> 6, ch = item & 63, c0 = ch * 8, g = ch >> 4;
    const int w = 2 << g, tpos = row & (SEQ - 1);
    const int cnt = (tpos + 1 < w) ? tpos + 1 : w;
    u32x4 v[16];
#pragma unroll
    for (int k = 0; k < 16; ++k) { v[k] = (u32x4){0u, 0u, 0u, 0u}; if (k < cnt) v[k] = *(const u32x4*)(Z0 + (size_t)(row - k) * EV_N + c0); }
    float s[8] = {0.f, 0.f, 0.f, 0.f, 0.f, 0.f, 0.f, 0.f};
#pragma unroll
    for (int k = 0; k < 16; ++k) {
        s[0] += pg8::bf_lo(v[k].x); s[1] += pg8::bf_hi(v[k].x); s[2] += pg8::bf_lo(v[k].y); s[3] += pg8::bf_hi(v[k].y);
        s[4] += pg8::bf_lo(v[k].z); s[5] += pg8::bf_hi(v[k].z); s[6] += pg8::bf_lo(v[k].w); s[7] += pg8::bf_hi(v[k].w);
    }
    const float self[8] = {pg8::bf_lo(v[0].x), pg8::bf_hi(v[0].x), pg8::bf_lo(v[0].y), pg8::bf_hi(v[0].y), pg8::bf_lo(v[0].z), pg8::bf_hi(v[0].z), pg8::bf_lo(v[0].w), pg8::bf_hi(v[0].w)};
    const float inv = 1.0f / (float)cnt;
    u32x4 o; o.x = cvtpk(s[0] * inv - self[0], s[1] * inv - self[1]); o.y = cvtpk(s[2] * inv - self[2], s[3] * inv - self[3]);
    o.z = cvtpk(s[4] * inv - self[4], s[5] * inv - self[5]); o.w = cvtpk(s[6] * inv - self[6], s[7] * inv - self[7]);
    *(u32x4*)(Y + (size_t)row * DMODEL + c0) = o;
}
}
namespace foxa {
using bf16=__hip_bfloat16;
using bf16x8=__attribute__((ext_vector_type(8)))short;
using s16x4=__attribute__((ext_vector_type(4)))short;
using f32x16=__attribute__((ext_vector_type(16)))float;
using u32x4=__attribute__((ext_vector_type(4)))unsigned;
using f32x4v=__attribute__((ext_vector_type(4)))float;
constexpr int CUM_OFF=86016;
constexpr int SEQL=2048,D=64,OPI=1024;
constexpr int NW=8,QBLK=32,QB=QBLK*NW,KVBLK=64;
__device__ __forceinline__ int crow(int r,int hi){return (r&3)+8*(r>>2)+4*hi;}
#define SBAR() __builtin_amdgcn_sched_barrier(0)
__device__ __forceinline__ void cmask(f32x16&p0,f32x16&p1,int jb,int qrel,int hi){
  const float NEG=-INFINITY; int kb=64*jb+4*hi;
  #pragma unroll
  for(int r=0;r<16;++r){int kv=kb+(r&3)+8*(r>>2); if(kv>qrel)p0[r]=NEG; if(kv+32>qrel)p1[r]=NEG;}
}

constexpr int NSLOT=3, SLOTB=8192;
constexpr int LDS_K=0, LDS_V=NSLOT*SLOTB, LDS_WS=2*NSLOT*SLOTB, LDS_OST=LDS_WS+NW*64*4, LDS_BYTES=LDS_OST+NW*4096;
constexpr float C2=0.125f*1.4426950408889634f;
__device__ __forceinline__ void glds16(const void*gsrc,unsigned lds_dst){unsigned keep;
  asm volatile("s_mov_b32 %0, m0\n\ts_mov_b32 m0, %2\n\ts_nop 0\n\tglobal_load_lds_dwordx4 %1, off\n\ts_mov_b32 m0, %0":"=&s"(keep):"v"(gsrc),"s"(lds_dst):"memory");}
__device__ __forceinline__ float max3f(float a,float b,float c){float r;asm("v_max3_f32 %0, %1, %2, %3":"=v"(r):"v"(a),"v"(b),"v"(c));return r;}
__device__ __forceinline__ float max2f(float a,float b){float r;asm("v_max_f32_e32 %0, %1, %2":"=v"(r):"v"(a),"v"(b));return r;}
__device__ __forceinline__ float fadd_s(float a,float b){float r;asm("v_add_f32_e32 %0, %1, %2":"=v"(r):"v"(a),"v"(b));return r;}
__device__ __forceinline__ float fsub_s(float a,float b){float r;asm("v_sub_f32_e32 %0, %1, %2":"=v"(r):"v"(a),"v"(b));return r;}
typedef float f32x2_t __attribute__((ext_vector_type(2))); typedef __bf16 bf16x2_t __attribute__((ext_vector_type(2)));
__device__ __forceinline__ unsigned cvtpk_s(float lo,float hi){f32x2_t v={lo,hi};bf16x2_t b=__builtin_convertvector(v,bf16x2_t);return __builtin_bit_cast(unsigned,b);}
#define WAIT_BAR(N) asm volatile("s_waitcnt vmcnt(" #N ") lgkmcnt(0)\n\ts_barrier":::"memory")

__device__ __forceinline__ void qkt(f32x16&p0,f32x16&p1,const char*Kslot,const bf16x8*qr,const f32x16&negm,int r32,int hi){
  const char*kb=Kslot+hi*1024+r32*16;
  #pragma unroll
  for(int d0=0;d0<4;++d0){
    const bf16x8 b0=*reinterpret_cast<const bf16x8*>(kb+d0*2048);
    const bf16x8 b1=*reinterpret_cast<const bf16x8*>(kb+d0*2048+512);
    if(d0==0){p0=__builtin_amdgcn_mfma_f32_32x32x16_bf16(b0,qr[0],negm,0,0,0);p1=__builtin_amdgcn_mfma_f32_32x32x16_bf16(b1,qr[0],negm,0,0,0);}
    else{p0=__builtin_amdgcn_mfma_f32_32x32x16_bf16(b0,qr[d0],p0,0,0,0);p1=__builtin_amdgcn_mfma_f32_32x32x16_bf16(b1,qr[d0],p1,0,0,0);}}
}
typedef __attribute__((address_space(3))) const char* lds_cptr;
typedef short v4i16_t __attribute__((ext_vector_type(4)));
__device__ __forceinline__ void kload8(bf16x8*kf,lds_cptr kp){
  kf[0]=*(const __attribute__((address_space(3))) bf16x8*)(kp);      kf[1]=*(const __attribute__((address_space(3))) bf16x8*)(kp+512);
  kf[2]=*(const __attribute__((address_space(3))) bf16x8*)(kp+2048); kf[3]=*(const __attribute__((address_space(3))) bf16x8*)(kp+2560);
  kf[4]=*(const __attribute__((address_space(3))) bf16x8*)(kp+4096); kf[5]=*(const __attribute__((address_space(3))) bf16x8*)(kp+4608);
  kf[6]=*(const __attribute__((address_space(3))) bf16x8*)(kp+6144); kf[7]=*(const __attribute__((address_space(3))) bf16x8*)(kp+6656);
}
__device__ __forceinline__ void kload2(bf16x8*kf,lds_cptr kp,int j){ kf[2*j]=*(const __attribute__((address_space(3))) bf16x8*)(kp+j*2048); kf[2*j+1]=*(const __attribute__((address_space(3))) bf16x8*)(kp+j*2048+512); }
__device__ __forceinline__ s16x4 vtr(lds_cptr p){ return __builtin_bit_cast(s16x4,__builtin_amdgcn_ds_read_tr16_b64_v4i16((__attribute__((address_space(3))) v4i16_t*)p)); }
__device__ __forceinline__ float rowmax(const f32x16&p0,const f32x16&p1){
  float a=max3f(p0[0],p0[1],p1[0]),b=max3f(p0[2],p0[3],p1[1]);a=max3f(a,p1[2],p1[3]);
  #pragma unroll
  for(int r=4;r<16;r+=4){a=max3f(a,p0[r],p0[r+1]);b=max3f(b,p0[r+2],p0[r+3]);a=max3f(a,p1[r],p1[r+1]);b=max3f(b,p1[r+2],p1[r+3]);}
  const float m=max2f(a,b);
  auto rr=__builtin_amdgcn_permlane32_swap(__float_as_uint(m),__float_as_uint(m),false,false);
  return max2f(__uint_as_float(rr[0]),__uint_as_float(rr[1]));
}
__device__ __forceinline__ void pv(f32x16*o,int vb,bf16x8 pa0,bf16x8 pa1,bf16x8 pa2,bf16x8 pa3){
  #pragma unroll
  for(int d0=0;d0<2;++d0){s16x4 lo[4],hi[4];
    #pragma unroll
    for(int ks=0;ks<4;++ks){
      asm volatile("ds_read_b64_tr_b16 %0,%1 offset:%c2":"=&v"(lo[ks]):"v"(vb),"i"(d0*4096+ks*1024):"memory");
      asm volatile("ds_read_b64_tr_b16 %0,%1 offset:%c2":"=&v"(hi[ks]):"v"(vb),"i"(d0*4096+ks*1024+512):"memory");}
    asm volatile("s_waitcnt lgkmcnt(0)":::"memory");SBAR();
    #define PK(k) (bf16x8){lo[k][0],lo[k][1],lo[k][2],lo[k][3],hi[k][0],hi[k][1],hi[k][2],hi[k][3]}
    o[d0]=__builtin_amdgcn_mfma_f32_32x32x16_bf16(pa0,PK(0),o[d0],0,0,0);
    o[d0]=__builtin_amdgcn_mfma_f32_32x32x16_bf16(pa1,PK(1),o[d0],0,0,0);
    o[d0]=__builtin_amdgcn_mfma_f32_32x32x16_bf16(pa2,PK(2),o[d0],0,0,0);
    o[d0]=__builtin_amdgcn_mfma_f32_32x32x16_bf16(pa3,PK(3),o[d0],0,0,0);
    #undef PK
  }
}

#ifndef ATTN_STORE16
#define ATTN_STORE16(p,v) (*(u32x4*)(p)=(v))
#endif
template<int THRL,int MODE,int QKVP,class CumFn> __device__ __forceinline__ void attn_unit(CumFn&& CUMFN,int b,int h,int qb,int q0abs,int NTU,const bf16*Q,const bf16*__restrict__ K,const bf16*__restrict__ V,bf16*O,char*shm,const __attribute__((address_space(3))) unsigned*selw,const int wave_s){
  const int tid=wave_s*64+lane_opaque(),lane=tid&63,r32=lane&31,hi=lane>>5; const int wid=__builtin_amdgcn_readfirstlane(tid>>6);
  const long rowbase=(long)b*SEQL; const int q0=(MODE==0)?qb*QB:q0abs;
  const bf16*Qw=(MODE==0)?Q+(rowbase+q0+wid*QBLK)*QKVP+h*D:Q+(rowbase+q0)*QKVP+wid*D;
  const bf16*Kh=K+rowbase*QKVP+h*D,*Vh=V+rowbase*QKVP+h*D;
  const unsigned lds0=(unsigned)(uintptr_t)shm;
  float*wsf=(float*)(shm+LDS_WS)+wid*64;
  const bf16*ksrc=Kh+(long)lane*QKVP+wid*8;
  const bf16*vsrc=Vh+(long)(16*(wid&3)+(lane>>2))*QKVP+(wid>>2)*32+(lane&3)*8;
  const unsigned kdst=lds0+LDS_K+wid*1024, vdst=lds0+LDS_V+wid*1024;
  #define DMA_K(t,slot) glds16(ksrc+(long)(t)*KVBLK*QKVP,(unsigned)__builtin_amdgcn_readfirstlane(kdst+(slot)))
  #define DMA_V(t,slot) glds16(vsrc+(long)(t)*KVBLK*QKVP,(unsigned)__builtin_amdgcn_readfirstlane(vdst+(slot)))
  const int vb0=(int)(lds0+LDS_V)+((lane>>4)&1)*32+(lane&3)*8+(4*hi+((lane&15)>>2))*64;
  const char*Kbase=shm+LDS_K; bf16x8 kf[8];
  const lds_cptr shm3=(lds_cptr)shm; const lds_cptr kp0=shm3+LDS_K+hi*1024+r32*16; const lds_cptr vp0=shm3+LDS_V+((lane>>4)&1)*32+(lane&3)*8+(4*hi+((lane&15)>>2))*64;
  const int NT=(MODE==0)?(q0+QB)/KVBLK:NTU;
  DMA_K(0,0);DMA_V(0,0);DMA_K(1,SLOTB);
  if constexpr(MODE==0){ CUMFN(); }
  bf16x8 qr[4];
  #pragma unroll
  for(int d0=0;d0<4;++d0)qr[d0]=*reinterpret_cast<const bf16x8*>(&Qw[(long)r32*QKVP+d0*16+hi*8]);
  float mhat=0.f,l_reg=0.f;float z_=0.f;asm volatile("":"+v"(z_));f32x16 o[2];o[0]=(f32x16){z_,z_,z_,z_,z_,z_,z_,z_,z_,z_,z_,z_,z_,z_,z_,z_};o[1]=o[0];f32x16 negm=o[0];asm volatile("":"+v"(negm));
  const int qrel=wid*QBLK+r32;
  const __attribute__((address_space(3))) float*cum2=(const __attribute__((address_space(3))) float*)(shm+CUM_OFF);
  const float cq2=(MODE==0)?cum2[q0+qrel]:0.f;
  #define BIAS(P0,P1,t) do{ if constexpr(MODE==0){ const __attribute__((address_space(3))) float*cb_=cum2+64*(t)+4*hi; \
    _Pragma("unroll") for(int g_=0;g_<4;++g_){ const f32x4v c0_=*(const __attribute__((address_space(3))) f32x4v*)(cb_+8*g_), c1_=*(const __attribute__((address_space(3))) f32x4v*)(cb_+32+8*g_); \
      P0[4*g_+0]+=cq2-c0_.x; P0[4*g_+1]+=cq2-c0_.y; P0[4*g_+2]+=cq2-c0_.z; P0[4*g_+3]+=cq2-c0_.w; \
      P1[4*g_+0]+=cq2-c1_.x; P1[4*g_+1]+=cq2-c1_.y; P1[4*g_+2]+=cq2-c1_.z; P1[4*g_+3]+=cq2-c1_.w; } } }while(0)
  #define SELM(P0,P1,t) do{ if constexpr(MODE==1){ const unsigned w0_=selw[(2*(t))*32+r32]>>(4*hi), w1_=selw[(2*(t)+1)*32+r32]>>(4*hi); \
    _Pragma("unroll") for(int r=0;r<16;++r){ const int sh_=(r&3)+8*(r>>2); if(!((w0_>>sh_)&1u))P0[r]=-INFINITY; if(!((w1_>>sh_)&1u))P1[r]=-INFINITY; } } }while(0)
  #define CMASK(P0,P1,t) do{ if constexpr(MODE==0){int jb_=(t)-(NT-4); if(jb_>=0)cmask(P0,P1,jb_,qrel,hi);} }while(0)
  bool resc=false;
  #define START(P0,P1) do{ const float rm=rowmax(P0,P1); resc=false; \
    { const float dl=(MODE==1&&!(rm>-1e30f))?0.f:rm; mhat=fadd_s(mhat,dl); \
      _Pragma("unroll") for(int r=0;r<16;++r){P0[r]=fsub_s(P0[r],dl);P1[r]=fsub_s(P1[r],dl);} \
      _Pragma("unroll") for(int r=0;r<16;++r)negm[r]=-mhat; asm volatile("":"+v"(negm)); } \
    _Pragma("unroll") for(int r=0;r<16;++r)P0[r]=__builtin_amdgcn_exp2f(P0[r]); }while(0)
  #define RESC() do{ if(resc){ asm volatile("s_waitcnt lgkmcnt(0)":::"memory"); \
      _Pragma("unroll") for(int d_=0;d_<2;++d_) _Pragma("unroll") for(int r=0;r<16;++r)o[d_][r]*=wsf[crow(r,hi)]; } }while(0)
  f32x16 pA0,pA1,pB0,pB1;
  int sl_prev=0,sl_cur=0,sl_next=SLOTB;
  #define ROT() do{sl_prev=sl_cur;sl_cur=sl_next;sl_next=(sl_next==(NSLOT-1)*SLOTB)?0:sl_next+SLOTB;}while(0)
  DMA_K(2,2*SLOTB);
  WAIT_BAR(3);
  qkt(pA0,pA1,Kbase,qr,negm,r32,hi);asm volatile("s_nop 15\n\ts_nop 7":"+v"(pA0),"+v"(pA1));BIAS(pA0,pA1,0);SELM(pA0,pA1,0);CMASK(pA0,pA1,0);
  START(pA0,pA1);
  _Pragma("unroll") for(int r=0;r<16;++r)pA1[r]=__builtin_amdgcn_exp2f(pA1[r]);
  WAIT_BAR(0);
  DMA_K(3,0);DMA_V(1,SLOTB);
  ROT();
  kload8(kf,kp0+sl_cur);
  WAIT_BAR(2);
  s16x4 vlo[8],vhi[8]; u32x4 pw0,pw1,pw2,pw3;
  #define PKW(P,B) cvtpk_s(P[B],P[B+1])
  #define PAF(k) __builtin_bit_cast(bf16x8,pw##k)
  #define VFR(i) (bf16x8){vlo[i][0],vlo[i][1],vlo[i][2],vlo[i][3],vhi[i][0],vhi[i][1],vhi[i][2],vhi[i][3]}
  #define PIN(x) asm volatile("":"+v"(x))
  #define MX3(a,b,c) __builtin_fmaxf(__builtin_fmaxf((a),(b)),(c))
  #define GAPA(MF,A0,A1,A2,A3,W0,W1,PW) do{ MF; sacc+=A0; sacc+=A1; sacc+=A2; sacc+=A3; PIN(sacc); W0; W1; PIN(PW); SBAR(); }while(0)
  #define EX(v) __builtin_amdgcn_exp2f(v)
  #define GAPB(MF,X,B) do{ MF; X[B]=EX(X[B]); X[B+1]=EX(X[B+1]); X[B+2]=EX(X[B+2]); X[B+3]=EX(X[B+3]); PIN(X); SBAR(); }while(0)
  #define VRD(i) do{ vlo[i]=vtr(vp_+(((i)>>2)*4096+((i)&3)*1024)); vhi[i]=vtr(vp_+(((i)>>2)*4096+((i)&3)*1024+512)); }while(0)
  #define KRD(G,j) do{ if(G){ kload2(kf,kp0+sl_next,j); SBAR(); } }while(0)
  #define STEP(C0,C1,P0,P1,t,GK,GV,GL) do{ SBAR(); \
    const lds_cptr vp_=vp0+sl_prev; \
    VRD(0); SBAR(); float sacc=(P0[0]+P0[1]); \
    GAPA(C0=__builtin_amdgcn_mfma_f32_32x32x16_bf16(kf[0],qr[0],negm,0,0,0), P0[2],P0[3],P0[4],P0[5],     pw0[0]=PKW(P0,0), pw0[1]=PKW(P0,2), pw0); \
    VRD(4); SBAR(); GAPA(C1=__builtin_amdgcn_mfma_f32_32x32x16_bf16(kf[1],qr[0],negm,0,0,0), P0[6],P0[7],P0[8],P0[9],     pw0[2]=PKW(P0,4), pw0[3]=PKW(P0,6), pw0); \
    VRD(1); SBAR(); GAPA(C0=__builtin_amdgcn_mfma_f32_32x32x16_bf16(kf[2],qr[1],C0,0,0,0),   P0[10],P0[11],P0[12],P0[13], pw1[0]=PKW(P0,8), pw1[1]=PKW(P0,10), pw1); \
    VRD(5); SBAR(); GAPA(C1=__builtin_amdgcn_mfma_f32_32x32x16_bf16(kf[3],qr[1],C1,0,0,0),   P0[14],P0[15],P1[0],P1[1],   pw1[2]=PKW(P0,12),pw1[3]=PKW(P0,14), pw1); \
    VRD(2); SBAR(); GAPA(C0=__builtin_amdgcn_mfma_f32_32x32x16_bf16(kf[4],qr[2],C0,0,0,0),   P1[2],P1[3],P1[4],P1[5],     pw2[0]=PKW(P1,0), pw2[1]=PKW(P1,2), pw2); \
    VRD(6); SBAR(); GAPA(C1=__builtin_amdgcn_mfma_f32_32x32x16_bf16(kf[5],qr[2],C1,0,0,0),   P1[6],P1[7],P1[8],P1[9],     pw2[2]=PKW(P1,4), pw2[3]=PKW(P1,6), pw2); \
    VRD(3); SBAR(); GAPA(C0=__builtin_amdgcn_mfma_f32_32x32x16_bf16(kf[6],qr[3],C0,0,0,0),   P1[10],P1[11],P1[12],P1[13], pw3[0]=PKW(P1,8), pw3[1]=PKW(P1,10), pw3); \
    VRD(7); SBAR(); GAPA(C1=__builtin_amdgcn_mfma_f32_32x32x16_bf16(kf[7],qr[3],C1,0,0,0),   P1[14],P1[15],0.f,0.f,       pw3[2]=PKW(P1,12),pw3[3]=PKW(P1,14), pw3); \
    l_reg+=sacc; \
    if(GK){DMA_K((t)+3,sl_cur);} if(GV){DMA_V((t)+1,sl_next);} \
    BIAS(C0,C1,t); SELM(C0,C1,t); CMASK(C0,C1,t); \
    { float a=MX3(C0[0],C0[1],C1[0]),b=MX3(C0[2],C0[3],C1[1]); a=MX3(a,C1[2],C1[3]); \
      _Pragma("unroll") for(int r=4;r<16;r+=4){a=MX3(a,C0[r],C0[r+1]);b=MX3(b,C0[r+2],C0[r+3]);a=MX3(a,C1[r],C1[r+1]);b=MX3(b,C1[r+2],C1[r+3]);} \
      float rm=__builtin_fmaxf(a,b); { auto rr=__builtin_amdgcn_permlane32_swap(__float_as_uint(rm),__float_as_uint(rm),false,false); rm=__builtin_fmaxf(__uint_as_float(rr[0]),__uint_as_float(rr[1])); } \
      resc=false; \
      if(__builtin_expect(__any(rm>(float)THRL),0)){ const float dl=__builtin_fmaxf(rm,0.f); mhat+=dl; \
        _Pragma("unroll") for(int r=0;r<16;++r){C0[r]-=dl;C1[r]-=dl;} \
        _Pragma("unroll") for(int r=0;r<16;++r)negm[r]=-mhat; asm volatile("":"+v"(negm)); \
        const float f=__builtin_amdgcn_exp2f(-dl); l_reg*=f; if(hi==0)wsf[r32]=f; resc=true; } } \
    SBAR(); \
    GAPB(o[0]=__builtin_amdgcn_mfma_f32_32x32x16_bf16(PAF(0),VFR(0),o[0],0,0,0), C0,0); \
    GAPB(o[1]=__builtin_amdgcn_mfma_f32_32x32x16_bf16(PAF(0),VFR(4),o[1],0,0,0), C0,4); \
    KRD(GL,0); GAPB(o[0]=__builtin_amdgcn_mfma_f32_32x32x16_bf16(PAF(1),VFR(1),o[0],0,0,0), C0,8); \
    KRD(GL,1); GAPB(o[1]=__builtin_amdgcn_mfma_f32_32x32x16_bf16(PAF(1),VFR(5),o[1],0,0,0), C0,12); \
    KRD(GL,2); GAPB(o[0]=__builtin_amdgcn_mfma_f32_32x32x16_bf16(PAF(2),VFR(2),o[0],0,0,0), C1,0); \
    KRD(GL,3); GAPB(o[1]=__builtin_amdgcn_mfma_f32_32x32x16_bf16(PAF(2),VFR(6),o[1],0,0,0), C1,4); \
    GAPB(o[0]=__builtin_amdgcn_mfma_f32_32x32x16_bf16(PAF(3),VFR(3),o[0],0,0,0), C1,8); \
    GAPB(o[1]=__builtin_amdgcn_mfma_f32_32x32x16_bf16(PAF(3),VFR(7),o[1],0,0,0), C1,12); \
    }while(0)
  int t=1;
  #undef CMASK
  #define CMASK(P0,P1,t) do{}while(0)
  for(;t+5<NT;t+=2){
    STEP(pB0,pB1,pA0,pA1,t,true,true,true);     WAIT_BAR(2); RESC(); ROT();
    STEP(pA0,pA1,pB0,pB1,t+1,true,true,true);   WAIT_BAR(2); RESC(); ROT();
  }
  #undef CMASK
  #define CMASK(P0,P1,t) do{ if constexpr(MODE==0){int jb_=(t)-(NT-4); if(jb_>=0)cmask(P0,P1,jb_,qrel,hi);} }while(0)
  #define ENDW(tt) do{ if((tt)+3<NT){WAIT_BAR(2);} else if((tt)+2<NT){WAIT_BAR(1);} else {WAIT_BAR(0);} }while(0)
  for(;t+1<NT;t+=2){
    STEP(pB0,pB1,pA0,pA1,t,(t+3<NT),(t+1<NT),(t+1<NT));       ENDW(t);   RESC(); ROT();
    STEP(pA0,pA1,pB0,pB1,t+1,(t+4<NT),(t+2<NT),(t+2<NT));     ENDW(t+1); RESC(); ROT();
  }
  STEP(pB0,pB1,pA0,pA1,NT-1,false,false,false); RESC();
  { float sacc=pB0[0]+pB0[1]; _Pragma("unroll") for(int r=2;r<16;++r)sacc+=pB0[r]; _Pragma("unroll") for(int r=0;r<16;++r)sacc+=pB1[r]; l_reg+=sacc;
    pw0=(u32x4){PKW(pB0,0),PKW(pB0,2),PKW(pB0,4),PKW(pB0,6)};pw1=(u32x4){PKW(pB0,8),PKW(pB0,10),PKW(pB0,12),PKW(pB0,14)};pw2=(u32x4){PKW(pB1,0),PKW(pB1,2),PKW(pB1,4),PKW(pB1,6)};pw3=(u32x4){PKW(pB1,8),PKW(pB1,10),PKW(pB1,12),PKW(pB1,14)};
    SBAR(); pv(o,vb0+sl_cur,PAF(0),PAF(1),PAF(2),PAF(3)); }
  #undef PKW
  #undef PAF
  #undef VFR
  #undef PIN
  #undef MX3
  #undef GAPA
  #undef GAPB
  #undef EX
  #undef VRD
  #undef KRD
  #undef STEP
  #undef ENDW
  {auto rr=__builtin_amdgcn_permlane32_swap(__float_as_uint(l_reg),__float_as_uint(l_reg),false,false);l_reg=__uint_as_float(rr[0])+__uint_as_float(rr[1]);}
  if(hi==0)wsf[32+r32]=l_reg;asm volatile("s_waitcnt lgkmcnt(0)":::"memory");
  float rli[16];
  #pragma unroll
  for(int r=0;r<16;++r)rli[r]=__builtin_amdgcn_rcpf(wsf[32+crow(r,hi)]);
  bf16*Ow=(MODE==0)?O+(rowbase+q0+wid*QBLK)*OPI+h*D:O+(rowbase+q0)*OPI+wid*D;
  { bf16*stg=(bf16*)(shm+LDS_OST)+wid*2048;
    #pragma unroll
    for(int r=0;r<16;++r){const int orow=crow(r,hi);
      #pragma unroll
      for(int d0=0;d0<2;++d0)stg[orow*64+d0*32+r32]=__float2bfloat16(o[d0][r]*rli[r]);}
    asm volatile("s_waitcnt lgkmcnt(0)":::"memory");
    #pragma unroll
    for(int i=0;i<4;++i){const int row=i*8+(lane>>3),ch=lane&7; const u32x4 v=*(const u32x4*)(stg+row*64+ch*8); ATTN_STORE16(Ow+(long)row*OPI+ch*8,v);} }
  asm volatile("s_waitcnt lgkmcnt(0)\n\ts_barrier":::"memory");
  #undef DMA_K
  #undef DMA_V
  #undef CMASK
  #undef START
  #undef BIAS
  #undef SELM
  #undef RESC
  #undef ROT
}
#undef SBAR
#undef WAIT_BAR
}

#ifndef DBG_REP_SEL
#define DBG_REP_SEL 1
#endif
namespace mix {
__device__ __forceinline__ void fox_unit2(int b, int h, int qb, const bf16_t* Z1, const float* F, const float* bfp, bf16_t* Y, char* shm, const int wave_s) {
    const size_t rowb = (size_t)b * SEQ;
    const int nk = 256 * (qb + 1);
    auto cumfn = [=]() {
        const int tid = wave_s * 64 + lane_opaque(), lane = tid & 63; const int wid = __builtin_amdgcn_readfirstlane(tid >> 6);
        MLAS char* L = (MLAS char*)shm;
        MLAS float* cum2 = (MLAS float*)(L + foxa::CUM_OFF);
        MLAS float* wtot = (MLAS float*)(L + foxa::CUM_OFF + 8192);
        const float bias = bfp[h];
        const int s0 = 4 * tid;
        float v[4]; float run = 0.f;
#pragma unroll
        for (int i = 0; i < 4; ++i) {
            float x = 0.f;
            if (s0 + i < nk) x = F[(rowb + s0 + i) * 8 + h] + bias;
            const float ls = (s0 + i < nk) ? (fminf(x, 0.f) - log1pf(expf(-fabsf(x)))) : 0.f;
            run += ls; v[i] = run;
        }
        float inc = run;
#pragma unroll
        for (int o = 1; o < 64; o <<= 1) { const int ln = lane_opaque(); const float t = __builtin_bit_cast(float, __builtin_amdgcn_ds_bpermute((ln - o) << 2, __builtin_bit_cast(int, inc))); if (ln >= o) inc += t; }
        if (lane == 63) wtot[wid] = inc;
        LGKM_BAR();
        float off = inc - run;
        for (int w = 0; w < wid; ++w) off += wtot[w];
#pragma unroll
        for (int i = 0; i < 4; ++i) cum2[s0 + i] = (off + v[i]) * 1.4426950408889634f;
        LGKM_BAR();
    };
    foxa::attn_unit<8, 0, 2560>(cumfn, b, h, qb, 0, 0, (const foxa::bf16*)Z1, (const foxa::bf16*)(Z1 + 512), (const foxa::bf16*)(Z1 + 1024), (foxa::bf16*)Y, shm, nullptr, wave_s);
}
__device__ __forceinline__ void dsa_unit(int b, int qg, const bf16_t* Z0, bf16_t* Y, char* shm, unsigned lds0, const int wave_s) {
    for (int rep_ = 0; rep_ < DBG_REP_SEL; ++rep_) dsa_select(b, qg, Z0, shm, wave_s);
    const int nt64 = (qg >> 1) + 1; int ntu = (nt64 + 1) & ~1; if (ntu < 4) ntu = 4;
    foxa::attn_unit<8, 1, EV_N>([]() {}, b, 0, 0, 32 * qg, ntu, (const foxa::bf16*)(Z0 + 512), (const foxa::bf16*)(Z0 + 1024), (const foxa::bf16*)(Z0 + 1088), (foxa::bf16*)(Y + 512), shm,
                                (const MLAS unsigned*)((MLAS char*)shm + LX_SEL), wave_s);
}
}
constexpr int NWAVES = 8;
constexpr size_t KiB = 1024, MiB = 1u << 20;
constexpr size_t WS_CTL = 0, CTL_ZERO_BYTES = 1 * MiB;
constexpr size_t WS_W_EVIN = 1 * MiB, WS_W_OUT0 = 4 * MiB, WS_W_FFI0 = 6 * MiB, WS_W_FFO0 = 17 * MiB, WS_W_PG0 = 22 * MiB + 512 * KiB, WS_W_PP0 = 24 * MiB + 512 * KiB;
constexpr size_t WS_W_ODIN = 25 * MiB, WS_W_OUT1 = 30 * MiB + 512 * KiB, WS_W_FFI1 = 32 * MiB + 512 * KiB, WS_W_FFO1 = 43 * MiB + 512 * KiB, WS_W_PG1 = 49 * MiB, WS_W_PP1 = 51 * MiB, WS_W_SGU = 51 * MiB + 512 * KiB;
constexpr size_t WS_RSTD = 57 * MiB + 768 * KiB;
constexpr size_t WS_SSQA = 52 * MiB, WS_SSQB = 53 * MiB, WS_ROPE = 54 * MiB, WS_AH = 55 * MiB, WS_FBUF = 58 * MiB + 512 * KiB, WS_SST = 59 * MiB;
constexpr size_t WS_HB = 60 * MiB, WS_AHALO = 92 * MiB, WS_PP = 92 * MiB + 512 * KiB, WS_Y = 124 * MiB + 512 * KiB, WS_ZH = 156 * MiB + 512 * KiB, WS_PB = 244 * MiB + 512 * KiB, WS_END = 252 * MiB + 512 * KiB;
static_assert(WS_AHALO == WS_HB + (size_t)TOK * 1024 * 2, "the halo rows are row tile 64 of the FFN in-projection A operand");
static_assert(WS_W_EVIN + (size_t)EV_N * 1024 * 2 <= WS_W_OUT0 && WS_W_FFI0 + (size_t)NFF2 * 1024 * 2 <= WS_W_FFO0 && WS_W_FFO0 + (size_t)1024 * DFF * 2 <= WS_W_PG0, "ws map 1");
static_assert(WS_W_ODIN + (size_t)OD_N * 1024 * 2 <= WS_W_OUT1 && WS_W_FFI1 + (size_t)NFF2 * 1024 * 2 <= WS_W_FFO1 && WS_W_FFO1 + (size_t)1024 * DFF * 2 <= WS_W_PG1 && WS_W_SGU + 4 * 128 * 128 * 2 <= WS_SSQA, "ws map 2");
static_assert(WS_AH + (size_t)128 * NFF2 * 4 <= WS_RSTD && WS_ZH + (size_t)TOK * DFF * 2 <= WS_PB && WS_PB + (size_t)TOK * PLE * 2 <= WS_END, "ws map 3");
constexpr int CW_BAR = 4096, CW_FLAG = 8192;
constexpr int RING_BYTES = 131072, XB_OFF = RING_BYTES, LDSCTL_OFF = XB_OFF + 8192 + 1024 + 64, MISC_OFF = LDSCTL_OFF + 320, LDS_BYTES = 147456;
static_assert(MISC_OFF + 128 <= LDS_BYTES, "LDS map");

#define GAS __attribute__((address_space(1)))
#define LAS __attribute__((address_space(3)))
typedef unsigned short bf16;
typedef unsigned v4u __attribute__((ext_vector_type(4)));
typedef float f32x4 __attribute__((ext_vector_type(4)));
typedef float f32x2 __attribute__((ext_vector_type(2)));
#define LDS_WAIT() asm volatile("s_waitcnt lgkmcnt(0)" ::: "memory")
#define VM_WAIT() asm volatile("s_waitcnt vmcnt(0)" ::: "memory")
__device__ __forceinline__ unsigned f2bf(float f) { unsigned u = __builtin_bit_cast(unsigned, f); return (u + 0x7fffu + ((u >> 16) & 1u)) >> 16; }
__device__ __forceinline__ unsigned pk2(float lo, float hi) { return f2bf(lo) | (f2bf(hi) << 16); }

#define XB_TMO      128
#define XB_XCNT(j)  (256  + 64 * (j))
#define XB_XSUB(j)  (1280 + 64 * (j))
#define XB_XGEN(j)  (2304 + 64 * (j))
#define XB_TOP      3328
#define XB_TOPGEN   3392
#define XCD_BAR_WORDS 3456
#define XB_SPIN_CAP (1u << 18)
__device__ __forceinline__ unsigned xb_ld(unsigned* p)              { return __hip_atomic_load(p, __ATOMIC_RELAXED, __HIP_MEMORY_SCOPE_AGENT); }
__device__ __forceinline__ unsigned xb_add(unsigned* p, unsigned v) { return __hip_atomic_fetch_add(p, v, __ATOMIC_RELAXED, __HIP_MEMORY_SCOPE_AGENT); }
__device__ __forceinline__ unsigned xb_xcc_id() { return (unsigned)__builtin_amdgcn_s_getreg((3 << 11) | 20) & 0xFu; }
#define XB_SPIN(cond, bar) do { unsigned _sp = 0; while (cond) { __builtin_amdgcn_s_sleep(1); \
    if ((++_sp & 255u) == 0u) { if (xb_ld(&(bar)[XB_TMO])) break; if (_sp > XB_SPIN_CAP) { atomicAdd(&(bar)[XB_TMO], 1u); break; } } } } while (0)
struct XcdBarrier { unsigned* bar; unsigned x; volatile LAS unsigned* st; };
__device__ __forceinline__ XcdBarrier xcd_barrier_post(unsigned* bar, volatile LAS unsigned* st) {
    XcdBarrier b; b.bar = bar; b.x = xb_xcc_id(); b.st = st;
    if (threadIdx.x == 0) (void)xb_add(&bar[XB_XCNT(b.x)], 1u);
    return b;
}
__device__ __forceinline__ void xcd_barrier_complete(unsigned* bar, unsigned x, unsigned& nloc, unsigned& nx) {
    const unsigned G = gridDim.x * gridDim.y * gridDim.z;
    unsigned sum, cnt, mine, sp = 0u;
    for (;;) {
        sum = 0u; cnt = 0u; mine = 0u;
#pragma unroll 1
        for (unsigned j = 0; j < 16; ++j) { const unsigned c = xb_ld(&bar[XB_XCNT(j)]); sum += c; cnt += (c > 0u) ? 1u : 0u; mine = (j == x) ? c : mine; }
        if (sum == G) break;
        __builtin_amdgcn_s_sleep(1);
        if ((++sp & 255u) == 0u) { if (xb_ld(&bar[XB_TMO])) break; if (sp > XB_SPIN_CAP) { atomicAdd(&bar[XB_TMO], 1u); break; } }
    }
    nloc = mine > 0u ? mine : 1u; nx = cnt > 0u ? cnt : 1u;
}
__device__ __forceinline__ void xcd_barrier(const XcdBarrier& b) {
    asm volatile("s_waitcnt vmcnt(0)" ::: "memory");
    __syncthreads();
    if (threadIdx.x == 0) {
        unsigned* bar = b.bar;
        __builtin_amdgcn_s_waitcnt(0);
        unsigned nloc = b.st[0], nx = b.st[1];
        if (nloc == 0u) { xcd_barrier_complete(bar, b.x, nloc, nx); b.st[0] = nloc; b.st[1] = nx; }
        const unsigned old = xb_add(&bar[XB_XSUB(b.x)], 1u);
        const unsigned gen = old / nloc;
        if (old + 1u == (gen + 1u) * nloc) {
            __builtin_amdgcn_fence(__ATOMIC_RELEASE, "agent");
            asm volatile("s_waitcnt vmcnt(0)" ::: "memory");
            const unsigned og = xb_add(&bar[XB_TOP], 1u);
            const unsigned tg = og / nx;
            if (og + 1u == (tg + 1u) * nx) xb_add(&bar[XB_TOPGEN], 1u);
            else XB_SPIN(xb_ld(&bar[XB_TOPGEN]) == tg, bar);
            __builtin_amdgcn_fence(__ATOMIC_ACQUIRE, "agent");
            xb_add(&bar[XB_XGEN(b.x)], 1u);
            asm volatile("s_waitcnt vmcnt(0)" ::: "memory");
        } else {
            XB_SPIN(xb_ld(&bar[XB_XGEN(b.x)]) == gen, bar);
            __builtin_amdgcn_fence(__ATOMIC_ACQUIRE, "agent");
            asm volatile("s_waitcnt vmcnt(0)" ::: "memory");
        }
    }
    __syncthreads();
}

__device__ __forceinline__ float wave_sum(float v) {
#pragma unroll
    for (int o = 1; o < 64; o <<= 1) v += __builtin_bit_cast(float, __builtin_amdgcn_ds_bpermute((lane_opaque() ^ o) << 2, __builtin_bit_cast(int, v)));
    return v;
}
__device__ __forceinline__ int vcu_of(int i, int n) { return i; }
__device__ __forceinline__ int unperm16(int d) { return d < 16 ? ((d >> 1) + 8 * (d & 1)) : d; }
__device__ __forceinline__ int map_col(int type, int n, int nold) {
    if (type == 0) return n < nold ? n : -1;
    if (type == 1) {
        if (n < 512) return n;
        if (n < 1024) { const int h = (n - 512) >> 6, d = (n - 512) & 63; return 512 + 64 * h + unperm16(d); }
        if (n < 1088) return 1024 + unperm16(n - 1024);
        if (n < 1152) return n;
        if (n < 1216) return 1408 + unperm16(n - 1152);
        if (n < 1220) return 1472 + (n - 1216);
        if (n < 1280) return -1;
        { const int h = (n - 1280) >> 6, d = (n - 1280) & 63; return 1152 + 64 * h + unperm16(d); }
    }
    if (type == 2) {
        if (n < 1536) return n;
        if (n < 2560) return n + 8;
        if (n < 2568) return 1536 + (n - 2560);
        return -1;
    }
    { const int pn = n >> 8, bj = (n >> 7) & 1, jj = n & 127; return bj * DFF + 128 * pn + jj; }
}
struct TJob { const float* W; const float* rowscale; bf16* WT; int K, Nold, Nnew, ldk, koff, type, nitems; };
__device__ __forceinline__ void transpose_item(const TJob& J, LAS float* scr, int item, int lane) {
    const int nblk = J.Nnew / 32, kb = item / nblk, nb = item % nblk, k0 = 64 * kb, n0 = 32 * nb;
    const int oc = map_col(J.type, n0 + (lane & 31), J.Nold);
    const int occ = oc >= 0 ? oc : 0;
    float vv[32];
#pragma unroll
    for (int i = 0; i < 32; ++i) vv[i] = J.W[(size_t)(k0 + 2 * i + (lane >> 5)) * J.Nold + occ];
#pragma unroll
    for (int i = 0; i < 32; ++i) { const int kk = 2 * i + (lane >> 5);
        float v = (oc >= 0) ? vv[i] : 0.f;
        if (J.rowscale) v *= J.rowscale[k0 + kk];
        scr[kk * 33 + (lane & 31)] = v; }
    LDS_WAIT(); asm volatile("" ::: "memory");
    const int c = lane & 7;
#pragma unroll
    for (int j = 0; j < 4; ++j) { const int n = (lane >> 3) + 8 * j; const LAS float* s = scr + (8 * c) * 33 + n;
        v4u o; o.x = pk2(s[0 * 33], s[1 * 33]); o.y = pk2(s[2 * 33], s[3 * 33]); o.z = pk2(s[4 * 33], s[5 * 33]); o.w = pk2(s[6 * 33], s[7 * 33]);
        *(GAS v4u*)(J.WT + (size_t)(n0 + n) * J.ldk + J.koff + k0 + 8 * c) = o; }
    LDS_WAIT(); asm volatile("" ::: "memory");
}
__device__ __forceinline__ void sincos_d(double a, float& sn, float& cs) {
    const double q = rint(a * 0.63661977236758134308);
    double r = a - q * 1.57079632673412561417e+00; r -= q * 6.07710050650619224932e-11;
    const double r2 = r * r;
    double s = 1.0 / 6227020800.0; s = s * r2 - 1.0 / 39916800.0; s = s * r2 + 1.0 / 362880.0; s = s * r2 - 1.0 / 5040.0; s = s * r2 + 1.0 / 120.0; s = s * r2 - 1.0 / 6.0; s = s * r2 * r + r;
    double c = -1.0 / 87178291200.0; c = c * r2 + 1.0 / 479001600.0; c = c * r2 - 1.0 / 3628800.0; c = c * r2 + 1.0 / 40320.0; c = c * r2 - 1.0 / 720.0; c = c * r2 + 1.0 / 24.0; c = c * r2 - 0.5; c = c * r2 + 1.0;
    const int qi = ((int)q) & 3;
    const double ss = (qi == 0) ? s : (qi == 1) ? c : (qi == 2) ? -s : -c;
    const double cc = (qi == 0) ? c : (qi == 1) ? -s : (qi == 2) ? -c : s;
    sn = (float)ss; cs = (float)cc;
}

struct Args { const void* in[24]; float* out; unsigned char* ws; int ph_lo, ph_hi; };
typedef const Args __attribute__((address_space(4)))* argp_t;
__device__ __forceinline__ argp_t get_args() { argp_t p = (argp_t)__builtin_amdgcn_kernarg_segment_ptr(); asm volatile("" : "+s"(p)); return p; }
__device__ __forceinline__ int otid(int wave_s) { return wave_s * 64 + lane_opaque(); }
#define IN_F(k) ((const float*)A_->in[k])
#define PH_LOCALS \
    argp_t A_ = get_args(); unsigned char* const ws = A_->ws; float* const out = A_->out; (void)out; \
    const int tid = otid(wave_s), lane = tid & 63, wave = wave_s; (void)lane; (void)wave; \
    const int G = gridDim.x, bx = blockIdx.x, vcu = (G % 8 == 0) ? (bx % 8) * (G / 8) + bx / 8 : bx; (void)vcu; \
    const int gw = vcu * NWAVES + wave, NGW = G * NWAVES, gt = vcu * (NWAVES * 64) + tid, NGT = G * NWAVES * 64; (void)gw; (void)NGW; (void)gt; (void)NGT; \
    LAS unsigned char* const L = (LAS unsigned char*)lds; (void)L;
#define WSP(T, off) ((T*)(ws + (off)))

__global__ void __launch_bounds__(NWAVES * 64, 2) mega_fwd(Args args) {
    extern __shared__ __attribute__((aligned(16))) unsigned char lds[];
    int lo, hi; XcdBarrier bar;
    const int wave_s = __builtin_amdgcn_readfirstlane((int)threadIdx.x >> 6);
    {
        PH_LOCALS
        volatile LAS unsigned* MISC = (volatile LAS unsigned*)(L + MISC_OFF);
        for (int u = tid; u < (LDS_BYTES - XB_OFF) / 4; u += NWAVES * 64) ((LAS unsigned*)(L + XB_OFF))[u] = 0u;
        __syncthreads();
        bar = xcd_barrier_post((unsigned*)(ws + WS_CTL) + CW_BAR, MISC + 8);
        lo = A_->ph_lo; hi = A_->ph_hi;
    }
#ifndef DBG_REP_TR
#define DBG_REP_TR 1
#endif
#ifndef DBG_REP_HB
#define DBG_REP_HB 1
#endif
#ifndef DBG_REP_FOX
#define DBG_REP_FOX 1
#endif
#ifndef DBG_REP_DSA
#define DBG_REP_DSA 1
#endif
#ifndef DBG_REP_SGU
#define DBG_REP_SGU 1
#endif
#ifndef DBG_REP_POOL
#define DBG_REP_POOL 1
#endif
#ifndef PHMASK
#define PHMASK 0xffffffu
#endif
#define IN(k) (((PHMASK >> (k)) & 1u) && lo <= (k) && (k) < hi)
#define SEAM(k) do { if (IN(k) && IN((k) + 1)) xcd_barrier(bar); } while (0)
    if (IN(0)) {
        PH_LOCALS
        LAS float* scr = (LAS float*)(L + wave * 16384);
        const float* norm_mix = IN_F(3); const float* norm_ffn = IN_F(4); const float* norm_ple = IN_F(5);
        const float* ffn_w_in = IN_F(6); const float* ffn_w_out = IN_F(9); const float* ple_w_proj = IN_F(10); const float* ple_w_gate = IN_F(11);
        const float* ev_w_in = IN_F(13); const float* ev_w_out = IN_F(14); const float* od_w_in = IN_F(17); const float* od_w_out = IN_F(18);
#define TJ(Wp, RS, WTp, K_, NOLD, NNEW, LDK, KOFF, TYPE) { constexpr int NI_ = ((K_) / 64) * ((NNEW) / 32); if (r < NI_) { const TJob J{(Wp), (RS), (WTp), (K_), (NOLD), (NNEW), (LDK), (KOFF), (TYPE), NI_}; transpose_item(J, scr, r, lane); continue; } r -= NI_; }
        constexpr int NITEMS = 16 * 48 + 8 * 32 + 44 * 32 + 4 * 32;
        for (int rep_ = 0; rep_ < DBG_REP_TR; ++rep_) for (int it = gw; it < NITEMS; it += NGW) {
            int r = it;
            TJ(ev_w_in, norm_mix, WSP(bf16, WS_W_EVIN), 1024, 1476, EV_N, 1024, 0, 1)
            TJ(ev_w_out + (size_t)512 * 1024, nullptr, WSP(bf16, WS_W_OUT0), 512, 1024, 1024, 1024, 512, 0)
            TJ(ffn_w_out + (size_t)DFF * 1024, nullptr, WSP(bf16, WS_W_FFO1), DFF, 1024, 1024, DFF, 0, 0)
            TJ(ple_w_proj + (size_t)256 * 1024, nullptr, WSP(bf16, WS_W_PP1), 256, 1024, 1024, 256, 0, 0)
        }
#undef TJ
        { const float* sgu_w = IN_F(22); bf16* W_SGU = WSP(bf16, WS_W_SGU);
          for (int i = gt; i < 4 * 128 * 128; i += NGT) { const int jj = i & 127, ii = (i >> 7) & 127; W_SGU[i] = (bf16)((ii < 64 && jj >= 64) ? 0u : f2bf(sgu_w[i])); } }
        { const float* x = IN_F(0); bf16* HB = WSP(bf16, WS_HB); float* SSQA = WSP(float, WS_SSQA);
          for (int m = gw; m < TOK; m += 4 * NGW) {
            f32x4 v[4][4];
#pragma unroll
            for (int q = 0; q < 4; ++q) { const int mm = (m + q * NGW < TOK) ? m + q * NGW : m; const f32x4* xr = (const f32x4*)(x + (size_t)mm * DMODEL) + lane;
#pragma unroll
                for (int j = 0; j < 4; ++j) v[q][j] = xr[64 * j]; }
#pragma unroll
            for (int q = 0; q < 4; ++q) { const int mm = m + q * NGW; if (mm < TOK) {
                float s = 0.f; unsigned long long* o8 = (unsigned long long*)(HB + (size_t)mm * DMODEL) + lane;
#pragma unroll
                for (int j = 0; j < 4; ++j) { const f32x4 w = v[q][j]; s += (w.x * w.x + w.y * w.y) + (w.z * w.z + w.w * w.w);
                    o8[64 * j] = (unsigned long long)pk2(w.x, w.y) | ((unsigned long long)pk2(w.z, w.w) << 32); }
                s = wave_sum(s);
                if (lane < 16) SSQA[(size_t)mm * 16 + lane] = (lane == 0) ? s : 0.f; } }
          } }
        { const float* p_in = IN_F(1); bf16* PB = WSP(bf16, WS_PB);
          for (int i = gt; i < TOK * PLE / 4; i += 4 * NGT) { f32x4 v[4];
#pragma unroll
            for (int q = 0; q < 4; ++q) v[q] = ((const f32x4*)p_in)[(i + q * NGT < TOK * PLE / 4) ? i + q * NGT : i];
#pragma unroll
            for (int q = 0; q < 4; ++q) if (i + q * NGT < TOK * PLE / 4) ((unsigned long long*)PB)[i + q * NGT] = (unsigned long long)pk2(v[q].x, v[q].y) | ((unsigned long long)pk2(v[q].z, v[q].w) << 32); } }
        { const int* positions = (const int*)A_->in[2]; f32x2* ROPE = WSP(f32x2, WS_ROPE);
          for (int i = gt; i < TOK * 8; i += NGT) {
            const int row = i >> 3, j = i & 7;
            const float invf = (j == 0) ? 1.0f : (j == 1) ? 0.1939227432012558f : (j == 2) ? 0.03760603070259094f : (j == 3) ? 0.007292664609849453f : (j == 4) ? 0.0014142135623842478f :
                               (j == 5) ? 0.00027424818836152554f : (j == 6) ? 5.3182957344688475e-05f : 1.0313385246263351e-05f;
            const float ang = (float)positions[row] * invf;
            float sn, cs; sincos_d((double)ang, sn, cs);
            ROPE[i] = (f32x2){cs, sn};
          } }
    }
    SEAM(0);
    if (IN(1)) {
        { PH_LOCALS
          pg8::Gemm g{WSP(bf16, WS_HB), WSP(bf16, WS_W_EVIN), TOK, EV_N, 1024}; pg8::StaticOrder S; S.init(TOK, EV_N, G, bx);
          pg8::EpiEvenIn E{WSP(float, WS_SSQA), WSP(bf16, WS_ZH), WSP(const pg8::f32x2, WS_ROPE)};
          pg8::gemm_phase<pg8::EpiEvenIn, pg8::StaticOrder, true, true>(L, g, S, E, wave_s); }
        if (gridDim.x == 256 && blockIdx.x >= 128) {
            PH_LOCALS
            LAS float* scr = (LAS float*)(L + wave * 16384);
            const float* norm_mix = IN_F(3); const float* norm_ffn = IN_F(4); const float* norm_ple = IN_F(5);
            const float* ffn_w_in = IN_F(6); const float* ffn_w_out = IN_F(9); const float* ple_w_proj = IN_F(10); const float* ple_w_gate = IN_F(11);
            const float* od_w_in = IN_F(17); const float* od_w_out = IN_F(18);
#define TJ(Wp, RS, WTp, K_, NOLD, NNEW, LDK, KOFF, TYPE) { constexpr int NI_ = ((K_) / 64) * ((NNEW) / 32); if (r < NI_) { const TJob J{(Wp), (RS), (WTp), (K_), (NOLD), (NNEW), (LDK), (KOFF), (TYPE), NI_}; transpose_item(J, scr, r, lane); continue; } r -= NI_; }
            constexpr int NITEMS_B = (16 * 176 + 44 * 32 + 16 * 32 + 4 * 32) + 16 * 88 + 16 * 32;
            const int gwb = (vcu_of(bx - 128, 128)) * NWAVES + wave, NGWB = 128 * NWAVES;
            for (int it = gwb; it < NITEMS_B; it += NGWB) {
                int r = it;
                TJ(ffn_w_in, norm_ffn, WSP(bf16, WS_W_FFI0), 1024, NFF2, NFF2, 1024, 0, 3)
                TJ(ffn_w_out, nullptr, WSP(bf16, WS_W_FFO0), DFF, 1024, 1024, DFF, 0, 0)
                TJ(ple_w_gate, norm_ple, WSP(bf16, WS_W_PG0), 1024, 1024, 1024, 1024, 0, 0)
                TJ(ple_w_proj, nullptr, WSP(bf16, WS_W_PP0), 256, 1024, 1024, 256, 0, 0)
                TJ(od_w_in, norm_mix + 1024, WSP(bf16, WS_W_ODIN), 1024, 2568, OD_N, 1024, 0, 2)
                TJ(od_w_out, nullptr, WSP(bf16, WS_W_OUT1), 1024, 1024, 1024, 1024, 0, 0)
            }
#undef TJ
        {
            const float* pool_w = IN_F(15); const float* pool_scale = IN_F(16); const float* ev_w_out = IN_F(14); bf16* W_OUT0 = WSP(bf16, WS_W_OUT0);
            for (int it = gwb; it < 1024; it += NGWB) {
                const int g = it >> 8, nb = (it >> 4) & 15, cb = it & 15, n = 64 * nb + lane;
                float acc[8];
#pragma unroll
                for (int cc = 0; cc < 8; ++cc) acc[cc] = 0.f;
#pragma unroll 1
                for (int d0 = 0; d0 < 128; d0 += 16) {
                    float wv[16];
#pragma unroll
                    for (int e = 0; e < 16; ++e) wv[e] = ev_w_out[(size_t)(128 * g + d0 + e) * 1024 + n] * pool_scale[128 * g + d0 + e];
#pragma unroll
                    for (int cc = 0; cc < 8; ++cc) {
                        const float* pw = pool_w + ((size_t)g * 128 + 8 * cb + cc) * 128 + d0;
#pragma unroll
                        for (int e = 0; e < 16; ++e) acc[cc] += pw[e] * wv[e];
                    }
                }
#pragma unroll
                for (int c2 = 0; c2 < 4; ++c2) *(unsigned*)(W_OUT0 + (size_t)n * 1024 + 128 * g + 8 * cb + 2 * c2) = pk2(acc[2 * c2], acc[2 * c2 + 1]);
            }
        }
        }
    }
    SEAM(1);
    if (IN(2)) {
        { PH_LOCALS
          const bf16* ZH = WSP(bf16, WS_ZH); bf16* Y = WSP(bf16, WS_Y); const unsigned lds0 = (unsigned)(uintptr_t)lds;
          for (int pi = vcu; pi < 256; pi += G) {
            const int b = pi >> 5, s = pi & 31;
#pragma unroll 1
            for (int k = 0; k < 2 * DBG_REP_DSA; ++k) mix::dsa_unit(b, (k & 1) ? s : 63 - s, ZH, Y, (char*)lds, lds0, wave_s);
          } }
        { PH_LOCALS
          const bf16* ZH = WSP(bf16, WS_ZH); bf16* Y = WSP(bf16, WS_Y);
          for (int rep_ = 0; rep_ < DBG_REP_POOL; ++rep_) for (int it = gt; it < TOK * 64; it += NGT) mix::pool_item(it, ZH, Y);
        }
    }
    SEAM(2);
    {
        const size_t s1o = (0 == 0) ? WS_SSQA : WS_SSQB, s2o = (0 == 0) ? WS_SSQB : WS_SSQA, s3o = s1o;
        if (IN(3)) {
            PH_LOCALS
            pg8::Gemm g{WSP(bf16, WS_Y), WSP(bf16, (0 == 0) ? WS_W_OUT0 : WS_W_OUT1), TOK, 1024, 1024}; pg8::StaticOrder S; S.init(TOK, 1024, G, bx);
            pg8::EpiRes E{IN_F(0), nullptr, WSP(bf16, WS_HB), WSP(float, s1o), WSP(bf16, WS_AHALO)};
            pg8::gemm_phase<pg8::EpiRes, pg8::StaticOrder, true, true>(L, g, S, E, wave_s);
        }
        SEAM(3);
        if (IN(3 + 2)) {
            PH_LOCALS
            pg8::Gemm g{WSP(bf16, WS_HB), WSP(bf16, WS_W_FFI0), TOK + 256, NFF2, 1024}; pg8::StaticOrder S; S.init(TOK, NFF2, G, bx);
            if (G == 256 && bx >= 128 && bx < 128 + NFF2 / 256) {
                pg8::OneUnit S1{64, bx - 128, 1};
                pg8::EpiHaloF EH{WSP(float, s1o), WSP(float, WS_AH), (unsigned*)(ws + WS_CTL) + CW_FLAG + 2048 * 0};
                pg8::gemm_phase<pg8::EpiHaloF, pg8::OneUnit, true, true>(L, g, S1, EH, wave_s);
            }
            pg8::EpiFfnIn E{WSP(float, s1o), IN_F(7) + (size_t)0 * 3 * NFF2, IN_F(8) + (size_t)0 * NFF2, WSP(float, WS_AH), WSP(bf16, WS_ZH), (LAS float*)(L + XB_OFF), (unsigned*)(ws + WS_CTL) + CW_FLAG + 2048 * 0, 1u};
            pg8::gemm_phase<pg8::EpiFfnIn, pg8::StaticOrder, true, true>(L, g, S, E, wave_s);
            if (G == 256 && bx >= 150) {
                pg8::Gemm gp{WSP(bf16, WS_PB), WSP(bf16, WS_W_PP0), TOK, 1024, PLE}; pg8::StaticOrder SP; SP.init(TOK, 1024, 106, bx - 150);
                pg8::EpiBf16Plain EP{WSP(bf16, WS_PP), 1024};
                pg8::gemm_phase<pg8::EpiBf16Plain, pg8::StaticOrder, true, true>(L, gp, SP, EP, wave_s);
            }
        }
        SEAM(3 + 2);
        if (IN(3 + 3)) {
            PH_LOCALS
            pg8::Gemm g{WSP(bf16, WS_ZH), WSP(bf16, (0 == 0) ? WS_W_FFO0 : WS_W_FFO1), TOK, 1024, DFF}; pg8::StaticOrder S; S.init(TOK, 1024, G, bx);
            pg8::EpiRes E{nullptr, WSP(bf16, WS_HB), WSP(bf16, WS_HB), WSP(float, s2o), nullptr};
            pg8::gemm_phase<pg8::EpiRes, pg8::StaticOrder, true, true>(L, g, S, E, wave_s);
        }
        SEAM(3 + 3);
        if (IN(3 + 4)) {
            PH_LOCALS
            pg8::Gemm g{WSP(bf16, WS_HB), WSP(bf16, (0 == 0) ? WS_W_PG0 : WS_W_PG1), TOK, 1024, 1024}; pg8::StaticOrder S; S.init(TOK, 1024, G, bx);
            pg8::EpiGate E{WSP(float, s2o), WSP(bf16, WS_HB), WSP(bf16, WS_PP), (bf16*)out, WSP(float, s3o)};
            pg8::gemm_phase<pg8::EpiGate, pg8::StaticOrder, true, true>(L, g, S, E, wave_s);
        }
        SEAM(3 + 4);
    }
    {

            if (IN(8)) {
                { PH_LOCALS
                  pg8::Gemm g{(const bf16*)out, WSP(bf16, WS_W_ODIN), TOK, OD_N, 1024}; pg8::StaticOrder S; S.init(TOK, OD_N, G, bx);
                  pg8::EpiOddIn E{WSP(float, WS_SSQA), WSP(bf16, WS_ZH), WSP(float, WS_FBUF), WSP(float, WS_SST)};
                  pg8::gemm_phase<pg8::EpiOddIn, pg8::StaticOrder, true, true>(L, g, S, E, wave_s); }
                if (gridDim.x == 256 && blockIdx.x >= 192) {
                    PH_LOCALS
                    LAS float* scr = (LAS float*)(L + wave * 16384);
                    const float* norm_ffn = IN_F(4); const float* norm_ple = IN_F(5); const float* ffn_w_in = IN_F(6); const float* ple_w_gate = IN_F(11);
#define TJ(Wp, RS, WTp, K_, NOLD, NNEW, LDK, KOFF, TYPE) { constexpr int NI_ = ((K_) / 64) * ((NNEW) / 32); if (r < NI_) { const TJob J{(Wp), (RS), (WTp), (K_), (NOLD), (NNEW), (LDK), (KOFF), (TYPE), NI_}; transpose_item(J, scr, r, lane); continue; } r -= NI_; }
                    constexpr int NITEMS_C = 16 * 176 + 16 * 32;
                    const int gwc = (bx - 192) * NWAVES + wave, NGWC = 64 * NWAVES;
                    for (int it = gwc; it < NITEMS_C; it += NGWC) {
                        int r = it;
                        TJ(ffn_w_in + (size_t)1024 * NFF2, norm_ffn + 1024, WSP(bf16, WS_W_FFI1), 1024, NFF2, NFF2, 1024, 0, 3)
                        TJ(ple_w_gate + (size_t)1024 * 1024, norm_ple + 1024, WSP(bf16, WS_W_PG1), 1024, 1024, 1024, 1024, 0, 0)
                    }
#undef TJ
                    const float* p1 = IN_F(1) + (size_t)TOK * PLE; bf16* PB = WSP(bf16, WS_PB);
                    const int gtc = (bx - 192) * (NWAVES * 64) + tid, NGTC = 64 * NWAVES * 64;
                    for (int i = gtc; i < TOK * PLE / 4; i += 4 * NGTC) { f32x4 v[4];
#pragma unroll
                        for (int q = 0; q < 4; ++q) v[q] = ((const f32x4*)p1)[(i + q * NGTC < TOK * PLE / 4) ? i + q * NGTC : i];
#pragma unroll
                        for (int q = 0; q < 4; ++q) if (i + q * NGTC < TOK * PLE / 4) ((unsigned long long*)PB)[i + q * NGTC] = (unsigned long long)pk2(v[q].x, v[q].y) | ((unsigned long long)pk2(v[q].z, v[q].w) << 32); }
                }
            }
            SEAM(8);
            if (IN(9)) {
                { PH_LOCALS
                  const bf16* ZH = WSP(bf16, WS_ZH); bf16* Y = WSP(bf16, WS_Y); const unsigned lds0 = (unsigned)(uintptr_t)lds;
                  const float* FBUF = WSP(float, WS_FBUF); const float* fox_b_f = IN_F(19);
                  for (int pi = vcu; pi < 256; pi += G) {
                    const int bh = pi >> 2, s = pi & 3;
#pragma unroll 1
                    for (int k = 0; k < 2 * DBG_REP_FOX; ++k) mix::fox_unit2(bh >> 3, bh & 7, (k & 1) ? s : 7 - s, ZH, FBUF, fox_b_f, Y, (char*)lds, wave_s);
                  } }
                { PH_LOCALS
                  const bf16* ZH = WSP(bf16, WS_ZH); bf16* Y = WSP(bf16, WS_Y);
                  for (int rep_ = 0; rep_ < DBG_REP_SGU; ++rep_) for (int u = vcu; u < 512; u += G) mix::sgu_unit(u >> 6, (u >> 2) & 15, u & 3, ZH, WSP(float, WS_SST), IN_F(20), IN_F(21), WSP(bf16, WS_W_SGU), IN_F(23), Y, (char*)lds, wave_s); }
            }
            SEAM(9);
            }
    {
        const size_t s1o = (1 == 0) ? WS_SSQA : WS_SSQB, s2o = (1 == 0) ? WS_SSQB : WS_SSQA, s3o = s1o;
        if (IN(10)) {
            PH_LOCALS
            pg8::Gemm g{WSP(bf16, WS_Y), WSP(bf16, (1 == 0) ? WS_W_OUT0 : WS_W_OUT1), TOK, 1024, 1024}; pg8::StaticOrder S; S.init(TOK, 1024, G, bx);
            pg8::EpiRes E{nullptr, (const bf16*)out, WSP(bf16, WS_HB), WSP(float, s1o), WSP(bf16, WS_AHALO)};
            pg8::gemm_phase<pg8::EpiRes, pg8::StaticOrder, true, true>(L, g, S, E, wave_s);
        }
        SEAM(10);
        if (IN(10 + 2)) {
            PH_LOCALS
            pg8::Gemm g{WSP(bf16, WS_HB), WSP(bf16, WS_W_FFI1), TOK + 256, NFF2, 1024}; pg8::StaticOrder S; S.init(TOK, NFF2, G, bx);
            if (G == 256 && bx >= 128 && bx < 128 + NFF2 / 256) {
                pg8::OneUnit S1{64, bx - 128, 1};
                pg8::EpiHaloF EH{WSP(float, s1o), WSP(float, WS_AH), (unsigned*)(ws + WS_CTL) + CW_FLAG + 2048 * 1};
                pg8::gemm_phase<pg8::EpiHaloF, pg8::OneUnit, true, true>(L, g, S1, EH, wave_s);
            }
            pg8::EpiFfnIn E{WSP(float, s1o), IN_F(7) + (size_t)1 * 3 * NFF2, IN_F(8) + (size_t)1 * NFF2, WSP(float, WS_AH), WSP(bf16, WS_ZH), (LAS float*)(L + XB_OFF), (unsigned*)(ws + WS_CTL) + CW_FLAG + 2048 * 1, 2u};
            pg8::gemm_phase<pg8::EpiFfnIn, pg8::StaticOrder, true, true>(L, g, S, E, wave_s);
            if (G == 256 && bx >= 150) {
                pg8::Gemm gp{WSP(bf16, WS_PB), WSP(bf16, WS_W_PP1), TOK, 1024, PLE}; pg8::StaticOrder SP; SP.init(TOK, 1024, 106, bx - 150);
                pg8::EpiBf16Plain EP{WSP(bf16, WS_PP), 1024};
                pg8::gemm_phase<pg8::EpiBf16Plain, pg8::StaticOrder, true, true>(L, gp, SP, EP, wave_s);
            }
        }
        SEAM(10 + 2);
        if (IN(10 + 3)) {
            PH_LOCALS
            pg8::Gemm g{WSP(bf16, WS_ZH), WSP(bf16, (1 == 0) ? WS_W_FFO0 : WS_W_FFO1), TOK, 1024, DFF}; pg8::StaticOrder S; S.init(TOK, 1024, G, bx);
            pg8::EpiRes E{nullptr, WSP(bf16, WS_HB), WSP(bf16, WS_HB), WSP(float, s2o), nullptr};
            pg8::gemm_phase<pg8::EpiRes, pg8::StaticOrder, true, true>(L, g, S, E, wave_s);
        }
        SEAM(10 + 3);
        if (IN(10 + 4)) {
            PH_LOCALS
            pg8::Gemm g{WSP(bf16, WS_HB), WSP(bf16, (1 == 0) ? WS_W_PG0 : WS_W_PG1), TOK, 1024, 1024}; pg8::StaticOrder S; S.init(TOK, 1024, G, bx);
            pg8::EpiGate E{WSP(float, s2o), WSP(bf16, WS_HB), WSP(bf16, WS_PP), WSP(bf16, WS_Y), WSP(float, s3o)};
            pg8::gemm_phase<pg8::EpiGate, pg8::StaticOrder, true, true>(L, g, S, E, wave_s);
        }
        SEAM(10 + 4);
    }
    if (IN(15)) {
        PH_LOCALS
        const float* SSQB = WSP(float, WS_SSQB); const float* norm_final = IN_F(12); const bf16* H6 = WSP(bf16, WS_Y);
        for (int m = gw; m < TOK; m += 4 * NGW) {
            unsigned long long w[4][4]; float rs[4];
#pragma unroll
            for (int q = 0; q < 4; ++q) { const int mm = (m + q * NGW < TOK) ? m + q * NGW : m; rs[q] = pg8::row_rstd(SSQB, mm);
                const unsigned long long* hr = (const unsigned long long*)(H6 + (size_t)mm * DMODEL) + lane;
#pragma unroll
                for (int j = 0; j < 4; ++j) w[q][j] = hr[64 * j]; }
            const f32x4* gr = (const f32x4*)norm_final + lane;
            f32x4 gg[4];
#pragma unroll
            for (int j = 0; j < 4; ++j) gg[j] = gr[64 * j];
#pragma unroll
            for (int q = 0; q < 4; ++q) { const int mm = m + q * NGW; if (mm < TOK) { f32x4* xr = (f32x4*)(out + (size_t)mm * DMODEL) + lane;
#pragma unroll
                for (int j = 0; j < 4; ++j) { const unsigned long long ww = w[q][j];
                    const f32x4 v = {pg8::bf_lo((unsigned)ww), pg8::bf_hi((unsigned)ww), pg8::bf_lo((unsigned)(ww >> 32)), pg8::bf_hi((unsigned)(ww >> 32))};
                    __builtin_nontemporal_store(v * rs[q] * gg[j], xr + 64 * j); } } }
        }
    }
#undef IN
#undef SEAM
}

#ifndef MK_N_LAUNCHES
#define MK_N_LAUNCHES 1
#endif
constexpr int N_PHASES = 16;
extern "C" void kernel_launch(void* const* d_in, const int* in_sizes, int n_in, void* d_out, int out_size, void* d_ws, size_t ws_size, hipStream_t stream) {
    static int grid = 0;
    if (grid == 0) {
        if (n_in != 24 || out_size != TOK * DMODEL || ws_size < WS_END) { fprintf(stderr, "kernel_launch: unexpected shapes (n_in %d, out %d, ws %zu)\n", n_in, out_size, ws_size); grid = -1; return; }
        int dev = 0, cus = 0;
        if (hipGetDevice(&dev) != hipSuccess || hipDeviceGetAttribute(&cus, hipDeviceAttributeMultiprocessorCount, dev) != hipSuccess) { grid = -1; return; }
        if (hipFuncSetAttribute((const void*)mega_fwd, hipFuncAttributeMaxDynamicSharedMemorySize, LDS_BYTES) != hipSuccess) { fprintf(stderr, "kernel_launch: hipFuncSetAttribute failed\n"); grid = -1; return; }
        int per_cu = 0;
        if (hipOccupancyMaxActiveBlocksPerMultiprocessor(&per_cu, (const void*)mega_fwd, NWAVES * 64, LDS_BYTES) != hipSuccess || per_cu < 1) { fprintf(stderr, "kernel_launch: occupancy query says %d\n", per_cu); }
        (void)hipGetLastError();
        grid = cus;
    }
    if (grid < 0) return;
    (void)hipMemsetAsync((char*)d_ws + WS_CTL, 0, CTL_ZERO_BYTES, stream);
    Args a{};
    for (int i = 0; i < 24; ++i) a.in[i] = d_in[i];
    a.out = (float*)d_out; a.ws = (unsigned char*)d_ws;
#ifdef DBG_CHECK
    {
        using namespace dbg;
        auto LP = [&](int ph) { a.ph_lo = ph; a.ph_hi = ph + 1; hipLaunchKernelGGL(mega_fwd, dim3(grid), dim3(NWAVES * 64), LDS_BYTES, stream, a); };
        char* wsb = (char*)d_ws; float* ERR = (float*)(wsb + 512 * 1024); float* SNAP = (float*)(wsb + 600 * 1024); float* outp = (float*)d_out;
        const unsigned short* ZHp = (const unsigned short*)(wsb + WS_ZH); const unsigned short* Yp = (const unsigned short*)(wsb + WS_Y); const float* FB = (const float*)(wsb + WS_FBUF);
        const unsigned short* HBp = (const unsigned short*)(wsb + WS_HB); const unsigned short* H3p = (const unsigned short*)d_out;
        auto F = [&](int i) { return (const float*)d_in[i]; };
        const float* x = F(0);
        LP(0); LP(1);
        k_evenin<<<NS, 256, 0, stream>>>(x, F(3), F(13), (const int*)d_in[2], ZHp, ERR, 0);
        LP(2);
        k_pool<<<NS, 256, 0, stream>>>(ZHp, Yp, ERR, 1);
        k_dsa<<<NS, 256, 0, stream>>>(ZHp, Yp, ERR, 2);
        LP(3);
        k_outproj<<<NS, 256, 0, stream>>>(x, 0, SNAP, Yp, F(14), F(15), F(16), HBp, ERR, 3);
        for (int layer = 0; layer < 2; ++layer) {
            const int pb = layer ? 10 : 3, kb = layer ? 10 : 3;
            if (layer == 1) {
                LP(8);
                k_oddin<<<NS, 256, 0, stream>>>(H3p, F(3) + 1024, F(17), ZHp, FB, ERR, 7);
                LP(9);
                k_fox<<<NS, 256, 0, stream>>>(ZHp, FB, F(19), Yp, ERR, 8);
                k_sgu<<<NS, 256, 0, stream>>>(ZHp, F(20), F(21), F(22), F(23), Yp, ERR, 9);
                k_snap<<<NS, 256, 0, stream>>>(H3p, SNAP);
                LP(10);
                k_outproj<<<NS, 256, 0, stream>>>(nullptr, 1, SNAP, Yp, F(18), nullptr, nullptr, HBp, ERR, 10);
            }
            LP(pb + 1); LP(pb + 2);
            k_ffnin<<<NS, 256, 0, stream>>>(HBp, F(4) + 1024 * layer, F(6) + (size_t)layer * 1024 * NFF2, F(7) + (size_t)layer * 3 * NFF2, F(8) + (size_t)layer * NFF2, ZHp, ERR, kb + 1);
            k_snap<<<NS, 256, 0, stream>>>(HBp, SNAP);
            LP(pb + 3);
            k_ffnout<<<NS, 256, 0, stream>>>(SNAP, ZHp, F(9) + (size_t)layer * DFF * 1024, HBp, ERR, kb + 2);
            k_snap<<<NS, 256, 0, stream>>>(HBp, SNAP);
            LP(pb + 4);
            k_ple<<<NS, 256, 0, stream>>>(SNAP, F(1) + (size_t)layer * TOK * PLE, F(5) + 1024 * layer, F(10) + (size_t)layer * PLE * 1024, F(11) + (size_t)layer * 1024 * 1024, layer ? Yp : H3p, ERR, kb + 3);
        }
        k_snap<<<NS, 256, 0, stream>>>(Yp, SNAP);
        LP(15);
        k_final<<<NS, 256, 0, stream>>>(SNAP, F(12), outp, ERR, 14);
        t_dpp<<<1, 64, 0, stream>>>(ERR + 40);
        k_report<<<1024, 256, 0, stream>>>(ERR, 15, DBG_TOL, outp);
        return;
    }
#endif
    if (MK_N_LAUNCHES == 1) {
        a.ph_lo = 0; a.ph_hi = N_PHASES;
        hipLaunchKernelGGL(mega_fwd, dim3(grid), dim3(NWAVES * 64), LDS_BYTES, stream, a);
    } else {
#ifndef DBG_STOP
#define DBG_STOP N_PHASES
#endif
#ifndef DBG_DOUBLE
#define DBG_DOUBLE -1
#endif
        for (int ph = 0; ph < DBG_STOP; ++ph) { a.ph_lo = ph; a.ph_hi = ph + 1; const int reps = (ph == DBG_DOUBLE || (DBG_DOUBLE == 100 && (ph == 0 || ph == 1 || ph == 2 || ph == 4 || ph == 5 || ph == 8 || ph == 9 || ph == 11 || ph == 12))) ? 2 : 1;
            for (int r = 0; r < reps; ++r) hipLaunchKernelGGL(mega_fwd, dim3(grid), dim3(NWAVES * 64), LDS_BYTES, stream, a); }
    }
}
```

```cpp
#include <hip/hip_runtime.h>
#include <hip/hip_bf16.h>
#include <cstdio>
#include <cstdint>
#include <cmath>
constexpr int TOK = 16384, DMODEL = 1024, SEQ = 2048, NBATCH = 8;
constexpr int DFF = 2816, NFF2 = 5632, PLE = 256;
constexpr int EV_N = 1536;
constexpr int OD_N = 2816;
constexpr int Z1P = 2560;
constexpr float RMS_EPS = 1e-6f;
constexpr float C2 = 0.125f * 1.4426950408889634f;


__device__ __forceinline__ int lane_opaque() { unsigned z = 0u; asm volatile("" : "+v"(z)); return (int)__builtin_amdgcn_mbcnt_hi(~0u, __builtin_amdgcn_mbcnt_lo(~0u, z)); }
__device__ __forceinline__ float xor16_f(float v) { return __builtin_bit_cast(float, __builtin_amdgcn_ds_swizzle(__builtin_bit_cast(int, v), 0x401F)); }
__device__ __forceinline__ void halves_pair(unsigned v, unsigned& a, unsigned& b) { unsigned w = v; asm volatile("" : "+v"(w)); auto rr = __builtin_amdgcn_permlane32_swap(v, w, false, false); a = rr[0]; b = rr[1]; }
__device__ __forceinline__ float halves_sum_f(float v) { unsigned a, b; halves_pair(__builtin_bit_cast(unsigned, v), a, b); return __builtin_bit_cast(float, a) + __builtin_bit_cast(float, b); }
__device__ __forceinline__ float halves_max_f(float v) { unsigned a, b; halves_pair(__builtin_bit_cast(unsigned, v), a, b); return __builtin_fmaxf(__builtin_bit_cast(float, a), __builtin_bit_cast(float, b)); }
__device__ __forceinline__ unsigned halves_add_u(unsigned v) { unsigned a, b; halves_pair(v, a, b); return a + b; }
__device__ __forceinline__ unsigned halves_or_u(unsigned v) { unsigned a, b; halves_pair(v, a, b); return a | b; }
namespace pg8 {
#define PG8_LAS __attribute__((address_space(3)))
typedef unsigned short bf16_t;
typedef short bf16x8 __attribute__((ext_vector_type(8)));
typedef float f32x4 __attribute__((ext_vector_type(4)));
typedef unsigned u32x4 __attribute__((ext_vector_type(4)));
constexpr int BM = 256, BK = 64, HALF = 128, HTB = HALF * BK * 2  , STAGE_BYTES = 8 * HTB, NXCD = 8, WGM = 8;

__host__ __device__ __forceinline__ int lds_byte(int r, int c) { const int st = (r >> 4) * 2 + (c >> 5), rr = r & 15, cc = c & 31, ob = rr * 64 + cc * 2; return st * 1024 + (ob ^ (((ob >> 9) & 1) << 5)); }
__host__ __device__ __forceinline__ void stage_rc(int b, int& R, int& C) { const int st = b / 1024, sb = b % 1024, swz = sb ^ (((sb >> 9) & 1) << 5); R = (st >> 1) * 16 + swz / 64; C = (st & 1) * 32 + (swz % 64) / 2; }
__host__ __device__ __forceinline__ int perm32(int rho) { const int n = rho >> 4, i = rho & 15; return 8 * (i >> 2) + 4 * n + (i & 3); }

struct Unit { int pm, pn; };
struct Gemm { const bf16_t* A; const bf16_t* Bt; int M, N, K; };

struct StaticOrder {
    int nM, nN, nwg, G, c;
    __host__ __device__ void init(int M, int N, int G_, int c_) { nM = M / BM; nN = N / BM; nwg = nM * nN; G = G_; c = c_; }
    __host__ __device__ bool next(int i, Unit& u) const {
        const long L = (long)i * G + c; if (L >= nwg) return false;
        int wgid = (int)L; { const int q = nwg / NXCD, r = nwg % NXCD, xcd = wgid % NXCD, off = wgid / NXCD; wgid = (xcd < r ? xcd * (q + 1) : r * (q + 1) + (xcd - r) * q) + off; }
        const int nig = WGM * nN, gid = wgid / nig, fm = gid * WGM, gsz = (nM - fm) < WGM ? (nM - fm) : WGM;
        u.pm = fm + ((wgid % nig) % gsz); u.pn = (wgid % nig) / gsz; return true;
    }
    __device__ __forceinline__ void a_ready(const Unit&) const {}
    __device__ __forceinline__ void done(const Unit&) const {}
};

struct OneUnit {
    int pm, pn, on;
    __host__ __device__ bool next(int i, Unit& u) const { if (!on || i != 0) return false; u.pm = pm; u.pn = pn; return true; }
    __device__ __forceinline__ void a_ready(const Unit&) const {}
    __device__ __forceinline__ void done(const Unit&) const {}
};
struct FfnOrder {
    StaticOrder S0; int extra;
    __host__ __device__ void init(int M, int N, int G_, int c_) { S0.init(M, N, G_, c_); extra = (G_ == 256 && c_ >= 128 && c_ < 128 + N / BM) ? 1 : 0; }
    __host__ __device__ bool next(int i, Unit& u) const { if (extra) { if (i == 0) { u.pm = 64; u.pn = S0.c - 128; return true; } return S0.next(i - 1, u); } return S0.next(i, u); }
    __device__ __forceinline__ void a_ready(const Unit&) const {}
    __device__ __forceinline__ void done(const Unit&) const {}
};
typedef float f32x2 __attribute__((ext_vector_type(2)));
typedef unsigned u32x2 __attribute__((ext_vector_type(2)));
__device__ __forceinline__ unsigned cvt_pk_bf16(float lo, float hi) { unsigned r; asm volatile("v_cvt_pk_bf16_f32 %0, %1, %2" : "=v"(r) : "v"(lo), "v"(hi)); return r; }
__device__ __forceinline__ float bf_lo(unsigned w) { return __builtin_bit_cast(float, w << 16); }
__device__ __forceinline__ float bf_hi(unsigned w) { return __builtin_bit_cast(float, w & 0xffff0000u); }
__device__ __forceinline__ float sq4(const f32x4 v) { return (v[0] * v[0] + v[1] * v[1]) + (v[2] * v[2] + v[3] * v[3]); }
__device__ __forceinline__ float row_rstd(const float* ssq, int row) {
    const f32x4* p = (const f32x4*)(ssq + (size_t)row * 16);
    const f32x4 a = p[0], b = p[1], c = p[2], d = p[3];
    const float s = (((a[0] + a[1]) + (a[2] + a[3])) + ((b[0] + b[1]) + (b[2] + b[3]))) + (((c[0] + c[1]) + (c[2] + c[3])) + ((d[0] + d[1]) + (d[2] + d[3])));
    return 1.0f / sqrtf(s * (1.0f / 1024.0f) + RMS_EPS);
}
__device__ __forceinline__ void ssq_write(float* ssq_out, float q, int row, int slot, int fq) {
    q += xor16_f(q); q = halves_sum_f(q);
    if (fq == 0) ssq_out[(size_t)row * 16 + slot] = q;
}
__device__ __forceinline__ float gelu_tanh(float x) {
    const float t = x + 0.044715f * x * x * x;
    const float e = __builtin_amdgcn_exp2f(-2.3022082f * t);
    return x * __builtin_amdgcn_rcpf(1.0f + e);
}
__device__ __forceinline__ float sigmoid_f(float x) { return __builtin_amdgcn_rcpf(1.0f + __builtin_amdgcn_exp2f(-1.4426950408889634f * x)); }


struct EpiRes {
    static constexpr bool PERM = true, AFTER_DRAIN = false;
    const float* basef; const bf16_t* baseb; bf16_t* hb; float* ssq_out; bf16_t* ahalo;
    __device__ __forceinline__ void operator()(const f32x4 (&acc)[2][2][4][2], const Unit& u_, int wr, int wc, int fr, int fq) const {
        Unit u; { int pm_ = u_.pm, pn_ = u_.pn; asm volatile("" : "+s"(pm_), "+s"(pn_)); u.pm = pm_; u.pn = pn_; }
        const int row0 = u.pm * BM + wr * 64 + fr, col0 = u.pn * BM + wc * 32 + 8 * fq;
        if (basef != nullptr) {
#pragma unroll
            for (int ai = 0; ai < 2; ++ai)
#pragma unroll
                for (int m = 0; m < 4; ++m) {
                    const int row = row0 + ai * HALF + m * 16; float q = 0.f;
#pragma unroll
                    for (int bj = 0; bj < 2; ++bj) {
                        const size_t off = (size_t)row * DMODEL + col0 + bj * HALF;
                        const f32x4 b0 = *(const f32x4*)(basef + off), b1 = *(const f32x4*)(basef + off + 4);
                        const f32x4 v0 = acc[ai][bj][m][0] + b0, v1 = acc[ai][bj][m][1] + b1;
                        q += sq4(v0) + sq4(v1);
                        u32x4 w; w.x = cvt_pk_bf16(v0[0], v0[1]); w.y = cvt_pk_bf16(v0[2], v0[3]); w.z = cvt_pk_bf16(v1[0], v1[1]); w.w = cvt_pk_bf16(v1[2], v1[3]);
                        *(u32x4*)(hb + off) = w;
                        if (ahalo != nullptr && ai == 1 && m == 3) {
                            const int rl = row & 255;
                            if (rl >= 254 && u.pm < 63) *(u32x4*)(ahalo + (size_t)(2 * (u.pm + 1) + (rl - 254)) * DMODEL + col0 + bj * HALF) = w;
                        }
                    }
                    ssq_write(ssq_out, q, row, u.pn * 4 + wc, fq);
                    if (m & 1) asm volatile("" ::: "memory");
                }
        } else {
#pragma unroll
            for (int ai = 0; ai < 2; ++ai) {
                u32x4 bw[4][2];
#pragma unroll
                for (int m = 0; m < 4; ++m)
#pragma unroll
                    for (int bj = 0; bj < 2; ++bj) bw[m][bj] = *(const u32x4*)(baseb + (size_t)(row0 + ai * HALF + m * 16) * DMODEL + col0 + bj * HALF);
                asm volatile("" ::: "memory");
#pragma unroll
                for (int m = 0; m < 4; ++m) {
                    const int row = row0 + ai * HALF + m * 16; float q = 0.f;
#pragma unroll
                    for (int bj = 0; bj < 2; ++bj) {
                        const size_t off = (size_t)row * DMODEL + col0 + bj * HALF;
                        const u32x4 pw = bw[m][bj];
                        const f32x4 b0 = {bf_lo(pw.x), bf_hi(pw.x), bf_lo(pw.y), bf_hi(pw.y)}, b1 = {bf_lo(pw.z), bf_hi(pw.z), bf_lo(pw.w), bf_hi(pw.w)};
                        const f32x4 v0 = acc[ai][bj][m][0] + b0, v1 = acc[ai][bj][m][1] + b1;
                        q += sq4(v0) + sq4(v1);
                        u32x4 w; w.x = cvt_pk_bf16(v0[0], v0[1]); w.y = cvt_pk_bf16(v0[2], v0[3]); w.z = cvt_pk_bf16(v1[0], v1[1]); w.w = cvt_pk_bf16(v1[2], v1[3]);
                        *(u32x4*)(hb + off) = w;
                        if (ahalo != nullptr && ai == 1 && m == 3) {
                            const int rl = row & 255;
                            if (rl >= 254 && u.pm < 63) *(u32x4*)(ahalo + (size_t)(2 * (u.pm + 1) + (rl - 254)) * DMODEL + col0 + bj * HALF) = w;
                        }
                    }
                    ssq_write(ssq_out, q, row, u.pn * 4 + wc, fq);
                }
                asm volatile("" ::: "memory");
            }
        }
    }
};
struct EpiGate {
    static constexpr bool PERM = true, AFTER_DRAIN = false;
    const float* ssq_in; const bf16_t* base; const bf16_t* pp; bf16_t* dst; float* ssq_out;
    __device__ __forceinline__ void operator()(const f32x4 (&acc)[2][2][4][2], const Unit& u_, int wr, int wc, int fr, int fq) const {
        Unit u; { int pm_ = u_.pm, pn_ = u_.pn; asm volatile("" : "+s"(pm_), "+s"(pn_)); u.pm = pm_; u.pn = pn_; }
        const int row0 = u.pm * BM + wr * 64 + fr, col0 = u.pn * BM + wc * 32 + 8 * fq;
#pragma unroll
        for (int ai = 0; ai < 2; ++ai)
#pragma unroll
            for (int mp = 0; mp < 2; ++mp) {
                u32x4 bw[2][2], pq[2][2]; float rs[2];
#pragma unroll
                for (int mi = 0; mi < 2; ++mi) {
                    const int row = row0 + ai * HALF + (2 * mp + mi) * 16;
#pragma unroll
                    for (int bj = 0; bj < 2; ++bj) { const size_t off = (size_t)row * DMODEL + col0 + bj * HALF; bw[mi][bj] = *(const u32x4*)(base + off); pq[mi][bj] = *(const u32x4*)(pp + off); }
                }
#pragma unroll
                for (int mi = 0; mi < 2; ++mi) rs[mi] = row_rstd(ssq_in, row0 + ai * HALF + (2 * mp + mi) * 16);
                asm volatile("" ::: "memory");
#pragma unroll
                for (int mi = 0; mi < 2; ++mi) {
                    const int m = 2 * mp + mi; const int row = row0 + ai * HALF + m * 16; float q = 0.f;
#pragma unroll
                    for (int bj = 0; bj < 2; ++bj) {
                        const size_t off = (size_t)row * DMODEL + col0 + bj * HALF;
                        const u32x4 b_ = bw[mi][bj], p_ = pq[mi][bj];
                        const float bb[8] = {bf_lo(b_.x), bf_hi(b_.x), bf_lo(b_.y), bf_hi(b_.y), bf_lo(b_.z), bf_hi(b_.z), bf_lo(b_.w), bf_hi(b_.w)};
                        const float pv[8] = {bf_lo(p_.x), bf_hi(p_.x), bf_lo(p_.y), bf_hi(p_.y), bf_lo(p_.z), bf_hi(p_.z), bf_lo(p_.w), bf_hi(p_.w)};
                        const f32x4 g0 = acc[ai][bj][m][0] * rs[mi], g1 = acc[ai][bj][m][1] * rs[mi];
                        const float gg[8] = {g0[0], g0[1], g0[2], g0[3], g1[0], g1[1], g1[2], g1[3]};
                        float v[8];
#pragma unroll
                        for (int i = 0; i < 8; ++i) { v[i] = bb[i] + pv[i] * sigmoid_f(gg[i]); q += v[i] * v[i]; }
                        u32x4 w; w.x = cvt_pk_bf16(v[0], v[1]); w.y = cvt_pk_bf16(v[2], v[3]); w.z = cvt_pk_bf16(v[4], v[5]); w.w = cvt_pk_bf16(v[6], v[7]);
                        *(u32x4*)(dst + off) = w;
                    }
                    ssq_write(ssq_out, q, row, u.pn * 4 + wc, fq);
                }
                asm volatile("" ::: "memory");
            }
    }
};
struct EpiBf16Plain {
    static constexpr bool PERM = true, AFTER_DRAIN = false;
    bf16_t* O; int ldc;
    __device__ __forceinline__ void operator()(const f32x4 (&acc)[2][2][4][2], const Unit& u_, int wr, int wc, int fr, int fq) const {
        Unit u; { int pm_ = u_.pm, pn_ = u_.pn; asm volatile("" : "+s"(pm_), "+s"(pn_)); u.pm = pm_; u.pn = pn_; }
        const int row0 = u.pm * BM + wr * 64 + fr, col0 = u.pn * BM + wc * 32 + 8 * fq;
#pragma unroll
        for (int ai = 0; ai < 2; ++ai)
#pragma unroll
            for (int m = 0; m < 4; ++m) {
                const int row = row0 + ai * HALF + m * 16;
#pragma unroll
                for (int bj = 0; bj < 2; ++bj) {
                    const f32x4 v0 = acc[ai][bj][m][0], v1 = acc[ai][bj][m][1];
                    u32x4 w; w.x = cvt_pk_bf16(v0[0], v0[1]); w.y = cvt_pk_bf16(v0[2], v0[3]); w.z = cvt_pk_bf16(v1[0], v1[1]); w.w = cvt_pk_bf16(v1[2], v1[3]);
                    *(u32x4*)(O + (size_t)row * ldc + col0 + bj * HALF) = w;
                }
            }
    }
};
struct EpiEvenIn {
    static constexpr bool PERM = true, AFTER_DRAIN = false;
    const float* ssq_in; bf16_t* Z; const f32x2* rope;
    __device__ __forceinline__ void operator()(const f32x4 (&acc)[2][2][4][2], const Unit& u_, int wr, int wc, int fr, int fq) const {
        Unit u; { int pm_ = u_.pm, pn_ = u_.pn; asm volatile("" : "+s"(pm_), "+s"(pn_)); u.pm = pm_; u.pn = pn_; }
        const int row0 = u.pm * BM + wr * 64 + fr, colw = wc * 32 + 8 * fq;
        const int pn = u.pn;
        const float sc = (pn == 2 || pn == 3) ? C2 : 1.0f;
#pragma unroll
        for (int ai = 0; ai < 2; ++ai)
#pragma unroll
            for (int m = 0; m < 4; ++m) {
                const int row = row0 + ai * HALF + m * 16;
                const float rs = row_rstd(ssq_in, row);
#pragma unroll
                for (int bj = 0; bj < 2; ++bj) {
                    const int gi = 2 * bj + (wc >> 1);
                    const bool ropeg = (pn == 2 || pn == 3 || pn == 5 || (pn == 4 && (gi == 0 || gi == 2))) && ((wc & 1) == 0);
                    f32x4 v0 = acc[ai][bj][m][0] * rs, v1 = acc[ai][bj][m][1] * rs;
                    if (ropeg && fq < 2) {
                        const f32x4* rp = (const f32x4*)(rope + (size_t)row * 8 + 4 * fq);
                        const f32x4 ra = rp[0], rb = rp[1];
                        f32x4 o0, o1;
                        o0[0] = v0[0] * ra[0] - v0[1] * ra[1]; o0[1] = v0[1] * ra[0] + v0[0] * ra[1];
                        o0[2] = v0[2] * ra[2] - v0[3] * ra[3]; o0[3] = v0[3] * ra[2] + v0[2] * ra[3];
                        o1[0] = v1[0] * rb[0] - v1[1] * rb[1]; o1[1] = v1[1] * rb[0] + v1[0] * rb[1];
                        o1[2] = v1[2] * rb[2] - v1[3] * rb[3]; o1[3] = v1[3] * rb[2] + v1[2] * rb[3];
                        v0 = o0; v1 = o1;
                    }
                    v0 = v0 * sc; v1 = v1 * sc;
                    u32x4 w; w.x = cvt_pk_bf16(v0[0], v0[1]); w.y = cvt_pk_bf16(v0[2], v0[3]); w.z = cvt_pk_bf16(v1[0], v1[1]); w.w = cvt_pk_bf16(v1[2], v1[3]);
                    *(u32x4*)(Z + (size_t)row * EV_N + pn * BM + bj * HALF + colw) = w;
                }
            }
    }
};
struct EpiOddIn {
    static constexpr bool PERM = true, AFTER_DRAIN = false;
    const float* ssq_in; bf16_t* Z; float* F; float* sst;
    __device__ __forceinline__ void operator()(const f32x4 (&acc)[2][2][4][2], const Unit& u_, int wr, int wc, int fr, int fq) const {
        Unit u; { int pm_ = u_.pm, pn_ = u_.pn; asm volatile("" : "+s"(pm_), "+s"(pn_)); u.pm = pm_; u.pn = pn_; }
        const int row0 = u.pm * BM + wr * 64 + fr, colw = wc * 32 + 8 * fq;
        const int pn = u.pn;
        const float sc = (pn < 2) ? C2 : 1.0f;
        const bool act = (pn >= 6 && pn < 10), stat = (pn == 8 || pn == 9);
#pragma unroll
        for (int ai = 0; ai < 2; ++ai)
#pragma unroll
            for (int m = 0; m < 4; ++m) {
                const int row = row0 + ai * HALF + m * 16;
                const float rs = row_rstd(ssq_in, row);
                if (pn == 10) {
                    if (wc == 0 && fq == 0) { *(f32x4*)(F + (size_t)row * 8) = acc[ai][0][m][0] * rs; *(f32x4*)(F + (size_t)row * 8 + 4) = acc[ai][0][m][1] * rs; }
                    continue;
                }
                float s1 = 0.f, s2 = 0.f;
#pragma unroll
                for (int bj = 0; bj < 2; ++bj) {
                    f32x4 v0 = acc[ai][bj][m][0] * (rs * sc), v1 = acc[ai][bj][m][1] * (rs * sc);
                    if (act) {
#pragma unroll
                        for (int i = 0; i < 4; ++i) { v0[i] = gelu_tanh(v0[i]); v1[i] = gelu_tanh(v1[i]); }
                    }
                    s1 += ((v0[0] + v0[1]) + (v0[2] + v0[3])) + ((v1[0] + v1[1]) + (v1[2] + v1[3])); s2 += sq4(v0) + sq4(v1);
                    u32x4 w; w.x = cvt_pk_bf16(v0[0], v0[1]); w.y = cvt_pk_bf16(v0[2], v0[3]); w.z = cvt_pk_bf16(v1[0], v1[1]); w.w = cvt_pk_bf16(v1[2], v1[3]);
                    *(u32x4*)(Z + (size_t)row * Z1P + pn * BM + bj * HALF + colw) = w;
                }
                if (stat) {
                    s1 += xor16_f(s1); s1 = halves_sum_f(s1); s2 += xor16_f(s2); s2 = halves_sum_f(s2);
                    if (fq == 0) *(f32x2*)(sst + ((size_t)row * 8 + (pn - 8) * 4 + wc) * 2) = (f32x2){s1, s2};
                }
            }
    }
};
struct EpiHalo {
    static constexpr bool PERM = true, AFTER_DRAIN = false;
    const float* ssq_in; float* AH;
    __device__ __forceinline__ void operator()(const f32x4 (&acc)[2][2][4][2], const Unit& u_, int wr, int wc, int fr, int fq) const {
        Unit u; { int pm_ = u_.pm, pn_ = u_.pn; asm volatile("" : "+s"(pm_), "+s"(pn_)); u.pm = pm_; u.pn = pn_; }
        const int col0 = u.pn * BM + wc * 32 + 8 * fq;
#pragma unroll
        for (int m = 0; m < 4; ++m) {
            const int rh = wr * 64 + m * 16 + fr;
            if (rh < 2) continue;
            const int tok = 256 * (rh >> 1) - 2 + (rh & 1);
            const float rs = row_rstd(ssq_in, tok);
#pragma unroll
            for (int bj = 0; bj < 2; ++bj) {
                *(f32x4*)(AH + (size_t)rh * NFF2 + col0 + bj * HALF) = acc[0][bj][m][0] * rs;
                *(f32x4*)(AH + (size_t)rh * NFF2 + col0 + bj * HALF + 4) = acc[0][bj][m][1] * rs;
            }
        }
    }
};
template <int SEL> __device__ __forceinline__ float dpp1(const float old, const float src) {
    const int o = __builtin_bit_cast(int, old), s = __builtin_bit_cast(int, src); int t;
    if (SEL == 0) t = __builtin_amdgcn_update_dpp(o, s, 0x111, 0xf, 0xf, false);
    else if (SEL == 1) t = __builtin_amdgcn_update_dpp(o, s, 0x112, 0xf, 0xf, false);
    else if (SEL == 2) t = __builtin_amdgcn_update_dpp(o, s, 0x10F, 0xf, 0xf, false);
    else t = __builtin_amdgcn_update_dpp(o, s, 0x10E, 0xf, 0xf, false);
    return __builtin_bit_cast(float, t);
}
template <int SEL> __device__ __forceinline__ f32x4 dpp4t(const f32x4 old, const f32x4 src) {
    const float o0 = old[0], o1 = old[1], o2 = old[2], o3 = old[3], s0 = src[0], s1 = src[1], s2 = src[2], s3 = src[3];
    const float r0 = dpp1<SEL>(o0, s0), r1 = dpp1<SEL>(o1, s1), r2 = dpp1<SEL>(o2, s2), r3 = dpp1<SEL>(o3, s3);
    return (f32x4){r0, r1, r2, r3};
}
#define dpp4(old, src, sel) dpp4t<sel>(old, src)
struct EpiHaloF {
    static constexpr bool PERM = true, AFTER_DRAIN = false;
    const float* ssq_in; float* ah; unsigned* flags;
    __device__ __forceinline__ void operator()(const f32x4 (&acc)[2][2][4][2], const Unit& u_, int wr, int wc, int fr, int fq) const {
        Unit u; { int pm_ = u_.pm, pn_ = u_.pn; asm volatile("" : "+s"(pm_), "+s"(pn_)); u.pm = pm_; u.pn = pn_; }
        const int col0 = u.pn * BM + wc * 32 + 8 * fq;
#pragma unroll
        for (int m = 0; m < 4; ++m) {
            const int rh = wr * 64 + m * 16 + fr;
            if (rh >= 2) {
                const int tok = 256 * (rh >> 1) - 2 + (rh & 1);
                const float rsh = row_rstd(ssq_in, tok);
#pragma unroll
                for (int bj = 0; bj < 2; ++bj) {
                    *(f32x4*)(ah + (size_t)rh * NFF2 + col0 + bj * HALF) = acc[0][bj][m][0] * rsh;
                    *(f32x4*)(ah + (size_t)rh * NFF2 + col0 + bj * HALF + 4) = acc[0][bj][m][1] * rsh;
                }
            }
        }
        asm volatile("s_waitcnt vmcnt(0)" ::: "memory"); __builtin_amdgcn_s_barrier(); asm volatile("" ::: "memory");
        if (wr == 0 && wc == 0 && fr == 0 && fq == 0) {
            __builtin_amdgcn_fence(__ATOMIC_RELEASE, "agent");
            asm volatile("s_waitcnt vmcnt(0)" ::: "memory");
            __hip_atomic_store(flags + 64 * u.pn, 1u, __ATOMIC_RELAXED, __HIP_MEMORY_SCOPE_AGENT);
        }
    }
};
struct EpiFfnIn {
    static constexpr bool PERM = true, AFTER_DRAIN = false;
    const float* ssq_in; const float* cw; const float* cb; float* ah; bf16_t* hid; PG8_LAS float* xb; unsigned* flags; unsigned phase_id;
    __device__ __forceinline__ void operator()(const f32x4 (&acc)[2][2][4][2], const Unit& u_, int wr, int wc, int fr, int fq) const {
        Unit u; { int pm_ = u_.pm, pn_ = u_.pn; asm volatile("" : "+s"(pm_), "+s"(pn_)); u.pm = pm_; u.pn = pn_; }
        PG8_LAS float* rtab = xb + 2048;
        const int row0 = u.pm * BM + wr * 64 + fr;
        if (wr == 0) rtab[wc * 64 + fq * 16 + fr] = row_rstd(ssq_in, u.pm * BM + wc * 64 + fq * 16 + fr);
        if (fr >= 14) {
#pragma unroll
            for (int ai = 0; ai < 2; ++ai) {
                PG8_LAS f32x4* dst = (PG8_LAS f32x4*)(xb + ((((ai * 2 + wr) * 4 + wc) * 2 + (fr - 14)) * 4 + fq) * 16);
#pragma unroll
                for (int bj = 0; bj < 2; ++bj)
#pragma unroll
                    for (int n = 0; n < 2; ++n) dst[bj * 2 + n] = acc[ai][bj][3][n];
            }
        }
        asm volatile("s_waitcnt lgkmcnt(0)" ::: "memory"); __builtin_amdgcn_s_barrier(); asm volatile("" ::: "memory");
        const bool has = (u.pm & 7) != 0;
        if (wr == 0) {
            PG8_LAS unsigned* stamp = (PG8_LAS unsigned*)(rtab + 256);
            if (*(volatile PG8_LAS unsigned*)stamp != phase_id) {
                if (wc == 0) {
                    unsigned sp = 0;
                    for (int t = 0; t < NFF2 / BM; ++t)
                        while (__hip_atomic_load(flags + 64 * t, __ATOMIC_RELAXED, __HIP_MEMORY_SCOPE_AGENT) == 0u) { __builtin_amdgcn_s_sleep(2); if (++sp > (1u << 22)) break; }
                    asm volatile("s_waitcnt vmcnt(0)" ::: "memory");
                    if (fr == 0 && fq == 0) *(volatile PG8_LAS unsigned*)stamp = phase_id;
                } else {
                    unsigned sp = 0;
                    while (*(volatile PG8_LAS unsigned*)stamp != phase_id) { __builtin_amdgcn_s_sleep(2); if (++sp > (1u << 22)) break; }
                }
            }
        }
        float rs[2][4];
#pragma unroll
        for (int ai = 0; ai < 2; ++ai)
#pragma unroll
            for (int m = 0; m < 4; ++m) rs[ai][m] = rtab[ai * HALF + wr * 64 + m * 16 + fr];
        const f32x4 zero4 = {0.f, 0.f, 0.f, 0.f};
#pragma unroll
        for (int ai = 0; ai < 2; ++ai) {
#pragma unroll
            for (int n = 0; n < 2; ++n) {
                f32x4 cg[4];
#pragma unroll
                for (int bj = 0; bj < 2; ++bj) {
                    f32x4 b0, b1;
                    if (ai == 0 && wr == 0) {
                        const size_t c = (size_t)u.pn * BM + bj * HALF + wc * 32 + 8 * fq + 4 * n;
                        b0 = has ? *(const f32x4*)(ah + (size_t)(2 * u.pm) * NFF2 + c) : zero4;
                        b1 = has ? *(const f32x4*)(ah + (size_t)(2 * u.pm + 1) * NFF2 + c) : zero4;
                    } else {
                        const int sa = (wr == 1) ? ai : ai - 1, sw = (wr == 1) ? 0 : 1;
                        const float r0 = rtab[sa * HALF + sw * 64 + 62], r1 = rtab[sa * HALF + sw * 64 + 63];
                        b0 = *(const PG8_LAS f32x4*)(xb + ((((sa * 2 + sw) * 4 + wc) * 2 + 0) * 4 + fq) * 16 + (bj * 2 + n) * 4) * r0;
                        b1 = *(const PG8_LAS f32x4*)(xb + ((((sa * 2 + sw) * 4 + wc) * 2 + 1) * 4 + fq) * 16 + (bj * 2 + n) * 4) * r1;
                    }
                    const int oc = bj * DFF + 128 * u.pn + wc * 32 + 8 * fq + 4 * n;
                    const f32x4 w0 = *(const f32x4*)(cw + oc), w1 = *(const f32x4*)(cw + NFF2 + oc), w2 = *(const f32x4*)(cw + 2 * NFF2 + oc), bb = *(const f32x4*)(cb + oc);
                    f32x4 prev = zero4;
#pragma unroll
                    for (int m = 0; m < 4; ++m) {
                        const f32x4 cur = acc[ai][bj][m][n] * rs[ai][m];
                        f32x4 y1, y2;
                        if (m == 0) { y1 = b1; y2 = (fr == 0) ? b0 : b1; }
                        else { y1 = dpp4(zero4, prev, 2); y2 = dpp4(zero4, prev, 3); }
                        const f32x4 p1 = dpp4(y1, cur, 0), p2 = dpp4(y2, cur, 1);
                        const f32x4 c = w0 * p2 + w1 * p1 + w2 * cur + bb;
                        prev = cur;
                        if (bj == 0) cg[m] = c;
                        else {
                            const float h0 = gelu_tanh(cg[m].x) * c.x, h1 = gelu_tanh(cg[m].y) * c.y, h2 = gelu_tanh(cg[m].z) * c.z, h3 = gelu_tanh(cg[m].w) * c.w;
                            u32x2 w; w.x = cvt_pk_bf16(h0, h1); w.y = cvt_pk_bf16(h2, h3);
                            const int row = row0 + ai * HALF + m * 16;
                            *(u32x2*)(hid + (size_t)row * DFF + 128 * u.pn + wc * 32 + 8 * fq + 4 * n) = w;
                        }
                    }
                    asm volatile("" ::: "memory");
                }
            }
        }
    }
};
template <class Epi, class Sched, bool ALIGN_EPI = false, bool SP2 = false>
__device__ __forceinline__ void gemm_phase(PG8_LAS unsigned char* lds, const Gemm g, const Sched& S, const Epi& E, const int wave_s) {
    const int tid_ = wave_s * 64 + lane_opaque(); const int tid = tid_, wid = __builtin_amdgcn_readfirstlane(tid >> 6), lane = tid & 63, wr = wid >> 2, wc = wid & 3, fr = lane & 15, fq = lane >> 4;
    const int K = g.K, nt = K / BK;
    unsigned voffA[2], voffB[2];
#pragma unroll
    for (int i = 0; i < 2; ++i) { int R, C; stage_rc(tid * 16 + i * 8192, R, C); const int Rb = Epi::PERM ? ((R & ~31) + perm32(R & 31)) : R;
        voffA[i] = (unsigned)(R * K + C) * 2u; voffB[i] = (unsigned)(Rb * K + C) * 2u; }
    const size_t kstep = (size_t)(BK * 2);
    const size_t hstep = (size_t)HALF * K * 2;
    const size_t tstep = 2 * hstep;
    const unsigned ldsw = (unsigned)wid * 1024u;
    const int aoff = lds_byte(wr * 64 + fr, fq * 8), boff = lds_byte(wc * 32 + fr, fq * 8);
#define PG8_SA(b, h) (((b) * 2 + (h)) * HTB)
#define PG8_SB(b, h) ((4 + (b) * 2 + (h)) * HTB)
#define PG8_STAGE(bufoff, gbase, voff) do { _Pragma("unroll") for (int _i = 0; _i < 2; ++_i) \
        __builtin_amdgcn_global_load_lds((const unsigned*)((const char*)(gbase) + (voff)[_i]), (PG8_LAS unsigned*)(lds + (bufoff) + ldsw + _i * 8192), 16, 0, 0); } while (0)
#define PG8_LDA(dst, b, h) do { _Pragma("unroll") for (int m = 0; m < 4; ++m) _Pragma("unroll") for (int k = 0; k < 2; ++k) dst[m][k] = *(const PG8_LAS bf16x8*)(lds + PG8_SA(b, h) + aoff + m * 2048 + k * 1024); } while (0)
#define PG8_LDB(dst, b, h) do { _Pragma("unroll") for (int n = 0; n < 2; ++n) _Pragma("unroll") for (int k = 0; k < 2; ++k) dst[n][k] = *(const PG8_LAS bf16x8*)(lds + PG8_SB(b, h) + boff + n * 2048 + k * 1024); } while (0)
#define PG8_MMA(ai, bj, At, Bt) do { __builtin_amdgcn_s_setprio(1); _Pragma("unroll") for (int m = 0; m < 4; ++m) _Pragma("unroll") for (int n = 0; n < 2; ++n) _Pragma("unroll") for (int k = 0; k < 2; ++k) \
        acc[ai][bj][m][n] = __builtin_amdgcn_mfma_f32_16x16x32_bf16(Bt[n][k], At[m][k], acc[ai][bj][m][n], 0, 0, 0); __builtin_amdgcn_s_setprio(0); } while (0)
#define PG8_WAIT_V(n) asm volatile("s_waitcnt vmcnt(" #n ")" ::: "memory")
#define PG8_WAIT_L(n) asm volatile("s_waitcnt lgkmcnt(" #n ")" ::: "memory")
#define PG8_BAR __builtin_amdgcn_s_barrier()
#define PG8_SCHED __builtin_amdgcn_sched_barrier(0)
    Unit cur, nxt; int ui = 0;
    if (!S.next(0, cur)) return;
    f32x4 acc[2][2][4][2];
#pragma unroll
    for (int a = 0; a < 2; ++a)
#pragma unroll
        for (int b = 0; b < 2; ++b)
#pragma unroll
            for (int m = 0; m < 4; ++m)
#pragma unroll
                for (int n = 0; n < 2; ++n) acc[a][b][m][n] = (f32x4){0.f, 0.f, 0.f, 0.f};
    bf16x8 At[4][2], B0[2][2], B1[2][2];
    const char* cA = (const char*)g.A + (size_t)cur.pm * tstep; const char* cB = (const char*)g.Bt + (size_t)cur.pn * tstep;
    S.a_ready(cur);
    if constexpr (SP2) {
        PG8_STAGE(PG8_SB(0, 0), cB, voffB); PG8_STAGE(PG8_SB(0, 1), cB + hstep, voffB); PG8_STAGE(PG8_SA(0, 0), cA, voffA); PG8_STAGE(PG8_SA(0, 1), cA + hstep, voffA);
        if (wr == 1) PG8_BAR;
        PG8_WAIT_V(2); PG8_BAR;
        PG8_STAGE(PG8_SB(1, 0), cB + kstep, voffB); PG8_STAGE(PG8_SA(1, 0), cA + kstep, voffA); PG8_STAGE(PG8_SB(1, 1), cB + hstep + kstep, voffB);
        PG8_WAIT_V(6); PG8_BAR;
    } else {
        PG8_STAGE(PG8_SB(0, 0), cB, voffB); PG8_STAGE(PG8_SA(0, 0), cA, voffA); PG8_STAGE(PG8_SB(0, 1), cB + hstep, voffB); PG8_STAGE(PG8_SA(0, 1), cA + hstep, voffA);
        if (wr == 1) PG8_BAR;
        PG8_WAIT_V(4); PG8_BAR;
        PG8_STAGE(PG8_SB(1, 0), cB + kstep, voffB); PG8_STAGE(PG8_SA(1, 0), cA + kstep, voffA); PG8_STAGE(PG8_SB(1, 1), cB + hstep + kstep, voffB);
        PG8_WAIT_V(6); PG8_BAR;
    }
    for (;;) {
        const bool has_next = S.next(ui + 1, nxt);
        const char* nA = has_next ? (const char*)g.A + (size_t)nxt.pm * tstep : cA; const char* nB = has_next ? (const char*)g.Bt + (size_t)nxt.pn * tstep : cB;
        for (int t = 0; t < nt; t += 2) {
            const bool last = (t == nt - 2);
            const char* a1 = cA + (size_t)(t + 1) * kstep;
            const char* a2 = last ? nA : cA + (size_t)(t + 2) * kstep; const char* b2 = last ? nB : cB + (size_t)(t + 2) * kstep;
            const char* a3 = a2 + kstep; const char* b3 = b2 + kstep;
            if (last && has_next) S.a_ready(nxt);
            if constexpr (SP2) {
            PG8_LDB(B0, 0, 0); PG8_LDB(B1, 0, 1); PG8_SCHED; PG8_LDA(At, 0, 0); PG8_STAGE(PG8_SA(1, 1), a1 + hstep, voffA);
            PG8_WAIT_V(8); PG8_WAIT_L(0); PG8_BAR; PG8_MMA(0, 0, At, B0); PG8_MMA(0, 1, At, B1); PG8_BAR; PG8_SCHED;
            PG8_LDA(At, 0, 1); PG8_STAGE(PG8_SB(0, 0), b2, voffB); PG8_STAGE(PG8_SB(0, 1), b2 + hstep, voffB); PG8_STAGE(PG8_SA(0, 0), a2, voffA);
            PG8_WAIT_V(8); PG8_WAIT_L(0); PG8_BAR; PG8_MMA(1, 0, At, B0); PG8_MMA(1, 1, At, B1); PG8_BAR; PG8_SCHED;
            PG8_LDB(B0, 1, 0); PG8_LDB(B1, 1, 1); PG8_SCHED; PG8_LDA(At, 1, 0); PG8_STAGE(PG8_SA(0, 1), a2 + hstep, voffA);
            PG8_WAIT_V(8); PG8_WAIT_L(0); PG8_BAR; PG8_MMA(0, 0, At, B0); PG8_MMA(0, 1, At, B1); PG8_BAR; PG8_SCHED;
            PG8_LDA(At, 1, 1); PG8_STAGE(PG8_SB(1, 0), b3, voffB); PG8_STAGE(PG8_SB(1, 1), b3 + hstep, voffB); PG8_STAGE(PG8_SA(1, 0), a3, voffA);
            PG8_WAIT_V(8); PG8_WAIT_L(0); PG8_BAR; PG8_MMA(1, 0, At, B0); PG8_MMA(1, 1, At, B1); PG8_BAR; PG8_SCHED;
            } else {
            PG8_LDB(B0, 0, 0); PG8_SCHED; PG8_LDA(At, 0, 0); PG8_STAGE(PG8_SA(1, 1), a1 + hstep, voffA);
            PG8_WAIT_L(8); PG8_BAR; PG8_WAIT_L(0); PG8_MMA(0, 0, At, B0); PG8_BAR; PG8_SCHED;
            PG8_LDB(B1, 0, 1); PG8_STAGE(PG8_SB(0, 0), b2, voffB);
            PG8_BAR; PG8_WAIT_L(0); PG8_MMA(0, 1, At, B1); PG8_BAR;
            PG8_LDA(At, 0, 1); PG8_STAGE(PG8_SA(0, 0), a2, voffA);
            PG8_BAR; PG8_WAIT_L(0); PG8_MMA(1, 0, At, B0); PG8_BAR; PG8_SCHED;
            PG8_STAGE(PG8_SB(0, 1), b2 + hstep, voffB);
            PG8_WAIT_V(6); PG8_BAR; PG8_MMA(1, 1, At, B1); PG8_BAR;
            PG8_LDB(B0, 1, 0); PG8_SCHED; PG8_LDA(At, 1, 0); PG8_STAGE(PG8_SA(0, 1), a2 + hstep, voffA);
            PG8_WAIT_L(8); PG8_BAR; PG8_WAIT_L(0); PG8_MMA(0, 0, At, B0); PG8_BAR; PG8_SCHED;
            PG8_LDB(B1, 1, 1); PG8_STAGE(PG8_SB(1, 0), b3, voffB);
            PG8_BAR; PG8_WAIT_L(0); PG8_MMA(0, 1, At, B1); PG8_BAR;
            PG8_LDA(At, 1, 1); PG8_STAGE(PG8_SA(1, 0), a3, voffA);
            PG8_BAR; PG8_WAIT_L(0); PG8_MMA(1, 0, At, B0); PG8_BAR; PG8_SCHED;
            PG8_STAGE(PG8_SB(1, 1), b3 + hstep, voffB);
            PG8_WAIT_V(6); PG8_BAR; PG8_MMA(1, 1, At, B1); PG8_BAR;
            }
        }
        if constexpr (ALIGN_EPI) { if (wr == 0) PG8_BAR; }
        if constexpr (!Epi::AFTER_DRAIN) { E(acc, cur, wr, wc, fr, fq); S.done(cur); }
        if (!has_next) break;
#pragma unroll
        for (int a = 0; a < 2; ++a)
#pragma unroll
            for (int b = 0; b < 2; ++b)
#pragma unroll
                for (int m = 0; m < 4; ++m)
#pragma unroll
                    for (int n = 0; n < 2; ++n) acc[a][b][m][n] = (f32x4){0.f, 0.f, 0.f, 0.f};
        cur = nxt; cA = nA; cB = nB; ++ui;
        if constexpr (ALIGN_EPI) { if (wr == 1) PG8_BAR; }
    }
    PG8_WAIT_V(0);
    if constexpr (!ALIGN_EPI) { if (wr == 0) PG8_BAR; }
    PG8_BAR;
    if constexpr (Epi::AFTER_DRAIN) { E.fused(acc, cur, wr, wc, fr, fq, lds, wid, lane); S.done(cur); }
#undef PG8_SA
#undef PG8_SB
#undef PG8_STAGE
#undef PG8_LDA
#undef PG8_LDB
#undef PG8_MMA
#undef PG8_WAIT_V
#undef PG8_WAIT_L
#undef PG8_BAR
#undef PG8_SCHED
}
}
namespace mix {
#define MLAS __attribute__((address_space(3)))
typedef unsigned short bf16_t;
typedef short bf16x8 __attribute__((ext_vector_type(8)));
typedef short s16x4 __attribute__((ext_vector_type(4)));
typedef float f32x16 __attribute__((ext_vector_type(16)));
typedef float f32x4 __attribute__((ext_vector_type(4)));
typedef float f32x2 __attribute__((ext_vector_type(2)));
typedef unsigned u32x4 __attribute__((ext_vector_type(4)));
typedef unsigned u32x2 __attribute__((ext_vector_type(2)));
typedef MLAS const char* lds_cptr;
typedef short v4i16_t __attribute__((ext_vector_type(4)));
typedef __bf16 bf16x2_t __attribute__((ext_vector_type(2)));

constexpr int SLOTB = 8192;
constexpr int NSLOT = 4;
constexpr int L_K = 0, L_V = NSLOT * SLOTB, L_WSF = 2 * NSLOT * SLOTB, L_OST = L_WSF + 8 * 256, L_X = L_OST + 8 * 4096;
constexpr int LX_IQ = L_X, LX_EQ = L_X, LX_PFX = L_X + 8192, LX_CNT = LX_IQ + 16384, LX_GT = LX_CNT + 2048, LX_SEL = LX_GT, LX_END = LX_GT + 8192;
static_assert(LX_END <= 131072, "mixer LDS map");

__device__ __forceinline__ int crow(int r, int hi) { return (r & 3) + 8 * (r >> 2) + 4 * hi; }
__device__ __forceinline__ void glds16(const void* gsrc, unsigned lds_dst) { unsigned keep;
    asm volatile("s_mov_b32 %0, m0\n\ts_mov_b32 m0, %2\n\ts_nop 0\n\tglobal_load_lds_dwordx4 %1, off\n\ts_mov_b32 m0, %0" : "=&s"(keep) : "v"(gsrc), "s"(lds_dst) : "memory"); }
__device__ __forceinline__ unsigned cvtpk(float lo, float hi) { f32x2 v = {lo, hi}; bf16x2_t b = __builtin_convertvector(v, bf16x2_t); return __builtin_bit_cast(unsigned, b); }
__device__ __forceinline__ s16x4 vtr(lds_cptr p) { return __builtin_bit_cast(s16x4, __builtin_amdgcn_ds_read_tr16_b64_v4i16((MLAS v4i16_t*)p)); }
#define WAITV_BAR() asm volatile("s_waitcnt vmcnt(0) lgkmcnt(0)\n\ts_barrier" ::: "memory")
#define LGKM_BAR() asm volatile("s_waitcnt lgkmcnt(0)\n\ts_barrier" ::: "memory")
#define WAITV2_BAR() asm volatile("s_waitcnt vmcnt(2) lgkmcnt(0)\n\ts_barrier" ::: "memory")

__device__ __forceinline__ void dma_kv(const bf16_t* kbase, const bf16_t* vbase, int pitch, unsigned lds0, int slot, int wid, int lane) {
    const bf16_t* ks = kbase + (size_t)lane * pitch + wid * 8;
    const bf16_t* vs = vbase + (size_t)(16 * (wid & 3) + (lane >> 2)) * pitch + (wid >> 2) * 32 + (lane & 3) * 8;
    glds16(ks, (unsigned)__builtin_amdgcn_readfirstlane(lds0 + L_K + slot * SLOTB + wid * 1024));
    glds16(vs, (unsigned)__builtin_amdgcn_readfirstlane(lds0 + L_V + slot * SLOTB + wid * 1024));
}
__device__ __forceinline__ void kload(bf16x8 (&kf)[8], lds_cptr kslot, int r32, int hi) {
    lds_cptr kb = kslot + hi * 1024 + r32 * 16;
#pragma unroll
    for (int d0 = 0; d0 < 4; ++d0) { kf[2 * d0] = *(const MLAS bf16x8*)(kb + d0 * 2048); kf[2 * d0 + 1] = *(const MLAS bf16x8*)(kb + d0 * 2048 + 512); }
}
__device__ __forceinline__ void qkt_mma(f32x16& p0, f32x16& p1, const bf16x8 (&kf)[8], const bf16x8* qr, const f32x16& cinit) {
    p0 = __builtin_amdgcn_mfma_f32_32x32x16_bf16(kf[0], qr[0], cinit, 0, 0, 0); p1 = __builtin_amdgcn_mfma_f32_32x32x16_bf16(kf[1], qr[0], cinit, 0, 0, 0);
#pragma unroll
    for (int d0 = 1; d0 < 4; ++d0) { p0 = __builtin_amdgcn_mfma_f32_32x32x16_bf16(kf[2 * d0], qr[d0], p0, 0, 0, 0); p1 = __builtin_amdgcn_mfma_f32_32x32x16_bf16(kf[2 * d0 + 1], qr[d0], p1, 0, 0, 0); }
}
__device__ __forceinline__ void qkt(f32x16& p0, f32x16& p1, lds_cptr kslot, const bf16x8* qr, const f32x16& cinit, int r32, int hi) {
    bf16x8 kf[8]; kload(kf, kslot, r32, hi); qkt_mma(p0, p1, kf, qr, cinit);
}
__device__ __forceinline__ void vload(bf16x8 (&vf)[8], lds_cptr vslot, int lane, int hi) {
    lds_cptr vp = vslot + ((lane >> 4) & 1) * 32 + (lane & 3) * 8 + (4 * hi + ((lane & 15) >> 2)) * 64;
#pragma unroll
    for (int d0 = 0; d0 < 2; ++d0)
#pragma unroll
        for (int ks = 0; ks < 4; ++ks) {
            const s16x4 lo = vtr(vp + d0 * 4096 + ks * 1024), hh = vtr(vp + d0 * 4096 + ks * 1024 + 512);
            vf[d0 * 4 + ks] = (bf16x8){lo[0], lo[1], lo[2], lo[3], hh[0], hh[1], hh[2], hh[3]};
        }
}
#define V16_TO_ARR(v, a, o) do { a[(o) + 0] = v[0]; a[(o) + 1] = v[1]; a[(o) + 2] = v[2]; a[(o) + 3] = v[3]; a[(o) + 4] = v[4]; a[(o) + 5] = v[5]; a[(o) + 6] = v[6]; a[(o) + 7] = v[7]; \
    a[(o) + 8] = v[8]; a[(o) + 9] = v[9]; a[(o) + 10] = v[10]; a[(o) + 11] = v[11]; a[(o) + 12] = v[12]; a[(o) + 13] = v[13]; a[(o) + 14] = v[14]; a[(o) + 15] = v[15]; } while (0)
__device__ __forceinline__ f32x16 splat16(float x) { return (f32x16){x, x, x, x, x, x, x, x, x, x, x, x, x, x, x, x}; }
struct AttnState { f32x16 o[2]; float m, l, pend; bool started; };
constexpr float ATT_THR = 8.0f;
__device__ __forceinline__ void softmax_pv(AttnState& st, float (&sc)[32], const bf16x8 (&vf)[8], MLAS float* wsf, int lane, int r32, int hi) {
    if (__any(st.pend != 0.f)) {
#pragma unroll
        for (int r = 0; r < 32; ++r) sc[r] -= st.pend;
    }
    st.pend = 0.f;
    float ra = __builtin_fmaxf(__builtin_fmaxf(sc[0], sc[1]), sc[2]), rb = __builtin_fmaxf(__builtin_fmaxf(sc[3], sc[4]), sc[5]);
#pragma unroll
    for (int r = 6; r < 30; r += 4) { ra = __builtin_fmaxf(__builtin_fmaxf(ra, sc[r]), sc[r + 1]); rb = __builtin_fmaxf(__builtin_fmaxf(rb, sc[r + 2]), sc[r + 3]); }
    float rm = __builtin_fmaxf(__builtin_fmaxf(ra, rb), __builtin_fmaxf(sc[30], sc[31]));
    rm = halves_max_f(rm);
    const bool fresh = !st.started;
    const bool need = (rm > ATT_THR) || (fresh && rm < -ATT_THR && rm > -1e29f);
    st.started = st.started || (rm > -1e29f);
    if (__any(need)) {
        const float dl = need ? rm : 0.f;
        st.m += dl; st.pend = dl;
#pragma unroll
        for (int r = 0; r < 32; ++r) sc[r] -= dl;
        const float alpha = fresh ? 1.0f : __builtin_amdgcn_exp2f(-dl);
        st.l *= alpha;
        if (hi == 0) wsf[r32] = alpha;
        float fr_[16];
#pragma unroll
        for (int r = 0; r < 16; ++r) fr_[r] = wsf[crow(r, hi)];
        const f32x16 fv = {fr_[0], fr_[1], fr_[2], fr_[3], fr_[4], fr_[5], fr_[6], fr_[7], fr_[8], fr_[9], fr_[10], fr_[11], fr_[12], fr_[13], fr_[14], fr_[15]};
        st.o[0] = st.o[0] * fv; st.o[1] = st.o[1] * fv;
    }
    float pe[32]; float s0 = 0.f, s1 = 0.f;
#pragma unroll
    for (int r = 0; r < 32; r += 2) { pe[r] = __builtin_amdgcn_exp2f(sc[r]); pe[r + 1] = __builtin_amdgcn_exp2f(sc[r + 1]); s0 += pe[r]; s1 += pe[r + 1]; }
    st.l += s0 + s1;
    u32x4 pw[4];
#pragma unroll
    for (int k = 0; k < 4; ++k) pw[k] = (u32x4){cvtpk(pe[8 * k + 0], pe[8 * k + 1]), cvtpk(pe[8 * k + 2], pe[8 * k + 3]), cvtpk(pe[8 * k + 4], pe[8 * k + 5]), cvtpk(pe[8 * k + 6], pe[8 * k + 7])};
#pragma unroll
    for (int d0 = 0; d0 < 2; ++d0)
#pragma unroll
        for (int ks = 0; ks < 4; ++ks) st.o[d0] = __builtin_amdgcn_mfma_f32_32x32x16_bf16(__builtin_bit_cast(bf16x8, pw[ks]), vf[d0 * 4 + ks], st.o[d0], 0, 0, 0);
}
__device__ __forceinline__ void attn_store(AttnState& st, bf16_t* Ow, int pitch, MLAS float* wsf, MLAS bf16_t* stg, int lane, int r32, int hi) {
    float l = halves_sum_f(st.l);
    if (hi == 0) wsf[32 + r32] = l;
    float rli[16];
#pragma unroll
    for (int r = 0; r < 16; ++r) rli[r] = 1.0f / wsf[32 + crow(r, hi)];
#pragma unroll
    for (int r = 0; r < 16; ++r) { const int orow = crow(r, hi);
#pragma unroll
        for (int d0 = 0; d0 < 2; ++d0) { const unsigned short b = (unsigned short)(cvtpk(st.o[d0][r] * rli[r], 0.f) & 0xffffu); stg[orow * 64 + d0 * 32 + r32] = b; } }
#pragma unroll
    for (int i = 0; i < 4; ++i) { const int row = i * 8 + (lane >> 3), ch = lane & 7; const u32x4 v = *(const MLAS u32x4*)(stg + row * 64 + ch * 8); *(u32x4*)(Ow + (size_t)row * pitch + ch * 8) = v; }
}

#ifndef DBG_REP_BS
#define DBG_REP_BS 1
#endif
__device__ __forceinline__ unsigned pk_sub_sat_u16(unsigned a, unsigned b) { unsigned r; asm("v_pk_sub_u16 %0, %1, %2 clamp" : "=v"(r) : "v"(a), "v"(b)); return r; }
__device__ __forceinline__ unsigned pk_min_u16(unsigned a, unsigned b) { unsigned r; asm("v_pk_min_u16 %0, %1, %2" : "=v"(r) : "v"(a), "v"(b)); return r; }
__device__ __forceinline__ unsigned pk_add_u16(unsigned a, unsigned b) { unsigned r; asm("v_pk_add_u16 %0, %1, %2" : "=v"(r) : "v"(a), "v"(b)); return r; }
__device__ __forceinline__ unsigned pk_ashr_i16(unsigned a, unsigned sh2) { unsigned r; asm("v_pk_ashrrev_i16 %0, %1, %2" : "=v"(r) : "v"(sh2), "v"(a)); return r; }
__device__ __forceinline__ unsigned score_keys(float a, float b) {
    const unsigned p = __builtin_bit_cast(unsigned, __builtin_amdgcn_cvt_pkrtz(a, b));
    const unsigned m = pk_ashr_i16(p, 0x000f000fu);
    return p ^ (m | 0x80008000u);
}
template <int NS> __device__ __forceinline__ unsigned bit_search(const unsigned (&kp)[8][8], MLAS unsigned* cntx, int wid, int r32, int hi) {
    unsigned tau = 0u;
#pragma unroll 1
    for (int bit = 15; bit >= 0; --bit) {
        const unsigned cand = tau | (1u << bit);
        const unsigned c2 = (cand - 1u) * 0x00010001u;
        unsigned cnt2 = 0;
#pragma unroll
        for (int jj = 0; jj < NS; ++jj)
#pragma unroll
            for (int r = 0; r < 8; ++r) cnt2 = pk_add_u16(cnt2, pk_min_u16(pk_sub_sat_u16(kp[jj][r], c2), 0x00010001u));
        unsigned cnt = (cnt2 & 0xffffu) + (cnt2 >> 16);
        cnt = halves_add_u(cnt);
        MLAS unsigned* cb = cntx + (bit & 1) * 256;
        if (hi == 0) cb[wid * 32 + r32] = cnt;
        LGKM_BAR();
        unsigned tot = 0;
#pragma unroll
        for (int w = 0; w < 8; ++w) tot += cb[w * 32 + r32];
        if (tot >= 256u) tau = cand;
    }
    return tau;
}
__device__ __forceinline__ void dsa_select(int b, int qg, const bf16_t* Z0, char* shm, const int wave_s) {
    const int tid_ = wave_s * 64 + lane_opaque(); const int tid = tid_, lane = tid & 63, r32 = lane & 31, hi = lane >> 5; const int wid = __builtin_amdgcn_readfirstlane(tid >> 6);
    MLAS char* L = (MLAS char*)shm;
    const int c = qg >> 1, nkeys = 64 * (c + 1), nt32 = nkeys >> 5, nt64 = nkeys >> 6;
    const size_t rowb = (size_t)b * SEQ;
    const size_t tok0 = rowb + 32 * qg;
    MLAS unsigned* selw = (MLAS unsigned*)(L + LX_SEL);
    if (nkeys <= 256) {
        for (int i = tid; i < 64 * 32; i += 512) selw[i] = (i < nt32 * 32) ? 0xffffffffu : 0u;
    } else {
        {
            MLAS u32x4* iqL = (MLAS u32x4*)(L + LX_IQ);
            for (int i = tid; i < 1024; i += 512) { const int q = i & 31, hh = (i >> 5) & 1, d0 = (i >> 6) & 3, h = i >> 8;
                iqL[i] = *(const u32x4*)(Z0 + (tok0 + q) * EV_N + 1280 + 64 * h + 16 * d0 + 8 * hh); }
        }
        float w4[4];
        { const u32x2 ww = *(const u32x2*)(Z0 + (tok0 + r32) * EV_N + 1216);
          w4[0] = pg8::bf_lo(ww.x) * 0.0625f; w4[1] = pg8::bf_hi(ww.x) * 0.0625f; w4[2] = pg8::bf_lo(ww.y) * 0.0625f; w4[3] = pg8::bf_hi(ww.y) * 0.0625f; }
        LGKM_BAR();
        unsigned kp[8][8];
        const int nslots = (nt32 + 7) >> 3;
        const MLAS bf16x8* iqf = (const MLAS bf16x8*)(L + LX_IQ) + hi * 32 + r32;
#pragma unroll
        for (int jj = 0; jj < 8; ++jj) {
            const int j = wid + 8 * jj;
            if (j < nt32) {
                const bf16_t* ikp = Z0 + (rowb + 32 * j + r32) * EV_N + 1152 + 8 * hi;
                bf16x8 af[4];
#pragma unroll
                for (int d0 = 0; d0 < 4; ++d0) af[d0] = *(const bf16x8*)(ikp + 16 * d0);
                f32x16 ah[4];
#pragma unroll
                for (int h = 0; h < 4; ++h) {
                    f32x16 a = {};
#pragma unroll
                    for (int d0 = 0; d0 < 4; ++d0) a = __builtin_amdgcn_mfma_f32_32x32x16_bf16(af[d0], iqf[(h * 4 + d0) * 64], a, 0, 0, 0);
                    ah[h] = a;
                }
                float sv[16];
                {
                    float a0[16], a1[16], a2[16], a3[16];
                    V16_TO_ARR(ah[0], a0, 0); V16_TO_ARR(ah[1], a1, 0); V16_TO_ARR(ah[2], a2, 0); V16_TO_ARR(ah[3], a3, 0);
#pragma unroll
                    for (int r = 0; r < 16; ++r) sv[r] = ((__builtin_fmaxf(a0[r], 0.f) * w4[0] + __builtin_fmaxf(a1[r], 0.f) * w4[1]) + __builtin_fmaxf(a2[r], 0.f) * w4[2]) + __builtin_fmaxf(a3[r], 0.f) * w4[3];
                }
#pragma unroll
                for (int r = 0; r < 8; ++r) kp[jj][r] = score_keys(sv[r], sv[r + 8]);
            } else {
#pragma unroll
                for (int r = 0; r < 8; ++r) kp[jj][r] = 0u;
            }
        }
        MLAS unsigned* cntx = (MLAS unsigned*)(L + L_OST);
        unsigned tau;
        for (int rep_ = 0; rep_ < DBG_REP_BS; ++rep_)
        switch (nslots) {
            case 2: tau = bit_search<2>(kp, cntx, wid, r32, hi); break;
            case 3: tau = bit_search<3>(kp, cntx, wid, r32, hi); break;
            case 4: tau = bit_search<4>(kp, cntx, wid, r32, hi); break;
            case 5: tau = bit_search<5>(kp, cntx, wid, r32, hi); break;
            case 6: tau = bit_search<6>(kp, cntx, wid, r32, hi); break;
            case 7: tau = bit_search<7>(kp, cntx, wid, r32, hi); break;
            default: tau = bit_search<8>(kp, cntx, wid, r32, hi); break;
        }
        MLAS unsigned* gtw = (MLAS unsigned*)(L + LX_GT); MLAS unsigned* eqw = (MLAS unsigned*)(L + LX_EQ); MLAS unsigned* pfx = (MLAS unsigned*)(L + LX_PFX);
        const unsigned tg = tau * 0x00010001u, te = (tau - 1u) * 0x00010001u;
#pragma unroll
        for (int jj = 0; jj < 8; ++jj) {
            const int j = wid + 8 * jj;
            if (j < nt32) {
                unsigned g = 0, e = 0;
#pragma unroll
                for (int r = 0; r < 8; ++r) {
                    const unsigned dgt = pk_min_u16(pk_sub_sat_u16(kp[jj][r], tg), 0x00010001u), dge = pk_min_u16(pk_sub_sat_u16(kp[jj][r], te), 0x00010001u);
                    const int pos = (r & 3) + 8 * (r >> 2);
                    g |= dgt << pos; e |= (dge - dgt) << pos;
                }
                g <<= 4 * hi; e <<= 4 * hi;
                g = halves_or_u(g); e = halves_or_u(e);
                if (hi == 0) { gtw[j * 32 + r32] = g; eqw[j * 32 + r32] = e; }
            }
        }
        LGKM_BAR();
        if (wid == 0 && hi == 0) {
            unsigned cg = 0;
            for (int j = 0; j < nt32; ++j) cg += __builtin_popcount(gtw[j * 32 + r32]);
            const int need = 256 - (int)cg;
            int run = 0;
            for (int j = 0; j < nt32; ++j) { const unsigned e = eqw[j * 32 + r32]; int k = need - run; k = k < 0 ? 0 : (k > 32 ? 32 : k); pfx[j * 32 + r32] = (unsigned)k; run += __builtin_popcount(e); }
        }
        LGKM_BAR();
        for (int i = tid; i < nt32 * 32; i += 512) {
            const unsigned g = gtw[i], e = eqw[i]; const int k = (int)pfx[i];
            unsigned take = 0;
            if (e != 0u && k > 0) {
                unsigned rem = e; int cntk = 0;
                while (rem != 0u && cntk < k) { const unsigned low = rem & (0u - rem); take |= low; rem ^= low; ++cntk; }
            }
            selw[i] = g | take;
        }
        for (int i = nt32 * 32 + tid; i < 64 * 32; i += 512) selw[i] = 0u;
    }
    WAITV_BAR();
}

__device__ __forceinline__ void fox_unit(int b, int h, int qb, const bf16_t* Z1, const float* F, const float* bfp, bf16_t* Y, char* shm, unsigned lds0, const int wave_s) {
    const int tid_ = wave_s * 64 + lane_opaque(); const int tid = tid_, lane = tid & 63, r32 = lane & 31, hi = lane >> 5; const int wid = __builtin_amdgcn_readfirstlane(tid >> 6);
    MLAS char* L = (MLAS char*)shm;
    const size_t rowb = (size_t)b * SEQ;
    const int NT = 4 * (qb + 1), nk = 64 * NT;
    MLAS float* cum2 = (MLAS float*)(L + L_X);
    MLAS float* wtot = (MLAS float*)(L + L_X + 8192);
    const bf16_t* Kb = Z1 + rowb * Z1P + 512 + 64 * h; const bf16_t* Vb = Z1 + rowb * Z1P + 1024 + 64 * h;
#pragma unroll
    for (int i = 0; i < 3; ++i) dma_kv(Kb + (size_t)64 * i * Z1P, Vb + (size_t)64 * i * Z1P, Z1P, lds0, i, wid, lane);
    {
        const float bias = bfp[h];
        const int s0 = 4 * tid;
        float v[4]; float run = 0.f;
#pragma unroll
        for (int i = 0; i < 4; ++i) {
            float x = 0.f;
            if (s0 + i < nk) x = F[(rowb + s0 + i) * 8 + h] + bias;
            const float ls = (s0 + i < nk) ? (fminf(x, 0.f) - log1pf(expf(-fabsf(x)))) : 0.f;
            run += ls; v[i] = run;
        }
        float inc = run;
#pragma unroll
        for (int o = 1; o < 64; o <<= 1) { const int ln = lane_opaque(); const float t = __builtin_bit_cast(float, __builtin_amdgcn_ds_bpermute((ln - o) << 2, __builtin_bit_cast(int, inc))); if (ln >= o) inc += t; }
        if (lane == 63) wtot[wid] = inc;
        LGKM_BAR();
        float off = inc - run;
        for (int w = 0; w < wid; ++w) off += wtot[w];
#pragma unroll
        for (int i = 0; i < 4; ++i) cum2[s0 + i] = (off + v[i]) * 1.4426950408889634f;
    }
    const int tq = 256 * qb + 32 * wid + r32;
    bf16x8 qr[4];
#pragma unroll
    for (int d0 = 0; d0 < 4; ++d0) qr[d0] = *(const bf16x8*)(Z1 + (rowb + tq) * Z1P + 64 * h + 16 * d0 + 8 * hi);
    AttnState st; st.o[0] = f32x16{}; st.o[1] = f32x16{}; st.m = 0.f; st.l = 0.f; st.pend = 0.f; st.started = false;
    MLAS float* wsf = (MLAS float*)(L + L_WSF) + wid * 64;
    WAITV_BAR();
    const float cq2 = cum2[tq];
    const int tlast = 4 * qb + (wid >> 1);
    f32x16 s0, s1;
    qkt(s0, s1, (lds_cptr)(L + L_K), qr, splat16(-st.m), r32, hi);
    for (int t = 0; t < NT; ++t) {
        const int slot = t & 3;
        { const int tt = (t + 3 < NT) ? t + 3 : NT - 1; dma_kv(Kb + (size_t)64 * tt * Z1P, Vb + (size_t)64 * tt * Z1P, Z1P, lds0, (t + 3) & 3, wid, lane); }
        bf16x8 kf[8], vf[8];
        kload(kf, (lds_cptr)(L + L_K + ((t + 1) & 3) * SLOTB), r32, hi);
        __builtin_amdgcn_sched_barrier(0);
        vload(vf, (lds_cptr)(L + L_V + slot * SLOTB), lane, hi);
        const MLAS float* cb = cum2 + 64 * t + 4 * hi;
        f32x4 c0[4], c1[4];
#pragma unroll
        for (int g = 0; g < 4; ++g) { c0[g] = *(const MLAS f32x4*)(cb + 8 * g); c1[g] = *(const MLAS f32x4*)(cb + 32 + 8 * g); }
        f32x16 n0, n1;
        qkt_mma(n0, n1, kf, qr, splat16(-st.m));
        float sc[32];
        V16_TO_ARR(s0, sc, 0); V16_TO_ARR(s1, sc, 16);
#pragma unroll
        for (int g = 0; g < 4; ++g) {
            sc[4 * g + 0] += cq2 - c0[g].x; sc[4 * g + 1] += cq2 - c0[g].y; sc[4 * g + 2] += cq2 - c0[g].z; sc[4 * g + 3] += cq2 - c0[g].w;
            sc[16 + 4 * g + 0] += cq2 - c1[g].x; sc[16 + 4 * g + 1] += cq2 - c1[g].y; sc[16 + 4 * g + 2] += cq2 - c1[g].z; sc[16 + 4 * g + 3] += cq2 - c1[g].w;
        }
        if (t >= tlast) {
            const int qrel = tq - 64 * t;
#pragma unroll
            for (int r = 0; r < 16; ++r) { const int kr = crow(r, hi); if (kr > qrel) sc[r] = -INFINITY; if (kr + 32 > qrel) sc[16 + r] = -INFINITY; }
        }
        softmax_pv(st, sc, vf, wsf, lane, r32, hi);
        s0 = n0; s1 = n1;
        WAITV2_BAR();
    }
    attn_store(st, Y + (rowb + 256 * qb + 32 * wid) * DMODEL + 64 * h, DMODEL, wsf, (MLAS bf16_t*)(L + L_OST) + wid * 2048, lane, r32, hi);
    WAITV_BAR();
}

__device__ __forceinline__ void sgu_unit(int b, int n, int g, const bf16_t* Z1, const float* sst, const float* lng, const float* lnb, const bf16_t* Wm, const float* bs, bf16_t* Y, char* shm, const int wave_s) {
    const int tid_ = wave_s * 64 + lane_opaque(); const int tid = tid_, lane = tid & 63, r32 = lane & 31, hi = lane >> 5; const int wid = __builtin_amdgcn_readfirstlane(tid >> 6);
    MLAS char* L = (MLAS char*)shm;
    MLAS bf16_t* vn = (MLAS bf16_t*)L;
    constexpr int VP = 136;
    const size_t tok0 = (size_t)b * SEQ + 128 * n;
    {
        const int j = tid >> 2, cq = (tid & 3) * 32;
        const float* sp = sst + (tok0 + j) * 16;
        float s1 = 0.f, s2 = 0.f;
#pragma unroll
        for (int k = 0; k < 8; ++k) { s1 += sp[2 * k]; s2 += sp[2 * k + 1]; }
        const float mu = s1 * (1.0f / 512.0f); const float var = fmaxf(s2 * (1.0f / 512.0f) - mu * mu, 0.f);
        const float rstd = 1.0f / sqrtf(var + RMS_EPS);
        const bf16_t* vp = Z1 + (tok0 + j) * Z1P + 2048 + 128 * g + cq;
#pragma unroll
        for (int k = 0; k < 4; ++k) {
            const u32x4 w = *(const u32x4*)(vp + 8 * k);
            const int cc = 128 * g + cq + 8 * k;
            const f32x4 g0 = *(const f32x4*)(lng + cc), g1 = *(const f32x4*)(lng + cc + 4), b0 = *(const f32x4*)(lnb + cc), b1 = *(const f32x4*)(lnb + cc + 4);
            float x[8] = {pg8::bf_lo(w.x), pg8::bf_hi(w.x), pg8::bf_lo(w.y), pg8::bf_hi(w.y), pg8::bf_lo(w.z), pg8::bf_hi(w.z), pg8::bf_lo(w.w), pg8::bf_hi(w.w)};
            float y[8];
#pragma unroll
            for (int i = 0; i < 4; ++i) { y[i] = (x[i] - mu) * rstd * g0[i] + b0[i]; y[4 + i] = (x[4 + i] - mu) * rstd * g1[i] + b1[i]; }
            u32x4 o; o.x = cvtpk(y[0], y[1]); o.y = cvtpk(y[2], y[3]); o.z = cvtpk(y[4], y[5]); o.w = cvtpk(y[6], y[7]);
            *(MLAS u32x4*)(vn + j * VP + cq + 8 * k) = o;
        }
    }
    LGKM_BAR();
    MLAS bf16_t* ut = (MLAS bf16_t*)(L + 128 * VP * 2);
    {
        const int j = tid >> 2, cq = (tid & 3) * 32;
        const bf16_t* up = Z1 + (tok0 + j) * Z1P + 1536 + 128 * g + cq;
#pragma unroll
        for (int k = 0; k < 4; ++k) *(MLAS u32x4*)(ut + j * VP + cq + 8 * k) = *(const u32x4*)(up + 8 * k);
    }
    LGKM_BAR();
    const int ib = wid & 3;
    const bf16_t* wrow = Wm + ((size_t)g * 128 + 32 * ib + r32) * 128 + 8 * hi;
    bf16x8 af[8];
#pragma unroll
    for (int s = 0; s < 8; ++s) af[s] = *(const bf16x8*)(wrow + 16 * s);
#pragma unroll
    for (int cbi = 0; cbi < 2; ++cbi) {
        const int cb = (wid >> 2) * 2 + cbi;
        f32x16 acc = {};
        lds_cptr bp = (lds_cptr)(vn) + ((size_t)(8 * hi + ((lane & 15) >> 2)) * VP + 32 * cb + 16 * ((lane >> 4) & 1) + 4 * (lane & 3)) * 2;
#pragma unroll
        for (int s = 0; s < 8; ++s) {
            const s16x4 lo = vtr(bp + (16 * s) * VP * 2), hh = vtr(bp + (16 * s + 4) * VP * 2);
            const bf16x8 bfr = {lo[0], lo[1], lo[2], lo[3], hh[0], hh[1], hh[2], hh[3]};
            acc = __builtin_amdgcn_mfma_f32_32x32x16_bf16(af[s], bfr, acc, 0, 0, 0);
        }
        float a16[16]; V16_TO_ARR(acc, a16, 0);
#pragma unroll
        for (int r = 0; r < 16; ++r) {
            const int i = 32 * ib + crow(r, hi), cc = 32 * cb + r32;
            const float uu = __builtin_bit_cast(float, (unsigned)ut[i * VP + cc] << 16);
            const float o = uu * (a16[r] + bs[g * 128 + i]);
            ut[i * VP + cc] = (bf16_t)(cvtpk(o, 0.f) & 0xffffu);
        }
    }
    LGKM_BAR();
    {
        const int j = tid >> 2, cq = (tid & 3) * 32;
        bf16_t* yp = Y + (tok0 + j) * DMODEL + 512 + 128 * g + cq;
#pragma unroll
        for (int k = 0; k < 4; ++k) *(u32x4*)(yp + 8 * k) = *(const MLAS u32x4*)(ut + j * VP + cq + 8 * k);
    }
    LGKM_BAR();
}

__device__ __forceinline__ void pool_item(int item, const bf16_t* Z0, bf16_t* Y) {
    const int row = item >> 6, ch = item & 63, c0 = ch * 8, g = ch >> 4;
    const int w = 2 << g, tpos = row & (SEQ - 1);
    const int cnt = (tpos + 1 < w) ? tpos + 1 : w;
    u32x4 v[16];
#pragma unroll
    for (int k = 0; k < 16; ++k) { v[k] = (u32x4){0u, 0u, 0u, 0u}; if (k < cnt) v[k] = *(const u32x4*)(Z0 + (size_t)(row - k) * EV_N + c0); }
    float s[8] = {0.f, 0.f, 0.f, 0.f, 0.f, 0.f, 0.f, 0.f};
#pragma unroll
    for (int k = 0; k < 16; ++k) {
        s[0] += pg8::bf_lo(v[k].x); s[1] += pg8::bf_hi(v[k].x); s[2] += pg8::bf_lo(v[k].y); s[3] += pg8::bf_hi(v[k].y);
        s[4] += pg8::bf_lo(v[k].z); s[5] += pg8::bf_hi(v[k].z); s[6] += pg8::bf_lo(v[k].w); s[7] += pg8::bf_hi(v[k].w);
    }
    const float self[8] = {pg8::bf_lo(v[0].x), pg8::bf_hi(v[0].x), pg8::bf_lo(v[0].y), pg8::bf_hi(v[0].y), pg8::bf_lo(v[0].z), pg8::bf_hi(v[0].z), pg8::bf_lo(v[0].w), pg8::bf_hi(v[0].w)};
    const float inv = 1.0f / (float)cnt;
    u32x4 o; o.x = cvtpk(s[0] * inv - self[0], s[1] * inv - self[1]); o.y = cvtpk(s[2] * inv - self[2], s[3] * inv - self[3]);
    o.z = cvtpk(s[4] * inv - self[4], s[5] * inv - self[5]); o.w = cvtpk(s[6] * inv - self[6], s[7] * inv - self[7]);
    *(u32x4*)(Y + (size_t)row * DMODEL + c0) = o;
}
}
namespace foxa {
using bf16=__hip_bfloat16;
using bf16x8=__attribute__((ext_vector_type(8)))short;
using s16x4=__attribute__((ext_vector_type(4)))short;
using f32x16=__attribute__((ext_vector_type(16)))float;
using u32x4=__attribute__((ext_vector_type(4)))unsigned;
using f32x4v=__attribute__((ext_vector_type(4)))float;
constexpr int CUM_OFF=86016;
constexpr int SEQL=2048,D=64,OPI=1024;
constexpr int NW=8,QBLK=32,QB=QBLK*NW,KVBLK=64;
__device__ __forceinline__ int crow(int r,int hi){return (r&3)+8*(r>>2)+4*hi;}
#define SBAR() __builtin_amdgcn_sched_barrier(0)
__device__ __forceinline__ void cmask(f32x16&p0,f32x16&p1,int jb,int qrel,int hi){
  const float NEG=-INFINITY; int kb=64*jb+4*hi;
  #pragma unroll
  for(int r=0;r<16;++r){int kv=kb+(r&3)+8*(r>>2); if(kv>qrel)p0[r]=NEG; if(kv+32>qrel)p1[r]=NEG;}
}

constexpr int NSLOT=3, SLOTB=8192;
constexpr int LDS_K=0, LDS_V=NSLOT*SLOTB, LDS_WS=2*NSLOT*SLOTB, LDS_OST=LDS_WS+NW*64*4, LDS_BYTES=LDS_OST+NW*4096;
constexpr float C2=0.125f*1.4426950408889634f;
__device__ __forceinline__ void glds16(const void*gsrc,unsigned lds_dst){unsigned keep;
  asm volatile("s_mov_b32 %0, m0\n\ts_mov_b32 m0, %2\n\ts_nop 0\n\tglobal_load_lds_dwordx4 %1, off\n\ts_mov_b32 m0, %0":"=&s"(keep):"v"(gsrc),"s"(lds_dst):"memory");}
__device__ __forceinline__ float max3f(float a,float b,float c){float r;asm("v_max3_f32 %0, %1, %2, %3":"=v"(r):"v"(a),"v"(b),"v"(c));return r;}
__device__ __forceinline__ float max2f(float a,float b){float r;asm("v_max_f32_e32 %0, %1, %2":"=v"(r):"v"(a),"v"(b));return r;}
__device__ __forceinline__ float fadd_s(float a,float b){float r;asm("v_add_f32_e32 %0, %1, %2":"=v"(r):"v"(a),"v"(b));return r;}
__device__ __forceinline__ float fsub_s(float a,float b){float r;asm("v_sub_f32_e32 %0, %1, %2":"=v"(r):"v"(a),"v"(b));return r;}
typedef float f32x2_t __attribute__((ext_vector_type(2))); typedef __bf16 bf16x2_t __attribute__((ext_vector_type(2)));
__device__ __forceinline__ unsigned cvtpk_s(float lo,float hi){f32x2_t v={lo,hi};bf16x2_t b=__builtin_convertvector(v,bf16x2_t);return __builtin_bit_cast(unsigned,b);}
#define WAIT_BAR(N) asm volatile("s_waitcnt vmcnt(" #N ") lgkmcnt(0)\n\ts_barrier":::"memory")

__device__ __forceinline__ void qkt(f32x16&p0,f32x16&p1,const char*Kslot,const bf16x8*qr,const f32x16&negm,int r32,int hi){
  const char*kb=Kslot+hi*1024+r32*16;
  #pragma unroll
  for(int d0=0;d0<4;++d0){
    const bf16x8 b0=*reinterpret_cast<const bf16x8*>(kb+d0*2048);
    const bf16x8 b1=*reinterpret_cast<const bf16x8*>(kb+d0*2048+512);
    if(d0==0){p0=__builtin_amdgcn_mfma_f32_32x32x16_bf16(b0,qr[0],negm,0,0,0);p1=__builtin_amdgcn_mfma_f32_32x32x16_bf16(b1,qr[0],negm,0,0,0);}
    else{p0=__builtin_amdgcn_mfma_f32_32x32x16_bf16(b0,qr[d0],p0,0,0,0);p1=__builtin_amdgcn_mfma_f32_32x32x16_bf16(b1,qr[d0],p1,0,0,0);}}
}
typedef __attribute__((address_space(3))) const char* lds_cptr;
typedef short v4i16_t __attribute__((ext_vector_type(4)));
__device__ __forceinline__ void kload8(bf16x8*kf,lds_cptr kp){
  kf[0]=*(const __attribute__((address_space(3))) bf16x8*)(kp);      kf[1]=*(const __attribute__((address_space(3))) bf16x8*)(kp+512);
  kf[2]=*(const __attribute__((address_space(3))) bf16x8*)(kp+2048); kf[3]=*(const __attribute__((address_space(3))) bf16x8*)(kp+2560);
  kf[4]=*(const __attribute__((address_space(3))) bf16x8*)(kp+4096); kf[5]=*(const __attribute__((address_space(3))) bf16x8*)(kp+4608);
  kf[6]=*(const __attribute__((address_space(3))) bf16x8*)(kp+6144); kf[7]=*(const __attribute__((address_space(3))) bf16x8*)(kp+6656);
}
__device__ __forceinline__ void kload2(bf16x8*kf,lds_cptr kp,int j){ kf[2*j]=*(const __attribute__((address_space(3))) bf16x8*)(kp+j*2048); kf[2*j+1]=*(const __attribute__((address_space(3))) bf16x8*)(kp+j*2048+512); }
__device__ __forceinline__ s16x4 vtr(lds_cptr p){ return __builtin_bit_cast(s16x4,__builtin_amdgcn_ds_read_tr16_b64_v4i16((__attribute__((address_space(3))) v4i16_t*)p)); }
__device__ __forceinline__ float rowmax(const f32x16&p0,const f32x16&p1){
  float a=max3f(p0[0],p0[1],p1[0]),b=max3f(p0[2],p0[3],p1[1]);a=max3f(a,p1[2],p1[3]);
  #pragma unroll
  for(int r=4;r<16;r+=4){a=max3f(a,p0[r],p0[r+1]);b=max3f(b,p0[r+2],p0[r+3]);a=max3f(a,p1[r],p1[r+1]);b=max3f(b,p1[r+2],p1[r+3]);}
  const float m=max2f(a,b);
  auto rr=__builtin_amdgcn_permlane32_swap(__float_as_uint(m),__float_as_uint(m),false,false);
  return max2f(__uint_as_float(rr[0]),__uint_as_float(rr[1]));
}
__device__ __forceinline__ void pv(f32x16*o,int vb,bf16x8 pa0,bf16x8 pa1,bf16x8 pa2,bf16x8 pa3){
  #pragma unroll
  for(int d0=0;d0<2;++d0){s16x4 lo[4],hi[4];
    #pragma unroll
    for(int ks=0;ks<4;++ks){
      asm volatile("ds_read_b64_tr_b16 %0,%1 offset:%c2":"=&v"(lo[ks]):"v"(vb),"i"(d0*4096+ks*1024):"memory");
      asm volatile("ds_read_b64_tr_b16 %0,%1 offset:%c2":"=&v"(hi[ks]):"v"(vb),"i"(d0*4096+ks*1024+512):"memory");}
    asm volatile("s_waitcnt lgkmcnt(0)":::"memory");SBAR();
    #define PK(k) (bf16x8){lo[k][0],lo[k][1],lo[k][2],lo[k][3],hi[k][0],hi[k][1],hi[k][2],hi[k][3]}
    o[d0]=__builtin_amdgcn_mfma_f32_32x32x16_bf16(pa0,PK(0),o[d0],0,0,0);
    o[d0]=__builtin_amdgcn_mfma_f32_32x32x16_bf16(pa1,PK(1),o[d0],0,0,0);
    o[d0]=__builtin_amdgcn_mfma_f32_32x32x16_bf16(pa2,PK(2),o[d0],0,0,0);
    o[d0]=__builtin_amdgcn_mfma_f32_32x32x16_bf16(pa3,PK(3),o[d0],0,0,0);
    #undef PK
  }
}

#ifndef ATTN_STORE16
#define ATTN_STORE16(p,v) (*(u32x4*)(p)=(v))
#endif
template<int THRL,int MODE,int QKVP,class CumFn> __device__ __forceinline__ void attn_unit(CumFn&& CUMFN,int b,int h,int qb,int q0abs,int NTU,const bf16*Q,const bf16*__restrict__ K,const bf16*__restrict__ V,bf16*O,char*shm,const __attribute__((address_space(3))) unsigned*selw,const int wave_s){
  const int tid=wave_s*64+lane_opaque(),lane=tid&63,r32=lane&31,hi=lane>>5; const int wid=__builtin_amdgcn_readfirstlane(tid>>6);
  const long rowbase=(long)b*SEQL; const int q0=(MODE==0)?qb*QB:q0abs;
  const bf16*Qw=(MODE==0)?Q+(rowbase+q0+wid*QBLK)*QKVP+h*D:Q+(rowbase+q0)*QKVP+wid*D;
  const bf16*Kh=K+rowbase*QKVP+h*D,*Vh=V+rowbase*QKVP+h*D;
  const unsigned lds0=(unsigned)(uintptr_t)shm;
  float*wsf=(float*)(shm+LDS_WS)+wid*64;
  const bf16*ksrc=Kh+(long)lane*QKVP+wid*8;
  const bf16*vsrc=Vh+(long)(16*(wid&3)+(lane>>2))*QKVP+(wid>>2)*32+(lane&3)*8;
  const unsigned kdst=lds0+LDS_K+wid*1024, vdst=lds0+LDS_V+wid*1024;
  #define DMA_K(t,slot) glds16(ksrc+(long)(t)*KVBLK*QKVP,(unsigned)__builtin_amdgcn_readfirstlane(kdst+(slot)))
  #define DMA_V(t,slot) glds16(vsrc+(long)(t)*KVBLK*QKVP,(unsigned)__builtin_amdgcn_readfirstlane(vdst+(slot)))
  const int vb0=(int)(lds0+LDS_V)+((lane>>4)&1)*32+(lane&3)*8+(4*hi+((lane&15)>>2))*64;
  const char*Kbase=shm+LDS_K; bf16x8 kf[8];
  const lds_cptr shm3=(lds_cptr)shm; const lds_cptr kp0=shm3+LDS_K+hi*1024+r32*16; const lds_cptr vp0=shm3+LDS_V+((lane>>4)&1)*32+(lane&3)*8+(4*hi+((lane&15)>>2))*64;
  const int NT=(MODE==0)?(q0+QB)/KVBLK:NTU;
  DMA_K(0,0);DMA_V(0,0);DMA_K(1,SLOTB);
  if constexpr(MODE==0){ CUMFN(); }
  bf16x8 qr[4];
  #pragma unroll
  for(int d0=0;d0<4;++d0)qr[d0]=*reinterpret_cast<const bf16x8*>(&Qw[(long)r32*QKVP+d0*16+hi*8]);
  float mhat=0.f,l_reg=0.f;float z_=0.f;asm volatile("":"+v"(z_));f32x16 o[2];o[0]=(f32x16){z_,z_,z_,z_,z_,z_,z_,z_,z_,z_,z_,z_,z_,z_,z_,z_};o[1]=o[0];f32x16 negm=o[0];asm volatile("":"+v"(negm));
  const int qrel=wid*QBLK+r32;
  const __attribute__((address_space(3))) float*cum2=(const __attribute__((address_space(3))) float*)(shm+CUM_OFF);
  const float cq2=(MODE==0)?cum2[q0+qrel]:0.f;
  #define BIAS(P0,P1,t) do{ if constexpr(MODE==0){ const __attribute__((address_space(3))) float*cb_=cum2+64*(t)+4*hi; \
    _Pragma("unroll") for(int g_=0;g_<4;++g_){ const f32x4v c0_=*(const __attribute__((address_space(3))) f32x4v*)(cb_+8*g_), c1_=*(const __attribute__((address_space(3))) f32x4v*)(cb_+32+8*g_); \
      P0[4*g_+0]+=cq2-c0_.x; P0[4*g_+1]+=cq2-c0_.y; P0[4*g_+2]+=cq2-c0_.z; P0[4*g_+3]+=cq2-c0_.w; \
      P1[4*g_+0]+=cq2-c1_.x; P1[4*g_+1]+=cq2-c1_.y; P1[4*g_+2]+=cq2-c1_.z; P1[4*g_+3]+=cq2-c1_.w; } } }while(0)
  #define SELM(P0,P1,t) do{ if constexpr(MODE==1){ const unsigned w0_=selw[(2*(t))*32+r32]>>(4*hi), w1_=selw[(2*(t)+1)*32+r32]>>(4*hi); \
    _Pragma("unroll") for(int r=0;r<16;++r){ const int sh_=(r&3)+8*(r>>2); if(!((w0_>>sh_)&1u))P0[r]=-INFINITY; if(!((w1_>>sh_)&1u))P1[r]=-INFINITY; } } }while(0)
  #define CMASK(P0,P1,t) do{ if constexpr(MODE==0){int jb_=(t)-(NT-4); if(jb_>=0)cmask(P0,P1,jb_,qrel,hi);} }while(0)
  bool resc=false;
  #define START(P0,P1) do{ const float rm=rowmax(P0,P1); resc=false; \
    { const float dl=(MODE==1&&!(rm>-1e30f))?0.f:rm; mhat=fadd_s(mhat,dl); \
      _Pragma("unroll") for(int r=0;r<16;++r){P0[r]=fsub_s(P0[r],dl);P1[r]=fsub_s(P1[r],dl);} \
      _Pragma("unroll") for(int r=0;r<16;++r)negm[r]=-mhat; asm volatile("":"+v"(negm)); } \
    _Pragma("unroll") for(int r=0;r<16;++r)P0[r]=__builtin_amdgcn_exp2f(P0[r]); }while(0)
  #define RESC() do{ if(resc){ asm volatile("s_waitcnt lgkmcnt(0)":::"memory"); \
      _Pragma("unroll") for(int d_=0;d_<2;++d_) _Pragma("unroll") for(int r=0;r<16;++r)o[d_][r]*=wsf[crow(r,hi)]; } }while(0)
  f32x16 pA0,pA1,pB0,pB1;
  int sl_prev=0,sl_cur=0,sl_next=SLOTB;
  #define ROT() do{sl_prev=sl_cur;sl_cur=sl_next;sl_next=(sl_next==(NSLOT-1)*SLOTB)?0:sl_next+SLOTB;}while(0)
  DMA_K(2,2*SLOTB);
  WAIT_BAR(3);
  qkt(pA0,pA1,Kbase,qr,negm,r32,hi);asm volatile("s_nop 15\n\ts_nop 7":"+v"(pA0),"+v"(pA1));BIAS(pA0,pA1,0);SELM(pA0,pA1,0);CMASK(pA0,pA1,0);
  START(pA0,pA1);
  _Pragma("unroll") for(int r=0;r<16;++r)pA1[r]=__builtin_amdgcn_exp2f(pA1[r]);
  WAIT_BAR(0);
  DMA_K(3,0);DMA_V(1,SLOTB);
  ROT();
  kload8(kf,kp0+sl_cur);
  WAIT_BAR(2);
  s16x4 vlo[8],vhi[8]; u32x4 pw0,pw1,pw2,pw3;
  #define PKW(P,B) cvtpk_s(P[B],P[B+1])
  #define PAF(k) __builtin_bit_cast(bf16x8,pw##k)
  #define VFR(i) (bf16x8){vlo[i][0],vlo[i][1],vlo[i][2],vlo[i][3],vhi[i][0],vhi[i][1],vhi[i][2],vhi[i][3]}
  #define PIN(x) asm volatile("":"+v"(x))
  #define MX3(a,b,c) __builtin_fmaxf(__builtin_fmaxf((a),(b)),(c))
  #define GAPA(MF,A0,A1,A2,A3,W0,W1,PW) do{ MF; sacc+=A0; sacc+=A1; sacc+=A2; sacc+=A3; PIN(sacc); W0; W1; PIN(PW); SBAR(); }while(0)
  #define EX(v) __builtin_amdgcn_exp2f(v)
  #define GAPB(MF,X,B) do{ MF; X[B]=EX(X[B]); X[B+1]=EX(X[B+1]); X[B+2]=EX(X[B+2]); X[B+3]=EX(X[B+3]); PIN(X); SBAR(); }while(0)
  #define VRD(i) do{ vlo[i]=vtr(vp_+(((i)>>2)*4096+((i)&3)*1024)); vhi[i]=vtr(vp_+(((i)>>2)*4096+((i)&3)*1024+512)); }while(0)
  #define KRD(G,j) do{ if(G){ kload2(kf,kp0+sl_next,j); SBAR(); } }while(0)
  #define STEP(C0,C1,P0,P1,t,GK,GV,GL) do{ SBAR(); \
    const lds_cptr vp_=vp0+sl_prev; \
    VRD(0); SBAR(); float sacc=(P0[0]+P0[1]); \
    GAPA(C0=__builtin_amdgcn_mfma_f32_32x32x16_bf16(kf[0],qr[0],negm,0,0,0), P0[2],P0[3],P0[4],P0[5],     pw0[0]=PKW(P0,0), pw0[1]=PKW(P0,2), pw0); \
    VRD(4); SBAR(); GAPA(C1=__builtin_amdgcn_mfma_f32_32x32x16_bf16(kf[1],qr[0],negm,0,0,0), P0[6],P0[7],P0[8],P0[9],     pw0[2]=PKW(P0,4), pw0[3]=PKW(P0,6), pw0); \
    VRD(1); SBAR(); GAPA(C0=__builtin_amdgcn_mfma_f32_32x32x16_bf16(kf[2],qr[1],C0,0,0,0),   P0[10],P0[11],P0[12],P0[13], pw1[0]=PKW(P0,8), pw1[1]=PKW(P0,10), pw1); \
    VRD(5); SBAR(); GAPA(C1=__builtin_amdgcn_mfma_f32_32x32x16_bf16(kf[3],qr[1],C1,0,0,0),   P0[14],P0[15],P1[0],P1[1],   pw1[2]=PKW(P0,12),pw1[3]=PKW(P0,14), pw1); \
    VRD(2); SBAR(); GAPA(C0=__builtin_amdgcn_mfma_f32_32x32x16_bf16(kf[4],qr[2],C0,0,0,0),   P1[2],P1[3],P1[4],P1[5],     pw2[0]=PKW(P1,0), pw2[1]=PKW(P1,2), pw2); \
    VRD(6); SBAR(); GAPA(C1=__builtin_amdgcn_mfma_f32_32x32x16_bf16(kf[5],qr[2],C1,0,0,0),   P1[6],P1[7],P1[8],P1[9],     pw2[2]=PKW(P1,4), pw2[3]=PKW(P1,6), pw2); \
    VRD(3); SBAR(); GAPA(C0=__builtin_amdgcn_mfma_f32_32x32x16_bf16(kf[6],qr[3],C0,0,0,0),   P1[10],P1[11],P1[12],P1[13], pw3[0]=PKW(P1,8), pw3[1]=PKW(P1,10), pw3); \
    VRD(7); SBAR(); GAPA(C1=__builtin_amdgcn_mfma_f32_32x32x16_bf16(kf[7],qr[3],C1,0,0,0),   P1[14],P1[15],0.f,0.f,       pw3[2]=PKW(P1,12),pw3[3]=PKW(P1,14), pw3); \
    l_reg+=sacc; \
    if(GK){DMA_K((t)+3,sl_cur);} if(GV){DMA_V((t)+1,sl_next);} \
    BIAS(C0,C1,t); SELM(C0,C1,t); CMASK(C0,C1,t); \
    { float a=MX3(C0[0],C0[1],C1[0]),b=MX3(C0[2],C0[3],C1[1]); a=MX3(a,C1[2],C1[3]); \
      _Pragma("unroll") for(int r=4;r<16;r+=4){a=MX3(a,C0[r],C0[r+1]);b=MX3(b,C0[r+2],C0[r+3]);a=MX3(a,C1[r],C1[r+1]);b=MX3(b,C1[r+2],C1[r+3]);} \
      float rm=__builtin_fmaxf(a,b); { auto rr=__builtin_amdgcn_permlane32_swap(__float_as_uint(rm),__float_as_uint(rm),false,false); rm=__builtin_fmaxf(__uint_as_float(rr[0]),__uint_as_float(rr[1])); } \
      resc=false; \
      if(__builtin_expect(__any(rm>(float)THRL),0)){ const float dl=__builtin_fmaxf(rm,0.f); mhat+=dl; \
        _Pragma("unroll") for(int r=0;r<16;++r){C0[r]-=dl;C1[r]-=dl;} \
        _Pragma("unroll") for(int r=0;r<16;++r)negm[r]=-mhat; asm volatile("":"+v"(negm)); \
        const float f=__builtin_amdgcn_exp2f(-dl); l_reg*=f; if(hi==0)wsf[r32]=f; resc=true; } } \
    SBAR(); \
    GAPB(o[0]=__builtin_amdgcn_mfma_f32_32x32x16_bf16(PAF(0),VFR(0),o[0],0,0,0), C0,0); \
    GAPB(o[1]=__builtin_amdgcn_mfma_f32_32x32x16_bf16(PAF(0),VFR(4),o[1],0,0,0), C0,4); \
    KRD(GL,0); GAPB(o[0]=__builtin_amdgcn_mfma_f32_32x32x16_bf16(PAF(1),VFR(1),o[0],0,0,0), C0,8); \
    KRD(GL,1); GAPB(o[1]=__builtin_amdgcn_mfma_f32_32x32x16_bf16(PAF(1),VFR(5),o[1],0,0,0), C0,12); \
    KRD(GL,2); GAPB(o[0]=__builtin_amdgcn_mfma_f32_32x32x16_bf16(PAF(2),VFR(2),o[0],0,0,0), C1,0); \
    KRD(GL,3); GAPB(o[1]=__builtin_amdgcn_mfma_f32_32x32x16_bf16(PAF(2),VFR(6),o[1],0,0,0), C1,4); \
    GAPB(o[0]=__builtin_amdgcn_mfma_f32_32x32x16_bf16(PAF(3),VFR(3),o[0],0,0,0), C1,8); \
    GAPB(o[1]=__builtin_amdgcn_mfma_f32_32x32x16_bf16(PAF(3),VFR(7),o[1],0,0,0), C1,12); \
    }while(0)
  int t=1;
  #undef CMASK
  #define CMASK(P0,P1,t) do{}while(0)
  for(;t+5<NT;t+=2){
    STEP(pB0,pB1,pA0,pA1,t,true,true,true);     WAIT_BAR(2); RESC(); ROT();
    STEP(pA0,pA1,pB0,pB1,t+1,true,true,true);   WAIT_BAR(2); RESC(); ROT();
  }
  #undef CMASK
  #define CMASK(P0,P1,t) do{ if constexpr(MODE==0){int jb_=(t)-(NT-4); if(jb_>=0)cmask(P0,P1,jb_,qrel,hi);} }while(0)
  #define ENDW(tt) do{ if((tt)+3<NT){WAIT_BAR(2);} else if((tt)+2<NT){WAIT_BAR(1);} else {WAIT_BAR(0);} }while(0)
  for(;t+1<NT;t+=2){
    STEP(pB0,pB1,pA0,pA1,t,(t+3<NT),(t+1<NT),(t+1<NT));       ENDW(t);   RESC(); ROT();
    STEP(pA0,pA1,pB0,pB1,t+1,(t+4<NT),(t+2<NT),(t+2<NT));     ENDW(t+1); RESC(); ROT();
  }
  STEP(pB0,pB1,pA0,pA1,NT-1,false,false,false); RESC();
  { float sacc=pB0[0]+pB0[1]; _Pragma("unroll") for(int r=2;r<16;++r)sacc+=pB0[r]; _Pragma("unroll") for(int r=0;r<16;++r)sacc+=pB1[r]; l_reg+=sacc;
    pw0=(u32x4){PKW(pB0,0),PKW(pB0,2),PKW(pB0,4),PKW(pB0,6)};pw1=(u32x4){PKW(pB0,8),PKW(pB0,10),PKW(pB0,12),PKW(pB0,14)};pw2=(u32x4){PKW(pB1,0),PKW(pB1,2),PKW(pB1,4),PKW(pB1,6)};pw3=(u32x4){PKW(pB1,8),PKW(pB1,10),PKW(pB1,12),PKW(pB1,14)};
    SBAR(); pv(o,vb0+sl_cur,PAF(0),PAF(1),PAF(2),PAF(3)); }
  #undef PKW
  #undef PAF
  #undef VFR
  #undef PIN
  #undef MX3
  #undef GAPA
  #undef GAPB
  #undef EX
  #undef VRD
  #undef KRD
  #undef STEP
  #undef ENDW
  {auto rr=__builtin_amdgcn_permlane32_swap(__float_as_uint(l_reg),__float_as_uint(l_reg),false,false);l_reg=__uint_as_float(rr[0])+__uint_as_float(rr[1]);}
  if(hi==0)wsf[32+r32]=l_reg;asm volatile("s_waitcnt lgkmcnt(0)":::"memory");
  float rli[16];
  #pragma unroll
  for(int r=0;r<16;++r)rli[r]=__builtin_amdgcn_rcpf(wsf[32+crow(r,hi)]);
  bf16*Ow=(MODE==0)?O+(rowbase+q0+wid*QBLK)*OPI+h*D:O+(rowbase+q0)*OPI+wid*D;
  { bf16*stg=(bf16*)(shm+LDS_OST)+wid*2048;
    #pragma unroll
    for(int r=0;r<16;++r){const int orow=crow(r,hi);
      #pragma unroll
      for(int d0=0;d0<2;++d0)stg[orow*64+d0*32+r32]=__float2bfloat16(o[d0][r]*rli[r]);}
    asm volatile("s_waitcnt lgkmcnt(0)":::"memory");
    #pragma unroll
    for(int i=0;i<4;++i){const int row=i*8+(lane>>3),ch=lane&7; const u32x4 v=*(const u32x4*)(stg+row*64+ch*8); ATTN_STORE16(Ow+(long)row*OPI+ch*8,v);} }
  asm volatile("s_waitcnt lgkmcnt(0)\n\ts_barrier":::"memory");
  #undef DMA_K
  #undef DMA_V
  #undef CMASK
  #undef START
  #undef BIAS
  #undef SELM
  #undef RESC
  #undef ROT
}
#undef SBAR
#undef WAIT_BAR
}

#ifndef DBG_REP_SEL
#define DBG_REP_SEL 1
#endif
namespace mix {
__device__ __forceinline__ void fox_unit2(int b, int h, int qb, const bf16_t* Z1, const float* F, const float* bfp, bf16_t* Y, char* shm, const int wave_s) {
    const size_t rowb = (size_t)b * SEQ;
    const int nk = 256 * (qb + 1);
    auto cumfn = [=]() {
        const int tid = wave_s * 64 + lane_opaque(), lane = tid & 63; const int wid = __builtin_amdgcn_readfirstlane(tid >> 6);
        MLAS char* L = (MLAS char*)shm;
        MLAS float* cum2 = (MLAS float*)(L + foxa::CUM_OFF);
        MLAS float* wtot = (MLAS float*)(L + foxa::CUM_OFF + 8192);
        const float bias = bfp[h];
        const int s0 = 4 * tid;
        float v[4]; float run = 0.f;
#pragma unroll
        for (int i = 0; i < 4; ++i) {
            float x = 0.f;
            if (s0 + i < nk) x = F[(rowb + s0 + i) * 8 + h] + bias;
            const float ls = (s0 + i < nk) ? (fminf(x, 0.f) - log1pf(expf(-fabsf(x)))) : 0.f;
            run += ls; v[i] = run;
        }
        float inc = run;
#pragma unroll
        for (int o = 1; o < 64; o <<= 1) { const int ln = lane_opaque(); const float t = __builtin_bit_cast(float, __builtin_amdgcn_ds_bpermute((ln - o) << 2, __builtin_bit_cast(int, inc))); if (ln >= o) inc += t; }
        if (lane == 63) wtot[wid] = inc;
        LGKM_BAR();
        float off = inc - run;
        for (int w = 0; w < wid; ++w) off += wtot[w];
#pragma unroll
        for (int i = 0; i < 4; ++i) cum2[s0 + i] = (off + v[i]) * 1.4426950408889634f;
        LGKM_BAR();
    };
    foxa::attn_unit<8, 0, 2560>(cumfn, b, h, qb, 0, 0, (const foxa::bf16*)Z1, (const foxa::bf16*)(Z1 + 512), (const foxa::bf16*)(Z1 + 1024), (foxa::bf16*)Y, shm, nullptr, wave_s);
}
__device__ __forceinline__ void dsa_unit(int b, int qg, const bf16_t* Z0, bf16_t* Y, char* shm, unsigned lds0, const int wave_s) {
    for (int rep_ = 0; rep_ < DBG_REP_SEL; ++rep_) dsa_select(b, qg, Z0, shm, wave_s);
    const int nt64 = (qg >> 1) + 1; int ntu = (nt64 + 1) & ~1; if (ntu < 4) ntu = 4;
    foxa::attn_unit<8, 1, EV_N>([]() {}, b, 0, 0, 32 * qg, ntu, (const foxa::bf16*)(Z0 + 512), (const foxa::bf16*)(Z0 + 1024), (const foxa::bf16*)(Z0 + 1088), (foxa::bf16*)(Y + 512), shm,
                                (const MLAS unsigned*)((MLAS char*)shm + LX_SEL), wave_s);
}
}
constexpr int NWAVES = 8;
constexpr size_t KiB = 1024, MiB = 1u << 20;
constexpr size_t WS_CTL = 0, CTL_ZERO_BYTES = 1 * MiB;
constexpr size_t WS_W_EVIN = 1 * MiB, WS_W_OUT0 = 4 * MiB, WS_W_FFI0 = 6 * MiB, WS_W_FFO0 = 17 * MiB, WS_W_PG0 = 22 * MiB + 512 * KiB, WS_W_PP0 = 24 * MiB + 512 * KiB;
constexpr size_t WS_W_ODIN = 25 * MiB, WS_W_OUT1 = 30 * MiB + 512 * KiB, WS_W_FFI1 = 32 * MiB + 512 * KiB, WS_W_FFO1 = 43 * MiB + 512 * KiB, WS_W_PG1 = 49 * MiB, WS_W_PP1 = 51 * MiB, WS_W_SGU = 51 * MiB + 512 * KiB;
constexpr size_t WS_RSTD = 57 * MiB + 768 * KiB;
constexpr size_t WS_SSQA = 52 * MiB, WS_SSQB = 53 * MiB, WS_ROPE = 54 * MiB, WS_AH = 55 * MiB, WS_FBUF = 58 * MiB + 512 * KiB, WS_SST = 59 * MiB;
constexpr size_t WS_HB = 60 * MiB, WS_AHALO = 92 * MiB, WS_PP = 92 * MiB + 512 * KiB, WS_Y = 124 * MiB + 512 * KiB, WS_ZH = 156 * MiB + 512 * KiB, WS_PB = 244 * MiB + 512 * KiB, WS_END = 252 * MiB + 512 * KiB;
static_assert(WS_AHALO == WS_HB + (size_t)TOK * 1024 * 2, "the halo rows are row tile 64 of the FFN in-projection A operand");
static_assert(WS_W_EVIN + (size_t)EV_N * 1024 * 2 <= WS_W_OUT0 && WS_W_FFI0 + (size_t)NFF2 * 1024 * 2 <= WS_W_FFO0 && WS_W_FFO0 + (size_t)1024 * DFF * 2 <= WS_W_PG0, "ws map 1");
static_assert(WS_W_ODIN + (size_t)OD_N * 1024 * 2 <= WS_W_OUT1 && WS_W_FFI1 + (size_t)NFF2 * 1024 * 2 <= WS_W_FFO1 && WS_W_FFO1 + (size_t)1024 * DFF * 2 <= WS_W_PG1 && WS_W_SGU + 4 * 128 * 128 * 2 <= WS_SSQA, "ws map 2");
static_assert(WS_AH + (size_t)128 * NFF2 * 4 <= WS_RSTD && WS_ZH + (size_t)TOK * DFF * 2 <= WS_PB && WS_PB + (size_t)TOK * PLE * 2 <= WS_END, "ws map 3");
constexpr int CW_BAR = 4096, CW_FLAG = 8192;
constexpr int RING_BYTES = 131072, XB_OFF = RING_BYTES, LDSCTL_OFF = XB_OFF + 8192 + 1024 + 64, MISC_OFF = LDSCTL_OFF + 320, LDS_BYTES = 147456;
static_assert(MISC_OFF + 128 <= LDS_BYTES, "LDS map");

#define GAS __attribute__((address_space(1)))
#define LAS __attribute__((address_space(3)))
typedef unsigned short bf16;
typedef unsigned v4u __attribute__((ext_vector_type(4)));
typedef float f32x4 __attribute__((ext_vector_type(4)));
typedef float f32x2 __attribute__((ext_vector_type(2)));
#define LDS_WAIT() asm volatile("s_waitcnt lgkmcnt(0)" ::: "memory")
#define VM_WAIT() asm volatile("s_waitcnt vmcnt(0)" ::: "memory")
__device__ __forceinline__ unsigned f2bf(float f) { unsigned u = __builtin_bit_cast(unsigned, f); return (u + 0x7fffu + ((u >> 16) & 1u)) >> 16; }
__device__ __forceinline__ unsigned pk2(float lo, float hi) { return f2bf(lo) | (f2bf(hi) << 16); }

#define XB_TMO      128
#define XB_XCNT(j)  (256  + 64 * (j))
#define XB_XSUB(j)  (1280 + 64 * (j))
#define XB_XGEN(j)  (2304 + 64 * (j))
#define XB_TOP      3328
#define XB_TOPGEN   3392
#define XCD_BAR_WORDS 3456
#define XB_SPIN_CAP (1u << 18)
__device__ __forceinline__ unsigned xb_ld(unsigned* p)              { return __hip_atomic_load(p, __ATOMIC_RELAXED, __HIP_MEMORY_SCOPE_AGENT); }
__device__ __forceinline__ unsigned xb_add(unsigned* p, unsigned v) { return __hip_atomic_fetch_add(p, v, __ATOMIC_RELAXED, __HIP_MEMORY_SCOPE_AGENT); }
__device__ __forceinline__ unsigned xb_xcc_id() { return (unsigned)__builtin_amdgcn_s_getreg((3 << 11) | 20) & 0xFu; }
#define XB_SPIN(cond, bar) do { unsigned _sp = 0; while (cond) { __builtin_amdgcn_s_sleep(1); \
    if ((++_sp & 255u) == 0u) { if (xb_ld(&(bar)[XB_TMO])) break; if (_sp > XB_SPIN_CAP) { atomicAdd(&(bar)[XB_TMO], 1u); break; } } } } while (0)
struct XcdBarrier { unsigned* bar; unsigned x; volatile LAS unsigned* st; };
__device__ __forceinline__ XcdBarrier xcd_barrier_post(unsigned* bar, volatile LAS unsigned* st) {
    XcdBarrier b; b.bar = bar; b.x = xb_xcc_id(); b.st = st;
    if (threadIdx.x == 0) (void)xb_add(&bar[XB_XCNT(b.x)], 1u);
    return b;
}
__device__ __forceinline__ void xcd_barrier_complete(unsigned* bar, unsigned x, unsigned& nloc, unsigned& nx) {
    const unsigned G = gridDim.x * gridDim.y * gridDim.z;
    unsigned sum, cnt, mine, sp = 0u;
    for (;;) {
        sum = 0u; cnt = 0u; mine = 0u;
#pragma unroll 1
        for (unsigned j = 0; j < 16; ++j) { const unsigned c = xb_ld(&bar[XB_XCNT(j)]); sum += c; cnt += (c > 0u) ? 1u : 0u; mine = (j == x) ? c : mine; }
        if (sum == G) break;
        __builtin_amdgcn_s_sleep(1);
        if ((++sp & 255u) == 0u) { if (xb_ld(&bar[XB_TMO])) break; if (sp > XB_SPIN_CAP) { atomicAdd(&bar[XB_TMO], 1u); break; } }
    }
    nloc = mine > 0u ? mine : 1u; nx = cnt > 0u ? cnt : 1u;
}
__device__ __forceinline__ void xcd_barrier(const XcdBarrier& b) {
    asm volatile("s_waitcnt vmcnt(0)" ::: "memory");
    __syncthreads();
    if (threadIdx.x == 0) {
        unsigned* bar = b.bar;
        __builtin_amdgcn_s_waitcnt(0);
        unsigned nloc = b.st[0], nx = b.st[1];
        if (nloc == 0u) { xcd_barrier_complete(bar, b.x, nloc, nx); b.st[0] = nloc; b.st[1] = nx; }
        const unsigned old = xb_add(&bar[XB_XSUB(b.x)], 1u);
        const unsigned gen = old / nloc;
        if (old + 1u == (gen + 1u) * nloc) {
            __builtin_amdgcn_fence(__ATOMIC_RELEASE, "agent");
            asm volatile("s_waitcnt vmcnt(0)" ::: "memory");
            const unsigned og = xb_add(&bar[XB_TOP], 1u);
            const unsigned tg = og / nx;
            if (og + 1u == (tg + 1u) * nx) xb_add(&bar[XB_TOPGEN], 1u);
            else XB_SPIN(xb_ld(&bar[XB_TOPGEN]) == tg, bar);
            __builtin_amdgcn_fence(__ATOMIC_ACQUIRE, "agent");
            xb_add(&bar[XB_XGEN(b.x)], 1u);
            asm volatile("s_waitcnt vmcnt(0)" ::: "memory");
        } else {
            XB_SPIN(xb_ld(&bar[XB_XGEN(b.x)]) == gen, bar);
            __builtin_amdgcn_fence(__ATOMIC_ACQUIRE, "agent");
            asm volatile("s_waitcnt vmcnt(0)" ::: "memory");
        }
    }
    __syncthreads();
}

__device__ __forceinline__ float wave_sum(float v) {
#pragma unroll
    for (int o = 1; o < 64; o <<= 1) v += __builtin_bit_cast(float, __builtin_amdgcn_ds_bpermute((lane_opaque() ^ o) << 2, __builtin_bit_cast(int, v)));
    return v;
}
__device__ __forceinline__ int vcu_of(int i, int n) { return i; }
__device__ __forceinline__ int unperm16(int d) { return d < 16 ? ((d >> 1) + 8 * (d & 1)) : d; }
__device__ __forceinline__ int map_col(int type, int n, int nold) {
    if (type == 0) return n < nold ? n : -1;
    if (type == 1) {
        if (n < 512) return n;
        if (n < 1024) { const int h = (n - 512) >> 6, d = (n - 512) & 63; return 512 + 64 * h + unperm16(d); }
        if (n < 1088) return 1024 + unperm16(n - 1024);
        if (n < 1152) return n;
        if (n < 1216) return 1408 + unperm16(n - 1152);
        if (n < 1220) return 1472 + (n - 1216);
        if (n < 1280) return -1;
        { const int h = (n - 1280) >> 6, d = (n - 1280) & 63; return 1152 + 64 * h + unperm16(d); }
    }
    if (type == 2) {
        if (n < 1536) return n;
        if (n < 2560) return n + 8;
        if (n < 2568) return 1536 + (n - 2560);
        return -1;
    }
    { const int pn = n >> 8, bj = (n >> 7) & 1, jj = n & 127; return bj * DFF + 128 * pn + jj; }
}
struct TJob { const float* W; const float* rowscale; bf16* WT; int K, Nold, Nnew, ldk, koff, type, nitems; };
__device__ __forceinline__ void transpose_item(const TJob& J, LAS float* scr, int item, int lane) {
    const int nblk = J.Nnew / 32, kb = item / nblk, nb = item % nblk, k0 = 64 * kb, n0 = 32 * nb;
    const int oc = map_col(J.type, n0 + (lane & 31), J.Nold);
    const int occ = oc >= 0 ? oc : 0;
    float vv[32];
#pragma unroll
    for (int i = 0; i < 32; ++i) vv[i] = J.W[(size_t)(k0 + 2 * i + (lane >> 5)) * J.Nold + occ];
#pragma unroll
    for (int i = 0; i < 32; ++i) { const int kk = 2 * i + (lane >> 5);
        float v = (oc >= 0) ? vv[i] : 0.f;
        if (J.rowscale) v *= J.rowscale[k0 + kk];
        scr[kk * 33 + (lane & 31)] = v; }
    LDS_WAIT(); asm volatile("" ::: "memory");
    const int c = lane & 7;
#pragma unroll
    for (int j = 0; j < 4; ++j) { const int n = (lane >> 3) + 8 * j; const LAS float* s = scr + (8 * c) * 33 + n;
        v4u o; o.x = pk2(s[0 * 33], s[1 * 33]); o.y = pk2(s[2 * 33], s[3 * 33]); o.z = pk2(s[4 * 33], s[5 * 33]); o.w = pk2(s[6 * 33], s[7 * 33]);
        *(GAS v4u*)(J.WT + (size_t)(n0 + n) * J.ldk + J.koff + k0 + 8 * c) = o; }
    LDS_WAIT(); asm volatile("" ::: "memory");
}
__device__ __forceinline__ void sincos_d(double a, float& sn, float& cs) {
    const double q = rint(a * 0.63661977236758134308);
    double r = a - q * 1.57079632673412561417e+00; r -= q * 6.07710050650619224932e-11;
    const double r2 = r * r;
    double s = 1.0 / 6227020800.0; s = s * r2 - 1.0 / 39916800.0; s = s * r2 + 1.0 / 362880.0; s = s * r2 - 1.0 / 5040.0; s = s * r2 + 1.0 / 120.0; s = s * r2 - 1.0 / 6.0; s = s * r2 * r + r;
    double c = -1.0 / 87178291200.0; c = c * r2 + 1.0 / 479001600.0; c = c * r2 - 1.0 / 3628800.0; c = c * r2 + 1.0 / 40320.0; c = c * r2 - 1.0 / 720.0; c = c * r2 + 1.0 / 24.0; c = c * r2 - 0.5; c = c * r2 + 1.0;
    const int qi = ((int)q) & 3;
    const double ss = (qi == 0) ? s : (qi == 1) ? c : (qi == 2) ? -s : -c;
    const double cc = (qi == 0) ? c : (qi == 1) ? -s : (qi == 2) ? -c : s;
    sn = (float)ss; cs = (float)cc;
}

struct Args { const void* in[24]; float* out; unsigned char* ws; int ph_lo, ph_hi; };
typedef const Args __attribute__((address_space(4)))* argp_t;
__device__ __forceinline__ argp_t get_args() { argp_t p = (argp_t)__builtin_amdgcn_kernarg_segment_ptr(); asm volatile("" : "+s"(p)); return p; }
__device__ __forceinline__ int otid(int wave_s) { return wave_s * 64 + lane_opaque(); }
#define IN_F(k) ((const float*)A_->in[k])
#define PH_LOCALS \
    argp_t A_ = get_args(); unsigned char* const ws = A_->ws; float* const out = A_->out; (void)out; \
    const int tid = otid(wave_s), lane = tid & 63, wave = wave_s; (void)lane; (void)wave; \
    const int G = gridDim.x, bx = blockIdx.x, vcu = (G % 8 == 0) ? (bx % 8) * (G / 8) + bx / 8 : bx; (void)vcu; \
    const int gw = vcu * NWAVES + wave, NGW = G * NWAVES, gt = vcu * (NWAVES * 64) + tid, NGT = G * NWAVES * 64; (void)gw; (void)NGW; (void)gt; (void)NGT; \
    LAS unsigned char* const L = (LAS unsigned char*)lds; (void)L;
#define WSP(T, off) ((T*)(ws + (off)))

__global__ void __launch_bounds__(NWAVES * 64, 2) mega_fwd(Args args) {
    extern __shared__ __attribute__((aligned(16))) unsigned char lds[];
    int lo, hi; XcdBarrier bar;
    const int wave_s = __builtin_amdgcn_readfirstlane((int)threadIdx.x >> 6);
    {
        PH_LOCALS
        volatile LAS unsigned* MISC = (volatile LAS unsigned*)(L + MISC_OFF);
        for (int u = tid; u < (LDS_BYTES - XB_OFF) / 4; u += NWAVES * 64) ((LAS unsigned*)(L + XB_OFF))[u] = 0u;
        __syncthreads();
        bar = xcd_barrier_post((unsigned*)(ws + WS_CTL) + CW_BAR, MISC + 8);
        lo = A_->ph_lo; hi = A_->ph_hi;
    }
#ifndef DBG_REP_TR
#define DBG_REP_TR 1
#endif
#ifndef DBG_REP_HB
#define DBG_REP_HB 1
#endif
#ifndef DBG_REP_FOX
#define DBG_REP_FOX 1
#endif
#ifndef DBG_REP_DSA
#define DBG_REP_DSA 1
#endif
#ifndef DBG_REP_SGU
#define DBG_REP_SGU 1
#endif
#ifndef DBG_REP_POOL
#define DBG_REP_POOL 1
#endif
#ifndef PHMASK
#define PHMASK 0xffffffu
#endif
#define IN(k) (((PHMASK >> (k)) & 1u) && lo <= (k) && (k) < hi)
#define SEAM(k) do { if (IN(k) && IN((k) + 1)) xcd_barrier(bar); } while (0)
    if (IN(0)) {
        PH_LOCALS
        LAS float* scr = (LAS float*)(L + wave * 16384);
        const float* norm_mix = IN_F(3); const float* norm_ffn = IN_F(4); const float* norm_ple = IN_F(5);
        const float* ffn_w_in = IN_F(6); const float* ffn_w_out = IN_F(9); const float* ple_w_proj = IN_F(10); const float* ple_w_gate = IN_F(11);
        const float* ev_w_in = IN_F(13); const float* ev_w_out = IN_F(14); const float* od_w_in = IN_F(17); const float* od_w_out = IN_F(18);
#define TJ(Wp, RS, WTp, K_, NOLD, NNEW, LDK, KOFF, TYPE) { constexpr int NI_ = ((K_) / 64) * ((NNEW) / 32); if (r < NI_) { const TJob J{(Wp), (RS), (WTp), (K_), (NOLD), (NNEW), (LDK), (KOFF), (TYPE), NI_}; transpose_item(J, scr, r, lane); continue; } r -= NI_; }
        constexpr int NITEMS = 16 * 48 + 8 * 32 + 44 * 32 + 4 * 32;
        for (int rep_ = 0; rep_ < DBG_REP_TR; ++rep_) for (int it = gw; it < NITEMS; it += NGW) {
            int r = it;
            TJ(ev_w_in, norm_mix, WSP(bf16, WS_W_EVIN), 1024, 1476, EV_N, 1024, 0, 1)
            TJ(ev_w_out + (size_t)512 * 1024, nullptr, WSP(bf16, WS_W_OUT0), 512, 1024, 1024, 1024, 512, 0)
            TJ(ffn_w_out + (size_t)DFF * 1024, nullptr, WSP(bf16, WS_W_FFO1), DFF, 1024, 1024, DFF, 0, 0)
            TJ(ple_w_proj + (size_t)256 * 1024, nullptr, WSP(bf16, WS_W_PP1), 256, 1024, 1024, 256, 0, 0)
        }
#undef TJ
        { const float* sgu_w = IN_F(22); bf16* W_SGU = WSP(bf16, WS_W_SGU);
          for (int i = gt; i < 4 * 128 * 128; i += NGT) { const int jj = i & 127, ii = (i >> 7) & 127; W_SGU[i] = (bf16)((ii < 64 && jj >= 64) ? 0u : f2bf(sgu_w[i])); } }
        { const float* x = IN_F(0); bf16* HB = WSP(bf16, WS_HB); float* SSQA = WSP(float, WS_SSQA);
          for (int m = gw; m < TOK; m += 4 * NGW) {
            f32x4 v[4][4];
#pragma unroll
            for (int q = 0; q < 4; ++q) { const int mm = (m + q * NGW < TOK) ? m + q * NGW : m; const f32x4* xr = (const f32x4*)(x + (size_t)mm * DMODEL) + lane;
#pragma unroll
                for (int j = 0; j < 4; ++j) v[q][j] = xr[64 * j]; }
#pragma unroll
            for (int q = 0; q < 4; ++q) { const int mm = m + q * NGW; if (mm < TOK) {
                float s = 0.f; unsigned long long* o8 = (unsigned long long*)(HB + (size_t)mm * DMODEL) + lane;
#pragma unroll
                for (int j = 0; j < 4; ++j) { const f32x4 w = v[q][j]; s += (w.x * w.x + w.y * w.y) + (w.z * w.z + w.w * w.w);
                    o8[64 * j] = (unsigned long long)pk2(w.x, w.y) | ((unsigned long long)pk2(w.z, w.w) << 32); }
                s = wave_sum(s);
                if (lane < 16) SSQA[(size_t)mm * 16 + lane] = (lane == 0) ? s : 0.f; } }
          } }
        { const float* p_in = IN_F(1); bf16* PB = WSP(bf16, WS_PB);
          for (int i = gt; i < TOK * PLE / 4; i += 4 * NGT) { f32x4 v[4];
#pragma unroll
            for (int q = 0; q < 4; ++q) v[q] = ((const f32x4*)p_in)[(i + q * NGT < TOK * PLE / 4) ? i + q * NGT : i];
#pragma unroll
            for (int q = 0; q < 4; ++q) if (i + q * NGT < TOK * PLE / 4) ((unsigned long long*)PB)[i + q * NGT] = (unsigned long long)pk2(v[q].x, v[q].y) | ((unsigned long long)pk2(v[q].z, v[q].w) << 32); } }
        { const int* positions = (const int*)A_->in[2]; f32x2* ROPE = WSP(f32x2, WS_ROPE);
          for (int i = gt; i < TOK * 8; i += NGT) {
            const int row = i >> 3, j = i & 7;
            const float invf = (j == 0) ? 1.0f : (j == 1) ? 0.1939227432012558f : (j == 2) ? 0.03760603070259094f : (j == 3) ? 0.007292664609849453f : (j == 4) ? 0.0014142135623842478f :
                               (j == 5) ? 0.00027424818836152554f : (j == 6) ? 5.3182957344688475e-05f : 1.0313385246263351e-05f;
            const float ang = (float)positions[row] * invf;
            float sn, cs; sincos_d((double)ang, sn, cs);
            ROPE[i] = (f32x2){cs, sn};
          } }
    }
    SEAM(0);
    if (IN(1)) {
        { PH_LOCALS
          pg8::Gemm g{WSP(bf16, WS_HB), WSP(bf16, WS_W_EVIN), TOK, EV_N, 1024}; pg8::StaticOrder S; S.init(TOK, EV_N, G, bx);
          pg8::EpiEvenIn E{WSP(float, WS_SSQA), WSP(bf16, WS_ZH), WSP(const pg8::f32x2, WS_ROPE)};
          pg8::gemm_phase<pg8::EpiEvenIn, pg8::StaticOrder, true, true>(L, g, S, E, wave_s); }
        if (gridDim.x == 256 && blockIdx.x >= 128) {
            PH_LOCALS
            LAS float* scr = (LAS float*)(L + wave * 16384);
            const float* norm_mix = IN_F(3); const float* norm_ffn = IN_F(4); const float* norm_ple = IN_F(5);
            const float* ffn_w_in = IN_F(6); const float* ffn_w_out = IN_F(9); const float* ple_w_proj = IN_F(10); const float* ple_w_gate = IN_F(11);
            const float* od_w_in = IN_F(17); const float* od_w_out = IN_F(18);
#define TJ(Wp, RS, WTp, K_, NOLD, NNEW, LDK, KOFF, TYPE) { constexpr int NI_ = ((K_) / 64) * ((NNEW) / 32); if (r < NI_) { const TJob J{(Wp), (RS), (WTp), (K_), (NOLD), (NNEW), (LDK), (KOFF), (TYPE), NI_}; transpose_item(J, scr, r, lane); continue; } r -= NI_; }
            constexpr int NITEMS_B = (16 * 176 + 44 * 32 + 16 * 32 + 4 * 32) + 16 * 88 + 16 * 32;
            const int gwb = (vcu_of(bx - 128, 128)) * NWAVES + wave, NGWB = 128 * NWAVES;
            for (int it = gwb; it < NITEMS_B; it += NGWB) {
                int r = it;
                TJ(ffn_w_in, norm_ffn, WSP(bf16, WS_W_FFI0), 1024, NFF2, NFF2, 1024, 0, 3)
                TJ(ffn_w_out, nullptr, WSP(bf16, WS_W_FFO0), DFF, 1024, 1024, DFF, 0, 0)
                TJ(ple_w_gate, norm_ple, WSP(bf16, WS_W_PG0), 1024, 1024, 1024, 1024, 0, 0)
                TJ(ple_w_proj, nullptr, WSP(bf16, WS_W_PP0), 256, 1024, 1024, 256, 0, 0)
                TJ(od_w_in, norm_mix + 1024, WSP(bf16, WS_W_ODIN), 1024, 2568, OD_N, 1024, 0, 2)
                TJ(od_w_out, nullptr, WSP(bf16, WS_W_OUT1), 1024, 1024, 1024, 1024, 0, 0)
            }
#undef TJ
        {
            const float* pool_w = IN_F(15); const float* pool_scale = IN_F(16); const float* ev_w_out = IN_F(14); bf16* W_OUT0 = WSP(bf16, WS_W_OUT0);
            for (int it = gwb; it < 1024; it += NGWB) {
                const int g = it >> 8, nb = (it >> 4) & 15, cb = it & 15, n = 64 * nb + lane;
                float acc[8];
#pragma unroll
                for (int cc = 0; cc < 8; ++cc) acc[cc] = 0.f;
#pragma unroll 1
                for (int d0 = 0; d0 < 128; d0 += 16) {
                    float wv[16];
#pragma unroll
                    for (int e = 0; e < 16; ++e) wv[e] = ev_w_out[(size_t)(128 * g + d0 + e) * 1024 + n] * pool_scale[128 * g + d0 + e];
#pragma unroll
                    for (int cc = 0; cc < 8; ++cc) {
                        const float* pw = pool_w + ((size_t)g * 128 + 8 * cb + cc) * 128 + d0;
#pragma unroll
                        for (int e = 0; e < 16; ++e) acc[cc] += pw[e] * wv[e];
                    }
                }
#pragma unroll
                for (int c2 = 0; c2 < 4; ++c2) *(unsigned*)(W_OUT0 + (size_t)n * 1024 + 128 * g + 8 * cb + 2 * c2) = pk2(acc[2 * c2], acc[2 * c2 + 1]);
            }
        }
        }
    }
    SEAM(1);
    if (IN(2)) {
        { PH_LOCALS
          const bf16* ZH = WSP(bf16, WS_ZH); bf16* Y = WSP(bf16, WS_Y); const unsigned lds0 = (unsigned)(uintptr_t)lds;
          for (int pi = vcu; pi < 256; pi += G) {
            const int b = pi >> 5, s = pi & 31;
#pragma unroll 1
            for (int k = 0; k < 2 * DBG_REP_DSA; ++k) mix::dsa_unit(b, (k & 1) ? s : 63 - s, ZH, Y, (char*)lds, lds0, wave_s);
          } }
        { PH_LOCALS
          const bf16* ZH = WSP(bf16, WS_ZH); bf16* Y = WSP(bf16, WS_Y);
          for (int rep_ = 0; rep_ < DBG_REP_POOL; ++rep_) for (int it = gt; it < TOK * 64; it += NGT) mix::pool_item(it, ZH, Y);
        }
    }
    SEAM(2);
    {
        const size_t s1o = (0 == 0) ? WS_SSQA : WS_SSQB, s2o = (0 == 0) ? WS_SSQB : WS_SSQA, s3o = s1o;
        if (IN(3)) {
            PH_LOCALS
            pg8::Gemm g{WSP(bf16, WS_Y), WSP(bf16, (0 == 0) ? WS_W_OUT0 : WS_W_OUT1), TOK, 1024, 1024}; pg8::StaticOrder S; S.init(TOK, 1024, G, bx);
            pg8::EpiRes E{IN_F(0), nullptr, WSP(bf16, WS_HB), WSP(float, s1o), WSP(bf16, WS_AHALO)};
            pg8::gemm_phase<pg8::EpiRes, pg8::StaticOrder, true, true>(L, g, S, E, wave_s);
        }
        SEAM(3);
        if (IN(3 + 2)) {
            PH_LOCALS
            pg8::Gemm g{WSP(bf16, WS_HB), WSP(bf16, WS_W_FFI0), TOK + 256, NFF2, 1024}; pg8::StaticOrder S; S.init(TOK, NFF2, G, bx);
            if (G == 256 && bx >= 128 && bx < 128 + NFF2 / 256) {
                pg8::OneUnit S1{64, bx - 128, 1};
                pg8::EpiHaloF EH{WSP(float, s1o), WSP(float, WS_AH), (unsigned*)(ws + WS_CTL) + CW_FLAG + 2048 * 0};
                pg8::gemm_phase<pg8::EpiHaloF, pg8::OneUnit, true, true>(L, g, S1, EH, wave_s);
            }
            pg8::EpiFfnIn E{WSP(float, s1o), IN_F(7) + (size_t)0 * 3 * NFF2, IN_F(8) + (size_t)0 * NFF2, WSP(float, WS_AH), WSP(bf16, WS_ZH), (LAS float*)(L + XB_OFF), (unsigned*)(ws + WS_CTL) + CW_FLAG + 2048 * 0, 1u};
            pg8::gemm_phase<pg8::EpiFfnIn, pg8::StaticOrder, true, true>(L, g, S, E, wave_s);
            if (G == 256 && bx >= 150) {
                pg8::Gemm gp{WSP(bf16, WS_PB), WSP(bf16, WS_W_PP0), TOK, 1024, PLE}; pg8::StaticOrder SP; SP.init(TOK, 1024, 106, bx - 150);
                pg8::EpiBf16Plain EP{WSP(bf16, WS_PP), 1024};
                pg8::gemm_phase<pg8::EpiBf16Plain, pg8::StaticOrder, true, true>(L, gp, SP, EP, wave_s);
            }
        }
        SEAM(3 + 2);
        if (IN(3 + 3)) {
            PH_LOCALS
            pg8::Gemm g{WSP(bf16, WS_ZH), WSP(bf16, (0 == 0) ? WS_W_FFO0 : WS_W_FFO1), TOK, 1024, DFF}; pg8::StaticOrder S; S.init(TOK, 1024, G, bx);
            pg8::EpiRes E{nullptr, WSP(bf16, WS_HB), WSP(bf16, WS_HB), WSP(float, s2o), nullptr};
            pg8::gemm_phase<pg8::EpiRes, pg8::StaticOrder, true, true>(L, g, S, E, wave_s);
        }
        SEAM(3 + 3);
        if (IN(3 + 4)) {
            PH_LOCALS
            pg8::Gemm g{WSP(bf16, WS_HB), WSP(bf16, (0 == 0) ? WS_W_PG0 : WS_W_PG1), TOK, 1024, 1024}; pg8::StaticOrder S; S.init(TOK, 1024, G, bx);
            pg8::EpiGate E{WSP(float, s2o), WSP(bf16, WS_HB), WSP(bf16, WS_PP), (bf16*)out, WSP(float, s3o)};
            pg8::gemm_phase<pg8::EpiGate, pg8::StaticOrder, true, true>(L, g, S, E, wave_s);
        }
        SEAM(3 + 4);
    }
    {

            if (IN(8)) {
                { PH_LOCALS
                  pg8::Gemm g{(const bf16*)out, WSP(bf16, WS_W_ODIN), TOK, OD_N, 1024}; pg8::StaticOrder S; S.init(TOK, OD_N, G, bx);
                  pg8::EpiOddIn E{WSP(float, WS_SSQA), WSP(bf16, WS_ZH), WSP(float, WS_FBUF), WSP(float, WS_SST)};
                  pg8::gemm_phase<pg8::EpiOddIn, pg8::StaticOrder, true, true>(L, g, S, E, wave_s); }
                if (gridDim.x == 256 && blockIdx.x >= 192) {
                    PH_LOCALS
                    LAS float* scr = (LAS float*)(L + wave * 16384);
                    const float* norm_ffn = IN_F(4); const float* norm_ple = IN_F(5); const float* ffn_w_in = IN_F(6); const float* ple_w_gate = IN_F(11);
#define TJ(Wp, RS, WTp, K_, NOLD, NNEW, LDK, KOFF, TYPE) { constexpr int NI_ = ((K_) / 64) * ((NNEW) / 32); if (r < NI_) { const TJob J{(Wp), (RS), (WTp), (K_), (NOLD), (NNEW), (LDK), (KOFF), (TYPE), NI_}; transpose_item(J, scr, r, lane); continue; } r -= NI_; }
                    constexpr int NITEMS_C = 16 * 176 + 16 * 32;
                    const int gwc = (bx - 192) * NWAVES + wave, NGWC = 64 * NWAVES;
                    for (int it = gwc; it < NITEMS_C; it += NGWC) {
                        int r = it;
                        TJ(ffn_w_in + (size_t)1024 * NFF2, norm_ffn + 1024, WSP(bf16, WS_W_FFI1), 1024, NFF2, NFF2, 1024, 0, 3)
                        TJ(ple_w_gate + (size_t)1024 * 1024, norm_ple + 1024, WSP(bf16, WS_W_PG1), 1024, 1024, 1024, 1024, 0, 0)
                    }
#undef TJ
                    const float* p1 = IN_F(1) + (size_t)TOK * PLE; bf16* PB = WSP(bf16, WS_PB);
                    const int gtc = (bx - 192) * (NWAVES * 64) + tid, NGTC = 64 * NWAVES * 64;
                    for (int i = gtc; i < TOK * PLE / 4; i += 4 * NGTC) { f32x4 v[4];
#pragma unroll
                        for (int q = 0; q < 4; ++q) v[q] = ((const f32x4*)p1)[(i + q * NGTC < TOK * PLE / 4) ? i + q * NGTC : i];
#pragma unroll
                        for (int q = 0; q < 4; ++q) if (i + q * NGTC < TOK * PLE / 4) ((unsigned long long*)PB)[i + q * NGTC] = (unsigned long long)pk2(v[q].x, v[q].y) | ((unsigned long long)pk2(v[q].z, v[q].w) << 32); }
                }
            }
            SEAM(8);
            if (IN(9)) {
                { PH_LOCALS
                  const bf16* ZH = WSP(bf16, WS_ZH); bf16* Y = WSP(bf16, WS_Y); const unsigned lds0 = (unsigned)(uintptr_t)lds;
                  const float* FBUF = WSP(float, WS_FBUF); const float* fox_b_f = IN_F(19);
                  for (int pi = vcu; pi < 256; pi += G) {
                    const int bh = pi >> 2, s = pi & 3;
#pragma unroll 1
                    for (int k = 0; k < 2 * DBG_REP_FOX; ++k) mix::fox_unit2(bh >> 3, bh & 7, (k & 1) ? s : 7 - s, ZH, FBUF, fox_b_f, Y, (char*)lds, wave_s);
                  } }
                { PH_LOCALS
                  const bf16* ZH = WSP(bf16, WS_ZH); bf16* Y = WSP(bf16, WS_Y);
                  for (int rep_ = 0; rep_ < DBG_REP_SGU; ++rep_) for (int u = vcu; u < 512; u += G) mix::sgu_unit(u >> 6, (u >> 2) & 15, u & 3, ZH, WSP(float, WS_SST), IN_F(20), IN_F(21), WSP(bf16, WS_W_SGU), IN_F(23), Y, (char*)lds, wave_s); }
            }
            SEAM(9);
            }
    {
        const size_t s1o = (1 == 0) ? WS_SSQA : WS_SSQB, s2o = (1 == 0) ? WS_SSQB : WS_SSQA, s3o = s1o;
        if (IN(10)) {
            PH_LOCALS
            pg8::Gemm g{WSP(bf16, WS_Y), WSP(bf16, (1 == 0) ? WS_W_OUT0 : WS_W_OUT1), TOK, 1024, 1024}; pg8::StaticOrder S; S.init(TOK, 1024, G, bx);
            pg8::EpiRes E{nullptr, (const bf16*)out, WSP(bf16, WS_HB), WSP(float, s1o), WSP(bf16, WS_AHALO)};
            pg8::gemm_phase<pg8::EpiRes, pg8::StaticOrder, true, true>(L, g, S, E, wave_s);
        }
        SEAM(10);
        if (IN(10 + 2)) {
            PH_LOCALS
            pg8::Gemm g{WSP(bf16, WS_HB), WSP(bf16, WS_W_FFI1), TOK + 256, NFF2, 1024}; pg8::StaticOrder S; S.init(TOK, NFF2, G, bx);
            if (G == 256 && bx >= 128 && bx < 128 + NFF2 / 256) {
                pg8::OneUnit S1{64, bx - 128, 1};
                pg8::EpiHaloF EH{WSP(float, s1o), WSP(float, WS_AH), (unsigned*)(ws + WS_CTL) + CW_FLAG + 2048 * 1};
                pg8::gemm_phase<pg8::EpiHaloF, pg8::OneUnit, true, true>(L, g, S1, EH, wave_s);
            }
            pg8::EpiFfnIn E{WSP(float, s1o), IN_F(7) + (size_t)1 * 3 * NFF2, IN_F(8) + (size_t)1 * NFF2, WSP(float, WS_AH), WSP(bf16, WS_ZH), (LAS float*)(L + XB_OFF), (unsigned*)(ws + WS_CTL) + CW_FLAG + 2048 * 1, 2u};
            pg8::gemm_phase<pg8::EpiFfnIn, pg8::StaticOrder, true, true>(L, g, S, E, wave_s);
            if (G == 256 && bx >= 150) {
                pg8::Gemm gp{WSP(bf16, WS_PB), WSP(bf16, WS_W_PP1), TOK, 1024, PLE}; pg8::StaticOrder SP; SP.init(TOK, 1024, 106, bx - 150);
                pg8::EpiBf16Plain EP{WSP(bf16, WS_PP), 1024};
                pg8::gemm_phase<pg8::EpiBf16Plain, pg8::StaticOrder, true, true>(L, gp, SP, EP, wave_s);
            }
        }
        SEAM(10 + 2);
        if (IN(10 + 3)) {
            PH_LOCALS
            pg8::Gemm g{WSP(bf16, WS_ZH), WSP(bf16, (1 == 0) ? WS_W_FFO0 : WS_W_FFO1), TOK, 1024, DFF}; pg8::StaticOrder S; S.init(TOK, 1024, G, bx);
            pg8::EpiRes E{nullptr, WSP(bf16, WS_HB), WSP(bf16, WS_HB), WSP(float, s2o), nullptr};
            pg8::gemm_phase<pg8::EpiRes, pg8::StaticOrder, true, true>(L, g, S, E, wave_s);
        }
        SEAM(10 + 3);
        if (IN(10 + 4)) {
            PH_LOCALS
            pg8::Gemm g{WSP(bf16, WS_HB), WSP(bf16, (1 == 0) ? WS_W_PG0 : WS_W_PG1), TOK, 1024, 1024}; pg8::StaticOrder S; S.init(TOK, 1024, G, bx);
            pg8::EpiGate E{WSP(float, s2o), WSP(bf16, WS_HB), WSP(bf16, WS_PP), WSP(bf16, WS_Y), WSP(float, s3o)};
            pg8::gemm_phase<pg8::EpiGate, pg8::StaticOrder, true, true>(L, g, S, E, wave_s);
        }
        SEAM(10 + 4);
    }
    if (IN(15)) {
        PH_LOCALS
        const float* SSQB = WSP(float, WS_SSQB); const float* norm_final = IN_F(12); const bf16* H6 = WSP(bf16, WS_Y);
        for (int m = gw; m < TOK; m += 4 * NGW) {
            unsigned long long w[4][4]; float rs[4];
#pragma unroll
            for (int q = 0; q < 4; ++q) { const int mm = (m + q * NGW < TOK) ? m + q * NGW : m; rs[q] = pg8::row_rstd(SSQB, mm);
                const unsigned long long* hr = (const unsigned long long*)(H6 + (size_t)mm * DMODEL) + lane;
#pragma unroll
                for (int j = 0; j < 4; ++j) w[q][j] = hr[64 * j]; }
            const f32x4* gr = (const f32x4*)norm_final + lane;
            f32x4 gg[4];
#pragma unroll
            for (int j = 0; j < 4; ++j) gg[j] = gr[64 * j];
#pragma unroll
            for (int q = 0; q < 4; ++q) { const int mm = m + q * NGW; if (mm < TOK) { f32x4* xr = (f32x4*)(out + (size_t)mm * DMODEL) + lane;
#pragma unroll
                for (int j = 0; j < 4; ++j) { const unsigned long long ww = w[q][j];
                    const f32x4 v = {pg8::bf_lo((unsigned)ww), pg8::bf_hi((unsigned)ww), pg8::bf_lo((unsigned)(ww >> 32)), pg8::bf_hi((unsigned)(ww >> 32))};
                    __builtin_nontemporal_store(v * rs[q] * gg[j], xr + 64 * j); } } }
        }
    }
#undef IN
#undef SEAM
}

#ifndef MK_N_LAUNCHES
#define MK_N_LAUNCHES 1
#endif
constexpr int N_PHASES = 16;
extern "C" void kernel_launch(void* const* d_in, const int* in_sizes, int n_in, void* d_out, int out_size, void* d_ws, size_t ws_size, hipStream_t stream) {
    static int grid = 0;
    if (grid == 0) {
        if (n_in != 24 || out_size != TOK * DMODEL || ws_size < WS_END) { fprintf(stderr, "kernel_launch: unexpected shapes (n_in %d, out %d, ws %zu)\n", n_in, out_size, ws_size); grid = -1; return; }
        int dev = 0, cus = 0;
        if (hipGetDevice(&dev) != hipSuccess || hipDeviceGetAttribute(&cus, hipDeviceAttributeMultiprocessorCount, dev) != hipSuccess) { grid = -1; return; }
        if (hipFuncSetAttribute((const void*)mega_fwd, hipFuncAttributeMaxDynamicSharedMemorySize, LDS_BYTES) != hipSuccess) { fprintf(stderr, "kernel_launch: hipFuncSetAttribute failed\n"); grid = -1; return; }
        int per_cu = 0;
        if (hipOccupancyMaxActiveBlocksPerMultiprocessor(&per_cu, (const void*)mega_fwd, NWAVES * 64, LDS_BYTES) != hipSuccess || per_cu < 1) { fprintf(stderr, "kernel_launch: occupancy query says %d\n", per_cu); }
        (void)hipGetLastError();
        grid = cus;
    }
    if (grid < 0) return;
    (void)hipMemsetAsync((char*)d_ws + WS_CTL, 0, CTL_ZERO_BYTES, stream);
    Args a{};
    for (int i = 0; i < 24; ++i) a.in[i] = d_in[i];
    a.out = (float*)d_out; a.ws = (unsigned char*)d_ws;
#ifdef DBG_CHECK
    {
        using namespace dbg;
        auto LP = [&](int ph) { a.ph_lo = ph; a.ph_hi = ph + 1; hipLaunchKernelGGL(mega_fwd, dim3(grid), dim3(NWAVES * 64), LDS_BYTES, stream, a); };
        char* wsb = (char*)d_ws; float* ERR = (float*)(wsb + 512 * 1024); float* SNAP = (float*)(wsb + 600 * 1024); float* outp = (float*)d_out;
        const unsigned short* ZHp = (const unsigned short*)(wsb + WS_ZH); const unsigned short* Yp = (const unsigned short*)(wsb + WS_Y); const float* FB = (const float*)(wsb + WS_FBUF);
        const unsigned short* HBp = (const unsigned short*)(wsb + WS_HB); const unsigned short* H3p = (const unsigned short*)d_out;
        auto F = [&](int i) { return (const float*)d_in[i]; };
        const float* x = F(0);
        LP(0); LP(1);
        k_evenin<<<NS, 256, 0, stream>>>(x, F(3), F(13), (const int*)d_in[2], ZHp, ERR, 0);
        LP(2);
        k_pool<<<NS, 256, 0, stream>>>(ZHp, Yp, ERR, 1);
        k_dsa<<<NS, 256, 0, stream>>>(ZHp, Yp, ERR, 2);
        LP(3);
        k_outproj<<<NS, 256, 0, stream>>>(x, 0, SNAP, Yp, F(14), F(15), F(16), HBp, ERR, 3);
        for (int layer = 0; layer < 2; ++layer) {
            const int pb = layer ? 10 : 3, kb = layer ? 10 : 3;
            if (layer == 1) {
                LP(8);
                k_oddin<<<NS, 256, 0, stream>>>(H3p, F(3) + 1024, F(17), ZHp, FB, ERR, 7);
                LP(9);
                k_fox<<<NS, 256, 0, stream>>>(ZHp, FB, F(19), Yp, ERR, 8);
                k_sgu<<<NS, 256, 0, stream>>>(ZHp, F(20), F(21), F(22), F(23), Yp, ERR, 9);
                k_snap<<<NS, 256, 0, stream>>>(H3p, SNAP);
                LP(10);
                k_outproj<<<NS, 256, 0, stream>>>(nullptr, 1, SNAP, Yp, F(18), nullptr, nullptr, HBp, ERR, 10);
            }
            LP(pb + 1); LP(pb + 2);
            k_ffnin<<<NS, 256, 0, stream>>>(HBp, F(4) + 1024 * layer, F(6) + (size_t)layer * 1024 * NFF2, F(7) + (size_t)layer * 3 * NFF2, F(8) + (size_t)layer * NFF2, ZHp, ERR, kb + 1);
            k_snap<<<NS, 256, 0, stream>>>(HBp, SNAP);
            LP(pb + 3);
            k_ffnout<<<NS, 256, 0, stream>>>(SNAP, ZHp, F(9) + (size_t)layer * DFF * 1024, HBp, ERR, kb + 2);
            k_snap<<<NS, 256, 0, stream>>>(HBp, SNAP);
            LP(pb + 4);
            k_ple<<<NS, 256, 0, stream>>>(SNAP, F(1) + (size_t)layer * TOK * PLE, F(5) + 1024 * layer, F(10) + (size_t)layer * PLE * 1024, F(11) + (size_t)layer * 1024 * 1024, layer ? Yp : H3p, ERR, kb + 3);
        }
        k_snap<<<NS, 256, 0, stream>>>(Yp, SNAP);
        LP(15);
        k_final<<<NS, 256, 0, stream>>>(SNAP, F(12), outp, ERR, 14);
        t_dpp<<<1, 64, 0, stream>>>(ERR + 40);
        k_report<<<1024, 256, 0, stream>>>(ERR, 15, DBG_TOL, outp);
        return;
    }
#endif
    if (MK_N_LAUNCHES == 1) {
        a.ph_lo = 0; a.ph_hi = N_PHASES;
        hipLaunchKernelGGL(mega_fwd, dim3(grid), dim3(NWAVES * 64), LDS_BYTES, stream, a);
    } else {
#ifndef DBG_STOP
#define DBG_STOP N_PHASES
#endif
#ifndef DBG_DOUBLE
#define DBG_DOUBLE -1
#endif
        for (int ph = 0; ph < DBG_STOP; ++ph) { a.ph_lo = ph; a.ph_hi = ph + 1; const int reps = (ph == DBG_DOUBLE || (DBG_DOUBLE == 100 && (ph == 0 || ph == 1 || ph == 2 || ph == 4 || ph == 5 || ph == 8 || ph == 9 || ph == 11 || ph == 12))) ? 2 : 1;
            for (int r = 0; r < reps; ++r) hipLaunchKernelGGL(mega_fwd, dim3(grid), dim3(NWAVES * 64), LDS_BYTES, stream, a); }
    }
}
```

```cpp
#include <hip/hip_runtime.h>
#include <hip/hip_bf16.h>
#include <cstdio>
#include <cstdint>
#include <cmath>
constexpr int TOK = 16384, DMODEL = 1024, SEQ = 2048, NBATCH = 8;
constexpr int DFF = 2816, NFF2 = 5632, PLE = 256;
constexpr int EV_N = 1536;
constexpr int OD_N = 2816;
constexpr int Z1P = 2560;
constexpr float RMS_EPS = 1e-6f;
constexpr float C2 = 0.125f * 1.4426950408889634f;


__device__ __forceinline__ int lane_opaque() { unsigned z = 0u; asm volatile("" : "+v"(z)); return (int)__builtin_amdgcn_mbcnt_hi(~0u, __builtin_amdgcn_mbcnt_lo(~0u, z)); }
__device__ __forceinline__ float xor16_f(float v) { return __builtin_bit_cast(float, __builtin_amdgcn_ds_swizzle(__builtin_bit_cast(int, v), 0x401F)); }
__device__ __forceinline__ void halves_pair(unsigned v, unsigned& a, unsigned& b) { unsigned w = v; asm volatile("" : "+v"(w)); auto rr = __builtin_amdgcn_permlane32_swap(v, w, false, false); a = rr[0]; b = rr[1]; }
__device__ __forceinline__ float halves_sum_f(float v) { unsigned a, b; halves_pair(__builtin_bit_cast(unsigned, v), a, b); return __builtin_bit_cast(float, a) + __builtin_bit_cast(float, b); }
__device__ __forceinline__ float halves_max_f(float v) { unsigned a, b; halves_pair(__builtin_bit_cast(unsigned, v), a, b); return __builtin_fmaxf(__builtin_bit_cast(float, a), __builtin_bit_cast(float, b)); }
__device__ __forceinline__ unsigned halves_add_u(unsigned v) { unsigned a, b; halves_pair(v, a, b); return a + b; }
__device__ __forceinline__ unsigned halves_or_u(unsigned v) { unsigned a, b; halves_pair(v, a, b); return a | b; }
namespace pg8 {
#define PG8_LAS __attribute__((address_space(3)))
typedef unsigned short bf16_t;
typedef short bf16x8 __attribute__((ext_vector_type(8)));
typedef float f32x4 __attribute__((ext_vector_type(4)));
typedef unsigned u32x4 __attribute__((ext_vector_type(4)));
constexpr int BM = 256, BK = 64, HALF = 128, HTB = HALF * BK * 2  , STAGE_BYTES = 8 * HTB, NXCD = 8, WGM = 8;

__host__ __device__ __forceinline__ int lds_byte(int r, int c) { const int st = (r >> 4) * 2 + (c >> 5), rr = r & 15, cc = c & 31, ob = rr * 64 + cc * 2; return st * 1024 + (ob ^ (((ob >> 9) & 1) << 5)); }
__host__ __device__ __forceinline__ void stage_rc(int b, int& R, int& C) { const int st = b / 1024, sb = b % 1024, swz = sb ^ (((sb >> 9) & 1) << 5); R = (st >> 1) * 16 + swz / 64; C = (st & 1) * 32 + (swz % 64) / 2; }
__host__ __device__ __forceinline__ int perm32(int rho) { const int n = rho >> 4, i = rho & 15; return 8 * (i >> 2) + 4 * n + (i & 3); }

struct Unit { int pm, pn; };
struct Gemm { const bf16_t* A; const bf16_t* Bt; int M, N, K; };

struct StaticOrder {
    int nM, nN, nwg, G, c;
    __host__ __device__ void init(int M, int N, int G_, int c_) { nM = M / BM; nN = N / BM; nwg = nM * nN; G = G_; c = c_; }
    __host__ __device__ bool next(int i, Unit& u) const {
        const long L = (long)i * G + c; if (L >= nwg) return false;
        int wgid = (int)L; { const int q = nwg / NXCD, r = nwg % NXCD, xcd = wgid % NXCD, off = wgid / NXCD; wgid = (xcd < r ? xcd * (q + 1) : r * (q + 1) + (xcd - r) * q) + off; }
        const int nig = WGM * nN, gid = wgid / nig, fm = gid * WGM, gsz = (nM - fm) < WGM ? (nM - fm) : WGM;
        u.pm = fm + ((wgid % nig) % gsz); u.pn = (wgid % nig) / gsz; return true;
    }
    __device__ __forceinline__ void a_ready(const Unit&) const {}
    __device__ __forceinline__ void done(const Unit&) const {}
};

struct OneUnit {
    int pm, pn, on;
    __host__ __device__ bool next(int i, Unit& u) const { if (!on || i != 0) return false; u.pm = pm; u.pn = pn; return true; }
    __device__ __forceinline__ void a_ready(const Unit&) const {}
    __device__ __forceinline__ void done(const Unit&) const {}
};
struct FfnOrder {
    StaticOrder S0; int extra;
    __host__ __device__ void init(int M, int N, int G_, int c_) { S0.init(M, N, G_, c_); extra = (G_ == 256 && c_ >= 128 && c_ < 128 + N / BM) ? 1 : 0; }
    __host__ __device__ bool next(int i, Unit& u) const { if (extra) { if (i == 0) { u.pm = 64; u.pn = S0.c - 128; return true; } return S0.next(i - 1, u); } return S0.next(i, u); }
    __device__ __forceinline__ void a_ready(const Unit&) const {}
    __device__ __forceinline__ void done(const Unit&) const {}
};
typedef float f32x2 __attribute__((ext_vector_type(2)));
typedef unsigned u32x2 __attribute__((ext_vector_type(2)));
__device__ __forceinline__ unsigned cvt_pk_bf16(float lo, float hi) { unsigned r; asm volatile("v_cvt_pk_bf16_f32 %0, %1, %2" : "=v"(r) : "v"(lo), "v"(hi)); return r; }
__device__ __forceinline__ float bf_lo(unsigned w) { return __builtin_bit_cast(float, w << 16); }
__device__ __forceinline__ float bf_hi(unsigned w) { return __builtin_bit_cast(float, w & 0xffff0000u); }
__device__ __forceinline__ float sq4(const f32x4 v) { return (v[0] * v[0] + v[1] * v[1]) + (v[2] * v[2] + v[3] * v[3]); }
__device__ __forceinline__ float row_rstd(const float* ssq, int row) {
    const f32x4* p = (const f32x4*)(ssq + (size_t)row * 16);
    const f32x4 a = p[0], b = p[1], c = p[2], d = p[3];
    const float s = (((a[0] + a[1]) + (a[2] + a[3])) + ((b[0] + b[1]) + (b[2] + b[3]))) + (((c[0] + c[1]) + (c[2] + c[3])) + ((d[0] + d[1]) + (d[2] + d[3])));
    return 1.0f / sqrtf(s * (1.0f / 1024.0f) + RMS_EPS);
}
__device__ __forceinline__ void ssq_write(float* ssq_out, float q, int row, int slot, int fq) {
    q += xor16_f(q); q = halves_sum_f(q);
    if (fq == 0) ssq_out[(size_t)row * 16 + slot] = q;
}
typedef float f32x2 __attribute__((ext_vector_type(2)));
__device__ __forceinline__ f32x2 gelu_mul2(const f32x2 x, const f32x2 c) {
    const f32x2 x2 = x * x;
    const f32x2 a = x * (x2 * (-2.3022082f * 0.044715f) + (-2.3022082f));
    f32x2 e; e.x = __builtin_amdgcn_exp2f(a.x); e.y = __builtin_amdgcn_exp2f(a.y);
    const f32x2 d = e + 1.0f;
    f32x2 r; r.x = __builtin_amdgcn_rcpf(d.x); r.y = __builtin_amdgcn_rcpf(d.y);
    return (x * c) * r;
}
__device__ __forceinline__ float gelu_tanh(float x) {
    const float t = x + 0.044715f * x * x * x;
    const float e = __builtin_amdgcn_exp2f(-2.3022082f * t);
    return x * __builtin_amdgcn_rcpf(1.0f + e);
}
__device__ __forceinline__ float sigmoid_f(float x) { return __builtin_amdgcn_rcpf(1.0f + __builtin_amdgcn_exp2f(-1.4426950408889634f * x)); }


struct EpiRes {
    static constexpr bool PERM = true, AFTER_DRAIN = false;
    const float* basef; const bf16_t* baseb; bf16_t* hb; float* ssq_out; bf16_t* ahalo;
    __device__ __forceinline__ void operator()(const f32x4 (&acc)[2][2][4][2], const Unit& u_, int wr, int wc, int fr, int fq) const {
        Unit u; { int pm_ = u_.pm, pn_ = u_.pn; asm volatile("" : "+s"(pm_), "+s"(pn_)); u.pm = pm_; u.pn = pn_; }
        const int row0 = u.pm * BM + wr * 64 + fr, col0 = u.pn * BM + wc * 32 + 8 * fq;
        if (basef != nullptr) {
#pragma unroll
            for (int ai = 0; ai < 2; ++ai)
#pragma unroll
                for (int m = 0; m < 4; ++m) {
                    const int row = row0 + ai * HALF + m * 16; float q = 0.f;
#pragma unroll
                    for (int bj = 0; bj < 2; ++bj) {
                        const size_t off = (size_t)row * DMODEL + col0 + bj * HALF;
                        const f32x4 b0 = *(const f32x4*)(basef + off), b1 = *(const f32x4*)(basef + off + 4);
                        const f32x4 v0 = acc[ai][bj][m][0] + b0, v1 = acc[ai][bj][m][1] + b1;
                        q += sq4(v0) + sq4(v1);
                        u32x4 w; w.x = cvt_pk_bf16(v0[0], v0[1]); w.y = cvt_pk_bf16(v0[2], v0[3]); w.z = cvt_pk_bf16(v1[0], v1[1]); w.w = cvt_pk_bf16(v1[2], v1[3]);
                        *(u32x4*)(hb + off) = w;
                        if (ahalo != nullptr && ai == 1 && m == 3) {
                            const int rl = row & 255;
                            if (rl >= 254 && u.pm < 63) *(u32x4*)(ahalo + (size_t)(2 * (u.pm + 1) + (rl - 254)) * DMODEL + col0 + bj * HALF) = w;
                        }
                    }
                    ssq_write(ssq_out, q, row, u.pn * 4 + wc, fq);
                    if (m & 1) asm volatile("" ::: "memory");
                }
        } else {
#pragma unroll
            for (int ai = 0; ai < 2; ++ai) {
                u32x4 bw[4][2];
#pragma unroll
                for (int m = 0; m < 4; ++m)
#pragma unroll
                    for (int bj = 0; bj < 2; ++bj) bw[m][bj] = *(const u32x4*)(baseb + (size_t)(row0 + ai * HALF + m * 16) * DMODEL + col0 + bj * HALF);
                asm volatile("" ::: "memory");
#pragma unroll
                for (int m = 0; m < 4; ++m) {
                    const int row = row0 + ai * HALF + m * 16; float q = 0.f;
#pragma unroll
                    for (int bj = 0; bj < 2; ++bj) {
                        const size_t off = (size_t)row * DMODEL + col0 + bj * HALF;
                        const u32x4 pw = bw[m][bj];
                        const f32x4 b0 = {bf_lo(pw.x), bf_hi(pw.x), bf_lo(pw.y), bf_hi(pw.y)}, b1 = {bf_lo(pw.z), bf_hi(pw.z), bf_lo(pw.w), bf_hi(pw.w)};
                        const f32x4 v0 = acc[ai][bj][m][0] + b0, v1 = acc[ai][bj][m][1] + b1;
                        q += sq4(v0) + sq4(v1);
                        u32x4 w; w.x = cvt_pk_bf16(v0[0], v0[1]); w.y = cvt_pk_bf16(v0[2], v0[3]); w.z = cvt_pk_bf16(v1[0], v1[1]); w.w = cvt_pk_bf16(v1[2], v1[3]);
                        *(u32x4*)(hb + off) = w;
                        if (ahalo != nullptr && ai == 1 && m == 3) {
                            const int rl = row & 255;
                            if (rl >= 254 && u.pm < 63) *(u32x4*)(ahalo + (size_t)(2 * (u.pm + 1) + (rl - 254)) * DMODEL + col0 + bj * HALF) = w;
                        }
                    }
                    ssq_write(ssq_out, q, row, u.pn * 4 + wc, fq);
                }
                asm volatile("" ::: "memory");
            }
        }
    }
};
struct EpiGate {
    static constexpr bool PERM = true, AFTER_DRAIN = false;
    const float* ssq_in; const bf16_t* base; const bf16_t* pp; bf16_t* dst; float* ssq_out;
    __device__ __forceinline__ void operator()(const f32x4 (&acc)[2][2][4][2], const Unit& u_, int wr, int wc, int fr, int fq) const {
        Unit u; { int pm_ = u_.pm, pn_ = u_.pn; asm volatile("" : "+s"(pm_), "+s"(pn_)); u.pm = pm_; u.pn = pn_; }
        const int row0 = u.pm * BM + wr * 64 + fr, col0 = u.pn * BM + wc * 32 + 8 * fq;
#pragma unroll
        for (int ai = 0; ai < 2; ++ai)
#pragma unroll
            for (int mp = 0; mp < 2; ++mp) {
                u32x4 bw[2][2], pq[2][2]; float rs[2];
#pragma unroll
                for (int mi = 0; mi < 2; ++mi) {
                    const int row = row0 + ai * HALF + (2 * mp + mi) * 16;
#pragma unroll
                    for (int bj = 0; bj < 2; ++bj) { const size_t off = (size_t)row * DMODEL + col0 + bj * HALF; bw[mi][bj] = *(const u32x4*)(base + off); pq[mi][bj] = *(const u32x4*)(pp + off); }
                }
#pragma unroll
                for (int mi = 0; mi < 2; ++mi) rs[mi] = row_rstd(ssq_in, row0 + ai * HALF + (2 * mp + mi) * 16);
                asm volatile("" ::: "memory");
#pragma unroll
                for (int mi = 0; mi < 2; ++mi) {
                    const int m = 2 * mp + mi; const int row = row0 + ai * HALF + m * 16; float q = 0.f;
#pragma unroll
                    for (int bj = 0; bj < 2; ++bj) {
                        const size_t off = (size_t)row * DMODEL + col0 + bj * HALF;
                        const u32x4 b_ = bw[mi][bj], p_ = pq[mi][bj];
                        const float bb[8] = {bf_lo(b_.x), bf_hi(b_.x), bf_lo(b_.y), bf_hi(b_.y), bf_lo(b_.z), bf_hi(b_.z), bf_lo(b_.w), bf_hi(b_.w)};
                        const float pv[8] = {bf_lo(p_.x), bf_hi(p_.x), bf_lo(p_.y), bf_hi(p_.y), bf_lo(p_.z), bf_hi(p_.z), bf_lo(p_.w), bf_hi(p_.w)};
                        const f32x4 g0 = acc[ai][bj][m][0] * rs[mi], g1 = acc[ai][bj][m][1] * rs[mi];
                        const float gg[8] = {g0[0], g0[1], g0[2], g0[3], g1[0], g1[1], g1[2], g1[3]};
                        float v[8];
#pragma unroll
                        for (int i = 0; i < 8; ++i) { v[i] = bb[i] + pv[i] * sigmoid_f(gg[i]); q += v[i] * v[i]; }
                        u32x4 w; w.x = cvt_pk_bf16(v[0], v[1]); w.y = cvt_pk_bf16(v[2], v[3]); w.z = cvt_pk_bf16(v[4], v[5]); w.w = cvt_pk_bf16(v[6], v[7]);
                        *(u32x4*)(dst + off) = w;
                    }
                    ssq_write(ssq_out, q, row, u.pn * 4 + wc, fq);
                }
                asm volatile("" ::: "memory");
            }
    }
};
struct EpiBf16Plain {
    static constexpr bool PERM = true, AFTER_DRAIN = false;
    bf16_t* O; int ldc;
    __device__ __forceinline__ void operator()(const f32x4 (&acc)[2][2][4][2], const Unit& u_, int wr, int wc, int fr, int fq) const {
        Unit u; { int pm_ = u_.pm, pn_ = u_.pn; asm volatile("" : "+s"(pm_), "+s"(pn_)); u.pm = pm_; u.pn = pn_; }
        const int row0 = u.pm * BM + wr * 64 + fr, col0 = u.pn * BM + wc * 32 + 8 * fq;
#pragma unroll
        for (int ai = 0; ai < 2; ++ai)
#pragma unroll
            for (int m = 0; m < 4; ++m) {
                const int row = row0 + ai * HALF + m * 16;
#pragma unroll
                for (int bj = 0; bj < 2; ++bj) {
                    const f32x4 v0 = acc[ai][bj][m][0], v1 = acc[ai][bj][m][1];
                    u32x4 w; w.x = cvt_pk_bf16(v0[0], v0[1]); w.y = cvt_pk_bf16(v0[2], v0[3]); w.z = cvt_pk_bf16(v1[0], v1[1]); w.w = cvt_pk_bf16(v1[2], v1[3]);
                    *(u32x4*)(O + (size_t)row * ldc + col0 + bj * HALF) = w;
                }
            }
    }
};
struct EpiEvenIn {
    static constexpr bool PERM = true, AFTER_DRAIN = false;
    const float* ssq_in; bf16_t* Z; const f32x2* rope;
    __device__ __forceinline__ void operator()(const f32x4 (&acc)[2][2][4][2], const Unit& u_, int wr, int wc, int fr, int fq) const {
        Unit u; { int pm_ = u_.pm, pn_ = u_.pn; asm volatile("" : "+s"(pm_), "+s"(pn_)); u.pm = pm_; u.pn = pn_; }
        const int row0 = u.pm * BM + wr * 64 + fr, colw = wc * 32 + 8 * fq;
        const int pn = u.pn;
        const float sc = (pn == 2 || pn == 3) ? C2 : 1.0f;
#pragma unroll
        for (int ai = 0; ai < 2; ++ai)
#pragma unroll
            for (int m = 0; m < 4; ++m) {
                const int row = row0 + ai * HALF + m * 16;
                const float rs = row_rstd(ssq_in, row);
#pragma unroll
                for (int bj = 0; bj < 2; ++bj) {
                    const int gi = 2 * bj + (wc >> 1);
                    const bool ropeg = (pn == 2 || pn == 3 || pn == 5 || (pn == 4 && (gi == 0 || gi == 2))) && ((wc & 1) == 0);
                    f32x4 v0 = acc[ai][bj][m][0] * rs, v1 = acc[ai][bj][m][1] * rs;
                    if (ropeg && fq < 2) {
                        const f32x4* rp = (const f32x4*)(rope + (size_t)row * 8 + 4 * fq);
                        const f32x4 ra = rp[0], rb = rp[1];
                        f32x4 o0, o1;
                        o0[0] = v0[0] * ra[0] - v0[1] * ra[1]; o0[1] = v0[1] * ra[0] + v0[0] * ra[1];
                        o0[2] = v0[2] * ra[2] - v0[3] * ra[3]; o0[3] = v0[3] * ra[2] + v0[2] * ra[3];
                        o1[0] = v1[0] * rb[0] - v1[1] * rb[1]; o1[1] = v1[1] * rb[0] + v1[0] * rb[1];
                        o1[2] = v1[2] * rb[2] - v1[3] * rb[3]; o1[3] = v1[3] * rb[2] + v1[2] * rb[3];
                        v0 = o0; v1 = o1;
                    }
                    v0 = v0 * sc; v1 = v1 * sc;
                    u32x4 w; w.x = cvt_pk_bf16(v0[0], v0[1]); w.y = cvt_pk_bf16(v0[2], v0[3]); w.z = cvt_pk_bf16(v1[0], v1[1]); w.w = cvt_pk_bf16(v1[2], v1[3]);
                    *(u32x4*)(Z + (size_t)row * EV_N + pn * BM + bj * HALF + colw) = w;
                }
            }
    }
};
struct EpiOddIn {
    static constexpr bool PERM = true, AFTER_DRAIN = false;
    const float* ssq_in; bf16_t* Z; float* F; float* sst;
    __device__ __forceinline__ void operator()(const f32x4 (&acc)[2][2][4][2], const Unit& u_, int wr, int wc, int fr, int fq) const {
        Unit u; { int pm_ = u_.pm, pn_ = u_.pn; asm volatile("" : "+s"(pm_), "+s"(pn_)); u.pm = pm_; u.pn = pn_; }
        const int row0 = u.pm * BM + wr * 64 + fr, colw = wc * 32 + 8 * fq;
        const int pn = u.pn;
        const float sc = (pn < 2) ? C2 : 1.0f;
        const bool act = (pn >= 6 && pn < 10), stat = (pn == 8 || pn == 9);
#pragma unroll
        for (int ai = 0; ai < 2; ++ai)
#pragma unroll
            for (int m = 0; m < 4; ++m) {
                const int row = row0 + ai * HALF + m * 16;
                const float rs = row_rstd(ssq_in, row);
                if (pn == 10) {
                    if (wc == 0 && fq == 0) { *(f32x4*)(F + (size_t)row * 8) = acc[ai][0][m][0] * rs; *(f32x4*)(F + (size_t)row * 8 + 4) = acc[ai][0][m][1] * rs; }
                    continue;
                }
                float s1 = 0.f, s2 = 0.f;
#pragma unroll
                for (int bj = 0; bj < 2; ++bj) {
                    f32x4 v0 = acc[ai][bj][m][0] * (rs * sc), v1 = acc[ai][bj][m][1] * (rs * sc);
                    if (act) {
#pragma unroll
                        for (int i = 0; i < 4; ++i) { v0[i] = gelu_tanh(v0[i]); v1[i] = gelu_tanh(v1[i]); }
                    }
                    s1 += ((v0[0] + v0[1]) + (v0[2] + v0[3])) + ((v1[0] + v1[1]) + (v1[2] + v1[3])); s2 += sq4(v0) + sq4(v1);
                    u32x4 w; w.x = cvt_pk_bf16(v0[0], v0[1]); w.y = cvt_pk_bf16(v0[2], v0[3]); w.z = cvt_pk_bf16(v1[0], v1[1]); w.w = cvt_pk_bf16(v1[2], v1[3]);
                    *(u32x4*)(Z + (size_t)row * Z1P + pn * BM + bj * HALF + colw) = w;
                }
                if (stat) {
                    s1 += xor16_f(s1); s1 = halves_sum_f(s1); s2 += xor16_f(s2); s2 = halves_sum_f(s2);
                    if (fq == 0) *(f32x2*)(sst + ((size_t)row * 8 + (pn - 8) * 4 + wc) * 2) = (f32x2){s1, s2};
                }
            }
    }
};
struct EpiHalo {
    static constexpr bool PERM = true, AFTER_DRAIN = false;
    const float* ssq_in; float* AH;
    __device__ __forceinline__ void operator()(const f32x4 (&acc)[2][2][4][2], const Unit& u_, int wr, int wc, int fr, int fq) const {
        Unit u; { int pm_ = u_.pm, pn_ = u_.pn; asm volatile("" : "+s"(pm_), "+s"(pn_)); u.pm = pm_; u.pn = pn_; }
        const int col0 = u.pn * BM + wc * 32 + 8 * fq;
#pragma unroll
        for (int m = 0; m < 4; ++m) {
            const int rh = wr * 64 + m * 16 + fr;
            if (rh < 2) continue;
            const int tok = 256 * (rh >> 1) - 2 + (rh & 1);
            const float rs = row_rstd(ssq_in, tok);
#pragma unroll
            for (int bj = 0; bj < 2; ++bj) {
                *(f32x4*)(AH + (size_t)rh * NFF2 + col0 + bj * HALF) = acc[0][bj][m][0] * rs;
                *(f32x4*)(AH + (size_t)rh * NFF2 + col0 + bj * HALF + 4) = acc[0][bj][m][1] * rs;
            }
        }
    }
};
template <int SEL> __device__ __forceinline__ float dpp1(const float old, const float src) {
    const int o = __builtin_bit_cast(int, old), s = __builtin_bit_cast(int, src); int t;
    if (SEL == 0) t = __builtin_amdgcn_update_dpp(o, s, 0x111, 0xf, 0xf, false);
    else if (SEL == 1) t = __builtin_amdgcn_update_dpp(o, s, 0x112, 0xf, 0xf, false);
    else if (SEL == 2) t = __builtin_amdgcn_update_dpp(o, s, 0x10F, 0xf, 0xf, false);
    else t = __builtin_amdgcn_update_dpp(o, s, 0x10E, 0xf, 0xf, false);
    return __builtin_bit_cast(float, t);
}
template <int SEL> __device__ __forceinline__ f32x4 dpp4t(const f32x4 old, const f32x4 src) {
    const float o0 = old[0], o1 = old[1], o2 = old[2], o3 = old[3], s0 = src[0], s1 = src[1], s2 = src[2], s3 = src[3];
    const float r0 = dpp1<SEL>(o0, s0), r1 = dpp1<SEL>(o1, s1), r2 = dpp1<SEL>(o2, s2), r3 = dpp1<SEL>(o3, s3);
    return (f32x4){r0, r1, r2, r3};
}
#define dpp4(old, src, sel) dpp4t<sel>(old, src)
__device__ __forceinline__ void conv_taps(f32x4& c, const f32x4 cur, const f32x4 prev, const f32x4 w0, const f32x4 w1) {
    float c0 = c[0], c1 = c[1], c2 = c[2], c3 = c[3];
    const float x0 = cur[0], x1 = cur[1], x2 = cur[2], x3 = cur[3], p0 = prev[0], p1 = prev[1], p2 = prev[2], p3 = prev[3];
    const float a0 = w1[0], a1 = w1[1], a2 = w1[2], a3 = w1[3], b0 = w0[0], b1 = w0[1], b2 = w0[2], b3 = w0[3];
    asm("s_nop 4\n\t"
        "v_fmac_f32_dpp %0, %4, %12 row_shr:1 row_mask:0xf bank_mask:0xf bound_ctrl:1\n\t"
        "v_fmac_f32_dpp %1, %5, %13 row_shr:1 row_mask:0xf bank_mask:0xf bound_ctrl:1\n\t"
        "v_fmac_f32_dpp %2, %6, %14 row_shr:1 row_mask:0xf bank_mask:0xf bound_ctrl:1\n\t"
        "v_fmac_f32_dpp %3, %7, %15 row_shr:1 row_mask:0xf bank_mask:0xf bound_ctrl:1\n\t"
        "v_fmac_f32_dpp %0, %4, %16 row_shr:2 row_mask:0xf bank_mask:0xf bound_ctrl:1\n\t"
        "v_fmac_f32_dpp %1, %5, %17 row_shr:2 row_mask:0xf bank_mask:0xf bound_ctrl:1\n\t"
        "v_fmac_f32_dpp %2, %6, %18 row_shr:2 row_mask:0xf bank_mask:0xf bound_ctrl:1\n\t"
        "v_fmac_f32_dpp %3, %7, %19 row_shr:2 row_mask:0xf bank_mask:0xf bound_ctrl:1\n\t"
        "v_fmac_f32_dpp %0, %8, %12 row_shl:15 row_mask:0xf bank_mask:0xf bound_ctrl:1\n\t"
        "v_fmac_f32_dpp %1, %9, %13 row_shl:15 row_mask:0xf bank_mask:0xf bound_ctrl:1\n\t"
        "v_fmac_f32_dpp %2, %10, %14 row_shl:15 row_mask:0xf bank_mask:0xf bound_ctrl:1\n\t"
        "v_fmac_f32_dpp %3, %11, %15 row_shl:15 row_mask:0xf bank_mask:0xf bound_ctrl:1\n\t"
        "v_fmac_f32_dpp %0, %8, %16 row_shl:14 row_mask:0xf bank_mask:0xf bound_ctrl:1\n\t"
        "v_fmac_f32_dpp %1, %9, %17 row_shl:14 row_mask:0xf bank_mask:0xf bound_ctrl:1\n\t"
        "v_fmac_f32_dpp %2, %10, %18 row_shl:14 row_mask:0xf bank_mask:0xf bound_ctrl:1\n\t"
        "v_fmac_f32_dpp %3, %11, %19 row_shl:14 row_mask:0xf bank_mask:0xf bound_ctrl:1"
        : "+v"(c0), "+v"(c1), "+v"(c2), "+v"(c3)
        : "v"(x0), "v"(x1), "v"(x2), "v"(x3), "v"(p0), "v"(p1), "v"(p2), "v"(p3), "v"(a0), "v"(a1), "v"(a2), "v"(a3), "v"(b0), "v"(b1), "v"(b2), "v"(b3));
    c[0] = c0; c[1] = c1; c[2] = c2; c[3] = c3;
}
struct EpiHaloF {
    static constexpr bool PERM = true, AFTER_DRAIN = false;
    const float* ssq_in; float* ah; unsigned* flags;
    __device__ __forceinline__ void operator()(const f32x4 (&acc)[2][2][4][2], const Unit& u_, int wr, int wc, int fr, int fq) const {
        Unit u; { int pm_ = u_.pm, pn_ = u_.pn; asm volatile("" : "+s"(pm_), "+s"(pn_)); u.pm = pm_; u.pn = pn_; }
        const int col0 = u.pn * BM + wc * 32 + 8 * fq;
#pragma unroll
        for (int m = 0; m < 4; ++m) {
            const int rh = wr * 64 + m * 16 + fr;
            if (rh >= 2) {
                const int tok = 256 * (rh >> 1) - 2 + (rh & 1);
                const float rsh = row_rstd(ssq_in, tok);
#pragma unroll
                for (int bj = 0; bj < 2; ++bj) {
                    *(f32x4*)(ah + (size_t)rh * NFF2 + col0 + bj * HALF) = acc[0][bj][m][0] * rsh;
                    *(f32x4*)(ah + (size_t)rh * NFF2 + col0 + bj * HALF + 4) = acc[0][bj][m][1] * rsh;
                }
            }
        }
        asm volatile("s_waitcnt vmcnt(0)" ::: "memory"); __builtin_amdgcn_s_barrier(); asm volatile("" ::: "memory");
        if (wr == 0 && wc == 0 && fr == 0 && fq == 0) {
            __builtin_amdgcn_fence(__ATOMIC_RELEASE, "agent");
            asm volatile("s_waitcnt vmcnt(0)" ::: "memory");
            __hip_atomic_store(flags + 64 * u.pn, 1u, __ATOMIC_RELAXED, __HIP_MEMORY_SCOPE_AGENT);
        }
    }
};
struct EpiFfnIn {
    static constexpr bool PERM = true, AFTER_DRAIN = false;
    const float* ssq_in; const float* cw; const float* cb; float* ah; bf16_t* hid; PG8_LAS float* xb; unsigned* flags; unsigned phase_id;
    __device__ __forceinline__ void operator()(const f32x4 (&acc)[2][2][4][2], const Unit& u_, int wr, int wc, int fr, int fq) const {
        Unit u; { int pm_ = u_.pm, pn_ = u_.pn; asm volatile("" : "+s"(pm_), "+s"(pn_)); u.pm = pm_; u.pn = pn_; }
        PG8_LAS float* rtab = xb + 2048;
        const int row0 = u.pm * BM + wr * 64 + fr;
        PG8_LAS float* cwl = xb + 2432 + wc * 256;
        PG8_LAS float* hl = xb + 3456 + wc * 128;
        if (wr == 0) {
            const float* src = (fq < 3 ? cw + fq * NFF2 : cb) + (fr >> 3) * DFF + 128 * u.pn + wc * 32 + (fr & 7) * 4;
            const f32x4 wv = *(const f32x4*)src;
            rtab[wc * 64 + fq * 16 + fr] = row_rstd(ssq_in, u.pm * BM + wc * 64 + fq * 16 + fr);
            *(PG8_LAS f32x4*)(cwl + (fq * 16 + fr) * 4) = wv;
        }
        if (fr >= 14) {
#pragma unroll
            for (int ai = 0; ai < 2; ++ai) {
                PG8_LAS f32x4* dst = (PG8_LAS f32x4*)(xb + ((((ai * 2 + wr) * 4 + wc) * 2 + (fr - 14)) * 4 + fq) * 16);
#pragma unroll
                for (int bj = 0; bj < 2; ++bj)
#pragma unroll
                    for (int n = 0; n < 2; ++n) dst[bj * 2 + n] = acc[ai][bj][3][n];
            }
        }
        asm volatile("s_waitcnt lgkmcnt(0)" ::: "memory"); __builtin_amdgcn_s_barrier(); asm volatile("" ::: "memory");
        const bool has = (u.pm & 7) != 0;
        if (wr == 0) {
            PG8_LAS unsigned* stamp = (PG8_LAS unsigned*)(rtab + 256);
            if (*(volatile PG8_LAS unsigned*)stamp != phase_id) {
                if (wc == 0) {
                    unsigned sp = 0;
                    for (int t = 0; t < NFF2 / BM; ++t)
                        while (__hip_atomic_load(flags + 64 * t, __ATOMIC_RELAXED, __HIP_MEMORY_SCOPE_AGENT) == 0u) { __builtin_amdgcn_s_sleep(2); if (++sp > (1u << 22)) break; }
                    asm volatile("s_waitcnt vmcnt(0)" ::: "memory");
                    if (fr == 0 && fq == 0) *(volatile PG8_LAS unsigned*)stamp = phase_id;
                } else {
                    unsigned sp = 0;
                    while (*(volatile PG8_LAS unsigned*)stamp != phase_id) { __builtin_amdgcn_s_sleep(2); if (++sp > (1u << 22)) break; }
                }
            }
        }
        if (wr == 0) {
            f32x2 hv = {0.f, 0.f};
            if (has) hv = *(const f32x2*)(ah + (size_t)(2 * u.pm + (fq >> 1)) * NFF2 + (size_t)u.pn * BM + (fq & 1) * HALF + wc * 32 + 2 * fr);
            *(PG8_LAS f32x2*)(hl + (fq * 16 + fr) * 2) = hv;
        }
        float rs[2][4];
#pragma unroll
        for (int ai = 0; ai < 2; ++ai)
#pragma unroll
            for (int m = 0; m < 4; ++m) rs[ai][m] = rtab[ai * HALF + wr * 64 + m * 16 + fr];
        const f32x4 zero4 = {0.f, 0.f, 0.f, 0.f};
#pragma unroll
        for (int ai = 0; ai < 2; ++ai) {
#pragma unroll
            for (int n = 0; n < 2; ++n) {
                f32x4 cg[4];
#pragma unroll
                for (int bj = 0; bj < 2; ++bj) {
                    f32x4 b0, b1;
                    if (ai == 0 && wr == 0) {
                        b0 = *(const PG8_LAS f32x4*)(hl + (0 * 2 + bj) * 32 + 8 * fq + 4 * n);
                        b1 = *(const PG8_LAS f32x4*)(hl + (1 * 2 + bj) * 32 + 8 * fq + 4 * n);
                    } else {
                        const int sa = (wr == 1) ? ai : ai - 1, sw = (wr == 1) ? 0 : 1;
                        const float r0 = rtab[sa * HALF + sw * 64 + 62], r1 = rtab[sa * HALF + sw * 64 + 63];
                        b0 = *(const PG8_LAS f32x4*)(xb + ((((sa * 2 + sw) * 4 + wc) * 2 + 0) * 4 + fq) * 16 + (bj * 2 + n) * 4) * r0;
                        b1 = *(const PG8_LAS f32x4*)(xb + ((((sa * 2 + sw) * 4 + wc) * 2 + 1) * 4 + fq) * 16 + (bj * 2 + n) * 4) * r1;
                    }
                    const int oc = bj * 32 + 8 * fq + 4 * n;
                    const f32x4 w0 = *(const PG8_LAS f32x4*)(cwl + oc), w1 = *(const PG8_LAS f32x4*)(cwl + 64 + oc), w2 = *(const PG8_LAS f32x4*)(cwl + 128 + oc), bb = *(const PG8_LAS f32x4*)(cwl + 192 + oc);
                    f32x4 prev = (fr == 14) ? b0 : b1;
#pragma unroll
                    for (int m = 0; m < 4; ++m) {
                        const f32x4 cur = acc[ai][bj][m][n] * rs[ai][m];
                        f32x4 c = w2 * cur + bb;
                        conv_taps(c, cur, prev, w0, w1);
                        prev = cur;
                        if (bj == 0) cg[m] = c;
                        else {
                            const f32x2 ha = gelu_mul2((f32x2){cg[m][0], cg[m][1]}, (f32x2){c[0], c[1]}), hb = gelu_mul2((f32x2){cg[m][2], cg[m][3]}, (f32x2){c[2], c[3]});
                            u32x2 w; w.x = cvt_pk_bf16(ha.x, ha.y); w.y = cvt_pk_bf16(hb.x, hb.y);
                            const int row = row0 + ai * HALF + m * 16;
                            *(u32x2*)(hid + (size_t)row * DFF + 128 * u.pn + wc * 32 + 8 * fq + 4 * n) = w;
                        }
                    }
                    asm volatile("" ::: "memory");
                }
            }
        }
    }
};
template <class Epi, class Sched, bool ALIGN_EPI = false, bool SP2 = false>
__device__ __forceinline__ void gemm_phase(PG8_LAS unsigned char* lds, const Gemm g, const Sched& S, const Epi& E, const int wave_s) {
    const int tid_ = wave_s * 64 + lane_opaque(); const int tid = tid_, wid = __builtin_amdgcn_readfirstlane(tid >> 6), lane = tid & 63, wr = wid >> 2, wc = wid & 3, fr = lane & 15, fq = lane >> 4;
    const int K = g.K, nt = K / BK;
    unsigned voffA[2], voffB[2];
#pragma unroll
    for (int i = 0; i < 2; ++i) { int R, C; stage_rc(tid * 16 + i * 8192, R, C); const int Rb = Epi::PERM ? ((R & ~31) + perm32(R & 31)) : R;
        voffA[i] = (unsigned)(R * K + C) * 2u; voffB[i] = (unsigned)(Rb * K + C) * 2u; }
    const size_t kstep = (size_t)(BK * 2);
    const size_t hstep = (size_t)HALF * K * 2;
    const size_t tstep = 2 * hstep;
    const unsigned ldsw = (unsigned)wid * 1024u;
    const int aoff = lds_byte(wr * 64 + fr, fq * 8), boff = lds_byte(wc * 32 + fr, fq * 8);
#define PG8_SA(b, h) (((b) * 2 + (h)) * HTB)
#define PG8_SB(b, h) ((4 + (b) * 2 + (h)) * HTB)
#define PG8_STAGE(bufoff, gbase, voff) do { _Pragma("unroll") for (int _i = 0; _i < 2; ++_i) \
        __builtin_amdgcn_global_load_lds((const unsigned*)((const char*)(gbase) + (voff)[_i]), (PG8_LAS unsigned*)(lds + (bufoff) + ldsw + _i * 8192), 16, 0, 0); } while (0)
#define PG8_LDA(dst, b, h) do { _Pragma("unroll") for (int m = 0; m < 4; ++m) _Pragma("unroll") for (int k = 0; k < 2; ++k) dst[m][k] = *(const PG8_LAS bf16x8*)(lds + PG8_SA(b, h) + aoff + m * 2048 + k * 1024); } while (0)
#define PG8_LDB(dst, b, h) do { _Pragma("unroll") for (int n = 0; n < 2; ++n) _Pragma("unroll") for (int k = 0; k < 2; ++k) dst[n][k] = *(const PG8_LAS bf16x8*)(lds + PG8_SB(b, h) + boff + n * 2048 + k * 1024); } while (0)
#define PG8_MMA(ai, bj, At, Bt) do { __builtin_amdgcn_s_setprio(1); _Pragma("unroll") for (int m = 0; m < 4; ++m) _Pragma("unroll") for (int n = 0; n < 2; ++n) _Pragma("unroll") for (int k = 0; k < 2; ++k) \
        acc[ai][bj][m][n] = __builtin_amdgcn_mfma_f32_16x16x32_bf16(Bt[n][k], At[m][k], acc[ai][bj][m][n], 0, 0, 0); __builtin_amdgcn_s_setprio(0); } while (0)
#define PG8_WAIT_V(n) asm volatile("s_waitcnt vmcnt(" #n ")" ::: "memory")
#define PG8_WAIT_L(n) asm volatile("s_waitcnt lgkmcnt(" #n ")" ::: "memory")
#define PG8_BAR __builtin_amdgcn_s_barrier()
#define PG8_SCHED __builtin_amdgcn_sched_barrier(0)
    Unit cur, nxt; int ui = 0;
    if (!S.next(0, cur)) return;
    f32x4 acc[2][2][4][2];
#pragma unroll
    for (int a = 0; a < 2; ++a)
#pragma unroll
        for (int b = 0; b < 2; ++b)
#pragma unroll
            for (int m = 0; m < 4; ++m)
#pragma unroll
                for (int n = 0; n < 2; ++n) acc[a][b][m][n] = (f32x4){0.f, 0.f, 0.f, 0.f};
    bf16x8 At[4][2], B0[2][2], B1[2][2];
    const char* cA = (const char*)g.A + (size_t)cur.pm * tstep; const char* cB = (const char*)g.Bt + (size_t)cur.pn * tstep;
    S.a_ready(cur);
    if constexpr (SP2) {
        PG8_STAGE(PG8_SB(0, 0), cB, voffB); PG8_STAGE(PG8_SB(0, 1), cB + hstep, voffB); PG8_STAGE(PG8_SA(0, 0), cA, voffA); PG8_STAGE(PG8_SA(0, 1), cA + hstep, voffA);
        if (wr == 1) PG8_BAR;
        PG8_WAIT_V(2); PG8_BAR;
        PG8_STAGE(PG8_SB(1, 0), cB + kstep, voffB); PG8_STAGE(PG8_SA(1, 0), cA + kstep, voffA); PG8_STAGE(PG8_SB(1, 1), cB + hstep + kstep, voffB);
        PG8_WAIT_V(6); PG8_BAR;
    } else {
        PG8_STAGE(PG8_SB(0, 0), cB, voffB); PG8_STAGE(PG8_SA(0, 0), cA, voffA); PG8_STAGE(PG8_SB(0, 1), cB + hstep, voffB); PG8_STAGE(PG8_SA(0, 1), cA + hstep, voffA);
        if (wr == 1) PG8_BAR;
        PG8_WAIT_V(4); PG8_BAR;
        PG8_STAGE(PG8_SB(1, 0), cB + kstep, voffB); PG8_STAGE(PG8_SA(1, 0), cA + kstep, voffA); PG8_STAGE(PG8_SB(1, 1), cB + hstep + kstep, voffB);
        PG8_WAIT_V(6); PG8_BAR;
    }
    for (;;) {
        const bool has_next = S.next(ui + 1, nxt);
        const char* nA = has_next ? (const char*)g.A + (size_t)nxt.pm * tstep : cA; const char* nB = has_next ? (const char*)g.Bt + (size_t)nxt.pn * tstep : cB;
        for (int t = 0; t < nt; t += 2) {
            const bool last = (t == nt - 2);
            const char* a1 = cA + (size_t)(t + 1) * kstep;
            const char* a2 = last ? nA : cA + (size_t)(t + 2) * kstep; const char* b2 = last ? nB : cB + (size_t)(t + 2) * kstep;
            const char* a3 = a2 + kstep; const char* b3 = b2 + kstep;
            if (last && has_next) S.a_ready(nxt);
            if constexpr (SP2) {
            PG8_LDB(B0, 0, 0); PG8_LDB(B1, 0, 1); PG8_SCHED; PG8_LDA(At, 0, 0); PG8_STAGE(PG8_SA(1, 1), a1 + hstep, voffA);
            PG8_WAIT_V(8); PG8_WAIT_L(0); PG8_BAR; PG8_MMA(0, 0, At, B0); PG8_MMA(0, 1, At, B1); PG8_BAR; PG8_SCHED;
            PG8_LDA(At, 0, 1); PG8_STAGE(PG8_SB(0, 0), b2, voffB); PG8_STAGE(PG8_SB(0, 1), b2 + hstep, voffB); PG8_STAGE(PG8_SA(0, 0), a2, voffA);
            PG8_WAIT_V(8); PG8_WAIT_L(0); PG8_BAR; PG8_MMA(1, 0, At, B0); PG8_MMA(1, 1, At, B1); PG8_BAR; PG8_SCHED;
            PG8_LDB(B0, 1, 0); PG8_LDB(B1, 1, 1); PG8_SCHED; PG8_LDA(At, 1, 0); PG8_STAGE(PG8_SA(0, 1), a2 + hstep, voffA);
            PG8_WAIT_V(8); PG8_WAIT_L(0); PG8_BAR; PG8_MMA(0, 0, At, B0); PG8_MMA(0, 1, At, B1); PG8_BAR; PG8_SCHED;
            PG8_LDA(At, 1, 1); PG8_STAGE(PG8_SB(1, 0), b3, voffB); PG8_STAGE(PG8_SB(1, 1), b3 + hstep, voffB); PG8_STAGE(PG8_SA(1, 0), a3, voffA);
            PG8_WAIT_V(8); PG8_WAIT_L(0); PG8_BAR; PG8_MMA(1, 0, At, B0); PG8_MMA(1, 1, At, B1); PG8_BAR; PG8_SCHED;
            } else {
            PG8_LDB(B0, 0, 0); PG8_SCHED; PG8_LDA(At, 0, 0); PG8_STAGE(PG8_SA(1, 1), a1 + hstep, voffA);
            PG8_WAIT_L(8); PG8_BAR; PG8_WAIT_L(0); PG8_MMA(0, 0, At, B0); PG8_BAR; PG8_SCHED;
            PG8_LDB(B1, 0, 1); PG8_STAGE(PG8_SB(0, 0), b2, voffB);
            PG8_BAR; PG8_WAIT_L(0); PG8_MMA(0, 1, At, B1); PG8_BAR;
            PG8_LDA(At, 0, 1); PG8_STAGE(PG8_SA(0, 0), a2, voffA);
            PG8_BAR; PG8_WAIT_L(0); PG8_MMA(1, 0, At, B0); PG8_BAR; PG8_SCHED;
            PG8_STAGE(PG8_SB(0, 1), b2 + hstep, voffB);
            PG8_WAIT_V(6); PG8_BAR; PG8_MMA(1, 1, At, B1); PG8_BAR;
            PG8_LDB(B0, 1, 0); PG8_SCHED; PG8_LDA(At, 1, 0); PG8_STAGE(PG8_SA(0, 1), a2 + hstep, voffA);
            PG8_WAIT_L(8); PG8_BAR; PG8_WAIT_L(0); PG8_MMA(0, 0, At, B0); PG8_BAR; PG8_SCHED;
            PG8_LDB(B1, 1, 1); PG8_STAGE(PG8_SB(1, 0), b3, voffB);
            PG8_BAR; PG8_WAIT_L(0); PG8_MMA(0, 1, At, B1); PG8_BAR;
            PG8_LDA(At, 1, 1); PG8_STAGE(PG8_SA(1, 0), a3, voffA);
            PG8_BAR; PG8_WAIT_L(0); PG8_MMA(1, 0, At, B0); PG8_BAR; PG8_SCHED;
            PG8_STAGE(PG8_SB(1, 1), b3 + hstep, voffB);
            PG8_WAIT_V(6); PG8_BAR; PG8_MMA(1, 1, At, B1); PG8_BAR;
            }
        }
        if constexpr (ALIGN_EPI) { if (wr == 0) PG8_BAR; }
        if constexpr (!Epi::AFTER_DRAIN) { E(acc, cur, wr, wc, fr, fq); S.done(cur); }
        if (!has_next) break;
#pragma unroll
        for (int a = 0; a < 2; ++a)
#pragma unroll
            for (int b = 0; b < 2; ++b)
#pragma unroll
                for (int m = 0; m < 4; ++m)
#pragma unroll
                    for (int n = 0; n < 2; ++n) acc[a][b][m][n] = (f32x4){0.f, 0.f, 0.f, 0.f};
        cur = nxt; cA = nA; cB = nB; ++ui;
        if constexpr (ALIGN_EPI) { if (wr == 1) PG8_BAR; }
    }
    PG8_WAIT_V(0);
    if constexpr (!ALIGN_EPI) { if (wr == 0) PG8_BAR; }
    PG8_BAR;
    if constexpr (Epi::AFTER_DRAIN) { E.fused(acc, cur, wr, wc, fr, fq, lds, wid, lane); S.done(cur); }
#undef PG8_SA
#undef PG8_SB
#undef PG8_STAGE
#undef PG8_LDA
#undef PG8_LDB
#undef PG8_MMA
#undef PG8_WAIT_V
#undef PG8_WAIT_L
#undef PG8_BAR
#undef PG8_SCHED
}
}
namespace mix {
#define MLAS __attribute__((address_space(3)))
typedef unsigned short bf16_t;
typedef short bf16x8 __attribute__((ext_vector_type(8)));
typedef short s16x4 __attribute__((ext_vector_type(4)));
typedef float f32x16 __attribute__((ext_vector_type(16)));
typedef float f32x4 __attribute__((ext_vector_type(4)));
typedef float f32x2 __attribute__((ext_vector_type(2)));
typedef unsigned u32x4 __attribute__((ext_vector_type(4)));
typedef unsigned u32x2 __attribute__((ext_vector_type(2)));
typedef MLAS const char* lds_cptr;
typedef short v4i16_t __attribute__((ext_vector_type(4)));
typedef __bf16 bf16x2_t __attribute__((ext_vector_type(2)));

constexpr int SLOTB = 8192;
constexpr int NSLOT = 4;
constexpr int L_K = 0, L_V = NSLOT * SLOTB, L_WSF = 2 * NSLOT * SLOTB, L_OST = L_WSF + 8 * 256, L_X = L_OST + 8 * 4096;
constexpr int LX_IQ = L_X, LX_EQ = L_X, LX_PFX = L_X + 8192, LX_CNT = LX_IQ + 16384, LX_GT = LX_CNT + 2048, LX_SEL = LX_GT, LX_END = LX_GT + 8192;
static_assert(LX_END <= 131072, "mixer LDS map");

__device__ __forceinline__ int crow(int r, int hi) { return (r & 3) + 8 * (r >> 2) + 4 * hi; }
__device__ __forceinline__ void glds16(const void* gsrc, unsigned lds_dst) { unsigned keep;
    asm volatile("s_mov_b32 %0, m0\n\ts_mov_b32 m0, %2\n\ts_nop 0\n\tglobal_load_lds_dwordx4 %1, off\n\ts_mov_b32 m0, %0" : "=&s"(keep) : "v"(gsrc), "s"(lds_dst) : "memory"); }
__device__ __forceinline__ unsigned cvtpk(float lo, float hi) { f32x2 v = {lo, hi}; bf16x2_t b = __builtin_convertvector(v, bf16x2_t); return __builtin_bit_cast(unsigned, b); }
__device__ __forceinline__ s16x4 vtr(lds_cptr p) { return __builtin_bit_cast(s16x4, __builtin_amdgcn_ds_read_tr16_b64_v4i16((MLAS v4i16_t*)p)); }
#define WAITV_BAR() asm volatile("s_waitcnt vmcnt(0) lgkmcnt(0)\n\ts_barrier" ::: "memory")
#define LGKM_BAR() asm volatile("s_waitcnt lgkmcnt(0)\n\ts_barrier" ::: "memory")
#define WAITV2_BAR() asm volatile("s_waitcnt vmcnt(2) lgkmcnt(0)\n\ts_barrier" ::: "memory")

__device__ __forceinline__ void dma_kv(const bf16_t* kbase, const bf16_t* vbase, int pitch, unsigned lds0, int slot, int wid, int lane) {
    const bf16_t* ks = kbase + (size_t)lane * pitch + wid * 8;
    const bf16_t* vs = vbase + (size_t)(16 * (wid & 3) + (lane >> 2)) * pitch + (wid >> 2) * 32 + (lane & 3) * 8;
    glds16(ks, (unsigned)__builtin_amdgcn_readfirstlane(lds0 + L_K + slot * SLOTB + wid * 1024));
    glds16(vs, (unsigned)__builtin_amdgcn_readfirstlane(lds0 + L_V + slot * SLOTB + wid * 1024));
}
__device__ __forceinline__ void kload(bf16x8 (&kf)[8], lds_cptr kslot, int r32, int hi) {
    lds_cptr kb = kslot + hi * 1024 + r32 * 16;
#pragma unroll
    for (int d0 = 0; d0 < 4; ++d0) { kf[2 * d0] = *(const MLAS bf16x8*)(kb + d0 * 2048); kf[2 * d0 + 1] = *(const MLAS bf16x8*)(kb + d0 * 2048 + 512); }
}
__device__ __forceinline__ void qkt_mma(f32x16& p0, f32x16& p1, const bf16x8 (&kf)[8], const bf16x8* qr, const f32x16& cinit) {
    p0 = __builtin_amdgcn_mfma_f32_32x32x16_bf16(kf[0], qr[0], cinit, 0, 0, 0); p1 = __builtin_amdgcn_mfma_f32_32x32x16_bf16(kf[1], qr[0], cinit, 0, 0, 0);
#pragma unroll
    for (int d0 = 1; d0 < 4; ++d0) { p0 = __builtin_amdgcn_mfma_f32_32x32x16_bf16(kf[2 * d0], qr[d0], p0, 0, 0, 0); p1 = __builtin_amdgcn_mfma_f32_32x32x16_bf16(kf[2 * d0 + 1], qr[d0], p1, 0, 0, 0); }
}
__device__ __forceinline__ void qkt(f32x16& p0, f32x16& p1, lds_cptr kslot, const bf16x8* qr, const f32x16& cinit, int r32, int hi) {
    bf16x8 kf[8]; kload(kf, kslot, r32, hi); qkt_mma(p0, p1, kf, qr, cinit);
}
__device__ __forceinline__ void vload(bf16x8 (&vf)[8], lds_cptr vslot, int lane, int hi) {
    lds_cptr vp = vslot + ((lane >> 4) & 1) * 32 + (lane & 3) * 8 + (4 * hi + ((lane & 15) >> 2)) * 64;
#pragma unroll
    for (int d0 = 0; d0 < 2; ++d0)
#pragma unroll
        for (int ks = 0; ks < 4; ++ks) {
            const s16x4 lo = vtr(vp + d0 * 4096 + ks * 1024), hh = vtr(vp + d0 * 4096 + ks * 1024 + 512);
            vf[d0 * 4 + ks] = (bf16x8){lo[0], lo[1], lo[2], lo[3], hh[0], hh[1], hh[2], hh[3]};
        }
}
#define V16_TO_ARR(v, a, o) do { a[(o) + 0] = v[0]; a[(o) + 1] = v[1]; a[(o) + 2] = v[2]; a[(o) + 3] = v[3]; a[(o) + 4] = v[4]; a[(o) + 5] = v[5]; a[(o) + 6] = v[6]; a[(o) + 7] = v[7]; \
    a[(o) + 8] = v[8]; a[(o) + 9] = v[9]; a[(o) + 10] = v[10]; a[(o) + 11] = v[11]; a[(o) + 12] = v[12]; a[(o) + 13] = v[13]; a[(o) + 14] = v[14]; a[(o) + 15] = v[15]; } while (0)
__device__ __forceinline__ f32x16 splat16(float x) { return (f32x16){x, x, x, x, x, x, x, x, x, x, x, x, x, x, x, x}; }
struct AttnState { f32x16 o[2]; float m, l, pend; bool started; };
constexpr float ATT_THR = 8.0f;
__device__ __forceinline__ void softmax_pv(AttnState& st, float (&sc)[32], const bf16x8 (&vf)[8], MLAS float* wsf, int lane, int r32, int hi) {
    if (__any(st.pend != 0.f)) {
#pragma unroll
        for (int r = 0; r < 32; ++r) sc[r] -= st.pend;
    }
    st.pend = 0.f;
    float ra = __builtin_fmaxf(__builtin_fmaxf(sc[0], sc[1]), sc[2]), rb = __builtin_fmaxf(__builtin_fmaxf(sc[3], sc[4]), sc[5]);
#pragma unroll
    for (int r = 6; r < 30; r += 4) { ra = __builtin_fmaxf(__builtin_fmaxf(ra, sc[r]), sc[r + 1]); rb = __builtin_fmaxf(__builtin_fmaxf(rb, sc[r + 2]), sc[r + 3]); }
    float rm = __builtin_fmaxf(__builtin_fmaxf(ra, rb), __builtin_fmaxf(sc[30], sc[31]));
    rm = halves_max_f(rm);
    const bool fresh = !st.started;
    const bool need = (rm > ATT_THR) || (fresh && rm < -ATT_THR && rm > -1e29f);
    st.started = st.started || (rm > -1e29f);
    if (__any(need)) {
        const float dl = need ? rm : 0.f;
        st.m += dl; st.pend = dl;
#pragma unroll
        for (int r = 0; r < 32; ++r) sc[r] -= dl;
        const float alpha = fresh ? 1.0f : __builtin_amdgcn_exp2f(-dl);
        st.l *= alpha;
        if (hi == 0) wsf[r32] = alpha;
        float fr_[16];
#pragma unroll
        for (int r = 0; r < 16; ++r) fr_[r] = wsf[crow(r, hi)];
        const f32x16 fv = {fr_[0], fr_[1], fr_[2], fr_[3], fr_[4], fr_[5], fr_[6], fr_[7], fr_[8], fr_[9], fr_[10], fr_[11], fr_[12], fr_[13], fr_[14], fr_[15]};
        st.o[0] = st.o[0] * fv; st.o[1] = st.o[1] * fv;
    }
    float pe[32]; float s0 = 0.f, s1 = 0.f;
#pragma unroll
    for (int r = 0; r < 32; r += 2) { pe[r] = __builtin_amdgcn_exp2f(sc[r]); pe[r + 1] = __builtin_amdgcn_exp2f(sc[r + 1]); s0 += pe[r]; s1 += pe[r + 1]; }
    st.l += s0 + s1;
    u32x4 pw[4];
#pragma unroll
    for (int k = 0; k < 4; ++k) pw[k] = (u32x4){cvtpk(pe[8 * k + 0], pe[8 * k + 1]), cvtpk(pe[8 * k + 2], pe[8 * k + 3]), cvtpk(pe[8 * k + 4], pe[8 * k + 5]), cvtpk(pe[8 * k + 6], pe[8 * k + 7])};
#pragma unroll
    for (int d0 = 0; d0 < 2; ++d0)
#pragma unroll
        for (int ks = 0; ks < 4; ++ks) st.o[d0] = __builtin_amdgcn_mfma_f32_32x32x16_bf16(__builtin_bit_cast(bf16x8, pw[ks]), vf[d0 * 4 + ks], st.o[d0], 0, 0, 0);
}
__device__ __forceinline__ void attn_store(AttnState& st, bf16_t* Ow, int pitch, MLAS float* wsf, MLAS bf16_t* stg, int lane, int r32, int hi) {
    float l = halves_sum_f(st.l);
    if (hi == 0) wsf[32 + r32] = l;
    float rli[16];
#pragma unroll
    for (int r = 0; r < 16; ++r) rli[r] = 1.0f / wsf[32 + crow(r, hi)];
#pragma unroll
    for (int r = 0; r < 16; ++r) { const int orow = crow(r, hi);
#pragma unroll
        for (int d0 = 0; d0 < 2; ++d0) { const unsigned short b = (unsigned short)(cvtpk(st.o[d0][r] * rli[r], 0.f) & 0xffffu); stg[orow * 64 + d0 * 32 + r32] = b; } }
#pragma unroll
    for (int i = 0; i < 4; ++i) { const int row = i * 8 + (lane >> 3), ch = lane & 7; const u32x4 v = *(const MLAS u32x4*)(stg + row * 64 + ch * 8); *(u32x4*)(Ow + (size_t)row * pitch + ch * 8) = v; }
}

#ifndef DBG_REP_BS
#define DBG_REP_BS 1
#endif
__device__ __forceinline__ unsigned pk_sub_sat_u16(unsigned a, unsigned b) { unsigned r; asm("v_pk_sub_u16 %0, %1, %2 clamp" : "=v"(r) : "v"(a), "v"(b)); return r; }
__device__ __forceinline__ unsigned pk_min_u16(unsigned a, unsigned b) { unsigned r; asm("v_pk_min_u16 %0, %1, %2" : "=v"(r) : "v"(a), "v"(b)); return r; }
__device__ __forceinline__ unsigned pk_add_u16(unsigned a, unsigned b) { unsigned r; asm("v_pk_add_u16 %0, %1, %2" : "=v"(r) : "v"(a), "v"(b)); return r; }
__device__ __forceinline__ unsigned pk_ashr_i16(unsigned a, unsigned sh2) { unsigned r; asm("v_pk_ashrrev_i16 %0, %1, %2" : "=v"(r) : "v"(sh2), "v"(a)); return r; }
__device__ __forceinline__ unsigned score_keys(float a, float b) {
    const unsigned p = __builtin_bit_cast(unsigned, __builtin_amdgcn_cvt_pkrtz(a, b));
    const unsigned m = pk_ashr_i16(p, 0x000f000fu);
    return p ^ (m | 0x80008000u);
}
template <int NS> __device__ __forceinline__ unsigned bit_search(const unsigned (&kp)[8][8], MLAS unsigned* cntx, int wid, int r32, int hi) {
    unsigned tau = 0u;
#pragma unroll 1
    for (int bit = 15; bit >= 0; --bit) {
        const unsigned cand = tau | (1u << bit);
        const unsigned c2 = (cand - 1u) * 0x00010001u;
        unsigned cnt2 = 0;
#pragma unroll
        for (int jj = 0; jj < NS; ++jj)
#pragma unroll
            for (int r = 0; r < 8; ++r) cnt2 = pk_add_u16(cnt2, pk_min_u16(pk_sub_sat_u16(kp[jj][r], c2), 0x00010001u));
        unsigned cnt = (cnt2 & 0xffffu) + (cnt2 >> 16);
        cnt = halves_add_u(cnt);
        MLAS unsigned* cb = cntx + (bit & 1) * 256;
        if (hi == 0) cb[wid * 32 + r32] = cnt;
        LGKM_BAR();
        unsigned tot = 0;
#pragma unroll
        for (int w = 0; w < 8; ++w) tot += cb[w * 32 + r32];
        if (tot >= 256u) tau = cand;
    }
    return tau;
}
__device__ __forceinline__ void dsa_select(int b, int qg, const bf16_t* Z0, char* shm, const int wave_s) {
    const int tid_ = wave_s * 64 + lane_opaque(); const int tid = tid_, lane = tid & 63, r32 = lane & 31, hi = lane >> 5; const int wid = __builtin_amdgcn_readfirstlane(tid >> 6);
    MLAS char* L = (MLAS char*)shm;
    const int c = qg >> 1, nkeys = 64 * (c + 1), nt32 = nkeys >> 5, nt64 = nkeys >> 6;
    const size_t rowb = (size_t)b * SEQ;
    const size_t tok0 = rowb + 32 * qg;
    MLAS unsigned* selw = (MLAS unsigned*)(L + LX_SEL);
    if (nkeys <= 256) {
        for (int i = tid; i < 64 * 32; i += 512) selw[i] = (i < nt32 * 32) ? 0xffffffffu : 0u;
    } else {
        {
            MLAS u32x4* iqL = (MLAS u32x4*)(L + LX_IQ);
            for (int i = tid; i < 1024; i += 512) { const int q = i & 31, hh = (i >> 5) & 1, d0 = (i >> 6) & 3, h = i >> 8;
                iqL[i] = *(const u32x4*)(Z0 + (tok0 + q) * EV_N + 1280 + 64 * h + 16 * d0 + 8 * hh); }
        }
        float w4[4];
        { const u32x2 ww = *(const u32x2*)(Z0 + (tok0 + r32) * EV_N + 1216);
          w4[0] = pg8::bf_lo(ww.x) * 0.0625f; w4[1] = pg8::bf_hi(ww.x) * 0.0625f; w4[2] = pg8::bf_lo(ww.y) * 0.0625f; w4[3] = pg8::bf_hi(ww.y) * 0.0625f; }
        LGKM_BAR();
        unsigned kp[8][8];
        const int nslots = (nt32 + 7) >> 3;
        const MLAS bf16x8* iqf = (const MLAS bf16x8*)(L + LX_IQ) + hi * 32 + r32;
#pragma unroll
        for (int jj = 0; jj < 8; ++jj) {
            const int j = wid + 8 * jj;
            if (j < nt32) {
                const bf16_t* ikp = Z0 + (rowb + 32 * j + r32) * EV_N + 1152 + 8 * hi;
                bf16x8 af[4];
#pragma unroll
                for (int d0 = 0; d0 < 4; ++d0) af[d0] = *(const bf16x8*)(ikp + 16 * d0);
                f32x16 ah[4];
#pragma unroll
                for (int h = 0; h < 4; ++h) {
                    f32x16 a = {};
#pragma unroll
                    for (int d0 = 0; d0 < 4; ++d0) a = __builtin_amdgcn_mfma_f32_32x32x16_bf16(af[d0], iqf[(h * 4 + d0) * 64], a, 0, 0, 0);
                    ah[h] = a;
                }
                float sv[16];
                {
                    float a0[16], a1[16], a2[16], a3[16];
                    V16_TO_ARR(ah[0], a0, 0); V16_TO_ARR(ah[1], a1, 0); V16_TO_ARR(ah[2], a2, 0); V16_TO_ARR(ah[3], a3, 0);
#pragma unroll
                    for (int r = 0; r < 16; ++r) sv[r] = ((__builtin_fmaxf(a0[r], 0.f) * w4[0] + __builtin_fmaxf(a1[r], 0.f) * w4[1]) + __builtin_fmaxf(a2[r], 0.f) * w4[2]) + __builtin_fmaxf(a3[r], 0.f) * w4[3];
                }
#pragma unroll
                for (int r = 0; r < 8; ++r) kp[jj][r] = score_keys(sv[r], sv[r + 8]);
            } else {
#pragma unroll
                for (int r = 0; r < 8; ++r) kp[jj][r] = 0u;
            }
        }
        MLAS unsigned* cntx = (MLAS unsigned*)(L + L_OST);
        unsigned tau;
        for (int rep_ = 0; rep_ < DBG_REP_BS; ++rep_)
        switch (nslots) {
            case 2: tau = bit_search<2>(kp, cntx, wid, r32, hi); break;
            case 3: tau = bit_search<3>(kp, cntx, wid, r32, hi); break;
            case 4: tau = bit_search<4>(kp, cntx, wid, r32, hi); break;
            case 5: tau = bit_search<5>(kp, cntx, wid, r32, hi); break;
            case 6: tau = bit_search<6>(kp, cntx, wid, r32, hi); break;
            case 7: tau = bit_search<7>(kp, cntx, wid, r32, hi); break;
            default: tau = bit_search<8>(kp, cntx, wid, r32, hi); break;
        }
        MLAS unsigned* gtw = (MLAS unsigned*)(L + LX_GT); MLAS unsigned* eqw = (MLAS unsigned*)(L + LX_EQ); MLAS unsigned* pfx = (MLAS unsigned*)(L + LX_PFX);
        const unsigned tg = tau * 0x00010001u, te = (tau - 1u) * 0x00010001u;
#pragma unroll
        for (int jj = 0; jj < 8; ++jj) {
            const int j = wid + 8 * jj;
            if (j < nt32) {
                unsigned g = 0, e = 0;
#pragma unroll
                for (int r = 0; r < 8; ++r) {
                    const unsigned dgt = pk_min_u16(pk_sub_sat_u16(kp[jj][r], tg), 0x00010001u), dge = pk_min_u16(pk_sub_sat_u16(kp[jj][r], te), 0x00010001u);
                    const int pos = (r & 3) + 8 * (r >> 2);
                    g |= dgt << pos; e |= (dge - dgt) << pos;
                }
                g <<= 4 * hi; e <<= 4 * hi;
                g = halves_or_u(g); e = halves_or_u(e);
                if (hi == 0) { gtw[j * 32 + r32] = g; eqw[j * 32 + r32] = e; }
            }
        }
        LGKM_BAR();
        if (wid == 0 && hi == 0) {
            unsigned cg = 0;
            for (int j = 0; j < nt32; ++j) cg += __builtin_popcount(gtw[j * 32 + r32]);
            const int need = 256 - (int)cg;
            int run = 0;
            for (int j = 0; j < nt32; ++j) { const unsigned e = eqw[j * 32 + r32]; int k = need - run; k = k < 0 ? 0 : (k > 32 ? 32 : k); pfx[j * 32 + r32] = (unsigned)k; run += __builtin_popcount(e); }
        }
        LGKM_BAR();
        for (int i = tid; i < nt32 * 32; i += 512) {
            const unsigned g = gtw[i], e = eqw[i]; const int k = (int)pfx[i];
            unsigned take = 0;
            if (e != 0u && k > 0) {
                unsigned rem = e; int cntk = 0;
                while (rem != 0u && cntk < k) { const unsigned low = rem & (0u - rem); take |= low; rem ^= low; ++cntk; }
            }
            selw[i] = g | take;
        }
        for (int i = nt32 * 32 + tid; i < 64 * 32; i += 512) selw[i] = 0u;
    }
    WAITV_BAR();
}

__device__ __forceinline__ void fox_unit(int b, int h, int qb, const bf16_t* Z1, const float* F, const float* bfp, bf16_t* Y, char* shm, unsigned lds0, const int wave_s) {
    const int tid_ = wave_s * 64 + lane_opaque(); const int tid = tid_, lane = tid & 63, r32 = lane & 31, hi = lane >> 5; const int wid = __builtin_amdgcn_readfirstlane(tid >> 6);
    MLAS char* L = (MLAS char*)shm;
    const size_t rowb = (size_t)b * SEQ;
    const int NT = 4 * (qb + 1), nk = 64 * NT;
    MLAS float* cum2 = (MLAS float*)(L + L_X);
    MLAS float* wtot = (MLAS float*)(L + L_X + 8192);
    const bf16_t* Kb = Z1 + rowb * Z1P + 512 + 64 * h; const bf16_t* Vb = Z1 + rowb * Z1P + 1024 + 64 * h;
#pragma unroll
    for (int i = 0; i < 3; ++i) dma_kv(Kb + (size_t)64 * i * Z1P, Vb + (size_t)64 * i * Z1P, Z1P, lds0, i, wid, lane);
    {
        const float bias = bfp[h];
        const int s0 = 4 * tid;
        float v[4]; float run = 0.f;
#pragma unroll
        for (int i = 0; i < 4; ++i) {
            float x = 0.f;
            if (s0 + i < nk) x = F[(rowb + s0 + i) * 8 + h] + bias;
            const float ls = (s0 + i < nk) ? (fminf(x, 0.f) - log1pf(expf(-fabsf(x)))) : 0.f;
            run += ls; v[i] = run;
        }
        float inc = run;
#pragma unroll
        for (int o = 1; o < 64; o <<= 1) { const int ln = lane_opaque(); const float t = __builtin_bit_cast(float, __builtin_amdgcn_ds_bpermute((ln - o) << 2, __builtin_bit_cast(int, inc))); if (ln >= o) inc += t; }
        if (lane == 63) wtot[wid] = inc;
        LGKM_BAR();
        float off = inc - run;
        for (int w = 0; w < wid; ++w) off += wtot[w];
#pragma unroll
        for (int i = 0; i < 4; ++i) cum2[s0 + i] = (off + v[i]) * 1.4426950408889634f;
    }
    const int tq = 256 * qb + 32 * wid + r32;
    bf16x8 qr[4];
#pragma unroll
    for (int d0 = 0; d0 < 4; ++d0) qr[d0] = *(const bf16x8*)(Z1 + (rowb + tq) * Z1P + 64 * h + 16 * d0 + 8 * hi);
    AttnState st; st.o[0] = f32x16{}; st.o[1] = f32x16{}; st.m = 0.f; st.l = 0.f; st.pend = 0.f; st.started = false;
    MLAS float* wsf = (MLAS float*)(L + L_WSF) + wid * 64;
    WAITV_BAR();
    const float cq2 = cum2[tq];
    const int tlast = 4 * qb + (wid >> 1);
    f32x16 s0, s1;
    qkt(s0, s1, (lds_cptr)(L + L_K), qr, splat16(-st.m), r32, hi);
    for (int t = 0; t < NT; ++t) {
        const int slot = t & 3;
        { const int tt = (t + 3 < NT) ? t + 3 : NT - 1; dma_kv(Kb + (size_t)64 * tt * Z1P, Vb + (size_t)64 * tt * Z1P, Z1P, lds0, (t + 3) & 3, wid, lane); }
        bf16x8 kf[8], vf[8];
        kload(kf, (lds_cptr)(L + L_K + ((t + 1) & 3) * SLOTB), r32, hi);
        __builtin_amdgcn_sched_barrier(0);
        vload(vf, (lds_cptr)(L + L_V + slot * SLOTB), lane, hi);
        const MLAS float* cb = cum2 + 64 * t + 4 * hi;
        f32x4 c0[4], c1[4];
#pragma unroll
        for (int g = 0; g < 4; ++g) { c0[g] = *(const MLAS f32x4*)(cb + 8 * g); c1[g] = *(const MLAS f32x4*)(cb + 32 + 8 * g); }
        f32x16 n0, n1;
        qkt_mma(n0, n1, kf, qr, splat16(-st.m));
        float sc[32];
        V16_TO_ARR(s0, sc, 0); V16_TO_ARR(s1, sc, 16);
#pragma unroll
        for (int g = 0; g < 4; ++g) {
            sc[4 * g + 0] += cq2 - c0[g].x; sc[4 * g + 1] += cq2 - c0[g].y; sc[4 * g + 2] += cq2 - c0[g].z; sc[4 * g + 3] += cq2 - c0[g].w;
            sc[16 + 4 * g + 0] += cq2 - c1[g].x; sc[16 + 4 * g + 1] += cq2 - c1[g].y; sc[16 + 4 * g + 2] += cq2 - c1[g].z; sc[16 + 4 * g + 3] += cq2 - c1[g].w;
        }
        if (t >= tlast) {
            const int qrel = tq - 64 * t;
#pragma unroll
            for (int r = 0; r < 16; ++r) { const int kr = crow(r, hi); if (kr > qrel) sc[r] = -INFINITY; if (kr + 32 > qrel) sc[16 + r] = -INFINITY; }
        }
        softmax_pv(st, sc, vf, wsf, lane, r32, hi);
        s0 = n0; s1 = n1;
        WAITV2_BAR();
    }
    attn_store(st, Y + (rowb + 256 * qb + 32 * wid) * DMODEL + 64 * h, DMODEL, wsf, (MLAS bf16_t*)(L + L_OST) + wid * 2048, lane, r32, hi);
    WAITV_BAR();
}

__device__ __forceinline__ void sgu_unit(int b, int n, int g, const bf16_t* Z1, const float* sst, const float* lng, const float* lnb, const bf16_t* Wm, const float* bs, bf16_t* Y, char* shm, const int wave_s) {
    const int tid_ = wave_s * 64 + lane_opaque(); const int tid = tid_, lane = tid & 63, r32 = lane & 31, hi = lane >> 5; const int wid = __builtin_amdgcn_readfirstlane(tid >> 6);
    MLAS char* L = (MLAS char*)shm;
    MLAS bf16_t* vn = (MLAS bf16_t*)L;
    constexpr int VP = 136;
    const size_t tok0 = (size_t)b * SEQ + 128 * n;
    {
        const int j = tid >> 2, cq = (tid & 3) * 32;
        const float* sp = sst + (tok0 + j) * 16;
        float s1 = 0.f, s2 = 0.f;
#pragma unroll
        for (int k = 0; k < 8; ++k) { s1 += sp[2 * k]; s2 += sp[2 * k + 1]; }
        const float mu = s1 * (1.0f / 512.0f); const float var = fmaxf(s2 * (1.0f / 512.0f) - mu * mu, 0.f);
        const float rstd = 1.0f / sqrtf(var + RMS_EPS);
        const bf16_t* vp = Z1 + (tok0 + j) * Z1P + 2048 + 128 * g + cq;
#pragma unroll
        for (int k = 0; k < 4; ++k) {
            const u32x4 w = *(const u32x4*)(vp + 8 * k);
            const int cc = 128 * g + cq + 8 * k;
            const f32x4 g0 = *(const f32x4*)(lng + cc), g1 = *(const f32x4*)(lng + cc + 4), b0 = *(const f32x4*)(lnb + cc), b1 = *(const f32x4*)(lnb + cc + 4);
            float x[8] = {pg8::bf_lo(w.x), pg8::bf_hi(w.x), pg8::bf_lo(w.y), pg8::bf_hi(w.y), pg8::bf_lo(w.z), pg8::bf_hi(w.z), pg8::bf_lo(w.w), pg8::bf_hi(w.w)};
            float y[8];
#pragma unroll
            for (int i = 0; i < 4; ++i) { y[i] = (x[i] - mu) * rstd * g0[i] + b0[i]; y[4 + i] = (x[4 + i] - mu) * rstd * g1[i] + b1[i]; }
            u32x4 o; o.x = cvtpk(y[0], y[1]); o.y = cvtpk(y[2], y[3]); o.z = cvtpk(y[4], y[5]); o.w = cvtpk(y[6], y[7]);
            *(MLAS u32x4*)(vn + j * VP + cq + 8 * k) = o;
        }
    }
    LGKM_BAR();
    MLAS bf16_t* ut = (MLAS bf16_t*)(L + 128 * VP * 2);
    {
        const int j = tid >> 2, cq = (tid & 3) * 32;
        const bf16_t* up = Z1 + (tok0 + j) * Z1P + 1536 + 128 * g + cq;
#pragma unroll
        for (int k = 0; k < 4; ++k) *(MLAS u32x4*)(ut + j * VP + cq + 8 * k) = *(const u32x4*)(up + 8 * k);
    }
    LGKM_BAR();
    const int ib = wid & 3;
    const bf16_t* wrow = Wm + ((size_t)g * 128 + 32 * ib + r32) * 128 + 8 * hi;
    bf16x8 af[8];
#pragma unroll
    for (int s = 0; s < 8; ++s) af[s] = *(const bf16x8*)(wrow + 16 * s);
#pragma unroll
    for (int cbi = 0; cbi < 2; ++cbi) {
        const int cb = (wid >> 2) * 2 + cbi;
        f32x16 acc = {};
        lds_cptr bp = (lds_cptr)(vn) + ((size_t)(8 * hi + ((lane & 15) >> 2)) * VP + 32 * cb + 16 * ((lane >> 4) & 1) + 4 * (lane & 3)) * 2;
#pragma unroll
        for (int s = 0; s < 8; ++s) {
            const s16x4 lo = vtr(bp + (16 * s) * VP * 2), hh = vtr(bp + (16 * s + 4) * VP * 2);
            const bf16x8 bfr = {lo[0], lo[1], lo[2], lo[3], hh[0], hh[1], hh[2], hh[3]};
            acc = __builtin_amdgcn_mfma_f32_32x32x16_bf16(af[s], bfr, acc, 0, 0, 0);
        }
        float a16[16]; V16_TO_ARR(acc, a16, 0);
#pragma unroll
        for (int r = 0; r < 16; ++r) {
            const int i = 32 * ib + crow(r, hi), cc = 32 * cb + r32;
            const float uu = __builtin_bit_cast(float, (unsigned)ut[i * VP + cc] << 16);
            const float o = uu * (a16[r] + bs[g * 128 + i]);
            ut[i * VP + cc] = (bf16_t)(cvtpk(o, 0.f) & 0xffffu);
        }
    }
    LGKM_BAR();
    {
        const int j = tid >> 2, cq = (tid & 3) * 32;
        bf16_t* yp = Y + (tok0 + j) * DMODEL + 512 + 128 * g + cq;
#pragma unroll
        for (int k = 0; k < 4; ++k) *(u32x4*)(yp + 8 * k) = *(const MLAS u32x4*)(ut + j * VP + cq + 8 * k);
    }
    LGKM_BAR();
}

__device__ __forceinline__ void pool_item(int item, const bf16_t* Z0, bf16_t* Y) {
    const int row = item >> 6, ch = item & 63, c0 = ch * 8, g = ch >> 4;
    const int w = 2 << g, tpos = row & (SEQ - 1);
    const int cnt = (tpos + 1 < w) ? tpos + 1 : w;
    u32x4 v[16];
#pragma unroll
    for (int k = 0; k < 16; ++k) { v[k] = (u32x4){0u, 0u, 0u, 0u}; if (k < cnt) v[k] = *(const u32x4*)(Z0 + (size_t)(row - k) * EV_N + c0); }
    float s[8] = {0.f, 0.f, 0.f, 0.f, 0.f, 0.f, 0.f, 0.f};
#pragma unroll
    for (int k = 0; k < 16; ++k) {
        s[0] += pg8::bf_lo(v[k].x); s[1] += pg8::bf_hi(v[k].x); s[2] += pg8::bf_lo(v[k].y); s[3] += pg8::bf_hi(v[k].y);
        s[4] += pg8::bf_lo(v[k].z); s[5] += pg8::bf_hi(v[k].z); s[6] += pg8::bf_lo(v[k].w); s[7] += pg8::bf_hi(v[k].w);
    }
    const float self[8] = {pg8::bf_lo(v[0].x), pg8::bf_hi(v[0].x), pg8::bf_lo(v[0].y), pg8::bf_hi(v[0].y), pg8::bf_lo(v[0].z), pg8::bf_hi(v[0].z), pg8::bf_lo(v[0].w), pg8::bf_hi(v[0].w)};
    const float inv = 1.0f / (float)cnt;
    u32x4 o; o.x = cvtpk(s[0] * inv - self[0], s[1] * inv - self[1]); o.y = cvtpk(s[2] * inv - self[2], s[3] * inv - self[3]);
    o.z = cvtpk(s[4] * inv - self[4], s[5] * inv - self[5]); o.w = cvtpk(s[6] * inv - self[6], s[7] * inv - self[7]);
    *(u32x4*)(Y + (size_t)row * DMODEL + c0) = o;
}
}
namespace foxa {
using bf16=__hip_bfloat16;
using bf16x8=__attribute__((ext_vector_type(8)))short;
using s16x4=__attribute__((ext_vector_type(4)))short;
using f32x16=__attribute__((ext_vector_type(16)))float;
using u32x4=__attribute__((ext_vector_type(4)))unsigned;
using f32x4v=__attribute__((ext_vector_type(4)))float;
constexpr int CUM_OFF=86016;
constexpr int SEQL=2048,D=64,OPI=1024;
constexpr int NW=8,QBLK=32,QB=QBLK*NW,KVBLK=64;
__device__ __forceinline__ int crow(int r,int hi){return (r&3)+8*(r>>2)+4*hi;}
#define SBAR() __builtin_amdgcn_sched_barrier(0)
__device__ __forceinline__ void cmask(f32x16&p0,f32x16&p1,int jb,int qrel,int hi){
  const float NEG=-INFINITY; int kb=64*jb+4*hi;
  #pragma unroll
  for(int r=0;r<16;++r){int kv=kb+(r&3)+8*(r>>2); if(kv>qrel)p0[r]=NEG; if(kv+32>qrel)p1[r]=NEG;}
}

constexpr int NSLOT=3, SLOTB=8192;
constexpr int LDS_K=0, LDS_V=NSLOT*SLOTB, LDS_WS=2*NSLOT*SLOTB, LDS_OST=LDS_WS+NW*64*4, LDS_BYTES=LDS_OST+NW*4096;
constexpr float C2=0.125f*1.4426950408889634f;
__device__ __forceinline__ void glds16(const void*gsrc,unsigned lds_dst){unsigned keep;
  asm volatile("s_mov_b32 %0, m0\n\ts_mov_b32 m0, %2\n\ts_nop 0\n\tglobal_load_lds_dwordx4 %1, off\n\ts_mov_b32 m0, %0":"=&s"(keep):"v"(gsrc),"s"(lds_dst):"memory");}
__device__ __forceinline__ float max3f(float a,float b,float c){float r;asm("v_max3_f32 %0, %1, %2, %3":"=v"(r):"v"(a),"v"(b),"v"(c));return r;}
__device__ __forceinline__ float max2f(float a,float b){float r;asm("v_max_f32_e32 %0, %1, %2":"=v"(r):"v"(a),"v"(b));return r;}
__device__ __forceinline__ float fadd_s(float a,float b){float r;asm("v_add_f32_e32 %0, %1, %2":"=v"(r):"v"(a),"v"(b));return r;}
__device__ __forceinline__ float fsub_s(float a,float b){float r;asm("v_sub_f32_e32 %0, %1, %2":"=v"(r):"v"(a),"v"(b));return r;}
typedef float f32x2_t __attribute__((ext_vector_type(2))); typedef __bf16 bf16x2_t __attribute__((ext_vector_type(2)));
__device__ __forceinline__ unsigned cvtpk_s(float lo,float hi){f32x2_t v={lo,hi};bf16x2_t b=__builtin_convertvector(v,bf16x2_t);return __builtin_bit_cast(unsigned,b);}
#define WAIT_BAR(N) asm volatile("s_waitcnt vmcnt(" #N ") lgkmcnt(0)\n\ts_barrier":::"memory")

__device__ __forceinline__ void qkt(f32x16&p0,f32x16&p1,const char*Kslot,const bf16x8*qr,const f32x16&negm,int r32,int hi){
  const char*kb=Kslot+hi*1024+r32*16;
  #pragma unroll
  for(int d0=0;d0<4;++d0){
    const bf16x8 b0=*reinterpret_cast<const bf16x8*>(kb+d0*2048);
    const bf16x8 b1=*reinterpret_cast<const bf16x8*>(kb+d0*2048+512);
    if(d0==0){p0=__builtin_amdgcn_mfma_f32_32x32x16_bf16(b0,qr[0],negm,0,0,0);p1=__builtin_amdgcn_mfma_f32_32x32x16_bf16(b1,qr[0],negm,0,0,0);}
    else{p0=__builtin_amdgcn_mfma_f32_32x32x16_bf16(b0,qr[d0],p0,0,0,0);p1=__builtin_amdgcn_mfma_f32_32x32x16_bf16(b1,qr[d0],p1,0,0,0);}}
}
typedef __attribute__((address_space(3))) const char* lds_cptr;
typedef short v4i16_t __attribute__((ext_vector_type(4)));
__device__ __forceinline__ void kload8(bf16x8*kf,lds_cptr kp){
  kf[0]=*(const __attribute__((address_space(3))) bf16x8*)(kp);      kf[1]=*(const __attribute__((address_space(3))) bf16x8*)(kp+512);
  kf[2]=*(const __attribute__((address_space(3))) bf16x8*)(kp+2048); kf[3]=*(const __attribute__((address_space(3))) bf16x8*)(kp+2560);
  kf[4]=*(const __attribute__((address_space(3))) bf16x8*)(kp+4096); kf[5]=*(const __attribute__((address_space(3))) bf16x8*)(kp+4608);
  kf[6]=*(const __attribute__((address_space(3))) bf16x8*)(kp+6144); kf[7]=*(const __attribute__((address_space(3))) bf16x8*)(kp+6656);
}
__device__ __forceinline__ void kload2(bf16x8*kf,lds_cptr kp,int j){ kf[2*j]=*(const __attribute__((address_space(3))) bf16x8*)(kp+j*2048); kf[2*j+1]=*(const __attribute__((address_space(3))) bf16x8*)(kp+j*2048+512); }
__device__ __forceinline__ s16x4 vtr(lds_cptr p){ return __builtin_bit_cast(s16x4,__builtin_amdgcn_ds_read_tr16_b64_v4i16((__attribute__((address_space(3))) v4i16_t*)p)); }
__device__ __forceinline__ float rowmax(const f32x16&p0,const f32x16&p1){
  float a=max3f(p0[0],p0[1],p1[0]),b=max3f(p0[2],p0[3],p1[1]);a=max3f(a,p1[2],p1[3]);
  #pragma unroll
  for(int r=4;r<16;r+=4){a=max3f(a,p0[r],p0[r+1]);b=max3f(b,p0[r+2],p0[r+3]);a=max3f(a,p1[r],p1[r+1]);b=max3f(b,p1[r+2],p1[r+3]);}
  const float m=max2f(a,b);
  auto rr=__builtin_amdgcn_permlane32_swap(__float_as_uint(m),__float_as_uint(m),false,false);
  return max2f(__uint_as_float(rr[0]),__uint_as_float(rr[1]));
}
__device__ __forceinline__ void pv(f32x16*o,int vb,bf16x8 pa0,bf16x8 pa1,bf16x8 pa2,bf16x8 pa3){
  #pragma unroll
  for(int d0=0;d0<2;++d0){s16x4 lo[4],hi[4];
    #pragma unroll
    for(int ks=0;ks<4;++ks){
      asm volatile("ds_read_b64_tr_b16 %0,%1 offset:%c2":"=&v"(lo[ks]):"v"(vb),"i"(d0*4096+ks*1024):"memory");
      asm volatile("ds_read_b64_tr_b16 %0,%1 offset:%c2":"=&v"(hi[ks]):"v"(vb),"i"(d0*4096+ks*1024+512):"memory");}
    asm volatile("s_waitcnt lgkmcnt(0)":::"memory");SBAR();
    #define PK(k) (bf16x8){lo[k][0],lo[k][1],lo[k][2],lo[k][3],hi[k][0],hi[k][1],hi[k][2],hi[k][3]}
    o[d0]=__builtin_amdgcn_mfma_f32_32x32x16_bf16(pa0,PK(0),o[d0],0,0,0);
    o[d0]=__builtin_amdgcn_mfma_f32_32x32x16_bf16(pa1,PK(1),o[d0],0,0,0);
    o[d0]=__builtin_amdgcn_mfma_f32_32x32x16_bf16(pa2,PK(2),o[d0],0,0,0);
    o[d0]=__builtin_amdgcn_mfma_f32_32x32x16_bf16(pa3,PK(3),o[d0],0,0,0);
    #undef PK
  }
}

#ifndef ATTN_STORE16
#define ATTN_STORE16(p,v) (*(u32x4*)(p)=(v))
#endif
template<int THRL,int MODE,int QKVP,class CumFn> __device__ __forceinline__ void attn_unit(CumFn&& CUMFN,int b,int h,int qb,int q0abs,int NTU,const bf16*Q,const bf16*__restrict__ K,const bf16*__restrict__ V,bf16*O,char*shm,const __attribute__((address_space(3))) unsigned*selw,const int wave_s){
  const int tid=wave_s*64+lane_opaque(),lane=tid&63,r32=lane&31,hi=lane>>5; const int wid=__builtin_amdgcn_readfirstlane(tid>>6);
  const long rowbase=(long)b*SEQL; const int q0=(MODE==0)?qb*QB:q0abs;
  const bf16*Qw=(MODE==0)?Q+(rowbase+q0+wid*QBLK)*QKVP+h*D:Q+(rowbase+q0)*QKVP+wid*D;
  const bf16*Kh=K+rowbase*QKVP+h*D,*Vh=V+rowbase*QKVP+h*D;
  const unsigned lds0=(unsigned)(uintptr_t)shm;
  float*wsf=(float*)(shm+LDS_WS)+wid*64;
  const bf16*ksrc=Kh+(long)lane*QKVP+wid*8;
  const bf16*vsrc=Vh+(long)(16*(wid&3)+(lane>>2))*QKVP+(wid>>2)*32+(lane&3)*8;
  const unsigned kdst=lds0+LDS_K+wid*1024, vdst=lds0+LDS_V+wid*1024;
  #define DMA_K(t,slot) glds16(ksrc+(long)(t)*KVBLK*QKVP,(unsigned)__builtin_amdgcn_readfirstlane(kdst+(slot)))
  #define DMA_V(t,slot) glds16(vsrc+(long)(t)*KVBLK*QKVP,(unsigned)__builtin_amdgcn_readfirstlane(vdst+(slot)))
  const int vb0=(int)(lds0+LDS_V)+((lane>>4)&1)*32+(lane&3)*8+(4*hi+((lane&15)>>2))*64;
  const char*Kbase=shm+LDS_K; bf16x8 kf[8];
  const lds_cptr shm3=(lds_cptr)shm; const lds_cptr kp0=shm3+LDS_K+hi*1024+r32*16; const lds_cptr vp0=shm3+LDS_V+((lane>>4)&1)*32+(lane&3)*8+(4*hi+((lane&15)>>2))*64;
  const int NT=(MODE==0)?(q0+QB)/KVBLK:NTU;
  DMA_K(0,0);DMA_V(0,0);DMA_K(1,SLOTB);
  if constexpr(MODE==0){ CUMFN(); }
  bf16x8 qr[4];
  #pragma unroll
  for(int d0=0;d0<4;++d0)qr[d0]=*reinterpret_cast<const bf16x8*>(&Qw[(long)r32*QKVP+d0*16+hi*8]);
  float mhat=0.f,l_reg=0.f;float z_=0.f;asm volatile("":"+v"(z_));f32x16 o[2];o[0]=(f32x16){z_,z_,z_,z_,z_,z_,z_,z_,z_,z_,z_,z_,z_,z_,z_,z_};o[1]=o[0];f32x16 negm=o[0];asm volatile("":"+v"(negm));
  const int qrel=wid*QBLK+r32;
  const __attribute__((address_space(3))) float*cum2=(const __attribute__((address_space(3))) float*)(shm+CUM_OFF);
  const float cq2=(MODE==0)?cum2[q0+qrel]:0.f;
  #define BIAS(P0,P1,t) do{ if constexpr(MODE==0){ const __attribute__((address_space(3))) float*cb_=cum2+64*(t)+4*hi; \
    _Pragma("unroll") for(int g_=0;g_<4;++g_){ const f32x4v c0_=*(const __attribute__((address_space(3))) f32x4v*)(cb_+8*g_), c1_=*(const __attribute__((address_space(3))) f32x4v*)(cb_+32+8*g_); \
      P0[4*g_+0]+=cq2-c0_.x; P0[4*g_+1]+=cq2-c0_.y; P0[4*g_+2]+=cq2-c0_.z; P0[4*g_+3]+=cq2-c0_.w; \
      P1[4*g_+0]+=cq2-c1_.x; P1[4*g_+1]+=cq2-c1_.y; P1[4*g_+2]+=cq2-c1_.z; P1[4*g_+3]+=cq2-c1_.w; } } }while(0)
  #define SELM(P0,P1,t) do{ if constexpr(MODE==1){ const unsigned w0_=selw[(2*(t))*32+r32]>>(4*hi), w1_=selw[(2*(t)+1)*32+r32]>>(4*hi); \
    _Pragma("unroll") for(int r=0;r<16;++r){ const int sh_=(r&3)+8*(r>>2); if(!((w0_>>sh_)&1u))P0[r]=-INFINITY; if(!((w1_>>sh_)&1u))P1[r]=-INFINITY; } } }while(0)
  #define CMASK(P0,P1,t) do{ if constexpr(MODE==0){int jb_=(t)-(NT-4); if(jb_>=0)cmask(P0,P1,jb_,qrel,hi);} }while(0)
  bool resc=false;
  #define START(P0,P1) do{ const float rm=rowmax(P0,P1); resc=false; \
    { const float dl=(MODE==1&&!(rm>-1e30f))?0.f:rm; mhat=fadd_s(mhat,dl); \
      _Pragma("unroll") for(int r=0;r<16;++r){P0[r]=fsub_s(P0[r],dl);P1[r]=fsub_s(P1[r],dl);} \
      _Pragma("unroll") for(int r=0;r<16;++r)negm[r]=-mhat; asm volatile("":"+v"(negm)); } \
    _Pragma("unroll") for(int r=0;r<16;++r)P0[r]=__builtin_amdgcn_exp2f(P0[r]); }while(0)
  #define RESC() do{ if(resc){ asm volatile("s_waitcnt lgkmcnt(0)":::"memory"); \
      _Pragma("unroll") for(int d_=0;d_<2;++d_) _Pragma("unroll") for(int r=0;r<16;++r)o[d_][r]*=wsf[crow(r,hi)]; } }while(0)
  f32x16 pA0,pA1,pB0,pB1;
  int sl_prev=0,sl_cur=0,sl_next=SLOTB;
  #define ROT() do{sl_prev=sl_cur;sl_cur=sl_next;sl_next=(sl_next==(NSLOT-1)*SLOTB)?0:sl_next+SLOTB;}while(0)
  DMA_K(2,2*SLOTB);
  WAIT_BAR(3);
  qkt(pA0,pA1,Kbase,qr,negm,r32,hi);asm volatile("s_nop 15\n\ts_nop 7":"+v"(pA0),"+v"(pA1));BIAS(pA0,pA1,0);SELM(pA0,pA1,0);CMASK(pA0,pA1,0);
  START(pA0,pA1);
  _Pragma("unroll") for(int r=0;r<16;++r)pA1[r]=__builtin_amdgcn_exp2f(pA1[r]);
  WAIT_BAR(0);
  DMA_K(3,0);DMA_V(1,SLOTB);
  ROT();
  kload8(kf,kp0+sl_cur);
  WAIT_BAR(2);
  s16x4 vlo[8],vhi[8]; u32x4 pw0,pw1,pw2,pw3;
  #define PKW(P,B) cvtpk_s(P[B],P[B+1])
  #define PAF(k) __builtin_bit_cast(bf16x8,pw##k)
  #define VFR(i) (bf16x8){vlo[i][0],vlo[i][1],vlo[i][2],vlo[i][3],vhi[i][0],vhi[i][1],vhi[i][2],vhi[i][3]}
  #define PIN(x) asm volatile("":"+v"(x))
  #define MX3(a,b,c) __builtin_fmaxf(__builtin_fmaxf((a),(b)),(c))
  #define GAPA(MF,A0,A1,A2,A3,W0,W1,PW) do{ MF; sacc+=A0; sacc+=A1; sacc+=A2; sacc+=A3; PIN(sacc); W0; W1; PIN(PW); SBAR(); }while(0)
  #define EX(v) __builtin_amdgcn_exp2f(v)
  #define GAPB(MF,X,B) do{ MF; X[B]=EX(X[B]); X[B+1]=EX(X[B+1]); X[B+2]=EX(X[B+2]); X[B+3]=EX(X[B+3]); PIN(X); SBAR(); }while(0)
  #define VRD(i) do{ vlo[i]=vtr(vp_+(((i)>>2)*4096+((i)&3)*1024)); vhi[i]=vtr(vp_+(((i)>>2)*4096+((i)&3)*1024+512)); }while(0)
  #define KRD(G,j) do{ if(G){ kload2(kf,kp0+sl_next,j); SBAR(); } }while(0)
  #define STEP(C0,C1,P0,P1,t,GK,GV,GL) do{ SBAR(); \
    const lds_cptr vp_=vp0+sl_prev; \
    VRD(0); SBAR(); float sacc=(P0[0]+P0[1]); \
    GAPA(C0=__builtin_amdgcn_mfma_f32_32x32x16_bf16(kf[0],qr[0],negm,0,0,0), P0[2],P0[3],P0[4],P0[5],     pw0[0]=PKW(P0,0), pw0[1]=PKW(P0,2), pw0); \
    VRD(4); SBAR(); GAPA(C1=__builtin_amdgcn_mfma_f32_32x32x16_bf16(kf[1],qr[0],negm,0,0,0), P0[6],P0[7],P0[8],P0[9],     pw0[2]=PKW(P0,4), pw0[3]=PKW(P0,6), pw0); \
    VRD(1); SBAR(); GAPA(C0=__builtin_amdgcn_mfma_f32_32x32x16_bf16(kf[2],qr[1],C0,0,0,0),   P0[10],P0[11],P0[12],P0[13], pw1[0]=PKW(P0,8), pw1[1]=PKW(P0,10), pw1); \
    VRD(5); SBAR(); GAPA(C1=__builtin_amdgcn_mfma_f32_32x32x16_bf16(kf[3],qr[1],C1,0,0,0),   P0[14],P0[15],P1[0],P1[1],   pw1[2]=PKW(P0,12),pw1[3]=PKW(P0,14), pw1); \
    VRD(2); SBAR(); GAPA(C0=__builtin_amdgcn_mfma_f32_32x32x16_bf16(kf[4],qr[2],C0,0,0,0),   P1[2],P1[3],P1[4],P1[5],     pw2[0]=PKW(P1,0), pw2[1]=PKW(P1,2), pw2); \
    VRD(6); SBAR(); GAPA(C1=__builtin_amdgcn_mfma_f32_32x32x16_bf16(kf[5],qr[2],C1,0,0,0),   P1[6],P1[7],P1[8],P1[9],     pw2[2]=PKW(P1,4), pw2[3]=PKW(P1,6), pw2); \
    VRD(3); SBAR(); GAPA(C0=__builtin_amdgcn_mfma_f32_32x32x16_bf16(kf[6],qr[3],C0,0,0,0),   P1[10],P1[11],P1[12],P1[13], pw3[0]=PKW(P1,8), pw3[1]=PKW(P1,10), pw3); \
    VRD(7); SBAR(); GAPA(C1=__builtin_amdgcn_mfma_f32_32x32x16_bf16(kf[7],qr[3],C1,0,0,0),   P1[14],P1[15],0.f,0.f,       pw3[2]=PKW(P1,12),pw3[3]=PKW(P1,14), pw3); \
    l_reg+=sacc; \
    if(GK){DMA_K((t)+3,sl_cur);} if(GV){DMA_V((t)+1,sl_next);} \
    BIAS(C0,C1,t); SELM(C0,C1,t); CMASK(C0,C1,t); \
    { float a=MX3(C0[0],C0[1],C1[0]),b=MX3(C0[2],C0[3],C1[1]); a=MX3(a,C1[2],C1[3]); \
      _Pragma("unroll") for(int r=4;r<16;r+=4){a=MX3(a,C0[r],C0[r+1]);b=MX3(b,C0[r+2],C0[r+3]);a=MX3(a,C1[r],C1[r+1]);b=MX3(b,C1[r+2],C1[r+3]);} \
      float rm=__builtin_fmaxf(a,b); { auto rr=__builtin_amdgcn_permlane32_swap(__float_as_uint(rm),__float_as_uint(rm),false,false); rm=__builtin_fmaxf(__uint_as_float(rr[0]),__uint_as_float(rr[1])); } \
      resc=false; \
      if(__builtin_expect(__any(rm>(float)THRL),0)){ const float dl=__builtin_fmaxf(rm,0.f); mhat+=dl; \
        _Pragma("unroll") for(int r=0;r<16;++r){C0[r]-=dl;C1[r]-=dl;} \
        _Pragma("unroll") for(int r=0;r<16;++r)negm[r]=-mhat; asm volatile("":"+v"(negm)); \
        const float f=__builtin_amdgcn_exp2f(-dl); l_reg*=f; if(hi==0)wsf[r32]=f; resc=true; } } \
    SBAR(); \
    GAPB(o[0]=__builtin_amdgcn_mfma_f32_32x32x16_bf16(PAF(0),VFR(0),o[0],0,0,0), C0,0); \
    GAPB(o[1]=__builtin_amdgcn_mfma_f32_32x32x16_bf16(PAF(0),VFR(4),o[1],0,0,0), C0,4); \
    KRD(GL,0); GAPB(o[0]=__builtin_amdgcn_mfma_f32_32x32x16_bf16(PAF(1),VFR(1),o[0],0,0,0), C0,8); \
    KRD(GL,1); GAPB(o[1]=__builtin_amdgcn_mfma_f32_32x32x16_bf16(PAF(1),VFR(5),o[1],0,0,0), C0,12); \
    KRD(GL,2); GAPB(o[0]=__builtin_amdgcn_mfma_f32_32x32x16_bf16(PAF(2),VFR(2),o[0],0,0,0), C1,0); \
    KRD(GL,3); GAPB(o[1]=__builtin_amdgcn_mfma_f32_32x32x16_bf16(PAF(2),VFR(6),o[1],0,0,0), C1,4); \
    GAPB(o[0]=__builtin_amdgcn_mfma_f32_32x32x16_bf16(PAF(3),VFR(3),o[0],0,0,0), C1,8); \
    GAPB(o[1]=__builtin_amdgcn_mfma_f32_32x32x16_bf16(PAF(3),VFR(7),o[1],0,0,0), C1,12); \
    }while(0)
  int t=1;
  #undef CMASK
  #define CMASK(P0,P1,t) do{}while(0)
  for(;t+5<NT;t+=2){
    STEP(pB0,pB1,pA0,pA1,t,true,true,true);     WAIT_BAR(2); RESC(); ROT();
    STEP(pA0,pA1,pB0,pB1,t+1,true,true,true);   WAIT_BAR(2); RESC(); ROT();
  }
  #undef CMASK
  #define CMASK(P0,P1,t) do{ if constexpr(MODE==0){int jb_=(t)-(NT-4); if(jb_>=0)cmask(P0,P1,jb_,qrel,hi);} }while(0)
  #define ENDW(tt) do{ if((tt)+3<NT){WAIT_BAR(2);} else if((tt)+2<NT){WAIT_BAR(1);} else {WAIT_BAR(0);} }while(0)
  for(;t+1<NT;t+=2){
    STEP(pB0,pB1,pA0,pA1,t,(t+3<NT),(t+1<NT),(t+1<NT));       ENDW(t);   RESC(); ROT();
    STEP(pA0,pA1,pB0,pB1,t+1,(t+4<NT),(t+2<NT),(t+2<NT));     ENDW(t+1); RESC(); ROT();
  }
  STEP(pB0,pB1,pA0,pA1,NT-1,false,false,false); RESC();
  { float sacc=pB0[0]+pB0[1]; _Pragma("unroll") for(int r=2;r<16;++r)sacc+=pB0[r]; _Pragma("unroll") for(int r=0;r<16;++r)sacc+=pB1[r]; l_reg+=sacc;
    pw0=(u32x4){PKW(pB0,0),PKW(pB0,2),PKW(pB0,4),PKW(pB0,6)};pw1=(u32x4){PKW(pB0,8),PKW(pB0,10),PKW(pB0,12),PKW(pB0,14)};pw2=(u32x4){PKW(pB1,0),PKW(pB1,2),PKW(pB1,4),PKW(pB1,6)};pw3=(u32x4){PKW(pB1,8),PKW(pB1,10),PKW(pB1,12),PKW(pB1,14)};
    SBAR(); pv(o,vb0+sl_cur,PAF(0),PAF(1),PAF(2),PAF(3)); }
  #undef PKW
  #undef PAF
  #undef VFR
  #undef PIN
  #undef MX3
  #undef GAPA
  #undef GAPB
  #undef EX
  #undef VRD
  #undef KRD
  #undef STEP
  #undef ENDW
  {auto rr=__builtin_amdgcn_permlane32_swap(__float_as_uint(l_reg),__float_as_uint(l_reg),false,false);l_reg=__uint_as_float(rr[0])+__uint_as_float(rr[1]);}
  if(hi==0)wsf[32+r32]=l_reg;asm volatile("s_waitcnt lgkmcnt(0)":::"memory");
  float rli[16];
  #pragma unroll
  for(int r=0;r<16;++r)rli[r]=__builtin_amdgcn_rcpf(wsf[32+crow(r,hi)]);
  bf16*Ow=(MODE==0)?O+(rowbase+q0+wid*QBLK)*OPI+h*D:O+(rowbase+q0)*OPI+wid*D;
  { bf16*stg=(bf16*)(shm+LDS_OST)+wid*2048;
    #pragma unroll
    for(int r=0;r<16;++r){const int orow=crow(r,hi);
      #pragma unroll
      for(int d0=0;d0<2;++d0)stg[orow*64+d0*32+r32]=__float2bfloat16(o[d0][r]*rli[r]);}
    asm volatile("s_waitcnt lgkmcnt(0)":::"memory");
    #pragma unroll
    for(int i=0;i<4;++i){const int row=i*8+(lane>>3),ch=lane&7; const u32x4 v=*(const u32x4*)(stg+row*64+ch*8); ATTN_STORE16(Ow+(long)row*OPI+ch*8,v);} }
  asm volatile("s_waitcnt lgkmcnt(0)\n\ts_barrier":::"memory");
  #undef DMA_K
  #undef DMA_V
  #undef CMASK
  #undef START
  #undef BIAS
  #undef SELM
  #undef RESC
  #undef ROT
}
#undef SBAR
#undef WAIT_BAR
}

#ifndef DBG_REP_SEL
#define DBG_REP_SEL 1
#endif
namespace mix {
__device__ __forceinline__ void fox_unit2(int b, int h, int qb, const bf16_t* Z1, const float* F, const float* bfp, bf16_t* Y, char* shm, const int wave_s) {
    const size_t rowb = (size_t)b * SEQ;
    const int nk = 256 * (qb + 1);
    auto cumfn = [=]() {
        const int tid = wave_s * 64 + lane_opaque(), lane = tid & 63; const int wid = __builtin_amdgcn_readfirstlane(tid >> 6);
        MLAS char* L = (MLAS char*)shm;
        MLAS float* cum2 = (MLAS float*)(L + foxa::CUM_OFF);
        MLAS float* wtot = (MLAS float*)(L + foxa::CUM_OFF + 8192);
        const float bias = bfp[h];
        const int s0 = 4 * tid;
        float v[4]; float run = 0.f;
#pragma unroll
        for (int i = 0; i < 4; ++i) {
            float x = 0.f;
            if (s0 + i < nk) x = F[(rowb + s0 + i) * 8 + h] + bias;
            const float ls = (s0 + i < nk) ? (fminf(x, 0.f) - log1pf(expf(-fabsf(x)))) : 0.f;
            run += ls; v[i] = run;
        }
        float inc = run;
#pragma unroll
        for (int o = 1; o < 64; o <<= 1) { const int ln = lane_opaque(); const float t = __builtin_bit_cast(float, __builtin_amdgcn_ds_bpermute((ln - o) << 2, __builtin_bit_cast(int, inc))); if (ln >= o) inc += t; }
        if (lane == 63) wtot[wid] = inc;
        LGKM_BAR();
        float off = inc - run;
        for (int w = 0; w < wid; ++w) off += wtot[w];
#pragma unroll
        for (int i = 0; i < 4; ++i) cum2[s0 + i] = (off + v[i]) * 1.4426950408889634f;
        LGKM_BAR();
    };
    foxa::attn_unit<8, 0, 2560>(cumfn, b, h, qb, 0, 0, (const foxa::bf16*)Z1, (const foxa::bf16*)(Z1 + 512), (const foxa::bf16*)(Z1 + 1024), (foxa::bf16*)Y, shm, nullptr, wave_s);
}
__device__ __forceinline__ void dsa_unit(int b, int qg, const bf16_t* Z0, bf16_t* Y, char* shm, unsigned lds0, const int wave_s) {
    for (int rep_ = 0; rep_ < DBG_REP_SEL; ++rep_) dsa_select(b, qg, Z0, shm, wave_s);
    const int nt64 = (qg >> 1) + 1; int ntu = (nt64 + 1) & ~1; if (ntu < 4) ntu = 4;
    foxa::attn_unit<8, 1, EV_N>([]() {}, b, 0, 0, 32 * qg, ntu, (const foxa::bf16*)(Z0 + 512), (const foxa::bf16*)(Z0 + 1024), (const foxa::bf16*)(Z0 + 1088), (foxa::bf16*)(Y + 512), shm,
                                (const MLAS unsigned*)((MLAS char*)shm + LX_SEL), wave_s);
}
}
constexpr int NWAVES = 8;
constexpr size_t KiB = 1024, MiB = 1u << 20;
constexpr size_t WS_CTL = 0, CTL_ZERO_BYTES = 1 * MiB;
constexpr size_t WS_W_EVIN = 1 * MiB, WS_W_OUT0 = 4 * MiB, WS_W_FFI0 = 6 * MiB, WS_W_FFO0 = 17 * MiB, WS_W_PG0 = 22 * MiB + 512 * KiB, WS_W_PP0 = 24 * MiB + 512 * KiB;
constexpr size_t WS_W_ODIN = 25 * MiB, WS_W_OUT1 = 30 * MiB + 512 * KiB, WS_W_FFI1 = 32 * MiB + 512 * KiB, WS_W_FFO1 = 43 * MiB + 512 * KiB, WS_W_PG1 = 49 * MiB, WS_W_PP1 = 51 * MiB, WS_W_SGU = 51 * MiB + 512 * KiB;
constexpr size_t WS_RSTD = 57 * MiB + 768 * KiB;
constexpr size_t WS_SSQA = 52 * MiB, WS_SSQB = 53 * MiB, WS_ROPE = 54 * MiB, WS_AH = 55 * MiB, WS_FBUF = 58 * MiB + 512 * KiB, WS_SST = 59 * MiB;
constexpr size_t WS_HB = 60 * MiB, WS_AHALO = 92 * MiB, WS_PP = 92 * MiB + 512 * KiB, WS_Y = 124 * MiB + 512 * KiB, WS_ZH = 156 * MiB + 512 * KiB, WS_PB = 244 * MiB + 512 * KiB, WS_END = 252 * MiB + 512 * KiB;
static_assert(WS_AHALO == WS_HB + (size_t)TOK * 1024 * 2, "the halo rows are row tile 64 of the FFN in-projection A operand");
static_assert(WS_W_EVIN + (size_t)EV_N * 1024 * 2 <= WS_W_OUT0 && WS_W_FFI0 + (size_t)NFF2 * 1024 * 2 <= WS_W_FFO0 && WS_W_FFO0 + (size_t)1024 * DFF * 2 <= WS_W_PG0, "ws map 1");
static_assert(WS_W_ODIN + (size_t)OD_N * 1024 * 2 <= WS_W_OUT1 && WS_W_FFI1 + (size_t)NFF2 * 1024 * 2 <= WS_W_FFO1 && WS_W_FFO1 + (size_t)1024 * DFF * 2 <= WS_W_PG1 && WS_W_SGU + 4 * 128 * 128 * 2 <= WS_SSQA, "ws map 2");
static_assert(WS_AH + (size_t)128 * NFF2 * 4 <= WS_RSTD && WS_ZH + (size_t)TOK * DFF * 2 <= WS_PB && WS_PB + (size_t)TOK * PLE * 2 <= WS_END, "ws map 3");
constexpr int CW_BAR = 4096, CW_FLAG = 8192;
constexpr int RING_BYTES = 131072, XB_OFF = RING_BYTES, LDSCTL_OFF = XB_OFF + 8192 + 1024 + 64, MISC_OFF = LDSCTL_OFF + 320, LDS_BYTES = 147456;
static_assert(MISC_OFF + 128 <= LDS_BYTES, "LDS map");

#define GAS __attribute__((address_space(1)))
#define LAS __attribute__((address_space(3)))
typedef unsigned short bf16;
typedef unsigned v4u __attribute__((ext_vector_type(4)));
typedef float f32x4 __attribute__((ext_vector_type(4)));
typedef float f32x2 __attribute__((ext_vector_type(2)));
#define LDS_WAIT() asm volatile("s_waitcnt lgkmcnt(0)" ::: "memory")
#define VM_WAIT() asm volatile("s_waitcnt vmcnt(0)" ::: "memory")
__device__ __forceinline__ unsigned f2bf(float f) { unsigned u = __builtin_bit_cast(unsigned, f); return (u + 0x7fffu + ((u >> 16) & 1u)) >> 16; }
__device__ __forceinline__ unsigned pk2(float lo, float hi) { return f2bf(lo) | (f2bf(hi) << 16); }

#define XB_TMO      128
#define XB_XCNT(j)  (256  + 64 * (j))
#define XB_XSUB(j)  (1280 + 64 * (j))
#define XB_XGEN(j)  (2304 + 64 * (j))
#define XB_TOP      3328
#define XB_TOPGEN   3392
#define XCD_BAR_WORDS 3456
#define XB_SPIN_CAP (1u << 18)
__device__ __forceinline__ unsigned xb_ld(unsigned* p)              { return __hip_atomic_load(p, __ATOMIC_RELAXED, __HIP_MEMORY_SCOPE_AGENT); }
__device__ __forceinline__ unsigned xb_add(unsigned* p, unsigned v) { return __hip_atomic_fetch_add(p, v, __ATOMIC_RELAXED, __HIP_MEMORY_SCOPE_AGENT); }
__device__ __forceinline__ unsigned xb_xcc_id() { return (unsigned)__builtin_amdgcn_s_getreg((3 << 11) | 20) & 0xFu; }
#define XB_SPIN(cond, bar) do { unsigned _sp = 0; while (cond) { __builtin_amdgcn_s_sleep(1); \
    if ((++_sp & 255u) == 0u) { if (xb_ld(&(bar)[XB_TMO])) break; if (_sp > XB_SPIN_CAP) { atomicAdd(&(bar)[XB_TMO], 1u); break; } } } } while (0)
struct XcdBarrier { unsigned* bar; unsigned x; volatile LAS unsigned* st; };
__device__ __forceinline__ XcdBarrier xcd_barrier_post(unsigned* bar, volatile LAS unsigned* st) {
    XcdBarrier b; b.bar = bar; b.x = xb_xcc_id(); b.st = st;
    if (threadIdx.x == 0) (void)xb_add(&bar[XB_XCNT(b.x)], 1u);
    return b;
}
__device__ __forceinline__ void xcd_barrier_complete(unsigned* bar, unsigned x, unsigned& nloc, unsigned& nx) {
    const unsigned G = gridDim.x * gridDim.y * gridDim.z;
    unsigned sum, cnt, mine, sp = 0u;
    for (;;) {
        sum = 0u; cnt = 0u; mine = 0u;
#pragma unroll 1
        for (unsigned j = 0; j < 16; ++j) { const unsigned c = xb_ld(&bar[XB_XCNT(j)]); sum += c; cnt += (c > 0u) ? 1u : 0u; mine = (j == x) ? c : mine; }
        if (sum == G) break;
        __builtin_amdgcn_s_sleep(1);
        if ((++sp & 255u) == 0u) { if (xb_ld(&bar[XB_TMO])) break; if (sp > XB_SPIN_CAP) { atomicAdd(&bar[XB_TMO], 1u); break; } }
    }
    nloc = mine > 0u ? mine : 1u; nx = cnt > 0u ? cnt : 1u;
}
__device__ __forceinline__ void xcd_barrier(const XcdBarrier& b) {
    asm volatile("s_waitcnt vmcnt(0)" ::: "memory");
    __syncthreads();
    if (threadIdx.x == 0) {
        unsigned* bar = b.bar;
        __builtin_amdgcn_s_waitcnt(0);
        unsigned nloc = b.st[0], nx = b.st[1];
        if (nloc == 0u) { xcd_barrier_complete(bar, b.x, nloc, nx); b.st[0] = nloc; b.st[1] = nx; }
        const unsigned old = xb_add(&bar[XB_XSUB(b.x)], 1u);
        const unsigned gen = old / nloc;
        if (old + 1u == (gen + 1u) * nloc) {
            __builtin_amdgcn_fence(__ATOMIC_RELEASE, "agent");
            asm volatile("s_waitcnt vmcnt(0)" ::: "memory");
            const unsigned og = xb_add(&bar[XB_TOP], 1u);
            const unsigned tg = og / nx;
            if (og + 1u == (tg + 1u) * nx) xb_add(&bar[XB_TOPGEN], 1u);
            else XB_SPIN(xb_ld(&bar[XB_TOPGEN]) == tg, bar);
            __builtin_amdgcn_fence(__ATOMIC_ACQUIRE, "agent");
            xb_add(&bar[XB_XGEN(b.x)], 1u);
            asm volatile("s_waitcnt vmcnt(0)" ::: "memory");
        } else {
            XB_SPIN(xb_ld(&bar[XB_XGEN(b.x)]) == gen, bar);
            __builtin_amdgcn_fence(__ATOMIC_ACQUIRE, "agent");
            asm volatile("s_waitcnt vmcnt(0)" ::: "memory");
        }
    }
    __syncthreads();
}

__device__ __forceinline__ float wave_sum(float v) {
#pragma unroll
    for (int o = 1; o < 64; o <<= 1) v += __builtin_bit_cast(float, __builtin_amdgcn_ds_bpermute((lane_opaque() ^ o) << 2, __builtin_bit_cast(int, v)));
    return v;
}
__device__ __forceinline__ int vcu_of(int i, int n) { return i; }
__device__ __forceinline__ int unperm16(int d) { return d < 16 ? ((d >> 1) + 8 * (d & 1)) : d; }
__device__ __forceinline__ int map_col(int type, int n, int nold) {
    if (type == 0) return n < nold ? n : -1;
    if (type == 1) {
        if (n < 512) return n;
        if (n < 1024) { const int h = (n - 512) >> 6, d = (n - 512) & 63; return 512 + 64 * h + unperm16(d); }
        if (n < 1088) return 1024 + unperm16(n - 1024);
        if (n < 1152) return n;
        if (n < 1216) return 1408 + unperm16(n - 1152);
        if (n < 1220) return 1472 + (n - 1216);
        if (n < 1280) return -1;
        { const int h = (n - 1280) >> 6, d = (n - 1280) & 63; return 1152 + 64 * h + unperm16(d); }
    }
    if (type == 2) {
        if (n < 1536) return n;
        if (n < 2560) return n + 8;
        if (n < 2568) return 1536 + (n - 2560);
        return -1;
    }
    { const int pn = n >> 8, bj = (n >> 7) & 1, jj = n & 127; return bj * DFF + 128 * pn + jj; }
}
struct TJob { const float* W; const float* rowscale; bf16* WT; int K, Nold, Nnew, ldk, koff, type, nitems; };
__device__ __forceinline__ void transpose_item(const TJob& J, LAS float* scr, int item, int lane) {
    const int nblk = J.Nnew / 32, kb = item / nblk, nb = item % nblk, k0 = 64 * kb, n0 = 32 * nb;
    const int oc = map_col(J.type, n0 + (lane & 31), J.Nold);
    const int occ = oc >= 0 ? oc : 0;
    float vv[32];
#pragma unroll
    for (int i = 0; i < 32; ++i) vv[i] = J.W[(size_t)(k0 + 2 * i + (lane >> 5)) * J.Nold + occ];
#pragma unroll
    for (int i = 0; i < 32; ++i) { const int kk = 2 * i + (lane >> 5);
        float v = (oc >= 0) ? vv[i] : 0.f;
        if (J.rowscale) v *= J.rowscale[k0 + kk];
        scr[kk * 33 + (lane & 31)] = v; }
    LDS_WAIT(); asm volatile("" ::: "memory");
    const int c = lane & 7;
#pragma unroll
    for (int j = 0; j < 4; ++j) { const int n = (lane >> 3) + 8 * j; const LAS float* s = scr + (8 * c) * 33 + n;
        v4u o; o.x = pk2(s[0 * 33], s[1 * 33]); o.y = pk2(s[2 * 33], s[3 * 33]); o.z = pk2(s[4 * 33], s[5 * 33]); o.w = pk2(s[6 * 33], s[7 * 33]);
        *(GAS v4u*)(J.WT + (size_t)(n0 + n) * J.ldk + J.koff + k0 + 8 * c) = o; }
    LDS_WAIT(); asm volatile("" ::: "memory");
}
__device__ __forceinline__ void sincos_d(double a, float& sn, float& cs) {
    const double q = rint(a * 0.63661977236758134308);
    double r = a - q * 1.57079632673412561417e+00; r -= q * 6.07710050650619224932e-11;
    const double r2 = r * r;
    double s = 1.0 / 6227020800.0; s = s * r2 - 1.0 / 39916800.0; s = s * r2 + 1.0 / 362880.0; s = s * r2 - 1.0 / 5040.0; s = s * r2 + 1.0 / 120.0; s = s * r2 - 1.0 / 6.0; s = s * r2 * r + r;
    double c = -1.0 / 87178291200.0; c = c * r2 + 1.0 / 479001600.0; c = c * r2 - 1.0 / 3628800.0; c = c * r2 + 1.0 / 40320.0; c = c * r2 - 1.0 / 720.0; c = c * r2 + 1.0 / 24.0; c = c * r2 - 0.5; c = c * r2 + 1.0;
    const int qi = ((int)q) & 3;
    const double ss = (qi == 0) ? s : (qi == 1) ? c : (qi == 2) ? -s : -c;
    const double cc = (qi == 0) ? c : (qi == 1) ? -s : (qi == 2) ? -c : s;
    sn = (float)ss; cs = (float)cc;
}

struct Args { const void* in[24]; float* out; unsigned char* ws; int ph_lo, ph_hi; };
typedef const Args __attribute__((address_space(4)))* argp_t;
__device__ __forceinline__ argp_t get_args() { argp_t p = (argp_t)__builtin_amdgcn_kernarg_segment_ptr(); asm volatile("" : "+s"(p)); return p; }
__device__ __forceinline__ int otid(int wave_s) { return wave_s * 64 + lane_opaque(); }
#define IN_F(k) ((const float*)A_->in[k])
#define PH_LOCALS \
    argp_t A_ = get_args(); unsigned char* const ws = A_->ws; float* const out = A_->out; (void)out; \
    const int tid = otid(wave_s), lane = tid & 63, wave = wave_s; (void)lane; (void)wave; \
    const int G = gridDim.x, bx = blockIdx.x, vcu = (G % 8 == 0) ? (bx % 8) * (G / 8) + bx / 8 : bx; (void)vcu; \
    const int gw = vcu * NWAVES + wave, NGW = G * NWAVES, gt = vcu * (NWAVES * 64) + tid, NGT = G * NWAVES * 64; (void)gw; (void)NGW; (void)gt; (void)NGT; \
    LAS unsigned char* const L = (LAS unsigned char*)lds; (void)L;
#define WSP(T, off) ((T*)(ws + (off)))

__global__ void __launch_bounds__(NWAVES * 64, 2) mega_fwd(Args args) {
    extern __shared__ __attribute__((aligned(16))) unsigned char lds[];
    int lo, hi; XcdBarrier bar;
    const int wave_s = __builtin_amdgcn_readfirstlane((int)threadIdx.x >> 6);
    {
        PH_LOCALS
        volatile LAS unsigned* MISC = (volatile LAS unsigned*)(L + MISC_OFF);
        for (int u = tid; u < (LDS_BYTES - XB_OFF) / 4; u += NWAVES * 64) ((LAS unsigned*)(L + XB_OFF))[u] = 0u;
        __syncthreads();
        bar = xcd_barrier_post((unsigned*)(ws + WS_CTL) + CW_BAR, MISC + 8);
        lo = A_->ph_lo; hi = A_->ph_hi;
    }
#ifndef DBG_REP_TR
#define DBG_REP_TR 1
#endif
#ifndef DBG_REP_HB
#define DBG_REP_HB 1
#endif
#ifndef DBG_REP_FOX
#define DBG_REP_FOX 1
#endif
#ifndef DBG_REP_DSA
#define DBG_REP_DSA 1
#endif
#ifndef DBG_REP_SGU
#define DBG_REP_SGU 1
#endif
#ifndef DBG_REP_POOL
#define DBG_REP_POOL 1
#endif
#ifndef PHMASK
#define PHMASK 0xffffffu
#endif
#define IN(k) (((PHMASK >> (k)) & 1u) && lo <= (k) && (k) < hi)
#define SEAM(k) do { if (IN(k) && IN((k) + 1)) xcd_barrier(bar); } while (0)
    if (IN(0)) {
        PH_LOCALS
        LAS float* scr = (LAS float*)(L + wave * 16384);
        const float* norm_mix = IN_F(3); const float* norm_ffn = IN_F(4); const float* norm_ple = IN_F(5);
        const float* ffn_w_in = IN_F(6); const float* ffn_w_out = IN_F(9); const float* ple_w_proj = IN_F(10); const float* ple_w_gate = IN_F(11);
        const float* ev_w_in = IN_F(13); const float* ev_w_out = IN_F(14); const float* od_w_in = IN_F(17); const float* od_w_out = IN_F(18);
#define TJ(Wp, RS, WTp, K_, NOLD, NNEW, LDK, KOFF, TYPE) { constexpr int NI_ = ((K_) / 64) * ((NNEW) / 32); if (r < NI_) { const TJob J{(Wp), (RS), (WTp), (K_), (NOLD), (NNEW), (LDK), (KOFF), (TYPE), NI_}; transpose_item(J, scr, r, lane); continue; } r -= NI_; }
        constexpr int NITEMS = 16 * 48 + 8 * 32 + 44 * 32 + 4 * 32;
        for (int rep_ = 0; rep_ < DBG_REP_TR; ++rep_) for (int it = gw; it < NITEMS; it += NGW) {
            int r = it;
            TJ(ev_w_in, norm_mix, WSP(bf16, WS_W_EVIN), 1024, 1476, EV_N, 1024, 0, 1)
            TJ(ev_w_out + (size_t)512 * 1024, nullptr, WSP(bf16, WS_W_OUT0), 512, 1024, 1024, 1024, 512, 0)
            TJ(ffn_w_out + (size_t)DFF * 1024, nullptr, WSP(bf16, WS_W_FFO1), DFF, 1024, 1024, DFF, 0, 0)
            TJ(ple_w_proj + (size_t)256 * 1024, nullptr, WSP(bf16, WS_W_PP1), 256, 1024, 1024, 256, 0, 0)
        }
#undef TJ
        { const float* sgu_w = IN_F(22); bf16* W_SGU = WSP(bf16, WS_W_SGU);
          for (int i = gt; i < 4 * 128 * 128; i += NGT) { const int jj = i & 127, ii = (i >> 7) & 127; W_SGU[i] = (bf16)((ii < 64 && jj >= 64) ? 0u : f2bf(sgu_w[i])); } }
        { const float* x = IN_F(0); bf16* HB = WSP(bf16, WS_HB); float* SSQA = WSP(float, WS_SSQA);
          for (int m = gw; m < TOK; m += 4 * NGW) {
            f32x4 v[4][4];
#pragma unroll
            for (int q = 0; q < 4; ++q) { const int mm = (m + q * NGW < TOK) ? m + q * NGW : m; const f32x4* xr = (const f32x4*)(x + (size_t)mm * DMODEL) + lane;
#pragma unroll
                for (int j = 0; j < 4; ++j) v[q][j] = xr[64 * j]; }
#pragma unroll
            for (int q = 0; q < 4; ++q) { const int mm = m + q * NGW; if (mm < TOK) {
                float s = 0.f; unsigned long long* o8 = (unsigned long long*)(HB + (size_t)mm * DMODEL) + lane;
#pragma unroll
                for (int j = 0; j < 4; ++j) { const f32x4 w = v[q][j]; s += (w.x * w.x + w.y * w.y) + (w.z * w.z + w.w * w.w);
                    o8[64 * j] = (unsigned long long)pk2(w.x, w.y) | ((unsigned long long)pk2(w.z, w.w) << 32); }
                s = wave_sum(s);
                if (lane < 16) SSQA[(size_t)mm * 16 + lane] = (lane == 0) ? s : 0.f; } }
          } }
        { const float* p_in = IN_F(1); bf16* PB = WSP(bf16, WS_PB);
          for (int i = gt; i < TOK * PLE / 4; i += 4 * NGT) { f32x4 v[4];
#pragma unroll
            for (int q = 0; q < 4; ++q) v[q] = ((const f32x4*)p_in)[(i + q * NGT < TOK * PLE / 4) ? i + q * NGT : i];
#pragma unroll
            for (int q = 0; q < 4; ++q) if (i + q * NGT < TOK * PLE / 4) ((unsigned long long*)PB)[i + q * NGT] = (unsigned long long)pk2(v[q].x, v[q].y) | ((unsigned long long)pk2(v[q].z, v[q].w) << 32); } }
        { const int* positions = (const int*)A_->in[2]; f32x2* ROPE = WSP(f32x2, WS_ROPE);
          for (int i = gt; i < TOK * 8; i += NGT) {
            const int row = i >> 3, j = i & 7;
            const float invf = (j == 0) ? 1.0f : (j == 1) ? 0.1939227432012558f : (j == 2) ? 0.03760603070259094f : (j == 3) ? 0.007292664609849453f : (j == 4) ? 0.0014142135623842478f :
                               (j == 5) ? 0.00027424818836152554f : (j == 6) ? 5.3182957344688475e-05f : 1.0313385246263351e-05f;
            const float ang = (float)positions[row] * invf;
            float sn, cs; sincos_d((double)ang, sn, cs);
            ROPE[i] = (f32x2){cs, sn};
          } }
    }
    SEAM(0);
    if (IN(1)) {
        { PH_LOCALS
          pg8::Gemm g{WSP(bf16, WS_HB), WSP(bf16, WS_W_EVIN), TOK, EV_N, 1024}; pg8::StaticOrder S; S.init(TOK, EV_N, G, bx);
          pg8::EpiEvenIn E{WSP(float, WS_SSQA), WSP(bf16, WS_ZH), WSP(const pg8::f32x2, WS_ROPE)};
          pg8::gemm_phase<pg8::EpiEvenIn, pg8::StaticOrder, true, true>(L, g, S, E, wave_s); }
        if (gridDim.x == 256 && blockIdx.x >= 128) {
            PH_LOCALS
            LAS float* scr = (LAS float*)(L + wave * 16384);
            const float* norm_mix = IN_F(3); const float* norm_ffn = IN_F(4); const float* norm_ple = IN_F(5);
            const float* ffn_w_in = IN_F(6); const float* ffn_w_out = IN_F(9); const float* ple_w_proj = IN_F(10); const float* ple_w_gate = IN_F(11);
            const float* od_w_in = IN_F(17); const float* od_w_out = IN_F(18);
#define TJ(Wp, RS, WTp, K_, NOLD, NNEW, LDK, KOFF, TYPE) { constexpr int NI_ = ((K_) / 64) * ((NNEW) / 32); if (r < NI_) { const TJob J{(Wp), (RS), (WTp), (K_), (NOLD), (NNEW), (LDK), (KOFF), (TYPE), NI_}; transpose_item(J, scr, r, lane); continue; } r -= NI_; }
            constexpr int NITEMS_B = (16 * 176 + 44 * 32 + 16 * 32 + 4 * 32) + 16 * 88 + 16 * 32;
            const int gwb = (vcu_of(bx - 128, 128)) * NWAVES + wave, NGWB = 128 * NWAVES;
            for (int it = gwb; it < NITEMS_B; it += NGWB) {
                int r = it;
                TJ(ffn_w_in, norm_ffn, WSP(bf16, WS_W_FFI0), 1024, NFF2, NFF2, 1024, 0, 3)
                TJ(ffn_w_out, nullptr, WSP(bf16, WS_W_FFO0), DFF, 1024, 1024, DFF, 0, 0)
                TJ(ple_w_gate, norm_ple, WSP(bf16, WS_W_PG0), 1024, 1024, 1024, 1024, 0, 0)
                TJ(ple_w_proj, nullptr, WSP(bf16, WS_W_PP0), 256, 1024, 1024, 256, 0, 0)
                TJ(od_w_in, norm_mix + 1024, WSP(bf16, WS_W_ODIN), 1024, 2568, OD_N, 1024, 0, 2)
                TJ(od_w_out, nullptr, WSP(bf16, WS_W_OUT1), 1024, 1024, 1024, 1024, 0, 0)
            }
#undef TJ
        {
            const float* pool_w = IN_F(15); const float* pool_scale = IN_F(16); const float* ev_w_out = IN_F(14); bf16* W_OUT0 = WSP(bf16, WS_W_OUT0);
            for (int it = gwb; it < 1024; it += NGWB) {
                const int g = it >> 8, nb = (it >> 4) & 15, cb = it & 15, n = 64 * nb + lane;
                float acc[8];
#pragma unroll
                for (int cc = 0; cc < 8; ++cc) acc[cc] = 0.f;
#pragma unroll 1
                for (int d0 = 0; d0 < 128; d0 += 16) {
                    float wv[16];
#pragma unroll
                    for (int e = 0; e < 16; ++e) wv[e] = ev_w_out[(size_t)(128 * g + d0 + e) * 1024 + n] * pool_scale[128 * g + d0 + e];
#pragma unroll
                    for (int cc = 0; cc < 8; ++cc) {
                        const float* pw = pool_w + ((size_t)g * 128 + 8 * cb + cc) * 128 + d0;
#pragma unroll
                        for (int e = 0; e < 16; ++e) acc[cc] += pw[e] * wv[e];
                    }
                }
#pragma unroll
                for (int c2 = 0; c2 < 4; ++c2) *(unsigned*)(W_OUT0 + (size_t)n * 1024 + 128 * g + 8 * cb + 2 * c2) = pk2(acc[2 * c2], acc[2 * c2 + 1]);
            }
        }
        }
    }
    SEAM(1);
    if (IN(2)) {
        { PH_LOCALS
          const bf16* ZH = WSP(bf16, WS_ZH); bf16* Y = WSP(bf16, WS_Y); const unsigned lds0 = (unsigned)(uintptr_t)lds;
          for (int pi = vcu; pi < 256; pi += G) {
            const int b = pi >> 5, s = pi & 31;
#pragma unroll 1
            for (int k = 0; k < 2 * DBG_REP_DSA; ++k) mix::dsa_unit(b, (k & 1) ? s : 63 - s, ZH, Y, (char*)lds, lds0, wave_s);
          } }
        { PH_LOCALS
          const bf16* ZH = WSP(bf16, WS_ZH); bf16* Y = WSP(bf16, WS_Y);
          for (int rep_ = 0; rep_ < DBG_REP_POOL; ++rep_) for (int it = gt; it < TOK * 64; it += NGT) mix::pool_item(it, ZH, Y);
        }
    }
    SEAM(2);
    {
        const size_t s1o = (0 == 0) ? WS_SSQA : WS_SSQB, s2o = (0 == 0) ? WS_SSQB : WS_SSQA, s3o = s1o;
        if (IN(3)) {
            PH_LOCALS
            pg8::Gemm g{WSP(bf16, WS_Y), WSP(bf16, (0 == 0) ? WS_W_OUT0 : WS_W_OUT1), TOK, 1024, 1024}; pg8::StaticOrder S; S.init(TOK, 1024, G, bx);
            pg8::EpiRes E{IN_F(0), nullptr, WSP(bf16, WS_HB), WSP(float, s1o), WSP(bf16, WS_AHALO)};
            pg8::gemm_phase<pg8::EpiRes, pg8::StaticOrder, true, true>(L, g, S, E, wave_s);
        }
        SEAM(3);
        if (IN(3 + 2)) {
            PH_LOCALS
            pg8::Gemm g{WSP(bf16, WS_HB), WSP(bf16, WS_W_FFI0), TOK + 256, NFF2, 1024}; pg8::StaticOrder S; S.init(TOK, NFF2, G, bx);
#ifdef STAGGER
            if (STAGGER_COND) { for (int i_ = 0; i_ < STAGGER; ++i_) __builtin_amdgcn_s_sleep(127); }
#endif
            if (G == 256 && bx >= 128 && bx < 128 + NFF2 / 256) {
                pg8::OneUnit S1{64, bx - 128, 1};
                pg8::EpiHaloF EH{WSP(float, s1o), WSP(float, WS_AH), (unsigned*)(ws + WS_CTL) + CW_FLAG + 2048 * 0};
                pg8::gemm_phase<pg8::EpiHaloF, pg8::OneUnit, true, true>(L, g, S1, EH, wave_s);
            }
#ifdef PP_FIRST
            if (G == 256 && bx >= 150) {
                pg8::Gemm gp{WSP(bf16, WS_PB), WSP(bf16, WS_W_PP0), TOK, 1024, PLE}; pg8::StaticOrder SP; SP.init(TOK, 1024, 106, bx - 150);
                pg8::EpiBf16Plain EP{WSP(bf16, WS_PP), 1024};
                pg8::gemm_phase<pg8::EpiBf16Plain, pg8::StaticOrder, true, true>(L, gp, SP, EP, wave_s);
            }
#endif
            pg8::EpiFfnIn E{WSP(float, s1o), IN_F(7) + (size_t)0 * 3 * NFF2, IN_F(8) + (size_t)0 * NFF2, WSP(float, WS_AH), WSP(bf16, WS_ZH), (LAS float*)(L + XB_OFF), (unsigned*)(ws + WS_CTL) + CW_FLAG + 2048 * 0, 1u};
            pg8::gemm_phase<pg8::EpiFfnIn, pg8::StaticOrder, true, true>(L, g, S, E, wave_s);
#ifndef PP_FIRST
            if (G == 256 && bx >= 150) {
                pg8::Gemm gp{WSP(bf16, WS_PB), WSP(bf16, WS_W_PP0), TOK, 1024, PLE}; pg8::StaticOrder SP; SP.init(TOK, 1024, 106, bx - 150);
                pg8::EpiBf16Plain EP{WSP(bf16, WS_PP), 1024};
                pg8::gemm_phase<pg8::EpiBf16Plain, pg8::StaticOrder, true, true>(L, gp, SP, EP, wave_s);
            }
#endif
        }
        SEAM(3 + 2);
        if (IN(3 + 3)) {
            PH_LOCALS
            pg8::Gemm g{WSP(bf16, WS_ZH), WSP(bf16, (0 == 0) ? WS_W_FFO0 : WS_W_FFO1), TOK, 1024, DFF}; pg8::StaticOrder S; S.init(TOK, 1024, G, bx);
            pg8::EpiRes E{nullptr, WSP(bf16, WS_HB), WSP(bf16, WS_HB), WSP(float, s2o), nullptr};
            pg8::gemm_phase<pg8::EpiRes, pg8::StaticOrder, true, true>(L, g, S, E, wave_s);
        }
        SEAM(3 + 3);
        if (IN(3 + 4)) {
            PH_LOCALS
            pg8::Gemm g{WSP(bf16, WS_HB), WSP(bf16, (0 == 0) ? WS_W_PG0 : WS_W_PG1), TOK, 1024, 1024}; pg8::StaticOrder S; S.init(TOK, 1024, G, bx);
            pg8::EpiGate E{WSP(float, s2o), WSP(bf16, WS_HB), WSP(bf16, WS_PP), (bf16*)out, WSP(float, s3o)};
            pg8::gemm_phase<pg8::EpiGate, pg8::StaticOrder, true, true>(L, g, S, E, wave_s);
        }
        SEAM(3 + 4);
    }
    {

            if (IN(8)) {
                { PH_LOCALS
                  pg8::Gemm g{(const bf16*)out, WSP(bf16, WS_W_ODIN), TOK, OD_N, 1024}; pg8::StaticOrder S; S.init(TOK, OD_N, G, bx);
                  pg8::EpiOddIn E{WSP(float, WS_SSQA), WSP(bf16, WS_ZH), WSP(float, WS_FBUF), WSP(float, WS_SST)};
                  pg8::gemm_phase<pg8::EpiOddIn, pg8::StaticOrder, true, true>(L, g, S, E, wave_s); }
                if (gridDim.x == 256 && blockIdx.x >= 192) {
                    PH_LOCALS
                    LAS float* scr = (LAS float*)(L + wave * 16384);
                    const float* norm_ffn = IN_F(4); const float* norm_ple = IN_F(5); const float* ffn_w_in = IN_F(6); const float* ple_w_gate = IN_F(11);
#define TJ(Wp, RS, WTp, K_, NOLD, NNEW, LDK, KOFF, TYPE) { constexpr int NI_ = ((K_) / 64) * ((NNEW) / 32); if (r < NI_) { const TJob J{(Wp), (RS), (WTp), (K_), (NOLD), (NNEW), (LDK), (KOFF), (TYPE), NI_}; transpose_item(J, scr, r, lane); continue; } r -= NI_; }
                    constexpr int NITEMS_C = 16 * 176 + 16 * 32;
                    const int gwc = (bx - 192) * NWAVES + wave, NGWC = 64 * NWAVES;
                    for (int it = gwc; it < NITEMS_C; it += NGWC) {
                        int r = it;
                        TJ(ffn_w_in + (size_t)1024 * NFF2, norm_ffn + 1024, WSP(bf16, WS_W_FFI1), 1024, NFF2, NFF2, 1024, 0, 3)
                        TJ(ple_w_gate + (size_t)1024 * 1024, norm_ple + 1024, WSP(bf16, WS_W_PG1), 1024, 1024, 1024, 1024, 0, 0)
                    }
#undef TJ
                    const float* p1 = IN_F(1) + (size_t)TOK * PLE; bf16* PB = WSP(bf16, WS_PB);
                    const int gtc = (bx - 192) * (NWAVES * 64) + tid, NGTC = 64 * NWAVES * 64;
                    for (int i = gtc; i < TOK * PLE / 4; i += 4 * NGTC) { f32x4 v[4];
#pragma unroll
                        for (int q = 0; q < 4; ++q) v[q] = ((const f32x4*)p1)[(i + q * NGTC < TOK * PLE / 4) ? i + q * NGTC : i];
#pragma unroll
                        for (int q = 0; q < 4; ++q) if (i + q * NGTC < TOK * PLE / 4) ((unsigned long long*)PB)[i + q * NGTC] = (unsigned long long)pk2(v[q].x, v[q].y) | ((unsigned long long)pk2(v[q].z, v[q].w) << 32); }
                }
            }
            SEAM(8);
            if (IN(9)) {
                { PH_LOCALS
                  const bf16* ZH = WSP(bf16, WS_ZH); bf16* Y = WSP(bf16, WS_Y); const unsigned lds0 = (unsigned)(uintptr_t)lds;
                  const float* FBUF = WSP(float, WS_FBUF); const float* fox_b_f = IN_F(19);
                  for (int pi = vcu; pi < 256; pi += G) {
                    const int bh = pi >> 2, s = pi & 3;
#pragma unroll 1
                    for (int k = 0; k < 2 * DBG_REP_FOX; ++k) mix::fox_unit2(bh >> 3, bh & 7, (k & 1) ? s : 7 - s, ZH, FBUF, fox_b_f, Y, (char*)lds, wave_s);
                  } }
                { PH_LOCALS
                  const bf16* ZH = WSP(bf16, WS_ZH); bf16* Y = WSP(bf16, WS_Y);
                  for (int rep_ = 0; rep_ < DBG_REP_SGU; ++rep_) for (int u = vcu; u < 512; u += G) mix::sgu_unit(u >> 6, (u >> 2) & 15, u & 3, ZH, WSP(float, WS_SST), IN_F(20), IN_F(21), WSP(bf16, WS_W_SGU), IN_F(23), Y, (char*)lds, wave_s); }
            }
            SEAM(9);
            }
    {
        const size_t s1o = (1 == 0) ? WS_SSQA : WS_SSQB, s2o = (1 == 0) ? WS_SSQB : WS_SSQA, s3o = s1o;
        if (IN(10)) {
            PH_LOCALS
            pg8::Gemm g{WSP(bf16, WS_Y), WSP(bf16, (1 == 0) ? WS_W_OUT0 : WS_W_OUT1), TOK, 1024, 1024}; pg8::StaticOrder S; S.init(TOK, 1024, G, bx);
            pg8::EpiRes E{nullptr, (const bf16*)out, WSP(bf16, WS_HB), WSP(float, s1o), WSP(bf16, WS_AHALO)};
            pg8::gemm_phase<pg8::EpiRes, pg8::StaticOrder, true, true>(L, g, S, E, wave_s);
        }
        SEAM(10);
        if (IN(10 + 2)) {
            PH_LOCALS
            pg8::Gemm g{WSP(bf16, WS_HB), WSP(bf16, WS_W_FFI1), TOK + 256, NFF2, 1024}; pg8::StaticOrder S; S.init(TOK, NFF2, G, bx);
#ifdef STAGGER
            if (STAGGER_COND) { for (int i_ = 0; i_ < STAGGER; ++i_) __builtin_amdgcn_s_sleep(127); }
#endif
            if (G == 256 && bx >= 128 && bx < 128 + NFF2 / 256) {
                pg8::OneUnit S1{64, bx - 128, 1};
                pg8::EpiHaloF EH{WSP(float, s1o), WSP(float, WS_AH), (unsigned*)(ws + WS_CTL) + CW_FLAG + 2048 * 1};
                pg8::gemm_phase<pg8::EpiHaloF, pg8::OneUnit, true, true>(L, g, S1, EH, wave_s);
            }
#ifdef PP_FIRST
            if (G == 256 && bx >= 150) {
                pg8::Gemm gp{WSP(bf16, WS_PB), WSP(bf16, WS_W_PP1), TOK, 1024, PLE}; pg8::StaticOrder SP; SP.init(TOK, 1024, 106, bx - 150);
                pg8::EpiBf16Plain EP{WSP(bf16, WS_PP), 1024};
                pg8::gemm_phase<pg8::EpiBf16Plain, pg8::StaticOrder, true, true>(L, gp, SP, EP, wave_s);
            }
#endif
            pg8::EpiFfnIn E{WSP(float, s1o), IN_F(7) + (size_t)1 * 3 * NFF2, IN_F(8) + (size_t)1 * NFF2, WSP(float, WS_AH), WSP(bf16, WS_ZH), (LAS float*)(L + XB_OFF), (unsigned*)(ws + WS_CTL) + CW_FLAG + 2048 * 1, 2u};
            pg8::gemm_phase<pg8::EpiFfnIn, pg8::StaticOrder, true, true>(L, g, S, E, wave_s);
#ifndef PP_FIRST
            if (G == 256 && bx >= 150) {
                pg8::Gemm gp{WSP(bf16, WS_PB), WSP(bf16, WS_W_PP1), TOK, 1024, PLE}; pg8::StaticOrder SP; SP.init(TOK, 1024, 106, bx - 150);
                pg8::EpiBf16Plain EP{WSP(bf16, WS_PP), 1024};
                pg8::gemm_phase<pg8::EpiBf16Plain, pg8::StaticOrder, true, true>(L, gp, SP, EP, wave_s);
            }
#endif
        }
        SEAM(10 + 2);
        if (IN(10 + 3)) {
            PH_LOCALS
            pg8::Gemm g{WSP(bf16, WS_ZH), WSP(bf16, (1 == 0) ? WS_W_FFO0 : WS_W_FFO1), TOK, 1024, DFF}; pg8::StaticOrder S; S.init(TOK, 1024, G, bx);
            pg8::EpiRes E{nullptr, WSP(bf16, WS_HB), WSP(bf16, WS_HB), WSP(float, s2o), nullptr};
            pg8::gemm_phase<pg8::EpiRes, pg8::StaticOrder, true, true>(L, g, S, E, wave_s);
        }
        SEAM(10 + 3);
        if (IN(10 + 4)) {
            PH_LOCALS
            pg8::Gemm g{WSP(bf16, WS_HB), WSP(bf16, (1 == 0) ? WS_W_PG0 : WS_W_PG1), TOK, 1024, 1024}; pg8::StaticOrder S; S.init(TOK, 1024, G, bx);
            pg8::EpiGate E{WSP(float, s2o), WSP(bf16, WS_HB), WSP(bf16, WS_PP), WSP(bf16, WS_Y), WSP(float, s3o)};
            pg8::gemm_phase<pg8::EpiGate, pg8::StaticOrder, true, true>(L, g, S, E, wave_s);
        }
        SEAM(10 + 4);
    }
    if (IN(15)) {
        PH_LOCALS
        const float* SSQB = WSP(float, WS_SSQB); const float* norm_final = IN_F(12); const bf16* H6 = WSP(bf16, WS_Y);
        for (int m = gw; m < TOK; m += 4 * NGW) {
            unsigned long long w[4][4]; float rs[4];
#pragma unroll
            for (int q = 0; q < 4; ++q) { const int mm = (m + q * NGW < TOK) ? m + q * NGW : m; rs[q] = pg8::row_rstd(SSQB, mm);
                const unsigned long long* hr = (const unsigned long long*)(H6 + (size_t)mm * DMODEL) + lane;
#pragma unroll
                for (int j = 0; j < 4; ++j) w[q][j] = hr[64 * j]; }
            const f32x4* gr = (const f32x4*)norm_final + lane;
            f32x4 gg[4];
#pragma unroll
            for (int j = 0; j < 4; ++j) gg[j] = gr[64 * j];
#pragma unroll
            for (int q = 0; q < 4; ++q) { const int mm = m + q * NGW; if (mm < TOK) { f32x4* xr = (f32x4*)(out + (size_t)mm * DMODEL) + lane;
#pragma unroll
                for (int j = 0; j < 4; ++j) { const unsigned long long ww = w[q][j];
                    const f32x4 v = {pg8::bf_lo((unsigned)ww), pg8::bf_hi((unsigned)ww), pg8::bf_lo((unsigned)(ww >> 32)), pg8::bf_hi((unsigned)(ww >> 32))};
                    __builtin_nontemporal_store(v * rs[q] * gg[j], xr + 64 * j); } } }
        }
    }
#undef IN
#undef SEAM
}

#ifndef MK_N_LAUNCHES
#define MK_N_LAUNCHES 1
#endif
constexpr int N_PHASES = 16;
extern "C" void kernel_launch(void* const* d_in, const int* in_sizes, int n_in, void* d_out, int out_size, void* d_ws, size_t ws_size, hipStream_t stream) {
    static int grid = 0;
    if (grid == 0) {
        if (n_in != 24 || out_size != TOK * DMODEL || ws_size < WS_END) { fprintf(stderr, "kernel_launch: unexpected shapes (n_in %d, out %d, ws %zu)\n", n_in, out_size, ws_size); grid = -1; return; }
        int dev = 0, cus = 0;
        if (hipGetDevice(&dev) != hipSuccess || hipDeviceGetAttribute(&cus, hipDeviceAttributeMultiprocessorCount, dev) != hipSuccess) { grid = -1; return; }
        if (hipFuncSetAttribute((const void*)mega_fwd, hipFuncAttributeMaxDynamicSharedMemorySize, LDS_BYTES) != hipSuccess) { fprintf(stderr, "kernel_launch: hipFuncSetAttribute failed\n"); grid = -1; return; }
        int per_cu = 0;
        if (hipOccupancyMaxActiveBlocksPerMultiprocessor(&per_cu, (const void*)mega_fwd, NWAVES * 64, LDS_BYTES) != hipSuccess || per_cu < 1) { fprintf(stderr, "kernel_launch: occupancy query says %d\n", per_cu); }
        (void)hipGetLastError();
        grid = cus;
    }
    if (grid < 0) return;
    (void)hipMemsetAsync((char*)d_ws + WS_CTL, 0, CTL_ZERO_BYTES, stream);
    Args a{};
    for (int i = 0; i < 24; ++i) a.in[i] = d_in[i];
    a.out = (float*)d_out; a.ws = (unsigned char*)d_ws;
#ifdef DBG_CHECK
    {
        using namespace dbg;
        auto LP = [&](int ph) { a.ph_lo = ph; a.ph_hi = ph + 1; hipLaunchKernelGGL(mega_fwd, dim3(grid), dim3(NWAVES * 64), LDS_BYTES, stream, a); };
        char* wsb = (char*)d_ws; float* ERR = (float*)(wsb + 512 * 1024); float* SNAP = (float*)(wsb + 600 * 1024); float* outp = (float*)d_out;
        const unsigned short* ZHp = (const unsigned short*)(wsb + WS_ZH); const unsigned short* Yp = (const unsigned short*)(wsb + WS_Y); const float* FB = (const float*)(wsb + WS_FBUF);
        const unsigned short* HBp = (const unsigned short*)(wsb + WS_HB); const unsigned short* H3p = (const unsigned short*)d_out;
        auto F = [&](int i) { return (const float*)d_in[i]; };
        const float* x = F(0);
        LP(0); LP(1);
        k_evenin<<<NS, 256, 0, stream>>>(x, F(3), F(13), (const int*)d_in[2], ZHp, ERR, 0);
        LP(2);
        k_pool<<<NS, 256, 0, stream>>>(ZHp, Yp, ERR, 1);
        k_dsa<<<NS, 256, 0, stream>>>(ZHp, Yp, ERR, 2);
        LP(3);
        k_outproj<<<NS, 256, 0, stream>>>(x, 0, SNAP, Yp, F(14), F(15), F(16), HBp, ERR, 3);
        for (int layer = 0; layer < 2; ++layer) {
            const int pb = layer ? 10 : 3, kb = layer ? 10 : 3;
            if (layer == 1) {
                LP(8);
                k_oddin<<<NS, 256, 0, stream>>>(H3p, F(3) + 1024, F(17), ZHp, FB, ERR, 7);
                LP(9);
                k_fox<<<NS, 256, 0, stream>>>(ZHp, FB, F(19), Yp, ERR, 8);
                k_sgu<<<NS, 256, 0, stream>>>(ZHp, F(20), F(21), F(22), F(23), Yp, ERR, 9);
                k_snap<<<NS, 256, 0, stream>>>(H3p, SNAP);
                LP(10);
                k_outproj<<<NS, 256, 0, stream>>>(nullptr, 1, SNAP, Yp, F(18), nullptr, nullptr, HBp, ERR, 10);
            }
            LP(pb + 1); LP(pb + 2);
            k_ffnin<<<NS, 256, 0, stream>>>(HBp, F(4) + 1024 * layer, F(6) + (size_t)layer * 1024 * NFF2, F(7) + (size_t)layer * 3 * NFF2, F(8) + (size_t)layer * NFF2, ZHp, ERR, kb + 1);
            k_snap<<<NS, 256, 0, stream>>>(HBp, SNAP);
            LP(pb + 3);
            k_ffnout<<<NS, 256, 0, stream>>>(SNAP, ZHp, F(9) + (size_t)layer * DFF * 1024, HBp, ERR, kb + 2);
            k_snap<<<NS, 256, 0, stream>>>(HBp, SNAP);
            LP(pb + 4);
            k_ple<<<NS, 256, 0, stream>>>(SNAP, F(1) + (size_t)layer * TOK * PLE, F(5) + 1024 * layer, F(10) + (size_t)layer * PLE * 1024, F(11) + (size_t)layer * 1024 * 1024, layer ? Yp : H3p, ERR, kb + 3);
        }
        k_snap<<<NS, 256, 0, stream>>>(Yp, SNAP);
        LP(15);
        k_final<<<NS, 256, 0, stream>>>(SNAP, F(12), outp, ERR, 14);
        t_dpp<<<1, 64, 0, stream>>>(ERR + 40);
        k_report<<<1024, 256, 0, stream>>>(ERR, 15, DBG_TOL, outp);
        return;
    }
#endif
    if (MK_N_LAUNCHES == 1) {
        a.ph_lo = 0; a.ph_hi = N_PHASES;
        hipLaunchKernelGGL(mega_fwd, dim3(grid), dim3(NWAVES * 64), LDS_BYTES, stream, a);
    } else {
#ifndef DBG_STOP
#define DBG_STOP N_PHASES
#endif
#ifndef DBG_DOUBLE
#define DBG_DOUBLE -1
#endif
        for (int ph = 0; ph < DBG_STOP; ++ph) { a.ph_lo = ph; a.ph_hi = ph + 1; const int reps = (ph == DBG_DOUBLE || (DBG_DOUBLE == 100 && (ph == 0 || ph == 1 || ph == 2 || ph == 4 || ph == 5 || ph == 8 || ph == 9 || ph == 11 || ph == 12))) ? 2 : 1;
            for (int r = 0; r < reps; ++r) hipLaunchKernelGGL(mega_fwd, dim3(grid), dim3(NWAVES * 64), LDS_BYTES, stream, a); }
    }
}
```

```cpp
#include <hip/hip_runtime.h>
#include <hip/hip_bf16.h>
#include <cstdio>
#include <cstdint>
#include <cmath>
constexpr int TOK = 16384, DMODEL = 1024, SEQ = 2048, NBATCH = 8;
constexpr int DFF = 2816, NFF2 = 5632, PLE = 256;
constexpr int EV_N = 1536;
constexpr int OD_N = 2816;
constexpr int Z1P = 2560;
constexpr float RMS_EPS = 1e-6f;
constexpr float C2 = 0.125f * 1.4426950408889634f;


__device__ __forceinline__ int lane_opaque() { unsigned z = 0u; asm volatile("" : "+v"(z)); return (int)__builtin_amdgcn_mbcnt_hi(~0u, __builtin_amdgcn_mbcnt_lo(~0u, z)); }
__device__ __forceinline__ float xor16_f(float v) { return __builtin_bit_cast(float, __builtin_amdgcn_ds_swizzle(__builtin_bit_cast(int, v), 0x401F)); }
__device__ __forceinline__ void halves_pair(unsigned v, unsigned& a, unsigned& b) { unsigned w = v; asm volatile("" : "+v"(w)); auto rr = __builtin_amdgcn_permlane32_swap(v, w, false, false); a = rr[0]; b = rr[1]; }
__device__ __forceinline__ float halves_sum_f(float v) { unsigned a, b; halves_pair(__builtin_bit_cast(unsigned, v), a, b); return __builtin_bit_cast(float, a) + __builtin_bit_cast(float, b); }
__device__ __forceinline__ float halves_max_f(float v) { unsigned a, b; halves_pair(__builtin_bit_cast(unsigned, v), a, b); return __builtin_fmaxf(__builtin_bit_cast(float, a), __builtin_bit_cast(float, b)); }
__device__ __forceinline__ unsigned halves_add_u(unsigned v) { unsigned a, b; halves_pair(v, a, b); return a + b; }
__device__ __forceinline__ unsigned halves_or_u(unsigned v) { unsigned a, b; halves_pair(v, a, b); return a | b; }
namespace pg8 {
#define PG8_LAS __attribute__((address_space(3)))
typedef unsigned short bf16_t;
typedef short bf16x8 __attribute__((ext_vector_type(8)));
typedef float f32x4 __attribute__((ext_vector_type(4)));
typedef unsigned u32x4 __attribute__((ext_vector_type(4)));
constexpr int BM = 256, BK = 64, HALF = 128, HTB = HALF * BK * 2  , STAGE_BYTES = 8 * HTB, NXCD = 8, WGM = 8;

__host__ __device__ __forceinline__ int lds_byte(int r, int c) { const int st = (r >> 4) * 2 + (c >> 5), rr = r & 15, cc = c & 31, ob = rr * 64 + cc * 2; return st * 1024 + (ob ^ (((ob >> 9) & 1) << 5)); }
__host__ __device__ __forceinline__ void stage_rc(int b, int& R, int& C) { const int st = b / 1024, sb = b % 1024, swz = sb ^ (((sb >> 9) & 1) << 5); R = (st >> 1) * 16 + swz / 64; C = (st & 1) * 32 + (swz % 64) / 2; }
__host__ __device__ __forceinline__ int perm32(int rho) { const int n = rho >> 4, i = rho & 15; return 8 * (i >> 2) + 4 * n + (i & 3); }

struct Unit { int pm, pn; };
struct Gemm { const bf16_t* A; const bf16_t* Bt; int M, N, K; };

struct StaticOrder {
    int nM, nN, nwg, G, c;
    __host__ __device__ void init(int M, int N, int G_, int c_) { nM = M / BM; nN = N / BM; nwg = nM * nN; G = G_; c = c_; }
    __host__ __device__ bool next(int i, Unit& u) const {
        const long L = (long)i * G + c; if (L >= nwg) return false;
        int wgid = (int)L; { const int q = nwg / NXCD, r = nwg % NXCD, xcd = wgid % NXCD, off = wgid / NXCD; wgid = (xcd < r ? xcd * (q + 1) : r * (q + 1) + (xcd - r) * q) + off; }
        const int nig = WGM * nN, gid = wgid / nig, fm = gid * WGM, gsz = (nM - fm) < WGM ? (nM - fm) : WGM;
        u.pm = fm + ((wgid % nig) % gsz); u.pn = (wgid % nig) / gsz; return true;
    }
    __device__ __forceinline__ void a_ready(const Unit&) const {}
    __device__ __forceinline__ void done(const Unit&) const {}
};

struct OneUnit {
    int pm, pn, on;
    __host__ __device__ bool next(int i, Unit& u) const { if (!on || i != 0) return false; u.pm = pm; u.pn = pn; return true; }
    __device__ __forceinline__ void a_ready(const Unit&) const {}
    __device__ __forceinline__ void done(const Unit&) const {}
};
struct FfnOrder {
    StaticOrder S0; int extra;
    __host__ __device__ void init(int M, int N, int G_, int c_) { S0.init(M, N, G_, c_); extra = (G_ == 256 && c_ >= 128 && c_ < 128 + N / BM) ? 1 : 0; }
    __host__ __device__ bool next(int i, Unit& u) const { if (extra) { if (i == 0) { u.pm = 64; u.pn = S0.c - 128; return true; } return S0.next(i - 1, u); } return S0.next(i, u); }
    __device__ __forceinline__ void a_ready(const Unit&) const {}
    __device__ __forceinline__ void done(const Unit&) const {}
};
typedef float f32x2 __attribute__((ext_vector_type(2)));
typedef unsigned u32x2 __attribute__((ext_vector_type(2)));
__device__ __forceinline__ unsigned cvt_pk_bf16(float lo, float hi) { unsigned r; asm volatile("v_cvt_pk_bf16_f32 %0, %1, %2" : "=v"(r) : "v"(lo), "v"(hi)); return r; }
__device__ __forceinline__ float bf_lo(unsigned w) { return __builtin_bit_cast(float, w << 16); }
__device__ __forceinline__ float bf_hi(unsigned w) { return __builtin_bit_cast(float, w & 0xffff0000u); }
__device__ __forceinline__ float sq4(const f32x4 v) { return (v[0] * v[0] + v[1] * v[1]) + (v[2] * v[2] + v[3] * v[3]); }
__device__ __forceinline__ float row_rstd(const float* ssq, int row) {
    const f32x4* p = (const f32x4*)(ssq + (size_t)row * 16);
    const f32x4 a = p[0], b = p[1], c = p[2], d = p[3];
    const float s = (((a[0] + a[1]) + (a[2] + a[3])) + ((b[0] + b[1]) + (b[2] + b[3]))) + (((c[0] + c[1]) + (c[2] + c[3])) + ((d[0] + d[1]) + (d[2] + d[3])));
    return 1.0f / sqrtf(s * (1.0f / 1024.0f) + RMS_EPS);
}
__device__ __forceinline__ float row_rstd_coh(const float* ssq, int row) {
    const float* p = ssq + (size_t)row * 16;
    f32x4 a, b, c, d;
    asm volatile("global_load_dwordx4 %0, %4, off sc1\n\tglobal_load_dwordx4 %1, %4, off offset:16 sc1\n\tglobal_load_dwordx4 %2, %4, off offset:32 sc1\n\tglobal_load_dwordx4 %3, %4, off offset:48 sc1\n\ts_waitcnt vmcnt(0)"
                 : "=&v"(a), "=&v"(b), "=&v"(c), "=&v"(d) : "v"(p) : "memory");
    const float s = (((a[0] + a[1]) + (a[2] + a[3])) + ((b[0] + b[1]) + (b[2] + b[3]))) + (((c[0] + c[1]) + (c[2] + c[3])) + ((d[0] + d[1]) + (d[2] + d[3])));
    return 1.0f / sqrtf(s * (1.0f / 1024.0f) + RMS_EPS);
}
__device__ __forceinline__ void ssq_write(float* ssq_out, float q, int row, int slot, int fq) {
    q += xor16_f(q); q = halves_sum_f(q);
    if (fq == 0) ssq_out[(size_t)row * 16 + slot] = q;
}
typedef float f32x2 __attribute__((ext_vector_type(2)));
__device__ __forceinline__ f32x2 gelu_mul2(const f32x2 x, const f32x2 c) {
    const f32x2 x2 = x * x;
    const f32x2 a = x * (x2 * (-2.3022082f * 0.044715f) + (-2.3022082f));
    f32x2 e; e.x = __builtin_amdgcn_exp2f(a.x); e.y = __builtin_amdgcn_exp2f(a.y);
    const f32x2 d = e + 1.0f;
    f32x2 r; r.x = __builtin_amdgcn_rcpf(d.x); r.y = __builtin_amdgcn_rcpf(d.y);
    return (x * c) * r;
}
__device__ __forceinline__ float gelu_tanh(float x) {
    const float t = x + 0.044715f * x * x * x;
    const float e = __builtin_amdgcn_exp2f(-2.3022082f * t);
    return x * __builtin_amdgcn_rcpf(1.0f + e);
}
__device__ __forceinline__ float sigmoid_f(float x) { return __builtin_amdgcn_rcpf(1.0f + __builtin_amdgcn_exp2f(-1.4426950408889634f * x)); }


struct EpiRes {
    static constexpr bool PERM = true, AFTER_DRAIN = false;
    const float* basef; const bf16_t* baseb; bf16_t* hb; float* ssq_out; bf16_t* ahalo;
    __device__ __forceinline__ void operator()(const f32x4 (&acc)[2][2][4][2], const Unit& u_, int wr, int wc, int fr, int fq) const {
        Unit u; { int pm_ = u_.pm, pn_ = u_.pn; asm volatile("" : "+s"(pm_), "+s"(pn_)); u.pm = pm_; u.pn = pn_; }
        const int row0 = u.pm * BM + wr * 64 + fr, col0 = u.pn * BM + wc * 32 + 8 * fq;
        if (basef != nullptr) {
#pragma unroll
            for (int ai = 0; ai < 2; ++ai)
#pragma unroll
                for (int m = 0; m < 4; ++m) {
                    const int row = row0 + ai * HALF + m * 16; float q = 0.f;
#pragma unroll
                    for (int bj = 0; bj < 2; ++bj) {
                        const size_t off = (size_t)row * DMODEL + col0 + bj * HALF;
                        const f32x4 b0 = *(const f32x4*)(basef + off), b1 = *(const f32x4*)(basef + off + 4);
                        const f32x4 v0 = acc[ai][bj][m][0] + b0, v1 = acc[ai][bj][m][1] + b1;
                        q += sq4(v0) + sq4(v1);
                        u32x4 w; w.x = cvt_pk_bf16(v0[0], v0[1]); w.y = cvt_pk_bf16(v0[2], v0[3]); w.z = cvt_pk_bf16(v1[0], v1[1]); w.w = cvt_pk_bf16(v1[2], v1[3]);
                        *(u32x4*)(hb + off) = w;
                        if (ahalo != nullptr && ai == 1 && m == 3) {
                            const int rl = row & 255;
                            if (rl >= 254 && u.pm < 63) *(u32x4*)(ahalo + (size_t)(2 * (u.pm + 1) + (rl - 254)) * DMODEL + col0 + bj * HALF) = w;
                        }
                    }
                    ssq_write(ssq_out, q, row, u.pn * 4 + wc, fq);
                    if (m & 1) asm volatile("" ::: "memory");
                }
        } else {
#pragma unroll
            for (int ai = 0; ai < 2; ++ai) {
                u32x4 bw[4][2];
#pragma unroll
                for (int m = 0; m < 4; ++m)
#pragma unroll
                    for (int bj = 0; bj < 2; ++bj) bw[m][bj] = *(const u32x4*)(baseb + (size_t)(row0 + ai * HALF + m * 16) * DMODEL + col0 + bj * HALF);
                asm volatile("" ::: "memory");
#pragma unroll
                for (int m = 0; m < 4; ++m) {
                    const int row = row0 + ai * HALF + m * 16; float q = 0.f;
#pragma unroll
                    for (int bj = 0; bj < 2; ++bj) {
                        const size_t off = (size_t)row * DMODEL + col0 + bj * HALF;
                        const u32x4 pw = bw[m][bj];
                        const f32x4 b0 = {bf_lo(pw.x), bf_hi(pw.x), bf_lo(pw.y), bf_hi(pw.y)}, b1 = {bf_lo(pw.z), bf_hi(pw.z), bf_lo(pw.w), bf_hi(pw.w)};
                        const f32x4 v0 = acc[ai][bj][m][0] + b0, v1 = acc[ai][bj][m][1] + b1;
                        q += sq4(v0) + sq4(v1);
                        u32x4 w; w.x = cvt_pk_bf16(v0[0], v0[1]); w.y = cvt_pk_bf16(v0[2], v0[3]); w.z = cvt_pk_bf16(v1[0], v1[1]); w.w = cvt_pk_bf16(v1[2], v1[3]);
                        *(u32x4*)(hb + off) = w;
                        if (ahalo != nullptr && ai == 1 && m == 3) {
                            const int rl = row & 255;
                            if (rl >= 254 && u.pm < 63) *(u32x4*)(ahalo + (size_t)(2 * (u.pm + 1) + (rl - 254)) * DMODEL + col0 + bj * HALF) = w;
                        }
                    }
                    ssq_write(ssq_out, q, row, u.pn * 4 + wc, fq);
                }
                asm volatile("" ::: "memory");
            }
        }
    }
};
struct EpiGate {
    static constexpr bool PERM = true, AFTER_DRAIN = false;
    const float* ssq_in; const bf16_t* base; const bf16_t* pp; bf16_t* dst; float* ssq_out;
    __device__ __forceinline__ void operator()(const f32x4 (&acc)[2][2][4][2], const Unit& u_, int wr, int wc, int fr, int fq) const {
        Unit u; { int pm_ = u_.pm, pn_ = u_.pn; asm volatile("" : "+s"(pm_), "+s"(pn_)); u.pm = pm_; u.pn = pn_; }
        const int row0 = u.pm * BM + wr * 64 + fr, col0 = u.pn * BM + wc * 32 + 8 * fq;
#pragma unroll
        for (int ai = 0; ai < 2; ++ai)
#pragma unroll
            for (int mp = 0; mp < 2; ++mp) {
                u32x4 bw[2][2], pq[2][2]; float rs[2];
#pragma unroll
                for (int mi = 0; mi < 2; ++mi) {
                    const int row = row0 + ai * HALF + (2 * mp + mi) * 16;
#pragma unroll
                    for (int bj = 0; bj < 2; ++bj) { const size_t off = (size_t)row * DMODEL + col0 + bj * HALF; bw[mi][bj] = *(const u32x4*)(base + off); pq[mi][bj] = *(const u32x4*)(pp + off); }
                }
#pragma unroll
                for (int mi = 0; mi < 2; ++mi) rs[mi] = row_rstd(ssq_in, row0 + ai * HALF + (2 * mp + mi) * 16);
                asm volatile("" ::: "memory");
#pragma unroll
                for (int mi = 0; mi < 2; ++mi) {
                    const int m = 2 * mp + mi; const int row = row0 + ai * HALF + m * 16; float q = 0.f;
#pragma unroll
                    for (int bj = 0; bj < 2; ++bj) {
                        const size_t off = (size_t)row * DMODEL + col0 + bj * HALF;
                        const u32x4 b_ = bw[mi][bj], p_ = pq[mi][bj];
                        const float bb[8] = {bf_lo(b_.x), bf_hi(b_.x), bf_lo(b_.y), bf_hi(b_.y), bf_lo(b_.z), bf_hi(b_.z), bf_lo(b_.w), bf_hi(b_.w)};
                        const float pv[8] = {bf_lo(p_.x), bf_hi(p_.x), bf_lo(p_.y), bf_hi(p_.y), bf_lo(p_.z), bf_hi(p_.z), bf_lo(p_.w), bf_hi(p_.w)};
                        const f32x4 g0 = acc[ai][bj][m][0] * rs[mi], g1 = acc[ai][bj][m][1] * rs[mi];
                        const float gg[8] = {g0[0], g0[1], g0[2], g0[3], g1[0], g1[1], g1[2], g1[3]};
                        float v[8];
#pragma unroll
                        for (int i = 0; i < 8; ++i) { v[i] = bb[i] + pv[i] * sigmoid_f(gg[i]); q += v[i] * v[i]; }
                        u32x4 w; w.x = cvt_pk_bf16(v[0], v[1]); w.y = cvt_pk_bf16(v[2], v[3]); w.z = cvt_pk_bf16(v[4], v[5]); w.w = cvt_pk_bf16(v[6], v[7]);
                        *(u32x4*)(dst + off) = w;
                    }
                    ssq_write(ssq_out, q, row, u.pn * 4 + wc, fq);
                }
                asm volatile("" ::: "memory");
            }
    }
};
struct EpiGateFinal {
    static constexpr bool PERM = true, AFTER_DRAIN = false;
    const float* ssq_in; const bf16_t* base; const bf16_t* pp; float* ssq_out; unsigned* cnt; const float* gain; float* outp; PG8_LAS float* rtab;
    __device__ __forceinline__ void operator()(const f32x4 (&acc)[2][2][4][2], const Unit& u_, int wr, int wc, int fr, int fq) const {
        Unit u; { int pm_ = u_.pm, pn_ = u_.pn; asm volatile("" : "+s"(pm_), "+s"(pn_)); u.pm = pm_; u.pn = pn_; }
        const int row0 = u.pm * BM + wr * 64 + fr, col0 = u.pn * BM + wc * 32 + 8 * fq;
        f32x4 hv[2][2][4][2];
#pragma unroll
        for (int ai = 0; ai < 2; ++ai)
#pragma unroll
            for (int mp = 0; mp < 2; ++mp) {
                u32x4 bw[2][2], pq[2][2]; float rs[2];
#pragma unroll
                for (int mi = 0; mi < 2; ++mi) {
                    const int row = row0 + ai * HALF + (2 * mp + mi) * 16;
#pragma unroll
                    for (int bj = 0; bj < 2; ++bj) { const size_t off = (size_t)row * DMODEL + col0 + bj * HALF; bw[mi][bj] = *(const u32x4*)(base + off); pq[mi][bj] = *(const u32x4*)(pp + off); }
                }
#pragma unroll
                for (int mi = 0; mi < 2; ++mi) rs[mi] = row_rstd(ssq_in, row0 + ai * HALF + (2 * mp + mi) * 16);
                asm volatile("" ::: "memory");
#pragma unroll
                for (int mi = 0; mi < 2; ++mi) {
                    const int m = 2 * mp + mi; const int row = row0 + ai * HALF + m * 16; float q = 0.f;
#pragma unroll
                    for (int bj = 0; bj < 2; ++bj) {
                        const u32x4 b_ = bw[mi][bj], p_ = pq[mi][bj];
                        const float bb[8] = {bf_lo(b_.x), bf_hi(b_.x), bf_lo(b_.y), bf_hi(b_.y), bf_lo(b_.z), bf_hi(b_.z), bf_lo(b_.w), bf_hi(b_.w)};
                        const float pv[8] = {bf_lo(p_.x), bf_hi(p_.x), bf_lo(p_.y), bf_hi(p_.y), bf_lo(p_.z), bf_hi(p_.z), bf_lo(p_.w), bf_hi(p_.w)};
                        const f32x4 g0 = acc[ai][bj][m][0] * rs[mi], g1 = acc[ai][bj][m][1] * rs[mi];
                        const float gg[8] = {g0[0], g0[1], g0[2], g0[3], g1[0], g1[1], g1[2], g1[3]};
                        float v[8];
#pragma unroll
                        for (int i = 0; i < 8; ++i) { v[i] = bb[i] + pv[i] * sigmoid_f(gg[i]); q += v[i] * v[i]; }
                        hv[ai][bj][m][0] = (f32x4){v[0], v[1], v[2], v[3]}; hv[ai][bj][m][1] = (f32x4){v[4], v[5], v[6], v[7]};
                    }
                    ssq_write(ssq_out, q, row, u.pn * 4 + wc, fq);
                }
                asm volatile("" ::: "memory");
            }
        asm volatile("s_waitcnt vmcnt(0)" ::: "memory"); __builtin_amdgcn_s_barrier(); asm volatile("" ::: "memory");
        if (wr == 0 && wc == 0) {
            if (fr == 0 && fq == 0) {
                __builtin_amdgcn_fence(__ATOMIC_RELEASE, "agent");
                asm volatile("s_waitcnt vmcnt(0)" ::: "memory");
                __hip_atomic_fetch_add(cnt + 64 * u.pm, 1u, __ATOMIC_RELAXED, __HIP_MEMORY_SCOPE_AGENT);
            }
            unsigned sp = 0;
            while (__hip_atomic_load(cnt + 64 * u.pm, __ATOMIC_RELAXED, __HIP_MEMORY_SCOPE_AGENT) < 4u) { __builtin_amdgcn_s_sleep(2); if (++sp > (1u << 22)) break; }
        }
        asm volatile("" ::: "memory"); __builtin_amdgcn_s_barrier(); asm volatile("" ::: "memory");
        if (wr == 0) rtab[wc * 64 + fq * 16 + fr] = row_rstd_coh(ssq_out, u.pm * BM + wc * 64 + fq * 16 + fr);
        asm volatile("s_waitcnt lgkmcnt(0)" ::: "memory"); __builtin_amdgcn_s_barrier(); asm volatile("" ::: "memory");
        f32x4 gn[2][2];
#pragma unroll
        for (int bj = 0; bj < 2; ++bj)
#pragma unroll
            for (int n = 0; n < 2; ++n) gn[bj][n] = *(const f32x4*)(gain + col0 + bj * HALF + 4 * n);
#pragma unroll
        for (int ai = 0; ai < 2; ++ai)
#pragma unroll
            for (int m = 0; m < 4; ++m) {
                const float rsf = rtab[ai * HALF + wr * 64 + m * 16 + fr];
                float* orow = outp + (size_t)(row0 + ai * HALF + m * 16) * DMODEL + col0;
#pragma unroll
                for (int bj = 0; bj < 2; ++bj)
#pragma unroll
                    for (int n = 0; n < 2; ++n) *(f32x4*)(orow + bj * HALF + 4 * n) = hv[ai][bj][m][n] * rsf * gn[bj][n];
            }
    }
};
struct EpiBf16Plain {
    static constexpr bool PERM = true, AFTER_DRAIN = false;
    bf16_t* O; int ldc;
    __device__ __forceinline__ void operator()(const f32x4 (&acc)[2][2][4][2], const Unit& u_, int wr, int wc, int fr, int fq) const {
        Unit u; { int pm_ = u_.pm, pn_ = u_.pn; asm volatile("" : "+s"(pm_), "+s"(pn_)); u.pm = pm_; u.pn = pn_; }
        const int row0 = u.pm * BM + wr * 64 + fr, col0 = u.pn * BM + wc * 32 + 8 * fq;
#pragma unroll
        for (int ai = 0; ai < 2; ++ai)
#pragma unroll
            for (int m = 0; m < 4; ++m) {
                const int row = row0 + ai * HALF + m * 16;
#pragma unroll
                for (int bj = 0; bj < 2; ++bj) {
                    const f32x4 v0 = acc[ai][bj][m][0], v1 = acc[ai][bj][m][1];
                    u32x4 w; w.x = cvt_pk_bf16(v0[0], v0[1]); w.y = cvt_pk_bf16(v0[2], v0[3]); w.z = cvt_pk_bf16(v1[0], v1[1]); w.w = cvt_pk_bf16(v1[2], v1[3]);
                    *(u32x4*)(O + (size_t)row * ldc + col0 + bj * HALF) = w;
                }
            }
    }
};
struct EpiEvenIn {
    static constexpr bool PERM = true, AFTER_DRAIN = false;
    const float* ssq_in; bf16_t* Z; const f32x2* rope;
    __device__ __forceinline__ void operator()(const f32x4 (&acc)[2][2][4][2], const Unit& u_, int wr, int wc, int fr, int fq) const {
        Unit u; { int pm_ = u_.pm, pn_ = u_.pn; asm volatile("" : "+s"(pm_), "+s"(pn_)); u.pm = pm_; u.pn = pn_; }
        const int row0 = u.pm * BM + wr * 64 + fr, colw = wc * 32 + 8 * fq;
        const int pn = u.pn;
        const float sc = (pn == 2 || pn == 3) ? C2 : 1.0f;
#pragma unroll
        for (int ai = 0; ai < 2; ++ai)
#pragma unroll
            for (int m = 0; m < 4; ++m) {
                const int row = row0 + ai * HALF + m * 16;
                const float rs = row_rstd(ssq_in, row);
#pragma unroll
                for (int bj = 0; bj < 2; ++bj) {
                    const int gi = 2 * bj + (wc >> 1);
                    const bool ropeg = (pn == 2 || pn == 3 || pn == 5 || (pn == 4 && (gi == 0 || gi == 2))) && ((wc & 1) == 0);
                    f32x4 v0 = acc[ai][bj][m][0] * rs, v1 = acc[ai][bj][m][1] * rs;
                    if (ropeg && fq < 2) {
                        const f32x4* rp = (const f32x4*)(rope + (size_t)row * 8 + 4 * fq);
                        const f32x4 ra = rp[0], rb = rp[1];
                        f32x4 o0, o1;
                        o0[0] = v0[0] * ra[0] - v0[1] * ra[1]; o0[1] = v0[1] * ra[0] + v0[0] * ra[1];
                        o0[2] = v0[2] * ra[2] - v0[3] * ra[3]; o0[3] = v0[3] * ra[2] + v0[2] * ra[3];
                        o1[0] = v1[0] * rb[0] - v1[1] * rb[1]; o1[1] = v1[1] * rb[0] + v1[0] * rb[1];
                        o1[2] = v1[2] * rb[2] - v1[3] * rb[3]; o1[3] = v1[3] * rb[2] + v1[2] * rb[3];
                        v0 = o0; v1 = o1;
                    }
                    v0 = v0 * sc; v1 = v1 * sc;
                    u32x4 w; w.x = cvt_pk_bf16(v0[0], v0[1]); w.y = cvt_pk_bf16(v0[2], v0[3]); w.z = cvt_pk_bf16(v1[0], v1[1]); w.w = cvt_pk_bf16(v1[2], v1[3]);
                    *(u32x4*)(Z + (size_t)row * EV_N + pn * BM + bj * HALF + colw) = w;
                }
            }
    }
};
struct EpiOddIn {
    static constexpr bool PERM = true, AFTER_DRAIN = false;
    const float* ssq_in; bf16_t* Z; float* F; float* sst;
    __device__ __forceinline__ void operator()(const f32x4 (&acc)[2][2][4][2], const Unit& u_, int wr, int wc, int fr, int fq) const {
        Unit u; { int pm_ = u_.pm, pn_ = u_.pn; asm volatile("" : "+s"(pm_), "+s"(pn_)); u.pm = pm_; u.pn = pn_; }
        const int row0 = u.pm * BM + wr * 64 + fr, colw = wc * 32 + 8 * fq;
        const int pn = u.pn;
        const float sc = (pn < 2) ? C2 : 1.0f;
        const bool act = (pn >= 6 && pn < 10), stat = (pn == 8 || pn == 9);
#pragma unroll
        for (int ai = 0; ai < 2; ++ai)
#pragma unroll
            for (int m = 0; m < 4; ++m) {
                const int row = row0 + ai * HALF + m * 16;
                const float rs = row_rstd(ssq_in, row);
                if (pn == 10) {
                    if (wc == 0 && fq == 0) { *(f32x4*)(F + (size_t)row * 8) = acc[ai][0][m][0] * rs; *(f32x4*)(F + (size_t)row * 8 + 4) = acc[ai][0][m][1] * rs; }
                    continue;
                }
                float s1 = 0.f, s2 = 0.f;
#pragma unroll
                for (int bj = 0; bj < 2; ++bj) {
                    f32x4 v0 = acc[ai][bj][m][0] * (rs * sc), v1 = acc[ai][bj][m][1] * (rs * sc);
                    if (act) {
#pragma unroll
                        for (int i = 0; i < 4; ++i) { v0[i] = gelu_tanh(v0[i]); v1[i] = gelu_tanh(v1[i]); }
                    }
                    s1 += ((v0[0] + v0[1]) + (v0[2] + v0[3])) + ((v1[0] + v1[1]) + (v1[2] + v1[3])); s2 += sq4(v0) + sq4(v1);
                    u32x4 w; w.x = cvt_pk_bf16(v0[0], v0[1]); w.y = cvt_pk_bf16(v0[2], v0[3]); w.z = cvt_pk_bf16(v1[0], v1[1]); w.w = cvt_pk_bf16(v1[2], v1[3]);
                    *(u32x4*)(Z + (size_t)row * Z1P + pn * BM + bj * HALF + colw) = w;
                }
                if (stat) {
                    s1 += xor16_f(s1); s1 = halves_sum_f(s1); s2 += xor16_f(s2); s2 = halves_sum_f(s2);
                    if (fq == 0) *(f32x2*)(sst + ((size_t)row * 8 + (pn - 8) * 4 + wc) * 2) = (f32x2){s1, s2};
                }
            }
    }
};
struct EpiHalo {
    static constexpr bool PERM = true, AFTER_DRAIN = false;
    const float* ssq_in; float* AH;
    __device__ __forceinline__ void operator()(const f32x4 (&acc)[2][2][4][2], const Unit& u_, int wr, int wc, int fr, int fq) const {
        Unit u; { int pm_ = u_.pm, pn_ = u_.pn; asm volatile("" : "+s"(pm_), "+s"(pn_)); u.pm = pm_; u.pn = pn_; }
        const int col0 = u.pn * BM + wc * 32 + 8 * fq;
#pragma unroll
        for (int m = 0; m < 4; ++m) {
            const int rh = wr * 64 + m * 16 + fr;
            if (rh < 2) continue;
            const int tok = 256 * (rh >> 1) - 2 + (rh & 1);
            const float rs = row_rstd(ssq_in, tok);
#pragma unroll
            for (int bj = 0; bj < 2; ++bj) {
                *(f32x4*)(AH + (size_t)rh * NFF2 + col0 + bj * HALF) = acc[0][bj][m][0] * rs;
                *(f32x4*)(AH + (size_t)rh * NFF2 + col0 + bj * HALF + 4) = acc[0][bj][m][1] * rs;
            }
        }
    }
};
template <int SEL> __device__ __forceinline__ float dpp1(const float old, const float src) {
    const int o = __builtin_bit_cast(int, old), s = __builtin_bit_cast(int, src); int t;
    if (SEL == 0) t = __builtin_amdgcn_update_dpp(o, s, 0x111, 0xf, 0xf, false);
    else if (SEL == 1) t = __builtin_amdgcn_update_dpp(o, s, 0x112, 0xf, 0xf, false);
    else if (SEL == 2) t = __builtin_amdgcn_update_dpp(o, s, 0x10F, 0xf, 0xf, false);
    else t = __builtin_amdgcn_update_dpp(o, s, 0x10E, 0xf, 0xf, false);
    return __builtin_bit_cast(float, t);
}
template <int SEL> __device__ __forceinline__ f32x4 dpp4t(const f32x4 old, const f32x4 src) {
    const float o0 = old[0], o1 = old[1], o2 = old[2], o3 = old[3], s0 = src[0], s1 = src[1], s2 = src[2], s3 = src[3];
    const float r0 = dpp1<SEL>(o0, s0), r1 = dpp1<SEL>(o1, s1), r2 = dpp1<SEL>(o2, s2), r3 = dpp1<SEL>(o3, s3);
    return (f32x4){r0, r1, r2, r3};
}
#define dpp4(old, src, sel) dpp4t<sel>(old, src)
__device__ __forceinline__ void conv_taps(f32x4& c, const f32x4 cur, const f32x4 prev, const f32x4 w0, const f32x4 w1) {
    float c0 = c[0], c1 = c[1], c2 = c[2], c3 = c[3];
    const float x0 = cur[0], x1 = cur[1], x2 = cur[2], x3 = cur[3], p0 = prev[0], p1 = prev[1], p2 = prev[2], p3 = prev[3];
    const float a0 = w1[0], a1 = w1[1], a2 = w1[2], a3 = w1[3], b0 = w0[0], b1 = w0[1], b2 = w0[2], b3 = w0[3];
    asm("s_nop 4\n\t"
        "v_fmac_f32_dpp %0, %4, %12 row_shr:1 row_mask:0xf bank_mask:0xf bound_ctrl:1\n\t"
        "v_fmac_f32_dpp %1, %5, %13 row_shr:1 row_mask:0xf bank_mask:0xf bound_ctrl:1\n\t"
        "v_fmac_f32_dpp %2, %6, %14 row_shr:1 row_mask:0xf bank_mask:0xf bound_ctrl:1\n\t"
        "v_fmac_f32_dpp %3, %7, %15 row_shr:1 row_mask:0xf bank_mask:0xf bound_ctrl:1\n\t"
        "v_fmac_f32_dpp %0, %4, %16 row_shr:2 row_mask:0xf bank_mask:0xf bound_ctrl:1\n\t"
        "v_fmac_f32_dpp %1, %5, %17 row_shr:2 row_mask:0xf bank_mask:0xf bound_ctrl:1\n\t"
        "v_fmac_f32_dpp %2, %6, %18 row_shr:2 row_mask:0xf bank_mask:0xf bound_ctrl:1\n\t"
        "v_fmac_f32_dpp %3, %7, %19 row_shr:2 row_mask:0xf bank_mask:0xf bound_ctrl:1\n\t"
        "v_fmac_f32_dpp %0, %8, %12 row_shl:15 row_mask:0xf bank_mask:0xf bound_ctrl:1\n\t"
        "v_fmac_f32_dpp %1, %9, %13 row_shl:15 row_mask:0xf bank_mask:0xf bound_ctrl:1\n\t"
        "v_fmac_f32_dpp %2, %10, %14 row_shl:15 row_mask:0xf bank_mask:0xf bound_ctrl:1\n\t"
        "v_fmac_f32_dpp %3, %11, %15 row_shl:15 row_mask:0xf bank_mask:0xf bound_ctrl:1\n\t"
        "v_fmac_f32_dpp %0, %8, %16 row_shl:14 row_mask:0xf bank_mask:0xf bound_ctrl:1\n\t"
        "v_fmac_f32_dpp %1, %9, %17 row_shl:14 row_mask:0xf bank_mask:0xf bound_ctrl:1\n\t"
        "v_fmac_f32_dpp %2, %10, %18 row_shl:14 row_mask:0xf bank_mask:0xf bound_ctrl:1\n\t"
        "v_fmac_f32_dpp %3, %11, %19 row_shl:14 row_mask:0xf bank_mask:0xf bound_ctrl:1"
        : "+v"(c0), "+v"(c1), "+v"(c2), "+v"(c3)
        : "v"(x0), "v"(x1), "v"(x2), "v"(x3), "v"(p0), "v"(p1), "v"(p2), "v"(p3), "v"(a0), "v"(a1), "v"(a2), "v"(a3), "v"(b0), "v"(b1), "v"(b2), "v"(b3));
    c[0] = c0; c[1] = c1; c[2] = c2; c[3] = c3;
}
struct EpiHaloF {
    static constexpr bool PERM = true, AFTER_DRAIN = false;
    const float* ssq_in; float* ah; unsigned* flags;
    __device__ __forceinline__ void operator()(const f32x4 (&acc)[2][2][4][2], const Unit& u_, int wr, int wc, int fr, int fq) const {
        Unit u; { int pm_ = u_.pm, pn_ = u_.pn; asm volatile("" : "+s"(pm_), "+s"(pn_)); u.pm = pm_; u.pn = pn_; }
        const int col0 = u.pn * BM + wc * 32 + 8 * fq;
#pragma unroll
        for (int m = 0; m < 4; ++m) {
            const int rh = wr * 64 + m * 16 + fr;
            if (rh >= 2) {
                const int tok = 256 * (rh >> 1) - 2 + (rh & 1);
                const float rsh = row_rstd(ssq_in, tok);
#pragma unroll
                for (int bj = 0; bj < 2; ++bj) {
                    *(f32x4*)(ah + (size_t)rh * NFF2 + col0 + bj * HALF) = acc[0][bj][m][0] * rsh;
                    *(f32x4*)(ah + (size_t)rh * NFF2 + col0 + bj * HALF + 4) = acc[0][bj][m][1] * rsh;
                }
            }
        }
        asm volatile("s_waitcnt vmcnt(0)" ::: "memory"); __builtin_amdgcn_s_barrier(); asm volatile("" ::: "memory");
        if (wr == 0 && wc == 0 && fr == 0 && fq == 0) {
            __builtin_amdgcn_fence(__ATOMIC_RELEASE, "agent");
            asm volatile("s_waitcnt vmcnt(0)" ::: "memory");
            __hip_atomic_store(flags + 64 * u.pn, 1u, __ATOMIC_RELAXED, __HIP_MEMORY_SCOPE_AGENT);
        }
    }
};
struct EpiFfnIn {
    static constexpr bool PERM = true, AFTER_DRAIN = false;
    const float* ssq_in; const float* cw; const float* cb; float* ah; bf16_t* hid; PG8_LAS float* xb; unsigned* flags; unsigned phase_id;
    __device__ __forceinline__ void operator()(const f32x4 (&acc)[2][2][4][2], const Unit& u_, int wr, int wc, int fr, int fq) const {
        Unit u; { int pm_ = u_.pm, pn_ = u_.pn; asm volatile("" : "+s"(pm_), "+s"(pn_)); u.pm = pm_; u.pn = pn_; }
        PG8_LAS float* rtab = xb + 2048;
        const int row0 = u.pm * BM + wr * 64 + fr;
        PG8_LAS float* cwl = xb + 2432 + wc * 256;
        PG8_LAS float* hl = xb + 3456 + wc * 128;
        if (wr == 0) {
            const float* src = (fq < 3 ? cw + fq * NFF2 : cb) + (fr >> 3) * DFF + 128 * u.pn + wc * 32 + (fr & 7) * 4;
            const f32x4 wv = *(const f32x4*)src;
            rtab[wc * 64 + fq * 16 + fr] = row_rstd(ssq_in, u.pm * BM + wc * 64 + fq * 16 + fr);
            *(PG8_LAS f32x4*)(cwl + (fq * 16 + fr) * 4) = wv;
        }
        if (fr >= 14) {
#pragma unroll
            for (int ai = 0; ai < 2; ++ai) {
                PG8_LAS f32x4* dst = (PG8_LAS f32x4*)(xb + ((((ai * 2 + wr) * 4 + wc) * 2 + (fr - 14)) * 4 + fq) * 16);
#pragma unroll
                for (int bj = 0; bj < 2; ++bj)
#pragma unroll
                    for (int n = 0; n < 2; ++n) dst[bj * 2 + n] = acc[ai][bj][3][n];
            }
        }
        asm volatile("s_waitcnt lgkmcnt(0)" ::: "memory"); __builtin_amdgcn_s_barrier(); asm volatile("" ::: "memory");
        const bool has = (u.pm & 7) != 0;
        if (wr == 0) {
            PG8_LAS unsigned* stamp = (PG8_LAS unsigned*)(rtab + 256);
            if (*(volatile PG8_LAS unsigned*)stamp != phase_id) {
                if (wc == 0) {
                    unsigned sp = 0;
                    for (int t = 0; t < NFF2 / BM; ++t)
                        while (__hip_atomic_load(flags + 64 * t, __ATOMIC_RELAXED, __HIP_MEMORY_SCOPE_AGENT) == 0u) { __builtin_amdgcn_s_sleep(2); if (++sp > (1u << 22)) break; }
                    asm volatile("s_waitcnt vmcnt(0)" ::: "memory");
                    if (fr == 0 && fq == 0) *(volatile PG8_LAS unsigned*)stamp = phase_id;
                } else {
                    unsigned sp = 0;
                    while (*(volatile PG8_LAS unsigned*)stamp != phase_id) { __builtin_amdgcn_s_sleep(2); if (++sp > (1u << 22)) break; }
                }
            }
        }
        if (wr == 0) {
            f32x2 hv = {0.f, 0.f};
            if (has) hv = *(const f32x2*)(ah + (size_t)(2 * u.pm + (fq >> 1)) * NFF2 + (size_t)u.pn * BM + (fq & 1) * HALF + wc * 32 + 2 * fr);
            *(PG8_LAS f32x2*)(hl + (fq * 16 + fr) * 2) = hv;
        }
        float rs[2][4];
#pragma unroll
        for (int ai = 0; ai < 2; ++ai)
#pragma unroll
            for (int m = 0; m < 4; ++m) rs[ai][m] = rtab[ai * HALF + wr * 64 + m * 16 + fr];
        const f32x4 zero4 = {0.f, 0.f, 0.f, 0.f};
#pragma unroll
        for (int ai = 0; ai < 2; ++ai) {
#pragma unroll
            for (int n = 0; n < 2; ++n) {
                f32x4 cg[4];
#pragma unroll
                for (int bj = 0; bj < 2; ++bj) {
                    f32x4 b0, b1;
                    if (ai == 0 && wr == 0) {
                        b0 = *(const PG8_LAS f32x4*)(hl + (0 * 2 + bj) * 32 + 8 * fq + 4 * n);
                        b1 = *(const PG8_LAS f32x4*)(hl + (1 * 2 + bj) * 32 + 8 * fq + 4 * n);
                    } else {
                        const int sa = (wr == 1) ? ai : ai - 1, sw = (wr == 1) ? 0 : 1;
                        const float r0 = rtab[sa * HALF + sw * 64 + 62], r1 = rtab[sa * HALF + sw * 64 + 63];
                        b0 = *(const PG8_LAS f32x4*)(xb + ((((sa * 2 + sw) * 4 + wc) * 2 + 0) * 4 + fq) * 16 + (bj * 2 + n) * 4) * r0;
                        b1 = *(const PG8_LAS f32x4*)(xb + ((((sa * 2 + sw) * 4 + wc) * 2 + 1) * 4 + fq) * 16 + (bj * 2 + n) * 4) * r1;
                    }
                    const int oc = bj * 32 + 8 * fq + 4 * n;
                    const f32x4 w0 = *(const PG8_LAS f32x4*)(cwl + oc), w1 = *(const PG8_LAS f32x4*)(cwl + 64 + oc), w2 = *(const PG8_LAS f32x4*)(cwl + 128 + oc), bb = *(const PG8_LAS f32x4*)(cwl + 192 + oc);
                    f32x4 prev = (fr == 14) ? b0 : b1;
#pragma unroll
                    for (int m = 0; m < 4; ++m) {
                        const f32x4 cur = acc[ai][bj][m][n] * rs[ai][m];
                        f32x4 c = w2 * cur + bb;
                        conv_taps(c, cur, prev, w0, w1);
                        prev = cur;
                        if (bj == 0) cg[m] = c;
                        else {
                            const f32x2 ha = gelu_mul2((f32x2){cg[m][0], cg[m][1]}, (f32x2){c[0], c[1]}), hb = gelu_mul2((f32x2){cg[m][2], cg[m][3]}, (f32x2){c[2], c[3]});
                            u32x2 w; w.x = cvt_pk_bf16(ha.x, ha.y); w.y = cvt_pk_bf16(hb.x, hb.y);
                            const int row = row0 + ai * HALF + m * 16;
                            *(u32x2*)(hid + (size_t)row * DFF + 128 * u.pn + wc * 32 + 8 * fq + 4 * n) = w;
                        }
                    }
                    asm volatile("" ::: "memory");
                }
            }
        }
    }
};
template <class Epi, class Sched, bool ALIGN_EPI = false, bool SP2 = false>
__device__ __forceinline__ void gemm_phase(PG8_LAS unsigned char* lds, const Gemm g, const Sched& S, const Epi& E, const int wave_s) {
    const int tid_ = wave_s * 64 + lane_opaque(); const int tid = tid_, wid = __builtin_amdgcn_readfirstlane(tid >> 6), lane = tid & 63, wr = wid >> 2, wc = wid & 3, fr = lane & 15, fq = lane >> 4;
    const int K = g.K, nt = K / BK;
    unsigned voffA[2], voffB[2];
#pragma unroll
    for (int i = 0; i < 2; ++i) { int R, C; stage_rc(tid * 16 + i * 8192, R, C); const int Rb = Epi::PERM ? ((R & ~31) + perm32(R & 31)) : R;
        voffA[i] = (unsigned)(R * K + C) * 2u; voffB[i] = (unsigned)(Rb * K + C) * 2u; }
    const size_t kstep = (size_t)(BK * 2);
    const size_t hstep = (size_t)HALF * K * 2;
    const size_t tstep = 2 * hstep;
    const unsigned ldsw = (unsigned)wid * 1024u;
    const int aoff = lds_byte(wr * 64 + fr, fq * 8), boff = lds_byte(wc * 32 + fr, fq * 8);
#define PG8_SA(b, h) (((b) * 2 + (h)) * HTB)
#define PG8_SB(b, h) ((4 + (b) * 2 + (h)) * HTB)
#define PG8_STAGE(bufoff, gbase, voff) do { _Pragma("unroll") for (int _i = 0; _i < 2; ++_i) \
        __builtin_amdgcn_global_load_lds((const unsigned*)((const char*)(gbase) + (voff)[_i]), (PG8_LAS unsigned*)(lds + (bufoff) + ldsw + _i * 8192), 16, 0, 0); } while (0)
#define PG8_LDA(dst, b, h) do { _Pragma("unroll") for (int m = 0; m < 4; ++m) _Pragma("unroll") for (int k = 0; k < 2; ++k) dst[m][k] = *(const PG8_LAS bf16x8*)(lds + PG8_SA(b, h) + aoff + m * 2048 + k * 1024); } while (0)
#define PG8_LDB(dst, b, h) do { _Pragma("unroll") for (int n = 0; n < 2; ++n) _Pragma("unroll") for (int k = 0; k < 2; ++k) dst[n][k] = *(const PG8_LAS bf16x8*)(lds + PG8_SB(b, h) + boff + n * 2048 + k * 1024); } while (0)
#define PG8_MMA(ai, bj, At, Bt) do { __builtin_amdgcn_s_setprio(1); _Pragma("unroll") for (int m = 0; m < 4; ++m) _Pragma("unroll") for (int n = 0; n < 2; ++n) _Pragma("unroll") for (int k = 0; k < 2; ++k) \
        acc[ai][bj][m][n] = __builtin_amdgcn_mfma_f32_16x16x32_bf16(Bt[n][k], At[m][k], acc[ai][bj][m][n], 0, 0, 0); __builtin_amdgcn_s_setprio(0); } while (0)
#define PG8_WAIT_V(n) asm volatile("s_waitcnt vmcnt(" #n ")" ::: "memory")
#define PG8_WAIT_L(n) asm volatile("s_waitcnt lgkmcnt(" #n ")" ::: "memory")
#define PG8_BAR __builtin_amdgcn_s_barrier()
#define PG8_SCHED __builtin_amdgcn_sched_barrier(0)
    Unit cur, nxt; int ui = 0;
    if (!S.next(0, cur)) return;
    f32x4 acc[2][2][4][2];
#pragma unroll
    for (int a = 0; a < 2; ++a)
#pragma unroll
        for (int b = 0; b < 2; ++b)
#pragma unroll
            for (int m = 0; m < 4; ++m)
#pragma unroll
                for (int n = 0; n < 2; ++n) acc[a][b][m][n] = (f32x4){0.f, 0.f, 0.f, 0.f};
    bf16x8 At[4][2], B0[2][2], B1[2][2];
    const char* cA = (const char*)g.A + (size_t)cur.pm * tstep; const char* cB = (const char*)g.Bt + (size_t)cur.pn * tstep;
    S.a_ready(cur);
    if constexpr (SP2) {
        PG8_STAGE(PG8_SB(0, 0), cB, voffB); PG8_STAGE(PG8_SB(0, 1), cB + hstep, voffB); PG8_STAGE(PG8_SA(0, 0), cA, voffA); PG8_STAGE(PG8_SA(0, 1), cA + hstep, voffA);
        if (wr == 1) PG8_BAR;
        PG8_WAIT_V(2); PG8_BAR;
        PG8_STAGE(PG8_SB(1, 0), cB + kstep, voffB); PG8_STAGE(PG8_SA(1, 0), cA + kstep, voffA); PG8_STAGE(PG8_SB(1, 1), cB + hstep + kstep, voffB);
        PG8_WAIT_V(6); PG8_BAR;
    } else {
        PG8_STAGE(PG8_SB(0, 0), cB, voffB); PG8_STAGE(PG8_SA(0, 0), cA, voffA); PG8_STAGE(PG8_SB(0, 1), cB + hstep, voffB); PG8_STAGE(PG8_SA(0, 1), cA + hstep, voffA);
        if (wr == 1) PG8_BAR;
        PG8_WAIT_V(4); PG8_BAR;
        PG8_STAGE(PG8_SB(1, 0), cB + kstep, voffB); PG8_STAGE(PG8_SA(1, 0), cA + kstep, voffA); PG8_STAGE(PG8_SB(1, 1), cB + hstep + kstep, voffB);
        PG8_WAIT_V(6); PG8_BAR;
    }
    for (;;) {
        const bool has_next = S.next(ui + 1, nxt);
        const char* nA = has_next ? (const char*)g.A + (size_t)nxt.pm * tstep : cA; const char* nB = has_next ? (const char*)g.Bt + (size_t)nxt.pn * tstep : cB;
        for (int t = 0; t < nt; t += 2) {
            const bool last = (t == nt - 2);
            const char* a1 = cA + (size_t)(t + 1) * kstep;
            const char* a2 = last ? nA : cA + (size_t)(t + 2) * kstep; const char* b2 = last ? nB : cB + (size_t)(t + 2) * kstep;
            const char* a3 = a2 + kstep; const char* b3 = b2 + kstep;
            if (last && has_next) S.a_ready(nxt);
            if constexpr (SP2) {
            PG8_LDB(B0, 0, 0); PG8_LDB(B1, 0, 1); PG8_SCHED; PG8_LDA(At, 0, 0); PG8_STAGE(PG8_SA(1, 1), a1 + hstep, voffA);
            PG8_WAIT_V(8); PG8_WAIT_L(0); PG8_BAR; PG8_MMA(0, 0, At, B0); PG8_MMA(0, 1, At, B1); PG8_BAR; PG8_SCHED;
            PG8_LDA(At, 0, 1); PG8_STAGE(PG8_SB(0, 0), b2, voffB); PG8_STAGE(PG8_SB(0, 1), b2 + hstep, voffB); PG8_STAGE(PG8_SA(0, 0), a2, voffA);
            PG8_WAIT_V(8); PG8_WAIT_L(0); PG8_BAR; PG8_MMA(1, 0, At, B0); PG8_MMA(1, 1, At, B1); PG8_BAR; PG8_SCHED;
            PG8_LDB(B0, 1, 0); PG8_LDB(B1, 1, 1); PG8_SCHED; PG8_LDA(At, 1, 0); PG8_STAGE(PG8_SA(0, 1), a2 + hstep, voffA);
            PG8_WAIT_V(8); PG8_WAIT_L(0); PG8_BAR; PG8_MMA(0, 0, At, B0); PG8_MMA(0, 1, At, B1); PG8_BAR; PG8_SCHED;
            PG8_LDA(At, 1, 1); PG8_STAGE(PG8_SB(1, 0), b3, voffB); PG8_STAGE(PG8_SB(1, 1), b3 + hstep, voffB); PG8_STAGE(PG8_SA(1, 0), a3, voffA);
            PG8_WAIT_V(8); PG8_WAIT_L(0); PG8_BAR; PG8_MMA(1, 0, At, B0); PG8_MMA(1, 1, At, B1); PG8_BAR; PG8_SCHED;
            } else {
            PG8_LDB(B0, 0, 0); PG8_SCHED; PG8_LDA(At, 0, 0); PG8_STAGE(PG8_SA(1, 1), a1 + hstep, voffA);
            PG8_WAIT_L(8); PG8_BAR; PG8_WAIT_L(0); PG8_MMA(0, 0, At, B0); PG8_BAR; PG8_SCHED;
            PG8_LDB(B1, 0, 1); PG8_STAGE(PG8_SB(0, 0), b2, voffB);
            PG8_BAR; PG8_WAIT_L(0); PG8_MMA(0, 1, At, B1); PG8_BAR;
            PG8_LDA(At, 0, 1); PG8_STAGE(PG8_SA(0, 0), a2, voffA);
            PG8_BAR; PG8_WAIT_L(0); PG8_MMA(1, 0, At, B0); PG8_BAR; PG8_SCHED;
            PG8_STAGE(PG8_SB(0, 1), b2 + hstep, voffB);
            PG8_WAIT_V(6); PG8_BAR; PG8_MMA(1, 1, At, B1); PG8_BAR;
            PG8_LDB(B0, 1, 0); PG8_SCHED; PG8_LDA(At, 1, 0); PG8_STAGE(PG8_SA(0, 1), a2 + hstep, voffA);
            PG8_WAIT_L(8); PG8_BAR; PG8_WAIT_L(0); PG8_MMA(0, 0, At, B0); PG8_BAR; PG8_SCHED;
            PG8_LDB(B1, 1, 1); PG8_STAGE(PG8_SB(1, 0), b3, voffB);
            PG8_BAR; PG8_WAIT_L(0); PG8_MMA(0, 1, At, B1); PG8_BAR;
            PG8_LDA(At, 1, 1); PG8_STAGE(PG8_SA(1, 0), a3, voffA);
            PG8_BAR; PG8_WAIT_L(0); PG8_MMA(1, 0, At, B0); PG8_BAR; PG8_SCHED;
            PG8_STAGE(PG8_SB(1, 1), b3 + hstep, voffB);
            PG8_WAIT_V(6); PG8_BAR; PG8_MMA(1, 1, At, B1); PG8_BAR;
            }
        }
        if constexpr (ALIGN_EPI) { if (wr == 0) PG8_BAR; }
        if constexpr (!Epi::AFTER_DRAIN) { E(acc, cur, wr, wc, fr, fq); S.done(cur); }
        if (!has_next) break;
#pragma unroll
        for (int a = 0; a < 2; ++a)
#pragma unroll
            for (int b = 0; b < 2; ++b)
#pragma unroll
                for (int m = 0; m < 4; ++m)
#pragma unroll
                    for (int n = 0; n < 2; ++n) acc[a][b][m][n] = (f32x4){0.f, 0.f, 0.f, 0.f};
        cur = nxt; cA = nA; cB = nB; ++ui;
        if constexpr (ALIGN_EPI) { if (wr == 1) PG8_BAR; }
    }
    PG8_WAIT_V(0);
    if constexpr (!ALIGN_EPI) { if (wr == 0) PG8_BAR; }
    PG8_BAR;
    if constexpr (Epi::AFTER_DRAIN) { E.fused(acc, cur, wr, wc, fr, fq, lds, wid, lane); S.done(cur); }
#undef PG8_SA
#undef PG8_SB
#undef PG8_STAGE
#undef PG8_LDA
#undef PG8_LDB
#undef PG8_MMA
#undef PG8_WAIT_V
#undef PG8_WAIT_L
#undef PG8_BAR
#undef PG8_SCHED
}
}
namespace mix {
#define MLAS __attribute__((address_space(3)))
typedef unsigned short bf16_t;
typedef short bf16x8 __attribute__((ext_vector_type(8)));
typedef short s16x4 __attribute__((ext_vector_type(4)));
typedef float f32x16 __attribute__((ext_vector_type(16)));
typedef float f32x4 __attribute__((ext_vector_type(4)));
typedef float f32x2 __attribute__((ext_vector_type(2)));
typedef unsigned u32x4 __attribute__((ext_vector_type(4)));
typedef unsigned u32x2 __attribute__((ext_vector_type(2)));
typedef MLAS const char* lds_cptr;
typedef short v4i16_t __attribute__((ext_vector_type(4)));
typedef __bf16 bf16x2_t __attribute__((ext_vector_type(2)));

constexpr int SLOTB = 8192;
constexpr int NSLOT = 4;
constexpr int L_K = 0, L_V = NSLOT * SLOTB, L_WSF = 2 * NSLOT * SLOTB, L_OST = L_WSF + 8 * 256, L_X = L_OST + 8 * 4096;
constexpr int LX_IQ = L_X, LX_EQ = L_X, LX_PFX = L_X + 8192, LX_CNT = LX_IQ + 16384, LX_GT = LX_CNT + 2048, LX_SEL = LX_GT, LX_END = LX_GT + 8192;
static_assert(LX_END <= 131072, "mixer LDS map");

__device__ __forceinline__ int crow(int r, int hi) { return (r & 3) + 8 * (r >> 2) + 4 * hi; }
__device__ __forceinline__ void glds16(const void* gsrc, unsigned lds_dst) { unsigned keep;
    asm volatile("s_mov_b32 %0, m0\n\ts_mov_b32 m0, %2\n\ts_nop 0\n\tglobal_load_lds_dwordx4 %1, off\n\ts_mov_b32 m0, %0" : "=&s"(keep) : "v"(gsrc), "s"(lds_dst) : "memory"); }
__device__ __forceinline__ unsigned cvtpk(float lo, float hi) { f32x2 v = {lo, hi}; bf16x2_t b = __builtin_convertvector(v, bf16x2_t); return __builtin_bit_cast(unsigned, b); }
__device__ __forceinline__ s16x4 vtr(lds_cptr p) { return __builtin_bit_cast(s16x4, __builtin_amdgcn_ds_read_tr16_b64_v4i16((MLAS v4i16_t*)p)); }
#define WAITV_BAR() asm volatile("s_waitcnt vmcnt(0) lgkmcnt(0)\n\ts_barrier" ::: "memory")
#define LGKM_BAR() asm volatile("s_waitcnt lgkmcnt(0)\n\ts_barrier" ::: "memory")
#define WAITV2_BAR() asm volatile("s_waitcnt vmcnt(2) lgkmcnt(0)\n\ts_barrier" ::: "memory")

__device__ __forceinline__ void dma_kv(const bf16_t* kbase, const bf16_t* vbase, int pitch, unsigned lds0, int slot, int wid, int lane) {
    const bf16_t* ks = kbase + (size_t)lane * pitch + wid * 8;
    const bf16_t* vs = vbase + (size_t)(16 * (wid & 3) + (lane >> 2)) * pitch + (wid >> 2) * 32 + (lane & 3) * 8;
    glds16(ks, (unsigned)__builtin_amdgcn_readfirstlane(lds0 + L_K + slot * SLOTB + wid * 1024));
    glds16(vs, (unsigned)__builtin_amdgcn_readfirstlane(lds0 + L_V + slot * SLOTB + wid * 1024));
}
__device__ __forceinline__ void kload(bf16x8 (&kf)[8], lds_cptr kslot, int r32, int hi) {
    lds_cptr kb = kslot + hi * 1024 + r32 * 16;
#pragma unroll
    for (int d0 = 0; d0 < 4; ++d0) { kf[2 * d0] = *(const MLAS bf16x8*)(kb + d0 * 2048); kf[2 * d0 + 1] = *(const MLAS bf16x8*)(kb + d0 * 2048 + 512); }
}
__device__ __forceinline__ void qkt_mma(f32x16& p0, f32x16& p1, const bf16x8 (&kf)[8], const bf16x8* qr, const f32x16& cinit) {
    p0 = __builtin_amdgcn_mfma_f32_32x32x16_bf16(kf[0], qr[0], cinit, 0, 0, 0); p1 = __builtin_amdgcn_mfma_f32_32x32x16_bf16(kf[1], qr[0], cinit, 0, 0, 0);
#pragma unroll
    for (int d0 = 1; d0 < 4; ++d0) { p0 = __builtin_amdgcn_mfma_f32_32x32x16_bf16(kf[2 * d0], qr[d0], p0, 0, 0, 0); p1 = __builtin_amdgcn_mfma_f32_32x32x16_bf16(kf[2 * d0 + 1], qr[d0], p1, 0, 0, 0); }
}
__device__ __forceinline__ void qkt(f32x16& p0, f32x16& p1, lds_cptr kslot, const bf16x8* qr, const f32x16& cinit, int r32, int hi) {
    bf16x8 kf[8]; kload(kf, kslot, r32, hi); qkt_mma(p0, p1, kf, qr, cinit);
}
__device__ __forceinline__ void vload(bf16x8 (&vf)[8], lds_cptr vslot, int lane, int hi) {
    lds_cptr vp = vslot + ((lane >> 4) & 1) * 32 + (lane & 3) * 8 + (4 * hi + ((lane & 15) >> 2)) * 64;
#pragma unroll
    for (int d0 = 0; d0 < 2; ++d0)
#pragma unroll
        for (int ks = 0; ks < 4; ++ks) {
            const s16x4 lo = vtr(vp + d0 * 4096 + ks * 1024), hh = vtr(vp + d0 * 4096 + ks * 1024 + 512);
            vf[d0 * 4 + ks] = (bf16x8){lo[0], lo[1], lo[2], lo[3], hh[0], hh[1], hh[2], hh[3]};
        }
}
#define V16_TO_ARR(v, a, o) do { a[(o) + 0] = v[0]; a[(o) + 1] = v[1]; a[(o) + 2] = v[2]; a[(o) + 3] = v[3]; a[(o) + 4] = v[4]; a[(o) + 5] = v[5]; a[(o) + 6] = v[6]; a[(o) + 7] = v[7]; \
    a[(o) + 8] = v[8]; a[(o) + 9] = v[9]; a[(o) + 10] = v[10]; a[(o) + 11] = v[11]; a[(o) + 12] = v[12]; a[(o) + 13] = v[13]; a[(o) + 14] = v[14]; a[(o) + 15] = v[15]; } while (0)
__device__ __forceinline__ f32x16 splat16(float x) { return (f32x16){x, x, x, x, x, x, x, x, x, x, x, x, x, x, x, x}; }
struct AttnState { f32x16 o[2]; float m, l, pend; bool started; };
constexpr float ATT_THR = 8.0f;
__device__ __forceinline__ void softmax_pv(AttnState& st, float (&sc)[32], const bf16x8 (&vf)[8], MLAS float* wsf, int lane, int r32, int hi) {
    if (__any(st.pend != 0.f)) {
#pragma unroll
        for (int r = 0; r < 32; ++r) sc[r] -= st.pend;
    }
    st.pend = 0.f;
    float ra = __builtin_fmaxf(__builtin_fmaxf(sc[0], sc[1]), sc[2]), rb = __builtin_fmaxf(__builtin_fmaxf(sc[3], sc[4]), sc[5]);
#pragma unroll
    for (int r = 6; r < 30; r += 4) { ra = __builtin_fmaxf(__builtin_fmaxf(ra, sc[r]), sc[r + 1]); rb = __builtin_fmaxf(__builtin_fmaxf(rb, sc[r + 2]), sc[r + 3]); }
    float rm = __builtin_fmaxf(__builtin_fmaxf(ra, rb), __builtin_fmaxf(sc[30], sc[31]));
    rm = halves_max_f(rm);
    const bool fresh = !st.started;
    const bool need = (rm > ATT_THR) || (fresh && rm < -ATT_THR && rm > -1e29f);
    st.started = st.started || (rm > -1e29f);
    if (__any(need)) {
        const float dl = need ? rm : 0.f;
        st.m += dl; st.pend = dl;
#pragma unroll
        for (int r = 0; r < 32; ++r) sc[r] -= dl;
        const float alpha = fresh ? 1.0f : __builtin_amdgcn_exp2f(-dl);
        st.l *= alpha;
        if (hi == 0) wsf[r32] = alpha;
        float fr_[16];
#pragma unroll
        for (int r = 0; r < 16; ++r) fr_[r] = wsf[crow(r, hi)];
        const f32x16 fv = {fr_[0], fr_[1], fr_[2], fr_[3], fr_[4], fr_[5], fr_[6], fr_[7], fr_[8], fr_[9], fr_[10], fr_[11], fr_[12], fr_[13], fr_[14], fr_[15]};
        st.o[0] = st.o[0] * fv; st.o[1] = st.o[1] * fv;
    }
    float pe[32]; float s0 = 0.f, s1 = 0.f;
#pragma unroll
    for (int r = 0; r < 32; r += 2) { pe[r] = __builtin_amdgcn_exp2f(sc[r]); pe[r + 1] = __builtin_amdgcn_exp2f(sc[r + 1]); s0 += pe[r]; s1 += pe[r + 1]; }
    st.l += s0 + s1;
    u32x4 pw[4];
#pragma unroll
    for (int k = 0; k < 4; ++k) pw[k] = (u32x4){cvtpk(pe[8 * k + 0], pe[8 * k + 1]), cvtpk(pe[8 * k + 2], pe[8 * k + 3]), cvtpk(pe[8 * k + 4], pe[8 * k + 5]), cvtpk(pe[8 * k + 6], pe[8 * k + 7])};
#pragma unroll
    for (int d0 = 0; d0 < 2; ++d0)
#pragma unroll
        for (int ks = 0; ks < 4; ++ks) st.o[d0] = __builtin_amdgcn_mfma_f32_32x32x16_bf16(__builtin_bit_cast(bf16x8, pw[ks]), vf[d0 * 4 + ks], st.o[d0], 0, 0, 0);
}
__device__ __forceinline__ void attn_store(AttnState& st, bf16_t* Ow, int pitch, MLAS float* wsf, MLAS bf16_t* stg, int lane, int r32, int hi) {
    float l = halves_sum_f(st.l);
    if (hi == 0) wsf[32 + r32] = l;
    float rli[16];
#pragma unroll
    for (int r = 0; r < 16; ++r) rli[r] = 1.0f / wsf[32 + crow(r, hi)];
#pragma unroll
    for (int r = 0; r < 16; ++r) { const int orow = crow(r, hi);
#pragma unroll
        for (int d0 = 0; d0 < 2; ++d0) { const unsigned short b = (unsigned short)(cvtpk(st.o[d0][r] * rli[r], 0.f) & 0xffffu); stg[orow * 64 + d0 * 32 + r32] = b; } }
#pragma unroll
    for (int i = 0; i < 4; ++i) { const int row = i * 8 + (lane >> 3), ch = lane & 7; const u32x4 v = *(const MLAS u32x4*)(stg + row * 64 + ch * 8); *(u32x4*)(Ow + (size_t)row * pitch + ch * 8) = v; }
}

#ifndef DBG_REP_BS
#define DBG_REP_BS 1
#endif
__device__ __forceinline__ unsigned pk_sub_sat_u16(unsigned a, unsigned b) { unsigned r; asm("v_pk_sub_u16 %0, %1, %2 clamp" : "=v"(r) : "v"(a), "v"(b)); return r; }
__device__ __forceinline__ unsigned pk_min_u16(unsigned a, unsigned b) { unsigned r; asm("v_pk_min_u16 %0, %1, %2" : "=v"(r) : "v"(a), "v"(b)); return r; }
__device__ __forceinline__ unsigned pk_add_u16(unsigned a, unsigned b) { unsigned r; asm("v_pk_add_u16 %0, %1, %2" : "=v"(r) : "v"(a), "v"(b)); return r; }
__device__ __forceinline__ unsigned pk_ashr_i16(unsigned a, unsigned sh2) { unsigned r; asm("v_pk_ashrrev_i16 %0, %1, %2" : "=v"(r) : "v"(sh2), "v"(a)); return r; }
__device__ __forceinline__ unsigned score_keys(float a, float b) {
    const unsigned p = __builtin_bit_cast(unsigned, __builtin_amdgcn_cvt_pkrtz(a, b));
    const unsigned m = pk_ashr_i16(p, 0x000f000fu);
    return p ^ (m | 0x80008000u);
}
template <int NS> __device__ __forceinline__ unsigned bit_search(const unsigned (&kp)[8][8], MLAS unsigned* cntx, int wid, int r32, int hi) {
    unsigned tau = 0u;
#pragma unroll 1
    for (int bit = 15; bit >= 0; --bit) {
        const unsigned cand = tau | (1u << bit);
        const unsigned c2 = (cand - 1u) * 0x00010001u;
        unsigned cnt2 = 0;
#pragma unroll
        for (int jj = 0; jj < NS; ++jj)
#pragma unroll
            for (int r = 0; r < 8; ++r) cnt2 = pk_add_u16(cnt2, pk_min_u16(pk_sub_sat_u16(kp[jj][r], c2), 0x00010001u));
        unsigned cnt = (cnt2 & 0xffffu) + (cnt2 >> 16);
        cnt = halves_add_u(cnt);
        MLAS unsigned* cb = cntx + (bit & 1) * 256;
        if (hi == 0) cb[wid * 32 + r32] = cnt;
        LGKM_BAR();
        unsigned tot = 0;
#pragma unroll
        for (int w = 0; w < 8; ++w) tot += cb[w * 32 + r32];
        if (tot >= 256u) tau = cand;
    }
    return tau;
}
__device__ __forceinline__ void dsa_select(int b, int qg, const bf16_t* Z0, char* shm, const int wave_s) {
    const int tid_ = wave_s * 64 + lane_opaque(); const int tid = tid_, lane = tid & 63, r32 = lane & 31, hi = lane >> 5; const int wid = __builtin_amdgcn_readfirstlane(tid >> 6);
    MLAS char* L = (MLAS char*)shm;
    const int c = qg >> 1, nkeys = 64 * (c + 1), nt32 = nkeys >> 5, nt64 = nkeys >> 6;
    const size_t rowb = (size_t)b * SEQ;
    const size_t tok0 = rowb + 32 * qg;
    MLAS unsigned* selw = (MLAS unsigned*)(L + LX_SEL);
    if (nkeys <= 256) {
        for (int i = tid; i < 64 * 32; i += 512) selw[i] = (i < nt32 * 32) ? 0xffffffffu : 0u;
    } else {
        {
            MLAS u32x4* iqL = (MLAS u32x4*)(L + LX_IQ);
            for (int i = tid; i < 1024; i += 512) { const int q = i & 31, hh = (i >> 5) & 1, d0 = (i >> 6) & 3, h = i >> 8;
                iqL[i] = *(const u32x4*)(Z0 + (tok0 + q) * EV_N + 1280 + 64 * h + 16 * d0 + 8 * hh); }
        }
        float w4[4];
        { const u32x2 ww = *(const u32x2*)(Z0 + (tok0 + r32) * EV_N + 1216);
          w4[0] = pg8::bf_lo(ww.x) * 0.0625f; w4[1] = pg8::bf_hi(ww.x) * 0.0625f; w4[2] = pg8::bf_lo(ww.y) * 0.0625f; w4[3] = pg8::bf_hi(ww.y) * 0.0625f; }
        LGKM_BAR();
        unsigned kp[8][8];
        const int nslots = (nt32 + 7) >> 3;
        const MLAS bf16x8* iqf = (const MLAS bf16x8*)(L + LX_IQ) + hi * 32 + r32;
#pragma unroll
        for (int jj = 0; jj < 8; ++jj) {
            const int j = wid + 8 * jj;
            if (j < nt32) {
                const bf16_t* ikp = Z0 + (rowb + 32 * j + r32) * EV_N + 1152 + 8 * hi;
                bf16x8 af[4];
#pragma unroll
                for (int d0 = 0; d0 < 4; ++d0) af[d0] = *(const bf16x8*)(ikp + 16 * d0);
                f32x16 ah[4];
#pragma unroll
                for (int h = 0; h < 4; ++h) {
                    f32x16 a = {};
#pragma unroll
                    for (int d0 = 0; d0 < 4; ++d0) a = __builtin_amdgcn_mfma_f32_32x32x16_bf16(af[d0], iqf[(h * 4 + d0) * 64], a, 0, 0, 0);
                    ah[h] = a;
                }
                float sv[16];
                {
                    float a0[16], a1[16], a2[16], a3[16];
                    V16_TO_ARR(ah[0], a0, 0); V16_TO_ARR(ah[1], a1, 0); V16_TO_ARR(ah[2], a2, 0); V16_TO_ARR(ah[3], a3, 0);
#pragma unroll
                    for (int r = 0; r < 16; ++r) sv[r] = ((__builtin_fmaxf(a0[r], 0.f) * w4[0] + __builtin_fmaxf(a1[r], 0.f) * w4[1]) + __builtin_fmaxf(a2[r], 0.f) * w4[2]) + __builtin_fmaxf(a3[r], 0.f) * w4[3];
                }
#pragma unroll
                for (int r = 0; r < 8; ++r) kp[jj][r] = score_keys(sv[r], sv[r + 8]);
            } else {
#pragma unroll
                for (int r = 0; r < 8; ++r) kp[jj][r] = 0u;
            }
        }
        MLAS unsigned* cntx = (MLAS unsigned*)(L + L_OST);
        unsigned tau;
        for (int rep_ = 0; rep_ < DBG_REP_BS; ++rep_)
        switch (nslots) {
            case 2: tau = bit_search<2>(kp, cntx, wid, r32, hi); break;
            case 3: tau = bit_search<3>(kp, cntx, wid, r32, hi); break;
            case 4: tau = bit_search<4>(kp, cntx, wid, r32, hi); break;
            case 5: tau = bit_search<5>(kp, cntx, wid, r32, hi); break;
            case 6: tau = bit_search<6>(kp, cntx, wid, r32, hi); break;
            case 7: tau = bit_search<7>(kp, cntx, wid, r32, hi); break;
            default: tau = bit_search<8>(kp, cntx, wid, r32, hi); break;
        }
        MLAS unsigned* gtw = (MLAS unsigned*)(L + LX_GT); MLAS unsigned* eqw = (MLAS unsigned*)(L + LX_EQ); MLAS unsigned* pfx = (MLAS unsigned*)(L + LX_PFX);
        const unsigned tg = tau * 0x00010001u, te = (tau - 1u) * 0x00010001u;
#pragma unroll
        for (int jj = 0; jj < 8; ++jj) {
            const int j = wid + 8 * jj;
            if (j < nt32) {
                unsigned g = 0, e = 0;
#pragma unroll
                for (int r = 0; r < 8; ++r) {
                    const unsigned dgt = pk_min_u16(pk_sub_sat_u16(kp[jj][r], tg), 0x00010001u), dge = pk_min_u16(pk_sub_sat_u16(kp[jj][r], te), 0x00010001u);
                    const int pos = (r & 3) + 8 * (r >> 2);
                    g |= dgt << pos; e |= (dge - dgt) << pos;
                }
                g <<= 4 * hi; e <<= 4 * hi;
                g = halves_or_u(g); e = halves_or_u(e);
                if (hi == 0) { gtw[j * 32 + r32] = g; eqw[j * 32 + r32] = e; }
            }
        }
        LGKM_BAR();
        if (wid == 0 && hi == 0) {
            unsigned cg = 0;
            for (int j = 0; j < nt32; ++j) cg += __builtin_popcount(gtw[j * 32 + r32]);
            const int need = 256 - (int)cg;
            int run = 0;
            for (int j = 0; j < nt32; ++j) { const unsigned e = eqw[j * 32 + r32]; int k = need - run; k = k < 0 ? 0 : (k > 32 ? 32 : k); pfx[j * 32 + r32] = (unsigned)k; run += __builtin_popcount(e); }
        }
        LGKM_BAR();
        for (int i = tid; i < nt32 * 32; i += 512) {
            const unsigned g = gtw[i], e = eqw[i]; const int k = (int)pfx[i];
            unsigned take = 0;
            if (e != 0u && k > 0) {
                unsigned rem = e; int cntk = 0;
                while (rem != 0u && cntk < k) { const unsigned low = rem & (0u - rem); take |= low; rem ^= low; ++cntk; }
            }
            selw[i] = g | take;
        }
        for (int i = nt32 * 32 + tid; i < 64 * 32; i += 512) selw[i] = 0u;
    }
    WAITV_BAR();
}

__device__ __forceinline__ void fox_unit(int b, int h, int qb, const bf16_t* Z1, const float* F, const float* bfp, bf16_t* Y, char* shm, unsigned lds0, const int wave_s) {
    const int tid_ = wave_s * 64 + lane_opaque(); const int tid = tid_, lane = tid & 63, r32 = lane & 31, hi = lane >> 5; const int wid = __builtin_amdgcn_readfirstlane(tid >> 6);
    MLAS char* L = (MLAS char*)shm;
    const size_t rowb = (size_t)b * SEQ;
    const int NT = 4 * (qb + 1), nk = 64 * NT;
    MLAS float* cum2 = (MLAS float*)(L + L_X);
    MLAS float* wtot = (MLAS float*)(L + L_X + 8192);
    const bf16_t* Kb = Z1 + rowb * Z1P + 512 + 64 * h; const bf16_t* Vb = Z1 + rowb * Z1P + 1024 + 64 * h;
#pragma unroll
    for (int i = 0; i < 3; ++i) dma_kv(Kb + (size_t)64 * i * Z1P, Vb + (size_t)64 * i * Z1P, Z1P, lds0, i, wid, lane);
    {
        const float bias = bfp[h];
        const int s0 = 4 * tid;
        float v[4]; float run = 0.f;
#pragma unroll
        for (int i = 0; i < 4; ++i) {
            float x = 0.f;
            if (s0 + i < nk) x = F[(rowb + s0 + i) * 8 + h] + bias;
            const float ls = (s0 + i < nk) ? (fminf(x, 0.f) - log1pf(expf(-fabsf(x)))) : 0.f;
            run += ls; v[i] = run;
        }
        float inc = run;
#pragma unroll
        for (int o = 1; o < 64; o <<= 1) { const int ln = lane_opaque(); const float t = __builtin_bit_cast(float, __builtin_amdgcn_ds_bpermute((ln - o) << 2, __builtin_bit_cast(int, inc))); if (ln >= o) inc += t; }
        if (lane == 63) wtot[wid] = inc;
        LGKM_BAR();
        float off = inc - run;
        for (int w = 0; w < wid; ++w) off += wtot[w];
#pragma unroll
        for (int i = 0; i < 4; ++i) cum2[s0 + i] = (off + v[i]) * 1.4426950408889634f;
    }
    const int tq = 256 * qb + 32 * wid + r32;
    bf16x8 qr[4];
#pragma unroll
    for (int d0 = 0; d0 < 4; ++d0) qr[d0] = *(const bf16x8*)(Z1 + (rowb + tq) * Z1P + 64 * h + 16 * d0 + 8 * hi);
    AttnState st; st.o[0] = f32x16{}; st.o[1] = f32x16{}; st.m = 0.f; st.l = 0.f; st.pend = 0.f; st.started = false;
    MLAS float* wsf = (MLAS float*)(L + L_WSF) + wid * 64;
    WAITV_BAR();
    const float cq2 = cum2[tq];
    const int tlast = 4 * qb + (wid >> 1);
    f32x16 s0, s1;
    qkt(s0, s1, (lds_cptr)(L + L_K), qr, splat16(-st.m), r32, hi);
    for (int t = 0; t < NT; ++t) {
        const int slot = t & 3;
        { const int tt = (t + 3 < NT) ? t + 3 : NT - 1; dma_kv(Kb + (size_t)64 * tt * Z1P, Vb + (size_t)64 * tt * Z1P, Z1P, lds0, (t + 3) & 3, wid, lane); }
        bf16x8 kf[8], vf[8];
        kload(kf, (lds_cptr)(L + L_K + ((t + 1) & 3) * SLOTB), r32, hi);
        __builtin_amdgcn_sched_barrier(0);
        vload(vf, (lds_cptr)(L + L_V + slot * SLOTB), lane, hi);
        const MLAS float* cb = cum2 + 64 * t + 4 * hi;
        f32x4 c0[4], c1[4];
#pragma unroll
        for (int g = 0; g < 4; ++g) { c0[g] = *(const MLAS f32x4*)(cb + 8 * g); c1[g] = *(const MLAS f32x4*)(cb + 32 + 8 * g); }
        f32x16 n0, n1;
        qkt_mma(n0, n1, kf, qr, splat16(-st.m));
        float sc[32];
        V16_TO_ARR(s0, sc, 0); V16_TO_ARR(s1, sc, 16);
#pragma unroll
        for (int g = 0; g < 4; ++g) {
            sc[4 * g + 0] += cq2 - c0[g].x; sc[4 * g + 1] += cq2 - c0[g].y; sc[4 * g + 2] += cq2 - c0[g].z; sc[4 * g + 3] += cq2 - c0[g].w;
            sc[16 + 4 * g + 0] += cq2 - c1[g].x; sc[16 + 4 * g + 1] += cq2 - c1[g].y; sc[16 + 4 * g + 2] += cq2 - c1[g].z; sc[16 + 4 * g + 3] += cq2 - c1[g].w;
        }
        if (t >= tlast) {
            const int qrel = tq - 64 * t;
#pragma unroll
            for (int r = 0; r < 16; ++r) { const int kr = crow(r, hi); if (kr > qrel) sc[r] = -INFINITY; if (kr + 32 > qrel) sc[16 + r] = -INFINITY; }
        }
        softmax_pv(st, sc, vf, wsf, lane, r32, hi);
        s0 = n0; s1 = n1;
        WAITV2_BAR();
    }
    attn_store(st, Y + (rowb + 256 * qb + 32 * wid) * DMODEL + 64 * h, DMODEL, wsf, (MLAS bf16_t*)(L + L_OST) + wid * 2048, lane, r32, hi);
    WAITV_BAR();
}

__device__ __forceinline__ void sgu_unit(int b, int n, int g, const bf16_t* Z1, const float* sst, const float* lng, const float* lnb, const bf16_t* Wm, const float* bs, bf16_t* Y, char* shm, const int wave_s) {
    const int tid_ = wave_s * 64 + lane_opaque(); const int tid = tid_, lane = tid & 63, r32 = lane & 31, hi = lane >> 5; const int wid = __builtin_amdgcn_readfirstlane(tid >> 6);
    MLAS char* L = (MLAS char*)shm;
    MLAS bf16_t* vn = (MLAS bf16_t*)L;
    constexpr int VP = 136;
    const size_t tok0 = (size_t)b * SEQ + 128 * n;
    {
        const int j = tid >> 2, cq = (tid & 3) * 32;
        const float* sp = sst + (tok0 + j) * 16;
        float s1 = 0.f, s2 = 0.f;
#pragma unroll
        for (int k = 0; k < 8; ++k) { s1 += sp[2 * k]; s2 += sp[2 * k + 1]; }
        const float mu = s1 * (1.0f / 512.0f); const float var = fmaxf(s2 * (1.0f / 512.0f) - mu * mu, 0.f);
        const float rstd = 1.0f / sqrtf(var + RMS_EPS);
        const bf16_t* vp = Z1 + (tok0 + j) * Z1P + 2048 + 128 * g + cq;
#pragma unroll
        for (int k = 0; k < 4; ++k) {
            const u32x4 w = *(const u32x4*)(vp + 8 * k);
            const int cc = 128 * g + cq + 8 * k;
            const f32x4 g0 = *(const f32x4*)(lng + cc), g1 = *(const f32x4*)(lng + cc + 4), b0 = *(const f32x4*)(lnb + cc), b1 = *(const f32x4*)(lnb + cc + 4);
            float x[8] = {pg8::bf_lo(w.x), pg8::bf_hi(w.x), pg8::bf_lo(w.y), pg8::bf_hi(w.y), pg8::bf_lo(w.z), pg8::bf_hi(w.z), pg8::bf_lo(w.w), pg8::bf_hi(w.w)};
            float y[8];
#pragma unroll
            for (int i = 0; i < 4; ++i) { y[i] = (x[i] - mu) * rstd * g0[i] + b0[i]; y[4 + i] = (x[4 + i] - mu) * rstd * g1[i] + b1[i]; }
            u32x4 o; o.x = cvtpk(y[0], y[1]); o.y = cvtpk(y[2], y[3]); o.z = cvtpk(y[4], y[5]); o.w = cvtpk(y[6], y[7]);
            *(MLAS u32x4*)(vn + j * VP + cq + 8 * k) = o;
        }
    }
    LGKM_BAR();
    MLAS bf16_t* ut = (MLAS bf16_t*)(L + 128 * VP * 2);
    {
        const int j = tid >> 2, cq = (tid & 3) * 32;
        const bf16_t* up = Z1 + (tok0 + j) * Z1P + 1536 + 128 * g + cq;
#pragma unroll
        for (int k = 0; k < 4; ++k) *(MLAS u32x4*)(ut + j * VP + cq + 8 * k) = *(const u32x4*)(up + 8 * k);
    }
    LGKM_BAR();
    const int ib = wid & 3;
    const bf16_t* wrow = Wm + ((size_t)g * 128 + 32 * ib + r32) * 128 + 8 * hi;
    bf16x8 af[8];
#pragma unroll
    for (int s = 0; s < 8; ++s) af[s] = *(const bf16x8*)(wrow + 16 * s);
#pragma unroll
    for (int cbi = 0; cbi < 2; ++cbi) {
        const int cb = (wid >> 2) * 2 + cbi;
        f32x16 acc = {};
        lds_cptr bp = (lds_cptr)(vn) + ((size_t)(8 * hi + ((lane & 15) >> 2)) * VP + 32 * cb + 16 * ((lane >> 4) & 1) + 4 * (lane & 3)) * 2;
#pragma unroll
        for (int s = 0; s < 8; ++s) {
            const s16x4 lo = vtr(bp + (16 * s) * VP * 2), hh = vtr(bp + (16 * s + 4) * VP * 2);
            const bf16x8 bfr = {lo[0], lo[1], lo[2], lo[3], hh[0], hh[1], hh[2], hh[3]};
            acc = __builtin_amdgcn_mfma_f32_32x32x16_bf16(af[s], bfr, acc, 0, 0, 0);
        }
        float a16[16]; V16_TO_ARR(acc, a16, 0);
#pragma unroll
        for (int r = 0; r < 16; ++r) {
            const int i = 32 * ib + crow(r, hi), cc = 32 * cb + r32;
            const float uu = __builtin_bit_cast(float, (unsigned)ut[i * VP + cc] << 16);
            const float o = uu * (a16[r] + bs[g * 128 + i]);
            ut[i * VP + cc] = (bf16_t)(cvtpk(o, 0.f) & 0xffffu);
        }
    }
    LGKM_BAR();
    {
        const int j = tid >> 2, cq = (tid & 3) * 32;
        bf16_t* yp = Y + (tok0 + j) * DMODEL + 512 + 128 * g + cq;
#pragma unroll
        for (int k = 0; k < 4; ++k) *(u32x4*)(yp + 8 * k) = *(const MLAS u32x4*)(ut + j * VP + cq + 8 * k);
    }
    LGKM_BAR();
}

__device__ __forceinline__ void pool_item(int item, const bf16_t* Z0, bf16_t* Y) {
    const int row = item >> 6, ch = item & 63, c0 = ch * 8, g = ch >> 4;
    const int w = 2 << g, tpos = row & (SEQ - 1);
    const int cnt = (tpos + 1 < w) ? tpos + 1 : w;
    u32x4 v[16];
#pragma unroll
    for (int k = 0; k < 16; ++k) { v[k] = (u32x4){0u, 0u, 0u, 0u}; if (k < cnt) v[k] = *(const u32x4*)(Z0 + (size_t)(row - k) * EV_N + c0); }
    float s[8] = {0.f, 0.f, 0.f, 0.f, 0.f, 0.f, 0.f, 0.f};
#pragma unroll
    for (int k = 0; k < 16; ++k) {
        s[0] += pg8::bf_lo(v[k].x); s[1] += pg8::bf_hi(v[k].x); s[2] += pg8::bf_lo(v[k].y); s[3] += pg8::bf_hi(v[k].y);
        s[4] += pg8::bf_lo(v[k].z); s[5] += pg8::bf_hi(v[k].z); s[6] += pg8::bf_lo(v[k].w); s[7] += pg8::bf_hi(v[k].w);
    }
    const float self[8] = {pg8::bf_lo(v[0].x), pg8::bf_hi(v[0].x), pg8::bf_lo(v[0].y), pg8::bf_hi(v[0].y), pg8::bf_lo(v[0].z), pg8::bf_hi(v[0].z), pg8::bf_lo(v[0].w), pg8::bf_hi(v[0].w)};
    const float inv = 1.0f / (float)cnt;
    u32x4 o; o.x = cvtpk(s[0] * inv - self[0], s[1] * inv - self[1]); o.y = cvtpk(s[2] * inv - self[2], s[3] * inv - self[3]);
    o.z = cvtpk(s[4] * inv - self[4], s[5] * inv - self[5]); o.w = cvtpk(s[6] * inv - self[6], s[7] * inv - self[7]);
    *(u32x4*)(Y + (size_t)row * DMODEL + c0) = o;
}
}
namespace foxa {
using bf16=__hip_bfloat16;
using bf16x8=__attribute__((ext_vector_type(8)))short;
using s16x4=__attribute__((ext_vector_type(4)))short;
using f32x16=__attribute__((ext_vector_type(16)))float;
using u32x4=__attribute__((ext_vector_type(4)))unsigned;
using f32x4v=__attribute__((ext_vector_type(4)))float;
constexpr int CUM_OFF=86016;
constexpr int SEQL=2048,D=64,OPI=1024;
constexpr int NW=8,QBLK=32,QB=QBLK*NW,KVBLK=64;
__device__ __forceinline__ int crow(int r,int hi){return (r&3)+8*(r>>2)+4*hi;}
#define SBAR() __builtin_amdgcn_sched_barrier(0)
__device__ __forceinline__ void cmask(f32x16&p0,f32x16&p1,int jb,int qrel,int hi){
  const float NEG=-INFINITY; int kb=64*jb+4*hi;
  #pragma unroll
  for(int r=0;r<16;++r){int kv=kb+(r&3)+8*(r>>2); if(kv>qrel)p0[r]=NEG; if(kv+32>qrel)p1[r]=NEG;}
}

constexpr int NSLOT=3, SLOTB=8192;
constexpr int LDS_K=0, LDS_V=NSLOT*SLOTB, LDS_WS=2*NSLOT*SLOTB, LDS_OST=LDS_WS+NW*64*4, LDS_BYTES=LDS_OST+NW*4096;
constexpr float C2=0.125f*1.4426950408889634f;
__device__ __forceinline__ void glds16(const void*gsrc,unsigned lds_dst){unsigned keep;
  asm volatile("s_mov_b32 %0, m0\n\ts_mov_b32 m0, %2\n\ts_nop 0\n\tglobal_load_lds_dwordx4 %1, off\n\ts_mov_b32 m0, %0":"=&s"(keep):"v"(gsrc),"s"(lds_dst):"memory");}
__device__ __forceinline__ float max3f(float a,float b,float c){float r;asm("v_max3_f32 %0, %1, %2, %3":"=v"(r):"v"(a),"v"(b),"v"(c));return r;}
__device__ __forceinline__ float max2f(float a,float b){float r;asm("v_max_f32_e32 %0, %1, %2":"=v"(r):"v"(a),"v"(b));return r;}
__device__ __forceinline__ float fadd_s(float a,float b){float r;asm("v_add_f32_e32 %0, %1, %2":"=v"(r):"v"(a),"v"(b));return r;}
__device__ __forceinline__ float fsub_s(float a,float b){float r;asm("v_sub_f32_e32 %0, %1, %2":"=v"(r):"v"(a),"v"(b));return r;}
typedef float f32x2_t __attribute__((ext_vector_type(2))); typedef __bf16 bf16x2_t __attribute__((ext_vector_type(2)));
__device__ __forceinline__ unsigned cvtpk_s(float lo,float hi){f32x2_t v={lo,hi};bf16x2_t b=__builtin_convertvector(v,bf16x2_t);return __builtin_bit_cast(unsigned,b);}
#define WAIT_BAR(N) asm volatile("s_waitcnt vmcnt(" #N ") lgkmcnt(0)\n\ts_barrier":::"memory")

__device__ __forceinline__ void qkt(f32x16&p0,f32x16&p1,const char*Kslot,const bf16x8*qr,const f32x16&negm,int r32,int hi){
  const char*kb=Kslot+hi*1024+r32*16;
  #pragma unroll
  for(int d0=0;d0<4;++d0){
    const bf16x8 b0=*reinterpret_cast<const bf16x8*>(kb+d0*2048);
    const bf16x8 b1=*reinterpret_cast<const bf16x8*>(kb+d0*2048+512);
    if(d0==0){p0=__builtin_amdgcn_mfma_f32_32x32x16_bf16(b0,qr[0],negm,0,0,0);p1=__builtin_amdgcn_mfma_f32_32x32x16_bf16(b1,qr[0],negm,0,0,0);}
    else{p0=__builtin_amdgcn_mfma_f32_32x32x16_bf16(b0,qr[d0],p0,0,0,0);p1=__builtin_amdgcn_mfma_f32_32x32x16_bf16(b1,qr[d0],p1,0,0,0);}}
}
typedef __attribute__((address_space(3))) const char* lds_cptr;
typedef short v4i16_t __attribute__((ext_vector_type(4)));
__device__ __forceinline__ void kload8(bf16x8*kf,lds_cptr kp){
  kf[0]=*(const __attribute__((address_space(3))) bf16x8*)(kp);      kf[1]=*(const __attribute__((address_space(3))) bf16x8*)(kp+512);
  kf[2]=*(const __attribute__((address_space(3))) bf16x8*)(kp+2048); kf[3]=*(const __attribute__((address_space(3))) bf16x8*)(kp+2560);
  kf[4]=*(const __attribute__((address_space(3))) bf16x8*)(kp+4096); kf[5]=*(const __attribute__((address_space(3))) bf16x8*)(kp+4608);
  kf[6]=*(const __attribute__((address_space(3))) bf16x8*)(kp+6144); kf[7]=*(const __attribute__((address_space(3))) bf16x8*)(kp+6656);
}
__device__ __forceinline__ void kload2(bf16x8*kf,lds_cptr kp,int j){ kf[2*j]=*(const __attribute__((address_space(3))) bf16x8*)(kp+j*2048); kf[2*j+1]=*(const __attribute__((address_space(3))) bf16x8*)(kp+j*2048+512); }
__device__ __forceinline__ s16x4 vtr(lds_cptr p){ return __builtin_bit_cast(s16x4,__builtin_amdgcn_ds_read_tr16_b64_v4i16((__attribute__((address_space(3))) v4i16_t*)p)); }
__device__ __forceinline__ float rowmax(const f32x16&p0,const f32x16&p1){
  float a=max3f(p0[0],p0[1],p1[0]),b=max3f(p0[2],p0[3],p1[1]);a=max3f(a,p1[2],p1[3]);
  #pragma unroll
  for(int r=4;r<16;r+=4){a=max3f(a,p0[r],p0[r+1]);b=max3f(b,p0[r+2],p0[r+3]);a=max3f(a,p1[r],p1[r+1]);b=max3f(b,p1[r+2],p1[r+3]);}
  const float m=max2f(a,b);
  auto rr=__builtin_amdgcn_permlane32_swap(__float_as_uint(m),__float_as_uint(m),false,false);
  return max2f(__uint_as_float(rr[0]),__uint_as_float(rr[1]));
}
__device__ __forceinline__ void pv(f32x16*o,int vb,bf16x8 pa0,bf16x8 pa1,bf16x8 pa2,bf16x8 pa3){
  #pragma unroll
  for(int d0=0;d0<2;++d0){s16x4 lo[4],hi[4];
    #pragma unroll
    for(int ks=0;ks<4;++ks){
      asm volatile("ds_read_b64_tr_b16 %0,%1 offset:%c2":"=&v"(lo[ks]):"v"(vb),"i"(d0*4096+ks*1024):"memory");
      asm volatile("ds_read_b64_tr_b16 %0,%1 offset:%c2":"=&v"(hi[ks]):"v"(vb),"i"(d0*4096+ks*1024+512):"memory");}
    asm volatile("s_waitcnt lgkmcnt(0)":::"memory");SBAR();
    #define PK(k) (bf16x8){lo[k][0],lo[k][1],lo[k][2],lo[k][3],hi[k][0],hi[k][1],hi[k][2],hi[k][3]}
    o[d0]=__builtin_amdgcn_mfma_f32_32x32x16_bf16(pa0,PK(0),o[d0],0,0,0);
    o[d0]=__builtin_amdgcn_mfma_f32_32x32x16_bf16(pa1,PK(1),o[d0],0,0,0);
    o[d0]=__builtin_amdgcn_mfma_f32_32x32x16_bf16(pa2,PK(2),o[d0],0,0,0);
    o[d0]=__builtin_amdgcn_mfma_f32_32x32x16_bf16(pa3,PK(3),o[d0],0,0,0);
    #undef PK
  }
}

#ifndef ATTN_STORE16
#define ATTN_STORE16(p,v) (*(u32x4*)(p)=(v))
#endif
template<int THRL,int MODE,int QKVP,class CumFn> __device__ __forceinline__ void attn_unit(CumFn&& CUMFN,int b,int h,int qb,int q0abs,int NTU,const bf16*Q,const bf16*__restrict__ K,const bf16*__restrict__ V,bf16*O,char*shm,const __attribute__((address_space(3))) unsigned*selw,const int wave_s){
  const int tid=wave_s*64+lane_opaque(),lane=tid&63,r32=lane&31,hi=lane>>5; const int wid=__builtin_amdgcn_readfirstlane(tid>>6);
  const long rowbase=(long)b*SEQL; const int q0=(MODE==0)?qb*QB:q0abs;
  const bf16*Qw=(MODE==0)?Q+(rowbase+q0+wid*QBLK)*QKVP+h*D:Q+(rowbase+q0)*QKVP+wid*D;
  const bf16*Kh=K+rowbase*QKVP+h*D,*Vh=V+rowbase*QKVP+h*D;
  const unsigned lds0=(unsigned)(uintptr_t)shm;
  float*wsf=(float*)(shm+LDS_WS)+wid*64;
  const bf16*ksrc=Kh+(long)lane*QKVP+wid*8;
  const bf16*vsrc=Vh+(long)(16*(wid&3)+(lane>>2))*QKVP+(wid>>2)*32+(lane&3)*8;
  const unsigned kdst=lds0+LDS_K+wid*1024, vdst=lds0+LDS_V+wid*1024;
  #define DMA_K(t,slot) glds16(ksrc+(long)(t)*KVBLK*QKVP,(unsigned)__builtin_amdgcn_readfirstlane(kdst+(slot)))
  #define DMA_V(t,slot) glds16(vsrc+(long)(t)*KVBLK*QKVP,(unsigned)__builtin_amdgcn_readfirstlane(vdst+(slot)))
  const int vb0=(int)(lds0+LDS_V)+((lane>>4)&1)*32+(lane&3)*8+(4*hi+((lane&15)>>2))*64;
  const char*Kbase=shm+LDS_K; bf16x8 kf[8];
  const lds_cptr shm3=(lds_cptr)shm; const lds_cptr kp0=shm3+LDS_K+hi*1024+r32*16; const lds_cptr vp0=shm3+LDS_V+((lane>>4)&1)*32+(lane&3)*8+(4*hi+((lane&15)>>2))*64;
  const int NT=(MODE==0)?(q0+QB)/KVBLK:NTU;
  DMA_K(0,0);DMA_V(0,0);DMA_K(1,SLOTB);
  if constexpr(MODE==0){ CUMFN(); }
  bf16x8 qr[4];
  #pragma unroll
  for(int d0=0;d0<4;++d0)qr[d0]=*reinterpret_cast<const bf16x8*>(&Qw[(long)r32*QKVP+d0*16+hi*8]);
  float mhat=0.f,l_reg=0.f;float z_=0.f;asm volatile("":"+v"(z_));f32x16 o[2];o[0]=(f32x16){z_,z_,z_,z_,z_,z_,z_,z_,z_,z_,z_,z_,z_,z_,z_,z_};o[1]=o[0];f32x16 negm=o[0];asm volatile("":"+v"(negm));
  const int qrel=wid*QBLK+r32;
  const __attribute__((address_space(3))) float*cum2=(const __attribute__((address_space(3))) float*)(shm+CUM_OFF);
  const float cq2=(MODE==0)?cum2[q0+qrel]:0.f;
  #define BIAS(P0,P1,t) do{ if constexpr(MODE==0){ const __attribute__((address_space(3))) float*cb_=cum2+64*(t)+4*hi; \
    _Pragma("unroll") for(int g_=0;g_<4;++g_){ const f32x4v c0_=*(const __attribute__((address_space(3))) f32x4v*)(cb_+8*g_), c1_=*(const __attribute__((address_space(3))) f32x4v*)(cb_+32+8*g_); \
      P0[4*g_+0]+=cq2-c0_.x; P0[4*g_+1]+=cq2-c0_.y; P0[4*g_+2]+=cq2-c0_.z; P0[4*g_+3]+=cq2-c0_.w; \
      P1[4*g_+0]+=cq2-c1_.x; P1[4*g_+1]+=cq2-c1_.y; P1[4*g_+2]+=cq2-c1_.z; P1[4*g_+3]+=cq2-c1_.w; } } }while(0)
  #define SELM(P0,P1,t) do{ if constexpr(MODE==1){ const unsigned w0_=selw[(2*(t))*32+r32]>>(4*hi), w1_=selw[(2*(t)+1)*32+r32]>>(4*hi); \
    _Pragma("unroll") for(int r=0;r<16;++r){ const int sh_=(r&3)+8*(r>>2); if(!((w0_>>sh_)&1u))P0[r]=-INFINITY; if(!((w1_>>sh_)&1u))P1[r]=-INFINITY; } } }while(0)
  #define CMASK(P0,P1,t) do{ if constexpr(MODE==0){int jb_=(t)-(NT-4); if(jb_>=0)cmask(P0,P1,jb_,qrel,hi);} }while(0)
  bool resc=false;
  #define START(P0,P1) do{ const float rm=rowmax(P0,P1); resc=false; \
    { const float dl=(MODE==1&&!(rm>-1e30f))?0.f:rm; mhat=fadd_s(mhat,dl); \
      _Pragma("unroll") for(int r=0;r<16;++r){P0[r]=fsub_s(P0[r],dl);P1[r]=fsub_s(P1[r],dl);} \
      _Pragma("unroll") for(int r=0;r<16;++r)negm[r]=-mhat; asm volatile("":"+v"(negm)); } \
    _Pragma("unroll") for(int r=0;r<16;++r)P0[r]=__builtin_amdgcn_exp2f(P0[r]); }while(0)
  #define RESC() do{ if(resc){ asm volatile("s_waitcnt lgkmcnt(0)":::"memory"); \
      _Pragma("unroll") for(int d_=0;d_<2;++d_) _Pragma("unroll") for(int r=0;r<16;++r)o[d_][r]*=wsf[crow(r,hi)]; } }while(0)
  f32x16 pA0,pA1,pB0,pB1;
  int sl_prev=0,sl_cur=0,sl_next=SLOTB;
  #define ROT() do{sl_prev=sl_cur;sl_cur=sl_next;sl_next=(sl_next==(NSLOT-1)*SLOTB)?0:sl_next+SLOTB;}while(0)
  DMA_K(2,2*SLOTB);
  WAIT_BAR(3);
  qkt(pA0,pA1,Kbase,qr,negm,r32,hi);asm volatile("s_nop 15\n\ts_nop 7":"+v"(pA0),"+v"(pA1));BIAS(pA0,pA1,0);SELM(pA0,pA1,0);CMASK(pA0,pA1,0);
  START(pA0,pA1);
  _Pragma("unroll") for(int r=0;r<16;++r)pA1[r]=__builtin_amdgcn_exp2f(pA1[r]);
  WAIT_BAR(0);
  DMA_K(3,0);DMA_V(1,SLOTB);
  ROT();
  kload8(kf,kp0+sl_cur);
  WAIT_BAR(2);
  s16x4 vlo[8],vhi[8]; u32x4 pw0,pw1,pw2,pw3;
  #define PKW(P,B) cvtpk_s(P[B],P[B+1])
  #define PAF(k) __builtin_bit_cast(bf16x8,pw##k)
  #define VFR(i) (bf16x8){vlo[i][0],vlo[i][1],vlo[i][2],vlo[i][3],vhi[i][0],vhi[i][1],vhi[i][2],vhi[i][3]}
  #define PIN(x) asm volatile("":"+v"(x))
  #define MX3(a,b,c) __builtin_fmaxf(__builtin_fmaxf((a),(b)),(c))
  #define GAPA(MF,A0,A1,A2,A3,W0,W1,PW) do{ MF; sacc+=A0; sacc+=A1; sacc+=A2; sacc+=A3; PIN(sacc); W0; W1; PIN(PW); SBAR(); }while(0)
  #define EX(v) __builtin_amdgcn_exp2f(v)
  #define GAPB(MF,X,B) do{ MF; X[B]=EX(X[B]); X[B+1]=EX(X[B+1]); X[B+2]=EX(X[B+2]); X[B+3]=EX(X[B+3]); PIN(X); SBAR(); }while(0)
  #define VRD(i) do{ vlo[i]=vtr(vp_+(((i)>>2)*4096+((i)&3)*1024)); vhi[i]=vtr(vp_+(((i)>>2)*4096+((i)&3)*1024+512)); }while(0)
  #define KRD(G,j) do{ if(G){ kload2(kf,kp0+sl_next,j); SBAR(); } }while(0)
  #define STEP(C0,C1,P0,P1,t,GK,GV,GL) do{ SBAR(); \
    const lds_cptr vp_=vp0+sl_prev; \
    VRD(0); SBAR(); float sacc=(P0[0]+P0[1]); \
    GAPA(C0=__builtin_amdgcn_mfma_f32_32x32x16_bf16(kf[0],qr[0],negm,0,0,0), P0[2],P0[3],P0[4],P0[5],     pw0[0]=PKW(P0,0), pw0[1]=PKW(P0,2), pw0); \
    VRD(4); SBAR(); GAPA(C1=__builtin_amdgcn_mfma_f32_32x32x16_bf16(kf[1],qr[0],negm,0,0,0), P0[6],P0[7],P0[8],P0[9],     pw0[2]=PKW(P0,4), pw0[3]=PKW(P0,6), pw0); \
    VRD(1); SBAR(); GAPA(C0=__builtin_amdgcn_mfma_f32_32x32x16_bf16(kf[2],qr[1],C0,0,0,0),   P0[10],P0[11],P0[12],P0[13], pw1[0]=PKW(P0,8), pw1[1]=PKW(P0,10), pw1); \
    VRD(5); SBAR(); GAPA(C1=__builtin_amdgcn_mfma_f32_32x32x16_bf16(kf[3],qr[1],C1,0,0,0),   P0[14],P0[15],P1[0],P1[1],   pw1[2]=PKW(P0,12),pw1[3]=PKW(P0,14), pw1); \
    VRD(2); SBAR(); GAPA(C0=__builtin_amdgcn_mfma_f32_32x32x16_bf16(kf[4],qr[2],C0,0,0,0),   P1[2],P1[3],P1[4],P1[5],     pw2[0]=PKW(P1,0), pw2[1]=PKW(P1,2), pw2); \
    VRD(6); SBAR(); GAPA(C1=__builtin_amdgcn_mfma_f32_32x32x16_bf16(kf[5],qr[2],C1,0,0,0),   P1[6],P1[7],P1[8],P1[9],     pw2[2]=PKW(P1,4), pw2[3]=PKW(P1,6), pw2); \
    VRD(3); SBAR(); GAPA(C0=__builtin_amdgcn_mfma_f32_32x32x16_bf16(kf[6],qr[3],C0,0,0,0),   P1[10],P1[11],P1[12],P1[13], pw3[0]=PKW(P1,8), pw3[1]=PKW(P1,10), pw3); \
    VRD(7); SBAR(); GAPA(C1=__builtin_amdgcn_mfma_f32_32x32x16_bf16(kf[7],qr[3],C1,0,0,0),   P1[14],P1[15],0.f,0.f,       pw3[2]=PKW(P1,12),pw3[3]=PKW(P1,14), pw3); \
    l_reg+=sacc; \
    if(GK){DMA_K((t)+3,sl_cur);} if(GV){DMA_V((t)+1,sl_next);} \
    BIAS(C0,C1,t); SELM(C0,C1,t); CMASK(C0,C1,t); \
    { float a=MX3(C0[0],C0[1],C1[0]),b=MX3(C0[2],C0[3],C1[1]); a=MX3(a,C1[2],C1[3]); \
      _Pragma("unroll") for(int r=4;r<16;r+=4){a=MX3(a,C0[r],C0[r+1]);b=MX3(b,C0[r+2],C0[r+3]);a=MX3(a,C1[r],C1[r+1]);b=MX3(b,C1[r+2],C1[r+3]);} \
      float rm=__builtin_fmaxf(a,b); { auto rr=__builtin_amdgcn_permlane32_swap(__float_as_uint(rm),__float_as_uint(rm),false,false); rm=__builtin_fmaxf(__uint_as_float(rr[0]),__uint_as_float(rr[1])); } \
      resc=false; \
      if(__builtin_expect(__any(rm>(float)THRL),0)){ const float dl=__builtin_fmaxf(rm,0.f); mhat+=dl; \
        _Pragma("unroll") for(int r=0;r<16;++r){C0[r]-=dl;C1[r]-=dl;} \
        _Pragma("unroll") for(int r=0;r<16;++r)negm[r]=-mhat; asm volatile("":"+v"(negm)); \
        const float f=__builtin_amdgcn_exp2f(-dl); l_reg*=f; if(hi==0)wsf[r32]=f; resc=true; } } \
    SBAR(); \
    GAPB(o[0]=__builtin_amdgcn_mfma_f32_32x32x16_bf16(PAF(0),VFR(0),o[0],0,0,0), C0,0); \
    GAPB(o[1]=__builtin_amdgcn_mfma_f32_32x32x16_bf16(PAF(0),VFR(4),o[1],0,0,0), C0,4); \
    KRD(GL,0); GAPB(o[0]=__builtin_amdgcn_mfma_f32_32x32x16_bf16(PAF(1),VFR(1),o[0],0,0,0), C0,8); \
    KRD(GL,1); GAPB(o[1]=__builtin_amdgcn_mfma_f32_32x32x16_bf16(PAF(1),VFR(5),o[1],0,0,0), C0,12); \
    KRD(GL,2); GAPB(o[0]=__builtin_amdgcn_mfma_f32_32x32x16_bf16(PAF(2),VFR(2),o[0],0,0,0), C1,0); \
    KRD(GL,3); GAPB(o[1]=__builtin_amdgcn_mfma_f32_32x32x16_bf16(PAF(2),VFR(6),o[1],0,0,0), C1,4); \
    GAPB(o[0]=__builtin_amdgcn_mfma_f32_32x32x16_bf16(PAF(3),VFR(3),o[0],0,0,0), C1,8); \
    GAPB(o[1]=__builtin_amdgcn_mfma_f32_32x32x16_bf16(PAF(3),VFR(7),o[1],0,0,0), C1,12); \
    }while(0)
  int t=1;
  #undef CMASK
  #define CMASK(P0,P1,t) do{}while(0)
  for(;t+5<NT;t+=2){
    STEP(pB0,pB1,pA0,pA1,t,true,true,true);     WAIT_BAR(2); RESC(); ROT();
    STEP(pA0,pA1,pB0,pB1,t+1,true,true,true);   WAIT_BAR(2); RESC(); ROT();
  }
  #undef CMASK
  #define CMASK(P0,P1,t) do{ if constexpr(MODE==0){int jb_=(t)-(NT-4); if(jb_>=0)cmask(P0,P1,jb_,qrel,hi);} }while(0)
  #define ENDW(tt) do{ if((tt)+3<NT){WAIT_BAR(2);} else if((tt)+2<NT){WAIT_BAR(1);} else {WAIT_BAR(0);} }while(0)
  for(;t+1<NT;t+=2){
    STEP(pB0,pB1,pA0,pA1,t,(t+3<NT),(t+1<NT),(t+1<NT));       ENDW(t);   RESC(); ROT();
    STEP(pA0,pA1,pB0,pB1,t+1,(t+4<NT),(t+2<NT),(t+2<NT));     ENDW(t+1); RESC(); ROT();
  }
  STEP(pB0,pB1,pA0,pA1,NT-1,false,false,false); RESC();
  { float sacc=pB0[0]+pB0[1]; _Pragma("unroll") for(int r=2;r<16;++r)sacc+=pB0[r]; _Pragma("unroll") for(int r=0;r<16;++r)sacc+=pB1[r]; l_reg+=sacc;
    pw0=(u32x4){PKW(pB0,0),PKW(pB0,2),PKW(pB0,4),PKW(pB0,6)};pw1=(u32x4){PKW(pB0,8),PKW(pB0,10),PKW(pB0,12),PKW(pB0,14)};pw2=(u32x4){PKW(pB1,0),PKW(pB1,2),PKW(pB1,4),PKW(pB1,6)};pw3=(u32x4){PKW(pB1,8),PKW(pB1,10),PKW(pB1,12),PKW(pB1,14)};
    SBAR(); pv(o,vb0+sl_cur,PAF(0),PAF(1),PAF(2),PAF(3)); }
  #undef PKW
  #undef PAF
  #undef VFR
  #undef PIN
  #undef MX3
  #undef GAPA
  #undef GAPB
  #undef EX
  #undef VRD
  #undef KRD
  #undef STEP
  #undef ENDW
  {auto rr=__builtin_amdgcn_permlane32_swap(__float_as_uint(l_reg),__float_as_uint(l_reg),false,false);l_reg=__uint_as_float(rr[0])+__uint_as_float(rr[1]);}
  if(hi==0)wsf[32+r32]=l_reg;asm volatile("s_waitcnt lgkmcnt(0)":::"memory");
  float rli[16];
  #pragma unroll
  for(int r=0;r<16;++r)rli[r]=__builtin_amdgcn_rcpf(wsf[32+crow(r,hi)]);
  bf16*Ow=(MODE==0)?O+(rowbase+q0+wid*QBLK)*OPI+h*D:O+(rowbase+q0)*OPI+wid*D;
  { bf16*stg=(bf16*)(shm+LDS_OST)+wid*2048;
    #pragma unroll
    for(int r=0;r<16;++r){const int orow=crow(r,hi);
      #pragma unroll
      for(int d0=0;d0<2;++d0)stg[orow*64+d0*32+r32]=__float2bfloat16(o[d0][r]*rli[r]);}
    asm volatile("s_waitcnt lgkmcnt(0)":::"memory");
    #pragma unroll
    for(int i=0;i<4;++i){const int row=i*8+(lane>>3),ch=lane&7; const u32x4 v=*(const u32x4*)(stg+row*64+ch*8); ATTN_STORE16(Ow+(long)row*OPI+ch*8,v);} }
  asm volatile("s_waitcnt lgkmcnt(0)\n\ts_barrier":::"memory");
  #undef DMA_K
  #undef DMA_V
  #undef CMASK
  #undef START
  #undef BIAS
  #undef SELM
  #undef RESC
  #undef ROT
}
#undef SBAR
#undef WAIT_BAR
}

#ifndef DBG_REP_SEL
#define DBG_REP_SEL 1
#endif
namespace mix {
__device__ __forceinline__ void fox_unit2(int b, int h, int qb, const bf16_t* Z1, const float* F, const float* bfp, bf16_t* Y, char* shm, const int wave_s) {
    const size_t rowb = (size_t)b * SEQ;
    const int nk = 256 * (qb + 1);
    auto cumfn = [=]() {
        const int tid = wave_s * 64 + lane_opaque(), lane = tid & 63; const int wid = __builtin_amdgcn_readfirstlane(tid >> 6);
        MLAS char* L = (MLAS char*)shm;
        MLAS float* cum2 = (MLAS float*)(L + foxa::CUM_OFF);
        MLAS float* wtot = (MLAS float*)(L + foxa::CUM_OFF + 8192);
        const float bias = bfp[h];
        const int s0 = 4 * tid;
        float v[4]; float run = 0.f;
#pragma unroll
        for (int i = 0; i < 4; ++i) {
            float x = 0.f;
            if (s0 + i < nk) x = F[(rowb + s0 + i) * 8 + h] + bias;
            const float ls = (s0 + i < nk) ? (fminf(x, 0.f) - log1pf(expf(-fabsf(x)))) : 0.f;
            run += ls; v[i] = run;
        }
        float inc = run;
#pragma unroll
        for (int o = 1; o < 64; o <<= 1) { const int ln = lane_opaque(); const float t = __builtin_bit_cast(float, __builtin_amdgcn_ds_bpermute((ln - o) << 2, __builtin_bit_cast(int, inc))); if (ln >= o) inc += t; }
        if (lane == 63) wtot[wid] = inc;
        LGKM_BAR();
        float off = inc - run;
        for (int w = 0; w < wid; ++w) off += wtot[w];
#pragma unroll
        for (int i = 0; i < 4; ++i) cum2[s0 + i] = (off + v[i]) * 1.4426950408889634f;
        LGKM_BAR();
    };
    foxa::attn_unit<8, 0, 2560>(cumfn, b, h, qb, 0, 0, (const foxa::bf16*)Z1, (const foxa::bf16*)(Z1 + 512), (const foxa::bf16*)(Z1 + 1024), (foxa::bf16*)Y, shm, nullptr, wave_s);
}
__device__ __forceinline__ void dsa_unit(int b, int qg, const bf16_t* Z0, bf16_t* Y, char* shm, unsigned lds0, const int wave_s) {
    for (int rep_ = 0; rep_ < DBG_REP_SEL; ++rep_) dsa_select(b, qg, Z0, shm, wave_s);
    const int nt64 = (qg >> 1) + 1; int ntu = (nt64 + 1) & ~1; if (ntu < 4) ntu = 4;
    foxa::attn_unit<8, 1, EV_N>([]() {}, b, 0, 0, 32 * qg, ntu, (const foxa::bf16*)(Z0 + 512), (const foxa::bf16*)(Z0 + 1024), (const foxa::bf16*)(Z0 + 1088), (foxa::bf16*)(Y + 512), shm,
                                (const MLAS unsigned*)((MLAS char*)shm + LX_SEL), wave_s);
}
}
constexpr int NWAVES = 8;
constexpr size_t KiB = 1024, MiB = 1u << 20;
constexpr size_t WS_CTL = 0, CTL_ZERO_BYTES = 1 * MiB;
constexpr size_t WS_W_EVIN = 1 * MiB, WS_W_OUT0 = 4 * MiB, WS_W_FFI0 = 6 * MiB, WS_W_FFO0 = 17 * MiB, WS_W_PG0 = 22 * MiB + 512 * KiB, WS_W_PP0 = 24 * MiB + 512 * KiB;
constexpr size_t WS_W_ODIN = 25 * MiB, WS_W_OUT1 = 30 * MiB + 512 * KiB, WS_W_FFI1 = 32 * MiB + 512 * KiB, WS_W_FFO1 = 43 * MiB + 512 * KiB, WS_W_PG1 = 49 * MiB, WS_W_PP1 = 51 * MiB, WS_W_SGU = 51 * MiB + 512 * KiB;
constexpr size_t WS_RSTD = 57 * MiB + 768 * KiB;
constexpr size_t WS_SSQA = 52 * MiB, WS_SSQB = 53 * MiB, WS_ROPE = 54 * MiB, WS_AH = 55 * MiB, WS_FBUF = 58 * MiB + 512 * KiB, WS_SST = 59 * MiB;
constexpr size_t WS_HB = 60 * MiB, WS_AHALO = 92 * MiB, WS_PP = 92 * MiB + 512 * KiB, WS_Y = 124 * MiB + 512 * KiB, WS_ZH = 156 * MiB + 512 * KiB, WS_PB = 244 * MiB + 512 * KiB, WS_END = 252 * MiB + 512 * KiB;
static_assert(WS_AHALO == WS_HB + (size_t)TOK * 1024 * 2, "the halo rows are row tile 64 of the FFN in-projection A operand");
static_assert(WS_W_EVIN + (size_t)EV_N * 1024 * 2 <= WS_W_OUT0 && WS_W_FFI0 + (size_t)NFF2 * 1024 * 2 <= WS_W_FFO0 && WS_W_FFO0 + (size_t)1024 * DFF * 2 <= WS_W_PG0, "ws map 1");
static_assert(WS_W_ODIN + (size_t)OD_N * 1024 * 2 <= WS_W_OUT1 && WS_W_FFI1 + (size_t)NFF2 * 1024 * 2 <= WS_W_FFO1 && WS_W_FFO1 + (size_t)1024 * DFF * 2 <= WS_W_PG1 && WS_W_SGU + 4 * 128 * 128 * 2 <= WS_SSQA, "ws map 2");
static_assert(WS_AH + (size_t)128 * NFF2 * 4 <= WS_RSTD && WS_ZH + (size_t)TOK * DFF * 2 <= WS_PB && WS_PB + (size_t)TOK * PLE * 2 <= WS_END, "ws map 3");
constexpr int CW_BAR = 4096, CW_FLAG = 8192, CW_PAN = 16384;
constexpr int RING_BYTES = 131072, XB_OFF = RING_BYTES, LDSCTL_OFF = XB_OFF + 8192 + 1024 + 64, MISC_OFF = LDSCTL_OFF + 320, LDS_BYTES = 147456;
static_assert(MISC_OFF + 128 <= LDS_BYTES, "LDS map");

#define GAS __attribute__((address_space(1)))
#define LAS __attribute__((address_space(3)))
typedef unsigned short bf16;
typedef unsigned v4u __attribute__((ext_vector_type(4)));
typedef float f32x4 __attribute__((ext_vector_type(4)));
typedef float f32x2 __attribute__((ext_vector_type(2)));
#define LDS_WAIT() asm volatile("s_waitcnt lgkmcnt(0)" ::: "memory")
#define VM_WAIT() asm volatile("s_waitcnt vmcnt(0)" ::: "memory")
__device__ __forceinline__ unsigned f2bf(float f) { unsigned u = __builtin_bit_cast(unsigned, f); return (u + 0x7fffu + ((u >> 16) & 1u)) >> 16; }
__device__ __forceinline__ unsigned pk2(float lo, float hi) { return f2bf(lo) | (f2bf(hi) << 16); }

#define XB_TMO      128
#define XB_XCNT(j)  (256  + 64 * (j))
#define XB_XSUB(j)  (1280 + 64 * (j))
#define XB_XGEN(j)  (2304 + 64 * (j))
#define XB_TOP      3328
#define XB_TOPGEN   3392
#define XCD_BAR_WORDS 3456
#define XB_SPIN_CAP (1u << 18)
__device__ __forceinline__ unsigned xb_ld(unsigned* p)              { return __hip_atomic_load(p, __ATOMIC_RELAXED, __HIP_MEMORY_SCOPE_AGENT); }
__device__ __forceinline__ unsigned xb_add(unsigned* p, unsigned v) { return __hip_atomic_fetch_add(p, v, __ATOMIC_RELAXED, __HIP_MEMORY_SCOPE_AGENT); }
__device__ __forceinline__ unsigned xb_xcc_id() { return (unsigned)__builtin_amdgcn_s_getreg((3 << 11) | 20) & 0xFu; }
#define XB_SPIN(cond, bar) do { unsigned _sp = 0; while (cond) { __builtin_amdgcn_s_sleep(1); \
    if ((++_sp & 255u) == 0u) { if (xb_ld(&(bar)[XB_TMO])) break; if (_sp > XB_SPIN_CAP) { atomicAdd(&(bar)[XB_TMO], 1u); break; } } } } while (0)
struct XcdBarrier { unsigned* bar; unsigned x; volatile LAS unsigned* st; };
__device__ __forceinline__ XcdBarrier xcd_barrier_post(unsigned* bar, volatile LAS unsigned* st) {
    XcdBarrier b; b.bar = bar; b.x = xb_xcc_id(); b.st = st;
    if (threadIdx.x == 0) (void)xb_add(&bar[XB_XCNT(b.x)], 1u);
    return b;
}
__device__ __forceinline__ void xcd_barrier_complete(unsigned* bar, unsigned x, unsigned& nloc, unsigned& nx) {
    const unsigned G = gridDim.x * gridDim.y * gridDim.z;
    unsigned sum, cnt, mine, sp = 0u;
    for (;;) {
        sum = 0u; cnt = 0u; mine = 0u;
#pragma unroll 1
        for (unsigned j = 0; j < 16; ++j) { const unsigned c = xb_ld(&bar[XB_XCNT(j)]); sum += c; cnt += (c > 0u) ? 1u : 0u; mine = (j == x) ? c : mine; }
        if (sum == G) break;
        __builtin_amdgcn_s_sleep(1);
        if ((++sp & 255u) == 0u) { if (xb_ld(&bar[XB_TMO])) break; if (sp > XB_SPIN_CAP) { atomicAdd(&bar[XB_TMO], 1u); break; } }
    }
    nloc = mine > 0u ? mine : 1u; nx = cnt > 0u ? cnt : 1u;
}
__device__ __forceinline__ void xcd_barrier(const XcdBarrier& b) {
    asm volatile("s_waitcnt vmcnt(0)" ::: "memory");
    __syncthreads();
    if (threadIdx.x == 0) {
        unsigned* bar = b.bar;
        __builtin_amdgcn_s_waitcnt(0);
        unsigned nloc = b.st[0], nx = b.st[1];
        if (nloc == 0u) { xcd_barrier_complete(bar, b.x, nloc, nx); b.st[0] = nloc; b.st[1] = nx; }
        const unsigned old = xb_add(&bar[XB_XSUB(b.x)], 1u);
        const unsigned gen = old / nloc;
        if (old + 1u == (gen + 1u) * nloc) {
            __builtin_amdgcn_fence(__ATOMIC_RELEASE, "agent");
            asm volatile("s_waitcnt vmcnt(0)" ::: "memory");
            const unsigned og = xb_add(&bar[XB_TOP], 1u);
            const unsigned tg = og / nx;
            if (og + 1u == (tg + 1u) * nx) xb_add(&bar[XB_TOPGEN], 1u);
            else XB_SPIN(xb_ld(&bar[XB_TOPGEN]) == tg, bar);
            __builtin_amdgcn_fence(__ATOMIC_ACQUIRE, "agent");
            xb_add(&bar[XB_XGEN(b.x)], 1u);
            asm volatile("s_waitcnt vmcnt(0)" ::: "memory");
        } else {
            XB_SPIN(xb_ld(&bar[XB_XGEN(b.x)]) == gen, bar);
            __builtin_amdgcn_fence(__ATOMIC_ACQUIRE, "agent");
            asm volatile("s_waitcnt vmcnt(0)" ::: "memory");
        }
    }
    __syncthreads();
}

__device__ __forceinline__ float wave_sum(float v) {
#pragma unroll
    for (int o = 1; o < 64; o <<= 1) v += __builtin_bit_cast(float, __builtin_amdgcn_ds_bpermute((lane_opaque() ^ o) << 2, __builtin_bit_cast(int, v)));
    return v;
}
__device__ __forceinline__ int vcu_of(int i, int n) { return i; }
__device__ __forceinline__ int unperm16(int d) { return d < 16 ? ((d >> 1) + 8 * (d & 1)) : d; }
__device__ __forceinline__ int map_col(int type, int n, int nold) {
    if (type == 0) return n < nold ? n : -1;
    if (type == 1) {
        if (n < 512) return n;
        if (n < 1024) { const int h = (n - 512) >> 6, d = (n - 512) & 63; return 512 + 64 * h + unperm16(d); }
        if (n < 1088) return 1024 + unperm16(n - 1024);
        if (n < 1152) return n;
        if (n < 1216) return 1408 + unperm16(n - 1152);
        if (n < 1220) return 1472 + (n - 1216);
        if (n < 1280) return -1;
        { const int h = (n - 1280) >> 6, d = (n - 1280) & 63; return 1152 + 64 * h + unperm16(d); }
    }
    if (type == 2) {
        if (n < 1536) return n;
        if (n < 2560) return n + 8;
        if (n < 2568) return 1536 + (n - 2560);
        return -1;
    }
    { const int pn = n >> 8, bj = (n >> 7) & 1, jj = n & 127; return bj * DFF + 128 * pn + jj; }
}
struct TJob { const float* W; const float* rowscale; bf16* WT; int K, Nold, Nnew, ldk, koff, type, nitems; };
__device__ __forceinline__ void transpose_item(const TJob& J, LAS float* scr, int item, int lane) {
    const int nblk = J.Nnew / 32, kb = item / nblk, nb = item % nblk, k0 = 64 * kb, n0 = 32 * nb;
    const int oc = map_col(J.type, n0 + (lane & 31), J.Nold);
    const int occ = oc >= 0 ? oc : 0;
    float vv[32];
#pragma unroll
    for (int i = 0; i < 32; ++i) vv[i] = J.W[(size_t)(k0 + 2 * i + (lane >> 5)) * J.Nold + occ];
#pragma unroll
    for (int i = 0; i < 32; ++i) { const int kk = 2 * i + (lane >> 5);
        float v = (oc >= 0) ? vv[i] : 0.f;
        if (J.rowscale) v *= J.rowscale[k0 + kk];
        scr[kk * 33 + (lane & 31)] = v; }
    LDS_WAIT(); asm volatile("" ::: "memory");
    const int c = lane & 7;
#pragma unroll
    for (int j = 0; j < 4; ++j) { const int n = (lane >> 3) + 8 * j; const LAS float* s = scr + (8 * c) * 33 + n;
        v4u o; o.x = pk2(s[0 * 33], s[1 * 33]); o.y = pk2(s[2 * 33], s[3 * 33]); o.z = pk2(s[4 * 33], s[5 * 33]); o.w = pk2(s[6 * 33], s[7 * 33]);
        *(GAS v4u*)(J.WT + (size_t)(n0 + n) * J.ldk + J.koff + k0 + 8 * c) = o; }
    LDS_WAIT(); asm volatile("" ::: "memory");
}
__device__ __forceinline__ void sincos_d(double a, float& sn, float& cs) {
    const double q = rint(a * 0.63661977236758134308);
    double r = a - q * 1.57079632673412561417e+00; r -= q * 6.07710050650619224932e-11;
    const double r2 = r * r;
    double s = 1.0 / 6227020800.0; s = s * r2 - 1.0 / 39916800.0; s = s * r2 + 1.0 / 362880.0; s = s * r2 - 1.0 / 5040.0; s = s * r2 + 1.0 / 120.0; s = s * r2 - 1.0 / 6.0; s = s * r2 * r + r;
    double c = -1.0 / 87178291200.0; c = c * r2 + 1.0 / 479001600.0; c = c * r2 - 1.0 / 3628800.0; c = c * r2 + 1.0 / 40320.0; c = c * r2 - 1.0 / 720.0; c = c * r2 + 1.0 / 24.0; c = c * r2 - 0.5; c = c * r2 + 1.0;
    const int qi = ((int)q) & 3;
    const double ss = (qi == 0) ? s : (qi == 1) ? c : (qi == 2) ? -s : -c;
    const double cc = (qi == 0) ? c : (qi == 1) ? -s : (qi == 2) ? -c : s;
    sn = (float)ss; cs = (float)cc;
}

struct Args { const void* in[24]; float* out; unsigned char* ws; int ph_lo, ph_hi; };
typedef const Args __attribute__((address_space(4)))* argp_t;
__device__ __forceinline__ argp_t get_args() { argp_t p = (argp_t)__builtin_amdgcn_kernarg_segment_ptr(); asm volatile("" : "+s"(p)); return p; }
__device__ __forceinline__ int otid(int wave_s) { return wave_s * 64 + lane_opaque(); }
#define IN_F(k) ((const float*)A_->in[k])
#define PH_LOCALS \
    argp_t A_ = get_args(); unsigned char* const ws = A_->ws; float* const out = A_->out; (void)out; \
    const int tid = otid(wave_s), lane = tid & 63, wave = wave_s; (void)lane; (void)wave; \
    const int G = gridDim.x, bx = blockIdx.x, vcu = (G % 8 == 0) ? (bx % 8) * (G / 8) + bx / 8 : bx; (void)vcu; \
    const int gw = vcu * NWAVES + wave, NGW = G * NWAVES, gt = vcu * (NWAVES * 64) + tid, NGT = G * NWAVES * 64; (void)gw; (void)NGW; (void)gt; (void)NGT; \
    LAS unsigned char* const L = (LAS unsigned char*)lds; (void)L;
#define WSP(T, off) ((T*)(ws + (off)))

__global__ void __launch_bounds__(NWAVES * 64, 2) mega_fwd(Args args) {
    extern __shared__ __attribute__((aligned(16))) unsigned char lds[];
    int lo, hi; XcdBarrier bar;
    const int wave_s = __builtin_amdgcn_readfirstlane((int)threadIdx.x >> 6);
    {
        PH_LOCALS
        volatile LAS unsigned* MISC = (volatile LAS unsigned*)(L + MISC_OFF);
        for (int u = tid; u < (LDS_BYTES - XB_OFF) / 4; u += NWAVES * 64) ((LAS unsigned*)(L + XB_OFF))[u] = 0u;
        __syncthreads();
        bar = xcd_barrier_post((unsigned*)(ws + WS_CTL) + CW_BAR, MISC + 8);
        lo = A_->ph_lo; hi = A_->ph_hi;
    }
#ifndef DBG_REP_TR
#define DBG_REP_TR 1
#endif
#ifndef DBG_REP_HB
#define DBG_REP_HB 1
#endif
#ifndef DBG_REP_FOX
#define DBG_REP_FOX 1
#endif
#ifndef DBG_REP_DSA
#define DBG_REP_DSA 1
#endif
#ifndef DBG_REP_SGU
#define DBG_REP_SGU 1
#endif
#ifndef DBG_REP_POOL
#define DBG_REP_POOL 1
#endif
#ifndef PHMASK
#define PHMASK 0xff7fffu
#endif
#define IN(k) (((PHMASK >> (k)) & 1u) && lo <= (k) && (k) < hi)
#define SEAM(k) do { if (IN(k) && IN((k) + 1)) xcd_barrier(bar); } while (0)
    if (IN(0)) {
        PH_LOCALS
        LAS float* scr = (LAS float*)(L + wave * 16384);
        const float* norm_mix = IN_F(3); const float* norm_ffn = IN_F(4); const float* norm_ple = IN_F(5);
        const float* ffn_w_in = IN_F(6); const float* ffn_w_out = IN_F(9); const float* ple_w_proj = IN_F(10); const float* ple_w_gate = IN_F(11);
        const float* ev_w_in = IN_F(13); const float* ev_w_out = IN_F(14); const float* od_w_in = IN_F(17); const float* od_w_out = IN_F(18);
#define TJ(Wp, RS, WTp, K_, NOLD, NNEW, LDK, KOFF, TYPE) { constexpr int NI_ = ((K_) / 64) * ((NNEW) / 32); if (r < NI_) { const TJob J{(Wp), (RS), (WTp), (K_), (NOLD), (NNEW), (LDK), (KOFF), (TYPE), NI_}; transpose_item(J, scr, r, lane); continue; } r -= NI_; }
        constexpr int NITEMS = 16 * 48 + 8 * 32 + 44 * 32 + 4 * 32;
        for (int rep_ = 0; rep_ < DBG_REP_TR; ++rep_) for (int it = gw; it < NITEMS; it += NGW) {
            int r = it;
            TJ(ev_w_in, norm_mix, WSP(bf16, WS_W_EVIN), 1024, 1476, EV_N, 1024, 0, 1)
            TJ(ev_w_out + (size_t)512 * 1024, nullptr, WSP(bf16, WS_W_OUT0), 512, 1024, 1024, 1024, 512, 0)
            TJ(ffn_w_out + (size_t)DFF * 1024, nullptr, WSP(bf16, WS_W_FFO1), DFF, 1024, 1024, DFF, 0, 0)
            TJ(ple_w_proj + (size_t)256 * 1024, nullptr, WSP(bf16, WS_W_PP1), 256, 1024, 1024, 256, 0, 0)
        }
#undef TJ
        { const float* sgu_w = IN_F(22); bf16* W_SGU = WSP(bf16, WS_W_SGU);
          for (int i = gt; i < 4 * 128 * 128; i += NGT) { const int jj = i & 127, ii = (i >> 7) & 127; W_SGU[i] = (bf16)((ii < 64 && jj >= 64) ? 0u : f2bf(sgu_w[i])); } }
        { const float* x = IN_F(0); bf16* HB = WSP(bf16, WS_HB); float* SSQA = WSP(float, WS_SSQA);
          for (int m = gw; m < TOK; m += 4 * NGW) {
            f32x4 v[4][4];
#pragma unroll
            for (int q = 0; q < 4; ++q) { const int mm = (m + q * NGW < TOK) ? m + q * NGW : m; const f32x4* xr = (const f32x4*)(x + (size_t)mm * DMODEL) + lane;
#pragma unroll
                for (int j = 0; j < 4; ++j) v[q][j] = xr[64 * j]; }
#pragma unroll
            for (int q = 0; q < 4; ++q) { const int mm = m + q * NGW; if (mm < TOK) {
                float s = 0.f; unsigned long long* o8 = (unsigned long long*)(HB + (size_t)mm * DMODEL) + lane;
#pragma unroll
                for (int j = 0; j < 4; ++j) { const f32x4 w = v[q][j]; s += (w.x * w.x + w.y * w.y) + (w.z * w.z + w.w * w.w);
                    o8[64 * j] = (unsigned long long)pk2(w.x, w.y) | ((unsigned long long)pk2(w.z, w.w) << 32); }
                s = wave_sum(s);
                if (lane < 16) SSQA[(size_t)mm * 16 + lane] = (lane == 0) ? s : 0.f; } }
          } }
        { const float* p_in = IN_F(1); bf16* PB = WSP(bf16, WS_PB);
          for (int i = gt; i < TOK * PLE / 4; i += 4 * NGT) { f32x4 v[4];
#pragma unroll
            for (int q = 0; q < 4; ++q) v[q] = ((const f32x4*)p_in)[(i + q * NGT < TOK * PLE / 4) ? i + q * NGT : i];
#pragma unroll
            for (int q = 0; q < 4; ++q) if (i + q * NGT < TOK * PLE / 4) ((unsigned long long*)PB)[i + q * NGT] = (unsigned long long)pk2(v[q].x, v[q].y) | ((unsigned long long)pk2(v[q].z, v[q].w) << 32); } }
        { const int* positions = (const int*)A_->in[2]; f32x2* ROPE = WSP(f32x2, WS_ROPE);
          for (int i = gt; i < TOK * 8; i += NGT) {
            const int row = i >> 3, j = i & 7;
            const float invf = (j == 0) ? 1.0f : (j == 1) ? 0.1939227432012558f : (j == 2) ? 0.03760603070259094f : (j == 3) ? 0.007292664609849453f : (j == 4) ? 0.0014142135623842478f :
                               (j == 5) ? 0.00027424818836152554f : (j == 6) ? 5.3182957344688475e-05f : 1.0313385246263351e-05f;
            const float ang = (float)positions[row] * invf;
            float sn, cs; sincos_d((double)ang, sn, cs);
            ROPE[i] = (f32x2){cs, sn};
          } }
    }
    SEAM(0);
    if (IN(1)) {
        { PH_LOCALS
          pg8::Gemm g{WSP(bf16, WS_HB), WSP(bf16, WS_W_EVIN), TOK, EV_N, 1024}; pg8::StaticOrder S; S.init(TOK, EV_N, G, bx);
          pg8::EpiEvenIn E{WSP(float, WS_SSQA), WSP(bf16, WS_ZH), WSP(const pg8::f32x2, WS_ROPE)};
          pg8::gemm_phase<pg8::EpiEvenIn, pg8::StaticOrder, true, true>(L, g, S, E, wave_s); }
        if (gridDim.x == 256 && blockIdx.x >= 128) {
            PH_LOCALS
            LAS float* scr = (LAS float*)(L + wave * 16384);
            const float* norm_mix = IN_F(3); const float* norm_ffn = IN_F(4); const float* norm_ple = IN_F(5);
            const float* ffn_w_in = IN_F(6); const float* ffn_w_out = IN_F(9); const float* ple_w_proj = IN_F(10); const float* ple_w_gate = IN_F(11);
            const float* od_w_in = IN_F(17); const float* od_w_out = IN_F(18);
#define TJ(Wp, RS, WTp, K_, NOLD, NNEW, LDK, KOFF, TYPE) { constexpr int NI_ = ((K_) / 64) * ((NNEW) / 32); if (r < NI_) { const TJob J{(Wp), (RS), (WTp), (K_), (NOLD), (NNEW), (LDK), (KOFF), (TYPE), NI_}; transpose_item(J, scr, r, lane); continue; } r -= NI_; }
            constexpr int NITEMS_B = (16 * 176 + 44 * 32 + 16 * 32 + 4 * 32) + 16 * 88 + 16 * 32;
            const int gwb = (vcu_of(bx - 128, 128)) * NWAVES + wave, NGWB = 128 * NWAVES;
            for (int it = gwb; it < NITEMS_B; it += NGWB) {
                int r = it;
                TJ(ffn_w_in, norm_ffn, WSP(bf16, WS_W_FFI0), 1024, NFF2, NFF2, 1024, 0, 3)
                TJ(ffn_w_out, nullptr, WSP(bf16, WS_W_FFO0), DFF, 1024, 1024, DFF, 0, 0)
                TJ(ple_w_gate, norm_ple, WSP(bf16, WS_W_PG0), 1024, 1024, 1024, 1024, 0, 0)
                TJ(ple_w_proj, nullptr, WSP(bf16, WS_W_PP0), 256, 1024, 1024, 256, 0, 0)
                TJ(od_w_in, norm_mix + 1024, WSP(bf16, WS_W_ODIN), 1024, 2568, OD_N, 1024, 0, 2)
                TJ(od_w_out, nullptr, WSP(bf16, WS_W_OUT1), 1024, 1024, 1024, 1024, 0, 0)
            }
#undef TJ
        {
            const float* pool_w = IN_F(15); const float* pool_scale = IN_F(16); const float* ev_w_out = IN_F(14); bf16* W_OUT0 = WSP(bf16, WS_W_OUT0);
            for (int it = gwb; it < 1024; it += NGWB) {
                const int g = it >> 8, nb = (it >> 4) & 15, cb = it & 15, n = 64 * nb + lane;
                float acc[8];
#pragma unroll
                for (int cc = 0; cc < 8; ++cc) acc[cc] = 0.f;
#pragma unroll 1
                for (int d0 = 0; d0 < 128; d0 += 16) {
                    float wv[16];
#pragma unroll
                    for (int e = 0; e < 16; ++e) wv[e] = ev_w_out[(size_t)(128 * g + d0 + e) * 1024 + n] * pool_scale[128 * g + d0 + e];
#pragma unroll
                    for (int cc = 0; cc < 8; ++cc) {
                        const float* pw = pool_w + ((size_t)g * 128 + 8 * cb + cc) * 128 + d0;
#pragma unroll
                        for (int e = 0; e < 16; ++e) acc[cc] += pw[e] * wv[e];
                    }
                }
#pragma unroll
                for (int c2 = 0; c2 < 4; ++c2) *(unsigned*)(W_OUT0 + (size_t)n * 1024 + 128 * g + 8 * cb + 2 * c2) = pk2(acc[2 * c2], acc[2 * c2 + 1]);
            }
        }
        }
    }
    SEAM(1);
    if (IN(2)) {
        { PH_LOCALS
          const bf16* ZH = WSP(bf16, WS_ZH); bf16* Y = WSP(bf16, WS_Y); const unsigned lds0 = (unsigned)(uintptr_t)lds;
          for (int pi = vcu; pi < 256; pi += G) {
            const int b = pi >> 5, s = pi & 31;
#pragma unroll 1
            for (int k = 0; k < 2 * DBG_REP_DSA; ++k) mix::dsa_unit(b, (k & 1) ? s : 63 - s, ZH, Y, (char*)lds, lds0, wave_s);
          } }
        { PH_LOCALS
          const bf16* ZH = WSP(bf16, WS_ZH); bf16* Y = WSP(bf16, WS_Y);
          for (int rep_ = 0; rep_ < DBG_REP_POOL; ++rep_) for (int it = gt; it < TOK * 64; it += NGT) mix::pool_item(it, ZH, Y);
        }
    }
    SEAM(2);
    {
        const size_t s1o = (0 == 0) ? WS_SSQA : WS_SSQB, s2o = (0 == 0) ? WS_SSQB : WS_SSQA, s3o = s1o;
        if (IN(3)) {
            PH_LOCALS
            pg8::Gemm g{WSP(bf16, WS_Y), WSP(bf16, (0 == 0) ? WS_W_OUT0 : WS_W_OUT1), TOK, 1024, 1024}; pg8::StaticOrder S; S.init(TOK, 1024, G, bx);
            pg8::EpiRes E{IN_F(0), nullptr, WSP(bf16, WS_HB), WSP(float, s1o), WSP(bf16, WS_AHALO)};
            pg8::gemm_phase<pg8::EpiRes, pg8::StaticOrder, true, true>(L, g, S, E, wave_s);
        }
        SEAM(3);
        if (IN(3 + 2)) {
            PH_LOCALS
            pg8::Gemm g{WSP(bf16, WS_HB), WSP(bf16, WS_W_FFI0), TOK + 256, NFF2, 1024}; pg8::StaticOrder S; S.init(TOK, NFF2, G, bx);
#ifdef STAGGER
            if (STAGGER_COND) { for (int i_ = 0; i_ < STAGGER; ++i_) __builtin_amdgcn_s_sleep(127); }
#endif
            if (G == 256 && bx >= 128 && bx < 128 + NFF2 / 256) {
                pg8::OneUnit S1{64, bx - 128, 1};
                pg8::EpiHaloF EH{WSP(float, s1o), WSP(float, WS_AH), (unsigned*)(ws + WS_CTL) + CW_FLAG + 2048 * 0};
                pg8::gemm_phase<pg8::EpiHaloF, pg8::OneUnit, true, true>(L, g, S1, EH, wave_s);
            }
#ifdef PP_FIRST
            if (G == 256 && bx >= 150) {
                pg8::Gemm gp{WSP(bf16, WS_PB), WSP(bf16, WS_W_PP0), TOK, 1024, PLE}; pg8::StaticOrder SP; SP.init(TOK, 1024, 106, bx - 150);
                pg8::EpiBf16Plain EP{WSP(bf16, WS_PP), 1024};
                pg8::gemm_phase<pg8::EpiBf16Plain, pg8::StaticOrder, true, true>(L, gp, SP, EP, wave_s);
            }
#endif
            pg8::EpiFfnIn E{WSP(float, s1o), IN_F(7) + (size_t)0 * 3 * NFF2, IN_F(8) + (size_t)0 * NFF2, WSP(float, WS_AH), WSP(bf16, WS_ZH), (LAS float*)(L + XB_OFF), (unsigned*)(ws + WS_CTL) + CW_FLAG + 2048 * 0, 1u};
            pg8::gemm_phase<pg8::EpiFfnIn, pg8::StaticOrder, true, true>(L, g, S, E, wave_s);
#ifndef PP_FIRST
            if (G == 256 && bx >= 150) {
                pg8::Gemm gp{WSP(bf16, WS_PB), WSP(bf16, WS_W_PP0), TOK, 1024, PLE}; pg8::StaticOrder SP; SP.init(TOK, 1024, 106, bx - 150);
                pg8::EpiBf16Plain EP{WSP(bf16, WS_PP), 1024};
                pg8::gemm_phase<pg8::EpiBf16Plain, pg8::StaticOrder, true, true>(L, gp, SP, EP, wave_s);
            }
#endif
        }
        SEAM(3 + 2);
        if (IN(3 + 3)) {
            PH_LOCALS
            pg8::Gemm g{WSP(bf16, WS_ZH), WSP(bf16, (0 == 0) ? WS_W_FFO0 : WS_W_FFO1), TOK, 1024, DFF}; pg8::StaticOrder S; S.init(TOK, 1024, G, bx);
            pg8::EpiRes E{nullptr, WSP(bf16, WS_HB), WSP(bf16, WS_HB), WSP(float, s2o), nullptr};
            pg8::gemm_phase<pg8::EpiRes, pg8::StaticOrder, true, true>(L, g, S, E, wave_s);
        }
        SEAM(3 + 3);
        if (IN(3 + 4)) {
            PH_LOCALS
            pg8::Gemm g{WSP(bf16, WS_HB), WSP(bf16, (0 == 0) ? WS_W_PG0 : WS_W_PG1), TOK, 1024, 1024}; pg8::StaticOrder S; S.init(TOK, 1024, G, bx);
            pg8::EpiGate E{WSP(float, s2o), WSP(bf16, WS_HB), WSP(bf16, WS_PP), (bf16*)out, WSP(float, s3o)};
            pg8::gemm_phase<pg8::EpiGate, pg8::StaticOrder, true, true>(L, g, S, E, wave_s);
        }
        SEAM(3 + 4);
    }
    {

            if (IN(8)) {
                { PH_LOCALS
                  pg8::Gemm g{(const bf16*)out, WSP(bf16, WS_W_ODIN), TOK, OD_N, 1024}; pg8::StaticOrder S; S.init(TOK, OD_N, G, bx);
                  pg8::EpiOddIn E{WSP(float, WS_SSQA), WSP(bf16, WS_ZH), WSP(float, WS_FBUF), WSP(float, WS_SST)};
                  pg8::gemm_phase<pg8::EpiOddIn, pg8::StaticOrder, true, true>(L, g, S, E, wave_s); }
                if (gridDim.x == 256 && blockIdx.x >= 192) {
                    PH_LOCALS
                    LAS float* scr = (LAS float*)(L + wave * 16384);
                    const float* norm_ffn = IN_F(4); const float* norm_ple = IN_F(5); const float* ffn_w_in = IN_F(6); const float* ple_w_gate = IN_F(11);
#define TJ(Wp, RS, WTp, K_, NOLD, NNEW, LDK, KOFF, TYPE) { constexpr int NI_ = ((K_) / 64) * ((NNEW) / 32); if (r < NI_) { const TJob J{(Wp), (RS), (WTp), (K_), (NOLD), (NNEW), (LDK), (KOFF), (TYPE), NI_}; transpose_item(J, scr, r, lane); continue; } r -= NI_; }
                    constexpr int NITEMS_C = 16 * 176 + 16 * 32;
                    const int gwc = (bx - 192) * NWAVES + wave, NGWC = 64 * NWAVES;
                    for (int it = gwc; it < NITEMS_C; it += NGWC) {
                        int r = it;
                        TJ(ffn_w_in + (size_t)1024 * NFF2, norm_ffn + 1024, WSP(bf16, WS_W_FFI1), 1024, NFF2, NFF2, 1024, 0, 3)
                        TJ(ple_w_gate + (size_t)1024 * 1024, norm_ple + 1024, WSP(bf16, WS_W_PG1), 1024, 1024, 1024, 1024, 0, 0)
                    }
#undef TJ
                    const float* p1 = IN_F(1) + (size_t)TOK * PLE; bf16* PB = WSP(bf16, WS_PB);
                    const int gtc = (bx - 192) * (NWAVES * 64) + tid, NGTC = 64 * NWAVES * 64;
                    for (int i = gtc; i < TOK * PLE / 4; i += 4 * NGTC) { f32x4 v[4];
#pragma unroll
                        for (int q = 0; q < 4; ++q) v[q] = ((const f32x4*)p1)[(i + q * NGTC < TOK * PLE / 4) ? i + q * NGTC : i];
#pragma unroll
                        for (int q = 0; q < 4; ++q) if (i + q * NGTC < TOK * PLE / 4) ((unsigned long long*)PB)[i + q * NGTC] = (unsigned long long)pk2(v[q].x, v[q].y) | ((unsigned long long)pk2(v[q].z, v[q].w) << 32); }
                }
            }
            SEAM(8);
            if (IN(9)) {
                { PH_LOCALS
                  const bf16* ZH = WSP(bf16, WS_ZH); bf16* Y = WSP(bf16, WS_Y); const unsigned lds0 = (unsigned)(uintptr_t)lds;
                  const float* FBUF = WSP(float, WS_FBUF); const float* fox_b_f = IN_F(19);
                  for (int pi = vcu; pi < 256; pi += G) {
                    const int bh = pi >> 2, s = pi & 3;
#pragma unroll 1
                    for (int k = 0; k < 2 * DBG_REP_FOX; ++k) mix::fox_unit2(bh >> 3, bh & 7, (k & 1) ? s : 7 - s, ZH, FBUF, fox_b_f, Y, (char*)lds, wave_s);
                  } }
                { PH_LOCALS
                  const bf16* ZH = WSP(bf16, WS_ZH); bf16* Y = WSP(bf16, WS_Y);
                  for (int rep_ = 0; rep_ < DBG_REP_SGU; ++rep_) for (int u = vcu; u < 512; u += G) mix::sgu_unit(u >> 6, (u >> 2) & 15, u & 3, ZH, WSP(float, WS_SST), IN_F(20), IN_F(21), WSP(bf16, WS_W_SGU), IN_F(23), Y, (char*)lds, wave_s); }
            }
            SEAM(9);
            }
    {
        const size_t s1o = (1 == 0) ? WS_SSQA : WS_SSQB, s2o = (1 == 0) ? WS_SSQB : WS_SSQA, s3o = s1o;
        if (IN(10)) {
            PH_LOCALS
            pg8::Gemm g{WSP(bf16, WS_Y), WSP(bf16, (1 == 0) ? WS_W_OUT0 : WS_W_OUT1), TOK, 1024, 1024}; pg8::StaticOrder S; S.init(TOK, 1024, G, bx);
            pg8::EpiRes E{nullptr, (const bf16*)out, WSP(bf16, WS_HB), WSP(float, s1o), WSP(bf16, WS_AHALO)};
            pg8::gemm_phase<pg8::EpiRes, pg8::StaticOrder, true, true>(L, g, S, E, wave_s);
        }
        SEAM(10);
        if (IN(10 + 2)) {
            PH_LOCALS
            pg8::Gemm g{WSP(bf16, WS_HB), WSP(bf16, WS_W_FFI1), TOK + 256, NFF2, 1024}; pg8::StaticOrder S; S.init(TOK, NFF2, G, bx);
#ifdef STAGGER
            if (STAGGER_COND) { for (int i_ = 0; i_ < STAGGER; ++i_) __builtin_amdgcn_s_sleep(127); }
#endif
            if (G == 256 && bx >= 128 && bx < 128 + NFF2 / 256) {
                pg8::OneUnit S1{64, bx - 128, 1};
                pg8::EpiHaloF EH{WSP(float, s1o), WSP(float, WS_AH), (unsigned*)(ws + WS_CTL) + CW_FLAG + 2048 * 1};
                pg8::gemm_phase<pg8::EpiHaloF, pg8::OneUnit, true, true>(L, g, S1, EH, wave_s);
            }
#ifdef PP_FIRST
            if (G == 256 && bx >= 150) {
                pg8::Gemm gp{WSP(bf16, WS_PB), WSP(bf16, WS_W_PP1), TOK, 1024, PLE}; pg8::StaticOrder SP; SP.init(TOK, 1024, 106, bx - 150);
                pg8::EpiBf16Plain EP{WSP(bf16, WS_PP), 1024};
                pg8::gemm_phase<pg8::EpiBf16Plain, pg8::StaticOrder, true, true>(L, gp, SP, EP, wave_s);
            }
#endif
            pg8::EpiFfnIn E{WSP(float, s1o), IN_F(7) + (size_t)1 * 3 * NFF2, IN_F(8) + (size_t)1 * NFF2, WSP(float, WS_AH), WSP(bf16, WS_ZH), (LAS float*)(L + XB_OFF), (unsigned*)(ws + WS_CTL) + CW_FLAG + 2048 * 1, 2u};
            pg8::gemm_phase<pg8::EpiFfnIn, pg8::StaticOrder, true, true>(L, g, S, E, wave_s);
#ifndef PP_FIRST
            if (G == 256 && bx >= 150) {
                pg8::Gemm gp{WSP(bf16, WS_PB), WSP(bf16, WS_W_PP1), TOK, 1024, PLE}; pg8::StaticOrder SP; SP.init(TOK, 1024, 106, bx - 150);
                pg8::EpiBf16Plain EP{WSP(bf16, WS_PP), 1024};
                pg8::gemm_phase<pg8::EpiBf16Plain, pg8::StaticOrder, true, true>(L, gp, SP, EP, wave_s);
            }
#endif
        }
        SEAM(10 + 2);
        if (IN(10 + 3)) {
            PH_LOCALS
            pg8::Gemm g{WSP(bf16, WS_ZH), WSP(bf16, (1 == 0) ? WS_W_FFO0 : WS_W_FFO1), TOK, 1024, DFF}; pg8::StaticOrder S; S.init(TOK, 1024, G, bx);
            pg8::EpiRes E{nullptr, WSP(bf16, WS_HB), WSP(bf16, WS_HB), WSP(float, s2o), nullptr};
            pg8::gemm_phase<pg8::EpiRes, pg8::StaticOrder, true, true>(L, g, S, E, wave_s);
        }
        SEAM(10 + 3);
        if (IN(10 + 4)) {
            PH_LOCALS
            pg8::Gemm g{WSP(bf16, WS_HB), WSP(bf16, (1 == 0) ? WS_W_PG0 : WS_W_PG1), TOK, 1024, 1024}; pg8::StaticOrder S; S.init(TOK, 1024, G, bx);
            pg8::EpiGateFinal E{WSP(float, s2o), WSP(bf16, WS_HB), WSP(bf16, WS_PP), WSP(float, s3o), (unsigned*)(ws + WS_CTL) + CW_PAN, IN_F(12), out, (LAS float*)(L + XB_OFF) + 2048};
            pg8::gemm_phase<pg8::EpiGateFinal, pg8::StaticOrder, true, true>(L, g, S, E, wave_s);
        }
        SEAM(10 + 4);
    }
    if (IN(15)) {
        PH_LOCALS
        const float* SSQB = WSP(float, WS_SSQB); const float* norm_final = IN_F(12); const bf16* H6 = WSP(bf16, WS_Y);
        for (int m = gw; m < TOK; m += 4 * NGW) {
            unsigned long long w[4][4]; float rs[4];
#pragma unroll
            for (int q = 0; q < 4; ++q) { const int mm = (m + q * NGW < TOK) ? m + q * NGW : m; rs[q] = pg8::row_rstd(SSQB, mm);
                const unsigned long long* hr = (const unsigned long long*)(H6 + (size_t)mm * DMODEL) + lane;
#pragma unroll
                for (int j = 0; j < 4; ++j) w[q][j] = hr[64 * j]; }
            const f32x4* gr = (const f32x4*)norm_final + lane;
            f32x4 gg[4];
#pragma unroll
            for (int j = 0; j < 4; ++j) gg[j] = gr[64 * j];
#pragma unroll
            for (int q = 0; q < 4; ++q) { const int mm = m + q * NGW; if (mm < TOK) { f32x4* xr = (f32x4*)(out + (size_t)mm * DMODEL) + lane;
#pragma unroll
                for (int j = 0; j < 4; ++j) { const unsigned long long ww = w[q][j];
                    const f32x4 v = {pg8::bf_lo((unsigned)ww), pg8::bf_hi((unsigned)ww), pg8::bf_lo((unsigned)(ww >> 32)), pg8::bf_hi((unsigned)(ww >> 32))};
                    __builtin_nontemporal_store(v * rs[q] * gg[j], xr + 64 * j); } } }
        }
    }
#undef IN
#undef SEAM
}

#ifndef MK_N_LAUNCHES
#define MK_N_LAUNCHES 1
#endif
constexpr int N_PHASES = 16;
extern "C" void kernel_launch(void* const* d_in, const int* in_sizes, int n_in, void* d_out, int out_size, void* d_ws, size_t ws_size, hipStream_t stream) {
    static int grid = 0;
    if (grid == 0) {
        if (n_in != 24 || out_size != TOK * DMODEL || ws_size < WS_END) { fprintf(stderr, "kernel_launch: unexpected shapes (n_in %d, out %d, ws %zu)\n", n_in, out_size, ws_size); grid = -1; return; }
        int dev = 0, cus = 0;
        if (hipGetDevice(&dev) != hipSuccess || hipDeviceGetAttribute(&cus, hipDeviceAttributeMultiprocessorCount, dev) != hipSuccess) { grid = -1; return; }
        if (hipFuncSetAttribute((const void*)mega_fwd, hipFuncAttributeMaxDynamicSharedMemorySize, LDS_BYTES) != hipSuccess) { fprintf(stderr, "kernel_launch: hipFuncSetAttribute failed\n"); grid = -1; return; }
        int per_cu = 0;
        if (hipOccupancyMaxActiveBlocksPerMultiprocessor(&per_cu, (const void*)mega_fwd, NWAVES * 64, LDS_BYTES) != hipSuccess || per_cu < 1) { fprintf(stderr, "kernel_launch: occupancy query says %d\n", per_cu); }
        (void)hipGetLastError();
        grid = cus;
    }
    if (grid < 0) return;
    (void)hipMemsetAsync((char*)d_ws + WS_CTL, 0, CTL_ZERO_BYTES, stream);
    Args a{};
    for (int i = 0; i < 24; ++i) a.in[i] = d_in[i];
    a.out = (float*)d_out; a.ws = (unsigned char*)d_ws;
#ifdef DBG_CHECK
    {
        using namespace dbg;
        auto LP = [&](int ph) { a.ph_lo = ph; a.ph_hi = ph + 1; hipLaunchKernelGGL(mega_fwd, dim3(grid), dim3(NWAVES * 64), LDS_BYTES, stream, a); };
        char* wsb = (char*)d_ws; float* ERR = (float*)(wsb + 512 * 1024); float* SNAP = (float*)(wsb + 600 * 1024); float* outp = (float*)d_out;
        const unsigned short* ZHp = (const unsigned short*)(wsb + WS_ZH); const unsigned short* Yp = (const unsigned short*)(wsb + WS_Y); const float* FB = (const float*)(wsb + WS_FBUF);
        const unsigned short* HBp = (const unsigned short*)(wsb + WS_HB); const unsigned short* H3p = (const unsigned short*)d_out;
        auto F = [&](int i) { return (const float*)d_in[i]; };
        const float* x = F(0);
        LP(0); LP(1);
        k_evenin<<<NS, 256, 0, stream>>>(x, F(3), F(13), (const int*)d_in[2], ZHp, ERR, 0);
        LP(2);
        k_pool<<<NS, 256, 0, stream>>>(ZHp, Yp, ERR, 1);
        k_dsa<<<NS, 256, 0, stream>>>(ZHp, Yp, ERR, 2);
        LP(3);
        k_outproj<<<NS, 256, 0, stream>>>(x, 0, SNAP, Yp, F(14), F(15), F(16), HBp, ERR, 3);
        for (int layer = 0; layer < 2; ++layer) {
            const int pb = layer ? 10 : 3, kb = layer ? 10 : 3;
            if (layer == 1) {
                LP(8);
                k_oddin<<<NS, 256, 0, stream>>>(H3p, F(3) + 1024, F(17), ZHp, FB, ERR, 7);
                LP(9);
                k_fox<<<NS, 256, 0, stream>>>(ZHp, FB, F(19), Yp, ERR, 8);
                k_sgu<<<NS, 256, 0, stream>>>(ZHp, F(20), F(21), F(22), F(23), Yp, ERR, 9);
                k_snap<<<NS, 256, 0, stream>>>(H3p, SNAP);
                LP(10);
                k_outproj<<<NS, 256, 0, stream>>>(nullptr, 1, SNAP, Yp, F(18), nullptr, nullptr, HBp, ERR, 10);
            }
            LP(pb + 1); LP(pb + 2);
            k_ffnin<<<NS, 256, 0, stream>>>(HBp, F(4) + 1024 * layer, F(6) + (size_t)layer * 1024 * NFF2, F(7) + (size_t)layer * 3 * NFF2, F(8) + (size_t)layer * NFF2, ZHp, ERR, kb + 1);
            k_snap<<<NS, 256, 0, stream>>>(HBp, SNAP);
            LP(pb + 3);
            k_ffnout<<<NS, 256, 0, stream>>>(SNAP, ZHp, F(9) + (size_t)layer * DFF * 1024, HBp, ERR, kb + 2);
            k_snap<<<NS, 256, 0, stream>>>(HBp, SNAP);
            LP(pb + 4);
            k_ple<<<NS, 256, 0, stream>>>(SNAP, F(1) + (size_t)layer * TOK * PLE, F(5) + 1024 * layer, F(10) + (size_t)layer * PLE * 1024, F(11) + (size_t)layer * 1024 * 1024, layer ? Yp : H3p, ERR, kb + 3);
        }
        k_snap<<<NS, 256, 0, stream>>>(Yp, SNAP);
        LP(15);
        k_final<<<NS, 256, 0, stream>>>(SNAP, F(12), outp, ERR, 14);
        t_dpp<<<1, 64, 0, stream>>>(ERR + 40);
        k_report<<<1024, 256, 0, stream>>>(ERR, 15, DBG_TOL, outp);
        return;
    }
#endif
    if (MK_N_LAUNCHES == 1) {
        a.ph_lo = 0; a.ph_hi = N_PHASES;
        hipLaunchKernelGGL(mega_fwd, dim3(grid), dim3(NWAVES * 64), LDS_BYTES, stream, a);
    } else {
#ifndef DBG_STOP
#define DBG_STOP N_PHASES
#endif
#ifndef DBG_DOUBLE
#define DBG_DOUBLE -1
#endif
        for (int ph = 0; ph < DBG_STOP; ++ph) { a.ph_lo = ph; a.ph_hi = ph + 1; const int reps = (ph == DBG_DOUBLE || (DBG_DOUBLE == 100 && (ph == 0 || ph == 1 || ph == 2 || ph == 4 || ph == 5 || ph == 8 || ph == 9 || ph == 11 || ph == 12))) ? 2 : 1;
            for (int r = 0; r < reps; ++r) hipLaunchKernelGGL(mega_fwd, dim3(grid), dim3(NWAVES * 64), LDS_BYTES, stream, a); }
    }
}
```

```cpp
#include <hip/hip_runtime.h>
#include <hip/hip_bf16.h>
#include <cstdio>
#include <cstdint>
#include <cmath>
constexpr int TOK = 16384, DMODEL = 1024, SEQ = 2048, NBATCH = 8;
constexpr int DFF = 2816, NFF2 = 5632, PLE = 256;
constexpr int EV_N = 1536;
constexpr int OD_N = 2816;
constexpr int Z1P = 2560;
constexpr float RMS_EPS = 1e-6f;
constexpr float C2 = 0.125f * 1.4426950408889634f;


__device__ __forceinline__ int lane_opaque() { unsigned z = 0u; asm volatile("" : "+v"(z)); return (int)__builtin_amdgcn_mbcnt_hi(~0u, __builtin_amdgcn_mbcnt_lo(~0u, z)); }
__device__ __forceinline__ float xor16_f(float v) { return __builtin_bit_cast(float, __builtin_amdgcn_ds_swizzle(__builtin_bit_cast(int, v), 0x401F)); }
__device__ __forceinline__ void halves_pair(unsigned v, unsigned& a, unsigned& b) { unsigned w = v; asm volatile("" : "+v"(w)); auto rr = __builtin_amdgcn_permlane32_swap(v, w, false, false); a = rr[0]; b = rr[1]; }
__device__ __forceinline__ float halves_sum_f(float v) { unsigned a, b; halves_pair(__builtin_bit_cast(unsigned, v), a, b); return __builtin_bit_cast(float, a) + __builtin_bit_cast(float, b); }
__device__ __forceinline__ float halves_max_f(float v) { unsigned a, b; halves_pair(__builtin_bit_cast(unsigned, v), a, b); return __builtin_fmaxf(__builtin_bit_cast(float, a), __builtin_bit_cast(float, b)); }
__device__ __forceinline__ unsigned halves_add_u(unsigned v) { unsigned a, b; halves_pair(v, a, b); return a + b; }
__device__ __forceinline__ unsigned halves_or_u(unsigned v) { unsigned a, b; halves_pair(v, a, b); return a | b; }
namespace pg8 {
#define PG8_LAS __attribute__((address_space(3)))
typedef unsigned short bf16_t;
typedef short bf16x8 __attribute__((ext_vector_type(8)));
typedef float f32x4 __attribute__((ext_vector_type(4)));
typedef unsigned u32x4 __attribute__((ext_vector_type(4)));
constexpr int BM = 256, BK = 64, HALF = 128, HTB = HALF * BK * 2  , STAGE_BYTES = 8 * HTB, NXCD = 8, WGM = 8;

__host__ __device__ __forceinline__ int lds_byte(int r, int c) { const int st = (r >> 4) * 2 + (c >> 5), rr = r & 15, cc = c & 31, ob = rr * 64 + cc * 2; return st * 1024 + (ob ^ (((ob >> 9) & 1) << 5)); }
__host__ __device__ __forceinline__ void stage_rc(int b, int& R, int& C) { const int st = b / 1024, sb = b % 1024, swz = sb ^ (((sb >> 9) & 1) << 5); R = (st >> 1) * 16 + swz / 64; C = (st & 1) * 32 + (swz % 64) / 2; }
__host__ __device__ __forceinline__ int perm32(int rho) { const int n = rho >> 4, i = rho & 15; return 8 * (i >> 2) + 4 * n + (i & 3); }

struct Unit { int pm, pn; };
struct Gemm { const bf16_t* A; const bf16_t* Bt; int M, N, K; };

struct StaticOrder {
    int nM, nN, nwg, G, c;
    __host__ __device__ void init(int M, int N, int G_, int c_) { nM = M / BM; nN = N / BM; nwg = nM * nN; G = G_; c = c_; }
    __host__ __device__ bool next(int i, Unit& u) const {
        const long L = (long)i * G + c; if (L >= nwg) return false;
        int wgid = (int)L; { const int q = nwg / NXCD, r = nwg % NXCD, xcd = wgid % NXCD, off = wgid / NXCD; wgid = (xcd < r ? xcd * (q + 1) : r * (q + 1) + (xcd - r) * q) + off; }
        const int nig = WGM * nN, gid = wgid / nig, fm = gid * WGM, gsz = (nM - fm) < WGM ? (nM - fm) : WGM;
        u.pm = fm + ((wgid % nig) % gsz); u.pn = (wgid % nig) / gsz; return true;
    }
    __device__ __forceinline__ void a_ready(const Unit&) const {}
    __device__ __forceinline__ void done(const Unit&) const {}
};

struct OneUnit {
    int pm, pn, on;
    __host__ __device__ bool next(int i, Unit& u) const { if (!on || i != 0) return false; u.pm = pm; u.pn = pn; return true; }
    __device__ __forceinline__ void a_ready(const Unit&) const {}
    __device__ __forceinline__ void done(const Unit&) const {}
};
struct FfnOrder {
    StaticOrder S0; int extra;
    __host__ __device__ void init(int M, int N, int G_, int c_) { S0.init(M, N, G_, c_); extra = (G_ == 256 && c_ >= 128 && c_ < 128 + N / BM) ? 1 : 0; }
    __host__ __device__ bool next(int i, Unit& u) const { if (extra) { if (i == 0) { u.pm = 64; u.pn = S0.c - 128; return true; } return S0.next(i - 1, u); } return S0.next(i, u); }
    __device__ __forceinline__ void a_ready(const Unit&) const {}
    __device__ __forceinline__ void done(const Unit&) const {}
};
typedef float f32x2 __attribute__((ext_vector_type(2)));
typedef unsigned u32x2 __attribute__((ext_vector_type(2)));
__device__ __forceinline__ unsigned cvt_pk_bf16(float lo, float hi) { unsigned r; asm volatile("v_cvt_pk_bf16_f32 %0, %1, %2" : "=v"(r) : "v"(lo), "v"(hi)); return r; }
__device__ __forceinline__ float bf_lo(unsigned w) { return __builtin_bit_cast(float, w << 16); }
__device__ __forceinline__ float bf_hi(unsigned w) { return __builtin_bit_cast(float, w & 0xffff0000u); }
__device__ __forceinline__ float sq4(const f32x4 v) { return (v[0] * v[0] + v[1] * v[1]) + (v[2] * v[2] + v[3] * v[3]); }
__device__ __forceinline__ float row_rstd(const float* ssq, int row) {
    const f32x4* p = (const f32x4*)(ssq + (size_t)row * 16);
    const f32x4 a = p[0], b = p[1], c = p[2], d = p[3];
    const float s = (((a[0] + a[1]) + (a[2] + a[3])) + ((b[0] + b[1]) + (b[2] + b[3]))) + (((c[0] + c[1]) + (c[2] + c[3])) + ((d[0] + d[1]) + (d[2] + d[3])));
    return 1.0f / sqrtf(s * (1.0f / 1024.0f) + RMS_EPS);
}
__device__ __forceinline__ float row_rstd_coh(const float* ssq, int row) {
    const float* p = ssq + (size_t)row * 16;
    f32x4 a, b, c, d;
    asm volatile("global_load_dwordx4 %0, %4, off sc1\n\tglobal_load_dwordx4 %1, %4, off offset:16 sc1\n\tglobal_load_dwordx4 %2, %4, off offset:32 sc1\n\tglobal_load_dwordx4 %3, %4, off offset:48 sc1\n\ts_waitcnt vmcnt(0)"
                 : "=&v"(a), "=&v"(b), "=&v"(c), "=&v"(d) : "v"(p) : "memory");
    const float s = (((a[0] + a[1]) + (a[2] + a[3])) + ((b[0] + b[1]) + (b[2] + b[3]))) + (((c[0] + c[1]) + (c[2] + c[3])) + ((d[0] + d[1]) + (d[2] + d[3])));
    return 1.0f / sqrtf(s * (1.0f / 1024.0f) + RMS_EPS);
}
__device__ __forceinline__ void ssq_write(float* ssq_out, float q, int row, int slot, int fq) {
    q += xor16_f(q); q = halves_sum_f(q);
    if (fq == 0) ssq_out[(size_t)row * 16 + slot] = q;
}
typedef float f32x2 __attribute__((ext_vector_type(2)));
__device__ __forceinline__ f32x2 gelu_mul2(const f32x2 x, const f32x2 c) {
    const f32x2 x2 = x * x;
    const f32x2 a = x * (x2 * (-2.3022082f * 0.044715f) + (-2.3022082f));
    f32x2 e; e.x = __builtin_amdgcn_exp2f(a.x); e.y = __builtin_amdgcn_exp2f(a.y);
    const f32x2 d = e + 1.0f;
    f32x2 r; r.x = __builtin_amdgcn_rcpf(d.x); r.y = __builtin_amdgcn_rcpf(d.y);
    return (x * c) * r;
}
__device__ __forceinline__ float gelu_tanh(float x) {
    const float t = x + 0.044715f * x * x * x;
    const float e = __builtin_amdgcn_exp2f(-2.3022082f * t);
    return x * __builtin_amdgcn_rcpf(1.0f + e);
}
__device__ __forceinline__ float sigmoid_f(float x) { return __builtin_amdgcn_rcpf(1.0f + __builtin_amdgcn_exp2f(-1.4426950408889634f * x)); }


struct EpiRes {
    static constexpr bool PERM = true, AFTER_DRAIN = false;
    const float* basef; const bf16_t* baseb; bf16_t* hb; float* ssq_out; bf16_t* ahalo;
    __device__ __forceinline__ void operator()(const f32x4 (&acc)[2][2][4][2], const Unit& u_, int wr, int wc, int fr, int fq) const {
        Unit u; { int pm_ = u_.pm, pn_ = u_.pn; asm volatile("" : "+s"(pm_), "+s"(pn_)); u.pm = pm_; u.pn = pn_; }
        const int row0 = u.pm * BM + wr * 64 + fr, col0 = u.pn * BM + wc * 32 + 8 * fq;
        if (basef != nullptr) {
#pragma unroll
            for (int ai = 0; ai < 2; ++ai)
#pragma unroll
                for (int m = 0; m < 4; ++m) {
                    const int row = row0 + ai * HALF + m * 16; float q = 0.f;
#pragma unroll
                    for (int bj = 0; bj < 2; ++bj) {
                        const size_t off = (size_t)row * DMODEL + col0 + bj * HALF;
                        const f32x4 b0 = *(const f32x4*)(basef + off), b1 = *(const f32x4*)(basef + off + 4);
                        const f32x4 v0 = acc[ai][bj][m][0] + b0, v1 = acc[ai][bj][m][1] + b1;
                        q += sq4(v0) + sq4(v1);
                        u32x4 w; w.x = cvt_pk_bf16(v0[0], v0[1]); w.y = cvt_pk_bf16(v0[2], v0[3]); w.z = cvt_pk_bf16(v1[0], v1[1]); w.w = cvt_pk_bf16(v1[2], v1[3]);
                        *(u32x4*)(hb + off) = w;
                        if (ahalo != nullptr && ai == 1 && m == 3) {
                            const int rl = row & 255;
                            if (rl >= 254 && u.pm < 63) *(u32x4*)(ahalo + (size_t)(2 * (u.pm + 1) + (rl - 254)) * DMODEL + col0 + bj * HALF) = w;
                        }
                    }
                    ssq_write(ssq_out, q, row, u.pn * 4 + wc, fq);
                    if (m & 1) asm volatile("" ::: "memory");
                }
        } else {
#pragma unroll
            for (int ai = 0; ai < 2; ++ai) {
                u32x4 bw[4][2];
#pragma unroll
                for (int m = 0; m < 4; ++m)
#pragma unroll
                    for (int bj = 0; bj < 2; ++bj) bw[m][bj] = *(const u32x4*)(baseb + (size_t)(row0 + ai * HALF + m * 16) * DMODEL + col0 + bj * HALF);
                asm volatile("" ::: "memory");
#pragma unroll
                for (int m = 0; m < 4; ++m) {
                    const int row = row0 + ai * HALF + m * 16; float q = 0.f;
#pragma unroll
                    for (int bj = 0; bj < 2; ++bj) {
                        const size_t off = (size_t)row * DMODEL + col0 + bj * HALF;
                        const u32x4 pw = bw[m][bj];
                        const f32x4 b0 = {bf_lo(pw.x), bf_hi(pw.x), bf_lo(pw.y), bf_hi(pw.y)}, b1 = {bf_lo(pw.z), bf_hi(pw.z), bf_lo(pw.w), bf_hi(pw.w)};
                        const f32x4 v0 = acc[ai][bj][m][0] + b0, v1 = acc[ai][bj][m][1] + b1;
                        q += sq4(v0) + sq4(v1);
                        u32x4 w; w.x = cvt_pk_bf16(v0[0], v0[1]); w.y = cvt_pk_bf16(v0[2], v0[3]); w.z = cvt_pk_bf16(v1[0], v1[1]); w.w = cvt_pk_bf16(v1[2], v1[3]);
                        *(u32x4*)(hb + off) = w;
                        if (ahalo != nullptr && ai == 1 && m == 3) {
                            const int rl = row & 255;
                            if (rl >= 254 && u.pm < 63) *(u32x4*)(ahalo + (size_t)(2 * (u.pm + 1) + (rl - 254)) * DMODEL + col0 + bj * HALF) = w;
                        }
                    }
                    ssq_write(ssq_out, q, row, u.pn * 4 + wc, fq);
                }
                asm volatile("" ::: "memory");
            }
        }
    }
};
struct EpiGate {
    static constexpr bool PERM = true, AFTER_DRAIN = false;
    const float* ssq_in; const bf16_t* base; const bf16_t* pp; bf16_t* dst; float* ssq_out;
    __device__ __forceinline__ void operator()(const f32x4 (&acc)[2][2][4][2], const Unit& u_, int wr, int wc, int fr, int fq) const {
        Unit u; { int pm_ = u_.pm, pn_ = u_.pn; asm volatile("" : "+s"(pm_), "+s"(pn_)); u.pm = pm_; u.pn = pn_; }
        const int row0 = u.pm * BM + wr * 64 + fr, col0 = u.pn * BM + wc * 32 + 8 * fq;
#pragma unroll
        for (int ai = 0; ai < 2; ++ai)
#pragma unroll
            for (int mp = 0; mp < 2; ++mp) {
                u32x4 bw[2][2], pq[2][2]; float rs[2];
#pragma unroll
                for (int mi = 0; mi < 2; ++mi) {
                    const int row = row0 + ai * HALF + (2 * mp + mi) * 16;
#pragma unroll
                    for (int bj = 0; bj < 2; ++bj) { const size_t off = (size_t)row * DMODEL + col0 + bj * HALF; bw[mi][bj] = *(const u32x4*)(base + off); pq[mi][bj] = *(const u32x4*)(pp + off); }
                }
#pragma unroll
                for (int mi = 0; mi < 2; ++mi) rs[mi] = row_rstd(ssq_in, row0 + ai * HALF + (2 * mp + mi) * 16);
                asm volatile("" ::: "memory");
#pragma unroll
                for (int mi = 0; mi < 2; ++mi) {
                    const int m = 2 * mp + mi; const int row = row0 + ai * HALF + m * 16; float q = 0.f;
#pragma unroll
                    for (int bj = 0; bj < 2; ++bj) {
                        const size_t off = (size_t)row * DMODEL + col0 + bj * HALF;
                        const u32x4 b_ = bw[mi][bj], p_ = pq[mi][bj];
                        const float bb[8] = {bf_lo(b_.x), bf_hi(b_.x), bf_lo(b_.y), bf_hi(b_.y), bf_lo(b_.z), bf_hi(b_.z), bf_lo(b_.w), bf_hi(b_.w)};
                        const float pv[8] = {bf_lo(p_.x), bf_hi(p_.x), bf_lo(p_.y), bf_hi(p_.y), bf_lo(p_.z), bf_hi(p_.z), bf_lo(p_.w), bf_hi(p_.w)};
                        const f32x4 g0 = acc[ai][bj][m][0] * rs[mi], g1 = acc[ai][bj][m][1] * rs[mi];
                        const float gg[8] = {g0[0], g0[1], g0[2], g0[3], g1[0], g1[1], g1[2], g1[3]};
                        float v[8];
#pragma unroll
                        for (int i = 0; i < 8; ++i) { v[i] = bb[i] + pv[i] * sigmoid_f(gg[i]); q += v[i] * v[i]; }
                        u32x4 w; w.x = cvt_pk_bf16(v[0], v[1]); w.y = cvt_pk_bf16(v[2], v[3]); w.z = cvt_pk_bf16(v[4], v[5]); w.w = cvt_pk_bf16(v[6], v[7]);
                        *(u32x4*)(dst + off) = w;
                    }
                    ssq_write(ssq_out, q, row, u.pn * 4 + wc, fq);
                }
                asm volatile("" ::: "memory");
            }
    }
};
struct EpiGateFinal {
    static constexpr bool PERM = true, AFTER_DRAIN = false;
    const float* ssq_in; const bf16_t* base; const bf16_t* pp; float* ssq_out; unsigned* cnt; const float* gain; float* outp; PG8_LAS float* rtab;
    __device__ __forceinline__ void operator()(const f32x4 (&acc)[2][2][4][2], const Unit& u_, int wr, int wc, int fr, int fq) const {
        Unit u; { int pm_ = u_.pm, pn_ = u_.pn; asm volatile("" : "+s"(pm_), "+s"(pn_)); u.pm = pm_; u.pn = pn_; }
        const int row0 = u.pm * BM + wr * 64 + fr, col0 = u.pn * BM + wc * 32 + 8 * fq;
        f32x4 hv[2][2][4][2];
#pragma unroll
        for (int ai = 0; ai < 2; ++ai)
#pragma unroll
            for (int mp = 0; mp < 2; ++mp) {
                u32x4 bw[2][2], pq[2][2]; float rs[2];
#pragma unroll
                for (int mi = 0; mi < 2; ++mi) {
                    const int row = row0 + ai * HALF + (2 * mp + mi) * 16;
#pragma unroll
                    for (int bj = 0; bj < 2; ++bj) { const size_t off = (size_t)row * DMODEL + col0 + bj * HALF; bw[mi][bj] = *(const u32x4*)(base + off); pq[mi][bj] = *(const u32x4*)(pp + off); }
                }
#pragma unroll
                for (int mi = 0; mi < 2; ++mi) rs[mi] = row_rstd(ssq_in, row0 + ai * HALF + (2 * mp + mi) * 16);
                asm volatile("" ::: "memory");
#pragma unroll
                for (int mi = 0; mi < 2; ++mi) {
                    const int m = 2 * mp + mi; const int row = row0 + ai * HALF + m * 16; float q = 0.f;
#pragma unroll
                    for (int bj = 0; bj < 2; ++bj) {
                        const u32x4 b_ = bw[mi][bj], p_ = pq[mi][bj];
                        const float bb[8] = {bf_lo(b_.x), bf_hi(b_.x), bf_lo(b_.y), bf_hi(b_.y), bf_lo(b_.z), bf_hi(b_.z), bf_lo(b_.w), bf_hi(b_.w)};
                        const float pv[8] = {bf_lo(p_.x), bf_hi(p_.x), bf_lo(p_.y), bf_hi(p_.y), bf_lo(p_.z), bf_hi(p_.z), bf_lo(p_.w), bf_hi(p_.w)};
                        const f32x4 g0 = acc[ai][bj][m][0] * rs[mi], g1 = acc[ai][bj][m][1] * rs[mi];
                        const float gg[8] = {g0[0], g0[1], g0[2], g0[3], g1[0], g1[1], g1[2], g1[3]};
                        float v[8];
#pragma unroll
                        for (int i = 0; i < 8; ++i) { v[i] = bb[i] + pv[i] * sigmoid_f(gg[i]); q += v[i] * v[i]; }
                        hv[ai][bj][m][0] = (f32x4){v[0], v[1], v[2], v[3]}; hv[ai][bj][m][1] = (f32x4){v[4], v[5], v[6], v[7]};
                    }
                    ssq_write(ssq_out, q, row, u.pn * 4 + wc, fq);
                }
                asm volatile("" ::: "memory");
            }
        asm volatile("s_waitcnt vmcnt(0)" ::: "memory"); __builtin_amdgcn_s_barrier(); asm volatile("" ::: "memory");
        if (wr == 0 && wc == 0) {
            if (fr == 0 && fq == 0) {
                __builtin_amdgcn_fence(__ATOMIC_RELEASE, "agent");
                asm volatile("s_waitcnt vmcnt(0)" ::: "memory");
                __hip_atomic_fetch_add(cnt + 64 * u.pm, 1u, __ATOMIC_RELAXED, __HIP_MEMORY_SCOPE_AGENT);
            }
            unsigned sp = 0;
            while (__hip_atomic_load(cnt + 64 * u.pm, __ATOMIC_RELAXED, __HIP_MEMORY_SCOPE_AGENT) < 4u) { __builtin_amdgcn_s_sleep(2); if (++sp > (1u << 22)) break; }
        }
        asm volatile("" ::: "memory"); __builtin_amdgcn_s_barrier(); asm volatile("" ::: "memory");
        if (wr == 0) rtab[wc * 64 + fq * 16 + fr] = row_rstd_coh(ssq_out, u.pm * BM + wc * 64 + fq * 16 + fr);
        asm volatile("s_waitcnt lgkmcnt(0)" ::: "memory"); __builtin_amdgcn_s_barrier(); asm volatile("" ::: "memory");
        f32x4 gn[2][2];
#pragma unroll
        for (int bj = 0; bj < 2; ++bj)
#pragma unroll
            for (int n = 0; n < 2; ++n) gn[bj][n] = *(const f32x4*)(gain + col0 + bj * HALF + 4 * n);
#pragma unroll
        for (int ai = 0; ai < 2; ++ai)
#pragma unroll
            for (int m = 0; m < 4; ++m) {
                const float rsf = rtab[ai * HALF + wr * 64 + m * 16 + fr];
                float* orow = outp + (size_t)(row0 + ai * HALF + m * 16) * DMODEL + col0;
#pragma unroll
                for (int bj = 0; bj < 2; ++bj)
#pragma unroll
                    for (int n = 0; n < 2; ++n) *(f32x4*)(orow + bj * HALF + 4 * n) = hv[ai][bj][m][n] * rsf * gn[bj][n];
            }
    }
};
struct EpiBf16Plain {
    static constexpr bool PERM = true, AFTER_DRAIN = false;
    bf16_t* O; int ldc;
    __device__ __forceinline__ void operator()(const f32x4 (&acc)[2][2][4][2], const Unit& u_, int wr, int wc, int fr, int fq) const {
        Unit u; { int pm_ = u_.pm, pn_ = u_.pn; asm volatile("" : "+s"(pm_), "+s"(pn_)); u.pm = pm_; u.pn = pn_; }
        const int row0 = u.pm * BM + wr * 64 + fr, col0 = u.pn * BM + wc * 32 + 8 * fq;
#pragma unroll
        for (int ai = 0; ai < 2; ++ai)
#pragma unroll
            for (int m = 0; m < 4; ++m) {
                const int row = row0 + ai * HALF + m * 16;
#pragma unroll
                for (int bj = 0; bj < 2; ++bj) {
                    const f32x4 v0 = acc[ai][bj][m][0], v1 = acc[ai][bj][m][1];
                    u32x4 w; w.x = cvt_pk_bf16(v0[0], v0[1]); w.y = cvt_pk_bf16(v0[2], v0[3]); w.z = cvt_pk_bf16(v1[0], v1[1]); w.w = cvt_pk_bf16(v1[2], v1[3]);
                    *(u32x4*)(O + (size_t)row * ldc + col0 + bj * HALF) = w;
                }
            }
    }
};
struct EpiEvenIn {
    static constexpr bool PERM = true, AFTER_DRAIN = false;
    const float* ssq_in; bf16_t* Z; const f32x2* rope;
    __device__ __forceinline__ void operator()(const f32x4 (&acc)[2][2][4][2], const Unit& u_, int wr, int wc, int fr, int fq) const {
        Unit u; { int pm_ = u_.pm, pn_ = u_.pn; asm volatile("" : "+s"(pm_), "+s"(pn_)); u.pm = pm_; u.pn = pn_; }
        const int row0 = u.pm * BM + wr * 64 + fr, colw = wc * 32 + 8 * fq;
        const int pn = u.pn;
        const float sc = (pn == 2 || pn == 3) ? C2 : 1.0f;
#pragma unroll
        for (int ai = 0; ai < 2; ++ai)
#pragma unroll
            for (int m = 0; m < 4; ++m) {
                const int row = row0 + ai * HALF + m * 16;
                const float rs = row_rstd(ssq_in, row);
#pragma unroll
                for (int bj = 0; bj < 2; ++bj) {
                    const int gi = 2 * bj + (wc >> 1);
                    const bool ropeg = (pn == 2 || pn == 3 || pn == 5 || (pn == 4 && (gi == 0 || gi == 2))) && ((wc & 1) == 0);
                    f32x4 v0 = acc[ai][bj][m][0] * rs, v1 = acc[ai][bj][m][1] * rs;
                    if (ropeg && fq < 2) {
                        const f32x4* rp = (const f32x4*)(rope + (size_t)row * 8 + 4 * fq);
                        const f32x4 ra = rp[0], rb = rp[1];
                        f32x4 o0, o1;
                        o0[0] = v0[0] * ra[0] - v0[1] * ra[1]; o0[1] = v0[1] * ra[0] + v0[0] * ra[1];
                        o0[2] = v0[2] * ra[2] - v0[3] * ra[3]; o0[3] = v0[3] * ra[2] + v0[2] * ra[3];
                        o1[0] = v1[0] * rb[0] - v1[1] * rb[1]; o1[1] = v1[1] * rb[0] + v1[0] * rb[1];
                        o1[2] = v1[2] * rb[2] - v1[3] * rb[3]; o1[3] = v1[3] * rb[2] + v1[2] * rb[3];
                        v0 = o0; v1 = o1;
                    }
                    v0 = v0 * sc; v1 = v1 * sc;
                    u32x4 w; w.x = cvt_pk_bf16(v0[0], v0[1]); w.y = cvt_pk_bf16(v0[2], v0[3]); w.z = cvt_pk_bf16(v1[0], v1[1]); w.w = cvt_pk_bf16(v1[2], v1[3]);
                    *(u32x4*)(Z + (size_t)row * EV_N + pn * BM + bj * HALF + colw) = w;
                }
            }
    }
};
struct EpiOddIn {
    static constexpr bool PERM = true, AFTER_DRAIN = false;
    const float* ssq_in; bf16_t* Z; float* F; float* sst;
    __device__ __forceinline__ void operator()(const f32x4 (&acc)[2][2][4][2], const Unit& u_, int wr, int wc, int fr, int fq) const {
        Unit u; { int pm_ = u_.pm, pn_ = u_.pn; asm volatile("" : "+s"(pm_), "+s"(pn_)); u.pm = pm_; u.pn = pn_; }
        const int row0 = u.pm * BM + wr * 64 + fr, colw = wc * 32 + 8 * fq;
        const int pn = u.pn;
        const float sc = (pn < 2) ? C2 : 1.0f;
        const bool act = (pn >= 6 && pn < 10), stat = (pn == 8 || pn == 9);
#pragma unroll
        for (int ai = 0; ai < 2; ++ai)
#pragma unroll
            for (int m = 0; m < 4; ++m) {
                const int row = row0 + ai * HALF + m * 16;
                const float rs = row_rstd(ssq_in, row);
                if (pn == 10) {
                    if (wc == 0 && fq == 0) { *(f32x4*)(F + (size_t)row * 8) = acc[ai][0][m][0] * rs; *(f32x4*)(F + (size_t)row * 8 + 4) = acc[ai][0][m][1] * rs; }
                    continue;
                }
                float s1 = 0.f, s2 = 0.f;
#pragma unroll
                for (int bj = 0; bj < 2; ++bj) {
                    f32x4 v0 = acc[ai][bj][m][0] * (rs * sc), v1 = acc[ai][bj][m][1] * (rs * sc);
                    if (act) {
#pragma unroll
                        for (int i = 0; i < 4; ++i) { v0[i] = gelu_tanh(v0[i]); v1[i] = gelu_tanh(v1[i]); }
                    }
                    s1 += ((v0[0] + v0[1]) + (v0[2] + v0[3])) + ((v1[0] + v1[1]) + (v1[2] + v1[3])); s2 += sq4(v0) + sq4(v1);
                    u32x4 w; w.x = cvt_pk_bf16(v0[0], v0[1]); w.y = cvt_pk_bf16(v0[2], v0[3]); w.z = cvt_pk_bf16(v1[0], v1[1]); w.w = cvt_pk_bf16(v1[2], v1[3]);
                    *(u32x4*)(Z + (size_t)row * Z1P + pn * BM + bj * HALF + colw) = w;
                }
                if (stat) {
                    s1 += xor16_f(s1); s1 = halves_sum_f(s1); s2 += xor16_f(s2); s2 = halves_sum_f(s2);
                    if (fq == 0) *(f32x2*)(sst + ((size_t)row * 8 + (pn - 8) * 4 + wc) * 2) = (f32x2){s1, s2};
                }
            }
    }
};
struct EpiHalo {
    static constexpr bool PERM = true, AFTER_DRAIN = false;
    const float* ssq_in; float* AH;
    __device__ __forceinline__ void operator()(const f32x4 (&acc)[2][2][4][2], const Unit& u_, int wr, int wc, int fr, int fq) const {
        Unit u; { int pm_ = u_.pm, pn_ = u_.pn; asm volatile("" : "+s"(pm_), "+s"(pn_)); u.pm = pm_; u.pn = pn_; }
        const int col0 = u.pn * BM + wc * 32 + 8 * fq;
#pragma unroll
        for (int m = 0; m < 4; ++m) {
            const int rh = wr * 64 + m * 16 + fr;
            if (rh < 2) continue;
            const int tok = 256 * (rh >> 1) - 2 + (rh & 1);
            const float rs = row_rstd(ssq_in, tok);
#pragma unroll
            for (int bj = 0; bj < 2; ++bj) {
                *(f32x4*)(AH + (size_t)rh * NFF2 + col0 + bj * HALF) = acc[0][bj][m][0] * rs;
                *(f32x4*)(AH + (size_t)rh * NFF2 + col0 + bj * HALF + 4) = acc[0][bj][m][1] * rs;
            }
        }
    }
};
template <int SEL> __device__ __forceinline__ float dpp1(const float old, const float src) {
    const int o = __builtin_bit_cast(int, old), s = __builtin_bit_cast(int, src); int t;
    if (SEL == 0) t = __builtin_amdgcn_update_dpp(o, s, 0x111, 0xf, 0xf, false);
    else if (SEL == 1) t = __builtin_amdgcn_update_dpp(o, s, 0x112, 0xf, 0xf, false);
    else if (SEL == 2) t = __builtin_amdgcn_update_dpp(o, s, 0x10F, 0xf, 0xf, false);
    else t = __builtin_amdgcn_update_dpp(o, s, 0x10E, 0xf, 0xf, false);
    return __builtin_bit_cast(float, t);
}
template <int SEL> __device__ __forceinline__ f32x4 dpp4t(const f32x4 old, const f32x4 src) {
    const float o0 = old[0], o1 = old[1], o2 = old[2], o3 = old[3], s0 = src[0], s1 = src[1], s2 = src[2], s3 = src[3];
    const float r0 = dpp1<SEL>(o0, s0), r1 = dpp1<SEL>(o1, s1), r2 = dpp1<SEL>(o2, s2), r3 = dpp1<SEL>(o3, s3);
    return (f32x4){r0, r1, r2, r3};
}
#define dpp4(old, src, sel) dpp4t<sel>(old, src)
__device__ __forceinline__ void conv_taps(f32x4& c, const f32x4 cur, const f32x4 prev, const f32x4 w0, const f32x4 w1) {
    float c0 = c[0], c1 = c[1], c2 = c[2], c3 = c[3];
    const float x0 = cur[0], x1 = cur[1], x2 = cur[2], x3 = cur[3], p0 = prev[0], p1 = prev[1], p2 = prev[2], p3 = prev[3];
    const float a0 = w1[0], a1 = w1[1], a2 = w1[2], a3 = w1[3], b0 = w0[0], b1 = w0[1], b2 = w0[2], b3 = w0[3];
    asm("s_nop 4\n\t"
        "v_fmac_f32_dpp %0, %4, %12 row_shr:1 row_mask:0xf bank_mask:0xf bound_ctrl:1\n\t"
        "v_fmac_f32_dpp %1, %5, %13 row_shr:1 row_mask:0xf bank_mask:0xf bound_ctrl:1\n\t"
        "v_fmac_f32_dpp %2, %6, %14 row_shr:1 row_mask:0xf bank_mask:0xf bound_ctrl:1\n\t"
        "v_fmac_f32_dpp %3, %7, %15 row_shr:1 row_mask:0xf bank_mask:0xf bound_ctrl:1\n\t"
        "v_fmac_f32_dpp %0, %4, %16 row_shr:2 row_mask:0xf bank_mask:0xf bound_ctrl:1\n\t"
        "v_fmac_f32_dpp %1, %5, %17 row_shr:2 row_mask:0xf bank_mask:0xf bound_ctrl:1\n\t"
        "v_fmac_f32_dpp %2, %6, %18 row_shr:2 row_mask:0xf bank_mask:0xf bound_ctrl:1\n\t"
        "v_fmac_f32_dpp %3, %7, %19 row_shr:2 row_mask:0xf bank_mask:0xf bound_ctrl:1\n\t"
        "v_fmac_f32_dpp %0, %8, %12 row_shl:15 row_mask:0xf bank_mask:0xf bound_ctrl:1\n\t"
        "v_fmac_f32_dpp %1, %9, %13 row_shl:15 row_mask:0xf bank_mask:0xf bound_ctrl:1\n\t"
        "v_fmac_f32_dpp %2, %10, %14 row_shl:15 row_mask:0xf bank_mask:0xf bound_ctrl:1\n\t"
        "v_fmac_f32_dpp %3, %11, %15 row_shl:15 row_mask:0xf bank_mask:0xf bound_ctrl:1\n\t"
        "v_fmac_f32_dpp %0, %8, %16 row_shl:14 row_mask:0xf bank_mask:0xf bound_ctrl:1\n\t"
        "v_fmac_f32_dpp %1, %9, %17 row_shl:14 row_mask:0xf bank_mask:0xf bound_ctrl:1\n\t"
        "v_fmac_f32_dpp %2, %10, %18 row_shl:14 row_mask:0xf bank_mask:0xf bound_ctrl:1\n\t"
        "v_fmac_f32_dpp %3, %11, %19 row_shl:14 row_mask:0xf bank_mask:0xf bound_ctrl:1"
        : "+v"(c0), "+v"(c1), "+v"(c2), "+v"(c3)
        : "v"(x0), "v"(x1), "v"(x2), "v"(x3), "v"(p0), "v"(p1), "v"(p2), "v"(p3), "v"(a0), "v"(a1), "v"(a2), "v"(a3), "v"(b0), "v"(b1), "v"(b2), "v"(b3));
    c[0] = c0; c[1] = c1; c[2] = c2; c[3] = c3;
}
struct EpiHaloF {
    static constexpr bool PERM = true, AFTER_DRAIN = false;
    const float* ssq_in; float* ah; unsigned* flags;
    __device__ __forceinline__ void operator()(const f32x4 (&acc)[2][2][4][2], const Unit& u_, int wr, int wc, int fr, int fq) const {
        Unit u; { int pm_ = u_.pm, pn_ = u_.pn; asm volatile("" : "+s"(pm_), "+s"(pn_)); u.pm = pm_; u.pn = pn_; }
        const int col0 = u.pn * BM + wc * 32 + 8 * fq;
#pragma unroll
        for (int m = 0; m < 4; ++m) {
            const int rh = wr * 64 + m * 16 + fr;
            if (rh >= 2) {
                const int tok = 256 * (rh >> 1) - 2 + (rh & 1);
                const float rsh = row_rstd(ssq_in, tok);
#pragma unroll
                for (int bj = 0; bj < 2; ++bj) {
                    *(f32x4*)(ah + (size_t)rh * NFF2 + col0 + bj * HALF) = acc[0][bj][m][0] * rsh;
                    *(f32x4*)(ah + (size_t)rh * NFF2 + col0 + bj * HALF + 4) = acc[0][bj][m][1] * rsh;
                }
            }
        }
        asm volatile("s_waitcnt vmcnt(0)" ::: "memory"); __builtin_amdgcn_s_barrier(); asm volatile("" ::: "memory");
        if (wr == 0 && wc == 0 && fr == 0 && fq == 0) {
            __builtin_amdgcn_fence(__ATOMIC_RELEASE, "agent");
            asm volatile("s_waitcnt vmcnt(0)" ::: "memory");
            __hip_atomic_store(flags + 64 * u.pn, 1u, __ATOMIC_RELAXED, __HIP_MEMORY_SCOPE_AGENT);
        }
    }
};
struct EpiFfnIn {
    static constexpr bool PERM = true, AFTER_DRAIN = false;
    const float* ssq_in; const float* cw; const float* cb; float* ah; bf16_t* hid; PG8_LAS float* xb; unsigned* flags; unsigned phase_id;
    __device__ __forceinline__ void operator()(const f32x4 (&acc)[2][2][4][2], const Unit& u_, int wr, int wc, int fr, int fq) const {
        Unit u; { int pm_ = u_.pm, pn_ = u_.pn; asm volatile("" : "+s"(pm_), "+s"(pn_)); u.pm = pm_; u.pn = pn_; }
        PG8_LAS float* rtab = xb + 2048;
        const int row0 = u.pm * BM + wr * 64 + fr;
        PG8_LAS float* cwl = xb + 2432 + wc * 256;
        PG8_LAS float* hl = xb + 3456 + wc * 128;
        if (wr == 0) {
            const float* src = (fq < 3 ? cw + fq * NFF2 : cb) + (fr >> 3) * DFF + 128 * u.pn + wc * 32 + (fr & 7) * 4;
            const f32x4 wv = *(const f32x4*)src;
            rtab[wc * 64 + fq * 16 + fr] = row_rstd(ssq_in, u.pm * BM + wc * 64 + fq * 16 + fr);
            *(PG8_LAS f32x4*)(cwl + (fq * 16 + fr) * 4) = wv;
        }
        if (fr >= 14) {
#pragma unroll
            for (int ai = 0; ai < 2; ++ai) {
                PG8_LAS f32x4* dst = (PG8_LAS f32x4*)(xb + ((((ai * 2 + wr) * 4 + wc) * 2 + (fr - 14)) * 4 + fq) * 16);
#pragma unroll
                for (int bj = 0; bj < 2; ++bj)
#pragma unroll
                    for (int n = 0; n < 2; ++n) dst[bj * 2 + n] = acc[ai][bj][3][n];
            }
        }
        asm volatile("s_waitcnt lgkmcnt(0)" ::: "memory"); __builtin_amdgcn_s_barrier(); asm volatile("" ::: "memory");
        const bool has = (u.pm & 7) != 0;
        if (wr == 0) {
            PG8_LAS unsigned* stamp = (PG8_LAS unsigned*)(rtab + 256);
            if (*(volatile PG8_LAS unsigned*)stamp != phase_id) {
                if (wc == 0) {
                    unsigned sp = 0;
                    for (int t = 0; t < NFF2 / BM; ++t)
                        while (__hip_atomic_load(flags + 64 * t, __ATOMIC_RELAXED, __HIP_MEMORY_SCOPE_AGENT) == 0u) { __builtin_amdgcn_s_sleep(2); if (++sp > (1u << 22)) break; }
                    asm volatile("s_waitcnt vmcnt(0)" ::: "memory");
                    if (fr == 0 && fq == 0) *(volatile PG8_LAS unsigned*)stamp = phase_id;
                } else {
                    unsigned sp = 0;
                    while (*(volatile PG8_LAS unsigned*)stamp != phase_id) { __builtin_amdgcn_s_sleep(2); if (++sp > (1u << 22)) break; }
                }
            }
        }
        if (wr == 0) {
            f32x2 hv = {0.f, 0.f};
            if (has) hv = *(const f32x2*)(ah + (size_t)(2 * u.pm + (fq >> 1)) * NFF2 + (size_t)u.pn * BM + (fq & 1) * HALF + wc * 32 + 2 * fr);
            *(PG8_LAS f32x2*)(hl + (fq * 16 + fr) * 2) = hv;
        }
        float rs[2][4];
#pragma unroll
        for (int ai = 0; ai < 2; ++ai)
#pragma unroll
            for (int m = 0; m < 4; ++m) rs[ai][m] = rtab[ai * HALF + wr * 64 + m * 16 + fr];
        const f32x4 zero4 = {0.f, 0.f, 0.f, 0.f};
#pragma unroll
        for (int ai = 0; ai < 2; ++ai) {
#pragma unroll
            for (int n = 0; n < 2; ++n) {
                f32x4 cg[4];
#pragma unroll
                for (int bj = 0; bj < 2; ++bj) {
                    f32x4 b0, b1;
                    if (ai == 0 && wr == 0) {
                        b0 = *(const PG8_LAS f32x4*)(hl + (0 * 2 + bj) * 32 + 8 * fq + 4 * n);
                        b1 = *(const PG8_LAS f32x4*)(hl + (1 * 2 + bj) * 32 + 8 * fq + 4 * n);
                    } else {
                        const int sa = (wr == 1) ? ai : ai - 1, sw = (wr == 1) ? 0 : 1;
                        const float r0 = rtab[sa * HALF + sw * 64 + 62], r1 = rtab[sa * HALF + sw * 64 + 63];
                        b0 = *(const PG8_LAS f32x4*)(xb + ((((sa * 2 + sw) * 4 + wc) * 2 + 0) * 4 + fq) * 16 + (bj * 2 + n) * 4) * r0;
                        b1 = *(const PG8_LAS f32x4*)(xb + ((((sa * 2 + sw) * 4 + wc) * 2 + 1) * 4 + fq) * 16 + (bj * 2 + n) * 4) * r1;
                    }
                    const int oc = bj * 32 + 8 * fq + 4 * n;
                    const f32x4 w0 = *(const PG8_LAS f32x4*)(cwl + oc), w1 = *(const PG8_LAS f32x4*)(cwl + 64 + oc), w2 = *(const PG8_LAS f32x4*)(cwl + 128 + oc), bb = *(const PG8_LAS f32x4*)(cwl + 192 + oc);
                    f32x4 prev = (fr == 14) ? b0 : b1;
#pragma unroll
                    for (int m = 0; m < 4; ++m) {
                        const f32x4 cur = acc[ai][bj][m][n] * rs[ai][m];
                        f32x4 c = w2 * cur + bb;
                        conv_taps(c, cur, prev, w0, w1);
                        prev = cur;
                        if (bj == 0) cg[m] = c;
                        else {
                            const f32x2 ha = gelu_mul2((f32x2){cg[m][0], cg[m][1]}, (f32x2){c[0], c[1]}), hb = gelu_mul2((f32x2){cg[m][2], cg[m][3]}, (f32x2){c[2], c[3]});
                            u32x2 w; w.x = cvt_pk_bf16(ha.x, ha.y); w.y = cvt_pk_bf16(hb.x, hb.y);
                            const int row = row0 + ai * HALF + m * 16;
                            *(u32x2*)(hid + (size_t)row * DFF + 128 * u.pn + wc * 32 + 8 * fq + 4 * n) = w;
                        }
                    }
                    asm volatile("" ::: "memory");
                }
            }
        }
    }
};
template <class Epi, class Sched, bool ALIGN_EPI = false, bool SP2 = false>
__device__ __forceinline__ void gemm_phase(PG8_LAS unsigned char* lds, const Gemm g, const Sched& S, const Epi& E, const int wave_s) {
    const int tid_ = wave_s * 64 + lane_opaque(); const int tid = tid_, wid = __builtin_amdgcn_readfirstlane(tid >> 6), lane = tid & 63, wr = wid >> 2, wc = wid & 3, fr = lane & 15, fq = lane >> 4;
    const int K = g.K, nt = K / BK;
    unsigned voffA[2], voffB[2];
#pragma unroll
    for (int i = 0; i < 2; ++i) { int R, C; stage_rc(tid * 16 + i * 8192, R, C); const int Rb = Epi::PERM ? ((R & ~31) + perm32(R & 31)) : R;
        voffA[i] = (unsigned)(R * K + C) * 2u; voffB[i] = (unsigned)(Rb * K + C) * 2u; }
    const size_t kstep = (size_t)(BK * 2);
    const size_t hstep = (size_t)HALF * K * 2;
    const size_t tstep = 2 * hstep;
    const unsigned ldsw = (unsigned)wid * 1024u;
    const int aoff = lds_byte(wr * 64 + fr, fq * 8), boff = lds_byte(wc * 32 + fr, fq * 8);
#define PG8_SA(b, h) (((b) * 2 + (h)) * HTB)
#define PG8_SB(b, h) ((4 + (b) * 2 + (h)) * HTB)
#define PG8_STAGE(bufoff, gbase, voff) do { _Pragma("unroll") for (int _i = 0; _i < 2; ++_i) \
        __builtin_amdgcn_global_load_lds((const unsigned*)((const char*)(gbase) + (voff)[_i]), (PG8_LAS unsigned*)(lds + (bufoff) + ldsw + _i * 8192), 16, 0, 0); } while (0)
#define PG8_LDA(dst, b, h) do { _Pragma("unroll") for (int m = 0; m < 4; ++m) _Pragma("unroll") for (int k = 0; k < 2; ++k) dst[m][k] = *(const PG8_LAS bf16x8*)(lds + PG8_SA(b, h) + aoff + m * 2048 + k * 1024); } while (0)
#define PG8_LDB(dst, b, h) do { _Pragma("unroll") for (int n = 0; n < 2; ++n) _Pragma("unroll") for (int k = 0; k < 2; ++k) dst[n][k] = *(const PG8_LAS bf16x8*)(lds + PG8_SB(b, h) + boff + n * 2048 + k * 1024); } while (0)
#define PG8_MMA(ai, bj, At, Bt) do { __builtin_amdgcn_s_setprio(1); _Pragma("unroll") for (int m = 0; m < 4; ++m) _Pragma("unroll") for (int n = 0; n < 2; ++n) _Pragma("unroll") for (int k = 0; k < 2; ++k) \
        acc[ai][bj][m][n] = __builtin_amdgcn_mfma_f32_16x16x32_bf16(Bt[n][k], At[m][k], acc[ai][bj][m][n], 0, 0, 0); __builtin_amdgcn_s_setprio(0); } while (0)
#define PG8_WAIT_V(n) asm volatile("s_waitcnt vmcnt(" #n ")" ::: "memory")
#define PG8_WAIT_L(n) asm volatile("s_waitcnt lgkmcnt(" #n ")" ::: "memory")
#define PG8_BAR __builtin_amdgcn_s_barrier()
#define PG8_SCHED __builtin_amdgcn_sched_barrier(0)
    Unit cur, nxt; int ui = 0;
    if (!S.next(0, cur)) return;
    f32x4 acc[2][2][4][2];
#pragma unroll
    for (int a = 0; a < 2; ++a)
#pragma unroll
        for (int b = 0; b < 2; ++b)
#pragma unroll
            for (int m = 0; m < 4; ++m)
#pragma unroll
                for (int n = 0; n < 2; ++n) acc[a][b][m][n] = (f32x4){0.f, 0.f, 0.f, 0.f};
    bf16x8 At[4][2], B0[2][2], B1[2][2];
    const char* cA = (const char*)g.A + (size_t)cur.pm * tstep; const char* cB = (const char*)g.Bt + (size_t)cur.pn * tstep;
    S.a_ready(cur);
    if constexpr (SP2) {
        PG8_STAGE(PG8_SB(0, 0), cB, voffB); PG8_STAGE(PG8_SB(0, 1), cB + hstep, voffB); PG8_STAGE(PG8_SA(0, 0), cA, voffA); PG8_STAGE(PG8_SA(0, 1), cA + hstep, voffA);
        if (wr == 1) PG8_BAR;
        PG8_WAIT_V(2); PG8_BAR;
        PG8_STAGE(PG8_SB(1, 0), cB + kstep, voffB); PG8_STAGE(PG8_SA(1, 0), cA + kstep, voffA); PG8_STAGE(PG8_SB(1, 1), cB + hstep + kstep, voffB);
        PG8_WAIT_V(6); PG8_BAR;
    } else {
        PG8_STAGE(PG8_SB(0, 0), cB, voffB); PG8_STAGE(PG8_SA(0, 0), cA, voffA); PG8_STAGE(PG8_SB(0, 1), cB + hstep, voffB); PG8_STAGE(PG8_SA(0, 1), cA + hstep, voffA);
        if (wr == 1) PG8_BAR;
        PG8_WAIT_V(4); PG8_BAR;
        PG8_STAGE(PG8_SB(1, 0), cB + kstep, voffB); PG8_STAGE(PG8_SA(1, 0), cA + kstep, voffA); PG8_STAGE(PG8_SB(1, 1), cB + hstep + kstep, voffB);
        PG8_WAIT_V(6); PG8_BAR;
    }
    for (;;) {
        const bool has_next = S.next(ui + 1, nxt);
        const char* nA = has_next ? (const char*)g.A + (size_t)nxt.pm * tstep : cA; const char* nB = has_next ? (const char*)g.Bt + (size_t)nxt.pn * tstep : cB;
        for (int t = 0; t < nt; t += 2) {
            const bool last = (t == nt - 2);
            const char* a1 = cA + (size_t)(t + 1) * kstep;
            const char* a2 = last ? nA : cA + (size_t)(t + 2) * kstep; const char* b2 = last ? nB : cB + (size_t)(t + 2) * kstep;
            const char* a3 = a2 + kstep; const char* b3 = b2 + kstep;
            if (last && has_next) S.a_ready(nxt);
            if constexpr (SP2) {
            PG8_LDB(B0, 0, 0); PG8_LDB(B1, 0, 1); PG8_SCHED; PG8_LDA(At, 0, 0); PG8_STAGE(PG8_SA(1, 1), a1 + hstep, voffA);
            PG8_WAIT_V(8); PG8_WAIT_L(0); PG8_BAR; PG8_MMA(0, 0, At, B0); PG8_MMA(0, 1, At, B1); PG8_BAR; PG8_SCHED;
            PG8_LDA(At, 0, 1); PG8_STAGE(PG8_SB(0, 0), b2, voffB); PG8_STAGE(PG8_SB(0, 1), b2 + hstep, voffB); PG8_STAGE(PG8_SA(0, 0), a2, voffA);
            PG8_WAIT_V(8); PG8_WAIT_L(0); PG8_BAR; PG8_MMA(1, 0, At, B0); PG8_MMA(1, 1, At, B1); PG8_BAR; PG8_SCHED;
            PG8_LDB(B0, 1, 0); PG8_LDB(B1, 1, 1); PG8_SCHED; PG8_LDA(At, 1, 0); PG8_STAGE(PG8_SA(0, 1), a2 + hstep, voffA);
            PG8_WAIT_V(8); PG8_WAIT_L(0); PG8_BAR; PG8_MMA(0, 0, At, B0); PG8_MMA(0, 1, At, B1); PG8_BAR; PG8_SCHED;
            PG8_LDA(At, 1, 1); PG8_STAGE(PG8_SB(1, 0), b3, voffB); PG8_STAGE(PG8_SB(1, 1), b3 + hstep, voffB); PG8_STAGE(PG8_SA(1, 0), a3, voffA);
            PG8_WAIT_V(8); PG8_WAIT_L(0); PG8_BAR; PG8_MMA(1, 0, At, B0); PG8_MMA(1, 1, At, B1); PG8_BAR; PG8_SCHED;
            } else {
            PG8_LDB(B0, 0, 0); PG8_SCHED; PG8_LDA(At, 0, 0); PG8_STAGE(PG8_SA(1, 1), a1 + hstep, voffA);
            PG8_WAIT_L(8); PG8_BAR; PG8_WAIT_L(0); PG8_MMA(0, 0, At, B0); PG8_BAR; PG8_SCHED;
            PG8_LDB(B1, 0, 1); PG8_STAGE(PG8_SB(0, 0), b2, voffB);
            PG8_BAR; PG8_WAIT_L(0); PG8_MMA(0, 1, At, B1); PG8_BAR;
            PG8_LDA(At, 0, 1); PG8_STAGE(PG8_SA(0, 0), a2, voffA);
            PG8_BAR; PG8_WAIT_L(0); PG8_MMA(1, 0, At, B0); PG8_BAR; PG8_SCHED;
            PG8_STAGE(PG8_SB(0, 1), b2 + hstep, voffB);
            PG8_WAIT_V(6); PG8_BAR; PG8_MMA(1, 1, At, B1); PG8_BAR;
            PG8_LDB(B0, 1, 0); PG8_SCHED; PG8_LDA(At, 1, 0); PG8_STAGE(PG8_SA(0, 1), a2 + hstep, voffA);
            PG8_WAIT_L(8); PG8_BAR; PG8_WAIT_L(0); PG8_MMA(0, 0, At, B0); PG8_BAR; PG8_SCHED;
            PG8_LDB(B1, 1, 1); PG8_STAGE(PG8_SB(1, 0), b3, voffB);
            PG8_BAR; PG8_WAIT_L(0); PG8_MMA(0, 1, At, B1); PG8_BAR;
            PG8_LDA(At, 1, 1); PG8_STAGE(PG8_SA(1, 0), a3, voffA);
            PG8_BAR; PG8_WAIT_L(0); PG8_MMA(1, 0, At, B0); PG8_BAR; PG8_SCHED;
            PG8_STAGE(PG8_SB(1, 1), b3 + hstep, voffB);
            PG8_WAIT_V(6); PG8_BAR; PG8_MMA(1, 1, At, B1); PG8_BAR;
            }
        }
        if constexpr (ALIGN_EPI) { if (wr == 0) PG8_BAR; }
        if constexpr (!Epi::AFTER_DRAIN) { E(acc, cur, wr, wc, fr, fq); S.done(cur); }
        if (!has_next) break;
#pragma unroll
        for (int a = 0; a < 2; ++a)
#pragma unroll
            for (int b = 0; b < 2; ++b)
#pragma unroll
                for (int m = 0; m < 4; ++m)
#pragma unroll
                    for (int n = 0; n < 2; ++n) acc[a][b][m][n] = (f32x4){0.f, 0.f, 0.f, 0.f};
        cur = nxt; cA = nA; cB = nB; ++ui;
        if constexpr (ALIGN_EPI) { if (wr == 1) PG8_BAR; }
    }
    PG8_WAIT_V(0);
    if constexpr (!ALIGN_EPI) { if (wr == 0) PG8_BAR; }
    PG8_BAR;
    if constexpr (Epi::AFTER_DRAIN) { E.fused(acc, cur, wr, wc, fr, fq, lds, wid, lane); S.done(cur); }
#undef PG8_SA
#undef PG8_SB
#undef PG8_STAGE
#undef PG8_LDA
#undef PG8_LDB
#undef PG8_MMA
#undef PG8_WAIT_V
#undef PG8_WAIT_L
#undef PG8_BAR
#undef PG8_SCHED
}
}
namespace mix {
#define MLAS __attribute__((address_space(3)))
typedef unsigned short bf16_t;
typedef short bf16x8 __attribute__((ext_vector_type(8)));
typedef short s16x4 __attribute__((ext_vector_type(4)));
typedef float f32x16 __attribute__((ext_vector_type(16)));
typedef float f32x4 __attribute__((ext_vector_type(4)));
typedef float f32x2 __attribute__((ext_vector_type(2)));
typedef unsigned u32x4 __attribute__((ext_vector_type(4)));
typedef unsigned u32x2 __attribute__((ext_vector_type(2)));
typedef MLAS const char* lds_cptr;
typedef short v4i16_t __attribute__((ext_vector_type(4)));
typedef __bf16 bf16x2_t __attribute__((ext_vector_type(2)));

constexpr int SLOTB = 8192;
constexpr int NSLOT = 4;
constexpr int L_K = 0, L_V = NSLOT * SLOTB, L_WSF = 2 * NSLOT * SLOTB, L_OST = L_WSF + 8 * 256, L_X = L_OST + 8 * 4096;
constexpr int LX_IQ = L_X, LX_EQ = L_X, LX_PFX = L_X + 8192, LX_CNT = LX_IQ + 16384, LX_GT = LX_CNT + 2048, LX_SEL = LX_GT, LX_END = LX_GT + 8192;
static_assert(LX_END <= 131072, "mixer LDS map");

__device__ __forceinline__ int crow(int r, int hi) { return (r & 3) + 8 * (r >> 2) + 4 * hi; }
__device__ __forceinline__ void glds16(const void* gsrc, unsigned lds_dst) { unsigned keep;
    asm volatile("s_mov_b32 %0, m0\n\ts_mov_b32 m0, %2\n\ts_nop 0\n\tglobal_load_lds_dwordx4 %1, off\n\ts_mov_b32 m0, %0" : "=&s"(keep) : "v"(gsrc), "s"(lds_dst) : "memory"); }
__device__ __forceinline__ unsigned cvtpk(float lo, float hi) { f32x2 v = {lo, hi}; bf16x2_t b = __builtin_convertvector(v, bf16x2_t); return __builtin_bit_cast(unsigned, b); }
__device__ __forceinline__ s16x4 vtr(lds_cptr p) { return __builtin_bit_cast(s16x4, __builtin_amdgcn_ds_read_tr16_b64_v4i16((MLAS v4i16_t*)p)); }
#define WAITV_BAR() asm volatile("s_waitcnt vmcnt(0) lgkmcnt(0)\n\ts_barrier" ::: "memory")
#define LGKM_BAR() asm volatile("s_waitcnt lgkmcnt(0)\n\ts_barrier" ::: "memory")
#define WAITV2_BAR() asm volatile("s_waitcnt vmcnt(2) lgkmcnt(0)\n\ts_barrier" ::: "memory")

__device__ __forceinline__ void dma_kv(const bf16_t* kbase, const bf16_t* vbase, int pitch, unsigned lds0, int slot, int wid, int lane) {
    const bf16_t* ks = kbase + (size_t)lane * pitch + wid * 8;
    const bf16_t* vs = vbase + (size_t)(16 * (wid & 3) + (lane >> 2)) * pitch + (wid >> 2) * 32 + (lane & 3) * 8;
    glds16(ks, (unsigned)__builtin_amdgcn_readfirstlane(lds0 + L_K + slot * SLOTB + wid * 1024));
    glds16(vs, (unsigned)__builtin_amdgcn_readfirstlane(lds0 + L_V + slot * SLOTB + wid * 1024));
}
__device__ __forceinline__ void kload(bf16x8 (&kf)[8], lds_cptr kslot, int r32, int hi) {
    lds_cptr kb = kslot + hi * 1024 + r32 * 16;
#pragma unroll
    for (int d0 = 0; d0 < 4; ++d0) { kf[2 * d0] = *(const MLAS bf16x8*)(kb + d0 * 2048); kf[2 * d0 + 1] = *(const MLAS bf16x8*)(kb + d0 * 2048 + 512); }
}
__device__ __forceinline__ void qkt_mma(f32x16& p0, f32x16& p1, const bf16x8 (&kf)[8], const bf16x8* qr, const f32x16& cinit) {
    p0 = __builtin_amdgcn_mfma_f32_32x32x16_bf16(kf[0], qr[0], cinit, 0, 0, 0); p1 = __builtin_amdgcn_mfma_f32_32x32x16_bf16(kf[1], qr[0], cinit, 0, 0, 0);
#pragma unroll
    for (int d0 = 1; d0 < 4; ++d0) { p0 = __builtin_amdgcn_mfma_f32_32x32x16_bf16(kf[2 * d0], qr[d0], p0, 0, 0, 0); p1 = __builtin_amdgcn_mfma_f32_32x32x16_bf16(kf[2 * d0 + 1], qr[d0], p1, 0, 0, 0); }
}
__device__ __forceinline__ void qkt(f32x16& p0, f32x16& p1, lds_cptr kslot, const bf16x8* qr, const f32x16& cinit, int r32, int hi) {
    bf16x8 kf[8]; kload(kf, kslot, r32, hi); qkt_mma(p0, p1, kf, qr, cinit);
}
__device__ __forceinline__ void vload(bf16x8 (&vf)[8], lds_cptr vslot, int lane, int hi) {
    lds_cptr vp = vslot + ((lane >> 4) & 1) * 32 + (lane & 3) * 8 + (4 * hi + ((lane & 15) >> 2)) * 64;
#pragma unroll
    for (int d0 = 0; d0 < 2; ++d0)
#pragma unroll
        for (int ks = 0; ks < 4; ++ks) {
            const s16x4 lo = vtr(vp + d0 * 4096 + ks * 1024), hh = vtr(vp + d0 * 4096 + ks * 1024 + 512);
            vf[d0 * 4 + ks] = (bf16x8){lo[0], lo[1], lo[2], lo[3], hh[0], hh[1], hh[2], hh[3]};
        }
}
#define V16_TO_ARR(v, a, o) do { a[(o) + 0] = v[0]; a[(o) + 1] = v[1]; a[(o) + 2] = v[2]; a[(o) + 3] = v[3]; a[(o) + 4] = v[4]; a[(o) + 5] = v[5]; a[(o) + 6] = v[6]; a[(o) + 7] = v[7]; \
    a[(o) + 8] = v[8]; a[(o) + 9] = v[9]; a[(o) + 10] = v[10]; a[(o) + 11] = v[11]; a[(o) + 12] = v[12]; a[(o) + 13] = v[13]; a[(o) + 14] = v[14]; a[(o) + 15] = v[15]; } while (0)
__device__ __forceinline__ f32x16 splat16(float x) { return (f32x16){x, x, x, x, x, x, x, x, x, x, x, x, x, x, x, x}; }
struct AttnState { f32x16 o[2]; float m, l, pend; bool started; };
constexpr float ATT_THR = 8.0f;
__device__ __forceinline__ void softmax_pv(AttnState& st, float (&sc)[32], const bf16x8 (&vf)[8], MLAS float* wsf, int lane, int r32, int hi) {
    if (__any(st.pend != 0.f)) {
#pragma unroll
        for (int r = 0; r < 32; ++r) sc[r] -= st.pend;
    }
    st.pend = 0.f;
    float ra = __builtin_fmaxf(__builtin_fmaxf(sc[0], sc[1]), sc[2]), rb = __builtin_fmaxf(__builtin_fmaxf(sc[3], sc[4]), sc[5]);
#pragma unroll
    for (int r = 6; r < 30; r += 4) { ra = __builtin_fmaxf(__builtin_fmaxf(ra, sc[r]), sc[r + 1]); rb = __builtin_fmaxf(__builtin_fmaxf(rb, sc[r + 2]), sc[r + 3]); }
    float rm = __builtin_fmaxf(__builtin_fmaxf(ra, rb), __builtin_fmaxf(sc[30], sc[31]));
    rm = halves_max_f(rm);
    const bool fresh = !st.started;
    const bool need = (rm > ATT_THR) || (fresh && rm < -ATT_THR && rm > -1e29f);
    st.started = st.started || (rm > -1e29f);
    if (__any(need)) {
        const float dl = need ? rm : 0.f;
        st.m += dl; st.pend = dl;
#pragma unroll
        for (int r = 0; r < 32; ++r) sc[r] -= dl;
        const float alpha = fresh ? 1.0f : __builtin_amdgcn_exp2f(-dl);
        st.l *= alpha;
        if (hi == 0) wsf[r32] = alpha;
        float fr_[16];
#pragma unroll
        for (int r = 0; r < 16; ++r) fr_[r] = wsf[crow(r, hi)];
        const f32x16 fv = {fr_[0], fr_[1], fr_[2], fr_[3], fr_[4], fr_[5], fr_[6], fr_[7], fr_[8], fr_[9], fr_[10], fr_[11], fr_[12], fr_[13], fr_[14], fr_[15]};
        st.o[0] = st.o[0] * fv; st.o[1] = st.o[1] * fv;
    }
    float pe[32]; float s0 = 0.f, s1 = 0.f;
#pragma unroll
    for (int r = 0; r < 32; r += 2) { pe[r] = __builtin_amdgcn_exp2f(sc[r]); pe[r + 1] = __builtin_amdgcn_exp2f(sc[r + 1]); s0 += pe[r]; s1 += pe[r + 1]; }
    st.l += s0 + s1;
    u32x4 pw[4];
#pragma unroll
    for (int k = 0; k < 4; ++k) pw[k] = (u32x4){cvtpk(pe[8 * k + 0], pe[8 * k + 1]), cvtpk(pe[8 * k + 2], pe[8 * k + 3]), cvtpk(pe[8 * k + 4], pe[8 * k + 5]), cvtpk(pe[8 * k + 6], pe[8 * k + 7])};
#pragma unroll
    for (int d0 = 0; d0 < 2; ++d0)
#pragma unroll
        for (int ks = 0; ks < 4; ++ks) st.o[d0] = __builtin_amdgcn_mfma_f32_32x32x16_bf16(__builtin_bit_cast(bf16x8, pw[ks]), vf[d0 * 4 + ks], st.o[d0], 0, 0, 0);
}
__device__ __forceinline__ void attn_store(AttnState& st, bf16_t* Ow, int pitch, MLAS float* wsf, MLAS bf16_t* stg, int lane, int r32, int hi) {
    float l = halves_sum_f(st.l);
    if (hi == 0) wsf[32 + r32] = l;
    float rli[16];
#pragma unroll
    for (int r = 0; r < 16; ++r) rli[r] = 1.0f / wsf[32 + crow(r, hi)];
#pragma unroll
    for (int r = 0; r < 16; ++r) { const int orow = crow(r, hi);
#pragma unroll
        for (int d0 = 0; d0 < 2; ++d0) { const unsigned short b = (unsigned short)(cvtpk(st.o[d0][r] * rli[r], 0.f) & 0xffffu); stg[orow * 64 + d0 * 32 + r32] = b; } }
#pragma unroll
    for (int i = 0; i < 4; ++i) { const int row = i * 8 + (lane >> 3), ch = lane & 7; const u32x4 v = *(const MLAS u32x4*)(stg + row * 64 + ch * 8); *(u32x4*)(Ow + (size_t)row * pitch + ch * 8) = v; }
}

#ifndef DBG_REP_BS
#define DBG_REP_BS 1
#endif
__device__ __forceinline__ unsigned pk_sub_sat_u16(unsigned a, unsigned b) { unsigned r; asm("v_pk_sub_u16 %0, %1, %2 clamp" : "=v"(r) : "v"(a), "v"(b)); return r; }
__device__ __forceinline__ unsigned pk_min_u16(unsigned a, unsigned b) { unsigned r; asm("v_pk_min_u16 %0, %1, %2" : "=v"(r) : "v"(a), "v"(b)); return r; }
__device__ __forceinline__ unsigned pk_add_u16(unsigned a, unsigned b) { unsigned r; asm("v_pk_add_u16 %0, %1, %2" : "=v"(r) : "v"(a), "v"(b)); return r; }
__device__ __forceinline__ unsigned pk_ashr_i16(unsigned a, unsigned sh2) { unsigned r; asm("v_pk_ashrrev_i16 %0, %1, %2" : "=v"(r) : "v"(sh2), "v"(a)); return r; }
__device__ __forceinline__ unsigned score_keys(float a, float b) {
    const unsigned p = __builtin_bit_cast(unsigned, __builtin_amdgcn_cvt_pkrtz(a, b));
    const unsigned m = pk_ashr_i16(p, 0x000f000fu);
    return p ^ (m | 0x80008000u);
}
template <int NS> __device__ __forceinline__ unsigned bit_search(const unsigned (&kp)[8][8], MLAS unsigned* cntx, int wid, int r32, int hi) {
    unsigned tau = 0u;
#pragma unroll 1
    for (int bit = 15; bit >= 0; --bit) {
        const unsigned cand = tau | (1u << bit);
        const unsigned c2 = (cand - 1u) * 0x00010001u;
        unsigned cnt2 = 0;
#pragma unroll
        for (int jj = 0; jj < NS; ++jj)
#pragma unroll
            for (int r = 0; r < 8; ++r) cnt2 = pk_add_u16(cnt2, pk_min_u16(pk_sub_sat_u16(kp[jj][r], c2), 0x00010001u));
        unsigned cnt = (cnt2 & 0xffffu) + (cnt2 >> 16);
        cnt = halves_add_u(cnt);
        MLAS unsigned* cb = cntx + (bit & 1) * 256;
        if (hi == 0) cb[wid * 32 + r32] = cnt;
        LGKM_BAR();
        unsigned tot = 0;
#pragma unroll
        for (int w = 0; w < 8; ++w) tot += cb[w * 32 + r32];
        if (tot >= 256u) tau = cand;
    }
    return tau;
}
__device__ __forceinline__ void dsa_select(int b, int qg, const bf16_t* Z0, char* shm, const int wave_s) {
    const int tid_ = wave_s * 64 + lane_opaque(); const int tid = tid_, lane = tid & 63, r32 = lane & 31, hi = lane >> 5; const int wid = __builtin_amdgcn_readfirstlane(tid >> 6);
    MLAS char* L = (MLAS char*)shm;
    const int c = qg >> 1, nkeys = 64 * (c + 1), nt32 = nkeys >> 5, nt64 = nkeys >> 6;
    const size_t rowb = (size_t)b * SEQ;
    const size_t tok0 = rowb + 32 * qg;
    MLAS unsigned* selw = (MLAS unsigned*)(L + LX_SEL);
    if (nkeys <= 256) {
        for (int i = tid; i < 64 * 32; i += 512) selw[i] = (i < nt32 * 32) ? 0xffffffffu : 0u;
    } else {
        {
            MLAS u32x4* iqL = (MLAS u32x4*)(L + LX_IQ);
            for (int i = tid; i < 1024; i += 512) { const int q = i & 31, hh = (i >> 5) & 1, d0 = (i >> 6) & 3, h = i >> 8;
                iqL[i] = *(const u32x4*)(Z0 + (tok0 + q) * EV_N + 1280 + 64 * h + 16 * d0 + 8 * hh); }
        }
        float w4[4];
        { const u32x2 ww = *(const u32x2*)(Z0 + (tok0 + r32) * EV_N + 1216);
          w4[0] = pg8::bf_lo(ww.x) * 0.0625f; w4[1] = pg8::bf_hi(ww.x) * 0.0625f; w4[2] = pg8::bf_lo(ww.y) * 0.0625f; w4[3] = pg8::bf_hi(ww.y) * 0.0625f; }
        LGKM_BAR();
        unsigned kp[8][8];
        const int nslots = (nt32 + 7) >> 3;
        const MLAS bf16x8* iqf = (const MLAS bf16x8*)(L + LX_IQ) + hi * 32 + r32;
#pragma unroll
        for (int jj = 0; jj < 8; ++jj) {
            const int j = wid + 8 * jj;
            if (j < nt32) {
                const bf16_t* ikp = Z0 + (rowb + 32 * j + r32) * EV_N + 1152 + 8 * hi;
                bf16x8 af[4];
#pragma unroll
                for (int d0 = 0; d0 < 4; ++d0) af[d0] = *(const bf16x8*)(ikp + 16 * d0);
                f32x16 ah[4];
#pragma unroll
                for (int h = 0; h < 4; ++h) {
                    f32x16 a = {};
#pragma unroll
                    for (int d0 = 0; d0 < 4; ++d0) a = __builtin_amdgcn_mfma_f32_32x32x16_bf16(af[d0], iqf[(h * 4 + d0) * 64], a, 0, 0, 0);
                    ah[h] = a;
                }
                float sv[16];
                {
                    float a0[16], a1[16], a2[16], a3[16];
                    V16_TO_ARR(ah[0], a0, 0); V16_TO_ARR(ah[1], a1, 0); V16_TO_ARR(ah[2], a2, 0); V16_TO_ARR(ah[3], a3, 0);
#pragma unroll
                    for (int r = 0; r < 16; ++r) sv[r] = ((__builtin_fmaxf(a0[r], 0.f) * w4[0] + __builtin_fmaxf(a1[r], 0.f) * w4[1]) + __builtin_fmaxf(a2[r], 0.f) * w4[2]) + __builtin_fmaxf(a3[r], 0.f) * w4[3];
                }
#pragma unroll
                for (int r = 0; r < 8; ++r) kp[jj][r] = score_keys(sv[r], sv[r + 8]);
            } else {
#pragma unroll
                for (int r = 0; r < 8; ++r) kp[jj][r] = 0u;
            }
        }
        MLAS unsigned* cntx = (MLAS unsigned*)(L + L_OST);
        unsigned tau;
        for (int rep_ = 0; rep_ < DBG_REP_BS; ++rep_)
        switch (nslots) {
            case 2: tau = bit_search<2>(kp, cntx, wid, r32, hi); break;
            case 3: tau = bit_search<3>(kp, cntx, wid, r32, hi); break;
            case 4: tau = bit_search<4>(kp, cntx, wid, r32, hi); break;
            case 5: tau = bit_search<5>(kp, cntx, wid, r32, hi); break;
            case 6: tau = bit_search<6>(kp, cntx, wid, r32, hi); break;
            case 7: tau = bit_search<7>(kp, cntx, wid, r32, hi); break;
            default: tau = bit_search<8>(kp, cntx, wid, r32, hi); break;
        }
        MLAS unsigned* gtw = (MLAS unsigned*)(L + LX_GT); MLAS unsigned* eqw = (MLAS unsigned*)(L + LX_EQ); MLAS unsigned* pfx = (MLAS unsigned*)(L + LX_PFX);
        const unsigned tg = tau * 0x00010001u, te = (tau - 1u) * 0x00010001u;
#pragma unroll
        for (int jj = 0; jj < 8; ++jj) {
            const int j = wid + 8 * jj;
            if (j < nt32) {
                unsigned g = 0, e = 0;
#pragma unroll
                for (int r = 0; r < 8; ++r) {
                    const unsigned dgt = pk_min_u16(pk_sub_sat_u16(kp[jj][r], tg), 0x00010001u), dge = pk_min_u16(pk_sub_sat_u16(kp[jj][r], te), 0x00010001u);
                    const int pos = (r & 3) + 8 * (r >> 2);
                    g |= dgt << pos; e |= (dge - dgt) << pos;
                }
                g <<= 4 * hi; e <<= 4 * hi;
                g = halves_or_u(g); e = halves_or_u(e);
                if (hi == 0) { gtw[j * 32 + r32] = g; eqw[j * 32 + r32] = e; }
            }
        }
        LGKM_BAR();
        if (wid == 0 && hi == 0) {
            unsigned cg = 0;
            for (int j = 0; j < nt32; ++j) cg += __builtin_popcount(gtw[j * 32 + r32]);
            const int need = 256 - (int)cg;
            int run = 0;
            for (int j = 0; j < nt32; ++j) { const unsigned e = eqw[j * 32 + r32]; int k = need - run; k = k < 0 ? 0 : (k > 32 ? 32 : k); pfx[j * 32 + r32] = (unsigned)k; run += __builtin_popcount(e); }
        }
        LGKM_BAR();
        for (int i = tid; i < nt32 * 32; i += 512) {
            const unsigned g = gtw[i], e = eqw[i]; const int k = (int)pfx[i];
            unsigned take = 0;
            if (e != 0u && k > 0) {
                unsigned rem = e; int cntk = 0;
                while (rem != 0u && cntk < k) { const unsigned low = rem & (0u - rem); take |= low; rem ^= low; ++cntk; }
            }
            selw[i] = g | take;
        }
        for (int i = nt32 * 32 + tid; i < 64 * 32; i += 512) selw[i] = 0u;
    }
    WAITV_BAR();
}

__device__ __forceinline__ void fox_unit(int b, int h, int qb, const bf16_t* Z1, const float* F, const float* bfp, bf16_t* Y, char* shm, unsigned lds0, const int wave_s) {
    const int tid_ = wave_s * 64 + lane_opaque(); const int tid = tid_, lane = tid & 63, r32 = lane & 31, hi = lane >> 5; const int wid = __builtin_amdgcn_readfirstlane(tid >> 6);
    MLAS char* L = (MLAS char*)shm;
    const size_t rowb = (size_t)b * SEQ;
    const int NT = 4 * (qb + 1), nk = 64 * NT;
    MLAS float* cum2 = (MLAS float*)(L + L_X);
    MLAS float* wtot = (MLAS float*)(L + L_X + 8192);
    const bf16_t* Kb = Z1 + rowb * Z1P + 512 + 64 * h; const bf16_t* Vb = Z1 + rowb * Z1P + 1024 + 64 * h;
#pragma unroll
    for (int i = 0; i < 3; ++i) dma_kv(Kb + (size_t)64 * i * Z1P, Vb + (size_t)64 * i * Z1P, Z1P, lds0, i, wid, lane);
    {
        const float bias = bfp[h];
        const int s0 = 4 * tid;
        float v[4]; float run = 0.f;
#pragma unroll
        for (int i = 0; i < 4; ++i) {
            float x = 0.f;
            if (s0 + i < nk) x = F[(rowb + s0 + i) * 8 + h] + bias;
            const float ls = (s0 + i < nk) ? (fminf(x, 0.f) - log1pf(expf(-fabsf(x)))) : 0.f;
            run += ls; v[i] = run;
        }
        float inc = run;
#pragma unroll
        for (int o = 1; o < 64; o <<= 1) { const int ln = lane_opaque(); const float t = __builtin_bit_cast(float, __builtin_amdgcn_ds_bpermute((ln - o) << 2, __builtin_bit_cast(int, inc))); if (ln >= o) inc += t; }
        if (lane == 63) wtot[wid] = inc;
        LGKM_BAR();
        float off = inc - run;
        for (int w = 0; w < wid; ++w) off += wtot[w];
#pragma unroll
        for (int i = 0; i < 4; ++i) cum2[s0 + i] = (off + v[i]) * 1.4426950408889634f;
    }
    const int tq = 256 * qb + 32 * wid + r32;
    bf16x8 qr[4];
#pragma unroll
    for (int d0 = 0; d0 < 4; ++d0) qr[d0] = *(const bf16x8*)(Z1 + (rowb + tq) * Z1P + 64 * h + 16 * d0 + 8 * hi);
    AttnState st; st.o[0] = f32x16{}; st.o[1] = f32x16{}; st.m = 0.f; st.l = 0.f; st.pend = 0.f; st.started = false;
    MLAS float* wsf = (MLAS float*)(L + L_WSF) + wid * 64;
    WAITV_BAR();
    const float cq2 = cum2[tq];
    const int tlast = 4 * qb + (wid >> 1);
    f32x16 s0, s1;
    qkt(s0, s1, (lds_cptr)(L + L_K), qr, splat16(-st.m), r32, hi);
    for (int t = 0; t < NT; ++t) {
        const int slot = t & 3;
        { const int tt = (t + 3 < NT) ? t + 3 : NT - 1; dma_kv(Kb + (size_t)64 * tt * Z1P, Vb + (size_t)64 * tt * Z1P, Z1P, lds0, (t + 3) & 3, wid, lane); }
        bf16x8 kf[8], vf[8];
        kload(kf, (lds_cptr)(L + L_K + ((t + 1) & 3) * SLOTB), r32, hi);
        __builtin_amdgcn_sched_barrier(0);
        vload(vf, (lds_cptr)(L + L_V + slot * SLOTB), lane, hi);
        const MLAS float* cb = cum2 + 64 * t + 4 * hi;
        f32x4 c0[4], c1[4];
#pragma unroll
        for (int g = 0; g < 4; ++g) { c0[g] = *(const MLAS f32x4*)(cb + 8 * g); c1[g] = *(const MLAS f32x4*)(cb + 32 + 8 * g); }
        f32x16 n0, n1;
        qkt_mma(n0, n1, kf, qr, splat16(-st.m));
        float sc[32];
        V16_TO_ARR(s0, sc, 0); V16_TO_ARR(s1, sc, 16);
#pragma unroll
        for (int g = 0; g < 4; ++g) {
            sc[4 * g + 0] += cq2 - c0[g].x; sc[4 * g + 1] += cq2 - c0[g].y; sc[4 * g + 2] += cq2 - c0[g].z; sc[4 * g + 3] += cq2 - c0[g].w;
            sc[16 + 4 * g + 0] += cq2 - c1[g].x; sc[16 + 4 * g + 1] += cq2 - c1[g].y; sc[16 + 4 * g + 2] += cq2 - c1[g].z; sc[16 + 4 * g + 3] += cq2 - c1[g].w;
        }
        if (t >= tlast) {
            const int qrel = tq - 64 * t;
#pragma unroll
            for (int r = 0; r < 16; ++r) { const int kr = crow(r, hi); if (kr > qrel) sc[r] = -INFINITY; if (kr + 32 > qrel) sc[16 + r] = -INFINITY; }
        }
        softmax_pv(st, sc, vf, wsf, lane, r32, hi);
        s0 = n0; s1 = n1;
        WAITV2_BAR();
    }
    attn_store(st, Y + (rowb + 256 * qb + 32 * wid) * DMODEL + 64 * h, DMODEL, wsf, (MLAS bf16_t*)(L + L_OST) + wid * 2048, lane, r32, hi);
    WAITV_BAR();
}

__device__ __forceinline__ void sgu_unit(int b, int n, int g, const bf16_t* Z1, const float* sst, const float* lng, const float* lnb, const bf16_t* Wm, const float* bs, bf16_t* Y, char* shm, const int wave_s) {
    const int tid_ = wave_s * 64 + lane_opaque(); const int tid = tid_, lane = tid & 63, r32 = lane & 31, hi = lane >> 5; const int wid = __builtin_amdgcn_readfirstlane(tid >> 6);
    MLAS char* L = (MLAS char*)shm;
    MLAS bf16_t* vn = (MLAS bf16_t*)L;
    constexpr int VP = 136;
    const size_t tok0 = (size_t)b * SEQ + 128 * n;
    {
        const int j = tid >> 2, cq = (tid & 3) * 32;
        const float* sp = sst + (tok0 + j) * 16;
        float s1 = 0.f, s2 = 0.f;
#pragma unroll
        for (int k = 0; k < 8; ++k) { s1 += sp[2 * k]; s2 += sp[2 * k + 1]; }
        const float mu = s1 * (1.0f / 512.0f); const float var = fmaxf(s2 * (1.0f / 512.0f) - mu * mu, 0.f);
        const float rstd = 1.0f / sqrtf(var + RMS_EPS);
        const bf16_t* vp = Z1 + (tok0 + j) * Z1P + 2048 + 128 * g + cq;
#pragma unroll
        for (int k = 0; k < 4; ++k) {
            const u32x4 w = *(const u32x4*)(vp + 8 * k);
            const int cc = 128 * g + cq + 8 * k;
            const f32x4 g0 = *(const f32x4*)(lng + cc), g1 = *(const f32x4*)(lng + cc + 4), b0 = *(const f32x4*)(lnb + cc), b1 = *(const f32x4*)(lnb + cc + 4);
            float x[8] = {pg8::bf_lo(w.x), pg8::bf_hi(w.x), pg8::bf_lo(w.y), pg8::bf_hi(w.y), pg8::bf_lo(w.z), pg8::bf_hi(w.z), pg8::bf_lo(w.w), pg8::bf_hi(w.w)};
            float y[8];
#pragma unroll
            for (int i = 0; i < 4; ++i) { y[i] = (x[i] - mu) * rstd * g0[i] + b0[i]; y[4 + i] = (x[4 + i] - mu) * rstd * g1[i] + b1[i]; }
            u32x4 o; o.x = cvtpk(y[0], y[1]); o.y = cvtpk(y[2], y[3]); o.z = cvtpk(y[4], y[5]); o.w = cvtpk(y[6], y[7]);
            *(MLAS u32x4*)(vn + j * VP + cq + 8 * k) = o;
        }
    }
    LGKM_BAR();
    MLAS bf16_t* ut = (MLAS bf16_t*)(L + 128 * VP * 2);
    {
        const int j = tid >> 2, cq = (tid & 3) * 32;
        const bf16_t* up = Z1 + (tok0 + j) * Z1P + 1536 + 128 * g + cq;
#pragma unroll
        for (int k = 0; k < 4; ++k) *(MLAS u32x4*)(ut + j * VP + cq + 8 * k) = *(const u32x4*)(up + 8 * k);
    }
    LGKM_BAR();
    const int ib = wid & 3;
    const bf16_t* wrow = Wm + ((size_t)g * 128 + 32 * ib + r32) * 128 + 8 * hi;
    bf16x8 af[8];
#pragma unroll
    for (int s = 0; s < 8; ++s) af[s] = *(const bf16x8*)(wrow + 16 * s);
#pragma unroll
    for (int cbi = 0; cbi < 2; ++cbi) {
        const int cb = (wid >> 2) * 2 + cbi;
        f32x16 acc = {};
        lds_cptr bp = (lds_cptr)(vn) + ((size_t)(8 * hi + ((lane & 15) >> 2)) * VP + 32 * cb + 16 * ((lane >> 4) & 1) + 4 * (lane & 3)) * 2;
#pragma unroll
        for (int s = 0; s < 8; ++s) {
            const s16x4 lo = vtr(bp + (16 * s) * VP * 2), hh = vtr(bp + (16 * s + 4) * VP * 2);
            const bf16x8 bfr = {lo[0], lo[1], lo[2], lo[3], hh[0], hh[1], hh[2], hh[3]};
            acc = __builtin_amdgcn_mfma_f32_32x32x16_bf16(af[s], bfr, acc, 0, 0, 0);
        }
        float a16[16]; V16_TO_ARR(acc, a16, 0);
#pragma unroll
        for (int r = 0; r < 16; ++r) {
            const int i = 32 * ib + crow(r, hi), cc = 32 * cb + r32;
            const float uu = __builtin_bit_cast(float, (unsigned)ut[i * VP + cc] << 16);
            const float o = uu * (a16[r] + bs[g * 128 + i]);
            ut[i * VP + cc] = (bf16_t)(cvtpk(o, 0.f) & 0xffffu);
        }
    }
    LGKM_BAR();
    {
        const int j = tid >> 2, cq = (tid & 3) * 32;
        bf16_t* yp = Y + (tok0 + j) * DMODEL + 512 + 128 * g + cq;
#pragma unroll
        for (int k = 0; k < 4; ++k) *(u32x4*)(yp + 8 * k) = *(const MLAS u32x4*)(ut + j * VP + cq + 8 * k);
    }
    LGKM_BAR();
}

__device__ __forceinline__ void pool_item(int item, const bf16_t* Z0, bf16_t* Y) {
    const int row = item >> 6, ch = item & 63, c0 = ch * 8, g = ch >> 4;
    const int w = 2 << g, tpos = row & (SEQ - 1);
    const int cnt = (tpos + 1 < w) ? tpos + 1 : w;
    u32x4 v[16];
#pragma unroll
    for (int k = 0; k < 16; ++k) { v[k] = (u32x4){0u, 0u, 0u, 0u}; if (k < cnt) v[k] = *(const u32x4*)(Z0 + (size_t)(row - k) * EV_N + c0); }
    float s[8] = {0.f, 0.f, 0.f, 0.f, 0.f, 0.f, 0.f, 0.f};
#pragma unroll
    for (int k = 0; k < 16; ++k) {
        s[0] += pg8::bf_lo(v[k].x); s[1] += pg8::bf_hi(v[k].x); s[2] += pg8::bf_lo(v[k].y); s[3] += pg8::bf_hi(v[k].y);
        s[4] += pg8::bf_lo(v[k].z); s[5] += pg8::bf_hi(v[k].z); s[6] += pg8::bf_lo(v[k].w); s[7] += pg8::bf_hi(v[k].w);
    }
    const float self[8] = {pg8::bf_lo(v[0].x), pg8::bf_hi(v[0].x), pg8::bf_lo(v[0].y), pg8::bf_hi(v[0].y), pg8::bf_lo(v[0].z), pg8::bf_hi(v[0].z), pg8::bf_lo(v[0].w), pg8::bf_hi(v[0].w)};
    const float inv = 1.0f / (float)cnt;
    u32x4 o; o.x = cvtpk(s[0] * inv - self[0], s[1] * inv - self[1]); o.y = cvtpk(s[2] * inv - self[2], s[3] * inv - self[3]);
    o.z = cvtpk(s[4] * inv - self[4], s[5] * inv - self[5]); o.w = cvtpk(s[6] * inv - self[6], s[7] * inv - self[7]);
    *(u32x4*)(Y + (size_t)row * DMODEL + c0) = o;
}
}
namespace foxa {
using bf16=__hip_bfloat16;
using bf16x8=__attribute__((ext_vector_type(8)))short;
using s16x4=__attribute__((ext_vector_type(4)))short;
using f32x16=__attribute__((ext_vector_type(16)))float;
using u32x4=__attribute__((ext_vector_type(4)))unsigned;
using f32x4v=__attribute__((ext_vector_type(4)))float;
constexpr int CUM_OFF=86016;
constexpr int SEQL=2048,D=64,OPI=1024;
constexpr int NW=8,QBLK=32,QB=QBLK*NW,KVBLK=64;
__device__ __forceinline__ int crow(int r,int hi){return (r&3)+8*(r>>2)+4*hi;}
#define SBAR() __builtin_amdgcn_sched_barrier(0)
__device__ __forceinline__ void cmask(f32x16&p0,f32x16&p1,int jb,int qrel,int hi){
  const float NEG=-INFINITY; int kb=64*jb+4*hi;
  #pragma unroll
  for(int r=0;r<16;++r){int kv=kb+(r&3)+8*(r>>2); if(kv>qrel)p0[r]=NEG; if(kv+32>qrel)p1[r]=NEG;}
}

constexpr int NSLOT=3, SLOTB=8192;
constexpr int LDS_K=0, LDS_V=NSLOT*SLOTB, LDS_WS=2*NSLOT*SLOTB, LDS_OST=LDS_WS+NW*64*4, LDS_BYTES=LDS_OST+NW*4096;
constexpr float C2=0.125f*1.4426950408889634f;
__device__ __forceinline__ void glds16(const void*gsrc,unsigned lds_dst){unsigned keep;
  asm volatile("s_mov_b32 %0, m0\n\ts_mov_b32 m0, %2\n\ts_nop 0\n\tglobal_load_lds_dwordx4 %1, off\n\ts_mov_b32 m0, %0":"=&s"(keep):"v"(gsrc),"s"(lds_dst):"memory");}
__device__ __forceinline__ float max3f(float a,float b,float c){float r;asm("v_max3_f32 %0, %1, %2, %3":"=v"(r):"v"(a),"v"(b),"v"(c));return r;}
__device__ __forceinline__ float max2f(float a,float b){float r;asm("v_max_f32_e32 %0, %1, %2":"=v"(r):"v"(a),"v"(b));return r;}
__device__ __forceinline__ float fadd_s(float a,float b){float r;asm("v_add_f32_e32 %0, %1, %2":"=v"(r):"v"(a),"v"(b));return r;}
__device__ __forceinline__ float fsub_s(float a,float b){float r;asm("v_sub_f32_e32 %0, %1, %2":"=v"(r):"v"(a),"v"(b));return r;}
typedef float f32x2_t __attribute__((ext_vector_type(2))); typedef __bf16 bf16x2_t __attribute__((ext_vector_type(2)));
__device__ __forceinline__ unsigned cvtpk_s(float lo,float hi){f32x2_t v={lo,hi};bf16x2_t b=__builtin_convertvector(v,bf16x2_t);return __builtin_bit_cast(unsigned,b);}
#define WAIT_BAR(N) asm volatile("s_waitcnt vmcnt(" #N ") lgkmcnt(0)\n\ts_barrier":::"memory")

__device__ __forceinline__ void qkt(f32x16&p0,f32x16&p1,const char*Kslot,const bf16x8*qr,const f32x16&negm,int r32,int hi){
  const char*kb=Kslot+hi*1024+r32*16;
  #pragma unroll
  for(int d0=0;d0<4;++d0){
    const bf16x8 b0=*reinterpret_cast<const bf16x8*>(kb+d0*2048);
    const bf16x8 b1=*reinterpret_cast<const bf16x8*>(kb+d0*2048+512);
    if(d0==0){p0=__builtin_amdgcn_mfma_f32_32x32x16_bf16(b0,qr[0],negm,0,0,0);p1=__builtin_amdgcn_mfma_f32_32x32x16_bf16(b1,qr[0],negm,0,0,0);}
    else{p0=__builtin_amdgcn_mfma_f32_32x32x16_bf16(b0,qr[d0],p0,0,0,0);p1=__builtin_amdgcn_mfma_f32_32x32x16_bf16(b1,qr[d0],p1,0,0,0);}}
}
typedef __attribute__((address_space(3))) const char* lds_cptr;
typedef short v4i16_t __attribute__((ext_vector_type(4)));
__device__ __forceinline__ void kload8(bf16x8*kf,lds_cptr kp){
  kf[0]=*(const __attribute__((address_space(3))) bf16x8*)(kp);      kf[1]=*(const __attribute__((address_space(3))) bf16x8*)(kp+512);
  kf[2]=*(const __attribute__((address_space(3))) bf16x8*)(kp+2048); kf[3]=*(const __attribute__((address_space(3))) bf16x8*)(kp+2560);
  kf[4]=*(const __attribute__((address_space(3))) bf16x8*)(kp+4096); kf[5]=*(const __attribute__((address_space(3))) bf16x8*)(kp+4608);
  kf[6]=*(const __attribute__((address_space(3))) bf16x8*)(kp+6144); kf[7]=*(const __attribute__((address_space(3))) bf16x8*)(kp+6656);
}
__device__ __forceinline__ void kload2(bf16x8*kf,lds_cptr kp,int j){ kf[2*j]=*(const __attribute__((address_space(3))) bf16x8*)(kp+j*2048); kf[2*j+1]=*(const __attribute__((address_space(3))) bf16x8*)(kp+j*2048+512); }
__device__ __forceinline__ s16x4 vtr(lds_cptr p){ return __builtin_bit_cast(s16x4,__builtin_amdgcn_ds_read_tr16_b64_v4i16((__attribute__((address_space(3))) v4i16_t*)p)); }
__device__ __forceinline__ float rowmax(const f32x16&p0,const f32x16&p1){
  float a=max3f(p0[0],p0[1],p1[0]),b=max3f(p0[2],p0[3],p1[1]);a=max3f(a,p1[2],p1[3]);
  #pragma unroll
  for(int r=4;r<16;r+=4){a=max3f(a,p0[r],p0[r+1]);b=max3f(b,p0[r+2],p0[r+3]);a=max3f(a,p1[r],p1[r+1]);b=max3f(b,p1[r+2],p1[r+3]);}
  const float m=max2f(a,b);
  auto rr=__builtin_amdgcn_permlane32_swap(__float_as_uint(m),__float_as_uint(m),false,false);
  return max2f(__uint_as_float(rr[0]),__uint_as_float(rr[1]));
}
__device__ __forceinline__ void pv(f32x16*o,int vb,bf16x8 pa0,bf16x8 pa1,bf16x8 pa2,bf16x8 pa3){
  #pragma unroll
  for(int d0=0;d0<2;++d0){s16x4 lo[4],hi[4];
    #pragma unroll
    for(int ks=0;ks<4;++ks){
      asm volatile("ds_read_b64_tr_b16 %0,%1 offset:%c2":"=&v"(lo[ks]):"v"(vb),"i"(d0*4096+ks*1024):"memory");
      asm volatile("ds_read_b64_tr_b16 %0,%1 offset:%c2":"=&v"(hi[ks]):"v"(vb),"i"(d0*4096+ks*1024+512):"memory");}
    asm volatile("s_waitcnt lgkmcnt(0)":::"memory");SBAR();
    #define PK(k) (bf16x8){lo[k][0],lo[k][1],lo[k][2],lo[k][3],hi[k][0],hi[k][1],hi[k][2],hi[k][3]}
    o[d0]=__builtin_amdgcn_mfma_f32_32x32x16_bf16(pa0,PK(0),o[d0],0,0,0);
    o[d0]=__builtin_amdgcn_mfma_f32_32x32x16_bf16(pa1,PK(1),o[d0],0,0,0);
    o[d0]=__builtin_amdgcn_mfma_f32_32x32x16_bf16(pa2,PK(2),o[d0],0,0,0);
    o[d0]=__builtin_amdgcn_mfma_f32_32x32x16_bf16(pa3,PK(3),o[d0],0,0,0);
    #undef PK
  }
}

#ifndef ATTN_STORE16
#define ATTN_STORE16(p,v) (*(u32x4*)(p)=(v))
#endif
template<int THRL,int MODE,int QKVP,class CumFn> __device__ __forceinline__ void attn_unit(CumFn&& CUMFN,int b,int h,int qb,int q0abs,int NTU,const bf16*Q,const bf16*__restrict__ K,const bf16*__restrict__ V,bf16*O,char*shm,const __attribute__((address_space(3))) unsigned*selw,const int wave_s){
  const int tid=wave_s*64+lane_opaque(),lane=tid&63,r32=lane&31,hi=lane>>5; const int wid=__builtin_amdgcn_readfirstlane(tid>>6);
  const long rowbase=(long)b*SEQL; const int q0=(MODE==0)?qb*QB:q0abs;
  const bf16*Qw=(MODE==0)?Q+(rowbase+q0+wid*QBLK)*QKVP+h*D:Q+(rowbase+q0)*QKVP+wid*D;
  const bf16*Kh=K+rowbase*QKVP+h*D,*Vh=V+rowbase*QKVP+h*D;
  const unsigned lds0=(unsigned)(uintptr_t)shm;
  float*wsf=(float*)(shm+LDS_WS)+wid*64;
  const bf16*ksrc=Kh+(long)lane*QKVP+wid*8;
  const bf16*vsrc=Vh+(long)(16*(wid&3)+(lane>>2))*QKVP+(wid>>2)*32+(lane&3)*8;
  const unsigned kdst=lds0+LDS_K+wid*1024, vdst=lds0+LDS_V+wid*1024;
  #define DMA_K(t,slot) glds16(ksrc+(long)(t)*KVBLK*QKVP,(unsigned)__builtin_amdgcn_readfirstlane(kdst+(slot)))
  #define DMA_V(t,slot) glds16(vsrc+(long)(t)*KVBLK*QKVP,(unsigned)__builtin_amdgcn_readfirstlane(vdst+(slot)))
  const int vb0=(int)(lds0+LDS_V)+((lane>>4)&1)*32+(lane&3)*8+(4*hi+((lane&15)>>2))*64;
  const char*Kbase=shm+LDS_K; bf16x8 kf[8];
  const lds_cptr shm3=(lds_cptr)shm; const lds_cptr kp0=shm3+LDS_K+hi*1024+r32*16; const lds_cptr vp0=shm3+LDS_V+((lane>>4)&1)*32+(lane&3)*8+(4*hi+((lane&15)>>2))*64;
  const int NT=(MODE==0)?(q0+QB)/KVBLK:NTU;
  DMA_K(0,0);DMA_V(0,0);DMA_K(1,SLOTB);
  if constexpr(MODE==0){ CUMFN(); }
  bf16x8 qr[4];
  #pragma unroll
  for(int d0=0;d0<4;++d0)qr[d0]=*reinterpret_cast<const bf16x8*>(&Qw[(long)r32*QKVP+d0*16+hi*8]);
  float mhat=0.f,l_reg=0.f;float z_=0.f;asm volatile("":"+v"(z_));f32x16 o[2];o[0]=(f32x16){z_,z_,z_,z_,z_,z_,z_,z_,z_,z_,z_,z_,z_,z_,z_,z_};o[1]=o[0];f32x16 negm=o[0];asm volatile("":"+v"(negm));
  const int qrel=wid*QBLK+r32;
  const __attribute__((address_space(3))) float*cum2=(const __attribute__((address_space(3))) float*)(shm+CUM_OFF);
  const float cq2=(MODE==0)?cum2[q0+qrel]:0.f;
  #define BIAS(P0,P1,t) do{ if constexpr(MODE==0){ const __attribute__((address_space(3))) float*cb_=cum2+64*(t)+4*hi; \
    _Pragma("unroll") for(int g_=0;g_<4;++g_){ const f32x4v c0_=*(const __attribute__((address_space(3))) f32x4v*)(cb_+8*g_), c1_=*(const __attribute__((address_space(3))) f32x4v*)(cb_+32+8*g_); \
      P0[4*g_+0]+=cq2-c0_.x; P0[4*g_+1]+=cq2-c0_.y; P0[4*g_+2]+=cq2-c0_.z; P0[4*g_+3]+=cq2-c0_.w; \
      P1[4*g_+0]+=cq2-c1_.x; P1[4*g_+1]+=cq2-c1_.y; P1[4*g_+2]+=cq2-c1_.z; P1[4*g_+3]+=cq2-c1_.w; } } }while(0)
  #define SELM(P0,P1,t) do{ if constexpr(MODE==1){ const unsigned w0_=selw[(2*(t))*32+r32]>>(4*hi), w1_=selw[(2*(t)+1)*32+r32]>>(4*hi); \
    _Pragma("unroll") for(int r=0;r<16;++r){ const int sh_=(r&3)+8*(r>>2); if(!((w0_>>sh_)&1u))P0[r]=-INFINITY; if(!((w1_>>sh_)&1u))P1[r]=-INFINITY; } } }while(0)
  #define CMASK(P0,P1,t) do{ if constexpr(MODE==0){int jb_=(t)-(NT-4); if(jb_>=0)cmask(P0,P1,jb_,qrel,hi);} }while(0)
  bool resc=false;
  #define START(P0,P1) do{ const float rm=rowmax(P0,P1); resc=false; \
    { const float dl=(MODE==1&&!(rm>-1e30f))?0.f:rm; mhat=fadd_s(mhat,dl); \
      _Pragma("unroll") for(int r=0;r<16;++r){P0[r]=fsub_s(P0[r],dl);P1[r]=fsub_s(P1[r],dl);} \
      _Pragma("unroll") for(int r=0;r<16;++r)negm[r]=-mhat; asm volatile("":"+v"(negm)); } \
    _Pragma("unroll") for(int r=0;r<16;++r)P0[r]=__builtin_amdgcn_exp2f(P0[r]); }while(0)
  #define RESC() do{ if(resc){ asm volatile("s_waitcnt lgkmcnt(0)":::"memory"); \
      _Pragma("unroll") for(int d_=0;d_<2;++d_) _Pragma("unroll") for(int r=0;r<16;++r)o[d_][r]*=wsf[crow(r,hi)]; } }while(0)
  f32x16 pA0,pA1,pB0,pB1;
  int sl_prev=0,sl_cur=0,sl_next=SLOTB;
  #define ROT() do{sl_prev=sl_cur;sl_cur=sl_next;sl_next=(sl_next==(NSLOT-1)*SLOTB)?0:sl_next+SLOTB;}while(0)
  DMA_K(2,2*SLOTB);
  WAIT_BAR(3);
  qkt(pA0,pA1,Kbase,qr,negm,r32,hi);asm volatile("s_nop 15\n\ts_nop 7":"+v"(pA0),"+v"(pA1));BIAS(pA0,pA1,0);SELM(pA0,pA1,0);CMASK(pA0,pA1,0);
  START(pA0,pA1);
  _Pragma("unroll") for(int r=0;r<16;++r)pA1[r]=__builtin_amdgcn_exp2f(pA1[r]);
  WAIT_BAR(0);
  DMA_K(3,0);DMA_V(1,SLOTB);
  ROT();
  kload8(kf,kp0+sl_cur);
  WAIT_BAR(2);
  s16x4 vlo[8],vhi[8]; u32x4 pw0,pw1,pw2,pw3;
  #define PKW(P,B) cvtpk_s(P[B],P[B+1])
  #define PAF(k) __builtin_bit_cast(bf16x8,pw##k)
  #define VFR(i) (bf16x8){vlo[i][0],vlo[i][1],vlo[i][2],vlo[i][3],vhi[i][0],vhi[i][1],vhi[i][2],vhi[i][3]}
  #define PIN(x) asm volatile("":"+v"(x))
  #define MX3(a,b,c) __builtin_fmaxf(__builtin_fmaxf((a),(b)),(c))
  #define GAPA(MF,A0,A1,A2,A3,W0,W1,PW) do{ MF; sacc+=A0; sacc+=A1; sacc+=A2; sacc+=A3; PIN(sacc); W0; W1; PIN(PW); SBAR(); }while(0)
  #define EX(v) __builtin_amdgcn_exp2f(v)
  #define GAPB(MF,X,B) do{ MF; X[B]=EX(X[B]); X[B+1]=EX(X[B+1]); X[B+2]=EX(X[B+2]); X[B+3]=EX(X[B+3]); PIN(X); SBAR(); }while(0)
  #define VRD(i) do{ vlo[i]=vtr(vp_+(((i)>>2)*4096+((i)&3)*1024)); vhi[i]=vtr(vp_+(((i)>>2)*4096+((i)&3)*1024+512)); }while(0)
  #define KRD(G,j) do{ if(G){ kload2(kf,kp0+sl_next,j); SBAR(); } }while(0)
  #define STEP(C0,C1,P0,P1,t,GK,GV,GL) do{ SBAR(); \
    const lds_cptr vp_=vp0+sl_prev; \
    VRD(0); SBAR(); float sacc=(P0[0]+P0[1]); \
    GAPA(C0=__builtin_amdgcn_mfma_f32_32x32x16_bf16(kf[0],qr[0],negm,0,0,0), P0[2],P0[3],P0[4],P0[5],     pw0[0]=PKW(P0,0), pw0[1]=PKW(P0,2), pw0); \
    VRD(4); SBAR(); GAPA(C1=__builtin_amdgcn_mfma_f32_32x32x16_bf16(kf[1],qr[0],negm,0,0,0), P0[6],P0[7],P0[8],P0[9],     pw0[2]=PKW(P0,4), pw0[3]=PKW(P0,6), pw0); \
    VRD(1); SBAR(); GAPA(C0=__builtin_amdgcn_mfma_f32_32x32x16_bf16(kf[2],qr[1],C0,0,0,0),   P0[10],P0[11],P0[12],P0[13], pw1[0]=PKW(P0,8), pw1[1]=PKW(P0,10), pw1); \
    VRD(5); SBAR(); GAPA(C1=__builtin_amdgcn_mfma_f32_32x32x16_bf16(kf[3],qr[1],C1,0,0,0),   P0[14],P0[15],P1[0],P1[1],   pw1[2]=PKW(P0,12),pw1[3]=PKW(P0,14), pw1); \
    VRD(2); SBAR(); GAPA(C0=__builtin_amdgcn_mfma_f32_32x32x16_bf16(kf[4],qr[2],C0,0,0,0),   P1[2],P1[3],P1[4],P1[5],     pw2[0]=PKW(P1,0), pw2[1]=PKW(P1,2), pw2); \
    VRD(6); SBAR(); GAPA(C1=__builtin_amdgcn_mfma_f32_32x32x16_bf16(kf[5],qr[2],C1,0,0,0),   P1[6],P1[7],P1[8],P1[9],     pw2[2]=PKW(P1,4), pw2[3]=PKW(P1,6), pw2); \
    VRD(3); SBAR(); GAPA(C0=__builtin_amdgcn_mfma_f32_32x32x16_bf16(kf[6],qr[3],C0,0,0,0),   P1[10],P1[11],P1[12],P1[13], pw3[0]=PKW(P1,8), pw3[1]=PKW(P1,10), pw3); \
    VRD(7); SBAR(); GAPA(C1=__builtin_amdgcn_mfma_f32_32x32x16_bf16(kf[7],qr[3],C1,0,0,0),   P1[14],P1[15],0.f,0.f,       pw3[2]=PKW(P1,12),pw3[3]=PKW(P1,14), pw3); \
    l_reg+=sacc; \
    if(GK){DMA_K((t)+3,sl_cur);} if(GV){DMA_V((t)+1,sl_next);} \
    BIAS(C0,C1,t); SELM(C0,C1,t); CMASK(C0,C1,t); \
    { float a=MX3(C0[0],C0[1],C1[0]),b=MX3(C0[2],C0[3],C1[1]); a=MX3(a,C1[2],C1[3]); \
      _Pragma("unroll") for(int r=4;r<16;r+=4){a=MX3(a,C0[r],C0[r+1]);b=MX3(b,C0[r+2],C0[r+3]);a=MX3(a,C1[r],C1[r+1]);b=MX3(b,C1[r+2],C1[r+3]);} \
      float rm=__builtin_fmaxf(a,b); { auto rr=__builtin_amdgcn_permlane32_swap(__float_as_uint(rm),__float_as_uint(rm),false,false); rm=__builtin_fmaxf(__uint_as_float(rr[0]),__uint_as_float(rr[1])); } \
      resc=false; \
      if(__builtin_expect(__any(rm>(float)THRL),0)){ const float dl=__builtin_fmaxf(rm,0.f); mhat+=dl; \
        _Pragma("unroll") for(int r=0;r<16;++r){C0[r]-=dl;C1[r]-=dl;} \
        _Pragma("unroll") for(int r=0;r<16;++r)negm[r]=-mhat; asm volatile("":"+v"(negm)); \
        const float f=__builtin_amdgcn_exp2f(-dl); l_reg*=f; if(hi==0)wsf[r32]=f; resc=true; } } \
    SBAR(); \
    GAPB(o[0]=__builtin_amdgcn_mfma_f32_32x32x16_bf16(PAF(0),VFR(0),o[0],0,0,0), C0,0); \
    GAPB(o[1]=__builtin_amdgcn_mfma_f32_32x32x16_bf16(PAF(0),VFR(4),o[1],0,0,0), C0,4); \
    KRD(GL,0); GAPB(o[0]=__builtin_amdgcn_mfma_f32_32x32x16_bf16(PAF(1),VFR(1),o[0],0,0,0), C0,8); \
    KRD(GL,1); GAPB(o[1]=__builtin_amdgcn_mfma_f32_32x32x16_bf16(PAF(1),VFR(5),o[1],0,0,0), C0,12); \
    KRD(GL,2); GAPB(o[0]=__builtin_amdgcn_mfma_f32_32x32x16_bf16(PAF(2),VFR(2),o[0],0,0,0), C1,0); \
    KRD(GL,3); GAPB(o[1]=__builtin_amdgcn_mfma_f32_32x32x16_bf16(PAF(2),VFR(6),o[1],0,0,0), C1,4); \
    GAPB(o[0]=__builtin_amdgcn_mfma_f32_32x32x16_bf16(PAF(3),VFR(3),o[0],0,0,0), C1,8); \
    GAPB(o[1]=__builtin_amdgcn_mfma_f32_32x32x16_bf16(PAF(3),VFR(7),o[1],0,0,0), C1,12); \
    }while(0)
  int t=1;
  #undef CMASK
  #define CMASK(P0,P1,t) do{}while(0)
  for(;t+5<NT;t+=2){
    STEP(pB0,pB1,pA0,pA1,t,true,true,true);     WAIT_BAR(2); RESC(); ROT();
    STEP(pA0,pA1,pB0,pB1,t+1,true,true,true);   WAIT_BAR(2); RESC(); ROT();
  }
  #undef CMASK
  #define CMASK(P0,P1,t) do{ if constexpr(MODE==0){int jb_=(t)-(NT-4); if(jb_>=0)cmask(P0,P1,jb_,qrel,hi);} }while(0)
  #define ENDW(tt) do{ if((tt)+3<NT){WAIT_BAR(2);} else if((tt)+2<NT){WAIT_BAR(1);} else {WAIT_BAR(0);} }while(0)
  for(;t+1<NT;t+=2){
    STEP(pB0,pB1,pA0,pA1,t,(t+3<NT),(t+1<NT),(t+1<NT));       ENDW(t);   RESC(); ROT();
    STEP(pA0,pA1,pB0,pB1,t+1,(t+4<NT),(t+2<NT),(t+2<NT));     ENDW(t+1); RESC(); ROT();
  }
  STEP(pB0,pB1,pA0,pA1,NT-1,false,false,false); RESC();
  { float sacc=pB0[0]+pB0[1]; _Pragma("unroll") for(int r=2;r<16;++r)sacc+=pB0[r]; _Pragma("unroll") for(int r=0;r<16;++r)sacc+=pB1[r]; l_reg+=sacc;
    pw0=(u32x4){PKW(pB0,0),PKW(pB0,2),PKW(pB0,4),PKW(pB0,6)};pw1=(u32x4){PKW(pB0,8),PKW(pB0,10),PKW(pB0,12),PKW(pB0,14)};pw2=(u32x4){PKW(pB1,0),PKW(pB1,2),PKW(pB1,4),PKW(pB1,6)};pw3=(u32x4){PKW(pB1,8),PKW(pB1,10),PKW(pB1,12),PKW(pB1,14)};
    SBAR(); pv(o,vb0+sl_cur,PAF(0),PAF(1),PAF(2),PAF(3)); }
  #undef PKW
  #undef PAF
  #undef VFR
  #undef PIN
  #undef MX3
  #undef GAPA
  #undef GAPB
  #undef EX
  #undef VRD
  #undef KRD
  #undef STEP
  #undef ENDW
  {auto rr=__builtin_amdgcn_permlane32_swap(__float_as_uint(l_reg),__float_as_uint(l_reg),false,false);l_reg=__uint_as_float(rr[0])+__uint_as_float(rr[1]);}
  if(hi==0)wsf[32+r32]=l_reg;asm volatile("s_waitcnt lgkmcnt(0)":::"memory");
  float rli[16];
  #pragma unroll
  for(int r=0;r<16;++r)rli[r]=__builtin_amdgcn_rcpf(wsf[32+crow(r,hi)]);
  bf16*Ow=(MODE==0)?O+(rowbase+q0+wid*QBLK)*OPI+h*D:O+(rowbase+q0)*OPI+wid*D;
  { bf16*stg=(bf16*)(shm+LDS_OST)+wid*2048;
    #pragma unroll
    for(int r=0;r<16;++r){const int orow=crow(r,hi);
      #pragma unroll
      for(int d0=0;d0<2;++d0)stg[orow*64+d0*32+r32]=__float2bfloat16(o[d0][r]*rli[r]);}
    asm volatile("s_waitcnt lgkmcnt(0)":::"memory");
    #pragma unroll
    for(int i=0;i<4;++i){const int row=i*8+(lane>>3),ch=lane&7; const u32x4 v=*(const u32x4*)(stg+row*64+ch*8); ATTN_STORE16(Ow+(long)row*OPI+ch*8,v);} }
  asm volatile("s_waitcnt lgkmcnt(0)\n\ts_barrier":::"memory");
  #undef DMA_K
  #undef DMA_V
  #undef CMASK
  #undef START
  #undef BIAS
  #undef SELM
  #undef RESC
  #undef ROT
}
#undef SBAR
#undef WAIT_BAR
}

#ifndef DBG_REP_SEL
#define DBG_REP_SEL 1
#endif
namespace mix {
__device__ __forceinline__ void fox_unit2(int b, int h, int qb, const bf16_t* Z1, const float* F, const float* bfp, bf16_t* Y, char* shm, const int wave_s) {
    const size_t rowb = (size_t)b * SEQ;
    const int nk = 256 * (qb + 1);
    auto cumfn = [=]() {
        const int tid = wave_s * 64 + lane_opaque(), lane = tid & 63; const int wid = __builtin_amdgcn_readfirstlane(tid >> 6);
        MLAS char* L = (MLAS char*)shm;
        MLAS float* cum2 = (MLAS float*)(L + foxa::CUM_OFF);
        MLAS float* wtot = (MLAS float*)(L + foxa::CUM_OFF + 8192);
        const float bias = bfp[h];
        const int s0 = 4 * tid;
        float v[4]; float run = 0.f;
#pragma unroll
        for (int i = 0; i < 4; ++i) {
            float x = 0.f;
            if (s0 + i < nk) x = F[(rowb + s0 + i) * 8 + h] + bias;
            const float ls = (s0 + i < nk) ? (fminf(x, 0.f) - log1pf(expf(-fabsf(x)))) : 0.f;
            run += ls; v[i] = run;
        }
        float inc = run;
#pragma unroll
        for (int o = 1; o < 64; o <<= 1) { const int ln = lane_opaque(); const float t = __builtin_bit_cast(float, __builtin_amdgcn_ds_bpermute((ln - o) << 2, __builtin_bit_cast(int, inc))); if (ln >= o) inc += t; }
        if (lane == 63) wtot[wid] = inc;
        LGKM_BAR();
        float off = inc - run;
        for (int w = 0; w < wid; ++w) off += wtot[w];
#pragma unroll
        for (int i = 0; i < 4; ++i) cum2[s0 + i] = (off + v[i]) * 1.4426950408889634f;
        LGKM_BAR();
    };
    foxa::attn_unit<8, 0, 2560>(cumfn, b, h, qb, 0, 0, (const foxa::bf16*)Z1, (const foxa::bf16*)(Z1 + 512), (const foxa::bf16*)(Z1 + 1024), (foxa::bf16*)Y, shm, nullptr, wave_s);
}
__device__ __forceinline__ void dsa_unit(int b, int qg, const bf16_t* Z0, bf16_t* Y, char* shm, unsigned lds0, const int wave_s) {
    for (int rep_ = 0; rep_ < DBG_REP_SEL; ++rep_) dsa_select(b, qg, Z0, shm, wave_s);
    const int nt64 = (qg >> 1) + 1; int ntu = (nt64 + 1) & ~1; if (ntu < 4) ntu = 4;
    foxa::attn_unit<8, 1, EV_N>([]() {}, b, 0, 0, 32 * qg, ntu, (const foxa::bf16*)(Z0 + 512), (const foxa::bf16*)(Z0 + 1024), (const foxa::bf16*)(Z0 + 1088), (foxa::bf16*)(Y + 512), shm,
                                (const MLAS unsigned*)((MLAS char*)shm + LX_SEL), wave_s);
}
}
constexpr int NWAVES = 8;
constexpr size_t KiB = 1024, MiB = 1u << 20;
constexpr size_t WS_CTL = 0, CTL_ZERO_BYTES = 1 * MiB;
constexpr size_t WS_W_EVIN = 1 * MiB, WS_W_OUT0 = 4 * MiB, WS_W_FFI0 = 6 * MiB, WS_W_FFO0 = 17 * MiB, WS_W_PG0 = 22 * MiB + 512 * KiB, WS_W_PP0 = 24 * MiB + 512 * KiB;
constexpr size_t WS_W_ODIN = 25 * MiB, WS_W_OUT1 = 30 * MiB + 512 * KiB, WS_W_FFI1 = 32 * MiB + 512 * KiB, WS_W_FFO1 = 43 * MiB + 512 * KiB, WS_W_PG1 = 49 * MiB, WS_W_PP1 = 51 * MiB, WS_W_SGU = 51 * MiB + 512 * KiB;
constexpr size_t WS_RSTD = 57 * MiB + 768 * KiB;
constexpr size_t WS_SSQA = 52 * MiB, WS_SSQB = 53 * MiB, WS_ROPE = 54 * MiB, WS_AH = 55 * MiB, WS_FBUF = 58 * MiB + 512 * KiB, WS_SST = 59 * MiB;
constexpr size_t WS_HB = 60 * MiB, WS_AHALO = 92 * MiB, WS_PP = 92 * MiB + 512 * KiB, WS_Y = 124 * MiB + 512 * KiB, WS_ZH = 156 * MiB + 512 * KiB, WS_PB = 244 * MiB + 512 * KiB, WS_END = 252 * MiB + 512 * KiB;
static_assert(WS_AHALO == WS_HB + (size_t)TOK * 1024 * 2, "the halo rows are row tile 64 of the FFN in-projection A operand");
static_assert(WS_W_EVIN + (size_t)EV_N * 1024 * 2 <= WS_W_OUT0 && WS_W_FFI0 + (size_t)NFF2 * 1024 * 2 <= WS_W_FFO0 && WS_W_FFO0 + (size_t)1024 * DFF * 2 <= WS_W_PG0, "ws map 1");
static_assert(WS_W_ODIN + (size_t)OD_N * 1024 * 2 <= WS_W_OUT1 && WS_W_FFI1 + (size_t)NFF2 * 1024 * 2 <= WS_W_FFO1 && WS_W_FFO1 + (size_t)1024 * DFF * 2 <= WS_W_PG1 && WS_W_SGU + 4 * 128 * 128 * 2 <= WS_SSQA, "ws map 2");
static_assert(WS_AH + (size_t)128 * NFF2 * 4 <= WS_RSTD && WS_ZH + (size_t)TOK * DFF * 2 <= WS_PB && WS_PB + (size_t)TOK * PLE * 2 <= WS_END, "ws map 3");
constexpr int CW_BAR = 4096, CW_FLAG = 8192, CW_PAN = 16384;
constexpr int RING_BYTES = 131072, XB_OFF = RING_BYTES, LDSCTL_OFF = XB_OFF + 8192 + 1024 + 64, MISC_OFF = LDSCTL_OFF + 320, LDS_BYTES = 147456;
static_assert(MISC_OFF + 128 <= LDS_BYTES, "LDS map");

#define GAS __attribute__((address_space(1)))
#define LAS __attribute__((address_space(3)))
typedef unsigned short bf16;
typedef unsigned v4u __attribute__((ext_vector_type(4)));
typedef float f32x4 __attribute__((ext_vector_type(4)));
typedef float f32x2 __attribute__((ext_vector_type(2)));
#define LDS_WAIT() asm volatile("s_waitcnt lgkmcnt(0)" ::: "memory")
#define VM_WAIT() asm volatile("s_waitcnt vmcnt(0)" ::: "memory")
__device__ __forceinline__ unsigned f2bf(float f) { unsigned u = __builtin_bit_cast(unsigned, f); return (u + 0x7fffu + ((u >> 16) & 1u)) >> 16; }
__device__ __forceinline__ unsigned pk2(float lo, float hi) { return f2bf(lo) | (f2bf(hi) << 16); }

#define XB_TMO      128
#define XB_XCNT(j)  (256  + 64 * (j))
#define XB_XSUB(j)  (1280 + 64 * (j))
#define XB_XGEN(j)  (2304 + 64 * (j))
#define XB_TOP      3328
#define XB_TOPGEN   3392
#define XCD_BAR_WORDS 3456
#define XB_SPIN_CAP (1u << 18)
__device__ __forceinline__ unsigned xb_ld(unsigned* p)              { return __hip_atomic_load(p, __ATOMIC_RELAXED, __HIP_MEMORY_SCOPE_AGENT); }
__device__ __forceinline__ unsigned xb_add(unsigned* p, unsigned v) { return __hip_atomic_fetch_add(p, v, __ATOMIC_RELAXED, __HIP_MEMORY_SCOPE_AGENT); }
__device__ __forceinline__ unsigned xb_xcc_id() { return (unsigned)__builtin_amdgcn_s_getreg((3 << 11) | 20) & 0xFu; }
#define XB_SPIN(cond, bar) do { unsigned _sp = 0; while (cond) { __builtin_amdgcn_s_sleep(1); \
    if ((++_sp & 255u) == 0u) { if (xb_ld(&(bar)[XB_TMO])) break; if (_sp > XB_SPIN_CAP) { atomicAdd(&(bar)[XB_TMO], 1u); break; } } } } while (0)
struct XcdBarrier { unsigned* bar; unsigned x; volatile LAS unsigned* st; };
__device__ __forceinline__ XcdBarrier xcd_barrier_post(unsigned* bar, volatile LAS unsigned* st) {
    XcdBarrier b; b.bar = bar; b.x = xb_xcc_id(); b.st = st;
    if (threadIdx.x == 0) (void)xb_add(&bar[XB_XCNT(b.x)], 1u);
    return b;
}
__device__ __forceinline__ void xcd_barrier_complete(unsigned* bar, unsigned x, unsigned& nloc, unsigned& nx) {
    const unsigned G = gridDim.x * gridDim.y * gridDim.z;
    unsigned sum, cnt, mine, sp = 0u;
    for (;;) {
        sum = 0u; cnt = 0u; mine = 0u;
#pragma unroll 1
        for (unsigned j = 0; j < 16; ++j) { const unsigned c = xb_ld(&bar[XB_XCNT(j)]); sum += c; cnt += (c > 0u) ? 1u : 0u; mine = (j == x) ? c : mine; }
        if (sum == G) break;
        __builtin_amdgcn_s_sleep(1);
        if ((++sp & 255u) == 0u) { if (xb_ld(&bar[XB_TMO])) break; if (sp > XB_SPIN_CAP) { atomicAdd(&bar[XB_TMO], 1u); break; } }
    }
    nloc = mine > 0u ? mine : 1u; nx = cnt > 0u ? cnt : 1u;
}
__device__ __forceinline__ void xcd_barrier(const XcdBarrier& b) {
    asm volatile("s_waitcnt vmcnt(0)" ::: "memory");
    __syncthreads();
    if (threadIdx.x == 0) {
        unsigned* bar = b.bar;
        __builtin_amdgcn_s_waitcnt(0);
        unsigned nloc = b.st[0], nx = b.st[1];
        if (nloc == 0u) { xcd_barrier_complete(bar, b.x, nloc, nx); b.st[0] = nloc; b.st[1] = nx; }
        const unsigned old = xb_add(&bar[XB_XSUB(b.x)], 1u);
        const unsigned gen = old / nloc;
        if (old + 1u == (gen + 1u) * nloc) {
            __builtin_amdgcn_fence(__ATOMIC_RELEASE, "agent");
            asm volatile("s_waitcnt vmcnt(0)" ::: "memory");
            const unsigned og = xb_add(&bar[XB_TOP], 1u);
            const unsigned tg = og / nx;
            if (og + 1u == (tg + 1u) * nx) xb_add(&bar[XB_TOPGEN], 1u);
            else XB_SPIN(xb_ld(&bar[XB_TOPGEN]) == tg, bar);
            __builtin_amdgcn_fence(__ATOMIC_ACQUIRE, "agent");
            xb_add(&bar[XB_XGEN(b.x)], 1u);
            asm volatile("s_waitcnt vmcnt(0)" ::: "memory");
        } else {
            XB_SPIN(xb_ld(&bar[XB_XGEN(b.x)]) == gen, bar);
            __builtin_amdgcn_fence(__ATOMIC_ACQUIRE, "agent");
            asm volatile("s_waitcnt vmcnt(0)" ::: "memory");
        }
    }
    __syncthreads();
}

__device__ __forceinline__ float wave_sum(float v) {
#pragma unroll
    for (int o = 1; o < 64; o <<= 1) v += __builtin_bit_cast(float, __builtin_amdgcn_ds_bpermute((lane_opaque() ^ o) << 2, __builtin_bit_cast(int, v)));
    return v;
}
__device__ __forceinline__ int vcu_of(int i, int n) { return i; }
__device__ __forceinline__ int unperm16(int d) { return d < 16 ? ((d >> 1) + 8 * (d & 1)) : d; }
__device__ __forceinline__ int map_col(int type, int n, int nold) {
    if (type == 0) return n < nold ? n : -1;
    if (type == 1) {
        if (n < 512) return n;
        if (n < 1024) { const int h = (n - 512) >> 6, d = (n - 512) & 63; return 512 + 64 * h + unperm16(d); }
        if (n < 1088) return 1024 + unperm16(n - 1024);
        if (n < 1152) return n;
        if (n < 1216) return 1408 + unperm16(n - 1152);
        if (n < 1220) return 1472 + (n - 1216);
        if (n < 1280) return -1;
        { const int h = (n - 1280) >> 6, d = (n - 1280) & 63; return 1152 + 64 * h + unperm16(d); }
    }
    if (type == 2) {
        if (n < 1536) return n;
        if (n < 2560) return n + 8;
        if (n < 2568) return 1536 + (n - 2560);
        return -1;
    }
    { const int pn = n >> 8, bj = (n >> 7) & 1, jj = n & 127; return bj * DFF + 128 * pn + jj; }
}
struct TJob { const float* W; const float* rowscale; bf16* WT; int K, Nold, Nnew, ldk, koff, type, nitems; };
__device__ __forceinline__ void transpose_item(const TJob& J, LAS float* scr, int item, int lane) {
    const int nblk = J.Nnew / 32, kb = item / nblk, nb = item % nblk, k0 = 64 * kb, n0 = 32 * nb;
    const int oc = map_col(J.type, n0 + (lane & 31), J.Nold);
    const int occ = oc >= 0 ? oc : 0;
    float vv[32];
#pragma unroll
    for (int i = 0; i < 32; ++i) vv[i] = J.W[(size_t)(k0 + 2 * i + (lane >> 5)) * J.Nold + occ];
#pragma unroll
    for (int i = 0; i < 32; ++i) { const int kk = 2 * i + (lane >> 5);
        float v = (oc >= 0) ? vv[i] : 0.f;
        if (J.rowscale) v *= J.rowscale[k0 + kk];
        scr[kk * 33 + (lane & 31)] = v; }
    LDS_WAIT(); asm volatile("" ::: "memory");
    const int c = lane & 7;
#pragma unroll
    for (int j = 0; j < 4; ++j) { const int n = (lane >> 3) + 8 * j; const LAS float* s = scr + (8 * c) * 33 + n;
        v4u o; o.x = pk2(s[0 * 33], s[1 * 33]); o.y = pk2(s[2 * 33], s[3 * 33]); o.z = pk2(s[4 * 33], s[5 * 33]); o.w = pk2(s[6 * 33], s[7 * 33]);
        *(GAS v4u*)(J.WT + (size_t)(n0 + n) * J.ldk + J.koff + k0 + 8 * c) = o; }
    LDS_WAIT(); asm volatile("" ::: "memory");
}
__device__ __forceinline__ void sincos_d(double a, float& sn, float& cs) {
    const double q = rint(a * 0.63661977236758134308);
    double r = a - q * 1.57079632673412561417e+00; r -= q * 6.07710050650619224932e-11;
    const double r2 = r * r;
    double s = 1.0 / 6227020800.0; s = s * r2 - 1.0 / 39916800.0; s = s * r2 + 1.0 / 362880.0; s = s * r2 - 1.0 / 5040.0; s = s * r2 + 1.0 / 120.0; s = s * r2 - 1.0 / 6.0; s = s * r2 * r + r;
    double c = -1.0 / 87178291200.0; c = c * r2 + 1.0 / 479001600.0; c = c * r2 - 1.0 / 3628800.0; c = c * r2 + 1.0 / 40320.0; c = c * r2 - 1.0 / 720.0; c = c * r2 + 1.0 / 24.0; c = c * r2 - 0.5; c = c * r2 + 1.0;
    const int qi = ((int)q) & 3;
    const double ss = (qi == 0) ? s : (qi == 1) ? c : (qi == 2) ? -s : -c;
    const double cc = (qi == 0) ? c : (qi == 1) ? -s : (qi == 2) ? -c : s;
    sn = (float)ss; cs = (float)cc;
}

struct Args { const void* in[24]; float* out; unsigned char* ws; int ph_lo, ph_hi; };
typedef const Args __attribute__((address_space(4)))* argp_t;
__device__ __forceinline__ argp_t get_args() { argp_t p = (argp_t)__builtin_amdgcn_kernarg_segment_ptr(); asm volatile("" : "+s"(p)); return p; }
__device__ __forceinline__ int otid(int wave_s) { return wave_s * 64 + lane_opaque(); }
#define IN_F(k) ((const float*)A_->in[k])
#define PH_LOCALS \
    argp_t A_ = get_args(); unsigned char* const ws = A_->ws; float* const out = A_->out; (void)out; \
    const int tid = otid(wave_s), lane = tid & 63, wave = wave_s; (void)lane; (void)wave; \
    const int G = gridDim.x, bx = blockIdx.x, vcu = (G % 8 == 0) ? (bx % 8) * (G / 8) + bx / 8 : bx; (void)vcu; \
    const int gw = vcu * NWAVES + wave, NGW = G * NWAVES, gt = vcu * (NWAVES * 64) + tid, NGT = G * NWAVES * 64; (void)gw; (void)NGW; (void)gt; (void)NGT; \
    LAS unsigned char* const L = (LAS unsigned char*)lds; (void)L;
#define WSP(T, off) ((T*)(ws + (off)))

__global__ void __launch_bounds__(NWAVES * 64, 2) mega_fwd(Args args) {
    extern __shared__ __attribute__((aligned(16))) unsigned char lds[];
    int lo, hi; XcdBarrier bar;
    const int wave_s = __builtin_amdgcn_readfirstlane((int)threadIdx.x >> 6);
    {
        PH_LOCALS
        volatile LAS unsigned* MISC = (volatile LAS unsigned*)(L + MISC_OFF);
        for (int u = tid; u < (LDS_BYTES - XB_OFF) / 4; u += NWAVES * 64) ((LAS unsigned*)(L + XB_OFF))[u] = 0u;
        __syncthreads();
        bar = xcd_barrier_post((unsigned*)(ws + WS_CTL) + CW_BAR, MISC + 8);
        lo = A_->ph_lo; hi = A_->ph_hi;
    }
#ifndef DBG_REP_TR
#define DBG_REP_TR 1
#endif
#ifndef DBG_REP_HB
#define DBG_REP_HB 1
#endif
#ifndef DBG_REP_FOX
#define DBG_REP_FOX 1
#endif
#ifndef DBG_REP_DSA
#define DBG_REP_DSA 1
#endif
#ifndef DBG_REP_SGU
#define DBG_REP_SGU 1
#endif
#ifndef DBG_REP_POOL
#define DBG_REP_POOL 1
#endif
#ifndef PHMASK
#define PHMASK 0xff7fffu
#endif
#define IN(k) (((PHMASK >> (k)) & 1u) && lo <= (k) && (k) < hi)
#define SEAM(k) do { if (IN(k) && IN((k) + 1)) xcd_barrier(bar); } while (0)
    if (IN(0)) {
        PH_LOCALS
        LAS float* scr = (LAS float*)(L + wave * 16384);
        const float* norm_mix = IN_F(3); const float* norm_ffn = IN_F(4); const float* norm_ple = IN_F(5);
        const float* ffn_w_in = IN_F(6); const float* ffn_w_out = IN_F(9); const float* ple_w_proj = IN_F(10); const float* ple_w_gate = IN_F(11);
        const float* ev_w_in = IN_F(13); const float* ev_w_out = IN_F(14); const float* od_w_in = IN_F(17); const float* od_w_out = IN_F(18);
#define TJ(Wp, RS, WTp, K_, NOLD, NNEW, LDK, KOFF, TYPE) { constexpr int NI_ = ((K_) / 64) * ((NNEW) / 32); if (r < NI_) { const TJob J{(Wp), (RS), (WTp), (K_), (NOLD), (NNEW), (LDK), (KOFF), (TYPE), NI_}; transpose_item(J, scr, r, lane); continue; } r -= NI_; }
        constexpr int NITEMS = 16 * 48 + 8 * 32 + 44 * 32 + 4 * 32;
        for (int rep_ = 0; rep_ < DBG_REP_TR; ++rep_) for (int it = gw; it < NITEMS; it += NGW) {
            int r = it;
            TJ(ev_w_in, norm_mix, WSP(bf16, WS_W_EVIN), 1024, 1476, EV_N, 1024, 0, 1)
            TJ(ev_w_out + (size_t)512 * 1024, nullptr, WSP(bf16, WS_W_OUT0), 512, 1024, 1024, 1024, 512, 0)
            TJ(ffn_w_out + (size_t)DFF * 1024, nullptr, WSP(bf16, WS_W_FFO1), DFF, 1024, 1024, DFF, 0, 0)
            TJ(ple_w_proj + (size_t)256 * 1024, nullptr, WSP(bf16, WS_W_PP1), 256, 1024, 1024, 256, 0, 0)
        }
#undef TJ
        { const float* sgu_w = IN_F(22); bf16* W_SGU = WSP(bf16, WS_W_SGU);
          for (int i = gt; i < 4 * 128 * 128; i += NGT) { const int jj = i & 127, ii = (i >> 7) & 127; W_SGU[i] = (bf16)((ii < 64 && jj >= 64) ? 0u : f2bf(sgu_w[i])); } }
        { const float* x = IN_F(0); bf16* HB = WSP(bf16, WS_HB); float* SSQA = WSP(float, WS_SSQA);
          for (int m = gw; m < TOK; m += 4 * NGW) {
            f32x4 v[4][4];
#pragma unroll
            for (int q = 0; q < 4; ++q) { const int mm = (m + q * NGW < TOK) ? m + q * NGW : m; const f32x4* xr = (const f32x4*)(x + (size_t)mm * DMODEL) + lane;
#pragma unroll
                for (int j = 0; j < 4; ++j) v[q][j] = xr[64 * j]; }
#pragma unroll
            for (int q = 0; q < 4; ++q) { const int mm = m + q * NGW; if (mm < TOK) {
                float s = 0.f; unsigned long long* o8 = (unsigned long long*)(HB + (size_t)mm * DMODEL) + lane;
#pragma unroll
                for (int j = 0; j < 4; ++j) { const f32x4 w = v[q][j]; s += (w.x * w.x + w.y * w.y) + (w.z * w.z + w.w * w.w);
                    o8[64 * j] = (unsigned long long)pk2(w.x, w.y) | ((unsigned long long)pk2(w.z, w.w) << 32); }
                s = wave_sum(s);
                if (lane < 16) SSQA[(size_t)mm * 16 + lane] = (lane == 0) ? s : 0.f; } }
          } }
        { const float* p_in = IN_F(1); bf16* PB = WSP(bf16, WS_PB);
          for (int i = gt; i < TOK * PLE / 4; i += 4 * NGT) { f32x4 v[4];
#pragma unroll
            for (int q = 0; q < 4; ++q) v[q] = ((const f32x4*)p_in)[(i + q * NGT < TOK * PLE / 4) ? i + q * NGT : i];
#pragma unroll
            for (int q = 0; q < 4; ++q) if (i + q * NGT < TOK * PLE / 4) ((unsigned long long*)PB)[i + q * NGT] = (unsigned long long)pk2(v[q].x, v[q].y) | ((unsigned long long)pk2(v[q].z, v[q].w) << 32); } }
        { const int* positions = (const int*)A_->in[2]; f32x2* ROPE = WSP(f32x2, WS_ROPE);
          for (int i = gt; i < TOK * 8; i += NGT) {
            const int row = i >> 3, j = i & 7;
            const float invf = (j == 0) ? 1.0f : (j == 1) ? 0.1939227432012558f : (j == 2) ? 0.03760603070259094f : (j == 3) ? 0.007292664609849453f : (j == 4) ? 0.0014142135623842478f :
                               (j == 5) ? 0.00027424818836152554f : (j == 6) ? 5.3182957344688475e-05f : 1.0313385246263351e-05f;
            const float ang = (float)positions[row] * invf;
            float sn, cs; sincos_d((double)ang, sn, cs);
            ROPE[i] = (f32x2){cs, sn};
          } }
    }
    SEAM(0);
    if (IN(1)) {
        { PH_LOCALS
          pg8::Gemm g{WSP(bf16, WS_HB), WSP(bf16, WS_W_EVIN), TOK, EV_N, 1024}; pg8::StaticOrder S; S.init(TOK, EV_N, G, bx);
          pg8::EpiEvenIn E{WSP(float, WS_SSQA), WSP(bf16, WS_ZH), WSP(const pg8::f32x2, WS_ROPE)};
          pg8::gemm_phase<pg8::EpiEvenIn, pg8::StaticOrder, true, true>(L, g, S, E, wave_s); }
        if (gridDim.x == 256 && blockIdx.x >= 128) {
            PH_LOCALS
            LAS float* scr = (LAS float*)(L + wave * 16384);
            const float* norm_mix = IN_F(3); const float* norm_ffn = IN_F(4); const float* norm_ple = IN_F(5);
            const float* ffn_w_in = IN_F(6); const float* ffn_w_out = IN_F(9); const float* ple_w_proj = IN_F(10); const float* ple_w_gate = IN_F(11);
            const float* od_w_in = IN_F(17); const float* od_w_out = IN_F(18);
#define TJ(Wp, RS, WTp, K_, NOLD, NNEW, LDK, KOFF, TYPE) { constexpr int NI_ = ((K_) / 64) * ((NNEW) / 32); if (r < NI_) { const TJob J{(Wp), (RS), (WTp), (K_), (NOLD), (NNEW), (LDK), (KOFF), (TYPE), NI_}; transpose_item(J, scr, r, lane); continue; } r -= NI_; }
            constexpr int NITEMS_B = (16 * 176 + 44 * 32 + 16 * 32 + 4 * 32) + 16 * 88 + 16 * 32;
            const int gwb = (vcu_of(bx - 128, 128)) * NWAVES + wave, NGWB = 128 * NWAVES;
            for (int it = gwb; it < NITEMS_B; it += NGWB) {
                int r = it;
                TJ(ffn_w_in, norm_ffn, WSP(bf16, WS_W_FFI0), 1024, NFF2, NFF2, 1024, 0, 3)
                TJ(ffn_w_out, nullptr, WSP(bf16, WS_W_FFO0), DFF, 1024, 1024, DFF, 0, 0)
                TJ(ple_w_gate, norm_ple, WSP(bf16, WS_W_PG0), 1024, 1024, 1024, 1024, 0, 0)
                TJ(ple_w_proj, nullptr, WSP(bf16, WS_W_PP0), 256, 1024, 1024, 256, 0, 0)
                TJ(od_w_in, norm_mix + 1024, WSP(bf16, WS_W_ODIN), 1024, 2568, OD_N, 1024, 0, 2)
                TJ(od_w_out, nullptr, WSP(bf16, WS_W_OUT1), 1024, 1024, 1024, 1024, 0, 0)
            }
#undef TJ
        {
            const float* pool_w = IN_F(15); const float* pool_scale = IN_F(16); const float* ev_w_out = IN_F(14); bf16* W_OUT0 = WSP(bf16, WS_W_OUT0);
            for (int it = gwb; it < 1024; it += NGWB) {
                const int g = it >> 8, nb = (it >> 4) & 15, cb = it & 15, n = 64 * nb + lane;
                float acc[8];
#pragma unroll
                for (int cc = 0; cc < 8; ++cc) acc[cc] = 0.f;
#pragma unroll 1
                for (int d0 = 0; d0 < 128; d0 += 16) {
                    float wv[16];
#pragma unroll
                    for (int e = 0; e < 16; ++e) wv[e] = ev_w_out[(size_t)(128 * g + d0 + e) * 1024 + n] * pool_scale[128 * g + d0 + e];
#pragma unroll
                    for (int cc = 0; cc < 8; ++cc) {
                        const float* pw = pool_w + ((size_t)g * 128 + 8 * cb + cc) * 128 + d0;
#pragma unroll
                        for (int e = 0; e < 16; ++e) acc[cc] += pw[e] * wv[e];
                    }
                }
#pragma unroll
                for (int c2 = 0; c2 < 4; ++c2) *(unsigned*)(W_OUT0 + (size_t)n * 1024 + 128 * g + 8 * cb + 2 * c2) = pk2(acc[2 * c2], acc[2 * c2 + 1]);
            }
        }
        }
    }
    SEAM(1);
    if (IN(2)) {
        { PH_LOCALS
          const bf16* ZH = WSP(bf16, WS_ZH); bf16* Y = WSP(bf16, WS_Y); const unsigned lds0 = (unsigned)(uintptr_t)lds;
          for (int pi = vcu; pi < 256; pi += G) {
            const int b = pi >> 5, s = pi & 31;
#pragma unroll 1
            for (int k = 0; k < 2 * DBG_REP_DSA; ++k) mix::dsa_unit(b, (k & 1) ? s : 63 - s, ZH, Y, (char*)lds, lds0, wave_s);
          } }
        { PH_LOCALS
          const bf16* ZH = WSP(bf16, WS_ZH); bf16* Y = WSP(bf16, WS_Y);
          for (int rep_ = 0; rep_ < DBG_REP_POOL; ++rep_) for (int it = gt; it < TOK * 64; it += NGT) mix::pool_item(it, ZH, Y);
        }
    }
    SEAM(2);
    {
        const size_t s1o = (0 == 0) ? WS_SSQA : WS_SSQB, s2o = (0 == 0) ? WS_SSQB : WS_SSQA, s3o = s1o;
        if (IN(3)) {
            PH_LOCALS
            pg8::Gemm g{WSP(bf16, WS_Y), WSP(bf16, (0 == 0) ? WS_W_OUT0 : WS_W_OUT1), TOK, 1024, 1024}; pg8::StaticOrder S; S.init(TOK, 1024, G, bx);
            pg8::EpiRes E{nullptr, WSP(bf16, WS_HB), WSP(bf16, WS_HB), WSP(float, s1o), WSP(bf16, WS_AHALO)};
            pg8::gemm_phase<pg8::EpiRes, pg8::StaticOrder, true, true>(L, g, S, E, wave_s);
        }
        SEAM(3);
        if (IN(3 + 2)) {
            PH_LOCALS
            pg8::Gemm g{WSP(bf16, WS_HB), WSP(bf16, WS_W_FFI0), TOK + 256, NFF2, 1024}; pg8::StaticOrder S; S.init(TOK, NFF2, G, bx);
#ifdef STAGGER
            if (STAGGER_COND) { for (int i_ = 0; i_ < STAGGER; ++i_) __builtin_amdgcn_s_sleep(127); }
#endif
            if (G == 256 && bx >= 128 && bx < 128 + NFF2 / 256) {
                pg8::OneUnit S1{64, bx - 128, 1};
                pg8::EpiHaloF EH{WSP(float, s1o), WSP(float, WS_AH), (unsigned*)(ws + WS_CTL) + CW_FLAG + 2048 * 0};
                pg8::gemm_phase<pg8::EpiHaloF, pg8::OneUnit, true, true>(L, g, S1, EH, wave_s);
            }
#ifdef PP_FIRST
            if (G == 256 && bx >= 150) {
                pg8::Gemm gp{WSP(bf16, WS_PB), WSP(bf16, WS_W_PP0), TOK, 1024, PLE}; pg8::StaticOrder SP; SP.init(TOK, 1024, 106, bx - 150);
                pg8::EpiBf16Plain EP{WSP(bf16, WS_PP), 1024};
                pg8::gemm_phase<pg8::EpiBf16Plain, pg8::StaticOrder, true, true>(L, gp, SP, EP, wave_s);
            }
#endif
            pg8::EpiFfnIn E{WSP(float, s1o), IN_F(7) + (size_t)0 * 3 * NFF2, IN_F(8) + (size_t)0 * NFF2, WSP(float, WS_AH), WSP(bf16, WS_ZH), (LAS float*)(L + XB_OFF), (unsigned*)(ws + WS_CTL) + CW_FLAG + 2048 * 0, 1u};
            pg8::gemm_phase<pg8::EpiFfnIn, pg8::StaticOrder, true, true>(L, g, S, E, wave_s);
#ifndef PP_FIRST
            if (G == 256 && bx >= 150) {
                pg8::Gemm gp{WSP(bf16, WS_PB), WSP(bf16, WS_W_PP0), TOK, 1024, PLE}; pg8::StaticOrder SP; SP.init(TOK, 1024, 106, bx - 150);
                pg8::EpiBf16Plain EP{WSP(bf16, WS_PP), 1024};
                pg8::gemm_phase<pg8::EpiBf16Plain, pg8::StaticOrder, true, true>(L, gp, SP, EP, wave_s);
            }
#endif
        }
        SEAM(3 + 2);
        if (IN(3 + 3)) {
            PH_LOCALS
            pg8::Gemm g{WSP(bf16, WS_ZH), WSP(bf16, (0 == 0) ? WS_W_FFO0 : WS_W_FFO1), TOK, 1024, DFF}; pg8::StaticOrder S; S.init(TOK, 1024, G, bx);
            pg8::EpiRes E{nullptr, WSP(bf16, WS_HB), WSP(bf16, WS_HB), WSP(float, s2o), nullptr};
            pg8::gemm_phase<pg8::EpiRes, pg8::StaticOrder, true, true>(L, g, S, E, wave_s);
        }
        SEAM(3 + 3);
        if (IN(3 + 4)) {
            PH_LOCALS
            pg8::Gemm g{WSP(bf16, WS_HB), WSP(bf16, (0 == 0) ? WS_W_PG0 : WS_W_PG1), TOK, 1024, 1024}; pg8::StaticOrder S; S.init(TOK, 1024, G, bx);
            pg8::EpiGate E{WSP(float, s2o), WSP(bf16, WS_HB), WSP(bf16, WS_PP), (bf16*)out, WSP(float, s3o)};
            pg8::gemm_phase<pg8::EpiGate, pg8::StaticOrder, true, true>(L, g, S, E, wave_s);
        }
        SEAM(3 + 4);
    }
    {

            if (IN(8)) {
                { PH_LOCALS
                  pg8::Gemm g{(const bf16*)out, WSP(bf16, WS_W_ODIN), TOK, OD_N, 1024}; pg8::StaticOrder S; S.init(TOK, OD_N, G, bx);
                  pg8::EpiOddIn E{WSP(float, WS_SSQA), WSP(bf16, WS_ZH), WSP(float, WS_FBUF), WSP(float, WS_SST)};
                  pg8::gemm_phase<pg8::EpiOddIn, pg8::StaticOrder, true, true>(L, g, S, E, wave_s); }
                if (gridDim.x == 256 && blockIdx.x >= 192) {
                    PH_LOCALS
                    LAS float* scr = (LAS float*)(L + wave * 16384);
                    const float* norm_ffn = IN_F(4); const float* norm_ple = IN_F(5); const float* ffn_w_in = IN_F(6); const float* ple_w_gate = IN_F(11);
#define TJ(Wp, RS, WTp, K_, NOLD, NNEW, LDK, KOFF, TYPE) { constexpr int NI_ = ((K_) / 64) * ((NNEW) / 32); if (r < NI_) { const TJob J{(Wp), (RS), (WTp), (K_), (NOLD), (NNEW), (LDK), (KOFF), (TYPE), NI_}; transpose_item(J, scr, r, lane); continue; } r -= NI_; }
                    constexpr int NITEMS_C = 16 * 176 + 16 * 32;
                    const int gwc = (bx - 192) * NWAVES + wave, NGWC = 64 * NWAVES;
                    for (int it = gwc; it < NITEMS_C; it += NGWC) {
                        int r = it;
                        TJ(ffn_w_in + (size_t)1024 * NFF2, norm_ffn + 1024, WSP(bf16, WS_W_FFI1), 1024, NFF2, NFF2, 1024, 0, 3)
                        TJ(ple_w_gate + (size_t)1024 * 1024, norm_ple + 1024, WSP(bf16, WS_W_PG1), 1024, 1024, 1024, 1024, 0, 0)
                    }
#undef TJ
                    const float* p1 = IN_F(1) + (size_t)TOK * PLE; bf16* PB = WSP(bf16, WS_PB);
                    const int gtc = (bx - 192) * (NWAVES * 64) + tid, NGTC = 64 * NWAVES * 64;
                    for (int i = gtc; i < TOK * PLE / 4; i += 4 * NGTC) { f32x4 v[4];
#pragma unroll
                        for (int q = 0; q < 4; ++q) v[q] = ((const f32x4*)p1)[(i + q * NGTC < TOK * PLE / 4) ? i + q * NGTC : i];
#pragma unroll
                        for (int q = 0; q < 4; ++q) if (i + q * NGTC < TOK * PLE / 4) ((unsigned long long*)PB)[i + q * NGTC] = (unsigned long long)pk2(v[q].x, v[q].y) | ((unsigned long long)pk2(v[q].z, v[q].w) << 32); }
                }
            }
            SEAM(8);
            if (IN(9)) {
                { PH_LOCALS
                  const bf16* ZH = WSP(bf16, WS_ZH); bf16* Y = WSP(bf16, WS_Y); const unsigned lds0 = (unsigned)(uintptr_t)lds;
                  const float* FBUF = WSP(float, WS_FBUF); const float* fox_b_f = IN_F(19);
                  for (int pi = vcu; pi < 256; pi += G) {
                    const int bh = pi >> 2, s = pi & 3;
#pragma unroll 1
                    for (int k = 0; k < 2 * DBG_REP_FOX; ++k) mix::fox_unit2(bh >> 3, bh & 7, (k & 1) ? s : 7 - s, ZH, FBUF, fox_b_f, Y, (char*)lds, wave_s);
                  } }
                { PH_LOCALS
                  const bf16* ZH = WSP(bf16, WS_ZH); bf16* Y = WSP(bf16, WS_Y);
                  for (int rep_ = 0; rep_ < DBG_REP_SGU; ++rep_) for (int u = vcu; u < 512; u += G) mix::sgu_unit(u >> 6, (u >> 2) & 15, u & 3, ZH, WSP(float, WS_SST), IN_F(20), IN_F(21), WSP(bf16, WS_W_SGU), IN_F(23), Y, (char*)lds, wave_s); }
            }
            SEAM(9);
            }
    {
        const size_t s1o = (1 == 0) ? WS_SSQA : WS_SSQB, s2o = (1 == 0) ? WS_SSQB : WS_SSQA, s3o = s1o;
        if (IN(10)) {
            PH_LOCALS
            pg8::Gemm g{WSP(bf16, WS_Y), WSP(bf16, (1 == 0) ? WS_W_OUT0 : WS_W_OUT1), TOK, 1024, 1024}; pg8::StaticOrder S; S.init(TOK, 1024, G, bx);
            pg8::EpiRes E{nullptr, (const bf16*)out, WSP(bf16, WS_HB), WSP(float, s1o), WSP(bf16, WS_AHALO)};
            pg8::gemm_phase<pg8::EpiRes, pg8::StaticOrder, true, true>(L, g, S, E, wave_s);
        }
        SEAM(10);
        if (IN(10 + 2)) {
            PH_LOCALS
            pg8::Gemm g{WSP(bf16, WS_HB), WSP(bf16, WS_W_FFI1), TOK + 256, NFF2, 1024}; pg8::StaticOrder S; S.init(TOK, NFF2, G, bx);
#ifdef STAGGER
            if (STAGGER_COND) { for (int i_ = 0; i_ < STAGGER; ++i_) __builtin_amdgcn_s_sleep(127); }
#endif
            if (G == 256 && bx >= 128 && bx < 128 + NFF2 / 256) {
                pg8::OneUnit S1{64, bx - 128, 1};
                pg8::EpiHaloF EH{WSP(float, s1o), WSP(float, WS_AH), (unsigned*)(ws + WS_CTL) + CW_FLAG + 2048 * 1};
                pg8::gemm_phase<pg8::EpiHaloF, pg8::OneUnit, true, true>(L, g, S1, EH, wave_s);
            }
#ifdef PP_FIRST
            if (G == 256 && bx >= 150) {
                pg8::Gemm gp{WSP(bf16, WS_PB), WSP(bf16, WS_W_PP1), TOK, 1024, PLE}; pg8::StaticOrder SP; SP.init(TOK, 1024, 106, bx - 150);
                pg8::EpiBf16Plain EP{WSP(bf16, WS_PP), 1024};
                pg8::gemm_phase<pg8::EpiBf16Plain, pg8::StaticOrder, true, true>(L, gp, SP, EP, wave_s);
            }
#endif
            pg8::EpiFfnIn E{WSP(float, s1o), IN_F(7) + (size_t)1 * 3 * NFF2, IN_F(8) + (size_t)1 * NFF2, WSP(float, WS_AH), WSP(bf16, WS_ZH), (LAS float*)(L + XB_OFF), (unsigned*)(ws + WS_CTL) + CW_FLAG + 2048 * 1, 2u};
            pg8::gemm_phase<pg8::EpiFfnIn, pg8::StaticOrder, true, true>(L, g, S, E, wave_s);
#ifndef PP_FIRST
            if (G == 256 && bx >= 150) {
                pg8::Gemm gp{WSP(bf16, WS_PB), WSP(bf16, WS_W_PP1), TOK, 1024, PLE}; pg8::StaticOrder SP; SP.init(TOK, 1024, 106, bx - 150);
                pg8::EpiBf16Plain EP{WSP(bf16, WS_PP), 1024};
                pg8::gemm_phase<pg8::EpiBf16Plain, pg8::StaticOrder, true, true>(L, gp, SP, EP, wave_s);
            }
#endif
        }
        SEAM(10 + 2);
        if (IN(10 + 3)) {
            PH_LOCALS
            pg8::Gemm g{WSP(bf16, WS_ZH), WSP(bf16, (1 == 0) ? WS_W_FFO0 : WS_W_FFO1), TOK, 1024, DFF}; pg8::StaticOrder S; S.init(TOK, 1024, G, bx);
            pg8::EpiRes E{nullptr, WSP(bf16, WS_HB), WSP(bf16, WS_HB), WSP(float, s2o), nullptr};
            pg8::gemm_phase<pg8::EpiRes, pg8::StaticOrder, true, true>(L, g, S, E, wave_s);
        }
        SEAM(10 + 3);
        if (IN(10 + 4)) {
            PH_LOCALS
            pg8::Gemm g{WSP(bf16, WS_HB), WSP(bf16, (1 == 0) ? WS_W_PG0 : WS_W_PG1), TOK, 1024, 1024}; pg8::StaticOrder S; S.init(TOK, 1024, G, bx);
            pg8::EpiGateFinal E{WSP(float, s2o), WSP(bf16, WS_HB), WSP(bf16, WS_PP), WSP(float, s3o), (unsigned*)(ws + WS_CTL) + CW_PAN, IN_F(12), out, (LAS float*)(L + XB_OFF) + 2048};
            pg8::gemm_phase<pg8::EpiGateFinal, pg8::StaticOrder, true, true>(L, g, S, E, wave_s);
        }
        SEAM(10 + 4);
    }
    if (IN(15)) {
        PH_LOCALS
        const float* SSQB = WSP(float, WS_SSQB); const float* norm_final = IN_F(12); const bf16* H6 = WSP(bf16, WS_Y);
        for (int m = gw; m < TOK; m += 4 * NGW) {
            unsigned long long w[4][4]; float rs[4];
#pragma unroll
            for (int q = 0; q < 4; ++q) { const int mm = (m + q * NGW < TOK) ? m + q * NGW : m; rs[q] = pg8::row_rstd(SSQB, mm);
                const unsigned long long* hr = (const unsigned long long*)(H6 + (size_t)mm * DMODEL) + lane;
#pragma unroll
                for (int j = 0; j < 4; ++j) w[q][j] = hr[64 * j]; }
            const f32x4* gr = (const f32x4*)norm_final + lane;
            f32x4 gg[4];
#pragma unroll
            for (int j = 0; j < 4; ++j) gg[j] = gr[64 * j];
#pragma unroll
            for (int q = 0; q < 4; ++q) { const int mm = m + q * NGW; if (mm < TOK) { f32x4* xr = (f32x4*)(out + (size_t)mm * DMODEL) + lane;
#pragma unroll
                for (int j = 0; j < 4; ++j) { const unsigned long long ww = w[q][j];
                    const f32x4 v = {pg8::bf_lo((unsigned)ww), pg8::bf_hi((unsigned)ww), pg8::bf_lo((unsigned)(ww >> 32)), pg8::bf_hi((unsigned)(ww >> 32))};
                    __builtin_nontemporal_store(v * rs[q] * gg[j], xr + 64 * j); } } }
        }
    }
#undef IN
#undef SEAM
}

#ifndef MK_N_LAUNCHES
#define MK_N_LAUNCHES 1
#endif
constexpr int N_PHASES = 16;
extern "C" void kernel_launch(void* const* d_in, const int* in_sizes, int n_in, void* d_out, int out_size, void* d_ws, size_t ws_size, hipStream_t stream) {
    static int grid = 0;
    if (grid == 0) {
        if (n_in != 24 || out_size != TOK * DMODEL || ws_size < WS_END) { fprintf(stderr, "kernel_launch: unexpected shapes (n_in %d, out %d, ws %zu)\n", n_in, out_size, ws_size); grid = -1; return; }
        int dev = 0, cus = 0;
        if (hipGetDevice(&dev) != hipSuccess || hipDeviceGetAttribute(&cus, hipDeviceAttributeMultiprocessorCount, dev) != hipSuccess) { grid = -1; return; }
        if (hipFuncSetAttribute((const void*)mega_fwd, hipFuncAttributeMaxDynamicSharedMemorySize, LDS_BYTES) != hipSuccess) { fprintf(stderr, "kernel_launch: hipFuncSetAttribute failed\n"); grid = -1; return; }
        int per_cu = 0;
        if (hipOccupancyMaxActiveBlocksPerMultiprocessor(&per_cu, (const void*)mega_fwd, NWAVES * 64, LDS_BYTES) != hipSuccess || per_cu < 1) { fprintf(stderr, "kernel_launch: occupancy query says %d\n", per_cu); }
        (void)hipGetLastError();
        grid = cus;
    }
    if (grid < 0) return;
    (void)hipMemsetAsync((char*)d_ws + WS_CTL, 0, CTL_ZERO_BYTES, stream);
    Args a{};
    for (int i = 0; i < 24; ++i) a.in[i] = d_in[i];
    a.out = (float*)d_out; a.ws = (unsigned char*)d_ws;
#ifdef DBG_CHECK
    {
        using namespace dbg;
        auto LP = [&](int ph) { a.ph_lo = ph; a.ph_hi = ph + 1; hipLaunchKernelGGL(mega_fwd, dim3(grid), dim3(NWAVES * 64), LDS_BYTES, stream, a); };
        char* wsb = (char*)d_ws; float* ERR = (float*)(wsb + 512 * 1024); float* SNAP = (float*)(wsb + 600 * 1024); float* outp = (float*)d_out;
        const unsigned short* ZHp = (const unsigned short*)(wsb + WS_ZH); const unsigned short* Yp = (const unsigned short*)(wsb + WS_Y); const float* FB = (const float*)(wsb + WS_FBUF);
        const unsigned short* HBp = (const unsigned short*)(wsb + WS_HB); const unsigned short* H3p = (const unsigned short*)d_out;
        auto F = [&](int i) { return (const float*)d_in[i]; };
        const float* x = F(0);
        LP(0); LP(1);
        k_evenin<<<NS, 256, 0, stream>>>(x, F(3), F(13), (const int*)d_in[2], ZHp, ERR, 0);
        LP(2);
        k_pool<<<NS, 256, 0, stream>>>(ZHp, Yp, ERR, 1);
        k_dsa<<<NS, 256, 0, stream>>>(ZHp, Yp, ERR, 2);
        LP(3);
        k_outproj<<<NS, 256, 0, stream>>>(x, 0, SNAP, Yp, F(14), F(15), F(16), HBp, ERR, 3);
        for (int layer = 0; layer < 2; ++layer) {
            const int pb = layer ? 10 : 3, kb = layer ? 10 : 3;
            if (layer == 1) {
                LP(8);
                k_oddin<<<NS, 256, 0, stream>>>(H3p, F(3) + 1024, F(17), ZHp, FB, ERR, 7);
                LP(9);
                k_fox<<<NS, 256, 0, stream>>>(ZHp, FB, F(19), Yp, ERR, 8);
                k_sgu<<<NS, 256, 0, stream>>>(ZHp, F(20), F(21), F(22), F(23), Yp, ERR, 9);
                k_snap<<<NS, 256, 0, stream>>>(H3p, SNAP);
                LP(10);
                k_outproj<<<NS, 256, 0, stream>>>(nullptr, 1, SNAP, Yp, F(18), nullptr, nullptr, HBp, ERR, 10);
            }
            LP(pb + 1); LP(pb + 2);
            k_ffnin<<<NS, 256, 0, stream>>>(HBp, F(4) + 1024 * layer, F(6) + (size_t)layer * 1024 * NFF2, F(7) + (size_t)layer * 3 * NFF2, F(8) + (size_t)layer * NFF2, ZHp, ERR, kb + 1);
            k_snap<<<NS, 256, 0, stream>>>(HBp, SNAP);
            LP(pb + 3);
            k_ffnout<<<NS, 256, 0, stream>>>(SNAP, ZHp, F(9) + (size_t)layer * DFF * 1024, HBp, ERR, kb + 2);
            k_snap<<<NS, 256, 0, stream>>>(HBp, SNAP);
            LP(pb + 4);
            k_ple<<<NS, 256, 0, stream>>>(SNAP, F(1) + (size_t)layer * TOK * PLE, F(5) + 1024 * layer, F(10) + (size_t)layer * PLE * 1024, F(11) + (size_t)layer * 1024 * 1024, layer ? Yp : H3p, ERR, kb + 3);
        }
        k_snap<<<NS, 256, 0, stream>>>(Yp, SNAP);
        LP(15);
        k_final<<<NS, 256, 0, stream>>>(SNAP, F(12), outp, ERR, 14);
        t_dpp<<<1, 64, 0, stream>>>(ERR + 40);
        k_report<<<1024, 256, 0, stream>>>(ERR, 15, DBG_TOL, outp);
        return;
    }
#endif
    if (MK_N_LAUNCHES == 1) {
        a.ph_lo = 0; a.ph_hi = N_PHASES;
        hipLaunchKernelGGL(mega_fwd, dim3(grid), dim3(NWAVES * 64), LDS_BYTES, stream, a);
    } else {
#ifndef DBG_STOP
#define DBG_STOP N_PHASES
#endif
#ifndef DBG_DOUBLE
#define DBG_DOUBLE -1
#endif
        for (int ph = 0; ph < DBG_STOP; ++ph) { a.ph_lo = ph; a.ph_hi = ph + 1; const int reps = (ph == DBG_DOUBLE || (DBG_DOUBLE == 100 && (ph == 0 || ph == 1 || ph == 2 || ph == 4 || ph == 5 || ph == 8 || ph == 9 || ph == 11 || ph == 12))) ? 2 : 1;
            for (int r = 0; r < reps; ++r) hipLaunchKernelGGL(mega_fwd, dim3(grid), dim3(NWAVES * 64), LDS_BYTES, stream, a); }
    }
}
```

```cpp
#include <hip/hip_runtime.h>
#include <hip/hip_bf16.h>
#include <cstdio>
#include <cstdint>
#include <cmath>
constexpr int TOK = 16384, DMODEL = 1024, SEQ = 2048, NBATCH = 8;
constexpr int DFF = 2816, NFF2 = 5632, PLE = 256;
constexpr int EV_N = 1536;
constexpr int OD_N = 2816;
constexpr int Z1P = 2560;
constexpr float RMS_EPS = 1e-6f;
constexpr float C2 = 0.125f * 1.4426950408889634f;


__device__ __forceinline__ int lane_opaque() { unsigned z = 0u; asm volatile("" : "+v"(z)); return (int)__builtin_amdgcn_mbcnt_hi(~0u, __builtin_amdgcn_mbcnt_lo(~0u, z)); }
__device__ __forceinline__ float xor16_f(float v) { return __builtin_bit_cast(float, __builtin_amdgcn_ds_swizzle(__builtin_bit_cast(int, v), 0x401F)); }
__device__ __forceinline__ void halves_pair(unsigned v, unsigned& a, unsigned& b) { unsigned w = v; asm volatile("" : "+v"(w)); auto rr = __builtin_amdgcn_permlane32_swap(v, w, false, false); a = rr[0]; b = rr[1]; }
__device__ __forceinline__ float halves_sum_f(float v) { unsigned a, b; halves_pair(__builtin_bit_cast(unsigned, v), a, b); return __builtin_bit_cast(float, a) + __builtin_bit_cast(float, b); }
__device__ __forceinline__ float halves_max_f(float v) { unsigned a, b; halves_pair(__builtin_bit_cast(unsigned, v), a, b); return __builtin_fmaxf(__builtin_bit_cast(float, a), __builtin_bit_cast(float, b)); }
__device__ __forceinline__ unsigned halves_add_u(unsigned v) { unsigned a, b; halves_pair(v, a, b); return a + b; }
__device__ __forceinline__ unsigned halves_or_u(unsigned v) { unsigned a, b; halves_pair(v, a, b); return a | b; }
namespace pg8 {
#define PG8_LAS __attribute__((address_space(3)))
typedef unsigned short bf16_t;
typedef short bf16x8 __attribute__((ext_vector_type(8)));
typedef float f32x4 __attribute__((ext_vector_type(4)));
typedef unsigned u32x4 __attribute__((ext_vector_type(4)));
constexpr int BM = 256, BK = 64, HALF = 128, HTB = HALF * BK * 2  , STAGE_BYTES = 8 * HTB, NXCD = 8, WGM = 8;

__host__ __device__ __forceinline__ int lds_byte(int r, int c) { const int st = (r >> 4) * 2 + (c >> 5), rr = r & 15, cc = c & 31, ob = rr * 64 + cc * 2; return st * 1024 + (ob ^ (((ob >> 9) & 1) << 5)); }
__host__ __device__ __forceinline__ void stage_rc(int b, int& R, int& C) { const int st = b / 1024, sb = b % 1024, swz = sb ^ (((sb >> 9) & 1) << 5); R = (st >> 1) * 16 + swz / 64; C = (st & 1) * 32 + (swz % 64) / 2; }
__host__ __device__ __forceinline__ int perm32(int rho) { const int n = rho >> 4, i = rho & 15; return 8 * (i >> 2) + 4 * n + (i & 3); }

struct Unit { int pm, pn; };
struct Gemm { const bf16_t* A; const bf16_t* Bt; int M, N, K; };

struct StaticOrder {
    int nM, nN, nwg, G, c;
    __host__ __device__ void init(int M, int N, int G_, int c_) { nM = M / BM; nN = N / BM; nwg = nM * nN; G = G_; c = c_; }
    __host__ __device__ bool next(int i, Unit& u) const {
        const long L = (long)i * G + c; if (L >= nwg) return false;
        int wgid = (int)L; { const int q = nwg / NXCD, r = nwg % NXCD, xcd = wgid % NXCD, off = wgid / NXCD; wgid = (xcd < r ? xcd * (q + 1) : r * (q + 1) + (xcd - r) * q) + off; }
        const int nig = WGM * nN, gid = wgid / nig, fm = gid * WGM, gsz = (nM - fm) < WGM ? (nM - fm) : WGM;
        u.pm = fm + ((wgid % nig) % gsz); u.pn = (wgid % nig) / gsz; return true;
    }
    __device__ __forceinline__ void a_ready(const Unit&) const {}
    __device__ __forceinline__ void done(const Unit&) const {}
};

struct OneUnit {
    int pm, pn, on;
    __host__ __device__ bool next(int i, Unit& u) const { if (!on || i != 0) return false; u.pm = pm; u.pn = pn; return true; }
    __device__ __forceinline__ void a_ready(const Unit&) const {}
    __device__ __forceinline__ void done(const Unit&) const {}
};
struct FfnOrder {
    StaticOrder S0; int extra;
    __host__ __device__ void init(int M, int N, int G_, int c_) { S0.init(M, N, G_, c_); extra = (G_ == 256 && c_ >= 128 && c_ < 128 + N / BM) ? 1 : 0; }
    __host__ __device__ bool next(int i, Unit& u) const { if (extra) { if (i == 0) { u.pm = 64; u.pn = S0.c - 128; return true; } return S0.next(i - 1, u); } return S0.next(i, u); }
    __device__ __forceinline__ void a_ready(const Unit&) const {}
    __device__ __forceinline__ void done(const Unit&) const {}
};
typedef float f32x2 __attribute__((ext_vector_type(2)));
typedef unsigned u32x2 __attribute__((ext_vector_type(2)));
__device__ __forceinline__ unsigned cvt_pk_bf16(float lo, float hi) { unsigned r; asm volatile("v_cvt_pk_bf16_f32 %0, %1, %2" : "=v"(r) : "v"(lo), "v"(hi)); return r; }
__device__ __forceinline__ float bf_lo(unsigned w) { return __builtin_bit_cast(float, w << 16); }
__device__ __forceinline__ float bf_hi(unsigned w) { return __builtin_bit_cast(float, w & 0xffff0000u); }
__device__ __forceinline__ float sq4(const f32x4 v) { return (v[0] * v[0] + v[1] * v[1]) + (v[2] * v[2] + v[3] * v[3]); }
__device__ __forceinline__ float row_rstd(const float* ssq, int row) {
    const f32x4* p = (const f32x4*)(ssq + (size_t)row * 16);
    const f32x4 a = p[0], b = p[1], c = p[2], d = p[3];
    const float s = (((a[0] + a[1]) + (a[2] + a[3])) + ((b[0] + b[1]) + (b[2] + b[3]))) + (((c[0] + c[1]) + (c[2] + c[3])) + ((d[0] + d[1]) + (d[2] + d[3])));
    return 1.0f / sqrtf(s * (1.0f / 1024.0f) + RMS_EPS);
}
__device__ __forceinline__ float row_rstd_coh(const float* ssq, int row) {
    const float* p = ssq + (size_t)row * 16;
    f32x4 a, b, c, d;
    asm volatile("global_load_dwordx4 %0, %4, off sc1\n\tglobal_load_dwordx4 %1, %4, off offset:16 sc1\n\tglobal_load_dwordx4 %2, %4, off offset:32 sc1\n\tglobal_load_dwordx4 %3, %4, off offset:48 sc1\n\ts_waitcnt vmcnt(0)"
                 : "=&v"(a), "=&v"(b), "=&v"(c), "=&v"(d) : "v"(p) : "memory");
    const float s = (((a[0] + a[1]) + (a[2] + a[3])) + ((b[0] + b[1]) + (b[2] + b[3]))) + (((c[0] + c[1]) + (c[2] + c[3])) + ((d[0] + d[1]) + (d[2] + d[3])));
    return 1.0f / sqrtf(s * (1.0f / 1024.0f) + RMS_EPS);
}
__device__ __forceinline__ void ssq_write(float* ssq_out, float q, int row, int slot, int fq) {
    q += xor16_f(q); q = halves_sum_f(q);
    if (fq == 0) ssq_out[(size_t)row * 16 + slot] = q;
}
typedef float f32x2 __attribute__((ext_vector_type(2)));
__device__ __forceinline__ f32x2 gelu_mul2(const f32x2 x, const f32x2 c) {
    const f32x2 x2 = x * x;
    const f32x2 a = x * (x2 * (-2.3022082f * 0.044715f) + (-2.3022082f));
    f32x2 e; e.x = __builtin_amdgcn_exp2f(a.x); e.y = __builtin_amdgcn_exp2f(a.y);
    const f32x2 d = e + 1.0f;
    f32x2 r; r.x = __builtin_amdgcn_rcpf(d.x); r.y = __builtin_amdgcn_rcpf(d.y);
    return (x * c) * r;
}
__device__ __forceinline__ float gelu_tanh(float x) {
    const float t = x + 0.044715f * x * x * x;
    const float e = __builtin_amdgcn_exp2f(-2.3022082f * t);
    return x * __builtin_amdgcn_rcpf(1.0f + e);
}
__device__ __forceinline__ float sigmoid_f(float x) { return __builtin_amdgcn_rcpf(1.0f + __builtin_amdgcn_exp2f(-1.4426950408889634f * x)); }


struct EpiRes {
    static constexpr bool PERM = true, AFTER_DRAIN = false;
    const float* basef; const bf16_t* baseb; bf16_t* hb; float* ssq_out; bf16_t* ahalo;
    __device__ __forceinline__ void operator()(const f32x4 (&acc)[2][2][4][2], const Unit& u_, int wr, int wc, int fr, int fq) const {
        Unit u; { int pm_ = u_.pm, pn_ = u_.pn; asm volatile("" : "+s"(pm_), "+s"(pn_)); u.pm = pm_; u.pn = pn_; }
        const int row0 = u.pm * BM + wr * 64 + fr, col0 = u.pn * BM + wc * 32 + 8 * fq;
        if (basef != nullptr) {
#pragma unroll
            for (int ai = 0; ai < 2; ++ai)
#pragma unroll
                for (int m = 0; m < 4; ++m) {
                    const int row = row0 + ai * HALF + m * 16; float q = 0.f;
#pragma unroll
                    for (int bj = 0; bj < 2; ++bj) {
                        const size_t off = (size_t)row * DMODEL + col0 + bj * HALF;
                        const f32x4 b0 = *(const f32x4*)(basef + off), b1 = *(const f32x4*)(basef + off + 4);
                        const f32x4 v0 = acc[ai][bj][m][0] + b0, v1 = acc[ai][bj][m][1] + b1;
                        q += sq4(v0) + sq4(v1);
                        u32x4 w; w.x = cvt_pk_bf16(v0[0], v0[1]); w.y = cvt_pk_bf16(v0[2], v0[3]); w.z = cvt_pk_bf16(v1[0], v1[1]); w.w = cvt_pk_bf16(v1[2], v1[3]);
                        *(u32x4*)(hb + off) = w;
                        if (ahalo != nullptr && ai == 1 && m == 3) {
                            const int rl = row & 255;
                            if (rl >= 254 && u.pm < 63) *(u32x4*)(ahalo + (size_t)(2 * (u.pm + 1) + (rl - 254)) * DMODEL + col0 + bj * HALF) = w;
                        }
                    }
                    ssq_write(ssq_out, q, row, u.pn * 4 + wc, fq);
                    if (m & 1) asm volatile("" ::: "memory");
                }
        } else {
#pragma unroll
            for (int ai = 0; ai < 2; ++ai) {
                u32x4 bw[4][2];
#pragma unroll
                for (int m = 0; m < 4; ++m)
#pragma unroll
                    for (int bj = 0; bj < 2; ++bj) bw[m][bj] = *(const u32x4*)(baseb + (size_t)(row0 + ai * HALF + m * 16) * DMODEL + col0 + bj * HALF);
                asm volatile("" ::: "memory");
#pragma unroll
                for (int m = 0; m < 4; ++m) {
                    const int row = row0 + ai * HALF + m * 16; float q = 0.f;
#pragma unroll
                    for (int bj = 0; bj < 2; ++bj) {
                        const size_t off = (size_t)row * DMODEL + col0 + bj * HALF;
                        const u32x4 pw = bw[m][bj];
                        const f32x4 b0 = {bf_lo(pw.x), bf_hi(pw.x), bf_lo(pw.y), bf_hi(pw.y)}, b1 = {bf_lo(pw.z), bf_hi(pw.z), bf_lo(pw.w), bf_hi(pw.w)};
                        const f32x4 v0 = acc[ai][bj][m][0] + b0, v1 = acc[ai][bj][m][1] + b1;
                        q += sq4(v0) + sq4(v1);
                        u32x4 w; w.x = cvt_pk_bf16(v0[0], v0[1]); w.y = cvt_pk_bf16(v0[2], v0[3]); w.z = cvt_pk_bf16(v1[0], v1[1]); w.w = cvt_pk_bf16(v1[2], v1[3]);
                        *(u32x4*)(hb + off) = w;
                        if (ahalo != nullptr && ai == 1 && m == 3) {
                            const int rl = row & 255;
                            if (rl >= 254 && u.pm < 63) *(u32x4*)(ahalo + (size_t)(2 * (u.pm + 1) + (rl - 254)) * DMODEL + col0 + bj * HALF) = w;
                        }
                    }
                    ssq_write(ssq_out, q, row, u.pn * 4 + wc, fq);
                }
                asm volatile("" ::: "memory");
            }
        }
    }
};
struct EpiGate {
    static constexpr bool PERM = true, AFTER_DRAIN = false;
    const float* ssq_in; const bf16_t* base; const bf16_t* pp; bf16_t* dst; float* ssq_out;
    __device__ __forceinline__ void operator()(const f32x4 (&acc)[2][2][4][2], const Unit& u_, int wr, int wc, int fr, int fq) const {
        Unit u; { int pm_ = u_.pm, pn_ = u_.pn; asm volatile("" : "+s"(pm_), "+s"(pn_)); u.pm = pm_; u.pn = pn_; }
        const int row0 = u.pm * BM + wr * 64 + fr, col0 = u.pn * BM + wc * 32 + 8 * fq;
#pragma unroll
        for (int ai = 0; ai < 2; ++ai)
#pragma unroll
            for (int mp = 0; mp < 2; ++mp) {
                u32x4 bw[2][2], pq[2][2]; float rs[2];
#pragma unroll
                for (int mi = 0; mi < 2; ++mi) {
                    const int row = row0 + ai * HALF + (2 * mp + mi) * 16;
#pragma unroll
                    for (int bj = 0; bj < 2; ++bj) { const size_t off = (size_t)row * DMODEL + col0 + bj * HALF; bw[mi][bj] = *(const u32x4*)(base + off); pq[mi][bj] = *(const u32x4*)(pp + off); }
                }
#pragma unroll
                for (int mi = 0; mi < 2; ++mi) rs[mi] = row_rstd(ssq_in, row0 + ai * HALF + (2 * mp + mi) * 16);
                asm volatile("" ::: "memory");
#pragma unroll
                for (int mi = 0; mi < 2; ++mi) {
                    const int m = 2 * mp + mi; const int row = row0 + ai * HALF + m * 16; float q = 0.f;
#pragma unroll
                    for (int bj = 0; bj < 2; ++bj) {
                        const size_t off = (size_t)row * DMODEL + col0 + bj * HALF;
                        const u32x4 b_ = bw[mi][bj], p_ = pq[mi][bj];
                        const float bb[8] = {bf_lo(b_.x), bf_hi(b_.x), bf_lo(b_.y), bf_hi(b_.y), bf_lo(b_.z), bf_hi(b_.z), bf_lo(b_.w), bf_hi(b_.w)};
                        const float pv[8] = {bf_lo(p_.x), bf_hi(p_.x), bf_lo(p_.y), bf_hi(p_.y), bf_lo(p_.z), bf_hi(p_.z), bf_lo(p_.w), bf_hi(p_.w)};
                        const f32x4 g0 = acc[ai][bj][m][0] * rs[mi], g1 = acc[ai][bj][m][1] * rs[mi];
                        const float gg[8] = {g0[0], g0[1], g0[2], g0[3], g1[0], g1[1], g1[2], g1[3]};
                        float v[8];
#pragma unroll
                        for (int i = 0; i < 8; ++i) { v[i] = bb[i] + pv[i] * sigmoid_f(gg[i]); q += v[i] * v[i]; }
                        u32x4 w; w.x = cvt_pk_bf16(v[0], v[1]); w.y = cvt_pk_bf16(v[2], v[3]); w.z = cvt_pk_bf16(v[4], v[5]); w.w = cvt_pk_bf16(v[6], v[7]);
                        *(u32x4*)(dst + off) = w;
                    }
                    ssq_write(ssq_out, q, row, u.pn * 4 + wc, fq);
                }
                asm volatile("" ::: "memory");
            }
    }
};
struct EpiGateFinal {
    static constexpr bool PERM = true, AFTER_DRAIN = false;
    const float* ssq_in; const bf16_t* base; const bf16_t* pp; float* ssq_out; unsigned* cnt; const float* gain; float* outp; PG8_LAS float* rtab;
    __device__ __forceinline__ void operator()(const f32x4 (&acc)[2][2][4][2], const Unit& u_, int wr, int wc, int fr, int fq) const {
        Unit u; { int pm_ = u_.pm, pn_ = u_.pn; asm volatile("" : "+s"(pm_), "+s"(pn_)); u.pm = pm_; u.pn = pn_; }
        const int row0 = u.pm * BM + wr * 64 + fr, col0 = u.pn * BM + wc * 32 + 8 * fq;
        f32x4 hv[2][2][4][2];
#pragma unroll
        for (int ai = 0; ai < 2; ++ai)
#pragma unroll
            for (int mp = 0; mp < 2; ++mp) {
                u32x4 bw[2][2], pq[2][2]; float rs[2];
#pragma unroll
                for (int mi = 0; mi < 2; ++mi) {
                    const int row = row0 + ai * HALF + (2 * mp + mi) * 16;
#pragma unroll
                    for (int bj = 0; bj < 2; ++bj) { const size_t off = (size_t)row * DMODEL + col0 + bj * HALF; bw[mi][bj] = *(const u32x4*)(base + off); pq[mi][bj] = *(const u32x4*)(pp + off); }
                }
#pragma unroll
                for (int mi = 0; mi < 2; ++mi) rs[mi] = row_rstd(ssq_in, row0 + ai * HALF + (2 * mp + mi) * 16);
                asm volatile("" ::: "memory");
#pragma unroll
                for (int mi = 0; mi < 2; ++mi) {
                    const int m = 2 * mp + mi; const int row = row0 + ai * HALF + m * 16; float q = 0.f;
#pragma unroll
                    for (int bj = 0; bj < 2; ++bj) {
                        const u32x4 b_ = bw[mi][bj], p_ = pq[mi][bj];
                        const float bb[8] = {bf_lo(b_.x), bf_hi(b_.x), bf_lo(b_.y), bf_hi(b_.y), bf_lo(b_.z), bf_hi(b_.z), bf_lo(b_.w), bf_hi(b_.w)};
                        const float pv[8] = {bf_lo(p_.x), bf_hi(p_.x), bf_lo(p_.y), bf_hi(p_.y), bf_lo(p_.z), bf_hi(p_.z), bf_lo(p_.w), bf_hi(p_.w)};
                        const f32x4 g0 = acc[ai][bj][m][0] * rs[mi], g1 = acc[ai][bj][m][1] * rs[mi];
                        const float gg[8] = {g0[0], g0[1], g0[2], g0[3], g1[0], g1[1], g1[2], g1[3]};
                        float v[8];
#pragma unroll
                        for (int i = 0; i < 8; ++i) { v[i] = bb[i] + pv[i] * sigmoid_f(gg[i]); q += v[i] * v[i]; }
                        hv[ai][bj][m][0] = (f32x4){v[0], v[1], v[2], v[3]}; hv[ai][bj][m][1] = (f32x4){v[4], v[5], v[6], v[7]};
                    }
                    ssq_write(ssq_out, q, row, u.pn * 4 + wc, fq);
                }
                asm volatile("" ::: "memory");
            }
        asm volatile("s_waitcnt vmcnt(0)" ::: "memory"); __builtin_amdgcn_s_barrier(); asm volatile("" ::: "memory");
        if (wr == 0 && wc == 0) {
            if (fr == 0 && fq == 0) {
                __builtin_amdgcn_fence(__ATOMIC_RELEASE, "agent");
                asm volatile("s_waitcnt vmcnt(0)" ::: "memory");
                __hip_atomic_fetch_add(cnt + 64 * u.pm, 1u, __ATOMIC_RELAXED, __HIP_MEMORY_SCOPE_AGENT);
            }
            unsigned sp = 0;
            while (__hip_atomic_load(cnt + 64 * u.pm, __ATOMIC_RELAXED, __HIP_MEMORY_SCOPE_AGENT) < 4u) { __builtin_amdgcn_s_sleep(2); if (++sp > (1u << 22)) break; }
        }
        asm volatile("" ::: "memory"); __builtin_amdgcn_s_barrier(); asm volatile("" ::: "memory");
        if (wr == 0) rtab[wc * 64 + fq * 16 + fr] = row_rstd_coh(ssq_out, u.pm * BM + wc * 64 + fq * 16 + fr);
        asm volatile("s_waitcnt lgkmcnt(0)" ::: "memory"); __builtin_amdgcn_s_barrier(); asm volatile("" ::: "memory");
        f32x4 gn[2][2];
#pragma unroll
        for (int bj = 0; bj < 2; ++bj)
#pragma unroll
            for (int n = 0; n < 2; ++n) gn[bj][n] = *(const f32x4*)(gain + col0 + bj * HALF + 4 * n);
#pragma unroll
        for (int ai = 0; ai < 2; ++ai)
#pragma unroll
            for (int m = 0; m < 4; ++m) {
                const float rsf = rtab[ai * HALF + wr * 64 + m * 16 + fr];
                float* orow = outp + (size_t)(row0 + ai * HALF + m * 16) * DMODEL + col0;
#pragma unroll
                for (int bj = 0; bj < 2; ++bj)
#pragma unroll
                    for (int n = 0; n < 2; ++n) *(f32x4*)(orow + bj * HALF + 4 * n) = hv[ai][bj][m][n] * rsf * gn[bj][n];
            }
    }
};
struct EpiBf16Plain {
    static constexpr bool PERM = true, AFTER_DRAIN = false;
    bf16_t* O; int ldc;
    __device__ __forceinline__ void operator()(const f32x4 (&acc)[2][2][4][2], const Unit& u_, int wr, int wc, int fr, int fq) const {
        Unit u; { int pm_ = u_.pm, pn_ = u_.pn; asm volatile("" : "+s"(pm_), "+s"(pn_)); u.pm = pm_; u.pn = pn_; }
        const int row0 = u.pm * BM + wr * 64 + fr, col0 = u.pn * BM + wc * 32 + 8 * fq;
#pragma unroll
        for (int ai = 0; ai < 2; ++ai)
#pragma unroll
            for (int m = 0; m < 4; ++m) {
                const int row = row0 + ai * HALF + m * 16;
#pragma unroll
                for (int bj = 0; bj < 2; ++bj) {
                    const f32x4 v0 = acc[ai][bj][m][0], v1 = acc[ai][bj][m][1];
                    u32x4 w; w.x = cvt_pk_bf16(v0[0], v0[1]); w.y = cvt_pk_bf16(v0[2], v0[3]); w.z = cvt_pk_bf16(v1[0], v1[1]); w.w = cvt_pk_bf16(v1[2], v1[3]);
                    *(u32x4*)(O + (size_t)row * ldc + col0 + bj * HALF) = w;
                }
            }
    }
};
struct EpiEvenIn {
    static constexpr bool PERM = true, AFTER_DRAIN = false;
    const float* ssq_in; bf16_t* Z; const f32x2* rope;
    __device__ __forceinline__ void operator()(const f32x4 (&acc)[2][2][4][2], const Unit& u_, int wr, int wc, int fr, int fq) const {
        Unit u; { int pm_ = u_.pm, pn_ = u_.pn; asm volatile("" : "+s"(pm_), "+s"(pn_)); u.pm = pm_; u.pn = pn_; }
        const int row0 = u.pm * BM + wr * 64 + fr, colw = wc * 32 + 8 * fq;
        const int pn = u.pn;
        const float sc = (pn == 2 || pn == 3) ? C2 : 1.0f;
#pragma unroll
        for (int ai = 0; ai < 2; ++ai)
#pragma unroll
            for (int m = 0; m < 4; ++m) {
                const int row = row0 + ai * HALF + m * 16;
                const float rs = row_rstd(ssq_in, row);
#pragma unroll
                for (int bj = 0; bj < 2; ++bj) {
                    const int gi = 2 * bj + (wc >> 1);
                    const bool ropeg = (pn == 2 || pn == 3 || pn == 5 || (pn == 4 && (gi == 0 || gi == 2))) && ((wc & 1) == 0);
                    f32x4 v0 = acc[ai][bj][m][0] * rs, v1 = acc[ai][bj][m][1] * rs;
                    if (ropeg && fq < 2) {
                        const f32x4* rp = (const f32x4*)(rope + (size_t)row * 8 + 4 * fq);
                        const f32x4 ra = rp[0], rb = rp[1];
                        f32x4 o0, o1;
                        o0[0] = v0[0] * ra[0] - v0[1] * ra[1]; o0[1] = v0[1] * ra[0] + v0[0] * ra[1];
                        o0[2] = v0[2] * ra[2] - v0[3] * ra[3]; o0[3] = v0[3] * ra[2] + v0[2] * ra[3];
                        o1[0] = v1[0] * rb[0] - v1[1] * rb[1]; o1[1] = v1[1] * rb[0] + v1[0] * rb[1];
                        o1[2] = v1[2] * rb[2] - v1[3] * rb[3]; o1[3] = v1[3] * rb[2] + v1[2] * rb[3];
                        v0 = o0; v1 = o1;
                    }
                    v0 = v0 * sc; v1 = v1 * sc;
                    u32x4 w; w.x = cvt_pk_bf16(v0[0], v0[1]); w.y = cvt_pk_bf16(v0[2], v0[3]); w.z = cvt_pk_bf16(v1[0], v1[1]); w.w = cvt_pk_bf16(v1[2], v1[3]);
                    *(u32x4*)(Z + (size_t)row * EV_N + pn * BM + bj * HALF + colw) = w;
                }
            }
    }
};
struct EpiOddIn {
    static constexpr bool PERM = true, AFTER_DRAIN = false;
    const float* ssq_in; bf16_t* Z; float* F; float* sst;
    __device__ __forceinline__ void operator()(const f32x4 (&acc)[2][2][4][2], const Unit& u_, int wr, int wc, int fr, int fq) const {
        Unit u; { int pm_ = u_.pm, pn_ = u_.pn; asm volatile("" : "+s"(pm_), "+s"(pn_)); u.pm = pm_; u.pn = pn_; }
        const int row0 = u.pm * BM + wr * 64 + fr, colw = wc * 32 + 8 * fq;
        const int pn = u.pn;
        const float sc = (pn < 2) ? C2 : 1.0f;
        const bool act = (pn >= 6 && pn < 10), stat = (pn == 8 || pn == 9);
#pragma unroll
        for (int ai = 0; ai < 2; ++ai)
#pragma unroll
            for (int m = 0; m < 4; ++m) {
                const int row = row0 + ai * HALF + m * 16;
                const float rs = row_rstd(ssq_in, row);
                if (pn == 10) {
                    if (wc == 0 && fq == 0) { *(f32x4*)(F + (size_t)row * 8) = acc[ai][0][m][0] * rs; *(f32x4*)(F + (size_t)row * 8 + 4) = acc[ai][0][m][1] * rs; }
                    continue;
                }
                float s1 = 0.f, s2 = 0.f;
#pragma unroll
                for (int bj = 0; bj < 2; ++bj) {
                    f32x4 v0 = acc[ai][bj][m][0] * (rs * sc), v1 = acc[ai][bj][m][1] * (rs * sc);
                    if (act) {
#pragma unroll
                        for (int i = 0; i < 4; ++i) { v0[i] = gelu_tanh(v0[i]); v1[i] = gelu_tanh(v1[i]); }
                    }
                    s1 += ((v0[0] + v0[1]) + (v0[2] + v0[3])) + ((v1[0] + v1[1]) + (v1[2] + v1[3])); s2 += sq4(v0) + sq4(v1);
                    u32x4 w; w.x = cvt_pk_bf16(v0[0], v0[1]); w.y = cvt_pk_bf16(v0[2], v0[3]); w.z = cvt_pk_bf16(v1[0], v1[1]); w.w = cvt_pk_bf16(v1[2], v1[3]);
                    *(u32x4*)(Z + (size_t)row * Z1P + pn * BM + bj * HALF + colw) = w;
                }
                if (stat) {
                    s1 += xor16_f(s1); s1 = halves_sum_f(s1); s2 += xor16_f(s2); s2 = halves_sum_f(s2);
                    if (fq == 0) *(f32x2*)(sst + ((size_t)row * 8 + (pn - 8) * 4 + wc) * 2) = (f32x2){s1, s2};
                }
            }
    }
};
struct EpiHalo {
    static constexpr bool PERM = true, AFTER_DRAIN = false;
    const float* ssq_in; float* AH;
    __device__ __forceinline__ void operator()(const f32x4 (&acc)[2][2][4][2], const Unit& u_, int wr, int wc, int fr, int fq) const {
        Unit u; { int pm_ = u_.pm, pn_ = u_.pn; asm volatile("" : "+s"(pm_), "+s"(pn_)); u.pm = pm_; u.pn = pn_; }
        const int col0 = u.pn * BM + wc * 32 + 8 * fq;
#pragma unroll
        for (int m = 0; m < 4; ++m) {
            const int rh = wr * 64 + m * 16 + fr;
            if (rh < 2) continue;
            const int tok = 256 * (rh >> 1) - 2 + (rh & 1);
            const float rs = row_rstd(ssq_in, tok);
#pragma unroll
            for (int bj = 0; bj < 2; ++bj) {
                *(f32x4*)(AH + (size_t)rh * NFF2 + col0 + bj * HALF) = acc[0][bj][m][0] * rs;
                *(f32x4*)(AH + (size_t)rh * NFF2 + col0 + bj * HALF + 4) = acc[0][bj][m][1] * rs;
            }
        }
    }
};
template <int SEL> __device__ __forceinline__ float dpp1(const float old, const float src) {
    const int o = __builtin_bit_cast(int, old), s = __builtin_bit_cast(int, src); int t;
    if (SEL == 0) t = __builtin_amdgcn_update_dpp(o, s, 0x111, 0xf, 0xf, false);
    else if (SEL == 1) t = __builtin_amdgcn_update_dpp(o, s, 0x112, 0xf, 0xf, false);
    else if (SEL == 2) t = __builtin_amdgcn_update_dpp(o, s, 0x10F, 0xf, 0xf, false);
    else t = __builtin_amdgcn_update_dpp(o, s, 0x10E, 0xf, 0xf, false);
    return __builtin_bit_cast(float, t);
}
template <int SEL> __device__ __forceinline__ f32x4 dpp4t(const f32x4 old, const f32x4 src) {
    const float o0 = old[0], o1 = old[1], o2 = old[2], o3 = old[3], s0 = src[0], s1 = src[1], s2 = src[2], s3 = src[3];
    const float r0 = dpp1<SEL>(o0, s0), r1 = dpp1<SEL>(o1, s1), r2 = dpp1<SEL>(o2, s2), r3 = dpp1<SEL>(o3, s3);
    return (f32x4){r0, r1, r2, r3};
}
#define dpp4(old, src, sel) dpp4t<sel>(old, src)
__device__ __forceinline__ void conv_taps(f32x4& c, const f32x4 cur, const f32x4 prev, const f32x4 w0, const f32x4 w1) {
    float c0 = c[0], c1 = c[1], c2 = c[2], c3 = c[3];
    const float x0 = cur[0], x1 = cur[1], x2 = cur[2], x3 = cur[3], p0 = prev[0], p1 = prev[1], p2 = prev[2], p3 = prev[3];
    const float a0 = w1[0], a1 = w1[1], a2 = w1[2], a3 = w1[3], b0 = w0[0], b1 = w0[1], b2 = w0[2], b3 = w0[3];
    asm("s_nop 4\n\t"
        "v_fmac_f32_dpp %0, %4, %12 row_shr:1 row_mask:0xf bank_mask:0xf bound_ctrl:1\n\t"
        "v_fmac_f32_dpp %1, %5, %13 row_shr:1 row_mask:0xf bank_mask:0xf bound_ctrl:1\n\t"
        "v_fmac_f32_dpp %2, %6, %14 row_shr:1 row_mask:0xf bank_mask:0xf bound_ctrl:1\n\t"
        "v_fmac_f32_dpp %3, %7, %15 row_shr:1 row_mask:0xf bank_mask:0xf bound_ctrl:1\n\t"
        "v_fmac_f32_dpp %0, %4, %16 row_shr:2 row_mask:0xf bank_mask:0xf bound_ctrl:1\n\t"
        "v_fmac_f32_dpp %1, %5, %17 row_shr:2 row_mask:0xf bank_mask:0xf bound_ctrl:1\n\t"
        "v_fmac_f32_dpp %2, %6, %18 row_shr:2 row_mask:0xf bank_mask:0xf bound_ctrl:1\n\t"
        "v_fmac_f32_dpp %3, %7, %19 row_shr:2 row_mask:0xf bank_mask:0xf bound_ctrl:1\n\t"
        "v_fmac_f32_dpp %0, %8, %12 row_shl:15 row_mask:0xf bank_mask:0xf bound_ctrl:1\n\t"
        "v_fmac_f32_dpp %1, %9, %13 row_shl:15 row_mask:0xf bank_mask:0xf bound_ctrl:1\n\t"
        "v_fmac_f32_dpp %2, %10, %14 row_shl:15 row_mask:0xf bank_mask:0xf bound_ctrl:1\n\t"
        "v_fmac_f32_dpp %3, %11, %15 row_shl:15 row_mask:0xf bank_mask:0xf bound_ctrl:1\n\t"
        "v_fmac_f32_dpp %0, %8, %16 row_shl:14 row_mask:0xf bank_mask:0xf bound_ctrl:1\n\t"
        "v_fmac_f32_dpp %1, %9, %17 row_shl:14 row_mask:0xf bank_mask:0xf bound_ctrl:1\n\t"
        "v_fmac_f32_dpp %2, %10, %18 row_shl:14 row_mask:0xf bank_mask:0xf bound_ctrl:1\n\t"
        "v_fmac_f32_dpp %3, %11, %19 row_shl:14 row_mask:0xf bank_mask:0xf bound_ctrl:1"
        : "+v"(c0), "+v"(c1), "+v"(c2), "+v"(c3)
        : "v"(x0), "v"(x1), "v"(x2), "v"(x3), "v"(p0), "v"(p1), "v"(p2), "v"(p3), "v"(a0), "v"(a1), "v"(a2), "v"(a3), "v"(b0), "v"(b1), "v"(b2), "v"(b3));
    c[0] = c0; c[1] = c1; c[2] = c2; c[3] = c3;
}
struct EpiHaloF {
    static constexpr bool PERM = true, AFTER_DRAIN = false;
    const float* ssq_in; float* ah; unsigned* flags;
    __device__ __forceinline__ void operator()(const f32x4 (&acc)[2][2][4][2], const Unit& u_, int wr, int wc, int fr, int fq) const {
        Unit u; { int pm_ = u_.pm, pn_ = u_.pn; asm volatile("" : "+s"(pm_), "+s"(pn_)); u.pm = pm_; u.pn = pn_; }
        const int col0 = u.pn * BM + wc * 32 + 8 * fq;
#pragma unroll
        for (int m = 0; m < 4; ++m) {
            const int rh = wr * 64 + m * 16 + fr;
            if (rh >= 2) {
                const int tok = 256 * (rh >> 1) - 2 + (rh & 1);
                const float rsh = row_rstd(ssq_in, tok);
#pragma unroll
                for (int bj = 0; bj < 2; ++bj) {
                    *(f32x4*)(ah + (size_t)rh * NFF2 + col0 + bj * HALF) = acc[0][bj][m][0] * rsh;
                    *(f32x4*)(ah + (size_t)rh * NFF2 + col0 + bj * HALF + 4) = acc[0][bj][m][1] * rsh;
                }
            }
        }
        asm volatile("s_waitcnt vmcnt(0)" ::: "memory"); __builtin_amdgcn_s_barrier(); asm volatile("" ::: "memory");
        if (wr == 0 && wc == 0 && fr == 0 && fq == 0) {
            __builtin_amdgcn_fence(__ATOMIC_RELEASE, "agent");
            asm volatile("s_waitcnt vmcnt(0)" ::: "memory");
            __hip_atomic_store(flags + 64 * u.pn, 1u, __ATOMIC_RELAXED, __HIP_MEMORY_SCOPE_AGENT);
        }
    }
};
struct EpiFfnIn {
    static constexpr bool PERM = true, AFTER_DRAIN = false;
    const float* ssq_in; const float* cw; const float* cb; float* ah; bf16_t* hid; PG8_LAS float* xb; unsigned* flags; unsigned phase_id;
    __device__ __forceinline__ void operator()(const f32x4 (&acc)[2][2][4][2], const Unit& u_, int wr, int wc, int fr, int fq) const {
        Unit u; { int pm_ = u_.pm, pn_ = u_.pn; asm volatile("" : "+s"(pm_), "+s"(pn_)); u.pm = pm_; u.pn = pn_; }
        PG8_LAS float* rtab = xb + 2048;
        const int row0 = u.pm * BM + wr * 64 + fr;
        PG8_LAS float* cwl = xb + 2432 + wc * 256;
        PG8_LAS float* hl = xb + 3456 + wc * 128;
        if (wr == 0) {
            const float* src = (fq < 3 ? cw + fq * NFF2 : cb) + (fr >> 3) * DFF + 128 * u.pn + wc * 32 + (fr & 7) * 4;
            const f32x4 wv = *(const f32x4*)src;
            rtab[wc * 64 + fq * 16 + fr] = row_rstd(ssq_in, u.pm * BM + wc * 64 + fq * 16 + fr);
            *(PG8_LAS f32x4*)(cwl + (fq * 16 + fr) * 4) = wv;
        }
        if (fr >= 14) {
#pragma unroll
            for (int ai = 0; ai < 2; ++ai) {
                PG8_LAS f32x4* dst = (PG8_LAS f32x4*)(xb + ((((ai * 2 + wr) * 4 + wc) * 2 + (fr - 14)) * 4 + fq) * 16);
#pragma unroll
                for (int bj = 0; bj < 2; ++bj)
#pragma unroll
                    for (int n = 0; n < 2; ++n) dst[bj * 2 + n] = acc[ai][bj][3][n];
            }
        }
        asm volatile("s_waitcnt lgkmcnt(0)" ::: "memory"); __builtin_amdgcn_s_barrier(); asm volatile("" ::: "memory");
        const bool has = (u.pm & 7) != 0;
        if (wr == 0) {
            PG8_LAS unsigned* stamp = (PG8_LAS unsigned*)(rtab + 256);
            if (*(volatile PG8_LAS unsigned*)stamp != phase_id) {
                if (wc == 0) {
                    unsigned sp = 0;
                    for (int t = 0; t < NFF2 / BM; ++t)
                        while (__hip_atomic_load(flags + 64 * t, __ATOMIC_RELAXED, __HIP_MEMORY_SCOPE_AGENT) == 0u) { __builtin_amdgcn_s_sleep(2); if (++sp > (1u << 22)) break; }
                    asm volatile("s_waitcnt vmcnt(0)" ::: "memory");
                    if (fr == 0 && fq == 0) *(volatile PG8_LAS unsigned*)stamp = phase_id;
                } else {
                    unsigned sp = 0;
                    while (*(volatile PG8_LAS unsigned*)stamp != phase_id) { __builtin_amdgcn_s_sleep(2); if (++sp > (1u << 22)) break; }
                }
            }
        }
        if (wr == 0) {
            f32x2 hv = {0.f, 0.f};
            if (has) hv = *(const f32x2*)(ah + (size_t)(2 * u.pm + (fq >> 1)) * NFF2 + (size_t)u.pn * BM + (fq & 1) * HALF + wc * 32 + 2 * fr);
            *(PG8_LAS f32x2*)(hl + (fq * 16 + fr) * 2) = hv;
        }
        float rs[2][4];
#pragma unroll
        for (int ai = 0; ai < 2; ++ai)
#pragma unroll
            for (int m = 0; m < 4; ++m) rs[ai][m] = rtab[ai * HALF + wr * 64 + m * 16 + fr];
        const f32x4 zero4 = {0.f, 0.f, 0.f, 0.f};
#pragma unroll
        for (int ai = 0; ai < 2; ++ai) {
#pragma unroll
            for (int n = 0; n < 2; ++n) {
                f32x4 cg[4];
#pragma unroll
                for (int bj = 0; bj < 2; ++bj) {
                    f32x4 b0, b1;
                    if (ai == 0 && wr == 0) {
                        b0 = *(const PG8_LAS f32x4*)(hl + (0 * 2 + bj) * 32 + 8 * fq + 4 * n);
                        b1 = *(const PG8_LAS f32x4*)(hl + (1 * 2 + bj) * 32 + 8 * fq + 4 * n);
                    } else {
                        const int sa = (wr == 1) ? ai : ai - 1, sw = (wr == 1) ? 0 : 1;
                        const float r0 = rtab[sa * HALF + sw * 64 + 62], r1 = rtab[sa * HALF + sw * 64 + 63];
                        b0 = *(const PG8_LAS f32x4*)(xb + ((((sa * 2 + sw) * 4 + wc) * 2 + 0) * 4 + fq) * 16 + (bj * 2 + n) * 4) * r0;
                        b1 = *(const PG8_LAS f32x4*)(xb + ((((sa * 2 + sw) * 4 + wc) * 2 + 1) * 4 + fq) * 16 + (bj * 2 + n) * 4) * r1;
                    }
                    const int oc = bj * 32 + 8 * fq + 4 * n;
                    const f32x4 w0 = *(const PG8_LAS f32x4*)(cwl + oc), w1 = *(const PG8_LAS f32x4*)(cwl + 64 + oc), w2 = *(const PG8_LAS f32x4*)(cwl + 128 + oc), bb = *(const PG8_LAS f32x4*)(cwl + 192 + oc);
                    f32x4 prev = (fr == 14) ? b0 : b1;
#pragma unroll
                    for (int m = 0; m < 4; ++m) {
                        const f32x4 cur = acc[ai][bj][m][n] * rs[ai][m];
                        f32x4 c = w2 * cur + bb;
                        conv_taps(c, cur, prev, w0, w1);
                        prev = cur;
                        if (bj == 0) cg[m] = c;
                        else {
                            const f32x2 ha = gelu_mul2((f32x2){cg[m][0], cg[m][1]}, (f32x2){c[0], c[1]}), hb = gelu_mul2((f32x2){cg[m][2], cg[m][3]}, (f32x2){c[2], c[3]});
                            u32x2 w; w.x = cvt_pk_bf16(ha.x, ha.y); w.y = cvt_pk_bf16(hb.x, hb.y);
                            const int row = row0 + ai * HALF + m * 16;
                            *(u32x2*)(hid + (size_t)row * DFF + 128 * u.pn + wc * 32 + 8 * fq + 4 * n) = w;
                        }
                    }
                    asm volatile("" ::: "memory");
                }
            }
        }
    }
};
template <class Epi, class Sched, bool ALIGN_EPI = false, bool SP2 = false>
__device__ __forceinline__ void gemm_phase(PG8_LAS unsigned char* lds, const Gemm g, const Sched& S, const Epi& E, const int wave_s) {
    const int tid_ = wave_s * 64 + lane_opaque(); const int tid = tid_, wid = __builtin_amdgcn_readfirstlane(tid >> 6), lane = tid & 63, wr = wid >> 2, wc = wid & 3, fr = lane & 15, fq = lane >> 4;
    const int K = g.K, nt = K / BK;
    unsigned voffA[2], voffB[2];
#pragma unroll
    for (int i = 0; i < 2; ++i) { int R, C; stage_rc(tid * 16 + i * 8192, R, C); const int Rb = Epi::PERM ? ((R & ~31) + perm32(R & 31)) : R;
        voffA[i] = (unsigned)(R * K + C) * 2u; voffB[i] = (unsigned)(Rb * K + C) * 2u; }
    const size_t kstep = (size_t)(BK * 2);
    const size_t hstep = (size_t)HALF * K * 2;
    const size_t tstep = 2 * hstep;
    const unsigned ldsw = (unsigned)wid * 1024u;
    const int aoff = lds_byte(wr * 64 + fr, fq * 8), boff = lds_byte(wc * 32 + fr, fq * 8);
#define PG8_SA(b, h) (((b) * 2 + (h)) * HTB)
#define PG8_SB(b, h) ((4 + (b) * 2 + (h)) * HTB)
#define PG8_STAGE(bufoff, gbase, voff) do { _Pragma("unroll") for (int _i = 0; _i < 2; ++_i) \
        __builtin_amdgcn_global_load_lds((const unsigned*)((const char*)(gbase) + (voff)[_i]), (PG8_LAS unsigned*)(lds + (bufoff) + ldsw + _i * 8192), 16, 0, 0); } while (0)
#define PG8_LDA(dst, b, h) do { _Pragma("unroll") for (int m = 0; m < 4; ++m) _Pragma("unroll") for (int k = 0; k < 2; ++k) dst[m][k] = *(const PG8_LAS bf16x8*)(lds + PG8_SA(b, h) + aoff + m * 2048 + k * 1024); } while (0)
#define PG8_LDB(dst, b, h) do { _Pragma("unroll") for (int n = 0; n < 2; ++n) _Pragma("unroll") for (int k = 0; k < 2; ++k) dst[n][k] = *(const PG8_LAS bf16x8*)(lds + PG8_SB(b, h) + boff + n * 2048 + k * 1024); } while (0)
#define PG8_MMA(ai, bj, At, Bt) do { __builtin_amdgcn_s_setprio(1); _Pragma("unroll") for (int m = 0; m < 4; ++m) _Pragma("unroll") for (int n = 0; n < 2; ++n) _Pragma("unroll") for (int k = 0; k < 2; ++k) \
        acc[ai][bj][m][n] = __builtin_amdgcn_mfma_f32_16x16x32_bf16(Bt[n][k], At[m][k], acc[ai][bj][m][n], 0, 0, 0); __builtin_amdgcn_s_setprio(0); } while (0)
#define PG8_WAIT_V(n) asm volatile("s_waitcnt vmcnt(" #n ")" ::: "memory")
#define PG8_WAIT_L(n) asm volatile("s_waitcnt lgkmcnt(" #n ")" ::: "memory")
#define PG8_BAR __builtin_amdgcn_s_barrier()
#define PG8_SCHED __builtin_amdgcn_sched_barrier(0)
    Unit cur, nxt; int ui = 0;
    if (!S.next(0, cur)) return;
    f32x4 acc[2][2][4][2];
#pragma unroll
    for (int a = 0; a < 2; ++a)
#pragma unroll
        for (int b = 0; b < 2; ++b)
#pragma unroll
            for (int m = 0; m < 4; ++m)
#pragma unroll
                for (int n = 0; n < 2; ++n) acc[a][b][m][n] = (f32x4){0.f, 0.f, 0.f, 0.f};
    bf16x8 At[4][2], B0[2][2], B1[2][2];
    const char* cA = (const char*)g.A + (size_t)cur.pm * tstep; const char* cB = (const char*)g.Bt + (size_t)cur.pn * tstep;
    S.a_ready(cur);
    if constexpr (SP2) {
        PG8_STAGE(PG8_SB(0, 0), cB, voffB); PG8_STAGE(PG8_SB(0, 1), cB + hstep, voffB); PG8_STAGE(PG8_SA(0, 0), cA, voffA); PG8_STAGE(PG8_SA(0, 1), cA + hstep, voffA);
        if (wr == 1) PG8_BAR;
        PG8_WAIT_V(2); PG8_BAR;
        PG8_STAGE(PG8_SB(1, 0), cB + kstep, voffB); PG8_STAGE(PG8_SA(1, 0), cA + kstep, voffA); PG8_STAGE(PG8_SB(1, 1), cB + hstep + kstep, voffB);
        PG8_WAIT_V(6); PG8_BAR;
    } else {
        PG8_STAGE(PG8_SB(0, 0), cB, voffB); PG8_STAGE(PG8_SA(0, 0), cA, voffA); PG8_STAGE(PG8_SB(0, 1), cB + hstep, voffB); PG8_STAGE(PG8_SA(0, 1), cA + hstep, voffA);
        if (wr == 1) PG8_BAR;
        PG8_WAIT_V(4); PG8_BAR;
        PG8_STAGE(PG8_SB(1, 0), cB + kstep, voffB); PG8_STAGE(PG8_SA(1, 0), cA + kstep, voffA); PG8_STAGE(PG8_SB(1, 1), cB + hstep + kstep, voffB);
        PG8_WAIT_V(6); PG8_BAR;
    }
    for (;;) {
        const bool has_next = S.next(ui + 1, nxt);
        const char* nA = has_next ? (const char*)g.A + (size_t)nxt.pm * tstep : cA; const char* nB = has_next ? (const char*)g.Bt + (size_t)nxt.pn * tstep : cB;
        for (int t = 0; t < nt; t += 2) {
            const bool last = (t == nt - 2);
            const char* a1 = cA + (size_t)(t + 1) * kstep;
            const char* a2 = last ? nA : cA + (size_t)(t + 2) * kstep; const char* b2 = last ? nB : cB + (size_t)(t + 2) * kstep;
            const char* a3 = a2 + kstep; const char* b3 = b2 + kstep;
            if (last && has_next) S.a_ready(nxt);
            if constexpr (SP2) {
            PG8_LDB(B0, 0, 0); PG8_LDB(B1, 0, 1); PG8_SCHED; PG8_LDA(At, 0, 0); PG8_STAGE(PG8_SA(1, 1), a1 + hstep, voffA);
            PG8_WAIT_V(8); PG8_WAIT_L(0); PG8_BAR; PG8_MMA(0, 0, At, B0); PG8_MMA(0, 1, At, B1); PG8_BAR; PG8_SCHED;
            PG8_LDA(At, 0, 1); PG8_STAGE(PG8_SB(0, 0), b2, voffB); PG8_STAGE(PG8_SB(0, 1), b2 + hstep, voffB); PG8_STAGE(PG8_SA(0, 0), a2, voffA);
            PG8_WAIT_V(8); PG8_WAIT_L(0); PG8_BAR; PG8_MMA(1, 0, At, B0); PG8_MMA(1, 1, At, B1); PG8_BAR; PG8_SCHED;
            PG8_LDB(B0, 1, 0); PG8_LDB(B1, 1, 1); PG8_SCHED; PG8_LDA(At, 1, 0); PG8_STAGE(PG8_SA(0, 1), a2 + hstep, voffA);
            PG8_WAIT_V(8); PG8_WAIT_L(0); PG8_BAR; PG8_MMA(0, 0, At, B0); PG8_MMA(0, 1, At, B1); PG8_BAR; PG8_SCHED;
            PG8_LDA(At, 1, 1); PG8_STAGE(PG8_SB(1, 0), b3, voffB); PG8_STAGE(PG8_SB(1, 1), b3 + hstep, voffB); PG8_STAGE(PG8_SA(1, 0), a3, voffA);
            PG8_WAIT_V(8); PG8_WAIT_L(0); PG8_BAR; PG8_MMA(1, 0, At, B0); PG8_MMA(1, 1, At, B1); PG8_BAR; PG8_SCHED;
            } else {
            PG8_LDB(B0, 0, 0); PG8_SCHED; PG8_LDA(At, 0, 0); PG8_STAGE(PG8_SA(1, 1), a1 + hstep, voffA);
            PG8_WAIT_L(8); PG8_BAR; PG8_WAIT_L(0); PG8_MMA(0, 0, At, B0); PG8_BAR; PG8_SCHED;
            PG8_LDB(B1, 0, 1); PG8_STAGE(PG8_SB(0, 0), b2, voffB);
            PG8_BAR; PG8_WAIT_L(0); PG8_MMA(0, 1, At, B1); PG8_BAR;
            PG8_LDA(At, 0, 1); PG8_STAGE(PG8_SA(0, 0), a2, voffA);
            PG8_BAR; PG8_WAIT_L(0); PG8_MMA(1, 0, At, B0); PG8_BAR; PG8_SCHED;
            PG8_STAGE(PG8_SB(0, 1), b2 + hstep, voffB);
            PG8_WAIT_V(6); PG8_BAR; PG8_MMA(1, 1, At, B1); PG8_BAR;
            PG8_LDB(B0, 1, 0); PG8_SCHED; PG8_LDA(At, 1, 0); PG8_STAGE(PG8_SA(0, 1), a2 + hstep, voffA);
            PG8_WAIT_L(8); PG8_BAR; PG8_WAIT_L(0); PG8_MMA(0, 0, At, B0); PG8_BAR; PG8_SCHED;
            PG8_LDB(B1, 1, 1); PG8_STAGE(PG8_SB(1, 0), b3, voffB);
            PG8_BAR; PG8_WAIT_L(0); PG8_MMA(0, 1, At, B1); PG8_BAR;
            PG8_LDA(At, 1, 1); PG8_STAGE(PG8_SA(1, 0), a3, voffA);
            PG8_BAR; PG8_WAIT_L(0); PG8_MMA(1, 0, At, B0); PG8_BAR; PG8_SCHED;
            PG8_STAGE(PG8_SB(1, 1), b3 + hstep, voffB);
            PG8_WAIT_V(6); PG8_BAR; PG8_MMA(1, 1, At, B1); PG8_BAR;
            }
        }
        if constexpr (ALIGN_EPI) { if (wr == 0) PG8_BAR; }
        if constexpr (!Epi::AFTER_DRAIN) { E(acc, cur, wr, wc, fr, fq); S.done(cur); }
        if (!has_next) break;
#pragma unroll
        for (int a = 0; a < 2; ++a)
#pragma unroll
            for (int b = 0; b < 2; ++b)
#pragma unroll
                for (int m = 0; m < 4; ++m)
#pragma unroll
                    for (int n = 0; n < 2; ++n) acc[a][b][m][n] = (f32x4){0.f, 0.f, 0.f, 0.f};
        cur = nxt; cA = nA; cB = nB; ++ui;
        if constexpr (ALIGN_EPI) { if (wr == 1) PG8_BAR; }
    }
    PG8_WAIT_V(0);
    if constexpr (!ALIGN_EPI) { if (wr == 0) PG8_BAR; }
    PG8_BAR;
    if constexpr (Epi::AFTER_DRAIN) { E.fused(acc, cur, wr, wc, fr, fq, lds, wid, lane); S.done(cur); }
#undef PG8_SA
#undef PG8_SB
#undef PG8_STAGE
#undef PG8_LDA
#undef PG8_LDB
#undef PG8_MMA
#undef PG8_WAIT_V
#undef PG8_WAIT_L
#undef PG8_BAR
#undef PG8_SCHED
}
}
namespace mix {
#define MLAS __attribute__((address_space(3)))
typedef unsigned short bf16_t;
typedef short bf16x8 __attribute__((ext_vector_type(8)));
typedef short s16x4 __attribute__((ext_vector_type(4)));
typedef float f32x16 __attribute__((ext_vector_type(16)));
typedef float f32x4 __attribute__((ext_vector_type(4)));
typedef float f32x2 __attribute__((ext_vector_type(2)));
typedef unsigned u32x4 __attribute__((ext_vector_type(4)));
typedef unsigned u32x2 __attribute__((ext_vector_type(2)));
typedef MLAS const char* lds_cptr;
typedef short v4i16_t __attribute__((ext_vector_type(4)));
typedef __bf16 bf16x2_t __attribute__((ext_vector_type(2)));

constexpr int SLOTB = 8192;
constexpr int NSLOT = 4;
constexpr int L_K = 0, L_V = NSLOT * SLOTB, L_WSF = 2 * NSLOT * SLOTB, L_OST = L_WSF + 8 * 256, L_X = L_OST + 8 * 4096;
constexpr int LX_IQ = L_X, LX_EQ = L_X, LX_PFX = L_X + 8192, LX_CNT = LX_IQ + 16384, LX_GT = LX_CNT + 2048, LX_SEL = LX_GT, LX_END = LX_GT + 8192;
static_assert(LX_END <= 131072, "mixer LDS map");

__device__ __forceinline__ int crow(int r, int hi) { return (r & 3) + 8 * (r >> 2) + 4 * hi; }
__device__ __forceinline__ void glds16(const void* gsrc, unsigned lds_dst) { unsigned keep;
    asm volatile("s_mov_b32 %0, m0\n\ts_mov_b32 m0, %2\n\ts_nop 0\n\tglobal_load_lds_dwordx4 %1, off\n\ts_mov_b32 m0, %0" : "=&s"(keep) : "v"(gsrc), "s"(lds_dst) : "memory"); }
__device__ __forceinline__ unsigned cvtpk(float lo, float hi) { f32x2 v = {lo, hi}; bf16x2_t b = __builtin_convertvector(v, bf16x2_t); return __builtin_bit_cast(unsigned, b); }
__device__ __forceinline__ s16x4 vtr(lds_cptr p) { return __builtin_bit_cast(s16x4, __builtin_amdgcn_ds_read_tr16_b64_v4i16((MLAS v4i16_t*)p)); }
#define WAITV_BAR() asm volatile("s_waitcnt vmcnt(0) lgkmcnt(0)\n\ts_barrier" ::: "memory")
#define LGKM_BAR() asm volatile("s_waitcnt lgkmcnt(0)\n\ts_barrier" ::: "memory")
#define WAITV2_BAR() asm volatile("s_waitcnt vmcnt(2) lgkmcnt(0)\n\ts_barrier" ::: "memory")

__device__ __forceinline__ void dma_kv(const bf16_t* kbase, const bf16_t* vbase, int pitch, unsigned lds0, int slot, int wid, int lane) {
    const bf16_t* ks = kbase + (size_t)lane * pitch + wid * 8;
    const bf16_t* vs = vbase + (size_t)(16 * (wid & 3) + (lane >> 2)) * pitch + (wid >> 2) * 32 + (lane & 3) * 8;
    glds16(ks, (unsigned)__builtin_amdgcn_readfirstlane(lds0 + L_K + slot * SLOTB + wid * 1024));
    glds16(vs, (unsigned)__builtin_amdgcn_readfirstlane(lds0 + L_V + slot * SLOTB + wid * 1024));
}
__device__ __forceinline__ void kload(bf16x8 (&kf)[8], lds_cptr kslot, int r32, int hi) {
    lds_cptr kb = kslot + hi * 1024 + r32 * 16;
#pragma unroll
    for (int d0 = 0; d0 < 4; ++d0) { kf[2 * d0] = *(const MLAS bf16x8*)(kb + d0 * 2048); kf[2 * d0 + 1] = *(const MLAS bf16x8*)(kb + d0 * 2048 + 512); }
}
__device__ __forceinline__ void qkt_mma(f32x16& p0, f32x16& p1, const bf16x8 (&kf)[8], const bf16x8* qr, const f32x16& cinit) {
    p0 = __builtin_amdgcn_mfma_f32_32x32x16_bf16(kf[0], qr[0], cinit, 0, 0, 0); p1 = __builtin_amdgcn_mfma_f32_32x32x16_bf16(kf[1], qr[0], cinit, 0, 0, 0);
#pragma unroll
    for (int d0 = 1; d0 < 4; ++d0) { p0 = __builtin_amdgcn_mfma_f32_32x32x16_bf16(kf[2 * d0], qr[d0], p0, 0, 0, 0); p1 = __builtin_amdgcn_mfma_f32_32x32x16_bf16(kf[2 * d0 + 1], qr[d0], p1, 0, 0, 0); }
}
__device__ __forceinline__ void qkt(f32x16& p0, f32x16& p1, lds_cptr kslot, const bf16x8* qr, const f32x16& cinit, int r32, int hi) {
    bf16x8 kf[8]; kload(kf, kslot, r32, hi); qkt_mma(p0, p1, kf, qr, cinit);
}
__device__ __forceinline__ void vload(bf16x8 (&vf)[8], lds_cptr vslot, int lane, int hi) {
    lds_cptr vp = vslot + ((lane >> 4) & 1) * 32 + (lane & 3) * 8 + (4 * hi + ((lane & 15) >> 2)) * 64;
#pragma unroll
    for (int d0 = 0; d0 < 2; ++d0)
#pragma unroll
        for (int ks = 0; ks < 4; ++ks) {
            const s16x4 lo = vtr(vp + d0 * 4096 + ks * 1024), hh = vtr(vp + d0 * 4096 + ks * 1024 + 512);
            vf[d0 * 4 + ks] = (bf16x8){lo[0], lo[1], lo[2], lo[3], hh[0], hh[1], hh[2], hh[3]};
        }
}
#define V16_TO_ARR(v, a, o) do { a[(o) + 0] = v[0]; a[(o) + 1] = v[1]; a[(o) + 2] = v[2]; a[(o) + 3] = v[3]; a[(o) + 4] = v[4]; a[(o) + 5] = v[5]; a[(o) + 6] = v[6]; a[(o) + 7] = v[7]; \
    a[(o) + 8] = v[8]; a[(o) + 9] = v[9]; a[(o) + 10] = v[10]; a[(o) + 11] = v[11]; a[(o) + 12] = v[12]; a[(o) + 13] = v[13]; a[(o) + 14] = v[14]; a[(o) + 15] = v[15]; } while (0)
__device__ __forceinline__ f32x16 splat16(float x) { return (f32x16){x, x, x, x, x, x, x, x, x, x, x, x, x, x, x, x}; }
struct AttnState { f32x16 o[2]; float m, l, pend; bool started; };
constexpr float ATT_THR = 8.0f;
__device__ __forceinline__ void softmax_pv(AttnState& st, float (&sc)[32], const bf16x8 (&vf)[8], MLAS float* wsf, int lane, int r32, int hi) {
    if (__any(st.pend != 0.f)) {
#pragma unroll
        for (int r = 0; r < 32; ++r) sc[r] -= st.pend;
    }
    st.pend = 0.f;
    float ra = __builtin_fmaxf(__builtin_fmaxf(sc[0], sc[1]), sc[2]), rb = __builtin_fmaxf(__builtin_fmaxf(sc[3], sc[4]), sc[5]);
#pragma unroll
    for (int r = 6; r < 30; r += 4) { ra = __builtin_fmaxf(__builtin_fmaxf(ra, sc[r]), sc[r + 1]); rb = __builtin_fmaxf(__builtin_fmaxf(rb, sc[r + 2]), sc[r + 3]); }
    float rm = __builtin_fmaxf(__builtin_fmaxf(ra, rb), __builtin_fmaxf(sc[30], sc[31]));
    rm = halves_max_f(rm);
    const bool fresh = !st.started;
    const bool need = (rm > ATT_THR) || (fresh && rm < -ATT_THR && rm > -1e29f);
    st.started = st.started || (rm > -1e29f);
    if (__any(need)) {
        const float dl = need ? rm : 0.f;
        st.m += dl; st.pend = dl;
#pragma unroll
        for (int r = 0; r < 32; ++r) sc[r] -= dl;
        const float alpha = fresh ? 1.0f : __builtin_amdgcn_exp2f(-dl);
        st.l *= alpha;
        if (hi == 0) wsf[r32] = alpha;
        float fr_[16];
#pragma unroll
        for (int r = 0; r < 16; ++r) fr_[r] = wsf[crow(r, hi)];
        const f32x16 fv = {fr_[0], fr_[1], fr_[2], fr_[3], fr_[4], fr_[5], fr_[6], fr_[7], fr_[8], fr_[9], fr_[10], fr_[11], fr_[12], fr_[13], fr_[14], fr_[15]};
        st.o[0] = st.o[0] * fv; st.o[1] = st.o[1] * fv;
    }
    float pe[32]; float s0 = 0.f, s1 = 0.f;
#pragma unroll
    for (int r = 0; r < 32; r += 2) { pe[r] = __builtin_amdgcn_exp2f(sc[r]); pe[r + 1] = __builtin_amdgcn_exp2f(sc[r + 1]); s0 += pe[r]; s1 += pe[r + 1]; }
    st.l += s0 + s1;
    u32x4 pw[4];
#pragma unroll
    for (int k = 0; k < 4; ++k) pw[k] = (u32x4){cvtpk(pe[8 * k + 0], pe[8 * k + 1]), cvtpk(pe[8 * k + 2], pe[8 * k + 3]), cvtpk(pe[8 * k + 4], pe[8 * k + 5]), cvtpk(pe[8 * k + 6], pe[8 * k + 7])};
#pragma unroll
    for (int d0 = 0; d0 < 2; ++d0)
#pragma unroll
        for (int ks = 0; ks < 4; ++ks) st.o[d0] = __builtin_amdgcn_mfma_f32_32x32x16_bf16(__builtin_bit_cast(bf16x8, pw[ks]), vf[d0 * 4 + ks], st.o[d0], 0, 0, 0);
}
__device__ __forceinline__ void attn_store(AttnState& st, bf16_t* Ow, int pitch, MLAS float* wsf, MLAS bf16_t* stg, int lane, int r32, int hi) {
    float l = halves_sum_f(st.l);
    if (hi == 0) wsf[32 + r32] = l;
    float rli[16];
#pragma unroll
    for (int r = 0; r < 16; ++r) rli[r] = 1.0f / wsf[32 + crow(r, hi)];
#pragma unroll
    for (int r = 0; r < 16; ++r) { const int orow = crow(r, hi);
#pragma unroll
        for (int d0 = 0; d0 < 2; ++d0) { const unsigned short b = (unsigned short)(cvtpk(st.o[d0][r] * rli[r], 0.f) & 0xffffu); stg[orow * 64 + d0 * 32 + r32] = b; } }
#pragma unroll
    for (int i = 0; i < 4; ++i) { const int row = i * 8 + (lane >> 3), ch = lane & 7; const u32x4 v = *(const MLAS u32x4*)(stg + row * 64 + ch * 8); *(u32x4*)(Ow + (size_t)row * pitch + ch * 8) = v; }
}

#ifndef DBG_REP_BS
#define DBG_REP_BS 1
#endif
__device__ __forceinline__ unsigned pk_sub_sat_u16(unsigned a, unsigned b) { unsigned r; asm("v_pk_sub_u16 %0, %1, %2 clamp" : "=v"(r) : "v"(a), "v"(b)); return r; }
__device__ __forceinline__ unsigned pk_min_u16(unsigned a, unsigned b) { unsigned r; asm("v_pk_min_u16 %0, %1, %2" : "=v"(r) : "v"(a), "v"(b)); return r; }
__device__ __forceinline__ unsigned pk_add_u16(unsigned a, unsigned b) { unsigned r; asm("v_pk_add_u16 %0, %1, %2" : "=v"(r) : "v"(a), "v"(b)); return r; }
__device__ __forceinline__ unsigned pk_ashr_i16(unsigned a, unsigned sh2) { unsigned r; asm("v_pk_ashrrev_i16 %0, %1, %2" : "=v"(r) : "v"(sh2), "v"(a)); return r; }
__device__ __forceinline__ unsigned score_keys(float a, float b) {
    const unsigned p = __builtin_bit_cast(unsigned, __builtin_amdgcn_cvt_pkrtz(a, b));
    const unsigned m = pk_ashr_i16(p, 0x000f000fu);
    return p ^ (m | 0x80008000u);
}
template <int NS> __device__ __forceinline__ unsigned bit_search(const unsigned (&kp)[8][8], MLAS unsigned* cntx, int wid, int r32, int hi) {
    unsigned tau = 0u;
#pragma unroll 1
    for (int bit = 15; bit >= 0; --bit) {
        const unsigned cand = tau | (1u << bit);
        const unsigned c2 = (cand - 1u) * 0x00010001u;
        unsigned cnt2 = 0;
#pragma unroll
        for (int jj = 0; jj < NS; ++jj)
#pragma unroll
            for (int r = 0; r < 8; ++r) cnt2 = pk_add_u16(cnt2, pk_min_u16(pk_sub_sat_u16(kp[jj][r], c2), 0x00010001u));
        unsigned cnt = (cnt2 & 0xffffu) + (cnt2 >> 16);
        cnt = halves_add_u(cnt);
        MLAS unsigned* cb = cntx + (bit & 1) * 256;
        if (hi == 0) cb[wid * 32 + r32] = cnt;
        LGKM_BAR();
        unsigned tot = 0;
#pragma unroll
        for (int w = 0; w < 8; ++w) tot += cb[w * 32 + r32];
        if (tot >= 256u) tau = cand;
    }
    return tau;
}
__device__ __forceinline__ void dsa_select(int b, int qg, const bf16_t* Z0, char* shm, const int wave_s) {
    const int tid_ = wave_s * 64 + lane_opaque(); const int tid = tid_, lane = tid & 63, r32 = lane & 31, hi = lane >> 5; const int wid = __builtin_amdgcn_readfirstlane(tid >> 6);
    MLAS char* L = (MLAS char*)shm;
    const int c = qg >> 1, nkeys = 64 * (c + 1), nt32 = nkeys >> 5, nt64 = nkeys >> 6;
    const size_t rowb = (size_t)b * SEQ;
    const size_t tok0 = rowb + 32 * qg;
    MLAS unsigned* selw = (MLAS unsigned*)(L + LX_SEL);
    if (nkeys <= 256) {
        for (int i = tid; i < 64 * 32; i += 512) selw[i] = (i < nt32 * 32) ? 0xffffffffu : 0u;
    } else {
        {
            MLAS u32x4* iqL = (MLAS u32x4*)(L + LX_IQ);
            for (int i = tid; i < 1024; i += 512) { const int q = i & 31, hh = (i >> 5) & 1, d0 = (i >> 6) & 3, h = i >> 8;
                iqL[i] = *(const u32x4*)(Z0 + (tok0 + q) * EV_N + 1280 + 64 * h + 16 * d0 + 8 * hh); }
        }
        float w4[4];
        { const u32x2 ww = *(const u32x2*)(Z0 + (tok0 + r32) * EV_N + 1216);
          w4[0] = pg8::bf_lo(ww.x) * 0.0625f; w4[1] = pg8::bf_hi(ww.x) * 0.0625f; w4[2] = pg8::bf_lo(ww.y) * 0.0625f; w4[3] = pg8::bf_hi(ww.y) * 0.0625f; }
        LGKM_BAR();
        unsigned kp[8][8];
        const int nslots = (nt32 + 7) >> 3;
        const MLAS bf16x8* iqf = (const MLAS bf16x8*)(L + LX_IQ) + hi * 32 + r32;
#pragma unroll
        for (int jj = 0; jj < 8; ++jj) {
            const int j = wid + 8 * jj;
            if (j < nt32) {
                const bf16_t* ikp = Z0 + (rowb + 32 * j + r32) * EV_N + 1152 + 8 * hi;
                bf16x8 af[4];
#pragma unroll
                for (int d0 = 0; d0 < 4; ++d0) af[d0] = *(const bf16x8*)(ikp + 16 * d0);
                f32x16 ah[4];
#pragma unroll
                for (int h = 0; h < 4; ++h) {
                    f32x16 a = {};
#pragma unroll
                    for (int d0 = 0; d0 < 4; ++d0) a = __builtin_amdgcn_mfma_f32_32x32x16_bf16(af[d0], iqf[(h * 4 + d0) * 64], a, 0, 0, 0);
                    ah[h] = a;
                }
                float sv[16];
                {
                    float a0[16], a1[16], a2[16], a3[16];
                    V16_TO_ARR(ah[0], a0, 0); V16_TO_ARR(ah[1], a1, 0); V16_TO_ARR(ah[2], a2, 0); V16_TO_ARR(ah[3], a3, 0);
#pragma unroll
                    for (int r = 0; r < 16; ++r) sv[r] = ((__builtin_fmaxf(a0[r], 0.f) * w4[0] + __builtin_fmaxf(a1[r], 0.f) * w4[1]) + __builtin_fmaxf(a2[r], 0.f) * w4[2]) + __builtin_fmaxf(a3[r], 0.f) * w4[3];
                }
#pragma unroll
                for (int r = 0; r < 8; ++r) kp[jj][r] = score_keys(sv[r], sv[r + 8]);
            } else {
#pragma unroll
                for (int r = 0; r < 8; ++r) kp[jj][r] = 0u;
            }
        }
        MLAS unsigned* cntx = (MLAS unsigned*)(L + L_OST);
        unsigned tau;
        for (int rep_ = 0; rep_ < DBG_REP_BS; ++rep_)
        switch (nslots) {
            case 2: tau = bit_search<2>(kp, cntx, wid, r32, hi); break;
            case 3: tau = bit_search<3>(kp, cntx, wid, r32, hi); break;
            case 4: tau = bit_search<4>(kp, cntx, wid, r32, hi); break;
            case 5: tau = bit_search<5>(kp, cntx, wid, r32, hi); break;
            case 6: tau = bit_search<6>(kp, cntx, wid, r32, hi); break;
            case 7: tau = bit_search<7>(kp, cntx, wid, r32, hi); break;
            default: tau = bit_search<8>(kp, cntx, wid, r32, hi); break;
        }
        MLAS unsigned* gtw = (MLAS unsigned*)(L + LX_GT); MLAS unsigned* eqw = (MLAS unsigned*)(L + LX_EQ); MLAS unsigned* pfx = (MLAS unsigned*)(L + LX_PFX);
        const unsigned tg = tau * 0x00010001u, te = (tau - 1u) * 0x00010001u;
#pragma unroll
        for (int jj = 0; jj < 8; ++jj) {
            const int j = wid + 8 * jj;
            if (j < nt32) {
                unsigned g = 0, e = 0;
#pragma unroll
                for (int r = 0; r < 8; ++r) {
                    const unsigned dgt = pk_min_u16(pk_sub_sat_u16(kp[jj][r], tg), 0x00010001u), dge = pk_min_u16(pk_sub_sat_u16(kp[jj][r], te), 0x00010001u);
                    const int pos = (r & 3) + 8 * (r >> 2);
                    g |= dgt << pos; e |= (dge - dgt) << pos;
                }
                g <<= 4 * hi; e <<= 4 * hi;
                g = halves_or_u(g); e = halves_or_u(e);
                if (hi == 0) { gtw[j * 32 + r32] = g; eqw[j * 32 + r32] = e; }
            }
        }
        LGKM_BAR();
        if (wid == 0 && hi == 0) {
            unsigned cg = 0;
            for (int j = 0; j < nt32; ++j) cg += __builtin_popcount(gtw[j * 32 + r32]);
            const int need = 256 - (int)cg;
            int run = 0;
            for (int j = 0; j < nt32; ++j) { const unsigned e = eqw[j * 32 + r32]; int k = need - run; k = k < 0 ? 0 : (k > 32 ? 32 : k); pfx[j * 32 + r32] = (unsigned)k; run += __builtin_popcount(e); }
        }
        LGKM_BAR();
        for (int i = tid; i < nt32 * 32; i += 512) {
            const unsigned g = gtw[i], e = eqw[i]; const int k = (int)pfx[i];
            unsigned take = 0;
            if (e != 0u && k > 0) {
                unsigned rem = e; int cntk = 0;
                while (rem != 0u && cntk < k) { const unsigned low = rem & (0u - rem); take |= low; rem ^= low; ++cntk; }
            }
            selw[i] = g | take;
        }
        for (int i = nt32 * 32 + tid; i < 64 * 32; i += 512) selw[i] = 0u;
    }
    WAITV_BAR();
}

__device__ __forceinline__ void fox_unit(int b, int h, int qb, const bf16_t* Z1, const float* F, const float* bfp, bf16_t* Y, char* shm, unsigned lds0, const int wave_s) {
    const int tid_ = wave_s * 64 + lane_opaque(); const int tid = tid_, lane = tid & 63, r32 = lane & 31, hi = lane >> 5; const int wid = __builtin_amdgcn_readfirstlane(tid >> 6);
    MLAS char* L = (MLAS char*)shm;
    const size_t rowb = (size_t)b * SEQ;
    const int NT = 4 * (qb + 1), nk = 64 * NT;
    MLAS float* cum2 = (MLAS float*)(L + L_X);
    MLAS float* wtot = (MLAS float*)(L + L_X + 8192);
    const bf16_t* Kb = Z1 + rowb * Z1P + 512 + 64 * h; const bf16_t* Vb = Z1 + rowb * Z1P + 1024 + 64 * h;
#pragma unroll
    for (int i = 0; i < 3; ++i) dma_kv(Kb + (size_t)64 * i * Z1P, Vb + (size_t)64 * i * Z1P, Z1P, lds0, i, wid, lane);
    {
        const float bias = bfp[h];
        const int s0 = 4 * tid;
        float v[4]; float run = 0.f;
#pragma unroll
        for (int i = 0; i < 4; ++i) {
            float x = 0.f;
            if (s0 + i < nk) x = F[(rowb + s0 + i) * 8 + h] + bias;
            const float ls = (s0 + i < nk) ? (fminf(x, 0.f) - log1pf(expf(-fabsf(x)))) : 0.f;
            run += ls; v[i] = run;
        }
        float inc = run;
#pragma unroll
        for (int o = 1; o < 64; o <<= 1) { const int ln = lane_opaque(); const float t = __builtin_bit_cast(float, __builtin_amdgcn_ds_bpermute((ln - o) << 2, __builtin_bit_cast(int, inc))); if (ln >= o) inc += t; }
        if (lane == 63) wtot[wid] = inc;
        LGKM_BAR();
        float off = inc - run;
        for (int w = 0; w < wid; ++w) off += wtot[w];
#pragma unroll
        for (int i = 0; i < 4; ++i) cum2[s0 + i] = (off + v[i]) * 1.4426950408889634f;
    }
    const int tq = 256 * qb + 32 * wid + r32;
    bf16x8 qr[4];
#pragma unroll
    for (int d0 = 0; d0 < 4; ++d0) qr[d0] = *(const bf16x8*)(Z1 + (rowb + tq) * Z1P + 64 * h + 16 * d0 + 8 * hi);
    AttnState st; st.o[0] = f32x16{}; st.o[1] = f32x16{}; st.m = 0.f; st.l = 0.f; st.pend = 0.f; st.started = false;
    MLAS float* wsf = (MLAS float*)(L + L_WSF) + wid * 64;
    WAITV_BAR();
    const float cq2 = cum2[tq];
    const int tlast = 4 * qb + (wid >> 1);
    f32x16 s0, s1;
    qkt(s0, s1, (lds_cptr)(L + L_K), qr, splat16(-st.m), r32, hi);
    for (int t = 0; t < NT; ++t) {
        const int slot = t & 3;
        { const int tt = (t + 3 < NT) ? t + 3 : NT - 1; dma_kv(Kb + (size_t)64 * tt * Z1P, Vb + (size_t)64 * tt * Z1P, Z1P, lds0, (t + 3) & 3, wid, lane); }
        bf16x8 kf[8], vf[8];
        kload(kf, (lds_cptr)(L + L_K + ((t + 1) & 3) * SLOTB), r32, hi);
        __builtin_amdgcn_sched_barrier(0);
        vload(vf, (lds_cptr)(L + L_V + slot * SLOTB), lane, hi);
        const MLAS float* cb = cum2 + 64 * t + 4 * hi;
        f32x4 c0[4], c1[4];
#pragma unroll
        for (int g = 0; g < 4; ++g) { c0[g] = *(const MLAS f32x4*)(cb + 8 * g); c1[g] = *(const MLAS f32x4*)(cb + 32 + 8 * g); }
        f32x16 n0, n1;
        qkt_mma(n0, n1, kf, qr, splat16(-st.m));
        float sc[32];
        V16_TO_ARR(s0, sc, 0); V16_TO_ARR(s1, sc, 16);
#pragma unroll
        for (int g = 0; g < 4; ++g) {
            sc[4 * g + 0] += cq2 - c0[g].x; sc[4 * g + 1] += cq2 - c0[g].y; sc[4 * g + 2] += cq2 - c0[g].z; sc[4 * g + 3] += cq2 - c0[g].w;
            sc[16 + 4 * g + 0] += cq2 - c1[g].x; sc[16 + 4 * g + 1] += cq2 - c1[g].y; sc[16 + 4 * g + 2] += cq2 - c1[g].z; sc[16 + 4 * g + 3] += cq2 - c1[g].w;
        }
        if (t >= tlast) {
            const int qrel = tq - 64 * t;
#pragma unroll
            for (int r = 0; r < 16; ++r) { const int kr = crow(r, hi); if (kr > qrel) sc[r] = -INFINITY; if (kr + 32 > qrel) sc[16 + r] = -INFINITY; }
        }
        softmax_pv(st, sc, vf, wsf, lane, r32, hi);
        s0 = n0; s1 = n1;
        WAITV2_BAR();
    }
    attn_store(st, Y + (rowb + 256 * qb + 32 * wid) * DMODEL + 64 * h, DMODEL, wsf, (MLAS bf16_t*)(L + L_OST) + wid * 2048, lane, r32, hi);
    WAITV_BAR();
}

__device__ __forceinline__ void sgu_unit(int b, int n, int g, const bf16_t* Z1, const float* sst, const float* lng, const float* lnb, const bf16_t* Wm, const float* bs, bf16_t* Y, char* shm, const int wave_s) {
    const int tid_ = wave_s * 64 + lane_opaque(); const int tid = tid_, lane = tid & 63, r32 = lane & 31, hi = lane >> 5; const int wid = __builtin_amdgcn_readfirstlane(tid >> 6);
    MLAS char* L = (MLAS char*)shm;
    MLAS bf16_t* vn = (MLAS bf16_t*)L;
    constexpr int VP = 136;
    const size_t tok0 = (size_t)b * SEQ + 128 * n;
    {
        const int j = tid >> 2, cq = (tid & 3) * 32;
        const float* sp = sst + (tok0 + j) * 16;
        float s1 = 0.f, s2 = 0.f;
#pragma unroll
        for (int k = 0; k < 8; ++k) { s1 += sp[2 * k]; s2 += sp[2 * k + 1]; }
        const float mu = s1 * (1.0f / 512.0f); const float var = fmaxf(s2 * (1.0f / 512.0f) - mu * mu, 0.f);
        const float rstd = 1.0f / sqrtf(var + RMS_EPS);
        const bf16_t* vp = Z1 + (tok0 + j) * Z1P + 2048 + 128 * g + cq;
#pragma unroll
        for (int k = 0; k < 4; ++k) {
            const u32x4 w = *(const u32x4*)(vp + 8 * k);
            const int cc = 128 * g + cq + 8 * k;
            const f32x4 g0 = *(const f32x4*)(lng + cc), g1 = *(const f32x4*)(lng + cc + 4), b0 = *(const f32x4*)(lnb + cc), b1 = *(const f32x4*)(lnb + cc + 4);
            float x[8] = {pg8::bf_lo(w.x), pg8::bf_hi(w.x), pg8::bf_lo(w.y), pg8::bf_hi(w.y), pg8::bf_lo(w.z), pg8::bf_hi(w.z), pg8::bf_lo(w.w), pg8::bf_hi(w.w)};
            float y[8];
#pragma unroll
            for (int i = 0; i < 4; ++i) { y[i] = (x[i] - mu) * rstd * g0[i] + b0[i]; y[4 + i] = (x[4 + i] - mu) * rstd * g1[i] + b1[i]; }
            u32x4 o; o.x = cvtpk(y[0], y[1]); o.y = cvtpk(y[2], y[3]); o.z = cvtpk(y[4], y[5]); o.w = cvtpk(y[6], y[7]);
            *(MLAS u32x4*)(vn + j * VP + cq + 8 * k) = o;
        }
    }
    LGKM_BAR();
    MLAS bf16_t* ut = (MLAS bf16_t*)(L + 128 * VP * 2);
    {
        const int j = tid >> 2, cq = (tid & 3) * 32;
        const bf16_t* up = Z1 + (tok0 + j) * Z1P + 1536 + 128 * g + cq;
#pragma unroll
        for (int k = 0; k < 4; ++k) *(MLAS u32x4*)(ut + j * VP + cq + 8 * k) = *(const u32x4*)(up + 8 * k);
    }
    LGKM_BAR();
    const int ib = wid & 3;
    const bf16_t* wrow = Wm + ((size_t)g * 128 + 32 * ib + r32) * 128 + 8 * hi;
    bf16x8 af[8];
#pragma unroll
    for (int s = 0; s < 8; ++s) af[s] = *(const bf16x8*)(wrow + 16 * s);
#pragma unroll
    for (int cbi = 0; cbi < 2; ++cbi) {
        const int cb = (wid >> 2) * 2 + cbi;
        f32x16 acc = {};
        lds_cptr bp = (lds_cptr)(vn) + ((size_t)(8 * hi + ((lane & 15) >> 2)) * VP + 32 * cb + 16 * ((lane >> 4) & 1) + 4 * (lane & 3)) * 2;
#pragma unroll
        for (int s = 0; s < 8; ++s) {
            const s16x4 lo = vtr(bp + (16 * s) * VP * 2), hh = vtr(bp + (16 * s + 4) * VP * 2);
            const bf16x8 bfr = {lo[0], lo[1], lo[2], lo[3], hh[0], hh[1], hh[2], hh[3]};
            acc = __builtin_amdgcn_mfma_f32_32x32x16_bf16(af[s], bfr, acc, 0, 0, 0);
        }
        float a16[16]; V16_TO_ARR(acc, a16, 0);
#pragma unroll
        for (int r = 0; r < 16; ++r) {
            const int i = 32 * ib + crow(r, hi), cc = 32 * cb + r32;
            const float uu = __builtin_bit_cast(float, (unsigned)ut[i * VP + cc] << 16);
            const float o = uu * (a16[r] + bs[g * 128 + i]);
            ut[i * VP + cc] = (bf16_t)(cvtpk(o, 0.f) & 0xffffu);
        }
    }
    LGKM_BAR();
    {
        const int j = tid >> 2, cq = (tid & 3) * 32;
        bf16_t* yp = Y + (tok0 + j) * DMODEL + 512 + 128 * g + cq;
#pragma unroll
        for (int k = 0; k < 4; ++k) *(u32x4*)(yp + 8 * k) = *(const MLAS u32x4*)(ut + j * VP + cq + 8 * k);
    }
    LGKM_BAR();
}

__device__ __forceinline__ void pool_item(int item, const bf16_t* Z0, bf16_t* Y) {
    const int row = item >> 6, ch = item & 63, c0 = ch * 8, g = ch >> 4;
    const int w = 2 << g, tpos = row & (SEQ - 1);
    const int cnt = (tpos + 1 < w) ? tpos + 1 : w;
    u32x4 v[16];
#pragma unroll
    for (int k = 0; k < 16; ++k) { v[k] = (u32x4){0u, 0u, 0u, 0u}; if (k < cnt) v[k] = *(const u32x4*)(Z0 + (size_t)(row - k) * EV_N + c0); }
    float s[8] = {0.f, 0.f, 0.f, 0.f, 0.f, 0.f, 0.f, 0.f};
#pragma unroll
    for (int k = 0; k < 16; ++k) {
        s[0] += pg8::bf_lo(v[k].x); s[1] += pg8::bf_hi(v[k].x); s[2] += pg8::bf_lo(v[k].y); s[3] += pg8::bf_hi(v[k].y);
        s[4] += pg8::bf_lo(v[k].z); s[5] += pg8::bf_hi(v[k].z); s[6] += pg8::bf_lo(v[k].w); s[7] += pg8::bf_hi(v[k].w);
    }
    const float self[8] = {pg8::bf_lo(v[0].x), pg8::bf_hi(v[0].x), pg8::bf_lo(v[0].y), pg8::bf_hi(v[0].y), pg8::bf_lo(v[0].z), pg8::bf_hi(v[0].z), pg8::bf_lo(v[0].w), pg8::bf_hi(v[0].w)};
    const float inv = 1.0f / (float)cnt;
    u32x4 o; o.x = cvtpk(s[0] * inv - self[0], s[1] * inv - self[1]); o.y = cvtpk(s[2] * inv - self[2], s[3] * inv - self[3]);
    o.z = cvtpk(s[4] * inv - self[4], s[5] * inv - self[5]); o.w = cvtpk(s[6] * inv - self[6], s[7] * inv - self[7]);
    *(u32x4*)(Y + (size_t)row * DMODEL + c0) = o;
}
}
namespace foxa {
using bf16=__hip_bfloat16;
using bf16x8=__attribute__((ext_vector_type(8)))short;
using s16x4=__attribute__((ext_vector_type(4)))short;
using f32x16=__attribute__((ext_vector_type(16)))float;
using u32x4=__attribute__((ext_vector_type(4)))unsigned;
using f32x4v=__attribute__((ext_vector_type(4)))float;
constexpr int CUM_OFF=86016;
constexpr int SEQL=2048,D=64,OPI=1024;
constexpr int NW=8,QBLK=32,QB=QBLK*NW,KVBLK=64;
__device__ __forceinline__ int crow(int r,int hi){return (r&3)+8*(r>>2)+4*hi;}
#define SBAR() __builtin_amdgcn_sched_barrier(0)
__device__ __forceinline__ void cmask(f32x16&p0,f32x16&p1,int jb,int qrel,int hi){
  const float NEG=-INFINITY; int kb=64*jb+4*hi;
  #pragma unroll
  for(int r=0;r<16;++r){int kv=kb+(r&3)+8*(r>>2); if(kv>qrel)p0[r]=NEG; if(kv+32>qrel)p1[r]=NEG;}
}

constexpr int NSLOT=3, SLOTB=8192;
constexpr int LDS_K=0, LDS_V=NSLOT*SLOTB, LDS_WS=2*NSLOT*SLOTB, LDS_OST=LDS_WS+NW*64*4, LDS_BYTES=LDS_OST+NW*4096;
constexpr float C2=0.125f*1.4426950408889634f;
__device__ __forceinline__ void glds16(const void*gsrc,unsigned lds_dst){unsigned keep;
  asm volatile("s_mov_b32 %0, m0\n\ts_mov_b32 m0, %2\n\ts_nop 0\n\tglobal_load_lds_dwordx4 %1, off\n\ts_mov_b32 m0, %0":"=&s"(keep):"v"(gsrc),"s"(lds_dst):"memory");}
__device__ __forceinline__ float max3f(float a,float b,float c){float r;asm("v_max3_f32 %0, %1, %2, %3":"=v"(r):"v"(a),"v"(b),"v"(c));return r;}
__device__ __forceinline__ float max2f(float a,float b){float r;asm("v_max_f32_e32 %0, %1, %2":"=v"(r):"v"(a),"v"(b));return r;}
__device__ __forceinline__ float fadd_s(float a,float b){float r;asm("v_add_f32_e32 %0, %1, %2":"=v"(r):"v"(a),"v"(b));return r;}
__device__ __forceinline__ float fsub_s(float a,float b){float r;asm("v_sub_f32_e32 %0, %1, %2":"=v"(r):"v"(a),"v"(b));return r;}
typedef float f32x2_t __attribute__((ext_vector_type(2))); typedef __bf16 bf16x2_t __attribute__((ext_vector_type(2)));
__device__ __forceinline__ unsigned cvtpk_s(float lo,float hi){f32x2_t v={lo,hi};bf16x2_t b=__builtin_convertvector(v,bf16x2_t);return __builtin_bit_cast(unsigned,b);}
#define WAIT_BAR(N) asm volatile("s_waitcnt vmcnt(" #N ") lgkmcnt(0)\n\ts_barrier":::"memory")

__device__ __forceinline__ void qkt(f32x16&p0,f32x16&p1,const char*Kslot,const bf16x8*qr,const f32x16&negm,int r32,int hi){
  const char*kb=Kslot+hi*1024+r32*16;
  #pragma unroll
  for(int d0=0;d0<4;++d0){
    const bf16x8 b0=*reinterpret_cast<const bf16x8*>(kb+d0*2048);
    const bf16x8 b1=*reinterpret_cast<const bf16x8*>(kb+d0*2048+512);
    if(d0==0){p0=__builtin_amdgcn_mfma_f32_32x32x16_bf16(b0,qr[0],negm,0,0,0);p1=__builtin_amdgcn_mfma_f32_32x32x16_bf16(b1,qr[0],negm,0,0,0);}
    else{p0=__builtin_amdgcn_mfma_f32_32x32x16_bf16(b0,qr[d0],p0,0,0,0);p1=__builtin_amdgcn_mfma_f32_32x32x16_bf16(b1,qr[d0],p1,0,0,0);}}
}
typedef __attribute__((address_space(3))) const char* lds_cptr;
typedef short v4i16_t __attribute__((ext_vector_type(4)));
__device__ __forceinline__ void kload8(bf16x8*kf,lds_cptr kp){
  kf[0]=*(const __attribute__((address_space(3))) bf16x8*)(kp);      kf[1]=*(const __attribute__((address_space(3))) bf16x8*)(kp+512);
  kf[2]=*(const __attribute__((address_space(3))) bf16x8*)(kp+2048); kf[3]=*(const __attribute__((address_space(3))) bf16x8*)(kp+2560);
  kf[4]=*(const __attribute__((address_space(3))) bf16x8*)(kp+4096); kf[5]=*(const __attribute__((address_space(3))) bf16x8*)(kp+4608);
  kf[6]=*(const __attribute__((address_space(3))) bf16x8*)(kp+6144); kf[7]=*(const __attribute__((address_space(3))) bf16x8*)(kp+6656);
}
__device__ __forceinline__ void kload2(bf16x8*kf,lds_cptr kp,int j){ kf[2*j]=*(const __attribute__((address_space(3))) bf16x8*)(kp+j*2048); kf[2*j+1]=*(const __attribute__((address_space(3))) bf16x8*)(kp+j*2048+512); }
__device__ __forceinline__ s16x4 vtr(lds_cptr p){ return __builtin_bit_cast(s16x4,__builtin_amdgcn_ds_read_tr16_b64_v4i16((__attribute__((address_space(3))) v4i16_t*)p)); }
__device__ __forceinline__ float rowmax(const f32x16&p0,const f32x16&p1){
  float a=max3f(p0[0],p0[1],p1[0]),b=max3f(p0[2],p0[3],p1[1]);a=max3f(a,p1[2],p1[3]);
  #pragma unroll
  for(int r=4;r<16;r+=4){a=max3f(a,p0[r],p0[r+1]);b=max3f(b,p0[r+2],p0[r+3]);a=max3f(a,p1[r],p1[r+1]);b=max3f(b,p1[r+2],p1[r+3]);}
  const float m=max2f(a,b);
  auto rr=__builtin_amdgcn_permlane32_swap(__float_as_uint(m),__float_as_uint(m),false,false);
  return max2f(__uint_as_float(rr[0]),__uint_as_float(rr[1]));
}
__device__ __forceinline__ void pv(f32x16*o,int vb,bf16x8 pa0,bf16x8 pa1,bf16x8 pa2,bf16x8 pa3){
  #pragma unroll
  for(int d0=0;d0<2;++d0){s16x4 lo[4],hi[4];
    #pragma unroll
    for(int ks=0;ks<4;++ks){
      asm volatile("ds_read_b64_tr_b16 %0,%1 offset:%c2":"=&v"(lo[ks]):"v"(vb),"i"(d0*4096+ks*1024):"memory");
      asm volatile("ds_read_b64_tr_b16 %0,%1 offset:%c2":"=&v"(hi[ks]):"v"(vb),"i"(d0*4096+ks*1024+512):"memory");}
    asm volatile("s_waitcnt lgkmcnt(0)":::"memory");SBAR();
    #define PK(k) (bf16x8){lo[k][0],lo[k][1],lo[k][2],lo[k][3],hi[k][0],hi[k][1],hi[k][2],hi[k][3]}
    o[d0]=__builtin_amdgcn_mfma_f32_32x32x16_bf16(pa0,PK(0),o[d0],0,0,0);
    o[d0]=__builtin_amdgcn_mfma_f32_32x32x16_bf16(pa1,PK(1),o[d0],0,0,0);
    o[d0]=__builtin_amdgcn_mfma_f32_32x32x16_bf16(pa2,PK(2),o[d0],0,0,0);
    o[d0]=__builtin_amdgcn_mfma_f32_32x32x16_bf16(pa3,PK(3),o[d0],0,0,0);
    #undef PK
  }
}

#ifndef ATTN_STORE16
#define ATTN_STORE16(p,v) (*(u32x4*)(p)=(v))
#endif
template<int THRL,int MODE,int QKVP,class CumFn> __device__ __forceinline__ void attn_unit(CumFn&& CUMFN,int b,int h,int qb,int q0abs,int NTU,const bf16*Q,const bf16*__restrict__ K,const bf16*__restrict__ V,bf16*O,char*shm,const __attribute__((address_space(3))) unsigned*selw,const int wave_s){
  const int tid=wave_s*64+lane_opaque(),lane=tid&63,r32=lane&31,hi=lane>>5; const int wid=__builtin_amdgcn_readfirstlane(tid>>6);
  const long rowbase=(long)b*SEQL; const int q0=(MODE==0)?qb*QB:q0abs;
  const bf16*Qw=(MODE==0)?Q+(rowbase+q0+wid*QBLK)*QKVP+h*D:Q+(rowbase+q0)*QKVP+wid*D;
  const bf16*Kh=K+rowbase*QKVP+h*D,*Vh=V+rowbase*QKVP+h*D;
  const unsigned lds0=(unsigned)(uintptr_t)shm;
  float*wsf=(float*)(shm+LDS_WS)+wid*64;
  const bf16*ksrc=Kh+(long)lane*QKVP+wid*8;
  const bf16*vsrc=Vh+(long)(16*(wid&3)+(lane>>2))*QKVP+(wid>>2)*32+(lane&3)*8;
  const unsigned kdst=lds0+LDS_K+wid*1024, vdst=lds0+LDS_V+wid*1024;
  #define DMA_K(t,slot) glds16(ksrc+(long)(t)*KVBLK*QKVP,(unsigned)__builtin_amdgcn_readfirstlane(kdst+(slot)))
  #define DMA_V(t,slot) glds16(vsrc+(long)(t)*KVBLK*QKVP,(unsigned)__builtin_amdgcn_readfirstlane(vdst+(slot)))
  const int vb0=(int)(lds0+LDS_V)+((lane>>4)&1)*32+(lane&3)*8+(4*hi+((lane&15)>>2))*64;
  const char*Kbase=shm+LDS_K; bf16x8 kf[8];
  const lds_cptr shm3=(lds_cptr)shm; const lds_cptr kp0=shm3+LDS_K+hi*1024+r32*16; const lds_cptr vp0=shm3+LDS_V+((lane>>4)&1)*32+(lane&3)*8+(4*hi+((lane&15)>>2))*64;
  const int NT=(MODE==0)?(q0+QB)/KVBLK:NTU;
  DMA_K(0,0);DMA_V(0,0);DMA_K(1,SLOTB);
  if constexpr(MODE==0){ CUMFN(); }
  bf16x8 qr[4];
  #pragma unroll
  for(int d0=0;d0<4;++d0)qr[d0]=*reinterpret_cast<const bf16x8*>(&Qw[(long)r32*QKVP+d0*16+hi*8]);
  float mhat=0.f,l_reg=0.f;float z_=0.f;asm volatile("":"+v"(z_));f32x16 o[2];o[0]=(f32x16){z_,z_,z_,z_,z_,z_,z_,z_,z_,z_,z_,z_,z_,z_,z_,z_};o[1]=o[0];f32x16 negm=o[0];asm volatile("":"+v"(negm));
  const int qrel=wid*QBLK+r32;
  const __attribute__((address_space(3))) float*cum2=(const __attribute__((address_space(3))) float*)(shm+CUM_OFF);
  const float cq2=(MODE==0)?cum2[q0+qrel]:0.f;
  #define BIAS(P0,P1,t) do{ if constexpr(MODE==0){ const __attribute__((address_space(3))) float*cb_=cum2+64*(t)+4*hi; \
    _Pragma("unroll") for(int g_=0;g_<4;++g_){ const f32x4v c0_=*(const __attribute__((address_space(3))) f32x4v*)(cb_+8*g_), c1_=*(const __attribute__((address_space(3))) f32x4v*)(cb_+32+8*g_); \
      P0[4*g_+0]+=cq2-c0_.x; P0[4*g_+1]+=cq2-c0_.y; P0[4*g_+2]+=cq2-c0_.z; P0[4*g_+3]+=cq2-c0_.w; \
      P1[4*g_+0]+=cq2-c1_.x; P1[4*g_+1]+=cq2-c1_.y; P1[4*g_+2]+=cq2-c1_.z; P1[4*g_+3]+=cq2-c1_.w; } } }while(0)
  #define SELM(P0,P1,t) do{ if constexpr(MODE==1){ const unsigned w0_=selw[(2*(t))*32+r32]>>(4*hi), w1_=selw[(2*(t)+1)*32+r32]>>(4*hi); \
    _Pragma("unroll") for(int r=0;r<16;++r){ const int sh_=(r&3)+8*(r>>2); if(!((w0_>>sh_)&1u))P0[r]=-INFINITY; if(!((w1_>>sh_)&1u))P1[r]=-INFINITY; } } }while(0)
  #define CMASK(P0,P1,t) do{ if constexpr(MODE==0){int jb_=(t)-(NT-4); if(jb_>=0)cmask(P0,P1,jb_,qrel,hi);} }while(0)
  bool resc=false;
  #define START(P0,P1) do{ const float rm=rowmax(P0,P1); resc=false; \
    { const float dl=(MODE==1&&!(rm>-1e30f))?0.f:rm; mhat=fadd_s(mhat,dl); \
      _Pragma("unroll") for(int r=0;r<16;++r){P0[r]=fsub_s(P0[r],dl);P1[r]=fsub_s(P1[r],dl);} \
      _Pragma("unroll") for(int r=0;r<16;++r)negm[r]=-mhat; asm volatile("":"+v"(negm)); } \
    _Pragma("unroll") for(int r=0;r<16;++r)P0[r]=__builtin_amdgcn_exp2f(P0[r]); }while(0)
  #define RESC() do{ if(resc){ asm volatile("s_waitcnt lgkmcnt(0)":::"memory"); \
      _Pragma("unroll") for(int d_=0;d_<2;++d_) _Pragma("unroll") for(int r=0;r<16;++r)o[d_][r]*=wsf[crow(r,hi)]; } }while(0)
  f32x16 pA0,pA1,pB0,pB1;
  int sl_prev=0,sl_cur=0,sl_next=SLOTB;
  #define ROT() do{sl_prev=sl_cur;sl_cur=sl_next;sl_next=(sl_next==(NSLOT-1)*SLOTB)?0:sl_next+SLOTB;}while(0)
  DMA_K(2,2*SLOTB);
  WAIT_BAR(3);
  qkt(pA0,pA1,Kbase,qr,negm,r32,hi);asm volatile("s_nop 15\n\ts_nop 7":"+v"(pA0),"+v"(pA1));BIAS(pA0,pA1,0);SELM(pA0,pA1,0);CMASK(pA0,pA1,0);
  START(pA0,pA1);
  _Pragma("unroll") for(int r=0;r<16;++r)pA1[r]=__builtin_amdgcn_exp2f(pA1[r]);
  WAIT_BAR(0);
  DMA_K(3,0);DMA_V(1,SLOTB);
  ROT();
  kload8(kf,kp0+sl_cur);
  WAIT_BAR(2);
  s16x4 vlo[8],vhi[8]; u32x4 pw0,pw1,pw2,pw3;
  #define PKW(P,B) cvtpk_s(P[B],P[B+1])
  #define PAF(k) __builtin_bit_cast(bf16x8,pw##k)
  #define VFR(i) (bf16x8){vlo[i][0],vlo[i][1],vlo[i][2],vlo[i][3],vhi[i][0],vhi[i][1],vhi[i][2],vhi[i][3]}
  #define PIN(x) asm volatile("":"+v"(x))
  #define MX3(a,b,c) __builtin_fmaxf(__builtin_fmaxf((a),(b)),(c))
  #define GAPA(MF,A0,A1,A2,A3,W0,W1,PW) do{ MF; sacc+=A0; sacc+=A1; sacc+=A2; sacc+=A3; PIN(sacc); W0; W1; PIN(PW); SBAR(); }while(0)
  #define EX(v) __builtin_amdgcn_exp2f(v)
  #define GAPB(MF,X,B) do{ MF; X[B]=EX(X[B]); X[B+1]=EX(X[B+1]); X[B+2]=EX(X[B+2]); X[B+3]=EX(X[B+3]); PIN(X); SBAR(); }while(0)
  #define VRD(i) do{ vlo[i]=vtr(vp_+(((i)>>2)*4096+((i)&3)*1024)); vhi[i]=vtr(vp_+(((i)>>2)*4096+((i)&3)*1024+512)); }while(0)
  #define KRD(G,j) do{ if(G){ kload2(kf,kp0+sl_next,j); SBAR(); } }while(0)
  #define STEP(C0,C1,P0,P1,t,GK,GV,GL) do{ SBAR(); \
    const lds_cptr vp_=vp0+sl_prev; \
    VRD(0); SBAR(); float sacc=(P0[0]+P0[1]); \
    GAPA(C0=__builtin_amdgcn_mfma_f32_32x32x16_bf16(kf[0],qr[0],negm,0,0,0), P0[2],P0[3],P0[4],P0[5],     pw0[0]=PKW(P0,0), pw0[1]=PKW(P0,2), pw0); \
    VRD(4); SBAR(); GAPA(C1=__builtin_amdgcn_mfma_f32_32x32x16_bf16(kf[1],qr[0],negm,0,0,0), P0[6],P0[7],P0[8],P0[9],     pw0[2]=PKW(P0,4), pw0[3]=PKW(P0,6), pw0); \
    VRD(1); SBAR(); GAPA(C0=__builtin_amdgcn_mfma_f32_32x32x16_bf16(kf[2],qr[1],C0,0,0,0),   P0[10],P0[11],P0[12],P0[13], pw1[0]=PKW(P0,8), pw1[1]=PKW(P0,10), pw1); \
    VRD(5); SBAR(); GAPA(C1=__builtin_amdgcn_mfma_f32_32x32x16_bf16(kf[3],qr[1],C1,0,0,0),   P0[14],P0[15],P1[0],P1[1],   pw1[2]=PKW(P0,12),pw1[3]=PKW(P0,14), pw1); \
    VRD(2); SBAR(); GAPA(C0=__builtin_amdgcn_mfma_f32_32x32x16_bf16(kf[4],qr[2],C0,0,0,0),   P1[2],P1[3],P1[4],P1[5],     pw2[0]=PKW(P1,0), pw2[1]=PKW(P1,2), pw2); \
    VRD(6); SBAR(); GAPA(C1=__builtin_amdgcn_mfma_f32_32x32x16_bf16(kf[5],qr[2],C1,0,0,0),   P1[6],P1[7],P1[8],P1[9],     pw2[2]=PKW(P1,4), pw2[3]=PKW(P1,6), pw2); \
    VRD(3); SBAR(); GAPA(C0=__builtin_amdgcn_mfma_f32_32x32x16_bf16(kf[6],qr[3],C0,0,0,0),   P1[10],P1[11],P1[12],P1[13], pw3[0]=PKW(P1,8), pw3[1]=PKW(P1,10), pw3); \
    VRD(7); SBAR(); GAPA(C1=__builtin_amdgcn_mfma_f32_32x32x16_bf16(kf[7],qr[3],C1,0,0,0),   P1[14],P1[15],0.f,0.f,       pw3[2]=PKW(P1,12),pw3[3]=PKW(P1,14), pw3); \
    l_reg+=sacc; \
    if(GK){DMA_K((t)+3,sl_cur);} if(GV){DMA_V((t)+1,sl_next);} \
    BIAS(C0,C1,t); SELM(C0,C1,t); CMASK(C0,C1,t); \
    { float a=MX3(C0[0],C0[1],C1[0]),b=MX3(C0[2],C0[3],C1[1]); a=MX3(a,C1[2],C1[3]); \
      _Pragma("unroll") for(int r=4;r<16;r+=4){a=MX3(a,C0[r],C0[r+1]);b=MX3(b,C0[r+2],C0[r+3]);a=MX3(a,C1[r],C1[r+1]);b=MX3(b,C1[r+2],C1[r+3]);} \
      float rm=__builtin_fmaxf(a,b); { auto rr=__builtin_amdgcn_permlane32_swap(__float_as_uint(rm),__float_as_uint(rm),false,false); rm=__builtin_fmaxf(__uint_as_float(rr[0]),__uint_as_float(rr[1])); } \
      resc=false; \
      if(__builtin_expect(__any(rm>(float)THRL),0)){ const float dl=__builtin_fmaxf(rm,0.f); mhat+=dl; \
        _Pragma("unroll") for(int r=0;r<16;++r){C0[r]-=dl;C1[r]-=dl;} \
        _Pragma("unroll") for(int r=0;r<16;++r)negm[r]=-mhat; asm volatile("":"+v"(negm)); \
        const float f=__builtin_amdgcn_exp2f(-dl); l_reg*=f; if(hi==0)wsf[r32]=f; resc=true; } } \
    SBAR(); \
    GAPB(o[0]=__builtin_amdgcn_mfma_f32_32x32x16_bf16(PAF(0),VFR(0),o[0],0,0,0), C0,0); \
    GAPB(o[1]=__builtin_amdgcn_mfma_f32_32x32x16_bf16(PAF(0),VFR(4),o[1],0,0,0), C0,4); \
    KRD(GL,0); GAPB(o[0]=__builtin_amdgcn_mfma_f32_32x32x16_bf16(PAF(1),VFR(1),o[0],0,0,0), C0,8); \
    KRD(GL,1); GAPB(o[1]=__builtin_amdgcn_mfma_f32_32x32x16_bf16(PAF(1),VFR(5),o[1],0,0,0), C0,12); \
    KRD(GL,2); GAPB(o[0]=__builtin_amdgcn_mfma_f32_32x32x16_bf16(PAF(2),VFR(2),o[0],0,0,0), C1,0); \
    KRD(GL,3); GAPB(o[1]=__builtin_amdgcn_mfma_f32_32x32x16_bf16(PAF(2),VFR(6),o[1],0,0,0), C1,4); \
    GAPB(o[0]=__builtin_amdgcn_mfma_f32_32x32x16_bf16(PAF(3),VFR(3),o[0],0,0,0), C1,8); \
    GAPB(o[1]=__builtin_amdgcn_mfma_f32_32x32x16_bf16(PAF(3),VFR(7),o[1],0,0,0), C1,12); \
    }while(0)
  int t=1;
  #undef CMASK
  #define CMASK(P0,P1,t) do{}while(0)
  for(;t+5<NT;t+=2){
    STEP(pB0,pB1,pA0,pA1,t,true,true,true);     WAIT_BAR(2); RESC(); ROT();
    STEP(pA0,pA1,pB0,pB1,t+1,true,true,true);   WAIT_BAR(2); RESC(); ROT();
  }
  #undef CMASK
  #define CMASK(P0,P1,t) do{ if constexpr(MODE==0){int jb_=(t)-(NT-4); if(jb_>=0)cmask(P0,P1,jb_,qrel,hi);} }while(0)
  #define ENDW(tt) do{ if((tt)+3<NT){WAIT_BAR(2);} else if((tt)+2<NT){WAIT_BAR(1);} else {WAIT_BAR(0);} }while(0)
  for(;t+1<NT;t+=2){
    STEP(pB0,pB1,pA0,pA1,t,(t+3<NT),(t+1<NT),(t+1<NT));       ENDW(t);   RESC(); ROT();
    STEP(pA0,pA1,pB0,pB1,t+1,(t+4<NT),(t+2<NT),(t+2<NT));     ENDW(t+1); RESC(); ROT();
  }
  STEP(pB0,pB1,pA0,pA1,NT-1,false,false,false); RESC();
  { float sacc=pB0[0]+pB0[1]; _Pragma("unroll") for(int r=2;r<16;++r)sacc+=pB0[r]; _Pragma("unroll") for(int r=0;r<16;++r)sacc+=pB1[r]; l_reg+=sacc;
    pw0=(u32x4){PKW(pB0,0),PKW(pB0,2),PKW(pB0,4),PKW(pB0,6)};pw1=(u32x4){PKW(pB0,8),PKW(pB0,10),PKW(pB0,12),PKW(pB0,14)};pw2=(u32x4){PKW(pB1,0),PKW(pB1,2),PKW(pB1,4),PKW(pB1,6)};pw3=(u32x4){PKW(pB1,8),PKW(pB1,10),PKW(pB1,12),PKW(pB1,14)};
    SBAR(); pv(o,vb0+sl_cur,PAF(0),PAF(1),PAF(2),PAF(3)); }
  #undef PKW
  #undef PAF
  #undef VFR
  #undef PIN
  #undef MX3
  #undef GAPA
  #undef GAPB
  #undef EX
  #undef VRD
  #undef KRD
  #undef STEP
  #undef ENDW
  {auto rr=__builtin_amdgcn_permlane32_swap(__float_as_uint(l_reg),__float_as_uint(l_reg),false,false);l_reg=__uint_as_float(rr[0])+__uint_as_float(rr[1]);}
  if(hi==0)wsf[32+r32]=l_reg;asm volatile("s_waitcnt lgkmcnt(0)":::"memory");
  float rli[16];
  #pragma unroll
  for(int r=0;r<16;++r)rli[r]=__builtin_amdgcn_rcpf(wsf[32+crow(r,hi)]);
  bf16*Ow=(MODE==0)?O+(rowbase+q0+wid*QBLK)*OPI+h*D:O+(rowbase+q0)*OPI+wid*D;
  { bf16*stg=(bf16*)(shm+LDS_OST)+wid*2048;
    #pragma unroll
    for(int r=0;r<16;++r){const int orow=crow(r,hi);
      #pragma unroll
      for(int d0=0;d0<2;++d0)stg[orow*64+d0*32+r32]=__float2bfloat16(o[d0][r]*rli[r]);}
    asm volatile("s_waitcnt lgkmcnt(0)":::"memory");
    #pragma unroll
    for(int i=0;i<4;++i){const int row=i*8+(lane>>3),ch=lane&7; const u32x4 v=*(const u32x4*)(stg+row*64+ch*8); ATTN_STORE16(Ow+(long)row*OPI+ch*8,v);} }
  asm volatile("s_waitcnt lgkmcnt(0)\n\ts_barrier":::"memory");
  #undef DMA_K
  #undef DMA_V
  #undef CMASK
  #undef START
  #undef BIAS
  #undef SELM
  #undef RESC
  #undef ROT
}
#undef SBAR
#undef WAIT_BAR
}

#ifndef DBG_REP_SEL
#define DBG_REP_SEL 1
#endif
namespace mix {
__device__ __forceinline__ void fox_unit2(int b, int h, int qb, const bf16_t* Z1, const float* F, const float* bfp, bf16_t* Y, char* shm, const int wave_s) {
    const size_t rowb = (size_t)b * SEQ;
    const int nk = 256 * (qb + 1);
    auto cumfn = [=]() {
        const int tid = wave_s * 64 + lane_opaque(), lane = tid & 63; const int wid = __builtin_amdgcn_readfirstlane(tid >> 6);
        MLAS char* L = (MLAS char*)shm;
        MLAS float* cum2 = (MLAS float*)(L + foxa::CUM_OFF);
        MLAS float* wtot = (MLAS float*)(L + foxa::CUM_OFF + 8192);
        const float bias = bfp[h];
        const int s0 = 4 * tid;
        float v[4]; float run = 0.f;
#pragma unroll
        for (int i = 0; i < 4; ++i) {
            float x = 0.f;
            if (s0 + i < nk) x = F[(rowb + s0 + i) * 8 + h] + bias;
            const float ls = (s0 + i < nk) ? (fminf(x, 0.f) - log1pf(expf(-fabsf(x)))) : 0.f;
            run += ls; v[i] = run;
        }
        float inc = run;
#pragma unroll
        for (int o = 1; o < 64; o <<= 1) { const int ln = lane_opaque(); const float t = __builtin_bit_cast(float, __builtin_amdgcn_ds_bpermute((ln - o) << 2, __builtin_bit_cast(int, inc))); if (ln >= o) inc += t; }
        if (lane == 63) wtot[wid] = inc;
        LGKM_BAR();
        float off = inc - run;
        for (int w = 0; w < wid; ++w) off += wtot[w];
#pragma unroll
        for (int i = 0; i < 4; ++i) cum2[s0 + i] = (off + v[i]) * 1.4426950408889634f;
        LGKM_BAR();
    };
    foxa::attn_unit<8, 0, 2560>(cumfn, b, h, qb, 0, 0, (const foxa::bf16*)Z1, (const foxa::bf16*)(Z1 + 512), (const foxa::bf16*)(Z1 + 1024), (foxa::bf16*)Y, shm, nullptr, wave_s);
}
__device__ __forceinline__ void dsa_unit(int b, int qg, const bf16_t* Z0, bf16_t* Y, char* shm, unsigned lds0, const int wave_s) {
    for (int rep_ = 0; rep_ < DBG_REP_SEL; ++rep_) dsa_select(b, qg, Z0, shm, wave_s);
    const int nt64 = (qg >> 1) + 1; int ntu = (nt64 + 1) & ~1; if (ntu < 4) ntu = 4;
    foxa::attn_unit<8, 1, EV_N>([]() {}, b, 0, 0, 32 * qg, ntu, (const foxa::bf16*)(Z0 + 512), (const foxa::bf16*)(Z0 + 1024), (const foxa::bf16*)(Z0 + 1088), (foxa::bf16*)(Y + 512), shm,
                                (const MLAS unsigned*)((MLAS char*)shm + LX_SEL), wave_s);
}
}
constexpr int NWAVES = 8;
constexpr size_t KiB = 1024, MiB = 1u << 20;
constexpr size_t WS_CTL = 0, CTL_ZERO_BYTES = 1 * MiB;
constexpr size_t WS_W_EVIN = 1 * MiB, WS_W_OUT0 = 4 * MiB, WS_W_FFI0 = 6 * MiB, WS_W_FFO0 = 17 * MiB, WS_W_PG0 = 22 * MiB + 512 * KiB, WS_W_PP0 = 24 * MiB + 512 * KiB;
constexpr size_t WS_W_ODIN = 25 * MiB, WS_W_OUT1 = 30 * MiB + 512 * KiB, WS_W_FFI1 = 32 * MiB + 512 * KiB, WS_W_FFO1 = 43 * MiB + 512 * KiB, WS_W_PG1 = 49 * MiB, WS_W_PP1 = 51 * MiB, WS_W_SGU = 51 * MiB + 512 * KiB;
constexpr size_t WS_RSTD = 57 * MiB + 768 * KiB;
constexpr size_t WS_SSQA = 52 * MiB, WS_SSQB = 53 * MiB, WS_ROPE = 54 * MiB, WS_AH = 55 * MiB, WS_FBUF = 58 * MiB + 512 * KiB, WS_SST = 59 * MiB;
constexpr size_t WS_HB = 60 * MiB, WS_AHALO = 92 * MiB, WS_PP = 92 * MiB + 512 * KiB, WS_Y = 124 * MiB + 512 * KiB, WS_ZH = 156 * MiB + 512 * KiB, WS_PB = 244 * MiB + 512 * KiB, WS_END = 252 * MiB + 512 * KiB;
static_assert(WS_AHALO == WS_HB + (size_t)TOK * 1024 * 2, "the halo rows are row tile 64 of the FFN in-projection A operand");
static_assert(WS_W_EVIN + (size_t)EV_N * 1024 * 2 <= WS_W_OUT0 && WS_W_FFI0 + (size_t)NFF2 * 1024 * 2 <= WS_W_FFO0 && WS_W_FFO0 + (size_t)1024 * DFF * 2 <= WS_W_PG0, "ws map 1");
static_assert(WS_W_ODIN + (size_t)OD_N * 1024 * 2 <= WS_W_OUT1 && WS_W_FFI1 + (size_t)NFF2 * 1024 * 2 <= WS_W_FFO1 && WS_W_FFO1 + (size_t)1024 * DFF * 2 <= WS_W_PG1 && WS_W_SGU + 4 * 128 * 128 * 2 <= WS_SSQA, "ws map 2");
static_assert(WS_AH + (size_t)128 * NFF2 * 4 <= WS_RSTD && WS_ZH + (size_t)TOK * DFF * 2 <= WS_PB && WS_PB + (size_t)TOK * PLE * 2 <= WS_END, "ws map 3");
constexpr int CW_BAR = 4096, CW_FLAG = 8192, CW_PAN = 16384;
constexpr int RING_BYTES = 131072, XB_OFF = RING_BYTES, LDSCTL_OFF = XB_OFF + 8192 + 1024 + 64, MISC_OFF = LDSCTL_OFF + 320, LDS_BYTES = 147456;
static_assert(MISC_OFF + 128 <= LDS_BYTES, "LDS map");

#define GAS __attribute__((address_space(1)))
#define LAS __attribute__((address_space(3)))
typedef unsigned short bf16;
typedef unsigned v4u __attribute__((ext_vector_type(4)));
typedef float f32x4 __attribute__((ext_vector_type(4)));
typedef float f32x2 __attribute__((ext_vector_type(2)));
#define LDS_WAIT() asm volatile("s_waitcnt lgkmcnt(0)" ::: "memory")
#define VM_WAIT() asm volatile("s_waitcnt vmcnt(0)" ::: "memory")
__device__ __forceinline__ unsigned f2bf(float f) { unsigned u = __builtin_bit_cast(unsigned, f); return (u + 0x7fffu + ((u >> 16) & 1u)) >> 16; }
__device__ __forceinline__ unsigned pk2(float lo, float hi) { return f2bf(lo) | (f2bf(hi) << 16); }

#define XB_TMO      128
#define XB_XCNT(j)  (256  + 64 * (j))
#define XB_XSUB(j)  (1280 + 64 * (j))
#define XB_XGEN(j)  (2304 + 64 * (j))
#define XB_TOP      3328
#define XB_TOPGEN   3392
#define XCD_BAR_WORDS 3456
#define XB_SPIN_CAP (1u << 18)
__device__ __forceinline__ unsigned xb_ld(unsigned* p)              { return __hip_atomic_load(p, __ATOMIC_RELAXED, __HIP_MEMORY_SCOPE_AGENT); }
__device__ __forceinline__ unsigned xb_add(unsigned* p, unsigned v) { return __hip_atomic_fetch_add(p, v, __ATOMIC_RELAXED, __HIP_MEMORY_SCOPE_AGENT); }
__device__ __forceinline__ unsigned xb_xcc_id() { return (unsigned)__builtin_amdgcn_s_getreg((3 << 11) | 20) & 0xFu; }
#define XB_SPIN(cond, bar) do { unsigned _sp = 0; while (cond) { __builtin_amdgcn_s_sleep(1); \
    if ((++_sp & 255u) == 0u) { if (xb_ld(&(bar)[XB_TMO])) break; if (_sp > XB_SPIN_CAP) { atomicAdd(&(bar)[XB_TMO], 1u); break; } } } } while (0)
struct XcdBarrier { unsigned* bar; unsigned x; volatile LAS unsigned* st; };
__device__ __forceinline__ XcdBarrier xcd_barrier_post(unsigned* bar, volatile LAS unsigned* st) {
    XcdBarrier b; b.bar = bar; b.x = xb_xcc_id(); b.st = st;
    if (threadIdx.x == 0) (void)xb_add(&bar[XB_XCNT(b.x)], 1u);
    return b;
}
__device__ __forceinline__ void xcd_barrier_complete(unsigned* bar, unsigned x, unsigned& nloc, unsigned& nx) {
    const unsigned G = gridDim.x * gridDim.y * gridDim.z;
    unsigned sum, cnt, mine, sp = 0u;
    for (;;) {
        sum = 0u; cnt = 0u; mine = 0u;
#pragma unroll 1
        for (unsigned j = 0; j < 16; ++j) { const unsigned c = xb_ld(&bar[XB_XCNT(j)]); sum += c; cnt += (c > 0u) ? 1u : 0u; mine = (j == x) ? c : mine; }
        if (sum == G) break;
        __builtin_amdgcn_s_sleep(1);
        if ((++sp & 255u) == 0u) { if (xb_ld(&bar[XB_TMO])) break; if (sp > XB_SPIN_CAP) { atomicAdd(&bar[XB_TMO], 1u); break; } }
    }
    nloc = mine > 0u ? mine : 1u; nx = cnt > 0u ? cnt : 1u;
}
__device__ __forceinline__ void xcd_barrier(const XcdBarrier& b) {
    asm volatile("s_waitcnt vmcnt(0)" ::: "memory");
    __syncthreads();
    if (threadIdx.x == 0) {
        unsigned* bar = b.bar;
        __builtin_amdgcn_s_waitcnt(0);
        unsigned nloc = b.st[0], nx = b.st[1];
        if (nloc == 0u) { xcd_barrier_complete(bar, b.x, nloc, nx); b.st[0] = nloc; b.st[1] = nx; }
        const unsigned old = xb_add(&bar[XB_XSUB(b.x)], 1u);
        const unsigned gen = old / nloc;
        if (old + 1u == (gen + 1u) * nloc) {
            __builtin_amdgcn_fence(__ATOMIC_RELEASE, "agent");
            asm volatile("s_waitcnt vmcnt(0)" ::: "memory");
            const unsigned og = xb_add(&bar[XB_TOP], 1u);
            const unsigned tg = og / nx;
            if (og + 1u == (tg + 1u) * nx) xb_add(&bar[XB_TOPGEN], 1u);
            else XB_SPIN(xb_ld(&bar[XB_TOPGEN]) == tg, bar);
            __builtin_amdgcn_fence(__ATOMIC_ACQUIRE, "agent");
            xb_add(&bar[XB_XGEN(b.x)], 1u);
            asm volatile("s_waitcnt vmcnt(0)" ::: "memory");
        } else {
            XB_SPIN(xb_ld(&bar[XB_XGEN(b.x)]) == gen, bar);
            __builtin_amdgcn_fence(__ATOMIC_ACQUIRE, "agent");
            asm volatile("s_waitcnt vmcnt(0)" ::: "memory");
        }
    }
    __syncthreads();
}

__device__ __forceinline__ float wave_sum(float v) {
#pragma unroll
    for (int o = 1; o < 64; o <<= 1) v += __builtin_bit_cast(float, __builtin_amdgcn_ds_bpermute((lane_opaque() ^ o) << 2, __builtin_bit_cast(int, v)));
    return v;
}
__device__ __forceinline__ int vcu_of(int i, int n) { return i; }
__device__ __forceinline__ int unperm16(int d) { return d < 16 ? ((d >> 1) + 8 * (d & 1)) : d; }
__device__ __forceinline__ int map_col(int type, int n, int nold) {
    if (type == 0) return n < nold ? n : -1;
    if (type == 1) {
        if (n < 512) return n;
        if (n < 1024) { const int h = (n - 512) >> 6, d = (n - 512) & 63; return 512 + 64 * h + unperm16(d); }
        if (n < 1088) return 1024 + unperm16(n - 1024);
        if (n < 1152) return n;
        if (n < 1216) return 1408 + unperm16(n - 1152);
        if (n < 1220) return 1472 + (n - 1216);
        if (n < 1280) return -1;
        { const int h = (n - 1280) >> 6, d = (n - 1280) & 63; return 1152 + 64 * h + unperm16(d); }
    }
    if (type == 2) {
        if (n < 1536) return n;
        if (n < 2560) return n + 8;
        if (n < 2568) return 1536 + (n - 2560);
        return -1;
    }
    { const int pn = n >> 8, bj = (n >> 7) & 1, jj = n & 127; return bj * DFF + 128 * pn + jj; }
}
struct TJob { const float* W; const float* rowscale; bf16* WT; int K, Nold, Nnew, ldk, koff, type, nitems; };
__device__ __forceinline__ void transpose_item(const TJob& J, LAS float* scr, int item, int lane) {
    const int nblk = J.Nnew / 32, kb = item / nblk, nb = item % nblk, k0 = 64 * kb, n0 = 32 * nb;
    const int oc = map_col(J.type, n0 + (lane & 31), J.Nold);
    const int occ = oc >= 0 ? oc : 0;
    float vv[32];
#pragma unroll
    for (int i = 0; i < 32; ++i) vv[i] = J.W[(size_t)(k0 + 2 * i + (lane >> 5)) * J.Nold + occ];
#pragma unroll
    for (int i = 0; i < 32; ++i) { const int kk = 2 * i + (lane >> 5);
        float v = (oc >= 0) ? vv[i] : 0.f;
        if (J.rowscale) v *= J.rowscale[k0 + kk];
        scr[kk * 33 + (lane & 31)] = v; }
    LDS_WAIT(); asm volatile("" ::: "memory");
    const int c = lane & 7;
#pragma unroll
    for (int j = 0; j < 4; ++j) { const int n = (lane >> 3) + 8 * j; const LAS float* s = scr + (8 * c) * 33 + n;
        v4u o; o.x = pk2(s[0 * 33], s[1 * 33]); o.y = pk2(s[2 * 33], s[3 * 33]); o.z = pk2(s[4 * 33], s[5 * 33]); o.w = pk2(s[6 * 33], s[7 * 33]);
        *(GAS v4u*)(J.WT + (size_t)(n0 + n) * J.ldk + J.koff + k0 + 8 * c) = o; }
    LDS_WAIT(); asm volatile("" ::: "memory");
}
__device__ __forceinline__ void sincos_d(double a, float& sn, float& cs) {
    const double q = rint(a * 0.63661977236758134308);
    double r = a - q * 1.57079632673412561417e+00; r -= q * 6.07710050650619224932e-11;
    const double r2 = r * r;
    double s = 1.0 / 6227020800.0; s = s * r2 - 1.0 / 39916800.0; s = s * r2 + 1.0 / 362880.0; s = s * r2 - 1.0 / 5040.0; s = s * r2 + 1.0 / 120.0; s = s * r2 - 1.0 / 6.0; s = s * r2 * r + r;
    double c = -1.0 / 87178291200.0; c = c * r2 + 1.0 / 479001600.0; c = c * r2 - 1.0 / 3628800.0; c = c * r2 + 1.0 / 40320.0; c = c * r2 - 1.0 / 720.0; c = c * r2 + 1.0 / 24.0; c = c * r2 - 0.5; c = c * r2 + 1.0;
    const int qi = ((int)q) & 3;
    const double ss = (qi == 0) ? s : (qi == 1) ? c : (qi == 2) ? -s : -c;
    const double cc = (qi == 0) ? c : (qi == 1) ? -s : (qi == 2) ? -c : s;
    sn = (float)ss; cs = (float)cc;
}

struct Args { const void* in[24]; float* out; unsigned char* ws; int ph_lo, ph_hi; };
typedef const Args __attribute__((address_space(4)))* argp_t;
__device__ __forceinline__ argp_t get_args() { argp_t p = (argp_t)__builtin_amdgcn_kernarg_segment_ptr(); asm volatile("" : "+s"(p)); return p; }
__device__ __forceinline__ int otid(int wave_s) { return wave_s * 64 + lane_opaque(); }
#define IN_F(k) ((const float*)A_->in[k])
#define PH_LOCALS \
    argp_t A_ = get_args(); unsigned char* const ws = A_->ws; float* const out = A_->out; (void)out; \
    const int tid = otid(wave_s), lane = tid & 63, wave = wave_s; (void)lane; (void)wave; \
    const int G = gridDim.x, bx = blockIdx.x, vcu = (G % 8 == 0) ? (bx % 8) * (G / 8) + bx / 8 : bx; (void)vcu; \
    const int gw = vcu * NWAVES + wave, NGW = G * NWAVES, gt = vcu * (NWAVES * 64) + tid, NGT = G * NWAVES * 64; (void)gw; (void)NGW; (void)gt; (void)NGT; \
    LAS unsigned char* const L = (LAS unsigned char*)lds; (void)L;
#define WSP(T, off) ((T*)(ws + (off)))

__global__ void __launch_bounds__(NWAVES * 64, 2) mega_fwd(Args args) {
    extern __shared__ __attribute__((aligned(16))) unsigned char lds[];
    int lo, hi; XcdBarrier bar;
    const int wave_s = __builtin_amdgcn_readfirstlane((int)threadIdx.x >> 6);
    {
        PH_LOCALS
        volatile LAS unsigned* MISC = (volatile LAS unsigned*)(L + MISC_OFF);
        for (int u = tid; u < (LDS_BYTES - XB_OFF) / 4; u += NWAVES * 64) ((LAS unsigned*)(L + XB_OFF))[u] = 0u;
        __syncthreads();
        bar = xcd_barrier_post((unsigned*)(ws + WS_CTL) + CW_BAR, MISC + 8);
        lo = A_->ph_lo; hi = A_->ph_hi;
    }
#ifndef DBG_REP_TR
#define DBG_REP_TR 1
#endif
#ifndef DBG_REP_HB
#define DBG_REP_HB 1
#endif
#ifndef DBG_REP_FOX
#define DBG_REP_FOX 1
#endif
#ifndef DBG_REP_DSA
#define DBG_REP_DSA 1
#endif
#ifndef DBG_REP_SGU
#define DBG_REP_SGU 1
#endif
#ifndef DBG_REP_POOL
#define DBG_REP_POOL 1
#endif
#ifndef PHMASK
#define PHMASK 0xff7fffu
#endif
#define IN(k) (((PHMASK >> (k)) & 1u) && lo <= (k) && (k) < hi)
#define SEAM(k) do { if (IN(k) && IN((k) + 1)) xcd_barrier(bar); } while (0)
    if (IN(0)) {
        PH_LOCALS
        LAS float* scr = (LAS float*)(L + wave * 16384);
        const float* norm_mix = IN_F(3); const float* norm_ffn = IN_F(4); const float* norm_ple = IN_F(5);
        const float* ffn_w_in = IN_F(6); const float* ffn_w_out = IN_F(9); const float* ple_w_proj = IN_F(10); const float* ple_w_gate = IN_F(11);
        const float* ev_w_in = IN_F(13); const float* ev_w_out = IN_F(14); const float* od_w_in = IN_F(17); const float* od_w_out = IN_F(18);
#define TJ(Wp, RS, WTp, K_, NOLD, NNEW, LDK, KOFF, TYPE) { constexpr int NI_ = ((K_) / 64) * ((NNEW) / 32); if (r < NI_) { const TJob J{(Wp), (RS), (WTp), (K_), (NOLD), (NNEW), (LDK), (KOFF), (TYPE), NI_}; transpose_item(J, scr, r, lane); continue; } r -= NI_; }
        constexpr int NITEMS = 16 * 48 + 8 * 32 + 44 * 32 + 4 * 32;
        for (int rep_ = 0; rep_ < DBG_REP_TR; ++rep_) for (int it = gw; it < NITEMS; it += NGW) {
            int r = it;
            TJ(ev_w_in, norm_mix, WSP(bf16, WS_W_EVIN), 1024, 1476, EV_N, 1024, 0, 1)
            TJ(ev_w_out + (size_t)512 * 1024, nullptr, WSP(bf16, WS_W_OUT0), 512, 1024, 1024, 1024, 512, 0)
            TJ(ffn_w_out + (size_t)DFF * 1024, nullptr, WSP(bf16, WS_W_FFO1), DFF, 1024, 1024, DFF, 0, 0)
            TJ(ple_w_proj + (size_t)256 * 1024, nullptr, WSP(bf16, WS_W_PP1), 256, 1024, 1024, 256, 0, 0)
        }
#undef TJ
        { const float* sgu_w = IN_F(22); bf16* W_SGU = WSP(bf16, WS_W_SGU);
          for (int i = gt; i < 4 * 128 * 128; i += NGT) { const int jj = i & 127, ii = (i >> 7) & 127; W_SGU[i] = (bf16)((ii < 64 && jj >= 64) ? 0u : f2bf(sgu_w[i])); } }
        { const float* x = IN_F(0); bf16* HB = WSP(bf16, WS_HB); float* SSQA = WSP(float, WS_SSQA);
          for (int m = gw; m < TOK; m += 4 * NGW) {
            f32x4 v[4][4];
#pragma unroll
            for (int q = 0; q < 4; ++q) { const int mm = (m + q * NGW < TOK) ? m + q * NGW : m; const f32x4* xr = (const f32x4*)(x + (size_t)mm * DMODEL) + lane;
#pragma unroll
                for (int j = 0; j < 4; ++j) v[q][j] = xr[64 * j]; }
#pragma unroll
            for (int q = 0; q < 4; ++q) { const int mm = m + q * NGW; if (mm < TOK) {
                float s = 0.f; unsigned long long* o8 = (unsigned long long*)(HB + (size_t)mm * DMODEL) + lane;
#pragma unroll
                for (int j = 0; j < 4; ++j) { const f32x4 w = v[q][j]; s += (w.x * w.x + w.y * w.y) + (w.z * w.z + w.w * w.w);
                    o8[64 * j] = (unsigned long long)pk2(w.x, w.y) | ((unsigned long long)pk2(w.z, w.w) << 32); }
                s = wave_sum(s);
                if (lane < 16) SSQA[(size_t)mm * 16 + lane] = (lane == 0) ? s : 0.f; } }
          } }
        { const float* p_in = IN_F(1); bf16* PB = WSP(bf16, WS_PB);
          for (int i = gt; i < TOK * PLE / 4; i += 4 * NGT) { f32x4 v[4];
#pragma unroll
            for (int q = 0; q < 4; ++q) v[q] = ((const f32x4*)p_in)[(i + q * NGT < TOK * PLE / 4) ? i + q * NGT : i];
#pragma unroll
            for (int q = 0; q < 4; ++q) if (i + q * NGT < TOK * PLE / 4) ((unsigned long long*)PB)[i + q * NGT] = (unsigned long long)pk2(v[q].x, v[q].y) | ((unsigned long long)pk2(v[q].z, v[q].w) << 32); } }
        { const int* positions = (const int*)A_->in[2]; f32x2* ROPE = WSP(f32x2, WS_ROPE);
          for (int i = gt; i < TOK * 8; i += NGT) {
            const int row = i >> 3, j = i & 7;
            const float invf = (j == 0) ? 1.0f : (j == 1) ? 0.1939227432012558f : (j == 2) ? 0.03760603070259094f : (j == 3) ? 0.007292664609849453f : (j == 4) ? 0.0014142135623842478f :
                               (j == 5) ? 0.00027424818836152554f : (j == 6) ? 5.3182957344688475e-05f : 1.0313385246263351e-05f;
            const float ang = (float)positions[row] * invf;
            float sn, cs; sincos_d((double)ang, sn, cs);
            ROPE[i] = (f32x2){cs, sn};
          } }
    }
    SEAM(0);
    if (IN(1)) {
        { PH_LOCALS
          pg8::Gemm g{WSP(bf16, WS_HB), WSP(bf16, WS_W_EVIN), TOK, EV_N, 1024}; pg8::StaticOrder S; S.init(TOK, EV_N, G, bx);
          pg8::EpiEvenIn E{WSP(float, WS_SSQA), WSP(bf16, WS_ZH), WSP(const pg8::f32x2, WS_ROPE)};
          pg8::gemm_phase<pg8::EpiEvenIn, pg8::StaticOrder, true, true>(L, g, S, E, wave_s); }
        if (gridDim.x == 256 && blockIdx.x >= 128) {
            PH_LOCALS
            LAS float* scr = (LAS float*)(L + wave * 16384);
            const float* norm_mix = IN_F(3); const float* norm_ffn = IN_F(4); const float* norm_ple = IN_F(5);
            const float* ffn_w_in = IN_F(6); const float* ffn_w_out = IN_F(9); const float* ple_w_proj = IN_F(10); const float* ple_w_gate = IN_F(11);
            const float* od_w_in = IN_F(17); const float* od_w_out = IN_F(18);
#define TJ(Wp, RS, WTp, K_, NOLD, NNEW, LDK, KOFF, TYPE) { constexpr int NI_ = ((K_) / 64) * ((NNEW) / 32); if (r < NI_) { const TJob J{(Wp), (RS), (WTp), (K_), (NOLD), (NNEW), (LDK), (KOFF), (TYPE), NI_}; transpose_item(J, scr, r, lane); continue; } r -= NI_; }
            constexpr int NITEMS_B = (16 * 176 + 44 * 32 + 16 * 32 + 4 * 32) + 16 * 88 + 16 * 32;
            const int gwb = (vcu_of(bx - 128, 128)) * NWAVES + wave, NGWB = 128 * NWAVES;
            for (int it = gwb; it < NITEMS_B; it += NGWB) {
                int r = it;
                TJ(ffn_w_in, norm_ffn, WSP(bf16, WS_W_FFI0), 1024, NFF2, NFF2, 1024, 0, 3)
                TJ(ffn_w_out, nullptr, WSP(bf16, WS_W_FFO0), DFF, 1024, 1024, DFF, 0, 0)
                TJ(ple_w_gate, norm_ple, WSP(bf16, WS_W_PG0), 1024, 1024, 1024, 1024, 0, 0)
                TJ(ple_w_proj, nullptr, WSP(bf16, WS_W_PP0), 256, 1024, 1024, 256, 0, 0)
                TJ(od_w_in, norm_mix + 1024, WSP(bf16, WS_W_ODIN), 1024, 2568, OD_N, 1024, 0, 2)
                TJ(od_w_out, nullptr, WSP(bf16, WS_W_OUT1), 1024, 1024, 1024, 1024, 0, 0)
            }
#undef TJ
        {
            const float* pool_w = IN_F(15); const float* pool_scale = IN_F(16); const float* ev_w_out = IN_F(14); bf16* W_OUT0 = WSP(bf16, WS_W_OUT0);
            for (int it = gwb; it < 1024; it += NGWB) {
                const int g = it >> 8, nb = (it >> 4) & 15, cb = it & 15, n = 64 * nb + lane;
                float acc[8];
#pragma unroll
                for (int cc = 0; cc < 8; ++cc) acc[cc] = 0.f;
#pragma unroll 1
                for (int d0 = 0; d0 < 128; d0 += 16) {
                    float wv[16];
#pragma unroll
                    for (int e = 0; e < 16; ++e) wv[e] = ev_w_out[(size_t)(128 * g + d0 + e) * 1024 + n] * pool_scale[128 * g + d0 + e];
#pragma unroll
                    for (int cc = 0; cc < 8; ++cc) {
                        const float* pw = pool_w + ((size_t)g * 128 + 8 * cb + cc) * 128 + d0;
#pragma unroll
                        for (int e = 0; e < 16; ++e) acc[cc] += pw[e] * wv[e];
                    }
                }
#pragma unroll
                for (int c2 = 0; c2 < 4; ++c2) *(unsigned*)(W_OUT0 + (size_t)n * 1024 + 128 * g + 8 * cb + 2 * c2) = pk2(acc[2 * c2], acc[2 * c2 + 1]);
            }
        }
        }
    }
    SEAM(1);
    if (IN(2)) {
        { PH_LOCALS
          const bf16* ZH = WSP(bf16, WS_ZH); bf16* Y = WSP(bf16, WS_Y); const unsigned lds0 = (unsigned)(uintptr_t)lds;
          for (int pi = vcu; pi < 256; pi += G) {
            const int b = pi >> 5, s = pi & 31;
#pragma unroll 1
            for (int k = 0; k < 2 * DBG_REP_DSA; ++k) mix::dsa_unit(b, (k & 1) ? s : 63 - s, ZH, Y, (char*)lds, lds0, wave_s);
          } }
        { PH_LOCALS
          const bf16* ZH = WSP(bf16, WS_ZH); bf16* Y = WSP(bf16, WS_Y);
          for (int rep_ = 0; rep_ < DBG_REP_POOL; ++rep_) for (int it = gt; it < TOK * 64; it += NGT) mix::pool_item(it, ZH, Y);
        }
        { PH_LOCALS
          const float* p1 = IN_F(1) + (size_t)TOK * PLE; bf16* PB1 = (bf16*)out + (size_t)16 * 1024 * 1024;
          for (int i = gt; i < TOK * PLE / 4; i += 4 * NGT) { f32x4 v[4];
#pragma unroll
              for (int q = 0; q < 4; ++q) v[q] = ((const f32x4*)p1)[(i + q * NGT < TOK * PLE / 4) ? i + q * NGT : i];
#pragma unroll
              for (int q = 0; q < 4; ++q) if (i + q * NGT < TOK * PLE / 4) ((unsigned long long*)PB1)[i + q * NGT] = (unsigned long long)pk2(v[q].x, v[q].y) | ((unsigned long long)pk2(v[q].z, v[q].w) << 32); }
        }
    }
    SEAM(2);
    {
        const size_t s1o = (0 == 0) ? WS_SSQA : WS_SSQB, s2o = (0 == 0) ? WS_SSQB : WS_SSQA, s3o = s1o;
        if (IN(3)) {
            PH_LOCALS
            pg8::Gemm g{WSP(bf16, WS_Y), WSP(bf16, (0 == 0) ? WS_W_OUT0 : WS_W_OUT1), TOK, 1024, 1024}; pg8::StaticOrder S; S.init(TOK, 1024, G, bx);
            pg8::EpiRes E{nullptr, WSP(bf16, WS_HB), WSP(bf16, WS_HB), WSP(float, s1o), WSP(bf16, WS_AHALO)};
            pg8::gemm_phase<pg8::EpiRes, pg8::StaticOrder, true, true>(L, g, S, E, wave_s);
        }
        SEAM(3);
        if (IN(3 + 2)) {
            PH_LOCALS
            pg8::Gemm g{WSP(bf16, WS_HB), WSP(bf16, WS_W_FFI0), TOK + 256, NFF2, 1024}; pg8::StaticOrder S; S.init(TOK, NFF2, G, bx);
#ifdef STAGGER
            if (STAGGER_COND) { for (int i_ = 0; i_ < STAGGER; ++i_) __builtin_amdgcn_s_sleep(127); }
#endif
            if (G == 256 && bx >= 128 && bx < 128 + NFF2 / 256) {
                pg8::OneUnit S1{64, bx - 128, 1};
                pg8::EpiHaloF EH{WSP(float, s1o), WSP(float, WS_AH), (unsigned*)(ws + WS_CTL) + CW_FLAG + 2048 * 0};
                pg8::gemm_phase<pg8::EpiHaloF, pg8::OneUnit, true, true>(L, g, S1, EH, wave_s);
            }
#ifdef PP_FIRST
            if (G == 256 && bx >= 150) {
                pg8::Gemm gp{WSP(bf16, WS_PB), WSP(bf16, WS_W_PP0), TOK, 1024, PLE}; pg8::StaticOrder SP; SP.init(TOK, 1024, 106, bx - 150);
                pg8::EpiBf16Plain EP{WSP(bf16, WS_PP), 1024};
                pg8::gemm_phase<pg8::EpiBf16Plain, pg8::StaticOrder, true, true>(L, gp, SP, EP, wave_s);
            }
#endif
            pg8::EpiFfnIn E{WSP(float, s1o), IN_F(7) + (size_t)0 * 3 * NFF2, IN_F(8) + (size_t)0 * NFF2, WSP(float, WS_AH), WSP(bf16, WS_ZH), (LAS float*)(L + XB_OFF), (unsigned*)(ws + WS_CTL) + CW_FLAG + 2048 * 0, 1u};
            pg8::gemm_phase<pg8::EpiFfnIn, pg8::StaticOrder, true, true>(L, g, S, E, wave_s);
#ifndef PP_FIRST
            if (G == 256 && bx >= 150) {
                pg8::Gemm gp{WSP(bf16, WS_PB), WSP(bf16, WS_W_PP0), TOK, 1024, PLE}; pg8::StaticOrder SP; SP.init(TOK, 1024, 106, bx - 150);
                pg8::EpiBf16Plain EP{WSP(bf16, WS_PP), 1024};
                pg8::gemm_phase<pg8::EpiBf16Plain, pg8::StaticOrder, true, true>(L, gp, SP, EP, wave_s);
            }
#endif
        }
        SEAM(3 + 2);
        if (IN(3 + 3)) {
            PH_LOCALS
            pg8::Gemm g{WSP(bf16, WS_ZH), WSP(bf16, (0 == 0) ? WS_W_FFO0 : WS_W_FFO1), TOK, 1024, DFF}; pg8::StaticOrder S; S.init(TOK, 1024, G, bx);
            pg8::EpiRes E{nullptr, WSP(bf16, WS_HB), WSP(bf16, WS_HB), WSP(float, s2o), nullptr};
            pg8::gemm_phase<pg8::EpiRes, pg8::StaticOrder, true, true>(L, g, S, E, wave_s);
        }
        SEAM(3 + 3);
        if (IN(3 + 4)) {
            PH_LOCALS
            pg8::Gemm g{WSP(bf16, WS_HB), WSP(bf16, (0 == 0) ? WS_W_PG0 : WS_W_PG1), TOK, 1024, 1024}; pg8::StaticOrder S; S.init(TOK, 1024, G, bx);
            pg8::EpiGate E{WSP(float, s2o), WSP(bf16, WS_HB), WSP(bf16, WS_PP), (bf16*)out, WSP(float, s3o)};
            pg8::gemm_phase<pg8::EpiGate, pg8::StaticOrder, true, true>(L, g, S, E, wave_s);
        }
        SEAM(3 + 4);
    }
    {

            if (IN(8)) {
                { PH_LOCALS
                  pg8::Gemm g{(const bf16*)out, WSP(bf16, WS_W_ODIN), TOK, OD_N, 1024}; pg8::StaticOrder S; S.init(TOK, OD_N, G, bx);
                  pg8::EpiOddIn E{WSP(float, WS_SSQA), WSP(bf16, WS_ZH), WSP(float, WS_FBUF), WSP(float, WS_SST)};
                  pg8::gemm_phase<pg8::EpiOddIn, pg8::StaticOrder, true, true>(L, g, S, E, wave_s); }
                if (gridDim.x == 256 && blockIdx.x >= 192) {
                    PH_LOCALS
                    LAS float* scr = (LAS float*)(L + wave * 16384);
                    const float* norm_ffn = IN_F(4); const float* norm_ple = IN_F(5); const float* ffn_w_in = IN_F(6); const float* ple_w_gate = IN_F(11);
#define TJ(Wp, RS, WTp, K_, NOLD, NNEW, LDK, KOFF, TYPE) { constexpr int NI_ = ((K_) / 64) * ((NNEW) / 32); if (r < NI_) { const TJob J{(Wp), (RS), (WTp), (K_), (NOLD), (NNEW), (LDK), (KOFF), (TYPE), NI_}; transpose_item(J, scr, r, lane); continue; } r -= NI_; }
                    constexpr int NITEMS_C = 16 * 176 + 16 * 32;
                    const int gwc = (bx - 192) * NWAVES + wave, NGWC = 64 * NWAVES;
                    for (int it = gwc; it < NITEMS_C; it += NGWC) {
                        int r = it;
                        TJ(ffn_w_in + (size_t)1024 * NFF2, norm_ffn + 1024, WSP(bf16, WS_W_FFI1), 1024, NFF2, NFF2, 1024, 0, 3)
                        TJ(ple_w_gate + (size_t)1024 * 1024, norm_ple + 1024, WSP(bf16, WS_W_PG1), 1024, 1024, 1024, 1024, 0, 0)
                    }
#undef TJ
                }
            }
            SEAM(8);
            if (IN(9)) {
                { PH_LOCALS
                  const bf16* ZH = WSP(bf16, WS_ZH); bf16* Y = WSP(bf16, WS_Y); const unsigned lds0 = (unsigned)(uintptr_t)lds;
                  const float* FBUF = WSP(float, WS_FBUF); const float* fox_b_f = IN_F(19);
                  for (int pi = vcu; pi < 256; pi += G) {
                    const int bh = pi >> 2, s = pi & 3;
#pragma unroll 1
                    for (int k = 0; k < 2 * DBG_REP_FOX; ++k) mix::fox_unit2(bh >> 3, bh & 7, (k & 1) ? s : 7 - s, ZH, FBUF, fox_b_f, Y, (char*)lds, wave_s);
                  } }
                { PH_LOCALS
                  const bf16* ZH = WSP(bf16, WS_ZH); bf16* Y = WSP(bf16, WS_Y);
                  for (int rep_ = 0; rep_ < DBG_REP_SGU; ++rep_) for (int u = vcu; u < 512; u += G) mix::sgu_unit(u >> 6, (u >> 2) & 15, u & 3, ZH, WSP(float, WS_SST), IN_F(20), IN_F(21), WSP(bf16, WS_W_SGU), IN_F(23), Y, (char*)lds, wave_s); }
            }
            SEAM(9);
            }
    {
        const size_t s1o = (1 == 0) ? WS_SSQA : WS_SSQB, s2o = (1 == 0) ? WS_SSQB : WS_SSQA, s3o = s1o;
        if (IN(10)) {
            PH_LOCALS
            pg8::Gemm g{WSP(bf16, WS_Y), WSP(bf16, (1 == 0) ? WS_W_OUT0 : WS_W_OUT1), TOK, 1024, 1024}; pg8::StaticOrder S; S.init(TOK, 1024, G, bx);
            pg8::EpiRes E{nullptr, (const bf16*)out, WSP(bf16, WS_HB), WSP(float, s1o), WSP(bf16, WS_AHALO)};
            pg8::gemm_phase<pg8::EpiRes, pg8::StaticOrder, true, true>(L, g, S, E, wave_s);
        }
        SEAM(10);
        if (IN(10 + 2)) {
            PH_LOCALS
            pg8::Gemm g{WSP(bf16, WS_HB), WSP(bf16, WS_W_FFI1), TOK + 256, NFF2, 1024}; pg8::StaticOrder S; S.init(TOK, NFF2, G, bx);
#ifdef STAGGER
            if (STAGGER_COND) { for (int i_ = 0; i_ < STAGGER; ++i_) __builtin_amdgcn_s_sleep(127); }
#endif
            if (G == 256 && bx >= 128 && bx < 128 + NFF2 / 256) {
                pg8::OneUnit S1{64, bx - 128, 1};
                pg8::EpiHaloF EH{WSP(float, s1o), WSP(float, WS_AH), (unsigned*)(ws + WS_CTL) + CW_FLAG + 2048 * 1};
                pg8::gemm_phase<pg8::EpiHaloF, pg8::OneUnit, true, true>(L, g, S1, EH, wave_s);
            }
#ifdef PP_FIRST
            if (G == 256 && bx >= 150) {
                pg8::Gemm gp{(const bf16*)out + (size_t)16 * 1024 * 1024, WSP(bf16, WS_W_PP1), TOK, 1024, PLE}; pg8::StaticOrder SP; SP.init(TOK, 1024, 106, bx - 150);
                pg8::EpiBf16Plain EP{WSP(bf16, WS_PP), 1024};
                pg8::gemm_phase<pg8::EpiBf16Plain, pg8::StaticOrder, true, true>(L, gp, SP, EP, wave_s);
            }
#endif
            pg8::EpiFfnIn E{WSP(float, s1o), IN_F(7) + (size_t)1 * 3 * NFF2, IN_F(8) + (size_t)1 * NFF2, WSP(float, WS_AH), WSP(bf16, WS_ZH), (LAS float*)(L + XB_OFF), (unsigned*)(ws + WS_CTL) + CW_FLAG + 2048 * 1, 2u};
            pg8::gemm_phase<pg8::EpiFfnIn, pg8::StaticOrder, true, true>(L, g, S, E, wave_s);
#ifndef PP_FIRST
            if (G == 256 && bx >= 150) {
                pg8::Gemm gp{(const bf16*)out + (size_t)16 * 1024 * 1024, WSP(bf16, WS_W_PP1), TOK, 1024, PLE}; pg8::StaticOrder SP; SP.init(TOK, 1024, 106, bx - 150);
                pg8::EpiBf16Plain EP{WSP(bf16, WS_PP), 1024};
                pg8::gemm_phase<pg8::EpiBf16Plain, pg8::StaticOrder, true, true>(L, gp, SP, EP, wave_s);
            }
#endif
        }
        SEAM(10 + 2);
        if (IN(10 + 3)) {
            PH_LOCALS
            pg8::Gemm g{WSP(bf16, WS_ZH), WSP(bf16, (1 == 0) ? WS_W_FFO0 : WS_W_FFO1), TOK, 1024, DFF}; pg8::StaticOrder S; S.init(TOK, 1024, G, bx);
            pg8::EpiRes E{nullptr, WSP(bf16, WS_HB), WSP(bf16, WS_HB), WSP(float, s2o), nullptr};
            pg8::gemm_phase<pg8::EpiRes, pg8::StaticOrder, true, true>(L, g, S, E, wave_s);
        }
        SEAM(10 + 3);
        if (IN(10 + 4)) {
            PH_LOCALS
            pg8::Gemm g{WSP(bf16, WS_HB), WSP(bf16, (1 == 0) ? WS_W_PG0 : WS_W_PG1), TOK, 1024, 1024}; pg8::StaticOrder S; S.init(TOK, 1024, G, bx);
            pg8::EpiGateFinal E{WSP(float, s2o), WSP(bf16, WS_HB), WSP(bf16, WS_PP), WSP(float, s3o), (unsigned*)(ws + WS_CTL) + CW_PAN, IN_F(12), out, (LAS float*)(L + XB_OFF) + 2048};
            pg8::gemm_phase<pg8::EpiGateFinal, pg8::StaticOrder, true, true>(L, g, S, E, wave_s);
        }
        SEAM(10 + 4);
    }
    if (IN(15)) {
        PH_LOCALS
        const float* SSQB = WSP(float, WS_SSQB); const float* norm_final = IN_F(12); const bf16* H6 = WSP(bf16, WS_Y);
        for (int m = gw; m < TOK; m += 4 * NGW) {
            unsigned long long w[4][4]; float rs[4];
#pragma unroll
            for (int q = 0; q < 4; ++q) { const int mm = (m + q * NGW < TOK) ? m + q * NGW : m; rs[q] = pg8::row_rstd(SSQB, mm);
                const unsigned long long* hr = (const unsigned long long*)(H6 + (size_t)mm * DMODEL) + lane;
#pragma unroll
                for (int j = 0; j < 4; ++j) w[q][j] = hr[64 * j]; }
            const f32x4* gr = (const f32x4*)norm_final + lane;
            f32x4 gg[4];
#pragma unroll
            for (int j = 0; j < 4; ++j) gg[j] = gr[64 * j];
#pragma unroll
            for (int q = 0; q < 4; ++q) { const int mm = m + q * NGW; if (mm < TOK) { f32x4* xr = (f32x4*)(out + (size_t)mm * DMODEL) + lane;
#pragma unroll
                for (int j = 0; j < 4; ++j) { const unsigned long long ww = w[q][j];
                    const f32x4 v = {pg8::bf_lo((unsigned)ww), pg8::bf_hi((unsigned)ww), pg8::bf_lo((unsigned)(ww >> 32)), pg8::bf_hi((unsigned)(ww >> 32))};
                    __builtin_nontemporal_store(v * rs[q] * gg[j], xr + 64 * j); } } }
        }
    }
#undef IN
#undef SEAM
}

#ifndef MK_N_LAUNCHES
#define MK_N_LAUNCHES 1
#endif
constexpr int N_PHASES = 16;
extern "C" void kernel_launch(void* const* d_in, const int* in_sizes, int n_in, void* d_out, int out_size, void* d_ws, size_t ws_size, hipStream_t stream) {
    static int grid = 0;
    if (grid == 0) {
        if (n_in != 24 || out_size != TOK * DMODEL || ws_size < WS_END) { fprintf(stderr, "kernel_launch: unexpected shapes (n_in %d, out %d, ws %zu)\n", n_in, out_size, ws_size); grid = -1; return; }
        int dev = 0, cus = 0;
        if (hipGetDevice(&dev) != hipSuccess || hipDeviceGetAttribute(&cus, hipDeviceAttributeMultiprocessorCount, dev) != hipSuccess) { grid = -1; return; }
        if (hipFuncSetAttribute((const void*)mega_fwd, hipFuncAttributeMaxDynamicSharedMemorySize, LDS_BYTES) != hipSuccess) { fprintf(stderr, "kernel_launch: hipFuncSetAttribute failed\n"); grid = -1; return; }
        int per_cu = 0;
        if (hipOccupancyMaxActiveBlocksPerMultiprocessor(&per_cu, (const void*)mega_fwd, NWAVES * 64, LDS_BYTES) != hipSuccess || per_cu < 1) { fprintf(stderr, "kernel_launch: occupancy query says %d\n", per_cu); }
        (void)hipGetLastError();
        grid = cus;
    }
    if (grid < 0) return;
    (void)hipMemsetAsync((char*)d_ws + WS_CTL, 0, CTL_ZERO_BYTES, stream);
    Args a{};
    for (int i = 0; i < 24; ++i) a.in[i] = d_in[i];
    a.out = (float*)d_out; a.ws = (unsigned char*)d_ws;
#ifdef DBG_CHECK
    {
        using namespace dbg;
        auto LP = [&](int ph) { a.ph_lo = ph; a.ph_hi = ph + 1; hipLaunchKernelGGL(mega_fwd, dim3(grid), dim3(NWAVES * 64), LDS_BYTES, stream, a); };
        char* wsb = (char*)d_ws; float* ERR = (float*)(wsb + 512 * 1024); float* SNAP = (float*)(wsb + 600 * 1024); float* outp = (float*)d_out;
        const unsigned short* ZHp = (const unsigned short*)(wsb + WS_ZH); const unsigned short* Yp = (const unsigned short*)(wsb + WS_Y); const float* FB = (const float*)(wsb + WS_FBUF);
        const unsigned short* HBp = (const unsigned short*)(wsb + WS_HB); const unsigned short* H3p = (const unsigned short*)d_out;
        auto F = [&](int i) { return (const float*)d_in[i]; };
        const float* x = F(0);
        LP(0); LP(1);
        k_evenin<<<NS, 256, 0, stream>>>(x, F(3), F(13), (const int*)d_in[2], ZHp, ERR, 0);
        LP(2);
        k_pool<<<NS, 256, 0, stream>>>(ZHp, Yp, ERR, 1);
        k_dsa<<<NS, 256, 0, stream>>>(ZHp, Yp, ERR, 2);
        LP(3);
        k_outproj<<<NS, 256, 0, stream>>>(x, 0, SNAP, Yp, F(14), F(15), F(16), HBp, ERR, 3);
        for (int layer = 0; layer < 2; ++layer) {
            const int pb = layer ? 10 : 3, kb = layer ? 10 : 3;
            if (layer == 1) {
                LP(8);
                k_oddin<<<NS, 256, 0, stream>>>(H3p, F(3) + 1024, F(17), ZHp, FB, ERR, 7);
                LP(9);
                k_fox<<<NS, 256, 0, stream>>>(ZHp, FB, F(19), Yp, ERR, 8);
                k_sgu<<<NS, 256, 0, stream>>>(ZHp, F(20), F(21), F(22), F(23), Yp, ERR, 9);
                k_snap<<<NS, 256, 0, stream>>>(H3p, SNAP);
                LP(10);
                k_outproj<<<NS, 256, 0, stream>>>(nullptr, 1, SNAP, Yp, F(18), nullptr, nullptr, HBp, ERR, 10);
            }
            LP(pb + 1); LP(pb + 2);
            k_ffnin<<<NS, 256, 0, stream>>>(HBp, F(4) + 1024 * layer, F(6) + (size_t)layer * 1024 * NFF2, F(7) + (size_t)layer * 3 * NFF2, F(8) + (size_t)layer * NFF2, ZHp, ERR, kb + 1);
            k_snap<<<NS, 256, 0, stream>>>(HBp, SNAP);
            LP(pb + 3);
            k_ffnout<<<NS, 256, 0, stream>>>(SNAP, ZHp, F(9) + (size_t)layer * DFF * 1024, HBp, ERR, kb + 2);
            k_snap<<<NS, 256, 0, stream>>>(HBp, SNAP);
            LP(pb + 4);
            k_ple<<<NS, 256, 0, stream>>>(SNAP, F(1) + (size_t)layer * TOK * PLE, F(5) + 1024 * layer, F(10) + (size_t)layer * PLE * 1024, F(11) + (size_t)layer * 1024 * 1024, layer ? Yp : H3p, ERR, kb + 3);
        }
        k_snap<<<NS, 256, 0, stream>>>(Yp, SNAP);
        LP(15);
        k_final<<<NS, 256, 0, stream>>>(SNAP, F(12), outp, ERR, 14);
        t_dpp<<<1, 64, 0, stream>>>(ERR + 40);
        k_report<<<1024, 256, 0, stream>>>(ERR, 15, DBG_TOL, outp);
        return;
    }
#endif
    if (MK_N_LAUNCHES == 1) {
        a.ph_lo = 0; a.ph_hi = N_PHASES;
        hipLaunchKernelGGL(mega_fwd, dim3(grid), dim3(NWAVES * 64), LDS_BYTES, stream, a);
    } else {
#ifndef DBG_STOP
#define DBG_STOP N_PHASES
#endif
#ifndef DBG_DOUBLE
#define DBG_DOUBLE -1
#endif
        for (int ph = 0; ph < DBG_STOP; ++ph) { a.ph_lo = ph; a.ph_hi = ph + 1; const int reps = (ph == DBG_DOUBLE || (DBG_DOUBLE == 100 && (ph == 0 || ph == 1 || ph == 2 || ph == 4 || ph == 5 || ph == 8 || ph == 9 || ph == 11 || ph == 12))) ? 2 : 1;
            for (int r = 0; r < reps; ++r) hipLaunchKernelGGL(mega_fwd, dim3(grid), dim3(NWAVES * 64), LDS_BYTES, stream, a); }
    }
}
```

```cpp
#include <hip/hip_runtime.h>
#include <hip/hip_bf16.h>
#include <cstdio>
#include <cstdint>
#include <cmath>
constexpr int TOK = 16384, DMODEL = 1024, SEQ = 2048, NBATCH = 8;
constexpr int DFF = 2816, NFF2 = 5632, PLE = 256;
constexpr int EV_N = 1536;
constexpr int OD_N = 2816;
constexpr int Z1P = 2560;
constexpr float RMS_EPS = 1e-6f;
constexpr float C2 = 0.125f * 1.4426950408889634f;


__device__ __forceinline__ int lane_opaque() { unsigned z = 0u; asm volatile("" : "+v"(z)); return (int)__builtin_amdgcn_mbcnt_hi(~0u, __builtin_amdgcn_mbcnt_lo(~0u, z)); }
__device__ __forceinline__ float xor16_f(float v) { return __builtin_bit_cast(float, __builtin_amdgcn_ds_swizzle(__builtin_bit_cast(int, v), 0x401F)); }
__device__ __forceinline__ void halves_pair(unsigned v, unsigned& a, unsigned& b) { unsigned w = v; asm volatile("" : "+v"(w)); auto rr = __builtin_amdgcn_permlane32_swap(v, w, false, false); a = rr[0]; b = rr[1]; }
__device__ __forceinline__ float halves_sum_f(float v) { unsigned a, b; halves_pair(__builtin_bit_cast(unsigned, v), a, b); return __builtin_bit_cast(float, a) + __builtin_bit_cast(float, b); }
__device__ __forceinline__ float halves_max_f(float v) { unsigned a, b; halves_pair(__builtin_bit_cast(unsigned, v), a, b); return __builtin_fmaxf(__builtin_bit_cast(float, a), __builtin_bit_cast(float, b)); }
__device__ __forceinline__ unsigned halves_add_u(unsigned v) { unsigned a, b; halves_pair(v, a, b); return a + b; }
__device__ __forceinline__ unsigned halves_or_u(unsigned v) { unsigned a, b; halves_pair(v, a, b); return a | b; }
namespace pg8 {
#define PG8_LAS __attribute__((address_space(3)))
typedef unsigned short bf16_t;
typedef short bf16x8 __attribute__((ext_vector_type(8)));
typedef float f32x4 __attribute__((ext_vector_type(4)));
typedef unsigned u32x4 __attribute__((ext_vector_type(4)));
constexpr int BM = 256, BK = 64, HALF = 128, HTB = HALF * BK * 2  , STAGE_BYTES = 8 * HTB, NXCD = 8, WGM = 8;

__host__ __device__ __forceinline__ int lds_byte(int r, int c) { const int st = (r >> 4) * 2 + (c >> 5), rr = r & 15, cc = c & 31, ob = rr * 64 + cc * 2; return st * 1024 + (ob ^ (((ob >> 9) & 1) << 5)); }
__host__ __device__ __forceinline__ void stage_rc(int b, int& R, int& C) { const int st = b / 1024, sb = b % 1024, swz = sb ^ (((sb >> 9) & 1) << 5); R = (st >> 1) * 16 + swz / 64; C = (st & 1) * 32 + (swz % 64) / 2; }
__host__ __device__ __forceinline__ int perm32(int rho) { const int n = rho >> 4, i = rho & 15; return 8 * (i >> 2) + 4 * n + (i & 3); }

struct Unit { int pm, pn; };
struct Gemm { const bf16_t* A; const bf16_t* Bt; int M, N, K; };

struct StaticOrder {
    int nM, nN, nwg, G, c;
    __host__ __device__ void init(int M, int N, int G_, int c_) { nM = M / BM; nN = N / BM; nwg = nM * nN; G = G_; c = c_; }
    __host__ __device__ bool next(int i, Unit& u) const {
        const long L = (long)i * G + c; if (L >= nwg) return false;
        int wgid = (int)L; { const int q = nwg / NXCD, r = nwg % NXCD, xcd = wgid % NXCD, off = wgid / NXCD; wgid = (xcd < r ? xcd * (q + 1) : r * (q + 1) + (xcd - r) * q) + off; }
        const int nig = WGM * nN, gid = wgid / nig, fm = gid * WGM, gsz = (nM - fm) < WGM ? (nM - fm) : WGM;
        u.pm = fm + ((wgid % nig) % gsz); u.pn = (wgid % nig) / gsz; return true;
    }
    __device__ __forceinline__ void a_ready(const Unit&) const {}
    __device__ __forceinline__ void done(const Unit&) const {}
};

struct OneUnit {
    int pm, pn, on;
    __host__ __device__ bool next(int i, Unit& u) const { if (!on || i != 0) return false; u.pm = pm; u.pn = pn; return true; }
    __device__ __forceinline__ void a_ready(const Unit&) const {}
    __device__ __forceinline__ void done(const Unit&) const {}
};
struct FfnOrder {
    StaticOrder S0; int extra;
    __host__ __device__ void init(int M, int N, int G_, int c_) { S0.init(M, N, G_, c_); extra = (G_ == 256 && c_ >= 128 && c_ < 128 + N / BM) ? 1 : 0; }
    __host__ __device__ bool next(int i, Unit& u) const { if (extra) { if (i == 0) { u.pm = 64; u.pn = S0.c - 128; return true; } return S0.next(i - 1, u); } return S0.next(i, u); }
    __device__ __forceinline__ void a_ready(const Unit&) const {}
    __device__ __forceinline__ void done(const Unit&) const {}
};
typedef float f32x2 __attribute__((ext_vector_type(2)));
typedef unsigned u32x2 __attribute__((ext_vector_type(2)));
__device__ __forceinline__ unsigned cvt_pk_bf16(float lo, float hi) { unsigned r; asm volatile("v_cvt_pk_bf16_f32 %0, %1, %2" : "=v"(r) : "v"(lo), "v"(hi)); return r; }
__device__ __forceinline__ float bf_lo(unsigned w) { return __builtin_bit_cast(float, w << 16); }
__device__ __forceinline__ float bf_hi(unsigned w) { return __builtin_bit_cast(float, w & 0xffff0000u); }
__device__ __forceinline__ float sq4(const f32x4 v) { return (v[0] * v[0] + v[1] * v[1]) + (v[2] * v[2] + v[3] * v[3]); }
__device__ __forceinline__ float row_rstd(const float* ssq, int row) {
    const f32x4* p = (const f32x4*)(ssq + (size_t)row * 16);
    const f32x4 a = p[0], b = p[1], c = p[2], d = p[3];
    const float s = (((a[0] + a[1]) + (a[2] + a[3])) + ((b[0] + b[1]) + (b[2] + b[3]))) + (((c[0] + c[1]) + (c[2] + c[3])) + ((d[0] + d[1]) + (d[2] + d[3])));
    return 1.0f / sqrtf(s * (1.0f / 1024.0f) + RMS_EPS);
}
__device__ __forceinline__ float row_rstd_coh(const float* ssq, int row) {
    const float* p = ssq + (size_t)row * 16;
    f32x4 a, b, c, d;
    asm volatile("global_load_dwordx4 %0, %4, off sc1\n\tglobal_load_dwordx4 %1, %4, off offset:16 sc1\n\tglobal_load_dwordx4 %2, %4, off offset:32 sc1\n\tglobal_load_dwordx4 %3, %4, off offset:48 sc1\n\ts_waitcnt vmcnt(0)"
                 : "=&v"(a), "=&v"(b), "=&v"(c), "=&v"(d) : "v"(p) : "memory");
    const float s = (((a[0] + a[1]) + (a[2] + a[3])) + ((b[0] + b[1]) + (b[2] + b[3]))) + (((c[0] + c[1]) + (c[2] + c[3])) + ((d[0] + d[1]) + (d[2] + d[3])));
    return 1.0f / sqrtf(s * (1.0f / 1024.0f) + RMS_EPS);
}
__device__ __forceinline__ void ssq_write(float* ssq_out, float q, int row, int slot, int fq) {
    q += xor16_f(q); q = halves_sum_f(q);
    if (fq == 0) ssq_out[(size_t)row * 16 + slot] = q;
}
typedef float f32x2 __attribute__((ext_vector_type(2)));
__device__ __forceinline__ f32x2 gelu_mul2(const f32x2 x, const f32x2 c) {
    const f32x2 x2 = x * x;
    const f32x2 a = x * (x2 * (-2.3022082f * 0.044715f) + (-2.3022082f));
    f32x2 e; e.x = __builtin_amdgcn_exp2f(a.x); e.y = __builtin_amdgcn_exp2f(a.y);
    const f32x2 d = e + 1.0f;
    f32x2 r; r.x = __builtin_amdgcn_rcpf(d.x); r.y = __builtin_amdgcn_rcpf(d.y);
    return (x * c) * r;
}
__device__ __forceinline__ float gelu_tanh(float x) {
    const float t = x + 0.044715f * x * x * x;
    const float e = __builtin_amdgcn_exp2f(-2.3022082f * t);
    return x * __builtin_amdgcn_rcpf(1.0f + e);
}
__device__ __forceinline__ float sigmoid_f(float x) { return __builtin_amdgcn_rcpf(1.0f + __builtin_amdgcn_exp2f(-1.4426950408889634f * x)); }


struct EpiRes {
    static constexpr bool PERM = true, AFTER_DRAIN = false;
    const float* basef; const bf16_t* baseb; bf16_t* hb; float* ssq_out; bf16_t* ahalo;
    __device__ __forceinline__ void operator()(const f32x4 (&acc)[2][2][4][2], const Unit& u_, int wr, int wc, int fr, int fq) const {
        Unit u; { int pm_ = u_.pm, pn_ = u_.pn; asm volatile("" : "+s"(pm_), "+s"(pn_)); u.pm = pm_; u.pn = pn_; }
        const int row0 = u.pm * BM + wr * 64 + fr, col0 = u.pn * BM + wc * 32 + 8 * fq;
        if (basef != nullptr) {
#pragma unroll
            for (int ai = 0; ai < 2; ++ai)
#pragma unroll
                for (int m = 0; m < 4; ++m) {
                    const int row = row0 + ai * HALF + m * 16; float q = 0.f;
#pragma unroll
                    for (int bj = 0; bj < 2; ++bj) {
                        const size_t off = (size_t)row * DMODEL + col0 + bj * HALF;
                        const f32x4 b0 = *(const f32x4*)(basef + off), b1 = *(const f32x4*)(basef + off + 4);
                        const f32x4 v0 = acc[ai][bj][m][0] + b0, v1 = acc[ai][bj][m][1] + b1;
                        q += sq4(v0) + sq4(v1);
                        u32x4 w; w.x = cvt_pk_bf16(v0[0], v0[1]); w.y = cvt_pk_bf16(v0[2], v0[3]); w.z = cvt_pk_bf16(v1[0], v1[1]); w.w = cvt_pk_bf16(v1[2], v1[3]);
                        *(u32x4*)(hb + off) = w;
                        if (ahalo != nullptr && ai == 1 && m == 3) {
                            const int rl = row & 255;
                            if (rl >= 254 && u.pm < 63) *(u32x4*)(ahalo + (size_t)(2 * (u.pm + 1) + (rl - 254)) * DMODEL + col0 + bj * HALF) = w;
                        }
                    }
                    ssq_write(ssq_out, q, row, u.pn * 4 + wc, fq);
                    if (m & 1) asm volatile("" ::: "memory");
                }
        } else {
#pragma unroll
            for (int ai = 0; ai < 2; ++ai) {
                u32x4 bw[4][2];
#pragma unroll
                for (int m = 0; m < 4; ++m)
#pragma unroll
                    for (int bj = 0; bj < 2; ++bj) bw[m][bj] = *(const u32x4*)(baseb + (size_t)(row0 + ai * HALF + m * 16) * DMODEL + col0 + bj * HALF);
                asm volatile("" ::: "memory");
#pragma unroll
                for (int m = 0; m < 4; ++m) {
                    const int row = row0 + ai * HALF + m * 16; float q = 0.f;
#pragma unroll
                    for (int bj = 0; bj < 2; ++bj) {
                        const size_t off = (size_t)row * DMODEL + col0 + bj * HALF;
                        const u32x4 pw = bw[m][bj];
                        const f32x4 b0 = {bf_lo(pw.x), bf_hi(pw.x), bf_lo(pw.y), bf_hi(pw.y)}, b1 = {bf_lo(pw.z), bf_hi(pw.z), bf_lo(pw.w), bf_hi(pw.w)};
                        const f32x4 v0 = acc[ai][bj][m][0] + b0, v1 = acc[ai][bj][m][1] + b1;
                        q += sq4(v0) + sq4(v1);
                        u32x4 w; w.x = cvt_pk_bf16(v0[0], v0[1]); w.y = cvt_pk_bf16(v0[2], v0[3]); w.z = cvt_pk_bf16(v1[0], v1[1]); w.w = cvt_pk_bf16(v1[2], v1[3]);
                        *(u32x4*)(hb + off) = w;
                        if (ahalo != nullptr && ai == 1 && m == 3) {
                            const int rl = row & 255;
                            if (rl >= 254 && u.pm < 63) *(u32x4*)(ahalo + (size_t)(2 * (u.pm + 1) + (rl - 254)) * DMODEL + col0 + bj * HALF) = w;
                        }
                    }
                    ssq_write(ssq_out, q, row, u.pn * 4 + wc, fq);
                }
                asm volatile("" ::: "memory");
            }
        }
    }
};
struct EpiGate {
    static constexpr bool PERM = true, AFTER_DRAIN = false;
    const float* ssq_in; const bf16_t* base; const bf16_t* pp; bf16_t* dst; float* ssq_out;
    __device__ __forceinline__ void operator()(const f32x4 (&acc)[2][2][4][2], const Unit& u_, int wr, int wc, int fr, int fq) const {
        Unit u; { int pm_ = u_.pm, pn_ = u_.pn; asm volatile("" : "+s"(pm_), "+s"(pn_)); u.pm = pm_; u.pn = pn_; }
        const int row0 = u.pm * BM + wr * 64 + fr, col0 = u.pn * BM + wc * 32 + 8 * fq;
#pragma unroll
        for (int ai = 0; ai < 2; ++ai)
#pragma unroll
            for (int mp = 0; mp < 2; ++mp) {
                u32x4 bw[2][2], pq[2][2]; float rs[2];
#pragma unroll
                for (int mi = 0; mi < 2; ++mi) {
                    const int row = row0 + ai * HALF + (2 * mp + mi) * 16;
#pragma unroll
                    for (int bj = 0; bj < 2; ++bj) { const size_t off = (size_t)row * DMODEL + col0 + bj * HALF; bw[mi][bj] = *(const u32x4*)(base + off); pq[mi][bj] = *(const u32x4*)(pp + off); }
                }
#pragma unroll
                for (int mi = 0; mi < 2; ++mi) rs[mi] = row_rstd(ssq_in, row0 + ai * HALF + (2 * mp + mi) * 16);
                asm volatile("" ::: "memory");
#pragma unroll
                for (int mi = 0; mi < 2; ++mi) {
                    const int m = 2 * mp + mi; const int row = row0 + ai * HALF + m * 16; float q = 0.f;
#pragma unroll
                    for (int bj = 0; bj < 2; ++bj) {
                        const size_t off = (size_t)row * DMODEL + col0 + bj * HALF;
                        const u32x4 b_ = bw[mi][bj], p_ = pq[mi][bj];
                        const float bb[8] = {bf_lo(b_.x), bf_hi(b_.x), bf_lo(b_.y), bf_hi(b_.y), bf_lo(b_.z), bf_hi(b_.z), bf_lo(b_.w), bf_hi(b_.w)};
                        const float pv[8] = {bf_lo(p_.x), bf_hi(p_.x), bf_lo(p_.y), bf_hi(p_.y), bf_lo(p_.z), bf_hi(p_.z), bf_lo(p_.w), bf_hi(p_.w)};
                        const f32x4 g0 = acc[ai][bj][m][0] * rs[mi], g1 = acc[ai][bj][m][1] * rs[mi];
                        const float gg[8] = {g0[0], g0[1], g0[2], g0[3], g1[0], g1[1], g1[2], g1[3]};
                        float v[8];
#pragma unroll
                        for (int i = 0; i < 8; ++i) { v[i] = bb[i] + pv[i] * sigmoid_f(gg[i]); q += v[i] * v[i]; }
                        u32x4 w; w.x = cvt_pk_bf16(v[0], v[1]); w.y = cvt_pk_bf16(v[2], v[3]); w.z = cvt_pk_bf16(v[4], v[5]); w.w = cvt_pk_bf16(v[6], v[7]);
                        *(u32x4*)(dst + off) = w;
                    }
                    ssq_write(ssq_out, q, row, u.pn * 4 + wc, fq);
                }
                asm volatile("" ::: "memory");
            }
    }
};
struct EpiGateFinal {
    static constexpr bool PERM = true, AFTER_DRAIN = false;
    const float* ssq_in; const bf16_t* base; const bf16_t* pp; float* ssq_out; unsigned* cnt; const float* gain; float* outp; PG8_LAS float* rtab;
    __device__ __forceinline__ void operator()(const f32x4 (&acc)[2][2][4][2], const Unit& u_, int wr, int wc, int fr, int fq) const {
        Unit u; { int pm_ = u_.pm, pn_ = u_.pn; asm volatile("" : "+s"(pm_), "+s"(pn_)); u.pm = pm_; u.pn = pn_; }
        const int row0 = u.pm * BM + wr * 64 + fr, col0 = u.pn * BM + wc * 32 + 8 * fq;
        f32x4 hv[2][2][4][2];
#pragma unroll
        for (int ai = 0; ai < 2; ++ai)
#pragma unroll
            for (int mp = 0; mp < 2; ++mp) {
                u32x4 bw[2][2], pq[2][2]; float rs[2];
#pragma unroll
                for (int mi = 0; mi < 2; ++mi) {
                    const int row = row0 + ai * HALF + (2 * mp + mi) * 16;
#pragma unroll
                    for (int bj = 0; bj < 2; ++bj) { const size_t off = (size_t)row * DMODEL + col0 + bj * HALF; bw[mi][bj] = *(const u32x4*)(base + off); pq[mi][bj] = *(const u32x4*)(pp + off); }
                }
#pragma unroll
                for (int mi = 0; mi < 2; ++mi) rs[mi] = row_rstd(ssq_in, row0 + ai * HALF + (2 * mp + mi) * 16);
                asm volatile("" ::: "memory");
#pragma unroll
                for (int mi = 0; mi < 2; ++mi) {
                    const int m = 2 * mp + mi; const int row = row0 + ai * HALF + m * 16; float q = 0.f;
#pragma unroll
                    for (int bj = 0; bj < 2; ++bj) {
                        const u32x4 b_ = bw[mi][bj], p_ = pq[mi][bj];
                        const float bb[8] = {bf_lo(b_.x), bf_hi(b_.x), bf_lo(b_.y), bf_hi(b_.y), bf_lo(b_.z), bf_hi(b_.z), bf_lo(b_.w), bf_hi(b_.w)};
                        const float pv[8] = {bf_lo(p_.x), bf_hi(p_.x), bf_lo(p_.y), bf_hi(p_.y), bf_lo(p_.z), bf_hi(p_.z), bf_lo(p_.w), bf_hi(p_.w)};
                        const f32x4 g0 = acc[ai][bj][m][0] * rs[mi], g1 = acc[ai][bj][m][1] * rs[mi];
                        const float gg[8] = {g0[0], g0[1], g0[2], g0[3], g1[0], g1[1], g1[2], g1[3]};
                        float v[8];
#pragma unroll
                        for (int i = 0; i < 8; ++i) { v[i] = bb[i] + pv[i] * sigmoid_f(gg[i]); q += v[i] * v[i]; }
                        hv[ai][bj][m][0] = (f32x4){v[0], v[1], v[2], v[3]}; hv[ai][bj][m][1] = (f32x4){v[4], v[5], v[6], v[7]};
                    }
                    ssq_write(ssq_out, q, row, u.pn * 4 + wc, fq);
                }
                asm volatile("" ::: "memory");
            }
        asm volatile("s_waitcnt vmcnt(0)" ::: "memory"); __builtin_amdgcn_s_barrier(); asm volatile("" ::: "memory");
        if (wr == 0 && wc == 0) {
            if (fr == 0 && fq == 0) {
                __builtin_amdgcn_fence(__ATOMIC_RELEASE, "agent");
                asm volatile("s_waitcnt vmcnt(0)" ::: "memory");
                __hip_atomic_fetch_add(cnt + 64 * u.pm, 1u, __ATOMIC_RELAXED, __HIP_MEMORY_SCOPE_AGENT);
            }
            unsigned sp = 0;
            while (__hip_atomic_load(cnt + 64 * u.pm, __ATOMIC_RELAXED, __HIP_MEMORY_SCOPE_AGENT) < 4u) { __builtin_amdgcn_s_sleep(2); if (++sp > (1u << 22)) break; }
        }
        asm volatile("" ::: "memory"); __builtin_amdgcn_s_barrier(); asm volatile("" ::: "memory");
        if (wr == 0) rtab[wc * 64 + fq * 16 + fr] = row_rstd_coh(ssq_out, u.pm * BM + wc * 64 + fq * 16 + fr);
        asm volatile("s_waitcnt lgkmcnt(0)" ::: "memory"); __builtin_amdgcn_s_barrier(); asm volatile("" ::: "memory");
        f32x4 gn[2][2];
#pragma unroll
        for (int bj = 0; bj < 2; ++bj)
#pragma unroll
            for (int n = 0; n < 2; ++n) gn[bj][n] = *(const f32x4*)(gain + col0 + bj * HALF + 4 * n);
#pragma unroll
        for (int ai = 0; ai < 2; ++ai)
#pragma unroll
            for (int m = 0; m < 4; ++m) {
                const float rsf = rtab[ai * HALF + wr * 64 + m * 16 + fr];
                float* orow = outp + (size_t)(row0 + ai * HALF + m * 16) * DMODEL + col0;
#pragma unroll
                for (int bj = 0; bj < 2; ++bj)
#pragma unroll
                    for (int n = 0; n < 2; ++n) *(f32x4*)(orow + bj * HALF + 4 * n) = hv[ai][bj][m][n] * rsf * gn[bj][n];
            }
    }
};
struct EpiBf16Plain {
    static constexpr bool PERM = true, AFTER_DRAIN = false;
    bf16_t* O; int ldc;
    __device__ __forceinline__ void operator()(const f32x4 (&acc)[2][2][4][2], const Unit& u_, int wr, int wc, int fr, int fq) const {
        Unit u; { int pm_ = u_.pm, pn_ = u_.pn; asm volatile("" : "+s"(pm_), "+s"(pn_)); u.pm = pm_; u.pn = pn_; }
        const int row0 = u.pm * BM + wr * 64 + fr, col0 = u.pn * BM + wc * 32 + 8 * fq;
#pragma unroll
        for (int ai = 0; ai < 2; ++ai)
#pragma unroll
            for (int m = 0; m < 4; ++m) {
                const int row = row0 + ai * HALF + m * 16;
#pragma unroll
                for (int bj = 0; bj < 2; ++bj) {
                    const f32x4 v0 = acc[ai][bj][m][0], v1 = acc[ai][bj][m][1];
                    u32x4 w; w.x = cvt_pk_bf16(v0[0], v0[1]); w.y = cvt_pk_bf16(v0[2], v0[3]); w.z = cvt_pk_bf16(v1[0], v1[1]); w.w = cvt_pk_bf16(v1[2], v1[3]);
                    *(u32x4*)(O + (size_t)row * ldc + col0 + bj * HALF) = w;
                }
            }
    }
};
struct EpiEvenIn {
    static constexpr bool PERM = true, AFTER_DRAIN = false;
    const float* ssq_in; bf16_t* Z; const f32x2* rope;
    __device__ __forceinline__ void operator()(const f32x4 (&acc)[2][2][4][2], const Unit& u_, int wr, int wc, int fr, int fq) const {
        Unit u; { int pm_ = u_.pm, pn_ = u_.pn; asm volatile("" : "+s"(pm_), "+s"(pn_)); u.pm = pm_; u.pn = pn_; }
        const int row0 = u.pm * BM + wr * 64 + fr, colw = wc * 32 + 8 * fq;
        const int pn = u.pn;
        const float sc = (pn == 2 || pn == 3) ? C2 : 1.0f;
#pragma unroll
        for (int ai = 0; ai < 2; ++ai)
#pragma unroll
            for (int m = 0; m < 4; ++m) {
                const int row = row0 + ai * HALF + m * 16;
                const float rs = row_rstd(ssq_in, row);
#pragma unroll
                for (int bj = 0; bj < 2; ++bj) {
                    const int gi = 2 * bj + (wc >> 1);
                    const bool ropeg = (pn == 2 || pn == 3 || pn == 5 || (pn == 4 && (gi == 0 || gi == 2))) && ((wc & 1) == 0);
                    f32x4 v0 = acc[ai][bj][m][0] * rs, v1 = acc[ai][bj][m][1] * rs;
                    if (ropeg && fq < 2) {
                        const f32x4* rp = (const f32x4*)(rope + (size_t)row * 8 + 4 * fq);
                        const f32x4 ra = rp[0], rb = rp[1];
                        f32x4 o0, o1;
                        o0[0] = v0[0] * ra[0] - v0[1] * ra[1]; o0[1] = v0[1] * ra[0] + v0[0] * ra[1];
                        o0[2] = v0[2] * ra[2] - v0[3] * ra[3]; o0[3] = v0[3] * ra[2] + v0[2] * ra[3];
                        o1[0] = v1[0] * rb[0] - v1[1] * rb[1]; o1[1] = v1[1] * rb[0] + v1[0] * rb[1];
                        o1[2] = v1[2] * rb[2] - v1[3] * rb[3]; o1[3] = v1[3] * rb[2] + v1[2] * rb[3];
                        v0 = o0; v1 = o1;
                    }
                    v0 = v0 * sc; v1 = v1 * sc;
                    u32x4 w; w.x = cvt_pk_bf16(v0[0], v0[1]); w.y = cvt_pk_bf16(v0[2], v0[3]); w.z = cvt_pk_bf16(v1[0], v1[1]); w.w = cvt_pk_bf16(v1[2], v1[3]);
                    *(u32x4*)(Z + (size_t)row * EV_N + pn * BM + bj * HALF + colw) = w;
                }
            }
    }
};
struct EpiOddIn {
    static constexpr bool PERM = true, AFTER_DRAIN = false;
    const float* ssq_in; bf16_t* Z; float* F; float* sst;
    __device__ __forceinline__ void operator()(const f32x4 (&acc)[2][2][4][2], const Unit& u_, int wr, int wc, int fr, int fq) const {
        Unit u; { int pm_ = u_.pm, pn_ = u_.pn; asm volatile("" : "+s"(pm_), "+s"(pn_)); u.pm = pm_; u.pn = pn_; }
        const int row0 = u.pm * BM + wr * 64 + fr, colw = wc * 32 + 8 * fq;
        const int pn = u.pn;
        const float sc = (pn < 2) ? C2 : 1.0f;
        const bool act = (pn >= 6 && pn < 10), stat = (pn == 8 || pn == 9);
#pragma unroll
        for (int ai = 0; ai < 2; ++ai)
#pragma unroll
            for (int m = 0; m < 4; ++m) {
                const int row = row0 + ai * HALF + m * 16;
                const float rs = row_rstd(ssq_in, row);
                if (pn == 10) {
                    if (wc == 0 && fq == 0) { *(f32x4*)(F + (size_t)row * 8) = acc[ai][0][m][0] * rs; *(f32x4*)(F + (size_t)row * 8 + 4) = acc[ai][0][m][1] * rs; }
                    continue;
                }
                float s1 = 0.f, s2 = 0.f;
#pragma unroll
                for (int bj = 0; bj < 2; ++bj) {
                    f32x4 v0 = acc[ai][bj][m][0] * (rs * sc), v1 = acc[ai][bj][m][1] * (rs * sc);
                    if (act) {
#pragma unroll
                        for (int i = 0; i < 4; ++i) { v0[i] = gelu_tanh(v0[i]); v1[i] = gelu_tanh(v1[i]); }
                    }
                    s1 += ((v0[0] + v0[1]) + (v0[2] + v0[3])) + ((v1[0] + v1[1]) + (v1[2] + v1[3])); s2 += sq4(v0) + sq4(v1);
                    u32x4 w; w.x = cvt_pk_bf16(v0[0], v0[1]); w.y = cvt_pk_bf16(v0[2], v0[3]); w.z = cvt_pk_bf16(v1[0], v1[1]); w.w = cvt_pk_bf16(v1[2], v1[3]);
                    *(u32x4*)(Z + (size_t)row * Z1P + pn * BM + bj * HALF + colw) = w;
                }
                if (stat) {
                    s1 += xor16_f(s1); s1 = halves_sum_f(s1); s2 += xor16_f(s2); s2 = halves_sum_f(s2);
                    if (fq == 0) *(f32x2*)(sst + ((size_t)row * 8 + (pn - 8) * 4 + wc) * 2) = (f32x2){s1, s2};
                }
            }
    }
};
struct EpiHalo {
    static constexpr bool PERM = true, AFTER_DRAIN = false;
    const float* ssq_in; float* AH;
    __device__ __forceinline__ void operator()(const f32x4 (&acc)[2][2][4][2], const Unit& u_, int wr, int wc, int fr, int fq) const {
        Unit u; { int pm_ = u_.pm, pn_ = u_.pn; asm volatile("" : "+s"(pm_), "+s"(pn_)); u.pm = pm_; u.pn = pn_; }
        const int col0 = u.pn * BM + wc * 32 + 8 * fq;
#pragma unroll
        for (int m = 0; m < 4; ++m) {
            const int rh = wr * 64 + m * 16 + fr;
            if (rh < 2) continue;
            const int tok = 256 * (rh >> 1) - 2 + (rh & 1);
            const float rs = row_rstd(ssq_in, tok);
#pragma unroll
            for (int bj = 0; bj < 2; ++bj) {
                *(f32x4*)(AH + (size_t)rh * NFF2 + col0 + bj * HALF) = acc[0][bj][m][0] * rs;
                *(f32x4*)(AH + (size_t)rh * NFF2 + col0 + bj * HALF + 4) = acc[0][bj][m][1] * rs;
            }
        }
    }
};
template <int SEL> __device__ __forceinline__ float dpp1(const float old, const float src) {
    const int o = __builtin_bit_cast(int, old), s = __builtin_bit_cast(int, src); int t;
    if (SEL == 0) t = __builtin_amdgcn_update_dpp(o, s, 0x111, 0xf, 0xf, false);
    else if (SEL == 1) t = __builtin_amdgcn_update_dpp(o, s, 0x112, 0xf, 0xf, false);
    else if (SEL == 2) t = __builtin_amdgcn_update_dpp(o, s, 0x10F, 0xf, 0xf, false);
    else t = __builtin_amdgcn_update_dpp(o, s, 0x10E, 0xf, 0xf, false);
    return __builtin_bit_cast(float, t);
}
template <int SEL> __device__ __forceinline__ f32x4 dpp4t(const f32x4 old, const f32x4 src) {
    const float o0 = old[0], o1 = old[1], o2 = old[2], o3 = old[3], s0 = src[0], s1 = src[1], s2 = src[2], s3 = src[3];
    const float r0 = dpp1<SEL>(o0, s0), r1 = dpp1<SEL>(o1, s1), r2 = dpp1<SEL>(o2, s2), r3 = dpp1<SEL>(o3, s3);
    return (f32x4){r0, r1, r2, r3};
}
#define dpp4(old, src, sel) dpp4t<sel>(old, src)
__device__ __forceinline__ void conv_taps(f32x4& c, const f32x4 cur, const f32x4 prev, const f32x4 w0, const f32x4 w1) {
    float c0 = c[0], c1 = c[1], c2 = c[2], c3 = c[3];
    const float x0 = cur[0], x1 = cur[1], x2 = cur[2], x3 = cur[3], p0 = prev[0], p1 = prev[1], p2 = prev[2], p3 = prev[3];
    const float a0 = w1[0], a1 = w1[1], a2 = w1[2], a3 = w1[3], b0 = w0[0], b1 = w0[1], b2 = w0[2], b3 = w0[3];
    asm("s_nop 4\n\t"
        "v_fmac_f32_dpp %0, %4, %12 row_shr:1 row_mask:0xf bank_mask:0xf bound_ctrl:1\n\t"
        "v_fmac_f32_dpp %1, %5, %13 row_shr:1 row_mask:0xf bank_mask:0xf bound_ctrl:1\n\t"
        "v_fmac_f32_dpp %2, %6, %14 row_shr:1 row_mask:0xf bank_mask:0xf bound_ctrl:1\n\t"
        "v_fmac_f32_dpp %3, %7, %15 row_shr:1 row_mask:0xf bank_mask:0xf bound_ctrl:1\n\t"
        "v_fmac_f32_dpp %0, %4, %16 row_shr:2 row_mask:0xf bank_mask:0xf bound_ctrl:1\n\t"
        "v_fmac_f32_dpp %1, %5, %17 row_shr:2 row_mask:0xf bank_mask:0xf bound_ctrl:1\n\t"
        "v_fmac_f32_dpp %2, %6, %18 row_shr:2 row_mask:0xf bank_mask:0xf bound_ctrl:1\n\t"
        "v_fmac_f32_dpp %3, %7, %19 row_shr:2 row_mask:0xf bank_mask:0xf bound_ctrl:1\n\t"
        "v_fmac_f32_dpp %0, %8, %12 row_shl:15 row_mask:0xf bank_mask:0xf bound_ctrl:1\n\t"
        "v_fmac_f32_dpp %1, %9, %13 row_shl:15 row_mask:0xf bank_mask:0xf bound_ctrl:1\n\t"
        "v_fmac_f32_dpp %2, %10, %14 row_shl:15 row_mask:0xf bank_mask:0xf bound_ctrl:1\n\t"
        "v_fmac_f32_dpp %3, %11, %15 row_shl:15 row_mask:0xf bank_mask:0xf bound_ctrl:1\n\t"
        "v_fmac_f32_dpp %0, %8, %16 row_shl:14 row_mask:0xf bank_mask:0xf bound_ctrl:1\n\t"
        "v_fmac_f32_dpp %1, %9, %17 row_shl:14 row_mask:0xf bank_mask:0xf bound_ctrl:1\n\t"
        "v_fmac_f32_dpp %2, %10, %18 row_shl:14 row_mask:0xf bank_mask:0xf bound_ctrl:1\n\t"
        "v_fmac_f32_dpp %3, %11, %19 row_shl:14 row_mask:0xf bank_mask:0xf bound_ctrl:1"
        : "+v"(c0), "+v"(c1), "+v"(c2), "+v"(c3)
        : "v"(x0), "v"(x1), "v"(x2), "v"(x3), "v"(p0), "v"(p1), "v"(p2), "v"(p3), "v"(a0), "v"(a1), "v"(a2), "v"(a3), "v"(b0), "v"(b1), "v"(b2), "v"(b3));
    c[0] = c0; c[1] = c1; c[2] = c2; c[3] = c3;
}
struct EpiHaloF {
    static constexpr bool PERM = true, AFTER_DRAIN = false;
    const float* ssq_in; float* ah; unsigned* flags;
    __device__ __forceinline__ void operator()(const f32x4 (&acc)[2][2][4][2], const Unit& u_, int wr, int wc, int fr, int fq) const {
        Unit u; { int pm_ = u_.pm, pn_ = u_.pn; asm volatile("" : "+s"(pm_), "+s"(pn_)); u.pm = pm_; u.pn = pn_; }
        const int col0 = u.pn * BM + wc * 32 + 8 * fq;
#pragma unroll
        for (int m = 0; m < 4; ++m) {
            const int rh = wr * 64 + m * 16 + fr;
            if (rh >= 2) {
                const int tok = 256 * (rh >> 1) - 2 + (rh & 1);
                const float rsh = row_rstd(ssq_in, tok);
#pragma unroll
                for (int bj = 0; bj < 2; ++bj) {
                    *(f32x4*)(ah + (size_t)rh * NFF2 + col0 + bj * HALF) = acc[0][bj][m][0] * rsh;
                    *(f32x4*)(ah + (size_t)rh * NFF2 + col0 + bj * HALF + 4) = acc[0][bj][m][1] * rsh;
                }
            }
        }
        asm volatile("s_waitcnt vmcnt(0)" ::: "memory"); __builtin_amdgcn_s_barrier(); asm volatile("" ::: "memory");
        if (wr == 0 && wc == 0 && fr == 0 && fq == 0) {
            __builtin_amdgcn_fence(__ATOMIC_RELEASE, "agent");
            asm volatile("s_waitcnt vmcnt(0)" ::: "memory");
            __hip_atomic_store(flags + 64 * u.pn, 1u, __ATOMIC_RELAXED, __HIP_MEMORY_SCOPE_AGENT);
        }
    }
};
struct EpiFfnIn {
    static constexpr bool PERM = true, AFTER_DRAIN = false;
    const float* ssq_in; const float* cw; const float* cb; float* ah; bf16_t* hid; PG8_LAS float* xb; unsigned* flags; unsigned phase_id;
    __device__ __forceinline__ void operator()(const f32x4 (&acc)[2][2][4][2], const Unit& u_, int wr, int wc, int fr, int fq) const {
        Unit u; { int pm_ = u_.pm, pn_ = u_.pn; asm volatile("" : "+s"(pm_), "+s"(pn_)); u.pm = pm_; u.pn = pn_; }
        PG8_LAS float* rtab = xb + 2048;
        const int row0 = u.pm * BM + wr * 64 + fr;
        PG8_LAS float* cwl = xb + 2432 + wc * 256;
        PG8_LAS float* hl = xb + 3456 + wc * 128;
        if (wr == 0) {
            const float* src = (fq < 3 ? cw + fq * NFF2 : cb) + (fr >> 3) * DFF + 128 * u.pn + wc * 32 + (fr & 7) * 4;
            const f32x4 wv = *(const f32x4*)src;
            rtab[wc * 64 + fq * 16 + fr] = row_rstd(ssq_in, u.pm * BM + wc * 64 + fq * 16 + fr);
            *(PG8_LAS f32x4*)(cwl + (fq * 16 + fr) * 4) = wv;
        }
        if (fr >= 14) {
#pragma unroll
            for (int ai = 0; ai < 2; ++ai) {
                PG8_LAS f32x4* dst = (PG8_LAS f32x4*)(xb + ((((ai * 2 + wr) * 4 + wc) * 2 + (fr - 14)) * 4 + fq) * 16);
#pragma unroll
                for (int bj = 0; bj < 2; ++bj)
#pragma unroll
                    for (int n = 0; n < 2; ++n) dst[bj * 2 + n] = acc[ai][bj][3][n];
            }
        }
        asm volatile("s_waitcnt lgkmcnt(0)" ::: "memory"); __builtin_amdgcn_s_barrier(); asm volatile("" ::: "memory");
        const bool has = (u.pm & 7) != 0;
        if (wr == 0) {
            PG8_LAS unsigned* stamp = (PG8_LAS unsigned*)(rtab + 256);
            if (*(volatile PG8_LAS unsigned*)stamp != phase_id) {
                if (wc == 0) {
                    unsigned sp = 0;
                    for (int t = 0; t < NFF2 / BM; ++t)
                        while (__hip_atomic_load(flags + 64 * t, __ATOMIC_RELAXED, __HIP_MEMORY_SCOPE_AGENT) == 0u) { __builtin_amdgcn_s_sleep(2); if (++sp > (1u << 22)) break; }
                    asm volatile("s_waitcnt vmcnt(0)" ::: "memory");
                    if (fr == 0 && fq == 0) *(volatile PG8_LAS unsigned*)stamp = phase_id;
                } else {
                    unsigned sp = 0;
                    while (*(volatile PG8_LAS unsigned*)stamp != phase_id) { __builtin_amdgcn_s_sleep(2); if (++sp > (1u << 22)) break; }
                }
            }
        }
        if (wr == 0) {
            f32x2 hv = {0.f, 0.f};
            if (has) hv = *(const f32x2*)(ah + (size_t)(2 * u.pm + (fq >> 1)) * NFF2 + (size_t)u.pn * BM + (fq & 1) * HALF + wc * 32 + 2 * fr);
            *(PG8_LAS f32x2*)(hl + (fq * 16 + fr) * 2) = hv;
        }
        float rs[2][4];
#pragma unroll
        for (int ai = 0; ai < 2; ++ai)
#pragma unroll
            for (int m = 0; m < 4; ++m) rs[ai][m] = rtab[ai * HALF + wr * 64 + m * 16 + fr];
        const f32x4 zero4 = {0.f, 0.f, 0.f, 0.f};
#pragma unroll
        for (int ai = 0; ai < 2; ++ai) {
#pragma unroll
            for (int n = 0; n < 2; ++n) {
                f32x4 cg[4];
#pragma unroll
                for (int bj = 0; bj < 2; ++bj) {
                    f32x4 b0, b1;
                    if (ai == 0 && wr == 0) {
                        b0 = *(const PG8_LAS f32x4*)(hl + (0 * 2 + bj) * 32 + 8 * fq + 4 * n);
                        b1 = *(const PG8_LAS f32x4*)(hl + (1 * 2 + bj) * 32 + 8 * fq + 4 * n);
                    } else {
                        const int sa = (wr == 1) ? ai : ai - 1, sw = (wr == 1) ? 0 : 1;
                        const float r0 = rtab[sa * HALF + sw * 64 + 62], r1 = rtab[sa * HALF + sw * 64 + 63];
                        b0 = *(const PG8_LAS f32x4*)(xb + ((((sa * 2 + sw) * 4 + wc) * 2 + 0) * 4 + fq) * 16 + (bj * 2 + n) * 4) * r0;
                        b1 = *(const PG8_LAS f32x4*)(xb + ((((sa * 2 + sw) * 4 + wc) * 2 + 1) * 4 + fq) * 16 + (bj * 2 + n) * 4) * r1;
                    }
                    const int oc = bj * 32 + 8 * fq + 4 * n;
                    const f32x4 w0 = *(const PG8_LAS f32x4*)(cwl + oc), w1 = *(const PG8_LAS f32x4*)(cwl + 64 + oc), w2 = *(const PG8_LAS f32x4*)(cwl + 128 + oc), bb = *(const PG8_LAS f32x4*)(cwl + 192 + oc);
                    f32x4 prev = (fr == 14) ? b0 : b1;
#pragma unroll
                    for (int m = 0; m < 4; ++m) {
                        const f32x4 cur = acc[ai][bj][m][n] * rs[ai][m];
                        f32x4 c = w2 * cur + bb;
                        conv_taps(c, cur, prev, w0, w1);
                        prev = cur;
                        if (bj == 0) cg[m] = c;
                        else {
                            const f32x2 ha = gelu_mul2((f32x2){cg[m][0], cg[m][1]}, (f32x2){c[0], c[1]}), hb = gelu_mul2((f32x2){cg[m][2], cg[m][3]}, (f32x2){c[2], c[3]});
                            u32x2 w; w.x = cvt_pk_bf16(ha.x, ha.y); w.y = cvt_pk_bf16(hb.x, hb.y);
                            const int row = row0 + ai * HALF + m * 16;
                            *(u32x2*)(hid + (size_t)row * DFF + 128 * u.pn + wc * 32 + 8 * fq + 4 * n) = w;
                        }
                    }
                    asm volatile("" ::: "memory");
                }
            }
        }
    }
};
template <class Epi, class Sched, bool ALIGN_EPI = false, bool SP2 = false>
__device__ __forceinline__ void gemm_phase(PG8_LAS unsigned char* lds, const Gemm g, const Sched& S, const Epi& E, const int wave_s) {
    const int tid_ = wave_s * 64 + lane_opaque(); const int tid = tid_, wid = __builtin_amdgcn_readfirstlane(tid >> 6), lane = tid & 63, wr = wid >> 2, wc = wid & 3, fr = lane & 15, fq = lane >> 4;
    const int K = g.K, nt = K / BK;
    unsigned voffA[2], voffB[2];
#pragma unroll
    for (int i = 0; i < 2; ++i) { int R, C; stage_rc(tid * 16 + i * 8192, R, C); const int Rb = Epi::PERM ? ((R & ~31) + perm32(R & 31)) : R;
        voffA[i] = (unsigned)(R * K + C) * 2u; voffB[i] = (unsigned)(Rb * K + C) * 2u; }
    const size_t kstep = (size_t)(BK * 2);
    const size_t hstep = (size_t)HALF * K * 2;
    const size_t tstep = 2 * hstep;
    const unsigned ldsw = (unsigned)wid * 1024u;
    const int aoff = lds_byte(wr * 64 + fr, fq * 8), boff = lds_byte(wc * 32 + fr, fq * 8);
#define PG8_SA(b, h) (((b) * 2 + (h)) * HTB)
#define PG8_SB(b, h) ((4 + (b) * 2 + (h)) * HTB)
#define PG8_STAGE(bufoff, gbase, voff) do { _Pragma("unroll") for (int _i = 0; _i < 2; ++_i) \
        __builtin_amdgcn_global_load_lds((const unsigned*)((const char*)(gbase) + (voff)[_i]), (PG8_LAS unsigned*)(lds + (bufoff) + ldsw + _i * 8192), 16, 0, 0); } while (0)
#define PG8_LDA(dst, b, h) do { _Pragma("unroll") for (int m = 0; m < 4; ++m) _Pragma("unroll") for (int k = 0; k < 2; ++k) dst[m][k] = *(const PG8_LAS bf16x8*)(lds + PG8_SA(b, h) + aoff + m * 2048 + k * 1024); } while (0)
#define PG8_LDB(dst, b, h) do { _Pragma("unroll") for (int n = 0; n < 2; ++n) _Pragma("unroll") for (int k = 0; k < 2; ++k) dst[n][k] = *(const PG8_LAS bf16x8*)(lds + PG8_SB(b, h) + boff + n * 2048 + k * 1024); } while (0)
#define PG8_MMA(ai, bj, At, Bt) do { __builtin_amdgcn_s_setprio(1); _Pragma("unroll") for (int m = 0; m < 4; ++m) _Pragma("unroll") for (int n = 0; n < 2; ++n) _Pragma("unroll") for (int k = 0; k < 2; ++k) \
        acc[ai][bj][m][n] = __builtin_amdgcn_mfma_f32_16x16x32_bf16(Bt[n][k], At[m][k], acc[ai][bj][m][n], 0, 0, 0); __builtin_amdgcn_s_setprio(0); } while (0)
#define PG8_WAIT_V(n) asm volatile("s_waitcnt vmcnt(" #n ")" ::: "memory")
#define PG8_WAIT_L(n) asm volatile("s_waitcnt lgkmcnt(" #n ")" ::: "memory")
#define PG8_BAR __builtin_amdgcn_s_barrier()
#define PG8_SCHED __builtin_amdgcn_sched_barrier(0)
    Unit cur, nxt; int ui = 0;
    if (!S.next(0, cur)) return;
    f32x4 acc[2][2][4][2];
#pragma unroll
    for (int a = 0; a < 2; ++a)
#pragma unroll
        for (int b = 0; b < 2; ++b)
#pragma unroll
            for (int m = 0; m < 4; ++m)
#pragma unroll
                for (int n = 0; n < 2; ++n) acc[a][b][m][n] = (f32x4){0.f, 0.f, 0.f, 0.f};
    bf16x8 At[4][2], B0[2][2], B1[2][2];
    const char* cA = (const char*)g.A + (size_t)cur.pm * tstep; const char* cB = (const char*)g.Bt + (size_t)cur.pn * tstep;
    S.a_ready(cur);
    if constexpr (SP2) {
        PG8_STAGE(PG8_SB(0, 0), cB, voffB); PG8_STAGE(PG8_SB(0, 1), cB + hstep, voffB); PG8_STAGE(PG8_SA(0, 0), cA, voffA); PG8_STAGE(PG8_SA(0, 1), cA + hstep, voffA);
        if (wr == 1) PG8_BAR;
        PG8_WAIT_V(2); PG8_BAR;
        PG8_STAGE(PG8_SB(1, 0), cB + kstep, voffB); PG8_STAGE(PG8_SA(1, 0), cA + kstep, voffA); PG8_STAGE(PG8_SB(1, 1), cB + hstep + kstep, voffB);
        PG8_WAIT_V(6); PG8_BAR;
    } else {
        PG8_STAGE(PG8_SB(0, 0), cB, voffB); PG8_STAGE(PG8_SA(0, 0), cA, voffA); PG8_STAGE(PG8_SB(0, 1), cB + hstep, voffB); PG8_STAGE(PG8_SA(0, 1), cA + hstep, voffA);
        if (wr == 1) PG8_BAR;
        PG8_WAIT_V(4); PG8_BAR;
        PG8_STAGE(PG8_SB(1, 0), cB + kstep, voffB); PG8_STAGE(PG8_SA(1, 0), cA + kstep, voffA); PG8_STAGE(PG8_SB(1, 1), cB + hstep + kstep, voffB);
        PG8_WAIT_V(6); PG8_BAR;
    }
    for (;;) {
        const bool has_next = S.next(ui + 1, nxt);
        const char* nA = has_next ? (const char*)g.A + (size_t)nxt.pm * tstep : cA; const char* nB = has_next ? (const char*)g.Bt + (size_t)nxt.pn * tstep : cB;
        for (int t = 0; t < nt; t += 2) {
            const bool last = (t == nt - 2);
            const char* a1 = cA + (size_t)(t + 1) * kstep;
            const char* a2 = last ? nA : cA + (size_t)(t + 2) * kstep; const char* b2 = last ? nB : cB + (size_t)(t + 2) * kstep;
            const char* a3 = a2 + kstep; const char* b3 = b2 + kstep;
            if (last && has_next) S.a_ready(nxt);
            if constexpr (SP2) {
            PG8_LDB(B0, 0, 0); PG8_LDB(B1, 0, 1); PG8_SCHED; PG8_LDA(At, 0, 0); PG8_STAGE(PG8_SA(1, 1), a1 + hstep, voffA);
            PG8_WAIT_V(8); PG8_WAIT_L(0); PG8_BAR; PG8_MMA(0, 0, At, B0); PG8_MMA(0, 1, At, B1); PG8_BAR; PG8_SCHED;
            PG8_LDA(At, 0, 1); PG8_STAGE(PG8_SB(0, 0), b2, voffB); PG8_STAGE(PG8_SB(0, 1), b2 + hstep, voffB); PG8_STAGE(PG8_SA(0, 0), a2, voffA);
            PG8_WAIT_V(8); PG8_WAIT_L(0); PG8_BAR; PG8_MMA(1, 0, At, B0); PG8_MMA(1, 1, At, B1); PG8_BAR; PG8_SCHED;
            PG8_LDB(B0, 1, 0); PG8_LDB(B1, 1, 1); PG8_SCHED; PG8_LDA(At, 1, 0); PG8_STAGE(PG8_SA(0, 1), a2 + hstep, voffA);
            PG8_WAIT_V(8); PG8_WAIT_L(0); PG8_BAR; PG8_MMA(0, 0, At, B0); PG8_MMA(0, 1, At, B1); PG8_BAR; PG8_SCHED;
            PG8_LDA(At, 1, 1); PG8_STAGE(PG8_SB(1, 0), b3, voffB); PG8_STAGE(PG8_SB(1, 1), b3 + hstep, voffB); PG8_STAGE(PG8_SA(1, 0), a3, voffA);
            PG8_WAIT_V(8); PG8_WAIT_L(0); PG8_BAR; PG8_MMA(1, 0, At, B0); PG8_MMA(1, 1, At, B1); PG8_BAR; PG8_SCHED;
            } else {
            PG8_LDB(B0, 0, 0); PG8_SCHED; PG8_LDA(At, 0, 0); PG8_STAGE(PG8_SA(1, 1), a1 + hstep, voffA);
            PG8_WAIT_L(8); PG8_BAR; PG8_WAIT_L(0); PG8_MMA(0, 0, At, B0); PG8_BAR; PG8_SCHED;
            PG8_LDB(B1, 0, 1); PG8_STAGE(PG8_SB(0, 0), b2, voffB);
            PG8_BAR; PG8_WAIT_L(0); PG8_MMA(0, 1, At, B1); PG8_BAR;
            PG8_LDA(At, 0, 1); PG8_STAGE(PG8_SA(0, 0), a2, voffA);
            PG8_BAR; PG8_WAIT_L(0); PG8_MMA(1, 0, At, B0); PG8_BAR; PG8_SCHED;
            PG8_STAGE(PG8_SB(0, 1), b2 + hstep, voffB);
            PG8_WAIT_V(6); PG8_BAR; PG8_MMA(1, 1, At, B1); PG8_BAR;
            PG8_LDB(B0, 1, 0); PG8_SCHED; PG8_LDA(At, 1, 0); PG8_STAGE(PG8_SA(0, 1), a2 + hstep, voffA);
            PG8_WAIT_L(8); PG8_BAR; PG8_WAIT_L(0); PG8_MMA(0, 0, At, B0); PG8_BAR; PG8_SCHED;
            PG8_LDB(B1, 1, 1); PG8_STAGE(PG8_SB(1, 0), b3, voffB);
            PG8_BAR; PG8_WAIT_L(0); PG8_MMA(0, 1, At, B1); PG8_BAR;
            PG8_LDA(At, 1, 1); PG8_STAGE(PG8_SA(1, 0), a3, voffA);
            PG8_BAR; PG8_WAIT_L(0); PG8_MMA(1, 0, At, B0); PG8_BAR; PG8_SCHED;
            PG8_STAGE(PG8_SB(1, 1), b3 + hstep, voffB);
            PG8_WAIT_V(6); PG8_BAR; PG8_MMA(1, 1, At, B1); PG8_BAR;
            }
        }
        if constexpr (ALIGN_EPI) { if (wr == 0) PG8_BAR; }
        if constexpr (!Epi::AFTER_DRAIN) { E(acc, cur, wr, wc, fr, fq); S.done(cur); }
        if (!has_next) break;
#pragma unroll
        for (int a = 0; a < 2; ++a)
#pragma unroll
            for (int b = 0; b < 2; ++b)
#pragma unroll
                for (int m = 0; m < 4; ++m)
#pragma unroll
                    for (int n = 0; n < 2; ++n) acc[a][b][m][n] = (f32x4){0.f, 0.f, 0.f, 0.f};
        cur = nxt; cA = nA; cB = nB; ++ui;
        if constexpr (ALIGN_EPI) { if (wr == 1) PG8_BAR; }
    }
    PG8_WAIT_V(0);
    if constexpr (!ALIGN_EPI) { if (wr == 0) PG8_BAR; }
    PG8_BAR;
    if constexpr (Epi::AFTER_DRAIN) { E.fused(acc, cur, wr, wc, fr, fq, lds, wid, lane); S.done(cur); }
#undef PG8_SA
#undef PG8_SB
#undef PG8_STAGE
#undef PG8_LDA
#undef PG8_LDB
#undef PG8_MMA
#undef PG8_WAIT_V
#undef PG8_WAIT_L
#undef PG8_BAR
#undef PG8_SCHED
}
}
namespace mix {
#define MLAS __attribute__((address_space(3)))
typedef unsigned short bf16_t;
typedef short bf16x8 __attribute__((ext_vector_type(8)));
typedef short s16x4 __attribute__((ext_vector_type(4)));
typedef float f32x16 __attribute__((ext_vector_type(16)));
typedef float f32x4 __attribute__((ext_vector_type(4)));
typedef float f32x2 __attribute__((ext_vector_type(2)));
typedef unsigned u32x4 __attribute__((ext_vector_type(4)));
typedef unsigned u32x2 __attribute__((ext_vector_type(2)));
typedef MLAS const char* lds_cptr;
typedef short v4i16_t __attribute__((ext_vector_type(4)));
typedef __bf16 bf16x2_t __attribute__((ext_vector_type(2)));

constexpr int SLOTB = 8192;
constexpr int NSLOT = 4;
constexpr int L_K = 0, L_V = NSLOT * SLOTB, L_WSF = 2 * NSLOT * SLOTB, L_OST = L_WSF + 8 * 256, L_X = L_OST + 8 * 4096;
constexpr int LX_IQ = L_X, LX_EQ = L_X, LX_PFX = L_X + 8192, LX_CNT = LX_IQ + 16384, LX_GT = LX_CNT + 2048, LX_SEL = LX_GT, LX_END = LX_GT + 8192;
static_assert(LX_END <= 131072, "mixer LDS map");

__device__ __forceinline__ int crow(int r, int hi) { return (r & 3) + 8 * (r >> 2) + 4 * hi; }
__device__ __forceinline__ void glds16(const void* gsrc, unsigned lds_dst) { unsigned keep;
    asm volatile("s_mov_b32 %0, m0\n\ts_mov_b32 m0, %2\n\ts_nop 0\n\tglobal_load_lds_dwordx4 %1, off\n\ts_mov_b32 m0, %0" : "=&s"(keep) : "v"(gsrc), "s"(lds_dst) : "memory"); }
__device__ __forceinline__ unsigned cvtpk(float lo, float hi) { f32x2 v = {lo, hi}; bf16x2_t b = __builtin_convertvector(v, bf16x2_t); return __builtin_bit_cast(unsigned, b); }
__device__ __forceinline__ s16x4 vtr(lds_cptr p) { return __builtin_bit_cast(s16x4, __builtin_amdgcn_ds_read_tr16_b64_v4i16((MLAS v4i16_t*)p)); }
#define WAITV_BAR() asm volatile("s_waitcnt vmcnt(0) lgkmcnt(0)\n\ts_barrier" ::: "memory")
#define LGKM_BAR() asm volatile("s_waitcnt lgkmcnt(0)\n\ts_barrier" ::: "memory")
#define WAITV2_BAR() asm volatile("s_waitcnt vmcnt(2) lgkmcnt(0)\n\ts_barrier" ::: "memory")

__device__ __forceinline__ void dma_kv(const bf16_t* kbase, const bf16_t* vbase, int pitch, unsigned lds0, int slot, int wid, int lane) {
    const bf16_t* ks = kbase + (size_t)lane * pitch + wid * 8;
    const bf16_t* vs = vbase + (size_t)(16 * (wid & 3) + (lane >> 2)) * pitch + (wid >> 2) * 32 + (lane & 3) * 8;
    glds16(ks, (unsigned)__builtin_amdgcn_readfirstlane(lds0 + L_K + slot * SLOTB + wid * 1024));
    glds16(vs, (unsigned)__builtin_amdgcn_readfirstlane(lds0 + L_V + slot * SLOTB + wid * 1024));
}
__device__ __forceinline__ void kload(bf16x8 (&kf)[8], lds_cptr kslot, int r32, int hi) {
    lds_cptr kb = kslot + hi * 1024 + r32 * 16;
#pragma unroll
    for (int d0 = 0; d0 < 4; ++d0) { kf[2 * d0] = *(const MLAS bf16x8*)(kb + d0 * 2048); kf[2 * d0 + 1] = *(const MLAS bf16x8*)(kb + d0 * 2048 + 512); }
}
__device__ __forceinline__ void qkt_mma(f32x16& p0, f32x16& p1, const bf16x8 (&kf)[8], const bf16x8* qr, const f32x16& cinit) {
    p0 = __builtin_amdgcn_mfma_f32_32x32x16_bf16(kf[0], qr[0], cinit, 0, 0, 0); p1 = __builtin_amdgcn_mfma_f32_32x32x16_bf16(kf[1], qr[0], cinit, 0, 0, 0);
#pragma unroll
    for (int d0 = 1; d0 < 4; ++d0) { p0 = __builtin_amdgcn_mfma_f32_32x32x16_bf16(kf[2 * d0], qr[d0], p0, 0, 0, 0); p1 = __builtin_amdgcn_mfma_f32_32x32x16_bf16(kf[2 * d0 + 1], qr[d0], p1, 0, 0, 0); }
}
__device__ __forceinline__ void qkt(f32x16& p0, f32x16& p1, lds_cptr kslot, const bf16x8* qr, const f32x16& cinit, int r32, int hi) {
    bf16x8 kf[8]; kload(kf, kslot, r32, hi); qkt_mma(p0, p1, kf, qr, cinit);
}
__device__ __forceinline__ void vload(bf16x8 (&vf)[8], lds_cptr vslot, int lane, int hi) {
    lds_cptr vp = vslot + ((lane >> 4) & 1) * 32 + (lane & 3) * 8 + (4 * hi + ((lane & 15) >> 2)) * 64;
#pragma unroll
    for (int d0 = 0; d0 < 2; ++d0)
#pragma unroll
        for (int ks = 0; ks < 4; ++ks) {
            const s16x4 lo = vtr(vp + d0 * 4096 + ks * 1024), hh = vtr(vp + d0 * 4096 + ks * 1024 + 512);
            vf[d0 * 4 + ks] = (bf16x8){lo[0], lo[1], lo[2], lo[3], hh[0], hh[1], hh[2], hh[3]};
        }
}
#define V16_TO_ARR(v, a, o) do { a[(o) + 0] = v[0]; a[(o) + 1] = v[1]; a[(o) + 2] = v[2]; a[(o) + 3] = v[3]; a[(o) + 4] = v[4]; a[(o) + 5] = v[5]; a[(o) + 6] = v[6]; a[(o) + 7] = v[7]; \
    a[(o) + 8] = v[8]; a[(o) + 9] = v[9]; a[(o) + 10] = v[10]; a[(o) + 11] = v[11]; a[(o) + 12] = v[12]; a[(o) + 13] = v[13]; a[(o) + 14] = v[14]; a[(o) + 15] = v[15]; } while (0)
__device__ __forceinline__ f32x16 splat16(float x) { return (f32x16){x, x, x, x, x, x, x, x, x, x, x, x, x, x, x, x}; }
struct AttnState { f32x16 o[2]; float m, l, pend; bool started; };
constexpr float ATT_THR = 8.0f;
__device__ __forceinline__ void softmax_pv(AttnState& st, float (&sc)[32], const bf16x8 (&vf)[8], MLAS float* wsf, int lane, int r32, int hi) {
    if (__any(st.pend != 0.f)) {
#pragma unroll
        for (int r = 0; r < 32; ++r) sc[r] -= st.pend;
    }
    st.pend = 0.f;
    float ra = __builtin_fmaxf(__builtin_fmaxf(sc[0], sc[1]), sc[2]), rb = __builtin_fmaxf(__builtin_fmaxf(sc[3], sc[4]), sc[5]);
#pragma unroll
    for (int r = 6; r < 30; r += 4) { ra = __builtin_fmaxf(__builtin_fmaxf(ra, sc[r]), sc[r + 1]); rb = __builtin_fmaxf(__builtin_fmaxf(rb, sc[r + 2]), sc[r + 3]); }
    float rm = __builtin_fmaxf(__builtin_fmaxf(ra, rb), __builtin_fmaxf(sc[30], sc[31]));
    rm = halves_max_f(rm);
    const bool fresh = !st.started;
    const bool need = (rm > ATT_THR) || (fresh && rm < -ATT_THR && rm > -1e29f);
    st.started = st.started || (rm > -1e29f);
    if (__any(need)) {
        const float dl = need ? rm : 0.f;
        st.m += dl; st.pend = dl;
#pragma unroll
        for (int r = 0; r < 32; ++r) sc[r] -= dl;
        const float alpha = fresh ? 1.0f : __builtin_amdgcn_exp2f(-dl);
        st.l *= alpha;
        if (hi == 0) wsf[r32] = alpha;
        float fr_[16];
#pragma unroll
        for (int r = 0; r < 16; ++r) fr_[r] = wsf[crow(r, hi)];
        const f32x16 fv = {fr_[0], fr_[1], fr_[2], fr_[3], fr_[4], fr_[5], fr_[6], fr_[7], fr_[8], fr_[9], fr_[10], fr_[11], fr_[12], fr_[13], fr_[14], fr_[15]};
        st.o[0] = st.o[0] * fv; st.o[1] = st.o[1] * fv;
    }
    float pe[32]; float s0 = 0.f, s1 = 0.f;
#pragma unroll
    for (int r = 0; r < 32; r += 2) { pe[r] = __builtin_amdgcn_exp2f(sc[r]); pe[r + 1] = __builtin_amdgcn_exp2f(sc[r + 1]); s0 += pe[r]; s1 += pe[r + 1]; }
    st.l += s0 + s1;
    u32x4 pw[4];
#pragma unroll
    for (int k = 0; k < 4; ++k) pw[k] = (u32x4){cvtpk(pe[8 * k + 0], pe[8 * k + 1]), cvtpk(pe[8 * k + 2], pe[8 * k + 3]), cvtpk(pe[8 * k + 4], pe[8 * k + 5]), cvtpk(pe[8 * k + 6], pe[8 * k + 7])};
#pragma unroll
    for (int d0 = 0; d0 < 2; ++d0)
#pragma unroll
        for (int ks = 0; ks < 4; ++ks) st.o[d0] = __builtin_amdgcn_mfma_f32_32x32x16_bf16(__builtin_bit_cast(bf16x8, pw[ks]), vf[d0 * 4 + ks], st.o[d0], 0, 0, 0);
}
__device__ __forceinline__ void attn_store(AttnState& st, bf16_t* Ow, int pitch, MLAS float* wsf, MLAS bf16_t* stg, int lane, int r32, int hi) {
    float l = halves_sum_f(st.l);
    if (hi == 0) wsf[32 + r32] = l;
    float rli[16];
#pragma unroll
    for (int r = 0; r < 16; ++r) rli[r] = 1.0f / wsf[32 + crow(r, hi)];
#pragma unroll
    for (int r = 0; r < 16; ++r) { const int orow = crow(r, hi);
#pragma unroll
        for (int d0 = 0; d0 < 2; ++d0) { const unsigned short b = (unsigned short)(cvtpk(st.o[d0][r] * rli[r], 0.f) & 0xffffu); stg[orow * 64 + d0 * 32 + r32] = b; } }
#pragma unroll
    for (int i = 0; i < 4; ++i) { const int row = i * 8 + (lane >> 3), ch = lane & 7; const u32x4 v = *(const MLAS u32x4*)(stg + row * 64 + ch * 8); *(u32x4*)(Ow + (size_t)row * pitch + ch * 8) = v; }
}

#ifndef DBG_REP_BS
#define DBG_REP_BS 1
#endif
__device__ __forceinline__ unsigned pk_sub_sat_u16(unsigned a, unsigned b) { unsigned r; asm("v_pk_sub_u16 %0, %1, %2 clamp" : "=v"(r) : "v"(a), "v"(b)); return r; }
__device__ __forceinline__ unsigned pk_min_u16(unsigned a, unsigned b) { unsigned r; asm("v_pk_min_u16 %0, %1, %2" : "=v"(r) : "v"(a), "v"(b)); return r; }
__device__ __forceinline__ unsigned pk_add_u16(unsigned a, unsigned b) { unsigned r; asm("v_pk_add_u16 %0, %1, %2" : "=v"(r) : "v"(a), "v"(b)); return r; }
__device__ __forceinline__ unsigned pk_ashr_i16(unsigned a, unsigned sh2) { unsigned r; asm("v_pk_ashrrev_i16 %0, %1, %2" : "=v"(r) : "v"(sh2), "v"(a)); return r; }
__device__ __forceinline__ unsigned score_keys(float a, float b) {
    const unsigned p = __builtin_bit_cast(unsigned, __builtin_amdgcn_cvt_pkrtz(a, b));
    const unsigned m = pk_ashr_i16(p, 0x000f000fu);
    return p ^ (m | 0x80008000u);
}
template <int NS> __device__ __forceinline__ unsigned bit_search(const unsigned (&kp)[8][8], MLAS unsigned* cntx, int wid, int r32, int hi) {
    unsigned tau = 0u;
#pragma unroll 1
    for (int bit = 15; bit >= 0; --bit) {
        const unsigned cand = tau | (1u << bit);
        const unsigned c2 = (cand - 1u) * 0x00010001u;
        unsigned cnt2 = 0;
#pragma unroll
        for (int jj = 0; jj < NS; ++jj)
#pragma unroll
            for (int r = 0; r < 8; ++r) cnt2 = pk_add_u16(cnt2, pk_min_u16(pk_sub_sat_u16(kp[jj][r], c2), 0x00010001u));
        unsigned cnt = (cnt2 & 0xffffu) + (cnt2 >> 16);
        cnt = halves_add_u(cnt);
        MLAS unsigned* cb = cntx + (bit & 1) * 256;
        if (hi == 0) cb[wid * 32 + r32] = cnt;
        LGKM_BAR();
        unsigned tot = 0;
#pragma unroll
        for (int w = 0; w < 8; ++w) tot += cb[w * 32 + r32];
        if (tot >= 256u) tau = cand;
    }
    return tau;
}
__device__ __forceinline__ void dsa_select(int b, int qg, const bf16_t* Z0, char* shm, const int wave_s) {
    const int tid_ = wave_s * 64 + lane_opaque(); const int tid = tid_, lane = tid & 63, r32 = lane & 31, hi = lane >> 5; const int wid = __builtin_amdgcn_readfirstlane(tid >> 6);
    MLAS char* L = (MLAS char*)shm;
    const int c = qg >> 1, nkeys = 64 * (c + 1), nt32 = nkeys >> 5, nt64 = nkeys >> 6;
    const size_t rowb = (size_t)b * SEQ;
    const size_t tok0 = rowb + 32 * qg;
    MLAS unsigned* selw = (MLAS unsigned*)(L + LX_SEL);
    if (nkeys <= 256) {
        for (int i = tid; i < 64 * 32; i += 512) selw[i] = (i < nt32 * 32) ? 0xffffffffu : 0u;
    } else {
        {
            MLAS u32x4* iqL = (MLAS u32x4*)(L + LX_IQ);
            for (int i = tid; i < 1024; i += 512) { const int q = i & 31, hh = (i >> 5) & 1, d0 = (i >> 6) & 3, h = i >> 8;
                iqL[i] = *(const u32x4*)(Z0 + (tok0 + q) * EV_N + 1280 + 64 * h + 16 * d0 + 8 * hh); }
        }
        float w4[4];
        { const u32x2 ww = *(const u32x2*)(Z0 + (tok0 + r32) * EV_N + 1216);
          w4[0] = pg8::bf_lo(ww.x) * 0.0625f; w4[1] = pg8::bf_hi(ww.x) * 0.0625f; w4[2] = pg8::bf_lo(ww.y) * 0.0625f; w4[3] = pg8::bf_hi(ww.y) * 0.0625f; }
        LGKM_BAR();
        unsigned kp[8][8];
        const int nslots = (nt32 + 7) >> 3;
        const MLAS bf16x8* iqf = (const MLAS bf16x8*)(L + LX_IQ) + hi * 32 + r32;
#pragma unroll
        for (int jj = 0; jj < 8; ++jj) {
            const int j = wid + 8 * jj;
            if (j < nt32) {
                const bf16_t* ikp = Z0 + (rowb + 32 * j + r32) * EV_N + 1152 + 8 * hi;
                bf16x8 af[4];
#pragma unroll
                for (int d0 = 0; d0 < 4; ++d0) af[d0] = *(const bf16x8*)(ikp + 16 * d0);
                f32x16 ah[4];
#pragma unroll
                for (int h = 0; h < 4; ++h) {
                    f32x16 a = {};
#pragma unroll
                    for (int d0 = 0; d0 < 4; ++d0) a = __builtin_amdgcn_mfma_f32_32x32x16_bf16(af[d0], iqf[(h * 4 + d0) * 64], a, 0, 0, 0);
                    ah[h] = a;
                }
                float sv[16];
                {
                    float a0[16], a1[16], a2[16], a3[16];
                    V16_TO_ARR(ah[0], a0, 0); V16_TO_ARR(ah[1], a1, 0); V16_TO_ARR(ah[2], a2, 0); V16_TO_ARR(ah[3], a3, 0);
#pragma unroll
                    for (int r = 0; r < 16; ++r) sv[r] = ((__builtin_fmaxf(a0[r], 0.f) * w4[0] + __builtin_fmaxf(a1[r], 0.f) * w4[1]) + __builtin_fmaxf(a2[r], 0.f) * w4[2]) + __builtin_fmaxf(a3[r], 0.f) * w4[3];
                }
#pragma unroll
                for (int r = 0; r < 8; ++r) kp[jj][r] = score_keys(sv[r], sv[r + 8]);
            } else {
#pragma unroll
                for (int r = 0; r < 8; ++r) kp[jj][r] = 0u;
            }
        }
        MLAS unsigned* cntx = (MLAS unsigned*)(L + L_OST);
        unsigned tau;
        for (int rep_ = 0; rep_ < DBG_REP_BS; ++rep_)
        switch (nslots) {
            case 2: tau = bit_search<2>(kp, cntx, wid, r32, hi); break;
            case 3: tau = bit_search<3>(kp, cntx, wid, r32, hi); break;
            case 4: tau = bit_search<4>(kp, cntx, wid, r32, hi); break;
            case 5: tau = bit_search<5>(kp, cntx, wid, r32, hi); break;
            case 6: tau = bit_search<6>(kp, cntx, wid, r32, hi); break;
            case 7: tau = bit_search<7>(kp, cntx, wid, r32, hi); break;
            default: tau = bit_search<8>(kp, cntx, wid, r32, hi); break;
        }
        MLAS unsigned* gtw = (MLAS unsigned*)(L + LX_GT); MLAS unsigned* eqw = (MLAS unsigned*)(L + LX_EQ); MLAS unsigned* pfx = (MLAS unsigned*)(L + LX_PFX);
        const unsigned tg = tau * 0x00010001u, te = (tau - 1u) * 0x00010001u;
#pragma unroll
        for (int jj = 0; jj < 8; ++jj) {
            const int j = wid + 8 * jj;
            if (j < nt32) {
                unsigned g = 0, e = 0;
#pragma unroll
                for (int r = 0; r < 8; ++r) {
                    const unsigned dgt = pk_min_u16(pk_sub_sat_u16(kp[jj][r], tg), 0x00010001u), dge = pk_min_u16(pk_sub_sat_u16(kp[jj][r], te), 0x00010001u);
                    const int pos = (r & 3) + 8 * (r >> 2);
                    g |= dgt << pos; e |= (dge - dgt) << pos;
                }
                g <<= 4 * hi; e <<= 4 * hi;
                g = halves_or_u(g); e = halves_or_u(e);
                if (hi == 0) { gtw[j * 32 + r32] = g; eqw[j * 32 + r32] = e; }
            }
        }
        LGKM_BAR();
        if (wid == 0 && hi == 0) {
            unsigned cg = 0;
            for (int j = 0; j < nt32; ++j) cg += __builtin_popcount(gtw[j * 32 + r32]);
            const int need = 256 - (int)cg;
            int run = 0;
            for (int j = 0; j < nt32; ++j) { const unsigned e = eqw[j * 32 + r32]; int k = need - run; k = k < 0 ? 0 : (k > 32 ? 32 : k); pfx[j * 32 + r32] = (unsigned)k; run += __builtin_popcount(e); }
        }
        LGKM_BAR();
        for (int i = tid; i < nt32 * 32; i += 512) {
            const unsigned g = gtw[i], e = eqw[i]; const int k = (int)pfx[i];
            unsigned take = 0;
            if (e != 0u && k > 0) {
                unsigned rem = e; int cntk = 0;
                while (rem != 0u && cntk < k) { const unsigned low = rem & (0u - rem); take |= low; rem ^= low; ++cntk; }
            }
            selw[i] = g | take;
        }
        for (int i = nt32 * 32 + tid; i < 64 * 32; i += 512) selw[i] = 0u;
    }
    WAITV_BAR();
}

__device__ __forceinline__ void fox_unit(int b, int h, int qb, const bf16_t* Z1, const float* F, const float* bfp, bf16_t* Y, char* shm, unsigned lds0, const int wave_s) {
    const int tid_ = wave_s * 64 + lane_opaque(); const int tid = tid_, lane = tid & 63, r32 = lane & 31, hi = lane >> 5; const int wid = __builtin_amdgcn_readfirstlane(tid >> 6);
    MLAS char* L = (MLAS char*)shm;
    const size_t rowb = (size_t)b * SEQ;
    const int NT = 4 * (qb + 1), nk = 64 * NT;
    MLAS float* cum2 = (MLAS float*)(L + L_X);
    MLAS float* wtot = (MLAS float*)(L + L_X + 8192);
    const bf16_t* Kb = Z1 + rowb * Z1P + 512 + 64 * h; const bf16_t* Vb = Z1 + rowb * Z1P + 1024 + 64 * h;
#pragma unroll
    for (int i = 0; i < 3; ++i) dma_kv(Kb + (size_t)64 * i * Z1P, Vb + (size_t)64 * i * Z1P, Z1P, lds0, i, wid, lane);
    {
        const float bias = bfp[h];
        const int s0 = 4 * tid;
        float v[4]; float run = 0.f;
#pragma unroll
        for (int i = 0; i < 4; ++i) {
            float x = 0.f;
            if (s0 + i < nk) x = F[(rowb + s0 + i) * 8 + h] + bias;
            const float ls = (s0 + i < nk) ? (fminf(x, 0.f) - log1pf(expf(-fabsf(x)))) : 0.f;
            run += ls; v[i] = run;
        }
        float inc = run;
#pragma unroll
        for (int o = 1; o < 64; o <<= 1) { const int ln = lane_opaque(); const float t = __builtin_bit_cast(float, __builtin_amdgcn_ds_bpermute((ln - o) << 2, __builtin_bit_cast(int, inc))); if (ln >= o) inc += t; }
        if (lane == 63) wtot[wid] = inc;
        LGKM_BAR();
        float off = inc - run;
        for (int w = 0; w < wid; ++w) off += wtot[w];
#pragma unroll
        for (int i = 0; i < 4; ++i) cum2[s0 + i] = (off + v[i]) * 1.4426950408889634f;
    }
    const int tq = 256 * qb + 32 * wid + r32;
    bf16x8 qr[4];
#pragma unroll
    for (int d0 = 0; d0 < 4; ++d0) qr[d0] = *(const bf16x8*)(Z1 + (rowb + tq) * Z1P + 64 * h + 16 * d0 + 8 * hi);
    AttnState st; st.o[0] = f32x16{}; st.o[1] = f32x16{}; st.m = 0.f; st.l = 0.f; st.pend = 0.f; st.started = false;
    MLAS float* wsf = (MLAS float*)(L + L_WSF) + wid * 64;
    WAITV_BAR();
    const float cq2 = cum2[tq];
    const int tlast = 4 * qb + (wid >> 1);
    f32x16 s0, s1;
    qkt(s0, s1, (lds_cptr)(L + L_K), qr, splat16(-st.m), r32, hi);
    for (int t = 0; t < NT; ++t) {
        const int slot = t & 3;
        { const int tt = (t + 3 < NT) ? t + 3 : NT - 1; dma_kv(Kb + (size_t)64 * tt * Z1P, Vb + (size_t)64 * tt * Z1P, Z1P, lds0, (t + 3) & 3, wid, lane); }
        bf16x8 kf[8], vf[8];
        kload(kf, (lds_cptr)(L + L_K + ((t + 1) & 3) * SLOTB), r32, hi);
        __builtin_amdgcn_sched_barrier(0);
        vload(vf, (lds_cptr)(L + L_V + slot * SLOTB), lane, hi);
        const MLAS float* cb = cum2 + 64 * t + 4 * hi;
        f32x4 c0[4], c1[4];
#pragma unroll
        for (int g = 0; g < 4; ++g) { c0[g] = *(const MLAS f32x4*)(cb + 8 * g); c1[g] = *(const MLAS f32x4*)(cb + 32 + 8 * g); }
        f32x16 n0, n1;
        qkt_mma(n0, n1, kf, qr, splat16(-st.m));
        float sc[32];
        V16_TO_ARR(s0, sc, 0); V16_TO_ARR(s1, sc, 16);
#pragma unroll
        for (int g = 0; g < 4; ++g) {
            sc[4 * g + 0] += cq2 - c0[g].x; sc[4 * g + 1] += cq2 - c0[g].y; sc[4 * g + 2] += cq2 - c0[g].z; sc[4 * g + 3] += cq2 - c0[g].w;
            sc[16 + 4 * g + 0] += cq2 - c1[g].x; sc[16 + 4 * g + 1] += cq2 - c1[g].y; sc[16 + 4 * g + 2] += cq2 - c1[g].z; sc[16 + 4 * g + 3] += cq2 - c1[g].w;
        }
        if (t >= tlast) {
            const int qrel = tq - 64 * t;
#pragma unroll
            for (int r = 0; r < 16; ++r) { const int kr = crow(r, hi); if (kr > qrel) sc[r] = -INFINITY; if (kr + 32 > qrel) sc[16 + r] = -INFINITY; }
        }
        softmax_pv(st, sc, vf, wsf, lane, r32, hi);
        s0 = n0; s1 = n1;
        WAITV2_BAR();
    }
    attn_store(st, Y + (rowb + 256 * qb + 32 * wid) * DMODEL + 64 * h, DMODEL, wsf, (MLAS bf16_t*)(L + L_OST) + wid * 2048, lane, r32, hi);
    WAITV_BAR();
}

__device__ __forceinline__ void sgu_unit(int b, int n, int g, const bf16_t* Z1, const float* sst, const float* lng, const float* lnb, const bf16_t* Wm, const float* bs, bf16_t* Y, char* shm, const int wave_s) {
    const int tid_ = wave_s * 64 + lane_opaque(); const int tid = tid_, lane = tid & 63, r32 = lane & 31, hi = lane >> 5; const int wid = __builtin_amdgcn_readfirstlane(tid >> 6);
    MLAS char* L = (MLAS char*)shm;
    MLAS bf16_t* vn = (MLAS bf16_t*)L;
    constexpr int VP = 136;
    const size_t tok0 = (size_t)b * SEQ + 128 * n;
    {
        const int j = tid >> 2, cq = (tid & 3) * 32;
        const float* sp = sst + (tok0 + j) * 16;
        float s1 = 0.f, s2 = 0.f;
#pragma unroll
        for (int k = 0; k < 8; ++k) { s1 += sp[2 * k]; s2 += sp[2 * k + 1]; }
        const float mu = s1 * (1.0f / 512.0f); const float var = fmaxf(s2 * (1.0f / 512.0f) - mu * mu, 0.f);
        const float rstd = 1.0f / sqrtf(var + RMS_EPS);
        const bf16_t* vp = Z1 + (tok0 + j) * Z1P + 2048 + 128 * g + cq;
#pragma unroll
        for (int k = 0; k < 4; ++k) {
            const u32x4 w = *(const u32x4*)(vp + 8 * k);
            const int cc = 128 * g + cq + 8 * k;
            const f32x4 g0 = *(const f32x4*)(lng + cc), g1 = *(const f32x4*)(lng + cc + 4), b0 = *(const f32x4*)(lnb + cc), b1 = *(const f32x4*)(lnb + cc + 4);
            float x[8] = {pg8::bf_lo(w.x), pg8::bf_hi(w.x), pg8::bf_lo(w.y), pg8::bf_hi(w.y), pg8::bf_lo(w.z), pg8::bf_hi(w.z), pg8::bf_lo(w.w), pg8::bf_hi(w.w)};
            float y[8];
#pragma unroll
            for (int i = 0; i < 4; ++i) { y[i] = (x[i] - mu) * rstd * g0[i] + b0[i]; y[4 + i] = (x[4 + i] - mu) * rstd * g1[i] + b1[i]; }
            u32x4 o; o.x = cvtpk(y[0], y[1]); o.y = cvtpk(y[2], y[3]); o.z = cvtpk(y[4], y[5]); o.w = cvtpk(y[6], y[7]);
            *(MLAS u32x4*)(vn + j * VP + cq + 8 * k) = o;
        }
    }
    LGKM_BAR();
    MLAS bf16_t* ut = (MLAS bf16_t*)(L + 128 * VP * 2);
    {
        const int j = tid >> 2, cq = (tid & 3) * 32;
        const bf16_t* up = Z1 + (tok0 + j) * Z1P + 1536 + 128 * g + cq;
#pragma unroll
        for (int k = 0; k < 4; ++k) *(MLAS u32x4*)(ut + j * VP + cq + 8 * k) = *(const u32x4*)(up + 8 * k);
    }
    LGKM_BAR();
    const int ib = wid & 3;
    const bf16_t* wrow = Wm + ((size_t)g * 128 + 32 * ib + r32) * 128 + 8 * hi;
    bf16x8 af[8];
#pragma unroll
    for (int s = 0; s < 8; ++s) af[s] = *(const bf16x8*)(wrow + 16 * s);
#pragma unroll
    for (int cbi = 0; cbi < 2; ++cbi) {
        const int cb = (wid >> 2) * 2 + cbi;
        f32x16 acc = {};
        lds_cptr bp = (lds_cptr)(vn) + ((size_t)(8 * hi + ((lane & 15) >> 2)) * VP + 32 * cb + 16 * ((lane >> 4) & 1) + 4 * (lane & 3)) * 2;
#pragma unroll
        for (int s = 0; s < 8; ++s) {
            const s16x4 lo = vtr(bp + (16 * s) * VP * 2), hh = vtr(bp + (16 * s + 4) * VP * 2);
            const bf16x8 bfr = {lo[0], lo[1], lo[2], lo[3], hh[0], hh[1], hh[2], hh[3]};
            acc = __builtin_amdgcn_mfma_f32_32x32x16_bf16(af[s], bfr, acc, 0, 0, 0);
        }
        float a16[16]; V16_TO_ARR(acc, a16, 0);
#pragma unroll
        for (int r = 0; r < 16; ++r) {
            const int i = 32 * ib + crow(r, hi), cc = 32 * cb + r32;
            const float uu = __builtin_bit_cast(float, (unsigned)ut[i * VP + cc] << 16);
            const float o = uu * (a16[r] + bs[g * 128 + i]);
            ut[i * VP + cc] = (bf16_t)(cvtpk(o, 0.f) & 0xffffu);
        }
    }
    LGKM_BAR();
    {
        const int j = tid >> 2, cq = (tid & 3) * 32;
        bf16_t* yp = Y + (tok0 + j) * DMODEL + 512 + 128 * g + cq;
#pragma unroll
        for (int k = 0; k < 4; ++k) *(u32x4*)(yp + 8 * k) = *(const MLAS u32x4*)(ut + j * VP + cq + 8 * k);
    }
    LGKM_BAR();
}

__device__ __forceinline__ void pool_item(int item, const bf16_t* Z0, bf16_t* Y) {
    const int row = item >> 6, ch = item & 63, c0 = ch * 8, g = ch >> 4;
    const int w = 2 << g, tpos = row & (SEQ - 1);
    const int cnt = (tpos + 1 < w) ? tpos + 1 : w;
    u32x4 v[16];
#pragma unroll
    for (int k = 0; k < 16; ++k) { v[k] = (u32x4){0u, 0u, 0u, 0u}; if (k < cnt) v[k] = *(const u32x4*)(Z0 + (size_t)(row - k) * EV_N + c0); }
    float s[8] = {0.f, 0.f, 0.f, 0.f, 0.f, 0.f, 0.f, 0.f};
#pragma unroll
    for (int k = 0; k < 16; ++k) {
        s[0] += pg8::bf_lo(v[k].x); s[1] += pg8::bf_hi(v[k].x); s[2] += pg8::bf_lo(v[k].y); s[3] += pg8::bf_hi(v[k].y);
        s[4] += pg8::bf_lo(v[k].z); s[5] += pg8::bf_hi(v[k].z); s[6] += pg8::bf_lo(v[k].w); s[7] += pg8::bf_hi(v[k].w);
    }
    const float self[8] = {pg8::bf_lo(v[0].x), pg8::bf_hi(v[0].x), pg8::bf_lo(v[0].y), pg8::bf_hi(v[0].y), pg8::bf_lo(v[0].z), pg8::bf_hi(v[0].z), pg8::bf_lo(v[0].w), pg8::bf_hi(v[0].w)};
    const float inv = 1.0f / (float)cnt;
    u32x4 o; o.x = cvtpk(s[0] * inv - self[0], s[1] * inv - self[1]); o.y = cvtpk(s[2] * inv - self[2], s[3] * inv - self[3]);
    o.z = cvtpk(s[4] * inv - self[4], s[5] * inv - self[5]); o.w = cvtpk(s[6] * inv - self[6], s[7] * inv - self[7]);
    *(u32x4*)(Y + (size_t)row * DMODEL + c0) = o;
}
}
namespace foxa {
using bf16=__hip_bfloat16;
using bf16x8=__attribute__((ext_vector_type(8)))short;
using s16x4=__attribute__((ext_vector_type(4)))short;
using f32x16=__attribute__((ext_vector_type(16)))float;
using u32x4=__attribute__((ext_vector_type(4)))unsigned;
using f32x4v=__attribute__((ext_vector_type(4)))float;
constexpr int CUM_OFF=86016;
constexpr int SEQL=2048,D=64,OPI=1024;
constexpr int NW=8,QBLK=32,QB=QBLK*NW,KVBLK=64;
__device__ __forceinline__ int crow(int r,int hi){return (r&3)+8*(r>>2)+4*hi;}
#define SBAR() __builtin_amdgcn_sched_barrier(0)
__device__ __forceinline__ void cmask(f32x16&p0,f32x16&p1,int jb,int qrel,int hi){
  const float NEG=-INFINITY; int kb=64*jb+4*hi;
  #pragma unroll
  for(int r=0;r<16;++r){int kv=kb+(r&3)+8*(r>>2); if(kv>qrel)p0[r]=NEG; if(kv+32>qrel)p1[r]=NEG;}
}

constexpr int NSLOT=3, SLOTB=8192;
constexpr int LDS_K=0, LDS_V=NSLOT*SLOTB, LDS_WS=2*NSLOT*SLOTB, LDS_OST=LDS_WS+NW*64*4, LDS_BYTES=LDS_OST+NW*4096;
constexpr float C2=0.125f*1.4426950408889634f;
__device__ __forceinline__ void glds16(const void*gsrc,unsigned lds_dst){unsigned keep;
  asm volatile("s_mov_b32 %0, m0\n\ts_mov_b32 m0, %2\n\ts_nop 0\n\tglobal_load_lds_dwordx4 %1, off\n\ts_mov_b32 m0, %0":"=&s"(keep):"v"(gsrc),"s"(lds_dst):"memory");}
__device__ __forceinline__ float max3f(float a,float b,float c){float r;asm("v_max3_f32 %0, %1, %2, %3":"=v"(r):"v"(a),"v"(b),"v"(c));return r;}
__device__ __forceinline__ float max2f(float a,float b){float r;asm("v_max_f32_e32 %0, %1, %2":"=v"(r):"v"(a),"v"(b));return r;}
__device__ __forceinline__ float fadd_s(float a,float b){float r;asm("v_add_f32_e32 %0, %1, %2":"=v"(r):"v"(a),"v"(b));return r;}
__device__ __forceinline__ float fsub_s(float a,float b){float r;asm("v_sub_f32_e32 %0, %1, %2":"=v"(r):"v"(a),"v"(b));return r;}
typedef float f32x2_t __attribute__((ext_vector_type(2))); typedef __bf16 bf16x2_t __attribute__((ext_vector_type(2)));
__device__ __forceinline__ unsigned cvtpk_s(float lo,float hi){f32x2_t v={lo,hi};bf16x2_t b=__builtin_convertvector(v,bf16x2_t);return __builtin_bit_cast(unsigned,b);}
#define WAIT_BAR(N) asm volatile("s_waitcnt vmcnt(" #N ") lgkmcnt(0)\n\ts_barrier":::"memory")

__device__ __forceinline__ void qkt(f32x16&p0,f32x16&p1,const char*Kslot,const bf16x8*qr,const f32x16&negm,int r32,int hi){
  const char*kb=Kslot+hi*1024+r32*16;
  #pragma unroll
  for(int d0=0;d0<4;++d0){
    const bf16x8 b0=*reinterpret_cast<const bf16x8*>(kb+d0*2048);
    const bf16x8 b1=*reinterpret_cast<const bf16x8*>(kb+d0*2048+512);
    if(d0==0){p0=__builtin_amdgcn_mfma_f32_32x32x16_bf16(b0,qr[0],negm,0,0,0);p1=__builtin_amdgcn_mfma_f32_32x32x16_bf16(b1,qr[0],negm,0,0,0);}
    else{p0=__builtin_amdgcn_mfma_f32_32x32x16_bf16(b0,qr[d0],p0,0,0,0);p1=__builtin_amdgcn_mfma_f32_32x32x16_bf16(b1,qr[d0],p1,0,0,0);}}
}
typedef __attribute__((address_space(3))) const char* lds_cptr;
typedef short v4i16_t __attribute__((ext_vector_type(4)));
__device__ __forceinline__ void kload8(bf16x8*kf,lds_cptr kp){
  kf[0]=*(const __attribute__((address_space(3))) bf16x8*)(kp);      kf[1]=*(const __attribute__((address_space(3))) bf16x8*)(kp+512);
  kf[2]=*(const __attribute__((address_space(3))) bf16x8*)(kp+2048); kf[3]=*(const __attribute__((address_space(3))) bf16x8*)(kp+2560);
  kf[4]=*(const __attribute__((address_space(3))) bf16x8*)(kp+4096); kf[5]=*(const __attribute__((address_space(3))) bf16x8*)(kp+4608);
  kf[6]=*(const __attribute__((address_space(3))) bf16x8*)(kp+6144); kf[7]=*(const __attribute__((address_space(3))) bf16x8*)(kp+6656);
}
__device__ __forceinline__ void kload2(bf16x8*kf,lds_cptr kp,int j){ kf[2*j]=*(const __attribute__((address_space(3))) bf16x8*)(kp+j*2048); kf[2*j+1]=*(const __attribute__((address_space(3))) bf16x8*)(kp+j*2048+512); }
__device__ __forceinline__ s16x4 vtr(lds_cptr p){ return __builtin_bit_cast(s16x4,__builtin_amdgcn_ds_read_tr16_b64_v4i16((__attribute__((address_space(3))) v4i16_t*)p)); }
__device__ __forceinline__ float rowmax(const f32x16&p0,const f32x16&p1){
  float a=max3f(p0[0],p0[1],p1[0]),b=max3f(p0[2],p0[3],p1[1]);a=max3f(a,p1[2],p1[3]);
  #pragma unroll
  for(int r=4;r<16;r+=4){a=max3f(a,p0[r],p0[r+1]);b=max3f(b,p0[r+2],p0[r+3]);a=max3f(a,p1[r],p1[r+1]);b=max3f(b,p1[r+2],p1[r+3]);}
  const float m=max2f(a,b);
  auto rr=__builtin_amdgcn_permlane32_swap(__float_as_uint(m),__float_as_uint(m),false,false);
  return max2f(__uint_as_float(rr[0]),__uint_as_float(rr[1]));
}
__device__ __forceinline__ void pv(f32x16*o,int vb,bf16x8 pa0,bf16x8 pa1,bf16x8 pa2,bf16x8 pa3){
  #pragma unroll
  for(int d0=0;d0<2;++d0){s16x4 lo[4],hi[4];
    #pragma unroll
    for(int ks=0;ks<4;++ks){
      asm volatile("ds_read_b64_tr_b16 %0,%1 offset:%c2":"=&v"(lo[ks]):"v"(vb),"i"(d0*4096+ks*1024):"memory");
      asm volatile("ds_read_b64_tr_b16 %0,%1 offset:%c2":"=&v"(hi[ks]):"v"(vb),"i"(d0*4096+ks*1024+512):"memory");}
    asm volatile("s_waitcnt lgkmcnt(0)":::"memory");SBAR();
    #define PK(k) (bf16x8){lo[k][0],lo[k][1],lo[k][2],lo[k][3],hi[k][0],hi[k][1],hi[k][2],hi[k][3]}
    o[d0]=__builtin_amdgcn_mfma_f32_32x32x16_bf16(pa0,PK(0),o[d0],0,0,0);
    o[d0]=__builtin_amdgcn_mfma_f32_32x32x16_bf16(pa1,PK(1),o[d0],0,0,0);
    o[d0]=__builtin_amdgcn_mfma_f32_32x32x16_bf16(pa2,PK(2),o[d0],0,0,0);
    o[d0]=__builtin_amdgcn_mfma_f32_32x32x16_bf16(pa3,PK(3),o[d0],0,0,0);
    #undef PK
  }
}

#ifndef ATTN_STORE16
#define ATTN_STORE16(p,v) (*(u32x4*)(p)=(v))
#endif
template<int THRL,int MODE,int QKVP,class CumFn> __device__ __forceinline__ void attn_unit(CumFn&& CUMFN,int b,int h,int qb,int q0abs,int NTU,const bf16*Q,const bf16*__restrict__ K,const bf16*__restrict__ V,bf16*O,char*shm,const __attribute__((address_space(3))) unsigned*selw,const int wave_s){
  const int tid=wave_s*64+lane_opaque(),lane=tid&63,r32=lane&31,hi=lane>>5; const int wid=__builtin_amdgcn_readfirstlane(tid>>6);
  const long rowbase=(long)b*SEQL; const int q0=(MODE==0)?qb*QB:q0abs;
  const bf16*Qw=(MODE==0)?Q+(rowbase+q0+wid*QBLK)*QKVP+h*D:Q+(rowbase+q0)*QKVP+wid*D;
  const bf16*Kh=K+rowbase*QKVP+h*D,*Vh=V+rowbase*QKVP+h*D;
  const unsigned lds0=(unsigned)(uintptr_t)shm;
  float*wsf=(float*)(shm+LDS_WS)+wid*64;
  const bf16*ksrc=Kh+(long)lane*QKVP+wid*8;
  const bf16*vsrc=Vh+(long)(16*(wid&3)+(lane>>2))*QKVP+(wid>>2)*32+(lane&3)*8;
  const unsigned kdst=lds0+LDS_K+wid*1024, vdst=lds0+LDS_V+wid*1024;
  #define DMA_K(t,slot) glds16(ksrc+(long)(t)*KVBLK*QKVP,(unsigned)__builtin_amdgcn_readfirstlane(kdst+(slot)))
  #define DMA_V(t,slot) glds16(vsrc+(long)(t)*KVBLK*QKVP,(unsigned)__builtin_amdgcn_readfirstlane(vdst+(slot)))
  const int vb0=(int)(lds0+LDS_V)+((lane>>4)&1)*32+(lane&3)*8+(4*hi+((lane&15)>>2))*64;
  const char*Kbase=shm+LDS_K; bf16x8 kf[8];
  const lds_cptr shm3=(lds_cptr)shm; const lds_cptr kp0=shm3+LDS_K+hi*1024+r32*16; const lds_cptr vp0=shm3+LDS_V+((lane>>4)&1)*32+(lane&3)*8+(4*hi+((lane&15)>>2))*64;
  const int NT=(MODE==0)?(q0+QB)/KVBLK:NTU;
  DMA_K(0,0);DMA_V(0,0);DMA_K(1,SLOTB);
  if constexpr(MODE==0){ CUMFN(); }
  bf16x8 qr[4];
  #pragma unroll
  for(int d0=0;d0<4;++d0)qr[d0]=*reinterpret_cast<const bf16x8*>(&Qw[(long)r32*QKVP+d0*16+hi*8]);
  float mhat=0.f,l_reg=0.f;float z_=0.f;asm volatile("":"+v"(z_));f32x16 o[2];o[0]=(f32x16){z_,z_,z_,z_,z_,z_,z_,z_,z_,z_,z_,z_,z_,z_,z_,z_};o[1]=o[0];f32x16 negm=o[0];asm volatile("":"+v"(negm));
  const int qrel=wid*QBLK+r32;
  const __attribute__((address_space(3))) float*cum2=(const __attribute__((address_space(3))) float*)(shm+CUM_OFF);
  const float cq2=(MODE==0)?cum2[q0+qrel]:0.f;
  #define BIAS(P0,P1,t) do{ if constexpr(MODE==0){ const __attribute__((address_space(3))) float*cb_=cum2+64*(t)+4*hi; \
    _Pragma("unroll") for(int g_=0;g_<4;++g_){ const f32x4v c0_=*(const __attribute__((address_space(3))) f32x4v*)(cb_+8*g_), c1_=*(const __attribute__((address_space(3))) f32x4v*)(cb_+32+8*g_); \
      P0[4*g_+0]+=cq2-c0_.x; P0[4*g_+1]+=cq2-c0_.y; P0[4*g_+2]+=cq2-c0_.z; P0[4*g_+3]+=cq2-c0_.w; \
      P1[4*g_+0]+=cq2-c1_.x; P1[4*g_+1]+=cq2-c1_.y; P1[4*g_+2]+=cq2-c1_.z; P1[4*g_+3]+=cq2-c1_.w; } } }while(0)
  #define SELM(P0,P1,t) do{ if constexpr(MODE==1){ const unsigned w0_=selw[(2*(t))*32+r32]>>(4*hi), w1_=selw[(2*(t)+1)*32+r32]>>(4*hi); \
    _Pragma("unroll") for(int r=0;r<16;++r){ const int sh_=(r&3)+8*(r>>2); if(!((w0_>>sh_)&1u))P0[r]=-INFINITY; if(!((w1_>>sh_)&1u))P1[r]=-INFINITY; } } }while(0)
  #define CMASK(P0,P1,t) do{ if constexpr(MODE==0){int jb_=(t)-(NT-4); if(jb_>=0)cmask(P0,P1,jb_,qrel,hi);} }while(0)
  bool resc=false;
  #define START(P0,P1) do{ const float rm=rowmax(P0,P1); resc=false; \
    { const float dl=(MODE==1&&!(rm>-1e30f))?0.f:rm; mhat=fadd_s(mhat,dl); \
      _Pragma("unroll") for(int r=0;r<16;++r){P0[r]=fsub_s(P0[r],dl);P1[r]=fsub_s(P1[r],dl);} \
      _Pragma("unroll") for(int r=0;r<16;++r)negm[r]=-mhat; asm volatile("":"+v"(negm)); } \
    _Pragma("unroll") for(int r=0;r<16;++r)P0[r]=__builtin_amdgcn_exp2f(P0[r]); }while(0)
  #define RESC() do{ if(resc){ asm volatile("s_waitcnt lgkmcnt(0)":::"memory"); \
      _Pragma("unroll") for(int d_=0;d_<2;++d_) _Pragma("unroll") for(int r=0;r<16;++r)o[d_][r]*=wsf[crow(r,hi)]; } }while(0)
  f32x16 pA0,pA1,pB0,pB1;
  int sl_prev=0,sl_cur=0,sl_next=SLOTB;
  #define ROT() do{sl_prev=sl_cur;sl_cur=sl_next;sl_next=(sl_next==(NSLOT-1)*SLOTB)?0:sl_next+SLOTB;}while(0)
  DMA_K(2,2*SLOTB);
  WAIT_BAR(3);
  qkt(pA0,pA1,Kbase,qr,negm,r32,hi);asm volatile("s_nop 15\n\ts_nop 7":"+v"(pA0),"+v"(pA1));BIAS(pA0,pA1,0);SELM(pA0,pA1,0);CMASK(pA0,pA1,0);
  START(pA0,pA1);
  _Pragma("unroll") for(int r=0;r<16;++r)pA1[r]=__builtin_amdgcn_exp2f(pA1[r]);
  WAIT_BAR(0);
  DMA_K(3,0);DMA_V(1,SLOTB);
  ROT();
  kload8(kf,kp0+sl_cur);
  WAIT_BAR(2);
  s16x4 vlo[8],vhi[8]; u32x4 pw0,pw1,pw2,pw3;
  #define PKW(P,B) cvtpk_s(P[B],P[B+1])
  #define PAF(k) __builtin_bit_cast(bf16x8,pw##k)
  #define VFR(i) (bf16x8){vlo[i][0],vlo[i][1],vlo[i][2],vlo[i][3],vhi[i][0],vhi[i][1],vhi[i][2],vhi[i][3]}
  #define PIN(x) asm volatile("":"+v"(x))
  #define MX3(a,b,c) __builtin_fmaxf(__builtin_fmaxf((a),(b)),(c))
  #define GAPA(MF,A0,A1,A2,A3,W0,W1,PW) do{ MF; sacc+=A0; sacc+=A1; sacc+=A2; sacc+=A3; PIN(sacc); W0; W1; PIN(PW); SBAR(); }while(0)
  #define EX(v) __builtin_amdgcn_exp2f(v)
  #define GAPB(MF,X,B) do{ MF; X[B]=EX(X[B]); X[B+1]=EX(X[B+1]); X[B+2]=EX(X[B+2]); X[B+3]=EX(X[B+3]); PIN(X); SBAR(); }while(0)
  #define VRD(i) do{ vlo[i]=vtr(vp_+(((i)>>2)*4096+((i)&3)*1024)); vhi[i]=vtr(vp_+(((i)>>2)*4096+((i)&3)*1024+512)); }while(0)
  #define KRD(G,j) do{ if(G){ kload2(kf,kp0+sl_next,j); SBAR(); } }while(0)
  #define STEP(C0,C1,P0,P1,t,GK,GV,GL) do{ SBAR(); \
    const lds_cptr vp_=vp0+sl_prev; \
    VRD(0); SBAR(); float sacc=(P0[0]+P0[1]); \
    GAPA(C0=__builtin_amdgcn_mfma_f32_32x32x16_bf16(kf[0],qr[0],negm,0,0,0), P0[2],P0[3],P0[4],P0[5],     pw0[0]=PKW(P0,0), pw0[1]=PKW(P0,2), pw0); \
    VRD(4); SBAR(); GAPA(C1=__builtin_amdgcn_mfma_f32_32x32x16_bf16(kf[1],qr[0],negm,0,0,0), P0[6],P0[7],P0[8],P0[9],     pw0[2]=PKW(P0,4), pw0[3]=PKW(P0,6), pw0); \
    VRD(1); SBAR(); GAPA(C0=__builtin_amdgcn_mfma_f32_32x32x16_bf16(kf[2],qr[1],C0,0,0,0),   P0[10],P0[11],P0[12],P0[13], pw1[0]=PKW(P0,8), pw1[1]=PKW(P0,10), pw1); \
    VRD(5); SBAR(); GAPA(C1=__builtin_amdgcn_mfma_f32_32x32x16_bf16(kf[3],qr[1],C1,0,0,0),   P0[14],P0[15],P1[0],P1[1],   pw1[2]=PKW(P0,12),pw1[3]=PKW(P0,14), pw1); \
    VRD(2); SBAR(); GAPA(C0=__builtin_amdgcn_mfma_f32_32x32x16_bf16(kf[4],qr[2],C0,0,0,0),   P1[2],P1[3],P1[4],P1[5],     pw2[0]=PKW(P1,0), pw2[1]=PKW(P1,2), pw2); \
    VRD(6); SBAR(); GAPA(C1=__builtin_amdgcn_mfma_f32_32x32x16_bf16(kf[5],qr[2],C1,0,0,0),   P1[6],P1[7],P1[8],P1[9],     pw2[2]=PKW(P1,4), pw2[3]=PKW(P1,6), pw2); \
    VRD(3); SBAR(); GAPA(C0=__builtin_amdgcn_mfma_f32_32x32x16_bf16(kf[6],qr[3],C0,0,0,0),   P1[10],P1[11],P1[12],P1[13], pw3[0]=PKW(P1,8), pw3[1]=PKW(P1,10), pw3); \
    VRD(7); SBAR(); GAPA(C1=__builtin_amdgcn_mfma_f32_32x32x16_bf16(kf[7],qr[3],C1,0,0,0),   P1[14],P1[15],0.f,0.f,       pw3[2]=PKW(P1,12),pw3[3]=PKW(P1,14), pw3); \
    l_reg+=sacc; \
    if(GK){DMA_K((t)+3,sl_cur);} if(GV){DMA_V((t)+1,sl_next);} \
    BIAS(C0,C1,t); SELM(C0,C1,t); CMASK(C0,C1,t); \
    { float a=MX3(C0[0],C0[1],C1[0]),b=MX3(C0[2],C0[3],C1[1]); a=MX3(a,C1[2],C1[3]); \
      _Pragma("unroll") for(int r=4;r<16;r+=4){a=MX3(a,C0[r],C0[r+1]);b=MX3(b,C0[r+2],C0[r+3]);a=MX3(a,C1[r],C1[r+1]);b=MX3(b,C1[r+2],C1[r+3]);} \
      float rm=__builtin_fmaxf(a,b); { auto rr=__builtin_amdgcn_permlane32_swap(__float_as_uint(rm),__float_as_uint(rm),false,false); rm=__builtin_fmaxf(__uint_as_float(rr[0]),__uint_as_float(rr[1])); } \
      resc=false; \
      if(__builtin_expect(__any(rm>(float)THRL),0)){ const float dl=__builtin_fmaxf(rm,0.f); mhat+=dl; \
        _Pragma("unroll") for(int r=0;r<16;++r){C0[r]-=dl;C1[r]-=dl;} \
        _Pragma("unroll") for(int r=0;r<16;++r)negm[r]=-mhat; asm volatile("":"+v"(negm)); \
        const float f=__builtin_amdgcn_exp2f(-dl); l_reg*=f; if(hi==0)wsf[r32]=f; resc=true; } } \
    SBAR(); \
    GAPB(o[0]=__builtin_amdgcn_mfma_f32_32x32x16_bf16(PAF(0),VFR(0),o[0],0,0,0), C0,0); \
    GAPB(o[1]=__builtin_amdgcn_mfma_f32_32x32x16_bf16(PAF(0),VFR(4),o[1],0,0,0), C0,4); \
    KRD(GL,0); GAPB(o[0]=__builtin_amdgcn_mfma_f32_32x32x16_bf16(PAF(1),VFR(1),o[0],0,0,0), C0,8); \
    KRD(GL,1); GAPB(o[1]=__builtin_amdgcn_mfma_f32_32x32x16_bf16(PAF(1),VFR(5),o[1],0,0,0), C0,12); \
    KRD(GL,2); GAPB(o[0]=__builtin_amdgcn_mfma_f32_32x32x16_bf16(PAF(2),VFR(2),o[0],0,0,0), C1,0); \
    KRD(GL,3); GAPB(o[1]=__builtin_amdgcn_mfma_f32_32x32x16_bf16(PAF(2),VFR(6),o[1],0,0,0), C1,4); \
    GAPB(o[0]=__builtin_amdgcn_mfma_f32_32x32x16_bf16(PAF(3),VFR(3),o[0],0,0,0), C1,8); \
    GAPB(o[1]=__builtin_amdgcn_mfma_f32_32x32x16_bf16(PAF(3),VFR(7),o[1],0,0,0), C1,12); \
    }while(0)
  int t=1;
  #undef CMASK
  #define CMASK(P0,P1,t) do{}while(0)
  for(;t+5<NT;t+=2){
    STEP(pB0,pB1,pA0,pA1,t,true,true,true);     WAIT_BAR(2); RESC(); ROT();
    STEP(pA0,pA1,pB0,pB1,t+1,true,true,true);   WAIT_BAR(2); RESC(); ROT();
  }
  #undef CMASK
  #define CMASK(P0,P1,t) do{ if constexpr(MODE==0){int jb_=(t)-(NT-4); if(jb_>=0)cmask(P0,P1,jb_,qrel,hi);} }while(0)
  #define ENDW(tt) do{ if((tt)+3<NT){WAIT_BAR(2);} else if((tt)+2<NT){WAIT_BAR(1);} else {WAIT_BAR(0);} }while(0)
  for(;t+1<NT;t+=2){
    STEP(pB0,pB1,pA0,pA1,t,(t+3<NT),(t+1<NT),(t+1<NT));       ENDW(t);   RESC(); ROT();
    STEP(pA0,pA1,pB0,pB1,t+1,(t+4<NT),(t+2<NT),(t+2<NT));     ENDW(t+1); RESC(); ROT();
  }
  STEP(pB0,pB1,pA0,pA1,NT-1,false,false,false); RESC();
  { float sacc=pB0[0]+pB0[1]; _Pragma("unroll") for(int r=2;r<16;++r)sacc+=pB0[r]; _Pragma("unroll") for(int r=0;r<16;++r)sacc+=pB1[r]; l_reg+=sacc;
    pw0=(u32x4){PKW(pB0,0),PKW(pB0,2),PKW(pB0,4),PKW(pB0,6)};pw1=(u32x4){PKW(pB0,8),PKW(pB0,10),PKW(pB0,12),PKW(pB0,14)};pw2=(u32x4){PKW(pB1,0),PKW(pB1,2),PKW(pB1,4),PKW(pB1,6)};pw3=(u32x4){PKW(pB1,8),PKW(pB1,10),PKW(pB1,12),PKW(pB1,14)};
    SBAR(); pv(o,vb0+sl_cur,PAF(0),PAF(1),PAF(2),PAF(3)); }
  #undef PKW
  #undef PAF
  #undef VFR
  #undef PIN
  #undef MX3
  #undef GAPA
  #undef GAPB
  #undef EX
  #undef VRD
  #undef KRD
  #undef STEP
  #undef ENDW
  {auto rr=__builtin_amdgcn_permlane32_swap(__float_as_uint(l_reg),__float_as_uint(l_reg),false,false);l_reg=__uint_as_float(rr[0])+__uint_as_float(rr[1]);}
  if(hi==0)wsf[32+r32]=l_reg;asm volatile("s_waitcnt lgkmcnt(0)":::"memory");
  float rli[16];
  #pragma unroll
  for(int r=0;r<16;++r)rli[r]=__builtin_amdgcn_rcpf(wsf[32+crow(r,hi)]);
  bf16*Ow=(MODE==0)?O+(rowbase+q0+wid*QBLK)*OPI+h*D:O+(rowbase+q0)*OPI+wid*D;
  { bf16*stg=(bf16*)(shm+LDS_OST)+wid*2048;
    #pragma unroll
    for(int r=0;r<16;++r){const int orow=crow(r,hi);
      #pragma unroll
      for(int d0=0;d0<2;++d0)stg[orow*64+d0*32+r32]=__float2bfloat16(o[d0][r]*rli[r]);}
    asm volatile("s_waitcnt lgkmcnt(0)":::"memory");
    #pragma unroll
    for(int i=0;i<4;++i){const int row=i*8+(lane>>3),ch=lane&7; const u32x4 v=*(const u32x4*)(stg+row*64+ch*8); ATTN_STORE16(Ow+(long)row*OPI+ch*8,v);} }
  asm volatile("s_waitcnt lgkmcnt(0)\n\ts_barrier":::"memory");
  #undef DMA_K
  #undef DMA_V
  #undef CMASK
  #undef START
  #undef BIAS
  #undef SELM
  #undef RESC
  #undef ROT
}
#undef SBAR
#undef WAIT_BAR
}

#ifndef DBG_REP_SEL
#define DBG_REP_SEL 1
#endif
namespace mix {
__device__ __forceinline__ void fox_unit2(int b, int h, int qb, const bf16_t* Z1, const float* F, const float* bfp, bf16_t* Y, char* shm, const int wave_s) {
    const size_t rowb = (size_t)b * SEQ;
    const int nk = 256 * (qb + 1);
    auto cumfn = [=]() {
        const int tid = wave_s * 64 + lane_opaque(), lane = tid & 63; const int wid = __builtin_amdgcn_readfirstlane(tid >> 6);
        MLAS char* L = (MLAS char*)shm;
        MLAS float* cum2 = (MLAS float*)(L + foxa::CUM_OFF);
        MLAS float* wtot = (MLAS float*)(L + foxa::CUM_OFF + 8192);
        const float bias = bfp[h];
        const int s0 = 4 * tid;
        float v[4]; float run = 0.f;
#pragma unroll
        for (int i = 0; i < 4; ++i) {
            float x = 0.f;
            if (s0 + i < nk) x = F[(rowb + s0 + i) * 8 + h] + bias;
            const float ls = (s0 + i < nk) ? (fminf(x, 0.f) - log1pf(expf(-fabsf(x)))) : 0.f;
            run += ls; v[i] = run;
        }
        float inc = run;
#pragma unroll
        for (int o = 1; o < 64; o <<= 1) { const int ln = lane_opaque(); const float t = __builtin_bit_cast(float, __builtin_amdgcn_ds_bpermute((ln - o) << 2, __builtin_bit_cast(int, inc))); if (ln >= o) inc += t; }
        if (lane == 63) wtot[wid] = inc;
        LGKM_BAR();
        float off = inc - run;
        for (int w = 0; w < wid; ++w) off += wtot[w];
#pragma unroll
        for (int i = 0; i < 4; ++i) cum2[s0 + i] = (off + v[i]) * 1.4426950408889634f;
        LGKM_BAR();
    };
    foxa::attn_unit<8, 0, 2560>(cumfn, b, h, qb, 0, 0, (const foxa::bf16*)Z1, (const foxa::bf16*)(Z1 + 512), (const foxa::bf16*)(Z1 + 1024), (foxa::bf16*)Y, shm, nullptr, wave_s);
}
__device__ __forceinline__ void dsa_unit(int b, int qg, const bf16_t* Z0, bf16_t* Y, char* shm, unsigned lds0, const int wave_s) {
    for (int rep_ = 0; rep_ < DBG_REP_SEL; ++rep_) dsa_select(b, qg, Z0, shm, wave_s);
    const int nt64 = (qg >> 1) + 1; int ntu = (nt64 + 1) & ~1; if (ntu < 4) ntu = 4;
    foxa::attn_unit<8, 1, EV_N>([]() {}, b, 0, 0, 32 * qg, ntu, (const foxa::bf16*)(Z0 + 512), (const foxa::bf16*)(Z0 + 1024), (const foxa::bf16*)(Z0 + 1088), (foxa::bf16*)(Y + 512), shm,
                                (const MLAS unsigned*)((MLAS char*)shm + LX_SEL), wave_s);
}
}
constexpr int NWAVES = 8;
constexpr size_t KiB = 1024, MiB = 1u << 20;
constexpr size_t WS_CTL = 0, CTL_ZERO_BYTES = 1 * MiB;
constexpr size_t WS_W_EVIN = 1 * MiB, WS_W_OUT0 = 4 * MiB, WS_W_FFI0 = 6 * MiB, WS_W_FFO0 = 17 * MiB, WS_W_PG0 = 22 * MiB + 512 * KiB, WS_W_PP0 = 24 * MiB + 512 * KiB;
constexpr size_t WS_W_ODIN = 25 * MiB, WS_W_OUT1 = 30 * MiB + 512 * KiB, WS_W_FFI1 = 32 * MiB + 512 * KiB, WS_W_FFO1 = 43 * MiB + 512 * KiB, WS_W_PG1 = 49 * MiB, WS_W_PP1 = 51 * MiB, WS_W_SGU = 51 * MiB + 512 * KiB;
constexpr size_t WS_RSTD = 57 * MiB + 768 * KiB;
constexpr size_t WS_SSQA = 52 * MiB, WS_SSQB = 53 * MiB, WS_ROPE = 54 * MiB, WS_AH = 55 * MiB, WS_FBUF = 58 * MiB + 512 * KiB, WS_SST = 59 * MiB;
constexpr size_t WS_HB = 60 * MiB, WS_AHALO = 92 * MiB, WS_PP = 92 * MiB + 512 * KiB, WS_Y = 124 * MiB + 512 * KiB, WS_ZH = 156 * MiB + 512 * KiB, WS_PB = 244 * MiB + 512 * KiB, WS_END = 252 * MiB + 512 * KiB;
static_assert(WS_AHALO == WS_HB + (size_t)TOK * 1024 * 2, "the halo rows are row tile 64 of the FFN in-projection A operand");
static_assert(WS_W_EVIN + (size_t)EV_N * 1024 * 2 <= WS_W_OUT0 && WS_W_FFI0 + (size_t)NFF2 * 1024 * 2 <= WS_W_FFO0 && WS_W_FFO0 + (size_t)1024 * DFF * 2 <= WS_W_PG0, "ws map 1");
static_assert(WS_W_ODIN + (size_t)OD_N * 1024 * 2 <= WS_W_OUT1 && WS_W_FFI1 + (size_t)NFF2 * 1024 * 2 <= WS_W_FFO1 && WS_W_FFO1 + (size_t)1024 * DFF * 2 <= WS_W_PG1 && WS_W_SGU + 4 * 128 * 128 * 2 <= WS_SSQA, "ws map 2");
static_assert(WS_AH + (size_t)128 * NFF2 * 4 <= WS_RSTD && WS_ZH + (size_t)TOK * DFF * 2 <= WS_PB && WS_PB + (size_t)TOK * PLE * 2 <= WS_END, "ws map 3");
constexpr int CW_BAR = 4096, CW_FLAG = 8192, CW_PAN = 16384;
constexpr int RING_BYTES = 131072, XB_OFF = RING_BYTES, LDSCTL_OFF = XB_OFF + 8192 + 1024 + 64, MISC_OFF = LDSCTL_OFF + 320, LDS_BYTES = 147456;
static_assert(MISC_OFF + 128 <= LDS_BYTES, "LDS map");

#define GAS __attribute__((address_space(1)))
#define LAS __attribute__((address_space(3)))
typedef unsigned short bf16;
typedef unsigned v4u __attribute__((ext_vector_type(4)));
typedef float f32x4 __attribute__((ext_vector_type(4)));
typedef float f32x2 __attribute__((ext_vector_type(2)));
#define LDS_WAIT() asm volatile("s_waitcnt lgkmcnt(0)" ::: "memory")
#define VM_WAIT() asm volatile("s_waitcnt vmcnt(0)" ::: "memory")
__device__ __forceinline__ unsigned f2bf(float f) { unsigned u = __builtin_bit_cast(unsigned, f); return (u + 0x7fffu + ((u >> 16) & 1u)) >> 16; }
__device__ __forceinline__ unsigned pk2(float lo, float hi) { return f2bf(lo) | (f2bf(hi) << 16); }

#define XB_TMO      128
#define XB_XCNT(j)  (256  + 64 * (j))
#define XB_XSUB(j)  (1280 + 64 * (j))
#define XB_XGEN(j)  (2304 + 64 * (j))
#define XB_TOP      3328
#define XB_TOPGEN   3392
#define XCD_BAR_WORDS 3456
#define XB_SPIN_CAP (1u << 18)
__device__ __forceinline__ unsigned xb_ld(unsigned* p)              { return __hip_atomic_load(p, __ATOMIC_RELAXED, __HIP_MEMORY_SCOPE_AGENT); }
__device__ __forceinline__ unsigned xb_add(unsigned* p, unsigned v) { return __hip_atomic_fetch_add(p, v, __ATOMIC_RELAXED, __HIP_MEMORY_SCOPE_AGENT); }
__device__ __forceinline__ unsigned xb_xcc_id() { return (unsigned)__builtin_amdgcn_s_getreg((3 << 11) | 20) & 0xFu; }
#define XB_SPIN(cond, bar) do { unsigned _sp = 0; while (cond) { __builtin_amdgcn_s_sleep(1); \
    if ((++_sp & 255u) == 0u) { if (xb_ld(&(bar)[XB_TMO])) break; if (_sp > XB_SPIN_CAP) { atomicAdd(&(bar)[XB_TMO], 1u); break; } } } } while (0)
struct XcdBarrier { unsigned* bar; unsigned x; volatile LAS unsigned* st; };
__device__ __forceinline__ XcdBarrier xcd_barrier_post(unsigned* bar, volatile LAS unsigned* st) {
    XcdBarrier b; b.bar = bar; b.x = xb_xcc_id(); b.st = st;
    if (threadIdx.x == 0) (void)xb_add(&bar[XB_XCNT(b.x)], 1u);
    return b;
}
__device__ __forceinline__ void xcd_barrier_complete(unsigned* bar, unsigned x, unsigned& nloc, unsigned& nx) {
    const unsigned G = gridDim.x * gridDim.y * gridDim.z;
    unsigned sum, cnt, mine, sp = 0u;
    for (;;) {
        sum = 0u; cnt = 0u; mine = 0u;
#pragma unroll 1
        for (unsigned j = 0; j < 16; ++j) { const unsigned c = xb_ld(&bar[XB_XCNT(j)]); sum += c; cnt += (c > 0u) ? 1u : 0u; mine = (j == x) ? c : mine; }
        if (sum == G) break;
        __builtin_amdgcn_s_sleep(1);
        if ((++sp & 255u) == 0u) { if (xb_ld(&bar[XB_TMO])) break; if (sp > XB_SPIN_CAP) { atomicAdd(&bar[XB_TMO], 1u); break; } }
    }
    nloc = mine > 0u ? mine : 1u; nx = cnt > 0u ? cnt : 1u;
}
__device__ __forceinline__ void xcd_barrier(const XcdBarrier& b) {
    asm volatile("s_waitcnt vmcnt(0)" ::: "memory");
    __syncthreads();
    if (threadIdx.x == 0) {
        unsigned* bar = b.bar;
        __builtin_amdgcn_s_waitcnt(0);
        unsigned nloc = b.st[0], nx = b.st[1];
        if (nloc == 0u) { xcd_barrier_complete(bar, b.x, nloc, nx); b.st[0] = nloc; b.st[1] = nx; }
        const unsigned old = xb_add(&bar[XB_XSUB(b.x)], 1u);
        const unsigned gen = old / nloc;
        if (old + 1u == (gen + 1u) * nloc) {
            __builtin_amdgcn_fence(__ATOMIC_RELEASE, "agent");
            asm volatile("s_waitcnt vmcnt(0)" ::: "memory");
            __builtin_amdgcn_fence(__ATOMIC_ACQUIRE, "agent");
            const unsigned og = xb_add(&bar[XB_TOP], 1u);
            const unsigned tg = og / nx;
            if (og + 1u == (tg + 1u) * nx) xb_add(&bar[XB_TOPGEN], 1u);
            else XB_SPIN(xb_ld(&bar[XB_TOPGEN]) == tg, bar);
            asm volatile("s_waitcnt vmcnt(0)" ::: "memory");
            xb_add(&bar[XB_XGEN(b.x)], 1u);
            asm volatile("s_waitcnt vmcnt(0)" ::: "memory");
        } else {
            __builtin_amdgcn_fence(__ATOMIC_ACQUIRE, "agent");
            XB_SPIN(xb_ld(&bar[XB_XGEN(b.x)]) == gen, bar);
            asm volatile("s_waitcnt vmcnt(0)" ::: "memory");
        }
    }
    __syncthreads();
}

__device__ __forceinline__ float wave_sum(float v) {
#pragma unroll
    for (int o = 1; o < 64; o <<= 1) v += __builtin_bit_cast(float, __builtin_amdgcn_ds_bpermute((lane_opaque() ^ o) << 2, __builtin_bit_cast(int, v)));
    return v;
}
__device__ __forceinline__ int vcu_of(int i, int n) { return i; }
__device__ __forceinline__ int unperm16(int d) { return d < 16 ? ((d >> 1) + 8 * (d & 1)) : d; }
__device__ __forceinline__ int map_col(int type, int n, int nold) {
    if (type == 0) return n < nold ? n : -1;
    if (type == 1) {
        if (n < 512) return n;
        if (n < 1024) { const int h = (n - 512) >> 6, d = (n - 512) & 63; return 512 + 64 * h + unperm16(d); }
        if (n < 1088) return 1024 + unperm16(n - 1024);
        if (n < 1152) return n;
        if (n < 1216) return 1408 + unperm16(n - 1152);
        if (n < 1220) return 1472 + (n - 1216);
        if (n < 1280) return -1;
        { const int h = (n - 1280) >> 6, d = (n - 1280) & 63; return 1152 + 64 * h + unperm16(d); }
    }
    if (type == 2) {
        if (n < 1536) return n;
        if (n < 2560) return n + 8;
        if (n < 2568) return 1536 + (n - 2560);
        return -1;
    }
    { const int pn = n >> 8, bj = (n >> 7) & 1, jj = n & 127; return bj * DFF + 128 * pn + jj; }
}
struct TJob { const float* W; const float* rowscale; bf16* WT; int K, Nold, Nnew, ldk, koff, type, nitems; };
__device__ __forceinline__ void transpose_item(const TJob& J, LAS float* scr, int item, int lane) {
    const int nblk = J.Nnew / 32, kb = item / nblk, nb = item % nblk, k0 = 64 * kb, n0 = 32 * nb;
    const int oc = map_col(J.type, n0 + (lane & 31), J.Nold);
    const int occ = oc >= 0 ? oc : 0;
    float vv[32];
#pragma unroll
    for (int i = 0; i < 32; ++i) vv[i] = J.W[(size_t)(k0 + 2 * i + (lane >> 5)) * J.Nold + occ];
#pragma unroll
    for (int i = 0; i < 32; ++i) { const int kk = 2 * i + (lane >> 5);
        float v = (oc >= 0) ? vv[i] : 0.f;
        if (J.rowscale) v *= J.rowscale[k0 + kk];
        scr[kk * 33 + (lane & 31)] = v; }
    LDS_WAIT(); asm volatile("" ::: "memory");
    const int c = lane & 7;
#pragma unroll
    for (int j = 0; j < 4; ++j) { const int n = (lane >> 3) + 8 * j; const LAS float* s = scr + (8 * c) * 33 + n;
        v4u o; o.x = pk2(s[0 * 33], s[1 * 33]); o.y = pk2(s[2 * 33], s[3 * 33]); o.z = pk2(s[4 * 33], s[5 * 33]); o.w = pk2(s[6 * 33], s[7 * 33]);
        *(GAS v4u*)(J.WT + (size_t)(n0 + n) * J.ldk + J.koff + k0 + 8 * c) = o; }
    LDS_WAIT(); asm volatile("" ::: "memory");
}
__device__ __forceinline__ void sincos_d(double a, float& sn, float& cs) {
    const double q = rint(a * 0.63661977236758134308);
    double r = a - q * 1.57079632673412561417e+00; r -= q * 6.07710050650619224932e-11;
    const double r2 = r * r;
    double s = 1.0 / 6227020800.0; s = s * r2 - 1.0 / 39916800.0; s = s * r2 + 1.0 / 362880.0; s = s * r2 - 1.0 / 5040.0; s = s * r2 + 1.0 / 120.0; s = s * r2 - 1.0 / 6.0; s = s * r2 * r + r;
    double c = -1.0 / 87178291200.0; c = c * r2 + 1.0 / 479001600.0; c = c * r2 - 1.0 / 3628800.0; c = c * r2 + 1.0 / 40320.0; c = c * r2 - 1.0 / 720.0; c = c * r2 + 1.0 / 24.0; c = c * r2 - 0.5; c = c * r2 + 1.0;
    const int qi = ((int)q) & 3;
    const double ss = (qi == 0) ? s : (qi == 1) ? c : (qi == 2) ? -s : -c;
    const double cc = (qi == 0) ? c : (qi == 1) ? -s : (qi == 2) ? -c : s;
    sn = (float)ss; cs = (float)cc;
}

struct Args { const void* in[24]; float* out; unsigned char* ws; int ph_lo, ph_hi; };
typedef const Args __attribute__((address_space(4)))* argp_t;
__device__ __forceinline__ argp_t get_args() { argp_t p = (argp_t)__builtin_amdgcn_kernarg_segment_ptr(); asm volatile("" : "+s"(p)); return p; }
__device__ __forceinline__ int otid(int wave_s) { return wave_s * 64 + lane_opaque(); }
#define IN_F(k) ((const float*)A_->in[k])
#define PH_LOCALS \
    argp_t A_ = get_args(); unsigned char* const ws = A_->ws; float* const out = A_->out; (void)out; \
    const int tid = otid(wave_s), lane = tid & 63, wave = wave_s; (void)lane; (void)wave; \
    const int G = gridDim.x, bx = blockIdx.x, vcu = (G % 8 == 0) ? (bx % 8) * (G / 8) + bx / 8 : bx; (void)vcu; \
    const int gw = vcu * NWAVES + wave, NGW = G * NWAVES, gt = vcu * (NWAVES * 64) + tid, NGT = G * NWAVES * 64; (void)gw; (void)NGW; (void)gt; (void)NGT; \
    LAS unsigned char* const L = (LAS unsigned char*)lds; (void)L;
#define WSP(T, off) ((T*)(ws + (off)))

__global__ void __launch_bounds__(NWAVES * 64, 2) mega_fwd(Args args) {
    extern __shared__ __attribute__((aligned(16))) unsigned char lds[];
    int lo, hi; XcdBarrier bar;
    const int wave_s = __builtin_amdgcn_readfirstlane((int)threadIdx.x >> 6);
    {
        PH_LOCALS
        volatile LAS unsigned* MISC = (volatile LAS unsigned*)(L + MISC_OFF);
        for (int u = tid; u < (LDS_BYTES - XB_OFF) / 4; u += NWAVES * 64) ((LAS unsigned*)(L + XB_OFF))[u] = 0u;
        __syncthreads();
        bar = xcd_barrier_post((unsigned*)(ws + WS_CTL) + CW_BAR, MISC + 8);
        lo = A_->ph_lo; hi = A_->ph_hi;
    }
#ifndef DBG_REP_TR
#define DBG_REP_TR 1
#endif
#ifndef DBG_REP_HB
#define DBG_REP_HB 1
#endif
#ifndef DBG_REP_FOX
#define DBG_REP_FOX 1
#endif
#ifndef DBG_REP_DSA
#define DBG_REP_DSA 1
#endif
#ifndef DBG_REP_SGU
#define DBG_REP_SGU 1
#endif
#ifndef DBG_REP_POOL
#define DBG_REP_POOL 1
#endif
#ifndef PHMASK
#define PHMASK 0xff7fffu
#endif
#define IN(k) (((PHMASK >> (k)) & 1u) && lo <= (k) && (k) < hi)
#define SEAM(k) do { if (IN(k) && IN((k) + 1)) xcd_barrier(bar); } while (0)
    if (IN(0)) {
        PH_LOCALS
        LAS float* scr = (LAS float*)(L + wave * 16384);
        const float* norm_mix = IN_F(3); const float* norm_ffn = IN_F(4); const float* norm_ple = IN_F(5);
        const float* ffn_w_in = IN_F(6); const float* ffn_w_out = IN_F(9); const float* ple_w_proj = IN_F(10); const float* ple_w_gate = IN_F(11);
        const float* ev_w_in = IN_F(13); const float* ev_w_out = IN_F(14); const float* od_w_in = IN_F(17); const float* od_w_out = IN_F(18);
#define TJ(Wp, RS, WTp, K_, NOLD, NNEW, LDK, KOFF, TYPE) { constexpr int NI_ = ((K_) / 64) * ((NNEW) / 32); if (r < NI_) { const TJob J{(Wp), (RS), (WTp), (K_), (NOLD), (NNEW), (LDK), (KOFF), (TYPE), NI_}; transpose_item(J, scr, r, lane); continue; } r -= NI_; }
        constexpr int NITEMS = 16 * 48 + 8 * 32 + 44 * 32 + 4 * 32;
        for (int rep_ = 0; rep_ < DBG_REP_TR; ++rep_) for (int it = gw; it < NITEMS; it += NGW) {
            int r = it;
            TJ(ev_w_in, norm_mix, WSP(bf16, WS_W_EVIN), 1024, 1476, EV_N, 1024, 0, 1)
            TJ(ev_w_out + (size_t)512 * 1024, nullptr, WSP(bf16, WS_W_OUT0), 512, 1024, 1024, 1024, 512, 0)
            TJ(ffn_w_out + (size_t)DFF * 1024, nullptr, WSP(bf16, WS_W_FFO1), DFF, 1024, 1024, DFF, 0, 0)
            TJ(ple_w_proj + (size_t)256 * 1024, nullptr, WSP(bf16, WS_W_PP1), 256, 1024, 1024, 256, 0, 0)
        }
#undef TJ
        { const float* sgu_w = IN_F(22); bf16* W_SGU = WSP(bf16, WS_W_SGU);
          for (int i = gt; i < 4 * 128 * 128; i += NGT) { const int jj = i & 127, ii = (i >> 7) & 127; W_SGU[i] = (bf16)((ii < 64 && jj >= 64) ? 0u : f2bf(sgu_w[i])); } }
        { const float* x = IN_F(0); bf16* HB = WSP(bf16, WS_HB); float* SSQA = WSP(float, WS_SSQA);
          for (int m = gw; m < TOK; m += 4 * NGW) {
            f32x4 v[4][4];
#pragma unroll
            for (int q = 0; q < 4; ++q) { const int mm = (m + q * NGW < TOK) ? m + q * NGW : m; const f32x4* xr = (const f32x4*)(x + (size_t)mm * DMODEL) + lane;
#pragma unroll
                for (int j = 0; j < 4; ++j) v[q][j] = xr[64 * j]; }
#pragma unroll
            for (int q = 0; q < 4; ++q) { const int mm = m + q * NGW; if (mm < TOK) {
                float s = 0.f; unsigned long long* o8 = (unsigned long long*)(HB + (size_t)mm * DMODEL) + lane;
#pragma unroll
                for (int j = 0; j < 4; ++j) { const f32x4 w = v[q][j]; s += (w.x * w.x + w.y * w.y) + (w.z * w.z + w.w * w.w);
                    o8[64 * j] = (unsigned long long)pk2(w.x, w.y) | ((unsigned long long)pk2(w.z, w.w) << 32); }
                s = wave_sum(s);
                if (lane < 16) SSQA[(size_t)mm * 16 + lane] = (lane == 0) ? s : 0.f; } }
          } }
        { const float* p_in = IN_F(1); bf16* PB = WSP(bf16, WS_PB);
          for (int i = gt; i < TOK * PLE / 4; i += 4 * NGT) { f32x4 v[4];
#pragma unroll
            for (int q = 0; q < 4; ++q) v[q] = ((const f32x4*)p_in)[(i + q * NGT < TOK * PLE / 4) ? i + q * NGT : i];
#pragma unroll
            for (int q = 0; q < 4; ++q) if (i + q * NGT < TOK * PLE / 4) ((unsigned long long*)PB)[i + q * NGT] = (unsigned long long)pk2(v[q].x, v[q].y) | ((unsigned long long)pk2(v[q].z, v[q].w) << 32); } }
        { const int* positions = (const int*)A_->in[2]; f32x2* ROPE = WSP(f32x2, WS_ROPE);
          for (int i = gt; i < TOK * 8; i += NGT) {
            const int row = i >> 3, j = i & 7;
            const float invf = (j == 0) ? 1.0f : (j == 1) ? 0.1939227432012558f : (j == 2) ? 0.03760603070259094f : (j == 3) ? 0.007292664609849453f : (j == 4) ? 0.0014142135623842478f :
                               (j == 5) ? 0.00027424818836152554f : (j == 6) ? 5.3182957344688475e-05f : 1.0313385246263351e-05f;
            const float ang = (float)positions[row] * invf;
            float sn, cs; sincos_d((double)ang, sn, cs);
            ROPE[i] = (f32x2){cs, sn};
          } }
    }
    SEAM(0);
    if (IN(1)) {
        { PH_LOCALS
          pg8::Gemm g{WSP(bf16, WS_HB), WSP(bf16, WS_W_EVIN), TOK, EV_N, 1024}; pg8::StaticOrder S; S.init(TOK, EV_N, G, bx);
          pg8::EpiEvenIn E{WSP(float, WS_SSQA), WSP(bf16, WS_ZH), WSP(const pg8::f32x2, WS_ROPE)};
          pg8::gemm_phase<pg8::EpiEvenIn, pg8::StaticOrder, true, true>(L, g, S, E, wave_s); }
        if (gridDim.x == 256 && blockIdx.x >= 128) {
            PH_LOCALS
            LAS float* scr = (LAS float*)(L + wave * 16384);
            const float* norm_mix = IN_F(3); const float* norm_ffn = IN_F(4); const float* norm_ple = IN_F(5);
            const float* ffn_w_in = IN_F(6); const float* ffn_w_out = IN_F(9); const float* ple_w_proj = IN_F(10); const float* ple_w_gate = IN_F(11);
            const float* od_w_in = IN_F(17); const float* od_w_out = IN_F(18);
#define TJ(Wp, RS, WTp, K_, NOLD, NNEW, LDK, KOFF, TYPE) { constexpr int NI_ = ((K_) / 64) * ((NNEW) / 32); if (r < NI_) { const TJob J{(Wp), (RS), (WTp), (K_), (NOLD), (NNEW), (LDK), (KOFF), (TYPE), NI_}; transpose_item(J, scr, r, lane); continue; } r -= NI_; }
            constexpr int NITEMS_B = (16 * 176 + 44 * 32 + 16 * 32 + 4 * 32) + 16 * 88 + 16 * 32;
            const int gwb = (vcu_of(bx - 128, 128)) * NWAVES + wave, NGWB = 128 * NWAVES;
            for (int it = gwb; it < NITEMS_B; it += NGWB) {
                int r = it;
                TJ(ffn_w_in, norm_ffn, WSP(bf16, WS_W_FFI0), 1024, NFF2, NFF2, 1024, 0, 3)
                TJ(ffn_w_out, nullptr, WSP(bf16, WS_W_FFO0), DFF, 1024, 1024, DFF, 0, 0)
                TJ(ple_w_gate, norm_ple, WSP(bf16, WS_W_PG0), 1024, 1024, 1024, 1024, 0, 0)
                TJ(ple_w_proj, nullptr, WSP(bf16, WS_W_PP0), 256, 1024, 1024, 256, 0, 0)
                TJ(od_w_in, norm_mix + 1024, WSP(bf16, WS_W_ODIN), 1024, 2568, OD_N, 1024, 0, 2)
                TJ(od_w_out, nullptr, WSP(bf16, WS_W_OUT1), 1024, 1024, 1024, 1024, 0, 0)
            }
#undef TJ
        {
            const float* pool_w = IN_F(15); const float* pool_scale = IN_F(16); const float* ev_w_out = IN_F(14); bf16* W_OUT0 = WSP(bf16, WS_W_OUT0);
            for (int it = gwb; it < 1024; it += NGWB) {
                const int g = it >> 8, nb = (it >> 4) & 15, cb = it & 15, n = 64 * nb + lane;
                float acc[8];
#pragma unroll
                for (int cc = 0; cc < 8; ++cc) acc[cc] = 0.f;
#pragma unroll 1
                for (int d0 = 0; d0 < 128; d0 += 16) {
                    float wv[16];
#pragma unroll
                    for (int e = 0; e < 16; ++e) wv[e] = ev_w_out[(size_t)(128 * g + d0 + e) * 1024 + n] * pool_scale[128 * g + d0 + e];
#pragma unroll
                    for (int cc = 0; cc < 8; ++cc) {
                        const float* pw = pool_w + ((size_t)g * 128 + 8 * cb + cc) * 128 + d0;
#pragma unroll
                        for (int e = 0; e < 16; ++e) acc[cc] += pw[e] * wv[e];
                    }
                }
#pragma unroll
                for (int c2 = 0; c2 < 4; ++c2) *(unsigned*)(W_OUT0 + (size_t)n * 1024 + 128 * g + 8 * cb + 2 * c2) = pk2(acc[2 * c2], acc[2 * c2 + 1]);
            }
        }
        }
    }
    SEAM(1);
    if (IN(2)) {
        { PH_LOCALS
          const bf16* ZH = WSP(bf16, WS_ZH); bf16* Y = WSP(bf16, WS_Y); const unsigned lds0 = (unsigned)(uintptr_t)lds;
          for (int pi = vcu; pi < 256; pi += G) {
            const int b = pi >> 5, s = pi & 31;
#pragma unroll 1
            for (int k = 0; k < 2 * DBG_REP_DSA; ++k) mix::dsa_unit(b, (k & 1) ? s : 63 - s, ZH, Y, (char*)lds, lds0, wave_s);
          } }
        { PH_LOCALS
          const bf16* ZH = WSP(bf16, WS_ZH); bf16* Y = WSP(bf16, WS_Y);
          for (int rep_ = 0; rep_ < DBG_REP_POOL; ++rep_) for (int it = gt; it < TOK * 64; it += NGT) mix::pool_item(it, ZH, Y);
        }
        { PH_LOCALS
          const float* p1 = IN_F(1) + (size_t)TOK * PLE; bf16* PB1 = (bf16*)out + (size_t)16 * 1024 * 1024;
          for (int i = gt; i < TOK * PLE / 4; i += 4 * NGT) { f32x4 v[4];
#pragma unroll
              for (int q = 0; q < 4; ++q) v[q] = ((const f32x4*)p1)[(i + q * NGT < TOK * PLE / 4) ? i + q * NGT : i];
#pragma unroll
              for (int q = 0; q < 4; ++q) if (i + q * NGT < TOK * PLE / 4) ((unsigned long long*)PB1)[i + q * NGT] = (unsigned long long)pk2(v[q].x, v[q].y) | ((unsigned long long)pk2(v[q].z, v[q].w) << 32); }
        }
    }
    SEAM(2);
    {
        const size_t s1o = (0 == 0) ? WS_SSQA : WS_SSQB, s2o = (0 == 0) ? WS_SSQB : WS_SSQA, s3o = s1o;
        if (IN(3)) {
            PH_LOCALS
            pg8::Gemm g{WSP(bf16, WS_Y), WSP(bf16, (0 == 0) ? WS_W_OUT0 : WS_W_OUT1), TOK, 1024, 1024}; pg8::StaticOrder S; S.init(TOK, 1024, G, bx);
            pg8::EpiRes E{nullptr, WSP(bf16, WS_HB), WSP(bf16, WS_HB), WSP(float, s1o), WSP(bf16, WS_AHALO)};
            pg8::gemm_phase<pg8::EpiRes, pg8::StaticOrder, true, true>(L, g, S, E, wave_s);
        }
        SEAM(3);
        if (IN(3 + 2)) {
            PH_LOCALS
            pg8::Gemm g{WSP(bf16, WS_HB), WSP(bf16, WS_W_FFI0), TOK + 256, NFF2, 1024}; pg8::StaticOrder S; S.init(TOK, NFF2, G, bx);
#ifdef STAGGER
            if (STAGGER_COND) { for (int i_ = 0; i_ < STAGGER; ++i_) __builtin_amdgcn_s_sleep(127); }
#endif
            if (G == 256 && bx >= 128 && bx < 128 + NFF2 / 256) {
                pg8::OneUnit S1{64, bx - 128, 1};
                pg8::EpiHaloF EH{WSP(float, s1o), WSP(float, WS_AH), (unsigned*)(ws + WS_CTL) + CW_FLAG + 2048 * 0};
                pg8::gemm_phase<pg8::EpiHaloF, pg8::OneUnit, true, true>(L, g, S1, EH, wave_s);
            }
#ifdef PP_FIRST
            if (G == 256 && bx >= 150) {
                pg8::Gemm gp{WSP(bf16, WS_PB), WSP(bf16, WS_W_PP0), TOK, 1024, PLE}; pg8::StaticOrder SP; SP.init(TOK, 1024, 106, bx - 150);
                pg8::EpiBf16Plain EP{WSP(bf16, WS_PP), 1024};
                pg8::gemm_phase<pg8::EpiBf16Plain, pg8::StaticOrder, true, true>(L, gp, SP, EP, wave_s);
            }
#endif
            pg8::EpiFfnIn E{WSP(float, s1o), IN_F(7) + (size_t)0 * 3 * NFF2, IN_F(8) + (size_t)0 * NFF2, WSP(float, WS_AH), WSP(bf16, WS_ZH), (LAS float*)(L + XB_OFF), (unsigned*)(ws + WS_CTL) + CW_FLAG + 2048 * 0, 1u};
            pg8::gemm_phase<pg8::EpiFfnIn, pg8::StaticOrder, true, true>(L, g, S, E, wave_s);
#ifndef PP_FIRST
            if (G == 256 && bx >= 150) {
                pg8::Gemm gp{WSP(bf16, WS_PB), WSP(bf16, WS_W_PP0), TOK, 1024, PLE}; pg8::StaticOrder SP; SP.init(TOK, 1024, 106, bx - 150);
                pg8::EpiBf16Plain EP{WSP(bf16, WS_PP), 1024};
                pg8::gemm_phase<pg8::EpiBf16Plain, pg8::StaticOrder, true, true>(L, gp, SP, EP, wave_s);
            }
#endif
        }
        SEAM(3 + 2);
        if (IN(3 + 3)) {
            PH_LOCALS
            pg8::Gemm g{WSP(bf16, WS_ZH), WSP(bf16, (0 == 0) ? WS_W_FFO0 : WS_W_FFO1), TOK, 1024, DFF}; pg8::StaticOrder S; S.init(TOK, 1024, G, bx);
            pg8::EpiRes E{nullptr, WSP(bf16, WS_HB), WSP(bf16, WS_HB), WSP(float, s2o), nullptr};
            pg8::gemm_phase<pg8::EpiRes, pg8::StaticOrder, true, true>(L, g, S, E, wave_s);
        }
        SEAM(3 + 3);
        if (IN(3 + 4)) {
            PH_LOCALS
            pg8::Gemm g{WSP(bf16, WS_HB), WSP(bf16, (0 == 0) ? WS_W_PG0 : WS_W_PG1), TOK, 1024, 1024}; pg8::StaticOrder S; S.init(TOK, 1024, G, bx);
            pg8::EpiGate E{WSP(float, s2o), WSP(bf16, WS_HB), WSP(bf16, WS_PP), (bf16*)out, WSP(float, s3o)};
            pg8::gemm_phase<pg8::EpiGate, pg8::StaticOrder, true, true>(L, g, S, E, wave_s);
        }
        SEAM(3 + 4);
    }
    {

            if (IN(8)) {
                { PH_LOCALS
                  pg8::Gemm g{(const bf16*)out, WSP(bf16, WS_W_ODIN), TOK, OD_N, 1024}; pg8::StaticOrder S; S.init(TOK, OD_N, G, bx);
                  pg8::EpiOddIn E{WSP(float, WS_SSQA), WSP(bf16, WS_ZH), WSP(float, WS_FBUF), WSP(float, WS_SST)};
                  pg8::gemm_phase<pg8::EpiOddIn, pg8::StaticOrder, true, true>(L, g, S, E, wave_s); }
                if (gridDim.x == 256 && blockIdx.x >= 192) {
                    PH_LOCALS
                    LAS float* scr = (LAS float*)(L + wave * 16384);
                    const float* norm_ffn = IN_F(4); const float* norm_ple = IN_F(5); const float* ffn_w_in = IN_F(6); const float* ple_w_gate = IN_F(11);
#define TJ(Wp, RS, WTp, K_, NOLD, NNEW, LDK, KOFF, TYPE) { constexpr int NI_ = ((K_) / 64) * ((NNEW) / 32); if (r < NI_) { const TJob J{(Wp), (RS), (WTp), (K_), (NOLD), (NNEW), (LDK), (KOFF), (TYPE), NI_}; transpose_item(J, scr, r, lane); continue; } r -= NI_; }
                    constexpr int NITEMS_C = 16 * 176 + 16 * 32;
                    const int gwc = (bx - 192) * NWAVES + wave, NGWC = 64 * NWAVES;
                    for (int it = gwc; it < NITEMS_C; it += NGWC) {
                        int r = it;
                        TJ(ffn_w_in + (size_t)1024 * NFF2, norm_ffn + 1024, WSP(bf16, WS_W_FFI1), 1024, NFF2, NFF2, 1024, 0, 3)
                        TJ(ple_w_gate + (size_t)1024 * 1024, norm_ple + 1024, WSP(bf16, WS_W_PG1), 1024, 1024, 1024, 1024, 0, 0)
                    }
#undef TJ
                }
            }
            SEAM(8);
            if (IN(9)) {
                { PH_LOCALS
                  const bf16* ZH = WSP(bf16, WS_ZH); bf16* Y = WSP(bf16, WS_Y); const unsigned lds0 = (unsigned)(uintptr_t)lds;
                  const float* FBUF = WSP(float, WS_FBUF); const float* fox_b_f = IN_F(19);
                  for (int pi = vcu; pi < 256; pi += G) {
                    const int bh = pi >> 2, s = pi & 3;
#pragma unroll 1
                    for (int k = 0; k < 2 * DBG_REP_FOX; ++k) mix::fox_unit2(bh >> 3, bh & 7, (k & 1) ? s : 7 - s, ZH, FBUF, fox_b_f, Y, (char*)lds, wave_s);
                  } }
                { PH_LOCALS
                  const bf16* ZH = WSP(bf16, WS_ZH); bf16* Y = WSP(bf16, WS_Y);
                  for (int rep_ = 0; rep_ < DBG_REP_SGU; ++rep_) for (int u = vcu; u < 512; u += G) mix::sgu_unit(u >> 6, (u >> 2) & 15, u & 3, ZH, WSP(float, WS_SST), IN_F(20), IN_F(21), WSP(bf16, WS_W_SGU), IN_F(23), Y, (char*)lds, wave_s); }
            }
            SEAM(9);
            }
    {
        const size_t s1o = (1 == 0) ? WS_SSQA : WS_SSQB, s2o = (1 == 0) ? WS_SSQB : WS_SSQA, s3o = s1o;
        if (IN(10)) {
            PH_LOCALS
            pg8::Gemm g{WSP(bf16, WS_Y), WSP(bf16, (1 == 0) ? WS_W_OUT0 : WS_W_OUT1), TOK, 1024, 1024}; pg8::StaticOrder S; S.init(TOK, 1024, G, bx);
            pg8::EpiRes E{nullptr, (const bf16*)out, WSP(bf16, WS_HB), WSP(float, s1o), WSP(bf16, WS_AHALO)};
            pg8::gemm_phase<pg8::EpiRes, pg8::StaticOrder, true, true>(L, g, S, E, wave_s);
        }
        SEAM(10);
        if (IN(10 + 2)) {
            PH_LOCALS
            pg8::Gemm g{WSP(bf16, WS_HB), WSP(bf16, WS_W_FFI1), TOK + 256, NFF2, 1024}; pg8::StaticOrder S; S.init(TOK, NFF2, G, bx);
#ifdef STAGGER
            if (STAGGER_COND) { for (int i_ = 0; i_ < STAGGER; ++i_) __builtin_amdgcn_s_sleep(127); }
#endif
            if (G == 256 && bx >= 128 && bx < 128 + NFF2 / 256) {
                pg8::OneUnit S1{64, bx - 128, 1};
                pg8::EpiHaloF EH{WSP(float, s1o), WSP(float, WS_AH), (unsigned*)(ws + WS_CTL) + CW_FLAG + 2048 * 1};
                pg8::gemm_phase<pg8::EpiHaloF, pg8::OneUnit, true, true>(L, g, S1, EH, wave_s);
            }
#ifdef PP_FIRST
            if (G == 256 && bx >= 150) {
                pg8::Gemm gp{(const bf16*)out + (size_t)16 * 1024 * 1024, WSP(bf16, WS_W_PP1), TOK, 1024, PLE}; pg8::StaticOrder SP; SP.init(TOK, 1024, 106, bx - 150);
                pg8::EpiBf16Plain EP{WSP(bf16, WS_PP), 1024};
                pg8::gemm_phase<pg8::EpiBf16Plain, pg8::StaticOrder, true, true>(L, gp, SP, EP, wave_s);
            }
#endif
            pg8::EpiFfnIn E{WSP(float, s1o), IN_F(7) + (size_t)1 * 3 * NFF2, IN_F(8) + (size_t)1 * NFF2, WSP(float, WS_AH), WSP(bf16, WS_ZH), (LAS float*)(L + XB_OFF), (unsigned*)(ws + WS_CTL) + CW_FLAG + 2048 * 1, 2u};
            pg8::gemm_phase<pg8::EpiFfnIn, pg8::StaticOrder, true, true>(L, g, S, E, wave_s);
#ifndef PP_FIRST
            if (G == 256 && bx >= 150) {
                pg8::Gemm gp{(const bf16*)out + (size_t)16 * 1024 * 1024, WSP(bf16, WS_W_PP1), TOK, 1024, PLE}; pg8::StaticOrder SP; SP.init(TOK, 1024, 106, bx - 150);
                pg8::EpiBf16Plain EP{WSP(bf16, WS_PP), 1024};
                pg8::gemm_phase<pg8::EpiBf16Plain, pg8::StaticOrder, true, true>(L, gp, SP, EP, wave_s);
            }
#endif
        }
        SEAM(10 + 2);
        if (IN(10 + 3)) {
            PH_LOCALS
            pg8::Gemm g{WSP(bf16, WS_ZH), WSP(bf16, (1 == 0) ? WS_W_FFO0 : WS_W_FFO1), TOK, 1024, DFF}; pg8::StaticOrder S; S.init(TOK, 1024, G, bx);
            pg8::EpiRes E{nullptr, WSP(bf16, WS_HB), WSP(bf16, WS_HB), WSP(float, s2o), nullptr};
            pg8::gemm_phase<pg8::EpiRes, pg8::StaticOrder, true, true>(L, g, S, E, wave_s);
        }
        SEAM(10 + 3);
        if (IN(10 + 4)) {
            PH_LOCALS
            pg8::Gemm g{WSP(bf16, WS_HB), WSP(bf16, (1 == 0) ? WS_W_PG0 : WS_W_PG1), TOK, 1024, 1024}; pg8::StaticOrder S; S.init(TOK, 1024, G, bx);
            pg8::EpiGateFinal E{WSP(float, s2o), WSP(bf16, WS_HB), WSP(bf16, WS_PP), WSP(float, s3o), (unsigned*)(ws + WS_CTL) + CW_PAN, IN_F(12), out, (LAS float*)(L + XB_OFF) + 2048};
            pg8::gemm_phase<pg8::EpiGateFinal, pg8::StaticOrder, true, true>(L, g, S, E, wave_s);
        }
        SEAM(10 + 4);
    }
    if (IN(15)) {
        PH_LOCALS
        const float* SSQB = WSP(float, WS_SSQB); const float* norm_final = IN_F(12); const bf16* H6 = WSP(bf16, WS_Y);
        for (int m = gw; m < TOK; m += 4 * NGW) {
            unsigned long long w[4][4]; float rs[4];
#pragma unroll
            for (int q = 0; q < 4; ++q) { const int mm = (m + q * NGW < TOK) ? m + q * NGW : m; rs[q] = pg8::row_rstd(SSQB, mm);
                const unsigned long long* hr = (const unsigned long long*)(H6 + (size_t)mm * DMODEL) + lane;
#pragma unroll
                for (int j = 0; j < 4; ++j) w[q][j] = hr[64 * j]; }
            const f32x4* gr = (const f32x4*)norm_final + lane;
            f32x4 gg[4];
#pragma unroll
            for (int j = 0; j < 4; ++j) gg[j] = gr[64 * j];
#pragma unroll
            for (int q = 0; q < 4; ++q) { const int mm = m + q * NGW; if (mm < TOK) { f32x4* xr = (f32x4*)(out + (size_t)mm * DMODEL) + lane;
#pragma unroll
                for (int j = 0; j < 4; ++j) { const unsigned long long ww = w[q][j];
                    const f32x4 v = {pg8::bf_lo((unsigned)ww), pg8::bf_hi((unsigned)ww), pg8::bf_lo((unsigned)(ww >> 32)), pg8::bf_hi((unsigned)(ww >> 32))};
                    __builtin_nontemporal_store(v * rs[q] * gg[j], xr + 64 * j); } } }
        }
    }
#undef IN
#undef SEAM
}

#ifndef MK_N_LAUNCHES
#define MK_N_LAUNCHES 1
#endif
constexpr int N_PHASES = 16;
extern "C" void kernel_launch(void* const* d_in, const int* in_sizes, int n_in, void* d_out, int out_size, void* d_ws, size_t ws_size, hipStream_t stream) {
    static int grid = 0;
    if (grid == 0) {
        if (n_in != 24 || out_size != TOK * DMODEL || ws_size < WS_END) { fprintf(stderr, "kernel_launch: unexpected shapes (n_in %d, out %d, ws %zu)\n", n_in, out_size, ws_size); grid = -1; return; }
        int dev = 0, cus = 0;
        if (hipGetDevice(&dev) != hipSuccess || hipDeviceGetAttribute(&cus, hipDeviceAttributeMultiprocessorCount, dev) != hipSuccess) { grid = -1; return; }
        if (hipFuncSetAttribute((const void*)mega_fwd, hipFuncAttributeMaxDynamicSharedMemorySize, LDS_BYTES) != hipSuccess) { fprintf(stderr, "kernel_launch: hipFuncSetAttribute failed\n"); grid = -1; return; }
        int per_cu = 0;
        if (hipOccupancyMaxActiveBlocksPerMultiprocessor(&per_cu, (const void*)mega_fwd, NWAVES * 64, LDS_BYTES) != hipSuccess || per_cu < 1) { fprintf(stderr, "kernel_launch: occupancy query says %d\n", per_cu); }
        (void)hipGetLastError();
        grid = cus;
    }
    if (grid < 0) return;
    (void)hipMemsetAsync((char*)d_ws + WS_CTL, 0, CTL_ZERO_BYTES, stream);
    Args a{};
    for (int i = 0; i < 24; ++i) a.in[i] = d_in[i];
    a.out = (float*)d_out; a.ws = (unsigned char*)d_ws;
#ifdef DBG_CHECK
    {
        using namespace dbg;
        auto LP = [&](int ph) { a.ph_lo = ph; a.ph_hi = ph + 1; hipLaunchKernelGGL(mega_fwd, dim3(grid), dim3(NWAVES * 64), LDS_BYTES, stream, a); };
        char* wsb = (char*)d_ws; float* ERR = (float*)(wsb + 512 * 1024); float* SNAP = (float*)(wsb + 600 * 1024); float* outp = (float*)d_out;
        const unsigned short* ZHp = (const unsigned short*)(wsb + WS_ZH); const unsigned short* Yp = (const unsigned short*)(wsb + WS_Y); const float* FB = (const float*)(wsb + WS_FBUF);
        const unsigned short* HBp = (const unsigned short*)(wsb + WS_HB); const unsigned short* H3p = (const unsigned short*)d_out;
        auto F = [&](int i) { return (const float*)d_in[i]; };
        const float* x = F(0);
        LP(0); LP(1);
        k_evenin<<<NS, 256, 0, stream>>>(x, F(3), F(13), (const int*)d_in[2], ZHp, ERR, 0);
        LP(2);
        k_pool<<<NS, 256, 0, stream>>>(ZHp, Yp, ERR, 1);
        k_dsa<<<NS, 256, 0, stream>>>(ZHp, Yp, ERR, 2);
        LP(3);
        k_outproj<<<NS, 256, 0, stream>>>(x, 0, SNAP, Yp, F(14), F(15), F(16), HBp, ERR, 3);
        for (int layer = 0; layer < 2; ++layer) {
            const int pb = layer ? 10 : 3, kb = layer ? 10 : 3;
            if (layer == 1) {
                LP(8);
                k_oddin<<<NS, 256, 0, stream>>>(H3p, F(3) + 1024, F(17), ZHp, FB, ERR, 7);
                LP(9);
                k_fox<<<NS, 256, 0, stream>>>(ZHp, FB, F(19), Yp, ERR, 8);
                k_sgu<<<NS, 256, 0, stream>>>(ZHp, F(20), F(21), F(22), F(23), Yp, ERR, 9);
                k_snap<<<NS, 256, 0, stream>>>(H3p, SNAP);
                LP(10);
                k_outproj<<<NS, 256, 0, stream>>>(nullptr, 1, SNAP, Yp, F(18), nullptr, nullptr, HBp, ERR, 10);
            }
            LP(pb + 1); LP(pb + 2);
            k_ffnin<<<NS, 256, 0, stream>>>(HBp, F(4) + 1024 * layer, F(6) + (size_t)layer * 1024 * NFF2, F(7) + (size_t)layer * 3 * NFF2, F(8) + (size_t)layer * NFF2, ZHp, ERR, kb + 1);
            k_snap<<<NS, 256, 0, stream>>>(HBp, SNAP);
            LP(pb + 3);
            k_ffnout<<<NS, 256, 0, stream>>>(SNAP, ZHp, F(9) + (size_t)layer * DFF * 1024, HBp, ERR, kb + 2);
            k_snap<<<NS, 256, 0, stream>>>(HBp, SNAP);
            LP(pb + 4);
            k_ple<<<NS, 256, 0, stream>>>(SNAP, F(1) + (size_t)layer * TOK * PLE, F(5) + 1024 * layer, F(10) + (size_t)layer * PLE * 1024, F(11) + (size_t)layer * 1024 * 1024, layer ? Yp : H3p, ERR, kb + 3);
        }
        k_snap<<<NS, 256, 0, stream>>>(Yp, SNAP);
        LP(15);
        k_final<<<NS, 256, 0, stream>>>(SNAP, F(12), outp, ERR, 14);
        t_dpp<<<1, 64, 0, stream>>>(ERR + 40);
        k_report<<<1024, 256, 0, stream>>>(ERR, 15, DBG_TOL, outp);
        return;
    }
#endif
    if (MK_N_LAUNCHES == 1) {
        a.ph_lo = 0; a.ph_hi = N_PHASES;
        hipLaunchKernelGGL(mega_fwd, dim3(grid), dim3(NWAVES * 64), LDS_BYTES, stream, a);
    } else {
#ifndef DBG_STOP
#define DBG_STOP N_PHASES
#endif
#ifndef DBG_DOUBLE
#define DBG_DOUBLE -1
#endif
        for (int ph = 0; ph < DBG_STOP; ++ph) { a.ph_lo = ph; a.ph_hi = ph + 1; const int reps = (ph == DBG_DOUBLE || (DBG_DOUBLE == 100 && (ph == 0 || ph == 1 || ph == 2 || ph == 4 || ph == 5 || ph == 8 || ph == 9 || ph == 11 || ph == 12))) ? 2 : 1;
            for (int r = 0; r < reps; ++r) hipLaunchKernelGGL(mega_fwd, dim3(grid), dim3(NWAVES * 64), LDS_BYTES, stream, a); }
    }
}
```

```cpp
#include <hip/hip_runtime.h>
#include <hip/hip_bf16.h>
#include <cstdio>
#include <cstdint>
#include <cmath>
constexpr int TOK = 16384, DMODEL = 1024, SEQ = 2048, NBATCH = 8;
constexpr int DFF = 2816, NFF2 = 5632, PLE = 256;
constexpr int EV_N = 1536;
constexpr int OD_N = 2816;
constexpr int Z1P = 2560;
constexpr float RMS_EPS = 1e-6f;
constexpr float C2 = 0.125f * 1.4426950408889634f;


__device__ __forceinline__ int lane_opaque() { unsigned z = 0u; asm volatile("" : "+v"(z)); return (int)__builtin_amdgcn_mbcnt_hi(~0u, __builtin_amdgcn_mbcnt_lo(~0u, z)); }
__device__ __forceinline__ float xor16_f(float v) { return __builtin_bit_cast(float, __builtin_amdgcn_ds_swizzle(__builtin_bit_cast(int, v), 0x401F)); }
__device__ __forceinline__ void halves_pair(unsigned v, unsigned& a, unsigned& b) { unsigned w = v; asm volatile("" : "+v"(w)); auto rr = __builtin_amdgcn_permlane32_swap(v, w, false, false); a = rr[0]; b = rr[1]; }
__device__ __forceinline__ float halves_sum_f(float v) { unsigned a, b; halves_pair(__builtin_bit_cast(unsigned, v), a, b); return __builtin_bit_cast(float, a) + __builtin_bit_cast(float, b); }
__device__ __forceinline__ float halves_max_f(float v) { unsigned a, b; halves_pair(__builtin_bit_cast(unsigned, v), a, b); return __builtin_fmaxf(__builtin_bit_cast(float, a), __builtin_bit_cast(float, b)); }
__device__ __forceinline__ unsigned halves_add_u(unsigned v) { unsigned a, b; halves_pair(v, a, b); return a + b; }
__device__ __forceinline__ unsigned halves_or_u(unsigned v) { unsigned a, b; halves_pair(v, a, b); return a | b; }
namespace pg8 {
#define PG8_LAS __attribute__((address_space(3)))
typedef unsigned short bf16_t;
typedef short bf16x8 __attribute__((ext_vector_type(8)));
typedef float f32x4 __attribute__((ext_vector_type(4)));
typedef unsigned u32x4 __attribute__((ext_vector_type(4)));
constexpr int BM = 256, BK = 64, HALF = 128, HTB = HALF * BK * 2  , STAGE_BYTES = 8 * HTB, NXCD = 8, WGM = 8;

__host__ __device__ __forceinline__ int lds_byte(int r, int c) { const int st = (r >> 4) * 2 + (c >> 5), rr = r & 15, cc = c & 31, ob = rr * 64 + cc * 2; return st * 1024 + (ob ^ (((ob >> 9) & 1) << 5)); }
__host__ __device__ __forceinline__ void stage_rc(int b, int& R, int& C) { const int st = b / 1024, sb = b % 1024, swz = sb ^ (((sb >> 9) & 1) << 5); R = (st >> 1) * 16 + swz / 64; C = (st & 1) * 32 + (swz % 64) / 2; }
__host__ __device__ __forceinline__ int perm32(int rho) { const int n = rho >> 4, i = rho & 15; return 8 * (i >> 2) + 4 * n + (i & 3); }

struct Unit { int pm, pn; };
struct Gemm { const bf16_t* A; const bf16_t* Bt; int M, N, K; };

struct StaticOrder {
    int nM, nN, nwg, G, c;
    __host__ __device__ void init(int M, int N, int G_, int c_) { nM = M / BM; nN = N / BM; nwg = nM * nN; G = G_; c = c_; }
    __host__ __device__ bool next(int i, Unit& u) const {
        const long L = (long)i * G + c; if (L >= nwg) return false;
        int wgid = (int)L; { const int q = nwg / NXCD, r = nwg % NXCD, xcd = wgid % NXCD, off = wgid / NXCD; wgid = (xcd < r ? xcd * (q + 1) : r * (q + 1) + (xcd - r) * q) + off; }
        const int nig = WGM * nN, gid = wgid / nig, fm = gid * WGM, gsz = (nM - fm) < WGM ? (nM - fm) : WGM;
        u.pm = fm + ((wgid % nig) % gsz); u.pn = (wgid % nig) / gsz; return true;
    }
    __device__ __forceinline__ void a_ready(const Unit&) const {}
    __device__ __forceinline__ void done(const Unit&) const {}
};

struct OneUnit {
    int pm, pn, on;
    __host__ __device__ bool next(int i, Unit& u) const { if (!on || i != 0) return false; u.pm = pm; u.pn = pn; return true; }
    __device__ __forceinline__ void a_ready(const Unit&) const {}
    __device__ __forceinline__ void done(const Unit&) const {}
};
struct FfnOrder {
    StaticOrder S0; int extra;
    __host__ __device__ void init(int M, int N, int G_, int c_) { S0.init(M, N, G_, c_); extra = (G_ == 256 && c_ >= 128 && c_ < 128 + N / BM) ? 1 : 0; }
    __host__ __device__ bool next(int i, Unit& u) const { if (extra) { if (i == 0) { u.pm = 64; u.pn = S0.c - 128; return true; } return S0.next(i - 1, u); } return S0.next(i, u); }
    __device__ __forceinline__ void a_ready(const Unit&) const {}
    __device__ __forceinline__ void done(const Unit&) const {}
};
typedef float f32x2 __attribute__((ext_vector_type(2)));
typedef unsigned u32x2 __attribute__((ext_vector_type(2)));
__device__ __forceinline__ unsigned cvt_pk_bf16(float lo, float hi) { unsigned r; asm volatile("v_cvt_pk_bf16_f32 %0, %1, %2" : "=v"(r) : "v"(lo), "v"(hi)); return r; }
__device__ __forceinline__ float bf_lo(unsigned w) { return __builtin_bit_cast(float, w << 16); }
__device__ __forceinline__ float bf_hi(unsigned w) { return __builtin_bit_cast(float, w & 0xffff0000u); }
__device__ __forceinline__ float sq4(const f32x4 v) { return (v[0] * v[0] + v[1] * v[1]) + (v[2] * v[2] + v[3] * v[3]); }
__device__ __forceinline__ float row_rstd(const float* ssq, int row) {
    const f32x4* p = (const f32x4*)(ssq + (size_t)row * 16);
    const f32x4 a = p[0], b = p[1], c = p[2], d = p[3];
    const float s = (((a[0] + a[1]) + (a[2] + a[3])) + ((b[0] + b[1]) + (b[2] + b[3]))) + (((c[0] + c[1]) + (c[2] + c[3])) + ((d[0] + d[1]) + (d[2] + d[3])));
    return 1.0f / sqrtf(s * (1.0f / 1024.0f) + RMS_EPS);
}
__device__ __forceinline__ float row_rstd_coh(const float* ssq, int row) {
    const float* p = ssq + (size_t)row * 16;
    f32x4 a, b, c, d;
    asm volatile("global_load_dwordx4 %0, %4, off sc1\n\tglobal_load_dwordx4 %1, %4, off offset:16 sc1\n\tglobal_load_dwordx4 %2, %4, off offset:32 sc1\n\tglobal_load_dwordx4 %3, %4, off offset:48 sc1\n\ts_waitcnt vmcnt(0)"
                 : "=&v"(a), "=&v"(b), "=&v"(c), "=&v"(d) : "v"(p) : "memory");
    const float s = (((a[0] + a[1]) + (a[2] + a[3])) + ((b[0] + b[1]) + (b[2] + b[3]))) + (((c[0] + c[1]) + (c[2] + c[3])) + ((d[0] + d[1]) + (d[2] + d[3])));
    return 1.0f / sqrtf(s * (1.0f / 1024.0f) + RMS_EPS);
}
__device__ __forceinline__ void ssq_write(float* ssq_out, float q, int row, int slot, int fq) {
    q += xor16_f(q); q = halves_sum_f(q);
    if (fq == 0) ssq_out[(size_t)row * 16 + slot] = q;
}
typedef float f32x2 __attribute__((ext_vector_type(2)));
__device__ __forceinline__ f32x2 gelu_mul2(const f32x2 x, const f32x2 c) {
    const f32x2 x2 = x * x;
    const f32x2 a = x * (x2 * (-2.3022082f * 0.044715f) + (-2.3022082f));
    f32x2 e; e.x = __builtin_amdgcn_exp2f(a.x); e.y = __builtin_amdgcn_exp2f(a.y);
    const f32x2 d = e + 1.0f;
    f32x2 r; r.x = __builtin_amdgcn_rcpf(d.x); r.y = __builtin_amdgcn_rcpf(d.y);
    return (x * c) * r;
}
__device__ __forceinline__ float gelu_tanh(float x) {
    const float t = x + 0.044715f * x * x * x;
    const float e = __builtin_amdgcn_exp2f(-2.3022082f * t);
    return x * __builtin_amdgcn_rcpf(1.0f + e);
}
__device__ __forceinline__ float sigmoid_f(float x) { return __builtin_amdgcn_rcpf(1.0f + __builtin_amdgcn_exp2f(-1.4426950408889634f * x)); }


struct EpiRes {
    static constexpr bool PERM = true, AFTER_DRAIN = false;
    const float* basef; const bf16_t* baseb; bf16_t* hb; float* ssq_out; bf16_t* ahalo;
    __device__ __forceinline__ void operator()(const f32x4 (&acc)[2][2][4][2], const Unit& u_, int wr, int wc, int fr, int fq) const {
        Unit u; { int pm_ = u_.pm, pn_ = u_.pn; asm volatile("" : "+s"(pm_), "+s"(pn_)); u.pm = pm_; u.pn = pn_; }
        const int row0 = u.pm * BM + wr * 64 + fr, col0 = u.pn * BM + wc * 32 + 8 * fq;
        if (basef != nullptr) {
#pragma unroll
            for (int ai = 0; ai < 2; ++ai)
#pragma unroll
                for (int m = 0; m < 4; ++m) {
                    const int row = row0 + ai * HALF + m * 16; float q = 0.f;
#pragma unroll
                    for (int bj = 0; bj < 2; ++bj) {
                        const size_t off = (size_t)row * DMODEL + col0 + bj * HALF;
                        const f32x4 b0 = *(const f32x4*)(basef + off), b1 = *(const f32x4*)(basef + off + 4);
                        const f32x4 v0 = acc[ai][bj][m][0] + b0, v1 = acc[ai][bj][m][1] + b1;
                        q += sq4(v0) + sq4(v1);
                        u32x4 w; w.x = cvt_pk_bf16(v0[0], v0[1]); w.y = cvt_pk_bf16(v0[2], v0[3]); w.z = cvt_pk_bf16(v1[0], v1[1]); w.w = cvt_pk_bf16(v1[2], v1[3]);
                        *(u32x4*)(hb + off) = w;
                        if (ahalo != nullptr && ai == 1 && m == 3) {
                            const int rl = row & 255;
                            if (rl >= 254 && u.pm < 63) *(u32x4*)(ahalo + (size_t)(2 * (u.pm + 1) + (rl - 254)) * DMODEL + col0 + bj * HALF) = w;
                        }
                    }
                    ssq_write(ssq_out, q, row, u.pn * 4 + wc, fq);
                    if (m & 1) asm volatile("" ::: "memory");
                }
        } else {
#pragma unroll
            for (int ai = 0; ai < 2; ++ai) {
                u32x4 bw[4][2];
#pragma unroll
                for (int m = 0; m < 4; ++m)
#pragma unroll
                    for (int bj = 0; bj < 2; ++bj) bw[m][bj] = *(const u32x4*)(baseb + (size_t)(row0 + ai * HALF + m * 16) * DMODEL + col0 + bj * HALF);
                asm volatile("" ::: "memory");
#pragma unroll
                for (int m = 0; m < 4; ++m) {
                    const int row = row0 + ai * HALF + m * 16; float q = 0.f;
#pragma unroll
                    for (int bj = 0; bj < 2; ++bj) {
                        const size_t off = (size_t)row * DMODEL + col0 + bj * HALF;
                        const u32x4 pw = bw[m][bj];
                        const f32x4 b0 = {bf_lo(pw.x), bf_hi(pw.x), bf_lo(pw.y), bf_hi(pw.y)}, b1 = {bf_lo(pw.z), bf_hi(pw.z), bf_lo(pw.w), bf_hi(pw.w)};
                        const f32x4 v0 = acc[ai][bj][m][0] + b0, v1 = acc[ai][bj][m][1] + b1;
                        q += sq4(v0) + sq4(v1);
                        u32x4 w; w.x = cvt_pk_bf16(v0[0], v0[1]); w.y = cvt_pk_bf16(v0[2], v0[3]); w.z = cvt_pk_bf16(v1[0], v1[1]); w.w = cvt_pk_bf16(v1[2], v1[3]);
                        *(u32x4*)(hb + off) = w;
                        if (ahalo != nullptr && ai == 1 && m == 3) {
                            const int rl = row & 255;
                            if (rl >= 254 && u.pm < 63) *(u32x4*)(ahalo + (size_t)(2 * (u.pm + 1) + (rl - 254)) * DMODEL + col0 + bj * HALF) = w;
                        }
                    }
                    ssq_write(ssq_out, q, row, u.pn * 4 + wc, fq);
                }
                asm volatile("" ::: "memory");
            }
        }
    }
};
struct EpiGate {
    static constexpr bool PERM = true, AFTER_DRAIN = false;
    const float* ssq_in; const bf16_t* base; const bf16_t* pp; bf16_t* dst; float* ssq_out;
    __device__ __forceinline__ void operator()(const f32x4 (&acc)[2][2][4][2], const Unit& u_, int wr, int wc, int fr, int fq) const {
        Unit u; { int pm_ = u_.pm, pn_ = u_.pn; asm volatile("" : "+s"(pm_), "+s"(pn_)); u.pm = pm_; u.pn = pn_; }
        const int row0 = u.pm * BM + wr * 64 + fr, col0 = u.pn * BM + wc * 32 + 8 * fq;
#pragma unroll
        for (int ai = 0; ai < 2; ++ai)
#pragma unroll
            for (int mp = 0; mp < 2; ++mp) {
                u32x4 bw[2][2], pq[2][2]; float rs[2];
#pragma unroll
                for (int mi = 0; mi < 2; ++mi) {
                    const int row = row0 + ai * HALF + (2 * mp + mi) * 16;
#pragma unroll
                    for (int bj = 0; bj < 2; ++bj) { const size_t off = (size_t)row * DMODEL + col0 + bj * HALF; bw[mi][bj] = *(const u32x4*)(base + off); pq[mi][bj] = *(const u32x4*)(pp + off); }
                }
#pragma unroll
                for (int mi = 0; mi < 2; ++mi) rs[mi] = row_rstd(ssq_in, row0 + ai * HALF + (2 * mp + mi) * 16);
                asm volatile("" ::: "memory");
#pragma unroll
                for (int mi = 0; mi < 2; ++mi) {
                    const int m = 2 * mp + mi; const int row = row0 + ai * HALF + m * 16; float q = 0.f;
#pragma unroll
                    for (int bj = 0; bj < 2; ++bj) {
                        const size_t off = (size_t)row * DMODEL + col0 + bj * HALF;
                        const u32x4 b_ = bw[mi][bj], p_ = pq[mi][bj];
                        const float bb[8] = {bf_lo(b_.x), bf_hi(b_.x), bf_lo(b_.y), bf_hi(b_.y), bf_lo(b_.z), bf_hi(b_.z), bf_lo(b_.w), bf_hi(b_.w)};
                        const float pv[8] = {bf_lo(p_.x), bf_hi(p_.x), bf_lo(p_.y), bf_hi(p_.y), bf_lo(p_.z), bf_hi(p_.z), bf_lo(p_.w), bf_hi(p_.w)};
                        const f32x4 g0 = acc[ai][bj][m][0] * rs[mi], g1 = acc[ai][bj][m][1] * rs[mi];
                        const float gg[8] = {g0[0], g0[1], g0[2], g0[3], g1[0], g1[1], g1[2], g1[3]};
                        float v[8];
#pragma unroll
                        for (int i = 0; i < 8; ++i) { v[i] = bb[i] + pv[i] * sigmoid_f(gg[i]); q += v[i] * v[i]; }
                        u32x4 w; w.x = cvt_pk_bf16(v[0], v[1]); w.y = cvt_pk_bf16(v[2], v[3]); w.z = cvt_pk_bf16(v[4], v[5]); w.w = cvt_pk_bf16(v[6], v[7]);
                        *(u32x4*)(dst + off) = w;
                    }
                    ssq_write(ssq_out, q, row, u.pn * 4 + wc, fq);
                }
                asm volatile("" ::: "memory");
            }
    }
};
struct EpiGateFinal {
    static constexpr bool PERM = true, AFTER_DRAIN = false;
    const float* ssq_in; const bf16_t* base; const bf16_t* pp; float* ssq_out; unsigned* cnt; const float* gain; float* outp; PG8_LAS float* rtab;
    __device__ __forceinline__ void operator()(const f32x4 (&acc)[2][2][4][2], const Unit& u_, int wr, int wc, int fr, int fq) const {
        Unit u; { int pm_ = u_.pm, pn_ = u_.pn; asm volatile("" : "+s"(pm_), "+s"(pn_)); u.pm = pm_; u.pn = pn_; }
        const int row0 = u.pm * BM + wr * 64 + fr, col0 = u.pn * BM + wc * 32 + 8 * fq;
        f32x4 hv[2][2][4][2];
#pragma unroll
        for (int ai = 0; ai < 2; ++ai)
#pragma unroll
            for (int mp = 0; mp < 2; ++mp) {
                u32x4 bw[2][2], pq[2][2]; float rs[2];
#pragma unroll
                for (int mi = 0; mi < 2; ++mi) {
                    const int row = row0 + ai * HALF + (2 * mp + mi) * 16;
#pragma unroll
                    for (int bj = 0; bj < 2; ++bj) { const size_t off = (size_t)row * DMODEL + col0 + bj * HALF; bw[mi][bj] = *(const u32x4*)(base + off); pq[mi][bj] = *(const u32x4*)(pp + off); }
                }
#pragma unroll
                for (int mi = 0; mi < 2; ++mi) rs[mi] = row_rstd(ssq_in, row0 + ai * HALF + (2 * mp + mi) * 16);
                asm volatile("" ::: "memory");
#pragma unroll
                for (int mi = 0; mi < 2; ++mi) {
                    const int m = 2 * mp + mi; const int row = row0 + ai * HALF + m * 16; float q = 0.f;
#pragma unroll
                    for (int bj = 0; bj < 2; ++bj) {
                        const u32x4 b_ = bw[mi][bj], p_ = pq[mi][bj];
                        const float bb[8] = {bf_lo(b_.x), bf_hi(b_.x), bf_lo(b_.y), bf_hi(b_.y), bf_lo(b_.z), bf_hi(b_.z), bf_lo(b_.w), bf_hi(b_.w)};
                        const float pv[8] = {bf_lo(p_.x), bf_hi(p_.x), bf_lo(p_.y), bf_hi(p_.y), bf_lo(p_.z), bf_hi(p_.z), bf_lo(p_.w), bf_hi(p_.w)};
                        const f32x4 g0 = acc[ai][bj][m][0] * rs[mi], g1 = acc[ai][bj][m][1] * rs[mi];
                        const float gg[8] = {g0[0], g0[1], g0[2], g0[3], g1[0], g1[1], g1[2], g1[3]};
                        float v[8];
#pragma unroll
                        for (int i = 0; i < 8; ++i) { v[i] = bb[i] + pv[i] * sigmoid_f(gg[i]); q += v[i] * v[i]; }
                        hv[ai][bj][m][0] = (f32x4){v[0], v[1], v[2], v[3]}; hv[ai][bj][m][1] = (f32x4){v[4], v[5], v[6], v[7]};
                    }
                    ssq_write(ssq_out, q, row, u.pn * 4 + wc, fq);
                }
                asm volatile("" ::: "memory");
            }
        asm volatile("s_waitcnt vmcnt(0)" ::: "memory"); __builtin_amdgcn_s_barrier(); asm volatile("" ::: "memory");
        if (wr == 0 && wc == 0) {
            if (fr == 0 && fq == 0) {
                __builtin_amdgcn_fence(__ATOMIC_RELEASE, "agent");
                asm volatile("s_waitcnt vmcnt(0)" ::: "memory");
                __hip_atomic_fetch_add(cnt + 64 * u.pm, 1u, __ATOMIC_RELAXED, __HIP_MEMORY_SCOPE_AGENT);
            }
            unsigned sp = 0;
            while (__hip_atomic_load(cnt + 64 * u.pm, __ATOMIC_RELAXED, __HIP_MEMORY_SCOPE_AGENT) < 4u) { __builtin_amdgcn_s_sleep(2); if (++sp > (1u << 22)) break; }
        }
        asm volatile("" ::: "memory"); __builtin_amdgcn_s_barrier(); asm volatile("" ::: "memory");
        if (wr == 0) rtab[wc * 64 + fq * 16 + fr] = row_rstd_coh(ssq_out, u.pm * BM + wc * 64 + fq * 16 + fr);
        asm volatile("s_waitcnt lgkmcnt(0)" ::: "memory"); __builtin_amdgcn_s_barrier(); asm volatile("" ::: "memory");
        f32x4 gn[2][2];
#pragma unroll
        for (int bj = 0; bj < 2; ++bj)
#pragma unroll
            for (int n = 0; n < 2; ++n) gn[bj][n] = *(const f32x4*)(gain + col0 + bj * HALF + 4 * n);
#pragma unroll
        for (int ai = 0; ai < 2; ++ai)
#pragma unroll
            for (int m = 0; m < 4; ++m) {
                const float rsf = rtab[ai * HALF + wr * 64 + m * 16 + fr];
                float* orow = outp + (size_t)(row0 + ai * HALF + m * 16) * DMODEL + col0;
#pragma unroll
                for (int bj = 0; bj < 2; ++bj)
#pragma unroll
                    for (int n = 0; n < 2; ++n) *(f32x4*)(orow + bj * HALF + 4 * n) = hv[ai][bj][m][n] * rsf * gn[bj][n];
            }
    }
};
struct EpiBf16Plain {
    static constexpr bool PERM = true, AFTER_DRAIN = false;
    bf16_t* O; int ldc;
    __device__ __forceinline__ void operator()(const f32x4 (&acc)[2][2][4][2], const Unit& u_, int wr, int wc, int fr, int fq) const {
        Unit u; { int pm_ = u_.pm, pn_ = u_.pn; asm volatile("" : "+s"(pm_), "+s"(pn_)); u.pm = pm_; u.pn = pn_; }
        const int row0 = u.pm * BM + wr * 64 + fr, col0 = u.pn * BM + wc * 32 + 8 * fq;
#pragma unroll
        for (int ai = 0; ai < 2; ++ai)
#pragma unroll
            for (int m = 0; m < 4; ++m) {
                const int row = row0 + ai * HALF + m * 16;
#pragma unroll
                for (int bj = 0; bj < 2; ++bj) {
                    const f32x4 v0 = acc[ai][bj][m][0], v1 = acc[ai][bj][m][1];
                    u32x4 w; w.x = cvt_pk_bf16(v0[0], v0[1]); w.y = cvt_pk_bf16(v0[2], v0[3]); w.z = cvt_pk_bf16(v1[0], v1[1]); w.w = cvt_pk_bf16(v1[2], v1[3]);
                    *(u32x4*)(O + (size_t)row * ldc + col0 + bj * HALF) = w;
                }
            }
    }
};
struct EpiEvenIn {
    static constexpr bool PERM = true, AFTER_DRAIN = false;
    const float* ssq_in; bf16_t* Z; const f32x2* rope;
    __device__ __forceinline__ void operator()(const f32x4 (&acc)[2][2][4][2], const Unit& u_, int wr, int wc, int fr, int fq) const {
        Unit u; { int pm_ = u_.pm, pn_ = u_.pn; asm volatile("" : "+s"(pm_), "+s"(pn_)); u.pm = pm_; u.pn = pn_; }
        const int row0 = u.pm * BM + wr * 64 + fr, colw = wc * 32 + 8 * fq;
        const int pn = u.pn;
        const float sc = (pn == 2 || pn == 3) ? C2 : 1.0f;
#pragma unroll
        for (int ai = 0; ai < 2; ++ai)
#pragma unroll
            for (int m = 0; m < 4; ++m) {
                const int row = row0 + ai * HALF + m * 16;
                const float rs = row_rstd(ssq_in, row);
#pragma unroll
                for (int bj = 0; bj < 2; ++bj) {
                    const int gi = 2 * bj + (wc >> 1);
                    const bool ropeg = (pn == 2 || pn == 3 || pn == 5 || (pn == 4 && (gi == 0 || gi == 2))) && ((wc & 1) == 0);
                    f32x4 v0 = acc[ai][bj][m][0] * rs, v1 = acc[ai][bj][m][1] * rs;
                    if (ropeg && fq < 2) {
                        const f32x4* rp = (const f32x4*)(rope + (size_t)row * 8 + 4 * fq);
                        const f32x4 ra = rp[0], rb = rp[1];
                        f32x4 o0, o1;
                        o0[0] = v0[0] * ra[0] - v0[1] * ra[1]; o0[1] = v0[1] * ra[0] + v0[0] * ra[1];
                        o0[2] = v0[2] * ra[2] - v0[3] * ra[3]; o0[3] = v0[3] * ra[2] + v0[2] * ra[3];
                        o1[0] = v1[0] * rb[0] - v1[1] * rb[1]; o1[1] = v1[1] * rb[0] + v1[0] * rb[1];
                        o1[2] = v1[2] * rb[2] - v1[3] * rb[3]; o1[3] = v1[3] * rb[2] + v1[2] * rb[3];
                        v0 = o0; v1 = o1;
                    }
                    v0 = v0 * sc; v1 = v1 * sc;
                    u32x4 w; w.x = cvt_pk_bf16(v0[0], v0[1]); w.y = cvt_pk_bf16(v0[2], v0[3]); w.z = cvt_pk_bf16(v1[0], v1[1]); w.w = cvt_pk_bf16(v1[2], v1[3]);
                    *(u32x4*)(Z + (size_t)row * EV_N + pn * BM + bj * HALF + colw) = w;
                }
            }
    }
};
struct EpiOddIn {
    static constexpr bool PERM = true, AFTER_DRAIN = false;
    const float* ssq_in; bf16_t* Z; float* F; float* sst;
    __device__ __forceinline__ void operator()(const f32x4 (&acc)[2][2][4][2], const Unit& u_, int wr, int wc, int fr, int fq) const {
        Unit u; { int pm_ = u_.pm, pn_ = u_.pn; asm volatile("" : "+s"(pm_), "+s"(pn_)); u.pm = pm_; u.pn = pn_; }
        const int row0 = u.pm * BM + wr * 64 + fr, colw = wc * 32 + 8 * fq;
        const int pn = u.pn;
        const float sc = (pn < 2) ? C2 : 1.0f;
        const bool act = (pn >= 6 && pn < 10), stat = (pn == 8 || pn == 9);
#pragma unroll
        for (int ai = 0; ai < 2; ++ai)
#pragma unroll
            for (int m = 0; m < 4; ++m) {
                const int row = row0 + ai * HALF + m * 16;
                const float rs = row_rstd(ssq_in, row);
                if (pn == 10) {
                    if (wc == 0 && fq == 0) { *(f32x4*)(F + (size_t)row * 8) = acc[ai][0][m][0] * rs; *(f32x4*)(F + (size_t)row * 8 + 4) = acc[ai][0][m][1] * rs; }
                    continue;
                }
                float s1 = 0.f, s2 = 0.f;
#pragma unroll
                for (int bj = 0; bj < 2; ++bj) {
                    f32x4 v0 = acc[ai][bj][m][0] * (rs * sc), v1 = acc[ai][bj][m][1] * (rs * sc);
                    if (act) {
#pragma unroll
                        for (int i = 0; i < 4; ++i) { v0[i] = gelu_tanh(v0[i]); v1[i] = gelu_tanh(v1[i]); }
                    }
                    s1 += ((v0[0] + v0[1]) + (v0[2] + v0[3])) + ((v1[0] + v1[1]) + (v1[2] + v1[3])); s2 += sq4(v0) + sq4(v1);
                    u32x4 w; w.x = cvt_pk_bf16(v0[0], v0[1]); w.y = cvt_pk_bf16(v0[2], v0[3]); w.z = cvt_pk_bf16(v1[0], v1[1]); w.w = cvt_pk_bf16(v1[2], v1[3]);
                    *(u32x4*)(Z + (size_t)row * Z1P + pn * BM + bj * HALF + colw) = w;
                }
                if (stat) {
                    s1 += xor16_f(s1); s1 = halves_sum_f(s1); s2 += xor16_f(s2); s2 = halves_sum_f(s2);
                    if (fq == 0) *(f32x2*)(sst + ((size_t)row * 8 + (pn - 8) * 4 + wc) * 2) = (f32x2){s1, s2};
                }
            }
    }
};
struct EpiHalo {
    static constexpr bool PERM = true, AFTER_DRAIN = false;
    const float* ssq_in; float* AH;
    __device__ __forceinline__ void operator()(const f32x4 (&acc)[2][2][4][2], const Unit& u_, int wr, int wc, int fr, int fq) const {
        Unit u; { int pm_ = u_.pm, pn_ = u_.pn; asm volatile("" : "+s"(pm_), "+s"(pn_)); u.pm = pm_; u.pn = pn_; }
        const int col0 = u.pn * BM + wc * 32 + 8 * fq;
#pragma unroll
        for (int m = 0; m < 4; ++m) {
            const int rh = wr * 64 + m * 16 + fr;
            if (rh < 2) continue;
            const int tok = 256 * (rh >> 1) - 2 + (rh & 1);
            const float rs = row_rstd(ssq_in, tok);
#pragma unroll
            for (int bj = 0; bj < 2; ++bj) {
                *(f32x4*)(AH + (size_t)rh * NFF2 + col0 + bj * HALF) = acc[0][bj][m][0] * rs;
                *(f32x4*)(AH + (size_t)rh * NFF2 + col0 + bj * HALF + 4) = acc[0][bj][m][1] * rs;
            }
        }
    }
};
template <int SEL> __device__ __forceinline__ float dpp1(const float old, const float src) {
    const int o = __builtin_bit_cast(int, old), s = __builtin_bit_cast(int, src); int t;
    if (SEL == 0) t = __builtin_amdgcn_update_dpp(o, s, 0x111, 0xf, 0xf, false);
    else if (SEL == 1) t = __builtin_amdgcn_update_dpp(o, s, 0x112, 0xf, 0xf, false);
    else if (SEL == 2) t = __builtin_amdgcn_update_dpp(o, s, 0x10F, 0xf, 0xf, false);
    else t = __builtin_amdgcn_update_dpp(o, s, 0x10E, 0xf, 0xf, false);
    return __builtin_bit_cast(float, t);
}
template <int SEL> __device__ __forceinline__ f32x4 dpp4t(const f32x4 old, const f32x4 src) {
    const float o0 = old[0], o1 = old[1], o2 = old[2], o3 = old[3], s0 = src[0], s1 = src[1], s2 = src[2], s3 = src[3];
    const float r0 = dpp1<SEL>(o0, s0), r1 = dpp1<SEL>(o1, s1), r2 = dpp1<SEL>(o2, s2), r3 = dpp1<SEL>(o3, s3);
    return (f32x4){r0, r1, r2, r3};
}
#define dpp4(old, src, sel) dpp4t<sel>(old, src)
__device__ __forceinline__ void conv_taps(f32x4& c, const f32x4 cur, const f32x4 prev, const f32x4 w0, const f32x4 w1) {
    float c0 = c[0], c1 = c[1], c2 = c[2], c3 = c[3];
    const float x0 = cur[0], x1 = cur[1], x2 = cur[2], x3 = cur[3], p0 = prev[0], p1 = prev[1], p2 = prev[2], p3 = prev[3];
    const float a0 = w1[0], a1 = w1[1], a2 = w1[2], a3 = w1[3], b0 = w0[0], b1 = w0[1], b2 = w0[2], b3 = w0[3];
    asm("s_nop 4\n\t"
        "v_fmac_f32_dpp %0, %4, %12 row_shr:1 row_mask:0xf bank_mask:0xf bound_ctrl:1\n\t"
        "v_fmac_f32_dpp %1, %5, %13 row_shr:1 row_mask:0xf bank_mask:0xf bound_ctrl:1\n\t"
        "v_fmac_f32_dpp %2, %6, %14 row_shr:1 row_mask:0xf bank_mask:0xf bound_ctrl:1\n\t"
        "v_fmac_f32_dpp %3, %7, %15 row_shr:1 row_mask:0xf bank_mask:0xf bound_ctrl:1\n\t"
        "v_fmac_f32_dpp %0, %4, %16 row_shr:2 row_mask:0xf bank_mask:0xf bound_ctrl:1\n\t"
        "v_fmac_f32_dpp %1, %5, %17 row_shr:2 row_mask:0xf bank_mask:0xf bound_ctrl:1\n\t"
        "v_fmac_f32_dpp %2, %6, %18 row_shr:2 row_mask:0xf bank_mask:0xf bound_ctrl:1\n\t"
        "v_fmac_f32_dpp %3, %7, %19 row_shr:2 row_mask:0xf bank_mask:0xf bound_ctrl:1\n\t"
        "v_fmac_f32_dpp %0, %8, %12 row_shl:15 row_mask:0xf bank_mask:0xf bound_ctrl:1\n\t"
        "v_fmac_f32_dpp %1, %9, %13 row_shl:15 row_mask:0xf bank_mask:0xf bound_ctrl:1\n\t"
        "v_fmac_f32_dpp %2, %10, %14 row_shl:15 row_mask:0xf bank_mask:0xf bound_ctrl:1\n\t"
        "v_fmac_f32_dpp %3, %11, %15 row_shl:15 row_mask:0xf bank_mask:0xf bound_ctrl:1\n\t"
        "v_fmac_f32_dpp %0, %8, %16 row_shl:14 row_mask:0xf bank_mask:0xf bound_ctrl:1\n\t"
        "v_fmac_f32_dpp %1, %9, %17 row_shl:14 row_mask:0xf bank_mask:0xf bound_ctrl:1\n\t"
        "v_fmac_f32_dpp %2, %10, %18 row_shl:14 row_mask:0xf bank_mask:0xf bound_ctrl:1\n\t"
        "v_fmac_f32_dpp %3, %11, %19 row_shl:14 row_mask:0xf bank_mask:0xf bound_ctrl:1"
        : "+v"(c0), "+v"(c1), "+v"(c2), "+v"(c3)
        : "v"(x0), "v"(x1), "v"(x2), "v"(x3), "v"(p0), "v"(p1), "v"(p2), "v"(p3), "v"(a0), "v"(a1), "v"(a2), "v"(a3), "v"(b0), "v"(b1), "v"(b2), "v"(b3));
    c[0] = c0; c[1] = c1; c[2] = c2; c[3] = c3;
}
struct EpiHaloF {
    static constexpr bool PERM = true, AFTER_DRAIN = false;
    const float* ssq_in; float* ah; unsigned* flags;
    __device__ __forceinline__ void operator()(const f32x4 (&acc)[2][2][4][2], const Unit& u_, int wr, int wc, int fr, int fq) const {
        Unit u; { int pm_ = u_.pm, pn_ = u_.pn; asm volatile("" : "+s"(pm_), "+s"(pn_)); u.pm = pm_; u.pn = pn_; }
        const int col0 = u.pn * BM + wc * 32 + 8 * fq;
#pragma unroll
        for (int m = 0; m < 4; ++m) {
            const int rh = wr * 64 + m * 16 + fr;
            if (rh >= 2) {
                const int tok = 256 * (rh >> 1) - 2 + (rh & 1);
                const float rsh = row_rstd(ssq_in, tok);
#pragma unroll
                for (int bj = 0; bj < 2; ++bj) {
                    *(f32x4*)(ah + (size_t)rh * NFF2 + col0 + bj * HALF) = acc[0][bj][m][0] * rsh;
                    *(f32x4*)(ah + (size_t)rh * NFF2 + col0 + bj * HALF + 4) = acc[0][bj][m][1] * rsh;
                }
            }
        }
        asm volatile("s_waitcnt vmcnt(0)" ::: "memory"); __builtin_amdgcn_s_barrier(); asm volatile("" ::: "memory");
        if (wr == 0 && wc == 0 && fr == 0 && fq == 0) {
            __builtin_amdgcn_fence(__ATOMIC_RELEASE, "agent");
            asm volatile("s_waitcnt vmcnt(0)" ::: "memory");
            __hip_atomic_store(flags + 64 * u.pn, 1u, __ATOMIC_RELAXED, __HIP_MEMORY_SCOPE_AGENT);
        }
    }
};
struct EpiFfnIn {
    static constexpr bool PERM = true, AFTER_DRAIN = false;
    const float* ssq_in; const float* cw; const float* cb; float* ah; bf16_t* hid; PG8_LAS float* xb; unsigned* flags; unsigned phase_id;
    __device__ __forceinline__ void operator()(const f32x4 (&acc)[2][2][4][2], const Unit& u_, int wr, int wc, int fr, int fq) const {
        Unit u; { int pm_ = u_.pm, pn_ = u_.pn; asm volatile("" : "+s"(pm_), "+s"(pn_)); u.pm = pm_; u.pn = pn_; }
        PG8_LAS float* rtab = xb + 2048;
        const int row0 = u.pm * BM + wr * 64 + fr;
        PG8_LAS float* cwl = xb + 2432 + wc * 256;
        PG8_LAS float* hl = xb + 3456 + wc * 128;
        if (wr == 0) {
            const float* src = (fq < 3 ? cw + fq * NFF2 : cb) + (fr >> 3) * DFF + 128 * u.pn + wc * 32 + (fr & 7) * 4;
            const f32x4 wv = *(const f32x4*)src;
            rtab[wc * 64 + fq * 16 + fr] = row_rstd(ssq_in, u.pm * BM + wc * 64 + fq * 16 + fr);
            *(PG8_LAS f32x4*)(cwl + (fq * 16 + fr) * 4) = wv;
        }
        if (fr >= 14) {
#pragma unroll
            for (int ai = 0; ai < 2; ++ai) {
                PG8_LAS f32x4* dst = (PG8_LAS f32x4*)(xb + ((((ai * 2 + wr) * 4 + wc) * 2 + (fr - 14)) * 4 + fq) * 16);
#pragma unroll
                for (int bj = 0; bj < 2; ++bj)
#pragma unroll
                    for (int n = 0; n < 2; ++n) dst[bj * 2 + n] = acc[ai][bj][3][n];
            }
        }
        asm volatile("s_waitcnt lgkmcnt(0)" ::: "memory"); __builtin_amdgcn_s_barrier(); asm volatile("" ::: "memory");
        const bool has = (u.pm & 7) != 0;
        if (wr == 0) {
            PG8_LAS unsigned* stamp = (PG8_LAS unsigned*)(rtab + 256);
            if (*(volatile PG8_LAS unsigned*)stamp != phase_id) {
                if (wc == 0) {
                    unsigned sp = 0;
                    for (int t = 0; t < NFF2 / BM; ++t)
                        while (__hip_atomic_load(flags + 64 * t, __ATOMIC_RELAXED, __HIP_MEMORY_SCOPE_AGENT) == 0u) { __builtin_amdgcn_s_sleep(2); if (++sp > (1u << 22)) break; }
                    asm volatile("s_waitcnt vmcnt(0)" ::: "memory");
                    if (fr == 0 && fq == 0) *(volatile PG8_LAS unsigned*)stamp = phase_id;
                } else {
                    unsigned sp = 0;
                    while (*(volatile PG8_LAS unsigned*)stamp != phase_id) { __builtin_amdgcn_s_sleep(2); if (++sp > (1u << 22)) break; }
                }
            }
        }
        if (wr == 0) {
            f32x2 hv = {0.f, 0.f};
            if (has) hv = *(const f32x2*)(ah + (size_t)(2 * u.pm + (fq >> 1)) * NFF2 + (size_t)u.pn * BM + (fq & 1) * HALF + wc * 32 + 2 * fr);
            *(PG8_LAS f32x2*)(hl + (fq * 16 + fr) * 2) = hv;
        }
        float rs[2][4];
#pragma unroll
        for (int ai = 0; ai < 2; ++ai)
#pragma unroll
            for (int m = 0; m < 4; ++m) rs[ai][m] = rtab[ai * HALF + wr * 64 + m * 16 + fr];
        const f32x4 zero4 = {0.f, 0.f, 0.f, 0.f};
#pragma unroll
        for (int ai = 0; ai < 2; ++ai) {
#pragma unroll
            for (int n = 0; n < 2; ++n) {
                f32x4 cg[4];
#pragma unroll
                for (int bj = 0; bj < 2; ++bj) {
                    f32x4 b0, b1;
                    if (ai == 0 && wr == 0) {
                        b0 = *(const PG8_LAS f32x4*)(hl + (0 * 2 + bj) * 32 + 8 * fq + 4 * n);
                        b1 = *(const PG8_LAS f32x4*)(hl + (1 * 2 + bj) * 32 + 8 * fq + 4 * n);
                    } else {
                        const int sa = (wr == 1) ? ai : ai - 1, sw = (wr == 1) ? 0 : 1;
                        const float r0 = rtab[sa * HALF + sw * 64 + 62], r1 = rtab[sa * HALF + sw * 64 + 63];
                        b0 = *(const PG8_LAS f32x4*)(xb + ((((sa * 2 + sw) * 4 + wc) * 2 + 0) * 4 + fq) * 16 + (bj * 2 + n) * 4) * r0;
                        b1 = *(const PG8_LAS f32x4*)(xb + ((((sa * 2 + sw) * 4 + wc) * 2 + 1) * 4 + fq) * 16 + (bj * 2 + n) * 4) * r1;
                    }
                    const int oc = bj * 32 + 8 * fq + 4 * n;
                    const f32x4 w0 = *(const PG8_LAS f32x4*)(cwl + oc), w1 = *(const PG8_LAS f32x4*)(cwl + 64 + oc), w2 = *(const PG8_LAS f32x4*)(cwl + 128 + oc), bb = *(const PG8_LAS f32x4*)(cwl + 192 + oc);
                    f32x4 prev = (fr == 14) ? b0 : b1;
#pragma unroll
                    for (int m = 0; m < 4; ++m) {
                        const f32x4 cur = acc[ai][bj][m][n] * rs[ai][m];
                        f32x4 c = w2 * cur + bb;
                        conv_taps(c, cur, prev, w0, w1);
                        prev = cur;
                        if (bj == 0) cg[m] = c;
                        else {
                            const f32x2 ha = gelu_mul2((f32x2){cg[m][0], cg[m][1]}, (f32x2){c[0], c[1]}), hb = gelu_mul2((f32x2){cg[m][2], cg[m][3]}, (f32x2){c[2], c[3]});
                            u32x2 w; w.x = cvt_pk_bf16(ha.x, ha.y); w.y = cvt_pk_bf16(hb.x, hb.y);
                            const int row = row0 + ai * HALF + m * 16;
                            *(u32x2*)(hid + (size_t)row * DFF + 128 * u.pn + wc * 32 + 8 * fq + 4 * n) = w;
                        }
                    }
                    asm volatile("" ::: "memory");
                }
            }
        }
    }
};
template <class Epi, class Sched, bool ALIGN_EPI = false, bool SP2 = false>
__device__ __forceinline__ void gemm_phase(PG8_LAS unsigned char* lds, const Gemm g, const Sched& S, const Epi& E, const int wave_s) {
    const int tid_ = wave_s * 64 + lane_opaque(); const int tid = tid_, wid = __builtin_amdgcn_readfirstlane(tid >> 6), lane = tid & 63, wr = wid >> 2, wc = wid & 3, fr = lane & 15, fq = lane >> 4;
    const int K = g.K, nt = K / BK;
    unsigned voffA[2], voffB[2];
#pragma unroll
    for (int i = 0; i < 2; ++i) { int R, C; stage_rc(tid * 16 + i * 8192, R, C); const int Rb = Epi::PERM ? ((R & ~31) + perm32(R & 31)) : R;
        voffA[i] = (unsigned)(R * K + C) * 2u; voffB[i] = (unsigned)(Rb * K + C) * 2u; }
    const size_t kstep = (size_t)(BK * 2);
    const size_t hstep = (size_t)HALF * K * 2;
    const size_t tstep = 2 * hstep;
    const unsigned ldsw = (unsigned)wid * 1024u;
    const int aoff = lds_byte(wr * 64 + fr, fq * 8), boff = lds_byte(wc * 32 + fr, fq * 8);
#define PG8_SA(b, h) (((b) * 2 + (h)) * HTB)
#define PG8_SB(b, h) ((4 + (b) * 2 + (h)) * HTB)
#define PG8_STAGE(bufoff, gbase, voff) do { _Pragma("unroll") for (int _i = 0; _i < 2; ++_i) \
        __builtin_amdgcn_global_load_lds((const unsigned*)((const char*)(gbase) + (voff)[_i]), (PG8_LAS unsigned*)(lds + (bufoff) + ldsw + _i * 8192), 16, 0, 0); } while (0)
#define PG8_LDA(dst, b, h) do { _Pragma("unroll") for (int m = 0; m < 4; ++m) _Pragma("unroll") for (int k = 0; k < 2; ++k) dst[m][k] = *(const PG8_LAS bf16x8*)(lds + PG8_SA(b, h) + aoff + m * 2048 + k * 1024); } while (0)
#define PG8_LDB(dst, b, h) do { _Pragma("unroll") for (int n = 0; n < 2; ++n) _Pragma("unroll") for (int k = 0; k < 2; ++k) dst[n][k] = *(const PG8_LAS bf16x8*)(lds + PG8_SB(b, h) + boff + n * 2048 + k * 1024); } while (0)
#define PG8_MMA(ai, bj, At, Bt) do { __builtin_amdgcn_s_setprio(1); _Pragma("unroll") for (int m = 0; m < 4; ++m) _Pragma("unroll") for (int n = 0; n < 2; ++n) _Pragma("unroll") for (int k = 0; k < 2; ++k) \
        acc[ai][bj][m][n] = __builtin_amdgcn_mfma_f32_16x16x32_bf16(Bt[n][k], At[m][k], acc[ai][bj][m][n], 0, 0, 0); __builtin_amdgcn_s_setprio(0); } while (0)
#define PG8_WAIT_V(n) asm volatile("s_waitcnt vmcnt(" #n ")" ::: "memory")
#define PG8_WAIT_L(n) asm volatile("s_waitcnt lgkmcnt(" #n ")" ::: "memory")
#define PG8_BAR __builtin_amdgcn_s_barrier()
#define PG8_SCHED __builtin_amdgcn_sched_barrier(0)
    Unit cur, nxt; int ui = 0;
    if (!S.next(0, cur)) return;
    f32x4 acc[2][2][4][2];
#pragma unroll
    for (int a = 0; a < 2; ++a)
#pragma unroll
        for (int b = 0; b < 2; ++b)
#pragma unroll
            for (int m = 0; m < 4; ++m)
#pragma unroll
                for (int n = 0; n < 2; ++n) acc[a][b][m][n] = (f32x4){0.f, 0.f, 0.f, 0.f};
    bf16x8 At[4][2], B0[2][2], B1[2][2];
    const char* cA = (const char*)g.A + (size_t)cur.pm * tstep; const char* cB = (const char*)g.Bt + (size_t)cur.pn * tstep;
    S.a_ready(cur);
    if constexpr (SP2) {
        PG8_STAGE(PG8_SB(0, 0), cB, voffB); PG8_STAGE(PG8_SB(0, 1), cB + hstep, voffB); PG8_STAGE(PG8_SA(0, 0), cA, voffA); PG8_STAGE(PG8_SA(0, 1), cA + hstep, voffA);
        if (wr == 1) PG8_BAR;
        PG8_WAIT_V(2); PG8_BAR;
        PG8_STAGE(PG8_SB(1, 0), cB + kstep, voffB); PG8_STAGE(PG8_SA(1, 0), cA + kstep, voffA); PG8_STAGE(PG8_SB(1, 1), cB + hstep + kstep, voffB);
        PG8_WAIT_V(6); PG8_BAR;
    } else {
        PG8_STAGE(PG8_SB(0, 0), cB, voffB); PG8_STAGE(PG8_SA(0, 0), cA, voffA); PG8_STAGE(PG8_SB(0, 1), cB + hstep, voffB); PG8_STAGE(PG8_SA(0, 1), cA + hstep, voffA);
        if (wr == 1) PG8_BAR;
        PG8_WAIT_V(4); PG8_BAR;
        PG8_STAGE(PG8_SB(1, 0), cB + kstep, voffB); PG8_STAGE(PG8_SA(1, 0), cA + kstep, voffA); PG8_STAGE(PG8_SB(1, 1), cB + hstep + kstep, voffB);
        PG8_WAIT_V(6); PG8_BAR;
    }
    for (;;) {
        const bool has_next = S.next(ui + 1, nxt);
        const char* nA = has_next ? (const char*)g.A + (size_t)nxt.pm * tstep : cA; const char* nB = has_next ? (const char*)g.Bt + (size_t)nxt.pn * tstep : cB;
        for (int t = 0; t < nt; t += 2) {
            const bool last = (t == nt - 2);
            const char* a1 = cA + (size_t)(t + 1) * kstep;
            const char* a2 = last ? nA : cA + (size_t)(t + 2) * kstep; const char* b2 = last ? nB : cB + (size_t)(t + 2) * kstep;
            const char* a3 = a2 + kstep; const char* b3 = b2 + kstep;
            if (last && has_next) S.a_ready(nxt);
            if constexpr (SP2) {
            PG8_LDB(B0, 0, 0); PG8_LDB(B1, 0, 1); PG8_SCHED; PG8_LDA(At, 0, 0); PG8_STAGE(PG8_SA(1, 1), a1 + hstep, voffA);
            PG8_WAIT_V(8); PG8_WAIT_L(0); PG8_BAR; PG8_MMA(0, 0, At, B0); PG8_MMA(0, 1, At, B1); PG8_BAR; PG8_SCHED;
            PG8_LDA(At, 0, 1); PG8_STAGE(PG8_SB(0, 0), b2, voffB); PG8_STAGE(PG8_SB(0, 1), b2 + hstep, voffB); PG8_STAGE(PG8_SA(0, 0), a2, voffA);
            PG8_WAIT_V(8); PG8_WAIT_L(0); PG8_BAR; PG8_MMA(1, 0, At, B0); PG8_MMA(1, 1, At, B1); PG8_BAR; PG8_SCHED;
            PG8_LDB(B0, 1, 0); PG8_LDB(B1, 1, 1); PG8_SCHED; PG8_LDA(At, 1, 0); PG8_STAGE(PG8_SA(0, 1), a2 + hstep, voffA);
            PG8_WAIT_V(8); PG8_WAIT_L(0); PG8_BAR; PG8_MMA(0, 0, At, B0); PG8_MMA(0, 1, At, B1); PG8_BAR; PG8_SCHED;
            PG8_LDA(At, 1, 1); PG8_STAGE(PG8_SB(1, 0), b3, voffB); PG8_STAGE(PG8_SB(1, 1), b3 + hstep, voffB); PG8_STAGE(PG8_SA(1, 0), a3, voffA);
            PG8_WAIT_V(8); PG8_WAIT_L(0); PG8_BAR; PG8_MMA(1, 0, At, B0); PG8_MMA(1, 1, At, B1); PG8_BAR; PG8_SCHED;
            } else {
            PG8_LDB(B0, 0, 0); PG8_SCHED; PG8_LDA(At, 0, 0); PG8_STAGE(PG8_SA(1, 1), a1 + hstep, voffA);
            PG8_WAIT_L(8); PG8_BAR; PG8_WAIT_L(0); PG8_MMA(0, 0, At, B0); PG8_BAR; PG8_SCHED;
            PG8_LDB(B1, 0, 1); PG8_STAGE(PG8_SB(0, 0), b2, voffB);
            PG8_BAR; PG8_WAIT_L(0); PG8_MMA(0, 1, At, B1); PG8_BAR;
            PG8_LDA(At, 0, 1); PG8_STAGE(PG8_SA(0, 0), a2, voffA);
            PG8_BAR; PG8_WAIT_L(0); PG8_MMA(1, 0, At, B0); PG8_BAR; PG8_SCHED;
            PG8_STAGE(PG8_SB(0, 1), b2 + hstep, voffB);
            PG8_WAIT_V(6); PG8_BAR; PG8_MMA(1, 1, At, B1); PG8_BAR;
            PG8_LDB(B0, 1, 0); PG8_SCHED; PG8_LDA(At, 1, 0); PG8_STAGE(PG8_SA(0, 1), a2 + hstep, voffA);
            PG8_WAIT_L(8); PG8_BAR; PG8_WAIT_L(0); PG8_MMA(0, 0, At, B0); PG8_BAR; PG8_SCHED;
            PG8_LDB(B1, 1, 1); PG8_STAGE(PG8_SB(1, 0), b3, voffB);
            PG8_BAR; PG8_WAIT_L(0); PG8_MMA(0, 1, At, B1); PG8_BAR;
            PG8_LDA(At, 1, 1); PG8_STAGE(PG8_SA(1, 0), a3, voffA);
            PG8_BAR; PG8_WAIT_L(0); PG8_MMA(1, 0, At, B0); PG8_BAR; PG8_SCHED;
            PG8_STAGE(PG8_SB(1, 1), b3 + hstep, voffB);
            PG8_WAIT_V(6); PG8_BAR; PG8_MMA(1, 1, At, B1); PG8_BAR;
            }
        }
        if constexpr (ALIGN_EPI) { if (wr == 0) PG8_BAR; }
        if constexpr (!Epi::AFTER_DRAIN) { E(acc, cur, wr, wc, fr, fq); S.done(cur); }
        if (!has_next) break;
#pragma unroll
        for (int a = 0; a < 2; ++a)
#pragma unroll
            for (int b = 0; b < 2; ++b)
#pragma unroll
                for (int m = 0; m < 4; ++m)
#pragma unroll
                    for (int n = 0; n < 2; ++n) acc[a][b][m][n] = (f32x4){0.f, 0.f, 0.f, 0.f};
        cur = nxt; cA = nA; cB = nB; ++ui;
        if constexpr (ALIGN_EPI) { if (wr == 1) PG8_BAR; }
    }
    PG8_WAIT_V(0);
    if constexpr (!ALIGN_EPI) { if (wr == 0) PG8_BAR; }
    PG8_BAR;
    if constexpr (Epi::AFTER_DRAIN) { E.fused(acc, cur, wr, wc, fr, fq, lds, wid, lane); S.done(cur); }
#undef PG8_SA
#undef PG8_SB
#undef PG8_STAGE
#undef PG8_LDA
#undef PG8_LDB
#undef PG8_MMA
#undef PG8_WAIT_V
#undef PG8_WAIT_L
#undef PG8_BAR
#undef PG8_SCHED
}
}
namespace mix {
#define MLAS __attribute__((address_space(3)))
typedef unsigned short bf16_t;
typedef short bf16x8 __attribute__((ext_vector_type(8)));
typedef short s16x4 __attribute__((ext_vector_type(4)));
typedef float f32x16 __attribute__((ext_vector_type(16)));
typedef float f32x4 __attribute__((ext_vector_type(4)));
typedef float f32x2 __attribute__((ext_vector_type(2)));
typedef unsigned u32x4 __attribute__((ext_vector_type(4)));
typedef unsigned u32x2 __attribute__((ext_vector_type(2)));
typedef MLAS const char* lds_cptr;
typedef short v4i16_t __attribute__((ext_vector_type(4)));
typedef __bf16 bf16x2_t __attribute__((ext_vector_type(2)));

constexpr int SLOTB = 8192;
constexpr int NSLOT = 4;
constexpr int L_K = 0, L_V = NSLOT * SLOTB, L_WSF = 2 * NSLOT * SLOTB, L_OST = L_WSF + 8 * 256, L_X = L_OST + 8 * 4096;
constexpr int LX_IQ = L_X, LX_EQ = L_X, LX_PFX = L_X + 8192, LX_CNT = LX_IQ + 16384, LX_GT = LX_CNT + 2048, LX_SEL = LX_GT, LX_END = LX_GT + 8192;
static_assert(LX_END <= 131072, "mixer LDS map");

__device__ __forceinline__ int crow(int r, int hi) { return (r & 3) + 8 * (r >> 2) + 4 * hi; }
__device__ __forceinline__ void glds16(const void* gsrc, unsigned lds_dst) { unsigned keep;
    asm volatile("s_mov_b32 %0, m0\n\ts_mov_b32 m0, %2\n\ts_nop 0\n\tglobal_load_lds_dwordx4 %1, off\n\ts_mov_b32 m0, %0" : "=&s"(keep) : "v"(gsrc), "s"(lds_dst) : "memory"); }
__device__ __forceinline__ unsigned cvtpk(float lo, float hi) { f32x2 v = {lo, hi}; bf16x2_t b = __builtin_convertvector(v, bf16x2_t); return __builtin_bit_cast(unsigned, b); }
__device__ __forceinline__ s16x4 vtr(lds_cptr p) { return __builtin_bit_cast(s16x4, __builtin_amdgcn_ds_read_tr16_b64_v4i16((MLAS v4i16_t*)p)); }
#define WAITV_BAR() asm volatile("s_waitcnt vmcnt(0) lgkmcnt(0)\n\ts_barrier" ::: "memory")
#define LGKM_BAR() asm volatile("s_waitcnt lgkmcnt(0)\n\ts_barrier" ::: "memory")
#define WAITV2_BAR() asm volatile("s_waitcnt vmcnt(2) lgkmcnt(0)\n\ts_barrier" ::: "memory")

__device__ __forceinline__ void dma_kv(const bf16_t* kbase, const bf16_t* vbase, int pitch, unsigned lds0, int slot, int wid, int lane) {
    const bf16_t* ks = kbase + (size_t)lane * pitch + wid * 8;
    const bf16_t* vs = vbase + (size_t)(16 * (wid & 3) + (lane >> 2)) * pitch + (wid >> 2) * 32 + (lane & 3) * 8;
    glds16(ks, (unsigned)__builtin_amdgcn_readfirstlane(lds0 + L_K + slot * SLOTB + wid * 1024));
    glds16(vs, (unsigned)__builtin_amdgcn_readfirstlane(lds0 + L_V + slot * SLOTB + wid * 1024));
}
__device__ __forceinline__ void kload(bf16x8 (&kf)[8], lds_cptr kslot, int r32, int hi) {
    lds_cptr kb = kslot + hi * 1024 + r32 * 16;
#pragma unroll
    for (int d0 = 0; d0 < 4; ++d0) { kf[2 * d0] = *(const MLAS bf16x8*)(kb + d0 * 2048); kf[2 * d0 + 1] = *(const MLAS bf16x8*)(kb + d0 * 2048 + 512); }
}
__device__ __forceinline__ void qkt_mma(f32x16& p0, f32x16& p1, const bf16x8 (&kf)[8], const bf16x8* qr, const f32x16& cinit) {
    p0 = __builtin_amdgcn_mfma_f32_32x32x16_bf16(kf[0], qr[0], cinit, 0, 0, 0); p1 = __builtin_amdgcn_mfma_f32_32x32x16_bf16(kf[1], qr[0], cinit, 0, 0, 0);
#pragma unroll
    for (int d0 = 1; d0 < 4; ++d0) { p0 = __builtin_amdgcn_mfma_f32_32x32x16_bf16(kf[2 * d0], qr[d0], p0, 0, 0, 0); p1 = __builtin_amdgcn_mfma_f32_32x32x16_bf16(kf[2 * d0 + 1], qr[d0], p1, 0, 0, 0); }
}
__device__ __forceinline__ void qkt(f32x16& p0, f32x16& p1, lds_cptr kslot, const bf16x8* qr, const f32x16& cinit, int r32, int hi) {
    bf16x8 kf[8]; kload(kf, kslot, r32, hi); qkt_mma(p0, p1, kf, qr, cinit);
}
__device__ __forceinline__ void vload(bf16x8 (&vf)[8], lds_cptr vslot, int lane, int hi) {
    lds_cptr vp = vslot + ((lane >> 4) & 1) * 32 + (lane & 3) * 8 + (4 * hi + ((lane & 15) >> 2)) * 64;
#pragma unroll
    for (int d0 = 0; d0 < 2; ++d0)
#pragma unroll
        for (int ks = 0; ks < 4; ++ks) {
            const s16x4 lo = vtr(vp + d0 * 4096 + ks * 1024), hh = vtr(vp + d0 * 4096 + ks * 1024 + 512);
            vf[d0 * 4 + ks] = (bf16x8){lo[0], lo[1], lo[2], lo[3], hh[0], hh[1], hh[2], hh[3]};
        }
}
#define V16_TO_ARR(v, a, o) do { a[(o) + 0] = v[0]; a[(o) + 1] = v[1]; a[(o) + 2] = v[2]; a[(o) + 3] = v[3]; a[(o) + 4] = v[4]; a[(o) + 5] = v[5]; a[(o) + 6] = v[6]; a[(o) + 7] = v[7]; \
    a[(o) + 8] = v[8]; a[(o) + 9] = v[9]; a[(o) + 10] = v[10]; a[(o) + 11] = v[11]; a[(o) + 12] = v[12]; a[(o) + 13] = v[13]; a[(o) + 14] = v[14]; a[(o) + 15] = v[15]; } while (0)
__device__ __forceinline__ f32x16 splat16(float x) { return (f32x16){x, x, x, x, x, x, x, x, x, x, x, x, x, x, x, x}; }
struct AttnState { f32x16 o[2]; float m, l, pend; bool started; };
constexpr float ATT_THR = 8.0f;
__device__ __forceinline__ void softmax_pv(AttnState& st, float (&sc)[32], const bf16x8 (&vf)[8], MLAS float* wsf, int lane, int r32, int hi) {
    if (__any(st.pend != 0.f)) {
#pragma unroll
        for (int r = 0; r < 32; ++r) sc[r] -= st.pend;
    }
    st.pend = 0.f;
    float ra = __builtin_fmaxf(__builtin_fmaxf(sc[0], sc[1]), sc[2]), rb = __builtin_fmaxf(__builtin_fmaxf(sc[3], sc[4]), sc[5]);
#pragma unroll
    for (int r = 6; r < 30; r += 4) { ra = __builtin_fmaxf(__builtin_fmaxf(ra, sc[r]), sc[r + 1]); rb = __builtin_fmaxf(__builtin_fmaxf(rb, sc[r + 2]), sc[r + 3]); }
    float rm = __builtin_fmaxf(__builtin_fmaxf(ra, rb), __builtin_fmaxf(sc[30], sc[31]));
    rm = halves_max_f(rm);
    const bool fresh = !st.started;
    const bool need = (rm > ATT_THR) || (fresh && rm < -ATT_THR && rm > -1e29f);
    st.started = st.started || (rm > -1e29f);
    if (__any(need)) {
        const float dl = need ? rm : 0.f;
        st.m += dl; st.pend = dl;
#pragma unroll
        for (int r = 0; r < 32; ++r) sc[r] -= dl;
        const float alpha = fresh ? 1.0f : __builtin_amdgcn_exp2f(-dl);
        st.l *= alpha;
        if (hi == 0) wsf[r32] = alpha;
        float fr_[16];
#pragma unroll
        for (int r = 0; r < 16; ++r) fr_[r] = wsf[crow(r, hi)];
        const f32x16 fv = {fr_[0], fr_[1], fr_[2], fr_[3], fr_[4], fr_[5], fr_[6], fr_[7], fr_[8], fr_[9], fr_[10], fr_[11], fr_[12], fr_[13], fr_[14], fr_[15]};
        st.o[0] = st.o[0] * fv; st.o[1] = st.o[1] * fv;
    }
    float pe[32]; float s0 = 0.f, s1 = 0.f;
#pragma unroll
    for (int r = 0; r < 32; r += 2) { pe[r] = __builtin_amdgcn_exp2f(sc[r]); pe[r + 1] = __builtin_amdgcn_exp2f(sc[r + 1]); s0 += pe[r]; s1 += pe[r + 1]; }
    st.l += s0 + s1;
    u32x4 pw[4];
#pragma unroll
    for (int k = 0; k < 4; ++k) pw[k] = (u32x4){cvtpk(pe[8 * k + 0], pe[8 * k + 1]), cvtpk(pe[8 * k + 2], pe[8 * k + 3]), cvtpk(pe[8 * k + 4], pe[8 * k + 5]), cvtpk(pe[8 * k + 6], pe[8 * k + 7])};
#pragma unroll
    for (int d0 = 0; d0 < 2; ++d0)
#pragma unroll
        for (int ks = 0; ks < 4; ++ks) st.o[d0] = __builtin_amdgcn_mfma_f32_32x32x16_bf16(__builtin_bit_cast(bf16x8, pw[ks]), vf[d0 * 4 + ks], st.o[d0], 0, 0, 0);
}
__device__ __forceinline__ void attn_store(AttnState& st, bf16_t* Ow, int pitch, MLAS float* wsf, MLAS bf16_t* stg, int lane, int r32, int hi) {
    float l = halves_sum_f(st.l);
    if (hi == 0) wsf[32 + r32] = l;
    float rli[16];
#pragma unroll
    for (int r = 0; r < 16; ++r) rli[r] = 1.0f / wsf[32 + crow(r, hi)];
#pragma unroll
    for (int r = 0; r < 16; ++r) { const int orow = crow(r, hi);
#pragma unroll
        for (int d0 = 0; d0 < 2; ++d0) { const unsigned short b = (unsigned short)(cvtpk(st.o[d0][r] * rli[r], 0.f) & 0xffffu); stg[orow * 64 + d0 * 32 + r32] = b; } }
#pragma unroll
    for (int i = 0; i < 4; ++i) { const int row = i * 8 + (lane >> 3), ch = lane & 7; const u32x4 v = *(const MLAS u32x4*)(stg + row * 64 + ch * 8); *(u32x4*)(Ow + (size_t)row * pitch + ch * 8) = v; }
}

#ifndef DBG_REP_BS
#define DBG_REP_BS 1
#endif
__device__ __forceinline__ unsigned pk_sub_sat_u16(unsigned a, unsigned b) { unsigned r; asm("v_pk_sub_u16 %0, %1, %2 clamp" : "=v"(r) : "v"(a), "v"(b)); return r; }
__device__ __forceinline__ unsigned pk_min_u16(unsigned a, unsigned b) { unsigned r; asm("v_pk_min_u16 %0, %1, %2" : "=v"(r) : "v"(a), "v"(b)); return r; }
__device__ __forceinline__ unsigned pk_add_u16(unsigned a, unsigned b) { unsigned r; asm("v_pk_add_u16 %0, %1, %2" : "=v"(r) : "v"(a), "v"(b)); return r; }
__device__ __forceinline__ unsigned pk_ashr_i16(unsigned a, unsigned sh2) { unsigned r; asm("v_pk_ashrrev_i16 %0, %1, %2" : "=v"(r) : "v"(sh2), "v"(a)); return r; }
__device__ __forceinline__ unsigned score_keys(float a, float b) {
    const unsigned p = __builtin_bit_cast(unsigned, __builtin_amdgcn_cvt_pkrtz(a, b));
    const unsigned m = pk_ashr_i16(p, 0x000f000fu);
    return p ^ (m | 0x80008000u);
}
template <int NS> __device__ __forceinline__ unsigned bit_search(const unsigned (&kp)[8][8], MLAS unsigned* cntx, int wid, int r32, int hi) {
    unsigned tau = 0u;
#pragma unroll 1
    for (int bit = 15; bit >= 0; --bit) {
        const unsigned cand = tau | (1u << bit);
        const unsigned c2 = (cand - 1u) * 0x00010001u;
        unsigned cnt2 = 0;
#pragma unroll
        for (int jj = 0; jj < NS; ++jj)
#pragma unroll
            for (int r = 0; r < 8; ++r) cnt2 = pk_add_u16(cnt2, pk_min_u16(pk_sub_sat_u16(kp[jj][r], c2), 0x00010001u));
        unsigned cnt = (cnt2 & 0xffffu) + (cnt2 >> 16);
        cnt = halves_add_u(cnt);
        MLAS unsigned* cb = cntx + (bit & 1) * 256;
        if (hi == 0) cb[wid * 32 + r32] = cnt;
        LGKM_BAR();
        unsigned tot = 0;
#pragma unroll
        for (int w = 0; w < 8; ++w) tot += cb[w * 32 + r32];
        if (tot >= 256u) tau = cand;
    }
    return tau;
}
__device__ __forceinline__ void dsa_select(int b, int qg, const bf16_t* Z0, char* shm, const int wave_s) {
    const int tid_ = wave_s * 64 + lane_opaque(); const int tid = tid_, lane = tid & 63, r32 = lane & 31, hi = lane >> 5; const int wid = __builtin_amdgcn_readfirstlane(tid >> 6);
    MLAS char* L = (MLAS char*)shm;
    const int c = qg >> 1, nkeys = 64 * (c + 1), nt32 = nkeys >> 5, nt64 = nkeys >> 6;
    const size_t rowb = (size_t)b * SEQ;
    const size_t tok0 = rowb + 32 * qg;
    MLAS unsigned* selw = (MLAS unsigned*)(L + LX_SEL);
    if (nkeys <= 256) {
        for (int i = tid; i < 64 * 32; i += 512) selw[i] = (i < nt32 * 32) ? 0xffffffffu : 0u;
    } else {
        {
            MLAS u32x4* iqL = (MLAS u32x4*)(L + LX_IQ);
            for (int i = tid; i < 1024; i += 512) { const int q = i & 31, hh = (i >> 5) & 1, d0 = (i >> 6) & 3, h = i >> 8;
                iqL[i] = *(const u32x4*)(Z0 + (tok0 + q) * EV_N + 1280 + 64 * h + 16 * d0 + 8 * hh); }
        }
        float w4[4];
        { const u32x2 ww = *(const u32x2*)(Z0 + (tok0 + r32) * EV_N + 1216);
          w4[0] = pg8::bf_lo(ww.x) * 0.0625f; w4[1] = pg8::bf_hi(ww.x) * 0.0625f; w4[2] = pg8::bf_lo(ww.y) * 0.0625f; w4[3] = pg8::bf_hi(ww.y) * 0.0625f; }
        LGKM_BAR();
        unsigned kp[8][8];
        const int nslots = (nt32 + 7) >> 3;
        const MLAS bf16x8* iqf = (const MLAS bf16x8*)(L + LX_IQ) + hi * 32 + r32;
#pragma unroll
        for (int jj = 0; jj < 8; ++jj) {
            const int j = wid + 8 * jj;
            if (j < nt32) {
                const bf16_t* ikp = Z0 + (rowb + 32 * j + r32) * EV_N + 1152 + 8 * hi;
                bf16x8 af[4];
#pragma unroll
                for (int d0 = 0; d0 < 4; ++d0) af[d0] = *(const bf16x8*)(ikp + 16 * d0);
                f32x16 ah[4];
#pragma unroll
                for (int h = 0; h < 4; ++h) {
                    f32x16 a = {};
#pragma unroll
                    for (int d0 = 0; d0 < 4; ++d0) a = __builtin_amdgcn_mfma_f32_32x32x16_bf16(af[d0], iqf[(h * 4 + d0) * 64], a, 0, 0, 0);
                    ah[h] = a;
                }
                float sv[16];
                {
                    float a0[16], a1[16], a2[16], a3[16];
                    V16_TO_ARR(ah[0], a0, 0); V16_TO_ARR(ah[1], a1, 0); V16_TO_ARR(ah[2], a2, 0); V16_TO_ARR(ah[3], a3, 0);
#pragma unroll
                    for (int r = 0; r < 16; ++r) sv[r] = ((__builtin_fmaxf(a0[r], 0.f) * w4[0] + __builtin_fmaxf(a1[r], 0.f) * w4[1]) + __builtin_fmaxf(a2[r], 0.f) * w4[2]) + __builtin_fmaxf(a3[r], 0.f) * w4[3];
                }
#pragma unroll
                for (int r = 0; r < 8; ++r) kp[jj][r] = score_keys(sv[r], sv[r + 8]);
            } else {
#pragma unroll
                for (int r = 0; r < 8; ++r) kp[jj][r] = 0u;
            }
        }
        MLAS unsigned* cntx = (MLAS unsigned*)(L + L_OST);
        unsigned tau;
        for (int rep_ = 0; rep_ < DBG_REP_BS; ++rep_)
        switch (nslots) {
            case 2: tau = bit_search<2>(kp, cntx, wid, r32, hi); break;
            case 3: tau = bit_search<3>(kp, cntx, wid, r32, hi); break;
            case 4: tau = bit_search<4>(kp, cntx, wid, r32, hi); break;
            case 5: tau = bit_search<5>(kp, cntx, wid, r32, hi); break;
            case 6: tau = bit_search<6>(kp, cntx, wid, r32, hi); break;
            case 7: tau = bit_search<7>(kp, cntx, wid, r32, hi); break;
            default: tau = bit_search<8>(kp, cntx, wid, r32, hi); break;
        }
        MLAS unsigned* gtw = (MLAS unsigned*)(L + LX_GT); MLAS unsigned* eqw = (MLAS unsigned*)(L + LX_EQ); MLAS unsigned* pfx = (MLAS unsigned*)(L + LX_PFX);
        const unsigned tg = tau * 0x00010001u, te = (tau - 1u) * 0x00010001u;
#pragma unroll
        for (int jj = 0; jj < 8; ++jj) {
            const int j = wid + 8 * jj;
            if (j < nt32) {
                unsigned g = 0, e = 0;
#pragma unroll
                for (int r = 0; r < 8; ++r) {
                    const unsigned dgt = pk_min_u16(pk_sub_sat_u16(kp[jj][r], tg), 0x00010001u), dge = pk_min_u16(pk_sub_sat_u16(kp[jj][r], te), 0x00010001u);
                    const int pos = (r & 3) + 8 * (r >> 2);
                    g |= dgt << pos; e |= (dge - dgt) << pos;
                }
                g <<= 4 * hi; e <<= 4 * hi;
                g = halves_or_u(g); e = halves_or_u(e);
                if (hi == 0) { gtw[j * 32 + r32] = g; eqw[j * 32 + r32] = e; }
            }
        }
        LGKM_BAR();
        if (wid == 0 && hi == 0) {
            unsigned cg = 0;
            for (int j = 0; j < nt32; ++j) cg += __builtin_popcount(gtw[j * 32 + r32]);
            const int need = 256 - (int)cg;
            int run = 0;
            for (int j = 0; j < nt32; ++j) { const unsigned e = eqw[j * 32 + r32]; int k = need - run; k = k < 0 ? 0 : (k > 32 ? 32 : k); pfx[j * 32 + r32] = (unsigned)k; run += __builtin_popcount(e); }
        }
        LGKM_BAR();
        for (int i = tid; i < nt32 * 32; i += 512) {
            const unsigned g = gtw[i], e = eqw[i]; const int k = (int)pfx[i];
            unsigned take = 0;
            if (e != 0u && k > 0) {
                unsigned rem = e; int cntk = 0;
                while (rem != 0u && cntk < k) { const unsigned low = rem & (0u - rem); take |= low; rem ^= low; ++cntk; }
            }
            selw[i] = g | take;
        }
        for (int i = nt32 * 32 + tid; i < 64 * 32; i += 512) selw[i] = 0u;
    }
    WAITV_BAR();
}

__device__ __forceinline__ void fox_unit(int b, int h, int qb, const bf16_t* Z1, const float* F, const float* bfp, bf16_t* Y, char* shm, unsigned lds0, const int wave_s) {
    const int tid_ = wave_s * 64 + lane_opaque(); const int tid = tid_, lane = tid & 63, r32 = lane & 31, hi = lane >> 5; const int wid = __builtin_amdgcn_readfirstlane(tid >> 6);
    MLAS char* L = (MLAS char*)shm;
    const size_t rowb = (size_t)b * SEQ;
    const int NT = 4 * (qb + 1), nk = 64 * NT;
    MLAS float* cum2 = (MLAS float*)(L + L_X);
    MLAS float* wtot = (MLAS float*)(L + L_X + 8192);
    const bf16_t* Kb = Z1 + rowb * Z1P + 512 + 64 * h; const bf16_t* Vb = Z1 + rowb * Z1P + 1024 + 64 * h;
#pragma unroll
    for (int i = 0; i < 3; ++i) dma_kv(Kb + (size_t)64 * i * Z1P, Vb + (size_t)64 * i * Z1P, Z1P, lds0, i, wid, lane);
    {
        const float bias = bfp[h];
        const int s0 = 4 * tid;
        float v[4]; float run = 0.f;
#pragma unroll
        for (int i = 0; i < 4; ++i) {
            float x = 0.f;
            if (s0 + i < nk) x = F[(rowb + s0 + i) * 8 + h] + bias;
            const float ls = (s0 + i < nk) ? (fminf(x, 0.f) - log1pf(expf(-fabsf(x)))) : 0.f;
            run += ls; v[i] = run;
        }
        float inc = run;
#pragma unroll
        for (int o = 1; o < 64; o <<= 1) { const int ln = lane_opaque(); const float t = __builtin_bit_cast(float, __builtin_amdgcn_ds_bpermute((ln - o) << 2, __builtin_bit_cast(int, inc))); if (ln >= o) inc += t; }
        if (lane == 63) wtot[wid] = inc;
        LGKM_BAR();
        float off = inc - run;
        for (int w = 0; w < wid; ++w) off += wtot[w];
#pragma unroll
        for (int i = 0; i < 4; ++i) cum2[s0 + i] = (off + v[i]) * 1.4426950408889634f;
    }
    const int tq = 256 * qb + 32 * wid + r32;
    bf16x8 qr[4];
#pragma unroll
    for (int d0 = 0; d0 < 4; ++d0) qr[d0] = *(const bf16x8*)(Z1 + (rowb + tq) * Z1P + 64 * h + 16 * d0 + 8 * hi);
    AttnState st; st.o[0] = f32x16{}; st.o[1] = f32x16{}; st.m = 0.f; st.l = 0.f; st.pend = 0.f; st.started = false;
    MLAS float* wsf = (MLAS float*)(L + L_WSF) + wid * 64;
    WAITV_BAR();
    const float cq2 = cum2[tq];
    const int tlast = 4 * qb + (wid >> 1);
    f32x16 s0, s1;
    qkt(s0, s1, (lds_cptr)(L + L_K), qr, splat16(-st.m), r32, hi);
    for (int t = 0; t < NT; ++t) {
        const int slot = t & 3;
        { const int tt = (t + 3 < NT) ? t + 3 : NT - 1; dma_kv(Kb + (size_t)64 * tt * Z1P, Vb + (size_t)64 * tt * Z1P, Z1P, lds0, (t + 3) & 3, wid, lane); }
        bf16x8 kf[8], vf[8];
        kload(kf, (lds_cptr)(L + L_K + ((t + 1) & 3) * SLOTB), r32, hi);
        __builtin_amdgcn_sched_barrier(0);
        vload(vf, (lds_cptr)(L + L_V + slot * SLOTB), lane, hi);
        const MLAS float* cb = cum2 + 64 * t + 4 * hi;
        f32x4 c0[4], c1[4];
#pragma unroll
        for (int g = 0; g < 4; ++g) { c0[g] = *(const MLAS f32x4*)(cb + 8 * g); c1[g] = *(const MLAS f32x4*)(cb + 32 + 8 * g); }
        f32x16 n0, n1;
        qkt_mma(n0, n1, kf, qr, splat16(-st.m));
        float sc[32];
        V16_TO_ARR(s0, sc, 0); V16_TO_ARR(s1, sc, 16);
#pragma unroll
        for (int g = 0; g < 4; ++g) {
            sc[4 * g + 0] += cq2 - c0[g].x; sc[4 * g + 1] += cq2 - c0[g].y; sc[4 * g + 2] += cq2 - c0[g].z; sc[4 * g + 3] += cq2 - c0[g].w;
            sc[16 + 4 * g + 0] += cq2 - c1[g].x; sc[16 + 4 * g + 1] += cq2 - c1[g].y; sc[16 + 4 * g + 2] += cq2 - c1[g].z; sc[16 + 4 * g + 3] += cq2 - c1[g].w;
        }
        if (t >= tlast) {
            const int qrel = tq - 64 * t;
#pragma unroll
            for (int r = 0; r < 16; ++r) { const int kr = crow(r, hi); if (kr > qrel) sc[r] = -INFINITY; if (kr + 32 > qrel) sc[16 + r] = -INFINITY; }
        }
        softmax_pv(st, sc, vf, wsf, lane, r32, hi);
        s0 = n0; s1 = n1;
        WAITV2_BAR();
    }
    attn_store(st, Y + (rowb + 256 * qb + 32 * wid) * DMODEL + 64 * h, DMODEL, wsf, (MLAS bf16_t*)(L + L_OST) + wid * 2048, lane, r32, hi);
    WAITV_BAR();
}

__device__ __forceinline__ void sgu_unit(int b, int n, int g, const bf16_t* Z1, const float* sst, const float* lng, const float* lnb, const bf16_t* Wm, const float* bs, bf16_t* Y, char* shm, const int wave_s) {
    const int tid_ = wave_s * 64 + lane_opaque(); const int tid = tid_, lane = tid & 63, r32 = lane & 31, hi = lane >> 5; const int wid = __builtin_amdgcn_readfirstlane(tid >> 6);
    MLAS char* L = (MLAS char*)shm;
    MLAS bf16_t* vn = (MLAS bf16_t*)L;
    constexpr int VP = 136;
    const size_t tok0 = (size_t)b * SEQ + 128 * n;
    {
        const int j = tid >> 2, cq = (tid & 3) * 32;
        const float* sp = sst + (tok0 + j) * 16;
        float s1 = 0.f, s2 = 0.f;
#pragma unroll
        for (int k = 0; k < 8; ++k) { s1 += sp[2 * k]; s2 += sp[2 * k + 1]; }
        const float mu = s1 * (1.0f / 512.0f); const float var = fmaxf(s2 * (1.0f / 512.0f) - mu * mu, 0.f);
        const float rstd = 1.0f / sqrtf(var + RMS_EPS);
        const bf16_t* vp = Z1 + (tok0 + j) * Z1P + 2048 + 128 * g + cq;
#pragma unroll
        for (int k = 0; k < 4; ++k) {
            const u32x4 w = *(const u32x4*)(vp + 8 * k);
            const int cc = 128 * g + cq + 8 * k;
            const f32x4 g0 = *(const f32x4*)(lng + cc), g1 = *(const f32x4*)(lng + cc + 4), b0 = *(const f32x4*)(lnb + cc), b1 = *(const f32x4*)(lnb + cc + 4);
            float x[8] = {pg8::bf_lo(w.x), pg8::bf_hi(w.x), pg8::bf_lo(w.y), pg8::bf_hi(w.y), pg8::bf_lo(w.z), pg8::bf_hi(w.z), pg8::bf_lo(w.w), pg8::bf_hi(w.w)};
            float y[8];
#pragma unroll
            for (int i = 0; i < 4; ++i) { y[i] = (x[i] - mu) * rstd * g0[i] + b0[i]; y[4 + i] = (x[4 + i] - mu) * rstd * g1[i] + b1[i]; }
            u32x4 o; o.x = cvtpk(y[0], y[1]); o.y = cvtpk(y[2], y[3]); o.z = cvtpk(y[4], y[5]); o.w = cvtpk(y[6], y[7]);
            *(MLAS u32x4*)(vn + j * VP + cq + 8 * k) = o;
        }
    }
    LGKM_BAR();
    MLAS bf16_t* ut = (MLAS bf16_t*)(L + 128 * VP * 2);
    {
        const int j = tid >> 2, cq = (tid & 3) * 32;
        const bf16_t* up = Z1 + (tok0 + j) * Z1P + 1536 + 128 * g + cq;
#pragma unroll
        for (int k = 0; k < 4; ++k) *(MLAS u32x4*)(ut + j * VP + cq + 8 * k) = *(const u32x4*)(up + 8 * k);
    }
    LGKM_BAR();
    const int ib = wid & 3;
    const bf16_t* wrow = Wm + ((size_t)g * 128 + 32 * ib + r32) * 128 + 8 * hi;
    bf16x8 af[8];
#pragma unroll
    for (int s = 0; s < 8; ++s) af[s] = *(const bf16x8*)(wrow + 16 * s);
#pragma unroll
    for (int cbi = 0; cbi < 2; ++cbi) {
        const int cb = (wid >> 2) * 2 + cbi;
        f32x16 acc = {};
        lds_cptr bp = (lds_cptr)(vn) + ((size_t)(8 * hi + ((lane & 15) >> 2)) * VP + 32 * cb + 16 * ((lane >> 4) & 1) + 4 * (lane & 3)) * 2;
#pragma unroll
        for (int s = 0; s < 8; ++s) {
            const s16x4 lo = vtr(bp + (16 * s) * VP * 2), hh = vtr(bp + (16 * s + 4) * VP * 2);
            const bf16x8 bfr = {lo[0], lo[1], lo[2], lo[3], hh[0], hh[1], hh[2], hh[3]};
            acc = __builtin_amdgcn_mfma_f32_32x32x16_bf16(af[s], bfr, acc, 0, 0, 0);
        }
        float a16[16]; V16_TO_ARR(acc, a16, 0);
#pragma unroll
        for (int r = 0; r < 16; ++r) {
            const int i = 32 * ib + crow(r, hi), cc = 32 * cb + r32;
            const float uu = __builtin_bit_cast(float, (unsigned)ut[i * VP + cc] << 16);
            const float o = uu * (a16[r] + bs[g * 128 + i]);
            ut[i * VP + cc] = (bf16_t)(cvtpk(o, 0.f) & 0xffffu);
        }
    }
    LGKM_BAR();
    {
        const int j = tid >> 2, cq = (tid & 3) * 32;
        bf16_t* yp = Y + (tok0 + j) * DMODEL + 512 + 128 * g + cq;
#pragma unroll
        for (int k = 0; k < 4; ++k) *(u32x4*)(yp + 8 * k) = *(const MLAS u32x4*)(ut + j * VP + cq + 8 * k);
    }
    LGKM_BAR();
}

__device__ __forceinline__ void pool_item(int item, const bf16_t* Z0, bf16_t* Y) {
    const int row = item >> 6, ch = item & 63, c0 = ch * 8, g = ch >> 4;
    const int w = 2 << g, tpos = row & (SEQ - 1);
    const int cnt = (tpos + 1 < w) ? tpos + 1 : w;
    u32x4 v[16];
#pragma unroll
    for (int k = 0; k < 16; ++k) { v[k] = (u32x4){0u, 0u, 0u, 0u}; if (k < cnt) v[k] = *(const u32x4*)(Z0 + (size_t)(row - k) * EV_N + c0); }
    float s[8] = {0.f, 0.f, 0.f, 0.f, 0.f, 0.f, 0.f, 0.f};
#pragma unroll
    for (int k = 0; k < 16; ++k) {
        s[0] += pg8::bf_lo(v[k].x); s[1] += pg8::bf_hi(v[k].x); s[2] += pg8::bf_lo(v[k].y); s[3] += pg8::bf_hi(v[k].y);
        s[4] += pg8::bf_lo(v[k].z); s[5] += pg8::bf_hi(v[k].z); s[6] += pg8::bf_lo(v[k].w); s[7] += pg8::bf_hi(v[k].w);
    }
    const float self[8] = {pg8::bf_lo(v[0].x), pg8::bf_hi(v[0].x), pg8::bf_lo(v[0].y), pg8::bf_hi(v[0].y), pg8::bf_lo(v[0].z), pg8::bf_hi(v[0].z), pg8::bf_lo(v[0].w), pg8::bf_hi(v[0].w)};
    const float inv = 1.0f / (float)cnt;
    u32x4 o; o.x = cvtpk(s[0] * inv - self[0], s[1] * inv - self[1]); o.y = cvtpk(s[2] * inv - self[2], s[3] * inv - self[3]);
    o.z = cvtpk(s[4] * inv - self[4], s[5] * inv - self[5]); o.w = cvtpk(s[6] * inv - self[6], s[7] * inv - self[7]);
    *(u32x4*)(Y + (size_t)row * DMODEL + c0) = o;
}
}
namespace foxa {
using bf16=__hip_bfloat16;
using bf16x8=__attribute__((ext_vector_type(8)))short;
using s16x4=__attribute__((ext_vector_type(4)))short;
using f32x16=__attribute__((ext_vector_type(16)))float;
using u32x4=__attribute__((ext_vector_type(4)))unsigned;
using f32x4v=__attribute__((ext_vector_type(4)))float;
constexpr int CUM_OFF=86016;
constexpr int SEQL=2048,D=64,OPI=1024;
constexpr int NW=8,QBLK=32,QB=QBLK*NW,KVBLK=64;
__device__ __forceinline__ int crow(int r,int hi){return (r&3)+8*(r>>2)+4*hi;}
#define SBAR() __builtin_amdgcn_sched_barrier(0)
__device__ __forceinline__ void cmask(f32x16&p0,f32x16&p1,int jb,int qrel,int hi){
  const float NEG=-INFINITY; int kb=64*jb+4*hi;
  #pragma unroll
  for(int r=0;r<16;++r){int kv=kb+(r&3)+8*(r>>2); if(kv>qrel)p0[r]=NEG; if(kv+32>qrel)p1[r]=NEG;}
}

constexpr int NSLOT=3, SLOTB=8192;
constexpr int LDS_K=0, LDS_V=NSLOT*SLOTB, LDS_WS=2*NSLOT*SLOTB, LDS_OST=LDS_WS+NW*64*4, LDS_BYTES=LDS_OST+NW*4096;
constexpr float C2=0.125f*1.4426950408889634f;
__device__ __forceinline__ void glds16(const void*gsrc,unsigned lds_dst){unsigned keep;
  asm volatile("s_mov_b32 %0, m0\n\ts_mov_b32 m0, %2\n\ts_nop 0\n\tglobal_load_lds_dwordx4 %1, off\n\ts_mov_b32 m0, %0":"=&s"(keep):"v"(gsrc),"s"(lds_dst):"memory");}
__device__ __forceinline__ float max3f(float a,float b,float c){float r;asm("v_max3_f32 %0, %1, %2, %3":"=v"(r):"v"(a),"v"(b),"v"(c));return r;}
__device__ __forceinline__ float max2f(float a,float b){float r;asm("v_max_f32_e32 %0, %1, %2":"=v"(r):"v"(a),"v"(b));return r;}
__device__ __forceinline__ float fadd_s(float a,float b){float r;asm("v_add_f32_e32 %0, %1, %2":"=v"(r):"v"(a),"v"(b));return r;}
__device__ __forceinline__ float fsub_s(float a,float b){float r;asm("v_sub_f32_e32 %0, %1, %2":"=v"(r):"v"(a),"v"(b));return r;}
typedef float f32x2_t __attribute__((ext_vector_type(2))); typedef __bf16 bf16x2_t __attribute__((ext_vector_type(2)));
__device__ __forceinline__ unsigned cvtpk_s(float lo,float hi){f32x2_t v={lo,hi};bf16x2_t b=__builtin_convertvector(v,bf16x2_t);return __builtin_bit_cast(unsigned,b);}
#define WAIT_BAR(N) asm volatile("s_waitcnt vmcnt(" #N ") lgkmcnt(0)\n\ts_barrier":::"memory")

__device__ __forceinline__ void qkt(f32x16&p0,f32x16&p1,const char*Kslot,const bf16x8*qr,const f32x16&negm,int r32,int hi){
  const char*kb=Kslot+hi*1024+r32*16;
  #pragma unroll
  for(int d0=0;d0<4;++d0){
    const bf16x8 b0=*reinterpret_cast<const bf16x8*>(kb+d0*2048);
    const bf16x8 b1=*reinterpret_cast<const bf16x8*>(kb+d0*2048+512);
    if(d0==0){p0=__builtin_amdgcn_mfma_f32_32x32x16_bf16(b0,qr[0],negm,0,0,0);p1=__builtin_amdgcn_mfma_f32_32x32x16_bf16(b1,qr[0],negm,0,0,0);}
    else{p0=__builtin_amdgcn_mfma_f32_32x32x16_bf16(b0,qr[d0],p0,0,0,0);p1=__builtin_amdgcn_mfma_f32_32x32x16_bf16(b1,qr[d0],p1,0,0,0);}}
}
typedef __attribute__((address_space(3))) const char* lds_cptr;
typedef short v4i16_t __attribute__((ext_vector_type(4)));
__device__ __forceinline__ void kload8(bf16x8*kf,lds_cptr kp){
  kf[0]=*(const __attribute__((address_space(3))) bf16x8*)(kp);      kf[1]=*(const __attribute__((address_space(3))) bf16x8*)(kp+512);
  kf[2]=*(const __attribute__((address_space(3))) bf16x8*)(kp+2048); kf[3]=*(const __attribute__((address_space(3))) bf16x8*)(kp+2560);
  kf[4]=*(const __attribute__((address_space(3))) bf16x8*)(kp+4096); kf[5]=*(const __attribute__((address_space(3))) bf16x8*)(kp+4608);
  kf[6]=*(const __attribute__((address_space(3))) bf16x8*)(kp+6144); kf[7]=*(const __attribute__((address_space(3))) bf16x8*)(kp+6656);
}
__device__ __forceinline__ void kload2(bf16x8*kf,lds_cptr kp,int j){ kf[2*j]=*(const __attribute__((address_space(3))) bf16x8*)(kp+j*2048); kf[2*j+1]=*(const __attribute__((address_space(3))) bf16x8*)(kp+j*2048+512); }
__device__ __forceinline__ s16x4 vtr(lds_cptr p){ return __builtin_bit_cast(s16x4,__builtin_amdgcn_ds_read_tr16_b64_v4i16((__attribute__((address_space(3))) v4i16_t*)p)); }
__device__ __forceinline__ float rowmax(const f32x16&p0,const f32x16&p1){
  float a=max3f(p0[0],p0[1],p1[0]),b=max3f(p0[2],p0[3],p1[1]);a=max3f(a,p1[2],p1[3]);
  #pragma unroll
  for(int r=4;r<16;r+=4){a=max3f(a,p0[r],p0[r+1]);b=max3f(b,p0[r+2],p0[r+3]);a=max3f(a,p1[r],p1[r+1]);b=max3f(b,p1[r+2],p1[r+3]);}
  const float m=max2f(a,b);
  auto rr=__builtin_amdgcn_permlane32_swap(__float_as_uint(m),__float_as_uint(m),false,false);
  return max2f(__uint_as_float(rr[0]),__uint_as_float(rr[1]));
}
__device__ __forceinline__ void pv(f32x16*o,int vb,bf16x8 pa0,bf16x8 pa1,bf16x8 pa2,bf16x8 pa3){
  #pragma unroll
  for(int d0=0;d0<2;++d0){s16x4 lo[4],hi[4];
    #pragma unroll
    for(int ks=0;ks<4;++ks){
      asm volatile("ds_read_b64_tr_b16 %0,%1 offset:%c2":"=&v"(lo[ks]):"v"(vb),"i"(d0*4096+ks*1024):"memory");
      asm volatile("ds_read_b64_tr_b16 %0,%1 offset:%c2":"=&v"(hi[ks]):"v"(vb),"i"(d0*4096+ks*1024+512):"memory");}
    asm volatile("s_waitcnt lgkmcnt(0)":::"memory");SBAR();
    #define PK(k) (bf16x8){lo[k][0],lo[k][1],lo[k][2],lo[k][3],hi[k][0],hi[k][1],hi[k][2],hi[k][3]}
    o[d0]=__builtin_amdgcn_mfma_f32_32x32x16_bf16(pa0,PK(0),o[d0],0,0,0);
    o[d0]=__builtin_amdgcn_mfma_f32_32x32x16_bf16(pa1,PK(1),o[d0],0,0,0);
    o[d0]=__builtin_amdgcn_mfma_f32_32x32x16_bf16(pa2,PK(2),o[d0],0,0,0);
    o[d0]=__builtin_amdgcn_mfma_f32_32x32x16_bf16(pa3,PK(3),o[d0],0,0,0);
    #undef PK
  }
}

#ifndef ATTN_STORE16
#define ATTN_STORE16(p,v) (*(u32x4*)(p)=(v))
#endif
template<int THRL,int MODE,int QKVP,class CumFn> __device__ __forceinline__ void attn_unit(CumFn&& CUMFN,int b,int h,int qb,int q0abs,int NTU,const bf16*Q,const bf16*__restrict__ K,const bf16*__restrict__ V,bf16*O,char*shm,const __attribute__((address_space(3))) unsigned*selw,const int wave_s){
  const int tid=wave_s*64+lane_opaque(),lane=tid&63,r32=lane&31,hi=lane>>5; const int wid=__builtin_amdgcn_readfirstlane(tid>>6);
  const long rowbase=(long)b*SEQL; const int q0=(MODE==0)?qb*QB:q0abs;
  const bf16*Qw=(MODE==0)?Q+(rowbase+q0+wid*QBLK)*QKVP+h*D:Q+(rowbase+q0)*QKVP+wid*D;
  const bf16*Kh=K+rowbase*QKVP+h*D,*Vh=V+rowbase*QKVP+h*D;
  const unsigned lds0=(unsigned)(uintptr_t)shm;
  float*wsf=(float*)(shm+LDS_WS)+wid*64;
  const bf16*ksrc=Kh+(long)lane*QKVP+wid*8;
  const bf16*vsrc=Vh+(long)(16*(wid&3)+(lane>>2))*QKVP+(wid>>2)*32+(lane&3)*8;
  const unsigned kdst=lds0+LDS_K+wid*1024, vdst=lds0+LDS_V+wid*1024;
  #define DMA_K(t,slot) glds16(ksrc+(long)(t)*KVBLK*QKVP,(unsigned)__builtin_amdgcn_readfirstlane(kdst+(slot)))
  #define DMA_V(t,slot) glds16(vsrc+(long)(t)*KVBLK*QKVP,(unsigned)__builtin_amdgcn_readfirstlane(vdst+(slot)))
  const int vb0=(int)(lds0+LDS_V)+((lane>>4)&1)*32+(lane&3)*8+(4*hi+((lane&15)>>2))*64;
  const char*Kbase=shm+LDS_K; bf16x8 kf[8];
  const lds_cptr shm3=(lds_cptr)shm; const lds_cptr kp0=shm3+LDS_K+hi*1024+r32*16; const lds_cptr vp0=shm3+LDS_V+((lane>>4)&1)*32+(lane&3)*8+(4*hi+((lane&15)>>2))*64;
  const int NT=(MODE==0)?(q0+QB)/KVBLK:NTU;
  DMA_K(0,0);DMA_V(0,0);DMA_K(1,SLOTB);
  if constexpr(MODE==0){ CUMFN(); }
  bf16x8 qr[4];
  #pragma unroll
  for(int d0=0;d0<4;++d0)qr[d0]=*reinterpret_cast<const bf16x8*>(&Qw[(long)r32*QKVP+d0*16+hi*8]);
  float mhat=0.f,l_reg=0.f;float z_=0.f;asm volatile("":"+v"(z_));f32x16 o[2];o[0]=(f32x16){z_,z_,z_,z_,z_,z_,z_,z_,z_,z_,z_,z_,z_,z_,z_,z_};o[1]=o[0];f32x16 negm=o[0];asm volatile("":"+v"(negm));
  const int qrel=wid*QBLK+r32;
  const __attribute__((address_space(3))) float*cum2=(const __attribute__((address_space(3))) float*)(shm+CUM_OFF);
  const float cq2=(MODE==0)?cum2[q0+qrel]:0.f;
  #define BIAS(P0,P1,t) do{ if constexpr(MODE==0){ const __attribute__((address_space(3))) float*cb_=cum2+64*(t)+4*hi; \
    _Pragma("unroll") for(int g_=0;g_<4;++g_){ const f32x4v c0_=*(const __attribute__((address_space(3))) f32x4v*)(cb_+8*g_), c1_=*(const __attribute__((address_space(3))) f32x4v*)(cb_+32+8*g_); \
      P0[4*g_+0]+=cq2-c0_.x; P0[4*g_+1]+=cq2-c0_.y; P0[4*g_+2]+=cq2-c0_.z; P0[4*g_+3]+=cq2-c0_.w; \
      P1[4*g_+0]+=cq2-c1_.x; P1[4*g_+1]+=cq2-c1_.y; P1[4*g_+2]+=cq2-c1_.z; P1[4*g_+3]+=cq2-c1_.w; } } }while(0)
  #define SELM(P0,P1,t) do{ if constexpr(MODE==1){ const unsigned w0_=selw[(2*(t))*32+r32]>>(4*hi), w1_=selw[(2*(t)+1)*32+r32]>>(4*hi); \
    _Pragma("unroll") for(int r=0;r<16;++r){ const int sh_=(r&3)+8*(r>>2); if(!((w0_>>sh_)&1u))P0[r]=-INFINITY; if(!((w1_>>sh_)&1u))P1[r]=-INFINITY; } } }while(0)
  #define CMASK(P0,P1,t) do{ if constexpr(MODE==0){int jb_=(t)-(NT-4); if(jb_>=0)cmask(P0,P1,jb_,qrel,hi);} }while(0)
  bool resc=false;
  #define START(P0,P1) do{ const float rm=rowmax(P0,P1); resc=false; \
    { const float dl=(MODE==1&&!(rm>-1e30f))?0.f:rm; mhat=fadd_s(mhat,dl); \
      _Pragma("unroll") for(int r=0;r<16;++r){P0[r]=fsub_s(P0[r],dl);P1[r]=fsub_s(P1[r],dl);} \
      _Pragma("unroll") for(int r=0;r<16;++r)negm[r]=-mhat; asm volatile("":"+v"(negm)); } \
    _Pragma("unroll") for(int r=0;r<16;++r)P0[r]=__builtin_amdgcn_exp2f(P0[r]); }while(0)
  #define RESC() do{ if(resc){ asm volatile("s_waitcnt lgkmcnt(0)":::"memory"); \
      _Pragma("unroll") for(int d_=0;d_<2;++d_) _Pragma("unroll") for(int r=0;r<16;++r)o[d_][r]*=wsf[crow(r,hi)]; } }while(0)
  f32x16 pA0,pA1,pB0,pB1;
  int sl_prev=0,sl_cur=0,sl_next=SLOTB;
  #define ROT() do{sl_prev=sl_cur;sl_cur=sl_next;sl_next=(sl_next==(NSLOT-1)*SLOTB)?0:sl_next+SLOTB;}while(0)
  DMA_K(2,2*SLOTB);
  WAIT_BAR(3);
  qkt(pA0,pA1,Kbase,qr,negm,r32,hi);asm volatile("s_nop 15\n\ts_nop 7":"+v"(pA0),"+v"(pA1));BIAS(pA0,pA1,0);SELM(pA0,pA1,0);CMASK(pA0,pA1,0);
  START(pA0,pA1);
  _Pragma("unroll") for(int r=0;r<16;++r)pA1[r]=__builtin_amdgcn_exp2f(pA1[r]);
  WAIT_BAR(0);
  DMA_K(3,0);DMA_V(1,SLOTB);
  ROT();
  kload8(kf,kp0+sl_cur);
  WAIT_BAR(2);
  s16x4 vlo[8],vhi[8]; u32x4 pw0,pw1,pw2,pw3;
  #define PKW(P,B) cvtpk_s(P[B],P[B+1])
  #define PAF(k) __builtin_bit_cast(bf16x8,pw##k)
  #define VFR(i) (bf16x8){vlo[i][0],vlo[i][1],vlo[i][2],vlo[i][3],vhi[i][0],vhi[i][1],vhi[i][2],vhi[i][3]}
  #define PIN(x) asm volatile("":"+v"(x))
  #define MX3(a,b,c) __builtin_fmaxf(__builtin_fmaxf((a),(b)),(c))
  #define GAPA(MF,A0,A1,A2,A3,W0,W1,PW) do{ MF; sacc+=A0; sacc+=A1; sacc+=A2; sacc+=A3; PIN(sacc); W0; W1; PIN(PW); SBAR(); }while(0)
  #define EX(v) __builtin_amdgcn_exp2f(v)
  #define GAPB(MF,X,B) do{ MF; X[B]=EX(X[B]); X[B+1]=EX(X[B+1]); X[B+2]=EX(X[B+2]); X[B+3]=EX(X[B+3]); PIN(X); SBAR(); }while(0)
  #define VRD(i) do{ vlo[i]=vtr(vp_+(((i)>>2)*4096+((i)&3)*1024)); vhi[i]=vtr(vp_+(((i)>>2)*4096+((i)&3)*1024+512)); }while(0)
  #define KRD(G,j) do{ if(G){ kload2(kf,kp0+sl_next,j); SBAR(); } }while(0)
  #define STEP(C0,C1,P0,P1,t,GK,GV,GL) do{ SBAR(); \
    const lds_cptr vp_=vp0+sl_prev; \
    VRD(0); SBAR(); float sacc=(P0[0]+P0[1]); \
    GAPA(C0=__builtin_amdgcn_mfma_f32_32x32x16_bf16(kf[0],qr[0],negm,0,0,0), P0[2],P0[3],P0[4],P0[5],     pw0[0]=PKW(P0,0), pw0[1]=PKW(P0,2), pw0); \
    VRD(4); SBAR(); GAPA(C1=__builtin_amdgcn_mfma_f32_32x32x16_bf16(kf[1],qr[0],negm,0,0,0), P0[6],P0[7],P0[8],P0[9],     pw0[2]=PKW(P0,4), pw0[3]=PKW(P0,6), pw0); \
    VRD(1); SBAR(); GAPA(C0=__builtin_amdgcn_mfma_f32_32x32x16_bf16(kf[2],qr[1],C0,0,0,0),   P0[10],P0[11],P0[12],P0[13], pw1[0]=PKW(P0,8), pw1[1]=PKW(P0,10), pw1); \
    VRD(5); SBAR(); GAPA(C1=__builtin_amdgcn_mfma_f32_32x32x16_bf16(kf[3],qr[1],C1,0,0,0),   P0[14],P0[15],P1[0],P1[1],   pw1[2]=PKW(P0,12),pw1[3]=PKW(P0,14), pw1); \
    VRD(2); SBAR(); GAPA(C0=__builtin_amdgcn_mfma_f32_32x32x16_bf16(kf[4],qr[2],C0,0,0,0),   P1[2],P1[3],P1[4],P1[5],     pw2[0]=PKW(P1,0), pw2[1]=PKW(P1,2), pw2); \
    VRD(6); SBAR(); GAPA(C1=__builtin_amdgcn_mfma_f32_32x32x16_bf16(kf[5],qr[2],C1,0,0,0),   P1[6],P1[7],P1[8],P1[9],     pw2[2]=PKW(P1,4), pw2[3]=PKW(P1,6), pw2); \
    VRD(3); SBAR(); GAPA(C0=__builtin_amdgcn_mfma_f32_32x32x16_bf16(kf[6],qr[3],C0,0,0,0),   P1[10],P1[11],P1[12],P1[13], pw3[0]=PKW(P1,8), pw3[1]=PKW(P1,10), pw3); \
    VRD(7); SBAR(); GAPA(C1=__builtin_amdgcn_mfma_f32_32x32x16_bf16(kf[7],qr[3],C1,0,0,0),   P1[14],P1[15],0.f,0.f,       pw3[2]=PKW(P1,12),pw3[3]=PKW(P1,14), pw3); \
    l_reg+=sacc; \
    if(GK){DMA_K((t)+3,sl_cur);} if(GV){DMA_V((t)+1,sl_next);} \
    BIAS(C0,C1,t); SELM(C0,C1,t); CMASK(C0,C1,t); \
    { float a=MX3(C0[0],C0[1],C1[0]),b=MX3(C0[2],C0[3],C1[1]); a=MX3(a,C1[2],C1[3]); \
      _Pragma("unroll") for(int r=4;r<16;r+=4){a=MX3(a,C0[r],C0[r+1]);b=MX3(b,C0[r+2],C0[r+3]);a=MX3(a,C1[r],C1[r+1]);b=MX3(b,C1[r+2],C1[r+3]);} \
      float rm=__builtin_fmaxf(a,b); { auto rr=__builtin_amdgcn_permlane32_swap(__float_as_uint(rm),__float_as_uint(rm),false,false); rm=__builtin_fmaxf(__uint_as_float(rr[0]),__uint_as_float(rr[1])); } \
      resc=false; \
      if(__builtin_expect(__any(rm>(float)THRL),0)){ const float dl=__builtin_fmaxf(rm,0.f); mhat+=dl; \
        _Pragma("unroll") for(int r=0;r<16;++r){C0[r]-=dl;C1[r]-=dl;} \
        _Pragma("unroll") for(int r=0;r<16;++r)negm[r]=-mhat; asm volatile("":"+v"(negm)); \
        const float f=__builtin_amdgcn_exp2f(-dl); l_reg*=f; if(hi==0)wsf[r32]=f; resc=true; } } \
    SBAR(); \
    GAPB(o[0]=__builtin_amdgcn_mfma_f32_32x32x16_bf16(PAF(0),VFR(0),o[0],0,0,0), C0,0); \
    GAPB(o[1]=__builtin_amdgcn_mfma_f32_32x32x16_bf16(PAF(0),VFR(4),o[1],0,0,0), C0,4); \
    KRD(GL,0); GAPB(o[0]=__builtin_amdgcn_mfma_f32_32x32x16_bf16(PAF(1),VFR(1),o[0],0,0,0), C0,8); \
    KRD(GL,1); GAPB(o[1]=__builtin_amdgcn_mfma_f32_32x32x16_bf16(PAF(1),VFR(5),o[1],0,0,0), C0,12); \
    KRD(GL,2); GAPB(o[0]=__builtin_amdgcn_mfma_f32_32x32x16_bf16(PAF(2),VFR(2),o[0],0,0,0), C1,0); \
    KRD(GL,3); GAPB(o[1]=__builtin_amdgcn_mfma_f32_32x32x16_bf16(PAF(2),VFR(6),o[1],0,0,0), C1,4); \
    GAPB(o[0]=__builtin_amdgcn_mfma_f32_32x32x16_bf16(PAF(3),VFR(3),o[0],0,0,0), C1,8); \
    GAPB(o[1]=__builtin_amdgcn_mfma_f32_32x32x16_bf16(PAF(3),VFR(7),o[1],0,0,0), C1,12); \
    }while(0)
  int t=1;
  #undef CMASK
  #define CMASK(P0,P1,t) do{}while(0)
  for(;t+5<NT;t+=2){
    STEP(pB0,pB1,pA0,pA1,t,true,true,true);     WAIT_BAR(2); RESC(); ROT();
    STEP(pA0,pA1,pB0,pB1,t+1,true,true,true);   WAIT_BAR(2); RESC(); ROT();
  }
  #undef CMASK
  #define CMASK(P0,P1,t) do{ if constexpr(MODE==0){int jb_=(t)-(NT-4); if(jb_>=0)cmask(P0,P1,jb_,qrel,hi);} }while(0)
  #define ENDW(tt) do{ if((tt)+3<NT){WAIT_BAR(2);} else if((tt)+2<NT){WAIT_BAR(1);} else {WAIT_BAR(0);} }while(0)
  for(;t+1<NT;t+=2){
    STEP(pB0,pB1,pA0,pA1,t,(t+3<NT),(t+1<NT),(t+1<NT));       ENDW(t);   RESC(); ROT();
    STEP(pA0,pA1,pB0,pB1,t+1,(t+4<NT),(t+2<NT),(t+2<NT));     ENDW(t+1); RESC(); ROT();
  }
  STEP(pB0,pB1,pA0,pA1,NT-1,false,false,false); RESC();
  { float sacc=pB0[0]+pB0[1]; _Pragma("unroll") for(int r=2;r<16;++r)sacc+=pB0[r]; _Pragma("unroll") for(int r=0;r<16;++r)sacc+=pB1[r]; l_reg+=sacc;
    pw0=(u32x4){PKW(pB0,0),PKW(pB0,2),PKW(pB0,4),PKW(pB0,6)};pw1=(u32x4){PKW(pB0,8),PKW(pB0,10),PKW(pB0,12),PKW(pB0,14)};pw2=(u32x4){PKW(pB1,0),PKW(pB1,2),PKW(pB1,4),PKW(pB1,6)};pw3=(u32x4){PKW(pB1,8),PKW(pB1,10),PKW(pB1,12),PKW(pB1,14)};
    SBAR(); pv(o,vb0+sl_cur,PAF(0),PAF(1),PAF(2),PAF(3)); }
  #undef PKW
  #undef PAF
  #undef VFR
  #undef PIN
  #undef MX3
  #undef GAPA
  #undef GAPB
  #undef EX
  #undef VRD
  #undef KRD
  #undef STEP
  #undef ENDW
  {auto rr=__builtin_amdgcn_permlane32_swap(__float_as_uint(l_reg),__float_as_uint(l_reg),false,false);l_reg=__uint_as_float(rr[0])+__uint_as_float(rr[1]);}
  if(hi==0)wsf[32+r32]=l_reg;asm volatile("s_waitcnt lgkmcnt(0)":::"memory");
  float rli[16];
  #pragma unroll
  for(int r=0;r<16;++r)rli[r]=__builtin_amdgcn_rcpf(wsf[32+crow(r,hi)]);
  bf16*Ow=(MODE==0)?O+(rowbase+q0+wid*QBLK)*OPI+h*D:O+(rowbase+q0)*OPI+wid*D;
  { bf16*stg=(bf16*)(shm+LDS_OST)+wid*2048;
    #pragma unroll
    for(int r=0;r<16;++r){const int orow=crow(r,hi);
      #pragma unroll
      for(int d0=0;d0<2;++d0)stg[orow*64+d0*32+r32]=__float2bfloat16(o[d0][r]*rli[r]);}
    asm volatile("s_waitcnt lgkmcnt(0)":::"memory");
    #pragma unroll
    for(int i=0;i<4;++i){const int row=i*8+(lane>>3),ch=lane&7; const u32x4 v=*(const u32x4*)(stg+row*64+ch*8); ATTN_STORE16(Ow+(long)row*OPI+ch*8,v);} }
  asm volatile("s_waitcnt lgkmcnt(0)\n\ts_barrier":::"memory");
  #undef DMA_K
  #undef DMA_V
  #undef CMASK
  #undef START
  #undef BIAS
  #undef SELM
  #undef RESC
  #undef ROT
}
#undef SBAR
#undef WAIT_BAR
}

#ifndef DBG_REP_SEL
#define DBG_REP_SEL 1
#endif
namespace mix {
__device__ __forceinline__ void fox_unit2(int b, int h, int qb, const bf16_t* Z1, const float* F, const float* bfp, bf16_t* Y, char* shm, const int wave_s) {
    const size_t rowb = (size_t)b * SEQ;
    const int nk = 256 * (qb + 1);
    auto cumfn = [=]() {
        const int tid = wave_s * 64 + lane_opaque(), lane = tid & 63; const int wid = __builtin_amdgcn_readfirstlane(tid >> 6);
        MLAS char* L = (MLAS char*)shm;
        MLAS float* cum2 = (MLAS float*)(L + foxa::CUM_OFF);
        MLAS float* wtot = (MLAS float*)(L + foxa::CUM_OFF + 8192);
        const float bias = bfp[h];
        const int s0 = 4 * tid;
        float v[4]; float run = 0.f;
#pragma unroll
        for (int i = 0; i < 4; ++i) {
            float x = 0.f;
            if (s0 + i < nk) x = F[(rowb + s0 + i) * 8 + h] + bias;
            const float ls = (s0 + i < nk) ? (fminf(x, 0.f) - log1pf(expf(-fabsf(x)))) : 0.f;
            run += ls; v[i] = run;
        }
        float inc = run;
#pragma unroll
        for (int o = 1; o < 64; o <<= 1) { const int ln = lane_opaque(); const float t = __builtin_bit_cast(float, __builtin_amdgcn_ds_bpermute((ln - o) << 2, __builtin_bit_cast(int, inc))); if (ln >= o) inc += t; }
        if (lane == 63) wtot[wid] = inc;
        LGKM_BAR();
        float off = inc - run;
        for (int w = 0; w < wid; ++w) off += wtot[w];
#pragma unroll
        for (int i = 0; i < 4; ++i) cum2[s0 + i] = (off + v[i]) * 1.4426950408889634f;
        LGKM_BAR();
    };
    foxa::attn_unit<8, 0, 2560>(cumfn, b, h, qb, 0, 0, (const foxa::bf16*)Z1, (const foxa::bf16*)(Z1 + 512), (const foxa::bf16*)(Z1 + 1024), (foxa::bf16*)Y, shm, nullptr, wave_s);
}
__device__ __forceinline__ void dsa_unit(int b, int qg, const bf16_t* Z0, bf16_t* Y, char* shm, unsigned lds0, const int wave_s) {
    for (int rep_ = 0; rep_ < DBG_REP_SEL; ++rep_) dsa_select(b, qg, Z0, shm, wave_s);
    const int nt64 = (qg >> 1) + 1; int ntu = (nt64 + 1) & ~1; if (ntu < 4) ntu = 4;
    foxa::attn_unit<8, 1, EV_N>([]() {}, b, 0, 0, 32 * qg, ntu, (const foxa::bf16*)(Z0 + 512), (const foxa::bf16*)(Z0 + 1024), (const foxa::bf16*)(Z0 + 1088), (foxa::bf16*)(Y + 512), shm,
                                (const MLAS unsigned*)((MLAS char*)shm + LX_SEL), wave_s);
}
}
constexpr int NWAVES = 8;
constexpr size_t KiB = 1024, MiB = 1u << 20;
constexpr size_t WS_CTL = 0, CTL_ZERO_BYTES = 1 * MiB;
constexpr size_t WS_W_EVIN = 1 * MiB, WS_W_OUT0 = 4 * MiB, WS_W_FFI0 = 6 * MiB, WS_W_FFO0 = 17 * MiB, WS_W_PG0 = 22 * MiB + 512 * KiB, WS_W_PP0 = 24 * MiB + 512 * KiB;
constexpr size_t WS_W_ODIN = 25 * MiB, WS_W_OUT1 = 30 * MiB + 512 * KiB, WS_W_FFI1 = 32 * MiB + 512 * KiB, WS_W_FFO1 = 43 * MiB + 512 * KiB, WS_W_PG1 = 49 * MiB, WS_W_PP1 = 51 * MiB, WS_W_SGU = 51 * MiB + 512 * KiB;
constexpr size_t WS_RSTD = 57 * MiB + 768 * KiB;
constexpr size_t WS_SSQA = 52 * MiB, WS_SSQB = 53 * MiB, WS_ROPE = 54 * MiB, WS_AH = 55 * MiB, WS_FBUF = 58 * MiB + 512 * KiB, WS_SST = 59 * MiB;
constexpr size_t WS_HB = 60 * MiB, WS_AHALO = 92 * MiB, WS_PP = 92 * MiB + 512 * KiB, WS_Y = 124 * MiB + 512 * KiB, WS_ZH = 156 * MiB + 512 * KiB, WS_PB = 244 * MiB + 512 * KiB, WS_END = 252 * MiB + 512 * KiB;
static_assert(WS_AHALO == WS_HB + (size_t)TOK * 1024 * 2, "the halo rows are row tile 64 of the FFN in-projection A operand");
static_assert(WS_W_EVIN + (size_t)EV_N * 1024 * 2 <= WS_W_OUT0 && WS_W_FFI0 + (size_t)NFF2 * 1024 * 2 <= WS_W_FFO0 && WS_W_FFO0 + (size_t)1024 * DFF * 2 <= WS_W_PG0, "ws map 1");
static_assert(WS_W_ODIN + (size_t)OD_N * 1024 * 2 <= WS_W_OUT1 && WS_W_FFI1 + (size_t)NFF2 * 1024 * 2 <= WS_W_FFO1 && WS_W_FFO1 + (size_t)1024 * DFF * 2 <= WS_W_PG1 && WS_W_SGU + 4 * 128 * 128 * 2 <= WS_SSQA, "ws map 2");
static_assert(WS_AH + (size_t)128 * NFF2 * 4 <= WS_RSTD && WS_ZH + (size_t)TOK * DFF * 2 <= WS_PB && WS_PB + (size_t)TOK * PLE * 2 <= WS_END, "ws map 3");
constexpr int CW_BAR = 4096, CW_FLAG = 8192, CW_PAN = 16384;
constexpr int RING_BYTES = 131072, XB_OFF = RING_BYTES, LDSCTL_OFF = XB_OFF + 8192 + 1024 + 64, MISC_OFF = LDSCTL_OFF + 320, LDS_BYTES = 147456;
static_assert(MISC_OFF + 128 <= LDS_BYTES, "LDS map");

#define GAS __attribute__((address_space(1)))
#define LAS __attribute__((address_space(3)))
typedef unsigned short bf16;
typedef unsigned v4u __attribute__((ext_vector_type(4)));
typedef float f32x4 __attribute__((ext_vector_type(4)));
typedef float f32x2 __attribute__((ext_vector_type(2)));
#define LDS_WAIT() asm volatile("s_waitcnt lgkmcnt(0)" ::: "memory")
#define VM_WAIT() asm volatile("s_waitcnt vmcnt(0)" ::: "memory")
__device__ __forceinline__ unsigned f2bf(float f) { unsigned u = __builtin_bit_cast(unsigned, f); return (u + 0x7fffu + ((u >> 16) & 1u)) >> 16; }
__device__ __forceinline__ unsigned pk2(float lo, float hi) { return f2bf(lo) | (f2bf(hi) << 16); }

#define XB_TMO      128
#define XB_XCNT(j)  (256  + 64 * (j))
#define XB_XSUB(j)  (1280 + 64 * (j))
#define XB_XGEN(j)  (2304 + 64 * (j))
#define XB_TOP      3328
#define XB_TOPGEN   3392
#define XCD_BAR_WORDS 3456
#define XB_SPIN_CAP (1u << 18)
__device__ __forceinline__ unsigned xb_ld(unsigned* p)              { return __hip_atomic_load(p, __ATOMIC_RELAXED, __HIP_MEMORY_SCOPE_AGENT); }
__device__ __forceinline__ unsigned xb_add(unsigned* p, unsigned v) { return __hip_atomic_fetch_add(p, v, __ATOMIC_RELAXED, __HIP_MEMORY_SCOPE_AGENT); }
__device__ __forceinline__ unsigned xb_xcc_id() { return (unsigned)__builtin_amdgcn_s_getreg((3 << 11) | 20) & 0xFu; }
#define XB_SPIN(cond, bar) do { unsigned _sp = 0; while (cond) { __builtin_amdgcn_s_sleep(1); \
    if ((++_sp & 255u) == 0u) { if (xb_ld(&(bar)[XB_TMO])) break; if (_sp > XB_SPIN_CAP) { atomicAdd(&(bar)[XB_TMO], 1u); break; } } } } while (0)
struct XcdBarrier { unsigned* bar; unsigned x; volatile LAS unsigned* st; };
__device__ __forceinline__ XcdBarrier xcd_barrier_post(unsigned* bar, volatile LAS unsigned* st) {
    XcdBarrier b; b.bar = bar; b.x = xb_xcc_id(); b.st = st;
    if (threadIdx.x == 0) (void)xb_add(&bar[XB_XCNT(b.x)], 1u);
    return b;
}
__device__ __forceinline__ void xcd_barrier_complete(unsigned* bar, unsigned x, unsigned& nloc, unsigned& nx) {
    const unsigned G = gridDim.x * gridDim.y * gridDim.z;
    unsigned sum, cnt, mine, sp = 0u;
    for (;;) {
        sum = 0u; cnt = 0u; mine = 0u;
#pragma unroll 1
        for (unsigned j = 0; j < 16; ++j) { const unsigned c = xb_ld(&bar[XB_XCNT(j)]); sum += c; cnt += (c > 0u) ? 1u : 0u; mine = (j == x) ? c : mine; }
        if (sum == G) break;
        __builtin_amdgcn_s_sleep(1);
        if ((++sp & 255u) == 0u) { if (xb_ld(&bar[XB_TMO])) break; if (sp > XB_SPIN_CAP) { atomicAdd(&bar[XB_TMO], 1u); break; } }
    }
    nloc = mine > 0u ? mine : 1u; nx = cnt > 0u ? cnt : 1u;
}
__device__ __forceinline__ void xcd_barrier(const XcdBarrier& b) {
    asm volatile("s_waitcnt vmcnt(0)" ::: "memory");
    __syncthreads();
    if (threadIdx.x == 0) {
        unsigned* bar = b.bar;
        __builtin_amdgcn_s_waitcnt(0);
        unsigned nloc = b.st[0], nx = b.st[1];
        if (nloc == 0u) { xcd_barrier_complete(bar, b.x, nloc, nx); b.st[0] = nloc; b.st[1] = nx; }
        const unsigned old = xb_add(&bar[XB_XSUB(b.x)], 1u);
        const unsigned gen = old / nloc;
        if (old + 1u == (gen + 1u) * nloc) {
            __builtin_amdgcn_fence(__ATOMIC_RELEASE, "agent");
            asm volatile("s_waitcnt vmcnt(0)" ::: "memory");
            __builtin_amdgcn_fence(__ATOMIC_ACQUIRE, "agent");
            const unsigned og = xb_add(&bar[XB_TOP], 1u);
            const unsigned tg = og / nx;
            if (og + 1u == (tg + 1u) * nx) xb_add(&bar[XB_TOPGEN], 1u);
            else XB_SPIN(xb_ld(&bar[XB_TOPGEN]) == tg, bar);
            asm volatile("s_waitcnt vmcnt(0)" ::: "memory");
            xb_add(&bar[XB_XGEN(b.x)], 1u);
            asm volatile("s_waitcnt vmcnt(0)" ::: "memory");
        } else {
            __builtin_amdgcn_fence(__ATOMIC_ACQUIRE, "agent");
            XB_SPIN(xb_ld(&bar[XB_XGEN(b.x)]) == gen, bar);
            asm volatile("s_waitcnt vmcnt(0)" ::: "memory");
        }
    }
    __syncthreads();
}

__device__ __forceinline__ float wave_sum(float v) {
#pragma unroll
    for (int o = 1; o < 64; o <<= 1) v += __builtin_bit_cast(float, __builtin_amdgcn_ds_bpermute((lane_opaque() ^ o) << 2, __builtin_bit_cast(int, v)));
    return v;
}
__device__ __forceinline__ int vcu_of(int i, int n) { return i; }
__device__ __forceinline__ int unperm16(int d) { return d < 16 ? ((d >> 1) + 8 * (d & 1)) : d; }
__device__ __forceinline__ int map_col(int type, int n, int nold) {
    if (type == 0) return n < nold ? n : -1;
    if (type == 1) {
        if (n < 512) return n;
        if (n < 1024) { const int h = (n - 512) >> 6, d = (n - 512) & 63; return 512 + 64 * h + unperm16(d); }
        if (n < 1088) return 1024 + unperm16(n - 1024);
        if (n < 1152) return n;
        if (n < 1216) return 1408 + unperm16(n - 1152);
        if (n < 1220) return 1472 + (n - 1216);
        if (n < 1280) return -1;
        { const int h = (n - 1280) >> 6, d = (n - 1280) & 63; return 1152 + 64 * h + unperm16(d); }
    }
    if (type == 2) {
        if (n < 1536) return n;
        if (n < 2560) return n + 8;
        if (n < 2568) return 1536 + (n - 2560);
        return -1;
    }
    { const int pn = n >> 8, bj = (n >> 7) & 1, jj = n & 127; return bj * DFF + 128 * pn + jj; }
}
struct TJob { const float* W; const float* rowscale; bf16* WT; int K, Nold, Nnew, ldk, koff, type, nitems; };
__device__ __forceinline__ void transpose_item(const TJob& J, LAS float* scr, int item, int lane) {
    const int nblk = J.Nnew / 32, kb = item / nblk, nb = item % nblk, k0 = 64 * kb, n0 = 32 * nb;
    const int oc = map_col(J.type, n0 + (lane & 31), J.Nold);
    const int occ = oc >= 0 ? oc : 0;
    float vv[32];
#pragma unroll
    for (int i = 0; i < 32; ++i) vv[i] = J.W[(size_t)(k0 + 2 * i + (lane >> 5)) * J.Nold + occ];
#pragma unroll
    for (int i = 0; i < 32; ++i) { const int kk = 2 * i + (lane >> 5);
        float v = (oc >= 0) ? vv[i] : 0.f;
        if (J.rowscale) v *= J.rowscale[k0 + kk];
        scr[kk * 33 + (lane & 31)] = v; }
    LDS_WAIT(); asm volatile("" ::: "memory");
    const int c = lane & 7;
#pragma unroll
    for (int j = 0; j < 4; ++j) { const int n = (lane >> 3) + 8 * j; const LAS float* s = scr + (8 * c) * 33 + n;
        v4u o; o.x = pk2(s[0 * 33], s[1 * 33]); o.y = pk2(s[2 * 33], s[3 * 33]); o.z = pk2(s[4 * 33], s[5 * 33]); o.w = pk2(s[6 * 33], s[7 * 33]);
        *(GAS v4u*)(J.WT + (size_t)(n0 + n) * J.ldk + J.koff + k0 + 8 * c) = o; }
    LDS_WAIT(); asm volatile("" ::: "memory");
}
__device__ __forceinline__ void sincos_d(double a, float& sn, float& cs) {
    const double q = rint(a * 0.63661977236758134308);
    double r = a - q * 1.57079632673412561417e+00; r -= q * 6.07710050650619224932e-11;
    const double r2 = r * r;
    double s = 1.0 / 6227020800.0; s = s * r2 - 1.0 / 39916800.0; s = s * r2 + 1.0 / 362880.0; s = s * r2 - 1.0 / 5040.0; s = s * r2 + 1.0 / 120.0; s = s * r2 - 1.0 / 6.0; s = s * r2 * r + r;
    double c = -1.0 / 87178291200.0; c = c * r2 + 1.0 / 479001600.0; c = c * r2 - 1.0 / 3628800.0; c = c * r2 + 1.0 / 40320.0; c = c * r2 - 1.0 / 720.0; c = c * r2 + 1.0 / 24.0; c = c * r2 - 0.5; c = c * r2 + 1.0;
    const int qi = ((int)q) & 3;
    const double ss = (qi == 0) ? s : (qi == 1) ? c : (qi == 2) ? -s : -c;
    const double cc = (qi == 0) ? c : (qi == 1) ? -s : (qi == 2) ? -c : s;
    sn = (float)ss; cs = (float)cc;
}

struct Args { const void* in[24]; float* out; unsigned char* ws; int ph_lo, ph_hi; };
typedef const Args __attribute__((address_space(4)))* argp_t;
__device__ __forceinline__ argp_t get_args() { argp_t p = (argp_t)__builtin_amdgcn_kernarg_segment_ptr(); asm volatile("" : "+s"(p)); return p; }
__device__ __forceinline__ int otid(int wave_s) { return wave_s * 64 + lane_opaque(); }
#define IN_F(k) ((const float*)A_->in[k])
#define PH_LOCALS \
    argp_t A_ = get_args(); unsigned char* const ws = A_->ws; float* const out = A_->out; (void)out; \
    const int tid = otid(wave_s), lane = tid & 63, wave = wave_s; (void)lane; (void)wave; \
    const int G = gridDim.x, bx = blockIdx.x, vcu = (G % 8 == 0) ? (bx % 8) * (G / 8) + bx / 8 : bx; (void)vcu; \
    const int gw = vcu * NWAVES + wave, NGW = G * NWAVES, gt = vcu * (NWAVES * 64) + tid, NGT = G * NWAVES * 64; (void)gw; (void)NGW; (void)gt; (void)NGT; \
    LAS unsigned char* const L = (LAS unsigned char*)lds; (void)L;
#define WSP(T, off) ((T*)(ws + (off)))

__global__ void __launch_bounds__(NWAVES * 64, 2) mega_fwd(Args args) {
    extern __shared__ __attribute__((aligned(16))) unsigned char lds[];
    int lo, hi; XcdBarrier bar;
    const int wave_s = __builtin_amdgcn_readfirstlane((int)threadIdx.x >> 6);
    {
        PH_LOCALS
        volatile LAS unsigned* MISC = (volatile LAS unsigned*)(L + MISC_OFF);
        for (int u = tid; u < (LDS_BYTES - XB_OFF) / 4; u += NWAVES * 64) ((LAS unsigned*)(L + XB_OFF))[u] = 0u;
        __syncthreads();
        bar = xcd_barrier_post((unsigned*)(ws + WS_CTL) + CW_BAR, MISC + 8);
        lo = A_->ph_lo; hi = A_->ph_hi;
    }
#ifndef DBG_REP_TR
#define DBG_REP_TR 1
#endif
#ifndef DBG_REP_HB
#define DBG_REP_HB 1
#endif
#ifndef DBG_REP_FOX
#define DBG_REP_FOX 1
#endif
#ifndef DBG_REP_DSA
#define DBG_REP_DSA 1
#endif
#ifndef DBG_REP_SGU
#define DBG_REP_SGU 1
#endif
#ifndef DBG_REP_POOL
#define DBG_REP_POOL 1
#endif
#ifndef PHMASK
#define PHMASK 0xff7fffu
#endif
#define IN(k) (((PHMASK >> (k)) & 1u) && lo <= (k) && (k) < hi)
#define SEAM(k) do { if (IN(k) && IN((k) + 1)) xcd_barrier(bar); } while (0)
    if (IN(0)) {
        PH_LOCALS
        LAS float* scr = (LAS float*)(L + wave * 16384);
        const float* norm_mix = IN_F(3); const float* norm_ffn = IN_F(4); const float* norm_ple = IN_F(5);
        const float* ffn_w_in = IN_F(6); const float* ffn_w_out = IN_F(9); const float* ple_w_proj = IN_F(10); const float* ple_w_gate = IN_F(11);
        const float* ev_w_in = IN_F(13); const float* ev_w_out = IN_F(14); const float* od_w_in = IN_F(17); const float* od_w_out = IN_F(18);
#define TJ(Wp, RS, WTp, K_, NOLD, NNEW, LDK, KOFF, TYPE) { constexpr int NI_ = ((K_) / 64) * ((NNEW) / 32); if (r < NI_) { const TJob J{(Wp), (RS), (WTp), (K_), (NOLD), (NNEW), (LDK), (KOFF), (TYPE), NI_}; transpose_item(J, scr, r, lane); continue; } r -= NI_; }
        constexpr int NITEMS = 16 * 48 + 8 * 32;
        for (int rep_ = 0; rep_ < DBG_REP_TR; ++rep_) for (int it = gw; it < NITEMS; it += NGW) {
            int r = it;
            TJ(ev_w_in, norm_mix, WSP(bf16, WS_W_EVIN), 1024, 1476, EV_N, 1024, 0, 1)
            TJ(ev_w_out + (size_t)512 * 1024, nullptr, WSP(bf16, WS_W_OUT0), 512, 1024, 1024, 1024, 512, 0)
        }
#undef TJ
        { const float* sgu_w = IN_F(22); bf16* W_SGU = WSP(bf16, WS_W_SGU);
          for (int i = gt; i < 4 * 128 * 128; i += NGT) { const int jj = i & 127, ii = (i >> 7) & 127; W_SGU[i] = (bf16)((ii < 64 && jj >= 64) ? 0u : f2bf(sgu_w[i])); } }
        { const float* x = IN_F(0); bf16* HB = WSP(bf16, WS_HB); float* SSQA = WSP(float, WS_SSQA);
          for (int m = gw; m < TOK; m += 4 * NGW) {
            f32x4 v[4][4];
#pragma unroll
            for (int q = 0; q < 4; ++q) { const int mm = (m + q * NGW < TOK) ? m + q * NGW : m; const f32x4* xr = (const f32x4*)(x + (size_t)mm * DMODEL) + lane;
#pragma unroll
                for (int j = 0; j < 4; ++j) v[q][j] = xr[64 * j]; }
#pragma unroll
            for (int q = 0; q < 4; ++q) { const int mm = m + q * NGW; if (mm < TOK) {
                float s = 0.f; unsigned long long* o8 = (unsigned long long*)(HB + (size_t)mm * DMODEL) + lane;
#pragma unroll
                for (int j = 0; j < 4; ++j) { const f32x4 w = v[q][j]; s += (w.x * w.x + w.y * w.y) + (w.z * w.z + w.w * w.w);
                    o8[64 * j] = (unsigned long long)pk2(w.x, w.y) | ((unsigned long long)pk2(w.z, w.w) << 32); }
                s = wave_sum(s);
                if (lane < 16) SSQA[(size_t)mm * 16 + lane] = (lane == 0) ? s : 0.f; } }
          } }
        { const float* p_in = IN_F(1); bf16* PB = WSP(bf16, WS_PB);
          for (int i = gt; i < TOK * PLE / 4; i += 4 * NGT) { f32x4 v[4];
#pragma unroll
            for (int q = 0; q < 4; ++q) v[q] = ((const f32x4*)p_in)[(i + q * NGT < TOK * PLE / 4) ? i + q * NGT : i];
#pragma unroll
            for (int q = 0; q < 4; ++q) if (i + q * NGT < TOK * PLE / 4) ((unsigned long long*)PB)[i + q * NGT] = (unsigned long long)pk2(v[q].x, v[q].y) | ((unsigned long long)pk2(v[q].z, v[q].w) << 32); } }
        { const int* positions = (const int*)A_->in[2]; f32x2* ROPE = WSP(f32x2, WS_ROPE);
          for (int i = gt; i < TOK * 8; i += NGT) {
            const int row = i >> 3, j = i & 7;
            const float invf = (j == 0) ? 1.0f : (j == 1) ? 0.1939227432012558f : (j == 2) ? 0.03760603070259094f : (j == 3) ? 0.007292664609849453f : (j == 4) ? 0.0014142135623842478f :
                               (j == 5) ? 0.00027424818836152554f : (j == 6) ? 5.3182957344688475e-05f : 1.0313385246263351e-05f;
            const float ang = (float)positions[row] * invf;
            float sn, cs; sincos_d((double)ang, sn, cs);
            ROPE[i] = (f32x2){cs, sn};
          } }
    }
    SEAM(0);
    if (IN(1)) {
        { PH_LOCALS
          pg8::Gemm g{WSP(bf16, WS_HB), WSP(bf16, WS_W_EVIN), TOK, EV_N, 1024}; pg8::StaticOrder S; S.init(TOK, EV_N, G, bx);
          pg8::EpiEvenIn E{WSP(float, WS_SSQA), WSP(bf16, WS_ZH), WSP(const pg8::f32x2, WS_ROPE)};
          pg8::gemm_phase<pg8::EpiEvenIn, pg8::StaticOrder, true, true>(L, g, S, E, wave_s); }
        if (gridDim.x == 256 && blockIdx.x >= 128) {
            PH_LOCALS
            LAS float* scr = (LAS float*)(L + wave * 16384);
            const float* norm_mix = IN_F(3); const float* norm_ffn = IN_F(4); const float* norm_ple = IN_F(5);
            const float* ffn_w_in = IN_F(6); const float* ffn_w_out = IN_F(9); const float* ple_w_proj = IN_F(10); const float* ple_w_gate = IN_F(11);
            const float* od_w_in = IN_F(17); const float* od_w_out = IN_F(18);
#define TJ(Wp, RS, WTp, K_, NOLD, NNEW, LDK, KOFF, TYPE) { constexpr int NI_ = ((K_) / 64) * ((NNEW) / 32); if (r < NI_) { const TJob J{(Wp), (RS), (WTp), (K_), (NOLD), (NNEW), (LDK), (KOFF), (TYPE), NI_}; transpose_item(J, scr, r, lane); continue; } r -= NI_; }
            constexpr int NITEMS_B = (16 * 176 + 44 * 32 + 16 * 32 + 4 * 32) + 16 * 88 + 16 * 32;
            const int gwb = (vcu_of(bx - 128, 128)) * NWAVES + wave, NGWB = 128 * NWAVES;
            for (int it = gwb; it < NITEMS_B; it += NGWB) {
                int r = it;
                TJ(ffn_w_in, norm_ffn, WSP(bf16, WS_W_FFI0), 1024, NFF2, NFF2, 1024, 0, 3)
                TJ(ffn_w_out, nullptr, WSP(bf16, WS_W_FFO0), DFF, 1024, 1024, DFF, 0, 0)
                TJ(ple_w_gate, norm_ple, WSP(bf16, WS_W_PG0), 1024, 1024, 1024, 1024, 0, 0)
                TJ(ple_w_proj, nullptr, WSP(bf16, WS_W_PP0), 256, 1024, 1024, 256, 0, 0)
                TJ(od_w_in, norm_mix + 1024, WSP(bf16, WS_W_ODIN), 1024, 2568, OD_N, 1024, 0, 2)
                TJ(od_w_out, nullptr, WSP(bf16, WS_W_OUT1), 1024, 1024, 1024, 1024, 0, 0)
            }
#undef TJ
        {
            const float* pool_w = IN_F(15); const float* pool_scale = IN_F(16); const float* ev_w_out = IN_F(14); bf16* W_OUT0 = WSP(bf16, WS_W_OUT0);
            for (int it = gwb; it < 1024; it += NGWB) {
                const int g = it >> 8, nb = (it >> 4) & 15, cb = it & 15, n = 64 * nb + lane;
                float acc[8];
#pragma unroll
                for (int cc = 0; cc < 8; ++cc) acc[cc] = 0.f;
#pragma unroll 1
                for (int d0 = 0; d0 < 128; d0 += 16) {
                    float wv[16];
#pragma unroll
                    for (int e = 0; e < 16; ++e) wv[e] = ev_w_out[(size_t)(128 * g + d0 + e) * 1024 + n] * pool_scale[128 * g + d0 + e];
#pragma unroll
                    for (int cc = 0; cc < 8; ++cc) {
                        const float* pw = pool_w + ((size_t)g * 128 + 8 * cb + cc) * 128 + d0;
#pragma unroll
                        for (int e = 0; e < 16; ++e) acc[cc] += pw[e] * wv[e];
                    }
                }
#pragma unroll
                for (int c2 = 0; c2 < 4; ++c2) *(unsigned*)(W_OUT0 + (size_t)n * 1024 + 128 * g + 8 * cb + 2 * c2) = pk2(acc[2 * c2], acc[2 * c2 + 1]);
            }
        }
        }
    }
    SEAM(1);
    if (IN(2)) {
        { PH_LOCALS
          const bf16* ZH = WSP(bf16, WS_ZH); bf16* Y = WSP(bf16, WS_Y); const unsigned lds0 = (unsigned)(uintptr_t)lds;
          for (int pi = vcu; pi < 256; pi += G) {
            const int b = pi >> 5, s = pi & 31;
#pragma unroll 1
            for (int k = 0; k < 2 * DBG_REP_DSA; ++k) mix::dsa_unit(b, (k & 1) ? s : 63 - s, ZH, Y, (char*)lds, lds0, wave_s);
          } }
        { PH_LOCALS
          const bf16* ZH = WSP(bf16, WS_ZH); bf16* Y = WSP(bf16, WS_Y);
          for (int rep_ = 0; rep_ < DBG_REP_POOL; ++rep_) for (int it = gt; it < TOK * 64; it += NGT) mix::pool_item(it, ZH, Y);
        }
        { PH_LOCALS
          const float* p1 = IN_F(1) + (size_t)TOK * PLE; bf16* PB1 = (bf16*)out + (size_t)16 * 1024 * 1024;
          for (int i = gt; i < TOK * PLE / 4; i += 4 * NGT) { f32x4 v[4];
#pragma unroll
              for (int q = 0; q < 4; ++q) v[q] = ((const f32x4*)p1)[(i + q * NGT < TOK * PLE / 4) ? i + q * NGT : i];
#pragma unroll
              for (int q = 0; q < 4; ++q) if (i + q * NGT < TOK * PLE / 4) ((unsigned long long*)PB1)[i + q * NGT] = (unsigned long long)pk2(v[q].x, v[q].y) | ((unsigned long long)pk2(v[q].z, v[q].w) << 32); }
        }
    }
    SEAM(2);
    {
        const size_t s1o = (0 == 0) ? WS_SSQA : WS_SSQB, s2o = (0 == 0) ? WS_SSQB : WS_SSQA, s3o = s1o;
        if (IN(3)) {
            PH_LOCALS
            pg8::Gemm g{WSP(bf16, WS_Y), WSP(bf16, (0 == 0) ? WS_W_OUT0 : WS_W_OUT1), TOK, 1024, 1024}; pg8::StaticOrder S; S.init(TOK, 1024, G, bx);
            pg8::EpiRes E{nullptr, WSP(bf16, WS_HB), WSP(bf16, WS_HB), WSP(float, s1o), WSP(bf16, WS_AHALO)};
            pg8::gemm_phase<pg8::EpiRes, pg8::StaticOrder, true, true>(L, g, S, E, wave_s);
        }
        SEAM(3);
        if (IN(3 + 2)) {
            PH_LOCALS
            pg8::Gemm g{WSP(bf16, WS_HB), WSP(bf16, WS_W_FFI0), TOK + 256, NFF2, 1024}; pg8::StaticOrder S; S.init(TOK, NFF2, G, bx);
            if (G == 256 && !(bx >= 128 && bx < 128 + NFF2 / 256)) {
                LAS float* scr = (LAS float*)(L + wave * 16384);
                const float* ffn_w_out = IN_F(9); const float* ple_w_proj = IN_F(10);
#define TJ(Wp, RS, WTp, K_, NOLD, NNEW, LDK, KOFF, TYPE) { constexpr int NI_ = ((K_) / 64) * ((NNEW) / 32); if (r < NI_) { const TJob J{(Wp), (RS), (WTp), (K_), (NOLD), (NNEW), (LDK), (KOFF), (TYPE), NI_}; transpose_item(J, scr, r, lane); continue; } r -= NI_; }
                const int wgi = bx < 128 ? bx : bx - 22;
                for (int it = wgi * NWAVES + wave; it < 44 * 32 + 4 * 32; it += 234 * NWAVES) {
                    int r = it;
                    TJ(ffn_w_out + (size_t)DFF * 1024, nullptr, WSP(bf16, WS_W_FFO1), DFF, 1024, 1024, DFF, 0, 0)
                    TJ(ple_w_proj + (size_t)256 * 1024, nullptr, WSP(bf16, WS_W_PP1), 256, 1024, 1024, 256, 0, 0)
                }
#undef TJ
                asm volatile("s_waitcnt vmcnt(0) lgkmcnt(0)" ::: "memory"); __syncthreads();
            }
#ifdef STAGGER
            if (STAGGER_COND) { for (int i_ = 0; i_ < STAGGER; ++i_) __builtin_amdgcn_s_sleep(127); }
#endif
            if (G == 256 && bx >= 128 && bx < 128 + NFF2 / 256) {
                pg8::OneUnit S1{64, bx - 128, 1};
                pg8::EpiHaloF EH{WSP(float, s1o), WSP(float, WS_AH), (unsigned*)(ws + WS_CTL) + CW_FLAG + 2048 * 0};
                pg8::gemm_phase<pg8::EpiHaloF, pg8::OneUnit, true, true>(L, g, S1, EH, wave_s);
            }
#ifdef PP_FIRST
            if (G == 256 && bx >= 150) {
                pg8::Gemm gp{WSP(bf16, WS_PB), WSP(bf16, WS_W_PP0), TOK, 1024, PLE}; pg8::StaticOrder SP; SP.init(TOK, 1024, 106, bx - 150);
                pg8::EpiBf16Plain EP{WSP(bf16, WS_PP), 1024};
                pg8::gemm_phase<pg8::EpiBf16Plain, pg8::StaticOrder, true, true>(L, gp, SP, EP, wave_s);
            }
#endif
            pg8::EpiFfnIn E{WSP(float, s1o), IN_F(7) + (size_t)0 * 3 * NFF2, IN_F(8) + (size_t)0 * NFF2, WSP(float, WS_AH), WSP(bf16, WS_ZH), (LAS float*)(L + XB_OFF), (unsigned*)(ws + WS_CTL) + CW_FLAG + 2048 * 0, 1u};
            pg8::gemm_phase<pg8::EpiFfnIn, pg8::StaticOrder, true, true>(L, g, S, E, wave_s);
#ifndef PP_FIRST
            if (G == 256 && bx >= 150) {
                pg8::Gemm gp{WSP(bf16, WS_PB), WSP(bf16, WS_W_PP0), TOK, 1024, PLE}; pg8::StaticOrder SP; SP.init(TOK, 1024, 106, bx - 150);
                pg8::EpiBf16Plain EP{WSP(bf16, WS_PP), 1024};
                pg8::gemm_phase<pg8::EpiBf16Plain, pg8::StaticOrder, true, true>(L, gp, SP, EP, wave_s);
            }
#endif
        }
        SEAM(3 + 2);
        if (IN(3 + 3)) {
            PH_LOCALS
            pg8::Gemm g{WSP(bf16, WS_ZH), WSP(bf16, (0 == 0) ? WS_W_FFO0 : WS_W_FFO1), TOK, 1024, DFF}; pg8::StaticOrder S; S.init(TOK, 1024, G, bx);
            pg8::EpiRes E{nullptr, WSP(bf16, WS_HB), WSP(bf16, WS_HB), WSP(float, s2o), nullptr};
            pg8::gemm_phase<pg8::EpiRes, pg8::StaticOrder, true, true>(L, g, S, E, wave_s);
        }
        SEAM(3 + 3);
        if (IN(3 + 4)) {
            PH_LOCALS
            pg8::Gemm g{WSP(bf16, WS_HB), WSP(bf16, (0 == 0) ? WS_W_PG0 : WS_W_PG1), TOK, 1024, 1024}; pg8::StaticOrder S; S.init(TOK, 1024, G, bx);
            pg8::EpiGate E{WSP(float, s2o), WSP(bf16, WS_HB), WSP(bf16, WS_PP), (bf16*)out, WSP(float, s3o)};
            pg8::gemm_phase<pg8::EpiGate, pg8::StaticOrder, true, true>(L, g, S, E, wave_s);
        }
        SEAM(3 + 4);
    }
    {

            if (IN(8)) {
                { PH_LOCALS
                  pg8::Gemm g{(const bf16*)out, WSP(bf16, WS_W_ODIN), TOK, OD_N, 1024}; pg8::StaticOrder S; S.init(TOK, OD_N, G, bx);
                  pg8::EpiOddIn E{WSP(float, WS_SSQA), WSP(bf16, WS_ZH), WSP(float, WS_FBUF), WSP(float, WS_SST)};
                  pg8::gemm_phase<pg8::EpiOddIn, pg8::StaticOrder, true, true>(L, g, S, E, wave_s); }
                if (gridDim.x == 256 && blockIdx.x >= 192) {
                    PH_LOCALS
                    LAS float* scr = (LAS float*)(L + wave * 16384);
                    const float* norm_ffn = IN_F(4); const float* norm_ple = IN_F(5); const float* ffn_w_in = IN_F(6); const float* ple_w_gate = IN_F(11);
#define TJ(Wp, RS, WTp, K_, NOLD, NNEW, LDK, KOFF, TYPE) { constexpr int NI_ = ((K_) / 64) * ((NNEW) / 32); if (r < NI_) { const TJob J{(Wp), (RS), (WTp), (K_), (NOLD), (NNEW), (LDK), (KOFF), (TYPE), NI_}; transpose_item(J, scr, r, lane); continue; } r -= NI_; }
                    constexpr int NITEMS_C = 16 * 176 + 16 * 32;
                    const int gwc = (bx - 192) * NWAVES + wave, NGWC = 64 * NWAVES;
                    for (int it = gwc; it < NITEMS_C; it += NGWC) {
                        int r = it;
                        TJ(ffn_w_in + (size_t)1024 * NFF2, norm_ffn + 1024, WSP(bf16, WS_W_FFI1), 1024, NFF2, NFF2, 1024, 0, 3)
                        TJ(ple_w_gate + (size_t)1024 * 1024, norm_ple + 1024, WSP(bf16, WS_W_PG1), 1024, 1024, 1024, 1024, 0, 0)
                    }
#undef TJ
                }
            }
            SEAM(8);
            if (IN(9)) {
                { PH_LOCALS
                  const bf16* ZH = WSP(bf16, WS_ZH); bf16* Y = WSP(bf16, WS_Y); const unsigned lds0 = (unsigned)(uintptr_t)lds;
                  const float* FBUF = WSP(float, WS_FBUF); const float* fox_b_f = IN_F(19);
                  for (int pi = vcu; pi < 256; pi += G) {
                    const int bh = pi >> 2, s = pi & 3;
#pragma unroll 1
                    for (int k = 0; k < 2 * DBG_REP_FOX; ++k) mix::fox_unit2(bh >> 3, bh & 7, (k & 1) ? s : 7 - s, ZH, FBUF, fox_b_f, Y, (char*)lds, wave_s);
                  } }
                { PH_LOCALS
                  const bf16* ZH = WSP(bf16, WS_ZH); bf16* Y = WSP(bf16, WS_Y);
                  for (int rep_ = 0; rep_ < DBG_REP_SGU; ++rep_) for (int u = vcu; u < 512; u += G) mix::sgu_unit(u >> 6, (u >> 2) & 15, u & 3, ZH, WSP(float, WS_SST), IN_F(20), IN_F(21), WSP(bf16, WS_W_SGU), IN_F(23), Y, (char*)lds, wave_s); }
            }
            SEAM(9);
            }
    {
        const size_t s1o = (1 == 0) ? WS_SSQA : WS_SSQB, s2o = (1 == 0) ? WS_SSQB : WS_SSQA, s3o = s1o;
        if (IN(10)) {
            PH_LOCALS
            pg8::Gemm g{WSP(bf16, WS_Y), WSP(bf16, (1 == 0) ? WS_W_OUT0 : WS_W_OUT1), TOK, 1024, 1024}; pg8::StaticOrder S; S.init(TOK, 1024, G, bx);
            pg8::EpiRes E{nullptr, (const bf16*)out, WSP(bf16, WS_HB), WSP(float, s1o), WSP(bf16, WS_AHALO)};
            pg8::gemm_phase<pg8::EpiRes, pg8::StaticOrder, true, true>(L, g, S, E, wave_s);
        }
        SEAM(10);
        if (IN(10 + 2)) {
            PH_LOCALS
            pg8::Gemm g{WSP(bf16, WS_HB), WSP(bf16, WS_W_FFI1), TOK + 256, NFF2, 1024}; pg8::StaticOrder S; S.init(TOK, NFF2, G, bx);
#ifdef STAGGER
            if (STAGGER_COND) { for (int i_ = 0; i_ < STAGGER; ++i_) __builtin_amdgcn_s_sleep(127); }
#endif
            if (G == 256 && bx >= 128 && bx < 128 + NFF2 / 256) {
                pg8::OneUnit S1{64, bx - 128, 1};
                pg8::EpiHaloF EH{WSP(float, s1o), WSP(float, WS_AH), (unsigned*)(ws + WS_CTL) + CW_FLAG + 2048 * 1};
                pg8::gemm_phase<pg8::EpiHaloF, pg8::OneUnit, true, true>(L, g, S1, EH, wave_s);
            }
#ifdef PP_FIRST
            if (G == 256 && bx >= 150) {
                pg8::Gemm gp{(const bf16*)out + (size_t)16 * 1024 * 1024, WSP(bf16, WS_W_PP1), TOK, 1024, PLE}; pg8::StaticOrder SP; SP.init(TOK, 1024, 106, bx - 150);
                pg8::EpiBf16Plain EP{WSP(bf16, WS_PP), 1024};
                pg8::gemm_phase<pg8::EpiBf16Plain, pg8::StaticOrder, true, true>(L, gp, SP, EP, wave_s);
            }
#endif
            pg8::EpiFfnIn E{WSP(float, s1o), IN_F(7) + (size_t)1 * 3 * NFF2, IN_F(8) + (size_t)1 * NFF2, WSP(float, WS_AH), WSP(bf16, WS_ZH), (LAS float*)(L + XB_OFF), (unsigned*)(ws + WS_CTL) + CW_FLAG + 2048 * 1, 2u};
            pg8::gemm_phase<pg8::EpiFfnIn, pg8::StaticOrder, true, true>(L, g, S, E, wave_s);
#ifndef PP_FIRST
            if (G == 256 && bx >= 150) {
                pg8::Gemm gp{(const bf16*)out + (size_t)16 * 1024 * 1024, WSP(bf16, WS_W_PP1), TOK, 1024, PLE}; pg8::StaticOrder SP; SP.init(TOK, 1024, 106, bx - 150);
                pg8::EpiBf16Plain EP{WSP(bf16, WS_PP), 1024};
                pg8::gemm_phase<pg8::EpiBf16Plain, pg8::StaticOrder, true, true>(L, gp, SP, EP, wave_s);
            }
#endif
        }
        SEAM(10 + 2);
        if (IN(10 + 3)) {
            PH_LOCALS
            pg8::Gemm g{WSP(bf16, WS_ZH), WSP(bf16, (1 == 0) ? WS_W_FFO0 : WS_W_FFO1), TOK, 1024, DFF}; pg8::StaticOrder S; S.init(TOK, 1024, G, bx);
            pg8::EpiRes E{nullptr, WSP(bf16, WS_HB), WSP(bf16, WS_HB), WSP(float, s2o), nullptr};
            pg8::gemm_phase<pg8::EpiRes, pg8::StaticOrder, true, true>(L, g, S, E, wave_s);
        }
        SEAM(10 + 3);
        if (IN(10 + 4)) {
            PH_LOCALS
            pg8::Gemm g{WSP(bf16, WS_HB), WSP(bf16, (1 == 0) ? WS_W_PG0 : WS_W_PG1), TOK, 1024, 1024}; pg8::StaticOrder S; S.init(TOK, 1024, G, bx);
            pg8::EpiGateFinal E{WSP(float, s2o), WSP(bf16, WS_HB), WSP(bf16, WS_PP), WSP(float, s3o), (unsigned*)(ws + WS_CTL) + CW_PAN, IN_F(12), out, (LAS float*)(L + XB_OFF) + 2048};
            pg8::gemm_phase<pg8::EpiGateFinal, pg8::StaticOrder, true, true>(L, g, S, E, wave_s);
        }
        SEAM(10 + 4);
    }
    if (IN(15)) {
        PH_LOCALS
        const float* SSQB = WSP(float, WS_SSQB); const float* norm_final = IN_F(12); const bf16* H6 = WSP(bf16, WS_Y);
        for (int m = gw; m < TOK; m += 4 * NGW) {
            unsigned long long w[4][4]; float rs[4];
#pragma unroll
            for (int q = 0; q < 4; ++q) { const int mm = (m + q * NGW < TOK) ? m + q * NGW : m; rs[q] = pg8::row_rstd(SSQB, mm);
                const unsigned long long* hr = (const unsigned long long*)(H6 + (size_t)mm * DMODEL) + lane;
#pragma unroll
                for (int j = 0; j < 4; ++j) w[q][j] = hr[64 * j]; }
            const f32x4* gr = (const f32x4*)norm_final + lane;
            f32x4 gg[4];
#pragma unroll
            for (int j = 0; j < 4; ++j) gg[j] = gr[64 * j];
#pragma unroll
            for (int q = 0; q < 4; ++q) { const int mm = m + q * NGW; if (mm < TOK) { f32x4* xr = (f32x4*)(out + (size_t)mm * DMODEL) + lane;
#pragma unroll
                for (int j = 0; j < 4; ++j) { const unsigned long long ww = w[q][j];
                    const f32x4 v = {pg8::bf_lo((unsigned)ww), pg8::bf_hi((unsigned)ww), pg8::bf_lo((unsigned)(ww >> 32)), pg8::bf_hi((unsigned)(ww >> 32))};
                    __builtin_nontemporal_store(v * rs[q] * gg[j], xr + 64 * j); } } }
        }
    }
#undef IN
#undef SEAM
}

#ifndef MK_N_LAUNCHES
#define MK_N_LAUNCHES 1
#endif
constexpr int N_PHASES = 16;
extern "C" void kernel_launch(void* const* d_in, const int* in_sizes, int n_in, void* d_out, int out_size, void* d_ws, size_t ws_size, hipStream_t stream) {
    static int grid = 0;
    if (grid == 0) {
        if (n_in != 24 || out_size != TOK * DMODEL || ws_size < WS_END) { fprintf(stderr, "kernel_launch: unexpected shapes (n_in %d, out %d, ws %zu)\n", n_in, out_size, ws_size); grid = -1; return; }
        int dev = 0, cus = 0;
        if (hipGetDevice(&dev) != hipSuccess || hipDeviceGetAttribute(&cus, hipDeviceAttributeMultiprocessorCount, dev) != hipSuccess) { grid = -1; return; }
        if (hipFuncSetAttribute((const void*)mega_fwd, hipFuncAttributeMaxDynamicSharedMemorySize, LDS_BYTES) != hipSuccess) { fprintf(stderr, "kernel_launch: hipFuncSetAttribute failed\n"); grid = -1; return; }
        int per_cu = 0;
        if (hipOccupancyMaxActiveBlocksPerMultiprocessor(&per_cu, (const void*)mega_fwd, NWAVES * 64, LDS_BYTES) != hipSuccess || per_cu < 1) { fprintf(stderr, "kernel_launch: occupancy query says %d\n", per_cu); }
        (void)hipGetLastError();
        grid = cus;
    }
    if (grid < 0) return;
    (void)hipMemsetAsync((char*)d_ws + WS_CTL, 0, CTL_ZERO_BYTES, stream);
    Args a{};
    for (int i = 0; i < 24; ++i) a.in[i] = d_in[i];
    a.out = (float*)d_out; a.ws = (unsigned char*)d_ws;
#ifdef DBG_CHECK
    {
        using namespace dbg;
        auto LP = [&](int ph) { a.ph_lo = ph; a.ph_hi = ph + 1; hipLaunchKernelGGL(mega_fwd, dim3(grid), dim3(NWAVES * 64), LDS_BYTES, stream, a); };
        char* wsb = (char*)d_ws; float* ERR = (float*)(wsb + 512 * 1024); float* SNAP = (float*)(wsb + 600 * 1024); float* outp = (float*)d_out;
        const unsigned short* ZHp = (const unsigned short*)(wsb + WS_ZH); const unsigned short* Yp = (const unsigned short*)(wsb + WS_Y); const float* FB = (const float*)(wsb + WS_FBUF);
        const unsigned short* HBp = (const unsigned short*)(wsb + WS_HB); const unsigned short* H3p = (const unsigned short*)d_out;
        auto F = [&](int i) { return (const float*)d_in[i]; };
        const float* x = F(0);
        LP(0); LP(1);
        k_evenin<<<NS, 256, 0, stream>>>(x, F(3), F(13), (const int*)d_in[2], ZHp, ERR, 0);
        LP(2);
        k_pool<<<NS, 256, 0, stream>>>(ZHp, Yp, ERR, 1);
        k_dsa<<<NS, 256, 0, stream>>>(ZHp, Yp, ERR, 2);
        LP(3);
        k_outproj<<<NS, 256, 0, stream>>>(x, 0, SNAP, Yp, F(14), F(15), F(16), HBp, ERR, 3);
        for (int layer = 0; layer < 2; ++layer) {
            const int pb = layer ? 10 : 3, kb = layer ? 10 : 3;
            if (layer == 1) {
                LP(8);
                k_oddin<<<NS, 256, 0, stream>>>(H3p, F(3) + 1024, F(17), ZHp, FB, ERR, 7);
                LP(9);
                k_fox<<<NS, 256, 0, stream>>>(ZHp, FB, F(19), Yp, ERR, 8);
                k_sgu<<<NS, 256, 0, stream>>>(ZHp, F(20), F(21), F(22), F(23), Yp, ERR, 9);
                k_snap<<<NS, 256, 0, stream>>>(H3p, SNAP);
                LP(10);
                k_outproj<<<NS, 256, 0, stream>>>(nullptr, 1, SNAP, Yp, F(18), nullptr, nullptr, HBp, ERR, 10);
            }
            LP(pb + 1); LP(pb + 2);
            k_ffnin<<<NS, 256, 0, stream>>>(HBp, F(4) + 1024 * layer, F(6) + (size_t)layer * 1024 * NFF2, F(7) + (size_t)layer * 3 * NFF2, F(8) + (size_t)layer * NFF2, ZHp, ERR, kb + 1);
            k_snap<<<NS, 256, 0, stream>>>(HBp, SNAP);
            LP(pb + 3);
            k_ffnout<<<NS, 256, 0, stream>>>(SNAP, ZHp, F(9) + (size_t)layer * DFF * 1024, HBp, ERR, kb + 2);
            k_snap<<<NS, 256, 0, stream>>>(HBp, SNAP);
            LP(pb + 4);
            k_ple<<<NS, 256, 0, stream>>>(SNAP, F(1) + (size_t)layer * TOK * PLE, F(5) + 1024 * layer, F(10) + (size_t)layer * PLE * 1024, F(11) + (size_t)layer * 1024 * 1024, layer ? Yp : H3p, ERR, kb + 3);
        }
        k_snap<<<NS, 256, 0, stream>>>(Yp, SNAP);
        LP(15);
        k_final<<<NS, 256, 0, stream>>>(SNAP, F(12), outp, ERR, 14);
        t_dpp<<<1, 64, 0, stream>>>(ERR + 40);
        k_report<<<1024, 256, 0, stream>>>(ERR, 15, DBG_TOL, outp);
        return;
    }
#endif
    if (MK_N_LAUNCHES == 1) {
        a.ph_lo = 0; a.ph_hi = N_PHASES;
        hipLaunchKernelGGL(mega_fwd, dim3(grid), dim3(NWAVES * 64), LDS_BYTES, stream, a);
    } else {
#ifndef DBG_STOP
#define DBG_STOP N_PHASES
#endif
#ifndef DBG_DOUBLE
#define DBG_DOUBLE -1
#endif
        for (int ph = 0; ph < DBG_STOP; ++ph) { a.ph_lo = ph; a.ph_hi = ph + 1; const int reps = (ph == DBG_DOUBLE || (DBG_DOUBLE == 100 && (ph == 0 || ph == 1 || ph == 2 || ph == 4 || ph == 5 || ph == 8 || ph == 9 || ph == 11 || ph == 12))) ? 2 : 1;
            for (int r = 0; r < reps; ++r) hipLaunchKernelGGL(mega_fwd, dim3(grid), dim3(NWAVES * 64), LDS_BYTES, stream, a); }
    }
}
```

```cpp
#include <hip/hip_runtime.h>
#include <hip/hip_bf16.h>
#include <cstdio>
#include <cstdint>
#include <cmath>
constexpr int TOK = 16384, DMODEL = 1024, SEQ = 2048, NBATCH = 8;
constexpr int DFF = 2816, NFF2 = 5632, PLE = 256;
constexpr int EV_N = 1536;
constexpr int OD_N = 2816;
constexpr int Z1P = 2560;
constexpr float RMS_EPS = 1e-6f;
constexpr float C2 = 0.125f * 1.4426950408889634f;


__device__ __forceinline__ int lane_opaque() { unsigned z = 0u; asm volatile("" : "+v"(z)); return (int)__builtin_amdgcn_mbcnt_hi(~0u, __builtin_amdgcn_mbcnt_lo(~0u, z)); }
__device__ __forceinline__ float xor16_f(float v) { return __builtin_bit_cast(float, __builtin_amdgcn_ds_swizzle(__builtin_bit_cast(int, v), 0x401F)); }
__device__ __forceinline__ void halves_pair(unsigned v, unsigned& a, unsigned& b) { unsigned w = v; asm volatile("" : "+v"(w)); auto rr = __builtin_amdgcn_permlane32_swap(v, w, false, false); a = rr[0]; b = rr[1]; }
__device__ __forceinline__ float halves_sum_f(float v) { unsigned a, b; halves_pair(__builtin_bit_cast(unsigned, v), a, b); return __builtin_bit_cast(float, a) + __builtin_bit_cast(float, b); }
__device__ __forceinline__ float halves_max_f(float v) { unsigned a, b; halves_pair(__builtin_bit_cast(unsigned, v), a, b); return __builtin_fmaxf(__builtin_bit_cast(float, a), __builtin_bit_cast(float, b)); }
__device__ __forceinline__ unsigned halves_add_u(unsigned v) { unsigned a, b; halves_pair(v, a, b); return a + b; }
__device__ __forceinline__ unsigned halves_or_u(unsigned v) { unsigned a, b; halves_pair(v, a, b); return a | b; }
namespace pg8 {
#define PG8_LAS __attribute__((address_space(3)))
typedef unsigned short bf16_t;
typedef short bf16x8 __attribute__((ext_vector_type(8)));
typedef float f32x4 __attribute__((ext_vector_type(4)));
typedef unsigned u32x4 __attribute__((ext_vector_type(4)));
constexpr int BM = 256, BK = 64, HALF = 128, HTB = HALF * BK * 2  , STAGE_BYTES = 8 * HTB, NXCD = 8, WGM = 8;

__host__ __device__ __forceinline__ int lds_byte(int r, int c) { const int st = (r >> 4) * 2 + (c >> 5), rr = r & 15, cc = c & 31, ob = rr * 64 + cc * 2; return st * 1024 + (ob ^ (((ob >> 9) & 1) << 5)); }
__host__ __device__ __forceinline__ void stage_rc(int b, int& R, int& C) { const int st = b / 1024, sb = b % 1024, swz = sb ^ (((sb >> 9) & 1) << 5); R = (st >> 1) * 16 + swz / 64; C = (st & 1) * 32 + (swz % 64) / 2; }
__host__ __device__ __forceinline__ int perm32(int rho) { const int n = rho >> 4, i = rho & 15; return 8 * (i >> 2) + 4 * n + (i & 3); }

struct Unit { int pm, pn; };
struct Gemm { const bf16_t* A; const bf16_t* Bt; int M, N, K; };

struct StaticOrder {
    int nM, nN, nwg, G, c;
    __host__ __device__ void init(int M, int N, int G_, int c_) { nM = M / BM; nN = N / BM; nwg = nM * nN; G = G_; c = c_; }
    __host__ __device__ bool next(int i, Unit& u) const {
        const long L = (long)i * G + c; if (L >= nwg) return false;
        int wgid = (int)L; { const int q = nwg / NXCD, r = nwg % NXCD, xcd = wgid % NXCD, off = wgid / NXCD; wgid = (xcd < r ? xcd * (q + 1) : r * (q + 1) + (xcd - r) * q) + off; }
        const int nig = WGM * nN, gid = wgid / nig, fm = gid * WGM, gsz = (nM - fm) < WGM ? (nM - fm) : WGM;
        u.pm = fm + ((wgid % nig) % gsz); u.pn = (wgid % nig) / gsz; return true;
    }
    __device__ __forceinline__ void a_ready(const Unit&) const {}
    __device__ __forceinline__ void done(const Unit&) const {}
};

struct OneUnit {
    int pm, pn, on;
    __host__ __device__ bool next(int i, Unit& u) const { if (!on || i != 0) return false; u.pm = pm; u.pn = pn; return true; }
    __device__ __forceinline__ void a_ready(const Unit&) const {}
    __device__ __forceinline__ void done(const Unit&) const {}
};
struct FfnOrder {
    StaticOrder S0; int extra;
    __host__ __device__ void init(int M, int N, int G_, int c_) { S0.init(M, N, G_, c_); extra = (G_ == 256 && c_ >= 128 && c_ < 128 + N / BM) ? 1 : 0; }
    __host__ __device__ bool next(int i, Unit& u) const { if (extra) { if (i == 0) { u.pm = 64; u.pn = S0.c - 128; return true; } return S0.next(i - 1, u); } return S0.next(i, u); }
    __device__ __forceinline__ void a_ready(const Unit&) const {}
    __device__ __forceinline__ void done(const Unit&) const {}
};
typedef float f32x2 __attribute__((ext_vector_type(2)));
typedef unsigned u32x2 __attribute__((ext_vector_type(2)));
__device__ __forceinline__ unsigned cvt_pk_bf16(float lo, float hi) { unsigned r; asm volatile("v_cvt_pk_bf16_f32 %0, %1, %2" : "=v"(r) : "v"(lo), "v"(hi)); return r; }
__device__ __forceinline__ float bf_lo(unsigned w) { return __builtin_bit_cast(float, w << 16); }
__device__ __forceinline__ float bf_hi(unsigned w) { return __builtin_bit_cast(float, w & 0xffff0000u); }
__device__ __forceinline__ float sq4(const f32x4 v) { return (v[0] * v[0] + v[1] * v[1]) + (v[2] * v[2] + v[3] * v[3]); }
__device__ __forceinline__ float row_rstd(const float* ssq, int row) {
    const f32x4* p = (const f32x4*)(ssq + (size_t)row * 16);
    const f32x4 a = p[0], b = p[1], c = p[2], d = p[3];
    const float s = (((a[0] + a[1]) + (a[2] + a[3])) + ((b[0] + b[1]) + (b[2] + b[3]))) + (((c[0] + c[1]) + (c[2] + c[3])) + ((d[0] + d[1]) + (d[2] + d[3])));
    return 1.0f / sqrtf(s * (1.0f / 1024.0f) + RMS_EPS);
}
__device__ __forceinline__ float row_rstd_coh(const float* ssq, int row) {
    const float* p = ssq + (size_t)row * 16;
    f32x4 a, b, c, d;
    asm volatile("global_load_dwordx4 %0, %4, off sc1\n\tglobal_load_dwordx4 %1, %4, off offset:16 sc1\n\tglobal_load_dwordx4 %2, %4, off offset:32 sc1\n\tglobal_load_dwordx4 %3, %4, off offset:48 sc1\n\ts_waitcnt vmcnt(0)"
                 : "=&v"(a), "=&v"(b), "=&v"(c), "=&v"(d) : "v"(p) : "memory");
    const float s = (((a[0] + a[1]) + (a[2] + a[3])) + ((b[0] + b[1]) + (b[2] + b[3]))) + (((c[0] + c[1]) + (c[2] + c[3])) + ((d[0] + d[1]) + (d[2] + d[3])));
    return 1.0f / sqrtf(s * (1.0f / 1024.0f) + RMS_EPS);
}
__device__ __forceinline__ void ssq_write(float* ssq_out, float q, int row, int slot, int fq) {
    q += xor16_f(q); q = halves_sum_f(q);
    if (fq == 0) ssq_out[(size_t)row * 16 + slot] = q;
}
typedef float f32x2 __attribute__((ext_vector_type(2)));
__device__ __forceinline__ f32x2 gelu_mul2(const f32x2 x, const f32x2 c) {
    const f32x2 x2 = x * x;
    const f32x2 a = x * (x2 * (-2.3022082f * 0.044715f) + (-2.3022082f));
    f32x2 e; e.x = __builtin_amdgcn_exp2f(a.x); e.y = __builtin_amdgcn_exp2f(a.y);
    const f32x2 d = e + 1.0f;
    f32x2 r; r.x = __builtin_amdgcn_rcpf(d.x); r.y = __builtin_amdgcn_rcpf(d.y);
    return (x * c) * r;
}
__device__ __forceinline__ float gelu_tanh(float x) {
    const float t = x + 0.044715f * x * x * x;
    const float e = __builtin_amdgcn_exp2f(-2.3022082f * t);
    return x * __builtin_amdgcn_rcpf(1.0f + e);
}
__device__ __forceinline__ float sigmoid_f(float x) { return __builtin_amdgcn_rcpf(1.0f + __builtin_amdgcn_exp2f(-1.4426950408889634f * x)); }


struct EpiRes {
    static constexpr bool PERM = true, AFTER_DRAIN = false;
    const float* basef; const bf16_t* baseb; bf16_t* hb; float* ssq_out; bf16_t* ahalo;
    __device__ __forceinline__ void operator()(const f32x4 (&acc)[2][2][4][2], const Unit& u_, int wr, int wc, int fr, int fq) const {
        Unit u; { int pm_ = u_.pm, pn_ = u_.pn; asm volatile("" : "+s"(pm_), "+s"(pn_)); u.pm = pm_; u.pn = pn_; }
        const int row0 = u.pm * BM + wr * 64 + fr, col0 = u.pn * BM + wc * 32 + 8 * fq;
        if (basef != nullptr) {
#pragma unroll
            for (int ai = 0; ai < 2; ++ai)
#pragma unroll
                for (int m = 0; m < 4; ++m) {
                    const int row = row0 + ai * HALF + m * 16; float q = 0.f;
#pragma unroll
                    for (int bj = 0; bj < 2; ++bj) {
                        const size_t off = (size_t)row * DMODEL + col0 + bj * HALF;
                        const f32x4 b0 = *(const f32x4*)(basef + off), b1 = *(const f32x4*)(basef + off + 4);
                        const f32x4 v0 = acc[ai][bj][m][0] + b0, v1 = acc[ai][bj][m][1] + b1;
                        q += sq4(v0) + sq4(v1);
                        u32x4 w; w.x = cvt_pk_bf16(v0[0], v0[1]); w.y = cvt_pk_bf16(v0[2], v0[3]); w.z = cvt_pk_bf16(v1[0], v1[1]); w.w = cvt_pk_bf16(v1[2], v1[3]);
                        *(u32x4*)(hb + off) = w;
                        if (ahalo != nullptr && ai == 1 && m == 3) {
                            const int rl = row & 255;
                            if (rl >= 254 && u.pm < 63) *(u32x4*)(ahalo + (size_t)(2 * (u.pm + 1) + (rl - 254)) * DMODEL + col0 + bj * HALF) = w;
                        }
                    }
                    ssq_write(ssq_out, q, row, u.pn * 4 + wc, fq);
                    if (m & 1) asm volatile("" ::: "memory");
                }
        } else {
#pragma unroll
            for (int ai = 0; ai < 2; ++ai) {
                u32x4 bw[4][2];
#pragma unroll
                for (int m = 0; m < 4; ++m)
#pragma unroll
                    for (int bj = 0; bj < 2; ++bj) bw[m][bj] = *(const u32x4*)(baseb + (size_t)(row0 + ai * HALF + m * 16) * DMODEL + col0 + bj * HALF);
                asm volatile("" ::: "memory");
#pragma unroll
                for (int m = 0; m < 4; ++m) {
                    const int row = row0 + ai * HALF + m * 16; float q = 0.f;
#pragma unroll
                    for (int bj = 0; bj < 2; ++bj) {
                        const size_t off = (size_t)row * DMODEL + col0 + bj * HALF;
                        const u32x4 pw = bw[m][bj];
                        const f32x4 b0 = {bf_lo(pw.x), bf_hi(pw.x), bf_lo(pw.y), bf_hi(pw.y)}, b1 = {bf_lo(pw.z), bf_hi(pw.z), bf_lo(pw.w), bf_hi(pw.w)};
                        const f32x4 v0 = acc[ai][bj][m][0] + b0, v1 = acc[ai][bj][m][1] + b1;
                        q += sq4(v0) + sq4(v1);
                        u32x4 w; w.x = cvt_pk_bf16(v0[0], v0[1]); w.y = cvt_pk_bf16(v0[2], v0[3]); w.z = cvt_pk_bf16(v1[0], v1[1]); w.w = cvt_pk_bf16(v1[2], v1[3]);
                        *(u32x4*)(hb + off) = w;
                        if (ahalo != nullptr && ai == 1 && m == 3) {
                            const int rl = row & 255;
                            if (rl >= 254 && u.pm < 63) *(u32x4*)(ahalo + (size_t)(2 * (u.pm + 1) + (rl - 254)) * DMODEL + col0 + bj * HALF) = w;
                        }
                    }
                    ssq_write(ssq_out, q, row, u.pn * 4 + wc, fq);
                }
                asm volatile("" ::: "memory");
            }
        }
    }
};
struct EpiGate {
    static constexpr bool PERM = true, AFTER_DRAIN = false;
    const float* ssq_in; const bf16_t* base; const bf16_t* pp; bf16_t* dst; float* ssq_out;
    __device__ __forceinline__ void operator()(const f32x4 (&acc)[2][2][4][2], const Unit& u_, int wr, int wc, int fr, int fq) const {
        Unit u; { int pm_ = u_.pm, pn_ = u_.pn; asm volatile("" : "+s"(pm_), "+s"(pn_)); u.pm = pm_; u.pn = pn_; }
        const int row0 = u.pm * BM + wr * 64 + fr, col0 = u.pn * BM + wc * 32 + 8 * fq;
#pragma unroll
        for (int ai = 0; ai < 2; ++ai)
#pragma unroll
            for (int mp = 0; mp < 2; ++mp) {
                u32x4 bw[2][2], pq[2][2]; float rs[2];
#pragma unroll
                for (int mi = 0; mi < 2; ++mi) {
                    const int row = row0 + ai * HALF + (2 * mp + mi) * 16;
#pragma unroll
                    for (int bj = 0; bj < 2; ++bj) { const size_t off = (size_t)row * DMODEL + col0 + bj * HALF; bw[mi][bj] = *(const u32x4*)(base + off); pq[mi][bj] = *(const u32x4*)(pp + off); }
                }
#pragma unroll
                for (int mi = 0; mi < 2; ++mi) rs[mi] = row_rstd(ssq_in, row0 + ai * HALF + (2 * mp + mi) * 16);
                asm volatile("" ::: "memory");
#pragma unroll
                for (int mi = 0; mi < 2; ++mi) {
                    const int m = 2 * mp + mi; const int row = row0 + ai * HALF + m * 16; float q = 0.f;
#pragma unroll
                    for (int bj = 0; bj < 2; ++bj) {
                        const size_t off = (size_t)row * DMODEL + col0 + bj * HALF;
                        const u32x4 b_ = bw[mi][bj], p_ = pq[mi][bj];
                        const float bb[8] = {bf_lo(b_.x), bf_hi(b_.x), bf_lo(b_.y), bf_hi(b_.y), bf_lo(b_.z), bf_hi(b_.z), bf_lo(b_.w), bf_hi(b_.w)};
                        const float pv[8] = {bf_lo(p_.x), bf_hi(p_.x), bf_lo(p_.y), bf_hi(p_.y), bf_lo(p_.z), bf_hi(p_.z), bf_lo(p_.w), bf_hi(p_.w)};
                        const f32x4 g0 = acc[ai][bj][m][0] * rs[mi], g1 = acc[ai][bj][m][1] * rs[mi];
                        const float gg[8] = {g0[0], g0[1], g0[2], g0[3], g1[0], g1[1], g1[2], g1[3]};
                        float v[8];
#pragma unroll
                        for (int i = 0; i < 8; ++i) { v[i] = bb[i] + pv[i] * sigmoid_f(gg[i]); q += v[i] * v[i]; }
                        u32x4 w; w.x = cvt_pk_bf16(v[0], v[1]); w.y = cvt_pk_bf16(v[2], v[3]); w.z = cvt_pk_bf16(v[4], v[5]); w.w = cvt_pk_bf16(v[6], v[7]);
                        *(u32x4*)(dst + off) = w;
                    }
                    ssq_write(ssq_out, q, row, u.pn * 4 + wc, fq);
                }
                asm volatile("" ::: "memory");
            }
    }
};
struct EpiGateFinal {
    static constexpr bool PERM = true, AFTER_DRAIN = false;
    const float* ssq_in; const bf16_t* base; const bf16_t* pp; float* ssq_out; unsigned* cnt; const float* gain; float* outp; PG8_LAS float* rtab;
    __device__ __forceinline__ void operator()(const f32x4 (&acc)[2][2][4][2], const Unit& u_, int wr, int wc, int fr, int fq) const {
        Unit u; { int pm_ = u_.pm, pn_ = u_.pn; asm volatile("" : "+s"(pm_), "+s"(pn_)); u.pm = pm_; u.pn = pn_; }
        const int row0 = u.pm * BM + wr * 64 + fr, col0 = u.pn * BM + wc * 32 + 8 * fq;
        f32x4 hv[2][2][4][2];
#pragma unroll
        for (int ai = 0; ai < 2; ++ai)
#pragma unroll
            for (int mp = 0; mp < 2; ++mp) {
                u32x4 bw[2][2], pq[2][2]; float rs[2];
#pragma unroll
                for (int mi = 0; mi < 2; ++mi) {
                    const int row = row0 + ai * HALF + (2 * mp + mi) * 16;
#pragma unroll
                    for (int bj = 0; bj < 2; ++bj) { const size_t off = (size_t)row * DMODEL + col0 + bj * HALF; bw[mi][bj] = *(const u32x4*)(base + off); pq[mi][bj] = *(const u32x4*)(pp + off); }
                }
#pragma unroll
                for (int mi = 0; mi < 2; ++mi) rs[mi] = row_rstd(ssq_in, row0 + ai * HALF + (2 * mp + mi) * 16);
                asm volatile("" ::: "memory");
#pragma unroll
                for (int mi = 0; mi < 2; ++mi) {
                    const int m = 2 * mp + mi; const int row = row0 + ai * HALF + m * 16; float q = 0.f;
#pragma unroll
                    for (int bj = 0; bj < 2; ++bj) {
                        const u32x4 b_ = bw[mi][bj], p_ = pq[mi][bj];
                        const float bb[8] = {bf_lo(b_.x), bf_hi(b_.x), bf_lo(b_.y), bf_hi(b_.y), bf_lo(b_.z), bf_hi(b_.z), bf_lo(b_.w), bf_hi(b_.w)};
                        const float pv[8] = {bf_lo(p_.x), bf_hi(p_.x), bf_lo(p_.y), bf_hi(p_.y), bf_lo(p_.z), bf_hi(p_.z), bf_lo(p_.w), bf_hi(p_.w)};
                        const f32x4 g0 = acc[ai][bj][m][0] * rs[mi], g1 = acc[ai][bj][m][1] * rs[mi];
                        const float gg[8] = {g0[0], g0[1], g0[2], g0[3], g1[0], g1[1], g1[2], g1[3]};
                        float v[8];
#pragma unroll
                        for (int i = 0; i < 8; ++i) { v[i] = bb[i] + pv[i] * sigmoid_f(gg[i]); q += v[i] * v[i]; }
                        hv[ai][bj][m][0] = (f32x4){v[0], v[1], v[2], v[3]}; hv[ai][bj][m][1] = (f32x4){v[4], v[5], v[6], v[7]};
                    }
                    ssq_write(ssq_out, q, row, u.pn * 4 + wc, fq);
                }
                asm volatile("" ::: "memory");
            }
        asm volatile("s_waitcnt vmcnt(0)" ::: "memory"); __builtin_amdgcn_s_barrier(); asm volatile("" ::: "memory");
        if (wr == 0 && wc == 0) {
            if (fr == 0 && fq == 0) {
                __builtin_amdgcn_fence(__ATOMIC_RELEASE, "agent");
                asm volatile("s_waitcnt vmcnt(0)" ::: "memory");
                __hip_atomic_fetch_add(cnt + 64 * u.pm, 1u, __ATOMIC_RELAXED, __HIP_MEMORY_SCOPE_AGENT);
            }
            unsigned sp = 0;
            while (__hip_atomic_load(cnt + 64 * u.pm, __ATOMIC_RELAXED, __HIP_MEMORY_SCOPE_AGENT) < 4u) { __builtin_amdgcn_s_sleep(2); if (++sp > (1u << 22)) break; }
        }
        asm volatile("" ::: "memory"); __builtin_amdgcn_s_barrier(); asm volatile("" ::: "memory");
        if (wr == 0) rtab[wc * 64 + fq * 16 + fr] = row_rstd_coh(ssq_out, u.pm * BM + wc * 64 + fq * 16 + fr);
        asm volatile("s_waitcnt lgkmcnt(0)" ::: "memory"); __builtin_amdgcn_s_barrier(); asm volatile("" ::: "memory");
        f32x4 gn[2][2];
#pragma unroll
        for (int bj = 0; bj < 2; ++bj)
#pragma unroll
            for (int n = 0; n < 2; ++n) gn[bj][n] = *(const f32x4*)(gain + col0 + bj * HALF + 4 * n);
#pragma unroll
        for (int ai = 0; ai < 2; ++ai)
#pragma unroll
            for (int m = 0; m < 4; ++m) {
                const float rsf = rtab[ai * HALF + wr * 64 + m * 16 + fr];
                float* orow = outp + (size_t)(row0 + ai * HALF + m * 16) * DMODEL + col0;
#pragma unroll
                for (int bj = 0; bj < 2; ++bj)
#pragma unroll
                    for (int n = 0; n < 2; ++n) *(f32x4*)(orow + bj * HALF + 4 * n) = hv[ai][bj][m][n] * rsf * gn[bj][n];
            }
    }
};
struct EpiBf16Plain {
    static constexpr bool PERM = true, AFTER_DRAIN = false;
    bf16_t* O; int ldc;
    __device__ __forceinline__ void operator()(const f32x4 (&acc)[2][2][4][2], const Unit& u_, int wr, int wc, int fr, int fq) const {
        Unit u; { int pm_ = u_.pm, pn_ = u_.pn; asm volatile("" : "+s"(pm_), "+s"(pn_)); u.pm = pm_; u.pn = pn_; }
        const int row0 = u.pm * BM + wr * 64 + fr, col0 = u.pn * BM + wc * 32 + 8 * fq;
#pragma unroll
        for (int ai = 0; ai < 2; ++ai)
#pragma unroll
            for (int m = 0; m < 4; ++m) {
                const int row = row0 + ai * HALF + m * 16;
#pragma unroll
                for (int bj = 0; bj < 2; ++bj) {
                    const f32x4 v0 = acc[ai][bj][m][0], v1 = acc[ai][bj][m][1];
                    u32x4 w; w.x = cvt_pk_bf16(v0[0], v0[1]); w.y = cvt_pk_bf16(v0[2], v0[3]); w.z = cvt_pk_bf16(v1[0], v1[1]); w.w = cvt_pk_bf16(v1[2], v1[3]);
                    *(u32x4*)(O + (size_t)row * ldc + col0 + bj * HALF) = w;
                }
            }
    }
};
struct EpiEvenIn {
    static constexpr bool PERM = true, AFTER_DRAIN = false;
    const float* ssq_in; bf16_t* Z; const f32x2* rope;
    __device__ __forceinline__ void operator()(const f32x4 (&acc)[2][2][4][2], const Unit& u_, int wr, int wc, int fr, int fq) const {
        Unit u; { int pm_ = u_.pm, pn_ = u_.pn; asm volatile("" : "+s"(pm_), "+s"(pn_)); u.pm = pm_; u.pn = pn_; }
        const int row0 = u.pm * BM + wr * 64 + fr, colw = wc * 32 + 8 * fq;
        const int pn = u.pn;
        const float sc = (pn == 2 || pn == 3) ? C2 : 1.0f;
#pragma unroll
        for (int ai = 0; ai < 2; ++ai)
#pragma unroll
            for (int m = 0; m < 4; ++m) {
                const int row = row0 + ai * HALF + m * 16;
                const float rs = row_rstd(ssq_in, row);
#pragma unroll
                for (int bj = 0; bj < 2; ++bj) {
                    const int gi = 2 * bj + (wc >> 1);
                    const bool ropeg = (pn == 2 || pn == 3 || pn == 5 || (pn == 4 && (gi == 0 || gi == 2))) && ((wc & 1) == 0);
                    f32x4 v0 = acc[ai][bj][m][0] * rs, v1 = acc[ai][bj][m][1] * rs;
                    if (ropeg && fq < 2) {
                        const f32x4* rp = (const f32x4*)(rope + (size_t)row * 8 + 4 * fq);
                        const f32x4 ra = rp[0], rb = rp[1];
                        f32x4 o0, o1;
                        o0[0] = v0[0] * ra[0] - v0[1] * ra[1]; o0[1] = v0[1] * ra[0] + v0[0] * ra[1];
                        o0[2] = v0[2] * ra[2] - v0[3] * ra[3]; o0[3] = v0[3] * ra[2] + v0[2] * ra[3];
                        o1[0] = v1[0] * rb[0] - v1[1] * rb[1]; o1[1] = v1[1] * rb[0] + v1[0] * rb[1];
                        o1[2] = v1[2] * rb[2] - v1[3] * rb[3]; o1[3] = v1[3] * rb[2] + v1[2] * rb[3];
                        v0 = o0; v1 = o1;
                    }
                    v0 = v0 * sc; v1 = v1 * sc;
                    u32x4 w; w.x = cvt_pk_bf16(v0[0], v0[1]); w.y = cvt_pk_bf16(v0[2], v0[3]); w.z = cvt_pk_bf16(v1[0], v1[1]); w.w = cvt_pk_bf16(v1[2], v1[3]);
                    *(u32x4*)(Z + (size_t)row * EV_N + pn * BM + bj * HALF + colw) = w;
                }
            }
    }
};
struct EpiOddIn {
    static constexpr bool PERM = true, AFTER_DRAIN = false;
    const float* ssq_in; bf16_t* Z; float* F; float* sst;
    __device__ __forceinline__ void operator()(const f32x4 (&acc)[2][2][4][2], const Unit& u_, int wr, int wc, int fr, int fq) const {
        Unit u; { int pm_ = u_.pm, pn_ = u_.pn; asm volatile("" : "+s"(pm_), "+s"(pn_)); u.pm = pm_; u.pn = pn_; }
        const int row0 = u.pm * BM + wr * 64 + fr, colw = wc * 32 + 8 * fq;
        const int pn = u.pn;
        const float sc = (pn < 2) ? C2 : 1.0f;
        const bool act = (pn >= 6 && pn < 10), stat = (pn == 8 || pn == 9);
#pragma unroll
        for (int ai = 0; ai < 2; ++ai)
#pragma unroll
            for (int m = 0; m < 4; ++m) {
                const int row = row0 + ai * HALF + m * 16;
                const float rs = row_rstd(ssq_in, row);
                if (pn == 10) {
                    if (wc == 0 && fq == 0) { *(f32x4*)(F + (size_t)row * 8) = acc[ai][0][m][0] * rs; *(f32x4*)(F + (size_t)row * 8 + 4) = acc[ai][0][m][1] * rs; }
                    continue;
                }
                float s1 = 0.f, s2 = 0.f;
#pragma unroll
                for (int bj = 0; bj < 2; ++bj) {
                    f32x4 v0 = acc[ai][bj][m][0] * (rs * sc), v1 = acc[ai][bj][m][1] * (rs * sc);
                    if (act) {
#pragma unroll
                        for (int i = 0; i < 4; ++i) { v0[i] = gelu_tanh(v0[i]); v1[i] = gelu_tanh(v1[i]); }
                    }
                    s1 += ((v0[0] + v0[1]) + (v0[2] + v0[3])) + ((v1[0] + v1[1]) + (v1[2] + v1[3])); s2 += sq4(v0) + sq4(v1);
                    u32x4 w; w.x = cvt_pk_bf16(v0[0], v0[1]); w.y = cvt_pk_bf16(v0[2], v0[3]); w.z = cvt_pk_bf16(v1[0], v1[1]); w.w = cvt_pk_bf16(v1[2], v1[3]);
                    *(u32x4*)(Z + (size_t)row * Z1P + pn * BM + bj * HALF + colw) = w;
                }
                if (stat) {
                    s1 += xor16_f(s1); s1 = halves_sum_f(s1); s2 += xor16_f(s2); s2 = halves_sum_f(s2);
                    if (fq == 0) *(f32x2*)(sst + ((size_t)row * 8 + (pn - 8) * 4 + wc) * 2) = (f32x2){s1, s2};
                }
            }
    }
};
struct EpiHalo {
    static constexpr bool PERM = true, AFTER_DRAIN = false;
    const float* ssq_in; float* AH;
    __device__ __forceinline__ void operator()(const f32x4 (&acc)[2][2][4][2], const Unit& u_, int wr, int wc, int fr, int fq) const {
        Unit u; { int pm_ = u_.pm, pn_ = u_.pn; asm volatile("" : "+s"(pm_), "+s"(pn_)); u.pm = pm_; u.pn = pn_; }
        const int col0 = u.pn * BM + wc * 32 + 8 * fq;
#pragma unroll
        for (int m = 0; m < 4; ++m) {
            const int rh = wr * 64 + m * 16 + fr;
            if (rh < 2) continue;
            const int tok = 256 * (rh >> 1) - 2 + (rh & 1);
            const float rs = row_rstd(ssq_in, tok);
#pragma unroll
            for (int bj = 0; bj < 2; ++bj) {
                *(f32x4*)(AH + (size_t)rh * NFF2 + col0 + bj * HALF) = acc[0][bj][m][0] * rs;
                *(f32x4*)(AH + (size_t)rh * NFF2 + col0 + bj * HALF + 4) = acc[0][bj][m][1] * rs;
            }
        }
    }
};
template <int SEL> __device__ __forceinline__ float dpp1(const float old, const float src) {
    const int o = __builtin_bit_cast(int, old), s = __builtin_bit_cast(int, src); int t;
    if (SEL == 0) t = __builtin_amdgcn_update_dpp(o, s, 0x111, 0xf, 0xf, false);
    else if (SEL == 1) t = __builtin_amdgcn_update_dpp(o, s, 0x112, 0xf, 0xf, false);
    else if (SEL == 2) t = __builtin_amdgcn_update_dpp(o, s, 0x10F, 0xf, 0xf, false);
    else t = __builtin_amdgcn_update_dpp(o, s, 0x10E, 0xf, 0xf, false);
    return __builtin_bit_cast(float, t);
}
template <int SEL> __device__ __forceinline__ f32x4 dpp4t(const f32x4 old, const f32x4 src) {
    const float o0 = old[0], o1 = old[1], o2 = old[2], o3 = old[3], s0 = src[0], s1 = src[1], s2 = src[2], s3 = src[3];
    const float r0 = dpp1<SEL>(o0, s0), r1 = dpp1<SEL>(o1, s1), r2 = dpp1<SEL>(o2, s2), r3 = dpp1<SEL>(o3, s3);
    return (f32x4){r0, r1, r2, r3};
}
#define dpp4(old, src, sel) dpp4t<sel>(old, src)
__device__ __forceinline__ void conv_taps(f32x4& c, const f32x4 cur, const f32x4 prev, const f32x4 w0, const f32x4 w1) {
    float c0 = c[0], c1 = c[1], c2 = c[2], c3 = c[3];
    const float x0 = cur[0], x1 = cur[1], x2 = cur[2], x3 = cur[3], p0 = prev[0], p1 = prev[1], p2 = prev[2], p3 = prev[3];
    const float a0 = w1[0], a1 = w1[1], a2 = w1[2], a3 = w1[3], b0 = w0[0], b1 = w0[1], b2 = w0[2], b3 = w0[3];
    asm("s_nop 4\n\t"
        "v_fmac_f32_dpp %0, %4, %12 row_shr:1 row_mask:0xf bank_mask:0xf bound_ctrl:1\n\t"
        "v_fmac_f32_dpp %1, %5, %13 row_shr:1 row_mask:0xf bank_mask:0xf bound_ctrl:1\n\t"
        "v_fmac_f32_dpp %2, %6, %14 row_shr:1 row_mask:0xf bank_mask:0xf bound_ctrl:1\n\t"
        "v_fmac_f32_dpp %3, %7, %15 row_shr:1 row_mask:0xf bank_mask:0xf bound_ctrl:1\n\t"
        "v_fmac_f32_dpp %0, %4, %16 row_shr:2 row_mask:0xf bank_mask:0xf bound_ctrl:1\n\t"
        "v_fmac_f32_dpp %1, %5, %17 row_shr:2 row_mask:0xf bank_mask:0xf bound_ctrl:1\n\t"
        "v_fmac_f32_dpp %2, %6, %18 row_shr:2 row_mask:0xf bank_mask:0xf bound_ctrl:1\n\t"
        "v_fmac_f32_dpp %3, %7, %19 row_shr:2 row_mask:0xf bank_mask:0xf bound_ctrl:1\n\t"
        "v_fmac_f32_dpp %0, %8, %12 row_shl:15 row_mask:0xf bank_mask:0xf bound_ctrl:1\n\t"
        "v_fmac_f32_dpp %1, %9, %13 row_shl:15 row_mask:0xf bank_mask:0xf bound_ctrl:1\n\t"
        "v_fmac_f32_dpp %2, %10, %14 row_shl:15 row_mask:0xf bank_mask:0xf bound_ctrl:1\n\t"
        "v_fmac_f32_dpp %3, %11, %15 row_shl:15 row_mask:0xf bank_mask:0xf bound_ctrl:1\n\t"
        "v_fmac_f32_dpp %0, %8, %16 row_shl:14 row_mask:0xf bank_mask:0xf bound_ctrl:1\n\t"
        "v_fmac_f32_dpp %1, %9, %17 row_shl:14 row_mask:0xf bank_mask:0xf bound_ctrl:1\n\t"
        "v_fmac_f32_dpp %2, %10, %18 row_shl:14 row_mask:0xf bank_mask:0xf bound_ctrl:1\n\t"
        "v_fmac_f32_dpp %3, %11, %19 row_shl:14 row_mask:0xf bank_mask:0xf bound_ctrl:1"
        : "+v"(c0), "+v"(c1), "+v"(c2), "+v"(c3)
        : "v"(x0), "v"(x1), "v"(x2), "v"(x3), "v"(p0), "v"(p1), "v"(p2), "v"(p3), "v"(a0), "v"(a1), "v"(a2), "v"(a3), "v"(b0), "v"(b1), "v"(b2), "v"(b3));
    c[0] = c0; c[1] = c1; c[2] = c2; c[3] = c3;
}
struct EpiHaloF {
    static constexpr bool PERM = true, AFTER_DRAIN = false;
    const float* ssq_in; float* ah; unsigned* flags;
    __device__ __forceinline__ void operator()(const f32x4 (&acc)[2][2][4][2], const Unit& u_, int wr, int wc, int fr, int fq) const {
        Unit u; { int pm_ = u_.pm, pn_ = u_.pn; asm volatile("" : "+s"(pm_), "+s"(pn_)); u.pm = pm_; u.pn = pn_; }
        const int col0 = u.pn * BM + wc * 32 + 8 * fq;
#pragma unroll
        for (int m = 0; m < 4; ++m) {
            const int rh = wr * 64 + m * 16 + fr;
            if (rh >= 2) {
                const int tok = 256 * (rh >> 1) - 2 + (rh & 1);
                const float rsh = row_rstd(ssq_in, tok);
#pragma unroll
                for (int bj = 0; bj < 2; ++bj) {
                    *(f32x4*)(ah + (size_t)rh * NFF2 + col0 + bj * HALF) = acc[0][bj][m][0] * rsh;
                    *(f32x4*)(ah + (size_t)rh * NFF2 + col0 + bj * HALF + 4) = acc[0][bj][m][1] * rsh;
                }
            }
        }
        asm volatile("s_waitcnt vmcnt(0)" ::: "memory"); __builtin_amdgcn_s_barrier(); asm volatile("" ::: "memory");
        if (wr == 0 && wc == 0 && fr == 0 && fq == 0) {
            __builtin_amdgcn_fence(__ATOMIC_RELEASE, "agent");
            asm volatile("s_waitcnt vmcnt(0)" ::: "memory");
            __hip_atomic_store(flags + 64 * u.pn, 1u, __ATOMIC_RELAXED, __HIP_MEMORY_SCOPE_AGENT);
        }
    }
};
struct EpiFfnIn {
    static constexpr bool PERM = true, AFTER_DRAIN = false;
    const float* ssq_in; const float* cw; const float* cb; float* ah; bf16_t* hid; PG8_LAS float* xb; unsigned* flags; unsigned phase_id;
    __device__ __forceinline__ void operator()(const f32x4 (&acc)[2][2][4][2], const Unit& u_, int wr, int wc, int fr, int fq) const {
        Unit u; { int pm_ = u_.pm, pn_ = u_.pn; asm volatile("" : "+s"(pm_), "+s"(pn_)); u.pm = pm_; u.pn = pn_; }
        PG8_LAS float* rtab = xb + 2048;
        const int row0 = u.pm * BM + wr * 64 + fr;
        PG8_LAS float* cwl = xb + 2432 + wc * 256;
        PG8_LAS float* hl = xb + 3456 + wc * 128;
        if (wr == 0) {
            const float* src = (fq < 3 ? cw + fq * NFF2 : cb) + (fr >> 3) * DFF + 128 * u.pn + wc * 32 + (fr & 7) * 4;
            const f32x4 wv = *(const f32x4*)src;
            rtab[wc * 64 + fq * 16 + fr] = row_rstd(ssq_in, u.pm * BM + wc * 64 + fq * 16 + fr);
            *(PG8_LAS f32x4*)(cwl + (fq * 16 + fr) * 4) = wv;
        }
        if (fr >= 14) {
#pragma unroll
            for (int ai = 0; ai < 2; ++ai) {
                PG8_LAS f32x4* dst = (PG8_LAS f32x4*)(xb + ((((ai * 2 + wr) * 4 + wc) * 2 + (fr - 14)) * 4 + fq) * 16);
#pragma unroll
                for (int bj = 0; bj < 2; ++bj)
#pragma unroll
                    for (int n = 0; n < 2; ++n) dst[bj * 2 + n] = acc[ai][bj][3][n];
            }
        }
        asm volatile("s_waitcnt lgkmcnt(0)" ::: "memory"); __builtin_amdgcn_s_barrier(); asm volatile("" ::: "memory");
        const bool has = (u.pm & 7) != 0;
        if (wr == 0) {
            PG8_LAS unsigned* stamp = (PG8_LAS unsigned*)(rtab + 256);
            if (*(volatile PG8_LAS unsigned*)stamp != phase_id) {
                if (wc == 0) {
                    unsigned sp = 0;
                    for (int t = 0; t < NFF2 / BM; ++t)
                        while (__hip_atomic_load(flags + 64 * t, __ATOMIC_RELAXED, __HIP_MEMORY_SCOPE_AGENT) == 0u) { __builtin_amdgcn_s_sleep(2); if (++sp > (1u << 22)) break; }
                    asm volatile("s_waitcnt vmcnt(0)" ::: "memory");
                    if (fr == 0 && fq == 0) *(volatile PG8_LAS unsigned*)stamp = phase_id;
                } else {
                    unsigned sp = 0;
                    while (*(volatile PG8_LAS unsigned*)stamp != phase_id) { __builtin_amdgcn_s_sleep(2); if (++sp > (1u << 22)) break; }
                }
            }
        }
        if (wr == 0) {
            f32x2 hv = {0.f, 0.f};
            if (has) hv = *(const f32x2*)(ah + (size_t)(2 * u.pm + (fq >> 1)) * NFF2 + (size_t)u.pn * BM + (fq & 1) * HALF + wc * 32 + 2 * fr);
            *(PG8_LAS f32x2*)(hl + (fq * 16 + fr) * 2) = hv;
        }
        float rs[2][4];
#pragma unroll
        for (int ai = 0; ai < 2; ++ai)
#pragma unroll
            for (int m = 0; m < 4; ++m) rs[ai][m] = rtab[ai * HALF + wr * 64 + m * 16 + fr];
        const f32x4 zero4 = {0.f, 0.f, 0.f, 0.f};
#pragma unroll
        for (int ai = 0; ai < 2; ++ai) {
#pragma unroll
            for (int n = 0; n < 2; ++n) {
                f32x4 cg[4];
#pragma unroll
                for (int bj = 0; bj < 2; ++bj) {
                    f32x4 b0, b1;
                    if (ai == 0 && wr == 0) {
                        b0 = *(const PG8_LAS f32x4*)(hl + (0 * 2 + bj) * 32 + 8 * fq + 4 * n);
                        b1 = *(const PG8_LAS f32x4*)(hl + (1 * 2 + bj) * 32 + 8 * fq + 4 * n);
                    } else {
                        const int sa = (wr == 1) ? ai : ai - 1, sw = (wr == 1) ? 0 : 1;
                        const float r0 = rtab[sa * HALF + sw * 64 + 62], r1 = rtab[sa * HALF + sw * 64 + 63];
                        b0 = *(const PG8_LAS f32x4*)(xb + ((((sa * 2 + sw) * 4 + wc) * 2 + 0) * 4 + fq) * 16 + (bj * 2 + n) * 4) * r0;
                        b1 = *(const PG8_LAS f32x4*)(xb + ((((sa * 2 + sw) * 4 + wc) * 2 + 1) * 4 + fq) * 16 + (bj * 2 + n) * 4) * r1;
                    }
                    const int oc = bj * 32 + 8 * fq + 4 * n;
                    const f32x4 w0 = *(const PG8_LAS f32x4*)(cwl + oc), w1 = *(const PG8_LAS f32x4*)(cwl + 64 + oc), w2 = *(const PG8_LAS f32x4*)(cwl + 128 + oc), bb = *(const PG8_LAS f32x4*)(cwl + 192 + oc);
                    f32x4 prev = (fr == 14) ? b0 : b1;
#pragma unroll
                    for (int m = 0; m < 4; ++m) {
                        const f32x4 cur = acc[ai][bj][m][n] * rs[ai][m];
                        f32x4 c = w2 * cur + bb;
                        conv_taps(c, cur, prev, w0, w1);
                        prev = cur;
                        if (bj == 0) cg[m] = c;
                        else {
                            const f32x2 ha = gelu_mul2((f32x2){cg[m][0], cg[m][1]}, (f32x2){c[0], c[1]}), hb = gelu_mul2((f32x2){cg[m][2], cg[m][3]}, (f32x2){c[2], c[3]});
                            u32x2 w; w.x = cvt_pk_bf16(ha.x, ha.y); w.y = cvt_pk_bf16(hb.x, hb.y);
                            const int row = row0 + ai * HALF + m * 16;
                            *(u32x2*)(hid + (size_t)row * DFF + 128 * u.pn + wc * 32 + 8 * fq + 4 * n) = w;
                        }
                    }
                    asm volatile("" ::: "memory");
                }
            }
        }
    }
};
template <class Epi, class Sched, bool ALIGN_EPI = false, bool SP2 = false>
__device__ __forceinline__ void gemm_phase(PG8_LAS unsigned char* lds, const Gemm g, const Sched& S, const Epi& E, const int wave_s) {
    const int tid_ = wave_s * 64 + lane_opaque(); const int tid = tid_, wid = __builtin_amdgcn_readfirstlane(tid >> 6), lane = tid & 63, wr = wid >> 2, wc = wid & 3, fr = lane & 15, fq = lane >> 4;
    const int K = g.K, nt = K / BK;
    unsigned voffA[2], voffB[2];
#pragma unroll
    for (int i = 0; i < 2; ++i) { int R, C; stage_rc(tid * 16 + i * 8192, R, C); const int Rb = Epi::PERM ? ((R & ~31) + perm32(R & 31)) : R;
        voffA[i] = (unsigned)(R * K + C) * 2u; voffB[i] = (unsigned)(Rb * K + C) * 2u; }
    const size_t kstep = (size_t)(BK * 2);
    const size_t hstep = (size_t)HALF * K * 2;
    const size_t tstep = 2 * hstep;
    const unsigned ldsw = (unsigned)wid * 1024u;
    const int aoff = lds_byte(wr * 64 + fr, fq * 8), boff = lds_byte(wc * 32 + fr, fq * 8);
#define PG8_SA(b, h) (((b) * 2 + (h)) * HTB)
#define PG8_SB(b, h) ((4 + (b) * 2 + (h)) * HTB)
#define PG8_STAGE(bufoff, gbase, voff) do { _Pragma("unroll") for (int _i = 0; _i < 2; ++_i) \
        __builtin_amdgcn_global_load_lds((const unsigned*)((const char*)(gbase) + (voff)[_i]), (PG8_LAS unsigned*)(lds + (bufoff) + ldsw + _i * 8192), 16, 0, 0); } while (0)
#define PG8_LDA(dst, b, h) do { _Pragma("unroll") for (int m = 0; m < 4; ++m) _Pragma("unroll") for (int k = 0; k < 2; ++k) dst[m][k] = *(const PG8_LAS bf16x8*)(lds + PG8_SA(b, h) + aoff + m * 2048 + k * 1024); } while (0)
#define PG8_LDB(dst, b, h) do { _Pragma("unroll") for (int n = 0; n < 2; ++n) _Pragma("unroll") for (int k = 0; k < 2; ++k) dst[n][k] = *(const PG8_LAS bf16x8*)(lds + PG8_SB(b, h) + boff + n * 2048 + k * 1024); } while (0)
#define PG8_MMA(ai, bj, At, Bt) do { __builtin_amdgcn_s_setprio(1); _Pragma("unroll") for (int m = 0; m < 4; ++m) _Pragma("unroll") for (int n = 0; n < 2; ++n) _Pragma("unroll") for (int k = 0; k < 2; ++k) \
        acc[ai][bj][m][n] = __builtin_amdgcn_mfma_f32_16x16x32_bf16(Bt[n][k], At[m][k], acc[ai][bj][m][n], 0, 0, 0); __builtin_amdgcn_s_setprio(0); } while (0)
#define PG8_WAIT_V(n) asm volatile("s_waitcnt vmcnt(" #n ")" ::: "memory")
#define PG8_WAIT_L(n) asm volatile("s_waitcnt lgkmcnt(" #n ")" ::: "memory")
#define PG8_BAR __builtin_amdgcn_s_barrier()
#define PG8_SCHED __builtin_amdgcn_sched_barrier(0)
    Unit cur, nxt; int ui = 0;
    if (!S.next(0, cur)) return;
    f32x4 acc[2][2][4][2];
#pragma unroll
    for (int a = 0; a < 2; ++a)
#pragma unroll
        for (int b = 0; b < 2; ++b)
#pragma unroll
            for (int m = 0; m < 4; ++m)
#pragma unroll
                for (int n = 0; n < 2; ++n) acc[a][b][m][n] = (f32x4){0.f, 0.f, 0.f, 0.f};
    bf16x8 At[4][2], B0[2][2], B1[2][2];
    const char* cA = (const char*)g.A + (size_t)cur.pm * tstep; const char* cB = (const char*)g.Bt + (size_t)cur.pn * tstep;
    S.a_ready(cur);
    if constexpr (SP2) {
        PG8_STAGE(PG8_SB(0, 0), cB, voffB); PG8_STAGE(PG8_SB(0, 1), cB + hstep, voffB); PG8_STAGE(PG8_SA(0, 0), cA, voffA); PG8_STAGE(PG8_SA(0, 1), cA + hstep, voffA);
        if (wr == 1) PG8_BAR;
        PG8_WAIT_V(2); PG8_BAR;
        PG8_STAGE(PG8_SB(1, 0), cB + kstep, voffB); PG8_STAGE(PG8_SA(1, 0), cA + kstep, voffA); PG8_STAGE(PG8_SB(1, 1), cB + hstep + kstep, voffB);
        PG8_WAIT_V(6); PG8_BAR;
    } else {
        PG8_STAGE(PG8_SB(0, 0), cB, voffB); PG8_STAGE(PG8_SA(0, 0), cA, voffA); PG8_STAGE(PG8_SB(0, 1), cB + hstep, voffB); PG8_STAGE(PG8_SA(0, 1), cA + hstep, voffA);
        if (wr == 1) PG8_BAR;
        PG8_WAIT_V(4); PG8_BAR;
        PG8_STAGE(PG8_SB(1, 0), cB + kstep, voffB); PG8_STAGE(PG8_SA(1, 0), cA + kstep, voffA); PG8_STAGE(PG8_SB(1, 1), cB + hstep + kstep, voffB);
        PG8_WAIT_V(6); PG8_BAR;
    }
    for (;;) {
        const bool has_next = S.next(ui + 1, nxt);
        const char* nA = has_next ? (const char*)g.A + (size_t)nxt.pm * tstep : cA; const char* nB = has_next ? (const char*)g.Bt + (size_t)nxt.pn * tstep : cB;
        for (int t = 0; t < nt; t += 2) {
            const bool last = (t == nt - 2);
            const char* a1 = cA + (size_t)(t + 1) * kstep;
            const char* a2 = last ? nA : cA + (size_t)(t + 2) * kstep; const char* b2 = last ? nB : cB + (size_t)(t + 2) * kstep;
            const char* a3 = a2 + kstep; const char* b3 = b2 + kstep;
            if (last && has_next) S.a_ready(nxt);
            if constexpr (SP2) {
            PG8_LDB(B0, 0, 0); PG8_LDB(B1, 0, 1); PG8_SCHED; PG8_LDA(At, 0, 0); PG8_STAGE(PG8_SA(1, 1), a1 + hstep, voffA);
            PG8_WAIT_V(8); PG8_WAIT_L(0); PG8_BAR; PG8_MMA(0, 0, At, B0); PG8_MMA(0, 1, At, B1); PG8_BAR; PG8_SCHED;
            PG8_LDA(At, 0, 1); PG8_STAGE(PG8_SB(0, 0), b2, voffB); PG8_STAGE(PG8_SB(0, 1), b2 + hstep, voffB); PG8_STAGE(PG8_SA(0, 0), a2, voffA);
            PG8_WAIT_V(8); PG8_WAIT_L(0); PG8_BAR; PG8_MMA(1, 0, At, B0); PG8_MMA(1, 1, At, B1); PG8_BAR; PG8_SCHED;
            PG8_LDB(B0, 1, 0); PG8_LDB(B1, 1, 1); PG8_SCHED; PG8_LDA(At, 1, 0); PG8_STAGE(PG8_SA(0, 1), a2 + hstep, voffA);
            PG8_WAIT_V(8); PG8_WAIT_L(0); PG8_BAR; PG8_MMA(0, 0, At, B0); PG8_MMA(0, 1, At, B1); PG8_BAR; PG8_SCHED;
            PG8_LDA(At, 1, 1); PG8_STAGE(PG8_SB(1, 0), b3, voffB); PG8_STAGE(PG8_SB(1, 1), b3 + hstep, voffB); PG8_STAGE(PG8_SA(1, 0), a3, voffA);
            PG8_WAIT_V(8); PG8_WAIT_L(0); PG8_BAR; PG8_MMA(1, 0, At, B0); PG8_MMA(1, 1, At, B1); PG8_BAR; PG8_SCHED;
            } else {
            PG8_LDB(B0, 0, 0); PG8_SCHED; PG8_LDA(At, 0, 0); PG8_STAGE(PG8_SA(1, 1), a1 + hstep, voffA);
            PG8_WAIT_L(8); PG8_BAR; PG8_WAIT_L(0); PG8_MMA(0, 0, At, B0); PG8_BAR; PG8_SCHED;
            PG8_LDB(B1, 0, 1); PG8_STAGE(PG8_SB(0, 0), b2, voffB);
            PG8_BAR; PG8_WAIT_L(0); PG8_MMA(0, 1, At, B1); PG8_BAR;
            PG8_LDA(At, 0, 1); PG8_STAGE(PG8_SA(0, 0), a2, voffA);
            PG8_BAR; PG8_WAIT_L(0); PG8_MMA(1, 0, At, B0); PG8_BAR; PG8_SCHED;
            PG8_STAGE(PG8_SB(0, 1), b2 + hstep, voffB);
            PG8_WAIT_V(6); PG8_BAR; PG8_MMA(1, 1, At, B1); PG8_BAR;
            PG8_LDB(B0, 1, 0); PG8_SCHED; PG8_LDA(At, 1, 0); PG8_STAGE(PG8_SA(0, 1), a2 + hstep, voffA);
            PG8_WAIT_L(8); PG8_BAR; PG8_WAIT_L(0); PG8_MMA(0, 0, At, B0); PG8_BAR; PG8_SCHED;
            PG8_LDB(B1, 1, 1); PG8_STAGE(PG8_SB(1, 0), b3, voffB);
            PG8_BAR; PG8_WAIT_L(0); PG8_MMA(0, 1, At, B1); PG8_BAR;
            PG8_LDA(At, 1, 1); PG8_STAGE(PG8_SA(1, 0), a3, voffA);
            PG8_BAR; PG8_WAIT_L(0); PG8_MMA(1, 0, At, B0); PG8_BAR; PG8_SCHED;
            PG8_STAGE(PG8_SB(1, 1), b3 + hstep, voffB);
            PG8_WAIT_V(6); PG8_BAR; PG8_MMA(1, 1, At, B1); PG8_BAR;
            }
        }
        if constexpr (ALIGN_EPI) { if (wr == 0) PG8_BAR; }
        if constexpr (!Epi::AFTER_DRAIN) { E(acc, cur, wr, wc, fr, fq); S.done(cur); }
        if (!has_next) break;
#pragma unroll
        for (int a = 0; a < 2; ++a)
#pragma unroll
            for (int b = 0; b < 2; ++b)
#pragma unroll
                for (int m = 0; m < 4; ++m)
#pragma unroll
                    for (int n = 0; n < 2; ++n) acc[a][b][m][n] = (f32x4){0.f, 0.f, 0.f, 0.f};
        cur = nxt; cA = nA; cB = nB; ++ui;
        if constexpr (ALIGN_EPI) { if (wr == 1) PG8_BAR; }
    }
    PG8_WAIT_V(0);
    if constexpr (!ALIGN_EPI) { if (wr == 0) PG8_BAR; }
    PG8_BAR;
    if constexpr (Epi::AFTER_DRAIN) { E.fused(acc, cur, wr, wc, fr, fq, lds, wid, lane); S.done(cur); }
#undef PG8_SA
#undef PG8_SB
#undef PG8_STAGE
#undef PG8_LDA
#undef PG8_LDB
#undef PG8_MMA
#undef PG8_WAIT_V
#undef PG8_WAIT_L
#undef PG8_BAR
#undef PG8_SCHED
}
}
namespace mix {
#define MLAS __attribute__((address_space(3)))
typedef unsigned short bf16_t;
typedef short bf16x8 __attribute__((ext_vector_type(8)));
typedef short s16x4 __attribute__((ext_vector_type(4)));
typedef float f32x16 __attribute__((ext_vector_type(16)));
typedef float f32x4 __attribute__((ext_vector_type(4)));
typedef float f32x2 __attribute__((ext_vector_type(2)));
typedef unsigned u32x4 __attribute__((ext_vector_type(4)));
typedef unsigned u32x2 __attribute__((ext_vector_type(2)));
typedef MLAS const char* lds_cptr;
typedef short v4i16_t __attribute__((ext_vector_type(4)));
typedef __bf16 bf16x2_t __attribute__((ext_vector_type(2)));

constexpr int SLOTB = 8192;
constexpr int NSLOT = 4;
constexpr int L_K = 0, L_V = NSLOT * SLOTB, L_WSF = 2 * NSLOT * SLOTB, L_OST = L_WSF + 8 * 256, L_X = L_OST + 8 * 4096;
constexpr int LX_IQ = L_X, LX_EQ = L_X, LX_PFX = L_X + 8192, LX_CNT = LX_IQ + 16384, LX_GT = LX_CNT + 2048, LX_SEL = LX_GT, LX_END = LX_GT + 8192;
static_assert(LX_END <= 131072, "mixer LDS map");

__device__ __forceinline__ int crow(int r, int hi) { return (r & 3) + 8 * (r >> 2) + 4 * hi; }
__device__ __forceinline__ void glds16(const void* gsrc, unsigned lds_dst) { unsigned keep;
    asm volatile("s_mov_b32 %0, m0\n\ts_mov_b32 m0, %2\n\ts_nop 0\n\tglobal_load_lds_dwordx4 %1, off\n\ts_mov_b32 m0, %0" : "=&s"(keep) : "v"(gsrc), "s"(lds_dst) : "memory"); }
__device__ __forceinline__ unsigned cvtpk(float lo, float hi) { f32x2 v = {lo, hi}; bf16x2_t b = __builtin_convertvector(v, bf16x2_t); return __builtin_bit_cast(unsigned, b); }
__device__ __forceinline__ s16x4 vtr(lds_cptr p) { return __builtin_bit_cast(s16x4, __builtin_amdgcn_ds_read_tr16_b64_v4i16((MLAS v4i16_t*)p)); }
#define WAITV_BAR() asm volatile("s_waitcnt vmcnt(0) lgkmcnt(0)\n\ts_barrier" ::: "memory")
#define LGKM_BAR() asm volatile("s_waitcnt lgkmcnt(0)\n\ts_barrier" ::: "memory")
#define WAITV2_BAR() asm volatile("s_waitcnt vmcnt(2) lgkmcnt(0)\n\ts_barrier" ::: "memory")

__device__ __forceinline__ void dma_kv(const bf16_t* kbase, const bf16_t* vbase, int pitch, unsigned lds0, int slot, int wid, int lane) {
    const bf16_t* ks = kbase + (size_t)lane * pitch + wid * 8;
    const bf16_t* vs = vbase + (size_t)(16 * (wid & 3) + (lane >> 2)) * pitch + (wid >> 2) * 32 + (lane & 3) * 8;
    glds16(ks, (unsigned)__builtin_amdgcn_readfirstlane(lds0 + L_K + slot * SLOTB + wid * 1024));
    glds16(vs, (unsigned)__builtin_amdgcn_readfirstlane(lds0 + L_V + slot * SLOTB + wid * 1024));
}
__device__ __forceinline__ void kload(bf16x8 (&kf)[8], lds_cptr kslot, int r32, int hi) {
    lds_cptr kb = kslot + hi * 1024 + r32 * 16;
#pragma unroll
    for (int d0 = 0; d0 < 4; ++d0) { kf[2 * d0] = *(const MLAS bf16x8*)(kb + d0 * 2048); kf[2 * d0 + 1] = *(const MLAS bf16x8*)(kb + d0 * 2048 + 512); }
}
__device__ __forceinline__ void qkt_mma(f32x16& p0, f32x16& p1, const bf16x8 (&kf)[8], const bf16x8* qr, const f32x16& cinit) {
    p0 = __builtin_amdgcn_mfma_f32_32x32x16_bf16(kf[0], qr[0], cinit, 0, 0, 0); p1 = __builtin_amdgcn_mfma_f32_32x32x16_bf16(kf[1], qr[0], cinit, 0, 0, 0);
#pragma unroll
    for (int d0 = 1; d0 < 4; ++d0) { p0 = __builtin_amdgcn_mfma_f32_32x32x16_bf16(kf[2 * d0], qr[d0], p0, 0, 0, 0); p1 = __builtin_amdgcn_mfma_f32_32x32x16_bf16(kf[2 * d0 + 1], qr[d0], p1, 0, 0, 0); }
}
__device__ __forceinline__ void qkt(f32x16& p0, f32x16& p1, lds_cptr kslot, const bf16x8* qr, const f32x16& cinit, int r32, int hi) {
    bf16x8 kf[8]; kload(kf, kslot, r32, hi); qkt_mma(p0, p1, kf, qr, cinit);
}
__device__ __forceinline__ void vload(bf16x8 (&vf)[8], lds_cptr vslot, int lane, int hi) {
    lds_cptr vp = vslot + ((lane >> 4) & 1) * 32 + (lane & 3) * 8 + (4 * hi + ((lane & 15) >> 2)) * 64;
#pragma unroll
    for (int d0 = 0; d0 < 2; ++d0)
#pragma unroll
        for (int ks = 0; ks < 4; ++ks) {
            const s16x4 lo = vtr(vp + d0 * 4096 + ks * 1024), hh = vtr(vp + d0 * 4096 + ks * 1024 + 512);
            vf[d0 * 4 + ks] = (bf16x8){lo[0], lo[1], lo[2], lo[3], hh[0], hh[1], hh[2], hh[3]};
        }
}
#define V16_TO_ARR(v, a, o) do { a[(o) + 0] = v[0]; a[(o) + 1] = v[1]; a[(o) + 2] = v[2]; a[(o) + 3] = v[3]; a[(o) + 4] = v[4]; a[(o) + 5] = v[5]; a[(o) + 6] = v[6]; a[(o) + 7] = v[7]; \
    a[(o) + 8] = v[8]; a[(o) + 9] = v[9]; a[(o) + 10] = v[10]; a[(o) + 11] = v[11]; a[(o) + 12] = v[12]; a[(o) + 13] = v[13]; a[(o) + 14] = v[14]; a[(o) + 15] = v[15]; } while (0)
__device__ __forceinline__ f32x16 splat16(float x) { return (f32x16){x, x, x, x, x, x, x, x, x, x, x, x, x, x, x, x}; }
struct AttnState { f32x16 o[2]; float m, l, pend; bool started; };
constexpr float ATT_THR = 8.0f;
__device__ __forceinline__ void softmax_pv(AttnState& st, float (&sc)[32], const bf16x8 (&vf)[8], MLAS float* wsf, int lane, int r32, int hi) {
    if (__any(st.pend != 0.f)) {
#pragma unroll
        for (int r = 0; r < 32; ++r) sc[r] -= st.pend;
    }
    st.pend = 0.f;
    float ra = __builtin_fmaxf(__builtin_fmaxf(sc[0], sc[1]), sc[2]), rb = __builtin_fmaxf(__builtin_fmaxf(sc[3], sc[4]), sc[5]);
#pragma unroll
    for (int r = 6; r < 30; r += 4) { ra = __builtin_fmaxf(__builtin_fmaxf(ra, sc[r]), sc[r + 1]); rb = __builtin_fmaxf(__builtin_fmaxf(rb, sc[r + 2]), sc[r + 3]); }
    float rm = __builtin_fmaxf(__builtin_fmaxf(ra, rb), __builtin_fmaxf(sc[30], sc[31]));
    rm = halves_max_f(rm);
    const bool fresh = !st.started;
    const bool need = (rm > ATT_THR) || (fresh && rm < -ATT_THR && rm > -1e29f);
    st.started = st.started || (rm > -1e29f);
    if (__any(need)) {
        const float dl = need ? rm : 0.f;
        st.m += dl; st.pend = dl;
#pragma unroll
        for (int r = 0; r < 32; ++r) sc[r] -= dl;
        const float alpha = fresh ? 1.0f : __builtin_amdgcn_exp2f(-dl);
        st.l *= alpha;
        if (hi == 0) wsf[r32] = alpha;
        float fr_[16];
#pragma unroll
        for (int r = 0; r < 16; ++r) fr_[r] = wsf[crow(r, hi)];
        const f32x16 fv = {fr_[0], fr_[1], fr_[2], fr_[3], fr_[4], fr_[5], fr_[6], fr_[7], fr_[8], fr_[9], fr_[10], fr_[11], fr_[12], fr_[13], fr_[14], fr_[15]};
        st.o[0] = st.o[0] * fv; st.o[1] = st.o[1] * fv;
    }
    float pe[32]; float s0 = 0.f, s1 = 0.f;
#pragma unroll
    for (int r = 0; r < 32; r += 2) { pe[r] = __builtin_amdgcn_exp2f(sc[r]); pe[r + 1] = __builtin_amdgcn_exp2f(sc[r + 1]); s0 += pe[r]; s1 += pe[r + 1]; }
    st.l += s0 + s1;
    u32x4 pw[4];
#pragma unroll
    for (int k = 0; k < 4; ++k) pw[k] = (u32x4){cvtpk(pe[8 * k + 0], pe[8 * k + 1]), cvtpk(pe[8 * k + 2], pe[8 * k + 3]), cvtpk(pe[8 * k + 4], pe[8 * k + 5]), cvtpk(pe[8 * k + 6], pe[8 * k + 7])};
#pragma unroll
    for (int d0 = 0; d0 < 2; ++d0)
#pragma unroll
        for (int ks = 0; ks < 4; ++ks) st.o[d0] = __builtin_amdgcn_mfma_f32_32x32x16_bf16(__builtin_bit_cast(bf16x8, pw[ks]), vf[d0 * 4 + ks], st.o[d0], 0, 0, 0);
}
__device__ __forceinline__ void attn_store(AttnState& st, bf16_t* Ow, int pitch, MLAS float* wsf, MLAS bf16_t* stg, int lane, int r32, int hi) {
    float l = halves_sum_f(st.l);
    if (hi == 0) wsf[32 + r32] = l;
    float rli[16];
#pragma unroll
    for (int r = 0; r < 16; ++r) rli[r] = 1.0f / wsf[32 + crow(r, hi)];
#pragma unroll
    for (int r = 0; r < 16; ++r) { const int orow = crow(r, hi);
#pragma unroll
        for (int d0 = 0; d0 < 2; ++d0) { const unsigned short b = (unsigned short)(cvtpk(st.o[d0][r] * rli[r], 0.f) & 0xffffu); stg[orow * 64 + d0 * 32 + r32] = b; } }
#pragma unroll
    for (int i = 0; i < 4; ++i) { const int row = i * 8 + (lane >> 3), ch = lane & 7; const u32x4 v = *(const MLAS u32x4*)(stg + row * 64 + ch * 8); *(u32x4*)(Ow + (size_t)row * pitch + ch * 8) = v; }
}

#ifndef DBG_REP_BS
#define DBG_REP_BS 1
#endif
__device__ __forceinline__ unsigned pk_sub_sat_u16(unsigned a, unsigned b) { unsigned r; asm("v_pk_sub_u16 %0, %1, %2 clamp" : "=v"(r) : "v"(a), "v"(b)); return r; }
__device__ __forceinline__ unsigned pk_min_u16(unsigned a, unsigned b) { unsigned r; asm("v_pk_min_u16 %0, %1, %2" : "=v"(r) : "v"(a), "v"(b)); return r; }
__device__ __forceinline__ unsigned pk_add_u16(unsigned a, unsigned b) { unsigned r; asm("v_pk_add_u16 %0, %1, %2" : "=v"(r) : "v"(a), "v"(b)); return r; }
__device__ __forceinline__ unsigned pk_ashr_i16(unsigned a, unsigned sh2) { unsigned r; asm("v_pk_ashrrev_i16 %0, %1, %2" : "=v"(r) : "v"(sh2), "v"(a)); return r; }
__device__ __forceinline__ unsigned score_keys(float a, float b) {
    const unsigned p = __builtin_bit_cast(unsigned, __builtin_amdgcn_cvt_pkrtz(a, b));
    const unsigned m = pk_ashr_i16(p, 0x000f000fu);
    return p ^ (m | 0x80008000u);
}
template <int NS> __device__ __forceinline__ unsigned bit_search(const unsigned (&kp)[8][8], MLAS unsigned* cntx, int wid, int r32, int hi) {
    unsigned tau = 0u;
#pragma unroll 1
    for (int bit = 15; bit >= 0; --bit) {
        const unsigned cand = tau | (1u << bit);
        const unsigned c2 = (cand - 1u) * 0x00010001u;
        unsigned cnt2 = 0;
#pragma unroll
        for (int jj = 0; jj < NS; ++jj)
#pragma unroll
            for (int r = 0; r < 8; ++r) cnt2 = pk_add_u16(cnt2, pk_min_u16(pk_sub_sat_u16(kp[jj][r], c2), 0x00010001u));
        unsigned cnt = (cnt2 & 0xffffu) + (cnt2 >> 16);
        cnt = halves_add_u(cnt);
        MLAS unsigned* cb = cntx + (bit & 1) * 256;
        if (hi == 0) cb[wid * 32 + r32] = cnt;
        LGKM_BAR();
        unsigned tot = 0;
#pragma unroll
        for (int w = 0; w < 8; ++w) tot += cb[w * 32 + r32];
        if (tot >= 256u) tau = cand;
    }
    return tau;
}
__device__ __forceinline__ void lds_inc(MLAS unsigned* p) { const unsigned one = 1u; asm volatile("ds_add_u32 %0, %1" :: "v"((unsigned)(uintptr_t)p), "v"(one) : "memory"); }
template <int NS> __device__ __forceinline__ unsigned radix_select(const unsigned (&kp)[8][8], MLAS char* L, int tid, int r32) {
    MLAS unsigned* h1 = (MLAS unsigned*)L; MLAS unsigned* h2 = h1 + 8224; MLAS unsigned* part = h2 + 8224; MLAS unsigned* res = part + 512;
    for (int i = tid; i < 2 * 8224; i += 512) h1[i] = 0u;
    LGKM_BAR();
    MLAS unsigned* col1 = h1 + r32; MLAS unsigned* col2 = h2 + r32;
#pragma unroll
    for (int jj = 0; jj < NS; ++jj)
#pragma unroll
        for (int r = 0; r < 8; ++r) { const unsigned k = kp[jj][r]; lds_inc(col1 + ((k >> 3) & 0x1fe0u)); lds_inc(col1 + ((k >> 19) & 0x1fe0u)); }
    LGKM_BAR();
    const int q = tid & 31, p = tid >> 5;
    { unsigned s = 0;
#pragma unroll
      for (int b = 0; b < 16; ++b) s += h1[(16 * p + b) * 32 + q];
      part[p * 32 + q] = s; }
    LGKM_BAR();
    { unsigned above = 0;
#pragma unroll
      for (int pp = 0; pp < 16; ++pp) { const unsigned v = part[pp * 32 + q]; above += (pp > p) ? v : 0u; }
      const unsigned s = part[p * 32 + q];
      if (above < 256u && above + s >= 256u) {
          unsigned cum = above, bsel = 0u, asel = 0u; bool found = false;
#pragma unroll
          for (int b = 15; b >= 0; --b) { const unsigned c = h1[(16 * p + b) * 32 + q]; if (!found && cum + c >= 256u) { bsel = (unsigned)(16 * p + b); asel = cum; found = true; } cum += c; }
          res[q] = bsel | (asel << 16);
      } }
    LGKM_BAR();
    const unsigned b1 = res[r32] & 0xffffu;
#pragma unroll
    for (int jj = 0; jj < NS; ++jj)
#pragma unroll
        for (int r = 0; r < 8; ++r) { const unsigned k = kp[jj][r];
            lds_inc(col2 + ((((k >> 8) & 0xffu) == b1) ? ((k & 0xffu) << 5) : 8192u));
            lds_inc(col2 + (((k >> 24) == b1) ? ((k >> 11) & 0x1fe0u) : 8192u)); }
    LGKM_BAR();
    const unsigned rq = res[q]; const unsigned need = 256u - (rq >> 16);
    { unsigned s = 0;
#pragma unroll
      for (int b = 0; b < 16; ++b) s += h2[(16 * p + b) * 32 + q];
      part[p * 32 + q] = s; }
    LGKM_BAR();
    { unsigned above = 0;
#pragma unroll
      for (int pp = 0; pp < 16; ++pp) { const unsigned v = part[pp * 32 + q]; above += (pp > p) ? v : 0u; }
      const unsigned s = part[p * 32 + q];
      if (above < need && above + s >= need) {
          unsigned cum = above, lsel = 0u; bool found = false;
#pragma unroll
          for (int b = 15; b >= 0; --b) { const unsigned c = h2[(16 * p + b) * 32 + q]; if (!found && cum + c >= need) { lsel = (unsigned)(16 * p + b); found = true; } cum += c; }
          res[32 + q] = ((rq & 0xffffu) << 8) | lsel;
      } }
    LGKM_BAR();
    return res[32 + r32];
}
__device__ __forceinline__ void dsa_select(int b, int qg, const bf16_t* Z0, char* shm, const int wave_s) {
    const int tid_ = wave_s * 64 + lane_opaque(); const int tid = tid_, lane = tid & 63, r32 = lane & 31, hi = lane >> 5; const int wid = __builtin_amdgcn_readfirstlane(tid >> 6);
    MLAS char* L = (MLAS char*)shm;
    const int c = qg >> 1, nkeys = 64 * (c + 1), nt32 = nkeys >> 5, nt64 = nkeys >> 6;
    const size_t rowb = (size_t)b * SEQ;
    const size_t tok0 = rowb + 32 * qg;
    MLAS unsigned* selw = (MLAS unsigned*)(L + LX_SEL);
    if (nkeys <= 256) {
        for (int i = tid; i < 64 * 32; i += 512) selw[i] = (i < nt32 * 32) ? 0xffffffffu : 0u;
    } else {
        {
            MLAS u32x4* iqL = (MLAS u32x4*)(L + LX_IQ);
            for (int i = tid; i < 1024; i += 512) { const int q = i & 31, hh = (i >> 5) & 1, d0 = (i >> 6) & 3, h = i >> 8;
                iqL[i] = *(const u32x4*)(Z0 + (tok0 + q) * EV_N + 1280 + 64 * h + 16 * d0 + 8 * hh); }
        }
        float w4[4];
        { const u32x2 ww = *(const u32x2*)(Z0 + (tok0 + r32) * EV_N + 1216);
          w4[0] = pg8::bf_lo(ww.x) * 0.0625f; w4[1] = pg8::bf_hi(ww.x) * 0.0625f; w4[2] = pg8::bf_lo(ww.y) * 0.0625f; w4[3] = pg8::bf_hi(ww.y) * 0.0625f; }
        LGKM_BAR();
        unsigned kp[8][8];
        const int nslots = (nt32 + 7) >> 3;
        const MLAS bf16x8* iqf = (const MLAS bf16x8*)(L + LX_IQ) + hi * 32 + r32;
#pragma unroll
        for (int jj = 0; jj < 8; ++jj) {
            const int j = wid + 8 * jj;
            if (j < nt32) {
                const bf16_t* ikp = Z0 + (rowb + 32 * j + r32) * EV_N + 1152 + 8 * hi;
                bf16x8 af[4];
#pragma unroll
                for (int d0 = 0; d0 < 4; ++d0) af[d0] = *(const bf16x8*)(ikp + 16 * d0);
                f32x16 ah[4];
#pragma unroll
                for (int h = 0; h < 4; ++h) {
                    f32x16 a = {};
#pragma unroll
                    for (int d0 = 0; d0 < 4; ++d0) a = __builtin_amdgcn_mfma_f32_32x32x16_bf16(af[d0], iqf[(h * 4 + d0) * 64], a, 0, 0, 0);
                    ah[h] = a;
                }
                float sv[16];
                {
                    float a0[16], a1[16], a2[16], a3[16];
                    V16_TO_ARR(ah[0], a0, 0); V16_TO_ARR(ah[1], a1, 0); V16_TO_ARR(ah[2], a2, 0); V16_TO_ARR(ah[3], a3, 0);
#pragma unroll
                    for (int r = 0; r < 16; ++r) sv[r] = ((__builtin_fmaxf(a0[r], 0.f) * w4[0] + __builtin_fmaxf(a1[r], 0.f) * w4[1]) + __builtin_fmaxf(a2[r], 0.f) * w4[2]) + __builtin_fmaxf(a3[r], 0.f) * w4[3];
                }
#pragma unroll
                for (int r = 0; r < 8; ++r) kp[jj][r] = score_keys(sv[r], sv[r + 8]);
            } else {
#pragma unroll
                for (int r = 0; r < 8; ++r) kp[jj][r] = 0u;
            }
        }
        MLAS unsigned* cntx = (MLAS unsigned*)(L + L_OST);
        unsigned tau;
        for (int rep_ = 0; rep_ < DBG_REP_BS; ++rep_)
#ifdef DSA_BIT_SEARCH
        switch (nslots) {
            case 2: tau = bit_search<2>(kp, cntx, wid, r32, hi); break;
            case 3: tau = bit_search<3>(kp, cntx, wid, r32, hi); break;
            case 4: tau = bit_search<4>(kp, cntx, wid, r32, hi); break;
            case 5: tau = bit_search<5>(kp, cntx, wid, r32, hi); break;
            case 6: tau = bit_search<6>(kp, cntx, wid, r32, hi); break;
            case 7: tau = bit_search<7>(kp, cntx, wid, r32, hi); break;
            default: tau = bit_search<8>(kp, cntx, wid, r32, hi); break;
        }
#else
        switch (nslots) {
            case 2: tau = radix_select<2>(kp, L, tid, r32); break;
            case 3: tau = radix_select<3>(kp, L, tid, r32); break;
            case 4: tau = radix_select<4>(kp, L, tid, r32); break;
            case 5: tau = radix_select<5>(kp, L, tid, r32); break;
            case 6: tau = radix_select<6>(kp, L, tid, r32); break;
            case 7: tau = radix_select<7>(kp, L, tid, r32); break;
            default: tau = radix_select<8>(kp, L, tid, r32); break;
        }
        (void)cntx;
#endif
        MLAS unsigned* gtw = (MLAS unsigned*)(L + LX_GT); MLAS unsigned* eqw = (MLAS unsigned*)(L + LX_EQ); MLAS unsigned* pfx = (MLAS unsigned*)(L + LX_PFX);
        const unsigned tg = tau * 0x00010001u, te = (tau - 1u) * 0x00010001u;
#pragma unroll
        for (int jj = 0; jj < 8; ++jj) {
            const int j = wid + 8 * jj;
            if (j < nt32) {
                unsigned g = 0, e = 0;
#pragma unroll
                for (int r = 0; r < 8; ++r) {
                    const unsigned dgt = pk_min_u16(pk_sub_sat_u16(kp[jj][r], tg), 0x00010001u), dge = pk_min_u16(pk_sub_sat_u16(kp[jj][r], te), 0x00010001u);
                    const int pos = (r & 3) + 8 * (r >> 2);
                    g |= dgt << pos; e |= (dge - dgt) << pos;
                }
                g <<= 4 * hi; e <<= 4 * hi;
                g = halves_or_u(g); e = halves_or_u(e);
                if (hi == 0) { gtw[j * 32 + r32] = g; eqw[j * 32 + r32] = e; }
            }
        }
        LGKM_BAR();
        if (wid == 0 && hi == 0) {
            unsigned cg = 0;
            for (int j = 0; j < nt32; ++j) cg += __builtin_popcount(gtw[j * 32 + r32]);
            const int need = 256 - (int)cg;
            int run = 0;
            for (int j = 0; j < nt32; ++j) { const unsigned e = eqw[j * 32 + r32]; int k = need - run; k = k < 0 ? 0 : (k > 32 ? 32 : k); pfx[j * 32 + r32] = (unsigned)k; run += __builtin_popcount(e); }
        }
        LGKM_BAR();
        for (int i = tid; i < nt32 * 32; i += 512) {
            const unsigned g = gtw[i], e = eqw[i]; const int k = (int)pfx[i];
            unsigned take = 0;
            if (e != 0u && k > 0) {
                unsigned rem = e; int cntk = 0;
                while (rem != 0u && cntk < k) { const unsigned low = rem & (0u - rem); take |= low; rem ^= low; ++cntk; }
            }
            selw[i] = g | take;
        }
        for (int i = nt32 * 32 + tid; i < 64 * 32; i += 512) selw[i] = 0u;
    }
    WAITV_BAR();
}

__device__ __forceinline__ void fox_unit(int b, int h, int qb, const bf16_t* Z1, const float* F, const float* bfp, bf16_t* Y, char* shm, unsigned lds0, const int wave_s) {
    const int tid_ = wave_s * 64 + lane_opaque(); const int tid = tid_, lane = tid & 63, r32 = lane & 31, hi = lane >> 5; const int wid = __builtin_amdgcn_readfirstlane(tid >> 6);
    MLAS char* L = (MLAS char*)shm;
    const size_t rowb = (size_t)b * SEQ;
    const int NT = 4 * (qb + 1), nk = 64 * NT;
    MLAS float* cum2 = (MLAS float*)(L + L_X);
    MLAS float* wtot = (MLAS float*)(L + L_X + 8192);
    const bf16_t* Kb = Z1 + rowb * Z1P + 512 + 64 * h; const bf16_t* Vb = Z1 + rowb * Z1P + 1024 + 64 * h;
#pragma unroll
    for (int i = 0; i < 3; ++i) dma_kv(Kb + (size_t)64 * i * Z1P, Vb + (size_t)64 * i * Z1P, Z1P, lds0, i, wid, lane);
    {
        const float bias = bfp[h];
        const int s0 = 4 * tid;
        float v[4]; float run = 0.f;
#pragma unroll
        for (int i = 0; i < 4; ++i) {
            float x = 0.f;
            if (s0 + i < nk) x = F[(rowb + s0 + i) * 8 + h] + bias;
            const float ls = (s0 + i < nk) ? (fminf(x, 0.f) - log1pf(expf(-fabsf(x)))) : 0.f;
            run += ls; v[i] = run;
        }
        float inc = run;
#pragma unroll
        for (int o = 1; o < 64; o <<= 1) { const int ln = lane_opaque(); const float t = __builtin_bit_cast(float, __builtin_amdgcn_ds_bpermute((ln - o) << 2, __builtin_bit_cast(int, inc))); if (ln >= o) inc += t; }
        if (lane == 63) wtot[wid] = inc;
        LGKM_BAR();
        float off = inc - run;
        for (int w = 0; w < wid; ++w) off += wtot[w];
#pragma unroll
        for (int i = 0; i < 4; ++i) cum2[s0 + i] = (off + v[i]) * 1.4426950408889634f;
    }
    const int tq = 256 * qb + 32 * wid + r32;
    bf16x8 qr[4];
#pragma unroll
    for (int d0 = 0; d0 < 4; ++d0) qr[d0] = *(const bf16x8*)(Z1 + (rowb + tq) * Z1P + 64 * h + 16 * d0 + 8 * hi);
    AttnState st; st.o[0] = f32x16{}; st.o[1] = f32x16{}; st.m = 0.f; st.l = 0.f; st.pend = 0.f; st.started = false;
    MLAS float* wsf = (MLAS float*)(L + L_WSF) + wid * 64;
    WAITV_BAR();
    const float cq2 = cum2[tq];
    const int tlast = 4 * qb + (wid >> 1);
    f32x16 s0, s1;
    qkt(s0, s1, (lds_cptr)(L + L_K), qr, splat16(-st.m), r32, hi);
    for (int t = 0; t < NT; ++t) {
        const int slot = t & 3;
        { const int tt = (t + 3 < NT) ? t + 3 : NT - 1; dma_kv(Kb + (size_t)64 * tt * Z1P, Vb + (size_t)64 * tt * Z1P, Z1P, lds0, (t + 3) & 3, wid, lane); }
        bf16x8 kf[8], vf[8];
        kload(kf, (lds_cptr)(L + L_K + ((t + 1) & 3) * SLOTB), r32, hi);
        __builtin_amdgcn_sched_barrier(0);
        vload(vf, (lds_cptr)(L + L_V + slot * SLOTB), lane, hi);
        const MLAS float* cb = cum2 + 64 * t + 4 * hi;
        f32x4 c0[4], c1[4];
#pragma unroll
        for (int g = 0; g < 4; ++g) { c0[g] = *(const MLAS f32x4*)(cb + 8 * g); c1[g] = *(const MLAS f32x4*)(cb + 32 + 8 * g); }
        f32x16 n0, n1;
        qkt_mma(n0, n1, kf, qr, splat16(-st.m));
        float sc[32];
        V16_TO_ARR(s0, sc, 0); V16_TO_ARR(s1, sc, 16);
#pragma unroll
        for (int g = 0; g < 4; ++g) {
            sc[4 * g + 0] += cq2 - c0[g].x; sc[4 * g + 1] += cq2 - c0[g].y; sc[4 * g + 2] += cq2 - c0[g].z; sc[4 * g + 3] += cq2 - c0[g].w;
            sc[16 + 4 * g + 0] += cq2 - c1[g].x; sc[16 + 4 * g + 1] += cq2 - c1[g].y; sc[16 + 4 * g + 2] += cq2 - c1[g].z; sc[16 + 4 * g + 3] += cq2 - c1[g].w;
        }
        if (t >= tlast) {
            const int qrel = tq - 64 * t;
#pragma unroll
            for (int r = 0; r < 16; ++r) { const int kr = crow(r, hi); if (kr > qrel) sc[r] = -INFINITY; if (kr + 32 > qrel) sc[16 + r] = -INFINITY; }
        }
        softmax_pv(st, sc, vf, wsf, lane, r32, hi);
        s0 = n0; s1 = n1;
        WAITV2_BAR();
    }
    attn_store(st, Y + (rowb + 256 * qb + 32 * wid) * DMODEL + 64 * h, DMODEL, wsf, (MLAS bf16_t*)(L + L_OST) + wid * 2048, lane, r32, hi);
    WAITV_BAR();
}

__device__ __forceinline__ void sgu_unit(int b, int n, int g, const bf16_t* Z1, const float* sst, const float* lng, const float* lnb, const bf16_t* Wm, const float* bs, bf16_t* Y, char* shm, const int wave_s) {
    const int tid_ = wave_s * 64 + lane_opaque(); const int tid = tid_, lane = tid & 63, r32 = lane & 31, hi = lane >> 5; const int wid = __builtin_amdgcn_readfirstlane(tid >> 6);
    MLAS char* L = (MLAS char*)shm;
    MLAS bf16_t* vn = (MLAS bf16_t*)L;
    constexpr int VP = 136;
    const size_t tok0 = (size_t)b * SEQ + 128 * n;
    {
        const int j = tid >> 2, cq = (tid & 3) * 32;
        const float* sp = sst + (tok0 + j) * 16;
        float s1 = 0.f, s2 = 0.f;
#pragma unroll
        for (int k = 0; k < 8; ++k) { s1 += sp[2 * k]; s2 += sp[2 * k + 1]; }
        const float mu = s1 * (1.0f / 512.0f); const float var = fmaxf(s2 * (1.0f / 512.0f) - mu * mu, 0.f);
        const float rstd = 1.0f / sqrtf(var + RMS_EPS);
        const bf16_t* vp = Z1 + (tok0 + j) * Z1P + 2048 + 128 * g + cq;
#pragma unroll
        for (int k = 0; k < 4; ++k) {
            const u32x4 w = *(const u32x4*)(vp + 8 * k);
            const int cc = 128 * g + cq + 8 * k;
            const f32x4 g0 = *(const f32x4*)(lng + cc), g1 = *(const f32x4*)(lng + cc + 4), b0 = *(const f32x4*)(lnb + cc), b1 = *(const f32x4*)(lnb + cc + 4);
            float x[8] = {pg8::bf_lo(w.x), pg8::bf_hi(w.x), pg8::bf_lo(w.y), pg8::bf_hi(w.y), pg8::bf_lo(w.z), pg8::bf_hi(w.z), pg8::bf_lo(w.w), pg8::bf_hi(w.w)};
            float y[8];
#pragma unroll
            for (int i = 0; i < 4; ++i) { y[i] = (x[i] - mu) * rstd * g0[i] + b0[i]; y[4 + i] = (x[4 + i] - mu) * rstd * g1[i] + b1[i]; }
            u32x4 o; o.x = cvtpk(y[0], y[1]); o.y = cvtpk(y[2], y[3]); o.z = cvtpk(y[4], y[5]); o.w = cvtpk(y[6], y[7]);
            *(MLAS u32x4*)(vn + j * VP + cq + 8 * k) = o;
        }
    }
    LGKM_BAR();
    MLAS bf16_t* ut = (MLAS bf16_t*)(L + 128 * VP * 2);
    {
        const int j = tid >> 2, cq = (tid & 3) * 32;
        const bf16_t* up = Z1 + (tok0 + j) * Z1P + 1536 + 128 * g + cq;
#pragma unroll
        for (int k = 0; k < 4; ++k) *(MLAS u32x4*)(ut + j * VP + cq + 8 * k) = *(const u32x4*)(up + 8 * k);
    }
    LGKM_BAR();
    const int ib = wid & 3;
    const bf16_t* wrow = Wm + ((size_t)g * 128 + 32 * ib + r32) * 128 + 8 * hi;
    bf16x8 af[8];
#pragma unroll
    for (int s = 0; s < 8; ++s) af[s] = *(const bf16x8*)(wrow + 16 * s);
#pragma unroll
    for (int cbi = 0; cbi < 2; ++cbi) {
        const int cb = (wid >> 2) * 2 + cbi;
        f32x16 acc = {};
        lds_cptr bp = (lds_cptr)(vn) + ((size_t)(8 * hi + ((lane & 15) >> 2)) * VP + 32 * cb + 16 * ((lane >> 4) & 1) + 4 * (lane & 3)) * 2;
#pragma unroll
        for (int s = 0; s < 8; ++s) {
            const s16x4 lo = vtr(bp + (16 * s) * VP * 2), hh = vtr(bp + (16 * s + 4) * VP * 2);
            const bf16x8 bfr = {lo[0], lo[1], lo[2], lo[3], hh[0], hh[1], hh[2], hh[3]};
            acc = __builtin_amdgcn_mfma_f32_32x32x16_bf16(af[s], bfr, acc, 0, 0, 0);
        }
        float a16[16]; V16_TO_ARR(acc, a16, 0);
#pragma unroll
        for (int r = 0; r < 16; ++r) {
            const int i = 32 * ib + crow(r, hi), cc = 32 * cb + r32;
            const float uu = __builtin_bit_cast(float, (unsigned)ut[i * VP + cc] << 16);
            const float o = uu * (a16[r] + bs[g * 128 + i]);
            ut[i * VP + cc] = (bf16_t)(cvtpk(o, 0.f) & 0xffffu);
        }
    }
    LGKM_BAR();
    {
        const int j = tid >> 2, cq = (tid & 3) * 32;
        bf16_t* yp = Y + (tok0 + j) * DMODEL + 512 + 128 * g + cq;
#pragma unroll
        for (int k = 0; k < 4; ++k) *(u32x4*)(yp + 8 * k) = *(const MLAS u32x4*)(ut + j * VP + cq + 8 * k);
    }
    LGKM_BAR();
}

__device__ __forceinline__ void pool_item(int item, const bf16_t* Z0, bf16_t* Y) {
    const int row = item >> 6, ch = item & 63, c0 = ch * 8, g = ch >> 4;
    const int w = 2 << g, tpos = row & (SEQ - 1);
    const int cnt = (tpos + 1 < w) ? tpos + 1 : w;
    u32x4 v[16];
#pragma unroll
    for (int k = 0; k < 16; ++k) { v[k] = (u32x4){0u, 0u, 0u, 0u}; if (k < cnt) v[k] = *(const u32x4*)(Z0 + (size_t)(row - k) * EV_N + c0); }
    float s[8] = {0.f, 0.f, 0.f, 0.f, 0.f, 0.f, 0.f, 0.f};
#pragma unroll
    for (int k = 0; k < 16; ++k) {
        s[0] += pg8::bf_lo(v[k].x); s[1] += pg8::bf_hi(v[k].x); s[2] += pg8::bf_lo(v[k].y); s[3] += pg8::bf_hi(v[k].y);
        s[4] += pg8::bf_lo(v[k].z); s[5] += pg8::bf_hi(v[k].z); s[6] += pg8::bf_lo(v[k].w); s[7] += pg8::bf_hi(v[k].w);
    }
    const float self[8] = {pg8::bf_lo(v[0].x), pg8::bf_hi(v[0].x), pg8::bf_lo(v[0].y), pg8::bf_hi(v[0].y), pg8::bf_lo(v[0].z), pg8::bf_hi(v[0].z), pg8::bf_lo(v[0].w), pg8::bf_hi(v[0].w)};
    const float inv = 1.0f / (float)cnt;
    u32x4 o; o.x = cvtpk(s[0] * inv - self[0], s[1] * inv - self[1]); o.y = cvtpk(s[2] * inv - self[2], s[3] * inv - self[3]);
    o.z = cvtpk(s[4] * inv - self[4], s[5] * inv - self[5]); o.w = cvtpk(s[6] * inv - self[6], s[7] * inv - self[7]);
    *(u32x4*)(Y + (size_t)row * DMODEL + c0) = o;
}
}
namespace foxa {
using bf16=__hip_bfloat16;
using bf16x8=__attribute__((ext_vector_type(8)))short;
using s16x4=__attribute__((ext_vector_type(4)))short;
using f32x16=__attribute__((ext_vector_type(16)))float;
using u32x4=__attribute__((ext_vector_type(4)))unsigned;
using f32x4v=__attribute__((ext_vector_type(4)))float;
constexpr int CUM_OFF=86016;
constexpr int SEQL=2048,D=64,OPI=1024;
constexpr int NW=8,QBLK=32,QB=QBLK*NW,KVBLK=64;
__device__ __forceinline__ int crow(int r,int hi){return (r&3)+8*(r>>2)+4*hi;}
#define SBAR() __builtin_amdgcn_sched_barrier(0)
__device__ __forceinline__ void cmask(f32x16&p0,f32x16&p1,int jb,int qrel,int hi){
  const float NEG=-INFINITY; int kb=64*jb+4*hi;
  #pragma unroll
  for(int r=0;r<16;++r){int kv=kb+(r&3)+8*(r>>2); if(kv>qrel)p0[r]=NEG; if(kv+32>qrel)p1[r]=NEG;}
}

constexpr int NSLOT=3, SLOTB=8192;
constexpr int LDS_K=0, LDS_V=NSLOT*SLOTB, LDS_WS=2*NSLOT*SLOTB, LDS_OST=LDS_WS+NW*64*4, LDS_BYTES=LDS_OST+NW*4096;
constexpr float C2=0.125f*1.4426950408889634f;
__device__ __forceinline__ void glds16(const void*gsrc,unsigned lds_dst){unsigned keep;
  asm volatile("s_mov_b32 %0, m0\n\ts_mov_b32 m0, %2\n\ts_nop 0\n\tglobal_load_lds_dwordx4 %1, off\n\ts_mov_b32 m0, %0":"=&s"(keep):"v"(gsrc),"s"(lds_dst):"memory");}
__device__ __forceinline__ float max3f(float a,float b,float c){float r;asm("v_max3_f32 %0, %1, %2, %3":"=v"(r):"v"(a),"v"(b),"v"(c));return r;}
__device__ __forceinline__ float max2f(float a,float b){float r;asm("v_max_f32_e32 %0, %1, %2":"=v"(r):"v"(a),"v"(b));return r;}
__device__ __forceinline__ float fadd_s(float a,float b){float r;asm("v_add_f32_e32 %0, %1, %2":"=v"(r):"v"(a),"v"(b));return r;}
__device__ __forceinline__ float fsub_s(float a,float b){float r;asm("v_sub_f32_e32 %0, %1, %2":"=v"(r):"v"(a),"v"(b));return r;}
typedef float f32x2_t __attribute__((ext_vector_type(2))); typedef __bf16 bf16x2_t __attribute__((ext_vector_type(2)));
__device__ __forceinline__ unsigned cvtpk_s(float lo,float hi){f32x2_t v={lo,hi};bf16x2_t b=__builtin_convertvector(v,bf16x2_t);return __builtin_bit_cast(unsigned,b);}
#define WAIT_BAR(N) asm volatile("s_waitcnt vmcnt(" #N ") lgkmcnt(0)\n\ts_barrier":::"memory")

__device__ __forceinline__ void qkt(f32x16&p0,f32x16&p1,const char*Kslot,const bf16x8*qr,const f32x16&negm,int r32,int hi){
  const char*kb=Kslot+hi*1024+r32*16;
  #pragma unroll
  for(int d0=0;d0<4;++d0){
    const bf16x8 b0=*reinterpret_cast<const bf16x8*>(kb+d0*2048);
    const bf16x8 b1=*reinterpret_cast<const bf16x8*>(kb+d0*2048+512);
    if(d0==0){p0=__builtin_amdgcn_mfma_f32_32x32x16_bf16(b0,qr[0],negm,0,0,0);p1=__builtin_amdgcn_mfma_f32_32x32x16_bf16(b1,qr[0],negm,0,0,0);}
    else{p0=__builtin_amdgcn_mfma_f32_32x32x16_bf16(b0,qr[d0],p0,0,0,0);p1=__builtin_amdgcn_mfma_f32_32x32x16_bf16(b1,qr[d0],p1,0,0,0);}}
}
typedef __attribute__((address_space(3))) const char* lds_cptr;
typedef short v4i16_t __attribute__((ext_vector_type(4)));
__device__ __forceinline__ void kload8(bf16x8*kf,lds_cptr kp){
  kf[0]=*(const __attribute__((address_space(3))) bf16x8*)(kp);      kf[1]=*(const __attribute__((address_space(3))) bf16x8*)(kp+512);
  kf[2]=*(const __attribute__((address_space(3))) bf16x8*)(kp+2048); kf[3]=*(const __attribute__((address_space(3))) bf16x8*)(kp+2560);
  kf[4]=*(const __attribute__((address_space(3))) bf16x8*)(kp+4096); kf[5]=*(const __attribute__((address_space(3))) bf16x8*)(kp+4608);
  kf[6]=*(const __attribute__((address_space(3))) bf16x8*)(kp+6144); kf[7]=*(const __attribute__((address_space(3))) bf16x8*)(kp+6656);
}
__device__ __forceinline__ void kload2(bf16x8*kf,lds_cptr kp,int j){ kf[2*j]=*(const __attribute__((address_space(3))) bf16x8*)(kp+j*2048); kf[2*j+1]=*(const __attribute__((address_space(3))) bf16x8*)(kp+j*2048+512); }
__device__ __forceinline__ s16x4 vtr(lds_cptr p){ return __builtin_bit_cast(s16x4,__builtin_amdgcn_ds_read_tr16_b64_v4i16((__attribute__((address_space(3))) v4i16_t*)p)); }
__device__ __forceinline__ float rowmax(const f32x16&p0,const f32x16&p1){
  float a=max3f(p0[0],p0[1],p1[0]),b=max3f(p0[2],p0[3],p1[1]);a=max3f(a,p1[2],p1[3]);
  #pragma unroll
  for(int r=4;r<16;r+=4){a=max3f(a,p0[r],p0[r+1]);b=max3f(b,p0[r+2],p0[r+3]);a=max3f(a,p1[r],p1[r+1]);b=max3f(b,p1[r+2],p1[r+3]);}
  const float m=max2f(a,b);
  auto rr=__builtin_amdgcn_permlane32_swap(__float_as_uint(m),__float_as_uint(m),false,false);
  return max2f(__uint_as_float(rr[0]),__uint_as_float(rr[1]));
}
__device__ __forceinline__ void pv(f32x16*o,int vb,bf16x8 pa0,bf16x8 pa1,bf16x8 pa2,bf16x8 pa3){
  #pragma unroll
  for(int d0=0;d0<2;++d0){s16x4 lo[4],hi[4];
    #pragma unroll
    for(int ks=0;ks<4;++ks){
      asm volatile("ds_read_b64_tr_b16 %0,%1 offset:%c2":"=&v"(lo[ks]):"v"(vb),"i"(d0*4096+ks*1024):"memory");
      asm volatile("ds_read_b64_tr_b16 %0,%1 offset:%c2":"=&v"(hi[ks]):"v"(vb),"i"(d0*4096+ks*1024+512):"memory");}
    asm volatile("s_waitcnt lgkmcnt(0)":::"memory");SBAR();
    #define PK(k) (bf16x8){lo[k][0],lo[k][1],lo[k][2],lo[k][3],hi[k][0],hi[k][1],hi[k][2],hi[k][3]}
    o[d0]=__builtin_amdgcn_mfma_f32_32x32x16_bf16(pa0,PK(0),o[d0],0,0,0);
    o[d0]=__builtin_amdgcn_mfma_f32_32x32x16_bf16(pa1,PK(1),o[d0],0,0,0);
    o[d0]=__builtin_amdgcn_mfma_f32_32x32x16_bf16(pa2,PK(2),o[d0],0,0,0);
    o[d0]=__builtin_amdgcn_mfma_f32_32x32x16_bf16(pa3,PK(3),o[d0],0,0,0);
    #undef PK
  }
}

#ifndef ATTN_STORE16
#define ATTN_STORE16(p,v) (*(u32x4*)(p)=(v))
#endif
template<int THRL,int MODE,int QKVP,class CumFn> __device__ __forceinline__ void attn_unit(CumFn&& CUMFN,int b,int h,int qb,int q0abs,int NTU,const bf16*Q,const bf16*__restrict__ K,const bf16*__restrict__ V,bf16*O,char*shm,const __attribute__((address_space(3))) unsigned*selw,const int wave_s){
  const int tid=wave_s*64+lane_opaque(),lane=tid&63,r32=lane&31,hi=lane>>5; const int wid=__builtin_amdgcn_readfirstlane(tid>>6);
  const long rowbase=(long)b*SEQL; const int q0=(MODE==0)?qb*QB:q0abs;
  const bf16*Qw=(MODE==0)?Q+(rowbase+q0+wid*QBLK)*QKVP+h*D:Q+(rowbase+q0)*QKVP+wid*D;
  const bf16*Kh=K+rowbase*QKVP+h*D,*Vh=V+rowbase*QKVP+h*D;
  const unsigned lds0=(unsigned)(uintptr_t)shm;
  float*wsf=(float*)(shm+LDS_WS)+wid*64;
  const bf16*ksrc=Kh+(long)lane*QKVP+wid*8;
  const bf16*vsrc=Vh+(long)(16*(wid&3)+(lane>>2))*QKVP+(wid>>2)*32+(lane&3)*8;
  const unsigned kdst=lds0+LDS_K+wid*1024, vdst=lds0+LDS_V+wid*1024;
  #define DMA_K(t,slot) glds16(ksrc+(long)(t)*KVBLK*QKVP,(unsigned)__builtin_amdgcn_readfirstlane(kdst+(slot)))
  #define DMA_V(t,slot) glds16(vsrc+(long)(t)*KVBLK*QKVP,(unsigned)__builtin_amdgcn_readfirstlane(vdst+(slot)))
  const int vb0=(int)(lds0+LDS_V)+((lane>>4)&1)*32+(lane&3)*8+(4*hi+((lane&15)>>2))*64;
  const char*Kbase=shm+LDS_K; bf16x8 kf[8];
  const lds_cptr shm3=(lds_cptr)shm; const lds_cptr kp0=shm3+LDS_K+hi*1024+r32*16; const lds_cptr vp0=shm3+LDS_V+((lane>>4)&1)*32+(lane&3)*8+(4*hi+((lane&15)>>2))*64;
  const int NT=(MODE==0)?(q0+QB)/KVBLK:NTU;
  DMA_K(0,0);DMA_V(0,0);DMA_K(1,SLOTB);
  if constexpr(MODE==0){ CUMFN(); }
  bf16x8 qr[4];
  #pragma unroll
  for(int d0=0;d0<4;++d0)qr[d0]=*reinterpret_cast<const bf16x8*>(&Qw[(long)r32*QKVP+d0*16+hi*8]);
  float mhat=0.f,l_reg=0.f;float z_=0.f;asm volatile("":"+v"(z_));f32x16 o[2];o[0]=(f32x16){z_,z_,z_,z_,z_,z_,z_,z_,z_,z_,z_,z_,z_,z_,z_,z_};o[1]=o[0];f32x16 negm=o[0];asm volatile("":"+v"(negm));
  const int qrel=wid*QBLK+r32;
  const __attribute__((address_space(3))) float*cum2=(const __attribute__((address_space(3))) float*)(shm+CUM_OFF);
  const float cq2=(MODE==0)?cum2[q0+qrel]:0.f;
  #define BIAS(P0,P1,t) do{ if constexpr(MODE==0){ const __attribute__((address_space(3))) float*cb_=cum2+64*(t)+4*hi; \
    _Pragma("unroll") for(int g_=0;g_<4;++g_){ const f32x4v c0_=*(const __attribute__((address_space(3))) f32x4v*)(cb_+8*g_), c1_=*(const __attribute__((address_space(3))) f32x4v*)(cb_+32+8*g_); \
      P0[4*g_+0]+=cq2-c0_.x; P0[4*g_+1]+=cq2-c0_.y; P0[4*g_+2]+=cq2-c0_.z; P0[4*g_+3]+=cq2-c0_.w; \
      P1[4*g_+0]+=cq2-c1_.x; P1[4*g_+1]+=cq2-c1_.y; P1[4*g_+2]+=cq2-c1_.z; P1[4*g_+3]+=cq2-c1_.w; } } }while(0)
  #define SELM(P0,P1,t) do{ if constexpr(MODE==1){ const unsigned w0_=selw[(2*(t))*32+r32]>>(4*hi), w1_=selw[(2*(t)+1)*32+r32]>>(4*hi); \
    _Pragma("unroll") for(int r=0;r<16;++r){ const int sh_=(r&3)+8*(r>>2); if(!((w0_>>sh_)&1u))P0[r]=-INFINITY; if(!((w1_>>sh_)&1u))P1[r]=-INFINITY; } } }while(0)
  #define CMASK(P0,P1,t) do{ if constexpr(MODE==0){int jb_=(t)-(NT-4); if(jb_>=0)cmask(P0,P1,jb_,qrel,hi);} }while(0)
  bool resc=false;
  #define START(P0,P1) do{ const float rm=rowmax(P0,P1); resc=false; \
    { const float dl=(MODE==1&&!(rm>-1e30f))?0.f:rm; mhat=fadd_s(mhat,dl); \
      _Pragma("unroll") for(int r=0;r<16;++r){P0[r]=fsub_s(P0[r],dl);P1[r]=fsub_s(P1[r],dl);} \
      _Pragma("unroll") for(int r=0;r<16;++r)negm[r]=-mhat; asm volatile("":"+v"(negm)); } \
    _Pragma("unroll") for(int r=0;r<16;++r)P0[r]=__builtin_amdgcn_exp2f(P0[r]); }while(0)
  #define RESC() do{ if(resc){ asm volatile("s_waitcnt lgkmcnt(0)":::"memory"); \
      _Pragma("unroll") for(int d_=0;d_<2;++d_) _Pragma("unroll") for(int r=0;r<16;++r)o[d_][r]*=wsf[crow(r,hi)]; } }while(0)
  f32x16 pA0,pA1,pB0,pB1;
  int sl_prev=0,sl_cur=0,sl_next=SLOTB;
  #define ROT() do{sl_prev=sl_cur;sl_cur=sl_next;sl_next=(sl_next==(NSLOT-1)*SLOTB)?0:sl_next+SLOTB;}while(0)
  DMA_K(2,2*SLOTB);
  WAIT_BAR(3);
  qkt(pA0,pA1,Kbase,qr,negm,r32,hi);asm volatile("s_nop 15\n\ts_nop 7":"+v"(pA0),"+v"(pA1));BIAS(pA0,pA1,0);SELM(pA0,pA1,0);CMASK(pA0,pA1,0);
  START(pA0,pA1);
  _Pragma("unroll") for(int r=0;r<16;++r)pA1[r]=__builtin_amdgcn_exp2f(pA1[r]);
  WAIT_BAR(0);
  DMA_K(3,0);DMA_V(1,SLOTB);
  ROT();
  kload8(kf,kp0+sl_cur);
  WAIT_BAR(2);
  s16x4 vlo[8],vhi[8]; u32x4 pw0,pw1,pw2,pw3;
  #define PKW(P,B) cvtpk_s(P[B],P[B+1])
  #define PAF(k) __builtin_bit_cast(bf16x8,pw##k)
  #define VFR(i) (bf16x8){vlo[i][0],vlo[i][1],vlo[i][2],vlo[i][3],vhi[i][0],vhi[i][1],vhi[i][2],vhi[i][3]}
  #define PIN(x) asm volatile("":"+v"(x))
  #define MX3(a,b,c) __builtin_fmaxf(__builtin_fmaxf((a),(b)),(c))
  #define GAPA(MF,A0,A1,A2,A3,W0,W1,PW) do{ MF; sacc+=A0; sacc+=A1; sacc+=A2; sacc+=A3; PIN(sacc); W0; W1; PIN(PW); SBAR(); }while(0)
  #define EX(v) __builtin_amdgcn_exp2f(v)
  #define GAPB(MF,X,B) do{ MF; X[B]=EX(X[B]); X[B+1]=EX(X[B+1]); X[B+2]=EX(X[B+2]); X[B+3]=EX(X[B+3]); PIN(X); SBAR(); }while(0)
  #define VRD(i) do{ vlo[i]=vtr(vp_+(((i)>>2)*4096+((i)&3)*1024)); vhi[i]=vtr(vp_+(((i)>>2)*4096+((i)&3)*1024+512)); }while(0)
  #define KRD(G,j) do{ if(G){ kload2(kf,kp0+sl_next,j); SBAR(); } }while(0)
  #define STEP(C0,C1,P0,P1,t,GK,GV,GL) do{ SBAR(); \
    const lds_cptr vp_=vp0+sl_prev; \
    VRD(0); SBAR(); float sacc=(P0[0]+P0[1]); \
    GAPA(C0=__builtin_amdgcn_mfma_f32_32x32x16_bf16(kf[0],qr[0],negm,0,0,0), P0[2],P0[3],P0[4],P0[5],     pw0[0]=PKW(P0,0), pw0[1]=PKW(P0,2), pw0); \
    VRD(4); SBAR(); GAPA(C1=__builtin_amdgcn_mfma_f32_32x32x16_bf16(kf[1],qr[0],negm,0,0,0), P0[6],P0[7],P0[8],P0[9],     pw0[2]=PKW(P0,4), pw0[3]=PKW(P0,6), pw0); \
    VRD(1); SBAR(); GAPA(C0=__builtin_amdgcn_mfma_f32_32x32x16_bf16(kf[2],qr[1],C0,0,0,0),   P0[10],P0[11],P0[12],P0[13], pw1[0]=PKW(P0,8), pw1[1]=PKW(P0,10), pw1); \
    VRD(5); SBAR(); GAPA(C1=__builtin_amdgcn_mfma_f32_32x32x16_bf16(kf[3],qr[1],C1,0,0,0),   P0[14],P0[15],P1[0],P1[1],   pw1[2]=PKW(P0,12),pw1[3]=PKW(P0,14), pw1); \
    VRD(2); SBAR(); GAPA(C0=__builtin_amdgcn_mfma_f32_32x32x16_bf16(kf[4],qr[2],C0,0,0,0),   P1[2],P1[3],P1[4],P1[5],     pw2[0]=PKW(P1,0), pw2[1]=PKW(P1,2), pw2); \
    VRD(6); SBAR(); GAPA(C1=__builtin_amdgcn_mfma_f32_32x32x16_bf16(kf[5],qr[2],C1,0,0,0),   P1[6],P1[7],P1[8],P1[9],     pw2[2]=PKW(P1,4), pw2[3]=PKW(P1,6), pw2); \
    VRD(3); SBAR(); GAPA(C0=__builtin_amdgcn_mfma_f32_32x32x16_bf16(kf[6],qr[3],C0,0,0,0),   P1[10],P1[11],P1[12],P1[13], pw3[0]=PKW(P1,8), pw3[1]=PKW(P1,10), pw3); \
    VRD(7); SBAR(); GAPA(C1=__builtin_amdgcn_mfma_f32_32x32x16_bf16(kf[7],qr[3],C1,0,0,0),   P1[14],P1[15],0.f,0.f,       pw3[2]=PKW(P1,12),pw3[3]=PKW(P1,14), pw3); \
    l_reg+=sacc; \
    if(GK){DMA_K((t)+3,sl_cur);} if(GV){DMA_V((t)+1,sl_next);} \
    BIAS(C0,C1,t); SELM(C0,C1,t); CMASK(C0,C1,t); \
    { float a=MX3(C0[0],C0[1],C1[0]),b=MX3(C0[2],C0[3],C1[1]); a=MX3(a,C1[2],C1[3]); \
      _Pragma("unroll") for(int r=4;r<16;r+=4){a=MX3(a,C0[r],C0[r+1]);b=MX3(b,C0[r+2],C0[r+3]);a=MX3(a,C1[r],C1[r+1]);b=MX3(b,C1[r+2],C1[r+3]);} \
      float rm=__builtin_fmaxf(a,b); { auto rr=__builtin_amdgcn_permlane32_swap(__float_as_uint(rm),__float_as_uint(rm),false,false); rm=__builtin_fmaxf(__uint_as_float(rr[0]),__uint_as_float(rr[1])); } \
      resc=false; \
      if(__builtin_expect(__any(rm>(float)THRL),0)){ const float dl=__builtin_fmaxf(rm,0.f); mhat+=dl; \
        _Pragma("unroll") for(int r=0;r<16;++r){C0[r]-=dl;C1[r]-=dl;} \
        _Pragma("unroll") for(int r=0;r<16;++r)negm[r]=-mhat; asm volatile("":"+v"(negm)); \
        const float f=__builtin_amdgcn_exp2f(-dl); l_reg*=f; if(hi==0)wsf[r32]=f; resc=true; } } \
    SBAR(); \
    GAPB(o[0]=__builtin_amdgcn_mfma_f32_32x32x16_bf16(PAF(0),VFR(0),o[0],0,0,0), C0,0); \
    GAPB(o[1]=__builtin_amdgcn_mfma_f32_32x32x16_bf16(PAF(0),VFR(4),o[1],0,0,0), C0,4); \
    KRD(GL,0); GAPB(o[0]=__builtin_amdgcn_mfma_f32_32x32x16_bf16(PAF(1),VFR(1),o[0],0,0,0), C0,8); \
    KRD(GL,1); GAPB(o[1]=__builtin_amdgcn_mfma_f32_32x32x16_bf16(PAF(1),VFR(5),o[1],0,0,0), C0,12); \
    KRD(GL,2); GAPB(o[0]=__builtin_amdgcn_mfma_f32_32x32x16_bf16(PAF(2),VFR(2),o[0],0,0,0), C1,0); \
    KRD(GL,3); GAPB(o[1]=__builtin_amdgcn_mfma_f32_32x32x16_bf16(PAF(2),VFR(6),o[1],0,0,0), C1,4); \
    GAPB(o[0]=__builtin_amdgcn_mfma_f32_32x32x16_bf16(PAF(3),VFR(3),o[0],0,0,0), C1,8); \
    GAPB(o[1]=__builtin_amdgcn_mfma_f32_32x32x16_bf16(PAF(3),VFR(7),o[1],0,0,0), C1,12); \
    }while(0)
  int t=1;
  #undef CMASK
  #define CMASK(P0,P1,t) do{}while(0)
  for(;t+5<NT;t+=2){
    STEP(pB0,pB1,pA0,pA1,t,true,true,true);     WAIT_BAR(2); RESC(); ROT();
    STEP(pA0,pA1,pB0,pB1,t+1,true,true,true);   WAIT_BAR(2); RESC(); ROT();
  }
  #undef CMASK
  #define CMASK(P0,P1,t) do{ if constexpr(MODE==0){int jb_=(t)-(NT-4); if(jb_>=0)cmask(P0,P1,jb_,qrel,hi);} }while(0)
  #define ENDW(tt) do{ if((tt)+3<NT){WAIT_BAR(2);} else if((tt)+2<NT){WAIT_BAR(1);} else {WAIT_BAR(0);} }while(0)
  for(;t+1<NT;t+=2){
    STEP(pB0,pB1,pA0,pA1,t,(t+3<NT),(t+1<NT),(t+1<NT));       ENDW(t);   RESC(); ROT();
    STEP(pA0,pA1,pB0,pB1,t+1,(t+4<NT),(t+2<NT),(t+2<NT));     ENDW(t+1); RESC(); ROT();
  }
  STEP(pB0,pB1,pA0,pA1,NT-1,false,false,false); RESC();
  { float sacc=pB0[0]+pB0[1]; _Pragma("unroll") for(int r=2;r<16;++r)sacc+=pB0[r]; _Pragma("unroll") for(int r=0;r<16;++r)sacc+=pB1[r]; l_reg+=sacc;
    pw0=(u32x4){PKW(pB0,0),PKW(pB0,2),PKW(pB0,4),PKW(pB0,6)};pw1=(u32x4){PKW(pB0,8),PKW(pB0,10),PKW(pB0,12),PKW(pB0,14)};pw2=(u32x4){PKW(pB1,0),PKW(pB1,2),PKW(pB1,4),PKW(pB1,6)};pw3=(u32x4){PKW(pB1,8),PKW(pB1,10),PKW(pB1,12),PKW(pB1,14)};
    SBAR(); pv(o,vb0+sl_cur,PAF(0),PAF(1),PAF(2),PAF(3)); }
  #undef PKW
  #undef PAF
  #undef VFR
  #undef PIN
  #undef MX3
  #undef GAPA
  #undef GAPB
  #undef EX
  #undef VRD
  #undef KRD
  #undef STEP
  #undef ENDW
  {auto rr=__builtin_amdgcn_permlane32_swap(__float_as_uint(l_reg),__float_as_uint(l_reg),false,false);l_reg=__uint_as_float(rr[0])+__uint_as_float(rr[1]);}
  if(hi==0)wsf[32+r32]=l_reg;asm volatile("s_waitcnt lgkmcnt(0)":::"memory");
  float rli[16];
  #pragma unroll
  for(int r=0;r<16;++r)rli[r]=__builtin_amdgcn_rcpf(wsf[32+crow(r,hi)]);
  bf16*Ow=(MODE==0)?O+(rowbase+q0+wid*QBLK)*OPI+h*D:O+(rowbase+q0)*OPI+wid*D;
  { bf16*stg=(bf16*)(shm+LDS_OST)+wid*2048;
    #pragma unroll
    for(int r=0;r<16;++r){const int orow=crow(r,hi);
      #pragma unroll
      for(int d0=0;d0<2;++d0)stg[orow*64+d0*32+r32]=__float2bfloat16(o[d0][r]*rli[r]);}
    asm volatile("s_waitcnt lgkmcnt(0)":::"memory");
    #pragma unroll
    for(int i=0;i<4;++i){const int row=i*8+(lane>>3),ch=lane&7; const u32x4 v=*(const u32x4*)(stg+row*64+ch*8); ATTN_STORE16(Ow+(long)row*OPI+ch*8,v);} }
  asm volatile("s_waitcnt lgkmcnt(0)\n\ts_barrier":::"memory");
  #undef DMA_K
  #undef DMA_V
  #undef CMASK
  #undef START
  #undef BIAS
  #undef SELM
  #undef RESC
  #undef ROT
}
#undef SBAR
#undef WAIT_BAR
}

#ifndef DBG_REP_SEL
#define DBG_REP_SEL 1
#endif
namespace mix {
__device__ __forceinline__ void fox_unit2(int b, int h, int qb, const bf16_t* Z1, const float* F, const float* bfp, bf16_t* Y, char* shm, const int wave_s) {
    const size_t rowb = (size_t)b * SEQ;
    const int nk = 256 * (qb + 1);
    auto cumfn = [=]() {
        const int tid = wave_s * 64 + lane_opaque(), lane = tid & 63; const int wid = __builtin_amdgcn_readfirstlane(tid >> 6);
        MLAS char* L = (MLAS char*)shm;
        MLAS float* cum2 = (MLAS float*)(L + foxa::CUM_OFF);
        MLAS float* wtot = (MLAS float*)(L + foxa::CUM_OFF + 8192);
        const float bias = bfp[h];
        const int s0 = 4 * tid;
        float v[4]; float run = 0.f;
#pragma unroll
        for (int i = 0; i < 4; ++i) {
            float x = 0.f;
            if (s0 + i < nk) x = F[(rowb + s0 + i) * 8 + h] + bias;
            const float ls = (s0 + i < nk) ? (fminf(x, 0.f) - log1pf(expf(-fabsf(x)))) : 0.f;
            run += ls; v[i] = run;
        }
        float inc = run;
#pragma unroll
        for (int o = 1; o < 64; o <<= 1) { const int ln = lane_opaque(); const float t = __builtin_bit_cast(float, __builtin_amdgcn_ds_bpermute((ln - o) << 2, __builtin_bit_cast(int, inc))); if (ln >= o) inc += t; }
        if (lane == 63) wtot[wid] = inc;
        LGKM_BAR();
        float off = inc - run;
        for (int w = 0; w < wid; ++w) off += wtot[w];
#pragma unroll
        for (int i = 0; i < 4; ++i) cum2[s0 + i] = (off + v[i]) * 1.4426950408889634f;
        LGKM_BAR();
    };
    foxa::attn_unit<8, 0, 2560>(cumfn, b, h, qb, 0, 0, (const foxa::bf16*)Z1, (const foxa::bf16*)(Z1 + 512), (const foxa::bf16*)(Z1 + 1024), (foxa::bf16*)Y, shm, nullptr, wave_s);
}
__device__ __forceinline__ void dsa_unit(int b, int qg, const bf16_t* Z0, bf16_t* Y, char* shm, unsigned lds0, const int wave_s) {
    for (int rep_ = 0; rep_ < DBG_REP_SEL; ++rep_) dsa_select(b, qg, Z0, shm, wave_s);
    const int nt64 = (qg >> 1) + 1; int ntu = (nt64 + 1) & ~1; if (ntu < 4) ntu = 4;
    foxa::attn_unit<8, 1, EV_N>([]() {}, b, 0, 0, 32 * qg, ntu, (const foxa::bf16*)(Z0 + 512), (const foxa::bf16*)(Z0 + 1024), (const foxa::bf16*)(Z0 + 1088), (foxa::bf16*)(Y + 512), shm,
                                (const MLAS unsigned*)((MLAS char*)shm + LX_SEL), wave_s);
}
}
constexpr int NWAVES = 8;
constexpr size_t KiB = 1024, MiB = 1u << 20;
constexpr size_t WS_CTL = 0, CTL_ZERO_BYTES = 1 * MiB;
constexpr size_t WS_W_EVIN = 1 * MiB, WS_W_OUT0 = 4 * MiB, WS_W_FFI0 = 6 * MiB, WS_W_FFO0 = 17 * MiB, WS_W_PG0 = 22 * MiB + 512 * KiB, WS_W_PP0 = 24 * MiB + 512 * KiB;
constexpr size_t WS_W_ODIN = 25 * MiB, WS_W_OUT1 = 30 * MiB + 512 * KiB, WS_W_FFI1 = 32 * MiB + 512 * KiB, WS_W_FFO1 = 43 * MiB + 512 * KiB, WS_W_PG1 = 49 * MiB, WS_W_PP1 = 51 * MiB, WS_W_SGU = 51 * MiB + 512 * KiB;
constexpr size_t WS_RSTD = 57 * MiB + 768 * KiB;
constexpr size_t WS_SSQA = 52 * MiB, WS_SSQB = 53 * MiB, WS_ROPE = 54 * MiB, WS_AH = 55 * MiB, WS_FBUF = 58 * MiB + 512 * KiB, WS_SST = 59 * MiB;
constexpr size_t WS_HB = 60 * MiB, WS_AHALO = 92 * MiB, WS_PP = 92 * MiB + 512 * KiB, WS_Y = 124 * MiB + 512 * KiB, WS_ZH = 156 * MiB + 512 * KiB, WS_PB = 244 * MiB + 512 * KiB, WS_END = 252 * MiB + 512 * KiB;
static_assert(WS_AHALO == WS_HB + (size_t)TOK * 1024 * 2, "the halo rows are row tile 64 of the FFN in-projection A operand");
static_assert(WS_W_EVIN + (size_t)EV_N * 1024 * 2 <= WS_W_OUT0 && WS_W_FFI0 + (size_t)NFF2 * 1024 * 2 <= WS_W_FFO0 && WS_W_FFO0 + (size_t)1024 * DFF * 2 <= WS_W_PG0, "ws map 1");
static_assert(WS_W_ODIN + (size_t)OD_N * 1024 * 2 <= WS_W_OUT1 && WS_W_FFI1 + (size_t)NFF2 * 1024 * 2 <= WS_W_FFO1 && WS_W_FFO1 + (size_t)1024 * DFF * 2 <= WS_W_PG1 && WS_W_SGU + 4 * 128 * 128 * 2 <= WS_SSQA, "ws map 2");
static_assert(WS_AH + (size_t)128 * NFF2 * 4 <= WS_RSTD && WS_ZH + (size_t)TOK * DFF * 2 <= WS_PB && WS_PB + (size_t)TOK * PLE * 2 <= WS_END, "ws map 3");
constexpr int CW_BAR = 4096, CW_FLAG = 8192, CW_PAN = 16384;
constexpr int RING_BYTES = 131072, XB_OFF = RING_BYTES, LDSCTL_OFF = XB_OFF + 8192 + 1024 + 64, MISC_OFF = LDSCTL_OFF + 320, LDS_BYTES = 147456;
static_assert(MISC_OFF + 128 <= LDS_BYTES, "LDS map");

#define GAS __attribute__((address_space(1)))
#define LAS __attribute__((address_space(3)))
typedef unsigned short bf16;
typedef unsigned v4u __attribute__((ext_vector_type(4)));
typedef float f32x4 __attribute__((ext_vector_type(4)));
typedef float f32x2 __attribute__((ext_vector_type(2)));
#define LDS_WAIT() asm volatile("s_waitcnt lgkmcnt(0)" ::: "memory")
#define VM_WAIT() asm volatile("s_waitcnt vmcnt(0)" ::: "memory")
__device__ __forceinline__ unsigned f2bf(float f) { unsigned u = __builtin_bit_cast(unsigned, f); return (u + 0x7fffu + ((u >> 16) & 1u)) >> 16; }
__device__ __forceinline__ unsigned pk2(float lo, float hi) { return f2bf(lo) | (f2bf(hi) << 16); }

#define XB_TMO      128
#define XB_XCNT(j)  (256  + 64 * (j))
#define XB_XSUB(j)  (1280 + 64 * (j))
#define XB_XGEN(j)  (2304 + 64 * (j))
#define XB_TOP      3328
#define XB_TOPGEN   3392
#define XCD_BAR_WORDS 3456
#define XB_SPIN_CAP (1u << 18)
__device__ __forceinline__ unsigned xb_ld(unsigned* p)              { return __hip_atomic_load(p, __ATOMIC_RELAXED, __HIP_MEMORY_SCOPE_AGENT); }
__device__ __forceinline__ unsigned xb_add(unsigned* p, unsigned v) { return __hip_atomic_fetch_add(p, v, __ATOMIC_RELAXED, __HIP_MEMORY_SCOPE_AGENT); }
__device__ __forceinline__ unsigned xb_xcc_id() { return (unsigned)__builtin_amdgcn_s_getreg((3 << 11) | 20) & 0xFu; }
#define XB_SPIN(cond, bar) do { unsigned _sp = 0; while (cond) { __builtin_amdgcn_s_sleep(1); \
    if ((++_sp & 255u) == 0u) { if (xb_ld(&(bar)[XB_TMO])) break; if (_sp > XB_SPIN_CAP) { atomicAdd(&(bar)[XB_TMO], 1u); break; } } } } while (0)
struct XcdBarrier { unsigned* bar; unsigned x; volatile LAS unsigned* st; };
__device__ __forceinline__ XcdBarrier xcd_barrier_post(unsigned* bar, volatile LAS unsigned* st) {
    XcdBarrier b; b.bar = bar; b.x = xb_xcc_id(); b.st = st;
    if (threadIdx.x == 0) (void)xb_add(&bar[XB_XCNT(b.x)], 1u);
    return b;
}
__device__ __forceinline__ void xcd_barrier_complete(unsigned* bar, unsigned x, unsigned& nloc, unsigned& nx) {
    const unsigned G = gridDim.x * gridDim.y * gridDim.z;
    unsigned sum, cnt, mine, sp = 0u;
    for (;;) {
        sum = 0u; cnt = 0u; mine = 0u;
#pragma unroll 1
        for (unsigned j = 0; j < 16; ++j) { const unsigned c = xb_ld(&bar[XB_XCNT(j)]); sum += c; cnt += (c > 0u) ? 1u : 0u; mine = (j == x) ? c : mine; }
        if (sum == G) break;
        __builtin_amdgcn_s_sleep(1);
        if ((++sp & 255u) == 0u) { if (xb_ld(&bar[XB_TMO])) break; if (sp > XB_SPIN_CAP) { atomicAdd(&bar[XB_TMO], 1u); break; } }
    }
    nloc = mine > 0u ? mine : 1u; nx = cnt > 0u ? cnt : 1u;
}
__device__ __forceinline__ void xcd_barrier(const XcdBarrier& b) {
    asm volatile("s_waitcnt vmcnt(0)" ::: "memory");
    __syncthreads();
    if (threadIdx.x == 0) {
        unsigned* bar = b.bar;
        __builtin_amdgcn_s_waitcnt(0);
        unsigned nloc = b.st[0], nx = b.st[1];
        if (nloc == 0u) { xcd_barrier_complete(bar, b.x, nloc, nx); b.st[0] = nloc; b.st[1] = nx; }
        const unsigned old = xb_add(&bar[XB_XSUB(b.x)], 1u);
        const unsigned gen = old / nloc;
        if (old + 1u == (gen + 1u) * nloc) {
            __builtin_amdgcn_fence(__ATOMIC_RELEASE, "agent");
            asm volatile("s_waitcnt vmcnt(0)" ::: "memory");
            __builtin_amdgcn_fence(__ATOMIC_ACQUIRE, "agent");
            const unsigned og = xb_add(&bar[XB_TOP], 1u);
            const unsigned tg = og / nx;
            if (og + 1u == (tg + 1u) * nx) xb_add(&bar[XB_TOPGEN], 1u);
            else XB_SPIN(xb_ld(&bar[XB_TOPGEN]) == tg, bar);
            asm volatile("s_waitcnt vmcnt(0)" ::: "memory");
            xb_add(&bar[XB_XGEN(b.x)], 1u);
            asm volatile("s_waitcnt vmcnt(0)" ::: "memory");
        } else {
            __builtin_amdgcn_fence(__ATOMIC_ACQUIRE, "agent");
            XB_SPIN(xb_ld(&bar[XB_XGEN(b.x)]) == gen, bar);
            asm volatile("s_waitcnt vmcnt(0)" ::: "memory");
        }
    }
    __syncthreads();
}

__device__ __forceinline__ float wave_sum(float v) {
#pragma unroll
    for (int o = 1; o < 64; o <<= 1) v += __builtin_bit_cast(float, __builtin_amdgcn_ds_bpermute((lane_opaque() ^ o) << 2, __builtin_bit_cast(int, v)));
    return v;
}
__device__ __forceinline__ int vcu_of(int i, int n) { return i; }
__device__ __forceinline__ int unperm16(int d) { return d < 16 ? ((d >> 1) + 8 * (d & 1)) : d; }
__device__ __forceinline__ int map_col(int type, int n, int nold) {
    if (type == 0) return n < nold ? n : -1;
    if (type == 1) {
        if (n < 512) return n;
        if (n < 1024) { const int h = (n - 512) >> 6, d = (n - 512) & 63; return 512 + 64 * h + unperm16(d); }
        if (n < 1088) return 1024 + unperm16(n - 1024);
        if (n < 1152) return n;
        if (n < 1216) return 1408 + unperm16(n - 1152);
        if (n < 1220) return 1472 + (n - 1216);
        if (n < 1280) return -1;
        { const int h = (n - 1280) >> 6, d = (n - 1280) & 63; return 1152 + 64 * h + unperm16(d); }
    }
    if (type == 2) {
        if (n < 1536) return n;
        if (n < 2560) return n + 8;
        if (n < 2568) return 1536 + (n - 2560);
        return -1;
    }
    { const int pn = n >> 8, bj = (n >> 7) & 1, jj = n & 127; return bj * DFF + 128 * pn + jj; }
}
struct TJob { const float* W; const float* rowscale; bf16* WT; int K, Nold, Nnew, ldk, koff, type, nitems; };
__device__ __forceinline__ void transpose_item(const TJob& J, LAS float* scr, int item, int lane) {
    const int nblk = J.Nnew / 32, kb = item / nblk, nb = item % nblk, k0 = 64 * kb, n0 = 32 * nb;
    const int oc = map_col(J.type, n0 + (lane & 31), J.Nold);
    const int occ = oc >= 0 ? oc : 0;
    float vv[32];
#pragma unroll
    for (int i = 0; i < 32; ++i) vv[i] = J.W[(size_t)(k0 + 2 * i + (lane >> 5)) * J.Nold + occ];
#pragma unroll
    for (int i = 0; i < 32; ++i) { const int kk = 2 * i + (lane >> 5);
        float v = (oc >= 0) ? vv[i] : 0.f;
        if (J.rowscale) v *= J.rowscale[k0 + kk];
        scr[kk * 33 + (lane & 31)] = v; }
    LDS_WAIT(); asm volatile("" ::: "memory");
    const int c = lane & 7;
#pragma unroll
    for (int j = 0; j < 4; ++j) { const int n = (lane >> 3) + 8 * j; const LAS float* s = scr + (8 * c) * 33 + n;
        v4u o; o.x = pk2(s[0 * 33], s[1 * 33]); o.y = pk2(s[2 * 33], s[3 * 33]); o.z = pk2(s[4 * 33], s[5 * 33]); o.w = pk2(s[6 * 33], s[7 * 33]);
        *(GAS v4u*)(J.WT + (size_t)(n0 + n) * J.ldk + J.koff + k0 + 8 * c) = o; }
    LDS_WAIT(); asm volatile("" ::: "memory");
}
__device__ __forceinline__ void sincos_d(double a, float& sn, float& cs) {
    const double q = rint(a * 0.63661977236758134308);
    double r = a - q * 1.57079632673412561417e+00; r -= q * 6.07710050650619224932e-11;
    const double r2 = r * r;
    double s = 1.0 / 6227020800.0; s = s * r2 - 1.0 / 39916800.0; s = s * r2 + 1.0 / 362880.0; s = s * r2 - 1.0 / 5040.0; s = s * r2 + 1.0 / 120.0; s = s * r2 - 1.0 / 6.0; s = s * r2 * r + r;
    double c = -1.0 / 87178291200.0; c = c * r2 + 1.0 / 479001600.0; c = c * r2 - 1.0 / 3628800.0; c = c * r2 + 1.0 / 40320.0; c = c * r2 - 1.0 / 720.0; c = c * r2 + 1.0 / 24.0; c = c * r2 - 0.5; c = c * r2 + 1.0;
    const int qi = ((int)q) & 3;
    const double ss = (qi == 0) ? s : (qi == 1) ? c : (qi == 2) ? -s : -c;
    const double cc = (qi == 0) ? c : (qi == 1) ? -s : (qi == 2) ? -c : s;
    sn = (float)ss; cs = (float)cc;
}

struct Args { const void* in[24]; float* out; unsigned char* ws; int ph_lo, ph_hi; };
typedef const Args __attribute__((address_space(4)))* argp_t;
__device__ __forceinline__ argp_t get_args() { argp_t p = (argp_t)__builtin_amdgcn_kernarg_segment_ptr(); asm volatile("" : "+s"(p)); return p; }
__device__ __forceinline__ int otid(int wave_s) { return wave_s * 64 + lane_opaque(); }
#define IN_F(k) ((const float*)A_->in[k])
#define PH_LOCALS \
    argp_t A_ = get_args(); unsigned char* const ws = A_->ws; float* const out = A_->out; (void)out; \
    const int tid = otid(wave_s), lane = tid & 63, wave = wave_s; (void)lane; (void)wave; \
    const int G = gridDim.x, bx = blockIdx.x, vcu = (G % 8 == 0) ? (bx % 8) * (G / 8) + bx / 8 : bx; (void)vcu; \
    const int gw = vcu * NWAVES + wave, NGW = G * NWAVES, gt = vcu * (NWAVES * 64) + tid, NGT = G * NWAVES * 64; (void)gw; (void)NGW; (void)gt; (void)NGT; \
    LAS unsigned char* const L = (LAS unsigned char*)lds; (void)L;
#define WSP(T, off) ((T*)(ws + (off)))

__global__ void __launch_bounds__(NWAVES * 64, 2) mega_fwd(Args args) {
    extern __shared__ __attribute__((aligned(16))) unsigned char lds[];
    int lo, hi; XcdBarrier bar;
    const int wave_s = __builtin_amdgcn_readfirstlane((int)threadIdx.x >> 6);
    {
        PH_LOCALS
        volatile LAS unsigned* MISC = (volatile LAS unsigned*)(L + MISC_OFF);
        for (int u = tid; u < (LDS_BYTES - XB_OFF) / 4; u += NWAVES * 64) ((LAS unsigned*)(L + XB_OFF))[u] = 0u;
        __syncthreads();
        bar = xcd_barrier_post((unsigned*)(ws + WS_CTL) + CW_BAR, MISC + 8);
        lo = A_->ph_lo; hi = A_->ph_hi;
    }
#ifndef DBG_REP_TR
#define DBG_REP_TR 1
#endif
#ifndef DBG_REP_HB
#define DBG_REP_HB 1
#endif
#ifndef DBG_REP_FOX
#define DBG_REP_FOX 1
#endif
#ifndef DBG_REP_DSA
#define DBG_REP_DSA 1
#endif
#ifndef DBG_REP_SGU
#define DBG_REP_SGU 1
#endif
#ifndef DBG_REP_POOL
#define DBG_REP_POOL 1
#endif
#ifndef PHMASK
#define PHMASK 0xff7fffu
#endif
#define IN(k) (((PHMASK >> (k)) & 1u) && lo <= (k) && (k) < hi)
#define SEAM(k) do { if (IN(k) && IN((k) + 1)) xcd_barrier(bar); } while (0)
    if (IN(0)) {
        PH_LOCALS
        LAS float* scr = (LAS float*)(L + wave * 16384);
        const float* norm_mix = IN_F(3); const float* norm_ffn = IN_F(4); const float* norm_ple = IN_F(5);
        const float* ffn_w_in = IN_F(6); const float* ffn_w_out = IN_F(9); const float* ple_w_proj = IN_F(10); const float* ple_w_gate = IN_F(11);
        const float* ev_w_in = IN_F(13); const float* ev_w_out = IN_F(14); const float* od_w_in = IN_F(17); const float* od_w_out = IN_F(18);
#define TJ(Wp, RS, WTp, K_, NOLD, NNEW, LDK, KOFF, TYPE) { constexpr int NI_ = ((K_) / 64) * ((NNEW) / 32); if (r < NI_) { const TJob J{(Wp), (RS), (WTp), (K_), (NOLD), (NNEW), (LDK), (KOFF), (TYPE), NI_}; transpose_item(J, scr, r, lane); continue; } r -= NI_; }
        constexpr int NITEMS = 16 * 48 + 8 * 32;
        for (int rep_ = 0; rep_ < DBG_REP_TR; ++rep_) for (int it = gw; it < NITEMS; it += NGW) {
            int r = it;
            TJ(ev_w_in, norm_mix, WSP(bf16, WS_W_EVIN), 1024, 1476, EV_N, 1024, 0, 1)
            TJ(ev_w_out + (size_t)512 * 1024, nullptr, WSP(bf16, WS_W_OUT0), 512, 1024, 1024, 1024, 512, 0)
        }
#undef TJ
        { const float* sgu_w = IN_F(22); bf16* W_SGU = WSP(bf16, WS_W_SGU);
          for (int i = gt; i < 4 * 128 * 128; i += NGT) { const int jj = i & 127, ii = (i >> 7) & 127; W_SGU[i] = (bf16)((ii < 64 && jj >= 64) ? 0u : f2bf(sgu_w[i])); } }
        { const float* x = IN_F(0); bf16* HB = WSP(bf16, WS_HB); float* SSQA = WSP(float, WS_SSQA);
          for (int m = gw; m < TOK; m += 4 * NGW) {
            f32x4 v[4][4];
#pragma unroll
            for (int q = 0; q < 4; ++q) { const int mm = (m + q * NGW < TOK) ? m + q * NGW : m; const f32x4* xr = (const f32x4*)(x + (size_t)mm * DMODEL) + lane;
#pragma unroll
                for (int j = 0; j < 4; ++j) v[q][j] = xr[64 * j]; }
#pragma unroll
            for (int q = 0; q < 4; ++q) { const int mm = m + q * NGW; if (mm < TOK) {
                float s = 0.f; unsigned long long* o8 = (unsigned long long*)(HB + (size_t)mm * DMODEL) + lane;
#pragma unroll
                for (int j = 0; j < 4; ++j) { const f32x4 w = v[q][j]; s += (w.x * w.x + w.y * w.y) + (w.z * w.z + w.w * w.w);
                    o8[64 * j] = (unsigned long long)pk2(w.x, w.y) | ((unsigned long long)pk2(w.z, w.w) << 32); }
                s = wave_sum(s);
                if (lane < 16) SSQA[(size_t)mm * 16 + lane] = (lane == 0) ? s : 0.f; } }
          } }
        { const float* p_in = IN_F(1); bf16* PB = WSP(bf16, WS_PB);
          for (int i = gt; i < TOK * PLE / 4; i += 4 * NGT) { f32x4 v[4];
#pragma unroll
            for (int q = 0; q < 4; ++q) v[q] = ((const f32x4*)p_in)[(i + q * NGT < TOK * PLE / 4) ? i + q * NGT : i];
#pragma unroll
            for (int q = 0; q < 4; ++q) if (i + q * NGT < TOK * PLE / 4) ((unsigned long long*)PB)[i + q * NGT] = (unsigned long long)pk2(v[q].x, v[q].y) | ((unsigned long long)pk2(v[q].z, v[q].w) << 32); } }
        { const int* positions = (const int*)A_->in[2]; f32x2* ROPE = WSP(f32x2, WS_ROPE);
          for (int i = gt; i < TOK * 8; i += NGT) {
            const int row = i >> 3, j = i & 7;
            const float invf = (j == 0) ? 1.0f : (j == 1) ? 0.1939227432012558f : (j == 2) ? 0.03760603070259094f : (j == 3) ? 0.007292664609849453f : (j == 4) ? 0.0014142135623842478f :
                               (j == 5) ? 0.00027424818836152554f : (j == 6) ? 5.3182957344688475e-05f : 1.0313385246263351e-05f;
            const float ang = (float)positions[row] * invf;
            float sn, cs; sincos_d((double)ang, sn, cs);
            ROPE[i] = (f32x2){cs, sn};
          } }
    }
    SEAM(0);
    if (IN(1)) {
        { PH_LOCALS
          pg8::Gemm g{WSP(bf16, WS_HB), WSP(bf16, WS_W_EVIN), TOK, EV_N, 1024}; pg8::StaticOrder S; S.init(TOK, EV_N, G, bx);
          pg8::EpiEvenIn E{WSP(float, WS_SSQA), WSP(bf16, WS_ZH), WSP(const pg8::f32x2, WS_ROPE)};
          pg8::gemm_phase<pg8::EpiEvenIn, pg8::StaticOrder, true, true>(L, g, S, E, wave_s); }
        if (gridDim.x == 256 && blockIdx.x >= 128) {
            PH_LOCALS
            LAS float* scr = (LAS float*)(L + wave * 16384);
            const float* norm_mix = IN_F(3); const float* norm_ffn = IN_F(4); const float* norm_ple = IN_F(5);
            const float* ffn_w_in = IN_F(6); const float* ffn_w_out = IN_F(9); const float* ple_w_proj = IN_F(10); const float* ple_w_gate = IN_F(11);
            const float* od_w_in = IN_F(17); const float* od_w_out = IN_F(18);
#define TJ(Wp, RS, WTp, K_, NOLD, NNEW, LDK, KOFF, TYPE) { constexpr int NI_ = ((K_) / 64) * ((NNEW) / 32); if (r < NI_) { const TJob J{(Wp), (RS), (WTp), (K_), (NOLD), (NNEW), (LDK), (KOFF), (TYPE), NI_}; transpose_item(J, scr, r, lane); continue; } r -= NI_; }
            constexpr int NITEMS_B = (16 * 176 + 44 * 32 + 16 * 32 + 4 * 32) + 16 * 88 + 16 * 32;
            const int gwb = (vcu_of(bx - 128, 128)) * NWAVES + wave, NGWB = 128 * NWAVES;
            for (int it = gwb; it < NITEMS_B; it += NGWB) {
                int r = it;
                TJ(ffn_w_in, norm_ffn, WSP(bf16, WS_W_FFI0), 1024, NFF2, NFF2, 1024, 0, 3)
                TJ(ffn_w_out, nullptr, WSP(bf16, WS_W_FFO0), DFF, 1024, 1024, DFF, 0, 0)
                TJ(ple_w_gate, norm_ple, WSP(bf16, WS_W_PG0), 1024, 1024, 1024, 1024, 0, 0)
                TJ(ple_w_proj, nullptr, WSP(bf16, WS_W_PP0), 256, 1024, 1024, 256, 0, 0)
                TJ(od_w_in, norm_mix + 1024, WSP(bf16, WS_W_ODIN), 1024, 2568, OD_N, 1024, 0, 2)
                TJ(od_w_out, nullptr, WSP(bf16, WS_W_OUT1), 1024, 1024, 1024, 1024, 0, 0)
            }
#undef TJ
        {
            const float* pool_w = IN_F(15); const float* pool_scale = IN_F(16); const float* ev_w_out = IN_F(14); bf16* W_OUT0 = WSP(bf16, WS_W_OUT0);
            for (int it = gwb; it < 1024; it += NGWB) {
                const int g = it >> 8, nb = (it >> 4) & 15, cb = it & 15, n = 64 * nb + lane;
                float acc[8];
#pragma unroll
                for (int cc = 0; cc < 8; ++cc) acc[cc] = 0.f;
#pragma unroll 1
                for (int d0 = 0; d0 < 128; d0 += 16) {
                    float wv[16];
#pragma unroll
                    for (int e = 0; e < 16; ++e) wv[e] = ev_w_out[(size_t)(128 * g + d0 + e) * 1024 + n] * pool_scale[128 * g + d0 + e];
#pragma unroll
                    for (int cc = 0; cc < 8; ++cc) {
                        const float* pw = pool_w + ((size_t)g * 128 + 8 * cb + cc) * 128 + d0;
#pragma unroll
                        for (int e = 0; e < 16; ++e) acc[cc] += pw[e] * wv[e];
                    }
                }
#pragma unroll
                for (int c2 = 0; c2 < 4; ++c2) *(unsigned*)(W_OUT0 + (size_t)n * 1024 + 128 * g + 8 * cb + 2 * c2) = pk2(acc[2 * c2], acc[2 * c2 + 1]);
            }
        }
        }
    }
    SEAM(1);
    if (IN(2)) {
        { PH_LOCALS
          const bf16* ZH = WSP(bf16, WS_ZH); bf16* Y = WSP(bf16, WS_Y); const unsigned lds0 = (unsigned)(uintptr_t)lds;
          for (int pi = vcu; pi < 256; pi += G) {
            const int b = pi >> 5, s = pi & 31;
#pragma unroll 1
            for (int k = 0; k < 2 * DBG_REP_DSA; ++k) mix::dsa_unit(b, (k & 1) ? s : 63 - s, ZH, Y, (char*)lds, lds0, wave_s);
          } }
        { PH_LOCALS
          const bf16* ZH = WSP(bf16, WS_ZH); bf16* Y = WSP(bf16, WS_Y);
          for (int rep_ = 0; rep_ < DBG_REP_POOL; ++rep_) for (int it = gt; it < TOK * 64; it += NGT) mix::pool_item(it, ZH, Y);
        }
        { PH_LOCALS
          const float* p1 = IN_F(1) + (size_t)TOK * PLE; bf16* PB1 = (bf16*)out + (size_t)16 * 1024 * 1024;
          for (int i = gt; i < TOK * PLE / 4; i += 4 * NGT) { f32x4 v[4];
#pragma unroll
              for (int q = 0; q < 4; ++q) v[q] = ((const f32x4*)p1)[(i + q * NGT < TOK * PLE / 4) ? i + q * NGT : i];
#pragma unroll
              for (int q = 0; q < 4; ++q) if (i + q * NGT < TOK * PLE / 4) ((unsigned long long*)PB1)[i + q * NGT] = (unsigned long long)pk2(v[q].x, v[q].y) | ((unsigned long long)pk2(v[q].z, v[q].w) << 32); }
        }
    }
    SEAM(2);
    {
        const size_t s1o = (0 == 0) ? WS_SSQA : WS_SSQB, s2o = (0 == 0) ? WS_SSQB : WS_SSQA, s3o = s1o;
        if (IN(3)) {
            PH_LOCALS
            pg8::Gemm g{WSP(bf16, WS_Y), WSP(bf16, (0 == 0) ? WS_W_OUT0 : WS_W_OUT1), TOK, 1024, 1024}; pg8::StaticOrder S; S.init(TOK, 1024, G, bx);
            pg8::EpiRes E{nullptr, WSP(bf16, WS_HB), WSP(bf16, WS_HB), WSP(float, s1o), WSP(bf16, WS_AHALO)};
            pg8::gemm_phase<pg8::EpiRes, pg8::StaticOrder, true, true>(L, g, S, E, wave_s);
        }
        SEAM(3);
        if (IN(3 + 2)) {
            PH_LOCALS
            pg8::Gemm g{WSP(bf16, WS_HB), WSP(bf16, WS_W_FFI0), TOK + 256, NFF2, 1024}; pg8::StaticOrder S; S.init(TOK, NFF2, G, bx);
            if (G == 256 && !(bx >= 128 && bx < 128 + NFF2 / 256)) {
                LAS float* scr = (LAS float*)(L + wave * 16384);
                const float* ffn_w_out = IN_F(9); const float* ple_w_proj = IN_F(10);
#define TJ(Wp, RS, WTp, K_, NOLD, NNEW, LDK, KOFF, TYPE) { constexpr int NI_ = ((K_) / 64) * ((NNEW) / 32); if (r < NI_) { const TJob J{(Wp), (RS), (WTp), (K_), (NOLD), (NNEW), (LDK), (KOFF), (TYPE), NI_}; transpose_item(J, scr, r, lane); continue; } r -= NI_; }
                const int wgi = bx < 128 ? bx : bx - 22;
                for (int it = wgi * NWAVES + wave; it < 44 * 32 + 4 * 32; it += 234 * NWAVES) {
                    int r = it;
                    TJ(ffn_w_out + (size_t)DFF * 1024, nullptr, WSP(bf16, WS_W_FFO1), DFF, 1024, 1024, DFF, 0, 0)
                    TJ(ple_w_proj + (size_t)256 * 1024, nullptr, WSP(bf16, WS_W_PP1), 256, 1024, 1024, 256, 0, 0)
                }
#undef TJ
                asm volatile("s_waitcnt vmcnt(0) lgkmcnt(0)" ::: "memory"); __syncthreads();
            }
#ifdef STAGGER
            if (STAGGER_COND) { for (int i_ = 0; i_ < STAGGER; ++i_) __builtin_amdgcn_s_sleep(127); }
#endif
            if (G == 256 && bx >= 128 && bx < 128 + NFF2 / 256) {
                pg8::OneUnit S1{64, bx - 128, 1};
                pg8::EpiHaloF EH{WSP(float, s1o), WSP(float, WS_AH), (unsigned*)(ws + WS_CTL) + CW_FLAG + 2048 * 0};
                pg8::gemm_phase<pg8::EpiHaloF, pg8::OneUnit, true, true>(L, g, S1, EH, wave_s);
            }
#ifdef PP_FIRST
            if (G == 256 && bx >= 150) {
                pg8::Gemm gp{WSP(bf16, WS_PB), WSP(bf16, WS_W_PP0), TOK, 1024, PLE}; pg8::StaticOrder SP; SP.init(TOK, 1024, 106, bx - 150);
                pg8::EpiBf16Plain EP{WSP(bf16, WS_PP), 1024};
                pg8::gemm_phase<pg8::EpiBf16Plain, pg8::StaticOrder, true, true>(L, gp, SP, EP, wave_s);
            }
#endif
            pg8::EpiFfnIn E{WSP(float, s1o), IN_F(7) + (size_t)0 * 3 * NFF2, IN_F(8) + (size_t)0 * NFF2, WSP(float, WS_AH), WSP(bf16, WS_ZH), (LAS float*)(L + XB_OFF), (unsigned*)(ws + WS_CTL) + CW_FLAG + 2048 * 0, 1u};
            pg8::gemm_phase<pg8::EpiFfnIn, pg8::StaticOrder, true, true>(L, g, S, E, wave_s);
#ifndef PP_FIRST
            if (G == 256 && bx >= 150) {
                pg8::Gemm gp{WSP(bf16, WS_PB), WSP(bf16, WS_W_PP0), TOK, 1024, PLE}; pg8::StaticOrder SP; SP.init(TOK, 1024, 106, bx - 150);
                pg8::EpiBf16Plain EP{WSP(bf16, WS_PP), 1024};
                pg8::gemm_phase<pg8::EpiBf16Plain, pg8::StaticOrder, true, true>(L, gp, SP, EP, wave_s);
            }
#endif
        }
        SEAM(3 + 2);
        if (IN(3 + 3)) {
            PH_LOCALS
            pg8::Gemm g{WSP(bf16, WS_ZH), WSP(bf16, (0 == 0) ? WS_W_FFO0 : WS_W_FFO1), TOK, 1024, DFF}; pg8::StaticOrder S; S.init(TOK, 1024, G, bx);
            pg8::EpiRes E{nullptr, WSP(bf16, WS_HB), WSP(bf16, WS_HB), WSP(float, s2o), nullptr};
            pg8::gemm_phase<pg8::EpiRes, pg8::StaticOrder, true, true>(L, g, S, E, wave_s);
        }
        SEAM(3 + 3);
        if (IN(3 + 4)) {
            PH_LOCALS
            pg8::Gemm g{WSP(bf16, WS_HB), WSP(bf16, (0 == 0) ? WS_W_PG0 : WS_W_PG1), TOK, 1024, 1024}; pg8::StaticOrder S; S.init(TOK, 1024, G, bx);
            pg8::EpiGate E{WSP(float, s2o), WSP(bf16, WS_HB), WSP(bf16, WS_PP), (bf16*)out, WSP(float, s3o)};
            pg8::gemm_phase<pg8::EpiGate, pg8::StaticOrder, true, true>(L, g, S, E, wave_s);
        }
        SEAM(3 + 4);
    }
    {

            if (IN(8)) {
                { PH_LOCALS
                  pg8::Gemm g{(const bf16*)out, WSP(bf16, WS_W_ODIN), TOK, OD_N, 1024}; pg8::StaticOrder S; S.init(TOK, OD_N, G, bx);
                  pg8::EpiOddIn E{WSP(float, WS_SSQA), WSP(bf16, WS_ZH), WSP(float, WS_FBUF), WSP(float, WS_SST)};
                  pg8::gemm_phase<pg8::EpiOddIn, pg8::StaticOrder, true, true>(L, g, S, E, wave_s); }
                if (gridDim.x == 256 && blockIdx.x >= 192) {
                    PH_LOCALS
                    LAS float* scr = (LAS float*)(L + wave * 16384);
                    const float* norm_ffn = IN_F(4); const float* norm_ple = IN_F(5); const float* ffn_w_in = IN_F(6); const float* ple_w_gate = IN_F(11);
#define TJ(Wp, RS, WTp, K_, NOLD, NNEW, LDK, KOFF, TYPE) { constexpr int NI_ = ((K_) / 64) * ((NNEW) / 32); if (r < NI_) { const TJob J{(Wp), (RS), (WTp), (K_), (NOLD), (NNEW), (LDK), (KOFF), (TYPE), NI_}; transpose_item(J, scr, r, lane); continue; } r -= NI_; }
                    constexpr int NITEMS_C = 16 * 176 + 16 * 32;
                    const int gwc = (bx - 192) * NWAVES + wave, NGWC = 64 * NWAVES;
                    for (int it = gwc; it < NITEMS_C; it += NGWC) {
                        int r = it;
                        TJ(ffn_w_in + (size_t)1024 * NFF2, norm_ffn + 1024, WSP(bf16, WS_W_FFI1), 1024, NFF2, NFF2, 1024, 0, 3)
                        TJ(ple_w_gate + (size_t)1024 * 1024, norm_ple + 1024, WSP(bf16, WS_W_PG1), 1024, 1024, 1024, 1024, 0, 0)
                    }
#undef TJ
                }
            }
            SEAM(8);
            if (IN(9)) {
                { PH_LOCALS
                  const bf16* ZH = WSP(bf16, WS_ZH); bf16* Y = WSP(bf16, WS_Y); const unsigned lds0 = (unsigned)(uintptr_t)lds;
                  const float* FBUF = WSP(float, WS_FBUF); const float* fox_b_f = IN_F(19);
                  for (int pi = vcu; pi < 256; pi += G) {
                    const int bh = pi >> 2, s = pi & 3;
#pragma unroll 1
                    for (int k = 0; k < 2 * DBG_REP_FOX; ++k) mix::fox_unit2(bh >> 3, bh & 7, (k & 1) ? s : 7 - s, ZH, FBUF, fox_b_f, Y, (char*)lds, wave_s);
                  } }
                { PH_LOCALS
                  const bf16* ZH = WSP(bf16, WS_ZH); bf16* Y = WSP(bf16, WS_Y);
                  for (int rep_ = 0; rep_ < DBG_REP_SGU; ++rep_) for (int u = vcu; u < 512; u += G) mix::sgu_unit(u >> 6, (u >> 2) & 15, u & 3, ZH, WSP(float, WS_SST), IN_F(20), IN_F(21), WSP(bf16, WS_W_SGU), IN_F(23), Y, (char*)lds, wave_s); }
            }
            SEAM(9);
            }
    {
        const size_t s1o = (1 == 0) ? WS_SSQA : WS_SSQB, s2o = (1 == 0) ? WS_SSQB : WS_SSQA, s3o = s1o;
        if (IN(10)) {
            PH_LOCALS
            pg8::Gemm g{WSP(bf16, WS_Y), WSP(bf16, (1 == 0) ? WS_W_OUT0 : WS_W_OUT1), TOK, 1024, 1024}; pg8::StaticOrder S; S.init(TOK, 1024, G, bx);
            pg8::EpiRes E{nullptr, (const bf16*)out, WSP(bf16, WS_HB), WSP(float, s1o), WSP(bf16, WS_AHALO)};
            pg8::gemm_phase<pg8::EpiRes, pg8::StaticOrder, true, true>(L, g, S, E, wave_s);
        }
        SEAM(10);
        if (IN(10 + 2)) {
            PH_LOCALS
            pg8::Gemm g{WSP(bf16, WS_HB), WSP(bf16, WS_W_FFI1), TOK + 256, NFF2, 1024}; pg8::StaticOrder S; S.init(TOK, NFF2, G, bx);
#ifdef STAGGER
            if (STAGGER_COND) { for (int i_ = 0; i_ < STAGGER; ++i_) __builtin_amdgcn_s_sleep(127); }
#endif
            if (G == 256 && bx >= 128 && bx < 128 + NFF2 / 256) {
                pg8::OneUnit S1{64, bx - 128, 1};
                pg8::EpiHaloF EH{WSP(float, s1o), WSP(float, WS_AH), (unsigned*)(ws + WS_CTL) + CW_FLAG + 2048 * 1};
                pg8::gemm_phase<pg8::EpiHaloF, pg8::OneUnit, true, true>(L, g, S1, EH, wave_s);
            }
#ifdef PP_FIRST
            if (G == 256 && bx >= 150) {
                pg8::Gemm gp{(const bf16*)out + (size_t)16 * 1024 * 1024, WSP(bf16, WS_W_PP1), TOK, 1024, PLE}; pg8::StaticOrder SP; SP.init(TOK, 1024, 106, bx - 150);
                pg8::EpiBf16Plain EP{WSP(bf16, WS_PP), 1024};
                pg8::gemm_phase<pg8::EpiBf16Plain, pg8::StaticOrder, true, true>(L, gp, SP, EP, wave_s);
            }
#endif
            pg8::EpiFfnIn E{WSP(float, s1o), IN_F(7) + (size_t)1 * 3 * NFF2, IN_F(8) + (size_t)1 * NFF2, WSP(float, WS_AH), WSP(bf16, WS_ZH), (LAS float*)(L + XB_OFF), (unsigned*)(ws + WS_CTL) + CW_FLAG + 2048 * 1, 2u};
            pg8::gemm_phase<pg8::EpiFfnIn, pg8::StaticOrder, true, true>(L, g, S, E, wave_s);
#ifndef PP_FIRST
            if (G == 256 && bx >= 150) {
                pg8::Gemm gp{(const bf16*)out + (size_t)16 * 1024 * 1024, WSP(bf16, WS_W_PP1), TOK, 1024, PLE}; pg8::StaticOrder SP; SP.init(TOK, 1024, 106, bx - 150);
                pg8::EpiBf16Plain EP{WSP(bf16, WS_PP), 1024};
                pg8::gemm_phase<pg8::EpiBf16Plain, pg8::StaticOrder, true, true>(L, gp, SP, EP, wave_s);
            }
#endif
        }
        SEAM(10 + 2);
        if (IN(10 + 3)) {
            PH_LOCALS
            pg8::Gemm g{WSP(bf16, WS_ZH), WSP(bf16, (1 == 0) ? WS_W_FFO0 : WS_W_FFO1), TOK, 1024, DFF}; pg8::StaticOrder S; S.init(TOK, 1024, G, bx);
            pg8::EpiRes E{nullptr, WSP(bf16, WS_HB), WSP(bf16, WS_HB), WSP(float, s2o), nullptr};
            pg8::gemm_phase<pg8::EpiRes, pg8::StaticOrder, true, true>(L, g, S, E, wave_s);
        }
        SEAM(10 + 3);
        if (IN(10 + 4)) {
            PH_LOCALS
            pg8::Gemm g{WSP(bf16, WS_HB), WSP(bf16, (1 == 0) ? WS_W_PG0 : WS_W_PG1), TOK, 1024, 1024}; pg8::StaticOrder S; S.init(TOK, 1024, G, bx);
            pg8::EpiGateFinal E{WSP(float, s2o), WSP(bf16, WS_HB), WSP(bf16, WS_PP), WSP(float, s3o), (unsigned*)(ws + WS_CTL) + CW_PAN, IN_F(12), out, (LAS float*)(L + XB_OFF) + 2048};
            pg8::gemm_phase<pg8::EpiGateFinal, pg8::StaticOrder, true, true>(L, g, S, E, wave_s);
        }
        SEAM(10 + 4);
    }
    if (IN(15)) {
        PH_LOCALS
        const float* SSQB = WSP(float, WS_SSQB); const float* norm_final = IN_F(12); const bf16* H6 = WSP(bf16, WS_Y);
        for (int m = gw; m < TOK; m += 4 * NGW) {
            unsigned long long w[4][4]; float rs[4];
#pragma unroll
            for (int q = 0; q < 4; ++q) { const int mm = (m + q * NGW < TOK) ? m + q * NGW : m; rs[q] = pg8::row_rstd(SSQB, mm);
                const unsigned long long* hr = (const unsigned long long*)(H6 + (size_t)mm * DMODEL) + lane;
#pragma unroll
                for (int j = 0; j < 4; ++j) w[q][j] = hr[64 * j]; }
            const f32x4* gr = (const f32x4*)norm_final + lane;
            f32x4 gg[4];
#pragma unroll
            for (int j = 0; j < 4; ++j) gg[j] = gr[64 * j];
#pragma unroll
            for (int q = 0; q < 4; ++q) { const int mm = m + q * NGW; if (mm < TOK) { f32x4* xr = (f32x4*)(out + (size_t)mm * DMODEL) + lane;
#pragma unroll
                for (int j = 0; j < 4; ++j) { const unsigned long long ww = w[q][j];
                    const f32x4 v = {pg8::bf_lo((unsigned)ww), pg8::bf_hi((unsigned)ww), pg8::bf_lo((unsigned)(ww >> 32)), pg8::bf_hi((unsigned)(ww >> 32))};
                    __builtin_nontemporal_store(v * rs[q] * gg[j], xr + 64 * j); } } }
        }
    }
#undef IN
#undef SEAM
}

#ifndef MK_N_LAUNCHES
#define MK_N_LAUNCHES 1
#endif
constexpr int N_PHASES = 16;
extern "C" void kernel_launch(void* const* d_in, const int* in_sizes, int n_in, void* d_out, int out_size, void* d_ws, size_t ws_size, hipStream_t stream) {
    static int grid = 0;
    if (grid == 0) {
        if (n_in != 24 || out_size != TOK * DMODEL || ws_size < WS_END) { fprintf(stderr, "kernel_launch: unexpected shapes (n_in %d, out %d, ws %zu)\n", n_in, out_size, ws_size); grid = -1; return; }
        int dev = 0, cus = 0;
        if (hipGetDevice(&dev) != hipSuccess || hipDeviceGetAttribute(&cus, hipDeviceAttributeMultiprocessorCount, dev) != hipSuccess) { grid = -1; return; }
        if (hipFuncSetAttribute((const void*)mega_fwd, hipFuncAttributeMaxDynamicSharedMemorySize, LDS_BYTES) != hipSuccess) { fprintf(stderr, "kernel_launch: hipFuncSetAttribute failed\n"); grid = -1; return; }
        int per_cu = 0;
        if (hipOccupancyMaxActiveBlocksPerMultiprocessor(&per_cu, (const void*)mega_fwd, NWAVES * 64, LDS_BYTES) != hipSuccess || per_cu < 1) { fprintf(stderr, "kernel_launch: occupancy query says %d\n", per_cu); }
        (void)hipGetLastError();
        grid = cus;
    }
    if (grid < 0) return;
    (void)hipMemsetAsync((char*)d_ws + WS_CTL, 0, CTL_ZERO_BYTES, stream);
    Args a{};
    for (int i = 0; i < 24; ++i) a.in[i] = d_in[i];
    a.out = (float*)d_out; a.ws = (unsigned char*)d_ws;
#ifdef DBG_CHECK
    {
        using namespace dbg;
        auto LP = [&](int ph) { a.ph_lo = ph; a.ph_hi = ph + 1; hipLaunchKernelGGL(mega_fwd, dim3(grid), dim3(NWAVES * 64), LDS_BYTES, stream, a); };
        char* wsb = (char*)d_ws; float* ERR = (float*)(wsb + 512 * 1024); float* SNAP = (float*)(wsb + 600 * 1024); float* outp = (float*)d_out;
        const unsigned short* ZHp = (const unsigned short*)(wsb + WS_ZH); const unsigned short* Yp = (const unsigned short*)(wsb + WS_Y); const float* FB = (const float*)(wsb + WS_FBUF);
        const unsigned short* HBp = (const unsigned short*)(wsb + WS_HB); const unsigned short* H3p = (const unsigned short*)d_out;
        auto F = [&](int i) { return (const float*)d_in[i]; };
        const float* x = F(0);
        LP(0); LP(1);
        k_evenin<<<NS, 256, 0, stream>>>(x, F(3), F(13), (const int*)d_in[2], ZHp, ERR, 0);
        LP(2);
        k_pool<<<NS, 256, 0, stream>>>(ZHp, Yp, ERR, 1);
        k_dsa<<<NS, 256, 0, stream>>>(ZHp, Yp, ERR, 2);
        LP(3);
        k_outproj<<<NS, 256, 0, stream>>>(x, 0, SNAP, Yp, F(14), F(15), F(16), HBp, ERR, 3);
        for (int layer = 0; layer < 2; ++layer) {
            const int pb = layer ? 10 : 3, kb = layer ? 10 : 3;
            if (layer == 1) {
                LP(8);
                k_oddin<<<NS, 256, 0, stream>>>(H3p, F(3) + 1024, F(17), ZHp, FB, ERR, 7);
                LP(9);
                k_fox<<<NS, 256, 0, stream>>>(ZHp, FB, F(19), Yp, ERR, 8);
                k_sgu<<<NS, 256, 0, stream>>>(ZHp, F(20), F(21), F(22), F(23), Yp, ERR, 9);
                k_snap<<<NS, 256, 0, stream>>>(H3p, SNAP);
                LP(10);
                k_outproj<<<NS, 256, 0, stream>>>(nullptr, 1, SNAP, Yp, F(18), nullptr, nullptr, HBp, ERR, 10);
            }
            LP(pb + 1); LP(pb + 2);
            k_ffnin<<<NS, 256, 0, stream>>>(HBp, F(4) + 1024 * layer, F(6) + (size_t)layer * 1024 * NFF2, F(7) + (size_t)layer * 3 * NFF2, F(8) + (size_t)layer * NFF2, ZHp, ERR, kb + 1);
            k_snap<<<NS, 256, 0, stream>>>(HBp, SNAP);
            LP(pb + 3);
            k_ffnout<<<NS, 256, 0, stream>>>(SNAP, ZHp, F(9) + (size_t)layer * DFF * 1024, HBp, ERR, kb + 2);
            k_snap<<<NS, 256, 0, stream>>>(HBp, SNAP);
            LP(pb + 4);
            k_ple<<<NS, 256, 0, stream>>>(SNAP, F(1) + (size_t)layer * TOK * PLE, F(5) + 1024 * layer, F(10) + (size_t)layer * PLE * 1024, F(11) + (size_t)layer * 1024 * 1024, layer ? Yp : H3p, ERR, kb + 3);
        }
        k_snap<<<NS, 256, 0, stream>>>(Yp, SNAP);
        LP(15);
        k_final<<<NS, 256, 0, stream>>>(SNAP, F(12), outp, ERR, 14);
        t_dpp<<<1, 64, 0, stream>>>(ERR + 40);
        k_report<<<1024, 256, 0, stream>>>(ERR, 15, DBG_TOL, outp);
        return;
    }
#endif
    if (MK_N_LAUNCHES == 1) {
        a.ph_lo = 0; a.ph_hi = N_PHASES;
        hipLaunchKernelGGL(mega_fwd, dim3(grid), dim3(NWAVES * 64), LDS_BYTES, stream, a);
    } else {
#ifndef DBG_STOP
#define DBG_STOP N_PHASES
#endif
#ifndef DBG_DOUBLE
#define DBG_DOUBLE -1
#endif
        for (int ph = 0; ph < DBG_STOP; ++ph) { a.ph_lo = ph; a.ph_hi = ph + 1; const int reps = (ph == DBG_DOUBLE || (DBG_DOUBLE == 100 && (ph == 0 || ph == 1 || ph == 2 || ph == 4 || ph == 5 || ph == 8 || ph == 9 || ph == 11 || ph == 12))) ? 2 : 1;
            for (int r = 0; r < reps; ++r) hipLaunchKernelGGL(mega_fwd, dim3(grid), dim3(NWAVES * 64), LDS_BYTES, stream, a); }
    }
}
```

```cpp
#include <hip/hip_runtime.h>
#include <hip/hip_bf16.h>
#include <cstdio>
#include <cstdint>
#include <cmath>
constexpr int TOK = 16384, DMODEL = 1024, SEQ = 2048, NBATCH = 8;
constexpr int DFF = 2816, NFF2 = 5632, PLE = 256;
constexpr int EV_N = 1536;
constexpr int OD_N = 2816;
constexpr int Z1P = 2560;
constexpr float RMS_EPS = 1e-6f;
constexpr float C2 = 0.125f * 1.4426950408889634f;


__device__ __forceinline__ int lane_opaque() { unsigned z = 0u; asm volatile("" : "+v"(z)); return (int)__builtin_amdgcn_mbcnt_hi(~0u, __builtin_amdgcn_mbcnt_lo(~0u, z)); }
__device__ __forceinline__ float xor16_f(float v) { return __builtin_bit_cast(float, __builtin_amdgcn_ds_swizzle(__builtin_bit_cast(int, v), 0x401F)); }
__device__ __forceinline__ void halves_pair(unsigned v, unsigned& a, unsigned& b) { unsigned w = v; asm volatile("" : "+v"(w)); auto rr = __builtin_amdgcn_permlane32_swap(v, w, false, false); a = rr[0]; b = rr[1]; }
__device__ __forceinline__ float halves_sum_f(float v) { unsigned a, b; halves_pair(__builtin_bit_cast(unsigned, v), a, b); return __builtin_bit_cast(float, a) + __builtin_bit_cast(float, b); }
__device__ __forceinline__ float halves_max_f(float v) { unsigned a, b; halves_pair(__builtin_bit_cast(unsigned, v), a, b); return __builtin_fmaxf(__builtin_bit_cast(float, a), __builtin_bit_cast(float, b)); }
__device__ __forceinline__ unsigned halves_add_u(unsigned v) { unsigned a, b; halves_pair(v, a, b); return a + b; }
__device__ __forceinline__ unsigned halves_or_u(unsigned v) { unsigned a, b; halves_pair(v, a, b); return a | b; }
namespace pg8 {
#define PG8_LAS __attribute__((address_space(3)))
typedef unsigned short bf16_t;
typedef short bf16x8 __attribute__((ext_vector_type(8)));
typedef float f32x4 __attribute__((ext_vector_type(4)));
typedef unsigned u32x4 __attribute__((ext_vector_type(4)));
constexpr int BM = 256, BK = 64, HALF = 128, HTB = HALF * BK * 2  , STAGE_BYTES = 8 * HTB, NXCD = 8, WGM = 8;

__host__ __device__ __forceinline__ int lds_byte(int r, int c) { const int st = (r >> 4) * 2 + (c >> 5), rr = r & 15, cc = c & 31, ob = rr * 64 + cc * 2; return st * 1024 + (ob ^ (((ob >> 9) & 1) << 5)); }
__host__ __device__ __forceinline__ void stage_rc(int b, int& R, int& C) { const int st = b / 1024, sb = b % 1024, swz = sb ^ (((sb >> 9) & 1) << 5); R = (st >> 1) * 16 + swz / 64; C = (st & 1) * 32 + (swz % 64) / 2; }
__host__ __device__ __forceinline__ int perm32(int rho) { const int n = rho >> 4, i = rho & 15; return 8 * (i >> 2) + 4 * n + (i & 3); }

struct Unit { int pm, pn; };
struct Gemm { const bf16_t* A; const bf16_t* Bt; int M, N, K; };

struct StaticOrder {
    int nM, nN, nwg, G, c;
    __host__ __device__ void init(int M, int N, int G_, int c_) { nM = M / BM; nN = N / BM; nwg = nM * nN; G = G_; c = c_; }
    __host__ __device__ bool next(int i, Unit& u) const {
        const long L = (long)i * G + c; if (L >= nwg) return false;
        int wgid = (int)L; { const int q = nwg / NXCD, r = nwg % NXCD, xcd = wgid % NXCD, off = wgid / NXCD; wgid = (xcd < r ? xcd * (q + 1) : r * (q + 1) + (xcd - r) * q) + off; }
        const int nig = WGM * nN, gid = wgid / nig, fm = gid * WGM, gsz = (nM - fm) < WGM ? (nM - fm) : WGM;
        u.pm = fm + ((wgid % nig) % gsz); u.pn = (wgid % nig) / gsz; return true;
    }
    __device__ __forceinline__ void a_ready(const Unit&) const {}
    __device__ __forceinline__ void done(const Unit&) const {}
};

struct OneUnit {
    int pm, pn, on;
    __host__ __device__ bool next(int i, Unit& u) const { if (!on || i != 0) return false; u.pm = pm; u.pn = pn; return true; }
    __device__ __forceinline__ void a_ready(const Unit&) const {}
    __device__ __forceinline__ void done(const Unit&) const {}
};
struct FfnOrder {
    StaticOrder S0; int extra;
    __host__ __device__ void init(int M, int N, int G_, int c_) { S0.init(M, N, G_, c_); extra = (G_ == 256 && c_ >= 128 && c_ < 128 + N / BM) ? 1 : 0; }
    __host__ __device__ bool next(int i, Unit& u) const { if (extra) { if (i == 0) { u.pm = 64; u.pn = S0.c - 128; return true; } return S0.next(i - 1, u); } return S0.next(i, u); }
    __device__ __forceinline__ void a_ready(const Unit&) const {}
    __device__ __forceinline__ void done(const Unit&) const {}
};
typedef float f32x2 __attribute__((ext_vector_type(2)));
typedef unsigned u32x2 __attribute__((ext_vector_type(2)));
__device__ __forceinline__ unsigned cvt_pk_bf16(float lo, float hi) { unsigned r; asm volatile("v_cvt_pk_bf16_f32 %0, %1, %2" : "=v"(r) : "v"(lo), "v"(hi)); return r; }
__device__ __forceinline__ float bf_lo(unsigned w) { return __builtin_bit_cast(float, w << 16); }
__device__ __forceinline__ float bf_hi(unsigned w) { return __builtin_bit_cast(float, w & 0xffff0000u); }
__device__ __forceinline__ float sq4(const f32x4 v) { return (v[0] * v[0] + v[1] * v[1]) + (v[2] * v[2] + v[3] * v[3]); }
__device__ __forceinline__ float row_rstd(const float* ssq, int row) {
    const f32x4* p = (const f32x4*)(ssq + (size_t)row * 16);
    const f32x4 a = p[0], b = p[1], c = p[2], d = p[3];
    const float s = (((a[0] + a[1]) + (a[2] + a[3])) + ((b[0] + b[1]) + (b[2] + b[3]))) + (((c[0] + c[1]) + (c[2] + c[3])) + ((d[0] + d[1]) + (d[2] + d[3])));
    return 1.0f / sqrtf(s * (1.0f / 1024.0f) + RMS_EPS);
}
__device__ __forceinline__ float row_rstd_coh(const float* ssq, int row) {
    const float* p = ssq + (size_t)row * 16;
    f32x4 a, b, c, d;
    asm volatile("global_load_dwordx4 %0, %4, off sc1\n\tglobal_load_dwordx4 %1, %4, off offset:16 sc1\n\tglobal_load_dwordx4 %2, %4, off offset:32 sc1\n\tglobal_load_dwordx4 %3, %4, off offset:48 sc1\n\ts_waitcnt vmcnt(0)"
                 : "=&v"(a), "=&v"(b), "=&v"(c), "=&v"(d) : "v"(p) : "memory");
    const float s = (((a[0] + a[1]) + (a[2] + a[3])) + ((b[0] + b[1]) + (b[2] + b[3]))) + (((c[0] + c[1]) + (c[2] + c[3])) + ((d[0] + d[1]) + (d[2] + d[3])));
    return 1.0f / sqrtf(s * (1.0f / 1024.0f) + RMS_EPS);
}
__device__ __forceinline__ void ssq_write(float* ssq_out, float q, int row, int slot, int fq) {
    q += xor16_f(q); q = halves_sum_f(q);
    if (fq == 0) ssq_out[(size_t)row * 16 + slot] = q;
}
typedef float f32x2 __attribute__((ext_vector_type(2)));
__device__ __forceinline__ f32x2 gelu_mul2(const f32x2 x, const f32x2 c) {
    const f32x2 x2 = x * x;
    const f32x2 a = x * (x2 * (-2.3022082f * 0.044715f) + (-2.3022082f));
    f32x2 e; e.x = __builtin_amdgcn_exp2f(a.x); e.y = __builtin_amdgcn_exp2f(a.y);
    const f32x2 d = e + 1.0f;
    f32x2 r; r.x = __builtin_amdgcn_rcpf(d.x); r.y = __builtin_amdgcn_rcpf(d.y);
    return (x * c) * r;
}
__device__ __forceinline__ float gelu_tanh(float x) {
    const float t = x + 0.044715f * x * x * x;
    const float e = __builtin_amdgcn_exp2f(-2.3022082f * t);
    return x * __builtin_amdgcn_rcpf(1.0f + e);
}
__device__ __forceinline__ float sigmoid_f(float x) { return __builtin_amdgcn_rcpf(1.0f + __builtin_amdgcn_exp2f(-1.4426950408889634f * x)); }


struct EpiRes {
    static constexpr bool PERM = true, AFTER_DRAIN = false;
    const float* basef; const bf16_t* baseb; bf16_t* hb; float* ssq_out; bf16_t* ahalo;
    __device__ __forceinline__ void operator()(const f32x4 (&acc)[2][2][4][2], const Unit& u_, int wr, int wc, int fr, int fq) const {
        Unit u; { int pm_ = u_.pm, pn_ = u_.pn; asm volatile("" : "+s"(pm_), "+s"(pn_)); u.pm = pm_; u.pn = pn_; }
        const int row0 = u.pm * BM + wr * 64 + fr, col0 = u.pn * BM + wc * 32 + 8 * fq;
        if (basef != nullptr) {
#pragma unroll
            for (int ai = 0; ai < 2; ++ai)
#pragma unroll
                for (int m = 0; m < 4; ++m) {
                    const int row = row0 + ai * HALF + m * 16; float q = 0.f;
#pragma unroll
                    for (int bj = 0; bj < 2; ++bj) {
                        const size_t off = (size_t)row * DMODEL + col0 + bj * HALF;
                        const f32x4 b0 = *(const f32x4*)(basef + off), b1 = *(const f32x4*)(basef + off + 4);
                        const f32x4 v0 = acc[ai][bj][m][0] + b0, v1 = acc[ai][bj][m][1] + b1;
                        q += sq4(v0) + sq4(v1);
                        u32x4 w; w.x = cvt_pk_bf16(v0[0], v0[1]); w.y = cvt_pk_bf16(v0[2], v0[3]); w.z = cvt_pk_bf16(v1[0], v1[1]); w.w = cvt_pk_bf16(v1[2], v1[3]);
                        *(u32x4*)(hb + off) = w;
                        if (ahalo != nullptr && ai == 1 && m == 3) {
                            const int rl = row & 255;
                            if (rl >= 254 && u.pm < 63) *(u32x4*)(ahalo + (size_t)(2 * (u.pm + 1) + (rl - 254)) * DMODEL + col0 + bj * HALF) = w;
                        }
                    }
                    ssq_write(ssq_out, q, row, u.pn * 4 + wc, fq);
                    if (m & 1) asm volatile("" ::: "memory");
                }
        } else {
#pragma unroll
            for (int ai = 0; ai < 2; ++ai) {
                u32x4 bw[4][2];
#pragma unroll
                for (int m = 0; m < 4; ++m)
#pragma unroll
                    for (int bj = 0; bj < 2; ++bj) bw[m][bj] = *(const u32x4*)(baseb + (size_t)(row0 + ai * HALF + m * 16) * DMODEL + col0 + bj * HALF);
                asm volatile("" ::: "memory");
#pragma unroll
                for (int m = 0; m < 4; ++m) {
                    const int row = row0 + ai * HALF + m * 16; float q = 0.f;
#pragma unroll
                    for (int bj = 0; bj < 2; ++bj) {
                        const size_t off = (size_t)row * DMODEL + col0 + bj * HALF;
                        const u32x4 pw = bw[m][bj];
                        const f32x4 b0 = {bf_lo(pw.x), bf_hi(pw.x), bf_lo(pw.y), bf_hi(pw.y)}, b1 = {bf_lo(pw.z), bf_hi(pw.z), bf_lo(pw.w), bf_hi(pw.w)};
                        const f32x4 v0 = acc[ai][bj][m][0] + b0, v1 = acc[ai][bj][m][1] + b1;
                        q += sq4(v0) + sq4(v1);
                        u32x4 w; w.x = cvt_pk_bf16(v0[0], v0[1]); w.y = cvt_pk_bf16(v0[2], v0[3]); w.z = cvt_pk_bf16(v1[0], v1[1]); w.w = cvt_pk_bf16(v1[2], v1[3]);
                        *(u32x4*)(hb + off) = w;
                        if (ahalo != nullptr && ai == 1 && m == 3) {
                            const int rl = row & 255;
                            if (rl >= 254 && u.pm < 63) *(u32x4*)(ahalo + (size_t)(2 * (u.pm + 1) + (rl - 254)) * DMODEL + col0 + bj * HALF) = w;
                        }
                    }
                    ssq_write(ssq_out, q, row, u.pn * 4 + wc, fq);
                }
                asm volatile("" ::: "memory");
            }
        }
    }
};
struct EpiGate {
    static constexpr bool PERM = true, AFTER_DRAIN = false;
    const float* ssq_in; const bf16_t* base; const bf16_t* pp; bf16_t* dst; float* ssq_out;
    __device__ __forceinline__ void operator()(const f32x4 (&acc)[2][2][4][2], const Unit& u_, int wr, int wc, int fr, int fq) const {
        Unit u; { int pm_ = u_.pm, pn_ = u_.pn; asm volatile("" : "+s"(pm_), "+s"(pn_)); u.pm = pm_; u.pn = pn_; }
        const int row0 = u.pm * BM + wr * 64 + fr, col0 = u.pn * BM + wc * 32 + 8 * fq;
#pragma unroll
        for (int ai = 0; ai < 2; ++ai)
#pragma unroll
            for (int mp = 0; mp < 2; ++mp) {
                u32x4 bw[2][2], pq[2][2]; float rs[2];
#pragma unroll
                for (int mi = 0; mi < 2; ++mi) {
                    const int row = row0 + ai * HALF + (2 * mp + mi) * 16;
#pragma unroll
                    for (int bj = 0; bj < 2; ++bj) { const size_t off = (size_t)row * DMODEL + col0 + bj * HALF; bw[mi][bj] = *(const u32x4*)(base + off); pq[mi][bj] = *(const u32x4*)(pp + off); }
                }
#pragma unroll
                for (int mi = 0; mi < 2; ++mi) rs[mi] = row_rstd(ssq_in, row0 + ai * HALF + (2 * mp + mi) * 16);
                asm volatile("" ::: "memory");
#pragma unroll
                for (int mi = 0; mi < 2; ++mi) {
                    const int m = 2 * mp + mi; const int row = row0 + ai * HALF + m * 16; float q = 0.f;
#pragma unroll
                    for (int bj = 0; bj < 2; ++bj) {
                        const size_t off = (size_t)row * DMODEL + col0 + bj * HALF;
                        const u32x4 b_ = bw[mi][bj], p_ = pq[mi][bj];
                        const float bb[8] = {bf_lo(b_.x), bf_hi(b_.x), bf_lo(b_.y), bf_hi(b_.y), bf_lo(b_.z), bf_hi(b_.z), bf_lo(b_.w), bf_hi(b_.w)};
                        const float pv[8] = {bf_lo(p_.x), bf_hi(p_.x), bf_lo(p_.y), bf_hi(p_.y), bf_lo(p_.z), bf_hi(p_.z), bf_lo(p_.w), bf_hi(p_.w)};
                        const f32x4 g0 = acc[ai][bj][m][0] * rs[mi], g1 = acc[ai][bj][m][1] * rs[mi];
                        const float gg[8] = {g0[0], g0[1], g0[2], g0[3], g1[0], g1[1], g1[2], g1[3]};
                        float v[8];
#pragma unroll
                        for (int i = 0; i < 8; ++i) { v[i] = bb[i] + pv[i] * sigmoid_f(gg[i]); q += v[i] * v[i]; }
                        u32x4 w; w.x = cvt_pk_bf16(v[0], v[1]); w.y = cvt_pk_bf16(v[2], v[3]); w.z = cvt_pk_bf16(v[4], v[5]); w.w = cvt_pk_bf16(v[6], v[7]);
                        *(u32x4*)(dst + off) = w;
                    }
                    ssq_write(ssq_out, q, row, u.pn * 4 + wc, fq);
                }
                asm volatile("" ::: "memory");
            }
    }
};
struct EpiGateFinal {
    static constexpr bool PERM = true, AFTER_DRAIN = false;
    const float* ssq_in; const bf16_t* base; const bf16_t* pp; float* ssq_out; unsigned* cnt; const float* gain; float* outp; PG8_LAS float* rtab;
    __device__ __forceinline__ void operator()(const f32x4 (&acc)[2][2][4][2], const Unit& u_, int wr, int wc, int fr, int fq) const {
        Unit u; { int pm_ = u_.pm, pn_ = u_.pn; asm volatile("" : "+s"(pm_), "+s"(pn_)); u.pm = pm_; u.pn = pn_; }
        const int row0 = u.pm * BM + wr * 64 + fr, col0 = u.pn * BM + wc * 32 + 8 * fq;
        f32x4 hv[2][2][4][2];
#pragma unroll
        for (int ai = 0; ai < 2; ++ai)
#pragma unroll
            for (int mp = 0; mp < 2; ++mp) {
                u32x4 bw[2][2], pq[2][2]; float rs[2];
#pragma unroll
                for (int mi = 0; mi < 2; ++mi) {
                    const int row = row0 + ai * HALF + (2 * mp + mi) * 16;
#pragma unroll
                    for (int bj = 0; bj < 2; ++bj) { const size_t off = (size_t)row * DMODEL + col0 + bj * HALF; bw[mi][bj] = *(const u32x4*)(base + off); pq[mi][bj] = *(const u32x4*)(pp + off); }
                }
#pragma unroll
                for (int mi = 0; mi < 2; ++mi) rs[mi] = row_rstd(ssq_in, row0 + ai * HALF + (2 * mp + mi) * 16);
                asm volatile("" ::: "memory");
#pragma unroll
                for (int mi = 0; mi < 2; ++mi) {
                    const int m = 2 * mp + mi; const int row = row0 + ai * HALF + m * 16; float q = 0.f;
#pragma unroll
                    for (int bj = 0; bj < 2; ++bj) {
                        const u32x4 b_ = bw[mi][bj], p_ = pq[mi][bj];
                        const float bb[8] = {bf_lo(b_.x), bf_hi(b_.x), bf_lo(b_.y), bf_hi(b_.y), bf_lo(b_.z), bf_hi(b_.z), bf_lo(b_.w), bf_hi(b_.w)};
                        const float pv[8] = {bf_lo(p_.x), bf_hi(p_.x), bf_lo(p_.y), bf_hi(p_.y), bf_lo(p_.z), bf_hi(p_.z), bf_lo(p_.w), bf_hi(p_.w)};
                        const f32x4 g0 = acc[ai][bj][m][0] * rs[mi], g1 = acc[ai][bj][m][1] * rs[mi];
                        const float gg[8] = {g0[0], g0[1], g0[2], g0[3], g1[0], g1[1], g1[2], g1[3]};
                        float v[8];
#pragma unroll
                        for (int i = 0; i < 8; ++i) { v[i] = bb[i] + pv[i] * sigmoid_f(gg[i]); q += v[i] * v[i]; }
                        hv[ai][bj][m][0] = (f32x4){v[0], v[1], v[2], v[3]}; hv[ai][bj][m][1] = (f32x4){v[4], v[5], v[6], v[7]};
                    }
                    ssq_write(ssq_out, q, row, u.pn * 4 + wc, fq);
                }
                asm volatile("" ::: "memory");
            }
        asm volatile("s_waitcnt vmcnt(0)" ::: "memory"); __builtin_amdgcn_s_barrier(); asm volatile("" ::: "memory");
        if (wr == 0 && wc == 0) {
            if (fr == 0 && fq == 0) {
                __builtin_amdgcn_fence(__ATOMIC_RELEASE, "agent");
                asm volatile("s_waitcnt vmcnt(0)" ::: "memory");
                __hip_atomic_fetch_add(cnt + 64 * u.pm, 1u, __ATOMIC_RELAXED, __HIP_MEMORY_SCOPE_AGENT);
            }
            unsigned sp = 0;
            while (__hip_atomic_load(cnt + 64 * u.pm, __ATOMIC_RELAXED, __HIP_MEMORY_SCOPE_AGENT) < 4u) { __builtin_amdgcn_s_sleep(2); if (++sp > (1u << 22)) break; }
        }
        asm volatile("" ::: "memory"); __builtin_amdgcn_s_barrier(); asm volatile("" ::: "memory");
        if (wr == 0) rtab[wc * 64 + fq * 16 + fr] = row_rstd_coh(ssq_out, u.pm * BM + wc * 64 + fq * 16 + fr);
        asm volatile("s_waitcnt lgkmcnt(0)" ::: "memory"); __builtin_amdgcn_s_barrier(); asm volatile("" ::: "memory");
        f32x4 gn[2][2];
#pragma unroll
        for (int bj = 0; bj < 2; ++bj)
#pragma unroll
            for (int n = 0; n < 2; ++n) gn[bj][n] = *(const f32x4*)(gain + col0 + bj * HALF + 4 * n);
#pragma unroll
        for (int ai = 0; ai < 2; ++ai)
#pragma unroll
            for (int m = 0; m < 4; ++m) {
                const float rsf = rtab[ai * HALF + wr * 64 + m * 16 + fr];
                float* orow = outp + (size_t)(row0 + ai * HALF + m * 16) * DMODEL + col0;
#pragma unroll
                for (int bj = 0; bj < 2; ++bj)
#pragma unroll
                    for (int n = 0; n < 2; ++n) *(f32x4*)(orow + bj * HALF + 4 * n) = hv[ai][bj][m][n] * rsf * gn[bj][n];
            }
    }
};
struct EpiBf16Plain {
    static constexpr bool PERM = true, AFTER_DRAIN = false;
    bf16_t* O; int ldc;
    __device__ __forceinline__ void operator()(const f32x4 (&acc)[2][2][4][2], const Unit& u_, int wr, int wc, int fr, int fq) const {
        Unit u; { int pm_ = u_.pm, pn_ = u_.pn; asm volatile("" : "+s"(pm_), "+s"(pn_)); u.pm = pm_; u.pn = pn_; }
        const int row0 = u.pm * BM + wr * 64 + fr, col0 = u.pn * BM + wc * 32 + 8 * fq;
#pragma unroll
        for (int ai = 0; ai < 2; ++ai)
#pragma unroll
            for (int m = 0; m < 4; ++m) {
                const int row = row0 + ai * HALF + m * 16;
#pragma unroll
                for (int bj = 0; bj < 2; ++bj) {
                    const f32x4 v0 = acc[ai][bj][m][0], v1 = acc[ai][bj][m][1];
                    u32x4 w; w.x = cvt_pk_bf16(v0[0], v0[1]); w.y = cvt_pk_bf16(v0[2], v0[3]); w.z = cvt_pk_bf16(v1[0], v1[1]); w.w = cvt_pk_bf16(v1[2], v1[3]);
                    *(u32x4*)(O + (size_t)row * ldc + col0 + bj * HALF) = w;
                }
            }
    }
};
struct EpiEvenIn {
    static constexpr bool PERM = true, AFTER_DRAIN = false;
    const float* ssq_in; bf16_t* Z; const f32x2* rope;
    __device__ __forceinline__ void operator()(const f32x4 (&acc)[2][2][4][2], const Unit& u_, int wr, int wc, int fr, int fq) const {
        Unit u; { int pm_ = u_.pm, pn_ = u_.pn; asm volatile("" : "+s"(pm_), "+s"(pn_)); u.pm = pm_; u.pn = pn_; }
        const int row0 = u.pm * BM + wr * 64 + fr, colw = wc * 32 + 8 * fq;
        const int pn = u.pn;
        const float sc = (pn == 2 || pn == 3) ? C2 : 1.0f;
#pragma unroll
        for (int ai = 0; ai < 2; ++ai)
#pragma unroll
            for (int m = 0; m < 4; ++m) {
                const int row = row0 + ai * HALF + m * 16;
                const float rs = row_rstd(ssq_in, row);
#pragma unroll
                for (int bj = 0; bj < 2; ++bj) {
                    const int gi = 2 * bj + (wc >> 1);
                    const bool ropeg = (pn == 2 || pn == 3 || pn == 5 || (pn == 4 && (gi == 0 || gi == 2))) && ((wc & 1) == 0);
                    f32x4 v0 = acc[ai][bj][m][0] * rs, v1 = acc[ai][bj][m][1] * rs;
                    if (ropeg && fq < 2) {
                        const f32x4* rp = (const f32x4*)(rope + (size_t)row * 8 + 4 * fq);
                        const f32x4 ra = rp[0], rb = rp[1];
                        f32x4 o0, o1;
                        o0[0] = v0[0] * ra[0] - v0[1] * ra[1]; o0[1] = v0[1] * ra[0] + v0[0] * ra[1];
                        o0[2] = v0[2] * ra[2] - v0[3] * ra[3]; o0[3] = v0[3] * ra[2] + v0[2] * ra[3];
                        o1[0] = v1[0] * rb[0] - v1[1] * rb[1]; o1[1] = v1[1] * rb[0] + v1[0] * rb[1];
                        o1[2] = v1[2] * rb[2] - v1[3] * rb[3]; o1[3] = v1[3] * rb[2] + v1[2] * rb[3];
                        v0 = o0; v1 = o1;
                    }
                    v0 = v0 * sc; v1 = v1 * sc;
                    u32x4 w; w.x = cvt_pk_bf16(v0[0], v0[1]); w.y = cvt_pk_bf16(v0[2], v0[3]); w.z = cvt_pk_bf16(v1[0], v1[1]); w.w = cvt_pk_bf16(v1[2], v1[3]);
                    *(u32x4*)(Z + (size_t)row * EV_N + pn * BM + bj * HALF + colw) = w;
                }
            }
    }
};
struct EpiOddIn {
    static constexpr bool PERM = true, AFTER_DRAIN = false;
    const float* ssq_in; bf16_t* Z; float* F; float* sst;
    __device__ __forceinline__ void operator()(const f32x4 (&acc)[2][2][4][2], const Unit& u_, int wr, int wc, int fr, int fq) const {
        Unit u; { int pm_ = u_.pm, pn_ = u_.pn; asm volatile("" : "+s"(pm_), "+s"(pn_)); u.pm = pm_; u.pn = pn_; }
        const int row0 = u.pm * BM + wr * 64 + fr, colw = wc * 32 + 8 * fq;
        const int pn = u.pn;
        const float sc = (pn < 2) ? C2 : 1.0f;
        const bool act = (pn >= 6 && pn < 10), stat = (pn == 8 || pn == 9);
#pragma unroll
        for (int ai = 0; ai < 2; ++ai)
#pragma unroll
            for (int m = 0; m < 4; ++m) {
                const int row = row0 + ai * HALF + m * 16;
                const float rs = row_rstd(ssq_in, row);
                if (pn == 10) {
                    if (wc == 0 && fq == 0) { *(f32x4*)(F + (size_t)row * 8) = acc[ai][0][m][0] * rs; *(f32x4*)(F + (size_t)row * 8 + 4) = acc[ai][0][m][1] * rs; }
                    continue;
                }
                float s1 = 0.f, s2 = 0.f;
#pragma unroll
                for (int bj = 0; bj < 2; ++bj) {
                    f32x4 v0 = acc[ai][bj][m][0] * (rs * sc), v1 = acc[ai][bj][m][1] * (rs * sc);
                    if (act) {
#pragma unroll
                        for (int i = 0; i < 4; ++i) { v0[i] = gelu_tanh(v0[i]); v1[i] = gelu_tanh(v1[i]); }
                    }
                    s1 += ((v0[0] + v0[1]) + (v0[2] + v0[3])) + ((v1[0] + v1[1]) + (v1[2] + v1[3])); s2 += sq4(v0) + sq4(v1);
                    u32x4 w; w.x = cvt_pk_bf16(v0[0], v0[1]); w.y = cvt_pk_bf16(v0[2], v0[3]); w.z = cvt_pk_bf16(v1[0], v1[1]); w.w = cvt_pk_bf16(v1[2], v1[3]);
                    *(u32x4*)(Z + (size_t)row * Z1P + pn * BM + bj * HALF + colw) = w;
                }
                if (stat) {
                    s1 += xor16_f(s1); s1 = halves_sum_f(s1); s2 += xor16_f(s2); s2 = halves_sum_f(s2);
                    if (fq == 0) *(f32x2*)(sst + ((size_t)row * 8 + (pn - 8) * 4 + wc) * 2) = (f32x2){s1, s2};
                }
            }
    }
};
struct EpiHalo {
    static constexpr bool PERM = true, AFTER_DRAIN = false;
    const float* ssq_in; float* AH;
    __device__ __forceinline__ void operator()(const f32x4 (&acc)[2][2][4][2], const Unit& u_, int wr, int wc, int fr, int fq) const {
        Unit u; { int pm_ = u_.pm, pn_ = u_.pn; asm volatile("" : "+s"(pm_), "+s"(pn_)); u.pm = pm_; u.pn = pn_; }
        const int col0 = u.pn * BM + wc * 32 + 8 * fq;
#pragma unroll
        for (int m = 0; m < 4; ++m) {
            const int rh = wr * 64 + m * 16 + fr;
            if (rh < 2) continue;
            const int tok = 256 * (rh >> 1) - 2 + (rh & 1);
            const float rs = row_rstd(ssq_in, tok);
#pragma unroll
            for (int bj = 0; bj < 2; ++bj) {
                *(f32x4*)(AH + (size_t)rh * NFF2 + col0 + bj * HALF) = acc[0][bj][m][0] * rs;
                *(f32x4*)(AH + (size_t)rh * NFF2 + col0 + bj * HALF + 4) = acc[0][bj][m][1] * rs;
            }
        }
    }
};
template <int SEL> __device__ __forceinline__ float dpp1(const float old, const float src) {
    const int o = __builtin_bit_cast(int, old), s = __builtin_bit_cast(int, src); int t;
    if (SEL == 0) t = __builtin_amdgcn_update_dpp(o, s, 0x111, 0xf, 0xf, false);
    else if (SEL == 1) t = __builtin_amdgcn_update_dpp(o, s, 0x112, 0xf, 0xf, false);
    else if (SEL == 2) t = __builtin_amdgcn_update_dpp(o, s, 0x10F, 0xf, 0xf, false);
    else t = __builtin_amdgcn_update_dpp(o, s, 0x10E, 0xf, 0xf, false);
    return __builtin_bit_cast(float, t);
}
template <int SEL> __device__ __forceinline__ f32x4 dpp4t(const f32x4 old, const f32x4 src) {
    const float o0 = old[0], o1 = old[1], o2 = old[2], o3 = old[3], s0 = src[0], s1 = src[1], s2 = src[2], s3 = src[3];
    const float r0 = dpp1<SEL>(o0, s0), r1 = dpp1<SEL>(o1, s1), r2 = dpp1<SEL>(o2, s2), r3 = dpp1<SEL>(o3, s3);
    return (f32x4){r0, r1, r2, r3};
}
#define dpp4(old, src, sel) dpp4t<sel>(old, src)
__device__ __forceinline__ void conv_taps(f32x4& c, const f32x4 cur, const f32x4 prev, const f32x4 w0, const f32x4 w1) {
    float c0 = c[0], c1 = c[1], c2 = c[2], c3 = c[3];
    const float x0 = cur[0], x1 = cur[1], x2 = cur[2], x3 = cur[3], p0 = prev[0], p1 = prev[1], p2 = prev[2], p3 = prev[3];
    const float a0 = w1[0], a1 = w1[1], a2 = w1[2], a3 = w1[3], b0 = w0[0], b1 = w0[1], b2 = w0[2], b3 = w0[3];
    asm("s_nop 4\n\t"
        "v_fmac_f32_dpp %0, %4, %12 row_shr:1 row_mask:0xf bank_mask:0xf bound_ctrl:1\n\t"
        "v_fmac_f32_dpp %1, %5, %13 row_shr:1 row_mask:0xf bank_mask:0xf bound_ctrl:1\n\t"
        "v_fmac_f32_dpp %2, %6, %14 row_shr:1 row_mask:0xf bank_mask:0xf bound_ctrl:1\n\t"
        "v_fmac_f32_dpp %3, %7, %15 row_shr:1 row_mask:0xf bank_mask:0xf bound_ctrl:1\n\t"
        "v_fmac_f32_dpp %0, %4, %16 row_shr:2 row_mask:0xf bank_mask:0xf bound_ctrl:1\n\t"
        "v_fmac_f32_dpp %1, %5, %17 row_shr:2 row_mask:0xf bank_mask:0xf bound_ctrl:1\n\t"
        "v_fmac_f32_dpp %2, %6, %18 row_shr:2 row_mask:0xf bank_mask:0xf bound_ctrl:1\n\t"
        "v_fmac_f32_dpp %3, %7, %19 row_shr:2 row_mask:0xf bank_mask:0xf bound_ctrl:1\n\t"
        "v_fmac_f32_dpp %0, %8, %12 row_shl:15 row_mask:0xf bank_mask:0xf bound_ctrl:1\n\t"
        "v_fmac_f32_dpp %1, %9, %13 row_shl:15 row_mask:0xf bank_mask:0xf bound_ctrl:1\n\t"
        "v_fmac_f32_dpp %2, %10, %14 row_shl:15 row_mask:0xf bank_mask:0xf bound_ctrl:1\n\t"
        "v_fmac_f32_dpp %3, %11, %15 row_shl:15 row_mask:0xf bank_mask:0xf bound_ctrl:1\n\t"
        "v_fmac_f32_dpp %0, %8, %16 row_shl:14 row_mask:0xf bank_mask:0xf bound_ctrl:1\n\t"
        "v_fmac_f32_dpp %1, %9, %17 row_shl:14 row_mask:0xf bank_mask:0xf bound_ctrl:1\n\t"
        "v_fmac_f32_dpp %2, %10, %18 row_shl:14 row_mask:0xf bank_mask:0xf bound_ctrl:1\n\t"
        "v_fmac_f32_dpp %3, %11, %19 row_shl:14 row_mask:0xf bank_mask:0xf bound_ctrl:1"
        : "+v"(c0), "+v"(c1), "+v"(c2), "+v"(c3)
        : "v"(x0), "v"(x1), "v"(x2), "v"(x3), "v"(p0), "v"(p1), "v"(p2), "v"(p3), "v"(a0), "v"(a1), "v"(a2), "v"(a3), "v"(b0), "v"(b1), "v"(b2), "v"(b3));
    c[0] = c0; c[1] = c1; c[2] = c2; c[3] = c3;
}
struct EpiHaloF {
    static constexpr bool PERM = true, AFTER_DRAIN = false;
    const float* ssq_in; float* ah; unsigned* flags;
    __device__ __forceinline__ void operator()(const f32x4 (&acc)[2][2][4][2], const Unit& u_, int wr, int wc, int fr, int fq) const {
        Unit u; { int pm_ = u_.pm, pn_ = u_.pn; asm volatile("" : "+s"(pm_), "+s"(pn_)); u.pm = pm_; u.pn = pn_; }
        const int col0 = u.pn * BM + wc * 32 + 8 * fq;
#pragma unroll
        for (int m = 0; m < 4; ++m) {
            const int rh = wr * 64 + m * 16 + fr;
            if (rh >= 2) {
                const int tok = 256 * (rh >> 1) - 2 + (rh & 1);
                const float rsh = row_rstd(ssq_in, tok);
#pragma unroll
                for (int bj = 0; bj < 2; ++bj) {
                    *(f32x4*)(ah + (size_t)rh * NFF2 + col0 + bj * HALF) = acc[0][bj][m][0] * rsh;
                    *(f32x4*)(ah + (size_t)rh * NFF2 + col0 + bj * HALF + 4) = acc[0][bj][m][1] * rsh;
                }
            }
        }
        asm volatile("s_waitcnt vmcnt(0)" ::: "memory"); __builtin_amdgcn_s_barrier(); asm volatile("" ::: "memory");
        if (wr == 0 && wc == 0 && fr == 0 && fq == 0) {
            __builtin_amdgcn_fence(__ATOMIC_RELEASE, "agent");
            asm volatile("s_waitcnt vmcnt(0)" ::: "memory");
            __hip_atomic_store(flags + 64 * u.pn, 1u, __ATOMIC_RELAXED, __HIP_MEMORY_SCOPE_AGENT);
        }
    }
};
struct EpiFfnIn {
    static constexpr bool PERM = true, AFTER_DRAIN = false;
    const float* ssq_in; const float* cw; const float* cb; float* ah; bf16_t* hid; PG8_LAS float* xb; unsigned* flags; unsigned phase_id;
    __device__ __forceinline__ void operator()(const f32x4 (&acc)[2][2][4][2], const Unit& u_, int wr, int wc, int fr, int fq) const {
        Unit u; { int pm_ = u_.pm, pn_ = u_.pn; asm volatile("" : "+s"(pm_), "+s"(pn_)); u.pm = pm_; u.pn = pn_; }
        PG8_LAS float* rtab = xb + 2048;
        const int row0 = u.pm * BM + wr * 64 + fr;
        PG8_LAS float* cwl = xb + 2432 + wc * 256;
        PG8_LAS float* hl = xb + 3456 + wc * 128;
        if (wr == 0) {
            const float* src = (fq < 3 ? cw + fq * NFF2 : cb) + (fr >> 3) * DFF + 128 * u.pn + wc * 32 + (fr & 7) * 4;
            const f32x4 wv = *(const f32x4*)src;
            rtab[wc * 64 + fq * 16 + fr] = row_rstd(ssq_in, u.pm * BM + wc * 64 + fq * 16 + fr);
            *(PG8_LAS f32x4*)(cwl + (fq * 16 + fr) * 4) = wv;
        }
        if (fr >= 14) {
#pragma unroll
            for (int ai = 0; ai < 2; ++ai) {
                PG8_LAS f32x4* dst = (PG8_LAS f32x4*)(xb + ((((ai * 2 + wr) * 4 + wc) * 2 + (fr - 14)) * 4 + fq) * 16);
#pragma unroll
                for (int bj = 0; bj < 2; ++bj)
#pragma unroll
                    for (int n = 0; n < 2; ++n) dst[bj * 2 + n] = acc[ai][bj][3][n];
            }
        }
        asm volatile("s_waitcnt lgkmcnt(0)" ::: "memory"); __builtin_amdgcn_s_barrier(); asm volatile("" ::: "memory");
        const bool has = (u.pm & 7) != 0;
        if (wr == 0) {
            PG8_LAS unsigned* stamp = (PG8_LAS unsigned*)(rtab + 256);
            if (*(volatile PG8_LAS unsigned*)stamp != phase_id) {
                if (wc == 0) {
                    unsigned sp = 0;
                    for (int t = 0; t < NFF2 / BM; ++t)
                        while (__hip_atomic_load(flags + 64 * t, __ATOMIC_RELAXED, __HIP_MEMORY_SCOPE_AGENT) == 0u) { __builtin_amdgcn_s_sleep(2); if (++sp > (1u << 22)) break; }
                    asm volatile("s_waitcnt vmcnt(0)" ::: "memory");
                    if (fr == 0 && fq == 0) *(volatile PG8_LAS unsigned*)stamp = phase_id;
                } else {
                    unsigned sp = 0;
                    while (*(volatile PG8_LAS unsigned*)stamp != phase_id) { __builtin_amdgcn_s_sleep(2); if (++sp > (1u << 22)) break; }
                }
            }
        }
        if (wr == 0) {
            f32x2 hv = {0.f, 0.f};
            if (has) hv = *(const f32x2*)(ah + (size_t)(2 * u.pm + (fq >> 1)) * NFF2 + (size_t)u.pn * BM + (fq & 1) * HALF + wc * 32 + 2 * fr);
            *(PG8_LAS f32x2*)(hl + (fq * 16 + fr) * 2) = hv;
        }
        float rs[2][4];
#pragma unroll
        for (int ai = 0; ai < 2; ++ai)
#pragma unroll
            for (int m = 0; m < 4; ++m) rs[ai][m] = rtab[ai * HALF + wr * 64 + m * 16 + fr];
        const f32x4 zero4 = {0.f, 0.f, 0.f, 0.f};
#pragma unroll
        for (int ai = 0; ai < 2; ++ai) {
#pragma unroll
            for (int n = 0; n < 2; ++n) {
                f32x4 cg[4];
#pragma unroll
                for (int bj = 0; bj < 2; ++bj) {
                    f32x4 b0, b1;
                    if (ai == 0 && wr == 0) {
                        b0 = *(const PG8_LAS f32x4*)(hl + (0 * 2 + bj) * 32 + 8 * fq + 4 * n);
                        b1 = *(const PG8_LAS f32x4*)(hl + (1 * 2 + bj) * 32 + 8 * fq + 4 * n);
                    } else {
                        const int sa = (wr == 1) ? ai : ai - 1, sw = (wr == 1) ? 0 : 1;
                        const float r0 = rtab[sa * HALF + sw * 64 + 62], r1 = rtab[sa * HALF + sw * 64 + 63];
                        b0 = *(const PG8_LAS f32x4*)(xb + ((((sa * 2 + sw) * 4 + wc) * 2 + 0) * 4 + fq) * 16 + (bj * 2 + n) * 4) * r0;
                        b1 = *(const PG8_LAS f32x4*)(xb + ((((sa * 2 + sw) * 4 + wc) * 2 + 1) * 4 + fq) * 16 + (bj * 2 + n) * 4) * r1;
                    }
                    const int oc = bj * 32 + 8 * fq + 4 * n;
                    const f32x4 w0 = *(const PG8_LAS f32x4*)(cwl + oc), w1 = *(const PG8_LAS f32x4*)(cwl + 64 + oc), w2 = *(const PG8_LAS f32x4*)(cwl + 128 + oc), bb = *(const PG8_LAS f32x4*)(cwl + 192 + oc);
                    f32x4 prev = (fr == 14) ? b0 : b1;
#pragma unroll
                    for (int m = 0; m < 4; ++m) {
                        const f32x4 cur = acc[ai][bj][m][n] * rs[ai][m];
                        f32x4 c = w2 * cur + bb;
                        conv_taps(c, cur, prev, w0, w1);
                        prev = cur;
                        if (bj == 0) cg[m] = c;
                        else {
                            const f32x2 ha = gelu_mul2((f32x2){cg[m][0], cg[m][1]}, (f32x2){c[0], c[1]}), hb = gelu_mul2((f32x2){cg[m][2], cg[m][3]}, (f32x2){c[2], c[3]});
                            u32x2 w; w.x = cvt_pk_bf16(ha.x, ha.y); w.y = cvt_pk_bf16(hb.x, hb.y);
                            const int row = row0 + ai * HALF + m * 16;
                            *(u32x2*)(hid + (size_t)row * DFF + 128 * u.pn + wc * 32 + 8 * fq + 4 * n) = w;
                        }
                    }
                    asm volatile("" ::: "memory");
                }
            }
        }
    }
};
template <class Epi, class Sched, bool ALIGN_EPI = false, bool SP2 = false>
__device__ __forceinline__ void gemm_phase(PG8_LAS unsigned char* lds, const Gemm g, const Sched& S, const Epi& E, const int wave_s) {
    const int tid_ = wave_s * 64 + lane_opaque(); const int tid = tid_, wid = __builtin_amdgcn_readfirstlane(tid >> 6), lane = tid & 63, wr = wid >> 2, wc = wid & 3, fr = lane & 15, fq = lane >> 4;
    const int K = g.K, nt = K / BK;
    unsigned voffA[2], voffB[2];
#pragma unroll
    for (int i = 0; i < 2; ++i) { int R, C; stage_rc(tid * 16 + i * 8192, R, C); const int Rb = Epi::PERM ? ((R & ~31) + perm32(R & 31)) : R;
        voffA[i] = (unsigned)(R * K + C) * 2u; voffB[i] = (unsigned)(Rb * K + C) * 2u; }
    const size_t kstep = (size_t)(BK * 2);
    const size_t hstep = (size_t)HALF * K * 2;
    const size_t tstep = 2 * hstep;
    const unsigned ldsw = (unsigned)wid * 1024u;
    const int aoff = lds_byte(wr * 64 + fr, fq * 8), boff = lds_byte(wc * 32 + fr, fq * 8);
#define PG8_SA(b, h) (((b) * 2 + (h)) * HTB)
#define PG8_SB(b, h) ((4 + (b) * 2 + (h)) * HTB)
#define PG8_STAGE(bufoff, gbase, voff) do { _Pragma("unroll") for (int _i = 0; _i < 2; ++_i) \
        __builtin_amdgcn_global_load_lds((const unsigned*)((const char*)(gbase) + (voff)[_i]), (PG8_LAS unsigned*)(lds + (bufoff) + ldsw + _i * 8192), 16, 0, 0); } while (0)
#define PG8_LDA(dst, b, h) do { _Pragma("unroll") for (int m = 0; m < 4; ++m) _Pragma("unroll") for (int k = 0; k < 2; ++k) dst[m][k] = *(const PG8_LAS bf16x8*)(lds + PG8_SA(b, h) + aoff + m * 2048 + k * 1024); } while (0)
#define PG8_LDB(dst, b, h) do { _Pragma("unroll") for (int n = 0; n < 2; ++n) _Pragma("unroll") for (int k = 0; k < 2; ++k) dst[n][k] = *(const PG8_LAS bf16x8*)(lds + PG8_SB(b, h) + boff + n * 2048 + k * 1024); } while (0)
#define PG8_MMA(ai, bj, At, Bt) do { __builtin_amdgcn_s_setprio(1); _Pragma("unroll") for (int m = 0; m < 4; ++m) _Pragma("unroll") for (int n = 0; n < 2; ++n) _Pragma("unroll") for (int k = 0; k < 2; ++k) \
        acc[ai][bj][m][n] = __builtin_amdgcn_mfma_f32_16x16x32_bf16(Bt[n][k], At[m][k], acc[ai][bj][m][n], 0, 0, 0); __builtin_amdgcn_s_setprio(0); } while (0)
#define PG8_WAIT_V(n) asm volatile("s_waitcnt vmcnt(" #n ")" ::: "memory")
#define PG8_WAIT_L(n) asm volatile("s_waitcnt lgkmcnt(" #n ")" ::: "memory")
#define PG8_BAR __builtin_amdgcn_s_barrier()
#define PG8_SCHED __builtin_amdgcn_sched_barrier(0)
    Unit cur, nxt; int ui = 0;
    if (!S.next(0, cur)) return;
    f32x4 acc[2][2][4][2];
#pragma unroll
    for (int a = 0; a < 2; ++a)
#pragma unroll
        for (int b = 0; b < 2; ++b)
#pragma unroll
            for (int m = 0; m < 4; ++m)
#pragma unroll
                for (int n = 0; n < 2; ++n) acc[a][b][m][n] = (f32x4){0.f, 0.f, 0.f, 0.f};
    bf16x8 At[4][2], B0[2][2], B1[2][2];
    const char* cA = (const char*)g.A + (size_t)cur.pm * tstep; const char* cB = (const char*)g.Bt + (size_t)cur.pn * tstep;
    S.a_ready(cur);
    if constexpr (SP2) {
        PG8_STAGE(PG8_SB(0, 0), cB, voffB); PG8_STAGE(PG8_SB(0, 1), cB + hstep, voffB); PG8_STAGE(PG8_SA(0, 0), cA, voffA); PG8_STAGE(PG8_SA(0, 1), cA + hstep, voffA);
        if (wr == 1) PG8_BAR;
        PG8_WAIT_V(2); PG8_BAR;
        PG8_STAGE(PG8_SB(1, 0), cB + kstep, voffB); PG8_STAGE(PG8_SA(1, 0), cA + kstep, voffA); PG8_STAGE(PG8_SB(1, 1), cB + hstep + kstep, voffB);
        PG8_WAIT_V(6); PG8_BAR;
    } else {
        PG8_STAGE(PG8_SB(0, 0), cB, voffB); PG8_STAGE(PG8_SA(0, 0), cA, voffA); PG8_STAGE(PG8_SB(0, 1), cB + hstep, voffB); PG8_STAGE(PG8_SA(0, 1), cA + hstep, voffA);
        if (wr == 1) PG8_BAR;
        PG8_WAIT_V(4); PG8_BAR;
        PG8_STAGE(PG8_SB(1, 0), cB + kstep, voffB); PG8_STAGE(PG8_SA(1, 0), cA + kstep, voffA); PG8_STAGE(PG8_SB(1, 1), cB + hstep + kstep, voffB);
        PG8_WAIT_V(6); PG8_BAR;
    }
    for (;;) {
        const bool has_next = S.next(ui + 1, nxt);
        const char* nA = has_next ? (const char*)g.A + (size_t)nxt.pm * tstep : cA; const char* nB = has_next ? (const char*)g.Bt + (size_t)nxt.pn * tstep : cB;
        for (int t = 0; t < nt; t += 2) {
            const bool last = (t == nt - 2);
            const char* a1 = cA + (size_t)(t + 1) * kstep;
            const char* a2 = last ? nA : cA + (size_t)(t + 2) * kstep; const char* b2 = last ? nB : cB + (size_t)(t + 2) * kstep;
            const char* a3 = a2 + kstep; const char* b3 = b2 + kstep;
            if (last && has_next) S.a_ready(nxt);
            if constexpr (SP2) {
            PG8_LDB(B0, 0, 0); PG8_LDB(B1, 0, 1); PG8_SCHED; PG8_LDA(At, 0, 0); PG8_STAGE(PG8_SA(1, 1), a1 + hstep, voffA);
            PG8_WAIT_V(8); PG8_WAIT_L(0); PG8_BAR; PG8_MMA(0, 0, At, B0); PG8_MMA(0, 1, At, B1); PG8_BAR; PG8_SCHED;
            PG8_LDA(At, 0, 1); PG8_STAGE(PG8_SB(0, 0), b2, voffB); PG8_STAGE(PG8_SB(0, 1), b2 + hstep, voffB); PG8_STAGE(PG8_SA(0, 0), a2, voffA);
            PG8_WAIT_V(8); PG8_WAIT_L(0); PG8_BAR; PG8_MMA(1, 0, At, B0); PG8_MMA(1, 1, At, B1); PG8_BAR; PG8_SCHED;
            PG8_LDB(B0, 1, 0); PG8_LDB(B1, 1, 1); PG8_SCHED; PG8_LDA(At, 1, 0); PG8_STAGE(PG8_SA(0, 1), a2 + hstep, voffA);
            PG8_WAIT_V(8); PG8_WAIT_L(0); PG8_BAR; PG8_MMA(0, 0, At, B0); PG8_MMA(0, 1, At, B1); PG8_BAR; PG8_SCHED;
            PG8_LDA(At, 1, 1); PG8_STAGE(PG8_SB(1, 0), b3, voffB); PG8_STAGE(PG8_SB(1, 1), b3 + hstep, voffB); PG8_STAGE(PG8_SA(1, 0), a3, voffA);
            PG8_WAIT_V(8); PG8_WAIT_L(0); PG8_BAR; PG8_MMA(1, 0, At, B0); PG8_MMA(1, 1, At, B1); PG8_BAR; PG8_SCHED;
            } else {
            PG8_LDB(B0, 0, 0); PG8_SCHED; PG8_LDA(At, 0, 0); PG8_STAGE(PG8_SA(1, 1), a1 + hstep, voffA);
            PG8_WAIT_L(8); PG8_BAR; PG8_WAIT_L(0); PG8_MMA(0, 0, At, B0); PG8_BAR; PG8_SCHED;
            PG8_LDB(B1, 0, 1); PG8_STAGE(PG8_SB(0, 0), b2, voffB);
            PG8_BAR; PG8_WAIT_L(0); PG8_MMA(0, 1, At, B1); PG8_BAR;
            PG8_LDA(At, 0, 1); PG8_STAGE(PG8_SA(0, 0), a2, voffA);
            PG8_BAR; PG8_WAIT_L(0); PG8_MMA(1, 0, At, B0); PG8_BAR; PG8_SCHED;
            PG8_STAGE(PG8_SB(0, 1), b2 + hstep, voffB);
            PG8_WAIT_V(6); PG8_BAR; PG8_MMA(1, 1, At, B1); PG8_BAR;
            PG8_LDB(B0, 1, 0); PG8_SCHED; PG8_LDA(At, 1, 0); PG8_STAGE(PG8_SA(0, 1), a2 + hstep, voffA);
            PG8_WAIT_L(8); PG8_BAR; PG8_WAIT_L(0); PG8_MMA(0, 0, At, B0); PG8_BAR; PG8_SCHED;
            PG8_LDB(B1, 1, 1); PG8_STAGE(PG8_SB(1, 0), b3, voffB);
            PG8_BAR; PG8_WAIT_L(0); PG8_MMA(0, 1, At, B1); PG8_BAR;
            PG8_LDA(At, 1, 1); PG8_STAGE(PG8_SA(1, 0), a3, voffA);
            PG8_BAR; PG8_WAIT_L(0); PG8_MMA(1, 0, At, B0); PG8_BAR; PG8_SCHED;
            PG8_STAGE(PG8_SB(1, 1), b3 + hstep, voffB);
            PG8_WAIT_V(6); PG8_BAR; PG8_MMA(1, 1, At, B1); PG8_BAR;
            }
        }
        if constexpr (ALIGN_EPI) { if (wr == 0) PG8_BAR; }
        if constexpr (!Epi::AFTER_DRAIN) { E(acc, cur, wr, wc, fr, fq); S.done(cur); }
        if (!has_next) break;
#pragma unroll
        for (int a = 0; a < 2; ++a)
#pragma unroll
            for (int b = 0; b < 2; ++b)
#pragma unroll
                for (int m = 0; m < 4; ++m)
#pragma unroll
                    for (int n = 0; n < 2; ++n) acc[a][b][m][n] = (f32x4){0.f, 0.f, 0.f, 0.f};
        cur = nxt; cA = nA; cB = nB; ++ui;
        if constexpr (ALIGN_EPI) { if (wr == 1) PG8_BAR; }
    }
    PG8_WAIT_V(0);
    if constexpr (!ALIGN_EPI) { if (wr == 0) PG8_BAR; }
    PG8_BAR;
    if constexpr (Epi::AFTER_DRAIN) { E.fused(acc, cur, wr, wc, fr, fq, lds, wid, lane); S.done(cur); }
#undef PG8_SA
#undef PG8_SB
#undef PG8_STAGE
#undef PG8_LDA
#undef PG8_LDB
#undef PG8_MMA
#undef PG8_WAIT_V
#undef PG8_WAIT_L
#undef PG8_BAR
#undef PG8_SCHED
}
}
namespace mix {
#define MLAS __attribute__((address_space(3)))
typedef unsigned short bf16_t;
typedef short bf16x8 __attribute__((ext_vector_type(8)));
typedef short s16x4 __attribute__((ext_vector_type(4)));
typedef float f32x16 __attribute__((ext_vector_type(16)));
typedef float f32x4 __attribute__((ext_vector_type(4)));
typedef float f32x2 __attribute__((ext_vector_type(2)));
typedef unsigned u32x4 __attribute__((ext_vector_type(4)));
typedef unsigned u32x2 __attribute__((ext_vector_type(2)));
typedef MLAS const char* lds_cptr;
typedef short v4i16_t __attribute__((ext_vector_type(4)));
typedef __bf16 bf16x2_t __attribute__((ext_vector_type(2)));

constexpr int SLOTB = 8192;
constexpr int NSLOT = 4;
constexpr int L_K = 0, L_V = NSLOT * SLOTB, L_WSF = 2 * NSLOT * SLOTB, L_OST = L_WSF + 8 * 256, L_X = L_OST + 8 * 4096;
constexpr int LX_IQ = L_X, LX_EQ = L_X, LX_PFX = L_X + 8192, LX_CNT = LX_IQ + 16384, LX_GT = LX_CNT + 2048, LX_SEL = LX_GT, LX_END = LX_GT + 8192;
static_assert(LX_END <= 131072, "mixer LDS map");

__device__ __forceinline__ int crow(int r, int hi) { return (r & 3) + 8 * (r >> 2) + 4 * hi; }
__device__ __forceinline__ void glds16(const void* gsrc, unsigned lds_dst) { unsigned keep;
    asm volatile("s_mov_b32 %0, m0\n\ts_mov_b32 m0, %2\n\ts_nop 0\n\tglobal_load_lds_dwordx4 %1, off\n\ts_mov_b32 m0, %0" : "=&s"(keep) : "v"(gsrc), "s"(lds_dst) : "memory"); }
__device__ __forceinline__ unsigned cvtpk(float lo, float hi) { f32x2 v = {lo, hi}; bf16x2_t b = __builtin_convertvector(v, bf16x2_t); return __builtin_bit_cast(unsigned, b); }
__device__ __forceinline__ s16x4 vtr(lds_cptr p) { return __builtin_bit_cast(s16x4, __builtin_amdgcn_ds_read_tr16_b64_v4i16((MLAS v4i16_t*)p)); }
#define WAITV_BAR() asm volatile("s_waitcnt vmcnt(0) lgkmcnt(0)\n\ts_barrier" ::: "memory")
#define LGKM_BAR() asm volatile("s_waitcnt lgkmcnt(0)\n\ts_barrier" ::: "memory")
#define WAITV2_BAR() asm volatile("s_waitcnt vmcnt(2) lgkmcnt(0)\n\ts_barrier" ::: "memory")

__device__ __forceinline__ void dma_kv(const bf16_t* kbase, const bf16_t* vbase, int pitch, unsigned lds0, int slot, int wid, int lane) {
    const bf16_t* ks = kbase + (size_t)lane * pitch + wid * 8;
    const bf16_t* vs = vbase + (size_t)(16 * (wid & 3) + (lane >> 2)) * pitch + (wid >> 2) * 32 + (lane & 3) * 8;
    glds16(ks, (unsigned)__builtin_amdgcn_readfirstlane(lds0 + L_K + slot * SLOTB + wid * 1024));
    glds16(vs, (unsigned)__builtin_amdgcn_readfirstlane(lds0 + L_V + slot * SLOTB + wid * 1024));
}
__device__ __forceinline__ void kload(bf16x8 (&kf)[8], lds_cptr kslot, int r32, int hi) {
    lds_cptr kb = kslot + hi * 1024 + r32 * 16;
#pragma unroll
    for (int d0 = 0; d0 < 4; ++d0) { kf[2 * d0] = *(const MLAS bf16x8*)(kb + d0 * 2048); kf[2 * d0 + 1] = *(const MLAS bf16x8*)(kb + d0 * 2048 + 512); }
}
__device__ __forceinline__ void qkt_mma(f32x16& p0, f32x16& p1, const bf16x8 (&kf)[8], const bf16x8* qr, const f32x16& cinit) {
    p0 = __builtin_amdgcn_mfma_f32_32x32x16_bf16(kf[0], qr[0], cinit, 0, 0, 0); p1 = __builtin_amdgcn_mfma_f32_32x32x16_bf16(kf[1], qr[0], cinit, 0, 0, 0);
#pragma unroll
    for (int d0 = 1; d0 < 4; ++d0) { p0 = __builtin_amdgcn_mfma_f32_32x32x16_bf16(kf[2 * d0], qr[d0], p0, 0, 0, 0); p1 = __builtin_amdgcn_mfma_f32_32x32x16_bf16(kf[2 * d0 + 1], qr[d0], p1, 0, 0, 0); }
}
__device__ __forceinline__ void qkt(f32x16& p0, f32x16& p1, lds_cptr kslot, const bf16x8* qr, const f32x16& cinit, int r32, int hi) {
    bf16x8 kf[8]; kload(kf, kslot, r32, hi); qkt_mma(p0, p1, kf, qr, cinit);
}
__device__ __forceinline__ void vload(bf16x8 (&vf)[8], lds_cptr vslot, int lane, int hi) {
    lds_cptr vp = vslot + ((lane >> 4) & 1) * 32 + (lane & 3) * 8 + (4 * hi + ((lane & 15) >> 2)) * 64;
#pragma unroll
    for (int d0 = 0; d0 < 2; ++d0)
#pragma unroll
        for (int ks = 0; ks < 4; ++ks) {
            const s16x4 lo = vtr(vp + d0 * 4096 + ks * 1024), hh = vtr(vp + d0 * 4096 + ks * 1024 + 512);
            vf[d0 * 4 + ks] = (bf16x8){lo[0], lo[1], lo[2], lo[3], hh[0], hh[1], hh[2], hh[3]};
        }
}
#define V16_TO_ARR(v, a, o) do { a[(o) + 0] = v[0]; a[(o) + 1] = v[1]; a[(o) + 2] = v[2]; a[(o) + 3] = v[3]; a[(o) + 4] = v[4]; a[(o) + 5] = v[5]; a[(o) + 6] = v[6]; a[(o) + 7] = v[7]; \
    a[(o) + 8] = v[8]; a[(o) + 9] = v[9]; a[(o) + 10] = v[10]; a[(o) + 11] = v[11]; a[(o) + 12] = v[12]; a[(o) + 13] = v[13]; a[(o) + 14] = v[14]; a[(o) + 15] = v[15]; } while (0)
__device__ __forceinline__ f32x16 splat16(float x) { return (f32x16){x, x, x, x, x, x, x, x, x, x, x, x, x, x, x, x}; }
struct AttnState { f32x16 o[2]; float m, l, pend; bool started; };
constexpr float ATT_THR = 8.0f;
__device__ __forceinline__ void softmax_pv(AttnState& st, float (&sc)[32], const bf16x8 (&vf)[8], MLAS float* wsf, int lane, int r32, int hi) {
    if (__any(st.pend != 0.f)) {
#pragma unroll
        for (int r = 0; r < 32; ++r) sc[r] -= st.pend;
    }
    st.pend = 0.f;
    float ra = __builtin_fmaxf(__builtin_fmaxf(sc[0], sc[1]), sc[2]), rb = __builtin_fmaxf(__builtin_fmaxf(sc[3], sc[4]), sc[5]);
#pragma unroll
    for (int r = 6; r < 30; r += 4) { ra = __builtin_fmaxf(__builtin_fmaxf(ra, sc[r]), sc[r + 1]); rb = __builtin_fmaxf(__builtin_fmaxf(rb, sc[r + 2]), sc[r + 3]); }
    float rm = __builtin_fmaxf(__builtin_fmaxf(ra, rb), __builtin_fmaxf(sc[30], sc[31]));
    rm = halves_max_f(rm);
    const bool fresh = !st.started;
    const bool need = (rm > ATT_THR) || (fresh && rm < -ATT_THR && rm > -1e29f);
    st.started = st.started || (rm > -1e29f);
    if (__any(need)) {
        const float dl = need ? rm : 0.f;
        st.m += dl; st.pend = dl;
#pragma unroll
        for (int r = 0; r < 32; ++r) sc[r] -= dl;
        const float alpha = fresh ? 1.0f : __builtin_amdgcn_exp2f(-dl);
        st.l *= alpha;
        if (hi == 0) wsf[r32] = alpha;
        float fr_[16];
#pragma unroll
        for (int r = 0; r < 16; ++r) fr_[r] = wsf[crow(r, hi)];
        const f32x16 fv = {fr_[0], fr_[1], fr_[2], fr_[3], fr_[4], fr_[5], fr_[6], fr_[7], fr_[8], fr_[9], fr_[10], fr_[11], fr_[12], fr_[13], fr_[14], fr_[15]};
        st.o[0] = st.o[0] * fv; st.o[1] = st.o[1] * fv;
    }
    float pe[32]; float s0 = 0.f, s1 = 0.f;
#pragma unroll
    for (int r = 0; r < 32; r += 2) { pe[r] = __builtin_amdgcn_exp2f(sc[r]); pe[r + 1] = __builtin_amdgcn_exp2f(sc[r + 1]); s0 += pe[r]; s1 += pe[r + 1]; }
    st.l += s0 + s1;
    u32x4 pw[4];
#pragma unroll
    for (int k = 0; k < 4; ++k) pw[k] = (u32x4){cvtpk(pe[8 * k + 0], pe[8 * k + 1]), cvtpk(pe[8 * k + 2], pe[8 * k + 3]), cvtpk(pe[8 * k + 4], pe[8 * k + 5]), cvtpk(pe[8 * k + 6], pe[8 * k + 7])};
#pragma unroll
    for (int d0 = 0; d0 < 2; ++d0)
#pragma unroll
        for (int ks = 0; ks < 4; ++ks) st.o[d0] = __builtin_amdgcn_mfma_f32_32x32x16_bf16(__builtin_bit_cast(bf16x8, pw[ks]), vf[d0 * 4 + ks], st.o[d0], 0, 0, 0);
}
__device__ __forceinline__ void attn_store(AttnState& st, bf16_t* Ow, int pitch, MLAS float* wsf, MLAS bf16_t* stg, int lane, int r32, int hi) {
    float l = halves_sum_f(st.l);
    if (hi == 0) wsf[32 + r32] = l;
    float rli[16];
#pragma unroll
    for (int r = 0; r < 16; ++r) rli[r] = 1.0f / wsf[32 + crow(r, hi)];
#pragma unroll
    for (int r = 0; r < 16; ++r) { const int orow = crow(r, hi);
#pragma unroll
        for (int d0 = 0; d0 < 2; ++d0) { const unsigned short b = (unsigned short)(cvtpk(st.o[d0][r] * rli[r], 0.f) & 0xffffu); stg[orow * 64 + d0 * 32 + r32] = b; } }
#pragma unroll
    for (int i = 0; i < 4; ++i) { const int row = i * 8 + (lane >> 3), ch = lane & 7; const u32x4 v = *(const MLAS u32x4*)(stg + row * 64 + ch * 8); *(u32x4*)(Ow + (size_t)row * pitch + ch * 8) = v; }
}

#ifndef DBG_REP_BS
#define DBG_REP_BS 1
#endif
__device__ __forceinline__ unsigned pk_sub_sat_u16(unsigned a, unsigned b) { unsigned r; asm("v_pk_sub_u16 %0, %1, %2 clamp" : "=v"(r) : "v"(a), "v"(b)); return r; }
__device__ __forceinline__ unsigned pk_min_u16(unsigned a, unsigned b) { unsigned r; asm("v_pk_min_u16 %0, %1, %2" : "=v"(r) : "v"(a), "v"(b)); return r; }
__device__ __forceinline__ unsigned pk_add_u16(unsigned a, unsigned b) { unsigned r; asm("v_pk_add_u16 %0, %1, %2" : "=v"(r) : "v"(a), "v"(b)); return r; }
__device__ __forceinline__ unsigned pk_ashr_i16(unsigned a, unsigned sh2) { unsigned r; asm("v_pk_ashrrev_i16 %0, %1, %2" : "=v"(r) : "v"(sh2), "v"(a)); return r; }
__device__ __forceinline__ unsigned score_keys(float a, float b) {
    const unsigned p = __builtin_bit_cast(unsigned, __builtin_amdgcn_cvt_pkrtz(a, b));
    const unsigned m = pk_ashr_i16(p, 0x000f000fu);
    return p ^ (m | 0x80008000u);
}
template <int NS> __device__ __forceinline__ unsigned bit_search(const unsigned (&kp)[8][8], MLAS unsigned* cntx, int wid, int r32, int hi) {
    unsigned tau = 0u;
#pragma unroll 1
    for (int bit = 15; bit >= 0; --bit) {
        const unsigned cand = tau | (1u << bit);
        const unsigned c2 = (cand - 1u) * 0x00010001u;
        unsigned cnt2 = 0;
#pragma unroll
        for (int jj = 0; jj < NS; ++jj)
#pragma unroll
            for (int r = 0; r < 8; ++r) cnt2 = pk_add_u16(cnt2, pk_min_u16(pk_sub_sat_u16(kp[jj][r], c2), 0x00010001u));
        unsigned cnt = (cnt2 & 0xffffu) + (cnt2 >> 16);
        cnt = halves_add_u(cnt);
        MLAS unsigned* cb = cntx + (bit & 1) * 256;
        if (hi == 0) cb[wid * 32 + r32] = cnt;
        LGKM_BAR();
        unsigned tot = 0;
#pragma unroll
        for (int w = 0; w < 8; ++w) tot += cb[w * 32 + r32];
        if (tot >= 256u) tau = cand;
    }
    return tau;
}
__device__ __forceinline__ void lds_inc(MLAS unsigned* p) { const unsigned one = 1u; asm volatile("ds_add_u32 %0, %1" :: "v"((unsigned)(uintptr_t)p), "v"(one) : "memory"); }
template <int NS> __device__ __forceinline__ unsigned radix_select(const unsigned (&kp)[8][8], MLAS char* L, int tid, int r32) {
    MLAS unsigned* h1 = (MLAS unsigned*)L; MLAS unsigned* h2 = h1 + 8224; MLAS unsigned* part = h2 + 8224; MLAS unsigned* res = part + 512;
    for (int i = tid; i < 2 * 8224; i += 512) h1[i] = 0u;
    LGKM_BAR();
    MLAS unsigned* col1 = h1 + r32; MLAS unsigned* col2 = h2 + r32;
#pragma unroll
    for (int jj = 0; jj < NS; ++jj)
#pragma unroll
        for (int r = 0; r < 8; ++r) { const unsigned k = kp[jj][r]; lds_inc(col1 + ((k >> 3) & 0x1fe0u)); lds_inc(col1 + ((k >> 19) & 0x1fe0u)); }
    LGKM_BAR();
    const int q = tid & 31, p = tid >> 5;
    { unsigned s = 0;
#pragma unroll
      for (int b = 0; b < 16; ++b) s += h1[(16 * p + b) * 32 + q];
      part[p * 32 + q] = s; }
    LGKM_BAR();
    { unsigned above = 0;
#pragma unroll
      for (int pp = 0; pp < 16; ++pp) { const unsigned v = part[pp * 32 + q]; above += (pp > p) ? v : 0u; }
      const unsigned s = part[p * 32 + q];
      if (above < 256u && above + s >= 256u) {
          unsigned cum = above, bsel = 0u, asel = 0u; bool found = false;
#pragma unroll
          for (int b = 15; b >= 0; --b) { const unsigned c = h1[(16 * p + b) * 32 + q]; if (!found && cum + c >= 256u) { bsel = (unsigned)(16 * p + b); asel = cum; found = true; } cum += c; }
          res[q] = bsel | (asel << 16);
      } }
    LGKM_BAR();
    const unsigned b1 = res[r32] & 0xffffu;
#pragma unroll
    for (int jj = 0; jj < NS; ++jj)
#pragma unroll
        for (int r = 0; r < 8; ++r) { const unsigned k = kp[jj][r];
            lds_inc(col2 + ((((k >> 8) & 0xffu) == b1) ? ((k & 0xffu) << 5) : 8192u));
            lds_inc(col2 + (((k >> 24) == b1) ? ((k >> 11) & 0x1fe0u) : 8192u)); }
    LGKM_BAR();
    const unsigned rq = res[q]; const unsigned need = 256u - (rq >> 16);
    { unsigned s = 0;
#pragma unroll
      for (int b = 0; b < 16; ++b) s += h2[(16 * p + b) * 32 + q];
      part[p * 32 + q] = s; }
    LGKM_BAR();
    { unsigned above = 0;
#pragma unroll
      for (int pp = 0; pp < 16; ++pp) { const unsigned v = part[pp * 32 + q]; above += (pp > p) ? v : 0u; }
      const unsigned s = part[p * 32 + q];
      if (above < need && above + s >= need) {
          unsigned cum = above, lsel = 0u; bool found = false;
#pragma unroll
          for (int b = 15; b >= 0; --b) { const unsigned c = h2[(16 * p + b) * 32 + q]; if (!found && cum + c >= need) { lsel = (unsigned)(16 * p + b); found = true; } cum += c; }
          res[32 + q] = ((rq & 0xffffu) << 8) | lsel;
      } }
    LGKM_BAR();
    return res[32 + r32];
}
__device__ __forceinline__ void dsa_select(int b, int qg, const bf16_t* Z0, char* shm, const int wave_s) {
    const int tid_ = wave_s * 64 + lane_opaque(); const int tid = tid_, lane = tid & 63, r32 = lane & 31, hi = lane >> 5; const int wid = __builtin_amdgcn_readfirstlane(tid >> 6);
    MLAS char* L = (MLAS char*)shm;
    const int c = qg >> 1, nkeys = 64 * (c + 1), nt32 = nkeys >> 5, nt64 = nkeys >> 6;
    const size_t rowb = (size_t)b * SEQ;
    const size_t tok0 = rowb + 32 * qg;
    MLAS unsigned* selw = (MLAS unsigned*)(L + LX_SEL);
    if (nkeys <= 256) {
        for (int i = tid; i < 64 * 32; i += 512) selw[i] = (i < nt32 * 32) ? 0xffffffffu : 0u;
    } else {
        {
            MLAS u32x4* iqL = (MLAS u32x4*)(L + LX_IQ);
            for (int i = tid; i < 1024; i += 512) { const int q = i & 31, hh = (i >> 5) & 1, d0 = (i >> 6) & 3, h = i >> 8;
                iqL[i] = *(const u32x4*)(Z0 + (tok0 + q) * EV_N + 1280 + 64 * h + 16 * d0 + 8 * hh); }
        }
        float w4[4];
        { const u32x2 ww = *(const u32x2*)(Z0 + (tok0 + r32) * EV_N + 1216);
          w4[0] = pg8::bf_lo(ww.x) * 0.0625f; w4[1] = pg8::bf_hi(ww.x) * 0.0625f; w4[2] = pg8::bf_lo(ww.y) * 0.0625f; w4[3] = pg8::bf_hi(ww.y) * 0.0625f; }
        LGKM_BAR();
        unsigned kp[8][8];
        const int nslots = (nt32 + 7) >> 3;
        const MLAS bf16x8* iqf = (const MLAS bf16x8*)(L + LX_IQ) + hi * 32 + r32;
#pragma unroll
        for (int jj = 0; jj < 8; ++jj) {
            const int j = wid + 8 * jj;
            if (j < nt32) {
                const bf16_t* ikp = Z0 + (rowb + 32 * j + r32) * EV_N + 1152 + 8 * hi;
                bf16x8 af[4];
#pragma unroll
                for (int d0 = 0; d0 < 4; ++d0) af[d0] = *(const bf16x8*)(ikp + 16 * d0);
                f32x16 ah[4];
#pragma unroll
                for (int h = 0; h < 4; ++h) {
                    f32x16 a = {};
#pragma unroll
                    for (int d0 = 0; d0 < 4; ++d0) a = __builtin_amdgcn_mfma_f32_32x32x16_bf16(af[d0], iqf[(h * 4 + d0) * 64], a, 0, 0, 0);
                    ah[h] = a;
                }
                float sv[16];
                {
                    float a0[16], a1[16], a2[16], a3[16];
                    V16_TO_ARR(ah[0], a0, 0); V16_TO_ARR(ah[1], a1, 0); V16_TO_ARR(ah[2], a2, 0); V16_TO_ARR(ah[3], a3, 0);
#pragma unroll
                    for (int r = 0; r < 16; ++r) sv[r] = ((__builtin_fmaxf(a0[r], 0.f) * w4[0] + __builtin_fmaxf(a1[r], 0.f) * w4[1]) + __builtin_fmaxf(a2[r], 0.f) * w4[2]) + __builtin_fmaxf(a3[r], 0.f) * w4[3];
                }
#pragma unroll
                for (int r = 0; r < 8; ++r) kp[jj][r] = score_keys(sv[r], sv[r + 8]);
            } else {
#pragma unroll
                for (int r = 0; r < 8; ++r) kp[jj][r] = 0u;
            }
        }
        MLAS unsigned* cntx = (MLAS unsigned*)(L + L_OST);
        unsigned tau;
        for (int rep_ = 0; rep_ < DBG_REP_BS; ++rep_)
#ifdef DSA_BIT_SEARCH
        switch (nslots) {
            case 2: tau = bit_search<2>(kp, cntx, wid, r32, hi); break;
            case 3: tau = bit_search<3>(kp, cntx, wid, r32, hi); break;
            case 4: tau = bit_search<4>(kp, cntx, wid, r32, hi); break;
            case 5: tau = bit_search<5>(kp, cntx, wid, r32, hi); break;
            case 6: tau = bit_search<6>(kp, cntx, wid, r32, hi); break;
            case 7: tau = bit_search<7>(kp, cntx, wid, r32, hi); break;
            default: tau = bit_search<8>(kp, cntx, wid, r32, hi); break;
        }
#else
        switch (nslots) {
            case 2: tau = radix_select<2>(kp, L, tid, r32); break;
            case 3: tau = radix_select<3>(kp, L, tid, r32); break;
            case 4: tau = radix_select<4>(kp, L, tid, r32); break;
            case 5: tau = radix_select<5>(kp, L, tid, r32); break;
            case 6: tau = radix_select<6>(kp, L, tid, r32); break;
            case 7: tau = radix_select<7>(kp, L, tid, r32); break;
            default: tau = radix_select<8>(kp, L, tid, r32); break;
        }
        (void)cntx;
#endif
        MLAS unsigned* gtw = (MLAS unsigned*)(L + LX_GT); MLAS unsigned* eqw = (MLAS unsigned*)(L + LX_EQ); MLAS unsigned* pfx = (MLAS unsigned*)(L + LX_PFX);
        const unsigned tg = tau * 0x00010001u, te = (tau - 1u) * 0x00010001u;
#pragma unroll
        for (int jj = 0; jj < 8; ++jj) {
            const int j = wid + 8 * jj;
            if (j < nt32) {
                unsigned g = 0, e = 0;
#pragma unroll
                for (int r = 0; r < 8; ++r) {
                    const unsigned dgt = pk_min_u16(pk_sub_sat_u16(kp[jj][r], tg), 0x00010001u), dge = pk_min_u16(pk_sub_sat_u16(kp[jj][r], te), 0x00010001u);
                    const int pos = (r & 3) + 8 * (r >> 2);
                    g |= dgt << pos; e |= (dge - dgt) << pos;
                }
                g <<= 4 * hi; e <<= 4 * hi;
                g = halves_or_u(g); e = halves_or_u(e);
                if (hi == 0) { gtw[j * 32 + r32] = g; eqw[j * 32 + r32] = e; }
            }
        }
        LGKM_BAR();
        if (wid == 0 && hi == 0) {
            unsigned cg = 0;
            for (int j = 0; j < nt32; ++j) cg += __builtin_popcount(gtw[j * 32 + r32]);
            const int need = 256 - (int)cg;
            int run = 0;
            for (int j = 0; j < nt32; ++j) { const unsigned e = eqw[j * 32 + r32]; int k = need - run; k = k < 0 ? 0 : (k > 32 ? 32 : k); pfx[j * 32 + r32] = (unsigned)k; run += __builtin_popcount(e); }
        }
        LGKM_BAR();
        for (int i = tid; i < nt32 * 32; i += 512) {
            const unsigned g = gtw[i], e = eqw[i]; const int k = (int)pfx[i];
            unsigned take = 0;
            if (e != 0u && k > 0) {
                unsigned rem = e; int cntk = 0;
                while (rem != 0u && cntk < k) { const unsigned low = rem & (0u - rem); take |= low; rem ^= low; ++cntk; }
            }
            selw[i] = g | take;
        }
        for (int i = nt32 * 32 + tid; i < 64 * 32; i += 512) selw[i] = 0u;
    }
    WAITV_BAR();
}

__device__ __forceinline__ void fox_unit(int b, int h, int qb, const bf16_t* Z1, const float* F, const float* bfp, bf16_t* Y, char* shm, unsigned lds0, const int wave_s) {
    const int tid_ = wave_s * 64 + lane_opaque(); const int tid = tid_, lane = tid & 63, r32 = lane & 31, hi = lane >> 5; const int wid = __builtin_amdgcn_readfirstlane(tid >> 6);
    MLAS char* L = (MLAS char*)shm;
    const size_t rowb = (size_t)b * SEQ;
    const int NT = 4 * (qb + 1), nk = 64 * NT;
    MLAS float* cum2 = (MLAS float*)(L + L_X);
    MLAS float* wtot = (MLAS float*)(L + L_X + 8192);
    const bf16_t* Kb = Z1 + rowb * Z1P + 512 + 64 * h; const bf16_t* Vb = Z1 + rowb * Z1P + 1024 + 64 * h;
#pragma unroll
    for (int i = 0; i < 3; ++i) dma_kv(Kb + (size_t)64 * i * Z1P, Vb + (size_t)64 * i * Z1P, Z1P, lds0, i, wid, lane);
    {
        const float bias = bfp[h];
        const int s0 = 4 * tid;
        float v[4]; float run = 0.f;
#pragma unroll
        for (int i = 0; i < 4; ++i) {
            float x = 0.f;
            if (s0 + i < nk) x = F[(rowb + s0 + i) * 8 + h] + bias;
            const float ls = (s0 + i < nk) ? (fminf(x, 0.f) - log1pf(expf(-fabsf(x)))) : 0.f;
            run += ls; v[i] = run;
        }
        float inc = run;
#pragma unroll
        for (int o = 1; o < 64; o <<= 1) { const int ln = lane_opaque(); const float t = __builtin_bit_cast(float, __builtin_amdgcn_ds_bpermute((ln - o) << 2, __builtin_bit_cast(int, inc))); if (ln >= o) inc += t; }
        if (lane == 63) wtot[wid] = inc;
        LGKM_BAR();
        float off = inc - run;
        for (int w = 0; w < wid; ++w) off += wtot[w];
#pragma unroll
        for (int i = 0; i < 4; ++i) cum2[s0 + i] = (off + v[i]) * 1.4426950408889634f;
    }
    const int tq = 256 * qb + 32 * wid + r32;
    bf16x8 qr[4];
#pragma unroll
    for (int d0 = 0; d0 < 4; ++d0) qr[d0] = *(const bf16x8*)(Z1 + (rowb + tq) * Z1P + 64 * h + 16 * d0 + 8 * hi);
    AttnState st; st.o[0] = f32x16{}; st.o[1] = f32x16{}; st.m = 0.f; st.l = 0.f; st.pend = 0.f; st.started = false;
    MLAS float* wsf = (MLAS float*)(L + L_WSF) + wid * 64;
    WAITV_BAR();
    const float cq2 = cum2[tq];
    const int tlast = 4 * qb + (wid >> 1);
    f32x16 s0, s1;
    qkt(s0, s1, (lds_cptr)(L + L_K), qr, splat16(-st.m), r32, hi);
    for (int t = 0; t < NT; ++t) {
        const int slot = t & 3;
        { const int tt = (t + 3 < NT) ? t + 3 : NT - 1; dma_kv(Kb + (size_t)64 * tt * Z1P, Vb + (size_t)64 * tt * Z1P, Z1P, lds0, (t + 3) & 3, wid, lane); }
        bf16x8 kf[8], vf[8];
        kload(kf, (lds_cptr)(L + L_K + ((t + 1) & 3) * SLOTB), r32, hi);
        __builtin_amdgcn_sched_barrier(0);
        vload(vf, (lds_cptr)(L + L_V + slot * SLOTB), lane, hi);
        const MLAS float* cb = cum2 + 64 * t + 4 * hi;
        f32x4 c0[4], c1[4];
#pragma unroll
        for (int g = 0; g < 4; ++g) { c0[g] = *(const MLAS f32x4*)(cb + 8 * g); c1[g] = *(const MLAS f32x4*)(cb + 32 + 8 * g); }
        f32x16 n0, n1;
        qkt_mma(n0, n1, kf, qr, splat16(-st.m));
        float sc[32];
        V16_TO_ARR(s0, sc, 0); V16_TO_ARR(s1, sc, 16);
#pragma unroll
        for (int g = 0; g < 4; ++g) {
            sc[4 * g + 0] += cq2 - c0[g].x; sc[4 * g + 1] += cq2 - c0[g].y; sc[4 * g + 2] += cq2 - c0[g].z; sc[4 * g + 3] += cq2 - c0[g].w;
            sc[16 + 4 * g + 0] += cq2 - c1[g].x; sc[16 + 4 * g + 1] += cq2 - c1[g].y; sc[16 + 4 * g + 2] += cq2 - c1[g].z; sc[16 + 4 * g + 3] += cq2 - c1[g].w;
        }
        if (t >= tlast) {
            const int qrel = tq - 64 * t;
#pragma unroll
            for (int r = 0; r < 16; ++r) { const int kr = crow(r, hi); if (kr > qrel) sc[r] = -INFINITY; if (kr + 32 > qrel) sc[16 + r] = -INFINITY; }
        }
        softmax_pv(st, sc, vf, wsf, lane, r32, hi);
        s0 = n0; s1 = n1;
        WAITV2_BAR();
    }
    attn_store(st, Y + (rowb + 256 * qb + 32 * wid) * DMODEL + 64 * h, DMODEL, wsf, (MLAS bf16_t*)(L + L_OST) + wid * 2048, lane, r32, hi);
    WAITV_BAR();
}

__device__ __forceinline__ void sgu_unit(int b, int n, int g, const bf16_t* Z1, const float* sst, const float* lng, const float* lnb, const bf16_t* Wm, const float* bs, bf16_t* Y, char* shm, const int wave_s) {
    const int tid_ = wave_s * 64 + lane_opaque(); const int tid = tid_, lane = tid & 63, r32 = lane & 31, hi = lane >> 5; const int wid = __builtin_amdgcn_readfirstlane(tid >> 6);
    MLAS char* L = (MLAS char*)shm;
    MLAS bf16_t* vn = (MLAS bf16_t*)L;
    constexpr int VP = 136;
    const size_t tok0 = (size_t)b * SEQ + 128 * n;
    {
        const int j = tid >> 2, cq = (tid & 3) * 32;
        const float* sp = sst + (tok0 + j) * 16;
        float s1 = 0.f, s2 = 0.f;
#pragma unroll
        for (int k = 0; k < 8; ++k) { s1 += sp[2 * k]; s2 += sp[2 * k + 1]; }
        const float mu = s1 * (1.0f / 512.0f); const float var = fmaxf(s2 * (1.0f / 512.0f) - mu * mu, 0.f);
        const float rstd = 1.0f / sqrtf(var + RMS_EPS);
        const bf16_t* vp = Z1 + (tok0 + j) * Z1P + 2048 + 128 * g + cq;
#pragma unroll
        for (int k = 0; k < 4; ++k) {
            const u32x4 w = *(const u32x4*)(vp + 8 * k);
            const int cc = 128 * g + cq + 8 * k;
            const f32x4 g0 = *(const f32x4*)(lng + cc), g1 = *(const f32x4*)(lng + cc + 4), b0 = *(const f32x4*)(lnb + cc), b1 = *(const f32x4*)(lnb + cc + 4);
            float x[8] = {pg8::bf_lo(w.x), pg8::bf_hi(w.x), pg8::bf_lo(w.y), pg8::bf_hi(w.y), pg8::bf_lo(w.z), pg8::bf_hi(w.z), pg8::bf_lo(w.w), pg8::bf_hi(w.w)};
            float y[8];
#pragma unroll
            for (int i = 0; i < 4; ++i) { y[i] = (x[i] - mu) * rstd * g0[i] + b0[i]; y[4 + i] = (x[4 + i] - mu) * rstd * g1[i] + b1[i]; }
            u32x4 o; o.x = cvtpk(y[0], y[1]); o.y = cvtpk(y[2], y[3]); o.z = cvtpk(y[4], y[5]); o.w = cvtpk(y[6], y[7]);
            *(MLAS u32x4*)(vn + j * VP + cq + 8 * k) = o;
        }
    }
    LGKM_BAR();
    MLAS bf16_t* ut = (MLAS bf16_t*)(L + 128 * VP * 2);
    {
        const int j = tid >> 2, cq = (tid & 3) * 32;
        const bf16_t* up = Z1 + (tok0 + j) * Z1P + 1536 + 128 * g + cq;
#pragma unroll
        for (int k = 0; k < 4; ++k) *(MLAS u32x4*)(ut + j * VP + cq + 8 * k) = *(const u32x4*)(up + 8 * k);
    }
    LGKM_BAR();
    const int ib = wid & 3;
    const bf16_t* wrow = Wm + ((size_t)g * 128 + 32 * ib + r32) * 128 + 8 * hi;
    bf16x8 af[8];
#pragma unroll
    for (int s = 0; s < 8; ++s) af[s] = *(const bf16x8*)(wrow + 16 * s);
#pragma unroll
    for (int cbi = 0; cbi < 2; ++cbi) {
        const int cb = (wid >> 2) * 2 + cbi;
        f32x16 acc = {};
        lds_cptr bp = (lds_cptr)(vn) + ((size_t)(8 * hi + ((lane & 15) >> 2)) * VP + 32 * cb + 16 * ((lane >> 4) & 1) + 4 * (lane & 3)) * 2;
#pragma unroll
        for (int s = 0; s < 8; ++s) {
            const s16x4 lo = vtr(bp + (16 * s) * VP * 2), hh = vtr(bp + (16 * s + 4) * VP * 2);
            const bf16x8 bfr = {lo[0], lo[1], lo[2], lo[3], hh[0], hh[1], hh[2], hh[3]};
            acc = __builtin_amdgcn_mfma_f32_32x32x16_bf16(af[s], bfr, acc, 0, 0, 0);
        }
        float a16[16]; V16_TO_ARR(acc, a16, 0);
#pragma unroll
        for (int r = 0; r < 16; ++r) {
            const int i = 32 * ib + crow(r, hi), cc = 32 * cb + r32;
            const float uu = __builtin_bit_cast(float, (unsigned)ut[i * VP + cc] << 16);
            const float o = uu * (a16[r] + bs[g * 128 + i]);
            ut[i * VP + cc] = (bf16_t)(cvtpk(o, 0.f) & 0xffffu);
        }
    }
    LGKM_BAR();
    {
        const int j = tid >> 2, cq = (tid & 3) * 32;
        bf16_t* yp = Y + (tok0 + j) * DMODEL + 512 + 128 * g + cq;
#pragma unroll
        for (int k = 0; k < 4; ++k) *(u32x4*)(yp + 8 * k) = *(const MLAS u32x4*)(ut + j * VP + cq + 8 * k);
    }
    LGKM_BAR();
}

__device__ __forceinline__ void pool_item(int item, const bf16_t* Z0, bf16_t* Y) {
    const int row = item >> 6, ch = item & 63, c0 = ch * 8, g = ch >> 4;
    const int w = 2 << g, tpos = row & (SEQ - 1);
    const int cnt = (tpos + 1 < w) ? tpos + 1 : w;
    u32x4 v[16];
#pragma unroll
    for (int k = 0; k < 16; ++k) { v[k] = (u32x4){0u, 0u, 0u, 0u}; if (k < cnt) v[k] = *(const u32x4*)(Z0 + (size_t)(row - k) * EV_N + c0); }
    float s[8] = {0.f, 0.f, 0.f, 0.f, 0.f, 0.f, 0.f, 0.f};
#pragma unroll
    for (int k = 0; k < 16; ++k) {
        s[0] += pg8::bf_lo(v[k].x); s[1] += pg8::bf_hi(v[k].x); s[2] += pg8::bf_lo(v[k].y); s[3] += pg8::bf_hi(v[k].y);
        s[4] += pg8::bf_lo(v[k].z); s[5] += pg8::bf_hi(v[k].z); s[6] += pg8::bf_lo(v[k].w); s[7] += pg8::bf_hi(v[k].w);
    }
    const float self[8] = {pg8::bf_lo(v[0].x), pg8::bf_hi(v[0].x), pg8::bf_lo(v[0].y), pg8::bf_hi(v[0].y), pg8::bf_lo(v[0].z), pg8::bf_hi(v[0].z), pg8::bf_lo(v[0].w), pg8::bf_hi(v[0].w)};
    const float inv = 1.0f / (float)cnt;
    u32x4 o; o.x = cvtpk(s[0] * inv - self[0], s[1] * inv - self[1]); o.y = cvtpk(s[2] * inv - self[2], s[3] * inv - self[3]);
    o.z = cvtpk(s[4] * inv - self[4], s[5] * inv - self[5]); o.w = cvtpk(s[6] * inv - self[6], s[7] * inv - self[7]);
    *(u32x4*)(Y + (size_t)row * DMODEL + c0) = o;
}
}
namespace foxa {
using bf16=__hip_bfloat16;
using bf16x8=__attribute__((ext_vector_type(8)))short;
using s16x4=__attribute__((ext_vector_type(4)))short;
using f32x16=__attribute__((ext_vector_type(16)))float;
using u32x4=__attribute__((ext_vector_type(4)))unsigned;
using f32x4v=__attribute__((ext_vector_type(4)))float;
constexpr int CUM_OFF=86016;
constexpr int SEQL=2048,D=64,OPI=1024;
constexpr int NW=8,QBLK=32,QB=QBLK*NW,KVBLK=64;
__device__ __forceinline__ int crow(int r,int hi){return (r&3)+8*(r>>2)+4*hi;}
#define SBAR() __builtin_amdgcn_sched_barrier(0)
__device__ __forceinline__ void cmask(f32x16&p0,f32x16&p1,int jb,int qrel,int hi){
  const float NEG=-INFINITY; int kb=64*jb+4*hi;
  #pragma unroll
  for(int r=0;r<16;++r){int kv=kb+(r&3)+8*(r>>2); if(kv>qrel)p0[r]=NEG; if(kv+32>qrel)p1[r]=NEG;}
}

constexpr int NSLOT=3, SLOTB=8192;
constexpr int LDS_K=0, LDS_V=NSLOT*SLOTB, LDS_WS=2*NSLOT*SLOTB, LDS_OST=LDS_WS+NW*64*4, LDS_BYTES=LDS_OST+NW*4096;
constexpr float C2=0.125f*1.4426950408889634f;
__device__ __forceinline__ void glds16(const void*gsrc,unsigned lds_dst){unsigned keep;
  asm volatile("s_mov_b32 %0, m0\n\ts_mov_b32 m0, %2\n\ts_nop 0\n\tglobal_load_lds_dwordx4 %1, off\n\ts_mov_b32 m0, %0":"=&s"(keep):"v"(gsrc),"s"(lds_dst):"memory");}
__device__ __forceinline__ float max3f(float a,float b,float c){float r;asm("v_max3_f32 %0, %1, %2, %3":"=v"(r):"v"(a),"v"(b),"v"(c));return r;}
__device__ __forceinline__ float max2f(float a,float b){float r;asm("v_max_f32_e32 %0, %1, %2":"=v"(r):"v"(a),"v"(b));return r;}
__device__ __forceinline__ float fadd_s(float a,float b){float r;asm("v_add_f32_e32 %0, %1, %2":"=v"(r):"v"(a),"v"(b));return r;}
__device__ __forceinline__ float fsub_s(float a,float b){float r;asm("v_sub_f32_e32 %0, %1, %2":"=v"(r):"v"(a),"v"(b));return r;}
typedef float f32x2_t __attribute__((ext_vector_type(2))); typedef __bf16 bf16x2_t __attribute__((ext_vector_type(2)));
__device__ __forceinline__ unsigned cvtpk_s(float lo,float hi){f32x2_t v={lo,hi};bf16x2_t b=__builtin_convertvector(v,bf16x2_t);return __builtin_bit_cast(unsigned,b);}
#define WAIT_BAR(N) asm volatile("s_waitcnt vmcnt(" #N ") lgkmcnt(0)\n\ts_barrier":::"memory")

__device__ __forceinline__ void qkt(f32x16&p0,f32x16&p1,const char*Kslot,const bf16x8*qr,const f32x16&negm,int r32,int hi){
  const char*kb=Kslot+hi*1024+r32*16;
  #pragma unroll
  for(int d0=0;d0<4;++d0){
    const bf16x8 b0=*reinterpret_cast<const bf16x8*>(kb+d0*2048);
    const bf16x8 b1=*reinterpret_cast<const bf16x8*>(kb+d0*2048+512);
    if(d0==0){p0=__builtin_amdgcn_mfma_f32_32x32x16_bf16(b0,qr[0],negm,0,0,0);p1=__builtin_amdgcn_mfma_f32_32x32x16_bf16(b1,qr[0],negm,0,0,0);}
    else{p0=__builtin_amdgcn_mfma_f32_32x32x16_bf16(b0,qr[d0],p0,0,0,0);p1=__builtin_amdgcn_mfma_f32_32x32x16_bf16(b1,qr[d0],p1,0,0,0);}}
}
typedef __attribute__((address_space(3))) const char* lds_cptr;
typedef short v4i16_t __attribute__((ext_vector_type(4)));
__device__ __forceinline__ void kload8(bf16x8*kf,lds_cptr kp){
  kf[0]=*(const __attribute__((address_space(3))) bf16x8*)(kp);      kf[1]=*(const __attribute__((address_space(3))) bf16x8*)(kp+512);
  kf[2]=*(const __attribute__((address_space(3))) bf16x8*)(kp+2048); kf[3]=*(const __attribute__((address_space(3))) bf16x8*)(kp+2560);
  kf[4]=*(const __attribute__((address_space(3))) bf16x8*)(kp+4096); kf[5]=*(const __attribute__((address_space(3))) bf16x8*)(kp+4608);
  kf[6]=*(const __attribute__((address_space(3))) bf16x8*)(kp+6144); kf[7]=*(const __attribute__((address_space(3))) bf16x8*)(kp+6656);
}
__device__ __forceinline__ void kload2(bf16x8*kf,lds_cptr kp,int j){ kf[2*j]=*(const __attribute__((address_space(3))) bf16x8*)(kp+j*2048); kf[2*j+1]=*(const __attribute__((address_space(3))) bf16x8*)(kp+j*2048+512); }
__device__ __forceinline__ s16x4 vtr(lds_cptr p){ return __builtin_bit_cast(s16x4,__builtin_amdgcn_ds_read_tr16_b64_v4i16((__attribute__((address_space(3))) v4i16_t*)p)); }
__device__ __forceinline__ float rowmax(const f32x16&p0,const f32x16&p1){
  float a=max3f(p0[0],p0[1],p1[0]),b=max3f(p0[2],p0[3],p1[1]);a=max3f(a,p1[2],p1[3]);
  #pragma unroll
  for(int r=4;r<16;r+=4){a=max3f(a,p0[r],p0[r+1]);b=max3f(b,p0[r+2],p0[r+3]);a=max3f(a,p1[r],p1[r+1]);b=max3f(b,p1[r+2],p1[r+3]);}
  const float m=max2f(a,b);
  auto rr=__builtin_amdgcn_permlane32_swap(__float_as_uint(m),__float_as_uint(m),false,false);
  return max2f(__uint_as_float(rr[0]),__uint_as_float(rr[1]));
}
__device__ __forceinline__ void pv(f32x16*o,int vb,bf16x8 pa0,bf16x8 pa1,bf16x8 pa2,bf16x8 pa3){
  #pragma unroll
  for(int d0=0;d0<2;++d0){s16x4 lo[4],hi[4];
    #pragma unroll
    for(int ks=0;ks<4;++ks){
      asm volatile("ds_read_b64_tr_b16 %0,%1 offset:%c2":"=&v"(lo[ks]):"v"(vb),"i"(d0*4096+ks*1024):"memory");
      asm volatile("ds_read_b64_tr_b16 %0,%1 offset:%c2":"=&v"(hi[ks]):"v"(vb),"i"(d0*4096+ks*1024+512):"memory");}
    asm volatile("s_waitcnt lgkmcnt(0)":::"memory");SBAR();
    #define PK(k) (bf16x8){lo[k][0],lo[k][1],lo[k][2],lo[k][3],hi[k][0],hi[k][1],hi[k][2],hi[k][3]}
    o[d0]=__builtin_amdgcn_mfma_f32_32x32x16_bf16(pa0,PK(0),o[d0],0,0,0);
    o[d0]=__builtin_amdgcn_mfma_f32_32x32x16_bf16(pa1,PK(1),o[d0],0,0,0);
    o[d0]=__builtin_amdgcn_mfma_f32_32x32x16_bf16(pa2,PK(2),o[d0],0,0,0);
    o[d0]=__builtin_amdgcn_mfma_f32_32x32x16_bf16(pa3,PK(3),o[d0],0,0,0);
    #undef PK
  }
}

#ifndef ATTN_STORE16
#define ATTN_STORE16(p,v) (*(u32x4*)(p)=(v))
#endif
template<int THRL,int MODE,int QKVP,class CumFn> __device__ __forceinline__ void attn_unit(CumFn&& CUMFN,int b,int h,int qb,int q0abs,int NTU,const bf16*Q,const bf16*__restrict__ K,const bf16*__restrict__ V,bf16*O,char*shm,const __attribute__((address_space(3))) unsigned*selw,const int wave_s){
  const int tid=wave_s*64+lane_opaque(),lane=tid&63,r32=lane&31,hi=lane>>5; const int wid=__builtin_amdgcn_readfirstlane(tid>>6);
  const long rowbase=(long)b*SEQL; const int q0=(MODE==0)?qb*QB:q0abs;
  const bf16*Qw=(MODE==0)?Q+(rowbase+q0+wid*QBLK)*QKVP+h*D:Q+(rowbase+q0)*QKVP+wid*D;
  const bf16*Kh=K+rowbase*QKVP+h*D,*Vh=V+rowbase*QKVP+h*D;
  const unsigned lds0=(unsigned)(uintptr_t)shm;
  float*wsf=(float*)(shm+LDS_WS)+wid*64;
  const bf16*ksrc=Kh+(long)lane*QKVP+wid*8;
  const bf16*vsrc=Vh+(long)(16*(wid&3)+(lane>>2))*QKVP+(wid>>2)*32+(lane&3)*8;
  const unsigned kdst=lds0+LDS_K+wid*1024, vdst=lds0+LDS_V+wid*1024;
  #define DMA_K(t,slot) glds16(ksrc+(long)(t)*KVBLK*QKVP,(unsigned)__builtin_amdgcn_readfirstlane(kdst+(slot)))
  #define DMA_V(t,slot) glds16(vsrc+(long)(t)*KVBLK*QKVP,(unsigned)__builtin_amdgcn_readfirstlane(vdst+(slot)))
  const int vb0=(int)(lds0+LDS_V)+((lane>>4)&1)*32+(lane&3)*8+(4*hi+((lane&15)>>2))*64;
  const char*Kbase=shm+LDS_K; bf16x8 kf[8];
  const lds_cptr shm3=(lds_cptr)shm; const lds_cptr kp0=shm3+LDS_K+hi*1024+r32*16; const lds_cptr vp0=shm3+LDS_V+((lane>>4)&1)*32+(lane&3)*8+(4*hi+((lane&15)>>2))*64;
  const int NT=(MODE==0)?(q0+QB)/KVBLK:NTU;
  DMA_K(0,0);DMA_V(0,0);DMA_K(1,SLOTB);
  if constexpr(MODE==0){ CUMFN(); }
  bf16x8 qr[4];
  #pragma unroll
  for(int d0=0;d0<4;++d0)qr[d0]=*reinterpret_cast<const bf16x8*>(&Qw[(long)r32*QKVP+d0*16+hi*8]);
  float mhat=0.f,l_reg=0.f;float z_=0.f;asm volatile("":"+v"(z_));f32x16 o[2];o[0]=(f32x16){z_,z_,z_,z_,z_,z_,z_,z_,z_,z_,z_,z_,z_,z_,z_,z_};o[1]=o[0];f32x16 negm=o[0];asm volatile("":"+v"(negm));
  const int qrel=wid*QBLK+r32;
  const __attribute__((address_space(3))) float*cum2=(const __attribute__((address_space(3))) float*)(shm+CUM_OFF);
  const float cq2=(MODE==0)?cum2[q0+qrel]:0.f;
  #define BIAS(P0,P1,t) do{ if constexpr(MODE==0){ const __attribute__((address_space(3))) float*cb_=cum2+64*(t)+4*hi; \
    _Pragma("unroll") for(int g_=0;g_<4;++g_){ const f32x4v c0_=*(const __attribute__((address_space(3))) f32x4v*)(cb_+8*g_), c1_=*(const __attribute__((address_space(3))) f32x4v*)(cb_+32+8*g_); \
      P0[4*g_+0]+=cq2-c0_.x; P0[4*g_+1]+=cq2-c0_.y; P0[4*g_+2]+=cq2-c0_.z; P0[4*g_+3]+=cq2-c0_.w; \
      P1[4*g_+0]+=cq2-c1_.x; P1[4*g_+1]+=cq2-c1_.y; P1[4*g_+2]+=cq2-c1_.z; P1[4*g_+3]+=cq2-c1_.w; } } }while(0)
  #define SELM(P0,P1,t) do{ if constexpr(MODE==1){ const unsigned w0_=selw[(2*(t))*32+r32]>>(4*hi), w1_=selw[(2*(t)+1)*32+r32]>>(4*hi); \
    _Pragma("unroll") for(int r=0;r<16;++r){ const int sh_=(r&3)+8*(r>>2); if(!((w0_>>sh_)&1u))P0[r]=-INFINITY; if(!((w1_>>sh_)&1u))P1[r]=-INFINITY; } } }while(0)
  #define CMASK(P0,P1,t) do{ if constexpr(MODE==0){int jb_=(t)-(NT-4); if(jb_>=0)cmask(P0,P1,jb_,qrel,hi);} }while(0)
  bool resc=false;
  #define START(P0,P1) do{ const float rm=rowmax(P0,P1); resc=false; \
    { const float dl=(MODE==1&&!(rm>-1e30f))?0.f:rm; mhat=fadd_s(mhat,dl); \
      _Pragma("unroll") for(int r=0;r<16;++r){P0[r]=fsub_s(P0[r],dl);P1[r]=fsub_s(P1[r],dl);} \
      _Pragma("unroll") for(int r=0;r<16;++r)negm[r]=-mhat; asm volatile("":"+v"(negm)); } \
    _Pragma("unroll") for(int r=0;r<16;++r)P0[r]=__builtin_amdgcn_exp2f(P0[r]); }while(0)
  #define RESC() do{ if(resc){ asm volatile("s_waitcnt lgkmcnt(0)":::"memory"); \
      _Pragma("unroll") for(int d_=0;d_<2;++d_) _Pragma("unroll") for(int r=0;r<16;++r)o[d_][r]*=wsf[crow(r,hi)]; } }while(0)
  f32x16 pA0,pA1,pB0,pB1;
  int sl_prev=0,sl_cur=0,sl_next=SLOTB;
  #define ROT() do{sl_prev=sl_cur;sl_cur=sl_next;sl_next=(sl_next==(NSLOT-1)*SLOTB)?0:sl_next+SLOTB;}while(0)
  DMA_K(2,2*SLOTB);
  WAIT_BAR(3);
  qkt(pA0,pA1,Kbase,qr,negm,r32,hi);asm volatile("s_nop 15\n\ts_nop 7":"+v"(pA0),"+v"(pA1));BIAS(pA0,pA1,0);SELM(pA0,pA1,0);CMASK(pA0,pA1,0);
  START(pA0,pA1);
  _Pragma("unroll") for(int r=0;r<16;++r)pA1[r]=__builtin_amdgcn_exp2f(pA1[r]);
  WAIT_BAR(0);
  DMA_K(3,0);DMA_V(1,SLOTB);
  ROT();
  kload8(kf,kp0+sl_cur);
  WAIT_BAR(2);
  s16x4 vlo[8],vhi[8]; u32x4 pw0,pw1,pw2,pw3;
  #define PKW(P,B) cvtpk_s(P[B],P[B+1])
  #define PAF(k) __builtin_bit_cast(bf16x8,pw##k)
  #define VFR(i) (bf16x8){vlo[i][0],vlo[i][1],vlo[i][2],vlo[i][3],vhi[i][0],vhi[i][1],vhi[i][2],vhi[i][3]}
  #define PIN(x) asm volatile("":"+v"(x))
  #define MX3(a,b,c) __builtin_fmaxf(__builtin_fmaxf((a),(b)),(c))
  #define GAPA(MF,A0,A1,A2,A3,W0,W1,PW) do{ MF; sacc+=A0; sacc+=A1; sacc+=A2; sacc+=A3; PIN(sacc); W0; W1; PIN(PW); SBAR(); }while(0)
  #define EX(v) __builtin_amdgcn_exp2f(v)
  #define GAPB(MF,X,B) do{ MF; X[B]=EX(X[B]); X[B+1]=EX(X[B+1]); X[B+2]=EX(X[B+2]); X[B+3]=EX(X[B+3]); PIN(X); SBAR(); }while(0)
  #define VRD(i) do{ vlo[i]=vtr(vp_+(((i)>>2)*4096+((i)&3)*1024)); vhi[i]=vtr(vp_+(((i)>>2)*4096+((i)&3)*1024+512)); }while(0)
  #define KRD(G,j) do{ if(G){ kload2(kf,kp0+sl_next,j); SBAR(); } }while(0)
  #define STEP(C0,C1,P0,P1,t,GK,GV,GL) do{ SBAR(); \
    const lds_cptr vp_=vp0+sl_prev; \
    VRD(0); SBAR(); float sacc=(P0[0]+P0[1]); \
    GAPA(C0=__builtin_amdgcn_mfma_f32_32x32x16_bf16(kf[0],qr[0],negm,0,0,0), P0[2],P0[3],P0[4],P0[5],     pw0[0]=PKW(P0,0), pw0[1]=PKW(P0,2), pw0); \
    VRD(4); SBAR(); GAPA(C1=__builtin_amdgcn_mfma_f32_32x32x16_bf16(kf[1],qr[0],negm,0,0,0), P0[6],P0[7],P0[8],P0[9],     pw0[2]=PKW(P0,4), pw0[3]=PKW(P0,6), pw0); \
    VRD(1); SBAR(); GAPA(C0=__builtin_amdgcn_mfma_f32_32x32x16_bf16(kf[2],qr[1],C0,0,0,0),   P0[10],P0[11],P0[12],P0[13], pw1[0]=PKW(P0,8), pw1[1]=PKW(P0,10), pw1); \
    VRD(5); SBAR(); GAPA(C1=__builtin_amdgcn_mfma_f32_32x32x16_bf16(kf[3],qr[1],C1,0,0,0),   P0[14],P0[15],P1[0],P1[1],   pw1[2]=PKW(P0,12),pw1[3]=PKW(P0,14), pw1); \
    VRD(2); SBAR(); GAPA(C0=__builtin_amdgcn_mfma_f32_32x32x16_bf16(kf[4],qr[2],C0,0,0,0),   P1[2],P1[3],P1[4],P1[5],     pw2[0]=PKW(P1,0), pw2[1]=PKW(P1,2), pw2); \
    VRD(6); SBAR(); GAPA(C1=__builtin_amdgcn_mfma_f32_32x32x16_bf16(kf[5],qr[2],C1,0,0,0),   P1[6],P1[7],P1[8],P1[9],     pw2[2]=PKW(P1,4), pw2[3]=PKW(P1,6), pw2); \
    VRD(3); SBAR(); GAPA(C0=__builtin_amdgcn_mfma_f32_32x32x16_bf16(kf[6],qr[3],C0,0,0,0),   P1[10],P1[11],P1[12],P1[13], pw3[0]=PKW(P1,8), pw3[1]=PKW(P1,10), pw3); \
    VRD(7); SBAR(); GAPA(C1=__builtin_amdgcn_mfma_f32_32x32x16_bf16(kf[7],qr[3],C1,0,0,0),   P1[14],P1[15],0.f,0.f,       pw3[2]=PKW(P1,12),pw3[3]=PKW(P1,14), pw3); \
    l_reg+=sacc; \
    if(GK){DMA_K((t)+3,sl_cur);} if(GV){DMA_V((t)+1,sl_next);} \
    BIAS(C0,C1,t); SELM(C0,C1,t); CMASK(C0,C1,t); \
    { float a=MX3(C0[0],C0[1],C1[0]),b=MX3(C0[2],C0[3],C1[1]); a=MX3(a,C1[2],C1[3]); \
      _Pragma("unroll") for(int r=4;r<16;r+=4){a=MX3(a,C0[r],C0[r+1]);b=MX3(b,C0[r+2],C0[r+3]);a=MX3(a,C1[r],C1[r+1]);b=MX3(b,C1[r+2],C1[r+3]);} \
      float rm=__builtin_fmaxf(a,b); { auto rr=__builtin_amdgcn_permlane32_swap(__float_as_uint(rm),__float_as_uint(rm),false,false); rm=__builtin_fmaxf(__uint_as_float(rr[0]),__uint_as_float(rr[1])); } \
      resc=false; \
      if(__builtin_expect(__any(rm>(float)THRL),0)){ const float dl=__builtin_fmaxf(rm,0.f); mhat+=dl; \
        _Pragma("unroll") for(int r=0;r<16;++r){C0[r]-=dl;C1[r]-=dl;} \
        _Pragma("unroll") for(int r=0;r<16;++r)negm[r]=-mhat; asm volatile("":"+v"(negm)); \
        const float f=__builtin_amdgcn_exp2f(-dl); l_reg*=f; if(hi==0)wsf[r32]=f; resc=true; } } \
    SBAR(); \
    GAPB(o[0]=__builtin_amdgcn_mfma_f32_32x32x16_bf16(PAF(0),VFR(0),o[0],0,0,0), C0,0); \
    GAPB(o[1]=__builtin_amdgcn_mfma_f32_32x32x16_bf16(PAF(0),VFR(4),o[1],0,0,0), C0,4); \
    KRD(GL,0); GAPB(o[0]=__builtin_amdgcn_mfma_f32_32x32x16_bf16(PAF(1),VFR(1),o[0],0,0,0), C0,8); \
    KRD(GL,1); GAPB(o[1]=__builtin_amdgcn_mfma_f32_32x32x16_bf16(PAF(1),VFR(5),o[1],0,0,0), C0,12); \
    KRD(GL,2); GAPB(o[0]=__builtin_amdgcn_mfma_f32_32x32x16_bf16(PAF(2),VFR(2),o[0],0,0,0), C1,0); \
    KRD(GL,3); GAPB(o[1]=__builtin_amdgcn_mfma_f32_32x32x16_bf16(PAF(2),VFR(6),o[1],0,0,0), C1,4); \
    GAPB(o[0]=__builtin_amdgcn_mfma_f32_32x32x16_bf16(PAF(3),VFR(3),o[0],0,0,0), C1,8); \
    GAPB(o[1]=__builtin_amdgcn_mfma_f32_32x32x16_bf16(PAF(3),VFR(7),o[1],0,0,0), C1,12); \
    }while(0)
  int t=1;
  #undef CMASK
  #define CMASK(P0,P1,t) do{}while(0)
  for(;t+5<NT;t+=2){
    STEP(pB0,pB1,pA0,pA1,t,true,true,true);     WAIT_BAR(2); RESC(); ROT();
    STEP(pA0,pA1,pB0,pB1,t+1,true,true,true);   WAIT_BAR(2); RESC(); ROT();
  }
  #undef CMASK
  #define CMASK(P0,P1,t) do{ if constexpr(MODE==0){int jb_=(t)-(NT-4); if(jb_>=0)cmask(P0,P1,jb_,qrel,hi);} }while(0)
  #define ENDW(tt) do{ if((tt)+3<NT){WAIT_BAR(2);} else if((tt)+2<NT){WAIT_BAR(1);} else {WAIT_BAR(0);} }while(0)
  for(;t+1<NT;t+=2){
    STEP(pB0,pB1,pA0,pA1,t,(t+3<NT),(t+1<NT),(t+1<NT));       ENDW(t);   RESC(); ROT();
    STEP(pA0,pA1,pB0,pB1,t+1,(t+4<NT),(t+2<NT),(t+2<NT));     ENDW(t+1); RESC(); ROT();
  }
  STEP(pB0,pB1,pA0,pA1,NT-1,false,false,false); RESC();
  { float sacc=pB0[0]+pB0[1]; _Pragma("unroll") for(int r=2;r<16;++r)sacc+=pB0[r]; _Pragma("unroll") for(int r=0;r<16;++r)sacc+=pB1[r]; l_reg+=sacc;
    pw0=(u32x4){PKW(pB0,0),PKW(pB0,2),PKW(pB0,4),PKW(pB0,6)};pw1=(u32x4){PKW(pB0,8),PKW(pB0,10),PKW(pB0,12),PKW(pB0,14)};pw2=(u32x4){PKW(pB1,0),PKW(pB1,2),PKW(pB1,4),PKW(pB1,6)};pw3=(u32x4){PKW(pB1,8),PKW(pB1,10),PKW(pB1,12),PKW(pB1,14)};
    SBAR(); pv(o,vb0+sl_cur,PAF(0),PAF(1),PAF(2),PAF(3)); }
  #undef PKW
  #undef PAF
  #undef VFR
  #undef PIN
  #undef MX3
  #undef GAPA
  #undef GAPB
  #undef EX
  #undef VRD
  #undef KRD
  #undef STEP
  #undef ENDW
  {auto rr=__builtin_amdgcn_permlane32_swap(__float_as_uint(l_reg),__float_as_uint(l_reg),false,false);l_reg=__uint_as_float(rr[0])+__uint_as_float(rr[1]);}
  if(hi==0)wsf[32+r32]=l_reg;asm volatile("s_waitcnt lgkmcnt(0)":::"memory");
  float rli[16];
  #pragma unroll
  for(int r=0;r<16;++r)rli[r]=__builtin_amdgcn_rcpf(wsf[32+crow(r,hi)]);
  bf16*Ow=(MODE==0)?O+(rowbase+q0+wid*QBLK)*OPI+h*D:O+(rowbase+q0)*OPI+wid*D;
  { bf16*stg=(bf16*)(shm+LDS_OST)+wid*2048;
    #pragma unroll
    for(int r=0;r<16;++r){const int orow=crow(r,hi);
      #pragma unroll
      for(int d0=0;d0<2;++d0)stg[orow*64+d0*32+r32]=__float2bfloat16(o[d0][r]*rli[r]);}
    asm volatile("s_waitcnt lgkmcnt(0)":::"memory");
    #pragma unroll
    for(int i=0;i<4;++i){const int row=i*8+(lane>>3),ch=lane&7; const u32x4 v=*(const u32x4*)(stg+row*64+ch*8); ATTN_STORE16(Ow+(long)row*OPI+ch*8,v);} }
  asm volatile("s_waitcnt lgkmcnt(0)\n\ts_barrier":::"memory");
  #undef DMA_K
  #undef DMA_V
  #undef CMASK
  #undef START
  #undef BIAS
  #undef SELM
  #undef RESC
  #undef ROT
}
#undef SBAR
#undef WAIT_BAR
}

#ifndef DBG_REP_SEL
#define DBG_REP_SEL 1
#endif
namespace mix {
__device__ __forceinline__ void fox_unit2(int b, int h, int qb, const bf16_t* Z1, const float* F, const float* bfp, bf16_t* Y, char* shm, const int wave_s) {
    const size_t rowb = (size_t)b * SEQ;
    const int nk = 256 * (qb + 1);
    auto cumfn = [=]() {
        const int tid = wave_s * 64 + lane_opaque(), lane = tid & 63; const int wid = __builtin_amdgcn_readfirstlane(tid >> 6);
        MLAS char* L = (MLAS char*)shm;
        MLAS float* cum2 = (MLAS float*)(L + foxa::CUM_OFF);
        MLAS float* wtot = (MLAS float*)(L + foxa::CUM_OFF + 8192);
        const float bias = bfp[h];
        const int s0 = 4 * tid;
        float v[4]; float run = 0.f;
#pragma unroll
        for (int i = 0; i < 4; ++i) {
            float x = 0.f;
            if (s0 + i < nk) x = F[(rowb + s0 + i) * 8 + h] + bias;
            const float ls = (s0 + i < nk) ? (fminf(x, 0.f) - log1pf(expf(-fabsf(x)))) : 0.f;
            run += ls; v[i] = run;
        }
        float inc = run;
#pragma unroll
        for (int o = 1; o < 64; o <<= 1) { const int ln = lane_opaque(); const float t = __builtin_bit_cast(float, __builtin_amdgcn_ds_bpermute((ln - o) << 2, __builtin_bit_cast(int, inc))); if (ln >= o) inc += t; }
        if (lane == 63) wtot[wid] = inc;
        LGKM_BAR();
        float off = inc - run;
        for (int w = 0; w < wid; ++w) off += wtot[w];
#pragma unroll
        for (int i = 0; i < 4; ++i) cum2[s0 + i] = (off + v[i]) * 1.4426950408889634f;
        LGKM_BAR();
    };
    foxa::attn_unit<8, 0, 2560>(cumfn, b, h, qb, 0, 0, (const foxa::bf16*)Z1, (const foxa::bf16*)(Z1 + 512), (const foxa::bf16*)(Z1 + 1024), (foxa::bf16*)Y, shm, nullptr, wave_s);
}
__device__ __forceinline__ void dsa_unit(int b, int qg, const bf16_t* Z0, bf16_t* Y, char* shm, unsigned lds0, const int wave_s) {
    for (int rep_ = 0; rep_ < DBG_REP_SEL; ++rep_) dsa_select(b, qg, Z0, shm, wave_s);
    const int nt64 = (qg >> 1) + 1; int ntu = (nt64 + 1) & ~1; if (ntu < 4) ntu = 4;
    foxa::attn_unit<8, 1, EV_N>([]() {}, b, 0, 0, 32 * qg, ntu, (const foxa::bf16*)(Z0 + 512), (const foxa::bf16*)(Z0 + 1024), (const foxa::bf16*)(Z0 + 1088), (foxa::bf16*)(Y + 512), shm,
                                (const MLAS unsigned*)((MLAS char*)shm + LX_SEL), wave_s);
}
}
constexpr int NWAVES = 8;
constexpr size_t KiB = 1024, MiB = 1u << 20;
constexpr size_t WS_CTL = 0, CTL_ZERO_BYTES = 1 * MiB;
constexpr size_t WS_W_EVIN = 1 * MiB, WS_W_OUT0 = 4 * MiB, WS_W_FFI0 = 6 * MiB, WS_W_FFO0 = 17 * MiB, WS_W_PG0 = 22 * MiB + 512 * KiB, WS_W_PP0 = 24 * MiB + 512 * KiB;
constexpr size_t WS_W_ODIN = 25 * MiB, WS_W_OUT1 = 30 * MiB + 512 * KiB, WS_W_FFI1 = 32 * MiB + 512 * KiB, WS_W_FFO1 = 43 * MiB + 512 * KiB, WS_W_PG1 = 49 * MiB, WS_W_PP1 = 51 * MiB, WS_W_SGU = 51 * MiB + 512 * KiB;
constexpr size_t WS_RSTD = 57 * MiB + 768 * KiB;
constexpr size_t WS_SSQA = 52 * MiB, WS_SSQB = 53 * MiB, WS_ROPE = 54 * MiB, WS_AH = 55 * MiB, WS_FBUF = 58 * MiB + 512 * KiB, WS_SST = 59 * MiB;
constexpr size_t WS_HB = 60 * MiB, WS_AHALO = 92 * MiB, WS_PP = 92 * MiB + 512 * KiB, WS_Y = 124 * MiB + 512 * KiB, WS_ZH = 156 * MiB + 512 * KiB, WS_PB = 244 * MiB + 512 * KiB, WS_END = 252 * MiB + 512 * KiB;
static_assert(WS_AHALO == WS_HB + (size_t)TOK * 1024 * 2, "the halo rows are row tile 64 of the FFN in-projection A operand");
static_assert(WS_W_EVIN + (size_t)EV_N * 1024 * 2 <= WS_W_OUT0 && WS_W_FFI0 + (size_t)NFF2 * 1024 * 2 <= WS_W_FFO0 && WS_W_FFO0 + (size_t)1024 * DFF * 2 <= WS_W_PG0, "ws map 1");
static_assert(WS_W_ODIN + (size_t)OD_N * 1024 * 2 <= WS_W_OUT1 && WS_W_FFI1 + (size_t)NFF2 * 1024 * 2 <= WS_W_FFO1 && WS_W_FFO1 + (size_t)1024 * DFF * 2 <= WS_W_PG1 && WS_W_SGU + 4 * 128 * 128 * 2 <= WS_SSQA, "ws map 2");
static_assert(WS_AH + (size_t)128 * NFF2 * 4 <= WS_RSTD && WS_ZH + (size_t)TOK * DFF * 2 <= WS_PB && WS_PB + (size_t)TOK * PLE * 2 <= WS_END, "ws map 3");
constexpr int CW_BAR = 4096, CW_FLAG = 8192, CW_PAN = 16384;
constexpr int RING_BYTES = 131072, XB_OFF = RING_BYTES, LDSCTL_OFF = XB_OFF + 8192 + 1024 + 64, MISC_OFF = LDSCTL_OFF + 320, LDS_BYTES = 147456;
static_assert(MISC_OFF + 128 <= LDS_BYTES, "LDS map");

#define GAS __attribute__((address_space(1)))
#define LAS __attribute__((address_space(3)))
typedef unsigned short bf16;
typedef unsigned v4u __attribute__((ext_vector_type(4)));
typedef float f32x4 __attribute__((ext_vector_type(4)));
typedef float f32x2 __attribute__((ext_vector_type(2)));
#define LDS_WAIT() asm volatile("s_waitcnt lgkmcnt(0)" ::: "memory")
#define VM_WAIT() asm volatile("s_waitcnt vmcnt(0)" ::: "memory")
__device__ __forceinline__ unsigned f2bf(float f) { unsigned u = __builtin_bit_cast(unsigned, f); return (u + 0x7fffu + ((u >> 16) & 1u)) >> 16; }
__device__ __forceinline__ unsigned pk2(float lo, float hi) { return f2bf(lo) | (f2bf(hi) << 16); }

#define XB_TMO      128
#define XB_XCNT(j)  (256  + 64 * (j))
#define XB_XSUB(j)  (1280 + 64 * (j))
#define XB_XGEN(j)  (2304 + 64 * (j))
#define XB_TOP      3328
#define XB_TOPGEN   3392
#define XCD_BAR_WORDS 3456
#define XB_SPIN_CAP (1u << 18)
__device__ __forceinline__ unsigned xb_ld(unsigned* p)              { return __hip_atomic_load(p, __ATOMIC_RELAXED, __HIP_MEMORY_SCOPE_AGENT); }
__device__ __forceinline__ unsigned xb_add(unsigned* p, unsigned v) { return __hip_atomic_fetch_add(p, v, __ATOMIC_RELAXED, __HIP_MEMORY_SCOPE_AGENT); }
__device__ __forceinline__ unsigned xb_xcc_id() { return (unsigned)__builtin_amdgcn_s_getreg((3 << 11) | 20) & 0xFu; }
#define XB_SPIN(cond, bar) do { unsigned _sp = 0; while (cond) { __builtin_amdgcn_s_sleep(1); \
    if ((++_sp & 255u) == 0u) { if (xb_ld(&(bar)[XB_TMO])) break; if (_sp > XB_SPIN_CAP) { atomicAdd(&(bar)[XB_TMO], 1u); break; } } } } while (0)
struct XcdBarrier { unsigned* bar; unsigned x; volatile LAS unsigned* st; };
__device__ __forceinline__ XcdBarrier xcd_barrier_post(unsigned* bar, volatile LAS unsigned* st) {
    XcdBarrier b; b.bar = bar; b.x = xb_xcc_id(); b.st = st;
    if (threadIdx.x == 0) (void)xb_add(&bar[XB_XCNT(b.x)], 1u);
    return b;
}
__device__ __forceinline__ void xcd_barrier_complete(unsigned* bar, unsigned x, unsigned& nloc, unsigned& nx) {
    const unsigned G = gridDim.x * gridDim.y * gridDim.z;
    unsigned sum, cnt, mine, sp = 0u;
    for (;;) {
        sum = 0u; cnt = 0u; mine = 0u;
#pragma unroll 1
        for (unsigned j = 0; j < 16; ++j) { const unsigned c = xb_ld(&bar[XB_XCNT(j)]); sum += c; cnt += (c > 0u) ? 1u : 0u; mine = (j == x) ? c : mine; }
        if (sum == G) break;
        __builtin_amdgcn_s_sleep(1);
        if ((++sp & 255u) == 0u) { if (xb_ld(&bar[XB_TMO])) break; if (sp > XB_SPIN_CAP) { atomicAdd(&bar[XB_TMO], 1u); break; } }
    }
    nloc = mine > 0u ? mine : 1u; nx = cnt > 0u ? cnt : 1u;
}
__device__ __forceinline__ void xcd_barrier(const XcdBarrier& b) {
    asm volatile("s_waitcnt vmcnt(0)" ::: "memory");
    __syncthreads();
    if (threadIdx.x == 0) {
        unsigned* bar = b.bar;
        __builtin_amdgcn_s_waitcnt(0);
        unsigned nloc = b.st[0], nx = b.st[1];
        if (nloc == 0u) { xcd_barrier_complete(bar, b.x, nloc, nx); b.st[0] = nloc; b.st[1] = nx; }
        const unsigned old = xb_add(&bar[XB_XSUB(b.x)], 1u);
        const unsigned gen = old / nloc;
        if (old + 1u == (gen + 1u) * nloc) {
            __builtin_amdgcn_fence(__ATOMIC_RELEASE, "agent");
            asm volatile("s_waitcnt vmcnt(0)" ::: "memory");
            __builtin_amdgcn_fence(__ATOMIC_ACQUIRE, "agent");
            const unsigned og = xb_add(&bar[XB_TOP], 1u);
            const unsigned tg = og / nx;
            if (og + 1u == (tg + 1u) * nx) xb_add(&bar[XB_TOPGEN], 1u);
            else XB_SPIN(xb_ld(&bar[XB_TOPGEN]) == tg, bar);
            asm volatile("s_waitcnt vmcnt(0)" ::: "memory");
            xb_add(&bar[XB_XGEN(b.x)], 1u);
            asm volatile("s_waitcnt vmcnt(0)" ::: "memory");
        } else {
            __builtin_amdgcn_fence(__ATOMIC_ACQUIRE, "agent");
            XB_SPIN(xb_ld(&bar[XB_XGEN(b.x)]) == gen, bar);
            asm volatile("s_waitcnt vmcnt(0)" ::: "memory");
        }
    }
    __syncthreads();
}

__device__ __forceinline__ float wave_sum(float v) {
#pragma unroll
    for (int o = 1; o < 64; o <<= 1) v += __builtin_bit_cast(float, __builtin_amdgcn_ds_bpermute((lane_opaque() ^ o) << 2, __builtin_bit_cast(int, v)));
    return v;
}
__device__ __forceinline__ int vcu_of(int i, int n) { return i; }
__device__ __forceinline__ int unperm16(int d) { return d < 16 ? ((d >> 1) + 8 * (d & 1)) : d; }
__device__ __forceinline__ int map_col(int type, int n, int nold) {
    if (type == 0) return n < nold ? n : -1;
    if (type == 1) {
        if (n < 512) return n;
        if (n < 1024) { const int h = (n - 512) >> 6, d = (n - 512) & 63; return 512 + 64 * h + unperm16(d); }
        if (n < 1088) return 1024 + unperm16(n - 1024);
        if (n < 1152) return n;
        if (n < 1216) return 1408 + unperm16(n - 1152);
        if (n < 1220) return 1472 + (n - 1216);
        if (n < 1280) return -1;
        { const int h = (n - 1280) >> 6, d = (n - 1280) & 63; return 1152 + 64 * h + unperm16(d); }
    }
    if (type == 2) {
        if (n < 1536) return n;
        if (n < 2560) return n + 8;
        if (n < 2568) return 1536 + (n - 2560);
        return -1;
    }
    { const int pn = n >> 8, bj = (n >> 7) & 1, jj = n & 127; return bj * DFF + 128 * pn + jj; }
}
struct TJob { const float* W; const float* rowscale; bf16* WT; int K, Nold, Nnew, ldk, koff, type, nitems; };
__device__ __forceinline__ void transpose_item(const TJob& J, LAS float* scr, int item, int lane) {
    const int nblk = J.Nnew / 32, kb = item / nblk, nb = item % nblk, k0 = 64 * kb, n0 = 32 * nb;
    const int oc = map_col(J.type, n0 + (lane & 31), J.Nold);
    const int occ = oc >= 0 ? oc : 0;
    float vv[32];
#pragma unroll
    for (int i = 0; i < 32; ++i) vv[i] = J.W[(size_t)(k0 + 2 * i + (lane >> 5)) * J.Nold + occ];
#pragma unroll
    for (int i = 0; i < 32; ++i) { const int kk = 2 * i + (lane >> 5);
        float v = (oc >= 0) ? vv[i] : 0.f;
        if (J.rowscale) v *= J.rowscale[k0 + kk];
        scr[kk * 33 + (lane & 31)] = v; }
    LDS_WAIT(); asm volatile("" ::: "memory");
    const int c = lane & 7;
#pragma unroll
    for (int j = 0; j < 4; ++j) { const int n = (lane >> 3) + 8 * j; const LAS float* s = scr + (8 * c) * 33 + n;
        v4u o; o.x = pk2(s[0 * 33], s[1 * 33]); o.y = pk2(s[2 * 33], s[3 * 33]); o.z = pk2(s[4 * 33], s[5 * 33]); o.w = pk2(s[6 * 33], s[7 * 33]);
        *(GAS v4u*)(J.WT + (size_t)(n0 + n) * J.ldk + J.koff + k0 + 8 * c) = o; }
    LDS_WAIT(); asm volatile("" ::: "memory");
}
__device__ __forceinline__ void ti_load(const TJob& J, int item, int lane, float (&vv)[32], f32x4& ra, f32x4& rb, int& oc) {
    const int nblk = J.Nnew / 32, kb = item / nblk, nb = item % nblk, k0 = 64 * kb, n0 = 32 * nb;
    oc = map_col(J.type, n0 + (lane & 31), J.Nold);
    const int occ = oc >= 0 ? oc : 0;
#pragma unroll
    for (int i = 0; i < 32; ++i) vv[i] = J.W[(size_t)(k0 + 2 * i + (lane >> 5)) * J.Nold + occ];
    ra = (f32x4){1.f, 1.f, 1.f, 1.f}; rb = ra;
    if (J.rowscale) { const f32x4* rp = (const f32x4*)(J.rowscale + k0 + 8 * (lane & 7)); ra = rp[0]; rb = rp[1]; }
}
__device__ __forceinline__ void ti_finish(const TJob& J, LAS float* scr, int item, int lane, const float (&vv)[32], const f32x4 ra, const f32x4 rb, const int oc) {
    const int nblk = J.Nnew / 32, kb = item / nblk, nb = item % nblk, k0 = 64 * kb, n0 = 32 * nb;
#pragma unroll
    for (int i = 0; i < 32; ++i) { const int kk = 2 * i + (lane >> 5); scr[kk * 33 + (lane & 31)] = (oc >= 0) ? vv[i] : 0.f; }
    LDS_WAIT(); asm volatile("" ::: "memory");
    const int c = lane & 7;
#pragma unroll
    for (int j = 0; j < 4; ++j) { const int n = (lane >> 3) + 8 * j; const LAS float* s = scr + (8 * c) * 33 + n;
        v4u o; o.x = pk2(s[0 * 33] * ra[0], s[1 * 33] * ra[1]); o.y = pk2(s[2 * 33] * ra[2], s[3 * 33] * ra[3]); o.z = pk2(s[4 * 33] * rb[0], s[5 * 33] * rb[1]); o.w = pk2(s[6 * 33] * rb[2], s[7 * 33] * rb[3]);
        *(GAS v4u*)(J.WT + (size_t)(n0 + n) * J.ldk + J.koff + k0 + 8 * c) = o; }
    LDS_WAIT(); asm volatile("" ::: "memory");
}
__device__ __forceinline__ void sincos_d(double a, float& sn, float& cs) {
    const double q = rint(a * 0.63661977236758134308);
    double r = a - q * 1.57079632673412561417e+00; r -= q * 6.07710050650619224932e-11;
    const double r2 = r * r;
    double s = 1.0 / 6227020800.0; s = s * r2 - 1.0 / 39916800.0; s = s * r2 + 1.0 / 362880.0; s = s * r2 - 1.0 / 5040.0; s = s * r2 + 1.0 / 120.0; s = s * r2 - 1.0 / 6.0; s = s * r2 * r + r;
    double c = -1.0 / 87178291200.0; c = c * r2 + 1.0 / 479001600.0; c = c * r2 - 1.0 / 3628800.0; c = c * r2 + 1.0 / 40320.0; c = c * r2 - 1.0 / 720.0; c = c * r2 + 1.0 / 24.0; c = c * r2 - 0.5; c = c * r2 + 1.0;
    const int qi = ((int)q) & 3;
    const double ss = (qi == 0) ? s : (qi == 1) ? c : (qi == 2) ? -s : -c;
    const double cc = (qi == 0) ? c : (qi == 1) ? -s : (qi == 2) ? -c : s;
    sn = (float)ss; cs = (float)cc;
}

struct Args { const void* in[24]; float* out; unsigned char* ws; int ph_lo, ph_hi; };
typedef const Args __attribute__((address_space(4)))* argp_t;
__device__ __forceinline__ argp_t get_args() { argp_t p = (argp_t)__builtin_amdgcn_kernarg_segment_ptr(); asm volatile("" : "+s"(p)); return p; }
__device__ __forceinline__ int otid(int wave_s) { return wave_s * 64 + lane_opaque(); }
#define IN_F(k) ((const float*)A_->in[k])
#define PH_LOCALS \
    argp_t A_ = get_args(); unsigned char* const ws = A_->ws; float* const out = A_->out; (void)out; \
    const int tid = otid(wave_s), lane = tid & 63, wave = wave_s; (void)lane; (void)wave; \
    const int G = gridDim.x, bx = blockIdx.x, vcu = (G % 8 == 0) ? (bx % 8) * (G / 8) + bx / 8 : bx; (void)vcu; \
    const int gw = vcu * NWAVES + wave, NGW = G * NWAVES, gt = vcu * (NWAVES * 64) + tid, NGT = G * NWAVES * 64; (void)gw; (void)NGW; (void)gt; (void)NGT; \
    LAS unsigned char* const L = (LAS unsigned char*)lds; (void)L;
#define WSP(T, off) ((T*)(ws + (off)))

__global__ void __launch_bounds__(NWAVES * 64, 2) mega_fwd(Args args) {
    extern __shared__ __attribute__((aligned(16))) unsigned char lds[];
    int lo, hi; XcdBarrier bar;
    const int wave_s = __builtin_amdgcn_readfirstlane((int)threadIdx.x >> 6);
    {
        PH_LOCALS
        volatile LAS unsigned* MISC = (volatile LAS unsigned*)(L + MISC_OFF);
        for (int u = tid; u < (LDS_BYTES - XB_OFF) / 4; u += NWAVES * 64) ((LAS unsigned*)(L + XB_OFF))[u] = 0u;
        __syncthreads();
        bar = xcd_barrier_post((unsigned*)(ws + WS_CTL) + CW_BAR, MISC + 8);
        lo = A_->ph_lo; hi = A_->ph_hi;
    }
#ifndef DBG_REP_TR
#define DBG_REP_TR 1
#endif
#ifndef DBG_REP_HB
#define DBG_REP_HB 1
#endif
#ifndef DBG_REP_FOX
#define DBG_REP_FOX 1
#endif
#ifndef DBG_REP_DSA
#define DBG_REP_DSA 1
#endif
#ifndef DBG_REP_SGU
#define DBG_REP_SGU 1
#endif
#ifndef DBG_REP_POOL
#define DBG_REP_POOL 1
#endif
#ifndef PHMASK
#define PHMASK 0xff7fffu
#endif
#define IN(k) (((PHMASK >> (k)) & 1u) && lo <= (k) && (k) < hi)
#define SEAM(k) do { if (IN(k) && IN((k) + 1)) xcd_barrier(bar); } while (0)
    if (IN(0)) {
        PH_LOCALS
        LAS float* scr = (LAS float*)(L + wave * 16384);
        const float* norm_mix = IN_F(3); const float* norm_ffn = IN_F(4); const float* norm_ple = IN_F(5);
        const float* ffn_w_in = IN_F(6); const float* ffn_w_out = IN_F(9); const float* ple_w_proj = IN_F(10); const float* ple_w_gate = IN_F(11);
        const float* ev_w_in = IN_F(13); const float* ev_w_out = IN_F(14); const float* od_w_in = IN_F(17); const float* od_w_out = IN_F(18);
#define TJ(Wp, RS, WTp, K_, NOLD, NNEW, LDK, KOFF, TYPE) { constexpr int NI_ = ((K_) / 64) * ((NNEW) / 32); if (r < NI_) { const TJob J{(Wp), (RS), (WTp), (K_), (NOLD), (NNEW), (LDK), (KOFF), (TYPE), NI_}; transpose_item(J, scr, r, lane); continue; } r -= NI_; }
        constexpr int NITEMS = 16 * 48 + 8 * 32;
        for (int rep_ = 0; rep_ < DBG_REP_TR; ++rep_) for (int it = gw; it < NITEMS; it += NGW) {
            int r = it;
            TJ(ev_w_in, norm_mix, WSP(bf16, WS_W_EVIN), 1024, 1476, EV_N, 1024, 0, 1)
            TJ(ev_w_out + (size_t)512 * 1024, nullptr, WSP(bf16, WS_W_OUT0), 512, 1024, 1024, 1024, 512, 0)
        }
#undef TJ
        { const float* sgu_w = IN_F(22); bf16* W_SGU = WSP(bf16, WS_W_SGU);
          for (int i = gt; i < 4 * 128 * 128; i += NGT) { const int jj = i & 127, ii = (i >> 7) & 127; W_SGU[i] = (bf16)((ii < 64 && jj >= 64) ? 0u : f2bf(sgu_w[i])); } }
        { const float* x = IN_F(0); bf16* HB = WSP(bf16, WS_HB); float* SSQA = WSP(float, WS_SSQA);
          for (int m = gw; m < TOK; m += 4 * NGW) {
            f32x4 v[4][4];
#pragma unroll
            for (int q = 0; q < 4; ++q) { const int mm = (m + q * NGW < TOK) ? m + q * NGW : m; const f32x4* xr = (const f32x4*)(x + (size_t)mm * DMODEL) + lane;
#pragma unroll
                for (int j = 0; j < 4; ++j) v[q][j] = xr[64 * j]; }
#pragma unroll
            for (int q = 0; q < 4; ++q) { const int mm = m + q * NGW; if (mm < TOK) {
                float s = 0.f; unsigned long long* o8 = (unsigned long long*)(HB + (size_t)mm * DMODEL) + lane;
#pragma unroll
                for (int j = 0; j < 4; ++j) { const f32x4 w = v[q][j]; s += (w.x * w.x + w.y * w.y) + (w.z * w.z + w.w * w.w);
                    o8[64 * j] = (unsigned long long)pk2(w.x, w.y) | ((unsigned long long)pk2(w.z, w.w) << 32); }
                s = wave_sum(s);
                if (lane < 16) SSQA[(size_t)mm * 16 + lane] = (lane == 0) ? s : 0.f; } }
          } }
        { const float* p_in = IN_F(1); bf16* PB = WSP(bf16, WS_PB);
          for (int i = gt; i < TOK * PLE / 4; i += 4 * NGT) { f32x4 v[4];
#pragma unroll
            for (int q = 0; q < 4; ++q) v[q] = ((const f32x4*)p_in)[(i + q * NGT < TOK * PLE / 4) ? i + q * NGT : i];
#pragma unroll
            for (int q = 0; q < 4; ++q) if (i + q * NGT < TOK * PLE / 4) ((unsigned long long*)PB)[i + q * NGT] = (unsigned long long)pk2(v[q].x, v[q].y) | ((unsigned long long)pk2(v[q].z, v[q].w) << 32); } }
        { const int* positions = (const int*)A_->in[2]; f32x2* ROPE = WSP(f32x2, WS_ROPE);
          for (int i = gt; i < TOK * 8; i += NGT) {
            const int row = i >> 3, j = i & 7;
            const float invf = (j == 0) ? 1.0f : (j == 1) ? 0.1939227432012558f : (j == 2) ? 0.03760603070259094f : (j == 3) ? 0.007292664609849453f : (j == 4) ? 0.0014142135623842478f :
                               (j == 5) ? 0.00027424818836152554f : (j == 6) ? 5.3182957344688475e-05f : 1.0313385246263351e-05f;
            const float ang = (float)positions[row] * invf;
            float sn, cs; sincos_d((double)ang, sn, cs);
            ROPE[i] = (f32x2){cs, sn};
          } }
    }
    SEAM(0);
    if (IN(1)) {
        { PH_LOCALS
          pg8::Gemm g{WSP(bf16, WS_HB), WSP(bf16, WS_W_EVIN), TOK, EV_N, 1024}; pg8::StaticOrder S; S.init(TOK, EV_N, G, bx);
          pg8::EpiEvenIn E{WSP(float, WS_SSQA), WSP(bf16, WS_ZH), WSP(const pg8::f32x2, WS_ROPE)};
          pg8::gemm_phase<pg8::EpiEvenIn, pg8::StaticOrder, true, true>(L, g, S, E, wave_s); }
        if (gridDim.x == 256 && blockIdx.x >= 128) {
            PH_LOCALS
            LAS float* scr = (LAS float*)(L + wave * 16384);
            const float* norm_mix = IN_F(3); const float* norm_ffn = IN_F(4); const float* norm_ple = IN_F(5);
            const float* ffn_w_in = IN_F(6); const float* ffn_w_out = IN_F(9); const float* ple_w_proj = IN_F(10); const float* ple_w_gate = IN_F(11);
            const float* od_w_in = IN_F(17); const float* od_w_out = IN_F(18);
#define TJ(Wp, RS, WTp, K_, NOLD, NNEW, LDK, KOFF, TYPE) { constexpr int NI_ = ((K_) / 64) * ((NNEW) / 32); if (r < NI_) { const TJob J{(Wp), (RS), (WTp), (K_), (NOLD), (NNEW), (LDK), (KOFF), (TYPE), NI_}; transpose_item(J, scr, r, lane); continue; } r -= NI_; }
            constexpr int NITEMS_B = (16 * 176 + 44 * 32 + 16 * 32 + 4 * 32) + 16 * 88 + 16 * 32;
            const int gwb = (vcu_of(bx - 128, 128)) * NWAVES + wave, NGWB = 128 * NWAVES;
#define TJR(Wp, RS, WTp, K_, NOLD, NNEW, LDK, KOFF, TYPE) if (!done_) { constexpr int NI_ = ((K_) / 64) * ((NNEW) / 32); if (r_ < NI_) { J_ = TJob{(Wp), (RS), (WTp), (K_), (NOLD), (NNEW), (LDK), (KOFF), (TYPE), NI_}; done_ = true; } else r_ -= NI_; }
#define RESOLVE_B(it_, Jarg_, rarg_) { bool done_ = false; TJob& J_ = (Jarg_); int& r_ = (rarg_); r_ = (it_); \
                TJR(ffn_w_in, norm_ffn, WSP(bf16, WS_W_FFI0), 1024, NFF2, NFF2, 1024, 0, 3) \
                TJR(ffn_w_out, nullptr, WSP(bf16, WS_W_FFO0), DFF, 1024, 1024, DFF, 0, 0) \
                TJR(ple_w_gate, norm_ple, WSP(bf16, WS_W_PG0), 1024, 1024, 1024, 1024, 0, 0) \
                TJR(ple_w_proj, nullptr, WSP(bf16, WS_W_PP0), 256, 1024, 1024, 256, 0, 0) \
                TJR(od_w_in, norm_mix + 1024, WSP(bf16, WS_W_ODIN), 1024, 2568, OD_N, 1024, 0, 2) \
                TJR(od_w_out, nullptr, WSP(bf16, WS_W_OUT1), 1024, 1024, 1024, 1024, 0, 0) }
            {
                int it = gwb, rc = 0, oca = 0; bool hc = it < NITEMS_B; TJob Jc{}; float va[32]; f32x4 raa = {1.f, 1.f, 1.f, 1.f}, rba = raa;
                if (hc) { RESOLVE_B(it, Jc, rc) ti_load(Jc, rc, lane, va, raa, rba, oca); }
                while (hc) {
                    const int itn = it + NGWB; const bool hn = itn < NITEMS_B; TJob Jn{}; int rn = 0, ocb = 0; float vb[32]; f32x4 rab = raa, rbb = rba;
                    if (hn) { RESOLVE_B(itn, Jn, rn) ti_load(Jn, rn, lane, vb, rab, rbb, ocb); }
                    ti_finish(Jc, scr, rc, lane, va, raa, rba, oca);
                    if (hn) {
#pragma unroll
                        for (int i = 0; i < 32; ++i) va[i] = vb[i];
                        Jc = Jn; rc = rn; oca = ocb; raa = rab; rba = rbb;
                    }
                    hc = hn; it = itn;
                }
            }
#undef RESOLVE_B
#undef TJR
#undef TJ
        {
            const float* pool_w = IN_F(15); const float* pool_scale = IN_F(16); const float* ev_w_out = IN_F(14); bf16* W_OUT0 = WSP(bf16, WS_W_OUT0);
            for (int it = gwb; it < 1024; it += NGWB) {
                const int g = it >> 8, nb = (it >> 4) & 15, cb = it & 15, n = 64 * nb + lane;
                {
                    const f32x4* pwg = (const f32x4*)(pool_w + ((size_t)g * 128 + 8 * cb) * 128);
#pragma unroll
                    for (int q = 0; q < 4; ++q) ((LAS f32x4*)scr)[64 * q + lane] = pwg[64 * q + lane];
                    if (lane < 32) ((LAS f32x4*)scr)[256 + lane] = ((const f32x4*)(pool_scale + 128 * g))[lane];
                }
                LDS_WAIT(); asm volatile("" ::: "memory");
                float acc[8];
#pragma unroll
                for (int cc = 0; cc < 8; ++cc) acc[cc] = 0.f;
#pragma unroll 1
                for (int d0 = 0; d0 < 128; d0 += 16) {
                    float wv[16];
#pragma unroll
                    for (int e = 0; e < 16; ++e) wv[e] = ev_w_out[(size_t)(128 * g + d0 + e) * 1024 + n];
#pragma unroll
                    for (int e4 = 0; e4 < 4; ++e4) { const f32x4 sc4 = ((const LAS f32x4*)scr)[256 + (d0 >> 2) + e4];
                        wv[4 * e4] *= sc4[0]; wv[4 * e4 + 1] *= sc4[1]; wv[4 * e4 + 2] *= sc4[2]; wv[4 * e4 + 3] *= sc4[3]; }
#pragma unroll
                    for (int cc = 0; cc < 8; ++cc) {
#pragma unroll
                        for (int e4 = 0; e4 < 4; ++e4) { const f32x4 pw4 = ((const LAS f32x4*)scr)[cc * 32 + (d0 >> 2) + e4];
                            acc[cc] += pw4[0] * wv[4 * e4] + pw4[1] * wv[4 * e4 + 1] + pw4[2] * wv[4 * e4 + 2] + pw4[3] * wv[4 * e4 + 3]; }
                    }
                }
#pragma unroll
                for (int c2 = 0; c2 < 4; ++c2) *(unsigned*)(W_OUT0 + (size_t)n * 1024 + 128 * g + 8 * cb + 2 * c2) = pk2(acc[2 * c2], acc[2 * c2 + 1]);
                LDS_WAIT(); asm volatile("" ::: "memory");
            }
        }
        }
    }
    SEAM(1);
    if (IN(2)) {
        { PH_LOCALS
          const bf16* ZH = WSP(bf16, WS_ZH); bf16* Y = WSP(bf16, WS_Y); const unsigned lds0 = (unsigned)(uintptr_t)lds;
          for (int pi = vcu; pi < 256; pi += G) {
            const int b = pi >> 5, s = pi & 31;
#pragma unroll 1
            for (int k = 0; k < 2 * DBG_REP_DSA; ++k) mix::dsa_unit(b, (k & 1) ? s : 63 - s, ZH, Y, (char*)lds, lds0, wave_s);
          } }
        { PH_LOCALS
          const bf16* ZH = WSP(bf16, WS_ZH); bf16* Y = WSP(bf16, WS_Y);
          for (int rep_ = 0; rep_ < DBG_REP_POOL; ++rep_) for (int it = gt; it < TOK * 64; it += NGT) mix::pool_item(it, ZH, Y);
        }
        { PH_LOCALS
          const float* p1 = IN_F(1) + (size_t)TOK * PLE; bf16* PB1 = (bf16*)out + (size_t)16 * 1024 * 1024;
          for (int i = gt; i < TOK * PLE / 4; i += 4 * NGT) { f32x4 v[4];
#pragma unroll
              for (int q = 0; q < 4; ++q) v[q] = ((const f32x4*)p1)[(i + q * NGT < TOK * PLE / 4) ? i + q * NGT : i];
#pragma unroll
              for (int q = 0; q < 4; ++q) if (i + q * NGT < TOK * PLE / 4) ((unsigned long long*)PB1)[i + q * NGT] = (unsigned long long)pk2(v[q].x, v[q].y) | ((unsigned long long)pk2(v[q].z, v[q].w) << 32); }
        }
    }
    SEAM(2);
    {
        const size_t s1o = (0 == 0) ? WS_SSQA : WS_SSQB, s2o = (0 == 0) ? WS_SSQB : WS_SSQA, s3o = s1o;
        if (IN(3)) {
            PH_LOCALS
            pg8::Gemm g{WSP(bf16, WS_Y), WSP(bf16, (0 == 0) ? WS_W_OUT0 : WS_W_OUT1), TOK, 1024, 1024}; pg8::StaticOrder S; S.init(TOK, 1024, G, bx);
            pg8::EpiRes E{nullptr, WSP(bf16, WS_HB), WSP(bf16, WS_HB), WSP(float, s1o), WSP(bf16, WS_AHALO)};
            pg8::gemm_phase<pg8::EpiRes, pg8::StaticOrder, true, true>(L, g, S, E, wave_s);
        }
        SEAM(3);
        if (IN(3 + 2)) {
            PH_LOCALS
            pg8::Gemm g{WSP(bf16, WS_HB), WSP(bf16, WS_W_FFI0), TOK + 256, NFF2, 1024}; pg8::StaticOrder S; S.init(TOK, NFF2, G, bx);
            if (G == 256 && !(bx >= 128 && bx < 128 + NFF2 / 256)) {
                LAS float* scr = (LAS float*)(L + wave * 16384);
                const float* ffn_w_out = IN_F(9); const float* ple_w_proj = IN_F(10);
#define TJ(Wp, RS, WTp, K_, NOLD, NNEW, LDK, KOFF, TYPE) { constexpr int NI_ = ((K_) / 64) * ((NNEW) / 32); if (r < NI_) { const TJob J{(Wp), (RS), (WTp), (K_), (NOLD), (NNEW), (LDK), (KOFF), (TYPE), NI_}; transpose_item(J, scr, r, lane); continue; } r -= NI_; }
                const int wgi = bx < 128 ? bx : bx - 22;
                for (int it = wgi * NWAVES + wave; it < 44 * 32 + 4 * 32; it += 234 * NWAVES) {
                    int r = it;
                    TJ(ffn_w_out + (size_t)DFF * 1024, nullptr, WSP(bf16, WS_W_FFO1), DFF, 1024, 1024, DFF, 0, 0)
                    TJ(ple_w_proj + (size_t)256 * 1024, nullptr, WSP(bf16, WS_W_PP1), 256, 1024, 1024, 256, 0, 0)
                }
#undef TJ
                asm volatile("s_waitcnt vmcnt(0) lgkmcnt(0)" ::: "memory"); __syncthreads();
            }
#ifdef STAGGER
            if (STAGGER_COND) { for (int i_ = 0; i_ < STAGGER; ++i_) __builtin_amdgcn_s_sleep(127); }
#endif
            if (G == 256 && bx >= 128 && bx < 128 + NFF2 / 256) {
                pg8::OneUnit S1{64, bx - 128, 1};
                pg8::EpiHaloF EH{WSP(float, s1o), WSP(float, WS_AH), (unsigned*)(ws + WS_CTL) + CW_FLAG + 2048 * 0};
                pg8::gemm_phase<pg8::EpiHaloF, pg8::OneUnit, true, true>(L, g, S1, EH, wave_s);
            }
#ifdef PP_FIRST
            if (G == 256 && bx >= 150) {
                pg8::Gemm gp{WSP(bf16, WS_PB), WSP(bf16, WS_W_PP0), TOK, 1024, PLE}; pg8::StaticOrder SP; SP.init(TOK, 1024, 106, bx - 150);
                pg8::EpiBf16Plain EP{WSP(bf16, WS_PP), 1024};
                pg8::gemm_phase<pg8::EpiBf16Plain, pg8::StaticOrder, true, true>(L, gp, SP, EP, wave_s);
            }
#endif
            pg8::EpiFfnIn E{WSP(float, s1o), IN_F(7) + (size_t)0 * 3 * NFF2, IN_F(8) + (size_t)0 * NFF2, WSP(float, WS_AH), WSP(bf16, WS_ZH), (LAS float*)(L + XB_OFF), (unsigned*)(ws + WS_CTL) + CW_FLAG + 2048 * 0, 1u};
            pg8::gemm_phase<pg8::EpiFfnIn, pg8::StaticOrder, true, true>(L, g, S, E, wave_s);
#ifndef PP_FIRST
            if (G == 256 && bx >= 150) {
                pg8::Gemm gp{WSP(bf16, WS_PB), WSP(bf16, WS_W_PP0), TOK, 1024, PLE}; pg8::StaticOrder SP; SP.init(TOK, 1024, 106, bx - 150);
                pg8::EpiBf16Plain EP{WSP(bf16, WS_PP), 1024};
                pg8::gemm_phase<pg8::EpiBf16Plain, pg8::StaticOrder, true, true>(L, gp, SP, EP, wave_s);
            }
#endif
        }
        SEAM(3 + 2);
        if (IN(3 + 3)) {
            PH_LOCALS
            pg8::Gemm g{WSP(bf16, WS_ZH), WSP(bf16, (0 == 0) ? WS_W_FFO0 : WS_W_FFO1), TOK, 1024, DFF}; pg8::StaticOrder S; S.init(TOK, 1024, G, bx);
            pg8::EpiRes E{nullptr, WSP(bf16, WS_HB), WSP(bf16, WS_HB), WSP(float, s2o), nullptr};
            pg8::gemm_phase<pg8::EpiRes, pg8::StaticOrder, true, true>(L, g, S, E, wave_s);
        }
        SEAM(3 + 3);
        if (IN(3 + 4)) {
            PH_LOCALS
            pg8::Gemm g{WSP(bf16, WS_HB), WSP(bf16, (0 == 0) ? WS_W_PG0 : WS_W_PG1), TOK, 1024, 1024}; pg8::StaticOrder S; S.init(TOK, 1024, G, bx);
            pg8::EpiGate E{WSP(float, s2o), WSP(bf16, WS_HB), WSP(bf16, WS_PP), (bf16*)out, WSP(float, s3o)};
            pg8::gemm_phase<pg8::EpiGate, pg8::StaticOrder, true, true>(L, g, S, E, wave_s);
        }
        SEAM(3 + 4);
    }
    {

            if (IN(8)) {
                { PH_LOCALS
                  pg8::Gemm g{(const bf16*)out, WSP(bf16, WS_W_ODIN), TOK, OD_N, 1024}; pg8::StaticOrder S; S.init(TOK, OD_N, G, bx);
                  pg8::EpiOddIn E{WSP(float, WS_SSQA), WSP(bf16, WS_ZH), WSP(float, WS_FBUF), WSP(float, WS_SST)};
                  pg8::gemm_phase<pg8::EpiOddIn, pg8::StaticOrder, true, true>(L, g, S, E, wave_s); }
                if (gridDim.x == 256 && blockIdx.x >= 192) {
                    PH_LOCALS
                    LAS float* scr = (LAS float*)(L + wave * 16384);
                    const float* norm_ffn = IN_F(4); const float* norm_ple = IN_F(5); const float* ffn_w_in = IN_F(6); const float* ple_w_gate = IN_F(11);
#define TJ(Wp, RS, WTp, K_, NOLD, NNEW, LDK, KOFF, TYPE) { constexpr int NI_ = ((K_) / 64) * ((NNEW) / 32); if (r < NI_) { const TJob J{(Wp), (RS), (WTp), (K_), (NOLD), (NNEW), (LDK), (KOFF), (TYPE), NI_}; transpose_item(J, scr, r, lane); continue; } r -= NI_; }
                    constexpr int NITEMS_C = 16 * 176 + 16 * 32;
                    const int gwc = (bx - 192) * NWAVES + wave, NGWC = 64 * NWAVES;
                    for (int it = gwc; it < NITEMS_C; it += NGWC) {
                        int r = it;
                        TJ(ffn_w_in + (size_t)1024 * NFF2, norm_ffn + 1024, WSP(bf16, WS_W_FFI1), 1024, NFF2, NFF2, 1024, 0, 3)
                        TJ(ple_w_gate + (size_t)1024 * 1024, norm_ple + 1024, WSP(bf16, WS_W_PG1), 1024, 1024, 1024, 1024, 0, 0)
                    }
#undef TJ
                }
            }
            SEAM(8);
            if (IN(9)) {
                { PH_LOCALS
                  const bf16* ZH = WSP(bf16, WS_ZH); bf16* Y = WSP(bf16, WS_Y); const unsigned lds0 = (unsigned)(uintptr_t)lds;
                  const float* FBUF = WSP(float, WS_FBUF); const float* fox_b_f = IN_F(19);
                  for (int pi = vcu; pi < 256; pi += G) {
                    const int bh = pi >> 2, s = pi & 3;
#pragma unroll 1
                    for (int k = 0; k < 2 * DBG_REP_FOX; ++k) mix::fox_unit2(bh >> 3, bh & 7, (k & 1) ? s : 7 - s, ZH, FBUF, fox_b_f, Y, (char*)lds, wave_s);
                  } }
                { PH_LOCALS
                  const bf16* ZH = WSP(bf16, WS_ZH); bf16* Y = WSP(bf16, WS_Y);
                  for (int rep_ = 0; rep_ < DBG_REP_SGU; ++rep_) for (int u = vcu; u < 512; u += G) mix::sgu_unit(u >> 6, (u >> 2) & 15, u & 3, ZH, WSP(float, WS_SST), IN_F(20), IN_F(21), WSP(bf16, WS_W_SGU), IN_F(23), Y, (char*)lds, wave_s); }
            }
            SEAM(9);
            }
    {
        const size_t s1o = (1 == 0) ? WS_SSQA : WS_SSQB, s2o = (1 == 0) ? WS_SSQB : WS_SSQA, s3o = s1o;
        if (IN(10)) {
            PH_LOCALS
            pg8::Gemm g{WSP(bf16, WS_Y), WSP(bf16, (1 == 0) ? WS_W_OUT0 : WS_W_OUT1), TOK, 1024, 1024}; pg8::StaticOrder S; S.init(TOK, 1024, G, bx);
            pg8::EpiRes E{nullptr, (const bf16*)out, WSP(bf16, WS_HB), WSP(float, s1o), WSP(bf16, WS_AHALO)};
            pg8::gemm_phase<pg8::EpiRes, pg8::StaticOrder, true, true>(L, g, S, E, wave_s);
        }
        SEAM(10);
        if (IN(10 + 2)) {
            PH_LOCALS
            pg8::Gemm g{WSP(bf16, WS_HB), WSP(bf16, WS_W_FFI1), TOK + 256, NFF2, 1024}; pg8::StaticOrder S; S.init(TOK, NFF2, G, bx);
#ifdef STAGGER
            if (STAGGER_COND) { for (int i_ = 0; i_ < STAGGER; ++i_) __builtin_amdgcn_s_sleep(127); }
#endif
            if (G == 256 && bx >= 128 && bx < 128 + NFF2 / 256) {
                pg8::OneUnit S1{64, bx - 128, 1};
                pg8::EpiHaloF EH{WSP(float, s1o), WSP(float, WS_AH), (unsigned*)(ws + WS_CTL) + CW_FLAG + 2048 * 1};
                pg8::gemm_phase<pg8::EpiHaloF, pg8::OneUnit, true, true>(L, g, S1, EH, wave_s);
            }
#ifdef PP_FIRST
            if (G == 256 && bx >= 150) {
                pg8::Gemm gp{(const bf16*)out + (size_t)16 * 1024 * 1024, WSP(bf16, WS_W_PP1), TOK, 1024, PLE}; pg8::StaticOrder SP; SP.init(TOK, 1024, 106, bx - 150);
                pg8::EpiBf16Plain EP{WSP(bf16, WS_PP), 1024};
                pg8::gemm_phase<pg8::EpiBf16Plain, pg8::StaticOrder, true, true>(L, gp, SP, EP, wave_s);
            }
#endif
            pg8::EpiFfnIn E{WSP(float, s1o), IN_F(7) + (size_t)1 * 3 * NFF2, IN_F(8) + (size_t)1 * NFF2, WSP(float, WS_AH), WSP(bf16, WS_ZH), (LAS float*)(L + XB_OFF), (unsigned*)(ws + WS_CTL) + CW_FLAG + 2048 * 1, 2u};
            pg8::gemm_phase<pg8::EpiFfnIn, pg8::StaticOrder, true, true>(L, g, S, E, wave_s);
#ifndef PP_FIRST
            if (G == 256 && bx >= 150) {
                pg8::Gemm gp{(const bf16*)out + (size_t)16 * 1024 * 1024, WSP(bf16, WS_W_PP1), TOK, 1024, PLE}; pg8::StaticOrder SP; SP.init(TOK, 1024, 106, bx - 150);
                pg8::EpiBf16Plain EP{WSP(bf16, WS_PP), 1024};
                pg8::gemm_phase<pg8::EpiBf16Plain, pg8::StaticOrder, true, true>(L, gp, SP, EP, wave_s);
            }
#endif
        }
        SEAM(10 + 2);
        if (IN(10 + 3)) {
            PH_LOCALS
            pg8::Gemm g{WSP(bf16, WS_ZH), WSP(bf16, (1 == 0) ? WS_W_FFO0 : WS_W_FFO1), TOK, 1024, DFF}; pg8::StaticOrder S; S.init(TOK, 1024, G, bx);
            pg8::EpiRes E{nullptr, WSP(bf16, WS_HB), WSP(bf16, WS_HB), WSP(float, s2o), nullptr};
            pg8::gemm_phase<pg8::EpiRes, pg8::StaticOrder, true, true>(L, g, S, E, wave_s);
        }
        SEAM(10 + 3);
        if (IN(10 + 4)) {
            PH_LOCALS
            pg8::Gemm g{WSP(bf16, WS_HB), WSP(bf16, (1 == 0) ? WS_W_PG0 : WS_W_PG1), TOK, 1024, 1024}; pg8::StaticOrder S; S.init(TOK, 1024, G, bx);
            pg8::EpiGateFinal E{WSP(float, s2o), WSP(bf16, WS_HB), WSP(bf16, WS_PP), WSP(float, s3o), (unsigned*)(ws + WS_CTL) + CW_PAN, IN_F(12), out, (LAS float*)(L + XB_OFF) + 2048};
            pg8::gemm_phase<pg8::EpiGateFinal, pg8::StaticOrder, true, true>(L, g, S, E, wave_s);
        }
        SEAM(10 + 4);
    }
    if (IN(15)) {
        PH_LOCALS
        const float* SSQB = WSP(float, WS_SSQB); const float* norm_final = IN_F(12); const bf16* H6 = WSP(bf16, WS_Y);
        for (int m = gw; m < TOK; m += 4 * NGW) {
            unsigned long long w[4][4]; float rs[4];
#pragma unroll
            for (int q = 0; q < 4; ++q) { const int mm = (m + q * NGW < TOK) ? m + q * NGW : m; rs[q] = pg8::row_rstd(SSQB, mm);
                const unsigned long long* hr = (const unsigned long long*)(H6 + (size_t)mm * DMODEL) + lane;
#pragma unroll
                for (int j = 0; j < 4; ++j) w[q][j] = hr[64 * j]; }
            const f32x4* gr = (const f32x4*)norm_final + lane;
            f32x4 gg[4];
#pragma unroll
            for (int j = 0; j < 4; ++j) gg[j] = gr[64 * j];
#pragma unroll
            for (int q = 0; q < 4; ++q) { const int mm = m + q * NGW; if (mm < TOK) { f32x4* xr = (f32x4*)(out + (size_t)mm * DMODEL) + lane;
#pragma unroll
                for (int j = 0; j < 4; ++j) { const unsigned long long ww = w[q][j];
                    const f32x4 v = {pg8::bf_lo((unsigned)ww), pg8::bf_hi((unsigned)ww), pg8::bf_lo((unsigned)(ww >> 32)), pg8::bf_hi((unsigned)(ww >> 32))};
                    __builtin_nontemporal_store(v * rs[q] * gg[j], xr + 64 * j); } } }
        }
    }
#undef IN
#undef SEAM
}

#ifndef MK_N_LAUNCHES
#define MK_N_LAUNCHES 1
#endif
constexpr int N_PHASES = 16;
extern "C" void kernel_launch(void* const* d_in, const int* in_sizes, int n_in, void* d_out, int out_size, void* d_ws, size_t ws_size, hipStream_t stream) {
    static int grid = 0;
    if (grid == 0) {
        if (n_in != 24 || out_size != TOK * DMODEL || ws_size < WS_END) { fprintf(stderr, "kernel_launch: unexpected shapes (n_in %d, out %d, ws %zu)\n", n_in, out_size, ws_size); grid = -1; return; }
        int dev = 0, cus = 0;
        if (hipGetDevice(&dev) != hipSuccess || hipDeviceGetAttribute(&cus, hipDeviceAttributeMultiprocessorCount, dev) != hipSuccess) { grid = -1; return; }
        if (hipFuncSetAttribute((const void*)mega_fwd, hipFuncAttributeMaxDynamicSharedMemorySize, LDS_BYTES) != hipSuccess) { fprintf(stderr, "kernel_launch: hipFuncSetAttribute failed\n"); grid = -1; return; }
        int per_cu = 0;
        if (hipOccupancyMaxActiveBlocksPerMultiprocessor(&per_cu, (const void*)mega_fwd, NWAVES * 64, LDS_BYTES) != hipSuccess || per_cu < 1) { fprintf(stderr, "kernel_launch: occupancy query says %d\n", per_cu); }
        (void)hipGetLastError();
        grid = cus;
    }
    if (grid < 0) return;
    (void)hipMemsetAsync((char*)d_ws + WS_CTL, 0, CTL_ZERO_BYTES, stream);
    Args a{};
    for (int i = 0; i < 24; ++i) a.in[i] = d_in[i];
    a.out = (float*)d_out; a.ws = (unsigned char*)d_ws;
#ifdef DBG_CHECK
    {
        using namespace dbg;
        auto LP = [&](int ph) { a.ph_lo = ph; a.ph_hi = ph + 1; hipLaunchKernelGGL(mega_fwd, dim3(grid), dim3(NWAVES * 64), LDS_BYTES, stream, a); };
        char* wsb = (char*)d_ws; float* ERR = (float*)(wsb + 512 * 1024); float* SNAP = (float*)(wsb + 600 * 1024); float* outp = (float*)d_out;
        const unsigned short* ZHp = (const unsigned short*)(wsb + WS_ZH); const unsigned short* Yp = (const unsigned short*)(wsb + WS_Y); const float* FB = (const float*)(wsb + WS_FBUF);
        const unsigned short* HBp = (const unsigned short*)(wsb + WS_HB); const unsigned short* H3p = (const unsigned short*)d_out;
        auto F = [&](int i) { return (const float*)d_in[i]; };
        const float* x = F(0);
        LP(0); LP(1);
        k_evenin<<<NS, 256, 0, stream>>>(x, F(3), F(13), (const int*)d_in[2], ZHp, ERR, 0);
        LP(2);
        k_pool<<<NS, 256, 0, stream>>>(ZHp, Yp, ERR, 1);
        k_dsa<<<NS, 256, 0, stream>>>(ZHp, Yp, ERR, 2);
        LP(3);
        k_outproj<<<NS, 256, 0, stream>>>(x, 0, SNAP, Yp, F(14), F(15), F(16), HBp, ERR, 3);
        for (int layer = 0; layer < 2; ++layer) {
            const int pb = layer ? 10 : 3, kb = layer ? 10 : 3;
            if (layer == 1) {
                LP(8);
                k_oddin<<<NS, 256, 0, stream>>>(H3p, F(3) + 1024, F(17), ZHp, FB, ERR, 7);
                LP(9);
                k_fox<<<NS, 256, 0, stream>>>(ZHp, FB, F(19), Yp, ERR, 8);
                k_sgu<<<NS, 256, 0, stream>>>(ZHp, F(20), F(21), F(22), F(23), Yp, ERR, 9);
                k_snap<<<NS, 256, 0, stream>>>(H3p, SNAP);
                LP(10);
                k_outproj<<<NS, 256, 0, stream>>>(nullptr, 1, SNAP, Yp, F(18), nullptr, nullptr, HBp, ERR, 10);
            }
            LP(pb + 1); LP(pb + 2);
            k_ffnin<<<NS, 256, 0, stream>>>(HBp, F(4) + 1024 * layer, F(6) + (size_t)layer * 1024 * NFF2, F(7) + (size_t)layer * 3 * NFF2, F(8) + (size_t)layer * NFF2, ZHp, ERR, kb + 1);
            k_snap<<<NS, 256, 0, stream>>>(HBp, SNAP);
            LP(pb + 3);
            k_ffnout<<<NS, 256, 0, stream>>>(SNAP, ZHp, F(9) + (size_t)layer * DFF * 1024, HBp, ERR, kb + 2);
            k_snap<<<NS, 256, 0, stream>>>(HBp, SNAP);
            LP(pb + 4);
            k_ple<<<NS, 256, 0, stream>>>(SNAP, F(1) + (size_t)layer * TOK * PLE, F(5) + 1024 * layer, F(10) + (size_t)layer * PLE * 1024, F(11) + (size_t)layer * 1024 * 1024, layer ? Yp : H3p, ERR, kb + 3);
        }
        k_snap<<<NS, 256, 0, stream>>>(Yp, SNAP);
        LP(15);
        k_final<<<NS, 256, 0, stream>>>(SNAP, F(12), outp, ERR, 14);
        t_dpp<<<1, 64, 0, stream>>>(ERR + 40);
        k_report<<<1024, 256, 0, stream>>>(ERR, 15, DBG_TOL, outp);
        return;
    }
#endif
    if (MK_N_LAUNCHES == 1) {
        a.ph_lo = 0; a.ph_hi = N_PHASES;
        hipLaunchKernelGGL(mega_fwd, dim3(grid), dim3(NWAVES * 64), LDS_BYTES, stream, a);
    } else {
#ifndef DBG_STOP
#define DBG_STOP N_PHASES
#endif
#ifndef DBG_DOUBLE
#define DBG_DOUBLE -1
#endif
        for (int ph = 0; ph < DBG_STOP; ++ph) { a.ph_lo = ph; a.ph_hi = ph + 1; const int reps = (ph == DBG_DOUBLE || (DBG_DOUBLE == 100 && (ph == 0 || ph == 1 || ph == 2 || ph == 4 || ph == 5 || ph == 8 || ph == 9 || ph == 11 || ph == 12))) ? 2 : 1;
            for (int r = 0; r < reps; ++r) hipLaunchKernelGGL(mega_fwd, dim3(grid), dim3(NWAVES * 64), LDS_BYTES, stream, a); }
    }
}
```

```cpp
#include <hip/hip_runtime.h>
#include <hip/hip_bf16.h>
#include <cstdio>
#include <cstdint>
#include <cmath>
constexpr int TOK = 16384, DMODEL = 1024, SEQ = 2048, NBATCH = 8;
constexpr int DFF = 2816, NFF2 = 5632, PLE = 256;
constexpr int EV_N = 1536;
constexpr int OD_N = 2816;
constexpr int Z1P = 2560;
constexpr float RMS_EPS = 1e-6f;
constexpr float C2 = 0.125f * 1.4426950408889634f;


__device__ __forceinline__ int lane_opaque() { unsigned z = 0u; asm volatile("" : "+v"(z)); return (int)__builtin_amdgcn_mbcnt_hi(~0u, __builtin_amdgcn_mbcnt_lo(~0u, z)); }
__device__ __forceinline__ float xor16_f(float v) { return __builtin_bit_cast(float, __builtin_amdgcn_ds_swizzle(__builtin_bit_cast(int, v), 0x401F)); }
__device__ __forceinline__ void halves_pair(unsigned v, unsigned& a, unsigned& b) { unsigned w = v; asm volatile("" : "+v"(w)); auto rr = __builtin_amdgcn_permlane32_swap(v, w, false, false); a = rr[0]; b = rr[1]; }
__device__ __forceinline__ float halves_sum_f(float v) { unsigned a, b; halves_pair(__builtin_bit_cast(unsigned, v), a, b); return __builtin_bit_cast(float, a) + __builtin_bit_cast(float, b); }
__device__ __forceinline__ float halves_max_f(float v) { unsigned a, b; halves_pair(__builtin_bit_cast(unsigned, v), a, b); return __builtin_fmaxf(__builtin_bit_cast(float, a), __builtin_bit_cast(float, b)); }
__device__ __forceinline__ unsigned halves_add_u(unsigned v) { unsigned a, b; halves_pair(v, a, b); return a + b; }
__device__ __forceinline__ unsigned halves_or_u(unsigned v) { unsigned a, b; halves_pair(v, a, b); return a | b; }
namespace pg8 {
#define PG8_LAS __attribute__((address_space(3)))
typedef unsigned short bf16_t;
typedef short bf16x8 __attribute__((ext_vector_type(8)));
typedef float f32x4 __attribute__((ext_vector_type(4)));
typedef unsigned u32x4 __attribute__((ext_vector_type(4)));
constexpr int BM = 256, BK = 64, HALF = 128, HTB = HALF * BK * 2  , STAGE_BYTES = 8 * HTB, NXCD = 8, WGM = 8;

__host__ __device__ __forceinline__ int lds_byte(int r, int c) { const int st = (r >> 4) * 2 + (c >> 5), rr = r & 15, cc = c & 31, ob = rr * 64 + cc * 2; return st * 1024 + (ob ^ (((ob >> 9) & 1) << 5)); }
__host__ __device__ __forceinline__ void stage_rc(int b, int& R, int& C) { const int st = b / 1024, sb = b % 1024, swz = sb ^ (((sb >> 9) & 1) << 5); R = (st >> 1) * 16 + swz / 64; C = (st & 1) * 32 + (swz % 64) / 2; }
__host__ __device__ __forceinline__ int perm32(int rho) { const int n = rho >> 4, i = rho & 15; return 8 * (i >> 2) + 4 * n + (i & 3); }

struct Unit { int pm, pn; };
struct Gemm { const bf16_t* A; const bf16_t* Bt; int M, N, K; };

struct StaticOrder {
    int nM, nN, nwg, G, c;
    __host__ __device__ void init(int M, int N, int G_, int c_) { nM = M / BM; nN = N / BM; nwg = nM * nN; G = G_; c = c_; }
    __host__ __device__ __forceinline__ bool next(int i, Unit& u) const {
        const long L = (long)i * G + c; if (L >= nwg) return false;
        int wgid = (int)L; { const int q = nwg / NXCD, r = nwg % NXCD, xcd = wgid % NXCD, off = wgid / NXCD; wgid = (xcd < r ? xcd * (q + 1) : r * (q + 1) + (xcd - r) * q) + off; }
        const int nig = WGM * nN, gid = wgid / nig, fm = gid * WGM, gsz = (nM - fm) < WGM ? (nM - fm) : WGM;
        u.pm = fm + ((wgid % nig) % gsz); u.pn = (wgid % nig) / gsz; return true;
    }
    __device__ __forceinline__ void a_ready(const Unit&) const {}
    __device__ __forceinline__ void done(const Unit&) const {}
};

struct PanelOrder {
    StaticOrder S0; unsigned* cnt; unsigned need; int wv; bool acq;
    __host__ __device__ __forceinline__ bool next(int i, Unit& u) const { return S0.next(i, u); }
    __device__ __forceinline__ void a_ready(const Unit& u) const {
        if (wv == 0) {
            unsigned sp = 0;
            while (__hip_atomic_load(cnt + 64 * u.pm, __ATOMIC_RELAXED, __HIP_MEMORY_SCOPE_AGENT) < need) { __builtin_amdgcn_s_sleep(2); if (++sp > (1u << 22)) break; }
            if (acq) { __builtin_amdgcn_fence(__ATOMIC_ACQUIRE, "agent"); asm volatile("s_waitcnt vmcnt(0)" ::: "memory"); }
        }
        asm volatile("" ::: "memory"); __builtin_amdgcn_s_barrier(); asm volatile("" ::: "memory");
    }
    __device__ __forceinline__ void done(const Unit&) const {}
};
struct OneUnit {
    int pm, pn, on;
    __host__ __device__ bool next(int i, Unit& u) const { if (!on || i != 0) return false; u.pm = pm; u.pn = pn; return true; }
    __device__ __forceinline__ void a_ready(const Unit&) const {}
    __device__ __forceinline__ void done(const Unit&) const {}
};
struct FfnOrder {
    StaticOrder S0; int extra;
    __host__ __device__ void init(int M, int N, int G_, int c_) { S0.init(M, N, G_, c_); extra = (G_ == 256 && c_ >= 128 && c_ < 128 + N / BM) ? 1 : 0; }
    __host__ __device__ bool next(int i, Unit& u) const { if (extra) { if (i == 0) { u.pm = 64; u.pn = S0.c - 128; return true; } return S0.next(i - 1, u); } return S0.next(i, u); }
    __device__ __forceinline__ void a_ready(const Unit&) const {}
    __device__ __forceinline__ void done(const Unit&) const {}
};
typedef float f32x2 __attribute__((ext_vector_type(2)));
typedef unsigned u32x2 __attribute__((ext_vector_type(2)));
__device__ __forceinline__ unsigned cvt_pk_bf16(float lo, float hi) { unsigned r; asm volatile("v_cvt_pk_bf16_f32 %0, %1, %2" : "=v"(r) : "v"(lo), "v"(hi)); return r; }
__device__ __forceinline__ float bf_lo(unsigned w) { return __builtin_bit_cast(float, w << 16); }
__device__ __forceinline__ float bf_hi(unsigned w) { return __builtin_bit_cast(float, w & 0xffff0000u); }
__device__ __forceinline__ float sq4(const f32x4 v) { return (v[0] * v[0] + v[1] * v[1]) + (v[2] * v[2] + v[3] * v[3]); }
__device__ __forceinline__ float row_rstd(const float* ssq, int row) {
    const f32x4* p = (const f32x4*)(ssq + (size_t)row * 16);
    const f32x4 a = p[0], b = p[1], c = p[2], d = p[3];
    const float s = (((a[0] + a[1]) + (a[2] + a[3])) + ((b[0] + b[1]) + (b[2] + b[3]))) + (((c[0] + c[1]) + (c[2] + c[3])) + ((d[0] + d[1]) + (d[2] + d[3])));
    return 1.0f / sqrtf(s * (1.0f / 1024.0f) + RMS_EPS);
}
__device__ __forceinline__ float row_rstd_coh(const float* ssq, int row) {
    const float* p = ssq + (size_t)row * 16;
    f32x4 a, b, c, d;
    asm volatile("global_load_dwordx4 %0, %4, off sc1\n\tglobal_load_dwordx4 %1, %4, off offset:16 sc1\n\tglobal_load_dwordx4 %2, %4, off offset:32 sc1\n\tglobal_load_dwordx4 %3, %4, off offset:48 sc1\n\ts_waitcnt vmcnt(0)"
                 : "=&v"(a), "=&v"(b), "=&v"(c), "=&v"(d) : "v"(p) : "memory");
    const float s = (((a[0] + a[1]) + (a[2] + a[3])) + ((b[0] + b[1]) + (b[2] + b[3]))) + (((c[0] + c[1]) + (c[2] + c[3])) + ((d[0] + d[1]) + (d[2] + d[3])));
    return 1.0f / sqrtf(s * (1.0f / 1024.0f) + RMS_EPS);
}
__device__ __forceinline__ void ssq_write(float* ssq_out, float q, int row, int slot, int fq) {
    q += xor16_f(q); q = halves_sum_f(q);
    if (fq == 0) ssq_out[(size_t)row * 16 + slot] = q;
}
typedef float f32x2 __attribute__((ext_vector_type(2)));
__device__ __forceinline__ f32x2 gelu_mul2(const f32x2 x, const f32x2 c) {
    const f32x2 x2 = x * x;
    const f32x2 a = x * (x2 * (-2.3022082f * 0.044715f) + (-2.3022082f));
    f32x2 e; e.x = __builtin_amdgcn_exp2f(a.x); e.y = __builtin_amdgcn_exp2f(a.y);
    const f32x2 d = e + 1.0f;
    f32x2 r; r.x = __builtin_amdgcn_rcpf(d.x); r.y = __builtin_amdgcn_rcpf(d.y);
    return (x * c) * r;
}
__device__ __forceinline__ float gelu_tanh(float x) {
    const float t = x + 0.044715f * x * x * x;
    const float e = __builtin_amdgcn_exp2f(-2.3022082f * t);
    return x * __builtin_amdgcn_rcpf(1.0f + e);
}
__device__ __forceinline__ float sigmoid_f(float x) { return __builtin_amdgcn_rcpf(1.0f + __builtin_amdgcn_exp2f(-1.4426950408889634f * x)); }


struct EpiRes {
    static constexpr bool PERM = true, AFTER_DRAIN = false;
    const float* basef; const bf16_t* baseb; bf16_t* hb; float* ssq_out; bf16_t* ahalo; unsigned* pub; bool pub_fence;
    __device__ __forceinline__ void operator()(const f32x4 (&acc)[2][2][4][2], const Unit& u_, int wr, int wc, int fr, int fq) const {
        Unit u; { int pm_ = u_.pm, pn_ = u_.pn; asm volatile("" : "+s"(pm_), "+s"(pn_)); u.pm = pm_; u.pn = pn_; }
        const int row0 = u.pm * BM + wr * 64 + fr, col0 = u.pn * BM + wc * 32 + 8 * fq;
        if (basef != nullptr) {
#pragma unroll
            for (int ai = 0; ai < 2; ++ai)
#pragma unroll
                for (int m = 0; m < 4; ++m) {
                    const int row = row0 + ai * HALF + m * 16; float q = 0.f;
#pragma unroll
                    for (int bj = 0; bj < 2; ++bj) {
                        const size_t off = (size_t)row * DMODEL + col0 + bj * HALF;
                        const f32x4 b0 = *(const f32x4*)(basef + off), b1 = *(const f32x4*)(basef + off + 4);
                        const f32x4 v0 = acc[ai][bj][m][0] + b0, v1 = acc[ai][bj][m][1] + b1;
                        q += sq4(v0) + sq4(v1);
                        u32x4 w; w.x = cvt_pk_bf16(v0[0], v0[1]); w.y = cvt_pk_bf16(v0[2], v0[3]); w.z = cvt_pk_bf16(v1[0], v1[1]); w.w = cvt_pk_bf16(v1[2], v1[3]);
                        *(u32x4*)(hb + off) = w;
                        if (ahalo != nullptr && ai == 1 && m == 3) {
                            const int rl = row & 255;
                            if (rl >= 254 && u.pm < 63) *(u32x4*)(ahalo + (size_t)(2 * (u.pm + 1) + (rl - 254)) * DMODEL + col0 + bj * HALF) = w;
                        }
                    }
                    ssq_write(ssq_out, q, row, u.pn * 4 + wc, fq);
                    if (m & 1) asm volatile("" ::: "memory");
                }
        } else {
            u32x4 bwa[2][4][2];
#pragma unroll
            for (int ai = 0; ai < 2; ++ai)
#pragma unroll
                for (int m = 0; m < 4; ++m)
#pragma unroll
                    for (int bj = 0; bj < 2; ++bj) bwa[ai][m][bj] = *(const u32x4*)(baseb + (size_t)(row0 + ai * HALF + m * 16) * DMODEL + col0 + bj * HALF);
            asm volatile("" ::: "memory");
#pragma unroll
            for (int ai = 0; ai < 2; ++ai) {
#pragma unroll
                for (int m = 0; m < 4; ++m) {
                    const int row = row0 + ai * HALF + m * 16; float q = 0.f;
#pragma unroll
                    for (int bj = 0; bj < 2; ++bj) {
                        const size_t off = (size_t)row * DMODEL + col0 + bj * HALF;
                        const u32x4 pw = bwa[ai][m][bj];
                        const f32x4 b0 = {bf_lo(pw.x), bf_hi(pw.x), bf_lo(pw.y), bf_hi(pw.y)}, b1 = {bf_lo(pw.z), bf_hi(pw.z), bf_lo(pw.w), bf_hi(pw.w)};
                        const f32x4 v0 = acc[ai][bj][m][0] + b0, v1 = acc[ai][bj][m][1] + b1;
                        q += sq4(v0) + sq4(v1);
                        u32x4 w; w.x = cvt_pk_bf16(v0[0], v0[1]); w.y = cvt_pk_bf16(v0[2], v0[3]); w.z = cvt_pk_bf16(v1[0], v1[1]); w.w = cvt_pk_bf16(v1[2], v1[3]);
                        *(u32x4*)(hb + off) = w;
                        if (ahalo != nullptr && ai == 1 && m == 3) {
                            const int rl = row & 255;
                            if (rl >= 254 && u.pm < 63) *(u32x4*)(ahalo + (size_t)(2 * (u.pm + 1) + (rl - 254)) * DMODEL + col0 + bj * HALF) = w;
                        }
                    }
                    ssq_write(ssq_out, q, row, u.pn * 4 + wc, fq);
                }
                asm volatile("" ::: "memory");
            }
        }
        if (pub != nullptr) {
            asm volatile("s_waitcnt vmcnt(0)" ::: "memory"); __builtin_amdgcn_s_barrier(); asm volatile("" ::: "memory");
            if (wr == 0 && wc == 0 && fr == 0 && fq == 0) {
                if (pub_fence) { __builtin_amdgcn_fence(__ATOMIC_RELEASE, "agent"); asm volatile("s_waitcnt vmcnt(0)" ::: "memory"); }
                __hip_atomic_fetch_add(pub + 64 * u.pm, 1u, __ATOMIC_RELAXED, __HIP_MEMORY_SCOPE_AGENT);
            }
        }
    }
};
#ifndef DBG_REP_EPG
#define DBG_REP_EPG 1
#endif
struct EpiGate {
    static constexpr bool PERM = true, AFTER_DRAIN = false;
    const float* ssq_in; const bf16_t* base; const bf16_t* pp; bf16_t* dst; float* ssq_out; PG8_LAS float* rtab;
    __device__ __forceinline__ void operator()(const f32x4 (&acc)[2][2][4][2], const Unit& u_, int wr, int wc, int fr, int fq) const {
        Unit u; { int pm_ = u_.pm, pn_ = u_.pn; asm volatile("" : "+s"(pm_), "+s"(pn_)); u.pm = pm_; u.pn = pn_; }
        const int row0 = u.pm * BM + wr * 64 + fr, col0 = u.pn * BM + wc * 32 + 8 * fq;
#pragma unroll 1
        for (int rep_ = 0; rep_ < DBG_REP_EPG; ++rep_) {
        if (wr == 0) rtab[wc * 64 + fq * 16 + fr] = row_rstd(ssq_in, u.pm * BM + wc * 64 + fq * 16 + fr);
#pragma unroll
        for (int ai = 0; ai < 2; ++ai) {
                u32x4 bw[4][2], pq[4][2];
#pragma unroll
                for (int m = 0; m < 4; ++m) {
                    const int row = row0 + ai * HALF + m * 16;
#pragma unroll
                    for (int bj = 0; bj < 2; ++bj) { const size_t off = (size_t)row * DMODEL + col0 + bj * HALF; bw[m][bj] = *(const u32x4*)(base + off); pq[m][bj] = *(const u32x4*)(pp + off); }
                }
                if (ai == 0) { asm volatile("s_waitcnt lgkmcnt(0)" ::: "memory"); __builtin_amdgcn_s_barrier(); }
                asm volatile("" ::: "memory");
#pragma unroll
                for (int m = 0; m < 4; ++m) {
                    const int row = row0 + ai * HALF + m * 16; float q = 0.f;
                    const float rs = rtab[ai * HALF + wr * 64 + m * 16 + fr];
#pragma unroll
                    for (int bj = 0; bj < 2; ++bj) {
                        const size_t off = (size_t)row * DMODEL + col0 + bj * HALF;
                        const u32x4 b_ = bw[m][bj], p_ = pq[m][bj];
                        const float bb[8] = {bf_lo(b_.x), bf_hi(b_.x), bf_lo(b_.y), bf_hi(b_.y), bf_lo(b_.z), bf_hi(b_.z), bf_lo(b_.w), bf_hi(b_.w)};
                        const float pv[8] = {bf_lo(p_.x), bf_hi(p_.x), bf_lo(p_.y), bf_hi(p_.y), bf_lo(p_.z), bf_hi(p_.z), bf_lo(p_.w), bf_hi(p_.w)};
                        const f32x4 g0 = acc[ai][bj][m][0] * rs, g1 = acc[ai][bj][m][1] * rs;
                        const float gg[8] = {g0[0], g0[1], g0[2], g0[3], g1[0], g1[1], g1[2], g1[3]};
                        float v[8];
#pragma unroll
                        for (int i = 0; i < 8; ++i) { v[i] = bb[i] + pv[i] * sigmoid_f(gg[i]); q += v[i] * v[i]; }
                        u32x4 w; w.x = cvt_pk_bf16(v[0], v[1]); w.y = cvt_pk_bf16(v[2], v[3]); w.z = cvt_pk_bf16(v[4], v[5]); w.w = cvt_pk_bf16(v[6], v[7]);
                        *(u32x4*)(dst + off) = w;
                    }
                    ssq_write(ssq_out, q, row, u.pn * 4 + wc, fq);
                }
                asm volatile("" ::: "memory");
        }
        if (DBG_REP_EPG > 1) { asm volatile("s_waitcnt lgkmcnt(0)" ::: "memory"); __builtin_amdgcn_s_barrier(); }
        }
    }
};
struct EpiGateFinal {
    static constexpr bool PERM = true, AFTER_DRAIN = false;
    const float* ssq_in; const bf16_t* base; const bf16_t* pp; float* ssq_out; unsigned* cnt; const float* gain; float* outp; PG8_LAS float* rtab; bool pub_fence;
    __device__ __forceinline__ void operator()(const f32x4 (&acc)[2][2][4][2], const Unit& u_, int wr, int wc, int fr, int fq) const {
        Unit u; { int pm_ = u_.pm, pn_ = u_.pn; asm volatile("" : "+s"(pm_), "+s"(pn_)); u.pm = pm_; u.pn = pn_; }
        const int row0 = u.pm * BM + wr * 64 + fr, col0 = u.pn * BM + wc * 32 + 8 * fq;
        f32x4 hv[2][2][4][2];
        if (wr == 0) rtab[wc * 64 + fq * 16 + fr] = row_rstd(ssq_in, u.pm * BM + wc * 64 + fq * 16 + fr);
#pragma unroll
        for (int ai = 0; ai < 2; ++ai) {
                u32x4 bw[4][2], pq[4][2];
#pragma unroll
                for (int m = 0; m < 4; ++m) {
                    const int row = row0 + ai * HALF + m * 16;
#pragma unroll
                    for (int bj = 0; bj < 2; ++bj) { const size_t off = (size_t)row * DMODEL + col0 + bj * HALF; bw[m][bj] = *(const u32x4*)(base + off); pq[m][bj] = *(const u32x4*)(pp + off); }
                }
                if (ai == 0) { asm volatile("s_waitcnt lgkmcnt(0)" ::: "memory"); __builtin_amdgcn_s_barrier(); }
                asm volatile("" ::: "memory");
#pragma unroll
                for (int m = 0; m < 4; ++m) {
                    const int row = row0 + ai * HALF + m * 16; float q = 0.f;
                    const float rsm = rtab[ai * HALF + wr * 64 + m * 16 + fr];
#pragma unroll
                    for (int bj = 0; bj < 2; ++bj) {
                        const u32x4 b_ = bw[m][bj], p_ = pq[m][bj];
                        const float bb[8] = {bf_lo(b_.x), bf_hi(b_.x), bf_lo(b_.y), bf_hi(b_.y), bf_lo(b_.z), bf_hi(b_.z), bf_lo(b_.w), bf_hi(b_.w)};
                        const float pv[8] = {bf_lo(p_.x), bf_hi(p_.x), bf_lo(p_.y), bf_hi(p_.y), bf_lo(p_.z), bf_hi(p_.z), bf_lo(p_.w), bf_hi(p_.w)};
                        const f32x4 g0 = acc[ai][bj][m][0] * rsm, g1 = acc[ai][bj][m][1] * rsm;
                        const float gg[8] = {g0[0], g0[1], g0[2], g0[3], g1[0], g1[1], g1[2], g1[3]};
                        float v[8];
#pragma unroll
                        for (int i = 0; i < 8; ++i) { v[i] = bb[i] + pv[i] * sigmoid_f(gg[i]); q += v[i] * v[i]; }
                        hv[ai][bj][m][0] = (f32x4){v[0], v[1], v[2], v[3]}; hv[ai][bj][m][1] = (f32x4){v[4], v[5], v[6], v[7]};
                    }
                    ssq_write(ssq_out, q, row, u.pn * 4 + wc, fq);
                }
                asm volatile("" ::: "memory");
            }
        asm volatile("s_waitcnt vmcnt(0)" ::: "memory"); __builtin_amdgcn_s_barrier(); asm volatile("" ::: "memory");
        if (wr == 0 && wc == 0) {
            if (fr == 0 && fq == 0) {
                if (pub_fence) { __builtin_amdgcn_fence(__ATOMIC_RELEASE, "agent"); asm volatile("s_waitcnt vmcnt(0)" ::: "memory"); }
                __hip_atomic_fetch_add(cnt + 64 * u.pm, 1u, __ATOMIC_RELAXED, __HIP_MEMORY_SCOPE_AGENT);
            }
            unsigned sp = 0;
            while (__hip_atomic_load(cnt + 64 * u.pm, __ATOMIC_RELAXED, __HIP_MEMORY_SCOPE_AGENT) < 4u) { __builtin_amdgcn_s_sleep(2); if (++sp > (1u << 22)) break; }
        }
        asm volatile("" ::: "memory"); __builtin_amdgcn_s_barrier(); asm volatile("" ::: "memory");
        if (wr == 0) rtab[wc * 64 + fq * 16 + fr] = row_rstd_coh(ssq_out, u.pm * BM + wc * 64 + fq * 16 + fr);
        asm volatile("s_waitcnt lgkmcnt(0)" ::: "memory"); __builtin_amdgcn_s_barrier(); asm volatile("" ::: "memory");
        f32x4 gn[2][2];
#pragma unroll
        for (int bj = 0; bj < 2; ++bj)
#pragma unroll
            for (int n = 0; n < 2; ++n) gn[bj][n] = *(const f32x4*)(gain + col0 + bj * HALF + 4 * n);
#pragma unroll
        for (int ai = 0; ai < 2; ++ai)
#pragma unroll
            for (int m = 0; m < 4; ++m) {
                const float rsf = rtab[ai * HALF + wr * 64 + m * 16 + fr];
                float* orow = outp + (size_t)(row0 + ai * HALF + m * 16) * DMODEL + col0;
#pragma unroll
                for (int bj = 0; bj < 2; ++bj)
#pragma unroll
                    for (int n = 0; n < 2; ++n) *(f32x4*)(orow + bj * HALF + 4 * n) = hv[ai][bj][m][n] * rsf * gn[bj][n];
            }
    }
};
struct EpiBf16Plain {
    static constexpr bool PERM = true, AFTER_DRAIN = false;
    bf16_t* O; int ldc;
    __device__ __forceinline__ void operator()(const f32x4 (&acc)[2][2][4][2], const Unit& u_, int wr, int wc, int fr, int fq) const {
        Unit u; { int pm_ = u_.pm, pn_ = u_.pn; asm volatile("" : "+s"(pm_), "+s"(pn_)); u.pm = pm_; u.pn = pn_; }
        const int row0 = u.pm * BM + wr * 64 + fr, col0 = u.pn * BM + wc * 32 + 8 * fq;
#pragma unroll
        for (int ai = 0; ai < 2; ++ai)
#pragma unroll
            for (int m = 0; m < 4; ++m) {
                const int row = row0 + ai * HALF + m * 16;
#pragma unroll
                for (int bj = 0; bj < 2; ++bj) {
                    const f32x4 v0 = acc[ai][bj][m][0], v1 = acc[ai][bj][m][1];
                    u32x4 w; w.x = cvt_pk_bf16(v0[0], v0[1]); w.y = cvt_pk_bf16(v0[2], v0[3]); w.z = cvt_pk_bf16(v1[0], v1[1]); w.w = cvt_pk_bf16(v1[2], v1[3]);
                    *(u32x4*)(O + (size_t)row * ldc + col0 + bj * HALF) = w;
                }
            }
    }
};
struct EpiEvenIn {
    static constexpr bool PERM = true, AFTER_DRAIN = false;
    const float* ssq_in; bf16_t* Z; const f32x2* rope;
    __device__ __forceinline__ void operator()(const f32x4 (&acc)[2][2][4][2], const Unit& u_, int wr, int wc, int fr, int fq) const {
        Unit u; { int pm_ = u_.pm, pn_ = u_.pn; asm volatile("" : "+s"(pm_), "+s"(pn_)); u.pm = pm_; u.pn = pn_; }
        const int row0 = u.pm * BM + wr * 64 + fr, colw = wc * 32 + 8 * fq;
        const int pn = u.pn;
        const float sc = (pn == 2 || pn == 3) ? C2 : 1.0f;
#pragma unroll
        for (int ai = 0; ai < 2; ++ai)
#pragma unroll
            for (int m = 0; m < 4; ++m) {
                const int row = row0 + ai * HALF + m * 16;
                const float rs = row_rstd(ssq_in, row);
#pragma unroll
                for (int bj = 0; bj < 2; ++bj) {
                    const int gi = 2 * bj + (wc >> 1);
                    const bool ropeg = (pn == 2 || pn == 3 || pn == 5 || (pn == 4 && (gi == 0 || gi == 2))) && ((wc & 1) == 0);
                    f32x4 v0 = acc[ai][bj][m][0] * rs, v1 = acc[ai][bj][m][1] * rs;
                    if (ropeg && fq < 2) {
                        const f32x4* rp = (const f32x4*)(rope + (size_t)row * 8 + 4 * fq);
                        const f32x4 ra = rp[0], rb = rp[1];
                        f32x4 o0, o1;
                        o0[0] = v0[0] * ra[0] - v0[1] * ra[1]; o0[1] = v0[1] * ra[0] + v0[0] * ra[1];
                        o0[2] = v0[2] * ra[2] - v0[3] * ra[3]; o0[3] = v0[3] * ra[2] + v0[2] * ra[3];
                        o1[0] = v1[0] * rb[0] - v1[1] * rb[1]; o1[1] = v1[1] * rb[0] + v1[0] * rb[1];
                        o1[2] = v1[2] * rb[2] - v1[3] * rb[3]; o1[3] = v1[3] * rb[2] + v1[2] * rb[3];
                        v0 = o0; v1 = o1;
                    }
                    v0 = v0 * sc; v1 = v1 * sc;
                    u32x4 w; w.x = cvt_pk_bf16(v0[0], v0[1]); w.y = cvt_pk_bf16(v0[2], v0[3]); w.z = cvt_pk_bf16(v1[0], v1[1]); w.w = cvt_pk_bf16(v1[2], v1[3]);
                    *(u32x4*)(Z + (size_t)row * EV_N + pn * BM + bj * HALF + colw) = w;
                }
            }
    }
};
struct EpiOddIn {
    static constexpr bool PERM = true, AFTER_DRAIN = false;
    const float* ssq_in; bf16_t* Z; float* F; float* sst;
    __device__ __forceinline__ void operator()(const f32x4 (&acc)[2][2][4][2], const Unit& u_, int wr, int wc, int fr, int fq) const {
        Unit u; { int pm_ = u_.pm, pn_ = u_.pn; asm volatile("" : "+s"(pm_), "+s"(pn_)); u.pm = pm_; u.pn = pn_; }
        const int row0 = u.pm * BM + wr * 64 + fr, colw = wc * 32 + 8 * fq;
        const int pn = u.pn;
        const float sc = (pn < 2) ? C2 : 1.0f;
        const bool act = (pn >= 6 && pn < 10), stat = (pn == 8 || pn == 9);
#pragma unroll
        for (int ai = 0; ai < 2; ++ai)
#pragma unroll
            for (int m = 0; m < 4; ++m) {
                const int row = row0 + ai * HALF + m * 16;
                const float rs = row_rstd(ssq_in, row);
                if (pn == 10) {
                    if (wc == 0 && fq == 0) { *(f32x4*)(F + (size_t)row * 8) = acc[ai][0][m][0] * rs; *(f32x4*)(F + (size_t)row * 8 + 4) = acc[ai][0][m][1] * rs; }
                    continue;
                }
                float s1 = 0.f, s2 = 0.f;
#pragma unroll
                for (int bj = 0; bj < 2; ++bj) {
                    f32x4 v0 = acc[ai][bj][m][0] * (rs * sc), v1 = acc[ai][bj][m][1] * (rs * sc);
                    if (act) {
#pragma unroll
                        for (int i = 0; i < 4; ++i) { v0[i] = gelu_tanh(v0[i]); v1[i] = gelu_tanh(v1[i]); }
                    }
                    s1 += ((v0[0] + v0[1]) + (v0[2] + v0[3])) + ((v1[0] + v1[1]) + (v1[2] + v1[3])); s2 += sq4(v0) + sq4(v1);
                    u32x4 w; w.x = cvt_pk_bf16(v0[0], v0[1]); w.y = cvt_pk_bf16(v0[2], v0[3]); w.z = cvt_pk_bf16(v1[0], v1[1]); w.w = cvt_pk_bf16(v1[2], v1[3]);
                    *(u32x4*)(Z + (size_t)row * Z1P + pn * BM + bj * HALF + colw) = w;
                }
                if (stat) {
                    s1 += xor16_f(s1); s1 = halves_sum_f(s1); s2 += xor16_f(s2); s2 = halves_sum_f(s2);
                    if (fq == 0) *(f32x2*)(sst + ((size_t)row * 8 + (pn - 8) * 4 + wc) * 2) = (f32x2){s1, s2};
                }
            }
    }
};
struct EpiHalo {
    static constexpr bool PERM = true, AFTER_DRAIN = false;
    const float* ssq_in; float* AH;
    __device__ __forceinline__ void operator()(const f32x4 (&acc)[2][2][4][2], const Unit& u_, int wr, int wc, int fr, int fq) const {
        Unit u; { int pm_ = u_.pm, pn_ = u_.pn; asm volatile("" : "+s"(pm_), "+s"(pn_)); u.pm = pm_; u.pn = pn_; }
        const int col0 = u.pn * BM + wc * 32 + 8 * fq;
#pragma unroll
        for (int m = 0; m < 4; ++m) {
            const int rh = wr * 64 + m * 16 + fr;
            if (rh < 2) continue;
            const int tok = 256 * (rh >> 1) - 2 + (rh & 1);
            const float rs = row_rstd(ssq_in, tok);
#pragma unroll
            for (int bj = 0; bj < 2; ++bj) {
                *(f32x4*)(AH + (size_t)rh * NFF2 + col0 + bj * HALF) = acc[0][bj][m][0] * rs;
                *(f32x4*)(AH + (size_t)rh * NFF2 + col0 + bj * HALF + 4) = acc[0][bj][m][1] * rs;
            }
        }
    }
};
template <int SEL> __device__ __forceinline__ float dpp1(const float old, const float src) {
    const int o = __builtin_bit_cast(int, old), s = __builtin_bit_cast(int, src); int t;
    if (SEL == 0) t = __builtin_amdgcn_update_dpp(o, s, 0x111, 0xf, 0xf, false);
    else if (SEL == 1) t = __builtin_amdgcn_update_dpp(o, s, 0x112, 0xf, 0xf, false);
    else if (SEL == 2) t = __builtin_amdgcn_update_dpp(o, s, 0x10F, 0xf, 0xf, false);
    else t = __builtin_amdgcn_update_dpp(o, s, 0x10E, 0xf, 0xf, false);
    return __builtin_bit_cast(float, t);
}
template <int SEL> __device__ __forceinline__ f32x4 dpp4t(const f32x4 old, const f32x4 src) {
    const float o0 = old[0], o1 = old[1], o2 = old[2], o3 = old[3], s0 = src[0], s1 = src[1], s2 = src[2], s3 = src[3];
    const float r0 = dpp1<SEL>(o0, s0), r1 = dpp1<SEL>(o1, s1), r2 = dpp1<SEL>(o2, s2), r3 = dpp1<SEL>(o3, s3);
    return (f32x4){r0, r1, r2, r3};
}
#define dpp4(old, src, sel) dpp4t<sel>(old, src)
__device__ __forceinline__ void conv_taps(f32x4& c, const f32x4 cur, const f32x4 prev, const f32x4 w0, const f32x4 w1) {
    float c0 = c[0], c1 = c[1], c2 = c[2], c3 = c[3];
    const float x0 = cur[0], x1 = cur[1], x2 = cur[2], x3 = cur[3], p0 = prev[0], p1 = prev[1], p2 = prev[2], p3 = prev[3];
    const float a0 = w1[0], a1 = w1[1], a2 = w1[2], a3 = w1[3], b0 = w0[0], b1 = w0[1], b2 = w0[2], b3 = w0[3];
    asm("s_nop 4\n\t"
        "v_fmac_f32_dpp %0, %4, %12 row_shr:1 row_mask:0xf bank_mask:0xf bound_ctrl:1\n\t"
        "v_fmac_f32_dpp %1, %5, %13 row_shr:1 row_mask:0xf bank_mask:0xf bound_ctrl:1\n\t"
        "v_fmac_f32_dpp %2, %6, %14 row_shr:1 row_mask:0xf bank_mask:0xf bound_ctrl:1\n\t"
        "v_fmac_f32_dpp %3, %7, %15 row_shr:1 row_mask:0xf bank_mask:0xf bound_ctrl:1\n\t"
        "v_fmac_f32_dpp %0, %4, %16 row_shr:2 row_mask:0xf bank_mask:0xf bound_ctrl:1\n\t"
        "v_fmac_f32_dpp %1, %5, %17 row_shr:2 row_mask:0xf bank_mask:0xf bound_ctrl:1\n\t"
        "v_fmac_f32_dpp %2, %6, %18 row_shr:2 row_mask:0xf bank_mask:0xf bound_ctrl:1\n\t"
        "v_fmac_f32_dpp %3, %7, %19 row_shr:2 row_mask:0xf bank_mask:0xf bound_ctrl:1\n\t"
        "v_fmac_f32_dpp %0, %8, %12 row_shl:15 row_mask:0xf bank_mask:0xf bound_ctrl:1\n\t"
        "v_fmac_f32_dpp %1, %9, %13 row_shl:15 row_mask:0xf bank_mask:0xf bound_ctrl:1\n\t"
        "v_fmac_f32_dpp %2, %10, %14 row_shl:15 row_mask:0xf bank_mask:0xf bound_ctrl:1\n\t"
        "v_fmac_f32_dpp %3, %11, %15 row_shl:15 row_mask:0xf bank_mask:0xf bound_ctrl:1\n\t"
        "v_fmac_f32_dpp %0, %8, %16 row_shl:14 row_mask:0xf bank_mask:0xf bound_ctrl:1\n\t"
        "v_fmac_f32_dpp %1, %9, %17 row_shl:14 row_mask:0xf bank_mask:0xf bound_ctrl:1\n\t"
        "v_fmac_f32_dpp %2, %10, %18 row_shl:14 row_mask:0xf bank_mask:0xf bound_ctrl:1\n\t"
        "v_fmac_f32_dpp %3, %11, %19 row_shl:14 row_mask:0xf bank_mask:0xf bound_ctrl:1"
        : "+v"(c0), "+v"(c1), "+v"(c2), "+v"(c3)
        : "v"(x0), "v"(x1), "v"(x2), "v"(x3), "v"(p0), "v"(p1), "v"(p2), "v"(p3), "v"(a0), "v"(a1), "v"(a2), "v"(a3), "v"(b0), "v"(b1), "v"(b2), "v"(b3));
    c[0] = c0; c[1] = c1; c[2] = c2; c[3] = c3;
}
struct EpiHaloF {
    static constexpr bool PERM = true, AFTER_DRAIN = false;
    const float* ssq_in; float* ah; unsigned* flags;
    __device__ __forceinline__ void operator()(const f32x4 (&acc)[2][2][4][2], const Unit& u_, int wr, int wc, int fr, int fq) const {
        Unit u; { int pm_ = u_.pm, pn_ = u_.pn; asm volatile("" : "+s"(pm_), "+s"(pn_)); u.pm = pm_; u.pn = pn_; }
        const int col0 = u.pn * BM + wc * 32 + 8 * fq;
#pragma unroll
        for (int m = 0; m < 4; ++m) {
            const int rh = wr * 64 + m * 16 + fr;
            if (rh >= 2) {
                const int tok = 256 * (rh >> 1) - 2 + (rh & 1);
                const float rsh = row_rstd(ssq_in, tok);
#pragma unroll
                for (int bj = 0; bj < 2; ++bj) {
                    *(f32x4*)(ah + (size_t)rh * NFF2 + col0 + bj * HALF) = acc[0][bj][m][0] * rsh;
                    *(f32x4*)(ah + (size_t)rh * NFF2 + col0 + bj * HALF + 4) = acc[0][bj][m][1] * rsh;
                }
            }
        }
        asm volatile("s_waitcnt vmcnt(0)" ::: "memory"); __builtin_amdgcn_s_barrier(); asm volatile("" ::: "memory");
        if (wr == 0 && wc == 0 && fr == 0 && fq == 0) {
            __builtin_amdgcn_fence(__ATOMIC_RELEASE, "agent");
            asm volatile("s_waitcnt vmcnt(0)" ::: "memory");
            __hip_atomic_store(flags + 64 * u.pn, 1u, __ATOMIC_RELAXED, __HIP_MEMORY_SCOPE_AGENT);
        }
    }
};
struct EpiFfnIn {
    static constexpr bool PERM = true, AFTER_DRAIN = false;
    const float* ssq_in; const float* cw; const float* cb; float* ah; bf16_t* hid; PG8_LAS float* xb; unsigned* flags; unsigned phase_id;
    __device__ __forceinline__ void operator()(const f32x4 (&acc)[2][2][4][2], const Unit& u_, int wr, int wc, int fr, int fq) const {
        Unit u; { int pm_ = u_.pm, pn_ = u_.pn; asm volatile("" : "+s"(pm_), "+s"(pn_)); u.pm = pm_; u.pn = pn_; }
        PG8_LAS float* rtab = xb + 2048;
        const int row0 = u.pm * BM + wr * 64 + fr;
        PG8_LAS float* cwl = xb + 2432 + wc * 256;
        PG8_LAS float* hl = xb + 3456 + wc * 128;
        if (wr == 0) {
            const float* src = (fq < 3 ? cw + fq * NFF2 : cb) + (fr >> 3) * DFF + 128 * u.pn + wc * 32 + (fr & 7) * 4;
            const f32x4 wv = *(const f32x4*)src;
            rtab[wc * 64 + fq * 16 + fr] = row_rstd(ssq_in, u.pm * BM + wc * 64 + fq * 16 + fr);
            *(PG8_LAS f32x4*)(cwl + (fq * 16 + fr) * 4) = wv;
        }
        if (fr >= 14) {
#pragma unroll
            for (int ai = 0; ai < 2; ++ai) {
                PG8_LAS f32x4* dst = (PG8_LAS f32x4*)(xb + ((((ai * 2 + wr) * 4 + wc) * 2 + (fr - 14)) * 4 + fq) * 16);
#pragma unroll
                for (int bj = 0; bj < 2; ++bj)
#pragma unroll
                    for (int n = 0; n < 2; ++n) dst[bj * 2 + n] = acc[ai][bj][3][n];
            }
        }
        asm volatile("s_waitcnt lgkmcnt(0)" ::: "memory"); __builtin_amdgcn_s_barrier(); asm volatile("" ::: "memory");
        const bool has = (u.pm & 7) != 0;
        if (wr == 0) {
            PG8_LAS unsigned* stamp = (PG8_LAS unsigned*)(rtab + 256);
            if (*(volatile PG8_LAS unsigned*)stamp != phase_id) {
                if (wc == 0) {
                    { unsigned sp = 0; const int lt = fq * 16 + fr; const int tt = lt < NFF2 / BM ? lt : 0;
                      for (;;) { const unsigned fv = __hip_atomic_load(flags + 64 * tt, __ATOMIC_RELAXED, __HIP_MEMORY_SCOPE_AGENT);
                          if (__builtin_amdgcn_ballot_w64(fv == 0u) == 0ull) break;
                          __builtin_amdgcn_s_sleep(2); if (++sp > (1u << 22)) break; } }
                    asm volatile("s_waitcnt vmcnt(0)" ::: "memory");
                    if (fr == 0 && fq == 0) *(volatile PG8_LAS unsigned*)stamp = phase_id;
                } else {
                    unsigned sp = 0;
                    while (*(volatile PG8_LAS unsigned*)stamp != phase_id) { __builtin_amdgcn_s_sleep(2); if (++sp > (1u << 22)) break; }
                }
            }
        }
        if (wr == 0) {
            f32x2 hv = {0.f, 0.f};
            if (has) hv = *(const f32x2*)(ah + (size_t)(2 * u.pm + (fq >> 1)) * NFF2 + (size_t)u.pn * BM + (fq & 1) * HALF + wc * 32 + 2 * fr);
            *(PG8_LAS f32x2*)(hl + (fq * 16 + fr) * 2) = hv;
        }
        float rs[2][4];
#pragma unroll
        for (int ai = 0; ai < 2; ++ai)
#pragma unroll
            for (int m = 0; m < 4; ++m) rs[ai][m] = rtab[ai * HALF + wr * 64 + m * 16 + fr];
        const f32x4 zero4 = {0.f, 0.f, 0.f, 0.f};
#pragma unroll
        for (int ai = 0; ai < 2; ++ai) {
#pragma unroll
            for (int n = 0; n < 2; ++n) {
                f32x4 cg[4];
#pragma unroll
                for (int bj = 0; bj < 2; ++bj) {
                    f32x4 b0, b1;
                    if (ai == 0 && wr == 0) {
                        b0 = *(const PG8_LAS f32x4*)(hl + (0 * 2 + bj) * 32 + 8 * fq + 4 * n);
                        b1 = *(const PG8_LAS f32x4*)(hl + (1 * 2 + bj) * 32 + 8 * fq + 4 * n);
                    } else {
                        const int sa = (wr == 1) ? ai : ai - 1, sw = (wr == 1) ? 0 : 1;
                        const float r0 = rtab[sa * HALF + sw * 64 + 62], r1 = rtab[sa * HALF + sw * 64 + 63];
                        b0 = *(const PG8_LAS f32x4*)(xb + ((((sa * 2 + sw) * 4 + wc) * 2 + 0) * 4 + fq) * 16 + (bj * 2 + n) * 4) * r0;
                        b1 = *(const PG8_LAS f32x4*)(xb + ((((sa * 2 + sw) * 4 + wc) * 2 + 1) * 4 + fq) * 16 + (bj * 2 + n) * 4) * r1;
                    }
                    const int oc = bj * 32 + 8 * fq + 4 * n;
                    const f32x4 w0 = *(const PG8_LAS f32x4*)(cwl + oc), w1 = *(const PG8_LAS f32x4*)(cwl + 64 + oc), w2 = *(const PG8_LAS f32x4*)(cwl + 128 + oc), bb = *(const PG8_LAS f32x4*)(cwl + 192 + oc);
                    f32x4 prev = (fr == 14) ? b0 : b1;
#pragma unroll
                    for (int m = 0; m < 4; ++m) {
                        const f32x4 cur = acc[ai][bj][m][n] * rs[ai][m];
                        f32x4 c = w2 * cur + bb;
                        conv_taps(c, cur, prev, w0, w1);
                        prev = cur;
                        if (bj == 0) cg[m] = c;
                        else {
                            const f32x2 ha = gelu_mul2((f32x2){cg[m][0], cg[m][1]}, (f32x2){c[0], c[1]}), hb = gelu_mul2((f32x2){cg[m][2], cg[m][3]}, (f32x2){c[2], c[3]});
                            u32x2 w; w.x = cvt_pk_bf16(ha.x, ha.y); w.y = cvt_pk_bf16(hb.x, hb.y);
                            const int row = row0 + ai * HALF + m * 16;
                            *(u32x2*)(hid + (size_t)row * DFF + 128 * u.pn + wc * 32 + 8 * fq + 4 * n) = w;
                        }
                    }
                    asm volatile("" ::: "memory");
                }
            }
        }
    }
};
template <class Epi, class Sched, bool ALIGN_EPI = false, bool SP2 = false>
__device__ __forceinline__ void gemm_phase(PG8_LAS unsigned char* lds, const Gemm g, const Sched& S, const Epi& E, const int wave_s) {
    const int tid_ = wave_s * 64 + lane_opaque(); const int tid = tid_, wid = __builtin_amdgcn_readfirstlane(tid >> 6), lane = tid & 63, wr = wid >> 2, wc = wid & 3, fr = lane & 15, fq = lane >> 4;
    const int K = g.K, nt = K / BK;
    unsigned voffA[2], voffB[2];
#pragma unroll
    for (int i = 0; i < 2; ++i) { int R, C; stage_rc(tid * 16 + i * 8192, R, C); const int Rb = Epi::PERM ? ((R & ~31) + perm32(R & 31)) : R;
        voffA[i] = (unsigned)(R * K + C) * 2u; voffB[i] = (unsigned)(Rb * K + C) * 2u; }
    const size_t kstep = (size_t)(BK * 2);
    const size_t hstep = (size_t)HALF * K * 2;
    const size_t tstep = 2 * hstep;
    const unsigned ldsw = (unsigned)wid * 1024u;
    const int aoff = lds_byte(wr * 64 + fr, fq * 8), boff = lds_byte(wc * 32 + fr, fq * 8);
#define PG8_SA(b, h) (((b) * 2 + (h)) * HTB)
#define PG8_SB(b, h) ((4 + (b) * 2 + (h)) * HTB)
#define PG8_STAGE(bufoff, gbase, voff) do { _Pragma("unroll") for (int _i = 0; _i < 2; ++_i) \
        __builtin_amdgcn_global_load_lds((const unsigned*)((const char*)(gbase) + (voff)[_i]), (PG8_LAS unsigned*)(lds + (bufoff) + ldsw + _i * 8192), 16, 0, 0); } while (0)
#define PG8_LDA(dst, b, h) do { _Pragma("unroll") for (int m = 0; m < 4; ++m) _Pragma("unroll") for (int k = 0; k < 2; ++k) dst[m][k] = *(const PG8_LAS bf16x8*)(lds + PG8_SA(b, h) + aoff + m * 2048 + k * 1024); } while (0)
#define PG8_LDB(dst, b, h) do { _Pragma("unroll") for (int n = 0; n < 2; ++n) _Pragma("unroll") for (int k = 0; k < 2; ++k) dst[n][k] = *(const PG8_LAS bf16x8*)(lds + PG8_SB(b, h) + boff + n * 2048 + k * 1024); } while (0)
#define PG8_MMA(ai, bj, At, Bt) do { __builtin_amdgcn_s_setprio(1); _Pragma("unroll") for (int m = 0; m < 4; ++m) _Pragma("unroll") for (int n = 0; n < 2; ++n) _Pragma("unroll") for (int k = 0; k < 2; ++k) \
        acc[ai][bj][m][n] = __builtin_amdgcn_mfma_f32_16x16x32_bf16(Bt[n][k], At[m][k], acc[ai][bj][m][n], 0, 0, 0); __builtin_amdgcn_s_setprio(0); } while (0)
#define PG8_WAIT_V(n) asm volatile("s_waitcnt vmcnt(" #n ")" ::: "memory")
#define PG8_WAIT_L(n) asm volatile("s_waitcnt lgkmcnt(" #n ")" ::: "memory")
#define PG8_BAR __builtin_amdgcn_s_barrier()
#define PG8_SCHED __builtin_amdgcn_sched_barrier(0)
    Unit cur, nxt; int ui = 0;
    if (!S.next(0, cur)) return;
    f32x4 acc[2][2][4][2];
#pragma unroll
    for (int a = 0; a < 2; ++a)
#pragma unroll
        for (int b = 0; b < 2; ++b)
#pragma unroll
            for (int m = 0; m < 4; ++m)
#pragma unroll
                for (int n = 0; n < 2; ++n) acc[a][b][m][n] = (f32x4){0.f, 0.f, 0.f, 0.f};
    bf16x8 At[4][2], B0[2][2], B1[2][2];
    const char* cA = (const char*)g.A + (size_t)cur.pm * tstep; const char* cB = (const char*)g.Bt + (size_t)cur.pn * tstep;
    if constexpr (SP2) {
        PG8_STAGE(PG8_SB(0, 0), cB, voffB); PG8_STAGE(PG8_SB(0, 1), cB + hstep, voffB);
        S.a_ready(cur);
        PG8_STAGE(PG8_SA(0, 0), cA, voffA); PG8_STAGE(PG8_SA(0, 1), cA + hstep, voffA);
        if (wr == 1) PG8_BAR;
        PG8_WAIT_V(2); PG8_BAR;
        PG8_STAGE(PG8_SB(1, 0), cB + kstep, voffB); PG8_STAGE(PG8_SA(1, 0), cA + kstep, voffA); PG8_STAGE(PG8_SB(1, 1), cB + hstep + kstep, voffB);
        PG8_WAIT_V(6); PG8_BAR;
    } else {
        S.a_ready(cur);
        PG8_STAGE(PG8_SB(0, 0), cB, voffB); PG8_STAGE(PG8_SA(0, 0), cA, voffA); PG8_STAGE(PG8_SB(0, 1), cB + hstep, voffB); PG8_STAGE(PG8_SA(0, 1), cA + hstep, voffA);
        if (wr == 1) PG8_BAR;
        PG8_WAIT_V(4); PG8_BAR;
        PG8_STAGE(PG8_SB(1, 0), cB + kstep, voffB); PG8_STAGE(PG8_SA(1, 0), cA + kstep, voffA); PG8_STAGE(PG8_SB(1, 1), cB + hstep + kstep, voffB);
        PG8_WAIT_V(6); PG8_BAR;
    }
    for (;;) {
        const bool has_next = S.next(ui + 1, nxt);
        const char* nA = has_next ? (const char*)g.A + (size_t)nxt.pm * tstep : cA; const char* nB = has_next ? (const char*)g.Bt + (size_t)nxt.pn * tstep : cB;
        for (int t = 0; t < nt; t += 2) {
            const bool last = (t == nt - 2);
            const char* a1 = cA + (size_t)(t + 1) * kstep;
            const char* a2 = last ? nA : cA + (size_t)(t + 2) * kstep; const char* b2 = last ? nB : cB + (size_t)(t + 2) * kstep;
            const char* a3 = a2 + kstep; const char* b3 = b2 + kstep;
            if (last && has_next) S.a_ready(nxt);
            if constexpr (SP2) {
            PG8_LDB(B0, 0, 0); PG8_LDB(B1, 0, 1); PG8_SCHED; PG8_LDA(At, 0, 0); PG8_STAGE(PG8_SA(1, 1), a1 + hstep, voffA);
            PG8_WAIT_V(8); PG8_WAIT_L(0); PG8_BAR; PG8_MMA(0, 0, At, B0); PG8_MMA(0, 1, At, B1); PG8_BAR; PG8_SCHED;
            PG8_LDA(At, 0, 1); PG8_STAGE(PG8_SB(0, 0), b2, voffB); PG8_STAGE(PG8_SB(0, 1), b2 + hstep, voffB); PG8_STAGE(PG8_SA(0, 0), a2, voffA);
            PG8_WAIT_V(8); PG8_WAIT_L(0); PG8_BAR; PG8_MMA(1, 0, At, B0); PG8_MMA(1, 1, At, B1); PG8_BAR; PG8_SCHED;
            PG8_LDB(B0, 1, 0); PG8_LDB(B1, 1, 1); PG8_SCHED; PG8_LDA(At, 1, 0); PG8_STAGE(PG8_SA(0, 1), a2 + hstep, voffA);
            PG8_WAIT_V(8); PG8_WAIT_L(0); PG8_BAR; PG8_MMA(0, 0, At, B0); PG8_MMA(0, 1, At, B1); PG8_BAR; PG8_SCHED;
            PG8_LDA(At, 1, 1); PG8_STAGE(PG8_SB(1, 0), b3, voffB); PG8_STAGE(PG8_SB(1, 1), b3 + hstep, voffB); PG8_STAGE(PG8_SA(1, 0), a3, voffA);
            PG8_WAIT_V(8); PG8_WAIT_L(0); PG8_BAR; PG8_MMA(1, 0, At, B0); PG8_MMA(1, 1, At, B1); PG8_BAR; PG8_SCHED;
            } else {
            PG8_LDB(B0, 0, 0); PG8_SCHED; PG8_LDA(At, 0, 0); PG8_STAGE(PG8_SA(1, 1), a1 + hstep, voffA);
            PG8_WAIT_L(8); PG8_BAR; PG8_WAIT_L(0); PG8_MMA(0, 0, At, B0); PG8_BAR; PG8_SCHED;
            PG8_LDB(B1, 0, 1); PG8_STAGE(PG8_SB(0, 0), b2, voffB);
            PG8_BAR; PG8_WAIT_L(0); PG8_MMA(0, 1, At, B1); PG8_BAR;
            PG8_LDA(At, 0, 1); PG8_STAGE(PG8_SA(0, 0), a2, voffA);
            PG8_BAR; PG8_WAIT_L(0); PG8_MMA(1, 0, At, B0); PG8_BAR; PG8_SCHED;
            PG8_STAGE(PG8_SB(0, 1), b2 + hstep, voffB);
            PG8_WAIT_V(6); PG8_BAR; PG8_MMA(1, 1, At, B1); PG8_BAR;
            PG8_LDB(B0, 1, 0); PG8_SCHED; PG8_LDA(At, 1, 0); PG8_STAGE(PG8_SA(0, 1), a2 + hstep, voffA);
            PG8_WAIT_L(8); PG8_BAR; PG8_WAIT_L(0); PG8_MMA(0, 0, At, B0); PG8_BAR; PG8_SCHED;
            PG8_LDB(B1, 1, 1); PG8_STAGE(PG8_SB(1, 0), b3, voffB);
            PG8_BAR; PG8_WAIT_L(0); PG8_MMA(0, 1, At, B1); PG8_BAR;
            PG8_LDA(At, 1, 1); PG8_STAGE(PG8_SA(1, 0), a3, voffA);
            PG8_BAR; PG8_WAIT_L(0); PG8_MMA(1, 0, At, B0); PG8_BAR; PG8_SCHED;
            PG8_STAGE(PG8_SB(1, 1), b3 + hstep, voffB);
            PG8_WAIT_V(6); PG8_BAR; PG8_MMA(1, 1, At, B1); PG8_BAR;
            }
        }
        if constexpr (ALIGN_EPI) { if (wr == 0) PG8_BAR; }
        if constexpr (!Epi::AFTER_DRAIN) { E(acc, cur, wr, wc, fr, fq); S.done(cur); }
        if (!has_next) break;
#pragma unroll
        for (int a = 0; a < 2; ++a)
#pragma unroll
            for (int b = 0; b < 2; ++b)
#pragma unroll
                for (int m = 0; m < 4; ++m)
#pragma unroll
                    for (int n = 0; n < 2; ++n) acc[a][b][m][n] = (f32x4){0.f, 0.f, 0.f, 0.f};
        cur = nxt; cA = nA; cB = nB; ++ui;
        if constexpr (ALIGN_EPI) { if (wr == 1) PG8_BAR; }
    }
    PG8_WAIT_V(0);
    if constexpr (!ALIGN_EPI) { if (wr == 0) PG8_BAR; }
    PG8_BAR;
    if constexpr (Epi::AFTER_DRAIN) { E.fused(acc, cur, wr, wc, fr, fq, lds, wid, lane); S.done(cur); }
#undef PG8_SA
#undef PG8_SB
#undef PG8_STAGE
#undef PG8_LDA
#undef PG8_LDB
#undef PG8_MMA
#undef PG8_WAIT_V
#undef PG8_WAIT_L
#undef PG8_BAR
#undef PG8_SCHED
}
}
namespace mix {
#define MLAS __attribute__((address_space(3)))
typedef unsigned short bf16_t;
typedef short bf16x8 __attribute__((ext_vector_type(8)));
typedef short s16x4 __attribute__((ext_vector_type(4)));
typedef float f32x16 __attribute__((ext_vector_type(16)));
typedef float f32x4 __attribute__((ext_vector_type(4)));
typedef float f32x2 __attribute__((ext_vector_type(2)));
typedef unsigned u32x4 __attribute__((ext_vector_type(4)));
typedef unsigned u32x2 __attribute__((ext_vector_type(2)));
typedef MLAS const char* lds_cptr;
typedef short v4i16_t __attribute__((ext_vector_type(4)));
typedef __bf16 bf16x2_t __attribute__((ext_vector_type(2)));

constexpr int SLOTB = 8192;
constexpr int NSLOT = 4;
constexpr int L_K = 0, L_V = NSLOT * SLOTB, L_WSF = 2 * NSLOT * SLOTB, L_OST = L_WSF + 8 * 256, L_X = L_OST + 8 * 4096;
constexpr int LX_IQ = L_X, LX_EQ = L_X, LX_PFX = L_X + 8192, LX_CNT = LX_IQ + 16384, LX_GT = LX_CNT + 2048, LX_SEL = LX_GT, LX_END = LX_GT + 8192;
static_assert(LX_END <= 131072, "mixer LDS map");

__device__ __forceinline__ int crow(int r, int hi) { return (r & 3) + 8 * (r >> 2) + 4 * hi; }
__device__ __forceinline__ void glds16(const void* gsrc, unsigned lds_dst) { unsigned keep;
    asm volatile("s_mov_b32 %0, m0\n\ts_mov_b32 m0, %2\n\ts_nop 0\n\tglobal_load_lds_dwordx4 %1, off\n\ts_mov_b32 m0, %0" : "=&s"(keep) : "v"(gsrc), "s"(lds_dst) : "memory"); }
__device__ __forceinline__ unsigned cvtpk(float lo, float hi) { f32x2 v = {lo, hi}; bf16x2_t b = __builtin_convertvector(v, bf16x2_t); return __builtin_bit_cast(unsigned, b); }
__device__ __forceinline__ s16x4 vtr(lds_cptr p) { return __builtin_bit_cast(s16x4, __builtin_amdgcn_ds_read_tr16_b64_v4i16((MLAS v4i16_t*)p)); }
#define WAITV_BAR() asm volatile("s_waitcnt vmcnt(0) lgkmcnt(0)\n\ts_barrier" ::: "memory")
#define LGKM_BAR() asm volatile("s_waitcnt lgkmcnt(0)\n\ts_barrier" ::: "memory")
#define WAITV2_BAR() asm volatile("s_waitcnt vmcnt(2) lgkmcnt(0)\n\ts_barrier" ::: "memory")

__device__ __forceinline__ void dma_kv(const bf16_t* kbase, const bf16_t* vbase, int pitch, unsigned lds0, int slot, int wid, int lane) {
    const bf16_t* ks = kbase + (size_t)lane * pitch + wid * 8;
    const bf16_t* vs = vbase + (size_t)(16 * (wid & 3) + (lane >> 2)) * pitch + (wid >> 2) * 32 + (lane & 3) * 8;
    glds16(ks, (unsigned)__builtin_amdgcn_readfirstlane(lds0 + L_K + slot * SLOTB + wid * 1024));
    glds16(vs, (unsigned)__builtin_amdgcn_readfirstlane(lds0 + L_V + slot * SLOTB + wid * 1024));
}
__device__ __forceinline__ void kload(bf16x8 (&kf)[8], lds_cptr kslot, int r32, int hi) {
    lds_cptr kb = kslot + hi * 1024 + r32 * 16;
#pragma unroll
    for (int d0 = 0; d0 < 4; ++d0) { kf[2 * d0] = *(const MLAS bf16x8*)(kb + d0 * 2048); kf[2 * d0 + 1] = *(const MLAS bf16x8*)(kb + d0 * 2048 + 512); }
}
__device__ __forceinline__ void qkt_mma(f32x16& p0, f32x16& p1, const bf16x8 (&kf)[8], const bf16x8* qr, const f32x16& cinit) {
    p0 = __builtin_amdgcn_mfma_f32_32x32x16_bf16(kf[0], qr[0], cinit, 0, 0, 0); p1 = __builtin_amdgcn_mfma_f32_32x32x16_bf16(kf[1], qr[0], cinit, 0, 0, 0);
#pragma unroll
    for (int d0 = 1; d0 < 4; ++d0) { p0 = __builtin_amdgcn_mfma_f32_32x32x16_bf16(kf[2 * d0], qr[d0], p0, 0, 0, 0); p1 = __builtin_amdgcn_mfma_f32_32x32x16_bf16(kf[2 * d0 + 1], qr[d0], p1, 0, 0, 0); }
}
__device__ __forceinline__ void qkt(f32x16& p0, f32x16& p1, lds_cptr kslot, const bf16x8* qr, const f32x16& cinit, int r32, int hi) {
    bf16x8 kf[8]; kload(kf, kslot, r32, hi); qkt_mma(p0, p1, kf, qr, cinit);
}
__device__ __forceinline__ void vload(bf16x8 (&vf)[8], lds_cptr vslot, int lane, int hi) {
    lds_cptr vp = vslot + ((lane >> 4) & 1) * 32 + (lane & 3) * 8 + (4 * hi + ((lane & 15) >> 2)) * 64;
#pragma unroll
    for (int d0 = 0; d0 < 2; ++d0)
#pragma unroll
        for (int ks = 0; ks < 4; ++ks) {
            const s16x4 lo = vtr(vp + d0 * 4096 + ks * 1024), hh = vtr(vp + d0 * 4096 + ks * 1024 + 512);
            vf[d0 * 4 + ks] = (bf16x8){lo[0], lo[1], lo[2], lo[3], hh[0], hh[1], hh[2], hh[3]};
        }
}
#define V16_TO_ARR(v, a, o) do { a[(o) + 0] = v[0]; a[(o) + 1] = v[1]; a[(o) + 2] = v[2]; a[(o) + 3] = v[3]; a[(o) + 4] = v[4]; a[(o) + 5] = v[5]; a[(o) + 6] = v[6]; a[(o) + 7] = v[7]; \
    a[(o) + 8] = v[8]; a[(o) + 9] = v[9]; a[(o) + 10] = v[10]; a[(o) + 11] = v[11]; a[(o) + 12] = v[12]; a[(o) + 13] = v[13]; a[(o) + 14] = v[14]; a[(o) + 15] = v[15]; } while (0)
__device__ __forceinline__ f32x16 splat16(float x) { return (f32x16){x, x, x, x, x, x, x, x, x, x, x, x, x, x, x, x}; }
struct AttnState { f32x16 o[2]; float m, l, pend; bool started; };
constexpr float ATT_THR = 8.0f;
__device__ __forceinline__ void softmax_pv(AttnState& st, float (&sc)[32], const bf16x8 (&vf)[8], MLAS float* wsf, int lane, int r32, int hi) {
    if (__any(st.pend != 0.f)) {
#pragma unroll
        for (int r = 0; r < 32; ++r) sc[r] -= st.pend;
    }
    st.pend = 0.f;
    float ra = __builtin_fmaxf(__builtin_fmaxf(sc[0], sc[1]), sc[2]), rb = __builtin_fmaxf(__builtin_fmaxf(sc[3], sc[4]), sc[5]);
#pragma unroll
    for (int r = 6; r < 30; r += 4) { ra = __builtin_fmaxf(__builtin_fmaxf(ra, sc[r]), sc[r + 1]); rb = __builtin_fmaxf(__builtin_fmaxf(rb, sc[r + 2]), sc[r + 3]); }
    float rm = __builtin_fmaxf(__builtin_fmaxf(ra, rb), __builtin_fmaxf(sc[30], sc[31]));
    rm = halves_max_f(rm);
    const bool fresh = !st.started;
    const bool need = (rm > ATT_THR) || (fresh && rm < -ATT_THR && rm > -1e29f);
    st.started = st.started || (rm > -1e29f);
    if (__any(need)) {
        const float dl = need ? rm : 0.f;
        st.m += dl; st.pend = dl;
#pragma unroll
        for (int r = 0; r < 32; ++r) sc[r] -= dl;
        const float alpha = fresh ? 1.0f : __builtin_amdgcn_exp2f(-dl);
        st.l *= alpha;
        if (hi == 0) wsf[r32] = alpha;
        float fr_[16];
#pragma unroll
        for (int r = 0; r < 16; ++r) fr_[r] = wsf[crow(r, hi)];
        const f32x16 fv = {fr_[0], fr_[1], fr_[2], fr_[3], fr_[4], fr_[5], fr_[6], fr_[7], fr_[8], fr_[9], fr_[10], fr_[11], fr_[12], fr_[13], fr_[14], fr_[15]};
        st.o[0] = st.o[0] * fv; st.o[1] = st.o[1] * fv;
    }
    float pe[32]; float s0 = 0.f, s1 = 0.f;
#pragma unroll
    for (int r = 0; r < 32; r += 2) { pe[r] = __builtin_amdgcn_exp2f(sc[r]); pe[r + 1] = __builtin_amdgcn_exp2f(sc[r + 1]); s0 += pe[r]; s1 += pe[r + 1]; }
    st.l += s0 + s1;
    u32x4 pw[4];
#pragma unroll
    for (int k = 0; k < 4; ++k) pw[k] = (u32x4){cvtpk(pe[8 * k + 0], pe[8 * k + 1]), cvtpk(pe[8 * k + 2], pe[8 * k + 3]), cvtpk(pe[8 * k + 4], pe[8 * k + 5]), cvtpk(pe[8 * k + 6], pe[8 * k + 7])};
#pragma unroll
    for (int d0 = 0; d0 < 2; ++d0)
#pragma unroll
        for (int ks = 0; ks < 4; ++ks) st.o[d0] = __builtin_amdgcn_mfma_f32_32x32x16_bf16(__builtin_bit_cast(bf16x8, pw[ks]), vf[d0 * 4 + ks], st.o[d0], 0, 0, 0);
}
__device__ __forceinline__ void attn_store(AttnState& st, bf16_t* Ow, int pitch, MLAS float* wsf, MLAS bf16_t* stg, int lane, int r32, int hi) {
    float l = halves_sum_f(st.l);
    if (hi == 0) wsf[32 + r32] = l;
    float rli[16];
#pragma unroll
    for (int r = 0; r < 16; ++r) rli[r] = 1.0f / wsf[32 + crow(r, hi)];
#pragma unroll
    for (int r = 0; r < 16; ++r) { const int orow = crow(r, hi);
#pragma unroll
        for (int d0 = 0; d0 < 2; ++d0) { const unsigned short b = (unsigned short)(cvtpk(st.o[d0][r] * rli[r], 0.f) & 0xffffu); stg[orow * 64 + d0 * 32 + r32] = b; } }
#pragma unroll
    for (int i = 0; i < 4; ++i) { const int row = i * 8 + (lane >> 3), ch = lane & 7; const u32x4 v = *(const MLAS u32x4*)(stg + row * 64 + ch * 8); *(u32x4*)(Ow + (size_t)row * pitch + ch * 8) = v; }
}

#ifndef DBG_REP_BS
#define DBG_REP_BS 1
#endif
__device__ __forceinline__ unsigned pk_sub_sat_u16(unsigned a, unsigned b) { unsigned r; asm("v_pk_sub_u16 %0, %1, %2 clamp" : "=v"(r) : "v"(a), "v"(b)); return r; }
__device__ __forceinline__ unsigned pk_min_u16(unsigned a, unsigned b) { unsigned r; asm("v_pk_min_u16 %0, %1, %2" : "=v"(r) : "v"(a), "v"(b)); return r; }
__device__ __forceinline__ unsigned pk_add_u16(unsigned a, unsigned b) { unsigned r; asm("v_pk_add_u16 %0, %1, %2" : "=v"(r) : "v"(a), "v"(b)); return r; }
__device__ __forceinline__ unsigned pk_ashr_i16(unsigned a, unsigned sh2) { unsigned r; asm("v_pk_ashrrev_i16 %0, %1, %2" : "=v"(r) : "v"(sh2), "v"(a)); return r; }
__device__ __forceinline__ unsigned score_keys(float a, float b) {
    const unsigned p = __builtin_bit_cast(unsigned, __builtin_amdgcn_cvt_pkrtz(a, b));
    const unsigned m = pk_ashr_i16(p, 0x000f000fu);
    return p ^ (m | 0x80008000u);
}
template <int NS> __device__ __forceinline__ unsigned bit_search(const unsigned (&kp)[8][8], MLAS unsigned* cntx, int wid, int r32, int hi) {
    unsigned tau = 0u;
#pragma unroll 1
    for (int bit = 15; bit >= 0; --bit) {
        const unsigned cand = tau | (1u << bit);
        const unsigned c2 = (cand - 1u) * 0x00010001u;
        unsigned cnt2 = 0;
#pragma unroll
        for (int jj = 0; jj < NS; ++jj)
#pragma unroll
            for (int r = 0; r < 8; ++r) cnt2 = pk_add_u16(cnt2, pk_min_u16(pk_sub_sat_u16(kp[jj][r], c2), 0x00010001u));
        unsigned cnt = (cnt2 & 0xffffu) + (cnt2 >> 16);
        cnt = halves_add_u(cnt);
        MLAS unsigned* cb = cntx + (bit & 1) * 256;
        if (hi == 0) cb[wid * 32 + r32] = cnt;
        LGKM_BAR();
        unsigned tot = 0;
#pragma unroll
        for (int w = 0; w < 8; ++w) tot += cb[w * 32 + r32];
        if (tot >= 256u) tau = cand;
    }
    return tau;
}
__device__ __forceinline__ void lds_inc(MLAS unsigned* p) { const unsigned one = 1u; asm volatile("ds_add_u32 %0, %1" :: "v"((unsigned)(uintptr_t)p), "v"(one) : "memory"); }
template <int NS> __device__ __forceinline__ unsigned radix_select(const unsigned (&kp)[8][8], MLAS char* L, int tid, int r32) {
    MLAS unsigned* h1 = (MLAS unsigned*)L; MLAS unsigned* h2 = h1 + 8224; MLAS unsigned* part = h2 + 8224; MLAS unsigned* res = part + 512;
    for (int i = tid; i < 2 * 8224; i += 512) h1[i] = 0u;
    LGKM_BAR();
    MLAS unsigned* col1 = h1 + r32; MLAS unsigned* col2 = h2 + r32;
#pragma unroll
    for (int jj = 0; jj < NS; ++jj)
#pragma unroll
        for (int r = 0; r < 8; ++r) { const unsigned k = kp[jj][r]; lds_inc(col1 + ((k >> 3) & 0x1fe0u)); lds_inc(col1 + ((k >> 19) & 0x1fe0u)); }
    LGKM_BAR();
    const int q = tid & 31, p = tid >> 5;
    { unsigned s = 0;
#pragma unroll
      for (int b = 0; b < 16; ++b) s += h1[(16 * p + b) * 32 + q];
      part[p * 32 + q] = s; }
    LGKM_BAR();
    { unsigned above = 0;
#pragma unroll
      for (int pp = 0; pp < 16; ++pp) { const unsigned v = part[pp * 32 + q]; above += (pp > p) ? v : 0u; }
      const unsigned s = part[p * 32 + q];
      if (above < 256u && above + s >= 256u) {
          unsigned cum = above, bsel = 0u, asel = 0u; bool found = false;
#pragma unroll
          for (int b = 15; b >= 0; --b) { const unsigned c = h1[(16 * p + b) * 32 + q]; if (!found && cum + c >= 256u) { bsel = (unsigned)(16 * p + b); asel = cum; found = true; } cum += c; }
          res[q] = bsel | (asel << 16);
      } }
    LGKM_BAR();
    const unsigned b1 = res[r32] & 0xffffu;
#pragma unroll
    for (int jj = 0; jj < NS; ++jj)
#pragma unroll
        for (int r = 0; r < 8; ++r) { const unsigned k = kp[jj][r];
            lds_inc(col2 + ((((k >> 8) & 0xffu) == b1) ? ((k & 0xffu) << 5) : 8192u));
            lds_inc(col2 + (((k >> 24) == b1) ? ((k >> 11) & 0x1fe0u) : 8192u)); }
    LGKM_BAR();
    const unsigned rq = res[q]; const unsigned need = 256u - (rq >> 16);
    { unsigned s = 0;
#pragma unroll
      for (int b = 0; b < 16; ++b) s += h2[(16 * p + b) * 32 + q];
      part[p * 32 + q] = s; }
    LGKM_BAR();
    { unsigned above = 0;
#pragma unroll
      for (int pp = 0; pp < 16; ++pp) { const unsigned v = part[pp * 32 + q]; above += (pp > p) ? v : 0u; }
      const unsigned s = part[p * 32 + q];
      if (above < need && above + s >= need) {
          unsigned cum = above, lsel = 0u; bool found = false;
#pragma unroll
          for (int b = 15; b >= 0; --b) { const unsigned c = h2[(16 * p + b) * 32 + q]; if (!found && cum + c >= need) { lsel = (unsigned)(16 * p + b); found = true; } cum += c; }
          res[32 + q] = ((rq & 0xffffu) << 8) | lsel;
      } }
    LGKM_BAR();
    return res[32 + r32];
}
__device__ __forceinline__ void dsa_select(int b, int qg, const bf16_t* Z0, char* shm, const int wave_s) {
    const int tid_ = wave_s * 64 + lane_opaque(); const int tid = tid_, lane = tid & 63, r32 = lane & 31, hi = lane >> 5; const int wid = __builtin_amdgcn_readfirstlane(tid >> 6);
    MLAS char* L = (MLAS char*)shm;
    const int c = qg >> 1, nkeys = 64 * (c + 1), nt32 = nkeys >> 5, nt64 = nkeys >> 6;
    const size_t rowb = (size_t)b * SEQ;
    const size_t tok0 = rowb + 32 * qg;
    MLAS unsigned* selw = (MLAS unsigned*)(L + LX_SEL);
    if (nkeys <= 256) {
        for (int i = tid; i < 64 * 32; i += 512) selw[i] = (i < nt32 * 32) ? 0xffffffffu : 0u;
    } else {
        {
            MLAS u32x4* iqL = (MLAS u32x4*)(L + LX_IQ);
            for (int i = tid; i < 1024; i += 512) { const int q = i & 31, hh = (i >> 5) & 1, d0 = (i >> 6) & 3, h = i >> 8;
                iqL[i] = *(const u32x4*)(Z0 + (tok0 + q) * EV_N + 1280 + 64 * h + 16 * d0 + 8 * hh); }
        }
        float w4[4];
        { const u32x2 ww = *(const u32x2*)(Z0 + (tok0 + r32) * EV_N + 1216);
          w4[0] = pg8::bf_lo(ww.x) * 0.0625f; w4[1] = pg8::bf_hi(ww.x) * 0.0625f; w4[2] = pg8::bf_lo(ww.y) * 0.0625f; w4[3] = pg8::bf_hi(ww.y) * 0.0625f; }
        LGKM_BAR();
        unsigned kp[8][8];
        const int nslots = (nt32 + 7) >> 3;
        const MLAS bf16x8* iqf = (const MLAS bf16x8*)(L + LX_IQ) + hi * 32 + r32;
#pragma unroll
        for (int jj = 0; jj < 8; ++jj) {
            const int j = wid + 8 * jj;
            if (j < nt32) {
                const bf16_t* ikp = Z0 + (rowb + 32 * j + r32) * EV_N + 1152 + 8 * hi;
                bf16x8 af[4];
#pragma unroll
                for (int d0 = 0; d0 < 4; ++d0) af[d0] = *(const bf16x8*)(ikp + 16 * d0);
                f32x16 ah[4];
#pragma unroll
                for (int h = 0; h < 4; ++h) {
                    f32x16 a = {};
#pragma unroll
                    for (int d0 = 0; d0 < 4; ++d0) a = __builtin_amdgcn_mfma_f32_32x32x16_bf16(af[d0], iqf[(h * 4 + d0) * 64], a, 0, 0, 0);
                    ah[h] = a;
                }
                float sv[16];
                {
                    float a0[16], a1[16], a2[16], a3[16];
                    V16_TO_ARR(ah[0], a0, 0); V16_TO_ARR(ah[1], a1, 0); V16_TO_ARR(ah[2], a2, 0); V16_TO_ARR(ah[3], a3, 0);
#pragma unroll
                    for (int r = 0; r < 16; ++r) sv[r] = ((__builtin_fmaxf(a0[r], 0.f) * w4[0] + __builtin_fmaxf(a1[r], 0.f) * w4[1]) + __builtin_fmaxf(a2[r], 0.f) * w4[2]) + __builtin_fmaxf(a3[r], 0.f) * w4[3];
                }
#pragma unroll
                for (int r = 0; r < 8; ++r) kp[jj][r] = score_keys(sv[r], sv[r + 8]);
            } else {
#pragma unroll
                for (int r = 0; r < 8; ++r) kp[jj][r] = 0u;
            }
        }
        MLAS unsigned* cntx = (MLAS unsigned*)(L + L_OST);
        unsigned tau;
        for (int rep_ = 0; rep_ < DBG_REP_BS; ++rep_)
#ifdef DSA_BIT_SEARCH
        switch (nslots) {
            case 2: tau = bit_search<2>(kp, cntx, wid, r32, hi); break;
            case 3: tau = bit_search<3>(kp, cntx, wid, r32, hi); break;
            case 4: tau = bit_search<4>(kp, cntx, wid, r32, hi); break;
            case 5: tau = bit_search<5>(kp, cntx, wid, r32, hi); break;
            case 6: tau = bit_search<6>(kp, cntx, wid, r32, hi); break;
            case 7: tau = bit_search<7>(kp, cntx, wid, r32, hi); break;
            default: tau = bit_search<8>(kp, cntx, wid, r32, hi); break;
        }
#else
        switch (nslots) {
            case 2: tau = radix_select<2>(kp, L, tid, r32); break;
            case 3: tau = radix_select<3>(kp, L, tid, r32); break;
            case 4: tau = radix_select<4>(kp, L, tid, r32); break;
            case 5: tau = radix_select<5>(kp, L, tid, r32); break;
            case 6: tau = radix_select<6>(kp, L, tid, r32); break;
            case 7: tau = radix_select<7>(kp, L, tid, r32); break;
            default: tau = radix_select<8>(kp, L, tid, r32); break;
        }
        (void)cntx;
#endif
        MLAS unsigned* gtw = (MLAS unsigned*)(L + LX_GT); MLAS unsigned* eqw = (MLAS unsigned*)(L + LX_EQ); MLAS unsigned* pfx = (MLAS unsigned*)(L + LX_PFX);
        const unsigned tg = tau * 0x00010001u, te = (tau - 1u) * 0x00010001u;
#pragma unroll
        for (int jj = 0; jj < 8; ++jj) {
            const int j = wid + 8 * jj;
            if (j < nt32) {
                unsigned g = 0, e = 0;
#pragma unroll
                for (int r = 0; r < 8; ++r) {
                    const unsigned dgt = pk_min_u16(pk_sub_sat_u16(kp[jj][r], tg), 0x00010001u), dge = pk_min_u16(pk_sub_sat_u16(kp[jj][r], te), 0x00010001u);
                    const int pos = (r & 3) + 8 * (r >> 2);
                    g |= dgt << pos; e |= (dge - dgt) << pos;
                }
                g <<= 4 * hi; e <<= 4 * hi;
                g = halves_or_u(g); e = halves_or_u(e);
                if (hi == 0) { gtw[j * 32 + r32] = g; eqw[j * 32 + r32] = e; }
            }
        }
        LGKM_BAR();
        {
            MLAS unsigned* sgs = (MLAS unsigned*)(L + L_OST) + 256;
            const int sg = wid * 2 + hi;
            unsigned e4[4], gs = 0u, es = 0u;
#pragma unroll
            for (int t = 0; t < 4; ++t) { const int j = 4 * sg + t; const unsigned g = (j < nt32) ? gtw[j * 32 + r32] : 0u; e4[t] = (j < nt32) ? eqw[j * 32 + r32] : 0u; gs += __builtin_popcount(g); es += __builtin_popcount(e4[t]); }
            sgs[sg * 32 + r32] = gs; sgs[512 + sg * 32 + r32] = es;
            LGKM_BAR();
            unsigned cg = 0u, ebefore = 0u;
#pragma unroll
            for (int s2 = 0; s2 < 16; ++s2) { const unsigned a = sgs[s2 * 32 + r32], bq = sgs[512 + s2 * 32 + r32]; cg += a; ebefore += (s2 < sg) ? bq : 0u; }
            const int need = 256 - (int)cg;
            int run = (int)ebefore;
#pragma unroll
            for (int t = 0; t < 4; ++t) { const int j = 4 * sg + t; int k = need - run; k = k < 0 ? 0 : (k > 32 ? 32 : k); if (j < nt32) pfx[j * 32 + r32] = (unsigned)k; run += __builtin_popcount(e4[t]); }
        }
        LGKM_BAR();
        for (int i = tid; i < nt32 * 32; i += 512) {
            const unsigned g = gtw[i], e = eqw[i]; const int k = (int)pfx[i];
            unsigned take = 0;
            if (e != 0u && k > 0) {
                unsigned rem = e; int cntk = 0;
                while (rem != 0u && cntk < k) { const unsigned low = rem & (0u - rem); take |= low; rem ^= low; ++cntk; }
            }
            selw[i] = g | take;
        }
        for (int i = nt32 * 32 + tid; i < 64 * 32; i += 512) selw[i] = 0u;
    }
    WAITV_BAR();
}

__device__ __forceinline__ void fox_unit(int b, int h, int qb, const bf16_t* Z1, const float* F, const float* bfp, bf16_t* Y, char* shm, unsigned lds0, const int wave_s) {
    const int tid_ = wave_s * 64 + lane_opaque(); const int tid = tid_, lane = tid & 63, r32 = lane & 31, hi = lane >> 5; const int wid = __builtin_amdgcn_readfirstlane(tid >> 6);
    MLAS char* L = (MLAS char*)shm;
    const size_t rowb = (size_t)b * SEQ;
    const int NT = 4 * (qb + 1), nk = 64 * NT;
    MLAS float* cum2 = (MLAS float*)(L + L_X);
    MLAS float* wtot = (MLAS float*)(L + L_X + 8192);
    const bf16_t* Kb = Z1 + rowb * Z1P + 512 + 64 * h; const bf16_t* Vb = Z1 + rowb * Z1P + 1024 + 64 * h;
#pragma unroll
    for (int i = 0; i < 3; ++i) dma_kv(Kb + (size_t)64 * i * Z1P, Vb + (size_t)64 * i * Z1P, Z1P, lds0, i, wid, lane);
    {
        const float bias = bfp[h];
        const int s0 = 4 * tid;
        float v[4]; float run = 0.f;
#pragma unroll
        for (int i = 0; i < 4; ++i) {
            float x = 0.f;
            if (s0 + i < nk) x = F[(rowb + s0 + i) * 8 + h] + bias;
            const float ls = (s0 + i < nk) ? (fminf(x, 0.f) - log1pf(expf(-fabsf(x)))) : 0.f;
            run += ls; v[i] = run;
        }
        float inc = run;
#pragma unroll
        for (int o = 1; o < 64; o <<= 1) { const int ln = lane_opaque(); const float t = __builtin_bit_cast(float, __builtin_amdgcn_ds_bpermute((ln - o) << 2, __builtin_bit_cast(int, inc))); if (ln >= o) inc += t; }
        if (lane == 63) wtot[wid] = inc;
        LGKM_BAR();
        float off = inc - run;
        for (int w = 0; w < wid; ++w) off += wtot[w];
#pragma unroll
        for (int i = 0; i < 4; ++i) cum2[s0 + i] = (off + v[i]) * 1.4426950408889634f;
    }
    const int tq = 256 * qb + 32 * wid + r32;
    bf16x8 qr[4];
#pragma unroll
    for (int d0 = 0; d0 < 4; ++d0) qr[d0] = *(const bf16x8*)(Z1 + (rowb + tq) * Z1P + 64 * h + 16 * d0 + 8 * hi);
    AttnState st; st.o[0] = f32x16{}; st.o[1] = f32x16{}; st.m = 0.f; st.l = 0.f; st.pend = 0.f; st.started = false;
    MLAS float* wsf = (MLAS float*)(L + L_WSF) + wid * 64;
    WAITV_BAR();
    const float cq2 = cum2[tq];
    const int tlast = 4 * qb + (wid >> 1);
    f32x16 s0, s1;
    qkt(s0, s1, (lds_cptr)(L + L_K), qr, splat16(-st.m), r32, hi);
    for (int t = 0; t < NT; ++t) {
        const int slot = t & 3;
        { const int tt = (t + 3 < NT) ? t + 3 : NT - 1; dma_kv(Kb + (size_t)64 * tt * Z1P, Vb + (size_t)64 * tt * Z1P, Z1P, lds0, (t + 3) & 3, wid, lane); }
        bf16x8 kf[8], vf[8];
        kload(kf, (lds_cptr)(L + L_K + ((t + 1) & 3) * SLOTB), r32, hi);
        __builtin_amdgcn_sched_barrier(0);
        vload(vf, (lds_cptr)(L + L_V + slot * SLOTB), lane, hi);
        const MLAS float* cb = cum2 + 64 * t + 4 * hi;
        f32x4 c0[4], c1[4];
#pragma unroll
        for (int g = 0; g < 4; ++g) { c0[g] = *(const MLAS f32x4*)(cb + 8 * g); c1[g] = *(const MLAS f32x4*)(cb + 32 + 8 * g); }
        f32x16 n0, n1;
        qkt_mma(n0, n1, kf, qr, splat16(-st.m));
        float sc[32];
        V16_TO_ARR(s0, sc, 0); V16_TO_ARR(s1, sc, 16);
#pragma unroll
        for (int g = 0; g < 4; ++g) {
            sc[4 * g + 0] += cq2 - c0[g].x; sc[4 * g + 1] += cq2 - c0[g].y; sc[4 * g + 2] += cq2 - c0[g].z; sc[4 * g + 3] += cq2 - c0[g].w;
            sc[16 + 4 * g + 0] += cq2 - c1[g].x; sc[16 + 4 * g + 1] += cq2 - c1[g].y; sc[16 + 4 * g + 2] += cq2 - c1[g].z; sc[16 + 4 * g + 3] += cq2 - c1[g].w;
        }
        if (t >= tlast) {
            const int qrel = tq - 64 * t;
#pragma unroll
            for (int r = 0; r < 16; ++r) { const int kr = crow(r, hi); if (kr > qrel) sc[r] = -INFINITY; if (kr + 32 > qrel) sc[16 + r] = -INFINITY; }
        }
        softmax_pv(st, sc, vf, wsf, lane, r32, hi);
        s0 = n0; s1 = n1;
        WAITV2_BAR();
    }
    attn_store(st, Y + (rowb + 256 * qb + 32 * wid) * DMODEL + 64 * h, DMODEL, wsf, (MLAS bf16_t*)(L + L_OST) + wid * 2048, lane, r32, hi);
    WAITV_BAR();
}

__device__ __forceinline__ void sgu_unit(int b, int n, int g, const bf16_t* Z1, const float* sst, const float* lng, const float* lnb, const bf16_t* Wm, const float* bs, bf16_t* Y, char* shm, const int wave_s) {
    const int tid_ = wave_s * 64 + lane_opaque(); const int tid = tid_, lane = tid & 63, r32 = lane & 31, hi = lane >> 5; const int wid = __builtin_amdgcn_readfirstlane(tid >> 6);
    MLAS char* L = (MLAS char*)shm;
    MLAS bf16_t* vn = (MLAS bf16_t*)L;
    constexpr int VP = 136;
    const size_t tok0 = (size_t)b * SEQ + 128 * n;
    {
        const int j = tid >> 2, cq = (tid & 3) * 32;
        const float* sp = sst + (tok0 + j) * 16;
        float s1 = 0.f, s2 = 0.f;
#pragma unroll
        for (int k = 0; k < 8; ++k) { s1 += sp[2 * k]; s2 += sp[2 * k + 1]; }
        const float mu = s1 * (1.0f / 512.0f); const float var = fmaxf(s2 * (1.0f / 512.0f) - mu * mu, 0.f);
        const float rstd = 1.0f / sqrtf(var + RMS_EPS);
        const bf16_t* vp = Z1 + (tok0 + j) * Z1P + 2048 + 128 * g + cq;
#pragma unroll
        for (int k = 0; k < 4; ++k) {
            const u32x4 w = *(const u32x4*)(vp + 8 * k);
            const int cc = 128 * g + cq + 8 * k;
            const f32x4 g0 = *(const f32x4*)(lng + cc), g1 = *(const f32x4*)(lng + cc + 4), b0 = *(const f32x4*)(lnb + cc), b1 = *(const f32x4*)(lnb + cc + 4);
            float x[8] = {pg8::bf_lo(w.x), pg8::bf_hi(w.x), pg8::bf_lo(w.y), pg8::bf_hi(w.y), pg8::bf_lo(w.z), pg8::bf_hi(w.z), pg8::bf_lo(w.w), pg8::bf_hi(w.w)};
            float y[8];
#pragma unroll
            for (int i = 0; i < 4; ++i) { y[i] = (x[i] - mu) * rstd * g0[i] + b0[i]; y[4 + i] = (x[4 + i] - mu) * rstd * g1[i] + b1[i]; }
            u32x4 o; o.x = cvtpk(y[0], y[1]); o.y = cvtpk(y[2], y[3]); o.z = cvtpk(y[4], y[5]); o.w = cvtpk(y[6], y[7]);
            *(MLAS u32x4*)(vn + j * VP + cq + 8 * k) = o;
        }
    }
    LGKM_BAR();
    MLAS bf16_t* ut = (MLAS bf16_t*)(L + 128 * VP * 2);
    {
        const int j = tid >> 2, cq = (tid & 3) * 32;
        const bf16_t* up = Z1 + (tok0 + j) * Z1P + 1536 + 128 * g + cq;
#pragma unroll
        for (int k = 0; k < 4; ++k) *(MLAS u32x4*)(ut + j * VP + cq + 8 * k) = *(const u32x4*)(up + 8 * k);
    }
    LGKM_BAR();
    const int ib = wid & 3;
    const bf16_t* wrow = Wm + ((size_t)g * 128 + 32 * ib + r32) * 128 + 8 * hi;
    bf16x8 af[8];
#pragma unroll
    for (int s = 0; s < 8; ++s) af[s] = *(const bf16x8*)(wrow + 16 * s);
#pragma unroll
    for (int cbi = 0; cbi < 2; ++cbi) {
        const int cb = (wid >> 2) * 2 + cbi;
        f32x16 acc = {};
        lds_cptr bp = (lds_cptr)(vn) + ((size_t)(8 * hi + ((lane & 15) >> 2)) * VP + 32 * cb + 16 * ((lane >> 4) & 1) + 4 * (lane & 3)) * 2;
#pragma unroll
        for (int s = 0; s < 8; ++s) {
            const s16x4 lo = vtr(bp + (16 * s) * VP * 2), hh = vtr(bp + (16 * s + 4) * VP * 2);
            const bf16x8 bfr = {lo[0], lo[1], lo[2], lo[3], hh[0], hh[1], hh[2], hh[3]};
            acc = __builtin_amdgcn_mfma_f32_32x32x16_bf16(af[s], bfr, acc, 0, 0, 0);
        }
        float a16[16]; V16_TO_ARR(acc, a16, 0);
#pragma unroll
        for (int r = 0; r < 16; ++r) {
            const int i = 32 * ib + crow(r, hi), cc = 32 * cb + r32;
            const float uu = __builtin_bit_cast(float, (unsigned)ut[i * VP + cc] << 16);
            const float o = uu * (a16[r] + bs[g * 128 + i]);
            ut[i * VP + cc] = (bf16_t)(cvtpk(o, 0.f) & 0xffffu);
        }
    }
    LGKM_BAR();
    {
        const int j = tid >> 2, cq = (tid & 3) * 32;
        bf16_t* yp = Y + (tok0 + j) * DMODEL + 512 + 128 * g + cq;
#pragma unroll
        for (int k = 0; k < 4; ++k) *(u32x4*)(yp + 8 * k) = *(const MLAS u32x4*)(ut + j * VP + cq + 8 * k);
    }
    LGKM_BAR();
}

__device__ __forceinline__ void pool_item(int item, const bf16_t* Z0, bf16_t* Y) {
    const int row = item >> 6, ch = item & 63, c0 = ch * 8, g = ch >> 4;
    const int w = 2 << g, tpos = row & (SEQ - 1);
    const int cnt = (tpos + 1 < w) ? tpos + 1 : w;
    u32x4 v[16];
#pragma unroll
    for (int k = 0; k < 16; ++k) { v[k] = (u32x4){0u, 0u, 0u, 0u}; if (k < cnt) v[k] = *(const u32x4*)(Z0 + (size_t)(row - k) * EV_N + c0); }
    float s[8] = {0.f, 0.f, 0.f, 0.f, 0.f, 0.f, 0.f, 0.f};
#pragma unroll
    for (int k = 0; k < 16; ++k) {
        s[0] += pg8::bf_lo(v[k].x); s[1] += pg8::bf_hi(v[k].x); s[2] += pg8::bf_lo(v[k].y); s[3] += pg8::bf_hi(v[k].y);
        s[4] += pg8::bf_lo(v[k].z); s[5] += pg8::bf_hi(v[k].z); s[6] += pg8::bf_lo(v[k].w); s[7] += pg8::bf_hi(v[k].w);
    }
    const float self[8] = {pg8::bf_lo(v[0].x), pg8::bf_hi(v[0].x), pg8::bf_lo(v[0].y), pg8::bf_hi(v[0].y), pg8::bf_lo(v[0].z), pg8::bf_hi(v[0].z), pg8::bf_lo(v[0].w), pg8::bf_hi(v[0].w)};
    const float inv = 1.0f / (float)cnt;
    u32x4 o; o.x = cvtpk(s[0] * inv - self[0], s[1] * inv - self[1]); o.y = cvtpk(s[2] * inv - self[2], s[3] * inv - self[3]);
    o.z = cvtpk(s[4] * inv - self[4], s[5] * inv - self[5]); o.w = cvtpk(s[6] * inv - self[6], s[7] * inv - self[7]);
    *(u32x4*)(Y + (size_t)row * DMODEL + c0) = o;
}
}
namespace foxa {
using bf16=__hip_bfloat16;
using bf16x8=__attribute__((ext_vector_type(8)))short;
using s16x4=__attribute__((ext_vector_type(4)))short;
using f32x16=__attribute__((ext_vector_type(16)))float;
using u32x4=__attribute__((ext_vector_type(4)))unsigned;
using f32x4v=__attribute__((ext_vector_type(4)))float;
constexpr int CUM_OFF=86016;
constexpr int SEQL=2048,D=64,OPI=1024;
constexpr int NW=8,QBLK=32,QB=QBLK*NW,KVBLK=64;
__device__ __forceinline__ int crow(int r,int hi){return (r&3)+8*(r>>2)+4*hi;}
#define SBAR() __builtin_amdgcn_sched_barrier(0)
__device__ __forceinline__ void cmask(f32x16&p0,f32x16&p1,int jb,int qrel,int hi){
  const float NEG=-INFINITY; int kb=64*jb+4*hi;
  #pragma unroll
  for(int r=0;r<16;++r){int kv=kb+(r&3)+8*(r>>2); if(kv>qrel)p0[r]=NEG; if(kv+32>qrel)p1[r]=NEG;}
}

constexpr int NSLOT=3, SLOTB=8192;
constexpr int LDS_K=0, LDS_V=NSLOT*SLOTB, LDS_WS=2*NSLOT*SLOTB, LDS_OST=LDS_WS+NW*64*4, LDS_BYTES=LDS_OST+NW*4096;
constexpr float C2=0.125f*1.4426950408889634f;
__device__ __forceinline__ void glds16(const void*gsrc,unsigned lds_dst){unsigned keep;
  asm volatile("s_mov_b32 %0, m0\n\ts_mov_b32 m0, %2\n\ts_nop 0\n\tglobal_load_lds_dwordx4 %1, off\n\ts_mov_b32 m0, %0":"=&s"(keep):"v"(gsrc),"s"(lds_dst):"memory");}
__device__ __forceinline__ float max3f(float a,float b,float c){float r;asm("v_max3_f32 %0, %1, %2, %3":"=v"(r):"v"(a),"v"(b),"v"(c));return r;}
__device__ __forceinline__ float max2f(float a,float b){float r;asm("v_max_f32_e32 %0, %1, %2":"=v"(r):"v"(a),"v"(b));return r;}
__device__ __forceinline__ float fadd_s(float a,float b){float r;asm("v_add_f32_e32 %0, %1, %2":"=v"(r):"v"(a),"v"(b));return r;}
__device__ __forceinline__ float fsub_s(float a,float b){float r;asm("v_sub_f32_e32 %0, %1, %2":"=v"(r):"v"(a),"v"(b));return r;}
typedef float f32x2_t __attribute__((ext_vector_type(2))); typedef __bf16 bf16x2_t __attribute__((ext_vector_type(2)));
__device__ __forceinline__ unsigned cvtpk_s(float lo,float hi){f32x2_t v={lo,hi};bf16x2_t b=__builtin_convertvector(v,bf16x2_t);return __builtin_bit_cast(unsigned,b);}
#define WAIT_BAR(N) asm volatile("s_waitcnt vmcnt(" #N ") lgkmcnt(0)\n\ts_barrier":::"memory")

__device__ __forceinline__ void qkt(f32x16&p0,f32x16&p1,const char*Kslot,const bf16x8*qr,const f32x16&negm,int r32,int hi){
  const char*kb=Kslot+hi*1024+r32*16;
  #pragma unroll
  for(int d0=0;d0<4;++d0){
    const bf16x8 b0=*reinterpret_cast<const bf16x8*>(kb+d0*2048);
    const bf16x8 b1=*reinterpret_cast<const bf16x8*>(kb+d0*2048+512);
    if(d0==0){p0=__builtin_amdgcn_mfma_f32_32x32x16_bf16(b0,qr[0],negm,0,0,0);p1=__builtin_amdgcn_mfma_f32_32x32x16_bf16(b1,qr[0],negm,0,0,0);}
    else{p0=__builtin_amdgcn_mfma_f32_32x32x16_bf16(b0,qr[d0],p0,0,0,0);p1=__builtin_amdgcn_mfma_f32_32x32x16_bf16(b1,qr[d0],p1,0,0,0);}}
}
typedef __attribute__((address_space(3))) const char* lds_cptr;
typedef short v4i16_t __attribute__((ext_vector_type(4)));
__device__ __forceinline__ void kload8(bf16x8*kf,lds_cptr kp){
  kf[0]=*(const __attribute__((address_space(3))) bf16x8*)(kp);      kf[1]=*(const __attribute__((address_space(3))) bf16x8*)(kp+512);
  kf[2]=*(const __attribute__((address_space(3))) bf16x8*)(kp+2048); kf[3]=*(const __attribute__((address_space(3))) bf16x8*)(kp+2560);
  kf[4]=*(const __attribute__((address_space(3))) bf16x8*)(kp+4096); kf[5]=*(const __attribute__((address_space(3))) bf16x8*)(kp+4608);
  kf[6]=*(const __attribute__((address_space(3))) bf16x8*)(kp+6144); kf[7]=*(const __attribute__((address_space(3))) bf16x8*)(kp+6656);
}
__device__ __forceinline__ void kload2(bf16x8*kf,lds_cptr kp,int j){ kf[2*j]=*(const __attribute__((address_space(3))) bf16x8*)(kp+j*2048); kf[2*j+1]=*(const __attribute__((address_space(3))) bf16x8*)(kp+j*2048+512); }
__device__ __forceinline__ s16x4 vtr(lds_cptr p){ return __builtin_bit_cast(s16x4,__builtin_amdgcn_ds_read_tr16_b64_v4i16((__attribute__((address_space(3))) v4i16_t*)p)); }
__device__ __forceinline__ float rowmax(const f32x16&p0,const f32x16&p1){
  float a=max3f(p0[0],p0[1],p1[0]),b=max3f(p0[2],p0[3],p1[1]);a=max3f(a,p1[2],p1[3]);
  #pragma unroll
  for(int r=4;r<16;r+=4){a=max3f(a,p0[r],p0[r+1]);b=max3f(b,p0[r+2],p0[r+3]);a=max3f(a,p1[r],p1[r+1]);b=max3f(b,p1[r+2],p1[r+3]);}
  const float m=max2f(a,b);
  auto rr=__builtin_amdgcn_permlane32_swap(__float_as_uint(m),__float_as_uint(m),false,false);
  return max2f(__uint_as_float(rr[0]),__uint_as_float(rr[1]));
}
__device__ __forceinline__ void pv(f32x16*o,int vb,bf16x8 pa0,bf16x8 pa1,bf16x8 pa2,bf16x8 pa3){
  #pragma unroll
  for(int d0=0;d0<2;++d0){s16x4 lo[4],hi[4];
    #pragma unroll
    for(int ks=0;ks<4;++ks){
      asm volatile("ds_read_b64_tr_b16 %0,%1 offset:%c2":"=&v"(lo[ks]):"v"(vb),"i"(d0*4096+ks*1024):"memory");
      asm volatile("ds_read_b64_tr_b16 %0,%1 offset:%c2":"=&v"(hi[ks]):"v"(vb),"i"(d0*4096+ks*1024+512):"memory");}
    asm volatile("s_waitcnt lgkmcnt(0)":::"memory");SBAR();
    #define PK(k) (bf16x8){lo[k][0],lo[k][1],lo[k][2],lo[k][3],hi[k][0],hi[k][1],hi[k][2],hi[k][3]}
    o[d0]=__builtin_amdgcn_mfma_f32_32x32x16_bf16(pa0,PK(0),o[d0],0,0,0);
    o[d0]=__builtin_amdgcn_mfma_f32_32x32x16_bf16(pa1,PK(1),o[d0],0,0,0);
    o[d0]=__builtin_amdgcn_mfma_f32_32x32x16_bf16(pa2,PK(2),o[d0],0,0,0);
    o[d0]=__builtin_amdgcn_mfma_f32_32x32x16_bf16(pa3,PK(3),o[d0],0,0,0);
    #undef PK
  }
}

#ifndef ATTN_STORE16
#define ATTN_STORE16(p,v) (*(u32x4*)(p)=(v))
#endif
template<int THRL,int MODE,int QKVP,class CumFn> __device__ __forceinline__ void attn_unit(CumFn&& CUMFN,int b,int h,int qb,int q0abs,int NTU,const bf16*Q,const bf16*__restrict__ K,const bf16*__restrict__ V,bf16*O,char*shm,const __attribute__((address_space(3))) unsigned*selw,const int wave_s){
  const int tid=wave_s*64+lane_opaque(),lane=tid&63,r32=lane&31,hi=lane>>5; const int wid=__builtin_amdgcn_readfirstlane(tid>>6);
  const long rowbase=(long)b*SEQL; const int q0=(MODE==0)?qb*QB:q0abs;
  const bf16*Qw=(MODE==0)?Q+(rowbase+q0+wid*QBLK)*QKVP+h*D:Q+(rowbase+q0)*QKVP+wid*D;
  const bf16*Kh=K+rowbase*QKVP+h*D,*Vh=V+rowbase*QKVP+h*D;
  const unsigned lds0=(unsigned)(uintptr_t)shm;
  float*wsf=(float*)(shm+LDS_WS)+wid*64;
  const bf16*ksrc=Kh+(long)lane*QKVP+wid*8;
  const bf16*vsrc=Vh+(long)(16*(wid&3)+(lane>>2))*QKVP+(wid>>2)*32+(lane&3)*8;
  const unsigned kdst=lds0+LDS_K+wid*1024, vdst=lds0+LDS_V+wid*1024;
  #define DMA_K(t,slot) glds16(ksrc+(long)(t)*KVBLK*QKVP,(unsigned)__builtin_amdgcn_readfirstlane(kdst+(slot)))
  #define DMA_V(t,slot) glds16(vsrc+(long)(t)*KVBLK*QKVP,(unsigned)__builtin_amdgcn_readfirstlane(vdst+(slot)))
  const int vb0=(int)(lds0+LDS_V)+((lane>>4)&1)*32+(lane&3)*8+(4*hi+((lane&15)>>2))*64;
  const char*Kbase=shm+LDS_K; bf16x8 kf[8];
  const lds_cptr shm3=(lds_cptr)shm; const lds_cptr kp0=shm3+LDS_K+hi*1024+r32*16; const lds_cptr vp0=shm3+LDS_V+((lane>>4)&1)*32+(lane&3)*8+(4*hi+((lane&15)>>2))*64;
  const int NT=(MODE==0)?(q0+QB)/KVBLK:NTU;
  DMA_K(0,0);DMA_V(0,0);DMA_K(1,SLOTB);
  if constexpr(MODE==0){ CUMFN(); }
  bf16x8 qr[4];
  #pragma unroll
  for(int d0=0;d0<4;++d0)qr[d0]=*reinterpret_cast<const bf16x8*>(&Qw[(long)r32*QKVP+d0*16+hi*8]);
  float mhat=0.f,l_reg=0.f;float z_=0.f;asm volatile("":"+v"(z_));f32x16 o[2];o[0]=(f32x16){z_,z_,z_,z_,z_,z_,z_,z_,z_,z_,z_,z_,z_,z_,z_,z_};o[1]=o[0];f32x16 negm=o[0];asm volatile("":"+v"(negm));
  const int qrel=wid*QBLK+r32;
  const __attribute__((address_space(3))) float*cum2=(const __attribute__((address_space(3))) float*)(shm+CUM_OFF);
  const float cq2=(MODE==0)?cum2[q0+qrel]:0.f;
  #define BIAS(P0,P1,t) do{ if constexpr(MODE==0){ const __attribute__((address_space(3))) float*cb_=cum2+64*(t)+4*hi; \
    _Pragma("unroll") for(int g_=0;g_<4;++g_){ const f32x4v c0_=*(const __attribute__((address_space(3))) f32x4v*)(cb_+8*g_), c1_=*(const __attribute__((address_space(3))) f32x4v*)(cb_+32+8*g_); \
      P0[4*g_+0]+=cq2-c0_.x; P0[4*g_+1]+=cq2-c0_.y; P0[4*g_+2]+=cq2-c0_.z; P0[4*g_+3]+=cq2-c0_.w; \
      P1[4*g_+0]+=cq2-c1_.x; P1[4*g_+1]+=cq2-c1_.y; P1[4*g_+2]+=cq2-c1_.z; P1[4*g_+3]+=cq2-c1_.w; } } }while(0)
  #define SELM(P0,P1,t) do{ if constexpr(MODE==1){ const unsigned w0_=selw[(2*(t))*32+r32]>>(4*hi), w1_=selw[(2*(t)+1)*32+r32]>>(4*hi); \
    _Pragma("unroll") for(int r=0;r<16;++r){ const int sh_=(r&3)+8*(r>>2); if(!((w0_>>sh_)&1u))P0[r]=-INFINITY; if(!((w1_>>sh_)&1u))P1[r]=-INFINITY; } } }while(0)
  #define CMASK(P0,P1,t) do{ if constexpr(MODE==0){int jb_=(t)-(NT-4); if(jb_>=0)cmask(P0,P1,jb_,qrel,hi);} }while(0)
  bool resc=false;
  #define START(P0,P1) do{ const float rm=rowmax(P0,P1); resc=false; \
    { const float dl=(MODE==1&&!(rm>-1e30f))?0.f:rm; mhat=fadd_s(mhat,dl); \
      _Pragma("unroll") for(int r=0;r<16;++r){P0[r]=fsub_s(P0[r],dl);P1[r]=fsub_s(P1[r],dl);} \
      _Pragma("unroll") for(int r=0;r<16;++r)negm[r]=-mhat; asm volatile("":"+v"(negm)); } \
    _Pragma("unroll") for(int r=0;r<16;++r)P0[r]=__builtin_amdgcn_exp2f(P0[r]); }while(0)
  #define RESC() do{ if(resc){ asm volatile("s_waitcnt lgkmcnt(0)":::"memory"); \
      _Pragma("unroll") for(int d_=0;d_<2;++d_) _Pragma("unroll") for(int r=0;r<16;++r)o[d_][r]*=wsf[crow(r,hi)]; } }while(0)
  f32x16 pA0,pA1,pB0,pB1;
  int sl_prev=0,sl_cur=0,sl_next=SLOTB;
  #define ROT() do{sl_prev=sl_cur;sl_cur=sl_next;sl_next=(sl_next==(NSLOT-1)*SLOTB)?0:sl_next+SLOTB;}while(0)
  DMA_K(2,2*SLOTB);
  WAIT_BAR(3);
  qkt(pA0,pA1,Kbase,qr,negm,r32,hi);asm volatile("s_nop 15\n\ts_nop 7":"+v"(pA0),"+v"(pA1));BIAS(pA0,pA1,0);SELM(pA0,pA1,0);CMASK(pA0,pA1,0);
  START(pA0,pA1);
  _Pragma("unroll") for(int r=0;r<16;++r)pA1[r]=__builtin_amdgcn_exp2f(pA1[r]);
  WAIT_BAR(0);
  DMA_K(3,0);DMA_V(1,SLOTB);
  ROT();
  kload8(kf,kp0+sl_cur);
  WAIT_BAR(2);
  s16x4 vlo[8],vhi[8]; u32x4 pw0,pw1,pw2,pw3;
  #define PKW(P,B) cvtpk_s(P[B],P[B+1])
  #define PAF(k) __builtin_bit_cast(bf16x8,pw##k)
  #define VFR(i) (bf16x8){vlo[i][0],vlo[i][1],vlo[i][2],vlo[i][3],vhi[i][0],vhi[i][1],vhi[i][2],vhi[i][3]}
  #define PIN(x) asm volatile("":"+v"(x))
  #define MX3(a,b,c) __builtin_fmaxf(__builtin_fmaxf((a),(b)),(c))
  #define GAPA(MF,A0,A1,A2,A3,W0,W1,PW) do{ MF; sacc+=A0; sacc+=A1; sacc+=A2; sacc+=A3; PIN(sacc); W0; W1; PIN(PW); SBAR(); }while(0)
  #define EX(v) __builtin_amdgcn_exp2f(v)
  #define GAPB(MF,X,B) do{ MF; X[B]=EX(X[B]); X[B+1]=EX(X[B+1]); X[B+2]=EX(X[B+2]); X[B+3]=EX(X[B+3]); PIN(X); SBAR(); }while(0)
  #define VRD(i) do{ vlo[i]=vtr(vp_+(((i)>>2)*4096+((i)&3)*1024)); vhi[i]=vtr(vp_+(((i)>>2)*4096+((i)&3)*1024+512)); }while(0)
  #define KRD(G,j) do{ if(G){ kload2(kf,kp0+sl_next,j); SBAR(); } }while(0)
  #define STEP(C0,C1,P0,P1,t,GK,GV,GL) do{ SBAR(); \
    const lds_cptr vp_=vp0+sl_prev; \
    VRD(0); SBAR(); float sacc=(P0[0]+P0[1]); \
    GAPA(C0=__builtin_amdgcn_mfma_f32_32x32x16_bf16(kf[0],qr[0],negm,0,0,0), P0[2],P0[3],P0[4],P0[5],     pw0[0]=PKW(P0,0), pw0[1]=PKW(P0,2), pw0); \
    VRD(4); SBAR(); GAPA(C1=__builtin_amdgcn_mfma_f32_32x32x16_bf16(kf[1],qr[0],negm,0,0,0), P0[6],P0[7],P0[8],P0[9],     pw0[2]=PKW(P0,4), pw0[3]=PKW(P0,6), pw0); \
    VRD(1); SBAR(); GAPA(C0=__builtin_amdgcn_mfma_f32_32x32x16_bf16(kf[2],qr[1],C0,0,0,0),   P0[10],P0[11],P0[12],P0[13], pw1[0]=PKW(P0,8), pw1[1]=PKW(P0,10), pw1); \
    VRD(5); SBAR(); GAPA(C1=__builtin_amdgcn_mfma_f32_32x32x16_bf16(kf[3],qr[1],C1,0,0,0),   P0[14],P0[15],P1[0],P1[1],   pw1[2]=PKW(P0,12),pw1[3]=PKW(P0,14), pw1); \
    VRD(2); SBAR(); GAPA(C0=__builtin_amdgcn_mfma_f32_32x32x16_bf16(kf[4],qr[2],C0,0,0,0),   P1[2],P1[3],P1[4],P1[5],     pw2[0]=PKW(P1,0), pw2[1]=PKW(P1,2), pw2); \
    VRD(6); SBAR(); GAPA(C1=__builtin_amdgcn_mfma_f32_32x32x16_bf16(kf[5],qr[2],C1,0,0,0),   P1[6],P1[7],P1[8],P1[9],     pw2[2]=PKW(P1,4), pw2[3]=PKW(P1,6), pw2); \
    VRD(3); SBAR(); GAPA(C0=__builtin_amdgcn_mfma_f32_32x32x16_bf16(kf[6],qr[3],C0,0,0,0),   P1[10],P1[11],P1[12],P1[13], pw3[0]=PKW(P1,8), pw3[1]=PKW(P1,10), pw3); \
    VRD(7); SBAR(); GAPA(C1=__builtin_amdgcn_mfma_f32_32x32x16_bf16(kf[7],qr[3],C1,0,0,0),   P1[14],P1[15],0.f,0.f,       pw3[2]=PKW(P1,12),pw3[3]=PKW(P1,14), pw3); \
    l_reg+=sacc; \
    if(GK){DMA_K((t)+3,sl_cur);} if(GV){DMA_V((t)+1,sl_next);} \
    BIAS(C0,C1,t); SELM(C0,C1,t); CMASK(C0,C1,t); \
    { float a=MX3(C0[0],C0[1],C1[0]),b=MX3(C0[2],C0[3],C1[1]); a=MX3(a,C1[2],C1[3]); \
      _Pragma("unroll") for(int r=4;r<16;r+=4){a=MX3(a,C0[r],C0[r+1]);b=MX3(b,C0[r+2],C0[r+3]);a=MX3(a,C1[r],C1[r+1]);b=MX3(b,C1[r+2],C1[r+3]);} \
      float rm=__builtin_fmaxf(a,b); { auto rr=__builtin_amdgcn_permlane32_swap(__float_as_uint(rm),__float_as_uint(rm),false,false); rm=__builtin_fmaxf(__uint_as_float(rr[0]),__uint_as_float(rr[1])); } \
      resc=false; \
      if(__builtin_expect(__any(rm>(float)THRL),0)){ const float dl=__builtin_fmaxf(rm,0.f); mhat+=dl; \
        _Pragma("unroll") for(int r=0;r<16;++r){C0[r]-=dl;C1[r]-=dl;} \
        _Pragma("unroll") for(int r=0;r<16;++r)negm[r]=-mhat; asm volatile("":"+v"(negm)); \
        const float f=__builtin_amdgcn_exp2f(-dl); l_reg*=f; if(hi==0)wsf[r32]=f; resc=true; } } \
    SBAR(); \
    GAPB(o[0]=__builtin_amdgcn_mfma_f32_32x32x16_bf16(PAF(0),VFR(0),o[0],0,0,0), C0,0); \
    GAPB(o[1]=__builtin_amdgcn_mfma_f32_32x32x16_bf16(PAF(0),VFR(4),o[1],0,0,0), C0,4); \
    KRD(GL,0); GAPB(o[0]=__builtin_amdgcn_mfma_f32_32x32x16_bf16(PAF(1),VFR(1),o[0],0,0,0), C0,8); \
    KRD(GL,1); GAPB(o[1]=__builtin_amdgcn_mfma_f32_32x32x16_bf16(PAF(1),VFR(5),o[1],0,0,0), C0,12); \
    KRD(GL,2); GAPB(o[0]=__builtin_amdgcn_mfma_f32_32x32x16_bf16(PAF(2),VFR(2),o[0],0,0,0), C1,0); \
    KRD(GL,3); GAPB(o[1]=__builtin_amdgcn_mfma_f32_32x32x16_bf16(PAF(2),VFR(6),o[1],0,0,0), C1,4); \
    GAPB(o[0]=__builtin_amdgcn_mfma_f32_32x32x16_bf16(PAF(3),VFR(3),o[0],0,0,0), C1,8); \
    GAPB(o[1]=__builtin_amdgcn_mfma_f32_32x32x16_bf16(PAF(3),VFR(7),o[1],0,0,0), C1,12); \
    }while(0)
  int t=1;
  #undef CMASK
  #define CMASK(P0,P1,t) do{}while(0)
  for(;t+5<NT;t+=2){
    STEP(pB0,pB1,pA0,pA1,t,true,true,true);     WAIT_BAR(2); RESC(); ROT();
    STEP(pA0,pA1,pB0,pB1,t+1,true,true,true);   WAIT_BAR(2); RESC(); ROT();
  }
  #undef CMASK
  #define CMASK(P0,P1,t) do{ if constexpr(MODE==0){int jb_=(t)-(NT-4); if(jb_>=0)cmask(P0,P1,jb_,qrel,hi);} }while(0)
  #define ENDW(tt) do{ if((tt)+3<NT){WAIT_BAR(2);} else if((tt)+2<NT){WAIT_BAR(1);} else {WAIT_BAR(0);} }while(0)
  for(;t+1<NT;t+=2){
    STEP(pB0,pB1,pA0,pA1,t,(t+3<NT),(t+1<NT),(t+1<NT));       ENDW(t);   RESC(); ROT();
    STEP(pA0,pA1,pB0,pB1,t+1,(t+4<NT),(t+2<NT),(t+2<NT));     ENDW(t+1); RESC(); ROT();
  }
  STEP(pB0,pB1,pA0,pA1,NT-1,false,false,false); RESC();
  { float sacc=pB0[0]+pB0[1]; _Pragma("unroll") for(int r=2;r<16;++r)sacc+=pB0[r]; _Pragma("unroll") for(int r=0;r<16;++r)sacc+=pB1[r]; l_reg+=sacc;
    pw0=(u32x4){PKW(pB0,0),PKW(pB0,2),PKW(pB0,4),PKW(pB0,6)};pw1=(u32x4){PKW(pB0,8),PKW(pB0,10),PKW(pB0,12),PKW(pB0,14)};pw2=(u32x4){PKW(pB1,0),PKW(pB1,2),PKW(pB1,4),PKW(pB1,6)};pw3=(u32x4){PKW(pB1,8),PKW(pB1,10),PKW(pB1,12),PKW(pB1,14)};
    SBAR(); pv(o,vb0+sl_cur,PAF(0),PAF(1),PAF(2),PAF(3)); }
  #undef PKW
  #undef PAF
  #undef VFR
  #undef PIN
  #undef MX3
  #undef GAPA
  #undef GAPB
  #undef EX
  #undef VRD
  #undef KRD
  #undef STEP
  #undef ENDW
  {auto rr=__builtin_amdgcn_permlane32_swap(__float_as_uint(l_reg),__float_as_uint(l_reg),false,false);l_reg=__uint_as_float(rr[0])+__uint_as_float(rr[1]);}
  if(hi==0)wsf[32+r32]=l_reg;asm volatile("s_waitcnt lgkmcnt(0)":::"memory");
  float rli[16];
  #pragma unroll
  for(int r=0;r<16;++r)rli[r]=__builtin_amdgcn_rcpf(wsf[32+crow(r,hi)]);
  bf16*Ow=(MODE==0)?O+(rowbase+q0+wid*QBLK)*OPI+h*D:O+(rowbase+q0)*OPI+wid*D;
  { bf16*stg=(bf16*)(shm+LDS_OST)+wid*2048;
    #pragma unroll
    for(int r=0;r<16;++r){const int orow=crow(r,hi);
      #pragma unroll
      for(int d0=0;d0<2;++d0)stg[orow*64+d0*32+r32]=__float2bfloat16(o[d0][r]*rli[r]);}
    asm volatile("s_waitcnt lgkmcnt(0)":::"memory");
    #pragma unroll
    for(int i=0;i<4;++i){const int row=i*8+(lane>>3),ch=lane&7; const u32x4 v=*(const u32x4*)(stg+row*64+ch*8); ATTN_STORE16(Ow+(long)row*OPI+ch*8,v);} }
  asm volatile("s_waitcnt lgkmcnt(0)\n\ts_barrier":::"memory");
  #undef DMA_K
  #undef DMA_V
  #undef CMASK
  #undef START
  #undef BIAS
  #undef SELM
  #undef RESC
  #undef ROT
}
#undef SBAR
#undef WAIT_BAR
}

#ifndef DBG_REP_SEL
#define DBG_REP_SEL 1
#endif
namespace mix {
__device__ __forceinline__ void fox_unit2(int b, int h, int qb, const bf16_t* Z1, const float* F, const float* bfp, bf16_t* Y, char* shm, const int wave_s) {
    const size_t rowb = (size_t)b * SEQ;
    const int nk = 256 * (qb + 1);
    auto cumfn = [=]() {
        const int tid = wave_s * 64 + lane_opaque(), lane = tid & 63; const int wid = __builtin_amdgcn_readfirstlane(tid >> 6);
        MLAS char* L = (MLAS char*)shm;
        MLAS float* cum2 = (MLAS float*)(L + foxa::CUM_OFF);
        MLAS float* wtot = (MLAS float*)(L + foxa::CUM_OFF + 8192);
        const float bias = bfp[h];
        const int s0 = 4 * tid;
        float v[4]; float run = 0.f;
#pragma unroll
        for (int i = 0; i < 4; ++i) {
            float x = 0.f;
            if (s0 + i < nk) x = F[(rowb + s0 + i) * 8 + h] + bias;
            const float ls = (s0 + i < nk) ? (fminf(x, 0.f) - log1pf(expf(-fabsf(x)))) : 0.f;
            run += ls; v[i] = run;
        }
        float inc = run;
#pragma unroll
        for (int o = 1; o < 64; o <<= 1) { const int ln = lane_opaque(); const float t = __builtin_bit_cast(float, __builtin_amdgcn_ds_bpermute((ln - o) << 2, __builtin_bit_cast(int, inc))); if (ln >= o) inc += t; }
        if (lane == 63) wtot[wid] = inc;
        LGKM_BAR();
        float off = inc - run;
        for (int w = 0; w < wid; ++w) off += wtot[w];
#pragma unroll
        for (int i = 0; i < 4; ++i) cum2[s0 + i] = (off + v[i]) * 1.4426950408889634f;
        LGKM_BAR();
    };
    foxa::attn_unit<8, 0, 2560>(cumfn, b, h, qb, 0, 0, (const foxa::bf16*)Z1, (const foxa::bf16*)(Z1 + 512), (const foxa::bf16*)(Z1 + 1024), (foxa::bf16*)Y, shm, nullptr, wave_s);
}
__device__ __forceinline__ void dsa_unit(int b, int qg, const bf16_t* Z0, bf16_t* Y, char* shm, unsigned lds0, const int wave_s) {
    for (int rep_ = 0; rep_ < DBG_REP_SEL; ++rep_) dsa_select(b, qg, Z0, shm, wave_s);
    const int nt64 = (qg >> 1) + 1; int ntu = (nt64 + 1) & ~1; if (ntu < 4) ntu = 4;
    foxa::attn_unit<8, 1, EV_N>([]() {}, b, 0, 0, 32 * qg, ntu, (const foxa::bf16*)(Z0 + 512), (const foxa::bf16*)(Z0 + 1024), (const foxa::bf16*)(Z0 + 1088), (foxa::bf16*)(Y + 512), shm,
                                (const MLAS unsigned*)((MLAS char*)shm + LX_SEL), wave_s);
}
}
constexpr int NWAVES = 8;
constexpr size_t KiB = 1024, MiB = 1u << 20;
constexpr size_t WS_CTL = 0, CTL_ZERO_BYTES = 1 * MiB;
constexpr size_t WS_W_EVIN = 1 * MiB, WS_W_OUT0 = 4 * MiB, WS_W_FFI0 = 6 * MiB, WS_W_FFO0 = 17 * MiB, WS_W_PG0 = 22 * MiB + 512 * KiB, WS_W_PP0 = 24 * MiB + 512 * KiB;
constexpr size_t WS_W_ODIN = 25 * MiB, WS_W_OUT1 = 30 * MiB + 512 * KiB, WS_W_FFI1 = 32 * MiB + 512 * KiB, WS_W_FFO1 = 43 * MiB + 512 * KiB, WS_W_PG1 = 49 * MiB, WS_W_PP1 = 51 * MiB, WS_W_SGU = 51 * MiB + 512 * KiB;
constexpr size_t WS_RSTD = 57 * MiB + 768 * KiB;
constexpr size_t WS_SSQA = 52 * MiB, WS_SSQB = 53 * MiB, WS_ROPE = 54 * MiB, WS_AH = 55 * MiB, WS_FBUF = 58 * MiB + 512 * KiB, WS_SST = 59 * MiB;
constexpr size_t WS_HB = 60 * MiB, WS_AHALO = 92 * MiB, WS_PP = 92 * MiB + 512 * KiB, WS_Y = 124 * MiB + 512 * KiB, WS_ZH = 156 * MiB + 512 * KiB, WS_PB = 244 * MiB + 512 * KiB, WS_END = 252 * MiB + 512 * KiB;
static_assert(WS_AHALO == WS_HB + (size_t)TOK * 1024 * 2, "the halo rows are row tile 64 of the FFN in-projection A operand");
static_assert(WS_W_EVIN + (size_t)EV_N * 1024 * 2 <= WS_W_OUT0 && WS_W_FFI0 + (size_t)NFF2 * 1024 * 2 <= WS_W_FFO0 && WS_W_FFO0 + (size_t)1024 * DFF * 2 <= WS_W_PG0, "ws map 1");
static_assert(WS_W_ODIN + (size_t)OD_N * 1024 * 2 <= WS_W_OUT1 && WS_W_FFI1 + (size_t)NFF2 * 1024 * 2 <= WS_W_FFO1 && WS_W_FFO1 + (size_t)1024 * DFF * 2 <= WS_W_PG1 && WS_W_SGU + 4 * 128 * 128 * 2 <= WS_SSQA, "ws map 2");
static_assert(WS_AH + (size_t)128 * NFF2 * 4 <= WS_RSTD && WS_ZH + (size_t)TOK * DFF * 2 <= WS_PB && WS_PB + (size_t)TOK * PLE * 2 <= WS_END, "ws map 3");
constexpr int CW_BAR = 4096, CW_FLAG = 8192, CW_PAN = 16384, CW_XTAB = 65536;
constexpr int RING_BYTES = 131072, XB_OFF = RING_BYTES, LDSCTL_OFF = XB_OFF + 8192 + 1024 + 64, MISC_OFF = LDSCTL_OFF + 320, LDS_BYTES = 147456;
static_assert(MISC_OFF + 128 <= LDS_BYTES, "LDS map");

#define GAS __attribute__((address_space(1)))
#define LAS __attribute__((address_space(3)))
typedef unsigned short bf16;
typedef unsigned v4u __attribute__((ext_vector_type(4)));
typedef float f32x4 __attribute__((ext_vector_type(4)));
typedef float f32x2 __attribute__((ext_vector_type(2)));
#define LDS_WAIT() asm volatile("s_waitcnt lgkmcnt(0)" ::: "memory")
#define VM_WAIT() asm volatile("s_waitcnt vmcnt(0)" ::: "memory")
__device__ __forceinline__ unsigned f2bf(float f) { unsigned u = __builtin_bit_cast(unsigned, f); return (u + 0x7fffu + ((u >> 16) & 1u)) >> 16; }
__device__ __forceinline__ unsigned pk2(float lo, float hi) { return f2bf(lo) | (f2bf(hi) << 16); }

#define XB_TMO      128
#define XB_XCNT(j)  (256  + 64 * (j))
#define XB_XSUB(j)  (1280 + 64 * (j))
#define XB_XGEN(j)  (2304 + 64 * (j))
#define XB_TOP      3328
#define XB_TOPGEN   3392
#define XCD_BAR_WORDS 3456
#define XB_SPIN_CAP (1u << 18)
__device__ __forceinline__ unsigned xb_ld(unsigned* p)              { return __hip_atomic_load(p, __ATOMIC_RELAXED, __HIP_MEMORY_SCOPE_AGENT); }
__device__ __forceinline__ unsigned xb_add(unsigned* p, unsigned v) { return __hip_atomic_fetch_add(p, v, __ATOMIC_RELAXED, __HIP_MEMORY_SCOPE_AGENT); }
__device__ __forceinline__ unsigned xb_xcc_id() { return (unsigned)__builtin_amdgcn_s_getreg((3 << 11) | 20) & 0xFu; }
#define XB_SPIN(cond, bar) do { unsigned _sp = 0; while (cond) { __builtin_amdgcn_s_sleep(1); \
    if ((++_sp & 255u) == 0u) { if (xb_ld(&(bar)[XB_TMO])) break; if (_sp > XB_SPIN_CAP) { atomicAdd(&(bar)[XB_TMO], 1u); break; } } } } while (0)
struct XcdBarrier { unsigned* bar; unsigned x; volatile LAS unsigned* st; };
__device__ __forceinline__ XcdBarrier xcd_barrier_post(unsigned* bar, volatile LAS unsigned* st) {
    XcdBarrier b; b.bar = bar; b.x = xb_xcc_id(); b.st = st;
    if (threadIdx.x == 0) (void)xb_add(&bar[XB_XCNT(b.x)], 1u);
    return b;
}
__device__ __forceinline__ void xcd_barrier_complete(unsigned* bar, unsigned x, unsigned& nloc, unsigned& nx) {
    const unsigned G = gridDim.x * gridDim.y * gridDim.z;
    unsigned sum, cnt, mine, sp = 0u;
    for (;;) {
        sum = 0u; cnt = 0u; mine = 0u;
#pragma unroll 1
        for (unsigned j = 0; j < 16; ++j) { const unsigned c = xb_ld(&bar[XB_XCNT(j)]); sum += c; cnt += (c > 0u) ? 1u : 0u; mine = (j == x) ? c : mine; }
        if (sum == G) break;
        __builtin_amdgcn_s_sleep(1);
        if ((++sp & 255u) == 0u) { if (xb_ld(&bar[XB_TMO])) break; if (sp > XB_SPIN_CAP) { atomicAdd(&bar[XB_TMO], 1u); break; } }
    }
    nloc = mine > 0u ? mine : 1u; nx = cnt > 0u ? cnt : 1u;
}
__device__ __forceinline__ void xcd_census_wave(unsigned* bar, unsigned x, volatile LAS unsigned* st) {
    const unsigned G = gridDim.x * gridDim.y * gridDim.z; const int lane = lane_opaque();
    unsigned sum, cnt, mine, sp = 0u;
    for (;;) {
        const unsigned cj = xb_ld(&bar[XB_XCNT(lane & 15)]);
        sum = 0u; cnt = 0u; mine = 0u;
#pragma unroll 1
        for (unsigned j = 0; j < 16; ++j) { const unsigned c = (unsigned)__builtin_amdgcn_readlane((int)cj, (int)j); sum += c; cnt += (c > 0u) ? 1u : 0u; mine = (j == x) ? c : mine; }
        if (sum == G) break;
        __builtin_amdgcn_s_sleep(1);
        if ((++sp & 255u) == 0u) { if (xb_ld(&bar[XB_TMO])) break; if (sp > XB_SPIN_CAP) { if (lane == 0) atomicAdd(&bar[XB_TMO], 1u); break; } }
    }
    if (lane == 0) { st[0] = mine > 0u ? mine : 1u; st[1] = cnt > 0u ? cnt : 1u; }
}
__device__ __forceinline__ void xcd_barrier(const XcdBarrier& b, unsigned* nonlocal = nullptr) {
    asm volatile("s_waitcnt vmcnt(0)" ::: "memory");
    __syncthreads();
    if (threadIdx.x == 0) {
        unsigned* bar = b.bar;
        __builtin_amdgcn_s_waitcnt(0);
        unsigned nloc = b.st[0], nx = b.st[1];
        if (nloc == 0u) { xcd_barrier_complete(bar, b.x, nloc, nx); b.st[0] = nloc; b.st[1] = nx; }
        const unsigned old = xb_add(&bar[XB_XSUB(b.x)], 1u);
        const unsigned gen = old / nloc;
        if (old + 1u == (gen + 1u) * nloc) {
            if (nonlocal == nullptr || xb_ld(nonlocal) != 0u) { __builtin_amdgcn_fence(__ATOMIC_RELEASE, "agent"); asm volatile("s_waitcnt vmcnt(0)" ::: "memory"); }
            __builtin_amdgcn_fence(__ATOMIC_ACQUIRE, "agent");
            const unsigned og = xb_add(&bar[XB_TOP], 1u);
            const unsigned tg = og / nx;
            if (og + 1u == (tg + 1u) * nx) {
                xb_add(&bar[XB_TOPGEN], 1u);
#pragma unroll 1
                for (unsigned j = 0; j < 16; ++j) xb_add(&bar[XB_XGEN(j)], 1u);
            } else XB_SPIN(xb_ld(&bar[XB_TOPGEN]) == tg, bar);
            asm volatile("s_waitcnt vmcnt(0)" ::: "memory");
        } else {
            __builtin_amdgcn_fence(__ATOMIC_ACQUIRE, "agent");
            XB_SPIN(xb_ld(&bar[XB_XGEN(b.x)]) == gen, bar);
            asm volatile("s_waitcnt vmcnt(0)" ::: "memory");
        }
    }
    __syncthreads();
}

__device__ __forceinline__ void xcd_barrier_arrive(const XcdBarrier& b) {
    asm volatile("s_waitcnt vmcnt(0)" ::: "memory");
    __syncthreads();
    if (threadIdx.x == 0) {
        unsigned* bar = b.bar;
        __builtin_amdgcn_s_waitcnt(0);
        unsigned nloc = b.st[0], nx = b.st[1];
        if (nloc == 0u) { xcd_barrier_complete(bar, b.x, nloc, nx); b.st[0] = nloc; b.st[1] = nx; }
        const unsigned old = xb_add(&bar[XB_XSUB(b.x)], 1u);
        const unsigned gen = old / nloc;
        if (old + 1u == (gen + 1u) * nloc) {
            __builtin_amdgcn_fence(__ATOMIC_RELEASE, "agent");
            asm volatile("s_waitcnt vmcnt(0)" ::: "memory");
            const unsigned og = xb_add(&bar[XB_TOP], 1u);
            const unsigned tg = og / nx;
            if (og + 1u == (tg + 1u) * nx) {
                xb_add(&bar[XB_TOPGEN], 1u);
#pragma unroll 1
                for (unsigned j = 0; j < 16; ++j) xb_add(&bar[XB_XGEN(j)], 1u);
            } else XB_SPIN(xb_ld(&bar[XB_TOPGEN]) == tg, bar);
            asm volatile("s_waitcnt vmcnt(0)" ::: "memory");
            b.st[5] = 0xffffffffu;
        } else b.st[5] = gen;
    }
}
__device__ __forceinline__ void xcd_barrier_wait(const XcdBarrier& b) {
    asm volatile("s_waitcnt vmcnt(0) lgkmcnt(0)" ::: "memory");
    __syncthreads();
    if (threadIdx.x == 0) {
        unsigned* bar = b.bar;
        const unsigned gen = b.st[5];
        __builtin_amdgcn_fence(__ATOMIC_ACQUIRE, "agent");
        if (gen != 0xffffffffu) XB_SPIN(xb_ld(&bar[XB_XGEN(b.x)]) == gen, bar);
        asm volatile("s_waitcnt vmcnt(0)" ::: "memory");
    }
    __syncthreads();
}
__device__ __forceinline__ void shadow_convert(const float* src, bf16* dst, int n4, int wave_s) {
    if (wave_s == 0) return;
    const int t7 = (int)blockIdx.x * (7 * 64) + (wave_s - 1) * 64 + lane_opaque(), N7 = (int)gridDim.x * 7 * 64;
    for (int i = t7; i < n4; i += 4 * N7) { f32x4 v[4];
#pragma unroll
        for (int q = 0; q < 4; ++q) v[q] = ((const f32x4*)src)[(i + q * N7 < n4) ? i + q * N7 : i];
#pragma unroll
        for (int q = 0; q < 4; ++q) if (i + q * N7 < n4) ((unsigned long long*)dst)[i + q * N7] = (unsigned long long)pk2(v[q].x, v[q].y) | ((unsigned long long)pk2(v[q].z, v[q].w) << 32); }
}
__device__ __forceinline__ float wave_sum(float v) {
#pragma unroll
    for (int o = 1; o < 64; o <<= 1) v += __builtin_bit_cast(float, __builtin_amdgcn_ds_bpermute((lane_opaque() ^ o) << 2, __builtin_bit_cast(int, v)));
    return v;
}
__device__ __forceinline__ int vcu_of(int i, int n) { return i; }
__device__ __forceinline__ int unperm16(int d) { return d < 16 ? ((d >> 1) + 8 * (d & 1)) : d; }
__device__ __forceinline__ int map_col(int type, int n, int nold) {
    if (type == 0) return n < nold ? n : -1;
    if (type == 1) {
        if (n < 512) return n;
        if (n < 1024) { const int h = (n - 512) >> 6, d = (n - 512) & 63; return 512 + 64 * h + unperm16(d); }
        if (n < 1088) return 1024 + unperm16(n - 1024);
        if (n < 1152) return n;
        if (n < 1216) return 1408 + unperm16(n - 1152);
        if (n < 1220) return 1472 + (n - 1216);
        if (n < 1280) return -1;
        { const int h = (n - 1280) >> 6, d = (n - 1280) & 63; return 1152 + 64 * h + unperm16(d); }
    }
    if (type == 2) {
        if (n < 1536) return n;
        if (n < 2560) return n + 8;
        if (n < 2568) return 1536 + (n - 2560);
        return -1;
    }
    { const int pn = n >> 8, bj = (n >> 7) & 1, jj = n & 127; return bj * DFF + 128 * pn + jj; }
}
struct TJob { const float* W; const float* rowscale; bf16* WT; int K, Nold, Nnew, ldk, koff, type, nitems; };
__device__ __forceinline__ void transpose_item(const TJob& J, LAS float* scr, int item, int lane) {
    const int nblk = J.Nnew / 32, kb = item / nblk, nb = item % nblk, k0 = 64 * kb, n0 = 32 * nb;
    const int oc = map_col(J.type, n0 + (lane & 31), J.Nold);
    const int occ = oc >= 0 ? oc : 0;
    float vv[32];
#pragma unroll
    for (int i = 0; i < 32; ++i) vv[i] = J.W[(size_t)(k0 + 2 * i + (lane >> 5)) * J.Nold + occ];
#pragma unroll
    for (int i = 0; i < 32; ++i) { const int kk = 2 * i + (lane >> 5);
        float v = (oc >= 0) ? vv[i] : 0.f;
        if (J.rowscale) v *= J.rowscale[k0 + kk];
        scr[kk * 33 + (lane & 31)] = v; }
    LDS_WAIT(); asm volatile("" ::: "memory");
    const int c = lane & 7;
#pragma unroll
    for (int j = 0; j < 4; ++j) { const int n = (lane >> 3) + 8 * j; const LAS float* s = scr + (8 * c) * 33 + n;
        v4u o; o.x = pk2(s[0 * 33], s[1 * 33]); o.y = pk2(s[2 * 33], s[3 * 33]); o.z = pk2(s[4 * 33], s[5 * 33]); o.w = pk2(s[6 * 33], s[7 * 33]);
        *(GAS v4u*)(J.WT + (size_t)(n0 + n) * J.ldk + J.koff + k0 + 8 * c) = o; }
    LDS_WAIT(); asm volatile("" ::: "memory");
}
__device__ __forceinline__ void ti_load(const TJob& J, int item, int lane, float (&vv)[32], f32x4& ra, f32x4& rb, int& oc) {
    const int nblk = J.Nnew / 32, kb = item / nblk, nb = item % nblk, k0 = 64 * kb, n0 = 32 * nb;
    oc = map_col(J.type, n0 + (lane & 31), J.Nold);
    const int occ = oc >= 0 ? oc : 0;
#pragma unroll
    for (int i = 0; i < 32; ++i) vv[i] = J.W[(size_t)(k0 + 2 * i + (lane >> 5)) * J.Nold + occ];
    ra = (f32x4){1.f, 1.f, 1.f, 1.f}; rb = ra;
    if (J.rowscale) { const f32x4* rp = (const f32x4*)(J.rowscale + k0 + 8 * (lane & 7)); ra = rp[0]; rb = rp[1]; }
}
__device__ __forceinline__ void ti_finish(const TJob& J, LAS float* scr, int item, int lane, const float (&vv)[32], const f32x4 ra, const f32x4 rb, const int oc) {
    const int nblk = J.Nnew / 32, kb = item / nblk, nb = item % nblk, k0 = 64 * kb, n0 = 32 * nb;
#pragma unroll
    for (int i = 0; i < 32; ++i) { const int kk = 2 * i + (lane >> 5); scr[kk * 33 + (lane & 31)] = (oc >= 0) ? vv[i] : 0.f; }
    LDS_WAIT(); asm volatile("" ::: "memory");
    const int c = lane & 7;
#pragma unroll
    for (int j = 0; j < 4; ++j) { const int n = (lane >> 3) + 8 * j; const LAS float* s = scr + (8 * c) * 33 + n;
        v4u o; o.x = pk2(s[0 * 33] * ra[0], s[1 * 33] * ra[1]); o.y = pk2(s[2 * 33] * ra[2], s[3 * 33] * ra[3]); o.z = pk2(s[4 * 33] * rb[0], s[5 * 33] * rb[1]); o.w = pk2(s[6 * 33] * rb[2], s[7 * 33] * rb[3]);
        *(GAS v4u*)(J.WT + (size_t)(n0 + n) * J.ldk + J.koff + k0 + 8 * c) = o; }
    LDS_WAIT(); asm volatile("" ::: "memory");
}
__device__ __forceinline__ void sincos_d(double a, float& sn, float& cs) {
    const double q = rint(a * 0.63661977236758134308);
    double r = a - q * 1.57079632673412561417e+00; r -= q * 6.07710050650619224932e-11;
    const double r2 = r * r;
    double s = 1.0 / 6227020800.0; s = s * r2 - 1.0 / 39916800.0; s = s * r2 + 1.0 / 362880.0; s = s * r2 - 1.0 / 5040.0; s = s * r2 + 1.0 / 120.0; s = s * r2 - 1.0 / 6.0; s = s * r2 * r + r;
    double c = -1.0 / 87178291200.0; c = c * r2 + 1.0 / 479001600.0; c = c * r2 - 1.0 / 3628800.0; c = c * r2 + 1.0 / 40320.0; c = c * r2 - 1.0 / 720.0; c = c * r2 + 1.0 / 24.0; c = c * r2 - 0.5; c = c * r2 + 1.0;
    const int qi = ((int)q) & 3;
    const double ss = (qi == 0) ? s : (qi == 1) ? c : (qi == 2) ? -s : -c;
    const double cc = (qi == 0) ? c : (qi == 1) ? -s : (qi == 2) ? -c : s;
    sn = (float)ss; cs = (float)cc;
}

struct Args { const void* in[24]; float* out; unsigned char* ws; int ph_lo, ph_hi; };
typedef const Args __attribute__((address_space(4)))* argp_t;
__device__ __forceinline__ argp_t get_args() { argp_t p = (argp_t)__builtin_amdgcn_kernarg_segment_ptr(); asm volatile("" : "+s"(p)); return p; }
__device__ __forceinline__ int otid(int wave_s) { return wave_s * 64 + lane_opaque(); }
#define IN_F(k) ((const float*)A_->in[k])
#define PH_LOCALS \
    argp_t A_ = get_args(); unsigned char* const ws = A_->ws; float* const out = A_->out; (void)out; \
    const int tid = otid(wave_s), lane = tid & 63, wave = wave_s; (void)lane; (void)wave; \
    const int G = gridDim.x, bx = blockIdx.x, vcu = (G % 8 == 0) ? (bx % 8) * (G / 8) + bx / 8 : bx; (void)vcu; \
    const int gw = vcu * NWAVES + wave, NGW = G * NWAVES, gt = vcu * (NWAVES * 64) + tid, NGT = G * NWAVES * 64; (void)gw; (void)NGW; (void)gt; (void)NGT; \
    LAS unsigned char* const L = (LAS unsigned char*)lds; (void)L;
#define WSP(T, off) ((T*)(ws + (off)))

__global__ void __launch_bounds__(NWAVES * 64, 2) mega_fwd(Args args) {
    extern __shared__ __attribute__((aligned(16))) unsigned char lds[];
    int lo, hi; XcdBarrier bar;
    const int wave_s = __builtin_amdgcn_readfirstlane((int)threadIdx.x >> 6);
    {
        PH_LOCALS
        volatile LAS unsigned* MISC = (volatile LAS unsigned*)(L + MISC_OFF);
        for (int u = tid; u < (LDS_BYTES - XB_OFF) / 4; u += NWAVES * 64) ((LAS unsigned*)(L + XB_OFF))[u] = 0u;
        __syncthreads();
        bar = xcd_barrier_post((unsigned*)(ws + WS_CTL) + CW_BAR, MISC + 8);
        if (tid == 0) __hip_atomic_store((unsigned*)(ws + WS_CTL) + CW_XTAB + 1024 + bx, bar.x + 1u, __ATOMIC_RELAXED, __HIP_MEMORY_SCOPE_AGENT);
        lo = A_->ph_lo; hi = A_->ph_hi;
    }
#ifndef DBG_REP_TR
#define DBG_REP_TR 1
#endif
#ifndef DBG_REP_HB
#define DBG_REP_HB 1
#endif
#ifndef DBG_REP_FOX
#define DBG_REP_FOX 1
#endif
#ifndef DBG_REP_DSA
#define DBG_REP_DSA 1
#endif
#ifndef DBG_REP_SGU
#define DBG_REP_SGU 1
#endif
#ifndef DBG_REP_POOL
#define DBG_REP_POOL 1
#endif
#ifndef PHMASK
#define PHMASK 0xff7fffu
#endif
#define IN(k) (((PHMASK >> (k)) & 1u) && lo <= (k) && (k) < hi)
#define SEAM(k) do { if (IN(k) && IN((k) + 1)) xcd_barrier(bar); } while (0)
#define SEAM_SPLIT(k, ...) do { if (IN(k)) { const bool bs_ = IN((k) + 1); if (bs_) xcd_barrier_arrive(bar); { __VA_ARGS__ } if (bs_) xcd_barrier_wait(bar); } } while (0)
    if (IN(0)) {
        PH_LOCALS
        LAS float* scr = (LAS float*)(L + wave * 16384);
        const float* norm_mix = IN_F(3); const float* norm_ffn = IN_F(4); const float* norm_ple = IN_F(5);
        const float* ffn_w_in = IN_F(6); const float* ffn_w_out = IN_F(9); const float* ple_w_proj = IN_F(10); const float* ple_w_gate = IN_F(11);
        const float* ev_w_in = IN_F(13); const float* ev_w_out = IN_F(14); const float* od_w_in = IN_F(17); const float* od_w_out = IN_F(18);
#define TJ(Wp, RS, WTp, K_, NOLD, NNEW, LDK, KOFF, TYPE) { constexpr int NI_ = ((K_) / 64) * ((NNEW) / 32); if (r < NI_) { const TJob J{(Wp), (RS), (WTp), (K_), (NOLD), (NNEW), (LDK), (KOFF), (TYPE), NI_}; transpose_item(J, scr, r, lane); continue; } r -= NI_; }
        constexpr int NITEMS = 16 * 48 + 8 * 32;
        for (int rep_ = 0; rep_ < DBG_REP_TR; ++rep_) for (int it = gw; it < NITEMS; it += NGW) {
            int r = it;
            TJ(ev_w_in, norm_mix, WSP(bf16, WS_W_EVIN), 1024, 1476, EV_N, 1024, 0, 1)
            TJ(ev_w_out + (size_t)512 * 1024, nullptr, WSP(bf16, WS_W_OUT0), 512, 1024, 1024, 1024, 512, 0)
        }
#undef TJ
        { const float* sgu_w = IN_F(22); bf16* W_SGU = WSP(bf16, WS_W_SGU);
          for (int i = gt; i < 4 * 128 * 128; i += NGT) { const int jj = i & 127, ii = (i >> 7) & 127; W_SGU[i] = (bf16)((ii < 64 && jj >= 64) ? 0u : f2bf(sgu_w[i])); } }
        { const float* x = IN_F(0); bf16* HB = WSP(bf16, WS_HB); float* SSQA = WSP(float, WS_SSQA);
          for (int m = gw; m < TOK; m += 4 * NGW) {
            f32x4 v[4][4];
#pragma unroll
            for (int q = 0; q < 4; ++q) { const int mm = (m + q * NGW < TOK) ? m + q * NGW : m; const f32x4* xr = (const f32x4*)(x + (size_t)mm * DMODEL) + lane;
#pragma unroll
                for (int j = 0; j < 4; ++j) v[q][j] = xr[64 * j]; }
#pragma unroll
            for (int q = 0; q < 4; ++q) { const int mm = m + q * NGW; if (mm < TOK) {
                float s = 0.f; unsigned long long* o8 = (unsigned long long*)(HB + (size_t)mm * DMODEL) + lane;
#pragma unroll
                for (int j = 0; j < 4; ++j) { const f32x4 w = v[q][j]; s += (w.x * w.x + w.y * w.y) + (w.z * w.z + w.w * w.w);
                    o8[64 * j] = (unsigned long long)pk2(w.x, w.y) | ((unsigned long long)pk2(w.z, w.w) << 32); }
                s = wave_sum(s);
                if (lane < 16) SSQA[(size_t)mm * 16 + lane] = (lane == 0) ? s : 0.f; } }
          } }
        { const int* positions = (const int*)A_->in[2]; f32x2* ROPE = WSP(f32x2, WS_ROPE);
          for (int i = gt; i < TOK * 8; i += NGT) {
            const int row = i >> 3, j = i & 7;
            const float invf = (j == 0) ? 1.0f : (j == 1) ? 0.1939227432012558f : (j == 2) ? 0.03760603070259094f : (j == 3) ? 0.007292664609849453f : (j == 4) ? 0.0014142135623842478f :
                               (j == 5) ? 0.00027424818836152554f : (j == 6) ? 5.3182957344688475e-05f : 1.0313385246263351e-05f;
            const float ang = (float)positions[row] * invf;
            float sn, cs; sincos_d((double)ang, sn, cs);
            ROPE[i] = (f32x2){cs, sn};
          } }
    }
    if (IN(0) && IN(1)) { asm volatile("s_waitcnt vmcnt(0)" ::: "memory"); if (threadIdx.x < 64 && bar.st[0] == 0u) xcd_census_wave(bar.bar, bar.x, bar.st); }
    SEAM_SPLIT(0, { argp_t A_ = get_args(); shadow_convert((const float*)A_->in[1], (bf16*)(A_->ws + WS_PB), TOK * PLE / 4, wave_s); });
    if (IN(1)) {
        { PH_LOCALS
          pg8::Gemm g{WSP(bf16, WS_HB), WSP(bf16, WS_W_EVIN), TOK, EV_N, 1024}; pg8::StaticOrder S; S.init(TOK, EV_N, G, bx);
          pg8::EpiEvenIn E{WSP(float, WS_SSQA), WSP(bf16, WS_ZH), WSP(const pg8::f32x2, WS_ROPE)};
          pg8::gemm_phase<pg8::EpiEvenIn, pg8::StaticOrder, true, true>(L, g, S, E, wave_s); }
        if (gridDim.x == 256 && blockIdx.x >= 128) {
            PH_LOCALS
            LAS float* scr = (LAS float*)(L + wave * 16384);
            const float* norm_mix = IN_F(3); const float* norm_ffn = IN_F(4); const float* norm_ple = IN_F(5);
            const float* ffn_w_in = IN_F(6); const float* ffn_w_out = IN_F(9); const float* ple_w_proj = IN_F(10); const float* ple_w_gate = IN_F(11);
            const float* od_w_in = IN_F(17); const float* od_w_out = IN_F(18);
            const int gwb = (vcu_of(bx - 128, 128)) * NWAVES + wave, NGWB = 128 * NWAVES;
        {
            const float* pool_w = IN_F(15); const float* pool_scale = IN_F(16); const float* ev_w_out = IN_F(14); bf16* W_OUT0 = WSP(bf16, WS_W_OUT0);
            for (int it = gwb; it < 1024; it += NGWB) {
                const int g = it >> 8, nb = (it >> 4) & 15, cb = it & 15, n = 64 * nb + lane;
                {
                    const f32x4* pwg = (const f32x4*)(pool_w + ((size_t)g * 128 + 8 * cb) * 128);
#pragma unroll
                    for (int q = 0; q < 4; ++q) ((LAS f32x4*)scr)[64 * q + lane] = pwg[64 * q + lane];
                    if (lane < 32) ((LAS f32x4*)scr)[256 + lane] = ((const f32x4*)(pool_scale + 128 * g))[lane];
                }
                LDS_WAIT(); asm volatile("" ::: "memory");
                float acc[8];
#pragma unroll
                for (int cc = 0; cc < 8; ++cc) acc[cc] = 0.f;
#pragma unroll 1
                for (int d0 = 0; d0 < 128; d0 += 16) {
                    float wv[16];
#pragma unroll
                    for (int e = 0; e < 16; ++e) wv[e] = ev_w_out[(size_t)(128 * g + d0 + e) * 1024 + n];
#pragma unroll
                    for (int e4 = 0; e4 < 4; ++e4) { const f32x4 sc4 = ((const LAS f32x4*)scr)[256 + (d0 >> 2) + e4];
                        wv[4 * e4] *= sc4[0]; wv[4 * e4 + 1] *= sc4[1]; wv[4 * e4 + 2] *= sc4[2]; wv[4 * e4 + 3] *= sc4[3]; }
#pragma unroll
                    for (int cc = 0; cc < 8; ++cc) {
#pragma unroll
                        for (int e4 = 0; e4 < 4; ++e4) { const f32x4 pw4 = ((const LAS f32x4*)scr)[cc * 32 + (d0 >> 2) + e4];
                            acc[cc] += pw4[0] * wv[4 * e4] + pw4[1] * wv[4 * e4 + 1] + pw4[2] * wv[4 * e4 + 2] + pw4[3] * wv[4 * e4 + 3]; }
                    }
                }
#pragma unroll
                for (int c2 = 0; c2 < 4; ++c2) *(unsigned*)(W_OUT0 + (size_t)n * 1024 + 128 * g + 8 * cb + 2 * c2) = pk2(acc[2 * c2], acc[2 * c2 + 1]);
                LDS_WAIT(); asm volatile("" ::: "memory");
            }
        }
        }
    }
    SEAM_SPLIT(1, { argp_t A_ = get_args(); shadow_convert((const float*)A_->in[1] + (size_t)TOK * PLE, (bf16*)A_->out + (size_t)16 * 1024 * 1024, TOK * PLE / 4, wave_s); });
    if (IN(2)) {
        { PH_LOCALS
          const bf16* ZH = WSP(bf16, WS_ZH); bf16* Y = WSP(bf16, WS_Y); const unsigned lds0 = (unsigned)(uintptr_t)lds;
          for (int pi = vcu; pi < 256; pi += G) {
            const int b = pi >> 5, s = pi & 31;
#pragma unroll 1
            for (int k = 0; k < 2 * DBG_REP_DSA; ++k) mix::dsa_unit(b, (k & 1) ? s : 63 - s, ZH, Y, (char*)lds, lds0, wave_s);
          } }
        { PH_LOCALS
          const bf16* ZH = WSP(bf16, WS_ZH); bf16* Y = WSP(bf16, WS_Y);
          for (int rep_ = 0; rep_ < DBG_REP_POOL; ++rep_) for (int it = gt; it < TOK * 64; it += NGT) mix::pool_item(it, ZH, Y);
        }
    }
    if (IN(2)) { const bool bs_ = IN(3); if (bs_) xcd_barrier_arrive(bar);
      { PH_LOCALS
        if (wave > 0) {
            LAS float* scr = (LAS float*)(L + wave * 16384);
            const float* norm_ffn = IN_F(4); const float* norm_ple = IN_F(5);
            const float* ffn_w_in = IN_F(6); const float* ffn_w_out = IN_F(9); const float* ple_w_proj = IN_F(10); const float* ple_w_gate = IN_F(11);
            constexpr int NITEMS_B = (16 * 176 + 44 * 32 + 4 * 32);
            const int gwb = bx * 7 + (wave - 1), NGWB = G * 7;
#define TJR(Wp, RS, WTp, K_, NOLD, NNEW, LDK, KOFF, TYPE) if (!done_) { constexpr int NI_ = ((K_) / 64) * ((NNEW) / 32); if (r_ < NI_) { J_ = TJob{(Wp), (RS), (WTp), (K_), (NOLD), (NNEW), (LDK), (KOFF), (TYPE), NI_}; done_ = true; } else r_ -= NI_; }
#define RESOLVE_B(it_, Jarg_, rarg_) { bool done_ = false; TJob& J_ = (Jarg_); int& r_ = (rarg_); r_ = (it_); \
                TJR(ffn_w_in, norm_ffn, WSP(bf16, WS_W_FFI0), 1024, NFF2, NFF2, 1024, 0, 3) \
                TJR(ffn_w_out, nullptr, WSP(bf16, WS_W_FFO0), DFF, 1024, 1024, DFF, 0, 0) \
                TJR(ple_w_proj, nullptr, WSP(bf16, WS_W_PP0), 256, 1024, 1024, 256, 0, 0) }
            int it = gwb, rc = 0, oca = 0; bool hc = it < NITEMS_B; TJob Jc{}; float va[32]; f32x4 raa = {1.f, 1.f, 1.f, 1.f}, rba = raa;
            if (hc) { RESOLVE_B(it, Jc, rc) ti_load(Jc, rc, lane, va, raa, rba, oca); }
            while (hc) {
                const int itn = it + NGWB; const bool hn = itn < NITEMS_B; TJob Jn{}; int rn = 0, ocb = 0; float vb[32]; f32x4 rab = raa, rbb = rba;
                if (hn) { RESOLVE_B(itn, Jn, rn) ti_load(Jn, rn, lane, vb, rab, rbb, ocb); }
                ti_finish(Jc, scr, rc, lane, va, raa, rba, oca);
                if (hn) {
#pragma unroll
                    for (int i = 0; i < 32; ++i) va[i] = vb[i];
                    Jc = Jn; rc = rn; oca = ocb; raa = rab; rba = rbb;
                }
                hc = hn; it = itn;
            }
#undef RESOLVE_B
#undef TJR
        } }
      if (bs_) xcd_barrier_wait(bar); }
    {
        const size_t s1o = (0 == 0) ? WS_SSQA : WS_SSQB, s2o = (0 == 0) ? WS_SSQB : WS_SSQA, s3o = s1o;
        if (IN(3)) {
            PH_LOCALS
            pg8::Gemm g{WSP(bf16, WS_Y), WSP(bf16, (0 == 0) ? WS_W_OUT0 : WS_W_OUT1), TOK, 1024, 1024}; pg8::StaticOrder S; S.init(TOK, 1024, G, bx);
            { pg8::Unit u0; if (S.next(0, u0) && tid == 0) __hip_atomic_store((unsigned*)(ws + WS_CTL) + CW_XTAB + u0.pm * 4 + u0.pn, bar.x + 1u, __ATOMIC_RELAXED, __HIP_MEMORY_SCOPE_AGENT); }
            pg8::EpiRes E{nullptr, WSP(bf16, WS_HB), WSP(bf16, WS_HB), WSP(float, s1o), WSP(bf16, WS_AHALO), nullptr, false};
            pg8::gemm_phase<pg8::EpiRes, pg8::StaticOrder, true, true>(L, g, S, E, wave_s);
        }
        if (IN(3)) { const bool bs_ = IN(4) || IN(5); if (bs_) xcd_barrier_arrive(bar);
          { PH_LOCALS
            if (wave > 0) {
                LAS float* scr = (LAS float*)(L + wave * 16384);
                const float* ple_w_gate = IN_F(11); const float* norm_ple = IN_F(5);
#define TJ(Wp, RS, WTp, K_, NOLD, NNEW, LDK, KOFF, TYPE) { constexpr int NI_ = ((K_) / 64) * ((NNEW) / 32); if (r < NI_) { const TJob J{(Wp), (RS), (WTp), (K_), (NOLD), (NNEW), (LDK), (KOFF), (TYPE), NI_}; transpose_item(J, scr, r, lane); continue; } r -= NI_; }
                for (int it = bx * 7 + (wave - 1); it < 16 * 32; it += G * 7) {
                    int r = it;
                    TJ(ple_w_gate, norm_ple, WSP(bf16, WS_W_PG0), 1024, 1024, 1024, 1024, 0, 0)
                }
#undef TJ
            } }
          if (bs_) xcd_barrier_wait(bar); }
        if (IN(3 + 2)) {
            PH_LOCALS
            pg8::Gemm g{WSP(bf16, WS_HB), WSP(bf16, WS_W_FFI0), TOK + 256, NFF2, 1024}; pg8::StaticOrder S; S.init(TOK, NFF2, G, bx);
            if (G == 256 && !(bx >= 128 && bx < 128 + NFF2 / 256)) {
                LAS float* scr = (LAS float*)(L + wave * 16384);
                const float* od_w_in = IN_F(17); const float* norm_mix = IN_F(3); const float* ple_w_proj = IN_F(10);
#define TJ(Wp, RS, WTp, K_, NOLD, NNEW, LDK, KOFF, TYPE) { constexpr int NI_ = ((K_) / 64) * ((NNEW) / 32); if (r < NI_) { const TJob J{(Wp), (RS), (WTp), (K_), (NOLD), (NNEW), (LDK), (KOFF), (TYPE), NI_}; transpose_item(J, scr, r, lane); continue; } r -= NI_; }
                const int wgi = bx < 128 ? bx : bx - 22;
                for (int it = wgi * NWAVES + wave; it < 16 * 88 + 4 * 32; it += 234 * NWAVES) {
                    int r = it;
                    TJ(od_w_in, norm_mix + 1024, WSP(bf16, WS_W_ODIN), 1024, 2568, OD_N, 1024, 0, 2)
                    TJ(ple_w_proj + (size_t)256 * 1024, nullptr, WSP(bf16, WS_W_PP1), 256, 1024, 1024, 256, 0, 0)
                }
#undef TJ
                asm volatile("s_waitcnt vmcnt(0) lgkmcnt(0)" ::: "memory"); __syncthreads();
            }
#ifdef STAGGER
            if (STAGGER_COND) { for (int i_ = 0; i_ < STAGGER; ++i_) __builtin_amdgcn_s_sleep(127); }
#endif
            if (G == 256 && bx >= 128 && bx < 128 + NFF2 / 256) {
                pg8::OneUnit S1{64, bx - 128, 1};
                pg8::EpiHaloF EH{WSP(float, s1o), WSP(float, WS_AH), (unsigned*)(ws + WS_CTL) + CW_FLAG + 2048 * 0};
                pg8::gemm_phase<pg8::EpiHaloF, pg8::OneUnit, true, true>(L, g, S1, EH, wave_s);
            }
#ifdef PP_FIRST
            if (G == 256 && bx >= 150) {
                pg8::Gemm gp{WSP(bf16, WS_PB), WSP(bf16, WS_W_PP0), TOK, 1024, PLE}; pg8::StaticOrder SP; SP.init(TOK, 1024, 106, bx - 150);
                pg8::EpiBf16Plain EP{WSP(bf16, WS_PP), 1024};
                pg8::gemm_phase<pg8::EpiBf16Plain, pg8::StaticOrder, true, true>(L, gp, SP, EP, wave_s);
            }
#endif
            pg8::EpiFfnIn E{WSP(float, s1o), IN_F(7) + (size_t)0 * 3 * NFF2, IN_F(8) + (size_t)0 * NFF2, WSP(float, WS_AH), WSP(bf16, WS_ZH), (LAS float*)(L + XB_OFF), (unsigned*)(ws + WS_CTL) + CW_FLAG + 2048 * 0, 1u};
            pg8::gemm_phase<pg8::EpiFfnIn, pg8::StaticOrder, true, true>(L, g, S, E, wave_s);
#ifndef PP_FIRST
            if (G == 256 && bx >= 150) {
                pg8::Gemm gp{WSP(bf16, WS_PB), WSP(bf16, WS_W_PP0), TOK, 1024, PLE}; pg8::StaticOrder SP; SP.init(TOK, 1024, 106, bx - 150);
                pg8::EpiBf16Plain EP{WSP(bf16, WS_PP), 1024};
                pg8::gemm_phase<pg8::EpiBf16Plain, pg8::StaticOrder, true, true>(L, gp, SP, EP, wave_s);
            }
#endif
        }
        SEAM_SPLIT(3 + 2, { PH_LOCALS (void)tid;
            if (wave == 0) { pg8::StaticOrder S8; S8.init(TOK, OD_N, G, bx); bool loc = true;
                for (int i_ = 0; i_ < 3; ++i_) { pg8::Unit u8; if (S8.next(i_, u8)) { const unsigned* xt = (const unsigned*)(ws + WS_CTL) + CW_XTAB + u8.pm * 4;
                    for (int q_ = 0; q_ < 4; ++q_) loc = loc && (__builtin_amdgcn_readfirstlane((int)__hip_atomic_load(xt + q_, __ATOMIC_RELAXED, __HIP_MEMORY_SCOPE_AGENT)) == (int)(bar.x + 1u)); } }
                if (!loc && lane == 0) __hip_atomic_store((unsigned*)(ws + WS_CTL) + CW_XTAB + 512, 1u, __ATOMIC_RELAXED, __HIP_MEMORY_SCOPE_AGENT);
                { const unsigned xv = __hip_atomic_load((unsigned*)(ws + WS_CTL) + CW_XTAB + 1024 + (bx & 7) + 8 * (lane & 31), __ATOMIC_RELAXED, __HIP_MEMORY_SCOPE_AGENT);
                  const bool grp = (G == 256) && (__builtin_amdgcn_ballot_w64(xv != bar.x + 1u) == 0ull);
                  if (!grp && lane == 0) __hip_atomic_store((unsigned*)(ws + WS_CTL) + CW_XTAB + 513, 1u, __ATOMIC_RELAXED, __HIP_MEMORY_SCOPE_AGENT); } } });
        if (IN(3 + 3)) {
            PH_LOCALS
            pg8::Gemm g{WSP(bf16, WS_ZH), WSP(bf16, (0 == 0) ? WS_W_FFO0 : WS_W_FFO1), TOK, 1024, DFF}; pg8::StaticOrder S; S.init(TOK, 1024, G, bx);
            bool same_xcd = true;
            { pg8::Unit u0; if (S.next(0, u0)) { const unsigned* xt = (const unsigned*)(ws + WS_CTL) + CW_XTAB + u0.pm * 4;
                const int x0_ = __builtin_amdgcn_readfirstlane((int)__hip_atomic_load(xt + u0.pn, __ATOMIC_RELAXED, __HIP_MEMORY_SCOPE_AGENT));
#pragma unroll
                for (int q_ = 0; q_ < 4; ++q_) same_xcd = same_xcd && (__builtin_amdgcn_readfirstlane((int)__hip_atomic_load(xt + q_, __ATOMIC_RELAXED, __HIP_MEMORY_SCOPE_AGENT)) == x0_) && x0_ != 0; } }
            pg8::EpiRes E{nullptr, WSP(bf16, WS_HB), WSP(bf16, WS_HB), WSP(float, s2o), nullptr, (unsigned*)(ws + WS_CTL) + CW_PAN + 8192 * 1, !same_xcd};
            pg8::gemm_phase<pg8::EpiRes, pg8::StaticOrder, true, true>(L, g, S, E, wave_s);
        }
        if (IN(3 + 4)) {
            PH_LOCALS
            pg8::Gemm g{WSP(bf16, WS_HB), WSP(bf16, (0 == 0) ? WS_W_PG0 : WS_W_PG1), TOK, 1024, 1024}; pg8::StaticOrder S; S.init(TOK, 1024, G, bx);
            bool same_xcd = true;
            { pg8::Unit u0; if (S.next(0, u0)) { const unsigned* xt = (const unsigned*)(ws + WS_CTL) + CW_XTAB + u0.pm * 4;
                const int x0_ = __builtin_amdgcn_readfirstlane((int)__hip_atomic_load(xt + u0.pn, __ATOMIC_RELAXED, __HIP_MEMORY_SCOPE_AGENT));
#pragma unroll
                for (int q_ = 0; q_ < 4; ++q_) same_xcd = same_xcd && (__builtin_amdgcn_readfirstlane((int)__hip_atomic_load(xt + q_, __ATOMIC_RELAXED, __HIP_MEMORY_SCOPE_AGENT)) == x0_) && x0_ != 0; } }
            pg8::PanelOrder SPn{S, (unsigned*)(ws + WS_CTL) + CW_PAN + 8192 * 1, 4u, wave_s, !same_xcd};
            pg8::EpiGate E{WSP(float, s2o), WSP(bf16, WS_HB), WSP(bf16, WS_PP), (bf16*)out, WSP(float, s3o), (LAS float*)(L + XB_OFF) + 2048};
            pg8::gemm_phase<pg8::EpiGate, pg8::PanelOrder, true, true>(L, g, SPn, E, wave_s);
        }
        do { if (IN(3 + 4) && IN(3 + 5)) { argp_t A7_ = get_args(); xcd_barrier(bar, (unsigned*)(A7_->ws + WS_CTL) + CW_XTAB + 512); } } while (0);
    }
    {

            if (IN(8)) {
                { PH_LOCALS
                  pg8::Gemm g{(const bf16*)out, WSP(bf16, WS_W_ODIN), TOK, OD_N, 1024}; pg8::StaticOrder S; S.init(TOK, OD_N, G, bx);
                  pg8::EpiOddIn E{WSP(float, WS_SSQA), WSP(bf16, WS_ZH), WSP(float, WS_FBUF), WSP(float, WS_SST)};
                  pg8::gemm_phase<pg8::EpiOddIn, pg8::StaticOrder, true, true>(L, g, S, E, wave_s); }
                if (gridDim.x == 256 && blockIdx.x >= 192) {
                    PH_LOCALS
                    LAS float* scr = (LAS float*)(L + wave * 16384);
                    const float* norm_ffn = IN_F(4); const float* ffn_w_in = IN_F(6); const float* od_w_out = IN_F(18);
#define TJ(Wp, RS, WTp, K_, NOLD, NNEW, LDK, KOFF, TYPE) { constexpr int NI_ = ((K_) / 64) * ((NNEW) / 32); if (r < NI_) { const TJob J{(Wp), (RS), (WTp), (K_), (NOLD), (NNEW), (LDK), (KOFF), (TYPE), NI_}; transpose_item(J, scr, r, lane); continue; } r -= NI_; }
                    constexpr int NITEMS_C = 16 * 176 + 16 * 32;
                    const int gwc = (bx - 192) * NWAVES + wave, NGWC = 64 * NWAVES;
                    for (int it = gwc; it < NITEMS_C; it += NGWC) {
                        int r = it;
                        TJ(ffn_w_in + (size_t)1024 * NFF2, norm_ffn + 1024, WSP(bf16, WS_W_FFI1), 1024, NFF2, NFF2, 1024, 0, 3)
                        TJ(od_w_out, nullptr, WSP(bf16, WS_W_OUT1), 1024, 1024, 1024, 1024, 0, 0)
                    }
#undef TJ
                }
            }
            SEAM(8);
            if (IN(9)) {
                { PH_LOCALS
                  const bf16* ZH = WSP(bf16, WS_ZH); bf16* Y = WSP(bf16, WS_Y); const unsigned lds0 = (unsigned)(uintptr_t)lds;
                  const float* FBUF = WSP(float, WS_FBUF); const float* fox_b_f = IN_F(19);
                  for (int pi = vcu; pi < 256; pi += G) {
                    const int bh = pi >> 2, s = pi & 3;
#pragma unroll 1
                    for (int k = 0; k < 2 * DBG_REP_FOX; ++k) mix::fox_unit2(bh >> 3, bh & 7, (k & 1) ? s : 7 - s, ZH, FBUF, fox_b_f, Y, (char*)lds, wave_s);
                  } }
                { PH_LOCALS
                  const bf16* ZH = WSP(bf16, WS_ZH); bf16* Y = WSP(bf16, WS_Y);
                  for (int rep_ = 0; rep_ < DBG_REP_SGU; ++rep_) for (int u = (G == 256) ? ((vcu >> 5) << 6) + (vcu & 31) : vcu; u < 512; u += (G == 256) ? ((u & 32) ? 512 : 32) : G) mix::sgu_unit(u >> 6, (u >> 2) & 15, u & 3, ZH, WSP(float, WS_SST), IN_F(20), IN_F(21), WSP(bf16, WS_W_SGU), IN_F(23), Y, (char*)lds, wave_s); }
            }
            do { if (IN(9) && IN(10)) { argp_t A9_ = get_args(); xcd_barrier(bar, (unsigned*)(A9_->ws + WS_CTL) + CW_XTAB + 513); } } while (0);
            }
    {
        const size_t s1o = (1 == 0) ? WS_SSQA : WS_SSQB, s2o = (1 == 0) ? WS_SSQB : WS_SSQA, s3o = s1o;
        if (IN(10)) {
            PH_LOCALS
            pg8::Gemm g{WSP(bf16, WS_Y), WSP(bf16, (1 == 0) ? WS_W_OUT0 : WS_W_OUT1), TOK, 1024, 1024}; pg8::StaticOrder S; S.init(TOK, 1024, G, bx);
            pg8::EpiRes E{nullptr, (const bf16*)out, WSP(bf16, WS_HB), WSP(float, s1o), WSP(bf16, WS_AHALO), nullptr, false};
            pg8::gemm_phase<pg8::EpiRes, pg8::StaticOrder, true, true>(L, g, S, E, wave_s);
        }
        SEAM(10);
        if (IN(10 + 2)) {
            PH_LOCALS
            pg8::Gemm g{WSP(bf16, WS_HB), WSP(bf16, WS_W_FFI1), TOK + 256, NFF2, 1024}; pg8::StaticOrder S; S.init(TOK, NFF2, G, bx);
            if (G == 256 && !(bx >= 128 && bx < 128 + NFF2 / 256)) {
                LAS float* scr = (LAS float*)(L + wave * 16384);
                const float* ffn_w_out = IN_F(9); const float* ple_w_gate = IN_F(11); const float* norm_ple = IN_F(5);
#define TJ(Wp, RS, WTp, K_, NOLD, NNEW, LDK, KOFF, TYPE) { constexpr int NI_ = ((K_) / 64) * ((NNEW) / 32); if (r < NI_) { const TJob J{(Wp), (RS), (WTp), (K_), (NOLD), (NNEW), (LDK), (KOFF), (TYPE), NI_}; transpose_item(J, scr, r, lane); continue; } r -= NI_; }
                const int wgi = bx < 128 ? bx : bx - 22;
                for (int it = wgi * NWAVES + wave; it < 44 * 32 + 16 * 32; it += 234 * NWAVES) {
                    int r = it;
                    TJ(ffn_w_out + (size_t)DFF * 1024, nullptr, WSP(bf16, WS_W_FFO1), DFF, 1024, 1024, DFF, 0, 0)
                    TJ(ple_w_gate + (size_t)1024 * 1024, norm_ple + 1024, WSP(bf16, WS_W_PG1), 1024, 1024, 1024, 1024, 0, 0)
                }
#undef TJ
                asm volatile("s_waitcnt vmcnt(0) lgkmcnt(0)" ::: "memory"); __syncthreads();
            }
#ifdef STAGGER
            if (STAGGER_COND) { for (int i_ = 0; i_ < STAGGER; ++i_) __builtin_amdgcn_s_sleep(127); }
#endif
            if (G == 256 && bx >= 128 && bx < 128 + NFF2 / 256) {
                pg8::OneUnit S1{64, bx - 128, 1};
                pg8::EpiHaloF EH{WSP(float, s1o), WSP(float, WS_AH), (unsigned*)(ws + WS_CTL) + CW_FLAG + 2048 * 1};
                pg8::gemm_phase<pg8::EpiHaloF, pg8::OneUnit, true, true>(L, g, S1, EH, wave_s);
            }
#ifdef PP_FIRST
            if (G == 256 && bx >= 150) {
                pg8::Gemm gp{(const bf16*)out + (size_t)16 * 1024 * 1024, WSP(bf16, WS_W_PP1), TOK, 1024, PLE}; pg8::StaticOrder SP; SP.init(TOK, 1024, 106, bx - 150);
                pg8::EpiBf16Plain EP{WSP(bf16, WS_PP), 1024};
                pg8::gemm_phase<pg8::EpiBf16Plain, pg8::StaticOrder, true, true>(L, gp, SP, EP, wave_s);
            }
#endif
            pg8::EpiFfnIn E{WSP(float, s1o), IN_F(7) + (size_t)1 * 3 * NFF2, IN_F(8) + (size_t)1 * NFF2, WSP(float, WS_AH), WSP(bf16, WS_ZH), (LAS float*)(L + XB_OFF), (unsigned*)(ws + WS_CTL) + CW_FLAG + 2048 * 1, 2u};
            pg8::gemm_phase<pg8::EpiFfnIn, pg8::StaticOrder, true, true>(L, g, S, E, wave_s);
#ifndef PP_FIRST
            if (G == 256 && bx >= 150) {
                pg8::Gemm gp{(const bf16*)out + (size_t)16 * 1024 * 1024, WSP(bf16, WS_W_PP1), TOK, 1024, PLE}; pg8::StaticOrder SP; SP.init(TOK, 1024, 106, bx - 150);
                pg8::EpiBf16Plain EP{WSP(bf16, WS_PP), 1024};
                pg8::gemm_phase<pg8::EpiBf16Plain, pg8::StaticOrder, true, true>(L, gp, SP, EP, wave_s);
            }
#endif
        }
        SEAM(10 + 2);
        if (IN(10 + 3)) {
            PH_LOCALS
            pg8::Gemm g{WSP(bf16, WS_ZH), WSP(bf16, (1 == 0) ? WS_W_FFO0 : WS_W_FFO1), TOK, 1024, DFF}; pg8::StaticOrder S; S.init(TOK, 1024, G, bx);
            bool same_xcd = true;
            { pg8::Unit u0; if (S.next(0, u0)) { const unsigned* xt = (const unsigned*)(ws + WS_CTL) + CW_XTAB + u0.pm * 4;
                const int x0_ = __builtin_amdgcn_readfirstlane((int)__hip_atomic_load(xt + u0.pn, __ATOMIC_RELAXED, __HIP_MEMORY_SCOPE_AGENT));
#pragma unroll
                for (int q_ = 0; q_ < 4; ++q_) same_xcd = same_xcd && (__builtin_amdgcn_readfirstlane((int)__hip_atomic_load(xt + q_, __ATOMIC_RELAXED, __HIP_MEMORY_SCOPE_AGENT)) == x0_) && x0_ != 0; } }
            pg8::EpiRes E{nullptr, WSP(bf16, WS_HB), WSP(bf16, WS_HB), WSP(float, s2o), nullptr, (unsigned*)(ws + WS_CTL) + CW_PAN + 8192 * 2, !same_xcd};
            pg8::gemm_phase<pg8::EpiRes, pg8::StaticOrder, true, true>(L, g, S, E, wave_s);
        }
        if (IN(10 + 4)) {
            PH_LOCALS
            pg8::Gemm g{WSP(bf16, WS_HB), WSP(bf16, (1 == 0) ? WS_W_PG0 : WS_W_PG1), TOK, 1024, 1024}; pg8::StaticOrder S; S.init(TOK, 1024, G, bx);
            bool same_xcd = true;
            { pg8::Unit u0; if (S.next(0, u0)) { const unsigned* xt = (const unsigned*)(ws + WS_CTL) + CW_XTAB + u0.pm * 4;
                const int x0_ = __builtin_amdgcn_readfirstlane((int)__hip_atomic_load(xt + u0.pn, __ATOMIC_RELAXED, __HIP_MEMORY_SCOPE_AGENT));
#pragma unroll
                for (int q_ = 0; q_ < 4; ++q_) same_xcd = same_xcd && (__builtin_amdgcn_readfirstlane((int)__hip_atomic_load(xt + q_, __ATOMIC_RELAXED, __HIP_MEMORY_SCOPE_AGENT)) == x0_) && x0_ != 0; } }
            pg8::PanelOrder SPn{S, (unsigned*)(ws + WS_CTL) + CW_PAN + 8192 * 2, 4u, wave_s, !same_xcd};
            pg8::EpiGateFinal E{WSP(float, s2o), WSP(bf16, WS_HB), WSP(bf16, WS_PP), WSP(float, s3o), (unsigned*)(ws + WS_CTL) + CW_PAN, IN_F(12), out, (LAS float*)(L + XB_OFF) + 2048, !same_xcd};
            pg8::gemm_phase<pg8::EpiGateFinal, pg8::PanelOrder, true, true>(L, g, SPn, E, wave_s);
        }
        SEAM(10 + 4);
    }
    if (IN(15)) {
        PH_LOCALS
        const float* SSQB = WSP(float, WS_SSQB); const float* norm_final = IN_F(12); const bf16* H6 = WSP(bf16, WS_Y);
        for (int m = gw; m < TOK; m += 4 * NGW) {
            unsigned long long w[4][4]; float rs[4];
#pragma unroll
            for (int q = 0; q < 4; ++q) { const int mm = (m + q * NGW < TOK) ? m + q * NGW : m; rs[q] = pg8::row_rstd(SSQB, mm);
                const unsigned long long* hr = (const unsigned long long*)(H6 + (size_t)mm * DMODEL) + lane;
#pragma unroll
                for (int j = 0; j < 4; ++j) w[q][j] = hr[64 * j]; }
            const f32x4* gr = (const f32x4*)norm_final + lane;
            f32x4 gg[4];
#pragma unroll
            for (int j = 0; j < 4; ++j) gg[j] = gr[64 * j];
#pragma unroll
            for (int q = 0; q < 4; ++q) { const int mm = m + q * NGW; if (mm < TOK) { f32x4* xr = (f32x4*)(out + (size_t)mm * DMODEL) + lane;
#pragma unroll
                for (int j = 0; j < 4; ++j) { const unsigned long long ww = w[q][j];
                    const f32x4 v = {pg8::bf_lo((unsigned)ww), pg8::bf_hi((unsigned)ww), pg8::bf_lo((unsigned)(ww >> 32)), pg8::bf_hi((unsigned)(ww >> 32))};
                    __builtin_nontemporal_store(v * rs[q] * gg[j], xr + 64 * j); } } }
        }
    }
#undef IN
#undef SEAM
}

#ifndef MK_N_LAUNCHES
#define MK_N_LAUNCHES 1
#endif
constexpr int N_PHASES = 16;
extern "C" void kernel_launch(void* const* d_in, const int* in_sizes, int n_in, void* d_out, int out_size, void* d_ws, size_t ws_size, hipStream_t stream) {
    static int grid = 0;
    if (grid == 0) {
        if (n_in != 24 || out_size != TOK * DMODEL || ws_size < WS_END) { fprintf(stderr, "kernel_launch: unexpected shapes (n_in %d, out %d, ws %zu)\n", n_in, out_size, ws_size); grid = -1; return; }
        int dev = 0, cus = 0;
        if (hipGetDevice(&dev) != hipSuccess || hipDeviceGetAttribute(&cus, hipDeviceAttributeMultiprocessorCount, dev) != hipSuccess) { grid = -1; return; }
        if (hipFuncSetAttribute((const void*)mega_fwd, hipFuncAttributeMaxDynamicSharedMemorySize, LDS_BYTES) != hipSuccess) { fprintf(stderr, "kernel_launch: hipFuncSetAttribute failed\n"); grid = -1; return; }
        int per_cu = 0;
        if (hipOccupancyMaxActiveBlocksPerMultiprocessor(&per_cu, (const void*)mega_fwd, NWAVES * 64, LDS_BYTES) != hipSuccess || per_cu < 1) { fprintf(stderr, "kernel_launch: occupancy query says %d\n", per_cu); }
        (void)hipGetLastError();
        grid = cus;
    }
    if (grid < 0) return;
    (void)hipMemsetAsync((char*)d_ws + WS_CTL, 0, CTL_ZERO_BYTES, stream);
    Args a{};
    for (int i = 0; i < 24; ++i) a.in[i] = d_in[i];
    a.out = (float*)d_out; a.ws = (unsigned char*)d_ws;
#ifdef DBG_CHECK
    {
        using namespace dbg;
        auto LP = [&](int ph) { a.ph_lo = ph; a.ph_hi = ph + 1; hipLaunchKernelGGL(mega_fwd, dim3(grid), dim3(NWAVES * 64), LDS_BYTES, stream, a); };
        char* wsb = (char*)d_ws; float* ERR = (float*)(wsb + 512 * 1024); float* SNAP = (float*)(wsb + 600 * 1024); float* outp = (float*)d_out;
        const unsigned short* ZHp = (const unsigned short*)(wsb + WS_ZH); const unsigned short* Yp = (const unsigned short*)(wsb + WS_Y); const float* FB = (const float*)(wsb + WS_FBUF);
        const unsigned short* HBp = (const unsigned short*)(wsb + WS_HB); const unsigned short* H3p = (const unsigned short*)d_out;
        auto F = [&](int i) { return (const float*)d_in[i]; };
        const float* x = F(0);
        LP(0); LP(1);
        k_evenin<<<NS, 256, 0, stream>>>(x, F(3), F(13), (const int*)d_in[2], ZHp, ERR, 0);
        LP(2);
        k_pool<<<NS, 256, 0, stream>>>(ZHp, Yp, ERR, 1);
        k_dsa<<<NS, 256, 0, stream>>>(ZHp, Yp, ERR, 2);
        LP(3);
        k_outproj<<<NS, 256, 0, stream>>>(x, 0, SNAP, Yp, F(14), F(15), F(16), HBp, ERR, 3);
        for (int layer = 0; layer < 2; ++layer) {
            const int pb = layer ? 10 : 3, kb = layer ? 10 : 3;
            if (layer == 1) {
                LP(8);
                k_oddin<<<NS, 256, 0, stream>>>(H3p, F(3) + 1024, F(17), ZHp, FB, ERR, 7);
                LP(9);
                k_fox<<<NS, 256, 0, stream>>>(ZHp, FB, F(19), Yp, ERR, 8);
                k_sgu<<<NS, 256, 0, stream>>>(ZHp, F(20), F(21), F(22), F(23), Yp, ERR, 9);
                k_snap<<<NS, 256, 0, stream>>>(H3p, SNAP);
                LP(10);
                k_outproj<<<NS, 256, 0, stream>>>(nullptr, 1, SNAP, Yp, F(18), nullptr, nullptr, HBp, ERR, 10);
            }
            LP(pb + 1); LP(pb + 2);
            k_ffnin<<<NS, 256, 0, stream>>>(HBp, F(4) + 1024 * layer, F(6) + (size_t)layer * 1024 * NFF2, F(7) + (size_t)layer * 3 * NFF2, F(8) + (size_t)layer * NFF2, ZHp, ERR, kb + 1);
            k_snap<<<NS, 256, 0, stream>>>(HBp, SNAP);
            LP(pb + 3);
            k_ffnout<<<NS, 256, 0, stream>>>(SNAP, ZHp, F(9) + (size_t)layer * DFF * 1024, HBp, ERR, kb + 2);
            k_snap<<<NS, 256, 0, stream>>>(HBp, SNAP);
            LP(pb + 4);
            k_ple<<<NS, 256, 0, stream>>>(SNAP, F(1) + (size_t)layer * TOK * PLE, F(5) + 1024 * layer, F(10) + (size_t)layer * PLE * 1024, F(11) + (size_t)layer * 1024 * 1024, layer ? Yp : H3p, ERR, kb + 3);
        }
        k_snap<<<NS, 256, 0, stream>>>(Yp, SNAP);
        LP(15);
        k_final<<<NS, 256, 0, stream>>>(SNAP, F(12), outp, ERR, 14);
        t_dpp<<<1, 64, 0, stream>>>(ERR + 40);
        k_report<<<1024, 256, 0, stream>>>(ERR, 15, DBG_TOL, outp);
        return;
    }
#endif
    if (MK_N_LAUNCHES == 1) {
        a.ph_lo = 0; a.ph_hi = N_PHASES;
        hipLaunchKernelGGL(mega_fwd, dim3(grid), dim3(NWAVES * 64), LDS_BYTES, stream, a);
    } else {
#ifndef DBG_STOP
#define DBG_STOP N_PHASES
#endif
#ifndef DBG_DOUBLE
#define DBG_DOUBLE -1
#endif
        for (int ph = 0; ph < DBG_STOP; ++ph) { a.ph_lo = ph; a.ph_hi = ph + 1; const int reps = (ph == DBG_DOUBLE || (DBG_DOUBLE == 100 && (ph == 0 || ph == 1 || ph == 2 || ph == 4 || ph == 5 || ph == 8 || ph == 9 || ph == 11 || ph == 12))) ? 2 : 1;
            for (int r = 0; r < reps; ++r) hipLaunchKernelGGL(mega_fwd, dim3(grid), dim3(NWAVES * 64), LDS_BYTES, stream, a); }
    }
}
```
